# Optimizing an MI355X kernel written in HIP

```python
import math
import jax, jax.numpy as jnp
from jax import lax
import numpy as np

D_MODEL = 4096
BATCH = 1
SEQ = 8192
DEPTH = 2

HEAD_DIM = 128
N_HEADS = D_MODEL // HEAD_DIM
ROPE_DIMS = HEAD_DIM // 4
ROPE_THETA = 500000.0
AXIAL_THETA = 10000.0
GRID_W = 64
Q_BLOCK = 128
A_HEADS = N_HEADS // 2
A_KV_HEADS = A_HEADS // 4
A_GROUP = A_HEADS // A_KV_HEADS
A_WINDOW = 128
B_PAIRS = ((128, 1), (512, 4), (2048, 16))
B_GROUP_HEADS = N_HEADS // 4
B_HEADS = len(B_PAIRS) * B_GROUP_HEADS
C_HEADS = N_HEADS // 4
D_HEADS = N_HEADS // 2
D_KV_HEADS = D_HEADS // 4
D_GROUP = D_HEADS // D_KV_HEADS
PEER_HEADS = 8
PEER_NKEYS = 128
PEER_EXPERTS = PEER_NKEYS * PEER_NKEYS
PEER_QDIM = 256
PEER_HALF = PEER_QDIM // 2
PEER_TOPK = 16
PEER_CHUNK = 128
DEEPNORM_ALPHA = (2 * DEPTH) ** 0.25
DEEPNORM_BETA = (8 * DEPTH) ** -0.25
N_EVEN = (DEPTH + 1) // 2
N_ODD = DEPTH // 2
LN_EPS = 1e-5
RMS_EPS = 1e-6
NEG_INF = -1e30

AB_SIZES = (A_HEADS * HEAD_DIM, A_KV_HEADS * HEAD_DIM, A_KV_HEADS * HEAD_DIM,
            B_HEADS * HEAD_DIM, B_HEADS * HEAD_DIM, B_HEADS * HEAD_DIM)
AB_OUT = (A_HEADS + B_GROUP_HEADS) * HEAD_DIM
CD_SIZES = (C_HEADS * 2 * HEAD_DIM, C_HEADS * 2 * HEAD_DIM, C_HEADS * 2 * HEAD_DIM,
            D_HEADS * HEAD_DIM, D_KV_HEADS * HEAD_DIM, D_KV_HEADS * HEAD_DIM)
CD_OUT = (2 * C_HEADS + D_HEADS) * HEAD_DIM

kernel_name = "hybrid_window_dilated_diff_axial_peer_encoder"


def layer_norm(x, g, b):
    xf = x.astype(jnp.float32)
    mu = xf.mean(-1, keepdims=True)
    var = jnp.square(xf - mu).mean(-1, keepdims=True)
    return ((xf - mu) * lax.rsqrt(var + LN_EPS) * g.astype(jnp.float32) + b.astype(jnp.float32)).astype(x.dtype)


def rms_norm(x, g):
    xf = x.astype(jnp.float32)
    return (xf * lax.rsqrt(jnp.square(xf).mean(-1, keepdims=True) + RMS_EPS) * g.astype(jnp.float32)).astype(x.dtype)


def rope(x, pos, start, n, theta):
    half = n // 2
    inv = theta ** (-jnp.arange(half, dtype=jnp.float32) / half)
    ang = pos.astype(jnp.float32)[:, None] * inv[None, :]
    cos, sin = jnp.cos(ang), jnp.sin(ang)
    xs = x[..., start:start + n].astype(jnp.float32)
    x1, x2 = xs[..., :half], xs[..., half:]
    rot = jnp.concatenate([x1 * cos - x2 * sin, x2 * cos + x1 * sin], -1).astype(x.dtype)
    return jnp.concatenate([x[..., :start], rot, x[..., start + n:]], -1)


def partial_rope(x, pos):
    return rope(x, pos, 0, ROPE_DIMS, ROPE_THETA)


def axial_rope(x, rows, cols):
    half = HEAD_DIM // 2
    return rope(rope(x, rows, 0, half, AXIAL_THETA), cols, half, half, AXIAL_THETA)


def split_cols(h, sizes):
    return jnp.split(h, np.cumsum(sizes)[:-1].tolist(), axis=-1)


def to_heads(t, n, dh):
    b, s, _ = t.shape
    return t.reshape(b, s, n, dh).transpose(0, 2, 1, 3)


def from_heads(o):
    b, h, s, dh = o.shape
    return o.transpose(0, 2, 1, 3).reshape(b, s, h * dh)


def banded_attention(q, k, v, window, block, sink=None):
    L, hd = q.shape[-2], q.shape[-1]
    nb = -(-L // block)
    pad = nb * block - L
    qb = jnp.pad(q, [(0, 0)] * (q.ndim - 2) + [(0, pad), (0, 0)])
    qb = qb.reshape(q.shape[:-2] + (nb, block, hd))

    def windows(a):
        ab = jnp.pad(a, [(0, 0)] * (a.ndim - 2) + [(block, pad + block), (0, 0)])
        ab = ab.reshape(a.shape[:-2] + (nb + 2, block, a.shape[-1]))
        return jnp.concatenate([ab[..., :-2, :, :], ab[..., 1:-1, :, :], ab[..., 2:, :, :]], axis=-2)

    kw, vw = windows(k), windows(v)
    s = jnp.einsum('...gnqd,...nkd->...gnqk', qb, kw,
                   preferred_element_type=jnp.float32) * (hd ** -0.5)
    qpos = jnp.arange(nb)[:, None] * block + jnp.arange(block)[None, :]
    kpos = (jnp.arange(nb)[:, None] - 1) * block + jnp.arange(3 * block)[None, :]
    mask = ((jnp.abs(qpos[:, :, None] - kpos[:, None, :]) <= window)
            & (kpos[:, None, :] >= 0) & (kpos[:, None, :] < L))
    s = jnp.where(mask, s, NEG_INF)
    m = s.max(-1)
    if sink is not None:
        sink_b = sink.astype(jnp.float32).reshape(sink.shape + (1, 1))
        m = jnp.maximum(m, sink_b)
    p = jnp.exp(s - m[..., None])
    denom = p.sum(-1)
    if sink is not None:
        denom = denom + jnp.exp(sink_b - m)
    o = jnp.einsum('...gnqk,...nkd->...gnqd', (p / denom[..., None]).astype(v.dtype), vw)
    o = o.reshape(q.shape[:-2] + (nb * block, hd))[..., :L, :]
    lse = (m + jnp.log(denom)).reshape(q.shape[:-2] + (nb * block,))[..., :L]
    return o, lse


def dilated_attention(q, k, v, dilation, n_side):
    b, h, s, hd = q.shape
    L = s // dilation
    fold = lambda t: t.reshape(b, h, L, dilation, hd).transpose(0, 1, 3, 2, 4)
    o, lse = banded_attention(fold(q)[:, :, :, None], fold(k), fold(v), n_side, n_side)
    o = o[:, :, :, 0].transpose(0, 1, 3, 2, 4).reshape(b, h, s, hd)
    lse = lse[:, :, :, 0].transpose(0, 1, 3, 2).reshape(b, h, s)
    return o, lse


def sweep_query_blocks(fn, qs):
    s = qs[0].shape[-2]
    nb = s // Q_BLOCK

    def split(a):
        return jnp.moveaxis(a.reshape(a.shape[:-2] + (nb, Q_BLOCK, a.shape[-1])), -3, 0)

    out = lax.map(lambda blks: fn(*blks), tuple(split(a) for a in qs))
    out = jnp.moveaxis(out, 0, -3)
    return out.reshape(out.shape[:-3] + (s, out.shape[-1]))


def even_mixer(x, w_in, sink, w_out, pos):
    b, s, _ = x.shape
    qa, ka, va, qb, kb, vb = split_cols(x @ w_in, AB_SIZES)
    qa = partial_rope(to_heads(qa, A_HEADS, HEAD_DIM), pos).reshape(b, A_KV_HEADS, A_GROUP, s, HEAD_DIM)
    ka = partial_rope(to_heads(ka, A_KV_HEADS, HEAD_DIM), pos)
    va = to_heads(va, A_KV_HEADS, HEAD_DIM)
    oa, _ = banded_attention(qa, ka, va, A_WINDOW, A_WINDOW, sink)
    oa = from_heads(oa.reshape(b, A_HEADS, s, HEAD_DIM))
    qb = partial_rope(to_heads(qb, B_HEADS, HEAD_DIM), pos)
    kb = partial_rope(to_heads(kb, B_HEADS, HEAD_DIM), pos)
    vb = to_heads(vb, B_HEADS, HEAD_DIM)
    outs, lses = [], []
    for g, (win, dil) in enumerate(B_PAIRS):
        sl = slice(g * B_GROUP_HEADS, (g + 1) * B_GROUP_HEADS)
        o, l = dilated_attention(qb[:, sl], kb[:, sl], vb[:, sl], dil, win // (2 * dil))
        outs.append(o)
        lses.append(l)
    wts = jax.nn.softmax(jnp.stack(lses), axis=0)
    ob = jnp.sum(wts[..., None] * jnp.stack(outs).astype(jnp.float32), axis=0).astype(x.dtype)
    ob = from_heads(ob)
    return jnp.concatenate([oa, ob], -1) @ w_out


def odd_mixer(x, w_in, lam_q1, lam_k1, lam_q2, lam_k2, subln_g, q_norm_g, k_norm_g, w_out,
              pos, rows, cols, lambda_init):
    b, s, _ = x.shape
    qc, kc, vc, qd, kd, vd = split_cols(x @ w_in, CD_SIZES)
    qc = to_heads(qc, C_HEADS, 2 * HEAD_DIM)
    kc = to_heads(kc, C_HEADS, 2 * HEAD_DIM)
    vc = to_heads(vc, C_HEADS, 2 * HEAD_DIM)
    q1, q2 = partial_rope(qc[..., :HEAD_DIM], pos), partial_rope(qc[..., HEAD_DIM:], pos)
    k1, k2 = partial_rope(kc[..., :HEAD_DIM], pos), partial_rope(kc[..., HEAD_DIM:], pos)
    f32 = jnp.float32
    lam = (jnp.exp(jnp.sum(lam_q1.astype(f32) * lam_k1.astype(f32)))
           - jnp.exp(jnp.sum(lam_q2.astype(f32) * lam_k2.astype(f32))) + lambda_init)
    scale = HEAD_DIM ** -0.5

    def c_block(q1b, q2b):
        s1 = jnp.einsum('bhqd,bhsd->bhqs', q1b, k1, preferred_element_type=f32) * scale
        s2 = jnp.einsum('bhqd,bhsd->bhqs', q2b, k2, preferred_element_type=f32) * scale
        a = jax.nn.softmax(s1, -1) - lam * jax.nn.softmax(s2, -1)
        return jnp.einsum('bhqs,bhsd->bhqd', a.astype(vc.dtype), vc)

    oc = sweep_query_blocks(c_block, (q1, q2))
    oc = from_heads(rms_norm(oc, subln_g) * (1.0 - lambda_init))
    qd = axial_rope(rms_norm(to_heads(qd, D_HEADS, HEAD_DIM), q_norm_g), rows, cols)
    qd = qd.reshape(b, D_KV_HEADS, D_GROUP, s, HEAD_DIM)
    kd = axial_rope(rms_norm(to_heads(kd, D_KV_HEADS, HEAD_DIM), k_norm_g), rows, cols)
    vd = to_heads(vd, D_KV_HEADS, HEAD_DIM)

    def d_block(qblk):
        sc = jnp.einsum('bkgqd,bksd->bkgqs', qblk, kd, preferred_element_type=f32) * scale
        return jnp.einsum('bkgqs,bksd->bkgqd', jax.nn.softmax(sc, -1).astype(vd.dtype), vd)

    od = sweep_query_blocks(d_block, (qd,))
    od = from_heads(od.reshape(b, D_HEADS, s, HEAD_DIM))
    return jnp.concatenate([oc, od], -1) @ w_out


def peer(x, w_q, sub_keys, u, v):
    b, s, d = x.shape
    t = b * s
    xt = x.reshape(t, d)
    q = (xt @ w_q).reshape(t, PEER_HEADS, 2, PEER_HALF)
    sc = jnp.einsum('thcd,hcnd->thcn', q, sub_keys, preferred_element_type=jnp.float32)
    sv, si = lax.top_k(sc, PEER_TOPK)
    cand = (sv[:, :, 0, :, None] + sv[:, :, 1, None, :]).reshape(t, PEER_HEADS, PEER_TOPK * PEER_TOPK)
    cidx = (si[:, :, 0, :, None] * PEER_NKEYS + si[:, :, 1, None, :]).reshape(t, PEER_HEADS, PEER_TOPK * PEER_TOPK)
    top_s, top_i = lax.top_k(cand, PEER_TOPK)
    eidx = jnp.take_along_axis(cidx, top_i, axis=-1)
    gate = jax.nn.softmax(top_s, axis=-1)
    n_chunks = t // PEER_CHUNK
    xc = xt.reshape(n_chunks, PEER_CHUNK, d)
    ec = eidx.reshape(n_chunks, PEER_CHUNK, PEER_HEADS * PEER_TOPK)
    gc = gate.reshape(n_chunks, PEER_CHUNK, PEER_HEADS * PEER_TOPK)

    def chunk(args):
        xk, ek, gk = args
        hid = jax.nn.gelu(jnp.einsum('cd,ced->ce', xk, u[ek], preferred_element_type=jnp.float32))
        return jnp.einsum('ce,ced->cd', (gk * hid).astype(v.dtype), v[ek])

    return lax.map(chunk, (xc, ec, gc)).reshape(b, s, d)


def setup_inputs(seed: int = 0) -> dict:
    key = jax.random.key(seed)
    ks = jax.random.split(key, 24)
    nrm = lambda k, shape, scale: jax.random.normal(k, shape, jnp.float32) * scale
    gain = lambda k, shape: 1.0 + nrm(k, shape, 0.02)
    return {
        "x": nrm(ks[0], (BATCH, SEQ, D_MODEL), 1.0),
        "w_in_ab": nrm(ks[1], (N_EVEN, D_MODEL, sum(AB_SIZES)), D_MODEL ** -0.5),
        "sink_a": nrm(ks[2], (N_EVEN, A_KV_HEADS, A_GROUP), 0.5),
        "w_out_ab": nrm(ks[3], (N_EVEN, AB_OUT, D_MODEL), DEEPNORM_BETA * AB_OUT ** -0.5),
        "w_in_cd": nrm(ks[4], (N_ODD, D_MODEL, sum(CD_SIZES)), D_MODEL ** -0.5),
        "lam_q1": nrm(ks[5], (N_ODD, HEAD_DIM), 0.1),
        "lam_k1": nrm(ks[6], (N_ODD, HEAD_DIM), 0.1),
        "lam_q2": nrm(ks[7], (N_ODD, HEAD_DIM), 0.1),
        "lam_k2": nrm(ks[8], (N_ODD, HEAD_DIM), 0.1),
        "subln_g": gain(ks[9], (N_ODD, 2 * HEAD_DIM)),
        "q_norm_g": gain(ks[10], (N_ODD, HEAD_DIM)),
        "k_norm_g": gain(ks[11], (N_ODD, HEAD_DIM)),
        "w_out_cd": nrm(ks[12], (N_ODD, CD_OUT, D_MODEL), DEEPNORM_BETA * CD_OUT ** -0.5),
        "ln_mix_g": gain(ks[13], (DEPTH, D_MODEL)),
        "ln_mix_b": nrm(ks[14], (DEPTH, D_MODEL), 0.02),
        "peer_wq": nrm(ks[15], (DEPTH, D_MODEL, PEER_HEADS * PEER_QDIM), D_MODEL ** -0.5),
        "peer_keys": nrm(ks[16], (DEPTH, PEER_HEADS, 2, PEER_NKEYS, PEER_HALF), PEER_HALF ** -0.5),
        "peer_u": nrm(ks[17], (DEPTH, PEER_EXPERTS, D_MODEL), D_MODEL ** -0.5),
        "peer_v": nrm(ks[18], (DEPTH, PEER_EXPERTS, D_MODEL), DEEPNORM_BETA * PEER_HEADS ** -0.5),
        "ln_ffn_g": gain(ks[19], (DEPTH, D_MODEL)),
        "ln_ffn_b": nrm(ks[20], (DEPTH, D_MODEL), 0.02),
    }


def reference(x, w_in_ab, sink_a, w_out_ab, w_in_cd, lam_q1, lam_k1, lam_q2, lam_k2, subln_g,
              q_norm_g, k_norm_g, w_out_cd, ln_mix_g, ln_mix_b, peer_wq, peer_keys, peer_u, peer_v,
              ln_ffn_g, ln_ffn_b):
    b, s, _ = x.shape
    pos = jnp.arange(s)
    ROWS = s // GRID_W
    rows = jnp.repeat(jnp.arange(ROWS), GRID_W)
    cols = jnp.tile(jnp.arange(GRID_W), ROWS)
    for layer in range(DEPTH):
        i = layer // 2
        if layer % 2 == 0:
            mix = even_mixer(x, w_in_ab[i], sink_a[i], w_out_ab[i], pos)
        else:
            lambda_init = 0.8 - 0.6 * math.exp(-0.3 * layer)
            mix = odd_mixer(x, w_in_cd[i], lam_q1[i], lam_k1[i], lam_q2[i], lam_k2[i], subln_g[i],
                            q_norm_g[i], k_norm_g[i], w_out_cd[i], pos, rows, cols, lambda_init)
        x = layer_norm(DEEPNORM_ALPHA * x + mix, ln_mix_g[layer], ln_mix_b[layer])
        ffn = peer(x, peer_wq[layer], peer_keys[layer], peer_u[layer], peer_v[layer])
        x = layer_norm(DEEPNORM_ALPHA * x + ffn, ln_ffn_g[layer], ln_ffn_b[layer])
    return x
```

```cpp
#include <hip/hip_runtime.h>
#include <stdint.h>

#define SEQ 8192
#define DM 4096
#define HD 128
#define ALPHA 1.4142135623730951f
#define LAMBDA_INIT 0.35550906759096934f
#define ATT_SCALE 0.088388347648318440f

__device__ const double REV_P[16] = {0.15915494309189535, 0.0700865215877985, 0.03086376340470123, 0.013591370636193905, 0.005985185712713705, 0.002635675898667414, 0.001160663641240061, 0.0005111175045375439, 0.00022507907903927653, 9.911730936901935e-05, 4.364795279280289e-05, 1.9221100684944863e-05, 8.464330808241401e-06, 3.727408601915352e-06, 1.6414262627950345e-06, 7.228293068832865e-07};
__device__ const double REV_A[32] = {0.15915494309189535, 0.11934937021124886, 0.08949940160889101, 0.06711508300522726, 0.050329212104487035, 0.03774158471741977, 0.0283021958306234, 0.02122365276477766, 0.015915494309189534, 0.011934937021124886, 0.008949940160889102, 0.006711508300522725, 0.005032921210448704, 0.003774158471741977, 0.00283021958306234, 0.0021223652764777662, 0.0015915494309189536, 0.0011934937021124885, 0.0008949940160889102, 0.0006711508300522726, 0.0005032921210448703, 0.00037741584717419774, 0.00028302195830623395, 0.0002122365276477766, 0.00015915494309189535, 0.00011934937021124886, 8.949940160889102e-05, 6.711508300522725e-05, 5.0329212104487035e-05, 3.774158471741978e-05, 2.8302195830623396e-05, 2.122365276477766e-05};

__device__ __forceinline__ void sincos_rev(double rev, float& s, float& c) {
    const double f = rev - floor(rev); const float ff = (float)f;
    s = __builtin_amdgcn_sinf(ff); c = __builtin_amdgcn_cosf(ff);
}
__device__ __forceinline__ float wave_sum(float v) {
#pragma unroll
    for (int o = 32; o >= 1; o >>= 1) v += __shfl_xor(v, o);
    return v;
}
__device__ __forceinline__ float wave_max(float v) {
#pragma unroll
    for (int o = 32; o >= 1; o >>= 1) v = fmaxf(v, __shfl_xor(v, o));
    return v;
}

__global__ __launch_bounds__(256) void k_gemm(const float* __restrict__ A, const float* __restrict__ W, float* __restrict__ C, const float* __restrict__ R, float ralpha, int M, int N, int K) {
    __shared__ float As[16][132];
    __shared__ float Bs[16][132];
    const int tid = threadIdx.x, ty = tid >> 4, tx = tid & 15;
    const int ntn = N / 128, ntm = M / 128;
    for (int tile = blockIdx.x; tile < ntn * ntm; tile += gridDim.x) {
        const int tm = tile / ntn, tn = tile % ntn;
        float acc[8][8];
#pragma unroll
        for (int i = 0; i < 8; ++i)
#pragma unroll
            for (int j = 0; j < 8; ++j) acc[i][j] = 0.f;
        const float* Ap = A + (size_t)(tm * 128 + (tid >> 1)) * K + (tid & 1) * 8;
        const float* Wp = W + (size_t)(tid >> 4) * N + tn * 128 + (tid & 15) * 8;
        for (int k0 = 0; k0 < K; k0 += 16) {
            const float4 a0 = *(const float4*)(Ap + k0), a1 = *(const float4*)(Ap + k0 + 4);
            const float4 b0 = *(const float4*)(Wp + (size_t)k0 * N), b1 = *(const float4*)(Wp + (size_t)k0 * N + 4);
            __syncthreads();
            { const int r = tid >> 1, kk = (tid & 1) * 8;
              As[kk + 0][r] = a0.x; As[kk + 1][r] = a0.y; As[kk + 2][r] = a0.z; As[kk + 3][r] = a0.w;
              As[kk + 4][r] = a1.x; As[kk + 5][r] = a1.y; As[kk + 6][r] = a1.z; As[kk + 7][r] = a1.w; }
            { const int kk = tid >> 4, n = (tid & 15) * 8;
              *(float4*)&Bs[kk][n] = b0; *(float4*)&Bs[kk][n + 4] = b1; }
            __syncthreads();
#pragma unroll
            for (int kk = 0; kk < 16; ++kk) {
                const float4 x0 = *(const float4*)&As[kk][ty * 8], x1 = *(const float4*)&As[kk][ty * 8 + 4];
                const float4 y0 = *(const float4*)&Bs[kk][tx * 8], y1 = *(const float4*)&Bs[kk][tx * 8 + 4];
                const float a[8] = {x0.x, x0.y, x0.z, x0.w, x1.x, x1.y, x1.z, x1.w};
                const float b[8] = {y0.x, y0.y, y0.z, y0.w, y1.x, y1.y, y1.z, y1.w};
#pragma unroll
                for (int i = 0; i < 8; ++i)
#pragma unroll
                    for (int j = 0; j < 8; ++j) acc[i][j] = fmaf(a[i], b[j], acc[i][j]);
            }
        }
#pragma unroll
        for (int i = 0; i < 8; ++i) {
            const size_t off = (size_t)(tm * 128 + ty * 8 + i) * N + tn * 128 + tx * 8;
            float4 o0 = {acc[i][0], acc[i][1], acc[i][2], acc[i][3]}, o1 = {acc[i][4], acc[i][5], acc[i][6], acc[i][7]};
            if (R) { const float4 r0 = *(const float4*)(R + off), r1 = *(const float4*)(R + off + 4);
                o0.x += ralpha * r0.x; o0.y += ralpha * r0.y; o0.z += ralpha * r0.z; o0.w += ralpha * r0.w;
                o1.x += ralpha * r1.x; o1.y += ralpha * r1.y; o1.z += ralpha * r1.z; o1.w += ralpha * r1.w; }
            *(float4*)(C + off) = o0; *(float4*)(C + off + 4) = o1;
        }
    }
}

__global__ __launch_bounds__(256) void k_rope_even(float* __restrict__ h) {
    const long total = (long)SEQ * 68 * 16;
    for (long i = (long)blockIdx.x * 256 + threadIdx.x; i < total; i += (long)gridDim.x * 256) {
        const int p = (int)(i & 15); const long r = i >> 4; const int hd = (int)(r % 68); const int t = (int)(r / 68);
        int col;
        if (hd < 16) col = hd * 128; else if (hd < 20) col = 2048 + (hd - 16) * 128; else if (hd < 44) col = 3072 + (hd - 20) * 128; else col = 6144 + (hd - 44) * 128;
        float* x = h + (size_t)t * 12288 + col;
        float s, c; sincos_rev((double)t * REV_P[p], s, c);
        const float x1 = x[p], x2 = x[p + 16];
        x[p] = x1 * c - x2 * s; x[p + 16] = x2 * c + x1 * s;
    }
}
__global__ __launch_bounds__(256) void k_rope_odd(float* __restrict__ h, const float* __restrict__ qg, const float* __restrict__ kg) {
    const long total = (long)SEQ * 32 * 16;
    for (long i = (long)blockIdx.x * 256 + threadIdx.x; i < total; i += (long)gridDim.x * 256) {
        const int p = (int)(i & 15); const long r = i >> 4; const int hd = (int)(r & 31); const int t = (int)(r >> 5);
        const int col = hd < 16 ? hd * 128 : 2048 + (hd - 16) * 128;
        float* x = h + (size_t)t * 9216 + col;
        float s, c; sincos_rev((double)t * REV_P[p], s, c);
        const float x1 = x[p], x2 = x[p + 16];
        x[p] = x1 * c - x2 * s; x[p + 16] = x2 * c + x1 * s;
    }
    const int lane = threadIdx.x & 63, wv = threadIdx.x >> 6;
    for (long j = (long)blockIdx.x * 4 + wv; j < (long)SEQ * 20; j += (long)gridDim.x * 4) {
        const int hd = (int)(j % 20), t = (int)(j / 20);
        const int col = hd < 16 ? 6144 + hd * 128 : 8192 + (hd - 16) * 128;
        const float* g = hd < 16 ? qg : kg;
        float* x = h + (size_t)t * 9216 + col;
        float a = x[lane], b = x[lane + 64];
        const float ss = wave_sum(a * a + b * b) * (1.0f / 128.0f);
        const float rs = 1.0f / sqrtf(ss + 1e-6f);
        a = a * rs * g[lane]; b = b * rs * g[lane + 64];
        const int fi = lane & 31;
        float s1, c1, s2, c2;
        sincos_rev((double)(t >> 6) * REV_A[fi], s1, c1);
        sincos_rev((double)(t & 63) * REV_A[fi], s2, c2);
        const float ap = __shfl_xor(a, 32), bp = __shfl_xor(b, 32);
        float na, nb;
        if (lane < 32) { na = a * c1 - ap * s1; nb = b * c2 - bp * s2; }
        else           { na = a * c1 + ap * s1; nb = b * c2 + bp * s2; }
        x[lane] = na; x[lane + 64] = nb;
    }
}

template <int VW>
__device__ __forceinline__ void attn_seg(const float q0, const float q1, const float* __restrict__ Kb, const float* __restrict__ Vb, const int ld,
                                         const int t, const int step, int jlo, int jhi, float& m, float& l, float (&o)[VW], const int lane) {
    { const int lo = -(t / step); if (jlo < lo) jlo = lo; const int hi = (SEQ - 1 - t) / step; if (jhi > hi) jhi = hi; }
    for (int j = jlo; j <= jhi; ++j) {
        const size_t tp = (size_t)(t + step * j);
        const float2 kk = *(const float2*)(Kb + tp * ld + 2 * lane);
        float vv[VW];
        if (VW == 2) { const float2 v2 = *(const float2*)(Vb + tp * ld + 2 * lane); vv[0] = v2.x; vv[1] = v2.y; }
        else { const float4 v4 = *(const float4*)(Vb + tp * ld + 4 * lane); vv[0] = v4.x; vv[1] = v4.y; vv[VW - 2] = v4.z; vv[VW - 1] = v4.w; }
        const float s = wave_sum(q0 * kk.x + q1 * kk.y) * ATT_SCALE;
        const float mn = fmaxf(m, s);
        const float al = __expf(m - mn), p = __expf(s - mn);
        l = l * al + p;
#pragma unroll
        for (int i = 0; i < VW; ++i) o[i] = o[i] * al + p * vv[i];
        m = mn;
    }
}

__global__ __launch_bounds__(256) void k_attn_even(const float* __restrict__ h, const float* __restrict__ sink, float* __restrict__ out) {
    const int lane = threadIdx.x & 63, wv = threadIdx.x >> 6;
    const int LD = 12288;
    for (long job = (long)blockIdx.x * 4 + wv; job < (long)SEQ * 24; job += (long)gridDim.x * 4) {
        const int hh = (int)(job / SEQ), t = (int)(job % SEQ);
        float o[2] = {0.f, 0.f}; float m, l;
        if (hh < 16) {
            const int kv = hh >> 2;
            const float* q = h + (size_t)t * LD + hh * 128;
            const float q0 = q[2 * lane], q1 = q[2 * lane + 1];
            m = sink[hh]; l = 1.f;
            attn_seg<2>(q0, q1, h + 2048 + kv * 128, h + 2560 + kv * 128, LD, t, 1, -128, 128, m, l, o, lane);
        } else {
            const int hb = hh - 16;
            m = -1e30f; l = 0.f;
#pragma unroll
            for (int g = 0; g < 3; ++g) {
                const int head = 8 * g + hb; const int step = g == 0 ? 1 : (g == 1 ? 4 : 16);
                const float* q = h + (size_t)t * LD + 3072 + head * 128;
                const float q0 = q[2 * lane], q1 = q[2 * lane + 1];
                attn_seg<2>(q0, q1, h + 6144 + head * 128, h + 9216 + head * 128, LD, t, step, -64, 64, m, l, o, lane);
            }
        }
        const float il = 1.0f / l;
        float* op = out + (size_t)t * 3072 + hh * 128 + 2 * lane;
        op[0] = o[0] * il; op[1] = o[1] * il;
    }
}

__global__ __launch_bounds__(256) void k_attn_odd(const float* __restrict__ h, const float* __restrict__ lq1, const float* __restrict__ lk1, const float* __restrict__ lq2,
                                                  const float* __restrict__ lk2, const float* __restrict__ subg, float* __restrict__ out) {
    const int lane = threadIdx.x & 63, wv = threadIdx.x >> 6;
    const int LD = 9216;
    const float lam = __expf(wave_sum(lq1[lane] * lk1[lane] + lq1[lane + 64] * lk1[lane + 64])) - __expf(wave_sum(lq2[lane] * lk2[lane] + lq2[lane + 64] * lk2[lane + 64])) + LAMBDA_INIT;
    for (long job = (long)blockIdx.x * 4 + wv; job < (long)SEQ * 24; job += (long)gridDim.x * 4) {
        const int hh = (int)(job / SEQ), t = (int)(job % SEQ);
        if (hh < 8) {
            float o1[4] = {0.f, 0.f, 0.f, 0.f}, o2[4] = {0.f, 0.f, 0.f, 0.f}; float m1 = -1e30f, l1 = 0.f, m2 = -1e30f, l2 = 0.f;
            const float* q = h + (size_t)t * LD + hh * 256;
            attn_seg<4>(q[2 * lane], q[2 * lane + 1], h + 2048 + hh * 256, h + 4096 + hh * 256, LD, t, 1, -SEQ, SEQ, m1, l1, o1, lane);
            attn_seg<4>(q[128 + 2 * lane], q[128 + 2 * lane + 1], h + 2048 + hh * 256 + 128, h + 4096 + hh * 256, LD, t, 1, -SEQ, SEQ, m2, l2, o2, lane);
            float o[4]; float ss = 0.f;
#pragma unroll
            for (int i = 0; i < 4; ++i) { o[i] = o1[i] / l1 - lam * (o2[i] / l2); ss += o[i] * o[i]; }
            ss = wave_sum(ss) * (1.0f / 256.0f);
            const float rs = (1.0f - LAMBDA_INIT) / sqrtf(ss + 1e-6f);
            float* op = out + (size_t)t * 4096 + hh * 256 + 4 * lane;
#pragma unroll
            for (int i = 0; i < 4; ++i) op[i] = o[i] * rs * subg[4 * lane + i];
        } else {
            const int hq = hh - 8, kv = hq >> 2;
            float o[2] = {0.f, 0.f}; float m = -1e30f, l = 0.f;
            const float* q = h + (size_t)t * LD + 6144 + hq * 128;
            attn_seg<2>(q[2 * lane], q[2 * lane + 1], h + 8192 + kv * 128, h + 8704 + kv * 128, LD, t, 1, -SEQ, SEQ, m, l, o, lane);
            const float il = 1.0f / l;
            float* op = out + (size_t)t * 4096 + 2048 + hq * 128 + 2 * lane;
            op[0] = o[0] * il; op[1] = o[1] * il;
        }
    }
}

__global__ __launch_bounds__(256) void k_ln(const float* __restrict__ y, const float* __restrict__ g, const float* __restrict__ b, float* __restrict__ out) {
    const int lane = threadIdx.x & 63, wv = threadIdx.x >> 6;
    for (int t = blockIdx.x * 4 + wv; t < SEQ; t += gridDim.x * 4) {
        float4 v[16]; float s = 0.f;
#pragma unroll
        for (int i = 0; i < 16; ++i) { v[i] = *(const float4*)(y + (size_t)t * DM + i * 256 + lane * 4); s += (v[i].x + v[i].y) + (v[i].z + v[i].w); }
        const float mean = wave_sum(s) * (1.0f / DM);
        float q = 0.f;
#pragma unroll
        for (int i = 0; i < 16; ++i) { const float a = v[i].x - mean, bb = v[i].y - mean, c = v[i].z - mean, d = v[i].w - mean; q += (a * a + bb * bb) + (c * c + d * d); }
        const float rstd = 1.0f / sqrtf(wave_sum(q) * (1.0f / DM) + 1e-5f);
#pragma unroll
        for (int i = 0; i < 16; ++i) {
            const float4 gg = *(const float4*)(g + i * 256 + lane * 4), bb = *(const float4*)(b + i * 256 + lane * 4);
            float4 o; o.x = (v[i].x - mean) * rstd * gg.x + bb.x; o.y = (v[i].y - mean) * rstd * gg.y + bb.y; o.z = (v[i].z - mean) * rstd * gg.z + bb.z; o.w = (v[i].w - mean) * rstd * gg.w + bb.w;
            *(float4*)(out + (size_t)t * DM + i * 256 + lane * 4) = o;
        }
    }
}

__global__ __launch_bounds__(256) void k_peer_route(const float* __restrict__ q  , const float* __restrict__ keys  , int* __restrict__ eidx, float* __restrict__ gate) {
    const int lane = threadIdx.x & 63, wv = threadIdx.x >> 6;
    for (long job = (long)blockIdx.x * 4 + wv; job < (long)SEQ * 8; job += (long)gridDim.x * 4) {
        const int hh = (int)(job & 7), t = (int)(job >> 3);
        float sv[2]; int si[2];
#pragma unroll
        for (int c = 0; c < 2; ++c) {
            const float* qq = q + (size_t)t * 2048 + hh * 256 + c * 128;
            const float* k0 = keys + ((size_t)(hh * 2 + c) * 128 + lane) * 128;
            const float* k1 = k0 + 64 * 128;
            float s0 = 0.f, s1 = 0.f;
            for (int d = 0; d < 128; d += 4) {
                const float4 qv = *(const float4*)(qq + d), a = *(const float4*)(k0 + d), b = *(const float4*)(k1 + d);
                s0 += qv.x * a.x + qv.y * a.y + qv.z * a.z + qv.w * a.w;
                s1 += qv.x * b.x + qv.y * b.y + qv.z * b.z + qv.w * b.w;
            }
            float myv = 0.f; int myi = 0;
            for (int k = 0; k < 16; ++k) {
                float bv; int bi;
                if (s1 > s0) { bv = s1; bi = lane + 64; } else { bv = s0; bi = lane; }
#pragma unroll
                for (int o = 32; o >= 1; o >>= 1) {
                    const float ov = __shfl_xor(bv, o); const int oi = __shfl_xor(bi, o);
                    if (ov > bv || (ov == bv && oi < bi)) { bv = ov; bi = oi; }
                }
                if (lane == k) { myv = bv; myi = bi; }
                if (bi == lane) s0 = -3.0e38f;
                if (bi == lane + 64) s1 = -3.0e38f;
            }
            sv[c] = myv; si[c] = myi;
        }
        float cv[4]; int ci[4];
        const float a = __shfl(sv[0], lane >> 2); const int ai = __shfl(si[0], lane >> 2);
#pragma unroll
        for (int r = 0; r < 4; ++r) { const float b = __shfl(sv[1], (lane & 3) * 4 + r); const int bi = __shfl(si[1], (lane & 3) * 4 + r); cv[r] = a + b; ci[r] = ai * 128 + bi; }
        float tv = 0.f; int te = 0;
        for (int k = 0; k < 16; ++k) {
            float bv = cv[0]; int bp = lane * 4, be = ci[0];
#pragma unroll
            for (int r = 1; r < 4; ++r) if (cv[r] > bv) { bv = cv[r]; bp = lane * 4 + r; be = ci[r]; }
#pragma unroll
            for (int o = 32; o >= 1; o >>= 1) {
                const float ov = __shfl_xor(bv, o); const int op = __shfl_xor(bp, o); const int oe = __shfl_xor(be, o);
                if (ov > bv || (ov == bv && op < bp)) { bv = ov; bp = op; be = oe; }
            }
            if (lane == k) { tv = bv; te = be; }
#pragma unroll
            for (int r = 0; r < 4; ++r) if (bp == lane * 4 + r) cv[r] = -3.0e38f;
        }
        const float v = lane < 16 ? tv : -3.0e38f;
        const float mx = wave_max(v);
        const float e = lane < 16 ? __expf(tv - mx) : 0.f;
        const float den = wave_sum(e);
        if (lane < 16) { eidx[(size_t)t * 128 + hh * 16 + lane] = te; gate[(size_t)t * 128 + hh * 16 + lane] = e / den; }
    }
}

__device__ __forceinline__ float gelu_tanh(float x) {
    const float z = 0.7978845608028654f * (x + 0.044715f * x * x * x);
    const float e = __expf(2.0f * z);
    const float th = 1.0f - 2.0f / (e + 1.0f);
    return 0.5f * x * (1.0f + th);
}

__global__ __launch_bounds__(256) void k_peer_expert(const float* __restrict__ x, const int* __restrict__ eidx, const float* __restrict__ gate, const float* __restrict__ U, const float* __restrict__ V,
                                                     const float* __restrict__ g, const float* __restrict__ b, float* __restrict__ out) {
    const int lane = threadIdx.x & 63, wv = threadIdx.x >> 6;
    for (int t = blockIdx.x * 4 + wv; t < SEQ; t += gridDim.x * 4) {
        float4 xv[16], acc[16];
#pragma unroll
        for (int i = 0; i < 16; ++i) { xv[i] = *(const float4*)(x + (size_t)t * DM + i * 256 + lane * 4); acc[i] = make_float4(0.f, 0.f, 0.f, 0.f); }
        for (int k = 0; k < 128; ++k) {
            const int e = eidx[(size_t)t * 128 + k]; const float gt = gate[(size_t)t * 128 + k];
            const float* up = U + (size_t)e * DM + lane * 4; const float* vp = V + (size_t)e * DM + lane * 4;
            float d = 0.f;
#pragma unroll
            for (int i = 0; i < 16; ++i) { const float4 u = *(const float4*)(up + i * 256); d += (xv[i].x * u.x + xv[i].y * u.y) + (xv[i].z * u.z + xv[i].w * u.w); }
            d = wave_sum(d);
            const float w = gt * gelu_tanh(d);
#pragma unroll
            for (int i = 0; i < 16; ++i) { const float4 vv = *(const float4*)(vp + i * 256); acc[i].x += w * vv.x; acc[i].y += w * vv.y; acc[i].z += w * vv.z; acc[i].w += w * vv.w; }
        }
        float s = 0.f;
#pragma unroll
        for (int i = 0; i < 16; ++i) { acc[i].x += ALPHA * xv[i].x; acc[i].y += ALPHA * xv[i].y; acc[i].z += ALPHA * xv[i].z; acc[i].w += ALPHA * xv[i].w; s += (acc[i].x + acc[i].y) + (acc[i].z + acc[i].w); }
        const float mean = wave_sum(s) * (1.0f / DM);
        float qq = 0.f;
#pragma unroll
        for (int i = 0; i < 16; ++i) { const float a = acc[i].x - mean, bb = acc[i].y - mean, c = acc[i].z - mean, d = acc[i].w - mean; qq += (a * a + bb * bb) + (c * c + d * d); }
        const float rstd = 1.0f / sqrtf(wave_sum(qq) * (1.0f / DM) + 1e-5f);
#pragma unroll
        for (int i = 0; i < 16; ++i) {
            const float4 gg = *(const float4*)(g + i * 256 + lane * 4), bb = *(const float4*)(b + i * 256 + lane * 4);
            float4 o; o.x = (acc[i].x - mean) * rstd * gg.x + bb.x; o.y = (acc[i].y - mean) * rstd * gg.y + bb.y; o.z = (acc[i].z - mean) * rstd * gg.z + bb.z; o.w = (acc[i].w - mean) * rstd * gg.w + bb.w;
            *(float4*)(out + (size_t)t * DM + i * 256 + lane * 4) = o;
        }
    }
}

extern "C" void kernel_launch(void* const* d_in, const int* in_sizes, int n_in, void* d_out, int out_size, void* d_ws, size_t ws_size, hipStream_t stream) {
    const float* x = (const float*)d_in[0];
    const float* w_in_ab = (const float*)d_in[1];
    const float* sink_a = (const float*)d_in[2];
    const float* w_out_ab = (const float*)d_in[3];
    const float* w_in_cd = (const float*)d_in[4];
    const float* lam_q1 = (const float*)d_in[5];
    const float* lam_k1 = (const float*)d_in[6];
    const float* lam_q2 = (const float*)d_in[7];
    const float* lam_k2 = (const float*)d_in[8];
    const float* subln_g = (const float*)d_in[9];
    const float* q_norm_g = (const float*)d_in[10];
    const float* k_norm_g = (const float*)d_in[11];
    const float* w_out_cd = (const float*)d_in[12];
    const float* ln_mix_g = (const float*)d_in[13];
    const float* ln_mix_b = (const float*)d_in[14];
    const float* peer_wq = (const float*)d_in[15];
    const float* peer_keys = (const float*)d_in[16];
    const float* peer_u = (const float*)d_in[17];
    const float* peer_v = (const float*)d_in[18];
    const float* ln_ffn_g = (const float*)d_in[19];
    const float* ln_ffn_b = (const float*)d_in[20];
    float* out = (float*)d_out;

    char* ws = (char*)d_ws;
    float* hbuf = (float*)ws;                 ws += (size_t)SEQ * 12288 * 4;
    float* abuf = (float*)ws;                 ws += (size_t)SEQ * 4096 * 4;
    float* ybuf = (float*)ws;                 ws += (size_t)SEQ * 4096 * 4;
    float* x1 = (float*)ws;                   ws += (size_t)SEQ * 4096 * 4;
    float* x2 = (float*)ws;                   ws += (size_t)SEQ * 4096 * 4;
    float* pq = (float*)ws;                   ws += (size_t)SEQ * 2048 * 4;
    int* eidx = (int*)ws;                     ws += (size_t)SEQ * 128 * 4;
    float* gate = (float*)ws;                 ws += (size_t)SEQ * 128 * 4;

    const int G = 2048;
    k_gemm<<<G, 256, 0, stream>>>(x, w_in_ab, hbuf, nullptr, 0.f, SEQ, 12288, DM);
    k_rope_even<<<G, 256, 0, stream>>>(hbuf);
    k_attn_even<<<G, 256, 0, stream>>>(hbuf, sink_a, abuf);
    k_gemm<<<G, 256, 0, stream>>>(abuf, w_out_ab, ybuf, x, ALPHA, SEQ, DM, 3072);
    k_ln<<<G, 256, 0, stream>>>(ybuf, ln_mix_g, ln_mix_b, x1);
    k_gemm<<<G, 256, 0, stream>>>(x1, peer_wq, pq, nullptr, 0.f, SEQ, 2048, DM);
    k_peer_route<<<G, 256, 0, stream>>>(pq, peer_keys, eidx, gate);
    k_peer_expert<<<G, 256, 0, stream>>>(x1, eidx, gate, peer_u, peer_v, ln_ffn_g, ln_ffn_b, x2);
    k_gemm<<<G, 256, 0, stream>>>(x2, w_in_cd, hbuf, nullptr, 0.f, SEQ, 9216, DM);
    k_rope_odd<<<G, 256, 0, stream>>>(hbuf, q_norm_g, k_norm_g);
    k_attn_odd<<<G, 256, 0, stream>>>(hbuf, lam_q1, lam_k1, lam_q2, lam_k2, subln_g, abuf);
    k_gemm<<<G, 256, 0, stream>>>(abuf, w_out_cd, ybuf, x2, ALPHA, SEQ, DM, DM);
    k_ln<<<G, 256, 0, stream>>>(ybuf, ln_mix_g + DM, ln_mix_b + DM, x1);
    k_gemm<<<G, 256, 0, stream>>>(x1, peer_wq + (size_t)DM * 2048, pq, nullptr, 0.f, SEQ, 2048, DM);
    k_peer_route<<<G, 256, 0, stream>>>(pq, peer_keys + (size_t)8 * 2 * 128 * 128, eidx, gate);
    k_peer_expert<<<G, 256, 0, stream>>>(x1, eidx, gate, peer_u + (size_t)16384 * DM, peer_v + (size_t)16384 * DM, ln_ffn_g + DM, ln_ffn_b + DM, out);
}
```

```cpp
#include <hip/hip_runtime.h>
#include <stdint.h>
#include <cstdio>

#define SEQ 8192
#define DM 4096
#define HD 128
#define ALPHA 1.4142135623730951f
#define LAMBDA_INIT 0.35550906759096934f
#define ATT_SCALE 0.088388347648318440f

__device__ const double REV_P[16] = {0.15915494309189535, 0.0700865215877985, 0.03086376340470123, 0.013591370636193905, 0.005985185712713705, 0.002635675898667414, 0.001160663641240061, 0.0005111175045375439, 0.00022507907903927653, 9.911730936901935e-05, 4.364795279280289e-05, 1.9221100684944863e-05, 8.464330808241401e-06, 3.727408601915352e-06, 1.6414262627950345e-06, 7.228293068832865e-07};
__device__ const double REV_A[32] = {0.15915494309189535, 0.11934937021124886, 0.08949940160889101, 0.06711508300522726, 0.050329212104487035, 0.03774158471741977, 0.0283021958306234, 0.02122365276477766, 0.015915494309189534, 0.011934937021124886, 0.008949940160889102, 0.006711508300522725, 0.005032921210448704, 0.003774158471741977, 0.00283021958306234, 0.0021223652764777662, 0.0015915494309189536, 0.0011934937021124885, 0.0008949940160889102, 0.0006711508300522726, 0.0005032921210448703, 0.00037741584717419774, 0.00028302195830623395, 0.0002122365276477766, 0.00015915494309189535, 0.00011934937021124886, 8.949940160889102e-05, 6.711508300522725e-05, 5.0329212104487035e-05, 3.774158471741978e-05, 2.8302195830623396e-05, 2.122365276477766e-05};

__device__ __forceinline__ void sincos_rev(double rev, float& s, float& c) {
    const double f = rev - floor(rev); const float ff = (float)f;
    s = __builtin_amdgcn_sinf(ff); c = __builtin_amdgcn_cosf(ff);
}
__device__ __forceinline__ float wave_sum(float v) {
#pragma unroll
    for (int o = 32; o >= 1; o >>= 1) v += __shfl_xor(v, o);
    return v;
}
__device__ __forceinline__ float wave_max(float v) {
#pragma unroll
    for (int o = 32; o >= 1; o >>= 1) v = fmaxf(v, __shfl_xor(v, o));
    return v;
}
namespace pg8 {
#define PG8_LAS __attribute__((address_space(3)))
typedef unsigned short bf16_t;
typedef short bf16x8 __attribute__((ext_vector_type(8)));
typedef float f32x4 __attribute__((ext_vector_type(4)));
typedef unsigned u32x4 __attribute__((ext_vector_type(4)));
constexpr int BM = 256, BK = 64, HALF = 128, HTB = HALF * BK * 2  , STAGE_BYTES = 8 * HTB, NXCD = 8, WGM = 8;

__host__ __device__ __forceinline__ int lds_byte(int r, int c) { const int st = (r >> 4) * 2 + (c >> 5), rr = r & 15, cc = c & 31, ob = rr * 64 + cc * 2; return st * 1024 + (ob ^ (((ob >> 9) & 1) << 5)); }
__host__ __device__ __forceinline__ void stage_rc(int b, int& R, int& C) { const int st = b / 1024, sb = b % 1024, swz = sb ^ (((sb >> 9) & 1) << 5); R = (st >> 1) * 16 + swz / 64; C = (st & 1) * 32 + (swz % 64) / 2; }
__host__ __device__ __forceinline__ int perm32(int rho) { const int n = rho >> 4, i = rho & 15; return 8 * (i >> 2) + 4 * n + (i & 3); }

struct Unit { int pm, pn; };
struct Gemm { const bf16_t* A; const bf16_t* Bt; int M, N, K; };

struct StaticOrder {
    int nM, nN, nwg, G, c;
    __host__ __device__ void init(int M, int N, int G_, int c_) { nM = M / BM; nN = N / BM; nwg = nM * nN; G = G_; c = c_; }
    __host__ __device__ bool next(int i, Unit& u) const {
        const long L = (long)i * G + c; if (L >= nwg) return false;
        int wgid = (int)L; { const int q = nwg / NXCD, r = nwg % NXCD, xcd = wgid % NXCD, off = wgid / NXCD; wgid = (xcd < r ? xcd * (q + 1) : r * (q + 1) + (xcd - r) * q) + off; }
        const int nig = WGM * nN, gid = wgid / nig, fm = gid * WGM, gsz = (nM - fm) < WGM ? (nM - fm) : WGM;
        u.pm = fm + ((wgid % nig) % gsz); u.pn = (wgid % nig) / gsz; return true;
    }
    __device__ __forceinline__ void a_ready(const Unit&) const {}
    __device__ __forceinline__ void done(const Unit&) const {}
};
__device__ __forceinline__ unsigned cvt_pk_bf16(float lo, float hi) { unsigned r; asm volatile("v_cvt_pk_bf16_f32 %0, %1, %2" : "=v"(r) : "v"(lo), "v"(hi)); return r; }
typedef float f32x2 __attribute__((ext_vector_type(2)));
template <class Epi, class Sched, bool STAMP = false>
__device__ __forceinline__ void gemm_phase(PG8_LAS unsigned char* lds, const Gemm g, const Sched& S, const Epi& E, unsigned long long* stamps, const int tid_in) {
    const int tid = tid_in, wid = __builtin_amdgcn_readfirstlane(tid >> 6), lane = tid & 63, wr = wid >> 2, wc = wid & 3, fr = lane & 15, fq = lane >> 4;
    const int K = g.K, nt = K / BK;
    int ts_lo = 0, ts_hi = 0, nts = 0; const unsigned long long rt_entry = STAMP ? (unsigned long long)wall_clock64() : 0ull;
#define PG8_STAMP() do { if (STAMP && wid == 0 && nts < 64) { const unsigned long long _c = (unsigned long long)clock64(); \
        ts_lo = (lane == nts) ? (int)(unsigned)_c : ts_lo; ts_hi = (lane == nts) ? (int)(unsigned)(_c >> 32) : ts_hi; ++nts; } } while (0)
    PG8_STAMP();
    unsigned voffA[2], voffB[2];
#pragma unroll
    for (int i = 0; i < 2; ++i) { int R, C; stage_rc(tid * 16 + i * 8192, R, C); const int Rb = Epi::PERM ? ((R & ~31) + perm32(R & 31)) : R;
        voffA[i] = (unsigned)(R * K + C) * 2u; voffB[i] = (unsigned)(Rb * K + C) * 2u; }
    const size_t kstep = (size_t)(BK * 2);
    const size_t hstep = (size_t)HALF * K * 2;
    const size_t tstep = 2 * hstep;
    const unsigned ldsw = (unsigned)wid * 1024u;
    const int aoff = lds_byte(wr * 64 + fr, fq * 8), boff = lds_byte(wc * 32 + fr, fq * 8);
#define PG8_SA(b, h) (((b) * 2 + (h)) * HTB)
#define PG8_SB(b, h) ((4 + (b) * 2 + (h)) * HTB)
#define PG8_STAGE(bufoff, gbase, voff) do { _Pragma("unroll") for (int _i = 0; _i < 2; ++_i) \
        __builtin_amdgcn_global_load_lds((const unsigned*)((const char*)(gbase) + (voff)[_i]), (PG8_LAS unsigned*)(lds + (bufoff) + ldsw + _i * 8192), 16, 0, 0); } while (0)
#define PG8_LDA(dst, b, h) do { _Pragma("unroll") for (int m = 0; m < 4; ++m) _Pragma("unroll") for (int k = 0; k < 2; ++k) dst[m][k] = *(const PG8_LAS bf16x8*)(lds + PG8_SA(b, h) + aoff + m * 2048 + k * 1024); } while (0)
#define PG8_LDB(dst, b, h) do { _Pragma("unroll") for (int n = 0; n < 2; ++n) _Pragma("unroll") for (int k = 0; k < 2; ++k) dst[n][k] = *(const PG8_LAS bf16x8*)(lds + PG8_SB(b, h) + boff + n * 2048 + k * 1024); } while (0)
#define PG8_MMA(ai, bj, At, Bt) do { __builtin_amdgcn_s_setprio(1); _Pragma("unroll") for (int m = 0; m < 4; ++m) _Pragma("unroll") for (int n = 0; n < 2; ++n) _Pragma("unroll") for (int k = 0; k < 2; ++k) \
        acc[ai][bj][m][n] = __builtin_amdgcn_mfma_f32_16x16x32_bf16(Bt[n][k], At[m][k], acc[ai][bj][m][n], 0, 0, 0); __builtin_amdgcn_s_setprio(0); } while (0)
#define PG8_WAIT_V(n) asm volatile("s_waitcnt vmcnt(" #n ")" ::: "memory")
#define PG8_WAIT_L(n) asm volatile("s_waitcnt lgkmcnt(" #n ")" ::: "memory")
#define PG8_BAR __builtin_amdgcn_s_barrier()
#define PG8_SCHED __builtin_amdgcn_sched_barrier(0)
    Unit cur, nxt; int ui = 0;
    if (!S.next(0, cur)) return;
    f32x4 acc[2][2][4][2];
#pragma unroll
    for (int a = 0; a < 2; ++a)
#pragma unroll
        for (int b = 0; b < 2; ++b)
#pragma unroll
            for (int m = 0; m < 4; ++m)
#pragma unroll
                for (int n = 0; n < 2; ++n) acc[a][b][m][n] = (f32x4){0.f, 0.f, 0.f, 0.f};
    bf16x8 At[4][2], B0[2][2], B1[2][2];
    const char* cA = (const char*)g.A + (size_t)cur.pm * tstep; const char* cB = (const char*)g.Bt + (size_t)cur.pn * tstep;
    S.a_ready(cur);
    PG8_STAGE(PG8_SB(0, 0), cB, voffB); PG8_STAGE(PG8_SA(0, 0), cA, voffA); PG8_STAGE(PG8_SB(0, 1), cB + hstep, voffB); PG8_STAGE(PG8_SA(0, 1), cA + hstep, voffA);
    if (wr == 1) PG8_BAR;
    PG8_WAIT_V(4); PG8_BAR;
    PG8_STAGE(PG8_SB(1, 0), cB + kstep, voffB); PG8_STAGE(PG8_SA(1, 0), cA + kstep, voffA); PG8_STAGE(PG8_SB(1, 1), cB + hstep + kstep, voffB);
    PG8_WAIT_V(6); PG8_BAR;
    PG8_STAMP();
    for (;;) {
        const bool has_next = S.next(ui + 1, nxt);
        const char* nA = has_next ? (const char*)g.A + (size_t)nxt.pm * tstep : cA; const char* nB = has_next ? (const char*)g.Bt + (size_t)nxt.pn * tstep : cB;
        for (int t = 0; t < nt; t += 2) {
            const bool last = (t == nt - 2);
            const char* a1 = cA + (size_t)(t + 1) * kstep;
            const char* a2 = last ? nA : cA + (size_t)(t + 2) * kstep; const char* b2 = last ? nB : cB + (size_t)(t + 2) * kstep;
            const char* a3 = a2 + kstep; const char* b3 = b2 + kstep;
            if (last && has_next) S.a_ready(nxt);
            PG8_LDB(B0, 0, 0); PG8_SCHED; PG8_LDA(At, 0, 0); PG8_STAGE(PG8_SA(1, 1), a1 + hstep, voffA);
            PG8_WAIT_L(8); PG8_BAR; PG8_WAIT_L(0); PG8_MMA(0, 0, At, B0); PG8_BAR; PG8_SCHED;
            PG8_LDB(B1, 0, 1); PG8_STAGE(PG8_SB(0, 0), b2, voffB);
            PG8_BAR; PG8_WAIT_L(0); PG8_MMA(0, 1, At, B1); PG8_BAR;
            PG8_LDA(At, 0, 1); PG8_STAGE(PG8_SA(0, 0), a2, voffA);
            PG8_BAR; PG8_WAIT_L(0); PG8_MMA(1, 0, At, B0); PG8_BAR; PG8_SCHED;
            PG8_STAGE(PG8_SB(0, 1), b2 + hstep, voffB);
            PG8_WAIT_V(6); PG8_BAR; PG8_MMA(1, 1, At, B1); PG8_BAR;
            PG8_LDB(B0, 1, 0); PG8_SCHED; PG8_LDA(At, 1, 0); PG8_STAGE(PG8_SA(0, 1), a2 + hstep, voffA);
            PG8_WAIT_L(8); PG8_BAR; PG8_WAIT_L(0); PG8_MMA(0, 0, At, B0); PG8_BAR; PG8_SCHED;
            PG8_LDB(B1, 1, 1); PG8_STAGE(PG8_SB(1, 0), b3, voffB);
            PG8_BAR; PG8_WAIT_L(0); PG8_MMA(0, 1, At, B1); PG8_BAR;
            PG8_LDA(At, 1, 1); PG8_STAGE(PG8_SA(1, 0), a3, voffA);
            PG8_BAR; PG8_WAIT_L(0); PG8_MMA(1, 0, At, B0); PG8_BAR; PG8_SCHED;
            PG8_STAGE(PG8_SB(1, 1), b3 + hstep, voffB);
            PG8_WAIT_V(6); PG8_BAR; PG8_MMA(1, 1, At, B1); PG8_BAR;
        }
        PG8_STAMP();
        if constexpr (!Epi::AFTER_DRAIN) { E(acc, cur, wr, wc, fr, fq); S.done(cur); }
        PG8_STAMP();
        if (!has_next) break;
#pragma unroll
        for (int a = 0; a < 2; ++a)
#pragma unroll
            for (int b = 0; b < 2; ++b)
#pragma unroll
                for (int m = 0; m < 4; ++m)
#pragma unroll
                    for (int n = 0; n < 2; ++n) acc[a][b][m][n] = (f32x4){0.f, 0.f, 0.f, 0.f};
        cur = nxt; cA = nA; cB = nB; ++ui;
    }
    PG8_WAIT_V(0);
    if (wr == 0) PG8_BAR;
    PG8_BAR;
    if constexpr (Epi::AFTER_DRAIN) { E.fused(acc, cur, wr, wc, fr, fq, lds, wid, lane); S.done(cur); }
    PG8_STAMP();
    if (STAMP && wid == 0) { stamps[lane] = lane < nts ? (((unsigned long long)(unsigned)ts_hi << 32) | (unsigned)ts_lo) : 0ull;
        if (lane == 62) stamps[62] = rt_entry; if (lane == 63) stamps[63] = (unsigned long long)wall_clock64(); }
#undef PG8_STAMP
#undef PG8_SA
#undef PG8_SB
#undef PG8_STAGE
#undef PG8_LDA
#undef PG8_LDB
#undef PG8_MMA
#undef PG8_WAIT_V
#undef PG8_WAIT_L
#undef PG8_BAR
#undef PG8_SCHED
}
}
#define XB_TMO      128
#define XB_XCNT(j)  (256  + 64 * (j))
#define XB_XSUB(j)  (1280 + 64 * (j))
#define XB_XGEN(j)  (2304 + 64 * (j))
#define XB_TOP      3328
#define XB_TOPGEN   3392
#define XCD_BAR_WORDS 3456
#define XB_SPIN_CAP (1u << 22)
#define LAS __attribute__((address_space(3)))

__device__ __forceinline__ unsigned xb_ld(unsigned* p)              { return __hip_atomic_load(p, __ATOMIC_RELAXED, __HIP_MEMORY_SCOPE_AGENT); }
__device__ __forceinline__ unsigned xb_add(unsigned* p, unsigned v) { return __hip_atomic_fetch_add(p, v, __ATOMIC_RELAXED, __HIP_MEMORY_SCOPE_AGENT); }
__device__ __forceinline__ unsigned xb_xcc_id() { return (unsigned)__builtin_amdgcn_s_getreg((3 << 11) | 20) & 0xFu; }
#define XB_SPIN(cond, bar) do { unsigned _sp = 0; while (cond) { __builtin_amdgcn_s_sleep(1); \
    if ((++_sp & 255u) == 0u) { if (xb_ld(&(bar)[XB_TMO])) break; if (_sp > XB_SPIN_CAP) { atomicAdd(&(bar)[XB_TMO], 1u); break; } } } } while (0)

struct XcdBarrier {
    unsigned* bar; unsigned x;
    volatile LAS unsigned* st;
};

__device__ __forceinline__ XcdBarrier xcd_barrier_post(unsigned* bar, volatile LAS unsigned* st, const int tid) {
    XcdBarrier b; b.bar = bar; b.x = xb_xcc_id(); b.st = st;
    if (tid == 0) (void)xb_add(&bar[XB_XCNT(b.x)], 1u);
    return b;
}
__device__ __forceinline__ void xcd_barrier_complete(unsigned* bar, unsigned x, unsigned& nloc, unsigned& nx) {
    const unsigned G = gridDim.x * gridDim.y * gridDim.z;
    unsigned sum, cnt, mine, sp = 0u;
    for (;;) {
        sum = 0u; cnt = 0u; mine = 0u;
#pragma unroll
        for (unsigned j = 0; j < 16; ++j) { const unsigned c = xb_ld(&bar[XB_XCNT(j)]); sum += c; cnt += (c > 0u) ? 1u : 0u; mine = (j == x) ? c : mine; }
        if (sum == G) break;
        __builtin_amdgcn_s_sleep(1);
        if ((++sp & 255u) == 0u) { if (xb_ld(&bar[XB_TMO])) break; if (sp > XB_SPIN_CAP) { atomicAdd(&bar[XB_TMO], 1u); break; } }
    }
    nloc = mine > 0u ? mine : 1u; nx = cnt > 0u ? cnt : 1u;
}

__device__ __forceinline__ void xcd_barrier(const XcdBarrier& b, const int tid) {
    asm volatile("s_waitcnt vmcnt(0)" ::: "memory");
    __syncthreads();
    if (tid == 0) {
        unsigned* bar = b.bar;
        __builtin_amdgcn_s_waitcnt(0);
        unsigned nloc = b.st[0], nx = b.st[1];
        if (nloc == 0u) { xcd_barrier_complete(bar, b.x, nloc, nx); b.st[0] = nloc; b.st[1] = nx; }
        const unsigned old = xb_add(&bar[XB_XSUB(b.x)], 1u);
        const unsigned gen = old / nloc;
        if (old + 1u == (gen + 1u) * nloc) {
            __builtin_amdgcn_fence(__ATOMIC_RELEASE, "agent");
            asm volatile("s_waitcnt vmcnt(0)" ::: "memory");
            const unsigned og = xb_add(&bar[XB_TOP], 1u);
            const unsigned tg = og / nx;
            if (og + 1u == (tg + 1u) * nx) xb_add(&bar[XB_TOPGEN], 1u);
            else XB_SPIN(xb_ld(&bar[XB_TOPGEN]) == tg, bar);
            __builtin_amdgcn_fence(__ATOMIC_ACQUIRE, "agent");
            xb_add(&bar[XB_XGEN(b.x)], 1u);
            asm volatile("s_waitcnt vmcnt(0)" ::: "memory");
        } else {
            XB_SPIN(xb_ld(&bar[XB_XGEN(b.x)]) == gen, bar);
            __builtin_amdgcn_fence(__ATOMIC_ACQUIRE, "agent");
            asm volatile("s_waitcnt vmcnt(0)" ::: "memory");
        }
    }
    __syncthreads();
}
namespace att {
using bf16 = unsigned short;
constexpr int   D = 128, NW = 8, QBLK = 32, KVBLK = 64;
constexpr float SCALE = 0.088388347648318440f;
constexpr float THR = 8.f;
constexpr int SDEPTH = 1;
constexpr size_t SHM_V = KVBLK * D * 2, SHM_K = KVBLK * D * 2, SHM_ATTN = 2 * SHM_V + 2 * SHM_K + NW * 64 * 4;
using bf16x8 = __attribute__((ext_vector_type(8))) short;
using s16x4  = __attribute__((ext_vector_type(4))) short;
using f32x16 = __attribute__((ext_vector_type(16))) float;
using f32x8  = __attribute__((ext_vector_type(8))) float;
using u32x4  = __attribute__((ext_vector_type(4))) unsigned;
#define KSWZ(row, colB) ((row) * 256 + ((colB) ^ (((row) & 7) << 4)))
#define SBAR() __builtin_amdgcn_sched_barrier(0)
__device__ __forceinline__ int crow(int r, int hi) { return (r & 3) + 8 * (r >> 2) + 4 * hi; }
__device__ __forceinline__ unsigned cvtpk(float lo, float hi) {
  unsigned r; asm volatile("v_cvt_pk_bf16_f32 %0, %1, %2" : "=v"(r) : "v"(lo), "v"(hi)); return r;
}
template <typename TIn> struct Stage;
template <> struct Stage<bf16>  { using T = bf16x8;
  __device__ static __forceinline__ T ld8(const bf16* p) { return *reinterpret_cast<const bf16x8*>(p); }
  __device__ static __forceinline__ bf16x8 tobf(T x) { return x; } };
template <> struct Stage<float> { using T = f32x8;
  __device__ static __forceinline__ T ld8(const float* p) { return *reinterpret_cast<const f32x8*>(p); }
  __device__ static __forceinline__ bf16x8 tobf(T x) {
    u32x4 w = {cvtpk(x[0], x[1]), cvtpk(x[2], x[3]), cvtpk(x[4], x[5]), cvtpk(x[6], x[7])}; return *reinterpret_cast<bf16x8*>(&w); } };

__device__ __forceinline__ void partialSM(f32x16& p0, f32x16& p1, float& m_reg, float& mn, float& alpha) {
  constexpr float C = SCALE * 1.4426950408889634f;
  float pmax = p0[0]; for (int r = 1; r < 16; ++r) pmax = fmaxf(pmax, p0[r]); for (int r = 0; r < 16; ++r) pmax = fmaxf(pmax, p1[r]);
  { auto rr = __builtin_amdgcn_permlane32_swap(__float_as_uint(pmax), __float_as_uint(pmax), false, false);
    pmax = fmaxf(__uint_as_float(rr[0]), __uint_as_float(rr[1])); }
  if (__builtin_expect(__all(pmax - m_reg <= THR / SCALE), 1)) { mn = m_reg; alpha = 1.f; }
  else { mn = fmaxf(m_reg, pmax); alpha = __builtin_amdgcn_exp2f((m_reg - mn) * C); m_reg = mn; }
  float mnC = -mn * C;
  for (int r = 0; r < 16; ++r) p0[r] = fmaf(p0[r], C, mnC); for (int r = 0; r < 16; ++r) p1[r] = fmaf(p1[r], C, mnC);
  for (int r = 0; r < 16; ++r) p0[r] = __builtin_amdgcn_exp2f(p0[r]);
}
__device__ __forceinline__ void finishSM(f32x16& p0, f32x16& p1, float alpha, float& l_reg, bf16x8& pa0, bf16x8& pa1, bf16x8& pa2, bf16x8& pa3) {
  for (int r = 0; r < 16; ++r) p1[r] = __builtin_amdgcn_exp2f(p1[r]);
  float ps = 0; for (int r = 0; r < 16; ++r) ps += p0[r]; for (int r = 0; r < 16; ++r) ps += p1[r];
  { auto rr = __builtin_amdgcn_permlane32_swap(__float_as_uint(ps), __float_as_uint(ps), false, false);
    ps = __uint_as_float(rr[0]) + __uint_as_float(rr[1]); }
  l_reg = l_reg * alpha + ps;
#define PK4(P, BASE, OUT) do { unsigned a0 = cvtpk(P[BASE + 0], P[BASE + 1]), a1 = cvtpk(P[BASE + 2], P[BASE + 3]);   \
    unsigned b0 = cvtpk(P[BASE + 4], P[BASE + 5]), b1 = cvtpk(P[BASE + 6], P[BASE + 7]);                              \
    auto r0 = __builtin_amdgcn_permlane32_swap(a0, b0, false, false); auto r1 = __builtin_amdgcn_permlane32_swap(a1, b1, false, false); \
    u32x4 w = {r0[0], r1[0], r0[1], r1[1]}; OUT = *reinterpret_cast<bf16x8*>(&w); } while (0)
  PK4(p0, 0, pa0); PK4(p0, 8, pa1); PK4(p1, 0, pa2); PK4(p1, 8, pa3);
#undef PK4
}
__device__ __forceinline__ void qkt(f32x16& p0, f32x16& p1, const bf16* Ks, const bf16x8* qr, int r32, int hi) {
  p0 = f32x16{}; p1 = f32x16{};
  for (int d0 = 0; d0 < 8; ++d0) { int cb = (d0 * 16 + hi * 8) * 2;
    bf16x8 b0 = *reinterpret_cast<const bf16x8*>((const char*)Ks + KSWZ(r32, cb));
    bf16x8 b1 = *reinterpret_cast<const bf16x8*>((const char*)Ks + KSWZ(32 + r32, cb));
    p0 = __builtin_amdgcn_mfma_f32_32x32x16_bf16(b0, qr[d0], p0, 0, 0, 0);
    p1 = __builtin_amdgcn_mfma_f32_32x32x16_bf16(b1, qr[d0], p1, 0, 0, 0); }
}
__device__ __forceinline__ int v_st(int k, int c) { const int kk = (k & ~0xC) | ((k & 4) << 1) | ((k & 8) >> 1); return ((kk >> 3) * 4 + (c >> 5)) * 512 + ((kk & 7) * 32 + (c & 31)) * 2; }
__device__ __forceinline__ int v_rd_base(int lane) { return ((lane & 3) << 3) | (((lane >> 2) & 3) << 6) | (((lane >> 4) & 1) << 5) | (((lane >> 5) & 1) << 8); }
constexpr int v_rd_off(int d0, int ks, int half) { return d0 * 512 + ks * 4096 + half * 2048; }
template <int OFF> __device__ __forceinline__ s16x4 tr_read(int vb) {
  s16x4 r; asm volatile("ds_read_b64_tr_b16 %0, %1 offset:%2" : "=&v"(r) : "v"(vb), "i"(OFF) : "memory"); return r;
}
template <int D0> __device__ __forceinline__ void pv_one(f32x16& od, int vb, bf16x8 pa0, bf16x8 pa1, bf16x8 pa2, bf16x8 pa3) {
  const s16x4 l0 = tr_read<v_rd_off(D0, 0, 0)>(vb), h0 = tr_read<v_rd_off(D0, 0, 1)>(vb), l1 = tr_read<v_rd_off(D0, 1, 0)>(vb), h1 = tr_read<v_rd_off(D0, 1, 1)>(vb);
  const s16x4 l2 = tr_read<v_rd_off(D0, 2, 0)>(vb), h2 = tr_read<v_rd_off(D0, 2, 1)>(vb), l3 = tr_read<v_rd_off(D0, 3, 0)>(vb), h3 = tr_read<v_rd_off(D0, 3, 1)>(vb);
  asm volatile("s_waitcnt lgkmcnt(0)" ::: "memory"); SBAR();
#define PK(L, H) (bf16x8){L[0], L[1], L[2], L[3], H[0], H[1], H[2], H[3]}
  od = __builtin_amdgcn_mfma_f32_32x32x16_bf16(pa0, PK(l0, h0), od, 0, 0, 0);
  od = __builtin_amdgcn_mfma_f32_32x32x16_bf16(pa1, PK(l1, h1), od, 0, 0, 0);
  od = __builtin_amdgcn_mfma_f32_32x32x16_bf16(pa2, PK(l2, h2), od, 0, 0, 0);
  od = __builtin_amdgcn_mfma_f32_32x32x16_bf16(pa3, PK(l3, h3), od, 0, 0, 0);
#undef PK
}
__device__ __forceinline__ void pv_d0(f32x16* o, int vb, bf16x8 pa0, bf16x8 pa1, bf16x8 pa2, bf16x8 pa3) {
  pv_one<0>(o[0], vb, pa0, pa1, pa2, pa3); pv_one<1>(o[1], vb, pa0, pa1, pa2, pa3); pv_one<2>(o[2], vb, pa0, pa1, pa2, pa3); pv_one<3>(o[3], vb, pa0, pa1, pa2, pa3);
}

template <typename TQ, int LDQ, int LDK, int LDO, typename TO>
__device__ __forceinline__ void attn_dense_body(const TQ* __restrict__ Qb, const bf16* __restrict__ Kh, const bf16* __restrict__ Vh,
                                                TO* __restrict__ Ob, int seq, char* lds, const int tid_in) {
  using St = Stage<bf16>; using SQ = Stage<TQ>;
  const int tid = tid_in, wid = tid >> 6, lane = tid & 63, r32 = lane & 31, hi = lane >> 5;
  bf16* V_lds = (bf16*)lds; bf16* K_lds = (bf16*)(lds + 2 * SHM_V);
  float* ws = (float*)(lds + 2 * SHM_V + 2 * SHM_K) + wid * 64; float* li_l = ws; float* al_l = ws + 32;
  float m_reg = -1e30f, l_reg = 0; f32x16 o[4] = {}; bf16x8 qr[8];
  const TQ* Qw = Qb + (long)(wid * QBLK + r32) * LDQ + hi * 8;
#pragma unroll
  for (int d0 = 0; d0 < 8; ++d0) qr[d0] = SQ::tobf(SQ::ld8(Qw + d0 * 16));
  const int sr = tid >> 4, sc = (tid & 15) * 8, vst0 = v_st(sr, sc), vst1 = v_st(32 + sr, sc);
  const int vb0 = (int)(uintptr_t)V_lds + v_rd_base(lane);
  struct { typename St::T vs0, vs1, ks0, ks1; } sr_[SDEPTH];
#define SLOAD(i, k0) do { sr_[i].vs0 = St::ld8(&Vh[(long)((k0) + sr) * LDK + sc]); sr_[i].vs1 = St::ld8(&Vh[(long)((k0) + 32 + sr) * LDK + sc]); \
    sr_[i].ks0 = St::ld8(&Kh[(long)((k0) + sr) * LDK + sc]); sr_[i].ks1 = St::ld8(&Kh[(long)((k0) + 32 + sr) * LDK + sc]); } while (0)
#define SWRITE(b, i) do { *(bf16x8*)((char*)V_lds + (b) * SHM_V + vst0) = St::tobf(sr_[i].vs0);          \
    *(bf16x8*)((char*)V_lds + (b) * SHM_V + vst1) = St::tobf(sr_[i].vs1); int kc = sc * 2;               \
    *(bf16x8*)((char*)K_lds + (b) * SHM_K + KSWZ(sr, kc)) = St::tobf(sr_[i].ks0);                       \
    *(bf16x8*)((char*)K_lds + (b) * SHM_K + KSWZ(32 + sr, kc)) = St::tobf(sr_[i].ks1); } while (0)
#define SWAIT() do { if constexpr (SDEPTH == 2) asm volatile("s_waitcnt vmcnt(4)" ::: "memory"); else asm volatile("s_waitcnt vmcnt(0)" ::: "memory"); } while (0)
#define RESC(a) do { if (__any((a) < 1.f)) { if (hi == 0) al_l[r32] = (a); asm volatile("s_waitcnt lgkmcnt(0)" ::: "memory"); \
    for (int d = 0; d < 4; ++d) for (int r = 0; r < 16; ++r) o[d][r] *= al_l[crow(r, hi)]; } } while (0)
  f32x16 pA0, pA1, pB0, pB1; float mnA, mnB, alA, alB; bf16x8 pa0, pa1, pa2, pa3; const int NT = seq / KVBLK;
  constexpr int SE = 0, SO = SDEPTH - 1;
  SLOAD(SE, 0); asm volatile("s_waitcnt vmcnt(0)" ::: "memory"); SWRITE(0, SE); __syncthreads();
  qkt(pA0, pA1, K_lds, qr, r32, hi); partialSM(pA0, pA1, m_reg, mnA, alA);
  SLOAD(SO, KVBLK); if constexpr (SDEPTH == 2) { if (2 < NT) SLOAD(SE, 2 * KVBLK); }
  SWAIT(); SWRITE(1, SO); __syncthreads();
  for (int j = 1; j + 1 < NT; j += 2) {
    SBAR(); qkt(pB0, pB1, (bf16*)((char*)K_lds + SHM_K), qr, r32, hi);
    finishSM(pA0, pA1, alA, l_reg, pa0, pa1, pa2, pa3); SBAR();
    SLOAD(SO, (j + SDEPTH) * KVBLK); SBAR();
    pv_d0(o, vb0, pa0, pa1, pa2, pa3); partialSM(pB0, pB1, m_reg, mnB, alB);
    __syncthreads(); SWAIT(); SWRITE(0, SE);
    RESC(alB); __syncthreads();
    SBAR(); qkt(pA0, pA1, K_lds, qr, r32, hi);
    finishSM(pB0, pB1, alB, l_reg, pa0, pa1, pa2, pa3); SBAR();
    if (SDEPTH == 1 || j + 3 < NT) SLOAD(SE, (j + 1 + SDEPTH) * KVBLK); SBAR();
    pv_d0(o, vb0 + (int)SHM_V, pa0, pa1, pa2, pa3); partialSM(pA0, pA1, m_reg, mnA, alA);
    __syncthreads(); SWAIT(); SWRITE(1, SO);
    RESC(alA); __syncthreads();
  }
  SBAR(); qkt(pB0, pB1, (bf16*)((char*)K_lds + SHM_K), qr, r32, hi);
  finishSM(pA0, pA1, alA, l_reg, pa0, pa1, pa2, pa3); SBAR();
  pv_d0(o, vb0, pa0, pa1, pa2, pa3); partialSM(pB0, pB1, m_reg, mnB, alB);
  __syncthreads(); RESC(alB);
  finishSM(pB0, pB1, alB, l_reg, pa0, pa1, pa2, pa3); SBAR();
  pv_d0(o, vb0 + (int)SHM_V, pa0, pa1, pa2, pa3);
  if (hi == 0) li_l[r32] = l_reg; asm volatile("s_waitcnt lgkmcnt(0)" ::: "memory");
  float rli[16];
#pragma unroll
  for (int r = 0; r < 16; ++r) rli[r] = __builtin_amdgcn_rcpf(li_l[crow(r, hi)]);
  TO* Ow = Ob + (long)(wid * QBLK) * LDO;
#pragma unroll
  for (int r = 0; r < 16; ++r) { int orow = crow(r, hi);
    for (int d0 = 0; d0 < 4; ++d0) { const float val = o[d0][r] * rli[r];
      if constexpr (sizeof(TO) == 4) Ow[(long)orow * LDO + d0 * 32 + r32] = val;
      else Ow[(long)orow * LDO + d0 * 32 + r32] = (TO)(cvtpk(val, val) & 0xffffu); } }
#undef SLOAD
#undef SWRITE
#undef SWAIT
#undef RESC
}
}
typedef unsigned short bf16_t;
typedef unsigned u32x4v __attribute__((ext_vector_type(4)));
#define LDSA __attribute__((address_space(3)))
constexpr size_t al256(size_t x) { return (x + 255) / 256 * 256; }
constexpr size_t WS_CTL  = 0;
constexpr size_t CTL_BYTES = 65536;
constexpr size_t WS_XB   = WS_CTL + CTL_BYTES;
constexpr size_t WS_WAB  = WS_XB + (size_t)SEQ * DM * 2;
constexpr size_t WS_WOAB = WS_WAB + (size_t)12288 * 4096 * 2;
constexpr size_t WS_WCD  = WS_WOAB + (size_t)4096 * 3072 * 2;
constexpr size_t WS_WOCD = WS_WCD + (size_t)9216 * 4096 * 2;
constexpr size_t WS_WQ   = WS_WOCD + (size_t)4096 * 4096 * 2;
constexpr size_t WS_UB   = WS_WQ + (size_t)2 * 2048 * 4096 * 2;
constexpr size_t WS_VB   = WS_UB + (size_t)2 * 16384 * 4096 * 2;
constexpr size_t WS_H    = WS_VB + (size_t)2 * 16384 * 4096 * 2;
constexpr size_t WS_Y    = WS_H;
constexpr size_t WS_PQ   = WS_H + (size_t)SEQ * 4096 * 4;
constexpr size_t WS_OC   = WS_H + (size_t)SEQ * 12288 * 4;
constexpr size_t WS_AB   = WS_OC + (size_t)2 * SEQ * 2048 * 4;
constexpr size_t WS_X1   = WS_AB + (size_t)SEQ * 4096 * 2;
constexpr size_t WS_X1B  = WS_X1 + (size_t)SEQ * 4096 * 4;
constexpr size_t WS_X2   = WS_X1B + (size_t)SEQ * 4096 * 2;
constexpr size_t WS_X2B  = WS_X2 + (size_t)SEQ * 4096 * 4;
constexpr size_t WS_EIDX = WS_X2B + (size_t)SEQ * 4096 * 2;
constexpr size_t WS_GATE = WS_EIDX + (size_t)SEQ * 128 * 4;
constexpr size_t WS_HB   = WS_GATE + (size_t)SEQ * 128 * 4;
constexpr size_t WS_END  = WS_HB + (size_t)SEQ * 12288 * 2;
static_assert(WS_END <= (size_t)2147483648ull, "workspace");

constexpr int LDS_BYTES = 147456;
constexpr int LDS_MISC = 131072;

struct MK { const float* in[21]; float* out; unsigned char* ws; int ph_lo, ph_hi; };

namespace pg8 {
struct EpiF32R {
    static constexpr bool PERM = false, AFTER_DRAIN = false;
    float* C; int ldc; const float* R; float ralpha;
    __device__ __forceinline__ void operator()(const f32x4 (&acc)[2][2][4][2], const Unit& u, int wr, int wc, int fr, int fq) const {
        const int row0 = u.pm * BM + wr * 64 + fr, col0 = u.pn * BM + wc * 32 + 4 * fq;
#pragma unroll
        for (int ai = 0; ai < 2; ++ai)
#pragma unroll
            for (int m = 0; m < 4; ++m) { const size_t off = (size_t)(row0 + ai * HALF + m * 16) * ldc + col0;
#pragma unroll
                for (int bj = 0; bj < 2; ++bj)
#pragma unroll
                    for (int n = 0; n < 2; ++n) { f32x4 v = acc[ai][bj][m][n];
                        if (R) { const f32x4 r = *(const f32x4*)(R + off + bj * HALF + n * 16); v += r * ralpha; }
                        *(f32x4*)(C + off + bj * HALF + n * 16) = v; } }
    }
};
}

__device__ __forceinline__ unsigned cvtpk_bf16(float lo, float hi) { unsigned r; asm volatile("v_cvt_pk_bf16_f32 %0, %1, %2" : "=v"(r) : "v"(lo), "v"(hi)); return r; }

__device__ __forceinline__ void cvt_rows_bf16(const float* __restrict__ src, bf16_t* __restrict__ dst, size_t n8, int bid, int nb, int tid, int nthr) {
    for (size_t i = (size_t)bid * nthr + tid; i < n8; i += (size_t)nb * nthr) {
        const float4 a = *(const float4*)(src + i * 8), b = *(const float4*)(src + i * 8 + 4);
        u32x4v w; w.x = cvtpk_bf16(a.x, a.y); w.y = cvtpk_bf16(a.z, a.w); w.z = cvtpk_bf16(b.x, b.y); w.w = cvtpk_bf16(b.z, b.w);
        *(u32x4v*)(dst + i * 8) = w;
    }
}
template <class PM>
__device__ __forceinline__ void transpose_cvt(const float* __restrict__ W, bf16_t* __restrict__ Wt, int K, int N, LDSA float* tile, int bid, int nb, PM pm, const int tid) {
    const int ntk = K / 64, ntn = N / 64;
    for (int t = bid; t < ntk * ntn; t += nb) {
        const int k0 = (t % ntk) * 64, n0 = (t / ntk) * 64;
        __syncthreads();
#pragma unroll
        for (int i = 0; i < 2; ++i) { const int r = (tid >> 4) + 32 * i, c = (tid & 15) * 4;
            const float4 v = *(const float4*)(W + (size_t)(k0 + r) * N + n0 + c);
            tile[r * 65 + c] = v.x; tile[r * 65 + c + 1] = v.y; tile[r * 65 + c + 2] = v.z; tile[r * 65 + c + 3] = v.w; }
        __syncthreads();
        const int mode = pm(n0);
        const int n = tid >> 3, kc = (tid & 7) * 8;
        int src = n;
        if (mode == 1) { if (n < 32) src = (n >> 1) + 16 * (n & 1); }
        else if (mode == 2) src = (n >> 1) + 32 * (n & 1);
        float f[8];
#pragma unroll
        for (int j = 0; j < 8; ++j) f[j] = tile[(kc + j) * 65 + src];
        u32x4v w; w.x = cvtpk_bf16(f[0], f[1]); w.y = cvtpk_bf16(f[2], f[3]); w.z = cvtpk_bf16(f[4], f[5]); w.w = cvtpk_bf16(f[6], f[7]);
        *(u32x4v*)(Wt + (size_t)(n0 + n) * K + k0 + kc) = w;
    }
}
struct PermNone { __device__ __forceinline__ int operator()(int) const { return 0; } };


typedef __bf16 bf2_t __attribute__((ext_vector_type(2)));
__device__ __forceinline__ float gelu_tanh_f(float x) {
    const float z = 0.7978845608028654f * (x + 0.044715f * x * x * x);
    const float e = __expf(2.0f * z);
    return 0.5f * x * (2.0f - 2.0f / (e + 1.0f));
}
__device__ __forceinline__ int pick_i(int a0, int a1, int k) { return k < 64 ? __builtin_amdgcn_readlane(a0, k) : __builtin_amdgcn_readlane(a1, k - 64); }
__device__ __forceinline__ float pick_f(float a0, float a1, int k) { return __int_as_float(pick_i(__float_as_int(a0), __float_as_int(a1), k)); }
#define PE_LOADROW(dst, base, e) do { const bf16_t* _p = (base) + (size_t)(e) * DM + lane * 8; _Pragma("unroll") for (int _i = 0; _i < 8; ++_i) dst[_i] = *(const u32x4v*)(_p + _i * 512); } while (0)
__device__ __forceinline__ float dot2_bf16(unsigned a, unsigned b, float c) { return __builtin_amdgcn_fdot2_f32_bf16(__builtin_bit_cast(bf2_t, a), __builtin_bit_cast(bf2_t, b), c, false); }
__device__ __forceinline__ float pe_dot(const u32x4v (&r)[8], const u32x4v (&x)[8]) {
    float d0 = 0.f, d1 = 0.f, d2 = 0.f, d3 = 0.f;
#pragma unroll
    for (int i = 0; i < 8; ++i) {
        d0 = dot2_bf16(r[i].x, x[i].x, d0);
        d1 = dot2_bf16(r[i].y, x[i].y, d1);
        d2 = dot2_bf16(r[i].z, x[i].z, d2);
        d3 = dot2_bf16(r[i].w, x[i].w, d3);
    }
    return wave_sum((d0 + d1) + (d2 + d3));
}
__device__ __forceinline__ void pe_axpy(float (&acc)[64], const u32x4v (&r)[8], const float w) {
#pragma unroll
    for (int i = 0; i < 8; ++i) {
        const unsigned q[4] = {r[i].x, r[i].y, r[i].z, r[i].w};
#pragma unroll
        for (int j = 0; j < 4; ++j) {
            acc[i * 8 + 2 * j]     = fmaf(w, __uint_as_float(q[j] << 16), acc[i * 8 + 2 * j]);
            acc[i * 8 + 2 * j + 1] = fmaf(w, __uint_as_float(q[j] & 0xffff0000u), acc[i * 8 + 2 * j + 1]);
        }
    }
}
__device__ __forceinline__ void peer_expert_phase(const float* __restrict__ x1, const bf16_t* __restrict__ x1b, const int* __restrict__ eidx, const float* __restrict__ gate,
                                                  const bf16_t* __restrict__ ub, const bf16_t* __restrict__ vb, const float* __restrict__ lg, const float* __restrict__ lb,
                                                  float* __restrict__ out, bf16_t* __restrict__ outb, const int bid, const int G, const int tid) {
    const int lane = tid & 63, wv = __builtin_amdgcn_readfirstlane(tid >> 6);
    for (int t = bid * 8 + wv; t < SEQ; t += G * 8) {
        const int e0 = eidx[(size_t)t * 128 + lane], e1 = eidx[(size_t)t * 128 + 64 + lane];
        const float g0 = gate[(size_t)t * 128 + lane], g1 = gate[(size_t)t * 128 + 64 + lane];
        u32x4v xq[8];
#pragma unroll
        for (int i = 0; i < 8; ++i) xq[i] = *(const u32x4v*)(x1b + (size_t)t * DM + i * 512 + lane * 8);
        float w0 = 0.f, w1 = 0.f;
        u32x4v A[8], B[8];
        PE_LOADROW(A, ub, pick_i(e0, e1, 0));
        for (int k = 0; k < 128; k += 2) {
            PE_LOADROW(B, ub, pick_i(e0, e1, k + 1));
            { const float d = pe_dot(A, xq); const float w = pick_f(g0, g1, k) * gelu_tanh_f(d);
              if (lane == (k & 63)) { if (k < 64) w0 = w; else w1 = w; } }
            { const int kn = (k + 2 < 128) ? k + 2 : 127; PE_LOADROW(A, ub, pick_i(e0, e1, kn)); }
            { const float d = pe_dot(B, xq); const float w = pick_f(g0, g1, k + 1) * gelu_tanh_f(d);
              if (lane == ((k + 1) & 63)) { if (k + 1 < 64) w0 = w; else w1 = w; } }
        }
        float acc[64];
#pragma unroll
        for (int i = 0; i < 64; ++i) acc[i] = 0.f;
        PE_LOADROW(A, vb, pick_i(e0, e1, 0));
        for (int k = 0; k < 128; k += 2) {
            PE_LOADROW(B, vb, pick_i(e0, e1, k + 1));
            pe_axpy(acc, A, pick_f(w0, w1, k));
            { const int kn = (k + 2 < 128) ? k + 2 : 127; PE_LOADROW(A, vb, pick_i(e0, e1, kn)); }
            pe_axpy(acc, B, pick_f(w0, w1, k + 1));
        }
        float s = 0.f;
#pragma unroll
        for (int i = 0; i < 8; ++i) {
            const float4 xa = *(const float4*)(x1 + (size_t)t * DM + i * 512 + lane * 8), xc = *(const float4*)(x1 + (size_t)t * DM + i * 512 + lane * 8 + 4);
            acc[i * 8 + 0] = fmaf(ALPHA, xa.x, acc[i * 8 + 0]); acc[i * 8 + 1] = fmaf(ALPHA, xa.y, acc[i * 8 + 1]); acc[i * 8 + 2] = fmaf(ALPHA, xa.z, acc[i * 8 + 2]); acc[i * 8 + 3] = fmaf(ALPHA, xa.w, acc[i * 8 + 3]);
            acc[i * 8 + 4] = fmaf(ALPHA, xc.x, acc[i * 8 + 4]); acc[i * 8 + 5] = fmaf(ALPHA, xc.y, acc[i * 8 + 5]); acc[i * 8 + 6] = fmaf(ALPHA, xc.z, acc[i * 8 + 6]); acc[i * 8 + 7] = fmaf(ALPHA, xc.w, acc[i * 8 + 7]);
#pragma unroll
            for (int j = 0; j < 8; ++j) s += acc[i * 8 + j];
            if (i & 1) asm volatile("" ::: "memory");
        }
        const float mean = wave_sum(s) * (1.0f / DM);
        float qq = 0.f;
#pragma unroll
        for (int i = 0; i < 64; ++i) { const float d = acc[i] - mean; qq = fmaf(d, d, qq); }
        const float rstd = 1.0f / sqrtf(wave_sum(qq) * (1.0f / DM) + 1e-5f);
#pragma unroll
        for (int i = 0; i < 8; ++i) {
            const int c = i * 512 + lane * 8;
            const float4 ga = *(const float4*)(lg + c), gc = *(const float4*)(lg + c + 4), ba = *(const float4*)(lb + c), bc = *(const float4*)(lb + c + 4);
            float4 oa, ob;
            oa.x = (acc[i * 8 + 0] - mean) * rstd * ga.x + ba.x; oa.y = (acc[i * 8 + 1] - mean) * rstd * ga.y + ba.y; oa.z = (acc[i * 8 + 2] - mean) * rstd * ga.z + ba.z; oa.w = (acc[i * 8 + 3] - mean) * rstd * ga.w + ba.w;
            ob.x = (acc[i * 8 + 4] - mean) * rstd * gc.x + bc.x; ob.y = (acc[i * 8 + 5] - mean) * rstd * gc.y + bc.y; ob.z = (acc[i * 8 + 6] - mean) * rstd * gc.z + bc.z; ob.w = (acc[i * 8 + 7] - mean) * rstd * gc.w + bc.w;
            *(float4*)(out + (size_t)t * DM + c) = oa; *(float4*)(out + (size_t)t * DM + c + 4) = ob;
            if (outb) { u32x4v w; w.x = cvtpk_bf16(oa.x, oa.y); w.y = cvtpk_bf16(oa.z, oa.w); w.z = cvtpk_bf16(ob.x, ob.y); w.w = cvtpk_bf16(ob.z, ob.w); *(u32x4v*)(outb + (size_t)t * DM + c) = w; }
            asm volatile("" ::: "memory");
        }
    }
}


__device__ __forceinline__ void attn1_phase(const bf16_t* __restrict__ hb, bf16_t* __restrict__ abb, float* __restrict__ oc, char* lds, const int bid, const int G, const int tid) {
    for (int u = bid; u < 512; u += G) {
        __syncthreads();
        const int kv = u >> 7, g = (u >> 5) & 3, qb = u & 31, hq = kv * 4 + g;
        att::attn_dense_body<att::bf16, 9216, 9216, 4096, att::bf16>(hb + (size_t)(qb * 256) * 9216 + 6144 + hq * 128, hb + 8192 + kv * 128, hb + 8704 + kv * 128,
                                                                       abb + (size_t)(qb * 256) * 4096 + 2048 + hq * 128, SEQ, lds, tid);
    }
    for (int v = bid; v < 1024; v += G) {
        __syncthreads();
        const int hm = v >> 6, vh = (v >> 5) & 1, qb = v & 31, h = hm >> 1, map = hm & 1;
        att::attn_dense_body<att::bf16, 9216, 9216, 2048, float>(hb + (size_t)(qb * 256) * 9216 + h * 256 + map * 128, hb + 2048 + h * 256 + map * 128, hb + 4096 + h * 256 + vh * 128,
                                                                   oc + (size_t)map * SEQ * 2048 + (size_t)(qb * 256) * 2048 + h * 256 + vh * 128, SEQ, lds, tid);
    }
}

__device__ __forceinline__ float bf_lo(unsigned w) { return __uint_as_float(w << 16); }
__device__ __forceinline__ float bf_hi(unsigned w) { return __uint_as_float(w & 0xffff0000u); }

__device__ __forceinline__ void post_even_phase(const float* __restrict__ h, bf16_t* __restrict__ hb, const int bid, const int G, const int tid) {
    const int lane = tid & 63, wv = tid >> 6;
    for (int job = bid * 8 + wv; job < SEQ * 96; job += G * 8) {
        const int t = job / 96, blk = job - t * 96;
        const bool rope = (blk < 20) || (blk >= 24 && blk < 72);
        const float2 v = *(const float2*)(h + (size_t)t * 12288 + blk * 128 + 2 * lane);
        float o0 = v.x, o1 = v.y;
        const float p0 = __shfl_xor(v.x, 8), p1 = __shfl_xor(v.y, 8);
        if (rope && lane < 16) {
            const int i0 = (2 * lane) & 15;
            float s0, c0, s1, c1; sincos_rev((double)t * REV_P[i0], s0, c0); sincos_rev((double)t * REV_P[i0 + 1], s1, c1);
            if (lane < 8) { o0 = v.x * c0 - p0 * s0; o1 = v.y * c1 - p1 * s1; }
            else          { o0 = v.x * c0 + p0 * s0; o1 = v.y * c1 + p1 * s1; }
        }
        *(unsigned*)(hb + (size_t)t * 12288 + blk * 128 + 2 * lane) = cvtpk_bf16(o0, o1);
    }
}
__device__ __forceinline__ void post_odd_phase(const float* __restrict__ h, bf16_t* __restrict__ hb, const float* __restrict__ qg, const float* __restrict__ kg, const int bid, const int G, const int tid) {
    const int lane = tid & 63, wv = tid >> 6;
    for (int job = bid * 8 + wv; job < SEQ * 72; job += G * 8) {
        const int t = job / 72, blk = job - t * 72;
        const float2 v = *(const float2*)(h + (size_t)t * 9216 + blk * 128 + 2 * lane);
        float o0 = v.x, o1 = v.y;
        if (blk < 32) {
            const float p0 = __shfl_xor(v.x, 8), p1 = __shfl_xor(v.y, 8);
            if (lane < 16) {
                const int i0 = (2 * lane) & 15;
                float s0, c0, s1, c1; sincos_rev((double)t * REV_P[i0], s0, c0); sincos_rev((double)t * REV_P[i0 + 1], s1, c1);
                if (lane < 8) { o0 = v.x * c0 - p0 * s0; o1 = v.y * c1 - p1 * s1; }
                else          { o0 = v.x * c0 + p0 * s0; o1 = v.y * c1 + p1 * s1; }
            }
        } else if (blk >= 48 && blk < 68) {
            const float* g = blk < 64 ? qg : kg;
            const float ss = wave_sum(v.x * v.x + v.y * v.y) * (1.0f / 128.0f);
            const float rs = 1.0f / sqrtf(ss + 1e-6f);
            const float a0 = v.x * rs * g[2 * lane], a1 = v.y * rs * g[2 * lane + 1];
            const float p0 = __shfl_xor(a0, 16), p1 = __shfl_xor(a1, 16);
            const int i0 = (2 * lane) & 31;
            const double pos = (double)(lane < 32 ? (t >> 6) : (t & 63));
            float s0, c0, s1, c1; sincos_rev(pos * REV_A[i0], s0, c0); sincos_rev(pos * REV_A[i0 + 1], s1, c1);
            if ((lane & 16) == 0) { o0 = a0 * c0 - p0 * s0; o1 = a1 * c1 - p1 * s1; }
            else                  { o0 = a0 * c0 + p0 * s0; o1 = a1 * c1 + p1 * s1; }
        }
        *(unsigned*)(hb + (size_t)t * 9216 + blk * 128 + 2 * lane) = cvtpk_bf16(o0, o1);
    }
}

__device__ __forceinline__ void attn_seg_b(const float q0, const float q1, const bf16_t* __restrict__ Kb, const bf16_t* __restrict__ Vb, const int ld,
                                           const int t, const int step, int jlo, int jhi, float& m, float& l, float& o0, float& o1, const int lane) {
    { const int lo = -(t / step); if (jlo < lo) jlo = lo; const int hi = (SEQ - 1 - t) / step; if (jhi > hi) jhi = hi; }
    for (int j = jlo; j <= jhi; ++j) {
        const size_t tp = (size_t)(t + step * j);
        const unsigned kw = *(const unsigned*)(Kb + tp * ld + 2 * lane), vw = *(const unsigned*)(Vb + tp * ld + 2 * lane);
        const float s = wave_sum(q0 * bf_lo(kw) + q1 * bf_hi(kw)) * ATT_SCALE;
        const float mn = fmaxf(m, s);
        const float al = __expf(m - mn), p = __expf(s - mn);
        l = l * al + p;
        o0 = o0 * al + p * bf_lo(vw); o1 = o1 * al + p * bf_hi(vw);
        m = mn;
    }
}
__device__ __forceinline__ void attn_even_valu_phase(const bf16_t* __restrict__ hb, const float* __restrict__ sink, bf16_t* __restrict__ abb, const int bid, const int G, const int tid) {
    const int lane = tid & 63, wv = tid >> 6;
    const int LD = 12288;
    for (int job = bid * 8 + wv; job < SEQ * 24; job += G * 8) {
        const int hh = job / SEQ, t = job % SEQ;
        float o0 = 0.f, o1 = 0.f, m, l;
        if (hh < 16) {
            const int kv = hh >> 2;
            const unsigned qw = *(const unsigned*)(hb + (size_t)t * LD + hh * 128 + 2 * lane);
            m = sink[hh]; l = 1.f;
            attn_seg_b(bf_lo(qw), bf_hi(qw), hb + 2048 + kv * 128, hb + 2560 + kv * 128, LD, t, 1, -128, 128, m, l, o0, o1, lane);
        } else {
            const int hbh = hh - 16;
            m = -1e30f; l = 0.f;
#pragma unroll
            for (int g = 0; g < 3; ++g) {
                const int head = 8 * g + hbh; const int step = g == 0 ? 1 : (g == 1 ? 4 : 16);
                const unsigned qw = *(const unsigned*)(hb + (size_t)t * LD + 3072 + head * 128 + 2 * lane);
                attn_seg_b(bf_lo(qw), bf_hi(qw), hb + 6144 + head * 128, hb + 9216 + head * 128, LD, t, step, -64, 64, m, l, o0, o1, lane);
            }
        }
        const float il = 1.0f / l;
        *(unsigned*)(abb + (size_t)t * 3072 + hh * 128 + 2 * lane) = cvtpk_bf16(o0 * il, o1 * il);
    }
}

__device__ __forceinline__ void ln_phase(const float* __restrict__ y, const float* __restrict__ g, const float* __restrict__ b, float* __restrict__ out, bf16_t* __restrict__ outb, const int bid, const int G, const int tid) {
    const int lane = tid & 63, wv = tid >> 6;
    for (int t = bid * 8 + wv; t < SEQ; t += G * 8) {
        float4 v[16]; float s = 0.f;
#pragma unroll
        for (int i = 0; i < 16; ++i) { v[i] = *(const float4*)(y + (size_t)t * DM + i * 256 + lane * 4); s += (v[i].x + v[i].y) + (v[i].z + v[i].w); }
        const float mean = wave_sum(s) * (1.0f / DM);
        float q = 0.f;
#pragma unroll
        for (int i = 0; i < 16; ++i) { const float a = v[i].x - mean, bb = v[i].y - mean, c = v[i].z - mean, d = v[i].w - mean; q += (a * a + bb * bb) + (c * c + d * d); }
        const float rstd = 1.0f / sqrtf(wave_sum(q) * (1.0f / DM) + 1e-5f);
#pragma unroll
        for (int i = 0; i < 16; ++i) {
            const float4 gg = *(const float4*)(g + i * 256 + lane * 4), bb = *(const float4*)(b + i * 256 + lane * 4);
            float4 o; o.x = (v[i].x - mean) * rstd * gg.x + bb.x; o.y = (v[i].y - mean) * rstd * gg.y + bb.y; o.z = (v[i].z - mean) * rstd * gg.z + bb.z; o.w = (v[i].w - mean) * rstd * gg.w + bb.w;
            *(float4*)(out + (size_t)t * DM + i * 256 + lane * 4) = o;
            uint2 w; w.x = cvtpk_bf16(o.x, o.y); w.y = cvtpk_bf16(o.z, o.w); *(uint2*)(outb + (size_t)t * DM + i * 256 + lane * 4) = w;
            if ((i & 3) == 3) asm volatile("" ::: "memory");
        }
    }
}

__device__ __forceinline__ void route_valu_phase(const float* __restrict__ q  , const float* __restrict__ keys  , int* __restrict__ eidx, float* __restrict__ gate, const int bid, const int G, const int tid) {
    const int lane = tid & 63, wv = tid >> 6;
    for (int job = bid * 8 + wv; job < SEQ * 8; job += G * 8) {
        const int hh = job & 7, t = job >> 3;
        float sv0 = 0.f, sv1 = 0.f; int si0 = 0, si1 = 0;
#pragma unroll
        for (int c = 0; c < 2; ++c) {
            const float* qq = q + (size_t)t * 2048 + hh * 256 + c * 128;
            const float* k0 = keys + ((size_t)(hh * 2 + c) * 128 + lane) * 128;
            const float* k1 = k0 + 64 * 128;
            float s0 = 0.f, s1 = 0.f;
            for (int d = 0; d < 128; d += 4) {
                const float4 qv = *(const float4*)(qq + d), a = *(const float4*)(k0 + d), b = *(const float4*)(k1 + d);
                s0 += qv.x * a.x + qv.y * a.y + qv.z * a.z + qv.w * a.w;
                s1 += qv.x * b.x + qv.y * b.y + qv.z * b.z + qv.w * b.w;
            }
            float myv = 0.f; int myi = 0;
            for (int k = 0; k < 16; ++k) {
                float bv; int bi;
                if (s1 > s0) { bv = s1; bi = lane + 64; } else { bv = s0; bi = lane; }
#pragma unroll
                for (int o = 32; o >= 1; o >>= 1) {
                    const float ov = __shfl_xor(bv, o); const int oi = __shfl_xor(bi, o);
                    if (ov > bv || (ov == bv && oi < bi)) { bv = ov; bi = oi; }
                }
                if (lane == k) { myv = bv; myi = bi; }
                if (bi == lane) s0 = -3.0e38f;
                if (bi == lane + 64) s1 = -3.0e38f;
            }
            if (c == 0) { sv0 = myv; si0 = myi; } else { sv1 = myv; si1 = myi; }
        }
        float cv0, cv1, cv2, cv3; int ci0, ci1, ci2, ci3;
        { const float a = __shfl(sv0, lane >> 2); const int ai = __shfl(si0, lane >> 2); const int jb = (lane & 3) * 4;
          cv0 = a + __shfl(sv1, jb + 0); ci0 = ai * 128 + __shfl(si1, jb + 0);
          cv1 = a + __shfl(sv1, jb + 1); ci1 = ai * 128 + __shfl(si1, jb + 1);
          cv2 = a + __shfl(sv1, jb + 2); ci2 = ai * 128 + __shfl(si1, jb + 2);
          cv3 = a + __shfl(sv1, jb + 3); ci3 = ai * 128 + __shfl(si1, jb + 3); }
        float tv = 0.f; int te = 0;
        for (int k = 0; k < 16; ++k) {
            float bv = cv0; int bp = lane * 4, be = ci0;
            if (cv1 > bv) { bv = cv1; bp = lane * 4 + 1; be = ci1; }
            if (cv2 > bv) { bv = cv2; bp = lane * 4 + 2; be = ci2; }
            if (cv3 > bv) { bv = cv3; bp = lane * 4 + 3; be = ci3; }
#pragma unroll
            for (int o = 32; o >= 1; o >>= 1) {
                const float ov = __shfl_xor(bv, o); const int op = __shfl_xor(bp, o); const int oe = __shfl_xor(be, o);
                if (ov > bv || (ov == bv && op < bp)) { bv = ov; bp = op; be = oe; }
            }
            if (lane == k) { tv = bv; te = be; }
            if (bp == lane * 4 + 0) cv0 = -3.0e38f;
            if (bp == lane * 4 + 1) cv1 = -3.0e38f;
            if (bp == lane * 4 + 2) cv2 = -3.0e38f;
            if (bp == lane * 4 + 3) cv3 = -3.0e38f;
        }
        const float v = lane < 16 ? tv : -3.0e38f;
        const float mx = wave_max(v);
        const float e = lane < 16 ? __expf(tv - mx) : 0.f;
        const float den = wave_sum(e);
        if (lane < 16) { eidx[(size_t)t * 128 + hh * 16 + lane] = te; gate[(size_t)t * 128 + hh * 16 + lane] = e / den; }
    }
}
#ifndef PH_MASK
#define PH_MASK 0xffffffffu
#endif
constexpr int N_PHASES = 20;
__global__ void __launch_bounds__(512, 2) mega(MK a) {
    extern __shared__ __attribute__((aligned(16))) unsigned char lds_raw[];
    LDSA unsigned char* lds = (LDSA unsigned char*)lds_raw;
    const int lo = a.ph_lo, hi = a.ph_hi;
    const int G = gridDim.x, bid = blockIdx.x;
    const int wid_s = __builtin_amdgcn_readfirstlane(threadIdx.x >> 6);
    unsigned char* ws = a.ws;
#define PH_TID() int tid; { int _z = 0; asm volatile("" : "+s"(_z)); tid = wid_s * 64 + (int)__builtin_amdgcn_mbcnt_hi(~0u, __builtin_amdgcn_mbcnt_lo(~0u, (unsigned)_z)); }
#define WSP(T, name, off) T* name; { unsigned char* _b = ws; asm volatile("" : "+s"(_b)); name = (T*)(_b + (off)); }
#define IN(k) ((((PH_MASK) >> (k)) & 1u) && lo <= (k) && (k) < hi)
#define SEAM(k) do { if ((k) + 1 < hi) { PH_TID() xcd_barrier(bar, tid); } } while (0)
    XcdBarrier bar;
    { PH_TID()
      volatile LAS unsigned* st = (volatile LAS unsigned*)(lds + LDS_MISC);
      if (tid == 0) { st[0] = 0u; st[1] = 0u; }
      __syncthreads();
      bar = xcd_barrier_post((unsigned*)(ws + WS_CTL), st, tid); }

    if (IN(0)) {
        PH_TID()
        WSP(bf16_t, xb, WS_XB) WSP(bf16_t, wab, WS_WAB) WSP(bf16_t, woab, WS_WOAB) WSP(bf16_t, wcd, WS_WCD) WSP(bf16_t, wocd, WS_WOCD) WSP(bf16_t, wq, WS_WQ) WSP(bf16_t, ub, WS_UB) WSP(bf16_t, vb, WS_VB)
        cvt_rows_bf16(a.in[0], xb, (size_t)SEQ * DM / 8, bid, G, tid, 512);
        LDSA float* tile = (LDSA float*)lds;
        transpose_cvt(a.in[1], wab, 4096, 12288, tile, bid, G, PermNone(), tid);
        transpose_cvt(a.in[3], woab, 3072, 4096, tile, bid, G, PermNone(), tid);
        transpose_cvt(a.in[4], wcd, 4096, 9216, tile, bid, G, PermNone(), tid);
        transpose_cvt(a.in[12], wocd, 4096, 4096, tile, bid, G, PermNone(), tid);
        transpose_cvt(a.in[15], wq, 4096, 2048, tile, bid, G, PermNone(), tid);
        transpose_cvt(a.in[15] + (size_t)4096 * 2048, wq + (size_t)2048 * 4096, 4096, 2048, tile, bid, G, PermNone(), tid);
        cvt_rows_bf16(a.in[17], ub, (size_t)2 * 16384 * 4096 / 8, bid, G, tid, 512);
        cvt_rows_bf16(a.in[18], vb, (size_t)2 * 16384 * 4096 / 8, bid, G, tid, 512);
        SEAM(0);
    }
#pragma unroll
    for (int layer = 0; layer < 2; ++layer) {
        const int pb = 1 + 10 * layer;
        if (IN(pb + 0)) {
            PH_TID() WSP(bf16_t, xb, WS_XB) WSP(bf16_t, x2b, WS_X2B) WSP(bf16_t, wab, WS_WAB) WSP(bf16_t, wcd, WS_WCD) WSP(float, hbuf, WS_H)
            const int N = layer == 0 ? 12288 : 9216;
            pg8::Gemm g{layer == 0 ? xb : x2b, layer == 0 ? wab : wcd, SEQ, N, 4096}; pg8::StaticOrder S; S.init(SEQ, N, G, bid);
            pg8::EpiF32R E{hbuf, N, nullptr, 0.f};
            pg8::gemm_phase<pg8::EpiF32R, pg8::StaticOrder>(lds, g, S, E, nullptr, tid);
            SEAM(pb + 0);
        }
        if (IN(pb + 1)) {
            PH_TID() WSP(float, hbuf, WS_H) WSP(bf16_t, hb, WS_HB)
            if (layer == 0) post_even_phase(hbuf, hb, bid, G, tid);
            else post_odd_phase(hbuf, hb, a.in[10], a.in[11], bid, G, tid);
            SEAM(pb + 1);
        }
        if (IN(pb + 2)) {
            PH_TID() WSP(bf16_t, hb, WS_HB) WSP(bf16_t, abb, WS_AB) WSP(float, oc, WS_OC)
            if (layer == 0) attn_even_valu_phase(hb, a.in[2], abb, bid, G, tid);
            else attn1_phase(hb, abb, oc, (char*)lds_raw, bid, G, tid);
            SEAM(pb + 2);
        }
        if (layer == 1) {
            if (IN(pb + 3)) {
                PH_TID() WSP(bf16_t, abb, WS_AB) WSP(float, oc, WS_OC)
                const int lane = tid & 63, wv = tid >> 6;
                const float* lq1 = a.in[5]; const float* lk1 = a.in[6]; const float* lq2 = a.in[7]; const float* lk2 = a.in[8]; const float* subg = a.in[9];
                const float lam = __expf(wave_sum(lq1[lane] * lk1[lane] + lq1[lane + 64] * lk1[lane + 64])) - __expf(wave_sum(lq2[lane] * lk2[lane] + lq2[lane + 64] * lk2[lane + 64])) + LAMBDA_INIT;
                const float4 sg = *(const float4*)(subg + 4 * lane);
                for (int j = bid * 8 + wv; j < SEQ * 8; j += G * 8) {
                    const int t = j >> 3, h = j & 7;
                    const float4 o1 = *(const float4*)(oc + (size_t)t * 2048 + h * 256 + 4 * lane), o2 = *(const float4*)(oc + (size_t)SEQ * 2048 + (size_t)t * 2048 + h * 256 + 4 * lane);
                    const float ox = o1.x - lam * o2.x, oy = o1.y - lam * o2.y, oz = o1.z - lam * o2.z, ow = o1.w - lam * o2.w;
                    const float ss = wave_sum((ox * ox + oy * oy) + (oz * oz + ow * ow)) * (1.0f / 256.0f);
                    const float rs = (1.0f - LAMBDA_INIT) / sqrtf(ss + 1e-6f);
                    uint2 w; w.x = cvtpk_bf16(ox * rs * sg.x, oy * rs * sg.y); w.y = cvtpk_bf16(oz * rs * sg.z, ow * rs * sg.w);
                    *(uint2*)(abb + (size_t)t * 4096 + h * 256 + 4 * lane) = w;
                }
                SEAM(pb + 3);
            }
        }
        if (IN(pb + 4)) {
            const int K = layer == 0 ? 3072 : 4096;
            PH_TID() WSP(bf16_t, abb, WS_AB) WSP(bf16_t, woab, WS_WOAB) WSP(bf16_t, wocd, WS_WOCD) WSP(float, ybuf, WS_Y) WSP(float, x2, WS_X2)
            pg8::Gemm g{abb, layer == 0 ? woab : wocd, SEQ, 4096, K}; pg8::StaticOrder S; S.init(SEQ, 4096, G, bid);
            pg8::EpiF32R E{ybuf, 4096, layer == 0 ? a.in[0] : (const float*)x2, ALPHA};
            pg8::gemm_phase<pg8::EpiF32R, pg8::StaticOrder>(lds, g, S, E, nullptr, tid);
            SEAM(pb + 4);
        }
        if (IN(pb + 5)) {
            PH_TID() WSP(float, ybuf, WS_Y) WSP(float, x1, WS_X1) WSP(bf16_t, x1b, WS_X1B)
            ln_phase(ybuf, a.in[13] + layer * DM, a.in[14] + layer * DM, x1, x1b, bid, G, tid);
            SEAM(pb + 5);
        }
        if (IN(pb + 6)) {
            PH_TID() WSP(bf16_t, x1b, WS_X1B) WSP(bf16_t, wq, WS_WQ) WSP(float, pq, WS_PQ)
            pg8::Gemm g{x1b, wq + (size_t)layer * 2048 * 4096, SEQ, 2048, 4096}; pg8::StaticOrder S; S.init(SEQ, 2048, G, bid);
            pg8::EpiF32R E{pq, 2048, nullptr, 0.f};
            pg8::gemm_phase<pg8::EpiF32R, pg8::StaticOrder>(lds, g, S, E, nullptr, tid);
            SEAM(pb + 6);
        }
        if (IN(pb + 7)) {
            PH_TID() WSP(float, pq, WS_PQ) WSP(int, eidx, WS_EIDX) WSP(float, gate, WS_GATE)
            route_valu_phase(pq, a.in[16] + (size_t)layer * 8 * 2 * 128 * 128, eidx, gate, bid, G, tid);
            SEAM(pb + 7);
        }
        if (IN(pb + 8)) {
            PH_TID() WSP(float, x1, WS_X1) WSP(bf16_t, x1b, WS_X1B) WSP(int, eidx, WS_EIDX) WSP(float, gate, WS_GATE) WSP(bf16_t, ub, WS_UB) WSP(bf16_t, vb, WS_VB) WSP(float, x2, WS_X2) WSP(bf16_t, x2b, WS_X2B)
            peer_expert_phase(x1, x1b, eidx, gate, ub + (size_t)layer * 16384 * 4096, vb + (size_t)layer * 16384 * 4096, a.in[19] + layer * DM, a.in[20] + layer * DM,
                              layer == 0 ? x2 : a.out, layer == 0 ? x2b : (bf16_t*)nullptr, bid, G, tid);
            SEAM(pb + 8);
        }
    }
#undef IN
}
#ifndef ONE_LAUNCH
#define ONE_LAUNCH 1
#endif
extern "C" void kernel_launch(void* const* d_in, const int* in_sizes, int n_in, void* d_out, int out_size, void* d_ws, size_t ws_size, hipStream_t stream) {
    static int ready = 0;
    if (!ready) {
        if (ws_size < WS_END) { fprintf(stderr, "kernel_launch: workspace too small: %zu < %zu\n", ws_size, (size_t)WS_END); return; }
        if (hipFuncSetAttribute((const void*)mega, hipFuncAttributeMaxDynamicSharedMemorySize, LDS_BYTES) != hipSuccess) { fprintf(stderr, "kernel_launch: hipFuncSetAttribute failed\n"); return; }
        int per_cu = 0;
        if (hipOccupancyMaxActiveBlocksPerMultiprocessor(&per_cu, (const void*)mega, 512, LDS_BYTES) != hipSuccess || per_cu < 1) fprintf(stderr, "kernel_launch: note: occupancy query reports %d blocks per CU\n", per_cu);
        (void)hipGetLastError();
        ready = 1;
    }
    unsigned char* ws = (unsigned char*)d_ws;
    (void)hipMemsetAsync(ws + WS_CTL, 0, CTL_BYTES, stream);
    MK a{}; for (int i = 0; i < 21; ++i) a.in[i] = (const float*)d_in[i];
    a.out = (float*)d_out; a.ws = ws;
#if ONE_LAUNCH
    a.ph_lo = 0; a.ph_hi = N_PHASES;
    hipLaunchKernelGGL(mega, dim3(256), dim3(512), LDS_BYTES, stream, a);
#else
    for (int k = 0; k < N_PHASES; ++k) { if (k == 4 || k == 10) continue; a.ph_lo = k; a.ph_hi = k + 1; hipLaunchKernelGGL(mega, dim3(256), dim3(512), LDS_BYTES, stream, a); }
#endif
    const hipError_t le = hipPeekAtLastError();
    if (le != hipSuccess) fprintf(stderr, "kernel_launch: launch failed: %s\n", hipGetErrorName(le));
}
```

```cpp
#include <hip/hip_runtime.h>
#include <stdint.h>
#include <cstdio>

#define SEQ 8192
#define DM 4096
#define HD 128
#define ALPHA 1.4142135623730951f
#define LAMBDA_INIT 0.35550906759096934f
#define ATT_SCALE 0.088388347648318440f

__device__ const double REV_P[16] = {0.15915494309189535, 0.0700865215877985, 0.03086376340470123, 0.013591370636193905, 0.005985185712713705, 0.002635675898667414, 0.001160663641240061, 0.0005111175045375439, 0.00022507907903927653, 9.911730936901935e-05, 4.364795279280289e-05, 1.9221100684944863e-05, 8.464330808241401e-06, 3.727408601915352e-06, 1.6414262627950345e-06, 7.228293068832865e-07};
__device__ const double REV_A[32] = {0.15915494309189535, 0.11934937021124886, 0.08949940160889101, 0.06711508300522726, 0.050329212104487035, 0.03774158471741977, 0.0283021958306234, 0.02122365276477766, 0.015915494309189534, 0.011934937021124886, 0.008949940160889102, 0.006711508300522725, 0.005032921210448704, 0.003774158471741977, 0.00283021958306234, 0.0021223652764777662, 0.0015915494309189536, 0.0011934937021124885, 0.0008949940160889102, 0.0006711508300522726, 0.0005032921210448703, 0.00037741584717419774, 0.00028302195830623395, 0.0002122365276477766, 0.00015915494309189535, 0.00011934937021124886, 8.949940160889102e-05, 6.711508300522725e-05, 5.0329212104487035e-05, 3.774158471741978e-05, 2.8302195830623396e-05, 2.122365276477766e-05};

__device__ __forceinline__ void sincos_rev(double rev, float& s, float& c) {
    const double f = rev - floor(rev); const float ff = (float)f;
    s = __builtin_amdgcn_sinf(ff); c = __builtin_amdgcn_cosf(ff);
}
__device__ __forceinline__ float wave_sum(float v) {
#pragma unroll
    for (int o = 32; o >= 1; o >>= 1) v += __shfl_xor(v, o);
    return v;
}
__device__ __forceinline__ float wave_max(float v) {
#pragma unroll
    for (int o = 32; o >= 1; o >>= 1) v = fmaxf(v, __shfl_xor(v, o));
    return v;
}
namespace pg8 {
#define PG8_LAS __attribute__((address_space(3)))
typedef unsigned short bf16_t;
typedef short bf16x8 __attribute__((ext_vector_type(8)));
typedef float f32x4 __attribute__((ext_vector_type(4)));
typedef unsigned u32x4 __attribute__((ext_vector_type(4)));
constexpr int BM = 256, BK = 64, HALF = 128, HTB = HALF * BK * 2  , STAGE_BYTES = 8 * HTB, NXCD = 8, WGM = 8;

__host__ __device__ __forceinline__ int lds_byte(int r, int c) { const int st = (r >> 4) * 2 + (c >> 5), rr = r & 15, cc = c & 31, ob = rr * 64 + cc * 2; return st * 1024 + (ob ^ (((ob >> 9) & 1) << 5)); }
__host__ __device__ __forceinline__ void stage_rc(int b, int& R, int& C) { const int st = b / 1024, sb = b % 1024, swz = sb ^ (((sb >> 9) & 1) << 5); R = (st >> 1) * 16 + swz / 64; C = (st & 1) * 32 + (swz % 64) / 2; }
__host__ __device__ __forceinline__ int perm32(int rho) { const int n = rho >> 4, i = rho & 15; return 8 * (i >> 2) + 4 * n + (i & 3); }

struct Unit { int pm, pn; };
struct Gemm { const bf16_t* A; const bf16_t* Bt; int M, N, K; };

struct StaticOrder {
    int nM, nN, nwg, G, c;
    __host__ __device__ void init(int M, int N, int G_, int c_) { nM = M / BM; nN = N / BM; nwg = nM * nN; G = G_; c = c_; }
    __host__ __device__ bool next(int i, Unit& u) const {
        const long L = (long)i * G + c; if (L >= nwg) return false;
        int wgid = (int)L; { const int q = nwg / NXCD, r = nwg % NXCD, xcd = wgid % NXCD, off = wgid / NXCD; wgid = (xcd < r ? xcd * (q + 1) : r * (q + 1) + (xcd - r) * q) + off; }
        const int nig = WGM * nN, gid = wgid / nig, fm = gid * WGM, gsz = (nM - fm) < WGM ? (nM - fm) : WGM;
        u.pm = fm + ((wgid % nig) % gsz); u.pn = (wgid % nig) / gsz; return true;
    }
    __device__ __forceinline__ void a_ready(const Unit&) const {}
    __device__ __forceinline__ void done(const Unit&) const {}
};
__device__ __forceinline__ unsigned cvt_pk_bf16(float lo, float hi) { unsigned r; asm volatile("v_cvt_pk_bf16_f32 %0, %1, %2" : "=v"(r) : "v"(lo), "v"(hi)); return r; }
typedef float f32x2 __attribute__((ext_vector_type(2)));
template <class Epi, class Sched, bool STAMP = false>
__device__ __forceinline__ void gemm_phase(PG8_LAS unsigned char* lds, const Gemm g, const Sched& S, const Epi& E, unsigned long long* stamps, const int tid_in) {
    const int tid = tid_in, wid = __builtin_amdgcn_readfirstlane(tid >> 6), lane = tid & 63, wr = wid >> 2, wc = wid & 3, fr = lane & 15, fq = lane >> 4;
    const int K = g.K, nt = K / BK;
    int ts_lo = 0, ts_hi = 0, nts = 0; const unsigned long long rt_entry = STAMP ? (unsigned long long)wall_clock64() : 0ull;
#define PG8_STAMP() do { if (STAMP && wid == 0 && nts < 64) { const unsigned long long _c = (unsigned long long)clock64(); \
        ts_lo = (lane == nts) ? (int)(unsigned)_c : ts_lo; ts_hi = (lane == nts) ? (int)(unsigned)(_c >> 32) : ts_hi; ++nts; } } while (0)
    PG8_STAMP();
    unsigned voffA[2], voffB[2];
#pragma unroll
    for (int i = 0; i < 2; ++i) { int R, C; stage_rc(tid * 16 + i * 8192, R, C); const int Rb = Epi::PERM ? ((R & ~31) + perm32(R & 31)) : R;
        voffA[i] = (unsigned)(R * K + C) * 2u; voffB[i] = (unsigned)(Rb * K + C) * 2u; }
    const size_t kstep = (size_t)(BK * 2);
    const size_t hstep = (size_t)HALF * K * 2;
    const size_t tstep = 2 * hstep;
    const unsigned ldsw = (unsigned)wid * 1024u;
    const int aoff = lds_byte(wr * 64 + fr, fq * 8), boff = lds_byte(wc * 32 + fr, fq * 8);
#define PG8_SA(b, h) (((b) * 2 + (h)) * HTB)
#define PG8_SB(b, h) ((4 + (b) * 2 + (h)) * HTB)
#define PG8_STAGE(bufoff, gbase, voff) do { _Pragma("unroll") for (int _i = 0; _i < 2; ++_i) \
        __builtin_amdgcn_global_load_lds((const unsigned*)((const char*)(gbase) + (voff)[_i]), (PG8_LAS unsigned*)(lds + (bufoff) + ldsw + _i * 8192), 16, 0, 0); } while (0)
#define PG8_LDA(dst, b, h) do { _Pragma("unroll") for (int m = 0; m < 4; ++m) _Pragma("unroll") for (int k = 0; k < 2; ++k) dst[m][k] = *(const PG8_LAS bf16x8*)(lds + PG8_SA(b, h) + aoff + m * 2048 + k * 1024); } while (0)
#define PG8_LDB(dst, b, h) do { _Pragma("unroll") for (int n = 0; n < 2; ++n) _Pragma("unroll") for (int k = 0; k < 2; ++k) dst[n][k] = *(const PG8_LAS bf16x8*)(lds + PG8_SB(b, h) + boff + n * 2048 + k * 1024); } while (0)
#define PG8_MMA(ai, bj, At, Bt) do { __builtin_amdgcn_s_setprio(1); _Pragma("unroll") for (int m = 0; m < 4; ++m) _Pragma("unroll") for (int n = 0; n < 2; ++n) _Pragma("unroll") for (int k = 0; k < 2; ++k) \
        acc[ai][bj][m][n] = __builtin_amdgcn_mfma_f32_16x16x32_bf16(Bt[n][k], At[m][k], acc[ai][bj][m][n], 0, 0, 0); __builtin_amdgcn_s_setprio(0); } while (0)
#define PG8_WAIT_V(n) asm volatile("s_waitcnt vmcnt(" #n ")" ::: "memory")
#define PG8_WAIT_L(n) asm volatile("s_waitcnt lgkmcnt(" #n ")" ::: "memory")
#define PG8_BAR __builtin_amdgcn_s_barrier()
#define PG8_SCHED __builtin_amdgcn_sched_barrier(0)
    Unit cur, nxt; int ui = 0;
    if (!S.next(0, cur)) return;
    f32x4 acc[2][2][4][2];
#pragma unroll
    for (int a = 0; a < 2; ++a)
#pragma unroll
        for (int b = 0; b < 2; ++b)
#pragma unroll
            for (int m = 0; m < 4; ++m)
#pragma unroll
                for (int n = 0; n < 2; ++n) acc[a][b][m][n] = (f32x4){0.f, 0.f, 0.f, 0.f};
    bf16x8 At[4][2], B0[2][2], B1[2][2];
    const char* cA = (const char*)g.A + (size_t)cur.pm * tstep; const char* cB = (const char*)g.Bt + (size_t)cur.pn * tstep;
    S.a_ready(cur);
    PG8_STAGE(PG8_SB(0, 0), cB, voffB); PG8_STAGE(PG8_SA(0, 0), cA, voffA); PG8_STAGE(PG8_SB(0, 1), cB + hstep, voffB); PG8_STAGE(PG8_SA(0, 1), cA + hstep, voffA);
    if (wr == 1) PG8_BAR;
    PG8_WAIT_V(4); PG8_BAR;
    PG8_STAGE(PG8_SB(1, 0), cB + kstep, voffB); PG8_STAGE(PG8_SA(1, 0), cA + kstep, voffA); PG8_STAGE(PG8_SB(1, 1), cB + hstep + kstep, voffB);
    PG8_WAIT_V(6); PG8_BAR;
    PG8_STAMP();
    for (;;) {
        const bool has_next = S.next(ui + 1, nxt);
        const char* nA = has_next ? (const char*)g.A + (size_t)nxt.pm * tstep : cA; const char* nB = has_next ? (const char*)g.Bt + (size_t)nxt.pn * tstep : cB;
        for (int t = 0; t < nt; t += 2) {
            const bool last = (t == nt - 2);
            const char* a1 = cA + (size_t)(t + 1) * kstep;
            const char* a2 = last ? nA : cA + (size_t)(t + 2) * kstep; const char* b2 = last ? nB : cB + (size_t)(t + 2) * kstep;
            const char* a3 = a2 + kstep; const char* b3 = b2 + kstep;
            if (last && has_next) S.a_ready(nxt);
            PG8_LDB(B0, 0, 0); PG8_SCHED; PG8_LDA(At, 0, 0); PG8_STAGE(PG8_SA(1, 1), a1 + hstep, voffA);
            PG8_WAIT_L(8); PG8_BAR; PG8_WAIT_L(0); PG8_MMA(0, 0, At, B0); PG8_BAR; PG8_SCHED;
            PG8_LDB(B1, 0, 1); PG8_STAGE(PG8_SB(0, 0), b2, voffB);
            PG8_BAR; PG8_WAIT_L(0); PG8_MMA(0, 1, At, B1); PG8_BAR;
            PG8_LDA(At, 0, 1); PG8_STAGE(PG8_SA(0, 0), a2, voffA);
            PG8_BAR; PG8_WAIT_L(0); PG8_MMA(1, 0, At, B0); PG8_BAR; PG8_SCHED;
            PG8_STAGE(PG8_SB(0, 1), b2 + hstep, voffB);
            PG8_WAIT_V(6); PG8_BAR; PG8_MMA(1, 1, At, B1); PG8_BAR;
            PG8_LDB(B0, 1, 0); PG8_SCHED; PG8_LDA(At, 1, 0); PG8_STAGE(PG8_SA(0, 1), a2 + hstep, voffA);
            PG8_WAIT_L(8); PG8_BAR; PG8_WAIT_L(0); PG8_MMA(0, 0, At, B0); PG8_BAR; PG8_SCHED;
            PG8_LDB(B1, 1, 1); PG8_STAGE(PG8_SB(1, 0), b3, voffB);
            PG8_BAR; PG8_WAIT_L(0); PG8_MMA(0, 1, At, B1); PG8_BAR;
            PG8_LDA(At, 1, 1); PG8_STAGE(PG8_SA(1, 0), a3, voffA);
            PG8_BAR; PG8_WAIT_L(0); PG8_MMA(1, 0, At, B0); PG8_BAR; PG8_SCHED;
            PG8_STAGE(PG8_SB(1, 1), b3 + hstep, voffB);
            PG8_WAIT_V(6); PG8_BAR; PG8_MMA(1, 1, At, B1); PG8_BAR;
        }
        PG8_STAMP();
        if constexpr (!Epi::AFTER_DRAIN) { E(acc, cur, wr, wc, fr, fq); S.done(cur); }
        PG8_STAMP();
        if (!has_next) break;
#pragma unroll
        for (int a = 0; a < 2; ++a)
#pragma unroll
            for (int b = 0; b < 2; ++b)
#pragma unroll
                for (int m = 0; m < 4; ++m)
#pragma unroll
                    for (int n = 0; n < 2; ++n) acc[a][b][m][n] = (f32x4){0.f, 0.f, 0.f, 0.f};
        cur = nxt; cA = nA; cB = nB; ++ui;
    }
    PG8_WAIT_V(0);
    if (wr == 0) PG8_BAR;
    PG8_BAR;
    if constexpr (Epi::AFTER_DRAIN) { E.fused(acc, cur, wr, wc, fr, fq, lds, wid, lane); S.done(cur); }
    PG8_STAMP();
    if (STAMP && wid == 0) { stamps[lane] = lane < nts ? (((unsigned long long)(unsigned)ts_hi << 32) | (unsigned)ts_lo) : 0ull;
        if (lane == 62) stamps[62] = rt_entry; if (lane == 63) stamps[63] = (unsigned long long)wall_clock64(); }
#undef PG8_STAMP
#undef PG8_SA
#undef PG8_SB
#undef PG8_STAGE
#undef PG8_LDA
#undef PG8_LDB
#undef PG8_MMA
#undef PG8_WAIT_V
#undef PG8_WAIT_L
#undef PG8_BAR
#undef PG8_SCHED
}
}
#define XB_TMO      128
#define XB_XCNT(j)  (256  + 64 * (j))
#define XB_XSUB(j)  (1280 + 64 * (j))
#define XB_XGEN(j)  (2304 + 64 * (j))
#define XB_TOP      3328
#define XB_TOPGEN   3392
#define XCD_BAR_WORDS 3456
#define XB_SPIN_CAP (1u << 22)
#define LAS __attribute__((address_space(3)))

__device__ __forceinline__ unsigned xb_ld(unsigned* p)              { return __hip_atomic_load(p, __ATOMIC_RELAXED, __HIP_MEMORY_SCOPE_AGENT); }
__device__ __forceinline__ unsigned xb_add(unsigned* p, unsigned v) { return __hip_atomic_fetch_add(p, v, __ATOMIC_RELAXED, __HIP_MEMORY_SCOPE_AGENT); }
__device__ __forceinline__ unsigned xb_xcc_id() { return (unsigned)__builtin_amdgcn_s_getreg((3 << 11) | 20) & 0xFu; }
#define XB_SPIN(cond, bar) do { unsigned _sp = 0; while (cond) { __builtin_amdgcn_s_sleep(1); \
    if ((++_sp & 255u) == 0u) { if (xb_ld(&(bar)[XB_TMO])) break; if (_sp > XB_SPIN_CAP) { atomicAdd(&(bar)[XB_TMO], 1u); break; } } } } while (0)

struct XcdBarrier {
    unsigned* bar; unsigned x;
    volatile LAS unsigned* st;
};

__device__ __forceinline__ XcdBarrier xcd_barrier_post(unsigned* bar, volatile LAS unsigned* st, const int tid) {
    XcdBarrier b; b.bar = bar; b.x = xb_xcc_id(); b.st = st;
    if (tid == 0) (void)xb_add(&bar[XB_XCNT(b.x)], 1u);
    return b;
}
__device__ __forceinline__ void xcd_barrier_complete(unsigned* bar, unsigned x, unsigned& nloc, unsigned& nx) {
    const unsigned G = gridDim.x * gridDim.y * gridDim.z;
    unsigned sum, cnt, mine, sp = 0u;
    for (;;) {
        sum = 0u; cnt = 0u; mine = 0u;
#pragma unroll
        for (unsigned j = 0; j < 16; ++j) { const unsigned c = xb_ld(&bar[XB_XCNT(j)]); sum += c; cnt += (c > 0u) ? 1u : 0u; mine = (j == x) ? c : mine; }
        if (sum == G) break;
        __builtin_amdgcn_s_sleep(1);
        if ((++sp & 255u) == 0u) { if (xb_ld(&bar[XB_TMO])) break; if (sp > XB_SPIN_CAP) { atomicAdd(&bar[XB_TMO], 1u); break; } }
    }
    nloc = mine > 0u ? mine : 1u; nx = cnt > 0u ? cnt : 1u;
}

__device__ __forceinline__ void xcd_barrier(const XcdBarrier& b, const int tid) {
    asm volatile("s_waitcnt vmcnt(0)" ::: "memory");
    __syncthreads();
    if (tid == 0) {
        unsigned* bar = b.bar;
        __builtin_amdgcn_s_waitcnt(0);
        unsigned nloc = b.st[0], nx = b.st[1];
        if (nloc == 0u) { xcd_barrier_complete(bar, b.x, nloc, nx); b.st[0] = nloc; b.st[1] = nx; }
        const unsigned old = xb_add(&bar[XB_XSUB(b.x)], 1u);
        const unsigned gen = old / nloc;
        if (old + 1u == (gen + 1u) * nloc) {
            __builtin_amdgcn_fence(__ATOMIC_RELEASE, "agent");
            asm volatile("s_waitcnt vmcnt(0)" ::: "memory");
            const unsigned og = xb_add(&bar[XB_TOP], 1u);
            const unsigned tg = og / nx;
            if (og + 1u == (tg + 1u) * nx) xb_add(&bar[XB_TOPGEN], 1u);
            else XB_SPIN(xb_ld(&bar[XB_TOPGEN]) == tg, bar);
            __builtin_amdgcn_fence(__ATOMIC_ACQUIRE, "agent");
            xb_add(&bar[XB_XGEN(b.x)], 1u);
            asm volatile("s_waitcnt vmcnt(0)" ::: "memory");
        } else {
            XB_SPIN(xb_ld(&bar[XB_XGEN(b.x)]) == gen, bar);
            __builtin_amdgcn_fence(__ATOMIC_ACQUIRE, "agent");
            asm volatile("s_waitcnt vmcnt(0)" ::: "memory");
        }
    }
    __syncthreads();
}
namespace att {
using bf16 = unsigned short;
constexpr int   D = 128, NW = 8, QBLK = 32, KVBLK = 64;
constexpr float SCALE = 0.088388347648318440f;
constexpr float THR = 8.f;
constexpr int SDEPTH = 1;
constexpr size_t SHM_V = KVBLK * D * 2, SHM_K = KVBLK * D * 2, SHM_ATTN = 2 * SHM_V + 2 * SHM_K + NW * 64 * 4;
using bf16x8 = __attribute__((ext_vector_type(8))) short;
using s16x4  = __attribute__((ext_vector_type(4))) short;
using f32x16 = __attribute__((ext_vector_type(16))) float;
using f32x8  = __attribute__((ext_vector_type(8))) float;
using u32x4  = __attribute__((ext_vector_type(4))) unsigned;
#define KSWZ(row, colB) ((row) * 256 + ((colB) ^ (((row) & 7) << 4)))
#define SBAR() __builtin_amdgcn_sched_barrier(0)
__device__ __forceinline__ int crow(int r, int hi) { return (r & 3) + 8 * (r >> 2) + 4 * hi; }
__device__ __forceinline__ unsigned cvtpk(float lo, float hi) {
  unsigned r; asm volatile("v_cvt_pk_bf16_f32 %0, %1, %2" : "=v"(r) : "v"(lo), "v"(hi)); return r;
}
template <typename TIn> struct Stage;
template <> struct Stage<bf16>  { using T = bf16x8;
  __device__ static __forceinline__ T ld8(const bf16* p) { return *reinterpret_cast<const bf16x8*>(p); }
  __device__ static __forceinline__ bf16x8 tobf(T x) { return x; } };
template <> struct Stage<float> { using T = f32x8;
  __device__ static __forceinline__ T ld8(const float* p) { return *reinterpret_cast<const f32x8*>(p); }
  __device__ static __forceinline__ bf16x8 tobf(T x) {
    u32x4 w = {cvtpk(x[0], x[1]), cvtpk(x[2], x[3]), cvtpk(x[4], x[5]), cvtpk(x[6], x[7])}; return *reinterpret_cast<bf16x8*>(&w); } };

__device__ __forceinline__ void partialSM(f32x16& p0, f32x16& p1, float& m_reg, float& mn, float& alpha) {
  constexpr float C = SCALE * 1.4426950408889634f;
  float pmax = p0[0]; for (int r = 1; r < 16; ++r) pmax = fmaxf(pmax, p0[r]); for (int r = 0; r < 16; ++r) pmax = fmaxf(pmax, p1[r]);
  { auto rr = __builtin_amdgcn_permlane32_swap(__float_as_uint(pmax), __float_as_uint(pmax), false, false);
    pmax = fmaxf(__uint_as_float(rr[0]), __uint_as_float(rr[1])); }
  if (__builtin_expect(__all(pmax - m_reg <= THR / SCALE), 1)) { mn = m_reg; alpha = 1.f; }
  else { mn = fmaxf(m_reg, pmax); alpha = __builtin_amdgcn_exp2f((m_reg - mn) * C); m_reg = mn; }
  float mnC = -mn * C;
  for (int r = 0; r < 16; ++r) p0[r] = fmaf(p0[r], C, mnC); for (int r = 0; r < 16; ++r) p1[r] = fmaf(p1[r], C, mnC);
  for (int r = 0; r < 16; ++r) p0[r] = __builtin_amdgcn_exp2f(p0[r]);
}
__device__ __forceinline__ void finishSM(f32x16& p0, f32x16& p1, float alpha, float& l_reg, bf16x8& pa0, bf16x8& pa1, bf16x8& pa2, bf16x8& pa3) {
  for (int r = 0; r < 16; ++r) p1[r] = __builtin_amdgcn_exp2f(p1[r]);
  float ps = 0; for (int r = 0; r < 16; ++r) ps += p0[r]; for (int r = 0; r < 16; ++r) ps += p1[r];
  { auto rr = __builtin_amdgcn_permlane32_swap(__float_as_uint(ps), __float_as_uint(ps), false, false);
    ps = __uint_as_float(rr[0]) + __uint_as_float(rr[1]); }
  l_reg = l_reg * alpha + ps;
#define PK4(P, BASE, OUT) do { unsigned a0 = cvtpk(P[BASE + 0], P[BASE + 1]), a1 = cvtpk(P[BASE + 2], P[BASE + 3]);   \
    unsigned b0 = cvtpk(P[BASE + 4], P[BASE + 5]), b1 = cvtpk(P[BASE + 6], P[BASE + 7]);                              \
    auto r0 = __builtin_amdgcn_permlane32_swap(a0, b0, false, false); auto r1 = __builtin_amdgcn_permlane32_swap(a1, b1, false, false); \
    u32x4 w = {r0[0], r1[0], r0[1], r1[1]}; OUT = *reinterpret_cast<bf16x8*>(&w); } while (0)
  PK4(p0, 0, pa0); PK4(p0, 8, pa1); PK4(p1, 0, pa2); PK4(p1, 8, pa3);
#undef PK4
}
__device__ __forceinline__ void qkt(f32x16& p0, f32x16& p1, const bf16* Ks, const bf16x8* qr, int r32, int hi) {
  p0 = f32x16{}; p1 = f32x16{};
  for (int d0 = 0; d0 < 8; ++d0) { int cb = (d0 * 16 + hi * 8) * 2;
    bf16x8 b0 = *reinterpret_cast<const bf16x8*>((const char*)Ks + KSWZ(r32, cb));
    bf16x8 b1 = *reinterpret_cast<const bf16x8*>((const char*)Ks + KSWZ(32 + r32, cb));
    p0 = __builtin_amdgcn_mfma_f32_32x32x16_bf16(b0, qr[d0], p0, 0, 0, 0);
    p1 = __builtin_amdgcn_mfma_f32_32x32x16_bf16(b1, qr[d0], p1, 0, 0, 0); }
}
__device__ __forceinline__ int v_st(int k, int c) { const int kk = (k & ~0xC) | ((k & 4) << 1) | ((k & 8) >> 1); return ((kk >> 3) * 4 + (c >> 5)) * 512 + ((kk & 7) * 32 + (c & 31)) * 2; }
__device__ __forceinline__ int v_rd_base(int lane) { return ((lane & 3) << 3) | (((lane >> 2) & 3) << 6) | (((lane >> 4) & 1) << 5) | (((lane >> 5) & 1) << 8); }
constexpr int v_rd_off(int d0, int ks, int half) { return d0 * 512 + ks * 4096 + half * 2048; }
template <int OFF> __device__ __forceinline__ s16x4 tr_read(int vb) {
  s16x4 r; asm volatile("ds_read_b64_tr_b16 %0, %1 offset:%2" : "=&v"(r) : "v"(vb), "i"(OFF) : "memory"); return r;
}
template <int D0> __device__ __forceinline__ void pv_one(f32x16& od, int vb, bf16x8 pa0, bf16x8 pa1, bf16x8 pa2, bf16x8 pa3) {
  const s16x4 l0 = tr_read<v_rd_off(D0, 0, 0)>(vb), h0 = tr_read<v_rd_off(D0, 0, 1)>(vb), l1 = tr_read<v_rd_off(D0, 1, 0)>(vb), h1 = tr_read<v_rd_off(D0, 1, 1)>(vb);
  const s16x4 l2 = tr_read<v_rd_off(D0, 2, 0)>(vb), h2 = tr_read<v_rd_off(D0, 2, 1)>(vb), l3 = tr_read<v_rd_off(D0, 3, 0)>(vb), h3 = tr_read<v_rd_off(D0, 3, 1)>(vb);
  asm volatile("s_waitcnt lgkmcnt(0)" ::: "memory"); SBAR();
#define PK(L, H) (bf16x8){L[0], L[1], L[2], L[3], H[0], H[1], H[2], H[3]}
  od = __builtin_amdgcn_mfma_f32_32x32x16_bf16(pa0, PK(l0, h0), od, 0, 0, 0);
  od = __builtin_amdgcn_mfma_f32_32x32x16_bf16(pa1, PK(l1, h1), od, 0, 0, 0);
  od = __builtin_amdgcn_mfma_f32_32x32x16_bf16(pa2, PK(l2, h2), od, 0, 0, 0);
  od = __builtin_amdgcn_mfma_f32_32x32x16_bf16(pa3, PK(l3, h3), od, 0, 0, 0);
#undef PK
}
__device__ __forceinline__ void pv_d0(f32x16* o, int vb, bf16x8 pa0, bf16x8 pa1, bf16x8 pa2, bf16x8 pa3) {
  pv_one<0>(o[0], vb, pa0, pa1, pa2, pa3); pv_one<1>(o[1], vb, pa0, pa1, pa2, pa3); pv_one<2>(o[2], vb, pa0, pa1, pa2, pa3); pv_one<3>(o[3], vb, pa0, pa1, pa2, pa3);
}

template <typename TQ, int LDQ, int LDK, int LDO, typename TO>
__device__ __forceinline__ void attn_dense_body(const TQ* __restrict__ Qb, const bf16* __restrict__ Kh, const bf16* __restrict__ Vh,
                                                TO* __restrict__ Ob, int seq, char* lds, const int tid_in) {
  using St = Stage<bf16>; using SQ = Stage<TQ>;
  const int tid = tid_in, wid = tid >> 6, lane = tid & 63, r32 = lane & 31, hi = lane >> 5;
  bf16* V_lds = (bf16*)lds; bf16* K_lds = (bf16*)(lds + 2 * SHM_V);
  float* ws = (float*)(lds + 2 * SHM_V + 2 * SHM_K) + wid * 64; float* li_l = ws; float* al_l = ws + 32;
  float m_reg = -1e30f, l_reg = 0; f32x16 o[4] = {}; bf16x8 qr[8];
  const TQ* Qw = Qb + (long)(wid * QBLK + r32) * LDQ + hi * 8;
#pragma unroll
  for (int d0 = 0; d0 < 8; ++d0) qr[d0] = SQ::tobf(SQ::ld8(Qw + d0 * 16));
  const int sr = tid >> 4, sc = (tid & 15) * 8, vst0 = v_st(sr, sc), vst1 = v_st(32 + sr, sc);
  const int vb0 = (int)(uintptr_t)V_lds + v_rd_base(lane);
  struct { typename St::T vs0, vs1, ks0, ks1; } sr_[SDEPTH];
#define SLOAD(i, k0) do { sr_[i].vs0 = St::ld8(&Vh[(long)((k0) + sr) * LDK + sc]); sr_[i].vs1 = St::ld8(&Vh[(long)((k0) + 32 + sr) * LDK + sc]); \
    sr_[i].ks0 = St::ld8(&Kh[(long)((k0) + sr) * LDK + sc]); sr_[i].ks1 = St::ld8(&Kh[(long)((k0) + 32 + sr) * LDK + sc]); } while (0)
#define SWRITE(b, i) do { *(bf16x8*)((char*)V_lds + (b) * SHM_V + vst0) = St::tobf(sr_[i].vs0);          \
    *(bf16x8*)((char*)V_lds + (b) * SHM_V + vst1) = St::tobf(sr_[i].vs1); int kc = sc * 2;               \
    *(bf16x8*)((char*)K_lds + (b) * SHM_K + KSWZ(sr, kc)) = St::tobf(sr_[i].ks0);                       \
    *(bf16x8*)((char*)K_lds + (b) * SHM_K + KSWZ(32 + sr, kc)) = St::tobf(sr_[i].ks1); } while (0)
#define SWAIT() do { if constexpr (SDEPTH == 2) asm volatile("s_waitcnt vmcnt(4)" ::: "memory"); else asm volatile("s_waitcnt vmcnt(0)" ::: "memory"); } while (0)
#define RESC(a) do { if (__any((a) < 1.f)) { if (hi == 0) al_l[r32] = (a); asm volatile("s_waitcnt lgkmcnt(0)" ::: "memory"); \
    for (int d = 0; d < 4; ++d) for (int r = 0; r < 16; ++r) o[d][r] *= al_l[crow(r, hi)]; } } while (0)
  f32x16 pA0, pA1, pB0, pB1; float mnA, mnB, alA, alB; bf16x8 pa0, pa1, pa2, pa3; const int NT = seq / KVBLK;
  constexpr int SE = 0, SO = SDEPTH - 1;
  SLOAD(SE, 0); asm volatile("s_waitcnt vmcnt(0)" ::: "memory"); SWRITE(0, SE); __syncthreads();
  qkt(pA0, pA1, K_lds, qr, r32, hi); partialSM(pA0, pA1, m_reg, mnA, alA);
  SLOAD(SO, KVBLK); if constexpr (SDEPTH == 2) { if (2 < NT) SLOAD(SE, 2 * KVBLK); }
  SWAIT(); SWRITE(1, SO); __syncthreads();
  for (int j = 1; j + 1 < NT; j += 2) {
    SBAR(); qkt(pB0, pB1, (bf16*)((char*)K_lds + SHM_K), qr, r32, hi);
    finishSM(pA0, pA1, alA, l_reg, pa0, pa1, pa2, pa3); SBAR();
    SLOAD(SO, (j + SDEPTH) * KVBLK); SBAR();
    pv_d0(o, vb0, pa0, pa1, pa2, pa3); partialSM(pB0, pB1, m_reg, mnB, alB);
    __syncthreads(); SWAIT(); SWRITE(0, SE);
    RESC(alB); __syncthreads();
    SBAR(); qkt(pA0, pA1, K_lds, qr, r32, hi);
    finishSM(pB0, pB1, alB, l_reg, pa0, pa1, pa2, pa3); SBAR();
    if (SDEPTH == 1 || j + 3 < NT) SLOAD(SE, (j + 1 + SDEPTH) * KVBLK); SBAR();
    pv_d0(o, vb0 + (int)SHM_V, pa0, pa1, pa2, pa3); partialSM(pA0, pA1, m_reg, mnA, alA);
    __syncthreads(); SWAIT(); SWRITE(1, SO);
    RESC(alA); __syncthreads();
  }
  SBAR(); qkt(pB0, pB1, (bf16*)((char*)K_lds + SHM_K), qr, r32, hi);
  finishSM(pA0, pA1, alA, l_reg, pa0, pa1, pa2, pa3); SBAR();
  pv_d0(o, vb0, pa0, pa1, pa2, pa3); partialSM(pB0, pB1, m_reg, mnB, alB);
  __syncthreads(); RESC(alB);
  finishSM(pB0, pB1, alB, l_reg, pa0, pa1, pa2, pa3); SBAR();
  pv_d0(o, vb0 + (int)SHM_V, pa0, pa1, pa2, pa3);
  if (hi == 0) li_l[r32] = l_reg; asm volatile("s_waitcnt lgkmcnt(0)" ::: "memory");
  float rli[16];
#pragma unroll
  for (int r = 0; r < 16; ++r) rli[r] = __builtin_amdgcn_rcpf(li_l[crow(r, hi)]);
  TO* Ow = Ob + (long)(wid * QBLK) * LDO;
#pragma unroll
  for (int r = 0; r < 16; ++r) { int orow = crow(r, hi);
    for (int d0 = 0; d0 < 4; ++d0) { const float val = o[d0][r] * rli[r];
      if constexpr (sizeof(TO) == 4) Ow[(long)orow * LDO + d0 * 32 + r32] = val;
      else Ow[(long)orow * LDO + d0 * 32 + r32] = (TO)(cvtpk(val, val) & 0xffffu); } }
#undef SLOAD
#undef SWRITE
#undef SWAIT
#undef RESC
}

template <int WIN>
__device__ __forceinline__ void attn_banded_body(const bf16* __restrict__ Qp, const bf16* __restrict__ Kp, const bf16* __restrict__ Vp, const long rs, const int Lseq, const int P0,
                                                 const float m_init, const float l_init, bf16* __restrict__ Ob, const long os, float* __restrict__ Lp, const long ls, char* lds, const int tid) {
  const int wid = __builtin_amdgcn_readfirstlane(tid >> 6), lane = tid & 63, r32 = lane & 31, hi = lane >> 5;
  bf16* V_lds = (bf16*)lds; bf16* K_lds = (bf16*)(lds + 2 * SHM_V);
  float* wsf = (float*)(lds + 2 * SHM_V + 2 * SHM_K) + wid * 64; float* li_l = wsf; float* al_l = wsf + 32;
  float m_reg = m_init, l_reg = l_init; f32x16 o[4] = {}; bf16x8 qr[8];
  const bf16* Qw = Qp + (long)(P0 + wid * QBLK + r32) * rs + hi * 8;
#pragma unroll
  for (int d0 = 0; d0 < 8; ++d0) qr[d0] = *reinterpret_cast<const bf16x8*>(Qw + d0 * 16);
  const int sr = tid >> 4, sc = (tid & 15) * 8, vst0 = v_st(sr, sc), vst1 = v_st(32 + sr, sc);
  const int vb0 = (int)(uintptr_t)V_lds + v_rd_base(lane);
  constexpr int NT = (256 + 2 * WIN) / 64, NTW = (2 * WIN + 32 + 63) / 64;
  const int klo = wid >> 1, qpos = P0 + wid * QBLK + r32;
  for (int k = 0; k < NT; ++k) {
    const int tb = P0 - WIN + 64 * k;
    if (tb < 0 || tb >= Lseq) continue;
    __syncthreads();
    { const bf16x8 v0 = *reinterpret_cast<const bf16x8*>(Vp + (long)(tb + sr) * rs + sc), v1 = *reinterpret_cast<const bf16x8*>(Vp + (long)(tb + 32 + sr) * rs + sc);
      const bf16x8 k0 = *reinterpret_cast<const bf16x8*>(Kp + (long)(tb + sr) * rs + sc), k1 = *reinterpret_cast<const bf16x8*>(Kp + (long)(tb + 32 + sr) * rs + sc);
      *(bf16x8*)((char*)V_lds + vst0) = v0; *(bf16x8*)((char*)V_lds + vst1) = v1;
      *(bf16x8*)((char*)K_lds + KSWZ(sr, sc * 2)) = k0; *(bf16x8*)((char*)K_lds + KSWZ(32 + sr, sc * 2)) = k1; }
    __syncthreads();
    if (k >= klo && k < klo + NTW) {
      f32x16 p0, p1; float mn, al; bf16x8 pa0, pa1, pa2, pa3;
      qkt(p0, p1, K_lds, qr, r32, hi);
      if (k == klo || k == klo + NTW - 1) {
#pragma unroll
        for (int r = 0; r < 16; ++r) { const int d = qpos - (tb + crow(r, hi));
          if (d > WIN || d < -WIN) p0[r] = -1e30f;
          if (d - 32 > WIN || d - 32 < -WIN) p1[r] = -1e30f; }
      }
      partialSM(p0, p1, m_reg, mn, al);
      if (__any(al < 1.f)) { if (hi == 0) al_l[r32] = al; asm volatile("s_waitcnt lgkmcnt(0)" ::: "memory");
#pragma unroll
        for (int d = 0; d < 4; ++d)
#pragma unroll
          for (int r = 0; r < 16; ++r) o[d][r] *= al_l[crow(r, hi)]; }
      finishSM(p0, p1, al, l_reg, pa0, pa1, pa2, pa3); SBAR();
      pv_d0(o, vb0, pa0, pa1, pa2, pa3);
    }
  }
  if (hi == 0) li_l[r32] = l_reg; asm volatile("s_waitcnt lgkmcnt(0)" ::: "memory");
  float rli[16];
#pragma unroll
  for (int r = 0; r < 16; ++r) rli[r] = __builtin_amdgcn_rcpf(li_l[crow(r, hi)]);
  bf16* Ow = Ob + (long)(P0 + wid * QBLK) * os;
#pragma unroll
  for (int r = 0; r < 16; ++r) { const int orow = crow(r, hi);
#pragma unroll
    for (int d0 = 0; d0 < 4; ++d0) { const float val = o[d0][r] * rli[r]; Ow[(long)orow * os + d0 * 32 + r32] = (bf16)(cvtpk(val, val) & 0xffffu); } }
  if (Lp != nullptr && hi == 0) Lp[(long)(P0 + wid * QBLK + r32) * ls] = m_reg * SCALE + __logf(l_reg);
}
}
typedef unsigned short bf16_t;
typedef unsigned u32x4v __attribute__((ext_vector_type(4)));
#define LDSA __attribute__((address_space(3)))
constexpr size_t al256(size_t x) { return (x + 255) / 256 * 256; }
constexpr size_t WS_CTL  = 0;
constexpr size_t CTL_BYTES = 65536;
constexpr size_t WS_XB   = WS_CTL + CTL_BYTES;
constexpr size_t WS_WAB  = WS_XB + (size_t)SEQ * DM * 2;
constexpr size_t WS_WOAB = WS_WAB + (size_t)12288 * 4096 * 2;
constexpr size_t WS_WCD  = WS_WOAB + (size_t)4096 * 3072 * 2;
constexpr size_t WS_WOCD = WS_WCD + (size_t)9216 * 4096 * 2;
constexpr size_t WS_WQ   = WS_WOCD + (size_t)4096 * 4096 * 2;
constexpr size_t WS_UB   = WS_WQ + (size_t)2 * 2048 * 4096 * 2;
constexpr size_t WS_VB   = WS_UB + (size_t)2 * 16384 * 4096 * 2;
constexpr size_t WS_H    = WS_VB + (size_t)2 * 16384 * 4096 * 2;
constexpr size_t WS_Y    = WS_H;
constexpr size_t WS_PQ   = WS_H + (size_t)SEQ * 4096 * 4;
constexpr size_t WS_OC   = WS_H + (size_t)SEQ * 12288 * 4;
constexpr size_t WS_AB   = WS_OC + (size_t)2 * SEQ * 2048 * 4;
constexpr size_t WS_X1   = WS_AB + (size_t)SEQ * 4096 * 2;
constexpr size_t WS_X1B  = WS_X1 + (size_t)SEQ * 4096 * 4;
constexpr size_t WS_X2   = WS_X1B + (size_t)SEQ * 4096 * 2;
constexpr size_t WS_X2B  = WS_X2 + (size_t)SEQ * 4096 * 4;
constexpr size_t WS_EIDX = WS_X2B + (size_t)SEQ * 4096 * 2;
constexpr size_t WS_GATE = WS_EIDX + (size_t)SEQ * 128 * 4;
constexpr size_t WS_HB   = WS_GATE + (size_t)SEQ * 128 * 4;
constexpr size_t WS_END  = WS_HB + (size_t)SEQ * 12288 * 2;
static_assert(WS_END <= (size_t)2147483648ull, "workspace");

constexpr int LDS_BYTES = 147456;
constexpr int LDS_MISC = 131072;

struct MK { const float* in[21]; float* out; unsigned char* ws; int ph_lo, ph_hi; };

namespace pg8 {
struct EpiF32R {
    static constexpr bool PERM = false, AFTER_DRAIN = false;
    float* C; int ldc; const float* R; float ralpha;
    __device__ __forceinline__ void operator()(const f32x4 (&acc)[2][2][4][2], const Unit& u, int wr, int wc, int fr, int fq) const {
        const int row0 = u.pm * BM + wr * 64 + fr, col0 = u.pn * BM + wc * 32 + 4 * fq;
#pragma unroll
        for (int ai = 0; ai < 2; ++ai)
#pragma unroll
            for (int m = 0; m < 4; ++m) { const size_t off = (size_t)(row0 + ai * HALF + m * 16) * ldc + col0;
#pragma unroll
                for (int bj = 0; bj < 2; ++bj)
#pragma unroll
                    for (int n = 0; n < 2; ++n) { f32x4 v = acc[ai][bj][m][n];
                        if (R) { const f32x4 r = *(const f32x4*)(R + off + bj * HALF + n * 16); v += r * ralpha; }
                        *(f32x4*)(C + off + bj * HALF + n * 16) = v; } }
    }
};
}

__device__ __forceinline__ float bf_lo(unsigned w) { return __uint_as_float(w << 16); }
__device__ __forceinline__ float bf_hi(unsigned w) { return __uint_as_float(w & 0xffff0000u); }
__device__ __forceinline__ unsigned cvtpk_bf16(float lo, float hi) { unsigned r; asm volatile("v_cvt_pk_bf16_f32 %0, %1, %2" : "=v"(r) : "v"(lo), "v"(hi)); return r; }

__device__ __forceinline__ void cvt_rows_bf16(const float* __restrict__ src, bf16_t* __restrict__ dst, size_t n8, int bid, int nb, int tid, int nthr) {
    for (size_t i = (size_t)bid * nthr + tid; i < n8; i += (size_t)nb * nthr) {
        const float4 a = *(const float4*)(src + i * 8), b = *(const float4*)(src + i * 8 + 4);
        u32x4v w; w.x = cvtpk_bf16(a.x, a.y); w.y = cvtpk_bf16(a.z, a.w); w.z = cvtpk_bf16(b.x, b.y); w.w = cvtpk_bf16(b.z, b.w);
        *(u32x4v*)(dst + i * 8) = w;
    }
}
template <class PM>
__device__ __forceinline__ void transpose_cvt(const float* __restrict__ W, bf16_t* __restrict__ Wt, int K, int N, LDSA float* tile, int bid, int nb, PM pm, const int tid) {
    const int ntk = K / 64, ntn = N / 64;
    for (int t = bid; t < ntk * ntn; t += nb) {
        const int k0 = (t % ntk) * 64, n0 = (t / ntk) * 64;
        __syncthreads();
#pragma unroll
        for (int i = 0; i < 2; ++i) { const int r = (tid >> 4) + 32 * i, c = (tid & 15) * 4;
            const float4 v = *(const float4*)(W + (size_t)(k0 + r) * N + n0 + c);
            tile[r * 65 + c] = v.x; tile[r * 65 + c + 1] = v.y; tile[r * 65 + c + 2] = v.z; tile[r * 65 + c + 3] = v.w; }
        __syncthreads();
        const int mode = pm(n0);
        const int n = tid >> 3, kc = (tid & 7) * 8;
        int src = n;
        if (mode == 1) { if (n < 32) src = (n >> 1) + 16 * (n & 1); }
        else if (mode == 2) src = (n >> 1) + 32 * (n & 1);
        float f[8];
#pragma unroll
        for (int j = 0; j < 8; ++j) f[j] = tile[(kc + j) * 65 + src];
        u32x4v w; w.x = cvtpk_bf16(f[0], f[1]); w.y = cvtpk_bf16(f[2], f[3]); w.z = cvtpk_bf16(f[4], f[5]); w.w = cvtpk_bf16(f[6], f[7]);
        *(u32x4v*)(Wt + (size_t)(n0 + n) * K + k0 + kc) = w;
    }
}
struct PermNone { __device__ __forceinline__ int operator()(int) const { return 0; } };


typedef __bf16 bf2_t __attribute__((ext_vector_type(2)));
__device__ __forceinline__ float gelu_tanh_f(float x) {
    const float z = 0.7978845608028654f * (x + 0.044715f * x * x * x);
    const float e = __expf(2.0f * z);
    return 0.5f * x * (2.0f - 2.0f / (e + 1.0f));
}
__device__ __forceinline__ int pick_i(int a0, int a1, int k) { return k < 64 ? __builtin_amdgcn_readlane(a0, k) : __builtin_amdgcn_readlane(a1, k - 64); }
__device__ __forceinline__ float pick_f(float a0, float a1, int k) { return __int_as_float(pick_i(__float_as_int(a0), __float_as_int(a1), k)); }
#define PE_LOADROW(dst, base, e) do { const bf16_t* _p = (base) + (size_t)(e) * DM + lane * 8; _Pragma("unroll") for (int _i = 0; _i < 8; ++_i) dst[_i] = *(const u32x4v*)(_p + _i * 512); } while (0)
__device__ __forceinline__ float dot2_bf16(unsigned a, unsigned b, float c) { return __builtin_amdgcn_fdot2_f32_bf16(__builtin_bit_cast(bf2_t, a), __builtin_bit_cast(bf2_t, b), c, false); }
__device__ __forceinline__ float pe_dot(const u32x4v (&r)[8], const u32x4v (&x)[8]) {
    float d0 = 0.f, d1 = 0.f, d2 = 0.f, d3 = 0.f;
#pragma unroll
    for (int i = 0; i < 8; ++i) {
        d0 = dot2_bf16(r[i].x, x[i].x, d0);
        d1 = dot2_bf16(r[i].y, x[i].y, d1);
        d2 = dot2_bf16(r[i].z, x[i].z, d2);
        d3 = dot2_bf16(r[i].w, x[i].w, d3);
    }
    return wave_sum((d0 + d1) + (d2 + d3));
}
__device__ __forceinline__ void pe_axpy(float (&acc)[64], const u32x4v (&r)[8], const float w) {
#pragma unroll
    for (int i = 0; i < 8; ++i) {
        const unsigned q[4] = {r[i].x, r[i].y, r[i].z, r[i].w};
#pragma unroll
        for (int j = 0; j < 4; ++j) {
            acc[i * 8 + 2 * j]     = fmaf(w, __uint_as_float(q[j] << 16), acc[i * 8 + 2 * j]);
            acc[i * 8 + 2 * j + 1] = fmaf(w, __uint_as_float(q[j] & 0xffff0000u), acc[i * 8 + 2 * j + 1]);
        }
    }
}
__device__ __forceinline__ void peer_expert_phase(const float* __restrict__ x1, const bf16_t* __restrict__ x1b, const int* __restrict__ eidx, const float* __restrict__ gate,
                                                  const bf16_t* __restrict__ ub, const bf16_t* __restrict__ vb, const float* __restrict__ lg, const float* __restrict__ lb,
                                                  float* __restrict__ out, bf16_t* __restrict__ outb, const int bid, const int G, const int tid) {
    const int lane = tid & 63, wv = __builtin_amdgcn_readfirstlane(tid >> 6);
    for (int t = bid * 8 + wv; t < SEQ; t += G * 8) {
        const int e0 = eidx[(size_t)t * 128 + lane], e1 = eidx[(size_t)t * 128 + 64 + lane];
        const float g0 = gate[(size_t)t * 128 + lane], g1 = gate[(size_t)t * 128 + 64 + lane];
        u32x4v xq[8];
#pragma unroll
        for (int i = 0; i < 8; ++i) xq[i] = *(const u32x4v*)(x1b + (size_t)t * DM + i * 512 + lane * 8);
        float w0 = 0.f, w1 = 0.f;
        u32x4v A[8], B[8];
        PE_LOADROW(A, ub, pick_i(e0, e1, 0));
        for (int k = 0; k < 128; k += 2) {
            PE_LOADROW(B, ub, pick_i(e0, e1, k + 1));
            { const float d = pe_dot(A, xq); const float w = pick_f(g0, g1, k) * gelu_tanh_f(d);
              if (lane == (k & 63)) { if (k < 64) w0 = w; else w1 = w; } }
            { const int kn = (k + 2 < 128) ? k + 2 : 127; PE_LOADROW(A, ub, pick_i(e0, e1, kn)); }
            { const float d = pe_dot(B, xq); const float w = pick_f(g0, g1, k + 1) * gelu_tanh_f(d);
              if (lane == ((k + 1) & 63)) { if (k + 1 < 64) w0 = w; else w1 = w; } }
        }
        float acc[64];
#pragma unroll
        for (int i = 0; i < 64; ++i) acc[i] = 0.f;
        PE_LOADROW(A, vb, pick_i(e0, e1, 0));
        for (int k = 0; k < 128; k += 2) {
            PE_LOADROW(B, vb, pick_i(e0, e1, k + 1));
            pe_axpy(acc, A, pick_f(w0, w1, k));
            { const int kn = (k + 2 < 128) ? k + 2 : 127; PE_LOADROW(A, vb, pick_i(e0, e1, kn)); }
            pe_axpy(acc, B, pick_f(w0, w1, k + 1));
        }
        float s = 0.f;
#pragma unroll
        for (int i = 0; i < 8; ++i) {
            const float4 xa = *(const float4*)(x1 + (size_t)t * DM + i * 512 + lane * 8), xc = *(const float4*)(x1 + (size_t)t * DM + i * 512 + lane * 8 + 4);
            acc[i * 8 + 0] = fmaf(ALPHA, xa.x, acc[i * 8 + 0]); acc[i * 8 + 1] = fmaf(ALPHA, xa.y, acc[i * 8 + 1]); acc[i * 8 + 2] = fmaf(ALPHA, xa.z, acc[i * 8 + 2]); acc[i * 8 + 3] = fmaf(ALPHA, xa.w, acc[i * 8 + 3]);
            acc[i * 8 + 4] = fmaf(ALPHA, xc.x, acc[i * 8 + 4]); acc[i * 8 + 5] = fmaf(ALPHA, xc.y, acc[i * 8 + 5]); acc[i * 8 + 6] = fmaf(ALPHA, xc.z, acc[i * 8 + 6]); acc[i * 8 + 7] = fmaf(ALPHA, xc.w, acc[i * 8 + 7]);
#pragma unroll
            for (int j = 0; j < 8; ++j) s += acc[i * 8 + j];
            if (i & 1) asm volatile("" ::: "memory");
        }
        const float mean = wave_sum(s) * (1.0f / DM);
        float qq = 0.f;
#pragma unroll
        for (int i = 0; i < 64; ++i) { const float d = acc[i] - mean; qq = fmaf(d, d, qq); }
        const float rstd = 1.0f / sqrtf(wave_sum(qq) * (1.0f / DM) + 1e-5f);
#pragma unroll
        for (int i = 0; i < 8; ++i) {
            const int c = i * 512 + lane * 8;
            const float4 ga = *(const float4*)(lg + c), gc = *(const float4*)(lg + c + 4), ba = *(const float4*)(lb + c), bc = *(const float4*)(lb + c + 4);
            float4 oa, ob;
            oa.x = (acc[i * 8 + 0] - mean) * rstd * ga.x + ba.x; oa.y = (acc[i * 8 + 1] - mean) * rstd * ga.y + ba.y; oa.z = (acc[i * 8 + 2] - mean) * rstd * ga.z + ba.z; oa.w = (acc[i * 8 + 3] - mean) * rstd * ga.w + ba.w;
            ob.x = (acc[i * 8 + 4] - mean) * rstd * gc.x + bc.x; ob.y = (acc[i * 8 + 5] - mean) * rstd * gc.y + bc.y; ob.z = (acc[i * 8 + 6] - mean) * rstd * gc.z + bc.z; ob.w = (acc[i * 8 + 7] - mean) * rstd * gc.w + bc.w;
            *(float4*)(out + (size_t)t * DM + c) = oa; *(float4*)(out + (size_t)t * DM + c + 4) = ob;
            if (outb) { u32x4v w; w.x = cvtpk_bf16(oa.x, oa.y); w.y = cvtpk_bf16(oa.z, oa.w); w.z = cvtpk_bf16(ob.x, ob.y); w.w = cvtpk_bf16(ob.z, ob.w); *(u32x4v*)(outb + (size_t)t * DM + c) = w; }
            asm volatile("" ::: "memory");
        }
    }
}


__device__ __forceinline__ void attn1_phase(const bf16_t* __restrict__ hb, bf16_t* __restrict__ abb, float* __restrict__ oc, char* lds, const int bid, const int G, const int tid) {
    for (int u = bid; u < 512; u += G) {
        __syncthreads();
        const int kv = u >> 7, g = (u >> 5) & 3, qb = u & 31, hq = kv * 4 + g;
        att::attn_dense_body<att::bf16, 9216, 9216, 4096, att::bf16>(hb + (size_t)(qb * 256) * 9216 + 6144 + hq * 128, hb + 8192 + kv * 128, hb + 8704 + kv * 128,
                                                                       abb + (size_t)(qb * 256) * 4096 + 2048 + hq * 128, SEQ, lds, tid);
    }
    for (int v = bid; v < 1024; v += G) {
        __syncthreads();
        const int hm = v >> 6, vh = (v >> 5) & 1, qb = v & 31, h = hm >> 1, map = hm & 1;
        att::attn_dense_body<att::bf16, 9216, 9216, 2048, float>(hb + (size_t)(qb * 256) * 9216 + h * 256 + map * 128, hb + 2048 + h * 256 + map * 128, hb + 4096 + h * 256 + vh * 128,
                                                                   oc + (size_t)map * SEQ * 2048 + (size_t)(qb * 256) * 2048 + h * 256 + vh * 128, SEQ, lds, tid);
    }
}


__device__ __forceinline__ void attn0_phase(const bf16_t* __restrict__ hb, const float* __restrict__ sink, bf16_t* __restrict__ abb, bf16_t* __restrict__ obg, float* __restrict__ lse, char* lds, const int bid, const int G, const int tid) {
    const long LD = 12288;
    for (int u = bid; u < 512; u += G) {
        __syncthreads();
        const int hq = u >> 5, qb = u & 31, kv = hq >> 2;
        att::attn_banded_body<128>(hb + hq * 128, hb + 2048 + kv * 128, hb + 2560 + kv * 128, LD, SEQ, qb * 256, sink[hq] * (1.0f / att::SCALE), 1.0f, abb + hq * 128, 3072, nullptr, 0, lds, tid);
    }
    for (int v = bid; v < 768; v += G) {
        __syncthreads();
        const int g = v >> 8, w = v & 255, h = w >> 5, rem = w & 31;
        const int dsh = 2 * g;
        const int nqb_sh = 5 - dsh;
        const int r = rem >> nqb_sh, qb = rem & ((1 << nqb_sh) - 1);
        const int head = 8 * g + h;
        const long rs = LD << dsh;
        att::attn_banded_body<64>(hb + (long)r * LD + 3072 + head * 128, hb + (long)r * LD + 6144 + head * 128, hb + (long)r * LD + 9216 + head * 128, rs, SEQ >> dsh, qb * 256, -1e30f, 0.f,
                                  obg + ((long)(g * 8 + h) * SEQ + r) * 128, (long)128 << dsh, lse + (long)(g * 8 + h) * SEQ + r, (long)1 << dsh, lds, tid);
    }
}
__device__ __forceinline__ void merge0_phase(const bf16_t* __restrict__ obg, const float* __restrict__ lse, bf16_t* __restrict__ abb, const int bid, const int G, const int tid) {
    const int lane = tid & 63, wv = tid >> 6;
    for (int j = bid * 8 + wv; j < SEQ * 8; j += G * 8) {
        const int h = j >> 13, t = j & (SEQ - 1);
        const float l0 = lse[(size_t)(0 * 8 + h) * SEQ + t], l1 = lse[(size_t)(1 * 8 + h) * SEQ + t], l2 = lse[(size_t)(2 * 8 + h) * SEQ + t];
        const float mx = fmaxf(l0, fmaxf(l1, l2));
        const float e0 = __expf(l0 - mx), e1 = __expf(l1 - mx), e2 = __expf(l2 - mx), inv = 1.0f / (e0 + e1 + e2);
        const unsigned a0 = *(const unsigned*)(obg + ((size_t)(0 * 8 + h) * SEQ + t) * 128 + 2 * lane), a1 = *(const unsigned*)(obg + ((size_t)(1 * 8 + h) * SEQ + t) * 128 + 2 * lane), a2 = *(const unsigned*)(obg + ((size_t)(2 * 8 + h) * SEQ + t) * 128 + 2 * lane);
        const float x = (e0 * bf_lo(a0) + e1 * bf_lo(a1) + e2 * bf_lo(a2)) * inv, y = (e0 * bf_hi(a0) + e1 * bf_hi(a1) + e2 * bf_hi(a2)) * inv;
        *(unsigned*)(abb + (size_t)t * 3072 + 2048 + h * 128 + 2 * lane) = cvtpk_bf16(x, y);
    }
}

__device__ __forceinline__ void post_even_phase(const float* __restrict__ h, bf16_t* __restrict__ hb, const int bid, const int G, const int tid) {
    const int lane = tid & 63, wv = tid >> 6;
    for (int job = bid * 8 + wv; job < SEQ * 96; job += G * 8) {
        const int t = job / 96, blk = job - t * 96;
        const bool rope = (blk < 20) || (blk >= 24 && blk < 72);
        const float2 v = *(const float2*)(h + (size_t)t * 12288 + blk * 128 + 2 * lane);
        float o0 = v.x, o1 = v.y;
        const float p0 = __shfl_xor(v.x, 8), p1 = __shfl_xor(v.y, 8);
        if (rope && lane < 16) {
            const int i0 = (2 * lane) & 15;
            float s0, c0, s1, c1; sincos_rev((double)t * REV_P[i0], s0, c0); sincos_rev((double)t * REV_P[i0 + 1], s1, c1);
            if (lane < 8) { o0 = v.x * c0 - p0 * s0; o1 = v.y * c1 - p1 * s1; }
            else          { o0 = v.x * c0 + p0 * s0; o1 = v.y * c1 + p1 * s1; }
        }
        *(unsigned*)(hb + (size_t)t * 12288 + blk * 128 + 2 * lane) = cvtpk_bf16(o0, o1);
    }
}
__device__ __forceinline__ void post_odd_phase(const float* __restrict__ h, bf16_t* __restrict__ hb, const float* __restrict__ qg, const float* __restrict__ kg, const int bid, const int G, const int tid) {
    const int lane = tid & 63, wv = tid >> 6;
    for (int job = bid * 8 + wv; job < SEQ * 72; job += G * 8) {
        const int t = job / 72, blk = job - t * 72;
        const float2 v = *(const float2*)(h + (size_t)t * 9216 + blk * 128 + 2 * lane);
        float o0 = v.x, o1 = v.y;
        if (blk < 32) {
            const float p0 = __shfl_xor(v.x, 8), p1 = __shfl_xor(v.y, 8);
            if (lane < 16) {
                const int i0 = (2 * lane) & 15;
                float s0, c0, s1, c1; sincos_rev((double)t * REV_P[i0], s0, c0); sincos_rev((double)t * REV_P[i0 + 1], s1, c1);
                if (lane < 8) { o0 = v.x * c0 - p0 * s0; o1 = v.y * c1 - p1 * s1; }
                else          { o0 = v.x * c0 + p0 * s0; o1 = v.y * c1 + p1 * s1; }
            }
        } else if (blk >= 48 && blk < 68) {
            const float* g = blk < 64 ? qg : kg;
            const float ss = wave_sum(v.x * v.x + v.y * v.y) * (1.0f / 128.0f);
            const float rs = 1.0f / sqrtf(ss + 1e-6f);
            const float a0 = v.x * rs * g[2 * lane], a1 = v.y * rs * g[2 * lane + 1];
            const float p0 = __shfl_xor(a0, 16), p1 = __shfl_xor(a1, 16);
            const int i0 = (2 * lane) & 31;
            const double pos = (double)(lane < 32 ? (t >> 6) : (t & 63));
            float s0, c0, s1, c1; sincos_rev(pos * REV_A[i0], s0, c0); sincos_rev(pos * REV_A[i0 + 1], s1, c1);
            if ((lane & 16) == 0) { o0 = a0 * c0 - p0 * s0; o1 = a1 * c1 - p1 * s1; }
            else                  { o0 = a0 * c0 + p0 * s0; o1 = a1 * c1 + p1 * s1; }
        }
        *(unsigned*)(hb + (size_t)t * 9216 + blk * 128 + 2 * lane) = cvtpk_bf16(o0, o1);
    }
}

__device__ __forceinline__ void attn_seg_b(const float q0, const float q1, const bf16_t* __restrict__ Kb, const bf16_t* __restrict__ Vb, const int ld,
                                           const int t, const int step, int jlo, int jhi, float& m, float& l, float& o0, float& o1, const int lane) {
    { const int lo = -(t / step); if (jlo < lo) jlo = lo; const int hi = (SEQ - 1 - t) / step; if (jhi > hi) jhi = hi; }
    for (int j = jlo; j <= jhi; ++j) {
        const size_t tp = (size_t)(t + step * j);
        const unsigned kw = *(const unsigned*)(Kb + tp * ld + 2 * lane), vw = *(const unsigned*)(Vb + tp * ld + 2 * lane);
        const float s = wave_sum(q0 * bf_lo(kw) + q1 * bf_hi(kw)) * ATT_SCALE;
        const float mn = fmaxf(m, s);
        const float al = __expf(m - mn), p = __expf(s - mn);
        l = l * al + p;
        o0 = o0 * al + p * bf_lo(vw); o1 = o1 * al + p * bf_hi(vw);
        m = mn;
    }
}
__device__ __forceinline__ void attn_even_valu_phase(const bf16_t* __restrict__ hb, const float* __restrict__ sink, bf16_t* __restrict__ abb, const int bid, const int G, const int tid) {
    const int lane = tid & 63, wv = tid >> 6;
    const int LD = 12288;
    for (int job = bid * 8 + wv; job < SEQ * 24; job += G * 8) {
        const int hh = job / SEQ, t = job % SEQ;
        float o0 = 0.f, o1 = 0.f, m, l;
        if (hh < 16) {
            const int kv = hh >> 2;
            const unsigned qw = *(const unsigned*)(hb + (size_t)t * LD + hh * 128 + 2 * lane);
            m = sink[hh]; l = 1.f;
            attn_seg_b(bf_lo(qw), bf_hi(qw), hb + 2048 + kv * 128, hb + 2560 + kv * 128, LD, t, 1, -128, 128, m, l, o0, o1, lane);
        } else {
            const int hbh = hh - 16;
            m = -1e30f; l = 0.f;
#pragma unroll
            for (int g = 0; g < 3; ++g) {
                const int head = 8 * g + hbh; const int step = g == 0 ? 1 : (g == 1 ? 4 : 16);
                const unsigned qw = *(const unsigned*)(hb + (size_t)t * LD + 3072 + head * 128 + 2 * lane);
                attn_seg_b(bf_lo(qw), bf_hi(qw), hb + 6144 + head * 128, hb + 9216 + head * 128, LD, t, step, -64, 64, m, l, o0, o1, lane);
            }
        }
        const float il = 1.0f / l;
        *(unsigned*)(abb + (size_t)t * 3072 + hh * 128 + 2 * lane) = cvtpk_bf16(o0 * il, o1 * il);
    }
}

__device__ __forceinline__ void ln_phase(const float* __restrict__ y, const float* __restrict__ g, const float* __restrict__ b, float* __restrict__ out, bf16_t* __restrict__ outb, const int bid, const int G, const int tid) {
    const int lane = tid & 63, wv = tid >> 6;
    for (int t = bid * 8 + wv; t < SEQ; t += G * 8) {
        float4 v[16]; float s = 0.f;
#pragma unroll
        for (int i = 0; i < 16; ++i) { v[i] = *(const float4*)(y + (size_t)t * DM + i * 256 + lane * 4); s += (v[i].x + v[i].y) + (v[i].z + v[i].w); }
        const float mean = wave_sum(s) * (1.0f / DM);
        float q = 0.f;
#pragma unroll
        for (int i = 0; i < 16; ++i) { const float a = v[i].x - mean, bb = v[i].y - mean, c = v[i].z - mean, d = v[i].w - mean; q += (a * a + bb * bb) + (c * c + d * d); }
        const float rstd = 1.0f / sqrtf(wave_sum(q) * (1.0f / DM) + 1e-5f);
#pragma unroll
        for (int i = 0; i < 16; ++i) {
            const float4 gg = *(const float4*)(g + i * 256 + lane * 4), bb = *(const float4*)(b + i * 256 + lane * 4);
            float4 o; o.x = (v[i].x - mean) * rstd * gg.x + bb.x; o.y = (v[i].y - mean) * rstd * gg.y + bb.y; o.z = (v[i].z - mean) * rstd * gg.z + bb.z; o.w = (v[i].w - mean) * rstd * gg.w + bb.w;
            *(float4*)(out + (size_t)t * DM + i * 256 + lane * 4) = o;
            uint2 w; w.x = cvtpk_bf16(o.x, o.y); w.y = cvtpk_bf16(o.z, o.w); *(uint2*)(outb + (size_t)t * DM + i * 256 + lane * 4) = w;
            if ((i & 3) == 3) asm volatile("" ::: "memory");
        }
    }
}

__device__ __forceinline__ void route_valu_phase(const float* __restrict__ q  , const float* __restrict__ keys  , int* __restrict__ eidx, float* __restrict__ gate, const int bid, const int G, const int tid) {
    const int lane = tid & 63, wv = tid >> 6;
    for (int job = bid * 8 + wv; job < SEQ * 8; job += G * 8) {
        const int hh = job & 7, t = job >> 3;
        float sv0 = 0.f, sv1 = 0.f; int si0 = 0, si1 = 0;
#pragma unroll
        for (int c = 0; c < 2; ++c) {
            const float* qq = q + (size_t)t * 2048 + hh * 256 + c * 128;
            const float* k0 = keys + ((size_t)(hh * 2 + c) * 128 + lane) * 128;
            const float* k1 = k0 + 64 * 128;
            float s0 = 0.f, s1 = 0.f;
            for (int d = 0; d < 128; d += 4) {
                const float4 qv = *(const float4*)(qq + d), a = *(const float4*)(k0 + d), b = *(const float4*)(k1 + d);
                s0 += qv.x * a.x + qv.y * a.y + qv.z * a.z + qv.w * a.w;
                s1 += qv.x * b.x + qv.y * b.y + qv.z * b.z + qv.w * b.w;
            }
            float myv = 0.f; int myi = 0;
            for (int k = 0; k < 16; ++k) {
                float bv; int bi;
                if (s1 > s0) { bv = s1; bi = lane + 64; } else { bv = s0; bi = lane; }
#pragma unroll
                for (int o = 32; o >= 1; o >>= 1) {
                    const float ov = __shfl_xor(bv, o); const int oi = __shfl_xor(bi, o);
                    if (ov > bv || (ov == bv && oi < bi)) { bv = ov; bi = oi; }
                }
                if (lane == k) { myv = bv; myi = bi; }
                if (bi == lane) s0 = -3.0e38f;
                if (bi == lane + 64) s1 = -3.0e38f;
            }
            if (c == 0) { sv0 = myv; si0 = myi; } else { sv1 = myv; si1 = myi; }
        }
        float cv0, cv1, cv2, cv3; int ci0, ci1, ci2, ci3;
        { const float a = __shfl(sv0, lane >> 2); const int ai = __shfl(si0, lane >> 2); const int jb = (lane & 3) * 4;
          cv0 = a + __shfl(sv1, jb + 0); ci0 = ai * 128 + __shfl(si1, jb + 0);
          cv1 = a + __shfl(sv1, jb + 1); ci1 = ai * 128 + __shfl(si1, jb + 1);
          cv2 = a + __shfl(sv1, jb + 2); ci2 = ai * 128 + __shfl(si1, jb + 2);
          cv3 = a + __shfl(sv1, jb + 3); ci3 = ai * 128 + __shfl(si1, jb + 3); }
        float tv = 0.f; int te = 0;
        for (int k = 0; k < 16; ++k) {
            float bv = cv0; int bp = lane * 4, be = ci0;
            if (cv1 > bv) { bv = cv1; bp = lane * 4 + 1; be = ci1; }
            if (cv2 > bv) { bv = cv2; bp = lane * 4 + 2; be = ci2; }
            if (cv3 > bv) { bv = cv3; bp = lane * 4 + 3; be = ci3; }
#pragma unroll
            for (int o = 32; o >= 1; o >>= 1) {
                const float ov = __shfl_xor(bv, o); const int op = __shfl_xor(bp, o); const int oe = __shfl_xor(be, o);
                if (ov > bv || (ov == bv && op < bp)) { bv = ov; bp = op; be = oe; }
            }
            if (lane == k) { tv = bv; te = be; }
            if (bp == lane * 4 + 0) cv0 = -3.0e38f;
            if (bp == lane * 4 + 1) cv1 = -3.0e38f;
            if (bp == lane * 4 + 2) cv2 = -3.0e38f;
            if (bp == lane * 4 + 3) cv3 = -3.0e38f;
        }
        const float v = lane < 16 ? tv : -3.0e38f;
        const float mx = wave_max(v);
        const float e = lane < 16 ? __expf(tv - mx) : 0.f;
        const float den = wave_sum(e);
        if (lane < 16) { eidx[(size_t)t * 128 + hh * 16 + lane] = te; gate[(size_t)t * 128 + hh * 16 + lane] = e / den; }
    }
}
#ifndef PH_MASK
#define PH_MASK 0xffffffffu
#endif
constexpr int N_PHASES = 20;
__global__ void __launch_bounds__(512, 2) mega(MK a) {
    extern __shared__ __attribute__((aligned(16))) unsigned char lds_raw[];
    LDSA unsigned char* lds = (LDSA unsigned char*)lds_raw;
    const int lo = a.ph_lo, hi = a.ph_hi;
    const int G = gridDim.x, bid = blockIdx.x;
    const int wid_s = __builtin_amdgcn_readfirstlane(threadIdx.x >> 6);
    unsigned char* ws = a.ws;
#define PH_TID() int tid; { int _z = 0; asm volatile("" : "+s"(_z)); tid = wid_s * 64 + (int)__builtin_amdgcn_mbcnt_hi(~0u, __builtin_amdgcn_mbcnt_lo(~0u, (unsigned)_z)); }
#define WSP(T, name, off) T* name; { unsigned char* _b = ws; asm volatile("" : "+s"(_b)); name = (T*)(_b + (off)); }
#define IN(k) ((((PH_MASK) >> (k)) & 1u) && lo <= (k) && (k) < hi)
#define SEAM(k) do { if ((k) + 1 < hi) { PH_TID() xcd_barrier(bar, tid); } } while (0)
    XcdBarrier bar;
    { PH_TID()
      volatile LAS unsigned* st = (volatile LAS unsigned*)(lds + LDS_MISC);
      if (tid == 0) { st[0] = 0u; st[1] = 0u; }
      __syncthreads();
      bar = xcd_barrier_post((unsigned*)(ws + WS_CTL), st, tid); }

    if (IN(0)) {
        PH_TID()
        WSP(bf16_t, xb, WS_XB) WSP(bf16_t, wab, WS_WAB) WSP(bf16_t, woab, WS_WOAB) WSP(bf16_t, wcd, WS_WCD) WSP(bf16_t, wocd, WS_WOCD) WSP(bf16_t, wq, WS_WQ) WSP(bf16_t, ub, WS_UB) WSP(bf16_t, vb, WS_VB)
        cvt_rows_bf16(a.in[0], xb, (size_t)SEQ * DM / 8, bid, G, tid, 512);
        LDSA float* tile = (LDSA float*)lds;
        transpose_cvt(a.in[1], wab, 4096, 12288, tile, bid, G, PermNone(), tid);
        transpose_cvt(a.in[3], woab, 3072, 4096, tile, bid, G, PermNone(), tid);
        transpose_cvt(a.in[4], wcd, 4096, 9216, tile, bid, G, PermNone(), tid);
        transpose_cvt(a.in[12], wocd, 4096, 4096, tile, bid, G, PermNone(), tid);
        transpose_cvt(a.in[15], wq, 4096, 2048, tile, bid, G, PermNone(), tid);
        transpose_cvt(a.in[15] + (size_t)4096 * 2048, wq + (size_t)2048 * 4096, 4096, 2048, tile, bid, G, PermNone(), tid);
        cvt_rows_bf16(a.in[17], ub, (size_t)2 * 16384 * 4096 / 8, bid, G, tid, 512);
        cvt_rows_bf16(a.in[18], vb, (size_t)2 * 16384 * 4096 / 8, bid, G, tid, 512);
        SEAM(0);
    }
#pragma unroll
    for (int layer = 0; layer < 2; ++layer) {
        const int pb = 1 + 10 * layer;
        if (IN(pb + 0)) {
            PH_TID() WSP(bf16_t, xb, WS_XB) WSP(bf16_t, x2b, WS_X2B) WSP(bf16_t, wab, WS_WAB) WSP(bf16_t, wcd, WS_WCD) WSP(float, hbuf, WS_H)
            const int N = layer == 0 ? 12288 : 9216;
            pg8::Gemm g{layer == 0 ? xb : x2b, layer == 0 ? wab : wcd, SEQ, N, 4096}; pg8::StaticOrder S; S.init(SEQ, N, G, bid);
            pg8::EpiF32R E{hbuf, N, nullptr, 0.f};
            pg8::gemm_phase<pg8::EpiF32R, pg8::StaticOrder>(lds, g, S, E, nullptr, tid);
            SEAM(pb + 0);
        }
        if (IN(pb + 1)) {
            PH_TID() WSP(float, hbuf, WS_H) WSP(bf16_t, hb, WS_HB)
            if (layer == 0) post_even_phase(hbuf, hb, bid, G, tid);
            else post_odd_phase(hbuf, hb, a.in[10], a.in[11], bid, G, tid);
            SEAM(pb + 1);
        }
        if (IN(pb + 2)) {
            PH_TID() WSP(bf16_t, hb, WS_HB) WSP(bf16_t, abb, WS_AB) WSP(float, oc, WS_OC)
            if (layer == 0) attn0_phase(hb, a.in[2], abb, (bf16_t*)oc, (float*)((unsigned char*)oc + (size_t)3 * 8 * SEQ * 128 * 2), (char*)lds_raw, bid, G, tid);
            else attn1_phase(hb, abb, oc, (char*)lds_raw, bid, G, tid);
            SEAM(pb + 2);
        }
        if (layer == 0) {
            if (IN(pb + 3)) {
                PH_TID() WSP(bf16_t, abb, WS_AB) WSP(float, oc, WS_OC)
                merge0_phase((const bf16_t*)oc, (const float*)((unsigned char*)oc + (size_t)3 * 8 * SEQ * 128 * 2), abb, bid, G, tid);
                SEAM(pb + 3);
            }
        } else {
            if (IN(pb + 3)) {
                PH_TID() WSP(bf16_t, abb, WS_AB) WSP(float, oc, WS_OC)
                const int lane = tid & 63, wv = tid >> 6;
                const float* lq1 = a.in[5]; const float* lk1 = a.in[6]; const float* lq2 = a.in[7]; const float* lk2 = a.in[8]; const float* subg = a.in[9];
                const float lam = __expf(wave_sum(lq1[lane] * lk1[lane] + lq1[lane + 64] * lk1[lane + 64])) - __expf(wave_sum(lq2[lane] * lk2[lane] + lq2[lane + 64] * lk2[lane + 64])) + LAMBDA_INIT;
                const float4 sg = *(const float4*)(subg + 4 * lane);
                for (int j = bid * 8 + wv; j < SEQ * 8; j += G * 8) {
                    const int t = j >> 3, h = j & 7;
                    const float4 o1 = *(const float4*)(oc + (size_t)t * 2048 + h * 256 + 4 * lane), o2 = *(const float4*)(oc + (size_t)SEQ * 2048 + (size_t)t * 2048 + h * 256 + 4 * lane);
                    const float ox = o1.x - lam * o2.x, oy = o1.y - lam * o2.y, oz = o1.z - lam * o2.z, ow = o1.w - lam * o2.w;
                    const float ss = wave_sum((ox * ox + oy * oy) + (oz * oz + ow * ow)) * (1.0f / 256.0f);
                    const float rs = (1.0f - LAMBDA_INIT) / sqrtf(ss + 1e-6f);
                    uint2 w; w.x = cvtpk_bf16(ox * rs * sg.x, oy * rs * sg.y); w.y = cvtpk_bf16(oz * rs * sg.z, ow * rs * sg.w);
                    *(uint2*)(abb + (size_t)t * 4096 + h * 256 + 4 * lane) = w;
                }
                SEAM(pb + 3);
            }
        }
        if (IN(pb + 4)) {
            const int K = layer == 0 ? 3072 : 4096;
            PH_TID() WSP(bf16_t, abb, WS_AB) WSP(bf16_t, woab, WS_WOAB) WSP(bf16_t, wocd, WS_WOCD) WSP(float, ybuf, WS_Y) WSP(float, x2, WS_X2)
            pg8::Gemm g{abb, layer == 0 ? woab : wocd, SEQ, 4096, K}; pg8::StaticOrder S; S.init(SEQ, 4096, G, bid);
            pg8::EpiF32R E{ybuf, 4096, layer == 0 ? a.in[0] : (const float*)x2, ALPHA};
            pg8::gemm_phase<pg8::EpiF32R, pg8::StaticOrder>(lds, g, S, E, nullptr, tid);
            SEAM(pb + 4);
        }
        if (IN(pb + 5)) {
            PH_TID() WSP(float, ybuf, WS_Y) WSP(float, x1, WS_X1) WSP(bf16_t, x1b, WS_X1B)
            ln_phase(ybuf, a.in[13] + layer * DM, a.in[14] + layer * DM, x1, x1b, bid, G, tid);
            SEAM(pb + 5);
        }
        if (IN(pb + 6)) {
            PH_TID() WSP(bf16_t, x1b, WS_X1B) WSP(bf16_t, wq, WS_WQ) WSP(float, pq, WS_PQ)
            pg8::Gemm g{x1b, wq + (size_t)layer * 2048 * 4096, SEQ, 2048, 4096}; pg8::StaticOrder S; S.init(SEQ, 2048, G, bid);
            pg8::EpiF32R E{pq, 2048, nullptr, 0.f};
            pg8::gemm_phase<pg8::EpiF32R, pg8::StaticOrder>(lds, g, S, E, nullptr, tid);
            SEAM(pb + 6);
        }
        if (IN(pb + 7)) {
            PH_TID() WSP(float, pq, WS_PQ) WSP(int, eidx, WS_EIDX) WSP(float, gate, WS_GATE)
            route_valu_phase(pq, a.in[16] + (size_t)layer * 8 * 2 * 128 * 128, eidx, gate, bid, G, tid);
            SEAM(pb + 7);
        }
        if (IN(pb + 8)) {
            PH_TID() WSP(float, x1, WS_X1) WSP(bf16_t, x1b, WS_X1B) WSP(int, eidx, WS_EIDX) WSP(float, gate, WS_GATE) WSP(bf16_t, ub, WS_UB) WSP(bf16_t, vb, WS_VB) WSP(float, x2, WS_X2) WSP(bf16_t, x2b, WS_X2B)
            peer_expert_phase(x1, x1b, eidx, gate, ub + (size_t)layer * 16384 * 4096, vb + (size_t)layer * 16384 * 4096, a.in[19] + layer * DM, a.in[20] + layer * DM,
                              layer == 0 ? x2 : a.out, layer == 0 ? x2b : (bf16_t*)nullptr, bid, G, tid);
            SEAM(pb + 8);
        }
    }
#undef IN
}
#ifndef ONE_LAUNCH
#define ONE_LAUNCH 1
#endif
extern "C" void kernel_launch(void* const* d_in, const int* in_sizes, int n_in, void* d_out, int out_size, void* d_ws, size_t ws_size, hipStream_t stream) {
    static int ready = 0;
    if (!ready) {
        if (ws_size < WS_END) { fprintf(stderr, "kernel_launch: workspace too small: %zu < %zu\n", ws_size, (size_t)WS_END); return; }
        if (hipFuncSetAttribute((const void*)mega, hipFuncAttributeMaxDynamicSharedMemorySize, LDS_BYTES) != hipSuccess) { fprintf(stderr, "kernel_launch: hipFuncSetAttribute failed\n"); return; }
        int per_cu = 0;
        if (hipOccupancyMaxActiveBlocksPerMultiprocessor(&per_cu, (const void*)mega, 512, LDS_BYTES) != hipSuccess || per_cu < 1) fprintf(stderr, "kernel_launch: note: occupancy query reports %d blocks per CU\n", per_cu);
        (void)hipGetLastError();
        ready = 1;
    }
    unsigned char* ws = (unsigned char*)d_ws;
    (void)hipMemsetAsync(ws + WS_CTL, 0, CTL_BYTES, stream);
    MK a{}; for (int i = 0; i < 21; ++i) a.in[i] = (const float*)d_in[i];
    a.out = (float*)d_out; a.ws = ws;
#if ONE_LAUNCH
    a.ph_lo = 0; a.ph_hi = N_PHASES;
    hipLaunchKernelGGL(mega, dim3(256), dim3(512), LDS_BYTES, stream, a);
#else
    for (int k = 0; k < N_PHASES; ++k) { if (k == 10) continue; a.ph_lo = k; a.ph_hi = k + 1; hipLaunchKernelGGL(mega, dim3(256), dim3(512), LDS_BYTES, stream, a); }
#endif
    const hipError_t le = hipPeekAtLastError();
    if (le != hipSuccess) fprintf(stderr, "kernel_launch: launch failed: %s\n", hipGetErrorName(le));
}
```

```cpp
#include <hip/hip_runtime.h>
#include <stdint.h>
#include <cstdio>

#define SEQ 8192
#define DM 4096
#define HD 128
#define ALPHA 1.4142135623730951f
#define LAMBDA_INIT 0.35550906759096934f
#define ATT_SCALE 0.088388347648318440f

__device__ const double REV_P[16] = {0.15915494309189535, 0.0700865215877985, 0.03086376340470123, 0.013591370636193905, 0.005985185712713705, 0.002635675898667414, 0.001160663641240061, 0.0005111175045375439, 0.00022507907903927653, 9.911730936901935e-05, 4.364795279280289e-05, 1.9221100684944863e-05, 8.464330808241401e-06, 3.727408601915352e-06, 1.6414262627950345e-06, 7.228293068832865e-07};
__device__ const double REV_A[32] = {0.15915494309189535, 0.11934937021124886, 0.08949940160889101, 0.06711508300522726, 0.050329212104487035, 0.03774158471741977, 0.0283021958306234, 0.02122365276477766, 0.015915494309189534, 0.011934937021124886, 0.008949940160889102, 0.006711508300522725, 0.005032921210448704, 0.003774158471741977, 0.00283021958306234, 0.0021223652764777662, 0.0015915494309189536, 0.0011934937021124885, 0.0008949940160889102, 0.0006711508300522726, 0.0005032921210448703, 0.00037741584717419774, 0.00028302195830623395, 0.0002122365276477766, 0.00015915494309189535, 0.00011934937021124886, 8.949940160889102e-05, 6.711508300522725e-05, 5.0329212104487035e-05, 3.774158471741978e-05, 2.8302195830623396e-05, 2.122365276477766e-05};

__device__ __forceinline__ void sincos_rev(double rev, float& s, float& c) {
    const double f = rev - floor(rev); const float ff = (float)f;
    s = __builtin_amdgcn_sinf(ff); c = __builtin_amdgcn_cosf(ff);
}
__device__ __forceinline__ float wave_sum(float v) {
#pragma unroll
    for (int o = 32; o >= 1; o >>= 1) v += __shfl_xor(v, o);
    return v;
}
__device__ __forceinline__ float wave_max(float v) {
#pragma unroll
    for (int o = 32; o >= 1; o >>= 1) v = fmaxf(v, __shfl_xor(v, o));
    return v;
}
namespace pg8 {
#define PG8_LAS __attribute__((address_space(3)))
typedef unsigned short bf16_t;
typedef short bf16x8 __attribute__((ext_vector_type(8)));
typedef float f32x4 __attribute__((ext_vector_type(4)));
typedef unsigned u32x4 __attribute__((ext_vector_type(4)));
constexpr int BM = 256, BK = 64, HALF = 128, HTB = HALF * BK * 2  , STAGE_BYTES = 8 * HTB, NXCD = 8, WGM = 8;

__host__ __device__ __forceinline__ int lds_byte(int r, int c) { const int st = (r >> 4) * 2 + (c >> 5), rr = r & 15, cc = c & 31, ob = rr * 64 + cc * 2; return st * 1024 + (ob ^ (((ob >> 9) & 1) << 5)); }
__host__ __device__ __forceinline__ void stage_rc(int b, int& R, int& C) { const int st = b / 1024, sb = b % 1024, swz = sb ^ (((sb >> 9) & 1) << 5); R = (st >> 1) * 16 + swz / 64; C = (st & 1) * 32 + (swz % 64) / 2; }
__host__ __device__ __forceinline__ int perm32(int rho) { const int n = rho >> 4, i = rho & 15; return 8 * (i >> 2) + 4 * n + (i & 3); }

struct Unit { int pm, pn; };
struct Gemm { const bf16_t* A; const bf16_t* Bt; int M, N, K; };

struct StaticOrder {
    int nM, nN, nwg, G, c;
    __host__ __device__ void init(int M, int N, int G_, int c_) { nM = M / BM; nN = N / BM; nwg = nM * nN; G = G_; c = c_; }
    __host__ __device__ bool next(int i, Unit& u) const {
        const long L = (long)i * G + c; if (L >= nwg) return false;
        int wgid = (int)L; { const int q = nwg / NXCD, r = nwg % NXCD, xcd = wgid % NXCD, off = wgid / NXCD; wgid = (xcd < r ? xcd * (q + 1) : r * (q + 1) + (xcd - r) * q) + off; }
        const int nig = WGM * nN, gid = wgid / nig, fm = gid * WGM, gsz = (nM - fm) < WGM ? (nM - fm) : WGM;
        u.pm = fm + ((wgid % nig) % gsz); u.pn = (wgid % nig) / gsz; return true;
    }
    __device__ __forceinline__ void a_ready(const Unit&) const {}
    __device__ __forceinline__ void done(const Unit&) const {}
};
__device__ __forceinline__ unsigned cvt_pk_bf16(float lo, float hi) { unsigned r; asm volatile("v_cvt_pk_bf16_f32 %0, %1, %2" : "=v"(r) : "v"(lo), "v"(hi)); return r; }
typedef float f32x2 __attribute__((ext_vector_type(2)));
template <class Epi, class Sched, bool STAMP = false>
__device__ __forceinline__ void gemm_phase(PG8_LAS unsigned char* lds, const Gemm g, const Sched& S, const Epi& E, unsigned long long* stamps, const int tid_in) {
    const int tid = tid_in, wid = __builtin_amdgcn_readfirstlane(tid >> 6), lane = tid & 63, wr = wid >> 2, wc = wid & 3, fr = lane & 15, fq = lane >> 4;
    const int K = g.K, nt = K / BK;
    int ts_lo = 0, ts_hi = 0, nts = 0; const unsigned long long rt_entry = STAMP ? (unsigned long long)wall_clock64() : 0ull;
#define PG8_STAMP() do { if (STAMP && wid == 0 && nts < 64) { const unsigned long long _c = (unsigned long long)clock64(); \
        ts_lo = (lane == nts) ? (int)(unsigned)_c : ts_lo; ts_hi = (lane == nts) ? (int)(unsigned)(_c >> 32) : ts_hi; ++nts; } } while (0)
    PG8_STAMP();
    unsigned voffA[2], voffB[2];
#pragma unroll
    for (int i = 0; i < 2; ++i) { int R, C; stage_rc(tid * 16 + i * 8192, R, C); const int Rb = Epi::PERM ? ((R & ~31) + perm32(R & 31)) : R;
        voffA[i] = (unsigned)(R * K + C) * 2u; voffB[i] = (unsigned)(Rb * K + C) * 2u; }
    const size_t kstep = (size_t)(BK * 2);
    const size_t hstep = (size_t)HALF * K * 2;
    const size_t tstep = 2 * hstep;
    const unsigned ldsw = (unsigned)wid * 1024u;
    const int aoff = lds_byte(wr * 64 + fr, fq * 8), boff = lds_byte(wc * 32 + fr, fq * 8);
#define PG8_SA(b, h) (((b) * 2 + (h)) * HTB)
#define PG8_SB(b, h) ((4 + (b) * 2 + (h)) * HTB)
#define PG8_STAGE(bufoff, gbase, voff) do { _Pragma("unroll") for (int _i = 0; _i < 2; ++_i) \
        __builtin_amdgcn_global_load_lds((const unsigned*)((const char*)(gbase) + (voff)[_i]), (PG8_LAS unsigned*)(lds + (bufoff) + ldsw + _i * 8192), 16, 0, 0); } while (0)
#define PG8_LDA(dst, b, h) do { _Pragma("unroll") for (int m = 0; m < 4; ++m) _Pragma("unroll") for (int k = 0; k < 2; ++k) dst[m][k] = *(const PG8_LAS bf16x8*)(lds + PG8_SA(b, h) + aoff + m * 2048 + k * 1024); } while (0)
#define PG8_LDB(dst, b, h) do { _Pragma("unroll") for (int n = 0; n < 2; ++n) _Pragma("unroll") for (int k = 0; k < 2; ++k) dst[n][k] = *(const PG8_LAS bf16x8*)(lds + PG8_SB(b, h) + boff + n * 2048 + k * 1024); } while (0)
#define PG8_MMA(ai, bj, At, Bt) do { __builtin_amdgcn_s_setprio(1); _Pragma("unroll") for (int m = 0; m < 4; ++m) _Pragma("unroll") for (int n = 0; n < 2; ++n) _Pragma("unroll") for (int k = 0; k < 2; ++k) \
        acc[ai][bj][m][n] = __builtin_amdgcn_mfma_f32_16x16x32_bf16(Bt[n][k], At[m][k], acc[ai][bj][m][n], 0, 0, 0); __builtin_amdgcn_s_setprio(0); } while (0)
#define PG8_WAIT_V(n) asm volatile("s_waitcnt vmcnt(" #n ")" ::: "memory")
#define PG8_WAIT_L(n) asm volatile("s_waitcnt lgkmcnt(" #n ")" ::: "memory")
#define PG8_BAR __builtin_amdgcn_s_barrier()
#define PG8_SCHED __builtin_amdgcn_sched_barrier(0)
    Unit cur, nxt; int ui = 0;
    if (!S.next(0, cur)) return;
    f32x4 acc[2][2][4][2];
#pragma unroll
    for (int a = 0; a < 2; ++a)
#pragma unroll
        for (int b = 0; b < 2; ++b)
#pragma unroll
            for (int m = 0; m < 4; ++m)
#pragma unroll
                for (int n = 0; n < 2; ++n) acc[a][b][m][n] = (f32x4){0.f, 0.f, 0.f, 0.f};
    bf16x8 At[4][2], B0[2][2], B1[2][2];
    const char* cA = (const char*)g.A + (size_t)cur.pm * tstep; const char* cB = (const char*)g.Bt + (size_t)cur.pn * tstep;
    S.a_ready(cur);
    PG8_STAGE(PG8_SB(0, 0), cB, voffB); PG8_STAGE(PG8_SA(0, 0), cA, voffA); PG8_STAGE(PG8_SB(0, 1), cB + hstep, voffB); PG8_STAGE(PG8_SA(0, 1), cA + hstep, voffA);
    if (wr == 1) PG8_BAR;
    PG8_WAIT_V(4); PG8_BAR;
    PG8_STAGE(PG8_SB(1, 0), cB + kstep, voffB); PG8_STAGE(PG8_SA(1, 0), cA + kstep, voffA); PG8_STAGE(PG8_SB(1, 1), cB + hstep + kstep, voffB);
    PG8_WAIT_V(6); PG8_BAR;
    PG8_STAMP();
    for (;;) {
        const bool has_next = S.next(ui + 1, nxt);
        const char* nA = has_next ? (const char*)g.A + (size_t)nxt.pm * tstep : cA; const char* nB = has_next ? (const char*)g.Bt + (size_t)nxt.pn * tstep : cB;
        for (int t = 0; t < nt; t += 2) {
            const bool last = (t == nt - 2);
            const char* a1 = cA + (size_t)(t + 1) * kstep;
            const char* a2 = last ? nA : cA + (size_t)(t + 2) * kstep; const char* b2 = last ? nB : cB + (size_t)(t + 2) * kstep;
            const char* a3 = a2 + kstep; const char* b3 = b2 + kstep;
            if (last && has_next) S.a_ready(nxt);
            PG8_LDB(B0, 0, 0); PG8_SCHED; PG8_LDA(At, 0, 0); PG8_STAGE(PG8_SA(1, 1), a1 + hstep, voffA);
            PG8_WAIT_L(8); PG8_BAR; PG8_WAIT_L(0); PG8_MMA(0, 0, At, B0); PG8_BAR; PG8_SCHED;
            PG8_LDB(B1, 0, 1); PG8_STAGE(PG8_SB(0, 0), b2, voffB);
            PG8_BAR; PG8_WAIT_L(0); PG8_MMA(0, 1, At, B1); PG8_BAR;
            PG8_LDA(At, 0, 1); PG8_STAGE(PG8_SA(0, 0), a2, voffA);
            PG8_BAR; PG8_WAIT_L(0); PG8_MMA(1, 0, At, B0); PG8_BAR; PG8_SCHED;
            PG8_STAGE(PG8_SB(0, 1), b2 + hstep, voffB);
            PG8_WAIT_V(6); PG8_BAR; PG8_MMA(1, 1, At, B1); PG8_BAR;
            PG8_LDB(B0, 1, 0); PG8_SCHED; PG8_LDA(At, 1, 0); PG8_STAGE(PG8_SA(0, 1), a2 + hstep, voffA);
            PG8_WAIT_L(8); PG8_BAR; PG8_WAIT_L(0); PG8_MMA(0, 0, At, B0); PG8_BAR; PG8_SCHED;
            PG8_LDB(B1, 1, 1); PG8_STAGE(PG8_SB(1, 0), b3, voffB);
            PG8_BAR; PG8_WAIT_L(0); PG8_MMA(0, 1, At, B1); PG8_BAR;
            PG8_LDA(At, 1, 1); PG8_STAGE(PG8_SA(1, 0), a3, voffA);
            PG8_BAR; PG8_WAIT_L(0); PG8_MMA(1, 0, At, B0); PG8_BAR; PG8_SCHED;
            PG8_STAGE(PG8_SB(1, 1), b3 + hstep, voffB);
            PG8_WAIT_V(6); PG8_BAR; PG8_MMA(1, 1, At, B1); PG8_BAR;
        }
        PG8_STAMP();
        if constexpr (!Epi::AFTER_DRAIN) { E(acc, cur, wr, wc, fr, fq); S.done(cur); }
        PG8_STAMP();
        if (!has_next) break;
#pragma unroll
        for (int a = 0; a < 2; ++a)
#pragma unroll
            for (int b = 0; b < 2; ++b)
#pragma unroll
                for (int m = 0; m < 4; ++m)
#pragma unroll
                    for (int n = 0; n < 2; ++n) acc[a][b][m][n] = (f32x4){0.f, 0.f, 0.f, 0.f};
        cur = nxt; cA = nA; cB = nB; ++ui;
    }
    PG8_WAIT_V(0);
    if (wr == 0) PG8_BAR;
    PG8_BAR;
    if constexpr (Epi::AFTER_DRAIN) { E.fused(acc, cur, wr, wc, fr, fq, lds, wid, lane); S.done(cur); }
    PG8_STAMP();
    if (STAMP && wid == 0) { stamps[lane] = lane < nts ? (((unsigned long long)(unsigned)ts_hi << 32) | (unsigned)ts_lo) : 0ull;
        if (lane == 62) stamps[62] = rt_entry; if (lane == 63) stamps[63] = (unsigned long long)wall_clock64(); }
#undef PG8_STAMP
#undef PG8_SA
#undef PG8_SB
#undef PG8_STAGE
#undef PG8_LDA
#undef PG8_LDB
#undef PG8_MMA
#undef PG8_WAIT_V
#undef PG8_WAIT_L
#undef PG8_BAR
#undef PG8_SCHED
}
}
#define XB_TMO      128
#define XB_XCNT(j)  (256  + 64 * (j))
#define XB_XSUB(j)  (1280 + 64 * (j))
#define XB_XGEN(j)  (2304 + 64 * (j))
#define XB_TOP      3328
#define XB_TOPGEN   3392
#define XCD_BAR_WORDS 3456
#define XB_SPIN_CAP (1u << 22)
#define LAS __attribute__((address_space(3)))

__device__ __forceinline__ unsigned xb_ld(unsigned* p)              { return __hip_atomic_load(p, __ATOMIC_RELAXED, __HIP_MEMORY_SCOPE_AGENT); }
__device__ __forceinline__ unsigned xb_add(unsigned* p, unsigned v) { return __hip_atomic_fetch_add(p, v, __ATOMIC_RELAXED, __HIP_MEMORY_SCOPE_AGENT); }
__device__ __forceinline__ unsigned xb_xcc_id() { return (unsigned)__builtin_amdgcn_s_getreg((3 << 11) | 20) & 0xFu; }
#define XB_SPIN(cond, bar) do { unsigned _sp = 0; while (cond) { __builtin_amdgcn_s_sleep(1); \
    if ((++_sp & 255u) == 0u) { if (xb_ld(&(bar)[XB_TMO])) break; if (_sp > XB_SPIN_CAP) { atomicAdd(&(bar)[XB_TMO], 1u); break; } } } } while (0)

struct XcdBarrier {
    unsigned* bar; unsigned x;
    volatile LAS unsigned* st;
};

__device__ __forceinline__ XcdBarrier xcd_barrier_post(unsigned* bar, volatile LAS unsigned* st, const int tid) {
    XcdBarrier b; b.bar = bar; b.x = xb_xcc_id(); b.st = st;
    if (tid == 0) (void)xb_add(&bar[XB_XCNT(b.x)], 1u);
    return b;
}
__device__ __forceinline__ void xcd_barrier_complete(unsigned* bar, unsigned x, unsigned& nloc, unsigned& nx) {
    const unsigned G = gridDim.x * gridDim.y * gridDim.z;
    unsigned sum, cnt, mine, sp = 0u;
    for (;;) {
        sum = 0u; cnt = 0u; mine = 0u;
#pragma unroll
        for (unsigned j = 0; j < 16; ++j) { const unsigned c = xb_ld(&bar[XB_XCNT(j)]); sum += c; cnt += (c > 0u) ? 1u : 0u; mine = (j == x) ? c : mine; }
        if (sum == G) break;
        __builtin_amdgcn_s_sleep(1);
        if ((++sp & 255u) == 0u) { if (xb_ld(&bar[XB_TMO])) break; if (sp > XB_SPIN_CAP) { atomicAdd(&bar[XB_TMO], 1u); break; } }
    }
    nloc = mine > 0u ? mine : 1u; nx = cnt > 0u ? cnt : 1u;
}

__device__ __forceinline__ void xcd_barrier(const XcdBarrier& b, const int tid) {
    asm volatile("s_waitcnt vmcnt(0)" ::: "memory");
    __syncthreads();
    if (tid == 0) {
        unsigned* bar = b.bar;
        __builtin_amdgcn_s_waitcnt(0);
        unsigned nloc = b.st[0], nx = b.st[1];
        if (nloc == 0u) { xcd_barrier_complete(bar, b.x, nloc, nx); b.st[0] = nloc; b.st[1] = nx; }
        const unsigned old = xb_add(&bar[XB_XSUB(b.x)], 1u);
        const unsigned gen = old / nloc;
        if (old + 1u == (gen + 1u) * nloc) {
            __builtin_amdgcn_fence(__ATOMIC_RELEASE, "agent");
            asm volatile("s_waitcnt vmcnt(0)" ::: "memory");
            const unsigned og = xb_add(&bar[XB_TOP], 1u);
            const unsigned tg = og / nx;
            if (og + 1u == (tg + 1u) * nx) xb_add(&bar[XB_TOPGEN], 1u);
            else XB_SPIN(xb_ld(&bar[XB_TOPGEN]) == tg, bar);
            __builtin_amdgcn_fence(__ATOMIC_ACQUIRE, "agent");
            xb_add(&bar[XB_XGEN(b.x)], 1u);
            asm volatile("s_waitcnt vmcnt(0)" ::: "memory");
        } else {
            XB_SPIN(xb_ld(&bar[XB_XGEN(b.x)]) == gen, bar);
            __builtin_amdgcn_fence(__ATOMIC_ACQUIRE, "agent");
            asm volatile("s_waitcnt vmcnt(0)" ::: "memory");
        }
    }
    __syncthreads();
}
namespace att {
using bf16 = unsigned short;
constexpr int   D = 128, NW = 8, QBLK = 32, KVBLK = 64;
constexpr float SCALE = 0.088388347648318440f;
constexpr float THR = 8.f;
constexpr int SDEPTH = 1;
constexpr size_t SHM_V = KVBLK * D * 2, SHM_K = KVBLK * D * 2, SHM_ATTN = 2 * SHM_V + 2 * SHM_K + NW * 64 * 4;
using bf16x8 = __attribute__((ext_vector_type(8))) short;
using s16x4  = __attribute__((ext_vector_type(4))) short;
using f32x16 = __attribute__((ext_vector_type(16))) float;
using f32x8  = __attribute__((ext_vector_type(8))) float;
using u32x4  = __attribute__((ext_vector_type(4))) unsigned;
#define KSWZ(row, colB) ((row) * 256 + ((colB) ^ (((row) & 7) << 4)))
#define SBAR() __builtin_amdgcn_sched_barrier(0)
__device__ __forceinline__ int crow(int r, int hi) { return (r & 3) + 8 * (r >> 2) + 4 * hi; }
__device__ __forceinline__ unsigned cvtpk(float lo, float hi) {
  unsigned r; asm volatile("v_cvt_pk_bf16_f32 %0, %1, %2" : "=v"(r) : "v"(lo), "v"(hi)); return r;
}
template <typename TIn> struct Stage;
template <> struct Stage<bf16>  { using T = bf16x8;
  __device__ static __forceinline__ T ld8(const bf16* p) { return *reinterpret_cast<const bf16x8*>(p); }
  __device__ static __forceinline__ bf16x8 tobf(T x) { return x; } };
template <> struct Stage<float> { using T = f32x8;
  __device__ static __forceinline__ T ld8(const float* p) { return *reinterpret_cast<const f32x8*>(p); }
  __device__ static __forceinline__ bf16x8 tobf(T x) {
    u32x4 w = {cvtpk(x[0], x[1]), cvtpk(x[2], x[3]), cvtpk(x[4], x[5]), cvtpk(x[6], x[7])}; return *reinterpret_cast<bf16x8*>(&w); } };

__device__ __forceinline__ void partialSM(f32x16& p0, f32x16& p1, float& m_reg, float& mn, float& alpha) {
  constexpr float C = SCALE * 1.4426950408889634f;
  float pmax = p0[0]; for (int r = 1; r < 16; ++r) pmax = fmaxf(pmax, p0[r]); for (int r = 0; r < 16; ++r) pmax = fmaxf(pmax, p1[r]);
  { auto rr = __builtin_amdgcn_permlane32_swap(__float_as_uint(pmax), __float_as_uint(pmax), false, false);
    pmax = fmaxf(__uint_as_float(rr[0]), __uint_as_float(rr[1])); }
  if (__builtin_expect(__all(pmax - m_reg <= THR / SCALE), 1)) { mn = m_reg; alpha = 1.f; }
  else { mn = fmaxf(m_reg, pmax); alpha = __builtin_amdgcn_exp2f((m_reg - mn) * C); m_reg = mn; }
  float mnC = -mn * C;
  for (int r = 0; r < 16; ++r) p0[r] = fmaf(p0[r], C, mnC); for (int r = 0; r < 16; ++r) p1[r] = fmaf(p1[r], C, mnC);
  for (int r = 0; r < 16; ++r) p0[r] = __builtin_amdgcn_exp2f(p0[r]);
}
__device__ __forceinline__ void finishSM(f32x16& p0, f32x16& p1, float alpha, float& l_reg, bf16x8& pa0, bf16x8& pa1, bf16x8& pa2, bf16x8& pa3) {
  for (int r = 0; r < 16; ++r) p1[r] = __builtin_amdgcn_exp2f(p1[r]);
  float ps = 0; for (int r = 0; r < 16; ++r) ps += p0[r]; for (int r = 0; r < 16; ++r) ps += p1[r];
  { auto rr = __builtin_amdgcn_permlane32_swap(__float_as_uint(ps), __float_as_uint(ps), false, false);
    ps = __uint_as_float(rr[0]) + __uint_as_float(rr[1]); }
  l_reg = l_reg * alpha + ps;
#define PK4(P, BASE, OUT) do { unsigned a0 = cvtpk(P[BASE + 0], P[BASE + 1]), a1 = cvtpk(P[BASE + 2], P[BASE + 3]);   \
    unsigned b0 = cvtpk(P[BASE + 4], P[BASE + 5]), b1 = cvtpk(P[BASE + 6], P[BASE + 7]);                              \
    auto r0 = __builtin_amdgcn_permlane32_swap(a0, b0, false, false); auto r1 = __builtin_amdgcn_permlane32_swap(a1, b1, false, false); \
    u32x4 w = {r0[0], r1[0], r0[1], r1[1]}; OUT = *reinterpret_cast<bf16x8*>(&w); } while (0)
  PK4(p0, 0, pa0); PK4(p0, 8, pa1); PK4(p1, 0, pa2); PK4(p1, 8, pa3);
#undef PK4
}
__device__ __forceinline__ void qkt(f32x16& p0, f32x16& p1, const bf16* Ks, const bf16x8* qr, int r32, int hi) {
  p0 = f32x16{}; p1 = f32x16{};
  for (int d0 = 0; d0 < 8; ++d0) { int cb = (d0 * 16 + hi * 8) * 2;
    bf16x8 b0 = *reinterpret_cast<const bf16x8*>((const char*)Ks + KSWZ(r32, cb));
    bf16x8 b1 = *reinterpret_cast<const bf16x8*>((const char*)Ks + KSWZ(32 + r32, cb));
    p0 = __builtin_amdgcn_mfma_f32_32x32x16_bf16(b0, qr[d0], p0, 0, 0, 0);
    p1 = __builtin_amdgcn_mfma_f32_32x32x16_bf16(b1, qr[d0], p1, 0, 0, 0); }
}
__device__ __forceinline__ int v_st(int k, int c) { const int kk = (k & ~0xC) | ((k & 4) << 1) | ((k & 8) >> 1); return ((kk >> 3) * 4 + (c >> 5)) * 512 + ((kk & 7) * 32 + (c & 31)) * 2; }
__device__ __forceinline__ int v_rd_base(int lane) { return ((lane & 3) << 3) | (((lane >> 2) & 3) << 6) | (((lane >> 4) & 1) << 5) | (((lane >> 5) & 1) << 8); }
constexpr int v_rd_off(int d0, int ks, int half) { return d0 * 512 + ks * 4096 + half * 2048; }
template <int OFF> __device__ __forceinline__ s16x4 tr_read(int vb) {
  s16x4 r; asm volatile("ds_read_b64_tr_b16 %0, %1 offset:%2" : "=&v"(r) : "v"(vb), "i"(OFF) : "memory"); return r;
}
template <int D0> __device__ __forceinline__ void pv_one(f32x16& od, int vb, bf16x8 pa0, bf16x8 pa1, bf16x8 pa2, bf16x8 pa3) {
  const s16x4 l0 = tr_read<v_rd_off(D0, 0, 0)>(vb), h0 = tr_read<v_rd_off(D0, 0, 1)>(vb), l1 = tr_read<v_rd_off(D0, 1, 0)>(vb), h1 = tr_read<v_rd_off(D0, 1, 1)>(vb);
  const s16x4 l2 = tr_read<v_rd_off(D0, 2, 0)>(vb), h2 = tr_read<v_rd_off(D0, 2, 1)>(vb), l3 = tr_read<v_rd_off(D0, 3, 0)>(vb), h3 = tr_read<v_rd_off(D0, 3, 1)>(vb);
  asm volatile("s_waitcnt lgkmcnt(0)" ::: "memory"); SBAR();
#define PK(L, H) (bf16x8){L[0], L[1], L[2], L[3], H[0], H[1], H[2], H[3]}
  od = __builtin_amdgcn_mfma_f32_32x32x16_bf16(pa0, PK(l0, h0), od, 0, 0, 0);
  od = __builtin_amdgcn_mfma_f32_32x32x16_bf16(pa1, PK(l1, h1), od, 0, 0, 0);
  od = __builtin_amdgcn_mfma_f32_32x32x16_bf16(pa2, PK(l2, h2), od, 0, 0, 0);
  od = __builtin_amdgcn_mfma_f32_32x32x16_bf16(pa3, PK(l3, h3), od, 0, 0, 0);
#undef PK
}
__device__ __forceinline__ void pv_d0(f32x16* o, int vb, bf16x8 pa0, bf16x8 pa1, bf16x8 pa2, bf16x8 pa3) {
  pv_one<0>(o[0], vb, pa0, pa1, pa2, pa3); pv_one<1>(o[1], vb, pa0, pa1, pa2, pa3); pv_one<2>(o[2], vb, pa0, pa1, pa2, pa3); pv_one<3>(o[3], vb, pa0, pa1, pa2, pa3);
}

template <typename TQ, int LDQ, int LDK, int LDO, typename TO>
__device__ __forceinline__ void attn_dense_body(const TQ* __restrict__ Qb, const bf16* __restrict__ Kh, const bf16* __restrict__ Vh,
                                                TO* __restrict__ Ob, int seq, char* lds, const int tid_in) {
  using St = Stage<bf16>; using SQ = Stage<TQ>;
  const int tid = tid_in, wid = tid >> 6, lane = tid & 63, r32 = lane & 31, hi = lane >> 5;
  bf16* V_lds = (bf16*)lds; bf16* K_lds = (bf16*)(lds + 2 * SHM_V);
  float* ws = (float*)(lds + 2 * SHM_V + 2 * SHM_K) + wid * 64; float* li_l = ws; float* al_l = ws + 32;
  float m_reg = -1e30f, l_reg = 0; f32x16 o[4] = {}; bf16x8 qr[8];
  const TQ* Qw = Qb + (long)(wid * QBLK + r32) * LDQ + hi * 8;
#pragma unroll
  for (int d0 = 0; d0 < 8; ++d0) qr[d0] = SQ::tobf(SQ::ld8(Qw + d0 * 16));
  const int sr = tid >> 4, sc = (tid & 15) * 8, vst0 = v_st(sr, sc), vst1 = v_st(32 + sr, sc);
  const int vb0 = (int)(uintptr_t)V_lds + v_rd_base(lane);
  struct { typename St::T vs0, vs1, ks0, ks1; } sr_[SDEPTH];
#define SLOAD(i, k0) do { sr_[i].vs0 = St::ld8(&Vh[(long)((k0) + sr) * LDK + sc]); sr_[i].vs1 = St::ld8(&Vh[(long)((k0) + 32 + sr) * LDK + sc]); \
    sr_[i].ks0 = St::ld8(&Kh[(long)((k0) + sr) * LDK + sc]); sr_[i].ks1 = St::ld8(&Kh[(long)((k0) + 32 + sr) * LDK + sc]); } while (0)
#define SWRITE(b, i) do { *(bf16x8*)((char*)V_lds + (b) * SHM_V + vst0) = St::tobf(sr_[i].vs0);          \
    *(bf16x8*)((char*)V_lds + (b) * SHM_V + vst1) = St::tobf(sr_[i].vs1); int kc = sc * 2;               \
    *(bf16x8*)((char*)K_lds + (b) * SHM_K + KSWZ(sr, kc)) = St::tobf(sr_[i].ks0);                       \
    *(bf16x8*)((char*)K_lds + (b) * SHM_K + KSWZ(32 + sr, kc)) = St::tobf(sr_[i].ks1); } while (0)
#define SWAIT() do { if constexpr (SDEPTH == 2) asm volatile("s_waitcnt vmcnt(4)" ::: "memory"); else asm volatile("s_waitcnt vmcnt(0)" ::: "memory"); } while (0)
#define RESC(a) do { if (__any((a) < 1.f)) { if (hi == 0) al_l[r32] = (a); asm volatile("s_waitcnt lgkmcnt(0)" ::: "memory"); \
    for (int d = 0; d < 4; ++d) for (int r = 0; r < 16; ++r) o[d][r] *= al_l[crow(r, hi)]; } } while (0)
  f32x16 pA0, pA1, pB0, pB1; float mnA, mnB, alA, alB; bf16x8 pa0, pa1, pa2, pa3; const int NT = seq / KVBLK;
  constexpr int SE = 0, SO = SDEPTH - 1;
  SLOAD(SE, 0); asm volatile("s_waitcnt vmcnt(0)" ::: "memory"); SWRITE(0, SE); __syncthreads();
  qkt(pA0, pA1, K_lds, qr, r32, hi); partialSM(pA0, pA1, m_reg, mnA, alA);
  SLOAD(SO, KVBLK); if constexpr (SDEPTH == 2) { if (2 < NT) SLOAD(SE, 2 * KVBLK); }
  SWAIT(); SWRITE(1, SO); __syncthreads();
  for (int j = 1; j + 1 < NT; j += 2) {
    SBAR(); qkt(pB0, pB1, (bf16*)((char*)K_lds + SHM_K), qr, r32, hi);
    finishSM(pA0, pA1, alA, l_reg, pa0, pa1, pa2, pa3); SBAR();
    SLOAD(SO, (j + SDEPTH) * KVBLK); SBAR();
    pv_d0(o, vb0, pa0, pa1, pa2, pa3); partialSM(pB0, pB1, m_reg, mnB, alB);
    __syncthreads(); SWAIT(); SWRITE(0, SE);
    RESC(alB); __syncthreads();
    SBAR(); qkt(pA0, pA1, K_lds, qr, r32, hi);
    finishSM(pB0, pB1, alB, l_reg, pa0, pa1, pa2, pa3); SBAR();
    if (SDEPTH == 1 || j + 3 < NT) SLOAD(SE, (j + 1 + SDEPTH) * KVBLK); SBAR();
    pv_d0(o, vb0 + (int)SHM_V, pa0, pa1, pa2, pa3); partialSM(pA0, pA1, m_reg, mnA, alA);
    __syncthreads(); SWAIT(); SWRITE(1, SO);
    RESC(alA); __syncthreads();
  }
  SBAR(); qkt(pB0, pB1, (bf16*)((char*)K_lds + SHM_K), qr, r32, hi);
  finishSM(pA0, pA1, alA, l_reg, pa0, pa1, pa2, pa3); SBAR();
  pv_d0(o, vb0, pa0, pa1, pa2, pa3); partialSM(pB0, pB1, m_reg, mnB, alB);
  __syncthreads(); RESC(alB);
  finishSM(pB0, pB1, alB, l_reg, pa0, pa1, pa2, pa3); SBAR();
  pv_d0(o, vb0 + (int)SHM_V, pa0, pa1, pa2, pa3);
  if (hi == 0) li_l[r32] = l_reg; asm volatile("s_waitcnt lgkmcnt(0)" ::: "memory");
  float rli[16];
#pragma unroll
  for (int r = 0; r < 16; ++r) rli[r] = __builtin_amdgcn_rcpf(li_l[crow(r, hi)]);
  TO* Ow = Ob + (long)(wid * QBLK) * LDO;
#pragma unroll
  for (int r = 0; r < 16; ++r) { int orow = crow(r, hi);
    for (int d0 = 0; d0 < 4; ++d0) { const float val = o[d0][r] * rli[r];
      if constexpr (sizeof(TO) == 4) Ow[(long)orow * LDO + d0 * 32 + r32] = val;
      else Ow[(long)orow * LDO + d0 * 32 + r32] = (TO)(cvtpk(val, val) & 0xffffu); } }
#undef SLOAD
#undef SWRITE
#undef SWAIT
#undef RESC
}

template <int WIN>
__device__ __forceinline__ void attn_banded_body(const bf16* __restrict__ Qp, const bf16* __restrict__ Kp, const bf16* __restrict__ Vp, const long rs, const int Lseq, const int P0,
                                                 const float m_init, const float l_init, bf16* __restrict__ Ob, const long os, float* __restrict__ Lp, const long ls, char* lds, const int tid) {
  const int wid = __builtin_amdgcn_readfirstlane(tid >> 6), lane = tid & 63, r32 = lane & 31, hi = lane >> 5;
  bf16* V_lds = (bf16*)lds; bf16* K_lds = (bf16*)(lds + 2 * SHM_V);
  float* wsf = (float*)(lds + 2 * SHM_V + 2 * SHM_K) + wid * 64; float* li_l = wsf; float* al_l = wsf + 32;
  float m_reg = m_init, l_reg = l_init; f32x16 o[4] = {}; bf16x8 qr[8];
  const bf16* Qw = Qp + (long)(P0 + wid * QBLK + r32) * rs + hi * 8;
#pragma unroll
  for (int d0 = 0; d0 < 8; ++d0) qr[d0] = *reinterpret_cast<const bf16x8*>(Qw + d0 * 16);
  const int sr = tid >> 4, sc = (tid & 15) * 8, vst0 = v_st(sr, sc), vst1 = v_st(32 + sr, sc);
  const int vb0 = (int)(uintptr_t)V_lds + v_rd_base(lane);
  constexpr int NT = (256 + 2 * WIN) / 64, NTW = (2 * WIN + 32 + 63) / 64;
  const int klo = wid >> 1, qpos = P0 + wid * QBLK + r32;
  for (int k = 0; k < NT; ++k) {
    const int tb = P0 - WIN + 64 * k;
    if (tb < 0 || tb >= Lseq) continue;
    __syncthreads();
    { const bf16x8 v0 = *reinterpret_cast<const bf16x8*>(Vp + (long)(tb + sr) * rs + sc), v1 = *reinterpret_cast<const bf16x8*>(Vp + (long)(tb + 32 + sr) * rs + sc);
      const bf16x8 k0 = *reinterpret_cast<const bf16x8*>(Kp + (long)(tb + sr) * rs + sc), k1 = *reinterpret_cast<const bf16x8*>(Kp + (long)(tb + 32 + sr) * rs + sc);
      *(bf16x8*)((char*)V_lds + vst0) = v0; *(bf16x8*)((char*)V_lds + vst1) = v1;
      *(bf16x8*)((char*)K_lds + KSWZ(sr, sc * 2)) = k0; *(bf16x8*)((char*)K_lds + KSWZ(32 + sr, sc * 2)) = k1; }
    __syncthreads();
    if (k >= klo && k < klo + NTW) {
      f32x16 p0, p1; float mn, al; bf16x8 pa0, pa1, pa2, pa3;
      qkt(p0, p1, K_lds, qr, r32, hi);
      if (k == klo || k == klo + NTW - 1) {
#pragma unroll
        for (int r = 0; r < 16; ++r) { const int d = qpos - (tb + crow(r, hi));
          if (d > WIN || d < -WIN) p0[r] = -1e30f;
          if (d - 32 > WIN || d - 32 < -WIN) p1[r] = -1e30f; }
      }
      partialSM(p0, p1, m_reg, mn, al);
      if (__any(al < 1.f)) { if (hi == 0) al_l[r32] = al; asm volatile("s_waitcnt lgkmcnt(0)" ::: "memory");
#pragma unroll
        for (int d = 0; d < 4; ++d)
#pragma unroll
          for (int r = 0; r < 16; ++r) o[d][r] *= al_l[crow(r, hi)]; }
      finishSM(p0, p1, al, l_reg, pa0, pa1, pa2, pa3); SBAR();
      pv_d0(o, vb0, pa0, pa1, pa2, pa3);
    }
  }
  if (hi == 0) li_l[r32] = l_reg; asm volatile("s_waitcnt lgkmcnt(0)" ::: "memory");
  float rli[16];
#pragma unroll
  for (int r = 0; r < 16; ++r) rli[r] = __builtin_amdgcn_rcpf(li_l[crow(r, hi)]);
  bf16* Ow = Ob + (long)(P0 + wid * QBLK) * os;
#pragma unroll
  for (int r = 0; r < 16; ++r) { const int orow = crow(r, hi);
#pragma unroll
    for (int d0 = 0; d0 < 4; ++d0) { const float val = o[d0][r] * rli[r]; Ow[(long)orow * os + d0 * 32 + r32] = (bf16)(cvtpk(val, val) & 0xffffu); } }
  if (Lp != nullptr && hi == 0) Lp[(long)(P0 + wid * QBLK + r32) * ls] = m_reg * SCALE + __logf(l_reg);
}
}
typedef unsigned short bf16_t;
typedef unsigned u32x4v __attribute__((ext_vector_type(4)));
#define LDSA __attribute__((address_space(3)))
constexpr size_t al256(size_t x) { return (x + 255) / 256 * 256; }
constexpr size_t WS_CTL  = 0;
constexpr size_t CTL_BYTES = 65536;
constexpr size_t WS_XB   = WS_CTL + CTL_BYTES;
constexpr size_t WS_WAB  = WS_XB + (size_t)SEQ * DM * 2;
constexpr size_t WS_WOAB = WS_WAB + (size_t)12288 * 4096 * 2;
constexpr size_t WS_WCD  = WS_WOAB + (size_t)4096 * 3072 * 2;
constexpr size_t WS_WOCD = WS_WCD + (size_t)9216 * 4096 * 2;
constexpr size_t WS_WQ   = WS_WOCD + (size_t)4096 * 4096 * 2;
constexpr size_t WS_UB   = WS_WQ + (size_t)2 * 2048 * 4096 * 2;
constexpr size_t WS_VB   = WS_UB + (size_t)2 * 16384 * 4096;
constexpr size_t WS_SU   = WS_VB + (size_t)2 * 16384 * 4096;
constexpr size_t WS_SV   = WS_SU + (size_t)2 * 16384 * 4;
constexpr size_t WS_H    = WS_SV + (size_t)2 * 16384 * 4;
constexpr size_t WS_Y    = WS_H;
constexpr size_t WS_PQ   = WS_H + (size_t)SEQ * 4096 * 4;
constexpr size_t WS_OC   = WS_H + (size_t)SEQ * 12288 * 4;
constexpr size_t WS_AB   = WS_OC + (size_t)2 * SEQ * 2048 * 4;
constexpr size_t WS_X1   = WS_AB + (size_t)SEQ * 4096 * 2;
constexpr size_t WS_X1B  = WS_X1 + (size_t)SEQ * 4096 * 4;
constexpr size_t WS_X2   = WS_X1B + (size_t)SEQ * 4096 * 2;
constexpr size_t WS_X2B  = WS_X2 + (size_t)SEQ * 4096 * 4;
constexpr size_t WS_EIDX = WS_X2B + (size_t)SEQ * 4096 * 2;
constexpr size_t WS_GATE = WS_EIDX + (size_t)SEQ * 128 * 4;
constexpr size_t WS_HB   = WS_GATE + (size_t)SEQ * 128 * 4;
constexpr size_t WS_KEYB = WS_HB + (size_t)SEQ * 12288 * 2;
constexpr size_t WS_END  = WS_KEYB + (size_t)2 * 8 * 2 * 128 * 128 * 2;
static_assert(WS_END <= (size_t)2147483648ull, "workspace");

constexpr int LDS_BYTES = 147456;
constexpr int LDS_MISC = 131072;

struct MK { const float* in[21]; float* out; unsigned char* ws; int ph_lo, ph_hi; };

namespace pg8 {
struct EpiF32R {
    static constexpr bool PERM = false, AFTER_DRAIN = false;
    float* C; int ldc; const float* R; float ralpha;
    __device__ __forceinline__ void operator()(const f32x4 (&acc)[2][2][4][2], const Unit& u, int wr, int wc, int fr, int fq) const {
        const int row0 = u.pm * BM + wr * 64 + fr, col0 = u.pn * BM + wc * 32 + 4 * fq;
#pragma unroll
        for (int ai = 0; ai < 2; ++ai)
#pragma unroll
            for (int m = 0; m < 4; ++m) { const size_t off = (size_t)(row0 + ai * HALF + m * 16) * ldc + col0;
#pragma unroll
                for (int bj = 0; bj < 2; ++bj)
#pragma unroll
                    for (int n = 0; n < 2; ++n) { f32x4 v = acc[ai][bj][m][n];
                        if (R) { const f32x4 r = *(const f32x4*)(R + off + bj * HALF + n * 16); v += r * ralpha; }
                        *(f32x4*)(C + off + bj * HALF + n * 16) = v; } }
    }
};
struct EpiBf16P {
    static constexpr bool PERM = true, AFTER_DRAIN = false;
    bf16_t* O; int ldc;
    __device__ __forceinline__ void operator()(const f32x4 (&acc)[2][2][4][2], const Unit& u, int wr, int wc, int fr, int fq) const {
        const int row0 = u.pm * BM + wr * 64 + fr, col0 = u.pn * BM + wc * 32 + 8 * fq;
#pragma unroll
        for (int ai = 0; ai < 2; ++ai)
#pragma unroll
            for (int m = 0; m < 4; ++m) { bf16_t* rowp = O + (size_t)(row0 + ai * HALF + m * 16) * ldc + col0;
#pragma unroll
                for (int bj = 0; bj < 2; ++bj) { const f32x4 v0 = acc[ai][bj][m][0], v1 = acc[ai][bj][m][1];
                    u32x4 w; w.x = cvt_pk_bf16(v0[0], v0[1]); w.y = cvt_pk_bf16(v0[2], v0[3]); w.z = cvt_pk_bf16(v1[0], v1[1]); w.w = cvt_pk_bf16(v1[2], v1[3]);
                    *(u32x4*)(rowp + bj * HALF) = w; } }
    }
};
}

__device__ __forceinline__ float bf_lo(unsigned w) { return __uint_as_float(w << 16); }
__device__ __forceinline__ float bf_hi(unsigned w) { return __uint_as_float(w & 0xffff0000u); }
__device__ __forceinline__ unsigned cvtpk_bf16(float lo, float hi) { unsigned r; asm volatile("v_cvt_pk_bf16_f32 %0, %1, %2" : "=v"(r) : "v"(lo), "v"(hi)); return r; }

__device__ __forceinline__ void cvt_rows_bf16(const float* __restrict__ src, bf16_t* __restrict__ dst, size_t n8, int bid, int nb, int tid, int nthr) {
    for (size_t i = (size_t)bid * nthr + tid; i < n8; i += (size_t)nb * nthr) {
        const float4 a = *(const float4*)(src + i * 8), b = *(const float4*)(src + i * 8 + 4);
        u32x4v w; w.x = cvtpk_bf16(a.x, a.y); w.y = cvtpk_bf16(a.z, a.w); w.z = cvtpk_bf16(b.x, b.y); w.w = cvtpk_bf16(b.z, b.w);
        *(u32x4v*)(dst + i * 8) = w;
    }
}
template <class PM>
__device__ __forceinline__ void transpose_cvt(const float* __restrict__ W, bf16_t* __restrict__ Wt, int K, int N, LDSA float* tile, int bid, int nb, PM pm, const int tid) {
    const int ntk = K / 64, ntn = N / 64;
    for (int t = bid; t < ntk * ntn; t += nb) {
        const int k0 = (t % ntk) * 64, n0 = (t / ntk) * 64;
        __syncthreads();
#pragma unroll
        for (int i = 0; i < 2; ++i) { const int r = (tid >> 4) + 32 * i, c = (tid & 15) * 4;
            const float4 v = *(const float4*)(W + (size_t)(k0 + r) * N + n0 + c);
            tile[r * 65 + c] = v.x; tile[r * 65 + c + 1] = v.y; tile[r * 65 + c + 2] = v.z; tile[r * 65 + c + 3] = v.w; }
        __syncthreads();
        const int mode = pm(n0);
        const int n = tid >> 3, kc = (tid & 7) * 8;
        int src = n;
        if (mode == 1) { if (n < 32) src = (n >> 1) + 16 * (n & 1); }
        else if (mode == 2) src = (n >> 1) + 32 * (n & 1);
        float f[8];
#pragma unroll
        for (int j = 0; j < 8; ++j) f[j] = tile[(kc + j) * 65 + src];
        u32x4v w; w.x = cvtpk_bf16(f[0], f[1]); w.y = cvtpk_bf16(f[2], f[3]); w.z = cvtpk_bf16(f[4], f[5]); w.w = cvtpk_bf16(f[6], f[7]);
        *(u32x4v*)(Wt + (size_t)(n0 + n) * K + k0 + kc) = w;
    }
}
struct PermNone { __device__ __forceinline__ int operator()(int) const { return 0; } };


typedef float f32x2v __attribute__((ext_vector_type(2)));
__device__ __forceinline__ void table_fp8(const float* __restrict__ src, unsigned char* __restrict__ dst, float* __restrict__ inv, const int rows, const int bid, const int G, const int tid) {
    const int lane = tid & 63, wv = tid >> 6;
    for (int r = bid * 8 + wv; r < rows; r += G * 8) {
        float4 v[16]; float am = 0.f;
#pragma unroll
        for (int i = 0; i < 16; ++i) { v[i] = *(const float4*)(src + (size_t)r * DM + i * 256 + lane * 4); am = fmaxf(am, fmaxf(fmaxf(fabsf(v[i].x), fabsf(v[i].y)), fmaxf(fabsf(v[i].z), fabsf(v[i].w)))); }
        am = wave_max(am);
        const float sc = am > 0.f ? 440.0f / am : 1.0f;
#pragma unroll
        for (int i = 0; i < 16; ++i) { int w = 0;
            w = __builtin_amdgcn_cvt_pk_fp8_f32(v[i].x * sc, v[i].y * sc, w, false);
            w = __builtin_amdgcn_cvt_pk_fp8_f32(v[i].z * sc, v[i].w * sc, w, true);
            *(int*)(dst + (size_t)r * DM + i * 256 + lane * 4) = w; }
        if (lane == 0) inv[r] = am > 0.f ? am * (1.0f / 440.0f) : 1.0f;
    }
}

__device__ __forceinline__ float gelu_tanh_f(float x) {
    const float z = 0.7978845608028654f * (x + 0.044715f * x * x * x);
    const float e = __expf(2.0f * z);
    return 0.5f * x * (2.0f - 2.0f / (e + 1.0f));
}
__device__ __forceinline__ int pick_i(int a0, int a1, int k) { return k < 64 ? __builtin_amdgcn_readlane(a0, k) : __builtin_amdgcn_readlane(a1, k - 64); }
__device__ __forceinline__ float pick_f(float a0, float a1, int k) { return __int_as_float(pick_i(__float_as_int(a0), __float_as_int(a1), k)); }
#define PE_LOADROW(dst, base, e) do { const unsigned char* _p = (base) + (size_t)(e) * DM + lane * 16; _Pragma("unroll") for (int _i = 0; _i < 4; ++_i) dst[_i] = *(const u32x4v*)(_p + _i * 1024); } while (0)
__device__ __forceinline__ void pe_cvt4(const unsigned w, float& a, float& b, float& c, float& d) {
    const f32x2v lo = __builtin_amdgcn_cvt_pk_f32_fp8((int)w, false), hi = __builtin_amdgcn_cvt_pk_f32_fp8((int)w, true);
    a = lo.x; b = lo.y; c = hi.x; d = hi.y;
}
__device__ __forceinline__ float pe_dot(const u32x4v (&r)[4], const float4 (&x)[16]) {
    float d0 = 0.f, d1 = 0.f, d2 = 0.f, d3 = 0.f;
#pragma unroll
    for (int i = 0; i < 4; ++i) {
        const unsigned q[4] = {r[i].x, r[i].y, r[i].z, r[i].w};
#pragma unroll
        for (int j = 0; j < 4; ++j) { float a, b, c, d; pe_cvt4(q[j], a, b, c, d);
            d0 = fmaf(a, x[i * 4 + j].x, d0); d1 = fmaf(b, x[i * 4 + j].y, d1); d2 = fmaf(c, x[i * 4 + j].z, d2); d3 = fmaf(d, x[i * 4 + j].w, d3); }
        asm volatile("" : "+v"(d0), "+v"(d1), "+v"(d2), "+v"(d3));
    }
    return wave_sum((d0 + d1) + (d2 + d3));
}
__device__ __forceinline__ void pe_axpy(float (&acc)[64], const u32x4v (&r)[4], const float w) {
#pragma unroll
    for (int i = 0; i < 4; ++i) {
        const unsigned q[4] = {r[i].x, r[i].y, r[i].z, r[i].w};
#pragma unroll
        for (int j = 0; j < 4; ++j) { float a, b, c, d; pe_cvt4(q[j], a, b, c, d);
            acc[i * 16 + j * 4 + 0] = fmaf(w, a, acc[i * 16 + j * 4 + 0]); acc[i * 16 + j * 4 + 1] = fmaf(w, b, acc[i * 16 + j * 4 + 1]);
            acc[i * 16 + j * 4 + 2] = fmaf(w, c, acc[i * 16 + j * 4 + 2]); acc[i * 16 + j * 4 + 3] = fmaf(w, d, acc[i * 16 + j * 4 + 3]); }
        asm volatile("" : "+v"(acc[i * 16 + 0]), "+v"(acc[i * 16 + 1]), "+v"(acc[i * 16 + 2]), "+v"(acc[i * 16 + 3]), "+v"(acc[i * 16 + 4]), "+v"(acc[i * 16 + 5]), "+v"(acc[i * 16 + 6]), "+v"(acc[i * 16 + 7]),
                           "+v"(acc[i * 16 + 8]), "+v"(acc[i * 16 + 9]), "+v"(acc[i * 16 + 10]), "+v"(acc[i * 16 + 11]), "+v"(acc[i * 16 + 12]), "+v"(acc[i * 16 + 13]), "+v"(acc[i * 16 + 14]), "+v"(acc[i * 16 + 15]));
    }
}
__device__ __forceinline__ void peer_expert_phase(const float* __restrict__ x1, const int* __restrict__ eidx, const float* __restrict__ gate,
                                                  const unsigned char* __restrict__ ub, const unsigned char* __restrict__ vb, const float* __restrict__ isu, const float* __restrict__ isv,
                                                  const float* __restrict__ lg, const float* __restrict__ lb, float* __restrict__ out, bf16_t* __restrict__ outb, const int bid, const int G, const int tid) {
    const int lane = tid & 63, wv = __builtin_amdgcn_readfirstlane(tid >> 6);
    for (int t = bid * 8 + wv; t < SEQ; t += G * 8) {
        const int e0 = eidx[(size_t)t * 128 + lane], e1 = eidx[(size_t)t * 128 + 64 + lane];
        const float g0 = gate[(size_t)t * 128 + lane], g1 = gate[(size_t)t * 128 + 64 + lane];
        const float iu0 = isu[e0], iu1 = isu[e1], iv0 = isv[e0], iv1 = isv[e1];
        float4 xf[16];
#pragma unroll
        for (int i = 0; i < 4; ++i)
#pragma unroll
            for (int j = 0; j < 4; ++j) xf[i * 4 + j] = *(const float4*)(x1 + (size_t)t * DM + i * 1024 + lane * 16 + j * 4);
        float w0 = 0.f, w1 = 0.f;
        u32x4v R0[4], R1[4], R2[4], R3[4];
#define PE_E(k) pick_i(e0, e1, (k) < 128 ? (k) : 127)
#define PE_USTEP(R, k) do { const float d = pe_dot(R, xf) * pick_f(iu0, iu1, (k)); const float w = pick_f(g0, g1, (k)) * gelu_tanh_f(d) * pick_f(iv0, iv1, (k)); \
            if (lane == ((k) & 63)) { if ((k) < 64) w0 = w; else w1 = w; } } while (0)
        PE_LOADROW(R0, ub, PE_E(0)); PE_LOADROW(R1, ub, PE_E(1)); PE_LOADROW(R2, ub, PE_E(2));
        for (int k = 0; k < 128; k += 4) {
            PE_LOADROW(R3, ub, PE_E(k + 3)); PE_USTEP(R0, k);
            PE_LOADROW(R0, ub, PE_E(k + 4)); PE_USTEP(R1, k + 1);
            PE_LOADROW(R1, ub, PE_E(k + 5)); PE_USTEP(R2, k + 2);
            PE_LOADROW(R2, ub, PE_E(k + 6)); PE_USTEP(R3, k + 3);
        }
        float acc[64];
#pragma unroll
        for (int i = 0; i < 64; ++i) acc[i] = 0.f;
        PE_LOADROW(R0, vb, PE_E(0)); PE_LOADROW(R1, vb, PE_E(1)); PE_LOADROW(R2, vb, PE_E(2));
        for (int k = 0; k < 128; k += 4) {
            PE_LOADROW(R3, vb, PE_E(k + 3)); pe_axpy(acc, R0, pick_f(w0, w1, k));
            PE_LOADROW(R0, vb, PE_E(k + 4)); pe_axpy(acc, R1, pick_f(w0, w1, k + 1));
            PE_LOADROW(R1, vb, PE_E(k + 5)); pe_axpy(acc, R2, pick_f(w0, w1, k + 2));
            PE_LOADROW(R2, vb, PE_E(k + 6)); pe_axpy(acc, R3, pick_f(w0, w1, k + 3));
        }
#undef PE_E
#undef PE_USTEP
        float s = 0.f;
        { const float* xr = x1 + (size_t)t * DM; asm volatile("" : "+s"(xr));
#pragma unroll
          for (int i = 0; i < 16; ++i) {
            const float4 xv = *(const float4*)(xr + (i >> 2) * 1024 + lane * 16 + (i & 3) * 4);
            acc[i * 4 + 0] = fmaf(ALPHA, xv.x, acc[i * 4 + 0]); acc[i * 4 + 1] = fmaf(ALPHA, xv.y, acc[i * 4 + 1]); acc[i * 4 + 2] = fmaf(ALPHA, xv.z, acc[i * 4 + 2]); acc[i * 4 + 3] = fmaf(ALPHA, xv.w, acc[i * 4 + 3]);
            s += (acc[i * 4 + 0] + acc[i * 4 + 1]) + (acc[i * 4 + 2] + acc[i * 4 + 3]);
            if ((i & 3) == 3) asm volatile("" ::: "memory");
          } }
        const float mean = wave_sum(s) * (1.0f / DM);
        float qq = 0.f;
#pragma unroll
        for (int i = 0; i < 64; ++i) { const float d = acc[i] - mean; qq = fmaf(d, d, qq); }
        const float rstd = 1.0f / sqrtf(wave_sum(qq) * (1.0f / DM) + 1e-5f);
#pragma unroll
        for (int i = 0; i < 4; ++i) {
#pragma unroll
            for (int j = 0; j < 4; ++j) {
                const int c = i * 1024 + lane * 16 + j * 4, a0 = i * 16 + j * 4;
                const float4 ga = *(const float4*)(lg + c), ba = *(const float4*)(lb + c);
                float4 oa;
                oa.x = (acc[a0 + 0] - mean) * rstd * ga.x + ba.x; oa.y = (acc[a0 + 1] - mean) * rstd * ga.y + ba.y; oa.z = (acc[a0 + 2] - mean) * rstd * ga.z + ba.z; oa.w = (acc[a0 + 3] - mean) * rstd * ga.w + ba.w;
                *(float4*)(out + (size_t)t * DM + c) = oa;
                if (outb) { uint2 w; w.x = cvtpk_bf16(oa.x, oa.y); w.y = cvtpk_bf16(oa.z, oa.w); *(uint2*)(outb + (size_t)t * DM + c) = w; }
            }
            asm volatile("" ::: "memory");
        }
    }
}

__device__ __forceinline__ void attn1_phase(const bf16_t* __restrict__ hb, bf16_t* __restrict__ abb, float* __restrict__ oc, char* lds, const int bid, const int G, const int tid) {
    for (int u = bid; u < 512; u += G) {
        __syncthreads();
        const int kv = u >> 7, g = (u >> 5) & 3, qb = u & 31, hq = kv * 4 + g;
        att::attn_dense_body<att::bf16, 9216, 9216, 4096, att::bf16>(hb + (size_t)(qb * 256) * 9216 + 6144 + hq * 128, hb + 8192 + kv * 128, hb + 8704 + kv * 128,
                                                                       abb + (size_t)(qb * 256) * 4096 + 2048 + hq * 128, SEQ, lds, tid);
    }
    for (int v = bid; v < 1024; v += G) {
        __syncthreads();
        const int hm = v >> 6, vh = (v >> 5) & 1, qb = v & 31, h = hm >> 1, map = hm & 1;
        att::attn_dense_body<att::bf16, 9216, 9216, 2048, float>(hb + (size_t)(qb * 256) * 9216 + h * 256 + map * 128, hb + 2048 + h * 256 + map * 128, hb + 4096 + h * 256 + vh * 128,
                                                                   oc + (size_t)map * SEQ * 2048 + (size_t)(qb * 256) * 2048 + h * 256 + vh * 128, SEQ, lds, tid);
    }
}


__device__ __forceinline__ void attn0_phase(const bf16_t* __restrict__ hb, const float* __restrict__ sink, bf16_t* __restrict__ abb, bf16_t* __restrict__ obg, float* __restrict__ lse, char* lds, const int bid, const int G, const int tid) {
    const long LD = 12288;
    for (int u = bid; u < 512; u += G) {
        __syncthreads();
        const int hq = u >> 5, qb = u & 31, kv = hq >> 2;
        att::attn_banded_body<128>(hb + hq * 128, hb + 2048 + kv * 128, hb + 2560 + kv * 128, LD, SEQ, qb * 256, sink[hq] * (1.0f / att::SCALE), 1.0f, abb + hq * 128, 3072, nullptr, 0, lds, tid);
    }
    for (int v = bid; v < 768; v += G) {
        __syncthreads();
        const int g = v >> 8, w = v & 255, h = w >> 5, rem = w & 31;
        const int dsh = 2 * g;
        const int nqb_sh = 5 - dsh;
        const int r = rem >> nqb_sh, qb = rem & ((1 << nqb_sh) - 1);
        const int head = 8 * g + h;
        const long rs = LD << dsh;
        att::attn_banded_body<64>(hb + (long)r * LD + 3072 + head * 128, hb + (long)r * LD + 6144 + head * 128, hb + (long)r * LD + 9216 + head * 128, rs, SEQ >> dsh, qb * 256, -1e30f, 0.f,
                                  obg + ((long)(g * 8 + h) * SEQ + r) * 128, (long)128 << dsh, lse + (long)(g * 8 + h) * SEQ + r, (long)1 << dsh, lds, tid);
    }
}
__device__ __forceinline__ void merge0_phase(const bf16_t* __restrict__ obg, const float* __restrict__ lse, bf16_t* __restrict__ abb, const int bid, const int G, const int tid) {
    const int lane = tid & 63, wv = tid >> 6;
    for (int j = bid * 8 + wv; j < SEQ * 8; j += G * 8) {
        const int h = j >> 13, t = j & (SEQ - 1);
        const float l0 = lse[(size_t)(0 * 8 + h) * SEQ + t], l1 = lse[(size_t)(1 * 8 + h) * SEQ + t], l2 = lse[(size_t)(2 * 8 + h) * SEQ + t];
        const float mx = fmaxf(l0, fmaxf(l1, l2));
        const float e0 = __expf(l0 - mx), e1 = __expf(l1 - mx), e2 = __expf(l2 - mx), inv = 1.0f / (e0 + e1 + e2);
        const unsigned a0 = *(const unsigned*)(obg + ((size_t)(0 * 8 + h) * SEQ + t) * 128 + 2 * lane), a1 = *(const unsigned*)(obg + ((size_t)(1 * 8 + h) * SEQ + t) * 128 + 2 * lane), a2 = *(const unsigned*)(obg + ((size_t)(2 * 8 + h) * SEQ + t) * 128 + 2 * lane);
        const float x = (e0 * bf_lo(a0) + e1 * bf_lo(a1) + e2 * bf_lo(a2)) * inv, y = (e0 * bf_hi(a0) + e1 * bf_hi(a1) + e2 * bf_hi(a2)) * inv;
        *(unsigned*)(abb + (size_t)t * 3072 + 2048 + h * 128 + 2 * lane) = cvtpk_bf16(x, y);
    }
}

__device__ __forceinline__ void post_even_phase(const float* __restrict__ h, bf16_t* __restrict__ hb, const int bid, const int G, const int tid) {
    const int lane = tid & 63, wv = tid >> 6;
    for (int job = bid * 8 + wv; job < SEQ * 96; job += G * 8) {
        const int t = job / 96, blk = job - t * 96;
        const bool rope = (blk < 20) || (blk >= 24 && blk < 72);
        const float2 v = *(const float2*)(h + (size_t)t * 12288 + blk * 128 + 2 * lane);
        float o0 = v.x, o1 = v.y;
        const float p0 = __shfl_xor(v.x, 8), p1 = __shfl_xor(v.y, 8);
        if (rope && lane < 16) {
            const int i0 = (2 * lane) & 15;
            float s0, c0, s1, c1; sincos_rev((double)t * REV_P[i0], s0, c0); sincos_rev((double)t * REV_P[i0 + 1], s1, c1);
            if (lane < 8) { o0 = v.x * c0 - p0 * s0; o1 = v.y * c1 - p1 * s1; }
            else          { o0 = v.x * c0 + p0 * s0; o1 = v.y * c1 + p1 * s1; }
        }
        *(unsigned*)(hb + (size_t)t * 12288 + blk * 128 + 2 * lane) = cvtpk_bf16(o0, o1);
    }
}
__device__ __forceinline__ void post_odd_phase(const float* __restrict__ h, bf16_t* __restrict__ hb, const float* __restrict__ qg, const float* __restrict__ kg, const int bid, const int G, const int tid) {
    const int lane = tid & 63, wv = tid >> 6;
    for (int job = bid * 8 + wv; job < SEQ * 72; job += G * 8) {
        const int t = job / 72, blk = job - t * 72;
        const float2 v = *(const float2*)(h + (size_t)t * 9216 + blk * 128 + 2 * lane);
        float o0 = v.x, o1 = v.y;
        if (blk < 32) {
            const float p0 = __shfl_xor(v.x, 8), p1 = __shfl_xor(v.y, 8);
            if (lane < 16) {
                const int i0 = (2 * lane) & 15;
                float s0, c0, s1, c1; sincos_rev((double)t * REV_P[i0], s0, c0); sincos_rev((double)t * REV_P[i0 + 1], s1, c1);
                if (lane < 8) { o0 = v.x * c0 - p0 * s0; o1 = v.y * c1 - p1 * s1; }
                else          { o0 = v.x * c0 + p0 * s0; o1 = v.y * c1 + p1 * s1; }
            }
        } else if (blk >= 48 && blk < 68) {
            const float* g = blk < 64 ? qg : kg;
            const float ss = wave_sum(v.x * v.x + v.y * v.y) * (1.0f / 128.0f);
            const float rs = 1.0f / sqrtf(ss + 1e-6f);
            const float a0 = v.x * rs * g[2 * lane], a1 = v.y * rs * g[2 * lane + 1];
            const float p0 = __shfl_xor(a0, 16), p1 = __shfl_xor(a1, 16);
            const int i0 = (2 * lane) & 31;
            const double pos = (double)(lane < 32 ? (t >> 6) : (t & 63));
            float s0, c0, s1, c1; sincos_rev(pos * REV_A[i0], s0, c0); sincos_rev(pos * REV_A[i0 + 1], s1, c1);
            if ((lane & 16) == 0) { o0 = a0 * c0 - p0 * s0; o1 = a1 * c1 - p1 * s1; }
            else                  { o0 = a0 * c0 + p0 * s0; o1 = a1 * c1 + p1 * s1; }
        }
        *(unsigned*)(hb + (size_t)t * 9216 + blk * 128 + 2 * lane) = cvtpk_bf16(o0, o1);
    }
}

__device__ __forceinline__ void attn_seg_b(const float q0, const float q1, const bf16_t* __restrict__ Kb, const bf16_t* __restrict__ Vb, const int ld,
                                           const int t, const int step, int jlo, int jhi, float& m, float& l, float& o0, float& o1, const int lane) {
    { const int lo = -(t / step); if (jlo < lo) jlo = lo; const int hi = (SEQ - 1 - t) / step; if (jhi > hi) jhi = hi; }
    for (int j = jlo; j <= jhi; ++j) {
        const size_t tp = (size_t)(t + step * j);
        const unsigned kw = *(const unsigned*)(Kb + tp * ld + 2 * lane), vw = *(const unsigned*)(Vb + tp * ld + 2 * lane);
        const float s = wave_sum(q0 * bf_lo(kw) + q1 * bf_hi(kw)) * ATT_SCALE;
        const float mn = fmaxf(m, s);
        const float al = __expf(m - mn), p = __expf(s - mn);
        l = l * al + p;
        o0 = o0 * al + p * bf_lo(vw); o1 = o1 * al + p * bf_hi(vw);
        m = mn;
    }
}
__device__ __forceinline__ void attn_even_valu_phase(const bf16_t* __restrict__ hb, const float* __restrict__ sink, bf16_t* __restrict__ abb, const int bid, const int G, const int tid) {
    const int lane = tid & 63, wv = tid >> 6;
    const int LD = 12288;
    for (int job = bid * 8 + wv; job < SEQ * 24; job += G * 8) {
        const int hh = job / SEQ, t = job % SEQ;
        float o0 = 0.f, o1 = 0.f, m, l;
        if (hh < 16) {
            const int kv = hh >> 2;
            const unsigned qw = *(const unsigned*)(hb + (size_t)t * LD + hh * 128 + 2 * lane);
            m = sink[hh]; l = 1.f;
            attn_seg_b(bf_lo(qw), bf_hi(qw), hb + 2048 + kv * 128, hb + 2560 + kv * 128, LD, t, 1, -128, 128, m, l, o0, o1, lane);
        } else {
            const int hbh = hh - 16;
            m = -1e30f; l = 0.f;
#pragma unroll
            for (int g = 0; g < 3; ++g) {
                const int head = 8 * g + hbh; const int step = g == 0 ? 1 : (g == 1 ? 4 : 16);
                const unsigned qw = *(const unsigned*)(hb + (size_t)t * LD + 3072 + head * 128 + 2 * lane);
                attn_seg_b(bf_lo(qw), bf_hi(qw), hb + 6144 + head * 128, hb + 9216 + head * 128, LD, t, step, -64, 64, m, l, o0, o1, lane);
            }
        }
        const float il = 1.0f / l;
        *(unsigned*)(abb + (size_t)t * 3072 + hh * 128 + 2 * lane) = cvtpk_bf16(o0 * il, o1 * il);
    }
}

__device__ __forceinline__ void ln_phase(const float* __restrict__ y, const float* __restrict__ g, const float* __restrict__ b, float* __restrict__ out, bf16_t* __restrict__ outb, const int bid, const int G, const int tid) {
    const int lane = tid & 63, wv = tid >> 6;
    for (int t = bid * 8 + wv; t < SEQ; t += G * 8) {
        float4 v[16]; float s = 0.f;
#pragma unroll
        for (int i = 0; i < 16; ++i) { v[i] = *(const float4*)(y + (size_t)t * DM + i * 256 + lane * 4); s += (v[i].x + v[i].y) + (v[i].z + v[i].w); }
        const float mean = wave_sum(s) * (1.0f / DM);
        float q = 0.f;
#pragma unroll
        for (int i = 0; i < 16; ++i) { const float a = v[i].x - mean, bb = v[i].y - mean, c = v[i].z - mean, d = v[i].w - mean; q += (a * a + bb * bb) + (c * c + d * d); }
        const float rstd = 1.0f / sqrtf(wave_sum(q) * (1.0f / DM) + 1e-5f);
#pragma unroll
        for (int i = 0; i < 16; ++i) {
            const float4 gg = *(const float4*)(g + i * 256 + lane * 4), bb = *(const float4*)(b + i * 256 + lane * 4);
            float4 o; o.x = (v[i].x - mean) * rstd * gg.x + bb.x; o.y = (v[i].y - mean) * rstd * gg.y + bb.y; o.z = (v[i].z - mean) * rstd * gg.z + bb.z; o.w = (v[i].w - mean) * rstd * gg.w + bb.w;
            *(float4*)(out + (size_t)t * DM + i * 256 + lane * 4) = o;
            uint2 w; w.x = cvtpk_bf16(o.x, o.y); w.y = cvtpk_bf16(o.z, o.w); *(uint2*)(outb + (size_t)t * DM + i * 256 + lane * 4) = w;
            if ((i & 3) == 3) asm volatile("" ::: "memory");
        }
    }
}

__device__ __forceinline__ void route_valu_phase(const float* __restrict__ q  , const float* __restrict__ keys  , int* __restrict__ eidx, float* __restrict__ gate, const int bid, const int G, const int tid) {
    const int lane = tid & 63, wv = tid >> 6;
    for (int job = bid * 8 + wv; job < SEQ * 8; job += G * 8) {
        const int hh = job & 7, t = job >> 3;
        float sv0 = 0.f, sv1 = 0.f; int si0 = 0, si1 = 0;
#pragma unroll
        for (int c = 0; c < 2; ++c) {
            const float* qq = q + (size_t)t * 2048 + hh * 256 + c * 128;
            const float* k0 = keys + ((size_t)(hh * 2 + c) * 128 + lane) * 128;
            const float* k1 = k0 + 64 * 128;
            float s0 = 0.f, s1 = 0.f;
            for (int d = 0; d < 128; d += 4) {
                const float4 qv = *(const float4*)(qq + d), a = *(const float4*)(k0 + d), b = *(const float4*)(k1 + d);
                s0 += qv.x * a.x + qv.y * a.y + qv.z * a.z + qv.w * a.w;
                s1 += qv.x * b.x + qv.y * b.y + qv.z * b.z + qv.w * b.w;
            }
            float myv = 0.f; int myi = 0;
            for (int k = 0; k < 16; ++k) {
                float bv; int bi;
                if (s1 > s0) { bv = s1; bi = lane + 64; } else { bv = s0; bi = lane; }
#pragma unroll
                for (int o = 32; o >= 1; o >>= 1) {
                    const float ov = __shfl_xor(bv, o); const int oi = __shfl_xor(bi, o);
                    if (ov > bv || (ov == bv && oi < bi)) { bv = ov; bi = oi; }
                }
                if (lane == k) { myv = bv; myi = bi; }
                if (bi == lane) s0 = -3.0e38f;
                if (bi == lane + 64) s1 = -3.0e38f;
            }
            if (c == 0) { sv0 = myv; si0 = myi; } else { sv1 = myv; si1 = myi; }
        }
        float cv0, cv1, cv2, cv3; int ci0, ci1, ci2, ci3;
        { const float a = __shfl(sv0, lane >> 2); const int ai = __shfl(si0, lane >> 2); const int jb = (lane & 3) * 4;
          cv0 = a + __shfl(sv1, jb + 0); ci0 = ai * 128 + __shfl(si1, jb + 0);
          cv1 = a + __shfl(sv1, jb + 1); ci1 = ai * 128 + __shfl(si1, jb + 1);
          cv2 = a + __shfl(sv1, jb + 2); ci2 = ai * 128 + __shfl(si1, jb + 2);
          cv3 = a + __shfl(sv1, jb + 3); ci3 = ai * 128 + __shfl(si1, jb + 3); }
        float tv = 0.f; int te = 0;
        for (int k = 0; k < 16; ++k) {
            float bv = cv0; int bp = lane * 4, be = ci0;
            if (cv1 > bv) { bv = cv1; bp = lane * 4 + 1; be = ci1; }
            if (cv2 > bv) { bv = cv2; bp = lane * 4 + 2; be = ci2; }
            if (cv3 > bv) { bv = cv3; bp = lane * 4 + 3; be = ci3; }
#pragma unroll
            for (int o = 32; o >= 1; o >>= 1) {
                const float ov = __shfl_xor(bv, o); const int op = __shfl_xor(bp, o); const int oe = __shfl_xor(be, o);
                if (ov > bv || (ov == bv && op < bp)) { bv = ov; bp = op; be = oe; }
            }
            if (lane == k) { tv = bv; te = be; }
            if (bp == lane * 4 + 0) cv0 = -3.0e38f;
            if (bp == lane * 4 + 1) cv1 = -3.0e38f;
            if (bp == lane * 4 + 2) cv2 = -3.0e38f;
            if (bp == lane * 4 + 3) cv3 = -3.0e38f;
        }
        const float v = lane < 16 ? tv : -3.0e38f;
        const float mx = wave_max(v);
        const float e = lane < 16 ? __expf(tv - mx) : 0.f;
        const float den = wave_sum(e);
        if (lane < 16) { eidx[(size_t)t * 128 + hh * 16 + lane] = te; gate[(size_t)t * 128 + hh * 16 + lane] = e / den; }
    }
}
namespace rt {
using att::f32x16; using att::bf16x8;
__device__ __forceinline__ float pair_max(float m) {
    auto rr = __builtin_amdgcn_permlane32_swap(__float_as_uint(m), __float_as_uint(m), false, false);
    return fmaxf(__uint_as_float(rr[0]), __uint_as_float(rr[1]));
}
__device__ __forceinline__ int pair_max_i(int m) {
    auto rr = __builtin_amdgcn_permlane32_swap((unsigned)m, (unsigned)m, false, false);
    const int a = (int)rr[0], b = (int)rr[1]; return a > b ? a : b;
}
__device__ __forceinline__ void top16_of_128(f32x16& p0, f32x16& p1, f32x16& p2, f32x16& p3, float (&t)[16]) {
#pragma unroll
    for (int k = 0; k < 16; ++k) {
        float m = p0[0];
#pragma unroll
        for (int r = 1; r < 16; ++r) m = fmaxf(m, p0[r]);
#pragma unroll
        for (int r = 0; r < 16; ++r) m = fmaxf(m, fmaxf(p1[r], fmaxf(p2[r], p3[r])));
        m = pair_max(m);
        t[k] = m;
#pragma unroll
        for (int r = 0; r < 16; ++r) { p0[r] = p0[r] == m ? -3.0e38f : p0[r]; p1[r] = p1[r] == m ? -3.0e38f : p1[r]; p2[r] = p2[r] == m ? -3.0e38f : p2[r]; p3[r] = p3[r] == m ? -3.0e38f : p3[r]; }
    }
}
__device__ __forceinline__ void tag_scores(f32x16& p, const int base, const int hi) {
#pragma unroll
    for (int r = 0; r < 16; ++r) p[r] = __uint_as_float((__float_as_uint(p[r]) & ~0x7Fu) | (unsigned)(base + att::crow(r, hi)));
}
}

__device__ __forceinline__ void route_mfma_phase(const bf16_t* __restrict__ pqb  , const bf16_t* __restrict__ keysb  , int* __restrict__ eidx, float* __restrict__ gate,
                                                 char* lds, const int bid, const int G, const int tid) {
    using namespace rt;
    const int wid = __builtin_amdgcn_readfirstlane(tid >> 6), lane = tid & 63, r32 = lane & 31, hi = lane >> 5;
    att::bf16* K_lds = (att::bf16*)lds;
    for (int u = bid; u < 256; u += G) {
        const int h = u & 7, tb = (u >> 3) * 256;
        const int tok = tb + wid * 32 + r32;
        float t0[16], t1[16];
#pragma unroll
        for (int c = 0; c < 2; ++c) {
            __syncthreads();
            { const bf16_t* kp = keysb + (size_t)(h * 2 + c) * 128 * 128;
              const int row = tid >> 2;
#pragma unroll
              for (int i = 0; i < 4; ++i) { const int sc = ((tid & 3) * 4 + i) * 8;
                  const bf16x8 v = *reinterpret_cast<const bf16x8*>(kp + row * 128 + sc);
                  *(bf16x8*)((char*)K_lds + (row >> 6) * 16384 + KSWZ(row & 63, sc * 2)) = v; } }
            bf16x8 qr[8];
            { const bf16_t* qw = pqb + (size_t)tok * 2048 + h * 256 + c * 128 + hi * 8;
#pragma unroll
              for (int d0 = 0; d0 < 8; ++d0) qr[d0] = *reinterpret_cast<const bf16x8*>(qw + d0 * 16); }
            __syncthreads();
            f32x16 p0, p1, p2, p3;
            att::qkt(p0, p1, K_lds, qr, r32, hi);
            att::qkt(p2, p3, (att::bf16*)((char*)K_lds + 16384), qr, r32, hi);
            tag_scores(p0, 0, hi); tag_scores(p1, 32, hi); tag_scores(p2, 64, hi); tag_scores(p3, 96, hi);
            if (c == 0) top16_of_128(p0, p1, p2, p3, t0); else top16_of_128(p0, p1, p2, p3, t1);
        }
        float v0[16], v1[16]; int k0[16], k1[16];
#pragma unroll
        for (int i = 0; i < 16; ++i) { const unsigned a = __float_as_uint(t0[i]), b = __float_as_uint(t1[i]);
            v0[i] = __uint_as_float(a & ~0x7Fu); v1[i] = __uint_as_float(b & ~0x7Fu); k0[i] = (int)((a & 0x7Fu) << 7); k1[i] = (int)(b & 0x7Fu); }
        float cv[25]; int ce[25];
    { const float s = hi ? (v0[0] + v1[1]) : (v0[0] + v1[0]); cv[0] = __uint_as_float((__float_as_uint(s) & ~0xFFu) | (unsigned)(2 * 0 + hi)); ce[0] = hi ? (k0[0] | k1[1]) : (k0[0] | k1[0]); }
    { const float s = hi ? (v0[0] + v1[3]) : (v0[0] + v1[2]); cv[1] = __uint_as_float((__float_as_uint(s) & ~0xFFu) | (unsigned)(2 * 1 + hi)); ce[1] = hi ? (k0[0] | k1[3]) : (k0[0] | k1[2]); }
    { const float s = hi ? (v0[0] + v1[5]) : (v0[0] + v1[4]); cv[2] = __uint_as_float((__float_as_uint(s) & ~0xFFu) | (unsigned)(2 * 2 + hi)); ce[2] = hi ? (k0[0] | k1[5]) : (k0[0] | k1[4]); }
    { const float s = hi ? (v0[0] + v1[7]) : (v0[0] + v1[6]); cv[3] = __uint_as_float((__float_as_uint(s) & ~0xFFu) | (unsigned)(2 * 3 + hi)); ce[3] = hi ? (k0[0] | k1[7]) : (k0[0] | k1[6]); }
    { const float s = hi ? (v0[0] + v1[9]) : (v0[0] + v1[8]); cv[4] = __uint_as_float((__float_as_uint(s) & ~0xFFu) | (unsigned)(2 * 4 + hi)); ce[4] = hi ? (k0[0] | k1[9]) : (k0[0] | k1[8]); }
    { const float s = hi ? (v0[0] + v1[11]) : (v0[0] + v1[10]); cv[5] = __uint_as_float((__float_as_uint(s) & ~0xFFu) | (unsigned)(2 * 5 + hi)); ce[5] = hi ? (k0[0] | k1[11]) : (k0[0] | k1[10]); }
    { const float s = hi ? (v0[0] + v1[13]) : (v0[0] + v1[12]); cv[6] = __uint_as_float((__float_as_uint(s) & ~0xFFu) | (unsigned)(2 * 6 + hi)); ce[6] = hi ? (k0[0] | k1[13]) : (k0[0] | k1[12]); }
    { const float s = hi ? (v0[0] + v1[15]) : (v0[0] + v1[14]); cv[7] = __uint_as_float((__float_as_uint(s) & ~0xFFu) | (unsigned)(2 * 7 + hi)); ce[7] = hi ? (k0[0] | k1[15]) : (k0[0] | k1[14]); }
    { const float s = hi ? (v0[1] + v1[1]) : (v0[1] + v1[0]); cv[8] = __uint_as_float((__float_as_uint(s) & ~0xFFu) | (unsigned)(2 * 8 + hi)); ce[8] = hi ? (k0[1] | k1[1]) : (k0[1] | k1[0]); }
    { const float s = hi ? (v0[1] + v1[3]) : (v0[1] + v1[2]); cv[9] = __uint_as_float((__float_as_uint(s) & ~0xFFu) | (unsigned)(2 * 9 + hi)); ce[9] = hi ? (k0[1] | k1[3]) : (k0[1] | k1[2]); }
    { const float s = hi ? (v0[1] + v1[5]) : (v0[1] + v1[4]); cv[10] = __uint_as_float((__float_as_uint(s) & ~0xFFu) | (unsigned)(2 * 10 + hi)); ce[10] = hi ? (k0[1] | k1[5]) : (k0[1] | k1[4]); }
    { const float s = hi ? (v0[1] + v1[7]) : (v0[1] + v1[6]); cv[11] = __uint_as_float((__float_as_uint(s) & ~0xFFu) | (unsigned)(2 * 11 + hi)); ce[11] = hi ? (k0[1] | k1[7]) : (k0[1] | k1[6]); }
    { const float s = hi ? (v0[2] + v1[1]) : (v0[2] + v1[0]); cv[12] = __uint_as_float((__float_as_uint(s) & ~0xFFu) | (unsigned)(2 * 12 + hi)); ce[12] = hi ? (k0[2] | k1[1]) : (k0[2] | k1[0]); }
    { const float s = hi ? (v0[2] + v1[3]) : (v0[2] + v1[2]); cv[13] = __uint_as_float((__float_as_uint(s) & ~0xFFu) | (unsigned)(2 * 13 + hi)); ce[13] = hi ? (k0[2] | k1[3]) : (k0[2] | k1[2]); }
    { const float s = hi ? (v0[3] + v1[0]) : (v0[2] + v1[4]); cv[14] = __uint_as_float((__float_as_uint(s) & ~0xFFu) | (unsigned)(2 * 14 + hi)); ce[14] = hi ? (k0[3] | k1[0]) : (k0[2] | k1[4]); }
    { const float s = hi ? (v0[3] + v1[2]) : (v0[3] + v1[1]); cv[15] = __uint_as_float((__float_as_uint(s) & ~0xFFu) | (unsigned)(2 * 15 + hi)); ce[15] = hi ? (k0[3] | k1[2]) : (k0[3] | k1[1]); }
    { const float s = hi ? (v0[4] + v1[0]) : (v0[3] + v1[3]); cv[16] = __uint_as_float((__float_as_uint(s) & ~0xFFu) | (unsigned)(2 * 16 + hi)); ce[16] = hi ? (k0[4] | k1[0]) : (k0[3] | k1[3]); }
    { const float s = hi ? (v0[4] + v1[2]) : (v0[4] + v1[1]); cv[17] = __uint_as_float((__float_as_uint(s) & ~0xFFu) | (unsigned)(2 * 17 + hi)); ce[17] = hi ? (k0[4] | k1[2]) : (k0[4] | k1[1]); }
    { const float s = hi ? (v0[5] + v1[1]) : (v0[5] + v1[0]); cv[18] = __uint_as_float((__float_as_uint(s) & ~0xFFu) | (unsigned)(2 * 18 + hi)); ce[18] = hi ? (k0[5] | k1[1]) : (k0[5] | k1[0]); }
    { const float s = hi ? (v0[6] + v1[1]) : (v0[6] + v1[0]); cv[19] = __uint_as_float((__float_as_uint(s) & ~0xFFu) | (unsigned)(2 * 19 + hi)); ce[19] = hi ? (k0[6] | k1[1]) : (k0[6] | k1[0]); }
    { const float s = hi ? (v0[7] + v1[1]) : (v0[7] + v1[0]); cv[20] = __uint_as_float((__float_as_uint(s) & ~0xFFu) | (unsigned)(2 * 20 + hi)); ce[20] = hi ? (k0[7] | k1[1]) : (k0[7] | k1[0]); }
    { const float s = hi ? (v0[9] + v1[0]) : (v0[8] + v1[0]); cv[21] = __uint_as_float((__float_as_uint(s) & ~0xFFu) | (unsigned)(2 * 21 + hi)); ce[21] = hi ? (k0[9] | k1[0]) : (k0[8] | k1[0]); }
    { const float s = hi ? (v0[11] + v1[0]) : (v0[10] + v1[0]); cv[22] = __uint_as_float((__float_as_uint(s) & ~0xFFu) | (unsigned)(2 * 22 + hi)); ce[22] = hi ? (k0[11] | k1[0]) : (k0[10] | k1[0]); }
    { const float s = hi ? (v0[13] + v1[0]) : (v0[12] + v1[0]); cv[23] = __uint_as_float((__float_as_uint(s) & ~0xFFu) | (unsigned)(2 * 23 + hi)); ce[23] = hi ? (k0[13] | k1[0]) : (k0[12] | k1[0]); }
    { const float s = hi ? (v0[15] + v1[0]) : (v0[14] + v1[0]); cv[24] = __uint_as_float((__float_as_uint(s) & ~0xFFu) | (unsigned)(2 * 24 + hi)); ce[24] = hi ? (k0[15] | k1[0]) : (k0[14] | k1[0]); }
        float ts[16]; int te[16];
#pragma unroll
        for (int k = 0; k < 16; ++k) {
            float m = cv[0];
#pragma unroll
            for (int n = 1; n < 25; ++n) m = fmaxf(m, cv[n]);
            m = pair_max(m);
            int e = -1;
#pragma unroll
            for (int n = 0; n < 25; ++n) { const bool hit = cv[n] == m; e = hit ? ce[n] : e; cv[n] = hit ? -3.0e38f : cv[n]; }
            ts[k] = __uint_as_float(__float_as_uint(m) & ~0xFFu); te[k] = pair_max_i(e);
        }
        float den = 0.f; const float mx = ts[0];
#pragma unroll
        for (int k = 0; k < 16; ++k) { ts[k] = __expf(ts[k] - mx); den += ts[k]; }
        const float inv = 1.0f / den;
        if (hi == 0) { int4* op = (int4*)(eidx + (size_t)tok * 128 + h * 16);
            op[0] = make_int4(te[0], te[1], te[2], te[3]); op[1] = make_int4(te[4], te[5], te[6], te[7]); op[2] = make_int4(te[8], te[9], te[10], te[11]); op[3] = make_int4(te[12], te[13], te[14], te[15]); }
        else { float4* op = (float4*)(gate + (size_t)tok * 128 + h * 16);
            op[0] = make_float4(ts[0] * inv, ts[1] * inv, ts[2] * inv, ts[3] * inv); op[1] = make_float4(ts[4] * inv, ts[5] * inv, ts[6] * inv, ts[7] * inv);
            op[2] = make_float4(ts[8] * inv, ts[9] * inv, ts[10] * inv, ts[11] * inv); op[3] = make_float4(ts[12] * inv, ts[13] * inv, ts[14] * inv, ts[15] * inv); }
    }
}
#ifndef PH_MASK
#define PH_MASK 0xffffffffu
#endif
constexpr int N_PHASES = 20;
__global__ void __launch_bounds__(512, 2) mega(MK a) {
    extern __shared__ __attribute__((aligned(16))) unsigned char lds_raw[];
    LDSA unsigned char* lds = (LDSA unsigned char*)lds_raw;
    const int lo = a.ph_lo, hi = a.ph_hi;
    const int G = gridDim.x, bid = blockIdx.x;
    const int wid_s = __builtin_amdgcn_readfirstlane(threadIdx.x >> 6);
    unsigned char* ws = a.ws;
#define PH_TID() int tid; { int _z = 0; asm volatile("" : "+s"(_z)); tid = wid_s * 64 + (int)__builtin_amdgcn_mbcnt_hi(~0u, __builtin_amdgcn_mbcnt_lo(~0u, (unsigned)_z)); }
#define WSP(T, name, off) T* name; { unsigned char* _b = ws; asm volatile("" : "+s"(_b)); name = (T*)(_b + (off)); }
#define IN(k) ((((PH_MASK) >> (k)) & 1u) && lo <= (k) && (k) < hi)
#define SEAM(k) do { if ((k) + 1 < hi) { PH_TID() xcd_barrier(bar, tid); } } while (0)
    XcdBarrier bar;
    { PH_TID()
      volatile LAS unsigned* st = (volatile LAS unsigned*)(lds + LDS_MISC);
      if (tid == 0) { st[0] = 0u; st[1] = 0u; }
      __syncthreads();
      bar = xcd_barrier_post((unsigned*)(ws + WS_CTL), st, tid); }

    if (IN(0)) {
        PH_TID()
        WSP(bf16_t, xb, WS_XB) WSP(bf16_t, wab, WS_WAB) WSP(bf16_t, woab, WS_WOAB) WSP(bf16_t, wcd, WS_WCD) WSP(bf16_t, wocd, WS_WOCD) WSP(bf16_t, wq, WS_WQ) WSP(unsigned char, ub, WS_UB) WSP(unsigned char, vb, WS_VB) WSP(float, isu, WS_SU) WSP(float, isv, WS_SV)
        cvt_rows_bf16(a.in[0], xb, (size_t)SEQ * DM / 8, bid, G, tid, 512);
        LDSA float* tile = (LDSA float*)lds;
        transpose_cvt(a.in[1], wab, 4096, 12288, tile, bid, G, PermNone(), tid);
        transpose_cvt(a.in[3], woab, 3072, 4096, tile, bid, G, PermNone(), tid);
        transpose_cvt(a.in[4], wcd, 4096, 9216, tile, bid, G, PermNone(), tid);
        transpose_cvt(a.in[12], wocd, 4096, 4096, tile, bid, G, PermNone(), tid);
        transpose_cvt(a.in[15], wq, 4096, 2048, tile, bid, G, PermNone(), tid);
        transpose_cvt(a.in[15] + (size_t)4096 * 2048, wq + (size_t)2048 * 4096, 4096, 2048, tile, bid, G, PermNone(), tid);
        table_fp8(a.in[17], ub, isu, 2 * 16384, bid, G, tid);
        table_fp8(a.in[18], vb, isv, 2 * 16384, bid, G, tid);
        { WSP(bf16_t, keyb, WS_KEYB) cvt_rows_bf16(a.in[16], keyb, (size_t)2 * 8 * 2 * 128 * 128 / 8, bid, G, tid, 512); }
        SEAM(0);
    }
#pragma unroll
    for (int layer = 0; layer < 2; ++layer) {
        const int pb = 1 + 10 * layer;
        if (IN(pb + 0)) {
            PH_TID() WSP(bf16_t, xb, WS_XB) WSP(bf16_t, x2b, WS_X2B) WSP(bf16_t, wab, WS_WAB) WSP(bf16_t, wcd, WS_WCD) WSP(float, hbuf, WS_H)
            const int N = layer == 0 ? 12288 : 9216;
            pg8::Gemm g{layer == 0 ? xb : x2b, layer == 0 ? wab : wcd, SEQ, N, 4096}; pg8::StaticOrder S; S.init(SEQ, N, G, bid);
            pg8::EpiF32R E{hbuf, N, nullptr, 0.f};
            pg8::gemm_phase<pg8::EpiF32R, pg8::StaticOrder>(lds, g, S, E, nullptr, tid);
            SEAM(pb + 0);
        }
        if (IN(pb + 1)) {
            PH_TID() WSP(float, hbuf, WS_H) WSP(bf16_t, hb, WS_HB)
            if (layer == 0) post_even_phase(hbuf, hb, bid, G, tid);
            else post_odd_phase(hbuf, hb, a.in[10], a.in[11], bid, G, tid);
            SEAM(pb + 1);
        }
        if (IN(pb + 2)) {
            PH_TID() WSP(bf16_t, hb, WS_HB) WSP(bf16_t, abb, WS_AB) WSP(float, oc, WS_OC)
            if (layer == 0) attn0_phase(hb, a.in[2], abb, (bf16_t*)oc, (float*)((unsigned char*)oc + (size_t)3 * 8 * SEQ * 128 * 2), (char*)lds_raw, bid, G, tid);
            else attn1_phase(hb, abb, oc, (char*)lds_raw, bid, G, tid);
            SEAM(pb + 2);
        }
        if (layer == 0) {
            if (IN(pb + 3)) {
                PH_TID() WSP(bf16_t, abb, WS_AB) WSP(float, oc, WS_OC)
                merge0_phase((const bf16_t*)oc, (const float*)((unsigned char*)oc + (size_t)3 * 8 * SEQ * 128 * 2), abb, bid, G, tid);
                SEAM(pb + 3);
            }
        } else {
            if (IN(pb + 3)) {
                PH_TID() WSP(bf16_t, abb, WS_AB) WSP(float, oc, WS_OC)
                const int lane = tid & 63, wv = tid >> 6;
                const float* lq1 = a.in[5]; const float* lk1 = a.in[6]; const float* lq2 = a.in[7]; const float* lk2 = a.in[8]; const float* subg = a.in[9];
                const float lam = __expf(wave_sum(lq1[lane] * lk1[lane] + lq1[lane + 64] * lk1[lane + 64])) - __expf(wave_sum(lq2[lane] * lk2[lane] + lq2[lane + 64] * lk2[lane + 64])) + LAMBDA_INIT;
                const float4 sg = *(const float4*)(subg + 4 * lane);
                for (int j = bid * 8 + wv; j < SEQ * 8; j += G * 8) {
                    const int t = j >> 3, h = j & 7;
                    const float4 o1 = *(const float4*)(oc + (size_t)t * 2048 + h * 256 + 4 * lane), o2 = *(const float4*)(oc + (size_t)SEQ * 2048 + (size_t)t * 2048 + h * 256 + 4 * lane);
                    const float ox = o1.x - lam * o2.x, oy = o1.y - lam * o2.y, oz = o1.z - lam * o2.z, ow = o1.w - lam * o2.w;
                    const float ss = wave_sum((ox * ox + oy * oy) + (oz * oz + ow * ow)) * (1.0f / 256.0f);
                    const float rs = (1.0f - LAMBDA_INIT) / sqrtf(ss + 1e-6f);
                    uint2 w; w.x = cvtpk_bf16(ox * rs * sg.x, oy * rs * sg.y); w.y = cvtpk_bf16(oz * rs * sg.z, ow * rs * sg.w);
                    *(uint2*)(abb + (size_t)t * 4096 + h * 256 + 4 * lane) = w;
                }
                SEAM(pb + 3);
            }
        }
        if (IN(pb + 4)) {
            const int K = layer == 0 ? 3072 : 4096;
            PH_TID() WSP(bf16_t, abb, WS_AB) WSP(bf16_t, woab, WS_WOAB) WSP(bf16_t, wocd, WS_WOCD) WSP(float, ybuf, WS_Y) WSP(float, x2, WS_X2)
            pg8::Gemm g{abb, layer == 0 ? woab : wocd, SEQ, 4096, K}; pg8::StaticOrder S; S.init(SEQ, 4096, G, bid);
            pg8::EpiF32R E{ybuf, 4096, layer == 0 ? a.in[0] : (const float*)x2, ALPHA};
            pg8::gemm_phase<pg8::EpiF32R, pg8::StaticOrder>(lds, g, S, E, nullptr, tid);
            SEAM(pb + 4);
        }
        if (IN(pb + 5)) {
            PH_TID() WSP(float, ybuf, WS_Y) WSP(float, x1, WS_X1) WSP(bf16_t, x1b, WS_X1B)
            ln_phase(ybuf, a.in[13] + layer * DM, a.in[14] + layer * DM, x1, x1b, bid, G, tid);
            SEAM(pb + 5);
        }
        if (IN(pb + 6)) {
            PH_TID() WSP(bf16_t, x1b, WS_X1B) WSP(bf16_t, wq, WS_WQ) WSP(bf16_t, pqb, WS_PQ)
            pg8::Gemm g{x1b, wq + (size_t)layer * 2048 * 4096, SEQ, 2048, 4096}; pg8::StaticOrder S; S.init(SEQ, 2048, G, bid);
            pg8::EpiBf16P E{pqb, 2048};
            pg8::gemm_phase<pg8::EpiBf16P, pg8::StaticOrder>(lds, g, S, E, nullptr, tid);
            SEAM(pb + 6);
        }
        if (IN(pb + 7)) {
            PH_TID() WSP(bf16_t, pqb, WS_PQ) WSP(bf16_t, keyb, WS_KEYB) WSP(int, eidx, WS_EIDX) WSP(float, gate, WS_GATE)
            route_mfma_phase(pqb, keyb + (size_t)layer * 8 * 2 * 128 * 128, eidx, gate, (char*)lds_raw, bid, G, tid);
            SEAM(pb + 7);
        }
        if (IN(pb + 8)) {
            PH_TID() WSP(float, x1, WS_X1) WSP(int, eidx, WS_EIDX) WSP(float, gate, WS_GATE) WSP(unsigned char, ub, WS_UB) WSP(unsigned char, vb, WS_VB) WSP(float, isu, WS_SU) WSP(float, isv, WS_SV) WSP(float, x2, WS_X2) WSP(bf16_t, x2b, WS_X2B)
            peer_expert_phase(x1, eidx, gate, ub + (size_t)layer * 16384 * 4096, vb + (size_t)layer * 16384 * 4096, isu + layer * 16384, isv + layer * 16384, a.in[19] + layer * DM, a.in[20] + layer * DM,
                              layer == 0 ? x2 : a.out, layer == 0 ? x2b : (bf16_t*)nullptr, bid, G, tid);
            SEAM(pb + 8);
        }
    }
#undef IN
}
#ifndef ONE_LAUNCH
#define ONE_LAUNCH 1
#endif
extern "C" void kernel_launch(void* const* d_in, const int* in_sizes, int n_in, void* d_out, int out_size, void* d_ws, size_t ws_size, hipStream_t stream) {
    static int ready = 0;
    if (!ready) {
        if (ws_size < WS_END) { fprintf(stderr, "kernel_launch: workspace too small: %zu < %zu\n", ws_size, (size_t)WS_END); return; }
        if (hipFuncSetAttribute((const void*)mega, hipFuncAttributeMaxDynamicSharedMemorySize, LDS_BYTES) != hipSuccess) { fprintf(stderr, "kernel_launch: hipFuncSetAttribute failed\n"); return; }
        int per_cu = 0;
        if (hipOccupancyMaxActiveBlocksPerMultiprocessor(&per_cu, (const void*)mega, 512, LDS_BYTES) != hipSuccess || per_cu < 1) fprintf(stderr, "kernel_launch: note: occupancy query reports %d blocks per CU\n", per_cu);
        (void)hipGetLastError();
        ready = 1;
    }
    unsigned char* ws = (unsigned char*)d_ws;
    (void)hipMemsetAsync(ws + WS_CTL, 0, CTL_BYTES, stream);
    MK a{}; for (int i = 0; i < 21; ++i) a.in[i] = (const float*)d_in[i];
    a.out = (float*)d_out; a.ws = ws;
#if ONE_LAUNCH
    a.ph_lo = 0; a.ph_hi = N_PHASES;
    hipLaunchKernelGGL(mega, dim3(256), dim3(512), LDS_BYTES, stream, a);
#else
    for (int k = 0; k < N_PHASES; ++k) { if (k == 10) continue; a.ph_lo = k; a.ph_hi = k + 1; hipLaunchKernelGGL(mega, dim3(256), dim3(512), LDS_BYTES, stream, a); }
#endif
    const hipError_t le = hipPeekAtLastError();
    if (le != hipSuccess) fprintf(stderr, "kernel_launch: launch failed: %s\n", hipGetErrorName(le));
}
```

```cpp
#include <hip/hip_runtime.h>
#include <stdint.h>
#include <cstdio>

#define SEQ 8192
#define DM 4096
#define HD 128
#define ALPHA 1.4142135623730951f
#define LAMBDA_INIT 0.35550906759096934f
#define ATT_SCALE 0.088388347648318440f

__device__ const double REV_P[16] = {0.15915494309189535, 0.0700865215877985, 0.03086376340470123, 0.013591370636193905, 0.005985185712713705, 0.002635675898667414, 0.001160663641240061, 0.0005111175045375439, 0.00022507907903927653, 9.911730936901935e-05, 4.364795279280289e-05, 1.9221100684944863e-05, 8.464330808241401e-06, 3.727408601915352e-06, 1.6414262627950345e-06, 7.228293068832865e-07};
__device__ const double REV_A[32] = {0.15915494309189535, 0.11934937021124886, 0.08949940160889101, 0.06711508300522726, 0.050329212104487035, 0.03774158471741977, 0.0283021958306234, 0.02122365276477766, 0.015915494309189534, 0.011934937021124886, 0.008949940160889102, 0.006711508300522725, 0.005032921210448704, 0.003774158471741977, 0.00283021958306234, 0.0021223652764777662, 0.0015915494309189536, 0.0011934937021124885, 0.0008949940160889102, 0.0006711508300522726, 0.0005032921210448703, 0.00037741584717419774, 0.00028302195830623395, 0.0002122365276477766, 0.00015915494309189535, 0.00011934937021124886, 8.949940160889102e-05, 6.711508300522725e-05, 5.0329212104487035e-05, 3.774158471741978e-05, 2.8302195830623396e-05, 2.122365276477766e-05};

__device__ __forceinline__ void sincos_rev(double rev, float& s, float& c) {
    const double f = rev - floor(rev); const float ff = (float)f;
    s = __builtin_amdgcn_sinf(ff); c = __builtin_amdgcn_cosf(ff);
}
__device__ __forceinline__ float wave_sum(float v) {
#pragma unroll
    for (int o = 32; o >= 1; o >>= 1) v += __shfl_xor(v, o);
    return v;
}
__device__ __forceinline__ float wave_max(float v) {
#pragma unroll
    for (int o = 32; o >= 1; o >>= 1) v = fmaxf(v, __shfl_xor(v, o));
    return v;
}
namespace pg8 {
#define PG8_LAS __attribute__((address_space(3)))
typedef unsigned short bf16_t;
typedef short bf16x8 __attribute__((ext_vector_type(8)));
typedef float f32x4 __attribute__((ext_vector_type(4)));
typedef unsigned u32x4 __attribute__((ext_vector_type(4)));
constexpr int BM = 256, BK = 64, HALF = 128, HTB = HALF * BK * 2  , STAGE_BYTES = 8 * HTB, NXCD = 8, WGM = 8;

__host__ __device__ __forceinline__ int lds_byte(int r, int c) { const int st = (r >> 4) * 2 + (c >> 5), rr = r & 15, cc = c & 31, ob = rr * 64 + cc * 2; return st * 1024 + (ob ^ (((ob >> 9) & 1) << 5)); }
__host__ __device__ __forceinline__ void stage_rc(int b, int& R, int& C) { const int st = b / 1024, sb = b % 1024, swz = sb ^ (((sb >> 9) & 1) << 5); R = (st >> 1) * 16 + swz / 64; C = (st & 1) * 32 + (swz % 64) / 2; }
__host__ __device__ __forceinline__ int perm32(int rho) { const int n = rho >> 4, i = rho & 15; return 8 * (i >> 2) + 4 * n + (i & 3); }

struct Unit { int pm, pn; };
struct Gemm { const bf16_t* A; const bf16_t* Bt; int M, N, K; };

struct StaticOrder {
    int nM, nN, nwg, G, c;
    __host__ __device__ void init(int M, int N, int G_, int c_) { nM = M / BM; nN = N / BM; nwg = nM * nN; G = G_; c = c_; }
    __host__ __device__ bool next(int i, Unit& u) const {
        const long L = (long)i * G + c; if (L >= nwg) return false;
        int wgid = (int)L; { const int q = nwg / NXCD, r = nwg % NXCD, xcd = wgid % NXCD, off = wgid / NXCD; wgid = (xcd < r ? xcd * (q + 1) : r * (q + 1) + (xcd - r) * q) + off; }
        const int nig = WGM * nN, gid = wgid / nig, fm = gid * WGM, gsz = (nM - fm) < WGM ? (nM - fm) : WGM;
        u.pm = fm + ((wgid % nig) % gsz); u.pn = (wgid % nig) / gsz; return true;
    }
    __device__ __forceinline__ void a_ready(const Unit&) const {}
    __device__ __forceinline__ void done(const Unit&) const {}
};
__device__ __forceinline__ unsigned cvt_pk_bf16(float lo, float hi) { unsigned r; asm volatile("v_cvt_pk_bf16_f32 %0, %1, %2" : "=v"(r) : "v"(lo), "v"(hi)); return r; }
typedef float f32x2 __attribute__((ext_vector_type(2)));
template <class Epi, class Sched, bool STAMP = false>
__device__ __forceinline__ void gemm_phase(PG8_LAS unsigned char* lds, const Gemm g, const Sched& S, const Epi& E, unsigned long long* stamps, const int tid_in) {
    const int tid = tid_in, wid = __builtin_amdgcn_readfirstlane(tid >> 6), lane = tid & 63, wr = wid >> 2, wc = wid & 3, fr = lane & 15, fq = lane >> 4;
    const int K = g.K, nt = K / BK;
    int ts_lo = 0, ts_hi = 0, nts = 0; const unsigned long long rt_entry = STAMP ? (unsigned long long)wall_clock64() : 0ull;
#define PG8_STAMP() do { if (STAMP && wid == 0 && nts < 64) { const unsigned long long _c = (unsigned long long)clock64(); \
        ts_lo = (lane == nts) ? (int)(unsigned)_c : ts_lo; ts_hi = (lane == nts) ? (int)(unsigned)(_c >> 32) : ts_hi; ++nts; } } while (0)
    PG8_STAMP();
    unsigned voffA[2], voffB[2];
#pragma unroll
    for (int i = 0; i < 2; ++i) { int R, C; stage_rc(tid * 16 + i * 8192, R, C); const int Rb = Epi::PERM ? ((R & ~31) + perm32(R & 31)) : R;
        voffA[i] = (unsigned)(R * K + C) * 2u; voffB[i] = (unsigned)(Rb * K + C) * 2u; }
    const size_t kstep = (size_t)(BK * 2);
    const size_t hstep = (size_t)HALF * K * 2;
    const size_t tstep = 2 * hstep;
    const unsigned ldsw = (unsigned)wid * 1024u;
    const int aoff = lds_byte(wr * 64 + fr, fq * 8), boff = lds_byte(wc * 32 + fr, fq * 8);
#define PG8_SA(b, h) (((b) * 2 + (h)) * HTB)
#define PG8_SB(b, h) ((4 + (b) * 2 + (h)) * HTB)
#define PG8_STAGE(bufoff, gbase, voff) do { _Pragma("unroll") for (int _i = 0; _i < 2; ++_i) \
        __builtin_amdgcn_global_load_lds((const unsigned*)((const char*)(gbase) + (voff)[_i]), (PG8_LAS unsigned*)(lds + (bufoff) + ldsw + _i * 8192), 16, 0, 0); } while (0)
#define PG8_LDA(dst, b, h) do { _Pragma("unroll") for (int m = 0; m < 4; ++m) _Pragma("unroll") for (int k = 0; k < 2; ++k) dst[m][k] = *(const PG8_LAS bf16x8*)(lds + PG8_SA(b, h) + aoff + m * 2048 + k * 1024); } while (0)
#define PG8_LDB(dst, b, h) do { _Pragma("unroll") for (int n = 0; n < 2; ++n) _Pragma("unroll") for (int k = 0; k < 2; ++k) dst[n][k] = *(const PG8_LAS bf16x8*)(lds + PG8_SB(b, h) + boff + n * 2048 + k * 1024); } while (0)
#define PG8_MMA(ai, bj, At, Bt) do { __builtin_amdgcn_s_setprio(1); _Pragma("unroll") for (int m = 0; m < 4; ++m) _Pragma("unroll") for (int n = 0; n < 2; ++n) _Pragma("unroll") for (int k = 0; k < 2; ++k) \
        acc[ai][bj][m][n] = __builtin_amdgcn_mfma_f32_16x16x32_bf16(Bt[n][k], At[m][k], acc[ai][bj][m][n], 0, 0, 0); __builtin_amdgcn_s_setprio(0); } while (0)
#define PG8_WAIT_V(n) asm volatile("s_waitcnt vmcnt(" #n ")" ::: "memory")
#define PG8_WAIT_L(n) asm volatile("s_waitcnt lgkmcnt(" #n ")" ::: "memory")
#define PG8_BAR __builtin_amdgcn_s_barrier()
#define PG8_SCHED __builtin_amdgcn_sched_barrier(0)
    Unit cur, nxt; int ui = 0;
    if (!S.next(0, cur)) return;
    f32x4 acc[2][2][4][2];
#pragma unroll
    for (int a = 0; a < 2; ++a)
#pragma unroll
        for (int b = 0; b < 2; ++b)
#pragma unroll
            for (int m = 0; m < 4; ++m)
#pragma unroll
                for (int n = 0; n < 2; ++n) acc[a][b][m][n] = (f32x4){0.f, 0.f, 0.f, 0.f};
    bf16x8 At[4][2], B0[2][2], B1[2][2];
    const char* cA = (const char*)g.A + (size_t)cur.pm * tstep; const char* cB = (const char*)g.Bt + (size_t)cur.pn * tstep;
    S.a_ready(cur);
    PG8_STAGE(PG8_SB(0, 0), cB, voffB); PG8_STAGE(PG8_SA(0, 0), cA, voffA); PG8_STAGE(PG8_SB(0, 1), cB + hstep, voffB); PG8_STAGE(PG8_SA(0, 1), cA + hstep, voffA);
    if (wr == 1) PG8_BAR;
    PG8_WAIT_V(4); PG8_BAR;
    PG8_STAGE(PG8_SB(1, 0), cB + kstep, voffB); PG8_STAGE(PG8_SA(1, 0), cA + kstep, voffA); PG8_STAGE(PG8_SB(1, 1), cB + hstep + kstep, voffB);
    PG8_WAIT_V(6); PG8_BAR;
    PG8_STAMP();
    for (;;) {
        const bool has_next = S.next(ui + 1, nxt);
        const char* nA = has_next ? (const char*)g.A + (size_t)nxt.pm * tstep : cA; const char* nB = has_next ? (const char*)g.Bt + (size_t)nxt.pn * tstep : cB;
        for (int t = 0; t < nt; t += 2) {
            const bool last = (t == nt - 2);
            const char* a1 = cA + (size_t)(t + 1) * kstep;
            const char* a2 = last ? nA : cA + (size_t)(t + 2) * kstep; const char* b2 = last ? nB : cB + (size_t)(t + 2) * kstep;
            const char* a3 = a2 + kstep; const char* b3 = b2 + kstep;
            if (last && has_next) S.a_ready(nxt);
            PG8_LDB(B0, 0, 0); PG8_SCHED; PG8_LDA(At, 0, 0); PG8_STAGE(PG8_SA(1, 1), a1 + hstep, voffA);
            PG8_WAIT_L(8); PG8_BAR; PG8_WAIT_L(0); PG8_MMA(0, 0, At, B0); PG8_BAR; PG8_SCHED;
            PG8_LDB(B1, 0, 1); PG8_STAGE(PG8_SB(0, 0), b2, voffB);
            PG8_BAR; PG8_WAIT_L(0); PG8_MMA(0, 1, At, B1); PG8_BAR;
            PG8_LDA(At, 0, 1); PG8_STAGE(PG8_SA(0, 0), a2, voffA);
            PG8_BAR; PG8_WAIT_L(0); PG8_MMA(1, 0, At, B0); PG8_BAR; PG8_SCHED;
            PG8_STAGE(PG8_SB(0, 1), b2 + hstep, voffB);
            PG8_WAIT_V(6); PG8_BAR; PG8_MMA(1, 1, At, B1); PG8_BAR;
            PG8_LDB(B0, 1, 0); PG8_SCHED; PG8_LDA(At, 1, 0); PG8_STAGE(PG8_SA(0, 1), a2 + hstep, voffA);
            PG8_WAIT_L(8); PG8_BAR; PG8_WAIT_L(0); PG8_MMA(0, 0, At, B0); PG8_BAR; PG8_SCHED;
            PG8_LDB(B1, 1, 1); PG8_STAGE(PG8_SB(1, 0), b3, voffB);
            PG8_BAR; PG8_WAIT_L(0); PG8_MMA(0, 1, At, B1); PG8_BAR;
            PG8_LDA(At, 1, 1); PG8_STAGE(PG8_SA(1, 0), a3, voffA);
            PG8_BAR; PG8_WAIT_L(0); PG8_MMA(1, 0, At, B0); PG8_BAR; PG8_SCHED;
            PG8_STAGE(PG8_SB(1, 1), b3 + hstep, voffB);
            PG8_WAIT_V(6); PG8_BAR; PG8_MMA(1, 1, At, B1); PG8_BAR;
        }
        PG8_STAMP();
        if constexpr (!Epi::AFTER_DRAIN) { E(acc, cur, wr, wc, fr, fq); S.done(cur); }
        PG8_STAMP();
        if (!has_next) break;
#pragma unroll
        for (int a = 0; a < 2; ++a)
#pragma unroll
            for (int b = 0; b < 2; ++b)
#pragma unroll
                for (int m = 0; m < 4; ++m)
#pragma unroll
                    for (int n = 0; n < 2; ++n) acc[a][b][m][n] = (f32x4){0.f, 0.f, 0.f, 0.f};
        cur = nxt; cA = nA; cB = nB; ++ui;
    }
    PG8_WAIT_V(0);
    if (wr == 0) PG8_BAR;
    PG8_BAR;
    if constexpr (Epi::AFTER_DRAIN) { E.fused(acc, cur, wr, wc, fr, fq, lds, wid, lane); S.done(cur); }
    PG8_STAMP();
    if (STAMP && wid == 0) { stamps[lane] = lane < nts ? (((unsigned long long)(unsigned)ts_hi << 32) | (unsigned)ts_lo) : 0ull;
        if (lane == 62) stamps[62] = rt_entry; if (lane == 63) stamps[63] = (unsigned long long)wall_clock64(); }
#undef PG8_STAMP
#undef PG8_SA
#undef PG8_SB
#undef PG8_STAGE
#undef PG8_LDA
#undef PG8_LDB
#undef PG8_MMA
#undef PG8_WAIT_V
#undef PG8_WAIT_L
#undef PG8_BAR
#undef PG8_SCHED
}
}
#define XB_TMO      128
#define XB_XCNT(j)  (256  + 64 * (j))
#define XB_XSUB(j)  (1280 + 64 * (j))
#define XB_XGEN(j)  (2304 + 64 * (j))
#define XB_TOP      3328
#define XB_TOPGEN   3392
#define XCD_BAR_WORDS 3456
#define XB_SPIN_CAP (1u << 22)
#define LAS __attribute__((address_space(3)))

__device__ __forceinline__ unsigned xb_ld(unsigned* p)              { return __hip_atomic_load(p, __ATOMIC_RELAXED, __HIP_MEMORY_SCOPE_AGENT); }
__device__ __forceinline__ unsigned xb_add(unsigned* p, unsigned v) { return __hip_atomic_fetch_add(p, v, __ATOMIC_RELAXED, __HIP_MEMORY_SCOPE_AGENT); }
__device__ __forceinline__ unsigned xb_xcc_id() { return (unsigned)__builtin_amdgcn_s_getreg((3 << 11) | 20) & 0xFu; }
#define XB_SPIN(cond, bar) do { unsigned _sp = 0; while (cond) { __builtin_amdgcn_s_sleep(1); \
    if ((++_sp & 255u) == 0u) { if (xb_ld(&(bar)[XB_TMO])) break; if (_sp > XB_SPIN_CAP) { atomicAdd(&(bar)[XB_TMO], 1u); break; } } } } while (0)

struct XcdBarrier {
    unsigned* bar; unsigned x;
    volatile LAS unsigned* st;
};

__device__ __forceinline__ XcdBarrier xcd_barrier_post(unsigned* bar, volatile LAS unsigned* st, const int tid) {
    XcdBarrier b; b.bar = bar; b.x = xb_xcc_id(); b.st = st;
    if (tid == 0) (void)xb_add(&bar[XB_XCNT(b.x)], 1u);
    return b;
}
__device__ __forceinline__ void xcd_barrier_complete(unsigned* bar, unsigned x, unsigned& nloc, unsigned& nx) {
    const unsigned G = gridDim.x * gridDim.y * gridDim.z;
    unsigned sum, cnt, mine, sp = 0u;
    for (;;) {
        sum = 0u; cnt = 0u; mine = 0u;
#pragma unroll
        for (unsigned j = 0; j < 16; ++j) { const unsigned c = xb_ld(&bar[XB_XCNT(j)]); sum += c; cnt += (c > 0u) ? 1u : 0u; mine = (j == x) ? c : mine; }
        if (sum == G) break;
        __builtin_amdgcn_s_sleep(1);
        if ((++sp & 255u) == 0u) { if (xb_ld(&bar[XB_TMO])) break; if (sp > XB_SPIN_CAP) { atomicAdd(&bar[XB_TMO], 1u); break; } }
    }
    nloc = mine > 0u ? mine : 1u; nx = cnt > 0u ? cnt : 1u;
}

__device__ __forceinline__ void xcd_barrier(const XcdBarrier& b, const int tid) {
    asm volatile("s_waitcnt vmcnt(0)" ::: "memory");
    __syncthreads();
    if (tid == 0) {
        unsigned* bar = b.bar;
        __builtin_amdgcn_s_waitcnt(0);
        unsigned nloc = b.st[0], nx = b.st[1];
        if (nloc == 0u) { xcd_barrier_complete(bar, b.x, nloc, nx); b.st[0] = nloc; b.st[1] = nx; }
        const unsigned old = xb_add(&bar[XB_XSUB(b.x)], 1u);
        const unsigned gen = old / nloc;
        if (old + 1u == (gen + 1u) * nloc) {
            __builtin_amdgcn_fence(__ATOMIC_RELEASE, "agent");
            asm volatile("s_waitcnt vmcnt(0)" ::: "memory");
            const unsigned og = xb_add(&bar[XB_TOP], 1u);
            const unsigned tg = og / nx;
            if (og + 1u == (tg + 1u) * nx) xb_add(&bar[XB_TOPGEN], 1u);
            else XB_SPIN(xb_ld(&bar[XB_TOPGEN]) == tg, bar);
            __builtin_amdgcn_fence(__ATOMIC_ACQUIRE, "agent");
            xb_add(&bar[XB_XGEN(b.x)], 1u);
            asm volatile("s_waitcnt vmcnt(0)" ::: "memory");
        } else {
            XB_SPIN(xb_ld(&bar[XB_XGEN(b.x)]) == gen, bar);
            __builtin_amdgcn_fence(__ATOMIC_ACQUIRE, "agent");
            asm volatile("s_waitcnt vmcnt(0)" ::: "memory");
        }
    }
    __syncthreads();
}
namespace att {
using bf16 = unsigned short;
constexpr int   D = 128, NW = 8, QBLK = 32, KVBLK = 64;
constexpr float SCALE = 0.088388347648318440f;
constexpr float THR = 8.f;
constexpr int SDEPTH = 1;
constexpr size_t SHM_V = KVBLK * D * 2, SHM_K = KVBLK * D * 2, SHM_ATTN = 2 * SHM_V + 2 * SHM_K + NW * 64 * 4;
using bf16x8 = __attribute__((ext_vector_type(8))) short;
using s16x4  = __attribute__((ext_vector_type(4))) short;
using f32x16 = __attribute__((ext_vector_type(16))) float;
using f32x8  = __attribute__((ext_vector_type(8))) float;
using u32x4  = __attribute__((ext_vector_type(4))) unsigned;
#define KSWZ(row, colB) ((row) * 256 + ((colB) ^ (((row) & 7) << 4)))
#define SBAR() __builtin_amdgcn_sched_barrier(0)
__device__ __forceinline__ int crow(int r, int hi) { return (r & 3) + 8 * (r >> 2) + 4 * hi; }
__device__ __forceinline__ unsigned cvtpk(float lo, float hi) {
  unsigned r; asm volatile("v_cvt_pk_bf16_f32 %0, %1, %2" : "=v"(r) : "v"(lo), "v"(hi)); return r;
}
template <typename TIn> struct Stage;
template <> struct Stage<bf16>  { using T = bf16x8;
  __device__ static __forceinline__ T ld8(const bf16* p) { return *reinterpret_cast<const bf16x8*>(p); }
  __device__ static __forceinline__ bf16x8 tobf(T x) { return x; } };
template <> struct Stage<float> { using T = f32x8;
  __device__ static __forceinline__ T ld8(const float* p) { return *reinterpret_cast<const f32x8*>(p); }
  __device__ static __forceinline__ bf16x8 tobf(T x) {
    u32x4 w = {cvtpk(x[0], x[1]), cvtpk(x[2], x[3]), cvtpk(x[4], x[5]), cvtpk(x[6], x[7])}; return *reinterpret_cast<bf16x8*>(&w); } };

__device__ __forceinline__ void partialSM(f32x16& p0, f32x16& p1, float& m_reg, float& mn, float& alpha) {
  constexpr float C = SCALE * 1.4426950408889634f;
  float pmax = p0[0]; for (int r = 1; r < 16; ++r) pmax = fmaxf(pmax, p0[r]); for (int r = 0; r < 16; ++r) pmax = fmaxf(pmax, p1[r]);
  { auto rr = __builtin_amdgcn_permlane32_swap(__float_as_uint(pmax), __float_as_uint(pmax), false, false);
    pmax = fmaxf(__uint_as_float(rr[0]), __uint_as_float(rr[1])); }
  if (__builtin_expect(__all(pmax - m_reg <= THR / SCALE), 1)) { mn = m_reg; alpha = 1.f; }
  else { mn = fmaxf(m_reg, pmax); alpha = __builtin_amdgcn_exp2f((m_reg - mn) * C); m_reg = mn; }
  float mnC = -mn * C;
  for (int r = 0; r < 16; ++r) p0[r] = fmaf(p0[r], C, mnC); for (int r = 0; r < 16; ++r) p1[r] = fmaf(p1[r], C, mnC);
  for (int r = 0; r < 16; ++r) p0[r] = __builtin_amdgcn_exp2f(p0[r]);
}
__device__ __forceinline__ void finishSM(f32x16& p0, f32x16& p1, float alpha, float& l_reg, bf16x8& pa0, bf16x8& pa1, bf16x8& pa2, bf16x8& pa3) {
  for (int r = 0; r < 16; ++r) p1[r] = __builtin_amdgcn_exp2f(p1[r]);
  float ps = 0; for (int r = 0; r < 16; ++r) ps += p0[r]; for (int r = 0; r < 16; ++r) ps += p1[r];
  { auto rr = __builtin_amdgcn_permlane32_swap(__float_as_uint(ps), __float_as_uint(ps), false, false);
    ps = __uint_as_float(rr[0]) + __uint_as_float(rr[1]); }
  l_reg = l_reg * alpha + ps;
#define PK4(P, BASE, OUT) do { unsigned a0 = cvtpk(P[BASE + 0], P[BASE + 1]), a1 = cvtpk(P[BASE + 2], P[BASE + 3]);   \
    unsigned b0 = cvtpk(P[BASE + 4], P[BASE + 5]), b1 = cvtpk(P[BASE + 6], P[BASE + 7]);                              \
    auto r0 = __builtin_amdgcn_permlane32_swap(a0, b0, false, false); auto r1 = __builtin_amdgcn_permlane32_swap(a1, b1, false, false); \
    u32x4 w = {r0[0], r1[0], r0[1], r1[1]}; OUT = *reinterpret_cast<bf16x8*>(&w); } while (0)
  PK4(p0, 0, pa0); PK4(p0, 8, pa1); PK4(p1, 0, pa2); PK4(p1, 8, pa3);
#undef PK4
}
__device__ __forceinline__ void qkt(f32x16& p0, f32x16& p1, const bf16* Ks, const bf16x8* qr, int r32, int hi) {
  p0 = f32x16{}; p1 = f32x16{};
  for (int d0 = 0; d0 < 8; ++d0) { int cb = (d0 * 16 + hi * 8) * 2;
    bf16x8 b0 = *reinterpret_cast<const bf16x8*>((const char*)Ks + KSWZ(r32, cb));
    bf16x8 b1 = *reinterpret_cast<const bf16x8*>((const char*)Ks + KSWZ(32 + r32, cb));
    p0 = __builtin_amdgcn_mfma_f32_32x32x16_bf16(b0, qr[d0], p0, 0, 0, 0);
    p1 = __builtin_amdgcn_mfma_f32_32x32x16_bf16(b1, qr[d0], p1, 0, 0, 0); }
}
__device__ __forceinline__ int v_st(int k, int c) { const int kk = (k & ~0xC) | ((k & 4) << 1) | ((k & 8) >> 1); return ((kk >> 3) * 4 + (c >> 5)) * 512 + ((kk & 7) * 32 + (c & 31)) * 2; }
__device__ __forceinline__ int v_rd_base(int lane) { return ((lane & 3) << 3) | (((lane >> 2) & 3) << 6) | (((lane >> 4) & 1) << 5) | (((lane >> 5) & 1) << 8); }
constexpr int v_rd_off(int d0, int ks, int half) { return d0 * 512 + ks * 4096 + half * 2048; }
template <int OFF> __device__ __forceinline__ s16x4 tr_read(int vb) {
  s16x4 r; asm volatile("ds_read_b64_tr_b16 %0, %1 offset:%2" : "=&v"(r) : "v"(vb), "i"(OFF) : "memory"); return r;
}
template <int D0> __device__ __forceinline__ void pv_one(f32x16& od, int vb, bf16x8 pa0, bf16x8 pa1, bf16x8 pa2, bf16x8 pa3) {
  const s16x4 l0 = tr_read<v_rd_off(D0, 0, 0)>(vb), h0 = tr_read<v_rd_off(D0, 0, 1)>(vb), l1 = tr_read<v_rd_off(D0, 1, 0)>(vb), h1 = tr_read<v_rd_off(D0, 1, 1)>(vb);
  const s16x4 l2 = tr_read<v_rd_off(D0, 2, 0)>(vb), h2 = tr_read<v_rd_off(D0, 2, 1)>(vb), l3 = tr_read<v_rd_off(D0, 3, 0)>(vb), h3 = tr_read<v_rd_off(D0, 3, 1)>(vb);
  asm volatile("s_waitcnt lgkmcnt(0)" ::: "memory"); SBAR();
#define PK(L, H) (bf16x8){L[0], L[1], L[2], L[3], H[0], H[1], H[2], H[3]}
  od = __builtin_amdgcn_mfma_f32_32x32x16_bf16(pa0, PK(l0, h0), od, 0, 0, 0);
  od = __builtin_amdgcn_mfma_f32_32x32x16_bf16(pa1, PK(l1, h1), od, 0, 0, 0);
  od = __builtin_amdgcn_mfma_f32_32x32x16_bf16(pa2, PK(l2, h2), od, 0, 0, 0);
  od = __builtin_amdgcn_mfma_f32_32x32x16_bf16(pa3, PK(l3, h3), od, 0, 0, 0);
#undef PK
}
__device__ __forceinline__ void pv_d0(f32x16* o, int vb, bf16x8 pa0, bf16x8 pa1, bf16x8 pa2, bf16x8 pa3) {
  pv_one<0>(o[0], vb, pa0, pa1, pa2, pa3); pv_one<1>(o[1], vb, pa0, pa1, pa2, pa3); pv_one<2>(o[2], vb, pa0, pa1, pa2, pa3); pv_one<3>(o[3], vb, pa0, pa1, pa2, pa3);
}

template <typename TQ, int LDQ, int LDK, int LDO, typename TO>
__device__ __forceinline__ void attn_dense_body(const TQ* __restrict__ Qb, const bf16* __restrict__ Kh, const bf16* __restrict__ Vh,
                                                TO* __restrict__ Ob, int seq, char* lds, const int tid_in) {
  using St = Stage<bf16>; using SQ = Stage<TQ>;
  const int tid = tid_in, wid = tid >> 6, lane = tid & 63, r32 = lane & 31, hi = lane >> 5;
  bf16* V_lds = (bf16*)lds; bf16* K_lds = (bf16*)(lds + 2 * SHM_V);
  float* ws = (float*)(lds + 2 * SHM_V + 2 * SHM_K) + wid * 64; float* li_l = ws; float* al_l = ws + 32;
  float m_reg = -1e30f, l_reg = 0; f32x16 o[4] = {}; bf16x8 qr[8];
  const TQ* Qw = Qb + ((wid * QBLK + r32) * LDQ + hi * 8);
#pragma unroll
  for (int d0 = 0; d0 < 8; ++d0) qr[d0] = SQ::tobf(SQ::ld8(Qw + d0 * 16));
  const int sr = tid >> 4, sc = (tid & 15) * 8, vst0 = v_st(sr, sc), vst1 = v_st(32 + sr, sc);
  const int vb0 = (int)(uintptr_t)V_lds + v_rd_base(lane);
  struct { typename St::T vs0, vs1, ks0, ks1; } sr_[SDEPTH];
#define SLOAD(i, k0) do { sr_[i].vs0 = St::ld8(Vh + (((k0) + sr) * LDK + sc)); sr_[i].vs1 = St::ld8(Vh + (((k0) + 32 + sr) * LDK + sc)); \
    sr_[i].ks0 = St::ld8(Kh + (((k0) + sr) * LDK + sc)); sr_[i].ks1 = St::ld8(Kh + (((k0) + 32 + sr) * LDK + sc)); } while (0)
#define SWRITE(b, i) do { *(bf16x8*)((char*)V_lds + (b) * SHM_V + vst0) = St::tobf(sr_[i].vs0);          \
    *(bf16x8*)((char*)V_lds + (b) * SHM_V + vst1) = St::tobf(sr_[i].vs1); int kc = sc * 2;               \
    *(bf16x8*)((char*)K_lds + (b) * SHM_K + KSWZ(sr, kc)) = St::tobf(sr_[i].ks0);                       \
    *(bf16x8*)((char*)K_lds + (b) * SHM_K + KSWZ(32 + sr, kc)) = St::tobf(sr_[i].ks1); } while (0)
#define SWAIT() do { if constexpr (SDEPTH == 2) asm volatile("s_waitcnt vmcnt(4)" ::: "memory"); else asm volatile("s_waitcnt vmcnt(0)" ::: "memory"); } while (0)
#define RESC(a) do { if (__any((a) < 1.f)) { if (hi == 0) al_l[r32] = (a); asm volatile("s_waitcnt lgkmcnt(0)" ::: "memory"); \
    for (int d = 0; d < 4; ++d) for (int r = 0; r < 16; ++r) o[d][r] *= al_l[crow(r, hi)]; } } while (0)
  f32x16 pA0, pA1, pB0, pB1; float mnA, mnB, alA, alB; bf16x8 pa0, pa1, pa2, pa3; const int NT = seq / KVBLK;
  constexpr int SE = 0, SO = SDEPTH - 1;
  SLOAD(SE, 0); asm volatile("s_waitcnt vmcnt(0)" ::: "memory"); SWRITE(0, SE); __syncthreads();
  qkt(pA0, pA1, K_lds, qr, r32, hi); partialSM(pA0, pA1, m_reg, mnA, alA);
  SLOAD(SO, KVBLK); if constexpr (SDEPTH == 2) { if (2 < NT) SLOAD(SE, 2 * KVBLK); }
  SWAIT(); SWRITE(1, SO); __syncthreads();
  for (int j = 1; j + 1 < NT; j += 2) {
    SBAR(); qkt(pB0, pB1, (bf16*)((char*)K_lds + SHM_K), qr, r32, hi);
    finishSM(pA0, pA1, alA, l_reg, pa0, pa1, pa2, pa3); SBAR();
    SLOAD(SO, (j + SDEPTH) * KVBLK); SBAR();
    pv_d0(o, vb0, pa0, pa1, pa2, pa3); partialSM(pB0, pB1, m_reg, mnB, alB);
    __syncthreads(); SWAIT(); SWRITE(0, SE);
    RESC(alB); __syncthreads();
    SBAR(); qkt(pA0, pA1, K_lds, qr, r32, hi);
    finishSM(pB0, pB1, alB, l_reg, pa0, pa1, pa2, pa3); SBAR();
    if (SDEPTH == 1 || j + 3 < NT) SLOAD(SE, (j + 1 + SDEPTH) * KVBLK); SBAR();
    pv_d0(o, vb0 + (int)SHM_V, pa0, pa1, pa2, pa3); partialSM(pA0, pA1, m_reg, mnA, alA);
    __syncthreads(); SWAIT(); SWRITE(1, SO);
    RESC(alA); __syncthreads();
  }
  SBAR(); qkt(pB0, pB1, (bf16*)((char*)K_lds + SHM_K), qr, r32, hi);
  finishSM(pA0, pA1, alA, l_reg, pa0, pa1, pa2, pa3); SBAR();
  pv_d0(o, vb0, pa0, pa1, pa2, pa3); partialSM(pB0, pB1, m_reg, mnB, alB);
  __syncthreads(); RESC(alB);
  finishSM(pB0, pB1, alB, l_reg, pa0, pa1, pa2, pa3); SBAR();
  pv_d0(o, vb0 + (int)SHM_V, pa0, pa1, pa2, pa3);
  if (hi == 0) li_l[r32] = l_reg; asm volatile("s_waitcnt lgkmcnt(0)" ::: "memory");
  float rli[16];
#pragma unroll
  for (int r = 0; r < 16; ++r) rli[r] = __builtin_amdgcn_rcpf(li_l[crow(r, hi)]);
  TO* Ow = Ob + (wid * QBLK) * LDO;
#pragma unroll
  for (int r = 0; r < 16; ++r) { int orow = crow(r, hi);
    for (int d0 = 0; d0 < 4; ++d0) { const float val = o[d0][r] * rli[r];
      if constexpr (sizeof(TO) == 4) Ow[orow * LDO + d0 * 32 + r32] = val;
      else Ow[orow * LDO + d0 * 32 + r32] = (TO)(cvtpk(val, val) & 0xffffu); } }
#undef SLOAD
#undef SWRITE
#undef SWAIT
#undef RESC
}

template <int WIN>
__device__ __forceinline__ void attn_banded_body(const bf16* __restrict__ Qp, const bf16* __restrict__ Kp, const bf16* __restrict__ Vp, const long rs, const int Lseq, const int P0,
                                                 const float m_init, const float l_init, bf16* __restrict__ Ob, const long os, float* __restrict__ Lp, const long ls, char* lds, const int tid) {
  const int wid = __builtin_amdgcn_readfirstlane(tid >> 6), lane = tid & 63, r32 = lane & 31, hi = lane >> 5;
  bf16* V_lds = (bf16*)lds; bf16* K_lds = (bf16*)(lds + 2 * SHM_V);
  float* wsf = (float*)(lds + 2 * SHM_V + 2 * SHM_K) + wid * 64; float* li_l = wsf; float* al_l = wsf + 32;
  float m_reg = m_init, l_reg = l_init; f32x16 o[4] = {}; bf16x8 qr[8];
  const bf16* Qw = Qp + (long)(P0 + wid * QBLK + r32) * rs + hi * 8;
#pragma unroll
  for (int d0 = 0; d0 < 8; ++d0) qr[d0] = *reinterpret_cast<const bf16x8*>(Qw + d0 * 16);
  const int sr = tid >> 4, sc = (tid & 15) * 8, vst0 = v_st(sr, sc), vst1 = v_st(32 + sr, sc);
  const int vb0 = (int)(uintptr_t)V_lds + v_rd_base(lane);
  constexpr int NT = (256 + 2 * WIN) / 64, NTW = (2 * WIN + 32 + 63) / 64;
  const int klo = wid >> 1, qpos = P0 + wid * QBLK + r32;
  for (int k = 0; k < NT; ++k) {
    const int tb = P0 - WIN + 64 * k;
    if (tb < 0 || tb >= Lseq) continue;
    __syncthreads();
    { const bf16x8 v0 = *reinterpret_cast<const bf16x8*>(Vp + (long)(tb + sr) * rs + sc), v1 = *reinterpret_cast<const bf16x8*>(Vp + (long)(tb + 32 + sr) * rs + sc);
      const bf16x8 k0 = *reinterpret_cast<const bf16x8*>(Kp + (long)(tb + sr) * rs + sc), k1 = *reinterpret_cast<const bf16x8*>(Kp + (long)(tb + 32 + sr) * rs + sc);
      *(bf16x8*)((char*)V_lds + vst0) = v0; *(bf16x8*)((char*)V_lds + vst1) = v1;
      *(bf16x8*)((char*)K_lds + KSWZ(sr, sc * 2)) = k0; *(bf16x8*)((char*)K_lds + KSWZ(32 + sr, sc * 2)) = k1; }
    __syncthreads();
    if (k >= klo && k < klo + NTW) {
      f32x16 p0, p1; float mn, al; bf16x8 pa0, pa1, pa2, pa3;
      qkt(p0, p1, K_lds, qr, r32, hi);
      if (k == klo || k == klo + NTW - 1) {
#pragma unroll
        for (int r = 0; r < 16; ++r) { const int d = qpos - (tb + crow(r, hi));
          if (d > WIN || d < -WIN) p0[r] = -1e30f;
          if (d - 32 > WIN || d - 32 < -WIN) p1[r] = -1e30f; }
      }
      partialSM(p0, p1, m_reg, mn, al);
      if (__any(al < 1.f)) { if (hi == 0) al_l[r32] = al; asm volatile("s_waitcnt lgkmcnt(0)" ::: "memory");
#pragma unroll
        for (int d = 0; d < 4; ++d)
#pragma unroll
          for (int r = 0; r < 16; ++r) o[d][r] *= al_l[crow(r, hi)]; }
      finishSM(p0, p1, al, l_reg, pa0, pa1, pa2, pa3); SBAR();
      pv_d0(o, vb0, pa0, pa1, pa2, pa3);
    }
  }
  if (hi == 0) li_l[r32] = l_reg; asm volatile("s_waitcnt lgkmcnt(0)" ::: "memory");
  float rli[16];
#pragma unroll
  for (int r = 0; r < 16; ++r) rli[r] = __builtin_amdgcn_rcpf(li_l[crow(r, hi)]);
  bf16* Ow = Ob + (long)(P0 + wid * QBLK) * os;
#pragma unroll
  for (int r = 0; r < 16; ++r) { const int orow = crow(r, hi);
#pragma unroll
    for (int d0 = 0; d0 < 4; ++d0) { const float val = o[d0][r] * rli[r]; Ow[(long)orow * os + d0 * 32 + r32] = (bf16)(cvtpk(val, val) & 0xffffu); } }
  if (Lp != nullptr && hi == 0) Lp[(long)(P0 + wid * QBLK + r32) * ls] = m_reg * SCALE + __logf(l_reg);
}
}
typedef unsigned short bf16_t;
typedef unsigned u32x4v __attribute__((ext_vector_type(4)));
#define LDSA __attribute__((address_space(3)))
constexpr size_t al256(size_t x) { return (x + 255) / 256 * 256; }
constexpr size_t WS_CTL  = 0;
constexpr size_t CTL_BYTES = 65536;
constexpr size_t WS_XB   = WS_CTL + CTL_BYTES;
constexpr size_t WS_WAB  = WS_XB + (size_t)SEQ * DM * 2;
constexpr size_t WS_WOAB = WS_WAB + (size_t)12288 * 4096 * 2;
constexpr size_t WS_WCD  = WS_WOAB + (size_t)4096 * 3072 * 2;
constexpr size_t WS_WOCD = WS_WCD + (size_t)9216 * 4096 * 2;
constexpr size_t WS_WQ   = WS_WOCD + (size_t)4096 * 4096 * 2;
constexpr size_t WS_UB   = WS_WQ + (size_t)2 * 2048 * 4096 * 2;
constexpr size_t WS_VB   = WS_UB + (size_t)2 * 16384 * 3072;
constexpr size_t WS_SU   = WS_VB + (size_t)2 * 16384 * 3072;
constexpr size_t WS_SV   = WS_SU + (size_t)2 * 16384 * 4;
constexpr size_t WS_H    = WS_SV + (size_t)2 * 16384 * 4;
constexpr size_t WS_Y    = WS_H;
constexpr size_t WS_PQ   = WS_H + (size_t)SEQ * 4096 * 4;
constexpr size_t WS_OC   = WS_H + (size_t)SEQ * 12288 * 4;
constexpr size_t WS_AB   = WS_OC + (size_t)2 * SEQ * 2048 * 4;
constexpr size_t WS_X1   = WS_AB + (size_t)SEQ * 4096 * 2;
constexpr size_t WS_X1B  = WS_X1 + (size_t)SEQ * 4096 * 4;
constexpr size_t WS_X2   = WS_X1B + (size_t)SEQ * 4096 * 2;
constexpr size_t WS_X2B  = WS_X2 + (size_t)SEQ * 4096 * 4;
constexpr size_t WS_EIDX = WS_X2B + (size_t)SEQ * 4096 * 2;
constexpr size_t WS_GATE = WS_EIDX + (size_t)SEQ * 128 * 4;
constexpr size_t WS_HB   = WS_GATE + (size_t)SEQ * 128 * 4;
constexpr size_t WS_KEYB = WS_HB + (size_t)SEQ * 12288 * 2;
constexpr size_t WS_CS0  = WS_KEYB + (size_t)2 * 8 * 2 * 128 * 128 * 2;
constexpr size_t WS_CSA  = WS_CS0 + (size_t)SEQ * 16 * 8;
constexpr size_t WS_END  = WS_CSA + (size_t)128 * 32 * 8;
static_assert(WS_END <= (size_t)2147483648ull, "workspace");

constexpr int LDS_BYTES = 155648;
constexpr int LDS_MISC = 139264;

struct MK { const float* in[21]; float* out; unsigned char* ws; int ph_lo, ph_hi; };

namespace pg8 {
struct EpiF32R {
    static constexpr bool PERM = false, AFTER_DRAIN = false;
    float* C; int ldc; const float* R; float ralpha;
    __device__ __forceinline__ void operator()(const f32x4 (&acc)[2][2][4][2], const Unit& u, int wr, int wc, int fr, int fq) const {
        const int row0 = u.pm * BM + wr * 64 + fr, col0 = u.pn * BM + wc * 32 + 4 * fq;
#pragma unroll
        for (int ai = 0; ai < 2; ++ai)
#pragma unroll
            for (int m = 0; m < 4; ++m) { const size_t off = (size_t)(row0 + ai * HALF + m * 16) * ldc + col0;
#pragma unroll
                for (int bj = 0; bj < 2; ++bj)
#pragma unroll
                    for (int n = 0; n < 2; ++n) { f32x4 v = acc[ai][bj][m][n];
                        if (R) { const f32x4 r = *(const f32x4*)(R + off + bj * HALF + n * 16); v += r * ralpha; }
                        *(f32x4*)(C + off + bj * HALF + n * 16) = v; } }
    }
};
struct EpiBf16P {
    static constexpr bool PERM = true, AFTER_DRAIN = false;
    bf16_t* O; int ldc;
    __device__ __forceinline__ void operator()(const f32x4 (&acc)[2][2][4][2], const Unit& u, int wr, int wc, int fr, int fq) const {
        const int row0 = u.pm * BM + wr * 64 + fr, col0 = u.pn * BM + wc * 32 + 8 * fq;
#pragma unroll
        for (int ai = 0; ai < 2; ++ai)
#pragma unroll
            for (int m = 0; m < 4; ++m) { bf16_t* rowp = O + (size_t)(row0 + ai * HALF + m * 16) * ldc + col0;
#pragma unroll
                for (int bj = 0; bj < 2; ++bj) { const f32x4 v0 = acc[ai][bj][m][0], v1 = acc[ai][bj][m][1];
                    u32x4 w; w.x = cvt_pk_bf16(v0[0], v0[1]); w.y = cvt_pk_bf16(v0[2], v0[3]); w.z = cvt_pk_bf16(v1[0], v1[1]); w.w = cvt_pk_bf16(v1[2], v1[3]);
                    *(u32x4*)(rowp + bj * HALF) = w; } }
    }
};

template <int LAYER> struct EpiProj {
    static constexpr bool PERM = true, AFTER_DRAIN = false;
    bf16_t* O; int ldc; const float* cs0; const float* csa; const float* gq; const float* gk; PG8_LAS float* xch;
    __device__ __forceinline__ void operator()(const f32x4 (&acc)[2][2][4][2], const Unit& u, int wr, int wc, int fr, int fq) const {
        const int row0 = u.pm * BM + wr * 64 + fr, col0 = u.pn * BM + wc * 32 + 8 * fq;
        const int pn = u.pn;
        const bool prope = LAYER == 0 ? (pn < 10 || (pn >= 12 && pn < 36)) : (pn < 16);
        const bool dnorm = LAYER == 1 && pn >= 24 && pn < 34;
        float rs[2][4][2];
        float gn[8];
        if (dnorm) {
            const int lrow = fr;
#pragma unroll
            for (int ai = 0; ai < 2; ++ai)
#pragma unroll
                for (int m = 0; m < 4; ++m)
#pragma unroll
                    for (int bj = 0; bj < 2; ++bj) { const f32x4 a = acc[ai][bj][m][0], b = acc[ai][bj][m][1];
                        float q = (a[0] * a[0] + a[1] * a[1]) + (a[2] * a[2] + a[3] * a[3]) + (b[0] * b[0] + b[1] * b[1]) + (b[2] * b[2] + b[3] * b[3]);
                        q += __shfl_xor(q, 16); q += __shfl_xor(q, 32);
                        if (fq == 0) xch[((wr * 128 + (ai * 4 + m) * 16 + lrow) * 2 + bj) * 4 + wc] = q; }
            asm volatile("s_waitcnt lgkmcnt(0)" ::: "memory"); __builtin_amdgcn_s_barrier(); asm volatile("" ::: "memory");
#pragma unroll
            for (int ai = 0; ai < 2; ++ai)
#pragma unroll
                for (int m = 0; m < 4; ++m)
#pragma unroll
                    for (int bj = 0; bj < 2; ++bj) { const f32x4 p = *(const PG8_LAS f32x4*)(xch + ((wr * 128 + (ai * 4 + m) * 16 + lrow) * 2 + bj) * 4);
                        rs[ai][m][bj] = 1.0f / sqrtf(((p[0] + p[1]) + (p[2] + p[3])) * (1.0f / 128.0f) + 1e-6f); }
            const float* g = pn < 32 ? gq : gk;
#pragma unroll
            for (int e = 0; e < 8; ++e) { const int p = wc * 32 + 8 * fq + e; const int orig = (p & 64) + ((p & 63) >> 1) + 32 * (p & 1); gn[e] = g[orig]; }
        }
        const bool rot = dnorm || (prope && wc == 0);
#pragma unroll
        for (int ai = 0; ai < 2; ++ai) {
            f32x4 cs[4][2];
            if (rot) {
#pragma unroll
                for (int m = 0; m < 4; ++m) { const int row = row0 + ai * HALF + m * 16;
                    const float* cp = dnorm ? csa + ((size_t)(wc < 2 ? (row >> 6) : (row & 63)) * 32 + 16 * (wc & 1) + 4 * fq) * 2 : cs0 + ((size_t)row * 16 + 4 * fq) * 2;
                    cs[m][0] = *(const f32x4*)cp; cs[m][1] = *(const f32x4*)(cp + 4); }
            }
#pragma unroll
            for (int m = 0; m < 4; ++m) {
                const int row = row0 + ai * HALF + m * 16;
                bf16_t* rowp = O + (size_t)row * ldc + col0;
                f32x4 c0 = (f32x4){1.f, 0.f, 1.f, 0.f}, c1 = c0;
                if (rot) { c0 = cs[m][0]; c1 = cs[m][1]; }
#pragma unroll
                for (int bj = 0; bj < 2; ++bj) { f32x4 v0 = acc[ai][bj][m][0], v1 = acc[ai][bj][m][1];
                    if (dnorm) { const float r = rs[ai][m][bj];
                        v0[0] *= r * gn[0]; v0[1] *= r * gn[1]; v0[2] *= r * gn[2]; v0[3] *= r * gn[3]; v1[0] *= r * gn[4]; v1[1] *= r * gn[5]; v1[2] *= r * gn[6]; v1[3] *= r * gn[7]; }
                    if (rot) {
                        const float a0 = v0[0] * c0[0] - v0[1] * c0[1], b0 = v0[1] * c0[0] + v0[0] * c0[1];
                        const float a1 = v0[2] * c0[2] - v0[3] * c0[3], b1 = v0[3] * c0[2] + v0[2] * c0[3];
                        const float a2 = v1[0] * c1[0] - v1[1] * c1[1], b2 = v1[1] * c1[0] + v1[0] * c1[1];
                        const float a3 = v1[2] * c1[2] - v1[3] * c1[3], b3 = v1[3] * c1[2] + v1[2] * c1[3];
                        v0 = (f32x4){a0, b0, a1, b1}; v1 = (f32x4){a2, b2, a3, b3}; }
                    u32x4 w; w.x = cvt_pk_bf16(v0[0], v0[1]); w.y = cvt_pk_bf16(v0[2], v0[3]); w.z = cvt_pk_bf16(v1[0], v1[1]); w.w = cvt_pk_bf16(v1[2], v1[3]);
                    *(u32x4*)(rowp + bj * HALF) = w; }
            }
            asm volatile("" ::: "memory");
        }
    }
};
}

__device__ __forceinline__ float bf_lo(unsigned w) { return __uint_as_float(w << 16); }
__device__ __forceinline__ float bf_hi(unsigned w) { return __uint_as_float(w & 0xffff0000u); }
__device__ __forceinline__ unsigned cvtpk_bf16(float lo, float hi) { unsigned r; asm volatile("v_cvt_pk_bf16_f32 %0, %1, %2" : "=v"(r) : "v"(lo), "v"(hi)); return r; }

__device__ __forceinline__ void cvt_rows_bf16(const float* __restrict__ src, bf16_t* __restrict__ dst, size_t n8, int bid, int nb, int tid, int nthr) {
    const size_t stride = (size_t)nb * nthr;
    for (size_t i = (size_t)bid * nthr + tid; i < n8; i += 4 * stride) {
        float4 a[4], b[4];
#pragma unroll
        for (int u = 0; u < 4; ++u) { const size_t j = i + u * stride; if (j < n8) { a[u] = *(const float4*)(src + j * 8); b[u] = *(const float4*)(src + j * 8 + 4); } }
#pragma unroll
        for (int u = 0; u < 4; ++u) { const size_t j = i + u * stride; if (j < n8) {
            u32x4v w; w.x = cvtpk_bf16(a[u].x, a[u].y); w.y = cvtpk_bf16(a[u].z, a[u].w); w.z = cvtpk_bf16(b[u].x, b[u].y); w.w = cvtpk_bf16(b[u].z, b[u].w);
            *(u32x4v*)(dst + j * 8) = w; } }
    }
}
template <class PM>
__device__ __forceinline__ void transpose_cvt(const float* __restrict__ W, bf16_t* __restrict__ Wt, int K, int N, LDSA float* tile0, int bid, int nb, PM pm, const int tid) {
    const int lane = tid & 63, wv = tid >> 6;
    LDSA float* tile = tile0 + wv * 4352;
    const int ntk = K / 64, ntn = N / 64;
    for (int t = bid * 8 + wv; t < ntk * ntn; t += nb * 8) {
        const int k0 = (t % ntk) * 64, n0 = (t / ntk) * 64;
        const int c = (lane & 15) * 4, r0 = lane >> 4;
        float4 v[16];
#pragma unroll
        for (int i = 0; i < 16; ++i) v[i] = *(const float4*)(W + (size_t)(k0 + r0 + 4 * i) * N + n0 + c);
#pragma unroll
        for (int i = 0; i < 16; ++i) { const int r = r0 + 4 * i; tile[r * 65 + c] = v[i].x; tile[r * 65 + c + 1] = v[i].y; tile[r * 65 + c + 2] = v[i].z; tile[r * 65 + c + 3] = v[i].w; }
        asm volatile("s_waitcnt lgkmcnt(0)" ::: "memory");
        const int mode = pm(n0);
#pragma unroll
        for (int h = 0; h < 8; ++h) {
            const int n = (lane >> 3) + 8 * h, kc = (lane & 7) * 8;
            int src = n;
            if (mode == 1) { if (n < 32) src = (n >> 1) + 16 * (n & 1); }
            else if (mode == 2) src = (n >> 1) + 32 * (n & 1);
            float f[8];
#pragma unroll
            for (int j = 0; j < 8; ++j) f[j] = tile[(kc + j) * 65 + src];
            u32x4v w; w.x = cvtpk_bf16(f[0], f[1]); w.y = cvtpk_bf16(f[2], f[3]); w.z = cvtpk_bf16(f[4], f[5]); w.w = cvtpk_bf16(f[6], f[7]);
            *(u32x4v*)(Wt + (size_t)(n0 + n) * K + k0 + kc) = w;
        }
        asm volatile("s_waitcnt lgkmcnt(0)" ::: "memory");
    }
}
struct PermNone { __device__ __forceinline__ int operator()(int) const { return 0; } };
struct PermAB { __device__ __forceinline__ int operator()(int n0) const { const bool rope = n0 < 2560 || (n0 >= 3072 && n0 < 9216); return (rope && (n0 & 127) == 0) ? 1 : 0; } };
struct PermCD { __device__ __forceinline__ int operator()(int n0) const { if (n0 < 4096) return (n0 & 127) == 0 ? 1 : 0; if (n0 >= 6144 && n0 < 8704) return 2; return 0; } };
__device__ __forceinline__ void rope_tables(float* __restrict__ cs0, float* __restrict__ csa, const int bid, const int G, const int tid) {
    for (int i = bid * 512 + tid; i < SEQ * 16; i += G * 512) { float s, c; sincos_rev((double)(i >> 4) * REV_P[i & 15], s, c); *(float2*)(cs0 + (size_t)i * 2) = make_float2(c, s); }
    for (int i = bid * 512 + tid; i < 128 * 32; i += G * 512) { float s, c; sincos_rev((double)(i >> 5) * REV_A[i & 31], s, c); *(float2*)(csa + (size_t)i * 2) = make_float2(c, s); }
}


typedef unsigned v6u_t __attribute__((ext_vector_type(6)));
typedef float f4v_t __attribute__((ext_vector_type(4)));
typedef unsigned v16u_t __attribute__((ext_vector_type(16)));
typedef float v16f_t __attribute__((ext_vector_type(16)));
typedef float v32f_t __attribute__((ext_vector_type(32)));
typedef __bf16 v32b_t __attribute__((ext_vector_type(32)));
constexpr int ROWB = 3072;
constexpr int XT_STRIDE = 68;
constexpr int XT_BYTES = 64 * XT_STRIDE * 4;
__device__ __forceinline__ void table_fp6(const float* __restrict__ src, unsigned char* __restrict__ dst, float* __restrict__ inv, const int rows, LDSA float* xt0, const int bid, const int G, const int tid) {
    const int lane = tid & 63, wv = tid >> 6;
    LDSA float* xt = xt0 + wv * (XT_BYTES / 4);
    for (int r = bid * 8 + wv; r < rows; r += G * 8) {
        float4 v[16]; float am = 0.f;
#pragma unroll
        for (int j = 0; j < 16; ++j) { v[j] = *(const float4*)(src + (size_t)r * DM + j * 256 + lane * 4); am = fmaxf(am, fmaxf(fmaxf(fabsf(v[j].x), fabsf(v[j].y)), fmaxf(fabsf(v[j].z), fabsf(v[j].w)))); }
        am = wave_max(am);
        const float sc = am > 0.f ? 7.0f / am : 1.0f;
#pragma unroll
        for (int j = 0; j < 16; ++j) *(LDSA f4v_t*)(xt + (4 * j + (lane >> 4)) * XT_STRIDE + 4 * (lane & 15)) = (f4v_t){v[j].x * sc, v[j].y * sc, v[j].z * sc, v[j].w * sc};
        asm volatile("s_waitcnt lgkmcnt(0)" ::: "memory");
        v16f_t f0, f1, f2, f3;
#pragma unroll
        for (int k = 0; k < 8; ++k) { const f4v_t a = *(const LDSA f4v_t*)(xt + lane * XT_STRIDE + 4 * k), c = *(const LDSA f4v_t*)(xt + lane * XT_STRIDE + 32 + 4 * k);
            f0[2 * k] = a[0]; f1[2 * k] = a[1]; f0[2 * k + 1] = a[2]; f1[2 * k + 1] = a[3];
            f2[2 * k] = c[0]; f3[2 * k] = c[1]; f2[2 * k + 1] = c[2]; f3[2 * k + 1] = c[3]; }
        asm volatile("s_waitcnt lgkmcnt(0)" ::: "memory");
        const v6u_t w0 = __builtin_amdgcn_cvt_scalef32_2xpk16_fp6_f32(f0, f1, 1.0f), w1 = __builtin_amdgcn_cvt_scalef32_2xpk16_fp6_f32(f2, f3, 1.0f);
        unsigned char* dp = dst + (size_t)r * ROWB + lane * 48;
        u32x4v s0, s1, s2; s0.x = w0[0]; s0.y = w0[1]; s0.z = w0[2]; s0.w = w0[3]; s1.x = w0[4]; s1.y = w0[5]; s1.z = w1[0]; s1.w = w1[1]; s2.x = w1[2]; s2.y = w1[3]; s2.z = w1[4]; s2.w = w1[5];
        *(u32x4v*)dp = s0; *(u32x4v*)(dp + 16) = s1; *(u32x4v*)(dp + 32) = s2;
        if (lane == 0) inv[r] = am > 0.f ? am * (1.0f / 7.0f) : 1.0f;
    }
}

typedef __bf16 bf2_t __attribute__((ext_vector_type(2)));
__device__ __forceinline__ float dot2_bf16(unsigned a, unsigned b, float c) { return __builtin_amdgcn_fdot2_f32_bf16(__builtin_bit_cast(bf2_t, a), __builtin_bit_cast(bf2_t, b), c, false); }
__device__ __forceinline__ float gelu_tanh_f(float x) {
    const float z = 0.7978845608028654f * (x + 0.044715f * x * x * x);
    const float e = __expf(2.0f * z);
    return 0.5f * x * (2.0f - 2.0f / (e + 1.0f));
}
__device__ __forceinline__ int pick_i(int a0, int a1, int k) { return k < 64 ? __builtin_amdgcn_readlane(a0, k) : __builtin_amdgcn_readlane(a1, k - 64); }
__device__ __forceinline__ float pick_f(float a0, float a1, int k) { return __int_as_float(pick_i(__float_as_int(a0), __float_as_int(a1), k)); }
#define PE_LOADROW(dst, base, e) do { const unsigned char* _p = (base) + (size_t)(e) * ROWB + lane * 48; dst[0] = *(const u32x4v*)_p; dst[1] = *(const u32x4v*)(_p + 16); dst[2] = *(const u32x4v*)(_p + 32); } while (0)
__device__ __forceinline__ float pe_dot(const u32x4v (&r)[3], const u32x4v (&x)[8]) {
    float d0 = 0.f, d1 = 0.f, d2 = 0.f, d3 = 0.f;
    { const v6u_t g = {r[0].x, r[0].y, r[0].z, r[0].w, r[1].x, r[1].y};
      const v16u_t z = __builtin_bit_cast(v16u_t, __builtin_amdgcn_cvt_scalef32_pk32_bf16_fp6(g, 1.0f));
#pragma unroll
      for (int k = 0; k < 4; ++k) { const unsigned xa = x[k].x, xb = x[k].y, xc = x[k].z, xd = x[k].w; const unsigned za = z[4 * k], zb = z[4 * k + 1], zc = z[4 * k + 2], zd = z[4 * k + 3];
          d0 = dot2_bf16(za, xa, d0); d1 = dot2_bf16(zb, xb, d1); d2 = dot2_bf16(zc, xc, d2); d3 = dot2_bf16(zd, xd, d3); }
      asm volatile("" : "+v"(d0), "+v"(d1), "+v"(d2), "+v"(d3)); }
    { const v6u_t g = {r[1].z, r[1].w, r[2].x, r[2].y, r[2].z, r[2].w};
      const v16u_t z = __builtin_bit_cast(v16u_t, __builtin_amdgcn_cvt_scalef32_pk32_bf16_fp6(g, 1.0f));
#pragma unroll
      for (int k = 0; k < 4; ++k) { const unsigned xa = x[4 + k].x, xb = x[4 + k].y, xc = x[4 + k].z, xd = x[4 + k].w; const unsigned za = z[4 * k], zb = z[4 * k + 1], zc = z[4 * k + 2], zd = z[4 * k + 3];
          d0 = dot2_bf16(za, xa, d0); d1 = dot2_bf16(zb, xb, d1); d2 = dot2_bf16(zc, xc, d2); d3 = dot2_bf16(zd, xd, d3); } }
    return wave_sum((d0 + d1) + (d2 + d3));
}
#define PE_PIN16(a, b) asm volatile("" : "+v"(a[b + 0]), "+v"(a[b + 1]), "+v"(a[b + 2]), "+v"(a[b + 3]), "+v"(a[b + 4]), "+v"(a[b + 5]), "+v"(a[b + 6]), "+v"(a[b + 7]), \
                                         "+v"(a[b + 8]), "+v"(a[b + 9]), "+v"(a[b + 10]), "+v"(a[b + 11]), "+v"(a[b + 12]), "+v"(a[b + 13]), "+v"(a[b + 14]), "+v"(a[b + 15]))
__device__ __forceinline__ void pe_axpy(float (&acc)[64], const u32x4v (&r)[3], const float w) {
    { const v6u_t g = {r[0].x, r[0].y, r[0].z, r[0].w, r[1].x, r[1].y};
      const v32f_t y = __builtin_amdgcn_cvt_scalef32_pk32_f32_fp6(g, 1.0f);
#pragma unroll
      for (int i = 0; i < 32; ++i) acc[i] = fmaf(w, y[i], acc[i]);
      PE_PIN16(acc, 0); PE_PIN16(acc, 16); }
    { const v6u_t g = {r[1].z, r[1].w, r[2].x, r[2].y, r[2].z, r[2].w};
      const v32f_t y = __builtin_amdgcn_cvt_scalef32_pk32_f32_fp6(g, 1.0f);
#pragma unroll
      for (int i = 0; i < 32; ++i) acc[32 + i] = fmaf(w, y[i], acc[32 + i]);
      PE_PIN16(acc, 32); PE_PIN16(acc, 48); }
}
__device__ __forceinline__ void peer_expert_phase(const float* __restrict__ x1, const bf16_t* __restrict__ x1b, const int* __restrict__ eidx, const float* __restrict__ gate,
                                                  const unsigned char* __restrict__ ub, const unsigned char* __restrict__ vb, const float* __restrict__ isu, const float* __restrict__ isv,
                                                  const float* __restrict__ lg, const float* __restrict__ lb, float* __restrict__ out, bf16_t* __restrict__ outb, LDSA float* xt0, const int bid, const int G, const int tid) {
    const int lane = tid & 63, wv = __builtin_amdgcn_readfirstlane(tid >> 6);
    LDSA float* xt = xt0 + wv * (XT_BYTES / 4);
    for (int t = bid * 8 + wv; t < SEQ; t += G * 8) {
        const int e0 = eidx[(size_t)t * 128 + lane], e1 = eidx[(size_t)t * 128 + 64 + lane];
        const float g0 = gate[(size_t)t * 128 + lane], g1 = gate[(size_t)t * 128 + 64 + lane];
        const float iu0 = isu[e0], iu1 = isu[e1], iv0 = isv[e0], iv1 = isv[e1];
        u32x4v xq[8];
#pragma unroll
        for (int k = 0; k < 8; ++k) xq[k] = *(const u32x4v*)(x1b + (size_t)t * DM + lane * 64 + k * 8);
        float w0 = 0.f, w1 = 0.f;
        u32x4v R0[3], R1[3], R2[3];
#define PE_E(k) pick_i(e0, e1, (k))
#define PE_USTEP(R, k) do { const float d = pe_dot(R, xq) * pick_f(iu0, iu1, (k)); const float w = pick_f(g0, g1, (k)) * gelu_tanh_f(d) * pick_f(iv0, iv1, (k)); \
            if (lane == ((k) & 63)) { if ((k) < 64) w0 = w; else w1 = w; } } while (0)
        PE_LOADROW(R0, ub, PE_E(0)); PE_LOADROW(R1, ub, PE_E(1));
        for (int k = 0; k < 126; k += 3) {
            PE_LOADROW(R2, ub, PE_E(k + 2)); PE_USTEP(R0, k);
            PE_LOADROW(R0, ub, PE_E(k + 3)); PE_USTEP(R1, k + 1);
            PE_LOADROW(R1, ub, PE_E(k + 4)); PE_USTEP(R2, k + 2);
        }
        PE_USTEP(R0, 126); PE_USTEP(R1, 127);
        float acc[64];
#pragma unroll
        for (int i = 0; i < 64; ++i) acc[i] = 0.f;
        PE_LOADROW(R0, vb, PE_E(0)); PE_LOADROW(R1, vb, PE_E(1));
        for (int k = 0; k < 126; k += 3) {
            PE_LOADROW(R2, vb, PE_E(k + 2)); pe_axpy(acc, R0, pick_f(w0, w1, k));
            PE_LOADROW(R0, vb, PE_E(k + 3)); pe_axpy(acc, R1, pick_f(w0, w1, k + 1));
            PE_LOADROW(R1, vb, PE_E(k + 4)); pe_axpy(acc, R2, pick_f(w0, w1, k + 2));
        }
        pe_axpy(acc, R0, pick_f(w0, w1, 126)); pe_axpy(acc, R1, pick_f(w0, w1, 127));
#undef PE_E
#undef PE_USTEP
#pragma unroll
        for (int k = 0; k < 16; ++k) *(LDSA f4v_t*)(xt + lane * XT_STRIDE + 4 * k) = (f4v_t){acc[4 * k], acc[4 * k + 1], acc[4 * k + 2], acc[4 * k + 3]};
        asm volatile("s_waitcnt lgkmcnt(0)" ::: "memory");
        float4 y[16]; float s = 0.f;
#pragma unroll
        for (int j = 0; j < 16; ++j) { const f4v_t f = *(const LDSA f4v_t*)(xt + (4 * j + (lane >> 4)) * XT_STRIDE + 4 * (lane & 15));
            const float4 xv = *(const float4*)(x1 + (size_t)t * DM + j * 256 + lane * 4);
            y[j].x = fmaf(ALPHA, xv.x, f.x); y[j].y = fmaf(ALPHA, xv.y, f.y); y[j].z = fmaf(ALPHA, xv.z, f.z); y[j].w = fmaf(ALPHA, xv.w, f.w);
            s += (y[j].x + y[j].y) + (y[j].z + y[j].w);
            if ((j & 3) == 3) asm volatile("" ::: "memory"); }
        asm volatile("s_waitcnt lgkmcnt(0)" ::: "memory");
        const float mean = wave_sum(s) * (1.0f / DM);
        float qq = 0.f;
#pragma unroll
        for (int j = 0; j < 16; ++j) { const float a = y[j].x - mean, b = y[j].y - mean, c = y[j].z - mean, d = y[j].w - mean; qq += (a * a + b * b) + (c * c + d * d); }
        const float rstd = 1.0f / sqrtf(wave_sum(qq) * (1.0f / DM) + 1e-5f);
#pragma unroll
        for (int j = 0; j < 16; ++j) {
            const int c = j * 256 + lane * 4;
            const float4 ga = *(const float4*)(lg + c), ba = *(const float4*)(lb + c);
            float4 oa; oa.x = (y[j].x - mean) * rstd * ga.x + ba.x; oa.y = (y[j].y - mean) * rstd * ga.y + ba.y; oa.z = (y[j].z - mean) * rstd * ga.z + ba.z; oa.w = (y[j].w - mean) * rstd * ga.w + ba.w;
            *(float4*)(out + (size_t)t * DM + c) = oa;
            if (outb) { uint2 w; w.x = cvtpk_bf16(oa.x, oa.y); w.y = cvtpk_bf16(oa.z, oa.w); *(uint2*)(outb + (size_t)t * DM + c) = w; }
            if ((j & 3) == 3) asm volatile("" ::: "memory");
        }
    }
}

__device__ __forceinline__ void attn1_phase(const bf16_t* __restrict__ hb, bf16_t* __restrict__ abb, float* __restrict__ oc, char* lds, const int bid, const int G, const int tid) {
    for (int u = bid; u < 512; u += G) {
        __syncthreads();
        const int kv = u >> 7, g = (u >> 5) & 3, qb = u & 31, hq = kv * 4 + g;
        att::attn_dense_body<att::bf16, 9216, 9216, 4096, att::bf16>(hb + (size_t)(qb * 256) * 9216 + 6144 + hq * 128, hb + 8192 + kv * 128, hb + 8704 + kv * 128,
                                                                       abb + (size_t)(qb * 256) * 4096 + 2048 + hq * 128, SEQ, lds, tid);
    }
    int tid2 = tid; asm volatile("" : "+v"(tid2));
    for (int v = bid; v < 1024; v += G) {
        __syncthreads();
        const int hm = v >> 6, vh = (v >> 5) & 1, qb = v & 31, h = hm >> 1, map = hm & 1;
        att::attn_dense_body<att::bf16, 9216, 9216, 2048, float>(hb + (size_t)(qb * 256) * 9216 + h * 256 + map * 128, hb + 2048 + h * 256 + map * 128, hb + 4096 + h * 256 + vh * 128,
                                                                   oc + (size_t)map * SEQ * 2048 + (size_t)(qb * 256) * 2048 + h * 256 + vh * 128, SEQ, lds, tid2);
    }
}


__device__ __forceinline__ void attn0_phase(const bf16_t* __restrict__ hb, const float* __restrict__ sink, bf16_t* __restrict__ abb, bf16_t* __restrict__ obg, float* __restrict__ lse, char* lds, const int bid, const int G, const int tid) {
    const long LD = 12288;
    for (int u = bid; u < 512; u += G) {
        __syncthreads();
        const int hq = u >> 5, qb = u & 31, kv = hq >> 2;
        att::attn_banded_body<128>(hb + hq * 128, hb + 2048 + kv * 128, hb + 2560 + kv * 128, LD, SEQ, qb * 256, sink[hq] * (1.0f / att::SCALE), 1.0f, abb + hq * 128, 3072, nullptr, 0, lds, tid);
    }
    int tid2 = tid; asm volatile("" : "+v"(tid2));
    for (int v = bid; v < 768; v += G) {
        __syncthreads();
        const int g = v >> 8, w = v & 255, h = w >> 5, rem = w & 31;
        const int dsh = 2 * g;
        const int nqb_sh = 5 - dsh;
        const int r = rem >> nqb_sh, qb = rem & ((1 << nqb_sh) - 1);
        const int head = 8 * g + h;
        const long rs = LD << dsh;
        att::attn_banded_body<64>(hb + (long)r * LD + 3072 + head * 128, hb + (long)r * LD + 6144 + head * 128, hb + (long)r * LD + 9216 + head * 128, rs, SEQ >> dsh, qb * 256, -1e30f, 0.f,
                                  obg + ((long)(g * 8 + h) * SEQ + r) * 128, (long)128 << dsh, lse + (long)(g * 8 + h) * SEQ + r, (long)1 << dsh, lds, tid2);
    }
}
__device__ __forceinline__ void merge0_phase(const bf16_t* __restrict__ obg, const float* __restrict__ lse, bf16_t* __restrict__ abb, const int bid, const int G, const int tid) {
    const int lane = tid & 63, wv = tid >> 6;
    for (int j = bid * 8 + wv; j < SEQ * 8; j += G * 8) {
        const int h = j >> 13, t = j & (SEQ - 1);
        const float l0 = lse[(size_t)(0 * 8 + h) * SEQ + t], l1 = lse[(size_t)(1 * 8 + h) * SEQ + t], l2 = lse[(size_t)(2 * 8 + h) * SEQ + t];
        const float mx = fmaxf(l0, fmaxf(l1, l2));
        const float e0 = __expf(l0 - mx), e1 = __expf(l1 - mx), e2 = __expf(l2 - mx), inv = 1.0f / (e0 + e1 + e2);
        const unsigned a0 = *(const unsigned*)(obg + ((size_t)(0 * 8 + h) * SEQ + t) * 128 + 2 * lane), a1 = *(const unsigned*)(obg + ((size_t)(1 * 8 + h) * SEQ + t) * 128 + 2 * lane), a2 = *(const unsigned*)(obg + ((size_t)(2 * 8 + h) * SEQ + t) * 128 + 2 * lane);
        const float x = (e0 * bf_lo(a0) + e1 * bf_lo(a1) + e2 * bf_lo(a2)) * inv, y = (e0 * bf_hi(a0) + e1 * bf_hi(a1) + e2 * bf_hi(a2)) * inv;
        *(unsigned*)(abb + (size_t)t * 3072 + 2048 + h * 128 + 2 * lane) = cvtpk_bf16(x, y);
    }
}

__device__ __forceinline__ void post_even_phase(const float* __restrict__ h, bf16_t* __restrict__ hb, const int bid, const int G, const int tid) {
    const int lane = tid & 63, wv = tid >> 6;
    for (int job = bid * 8 + wv; job < SEQ * 96; job += G * 8) {
        const int t = job / 96, blk = job - t * 96;
        const bool rope = (blk < 20) || (blk >= 24 && blk < 72);
        const float2 v = *(const float2*)(h + (size_t)t * 12288 + blk * 128 + 2 * lane);
        float o0 = v.x, o1 = v.y;
        const float p0 = __shfl_xor(v.x, 8), p1 = __shfl_xor(v.y, 8);
        if (rope && lane < 16) {
            const int i0 = (2 * lane) & 15;
            float s0, c0, s1, c1; sincos_rev((double)t * REV_P[i0], s0, c0); sincos_rev((double)t * REV_P[i0 + 1], s1, c1);
            if (lane < 8) { o0 = v.x * c0 - p0 * s0; o1 = v.y * c1 - p1 * s1; }
            else          { o0 = v.x * c0 + p0 * s0; o1 = v.y * c1 + p1 * s1; }
        }
        *(unsigned*)(hb + (size_t)t * 12288 + blk * 128 + 2 * lane) = cvtpk_bf16(o0, o1);
    }
}
__device__ __forceinline__ void post_odd_phase(const float* __restrict__ h, bf16_t* __restrict__ hb, const float* __restrict__ qg, const float* __restrict__ kg, const int bid, const int G, const int tid) {
    const int lane = tid & 63, wv = tid >> 6;
    for (int job = bid * 8 + wv; job < SEQ * 72; job += G * 8) {
        const int t = job / 72, blk = job - t * 72;
        const float2 v = *(const float2*)(h + (size_t)t * 9216 + blk * 128 + 2 * lane);
        float o0 = v.x, o1 = v.y;
        if (blk < 32) {
            const float p0 = __shfl_xor(v.x, 8), p1 = __shfl_xor(v.y, 8);
            if (lane < 16) {
                const int i0 = (2 * lane) & 15;
                float s0, c0, s1, c1; sincos_rev((double)t * REV_P[i0], s0, c0); sincos_rev((double)t * REV_P[i0 + 1], s1, c1);
                if (lane < 8) { o0 = v.x * c0 - p0 * s0; o1 = v.y * c1 - p1 * s1; }
                else          { o0 = v.x * c0 + p0 * s0; o1 = v.y * c1 + p1 * s1; }
            }
        } else if (blk >= 48 && blk < 68) {
            const float* g = blk < 64 ? qg : kg;
            const float ss = wave_sum(v.x * v.x + v.y * v.y) * (1.0f / 128.0f);
            const float rs = 1.0f / sqrtf(ss + 1e-6f);
            const float a0 = v.x * rs * g[2 * lane], a1 = v.y * rs * g[2 * lane + 1];
            const float p0 = __shfl_xor(a0, 16), p1 = __shfl_xor(a1, 16);
            const int i0 = (2 * lane) & 31;
            const double pos = (double)(lane < 32 ? (t >> 6) : (t & 63));
            float s0, c0, s1, c1; sincos_rev(pos * REV_A[i0], s0, c0); sincos_rev(pos * REV_A[i0 + 1], s1, c1);
            if ((lane & 16) == 0) { o0 = a0 * c0 - p0 * s0; o1 = a1 * c1 - p1 * s1; }
            else                  { o0 = a0 * c0 + p0 * s0; o1 = a1 * c1 + p1 * s1; }
        }
        *(unsigned*)(hb + (size_t)t * 9216 + blk * 128 + 2 * lane) = cvtpk_bf16(o0, o1);
    }
}

__device__ __forceinline__ void attn_seg_b(const float q0, const float q1, const bf16_t* __restrict__ Kb, const bf16_t* __restrict__ Vb, const int ld,
                                           const int t, const int step, int jlo, int jhi, float& m, float& l, float& o0, float& o1, const int lane) {
    { const int lo = -(t / step); if (jlo < lo) jlo = lo; const int hi = (SEQ - 1 - t) / step; if (jhi > hi) jhi = hi; }
    for (int j = jlo; j <= jhi; ++j) {
        const size_t tp = (size_t)(t + step * j);
        const unsigned kw = *(const unsigned*)(Kb + tp * ld + 2 * lane), vw = *(const unsigned*)(Vb + tp * ld + 2 * lane);
        const float s = wave_sum(q0 * bf_lo(kw) + q1 * bf_hi(kw)) * ATT_SCALE;
        const float mn = fmaxf(m, s);
        const float al = __expf(m - mn), p = __expf(s - mn);
        l = l * al + p;
        o0 = o0 * al + p * bf_lo(vw); o1 = o1 * al + p * bf_hi(vw);
        m = mn;
    }
}
__device__ __forceinline__ void attn_even_valu_phase(const bf16_t* __restrict__ hb, const float* __restrict__ sink, bf16_t* __restrict__ abb, const int bid, const int G, const int tid) {
    const int lane = tid & 63, wv = tid >> 6;
    const int LD = 12288;
    for (int job = bid * 8 + wv; job < SEQ * 24; job += G * 8) {
        const int hh = job / SEQ, t = job % SEQ;
        float o0 = 0.f, o1 = 0.f, m, l;
        if (hh < 16) {
            const int kv = hh >> 2;
            const unsigned qw = *(const unsigned*)(hb + (size_t)t * LD + hh * 128 + 2 * lane);
            m = sink[hh]; l = 1.f;
            attn_seg_b(bf_lo(qw), bf_hi(qw), hb + 2048 + kv * 128, hb + 2560 + kv * 128, LD, t, 1, -128, 128, m, l, o0, o1, lane);
        } else {
            const int hbh = hh - 16;
            m = -1e30f; l = 0.f;
#pragma unroll
            for (int g = 0; g < 3; ++g) {
                const int head = 8 * g + hbh; const int step = g == 0 ? 1 : (g == 1 ? 4 : 16);
                const unsigned qw = *(const unsigned*)(hb + (size_t)t * LD + 3072 + head * 128 + 2 * lane);
                attn_seg_b(bf_lo(qw), bf_hi(qw), hb + 6144 + head * 128, hb + 9216 + head * 128, LD, t, step, -64, 64, m, l, o0, o1, lane);
            }
        }
        const float il = 1.0f / l;
        *(unsigned*)(abb + (size_t)t * 3072 + hh * 128 + 2 * lane) = cvtpk_bf16(o0 * il, o1 * il);
    }
}

__device__ __forceinline__ void ln_phase(const float* __restrict__ y, const float* __restrict__ g, const float* __restrict__ b, float* __restrict__ out, bf16_t* __restrict__ outb, const int bid, const int G, const int tid) {
    const int lane = tid & 63, wv = tid >> 6;
    for (int t = bid * 8 + wv; t < SEQ; t += G * 8) {
        float4 v[16]; float s = 0.f;
#pragma unroll
        for (int i = 0; i < 16; ++i) { v[i] = *(const float4*)(y + (size_t)t * DM + i * 256 + lane * 4); s += (v[i].x + v[i].y) + (v[i].z + v[i].w); }
        const float mean = wave_sum(s) * (1.0f / DM);
        float q = 0.f;
#pragma unroll
        for (int i = 0; i < 16; ++i) { const float a = v[i].x - mean, bb = v[i].y - mean, c = v[i].z - mean, d = v[i].w - mean; q += (a * a + bb * bb) + (c * c + d * d); }
        const float rstd = 1.0f / sqrtf(wave_sum(q) * (1.0f / DM) + 1e-5f);
#pragma unroll
        for (int i = 0; i < 16; ++i) {
            const float4 gg = *(const float4*)(g + i * 256 + lane * 4), bb = *(const float4*)(b + i * 256 + lane * 4);
            float4 o; o.x = (v[i].x - mean) * rstd * gg.x + bb.x; o.y = (v[i].y - mean) * rstd * gg.y + bb.y; o.z = (v[i].z - mean) * rstd * gg.z + bb.z; o.w = (v[i].w - mean) * rstd * gg.w + bb.w;
            *(float4*)(out + (size_t)t * DM + i * 256 + lane * 4) = o;
            uint2 w; w.x = cvtpk_bf16(o.x, o.y); w.y = cvtpk_bf16(o.z, o.w); *(uint2*)(outb + (size_t)t * DM + i * 256 + lane * 4) = w;
            if ((i & 3) == 3) asm volatile("" ::: "memory");
        }
    }
}

__device__ __forceinline__ void route_valu_phase(const float* __restrict__ q  , const float* __restrict__ keys  , int* __restrict__ eidx, float* __restrict__ gate, const int bid, const int G, const int tid) {
    const int lane = tid & 63, wv = tid >> 6;
    for (int job = bid * 8 + wv; job < SEQ * 8; job += G * 8) {
        const int hh = job & 7, t = job >> 3;
        float sv0 = 0.f, sv1 = 0.f; int si0 = 0, si1 = 0;
#pragma unroll
        for (int c = 0; c < 2; ++c) {
            const float* qq = q + (size_t)t * 2048 + hh * 256 + c * 128;
            const float* k0 = keys + ((size_t)(hh * 2 + c) * 128 + lane) * 128;
            const float* k1 = k0 + 64 * 128;
            float s0 = 0.f, s1 = 0.f;
            for (int d = 0; d < 128; d += 4) {
                const float4 qv = *(const float4*)(qq + d), a = *(const float4*)(k0 + d), b = *(const float4*)(k1 + d);
                s0 += qv.x * a.x + qv.y * a.y + qv.z * a.z + qv.w * a.w;
                s1 += qv.x * b.x + qv.y * b.y + qv.z * b.z + qv.w * b.w;
            }
            float myv = 0.f; int myi = 0;
            for (int k = 0; k < 16; ++k) {
                float bv; int bi;
                if (s1 > s0) { bv = s1; bi = lane + 64; } else { bv = s0; bi = lane; }
#pragma unroll
                for (int o = 32; o >= 1; o >>= 1) {
                    const float ov = __shfl_xor(bv, o); const int oi = __shfl_xor(bi, o);
                    if (ov > bv || (ov == bv && oi < bi)) { bv = ov; bi = oi; }
                }
                if (lane == k) { myv = bv; myi = bi; }
                if (bi == lane) s0 = -3.0e38f;
                if (bi == lane + 64) s1 = -3.0e38f;
            }
            if (c == 0) { sv0 = myv; si0 = myi; } else { sv1 = myv; si1 = myi; }
        }
        float cv0, cv1, cv2, cv3; int ci0, ci1, ci2, ci3;
        { const float a = __shfl(sv0, lane >> 2); const int ai = __shfl(si0, lane >> 2); const int jb = (lane & 3) * 4;
          cv0 = a + __shfl(sv1, jb + 0); ci0 = ai * 128 + __shfl(si1, jb + 0);
          cv1 = a + __shfl(sv1, jb + 1); ci1 = ai * 128 + __shfl(si1, jb + 1);
          cv2 = a + __shfl(sv1, jb + 2); ci2 = ai * 128 + __shfl(si1, jb + 2);
          cv3 = a + __shfl(sv1, jb + 3); ci3 = ai * 128 + __shfl(si1, jb + 3); }
        float tv = 0.f; int te = 0;
        for (int k = 0; k < 16; ++k) {
            float bv = cv0; int bp = lane * 4, be = ci0;
            if (cv1 > bv) { bv = cv1; bp = lane * 4 + 1; be = ci1; }
            if (cv2 > bv) { bv = cv2; bp = lane * 4 + 2; be = ci2; }
            if (cv3 > bv) { bv = cv3; bp = lane * 4 + 3; be = ci3; }
#pragma unroll
            for (int o = 32; o >= 1; o >>= 1) {
                const float ov = __shfl_xor(bv, o); const int op = __shfl_xor(bp, o); const int oe = __shfl_xor(be, o);
                if (ov > bv || (ov == bv && op < bp)) { bv = ov; bp = op; be = oe; }
            }
            if (lane == k) { tv = bv; te = be; }
            if (bp == lane * 4 + 0) cv0 = -3.0e38f;
            if (bp == lane * 4 + 1) cv1 = -3.0e38f;
            if (bp == lane * 4 + 2) cv2 = -3.0e38f;
            if (bp == lane * 4 + 3) cv3 = -3.0e38f;
        }
        const float v = lane < 16 ? tv : -3.0e38f;
        const float mx = wave_max(v);
        const float e = lane < 16 ? __expf(tv - mx) : 0.f;
        const float den = wave_sum(e);
        if (lane < 16) { eidx[(size_t)t * 128 + hh * 16 + lane] = te; gate[(size_t)t * 128 + hh * 16 + lane] = e / den; }
    }
}
namespace rt {
using att::f32x16; using att::bf16x8;
__device__ __forceinline__ float pair_max(float m) {
    auto rr = __builtin_amdgcn_permlane32_swap(__float_as_uint(m), __float_as_uint(m), false, false);
    return fmaxf(__uint_as_float(rr[0]), __uint_as_float(rr[1]));
}
__device__ __forceinline__ int pair_max_i(int m) {
    auto rr = __builtin_amdgcn_permlane32_swap((unsigned)m, (unsigned)m, false, false);
    const int a = (int)rr[0], b = (int)rr[1]; return a > b ? a : b;
}
__device__ __forceinline__ void top16_of_128(f32x16& p0, f32x16& p1, f32x16& p2, f32x16& p3, float (&t)[16]) {
#pragma unroll
    for (int k = 0; k < 16; ++k) {
        float m = p0[0];
#pragma unroll
        for (int r = 1; r < 16; ++r) m = fmaxf(m, p0[r]);
#pragma unroll
        for (int r = 0; r < 16; ++r) m = fmaxf(m, fmaxf(p1[r], fmaxf(p2[r], p3[r])));
        m = pair_max(m);
        t[k] = m;
#pragma unroll
        for (int r = 0; r < 16; ++r) { p0[r] = p0[r] == m ? -3.0e38f : p0[r]; p1[r] = p1[r] == m ? -3.0e38f : p1[r]; p2[r] = p2[r] == m ? -3.0e38f : p2[r]; p3[r] = p3[r] == m ? -3.0e38f : p3[r]; }
    }
}
__device__ __forceinline__ void tag_scores(f32x16& p, const int base, const int hi) {
#pragma unroll
    for (int r = 0; r < 16; ++r) p[r] = __uint_as_float((__float_as_uint(p[r]) & ~0x7Fu) | (unsigned)(base + att::crow(r, hi)));
}
}

__device__ __forceinline__ void route_mfma_phase(const bf16_t* __restrict__ pqb  , const bf16_t* __restrict__ keysb  , int* __restrict__ eidx, float* __restrict__ gate,
                                                 char* lds, const int bid, const int G, const int tid) {
    using namespace rt;
    const int wid = __builtin_amdgcn_readfirstlane(tid >> 6), lane = tid & 63, r32 = lane & 31, hi = lane >> 5;
    att::bf16* K_lds = (att::bf16*)lds;
    for (int u = bid; u < 256; u += G) {
        const int h = u & 7, tb = (u >> 3) * 256;
        const int tok = tb + wid * 32 + r32;
        float t0[16], t1[16];
#pragma unroll
        for (int c = 0; c < 2; ++c) {
            __syncthreads();
            { const bf16_t* kp = keysb + (size_t)(h * 2 + c) * 128 * 128;
              const int row = tid >> 2;
#pragma unroll
              for (int i = 0; i < 4; ++i) { const int sc = ((tid & 3) * 4 + i) * 8;
                  const bf16x8 v = *reinterpret_cast<const bf16x8*>(kp + row * 128 + sc);
                  *(bf16x8*)((char*)K_lds + (row >> 6) * 16384 + KSWZ(row & 63, sc * 2)) = v; } }
            bf16x8 qr[8];
            { const bf16_t* qw = pqb + (size_t)tok * 2048 + h * 256 + c * 128 + hi * 8;
#pragma unroll
              for (int d0 = 0; d0 < 8; ++d0) qr[d0] = *reinterpret_cast<const bf16x8*>(qw + d0 * 16); }
            __syncthreads();
            f32x16 p0, p1, p2, p3;
            att::qkt(p0, p1, K_lds, qr, r32, hi);
            att::qkt(p2, p3, (att::bf16*)((char*)K_lds + 16384), qr, r32, hi);
            tag_scores(p0, 0, hi); tag_scores(p1, 32, hi); tag_scores(p2, 64, hi); tag_scores(p3, 96, hi);
            if (c == 0) top16_of_128(p0, p1, p2, p3, t0); else top16_of_128(p0, p1, p2, p3, t1);
        }
        float v0[16], v1[16]; int k0[16], k1[16];
#pragma unroll
        for (int i = 0; i < 16; ++i) { const unsigned a = __float_as_uint(t0[i]), b = __float_as_uint(t1[i]);
            v0[i] = __uint_as_float(a & ~0x7Fu); v1[i] = __uint_as_float(b & ~0x7Fu); k0[i] = (int)((a & 0x7Fu) << 7); k1[i] = (int)(b & 0x7Fu); }
        float cv[25]; int ce[25];
    { const float s = hi ? (v0[0] + v1[1]) : (v0[0] + v1[0]); cv[0] = __uint_as_float((__float_as_uint(s) & ~0xFFu) | (unsigned)(2 * 0 + hi)); ce[0] = hi ? (k0[0] | k1[1]) : (k0[0] | k1[0]); }
    { const float s = hi ? (v0[0] + v1[3]) : (v0[0] + v1[2]); cv[1] = __uint_as_float((__float_as_uint(s) & ~0xFFu) | (unsigned)(2 * 1 + hi)); ce[1] = hi ? (k0[0] | k1[3]) : (k0[0] | k1[2]); }
    { const float s = hi ? (v0[0] + v1[5]) : (v0[0] + v1[4]); cv[2] = __uint_as_float((__float_as_uint(s) & ~0xFFu) | (unsigned)(2 * 2 + hi)); ce[2] = hi ? (k0[0] | k1[5]) : (k0[0] | k1[4]); }
    { const float s = hi ? (v0[0] + v1[7]) : (v0[0] + v1[6]); cv[3] = __uint_as_float((__float_as_uint(s) & ~0xFFu) | (unsigned)(2 * 3 + hi)); ce[3] = hi ? (k0[0] | k1[7]) : (k0[0] | k1[6]); }
    { const float s = hi ? (v0[0] + v1[9]) : (v0[0] + v1[8]); cv[4] = __uint_as_float((__float_as_uint(s) & ~0xFFu) | (unsigned)(2 * 4 + hi)); ce[4] = hi ? (k0[0] | k1[9]) : (k0[0] | k1[8]); }
    { const float s = hi ? (v0[0] + v1[11]) : (v0[0] + v1[10]); cv[5] = __uint_as_float((__float_as_uint(s) & ~0xFFu) | (unsigned)(2 * 5 + hi)); ce[5] = hi ? (k0[0] | k1[11]) : (k0[0] | k1[10]); }
    { const float s = hi ? (v0[0] + v1[13]) : (v0[0] + v1[12]); cv[6] = __uint_as_float((__float_as_uint(s) & ~0xFFu) | (unsigned)(2 * 6 + hi)); ce[6] = hi ? (k0[0] | k1[13]) : (k0[0] | k1[12]); }
    { const float s = hi ? (v0[0] + v1[15]) : (v0[0] + v1[14]); cv[7] = __uint_as_float((__float_as_uint(s) & ~0xFFu) | (unsigned)(2 * 7 + hi)); ce[7] = hi ? (k0[0] | k1[15]) : (k0[0] | k1[14]); }
    { const float s = hi ? (v0[1] + v1[1]) : (v0[1] + v1[0]); cv[8] = __uint_as_float((__float_as_uint(s) & ~0xFFu) | (unsigned)(2 * 8 + hi)); ce[8] = hi ? (k0[1] | k1[1]) : (k0[1] | k1[0]); }
    { const float s = hi ? (v0[1] + v1[3]) : (v0[1] + v1[2]); cv[9] = __uint_as_float((__float_as_uint(s) & ~0xFFu) | (unsigned)(2 * 9 + hi)); ce[9] = hi ? (k0[1] | k1[3]) : (k0[1] | k1[2]); }
    { const float s = hi ? (v0[1] + v1[5]) : (v0[1] + v1[4]); cv[10] = __uint_as_float((__float_as_uint(s) & ~0xFFu) | (unsigned)(2 * 10 + hi)); ce[10] = hi ? (k0[1] | k1[5]) : (k0[1] | k1[4]); }
    { const float s = hi ? (v0[1] + v1[7]) : (v0[1] + v1[6]); cv[11] = __uint_as_float((__float_as_uint(s) & ~0xFFu) | (unsigned)(2 * 11 + hi)); ce[11] = hi ? (k0[1] | k1[7]) : (k0[1] | k1[6]); }
    { const float s = hi ? (v0[2] + v1[1]) : (v0[2] + v1[0]); cv[12] = __uint_as_float((__float_as_uint(s) & ~0xFFu) | (unsigned)(2 * 12 + hi)); ce[12] = hi ? (k0[2] | k1[1]) : (k0[2] | k1[0]); }
    { const float s = hi ? (v0[2] + v1[3]) : (v0[2] + v1[2]); cv[13] = __uint_as_float((__float_as_uint(s) & ~0xFFu) | (unsigned)(2 * 13 + hi)); ce[13] = hi ? (k0[2] | k1[3]) : (k0[2] | k1[2]); }
    { const float s = hi ? (v0[3] + v1[0]) : (v0[2] + v1[4]); cv[14] = __uint_as_float((__float_as_uint(s) & ~0xFFu) | (unsigned)(2 * 14 + hi)); ce[14] = hi ? (k0[3] | k1[0]) : (k0[2] | k1[4]); }
    { const float s = hi ? (v0[3] + v1[2]) : (v0[3] + v1[1]); cv[15] = __uint_as_float((__float_as_uint(s) & ~0xFFu) | (unsigned)(2 * 15 + hi)); ce[15] = hi ? (k0[3] | k1[2]) : (k0[3] | k1[1]); }
    { const float s = hi ? (v0[4] + v1[0]) : (v0[3] + v1[3]); cv[16] = __uint_as_float((__float_as_uint(s) & ~0xFFu) | (unsigned)(2 * 16 + hi)); ce[16] = hi ? (k0[4] | k1[0]) : (k0[3] | k1[3]); }
    { const float s = hi ? (v0[4] + v1[2]) : (v0[4] + v1[1]); cv[17] = __uint_as_float((__float_as_uint(s) & ~0xFFu) | (unsigned)(2 * 17 + hi)); ce[17] = hi ? (k0[4] | k1[2]) : (k0[4] | k1[1]); }
    { const float s = hi ? (v0[5] + v1[1]) : (v0[5] + v1[0]); cv[18] = __uint_as_float((__float_as_uint(s) & ~0xFFu) | (unsigned)(2 * 18 + hi)); ce[18] = hi ? (k0[5] | k1[1]) : (k0[5] | k1[0]); }
    { const float s = hi ? (v0[6] + v1[1]) : (v0[6] + v1[0]); cv[19] = __uint_as_float((__float_as_uint(s) & ~0xFFu) | (unsigned)(2 * 19 + hi)); ce[19] = hi ? (k0[6] | k1[1]) : (k0[6] | k1[0]); }
    { const float s = hi ? (v0[7] + v1[1]) : (v0[7] + v1[0]); cv[20] = __uint_as_float((__float_as_uint(s) & ~0xFFu) | (unsigned)(2 * 20 + hi)); ce[20] = hi ? (k0[7] | k1[1]) : (k0[7] | k1[0]); }
    { const float s = hi ? (v0[9] + v1[0]) : (v0[8] + v1[0]); cv[21] = __uint_as_float((__float_as_uint(s) & ~0xFFu) | (unsigned)(2 * 21 + hi)); ce[21] = hi ? (k0[9] | k1[0]) : (k0[8] | k1[0]); }
    { const float s = hi ? (v0[11] + v1[0]) : (v0[10] + v1[0]); cv[22] = __uint_as_float((__float_as_uint(s) & ~0xFFu) | (unsigned)(2 * 22 + hi)); ce[22] = hi ? (k0[11] | k1[0]) : (k0[10] | k1[0]); }
    { const float s = hi ? (v0[13] + v1[0]) : (v0[12] + v1[0]); cv[23] = __uint_as_float((__float_as_uint(s) & ~0xFFu) | (unsigned)(2 * 23 + hi)); ce[23] = hi ? (k0[13] | k1[0]) : (k0[12] | k1[0]); }
    { const float s = hi ? (v0[15] + v1[0]) : (v0[14] + v1[0]); cv[24] = __uint_as_float((__float_as_uint(s) & ~0xFFu) | (unsigned)(2 * 24 + hi)); ce[24] = hi ? (k0[15] | k1[0]) : (k0[14] | k1[0]); }
        float ts[16]; int te[16];
#pragma unroll
        for (int k = 0; k < 16; ++k) {
            float m = cv[0];
#pragma unroll
            for (int n = 1; n < 25; ++n) m = fmaxf(m, cv[n]);
            m = pair_max(m);
            int e = -1;
#pragma unroll
            for (int n = 0; n < 25; ++n) { const bool hit = cv[n] == m; e = hit ? ce[n] : e; cv[n] = hit ? -3.0e38f : cv[n]; }
            ts[k] = __uint_as_float(__float_as_uint(m) & ~0xFFu); te[k] = pair_max_i(e);
        }
        float den = 0.f; const float mx = ts[0];
#pragma unroll
        for (int k = 0; k < 16; ++k) { ts[k] = __expf(ts[k] - mx); den += ts[k]; }
        const float inv = 1.0f / den;
        if (hi == 0) { int4* op = (int4*)(eidx + (size_t)tok * 128 + h * 16);
            op[0] = make_int4(te[0], te[1], te[2], te[3]); op[1] = make_int4(te[4], te[5], te[6], te[7]); op[2] = make_int4(te[8], te[9], te[10], te[11]); op[3] = make_int4(te[12], te[13], te[14], te[15]); }
        else { float4* op = (float4*)(gate + (size_t)tok * 128 + h * 16);
            op[0] = make_float4(ts[0] * inv, ts[1] * inv, ts[2] * inv, ts[3] * inv); op[1] = make_float4(ts[4] * inv, ts[5] * inv, ts[6] * inv, ts[7] * inv);
            op[2] = make_float4(ts[8] * inv, ts[9] * inv, ts[10] * inv, ts[11] * inv); op[3] = make_float4(ts[12] * inv, ts[13] * inv, ts[14] * inv, ts[15] * inv); }
    }
}
#ifndef PH_MASK
#define PH_MASK 0xffffffffu
#endif
constexpr int N_PHASES = 20;
__global__ void __launch_bounds__(512, 2) mega(MK a) {
    extern __shared__ __attribute__((aligned(16))) unsigned char lds_raw[];
    LDSA unsigned char* lds = (LDSA unsigned char*)lds_raw;
    const int lo = a.ph_lo, hi = a.ph_hi;
    const int G = gridDim.x, bid = blockIdx.x;
    const int wid_s = __builtin_amdgcn_readfirstlane(threadIdx.x >> 6);
    unsigned char* ws = a.ws;
#define PH_TID() int tid; { int _z = 0; asm volatile("" : "+s"(_z)); tid = wid_s * 64 + (int)__builtin_amdgcn_mbcnt_hi(~0u, __builtin_amdgcn_mbcnt_lo(~0u, (unsigned)_z)); }
#define WSP(T, name, off) T* name; { unsigned char* _b = ws; asm volatile("" : "+s"(_b)); name = (T*)(_b + (off)); }
#define IN(k) ((((PH_MASK) >> (k)) & 1u) && lo <= (k) && (k) < hi)
#define SEAM(k) do { if ((k) + 1 < hi) { PH_TID() xcd_barrier(bar, tid); } } while (0)
    XcdBarrier bar;
    { PH_TID()
      volatile LAS unsigned* st = (volatile LAS unsigned*)(lds + LDS_MISC);
      if (tid == 0) { st[0] = 0u; st[1] = 0u; }
      __syncthreads();
      bar = xcd_barrier_post((unsigned*)(ws + WS_CTL), st, tid); }

    if (IN(0)) {
        PH_TID()
        WSP(bf16_t, xb, WS_XB) WSP(bf16_t, wab, WS_WAB) WSP(bf16_t, woab, WS_WOAB) WSP(bf16_t, wcd, WS_WCD) WSP(bf16_t, wocd, WS_WOCD) WSP(bf16_t, wq, WS_WQ) WSP(unsigned char, ub, WS_UB) WSP(unsigned char, vb, WS_VB) WSP(float, isu, WS_SU) WSP(float, isv, WS_SV)
        cvt_rows_bf16(a.in[0], xb, (size_t)SEQ * DM / 8, bid, G, tid, 512);
        LDSA float* tile = (LDSA float*)lds;
        transpose_cvt(a.in[1], wab, 4096, 12288, tile, bid, G, PermAB(), tid);
        transpose_cvt(a.in[3], woab, 3072, 4096, tile, bid, G, PermNone(), tid);
        transpose_cvt(a.in[4], wcd, 4096, 9216, tile, bid, G, PermCD(), tid);
        transpose_cvt(a.in[12], wocd, 4096, 4096, tile, bid, G, PermNone(), tid);
        transpose_cvt(a.in[15], wq, 4096, 2048, tile, bid, G, PermNone(), tid);
        transpose_cvt(a.in[15] + (size_t)4096 * 2048, wq + (size_t)2048 * 4096, 4096, 2048, tile, bid, G, PermNone(), tid);
        table_fp6(a.in[17], ub, isu, 2 * 16384, (LDSA float*)lds, bid, G, tid);
        table_fp6(a.in[18], vb, isv, 2 * 16384, (LDSA float*)lds, bid, G, tid);
        { WSP(float, cs0, WS_CS0) WSP(float, csa, WS_CSA) rope_tables(cs0, csa, bid, G, tid); }
        { WSP(bf16_t, keyb, WS_KEYB) cvt_rows_bf16(a.in[16], keyb, (size_t)2 * 8 * 2 * 128 * 128 / 8, bid, G, tid, 512); }
        SEAM(0);
    }
    { constexpr int layer = 0;
        const int pb = 1 + 10 * layer;
        if (IN(pb + 0)) {
            PH_TID() WSP(bf16_t, xb, WS_XB) WSP(bf16_t, x2b, WS_X2B) WSP(bf16_t, wab, WS_WAB) WSP(bf16_t, wcd, WS_WCD) WSP(bf16_t, hb, WS_HB) WSP(float, cs0, WS_CS0) WSP(float, csa, WS_CSA)
            if (layer == 0) {
                pg8::Gemm g{xb, wab, SEQ, 12288, 4096}; pg8::StaticOrder S; S.init(SEQ, 12288, G, bid);
                pg8::EpiProj<0> E{hb, 12288, cs0, csa, nullptr, nullptr, (LDSA float*)(lds + LDS_MISC + 64)};
                pg8::gemm_phase<pg8::EpiProj<0>, pg8::StaticOrder>(lds, g, S, E, nullptr, tid);
#ifdef PROBE_GEMM2
                pg8::gemm_phase<pg8::EpiProj<0>, pg8::StaticOrder>(lds, g, S, E, nullptr, tid);
#endif
            } else {
                pg8::Gemm g{x2b, wcd, SEQ, 9216, 4096}; pg8::StaticOrder S; S.init(SEQ, 9216, G, bid);
                pg8::EpiProj<1> E{hb, 9216, cs0, csa, a.in[10], a.in[11], (LDSA float*)(lds + LDS_MISC + 64)};
                pg8::gemm_phase<pg8::EpiProj<1>, pg8::StaticOrder>(lds, g, S, E, nullptr, tid);
            }
            SEAM(pb + 0);
        }
        if (IN(pb + 2)) {
            PH_TID() WSP(bf16_t, hb, WS_HB) WSP(bf16_t, abb, WS_AB) WSP(float, oc, WS_OC)
            if (layer == 0) attn0_phase(hb, a.in[2], abb, (bf16_t*)oc, (float*)((unsigned char*)oc + (size_t)3 * 8 * SEQ * 128 * 2), (char*)lds_raw, bid, G, tid);
            else attn1_phase(hb, abb, oc, (char*)lds_raw, bid, G, tid);
#ifdef PROBE_ATTN2
            if (layer == 1) { __syncthreads(); int t3 = tid; asm volatile("" : "+v"(t3)); attn1_phase(hb, abb, oc, (char*)lds_raw, bid, G, t3); }
#endif
            SEAM(pb + 2);
        }
        if (layer == 0) {
            if (IN(pb + 3)) {
                PH_TID() WSP(bf16_t, abb, WS_AB) WSP(float, oc, WS_OC)
                merge0_phase((const bf16_t*)oc, (const float*)((unsigned char*)oc + (size_t)3 * 8 * SEQ * 128 * 2), abb, bid, G, tid);
                SEAM(pb + 3);
            }
        } else {
            if (IN(pb + 3)) {
                PH_TID() WSP(bf16_t, abb, WS_AB) WSP(float, oc, WS_OC)
                const int lane = tid & 63, wv = tid >> 6;
                const float* lq1 = a.in[5]; const float* lk1 = a.in[6]; const float* lq2 = a.in[7]; const float* lk2 = a.in[8]; const float* subg = a.in[9];
                const float lam = __expf(wave_sum(lq1[lane] * lk1[lane] + lq1[lane + 64] * lk1[lane + 64])) - __expf(wave_sum(lq2[lane] * lk2[lane] + lq2[lane + 64] * lk2[lane + 64])) + LAMBDA_INIT;
                const float4 sg = *(const float4*)(subg + 4 * lane);
                for (int j = bid * 8 + wv; j < SEQ * 8; j += G * 8) {
                    const int t = j >> 3, h = j & 7;
                    const float4 o1 = *(const float4*)(oc + (size_t)t * 2048 + h * 256 + 4 * lane), o2 = *(const float4*)(oc + (size_t)SEQ * 2048 + (size_t)t * 2048 + h * 256 + 4 * lane);
                    const float ox = o1.x - lam * o2.x, oy = o1.y - lam * o2.y, oz = o1.z - lam * o2.z, ow = o1.w - lam * o2.w;
                    const float ss = wave_sum((ox * ox + oy * oy) + (oz * oz + ow * ow)) * (1.0f / 256.0f);
                    const float rs = (1.0f - LAMBDA_INIT) / sqrtf(ss + 1e-6f);
                    uint2 w; w.x = cvtpk_bf16(ox * rs * sg.x, oy * rs * sg.y); w.y = cvtpk_bf16(oz * rs * sg.z, ow * rs * sg.w);
                    *(uint2*)(abb + (size_t)t * 4096 + h * 256 + 4 * lane) = w;
                }
                SEAM(pb + 3);
            }
        }
        if (IN(pb + 4)) {
            const int K = layer == 0 ? 3072 : 4096;
            PH_TID() WSP(bf16_t, abb, WS_AB) WSP(bf16_t, woab, WS_WOAB) WSP(bf16_t, wocd, WS_WOCD) WSP(float, ybuf, WS_Y) WSP(float, x2, WS_X2)
            pg8::Gemm g{abb, layer == 0 ? woab : wocd, SEQ, 4096, K}; pg8::StaticOrder S; S.init(SEQ, 4096, G, bid);
            pg8::EpiF32R E{ybuf, 4096, layer == 0 ? a.in[0] : (const float*)x2, ALPHA};
            pg8::gemm_phase<pg8::EpiF32R, pg8::StaticOrder>(lds, g, S, E, nullptr, tid);
            SEAM(pb + 4);
        }
        if (IN(pb + 5)) {
            PH_TID() WSP(float, ybuf, WS_Y) WSP(float, x1, WS_X1) WSP(bf16_t, x1b, WS_X1B)
            ln_phase(ybuf, a.in[13] + layer * DM, a.in[14] + layer * DM, x1, x1b, bid, G, tid);
            SEAM(pb + 5);
        }
        if (IN(pb + 6)) {
            PH_TID() WSP(bf16_t, x1b, WS_X1B) WSP(bf16_t, wq, WS_WQ) WSP(bf16_t, pqb, WS_PQ)
            pg8::Gemm g{x1b, wq + (size_t)layer * 2048 * 4096, SEQ, 2048, 4096}; pg8::StaticOrder S; S.init(SEQ, 2048, G, bid);
            pg8::EpiBf16P E{pqb, 2048};
            pg8::gemm_phase<pg8::EpiBf16P, pg8::StaticOrder>(lds, g, S, E, nullptr, tid);
            SEAM(pb + 6);
        }
        if (IN(pb + 7)) {
            PH_TID() WSP(bf16_t, pqb, WS_PQ) WSP(bf16_t, keyb, WS_KEYB) WSP(int, eidx, WS_EIDX) WSP(float, gate, WS_GATE)
            route_mfma_phase(pqb, keyb + (size_t)layer * 8 * 2 * 128 * 128, eidx, gate, (char*)lds_raw, bid, G, tid);
            SEAM(pb + 7);
        }
        if (IN(pb + 8)) {
            PH_TID() WSP(float, x1, WS_X1) WSP(bf16_t, x1b, WS_X1B) WSP(int, eidx, WS_EIDX) WSP(float, gate, WS_GATE) WSP(unsigned char, ub, WS_UB) WSP(unsigned char, vb, WS_VB) WSP(float, isu, WS_SU) WSP(float, isv, WS_SV) WSP(float, x2, WS_X2) WSP(bf16_t, x2b, WS_X2B)
            peer_expert_phase(x1, x1b, eidx, gate, ub + (size_t)layer * 16384 * ROWB, vb + (size_t)layer * 16384 * ROWB, isu + layer * 16384, isv + layer * 16384, a.in[19] + layer * DM, a.in[20] + layer * DM,
                              layer == 0 ? x2 : a.out, layer == 0 ? x2b : (bf16_t*)nullptr, (LDSA float*)lds, bid, G, tid);
            SEAM(pb + 8);
        }
        }
    { constexpr int layer = 1;
        const int pb = 1 + 10 * layer;
        if (IN(pb + 0)) {
            PH_TID() WSP(bf16_t, xb, WS_XB) WSP(bf16_t, x2b, WS_X2B) WSP(bf16_t, wab, WS_WAB) WSP(bf16_t, wcd, WS_WCD) WSP(bf16_t, hb, WS_HB) WSP(float, cs0, WS_CS0) WSP(float, csa, WS_CSA)
            if (layer == 0) {
                pg8::Gemm g{xb, wab, SEQ, 12288, 4096}; pg8::StaticOrder S; S.init(SEQ, 12288, G, bid);
                pg8::EpiProj<0> E{hb, 12288, cs0, csa, nullptr, nullptr, (LDSA float*)(lds + LDS_MISC + 64)};
                pg8::gemm_phase<pg8::EpiProj<0>, pg8::StaticOrder>(lds, g, S, E, nullptr, tid);
#ifdef PROBE_GEMM2
                pg8::gemm_phase<pg8::EpiProj<0>, pg8::StaticOrder>(lds, g, S, E, nullptr, tid);
#endif
            } else {
                pg8::Gemm g{x2b, wcd, SEQ, 9216, 4096}; pg8::StaticOrder S; S.init(SEQ, 9216, G, bid);
                pg8::EpiProj<1> E{hb, 9216, cs0, csa, a.in[10], a.in[11], (LDSA float*)(lds + LDS_MISC + 64)};
                pg8::gemm_phase<pg8::EpiProj<1>, pg8::StaticOrder>(lds, g, S, E, nullptr, tid);
            }
            SEAM(pb + 0);
        }
        if (IN(pb + 2)) {
            PH_TID() WSP(bf16_t, hb, WS_HB) WSP(bf16_t, abb, WS_AB) WSP(float, oc, WS_OC)
            if (layer == 0) attn0_phase(hb, a.in[2], abb, (bf16_t*)oc, (float*)((unsigned char*)oc + (size_t)3 * 8 * SEQ * 128 * 2), (char*)lds_raw, bid, G, tid);
            else attn1_phase(hb, abb, oc, (char*)lds_raw, bid, G, tid);
#ifdef PROBE_ATTN2
            if (layer == 1) { __syncthreads(); int t3 = tid; asm volatile("" : "+v"(t3)); attn1_phase(hb, abb, oc, (char*)lds_raw, bid, G, t3); }
#endif
            SEAM(pb + 2);
        }
        if (layer == 0) {
            if (IN(pb + 3)) {
                PH_TID() WSP(bf16_t, abb, WS_AB) WSP(float, oc, WS_OC)
                merge0_phase((const bf16_t*)oc, (const float*)((unsigned char*)oc + (size_t)3 * 8 * SEQ * 128 * 2), abb, bid, G, tid);
                SEAM(pb + 3);
            }
        } else {
            if (IN(pb + 3)) {
                PH_TID() WSP(bf16_t, abb, WS_AB) WSP(float, oc, WS_OC)
                const int lane = tid & 63, wv = tid >> 6;
                const float* lq1 = a.in[5]; const float* lk1 = a.in[6]; const float* lq2 = a.in[7]; const float* lk2 = a.in[8]; const float* subg = a.in[9];
                const float lam = __expf(wave_sum(lq1[lane] * lk1[lane] + lq1[lane + 64] * lk1[lane + 64])) - __expf(wave_sum(lq2[lane] * lk2[lane] + lq2[lane + 64] * lk2[lane + 64])) + LAMBDA_INIT;
                const float4 sg = *(const float4*)(subg + 4 * lane);
                for (int j = bid * 8 + wv; j < SEQ * 8; j += G * 8) {
                    const int t = j >> 3, h = j & 7;
                    const float4 o1 = *(const float4*)(oc + (size_t)t * 2048 + h * 256 + 4 * lane), o2 = *(const float4*)(oc + (size_t)SEQ * 2048 + (size_t)t * 2048 + h * 256 + 4 * lane);
                    const float ox = o1.x - lam * o2.x, oy = o1.y - lam * o2.y, oz = o1.z - lam * o2.z, ow = o1.w - lam * o2.w;
                    const float ss = wave_sum((ox * ox + oy * oy) + (oz * oz + ow * ow)) * (1.0f / 256.0f);
                    const float rs = (1.0f - LAMBDA_INIT) / sqrtf(ss + 1e-6f);
                    uint2 w; w.x = cvtpk_bf16(ox * rs * sg.x, oy * rs * sg.y); w.y = cvtpk_bf16(oz * rs * sg.z, ow * rs * sg.w);
                    *(uint2*)(abb + (size_t)t * 4096 + h * 256 + 4 * lane) = w;
                }
                SEAM(pb + 3);
            }
        }
        if (IN(pb + 4)) {
            const int K = layer == 0 ? 3072 : 4096;
            PH_TID() WSP(bf16_t, abb, WS_AB) WSP(bf16_t, woab, WS_WOAB) WSP(bf16_t, wocd, WS_WOCD) WSP(float, ybuf, WS_Y) WSP(float, x2, WS_X2)
            pg8::Gemm g{abb, layer == 0 ? woab : wocd, SEQ, 4096, K}; pg8::StaticOrder S; S.init(SEQ, 4096, G, bid);
            pg8::EpiF32R E{ybuf, 4096, layer == 0 ? a.in[0] : (const float*)x2, ALPHA};
            pg8::gemm_phase<pg8::EpiF32R, pg8::StaticOrder>(lds, g, S, E, nullptr, tid);
            SEAM(pb + 4);
        }
        if (IN(pb + 5)) {
            PH_TID() WSP(float, ybuf, WS_Y) WSP(float, x1, WS_X1) WSP(bf16_t, x1b, WS_X1B)
            ln_phase(ybuf, a.in[13] + layer * DM, a.in[14] + layer * DM, x1, x1b, bid, G, tid);
            SEAM(pb + 5);
        }
        if (IN(pb + 6)) {
            PH_TID() WSP(bf16_t, x1b, WS_X1B) WSP(bf16_t, wq, WS_WQ) WSP(bf16_t, pqb, WS_PQ)
            pg8::Gemm g{x1b, wq + (size_t)layer * 2048 * 4096, SEQ, 2048, 4096}; pg8::StaticOrder S; S.init(SEQ, 2048, G, bid);
            pg8::EpiBf16P E{pqb, 2048};
            pg8::gemm_phase<pg8::EpiBf16P, pg8::StaticOrder>(lds, g, S, E, nullptr, tid);
            SEAM(pb + 6);
        }
        if (IN(pb + 7)) {
            PH_TID() WSP(bf16_t, pqb, WS_PQ) WSP(bf16_t, keyb, WS_KEYB) WSP(int, eidx, WS_EIDX) WSP(float, gate, WS_GATE)
            route_mfma_phase(pqb, keyb + (size_t)layer * 8 * 2 * 128 * 128, eidx, gate, (char*)lds_raw, bid, G, tid);
            SEAM(pb + 7);
        }
        if (IN(pb + 8)) {
            PH_TID() WSP(float, x1, WS_X1) WSP(bf16_t, x1b, WS_X1B) WSP(int, eidx, WS_EIDX) WSP(float, gate, WS_GATE) WSP(unsigned char, ub, WS_UB) WSP(unsigned char, vb, WS_VB) WSP(float, isu, WS_SU) WSP(float, isv, WS_SV) WSP(float, x2, WS_X2) WSP(bf16_t, x2b, WS_X2B)
            peer_expert_phase(x1, x1b, eidx, gate, ub + (size_t)layer * 16384 * ROWB, vb + (size_t)layer * 16384 * ROWB, isu + layer * 16384, isv + layer * 16384, a.in[19] + layer * DM, a.in[20] + layer * DM,
                              layer == 0 ? x2 : a.out, layer == 0 ? x2b : (bf16_t*)nullptr, (LDSA float*)lds, bid, G, tid);
            SEAM(pb + 8);
        }
        }

#ifdef PROBE_FP6
    if (bid == 0 && hi == N_PHASES) {
        PH_TID()
        if (tid == 0) {
            v16f_t s0, s1; float xs[32];
#pragma unroll
            for (int i = 0; i < 32; ++i) { const int e = i >> 3, m = i & 7; const float v = e == 0 ? 0.125f * m : (float)(1 << (e - 1)) * (1.0f + 0.125f * m); xs[i] = v; if (i < 16) s0[i] = v; else s1[i - 16] = v; }
            const v6u_t w = __builtin_amdgcn_cvt_scalef32_2xpk16_fp6_f32(s0, s1, 1.0f);
            const v32f_t y = __builtin_amdgcn_cvt_scalef32_pk32_f32_fp6(w, 1.0f);
            const v16u_t zb = __builtin_bit_cast(v16u_t, __builtin_amdgcn_cvt_scalef32_pk32_bf16_fp6(w, 1.0f));
            const v32f_t y2 = __builtin_amdgcn_cvt_scalef32_pk32_f32_fp6(w, 2.0f);
            const v6u_t w2 = __builtin_amdgcn_cvt_scalef32_2xpk16_fp6_f32(s0, s1, 2.0f);
            const v32f_t y3 = __builtin_amdgcn_cvt_scalef32_pk32_f32_fp6(w2, 1.0f);
            bool id32 = true, id16 = true, il32 = true;
#pragma unroll
            for (int i = 0; i < 32; ++i) { id32 = id32 && (y[i] == xs[i]);
                const unsigned d = zb[i >> 1]; const float b = (i & 1) ? bf_hi(d) : bf_lo(d); id16 = id16 && (b == xs[i]);
                const int src = (i & 1) ? 16 + (i >> 1) : (i >> 1); il32 = il32 && (y[i] == xs[src]); }
            int code = 64;
            if (id32) code += 1; if (id16) code += 2; if (il32) code += 4;
            if (y2[9] == 2.0f * y[9]) code += 8;
            if (y3[20] * 2.0f == y[20]) code += 16;
            if (y[1] == xs[1]) code += 32;
            a.out[0] += (float)code;
        }
    }
#endif
#undef IN
}
#ifndef ONE_LAUNCH
#define ONE_LAUNCH 1
#endif
extern "C" void kernel_launch(void* const* d_in, const int* in_sizes, int n_in, void* d_out, int out_size, void* d_ws, size_t ws_size, hipStream_t stream) {
    static int ready = 0;
    if (!ready) {
        if (ws_size < WS_END) { fprintf(stderr, "kernel_launch: workspace too small: %zu < %zu\n", ws_size, (size_t)WS_END); return; }
        if (hipFuncSetAttribute((const void*)mega, hipFuncAttributeMaxDynamicSharedMemorySize, LDS_BYTES) != hipSuccess) { fprintf(stderr, "kernel_launch: hipFuncSetAttribute failed\n"); return; }
        int per_cu = 0;
        if (hipOccupancyMaxActiveBlocksPerMultiprocessor(&per_cu, (const void*)mega, 512, LDS_BYTES) != hipSuccess || per_cu < 1) fprintf(stderr, "kernel_launch: note: occupancy query reports %d blocks per CU\n", per_cu);
        (void)hipGetLastError();
        ready = 1;
    }
    unsigned char* ws = (unsigned char*)d_ws;
    (void)hipMemsetAsync(ws + WS_CTL, 0, CTL_BYTES, stream);
    MK a{}; for (int i = 0; i < 21; ++i) a.in[i] = (const float*)d_in[i];
    a.out = (float*)d_out; a.ws = ws;
#if ONE_LAUNCH
    a.ph_lo = 0; a.ph_hi = N_PHASES;
    hipLaunchKernelGGL(mega, dim3(256), dim3(512), LDS_BYTES, stream, a);
#else
    for (int k = 0; k < N_PHASES; ++k) { if (k == 10 || k == 2 || k == 12) continue; a.ph_lo = k; a.ph_hi = k + 1; hipLaunchKernelGGL(mega, dim3(256), dim3(512), LDS_BYTES, stream, a); }
#endif
    const hipError_t le = hipPeekAtLastError();
    if (le != hipSuccess) fprintf(stderr, "kernel_launch: launch failed: %s\n", hipGetErrorName(le));
}
```

```cpp
#include <hip/hip_runtime.h>
#include <stdint.h>
#include <cstdio>

#define SEQ 8192
#define DM 4096
#define HD 128
#define ALPHA 1.4142135623730951f
#define LAMBDA_INIT 0.35550906759096934f
#define ATT_SCALE 0.088388347648318440f

__device__ const double REV_P[16] = {0.15915494309189535, 0.0700865215877985, 0.03086376340470123, 0.013591370636193905, 0.005985185712713705, 0.002635675898667414, 0.001160663641240061, 0.0005111175045375439, 0.00022507907903927653, 9.911730936901935e-05, 4.364795279280289e-05, 1.9221100684944863e-05, 8.464330808241401e-06, 3.727408601915352e-06, 1.6414262627950345e-06, 7.228293068832865e-07};
__device__ const double REV_A[32] = {0.15915494309189535, 0.11934937021124886, 0.08949940160889101, 0.06711508300522726, 0.050329212104487035, 0.03774158471741977, 0.0283021958306234, 0.02122365276477766, 0.015915494309189534, 0.011934937021124886, 0.008949940160889102, 0.006711508300522725, 0.005032921210448704, 0.003774158471741977, 0.00283021958306234, 0.0021223652764777662, 0.0015915494309189536, 0.0011934937021124885, 0.0008949940160889102, 0.0006711508300522726, 0.0005032921210448703, 0.00037741584717419774, 0.00028302195830623395, 0.0002122365276477766, 0.00015915494309189535, 0.00011934937021124886, 8.949940160889102e-05, 6.711508300522725e-05, 5.0329212104487035e-05, 3.774158471741978e-05, 2.8302195830623396e-05, 2.122365276477766e-05};

__device__ __forceinline__ void sincos_rev(double rev, float& s, float& c) {
    const double f = rev - floor(rev); const float ff = (float)f;
    s = __builtin_amdgcn_sinf(ff); c = __builtin_amdgcn_cosf(ff);
}
__device__ __forceinline__ float wave_sum(float v) {
#pragma unroll
    for (int o = 32; o >= 1; o >>= 1) v += __shfl_xor(v, o);
    return v;
}
__device__ __forceinline__ float wave_max(float v) {
#pragma unroll
    for (int o = 32; o >= 1; o >>= 1) v = fmaxf(v, __shfl_xor(v, o));
    return v;
}
namespace pg8 {
#define PG8_LAS __attribute__((address_space(3)))
typedef unsigned short bf16_t;
typedef short bf16x8 __attribute__((ext_vector_type(8)));
typedef float f32x4 __attribute__((ext_vector_type(4)));
typedef unsigned u32x4 __attribute__((ext_vector_type(4)));
constexpr int BM = 256, BK = 64, HALF = 128, HTB = HALF * BK * 2  , STAGE_BYTES = 8 * HTB, NXCD = 8, WGM = 8;

__host__ __device__ __forceinline__ int lds_byte(int r, int c) { const int st = (r >> 4) * 2 + (c >> 5), rr = r & 15, cc = c & 31, ob = rr * 64 + cc * 2; return st * 1024 + (ob ^ (((ob >> 9) & 1) << 5)); }
__host__ __device__ __forceinline__ void stage_rc(int b, int& R, int& C) { const int st = b / 1024, sb = b % 1024, swz = sb ^ (((sb >> 9) & 1) << 5); R = (st >> 1) * 16 + swz / 64; C = (st & 1) * 32 + (swz % 64) / 2; }
__host__ __device__ __forceinline__ int perm32(int rho) { const int n = rho >> 4, i = rho & 15; return 8 * (i >> 2) + 4 * n + (i & 3); }

struct Unit { int pm, pn; };
struct Gemm { const bf16_t* A; const bf16_t* Bt; int M, N, K; };

struct StaticOrder {
    int nM, nN, nwg, G, c;
    __host__ __device__ void init(int M, int N, int G_, int c_) { nM = M / BM; nN = N / BM; nwg = nM * nN; G = G_; c = c_; }
    __host__ __device__ bool next(int i, Unit& u) const {
        const long L = (long)i * G + c; if (L >= nwg) return false;
        int wgid = (int)L; { const int q = nwg / NXCD, r = nwg % NXCD, xcd = wgid % NXCD, off = wgid / NXCD; wgid = (xcd < r ? xcd * (q + 1) : r * (q + 1) + (xcd - r) * q) + off; }
        const int nig = WGM * nN, gid = wgid / nig, fm = gid * WGM, gsz = (nM - fm) < WGM ? (nM - fm) : WGM;
        u.pm = fm + ((wgid % nig) % gsz); u.pn = (wgid % nig) / gsz; return true;
    }
    __device__ __forceinline__ void a_ready(const Unit&) const {}
    __device__ __forceinline__ void done(const Unit&) const {}
};
__device__ __forceinline__ unsigned cvt_pk_bf16(float lo, float hi) { unsigned r; asm volatile("v_cvt_pk_bf16_f32 %0, %1, %2" : "=v"(r) : "v"(lo), "v"(hi)); return r; }
typedef float f32x2 __attribute__((ext_vector_type(2)));
template <class Epi, class Sched, bool STAMP = false>
__device__ __forceinline__ void gemm_phase(PG8_LAS unsigned char* lds, const Gemm g, const Sched& S, const Epi& E, unsigned long long* stamps, const int tid_in) {
    const int tid = tid_in, wid = __builtin_amdgcn_readfirstlane(tid >> 6), lane = tid & 63, wr = wid >> 2, wc = wid & 3, fr = lane & 15, fq = lane >> 4;
    const int K = g.K, nt = K / BK;
    int ts_lo = 0, ts_hi = 0, nts = 0; const unsigned long long rt_entry = STAMP ? (unsigned long long)wall_clock64() : 0ull;
#define PG8_STAMP() do { if (STAMP && wid == 0 && nts < 64) { const unsigned long long _c = (unsigned long long)clock64(); \
        ts_lo = (lane == nts) ? (int)(unsigned)_c : ts_lo; ts_hi = (lane == nts) ? (int)(unsigned)(_c >> 32) : ts_hi; ++nts; } } while (0)
    PG8_STAMP();
    unsigned voffA[2], voffB[2];
#pragma unroll
    for (int i = 0; i < 2; ++i) { int R, C; stage_rc(tid * 16 + i * 8192, R, C); const int Rb = Epi::PERM ? ((R & ~31) + perm32(R & 31)) : R;
        voffA[i] = (unsigned)(R * K + C) * 2u; voffB[i] = (unsigned)(Rb * K + C) * 2u; }
    const size_t kstep = (size_t)(BK * 2);
    const size_t hstep = (size_t)HALF * K * 2;
    const size_t tstep = 2 * hstep;
    const unsigned ldsw = (unsigned)wid * 1024u;
    const int aoff = lds_byte(wr * 64 + fr, fq * 8), boff = lds_byte(wc * 32 + fr, fq * 8);
#define PG8_SA(b, h) (((b) * 2 + (h)) * HTB)
#define PG8_SB(b, h) ((4 + (b) * 2 + (h)) * HTB)
#define PG8_STAGE(bufoff, gbase, voff) do { _Pragma("unroll") for (int _i = 0; _i < 2; ++_i) \
        __builtin_amdgcn_global_load_lds((const unsigned*)((const char*)(gbase) + (voff)[_i]), (PG8_LAS unsigned*)(lds + (bufoff) + ldsw + _i * 8192), 16, 0, 0); } while (0)
#define PG8_LDA(dst, b, h) do { _Pragma("unroll") for (int m = 0; m < 4; ++m) _Pragma("unroll") for (int k = 0; k < 2; ++k) dst[m][k] = *(const PG8_LAS bf16x8*)(lds + PG8_SA(b, h) + aoff + m * 2048 + k * 1024); } while (0)
#define PG8_LDB(dst, b, h) do { _Pragma("unroll") for (int n = 0; n < 2; ++n) _Pragma("unroll") for (int k = 0; k < 2; ++k) dst[n][k] = *(const PG8_LAS bf16x8*)(lds + PG8_SB(b, h) + boff + n * 2048 + k * 1024); } while (0)
#define PG8_MMA(ai, bj, At, Bt) do { __builtin_amdgcn_s_setprio(1); _Pragma("unroll") for (int m = 0; m < 4; ++m) _Pragma("unroll") for (int n = 0; n < 2; ++n) _Pragma("unroll") for (int k = 0; k < 2; ++k) \
        acc[ai][bj][m][n] = __builtin_amdgcn_mfma_f32_16x16x32_bf16(Bt[n][k], At[m][k], acc[ai][bj][m][n], 0, 0, 0); __builtin_amdgcn_s_setprio(0); } while (0)
#define PG8_WAIT_V(n) asm volatile("s_waitcnt vmcnt(" #n ")" ::: "memory")
#define PG8_WAIT_L(n) asm volatile("s_waitcnt lgkmcnt(" #n ")" ::: "memory")
#define PG8_BAR __builtin_amdgcn_s_barrier()
#define PG8_SCHED __builtin_amdgcn_sched_barrier(0)
    Unit cur, nxt; int ui = 0;
    if (!S.next(0, cur)) return;
    f32x4 acc[2][2][4][2];
#pragma unroll
    for (int a = 0; a < 2; ++a)
#pragma unroll
        for (int b = 0; b < 2; ++b)
#pragma unroll
            for (int m = 0; m < 4; ++m)
#pragma unroll
                for (int n = 0; n < 2; ++n) acc[a][b][m][n] = (f32x4){0.f, 0.f, 0.f, 0.f};
    bf16x8 At[4][2], B0[2][2], B1[2][2];
    const char* cA = (const char*)g.A + (size_t)cur.pm * tstep; const char* cB = (const char*)g.Bt + (size_t)cur.pn * tstep;
    S.a_ready(cur);
    PG8_STAGE(PG8_SB(0, 0), cB, voffB); PG8_STAGE(PG8_SA(0, 0), cA, voffA); PG8_STAGE(PG8_SB(0, 1), cB + hstep, voffB); PG8_STAGE(PG8_SA(0, 1), cA + hstep, voffA);
    if (wr == 1) PG8_BAR;
    PG8_WAIT_V(4); PG8_BAR;
    PG8_STAGE(PG8_SB(1, 0), cB + kstep, voffB); PG8_STAGE(PG8_SA(1, 0), cA + kstep, voffA); PG8_STAGE(PG8_SB(1, 1), cB + hstep + kstep, voffB);
    PG8_WAIT_V(6); PG8_BAR;
    PG8_STAMP();
    for (;;) {
        const bool has_next = S.next(ui + 1, nxt);
        const char* nA = has_next ? (const char*)g.A + (size_t)nxt.pm * tstep : cA; const char* nB = has_next ? (const char*)g.Bt + (size_t)nxt.pn * tstep : cB;
        for (int t = 0; t < nt; t += 2) {
            const bool last = (t == nt - 2);
            const char* a1 = cA + (size_t)(t + 1) * kstep;
            const char* a2 = last ? nA : cA + (size_t)(t + 2) * kstep; const char* b2 = last ? nB : cB + (size_t)(t + 2) * kstep;
            const char* a3 = a2 + kstep; const char* b3 = b2 + kstep;
            if (last && has_next) S.a_ready(nxt);
            PG8_LDB(B0, 0, 0); PG8_SCHED; PG8_LDA(At, 0, 0); PG8_STAGE(PG8_SA(1, 1), a1 + hstep, voffA);
            PG8_WAIT_L(8); PG8_BAR; PG8_WAIT_L(0); PG8_MMA(0, 0, At, B0); PG8_BAR; PG8_SCHED;
            PG8_LDB(B1, 0, 1); PG8_STAGE(PG8_SB(0, 0), b2, voffB);
            PG8_BAR; PG8_WAIT_L(0); PG8_MMA(0, 1, At, B1); PG8_BAR;
            PG8_LDA(At, 0, 1); PG8_STAGE(PG8_SA(0, 0), a2, voffA);
            PG8_BAR; PG8_WAIT_L(0); PG8_MMA(1, 0, At, B0); PG8_BAR; PG8_SCHED;
            PG8_STAGE(PG8_SB(0, 1), b2 + hstep, voffB);
            PG8_WAIT_V(6); PG8_BAR; PG8_MMA(1, 1, At, B1); PG8_BAR;
            PG8_LDB(B0, 1, 0); PG8_SCHED; PG8_LDA(At, 1, 0); PG8_STAGE(PG8_SA(0, 1), a2 + hstep, voffA);
            PG8_WAIT_L(8); PG8_BAR; PG8_WAIT_L(0); PG8_MMA(0, 0, At, B0); PG8_BAR; PG8_SCHED;
            PG8_LDB(B1, 1, 1); PG8_STAGE(PG8_SB(1, 0), b3, voffB);
            PG8_BAR; PG8_WAIT_L(0); PG8_MMA(0, 1, At, B1); PG8_BAR;
            PG8_LDA(At, 1, 1); PG8_STAGE(PG8_SA(1, 0), a3, voffA);
            PG8_BAR; PG8_WAIT_L(0); PG8_MMA(1, 0, At, B0); PG8_BAR; PG8_SCHED;
            PG8_STAGE(PG8_SB(1, 1), b3 + hstep, voffB);
            PG8_WAIT_V(6); PG8_BAR; PG8_MMA(1, 1, At, B1); PG8_BAR;
        }
        PG8_STAMP();
        if constexpr (!Epi::AFTER_DRAIN) { E(acc, cur, wr, wc, fr, fq); S.done(cur); }
        PG8_STAMP();
        if (!has_next) break;
#pragma unroll
        for (int a = 0; a < 2; ++a)
#pragma unroll
            for (int b = 0; b < 2; ++b)
#pragma unroll
                for (int m = 0; m < 4; ++m)
#pragma unroll
                    for (int n = 0; n < 2; ++n) acc[a][b][m][n] = (f32x4){0.f, 0.f, 0.f, 0.f};
        cur = nxt; cA = nA; cB = nB; ++ui;
    }
    PG8_WAIT_V(0);
    if (wr == 0) PG8_BAR;
    PG8_BAR;
    if constexpr (Epi::AFTER_DRAIN) { E.fused(acc, cur, wr, wc, fr, fq, lds, wid, lane); S.done(cur); }
    PG8_STAMP();
    if (STAMP && wid == 0) { stamps[lane] = lane < nts ? (((unsigned long long)(unsigned)ts_hi << 32) | (unsigned)ts_lo) : 0ull;
        if (lane == 62) stamps[62] = rt_entry; if (lane == 63) stamps[63] = (unsigned long long)wall_clock64(); }
#undef PG8_STAMP
#undef PG8_SA
#undef PG8_SB
#undef PG8_STAGE
#undef PG8_LDA
#undef PG8_LDB
#undef PG8_MMA
#undef PG8_WAIT_V
#undef PG8_WAIT_L
#undef PG8_BAR
#undef PG8_SCHED
}
}
#define XB_TMO      128
#define XB_XCNT(j)  (256  + 64 * (j))
#define XB_XSUB(j)  (1280 + 64 * (j))
#define XB_XGEN(j)  (2304 + 64 * (j))
#define XB_TOP      3328
#define XB_TOPGEN   3392
#define XCD_BAR_WORDS 3456
#define XB_SPIN_CAP (1u << 22)
#define LAS __attribute__((address_space(3)))

__device__ __forceinline__ unsigned xb_ld(unsigned* p)              { return __hip_atomic_load(p, __ATOMIC_RELAXED, __HIP_MEMORY_SCOPE_AGENT); }
__device__ __forceinline__ unsigned xb_add(unsigned* p, unsigned v) { return __hip_atomic_fetch_add(p, v, __ATOMIC_RELAXED, __HIP_MEMORY_SCOPE_AGENT); }
__device__ __forceinline__ unsigned xb_xcc_id() { return (unsigned)__builtin_amdgcn_s_getreg((3 << 11) | 20) & 0xFu; }
#define XB_SPIN(cond, bar) do { unsigned _sp = 0; while (cond) { __builtin_amdgcn_s_sleep(1); \
    if ((++_sp & 255u) == 0u) { if (xb_ld(&(bar)[XB_TMO])) break; if (_sp > XB_SPIN_CAP) { atomicAdd(&(bar)[XB_TMO], 1u); break; } } } } while (0)

struct XcdBarrier {
    unsigned* bar; unsigned x;
    volatile LAS unsigned* st;
};

__device__ __forceinline__ XcdBarrier xcd_barrier_post(unsigned* bar, volatile LAS unsigned* st, const int tid) {
    XcdBarrier b; b.bar = bar; b.x = xb_xcc_id(); b.st = st;
    if (tid == 0) (void)xb_add(&bar[XB_XCNT(b.x)], 1u);
    return b;
}
__device__ __forceinline__ void xcd_barrier_complete(unsigned* bar, unsigned x, unsigned& nloc, unsigned& nx) {
    const unsigned G = gridDim.x * gridDim.y * gridDim.z;
    unsigned sum, cnt, mine, sp = 0u;
    for (;;) {
        sum = 0u; cnt = 0u; mine = 0u;
#pragma unroll
        for (unsigned j = 0; j < 16; ++j) { const unsigned c = xb_ld(&bar[XB_XCNT(j)]); sum += c; cnt += (c > 0u) ? 1u : 0u; mine = (j == x) ? c : mine; }
        if (sum == G) break;
        __builtin_amdgcn_s_sleep(1);
        if ((++sp & 255u) == 0u) { if (xb_ld(&bar[XB_TMO])) break; if (sp > XB_SPIN_CAP) { atomicAdd(&bar[XB_TMO], 1u); break; } }
    }
    nloc = mine > 0u ? mine : 1u; nx = cnt > 0u ? cnt : 1u;
}

__device__ __forceinline__ void xcd_barrier(const XcdBarrier& b, const int tid) {
    asm volatile("s_waitcnt vmcnt(0)" ::: "memory");
    __syncthreads();
    if (tid == 0) {
        unsigned* bar = b.bar;
        __builtin_amdgcn_s_waitcnt(0);
        unsigned nloc = b.st[0], nx = b.st[1];
        if (nloc == 0u) { xcd_barrier_complete(bar, b.x, nloc, nx); b.st[0] = nloc; b.st[1] = nx; }
        const unsigned old = xb_add(&bar[XB_XSUB(b.x)], 1u);
        const unsigned gen = old / nloc;
        if (old + 1u == (gen + 1u) * nloc) {
            __builtin_amdgcn_fence(__ATOMIC_RELEASE, "agent");
            asm volatile("s_waitcnt vmcnt(0)" ::: "memory");
            const unsigned og = xb_add(&bar[XB_TOP], 1u);
            const unsigned tg = og / nx;
            if (og + 1u == (tg + 1u) * nx) xb_add(&bar[XB_TOPGEN], 1u);
            else XB_SPIN(xb_ld(&bar[XB_TOPGEN]) == tg, bar);
            __builtin_amdgcn_fence(__ATOMIC_ACQUIRE, "agent");
            xb_add(&bar[XB_XGEN(b.x)], 1u);
            asm volatile("s_waitcnt vmcnt(0)" ::: "memory");
        } else {
            XB_SPIN(xb_ld(&bar[XB_XGEN(b.x)]) == gen, bar);
            __builtin_amdgcn_fence(__ATOMIC_ACQUIRE, "agent");
            asm volatile("s_waitcnt vmcnt(0)" ::: "memory");
        }
    }
    __syncthreads();
}
namespace att {
using bf16 = unsigned short;
constexpr int   D = 128, NW = 8, QBLK = 32, KVBLK = 64;
constexpr float SCALE = 0.088388347648318440f;
constexpr float THR = 8.f;
constexpr int SDEPTH = 1;
constexpr size_t SHM_V = KVBLK * D * 2, SHM_K = KVBLK * D * 2, SHM_ATTN = 2 * SHM_V + 2 * SHM_K + NW * 64 * 4;
using bf16x8 = __attribute__((ext_vector_type(8))) short;
using s16x4  = __attribute__((ext_vector_type(4))) short;
using f32x16 = __attribute__((ext_vector_type(16))) float;
using f32x8  = __attribute__((ext_vector_type(8))) float;
using u32x4  = __attribute__((ext_vector_type(4))) unsigned;
#define KSWZ(row, colB) ((row) * 256 + ((colB) ^ (((row) & 7) << 4)))
#define SBAR() __builtin_amdgcn_sched_barrier(0)
__device__ __forceinline__ int crow(int r, int hi) { return (r & 3) + 8 * (r >> 2) + 4 * hi; }
__device__ __forceinline__ unsigned cvtpk(float lo, float hi) {
  unsigned r; asm volatile("v_cvt_pk_bf16_f32 %0, %1, %2" : "=v"(r) : "v"(lo), "v"(hi)); return r;
}
template <typename TIn> struct Stage;
template <> struct Stage<bf16>  { using T = bf16x8;
  __device__ static __forceinline__ T ld8(const bf16* p) { return *reinterpret_cast<const bf16x8*>(p); }
  __device__ static __forceinline__ bf16x8 tobf(T x) { return x; } };
template <> struct Stage<float> { using T = f32x8;
  __device__ static __forceinline__ T ld8(const float* p) { return *reinterpret_cast<const f32x8*>(p); }
  __device__ static __forceinline__ bf16x8 tobf(T x) {
    u32x4 w = {cvtpk(x[0], x[1]), cvtpk(x[2], x[3]), cvtpk(x[4], x[5]), cvtpk(x[6], x[7])}; return *reinterpret_cast<bf16x8*>(&w); } };

__device__ __forceinline__ void partialSM(f32x16& p0, f32x16& p1, float& m_reg, float& mn, float& alpha) {
  constexpr float C = SCALE * 1.4426950408889634f;
  float pmax = p0[0]; for (int r = 1; r < 16; ++r) pmax = fmaxf(pmax, p0[r]); for (int r = 0; r < 16; ++r) pmax = fmaxf(pmax, p1[r]);
  { auto rr = __builtin_amdgcn_permlane32_swap(__float_as_uint(pmax), __float_as_uint(pmax), false, false);
    pmax = fmaxf(__uint_as_float(rr[0]), __uint_as_float(rr[1])); }
  if (__builtin_expect(__all(pmax - m_reg <= THR / SCALE), 1)) { mn = m_reg; alpha = 1.f; }
  else { mn = fmaxf(m_reg, pmax); alpha = __builtin_amdgcn_exp2f((m_reg - mn) * C); m_reg = mn; }
  float mnC = -mn * C;
  for (int r = 0; r < 16; ++r) p0[r] = fmaf(p0[r], C, mnC); for (int r = 0; r < 16; ++r) p1[r] = fmaf(p1[r], C, mnC);
  for (int r = 0; r < 16; ++r) p0[r] = __builtin_amdgcn_exp2f(p0[r]);
}
__device__ __forceinline__ void finishSM(f32x16& p0, f32x16& p1, float alpha, float& l_reg, bf16x8& pa0, bf16x8& pa1, bf16x8& pa2, bf16x8& pa3) {
  for (int r = 0; r < 16; ++r) p1[r] = __builtin_amdgcn_exp2f(p1[r]);
  float ps = 0; for (int r = 0; r < 16; ++r) ps += p0[r]; for (int r = 0; r < 16; ++r) ps += p1[r];
  { auto rr = __builtin_amdgcn_permlane32_swap(__float_as_uint(ps), __float_as_uint(ps), false, false);
    ps = __uint_as_float(rr[0]) + __uint_as_float(rr[1]); }
  l_reg = l_reg * alpha + ps;
#define PK4(P, BASE, OUT) do { unsigned a0 = cvtpk(P[BASE + 0], P[BASE + 1]), a1 = cvtpk(P[BASE + 2], P[BASE + 3]);   \
    unsigned b0 = cvtpk(P[BASE + 4], P[BASE + 5]), b1 = cvtpk(P[BASE + 6], P[BASE + 7]);                              \
    auto r0 = __builtin_amdgcn_permlane32_swap(a0, b0, false, false); auto r1 = __builtin_amdgcn_permlane32_swap(a1, b1, false, false); \
    u32x4 w = {r0[0], r1[0], r0[1], r1[1]}; OUT = *reinterpret_cast<bf16x8*>(&w); } while (0)
  PK4(p0, 0, pa0); PK4(p0, 8, pa1); PK4(p1, 0, pa2); PK4(p1, 8, pa3);
#undef PK4
}
__device__ __forceinline__ void qkt(f32x16& p0, f32x16& p1, const bf16* Ks, const bf16x8* qr, int r32, int hi) {
  p0 = f32x16{}; p1 = f32x16{};
  for (int d0 = 0; d0 < 8; ++d0) { int cb = (d0 * 16 + hi * 8) * 2;
    bf16x8 b0 = *reinterpret_cast<const bf16x8*>((const char*)Ks + KSWZ(r32, cb));
    bf16x8 b1 = *reinterpret_cast<const bf16x8*>((const char*)Ks + KSWZ(32 + r32, cb));
    p0 = __builtin_amdgcn_mfma_f32_32x32x16_bf16(b0, qr[d0], p0, 0, 0, 0);
    p1 = __builtin_amdgcn_mfma_f32_32x32x16_bf16(b1, qr[d0], p1, 0, 0, 0); }
}
__device__ __forceinline__ int v_st(int k, int c) { const int kk = (k & ~0xC) | ((k & 4) << 1) | ((k & 8) >> 1); return ((kk >> 3) * 4 + (c >> 5)) * 512 + ((kk & 7) * 32 + (c & 31)) * 2; }
__device__ __forceinline__ int v_rd_base(int lane) { return ((lane & 3) << 3) | (((lane >> 2) & 3) << 6) | (((lane >> 4) & 1) << 5) | (((lane >> 5) & 1) << 8); }
constexpr int v_rd_off(int d0, int ks, int half) { return d0 * 512 + ks * 4096 + half * 2048; }
template <int OFF> __device__ __forceinline__ s16x4 tr_read(int vb) {
  s16x4 r; asm volatile("ds_read_b64_tr_b16 %0, %1 offset:%2" : "=&v"(r) : "v"(vb), "i"(OFF) : "memory"); return r;
}
template <int D0> __device__ __forceinline__ void pv_one(f32x16& od, int vb, bf16x8 pa0, bf16x8 pa1, bf16x8 pa2, bf16x8 pa3) {
  const s16x4 l0 = tr_read<v_rd_off(D0, 0, 0)>(vb), h0 = tr_read<v_rd_off(D0, 0, 1)>(vb), l1 = tr_read<v_rd_off(D0, 1, 0)>(vb), h1 = tr_read<v_rd_off(D0, 1, 1)>(vb);
  const s16x4 l2 = tr_read<v_rd_off(D0, 2, 0)>(vb), h2 = tr_read<v_rd_off(D0, 2, 1)>(vb), l3 = tr_read<v_rd_off(D0, 3, 0)>(vb), h3 = tr_read<v_rd_off(D0, 3, 1)>(vb);
  asm volatile("s_waitcnt lgkmcnt(0)" ::: "memory"); SBAR();
#define PK(L, H) (bf16x8){L[0], L[1], L[2], L[3], H[0], H[1], H[2], H[3]}
  od = __builtin_amdgcn_mfma_f32_32x32x16_bf16(pa0, PK(l0, h0), od, 0, 0, 0);
  od = __builtin_amdgcn_mfma_f32_32x32x16_bf16(pa1, PK(l1, h1), od, 0, 0, 0);
  od = __builtin_amdgcn_mfma_f32_32x32x16_bf16(pa2, PK(l2, h2), od, 0, 0, 0);
  od = __builtin_amdgcn_mfma_f32_32x32x16_bf16(pa3, PK(l3, h3), od, 0, 0, 0);
#undef PK
}
__device__ __forceinline__ void pv_d0(f32x16* o, int vb, bf16x8 pa0, bf16x8 pa1, bf16x8 pa2, bf16x8 pa3) {
  pv_one<0>(o[0], vb, pa0, pa1, pa2, pa3); pv_one<1>(o[1], vb, pa0, pa1, pa2, pa3); pv_one<2>(o[2], vb, pa0, pa1, pa2, pa3); pv_one<3>(o[3], vb, pa0, pa1, pa2, pa3);
}

template <typename TQ, int LDQ, int LDK, int LDO, typename TO>
__device__ __forceinline__ void attn_dense_body(const TQ* __restrict__ Qb, const bf16* __restrict__ Kh, const bf16* __restrict__ Vh,
                                                TO* __restrict__ Ob, int seq, char* lds, const int tid_in) {
  using St = Stage<bf16>; using SQ = Stage<TQ>;
  const int tid = tid_in, wid = tid >> 6, lane = tid & 63, r32 = lane & 31, hi = lane >> 5;
  bf16* V_lds = (bf16*)lds; bf16* K_lds = (bf16*)(lds + 2 * SHM_V);
  float* ws = (float*)(lds + 2 * SHM_V + 2 * SHM_K) + wid * 64; float* li_l = ws; float* al_l = ws + 32;
  float m_reg = -1e30f, l_reg = 0; f32x16 o[4] = {}; bf16x8 qr[8];
  const TQ* Qw = Qb + ((wid * QBLK + r32) * LDQ + hi * 8);
#pragma unroll
  for (int d0 = 0; d0 < 8; ++d0) qr[d0] = SQ::tobf(SQ::ld8(Qw + d0 * 16));
  const int sr = tid >> 4, sc = (tid & 15) * 8, vst0 = v_st(sr, sc), vst1 = v_st(32 + sr, sc);
  const int vb0 = (int)(uintptr_t)V_lds + v_rd_base(lane);
  struct { typename St::T vs0, vs1, ks0, ks1; } sr_[SDEPTH];
#define SLOAD(i, k0) do { sr_[i].vs0 = St::ld8(Vh + (((k0) + sr) * LDK + sc)); sr_[i].vs1 = St::ld8(Vh + (((k0) + 32 + sr) * LDK + sc)); \
    sr_[i].ks0 = St::ld8(Kh + (((k0) + sr) * LDK + sc)); sr_[i].ks1 = St::ld8(Kh + (((k0) + 32 + sr) * LDK + sc)); } while (0)
#define SWRITE(b, i) do { *(bf16x8*)((char*)V_lds + (b) * SHM_V + vst0) = St::tobf(sr_[i].vs0);          \
    *(bf16x8*)((char*)V_lds + (b) * SHM_V + vst1) = St::tobf(sr_[i].vs1); int kc = sc * 2;               \
    *(bf16x8*)((char*)K_lds + (b) * SHM_K + KSWZ(sr, kc)) = St::tobf(sr_[i].ks0);                       \
    *(bf16x8*)((char*)K_lds + (b) * SHM_K + KSWZ(32 + sr, kc)) = St::tobf(sr_[i].ks1); } while (0)
#define SWAIT() do { if constexpr (SDEPTH == 2) asm volatile("s_waitcnt vmcnt(4)" ::: "memory"); else asm volatile("s_waitcnt vmcnt(0)" ::: "memory"); } while (0)
#define RESC(a) do { if (__any((a) < 1.f)) { if (hi == 0) al_l[r32] = (a); asm volatile("s_waitcnt lgkmcnt(0)" ::: "memory"); \
    for (int d = 0; d < 4; ++d) for (int r = 0; r < 16; ++r) o[d][r] *= al_l[crow(r, hi)]; } } while (0)
  f32x16 pA0, pA1, pB0, pB1; float mnA, mnB, alA, alB; bf16x8 pa0, pa1, pa2, pa3; const int NT = seq / KVBLK;
  constexpr int SE = 0, SO = SDEPTH - 1;
  SLOAD(SE, 0); asm volatile("s_waitcnt vmcnt(0)" ::: "memory"); SWRITE(0, SE); __syncthreads();
  qkt(pA0, pA1, K_lds, qr, r32, hi); partialSM(pA0, pA1, m_reg, mnA, alA);
  SLOAD(SO, KVBLK); if constexpr (SDEPTH == 2) { if (2 < NT) SLOAD(SE, 2 * KVBLK); }
  SWAIT(); SWRITE(1, SO); __syncthreads();
  for (int j = 1; j + 1 < NT; j += 2) {
    SBAR(); qkt(pB0, pB1, (bf16*)((char*)K_lds + SHM_K), qr, r32, hi);
    finishSM(pA0, pA1, alA, l_reg, pa0, pa1, pa2, pa3); SBAR();
    SLOAD(SO, (j + SDEPTH) * KVBLK); SBAR();
    pv_d0(o, vb0, pa0, pa1, pa2, pa3); partialSM(pB0, pB1, m_reg, mnB, alB);
    __syncthreads(); SWAIT(); SWRITE(0, SE);
    RESC(alB); __syncthreads();
    SBAR(); qkt(pA0, pA1, K_lds, qr, r32, hi);
    finishSM(pB0, pB1, alB, l_reg, pa0, pa1, pa2, pa3); SBAR();
    if (SDEPTH == 1 || j + 3 < NT) SLOAD(SE, (j + 1 + SDEPTH) * KVBLK); SBAR();
    pv_d0(o, vb0 + (int)SHM_V, pa0, pa1, pa2, pa3); partialSM(pA0, pA1, m_reg, mnA, alA);
    __syncthreads(); SWAIT(); SWRITE(1, SO);
    RESC(alA); __syncthreads();
  }
  SBAR(); qkt(pB0, pB1, (bf16*)((char*)K_lds + SHM_K), qr, r32, hi);
  finishSM(pA0, pA1, alA, l_reg, pa0, pa1, pa2, pa3); SBAR();
  pv_d0(o, vb0, pa0, pa1, pa2, pa3); partialSM(pB0, pB1, m_reg, mnB, alB);
  __syncthreads(); RESC(alB);
  finishSM(pB0, pB1, alB, l_reg, pa0, pa1, pa2, pa3); SBAR();
  pv_d0(o, vb0 + (int)SHM_V, pa0, pa1, pa2, pa3);
  if (hi == 0) li_l[r32] = l_reg; asm volatile("s_waitcnt lgkmcnt(0)" ::: "memory");
  float rli[16];
#pragma unroll
  for (int r = 0; r < 16; ++r) rli[r] = __builtin_amdgcn_rcpf(li_l[crow(r, hi)]);
  TO* Ow = Ob + (wid * QBLK) * LDO;
#pragma unroll
  for (int r = 0; r < 16; ++r) { int orow = crow(r, hi);
    for (int d0 = 0; d0 < 4; ++d0) { const float val = o[d0][r] * rli[r];
      if constexpr (sizeof(TO) == 4) Ow[orow * LDO + d0 * 32 + r32] = val;
      else Ow[orow * LDO + d0 * 32 + r32] = (TO)(cvtpk(val, val) & 0xffffu); } }
#undef SLOAD
#undef SWRITE
#undef SWAIT
#undef RESC
}

template <int WIN>
__device__ __forceinline__ void attn_banded_body(const bf16* __restrict__ Qp, const bf16* __restrict__ Kp, const bf16* __restrict__ Vp, const long rs, const int Lseq, const int P0,
                                                 const float m_init, const float l_init, bf16* __restrict__ Ob, const long os, float* __restrict__ Lp, const long ls, char* lds, const int tid) {
  const int wid = __builtin_amdgcn_readfirstlane(tid >> 6), lane = tid & 63, r32 = lane & 31, hi = lane >> 5;
  bf16* V_lds = (bf16*)lds; bf16* K_lds = (bf16*)(lds + 2 * SHM_V);
  float* wsf = (float*)(lds + 2 * SHM_V + 2 * SHM_K) + wid * 64; float* li_l = wsf; float* al_l = wsf + 32;
  float m_reg = m_init, l_reg = l_init; f32x16 o[4] = {}; bf16x8 qr[8];
  const bf16* Qw = Qp + (long)(P0 + wid * QBLK + r32) * rs + hi * 8;
#pragma unroll
  for (int d0 = 0; d0 < 8; ++d0) qr[d0] = *reinterpret_cast<const bf16x8*>(Qw + d0 * 16);
  const int sr = tid >> 4, sc = (tid & 15) * 8, vst0 = v_st(sr, sc), vst1 = v_st(32 + sr, sc);
  const int vb0 = (int)(uintptr_t)V_lds + v_rd_base(lane);
  constexpr int NT = (256 + 2 * WIN) / 64, NTW = (2 * WIN + 32 + 63) / 64;
  const int klo = wid >> 1, qpos = P0 + wid * QBLK + r32;
  for (int k = 0; k < NT; ++k) {
    const int tb = P0 - WIN + 64 * k;
    if (tb < 0 || tb >= Lseq) continue;
    __syncthreads();
    { const bf16x8 v0 = *reinterpret_cast<const bf16x8*>(Vp + (long)(tb + sr) * rs + sc), v1 = *reinterpret_cast<const bf16x8*>(Vp + (long)(tb + 32 + sr) * rs + sc);
      const bf16x8 k0 = *reinterpret_cast<const bf16x8*>(Kp + (long)(tb + sr) * rs + sc), k1 = *reinterpret_cast<const bf16x8*>(Kp + (long)(tb + 32 + sr) * rs + sc);
      *(bf16x8*)((char*)V_lds + vst0) = v0; *(bf16x8*)((char*)V_lds + vst1) = v1;
      *(bf16x8*)((char*)K_lds + KSWZ(sr, sc * 2)) = k0; *(bf16x8*)((char*)K_lds + KSWZ(32 + sr, sc * 2)) = k1; }
    __syncthreads();
    if (k >= klo && k < klo + NTW) {
      f32x16 p0, p1; float mn, al; bf16x8 pa0, pa1, pa2, pa3;
      qkt(p0, p1, K_lds, qr, r32, hi);
      if (k == klo || k == klo + NTW - 1) {
#pragma unroll
        for (int r = 0; r < 16; ++r) { const int d = qpos - (tb + crow(r, hi));
          if (d > WIN || d < -WIN) p0[r] = -1e30f;
          if (d - 32 > WIN || d - 32 < -WIN) p1[r] = -1e30f; }
      }
      partialSM(p0, p1, m_reg, mn, al);
      if (__any(al < 1.f)) { if (hi == 0) al_l[r32] = al; asm volatile("s_waitcnt lgkmcnt(0)" ::: "memory");
#pragma unroll
        for (int d = 0; d < 4; ++d)
#pragma unroll
          for (int r = 0; r < 16; ++r) o[d][r] *= al_l[crow(r, hi)]; }
      finishSM(p0, p1, al, l_reg, pa0, pa1, pa2, pa3); SBAR();
      pv_d0(o, vb0, pa0, pa1, pa2, pa3);
    }
  }
  if (hi == 0) li_l[r32] = l_reg; asm volatile("s_waitcnt lgkmcnt(0)" ::: "memory");
  float rli[16];
#pragma unroll
  for (int r = 0; r < 16; ++r) rli[r] = __builtin_amdgcn_rcpf(li_l[crow(r, hi)]);
  bf16* Ow = Ob + (long)(P0 + wid * QBLK) * os;
#pragma unroll
  for (int r = 0; r < 16; ++r) { const int orow = crow(r, hi);
#pragma unroll
    for (int d0 = 0; d0 < 4; ++d0) { const float val = o[d0][r] * rli[r]; Ow[(long)orow * os + d0 * 32 + r32] = (bf16)(cvtpk(val, val) & 0xffffu); } }
  if (Lp != nullptr && hi == 0) Lp[(long)(P0 + wid * QBLK + r32) * ls] = m_reg * SCALE + __logf(l_reg);
}

constexpr int WB_TILE = 49152, WB_WS = 2 * WB_TILE;
template <int LDQ, int LDK, int LDO, int NVH, typename TO, bool COMBINE = false, int LDC = 0>
__device__ __forceinline__ void attn_wide_body(const bf16* __restrict__ Qb, const bf16* __restrict__ Kh, const bf16* __restrict__ Vh, TO* __restrict__ Ob, const int seq, char* lds, const int tid,
                                               const float lam = 0.f, const float gsc = 0.f, const float* __restrict__ gain = nullptr, bf16* __restrict__ Cb = nullptr) {
  const int wid = __builtin_amdgcn_readfirstlane(tid >> 6), lane = tid & 63, r32 = lane & 31, hi = lane >> 5;
  float* wsf = (float*)(lds + WB_WS) + wid * 64; float* li_l = wsf; float* al_l = wsf + 32;
  float m_reg = -1e30f, l_reg = 0; f32x16 o[4 * NVH] = {}; bf16x8 qr[8];
  { const bf16* Qw = Qb + ((wid * QBLK + r32) * LDQ + hi * 8);
#pragma unroll
    for (int d0 = 0; d0 < 8; ++d0) qr[d0] = *reinterpret_cast<const bf16x8*>(Qw + d0 * 16); }
  constexpr int NVP = 2 * NVH;
  int ksrc[2], vsrc[NVP];
#pragma unroll
  for (int i = 0; i < 2; ++i) { const int c = 2 * wid + i, row = 4 * c + (lane >> 4), colB = (16 * (lane & 15)) ^ ((row & 7) << 4); ksrc[i] = row * LDK + (colB >> 1); }
#pragma unroll
  for (int i = 0; i < NVP; ++i) { const int pc = wid * NVP + i, hf = pc >> 4, c = pc & 15, sub = 2 * c + (lane >> 5), kk = ((sub >> 2) << 3) | ((lane & 31) >> 2);
      const int k = (kk & ~0xC) | ((kk & 4) << 1) | ((kk & 8) >> 1), col = (sub & 3) * 32 + 8 * (lane & 3); vsrc[i] = k * LDK + hf * 128 + col; }
  using LP = __attribute__((address_space(3))) unsigned*;
#define WB_DMA(buf, key0) do { const bf16* _kb = Kh + (key0) * LDK; const bf16* _vb = Vh + (key0) * LDK; char* _l = lds + (buf) * WB_TILE; \
    _Pragma("unroll") for (int _i = 0; _i < 2; ++_i) __builtin_amdgcn_global_load_lds((const unsigned*)(_kb + ksrc[_i]), (LP)(_l + (2 * wid + _i) * 1024), 16, 0, 0); \
    _Pragma("unroll") for (int _i = 0; _i < NVP; ++_i) __builtin_amdgcn_global_load_lds((const unsigned*)(_vb + vsrc[_i]), (LP)(_l + 16384 + (wid * NVP + _i) * 1024), 16, 0, 0); } while (0)
  const int NT = seq / KVBLK;
  WB_DMA(0, 0);
  for (int j = 0; j < NT; ++j) {
    asm volatile("s_waitcnt vmcnt(0)" ::: "memory");
    __builtin_amdgcn_s_barrier();
    asm volatile("" ::: "memory");
    if (j + 1 < NT) WB_DMA((j + 1) & 1, (j + 1) * KVBLK);
    char* tb = lds + (j & 1) * WB_TILE;
    f32x16 p0, p1; float mn, al; bf16x8 pa0, pa1, pa2, pa3;
    qkt(p0, p1, (const bf16*)tb, qr, r32, hi);
    partialSM(p0, p1, m_reg, mn, al);
    if (__any(al < 1.f)) { if (hi == 0) al_l[r32] = al; asm volatile("s_waitcnt lgkmcnt(0)" ::: "memory");
#pragma unroll
      for (int d = 0; d < 4 * NVH; ++d)
#pragma unroll
        for (int r = 0; r < 16; ++r) o[d][r] *= al_l[crow(r, hi)]; }
    finishSM(p0, p1, al, l_reg, pa0, pa1, pa2, pa3); SBAR();
    const int vb0 = (int)(uintptr_t)(tb + 16384) + v_rd_base(lane);
    pv_one<0>(o[0], vb0, pa0, pa1, pa2, pa3); pv_one<1>(o[1], vb0, pa0, pa1, pa2, pa3); pv_one<2>(o[2], vb0, pa0, pa1, pa2, pa3); pv_one<3>(o[3], vb0, pa0, pa1, pa2, pa3);
    if constexpr (NVH == 2) {
    pv_one<0>(o[4 * (NVH - 1)], vb0 + 16384, pa0, pa1, pa2, pa3); pv_one<1>(o[4 * (NVH - 1) + 1], vb0 + 16384, pa0, pa1, pa2, pa3); pv_one<2>(o[4 * (NVH - 1) + 2], vb0 + 16384, pa0, pa1, pa2, pa3); pv_one<3>(o[4 * (NVH - 1) + 3], vb0 + 16384, pa0, pa1, pa2, pa3); }
  }
#undef WB_DMA
  int te = tid; asm volatile("" : "+v"(te));
  const int wid_e = __builtin_amdgcn_readfirstlane(te >> 6), r32_e = te & 31, hi_e = (te >> 5) & 1;
  float* li_e = (float*)(lds + WB_WS) + wid_e * 64;
  if (hi_e == 0) li_e[r32_e] = l_reg; asm volatile("s_waitcnt lgkmcnt(0)" ::: "memory");
  float rli[16];
#pragma unroll
  for (int r = 0; r < 16; ++r) rli[r] = __builtin_amdgcn_rcpf(li_e[crow(r, hi_e)]);
  TO* Ow = Ob + (wid_e * QBLK) * LDO;
  if constexpr (!COMBINE) {
#pragma unroll
    for (int r = 0; r < 16; ++r) { const int orow = crow(r, hi_e);
#pragma unroll
      for (int d0 = 0; d0 < 4 * NVH; ++d0) { const float val = o[d0][r] * rli[r];
        if constexpr (sizeof(TO) == 4) Ow[orow * LDO + d0 * 32 + r32_e] = val; else Ow[orow * LDO + d0 * 32 + r32_e] = (TO)(cvtpk(val, val) & 0xffffu); } }
  } else {
    static_assert(sizeof(TO) == 4 && NVH == 2, "combine: f32 first-map tile, 256-wide rows");
    float gn[8];
    { const float* g2 = gain; asm volatile("" : "+s"(g2));
#pragma unroll
      for (int d0 = 0; d0 < 8; ++d0) gn[d0] = g2[d0 * 32 + r32_e] * gsc; }
    bf16* Cw; { bf16* c2 = Cb; asm volatile("" : "+s"(c2)); Cw = c2 + (wid_e * QBLK) * LDC; }
    { TO* o2 = Ob; asm volatile("" : "+s"(o2)); Ow = o2 + (wid_e * QBLK) * LDO; }
#pragma unroll
    for (int r = 0; r < 16; ++r) { const int orow = crow(r, hi_e);
      float ss = 0.f;
#pragma unroll
      for (int d0 = 0; d0 < 8; ++d0) { const float o1 = __hip_atomic_load((const float*)Ow + orow * LDO + d0 * 32 + r32_e, __ATOMIC_RELAXED, __HIP_MEMORY_SCOPE_AGENT);
        const float av = o1 - lam * (o[d0][r] * rli[r]); o[d0][r] = av; ss = fmaf(av, av, ss); }
#define WB_SWZ(v, m) __int_as_float(__builtin_amdgcn_ds_swizzle(__float_as_int(v), ((m) << 10) | 0x1F))
      ss += WB_SWZ(ss, 1); ss += WB_SWZ(ss, 2); ss += WB_SWZ(ss, 4); ss += WB_SWZ(ss, 8); ss += WB_SWZ(ss, 16);
#undef WB_SWZ
      const float sc = 1.0f / sqrtf(ss * (1.0f / 256.0f) + 1e-6f);
#pragma unroll
      for (int d0 = 0; d0 < 8; ++d0) { const float val = o[d0][r] * sc * gn[d0]; Cw[orow * LDC + d0 * 32 + r32_e] = (bf16)(cvtpk(val, val) & 0xffffu); }
      asm volatile("" ::: "memory"); }
  }
}
}
typedef unsigned short bf16_t;
typedef unsigned u32x4v __attribute__((ext_vector_type(4)));
#define LDSA __attribute__((address_space(3)))
constexpr size_t al256(size_t x) { return (x + 255) / 256 * 256; }
constexpr size_t WS_CTL  = 0;
constexpr size_t CTL_BYTES = 65536;
constexpr size_t WS_XB   = WS_CTL + CTL_BYTES;
constexpr size_t WS_WAB  = WS_XB + (size_t)SEQ * DM * 2;
constexpr size_t WS_WOAB = WS_WAB + (size_t)12288 * 4096 * 2;
constexpr size_t WS_WCD  = WS_WOAB + (size_t)4096 * 3072 * 2;
constexpr size_t WS_WOCD = WS_WCD + (size_t)9216 * 4096 * 2;
constexpr size_t WS_WQ   = WS_WOCD + (size_t)4096 * 4096 * 2;
constexpr size_t WS_UB   = WS_WQ + (size_t)2 * 2048 * 4096 * 2;
constexpr size_t WS_VB   = WS_UB + (size_t)2 * 16384 * 3072;
constexpr size_t WS_SU   = WS_VB + (size_t)2 * 16384 * 3072;
constexpr size_t WS_SV   = WS_SU + (size_t)2 * 16384 * 4;
constexpr size_t WS_H    = WS_SV + (size_t)2 * 16384 * 4;
constexpr size_t WS_Y    = WS_H;
constexpr size_t WS_PQ   = WS_H + (size_t)SEQ * 4096 * 4;
constexpr size_t WS_OC   = WS_H + (size_t)SEQ * 12288 * 4;
constexpr size_t WS_AB   = WS_OC + (size_t)2 * SEQ * 2048 * 4;
constexpr size_t WS_X1   = WS_AB + (size_t)SEQ * 4096 * 2;
constexpr size_t WS_X1B  = WS_X1 + (size_t)SEQ * 4096 * 4;
constexpr size_t WS_X2   = WS_X1B + (size_t)SEQ * 4096 * 2;
constexpr size_t WS_X2B  = WS_X2 + (size_t)SEQ * 4096 * 4;
constexpr size_t WS_EIDX = WS_X2B + (size_t)SEQ * 4096 * 2;
constexpr size_t WS_GATE = WS_EIDX + (size_t)SEQ * 128 * 4;
constexpr size_t WS_HB   = WS_GATE + (size_t)SEQ * 128 * 4;
constexpr size_t WS_KEYB = WS_HB + (size_t)SEQ * 12288 * 2;
constexpr size_t WS_CS0  = WS_KEYB + (size_t)2 * 8 * 2 * 128 * 128 * 2;
constexpr size_t WS_CSA  = WS_CS0 + (size_t)SEQ * 16 * 8;
constexpr size_t WS_END  = WS_CSA + (size_t)128 * 32 * 8;
static_assert(WS_END <= (size_t)2147483648ull, "workspace");

constexpr int LDS_BYTES = 155648;
constexpr int LDS_MISC = 139264;

struct MK { const float* in[21]; float* out; unsigned char* ws; int ph_lo, ph_hi; };

namespace pg8 {
struct EpiF32R {
    static constexpr bool PERM = false, AFTER_DRAIN = false;
    float* C; int ldc; const float* R; float ralpha;
    __device__ __forceinline__ void operator()(const f32x4 (&acc)[2][2][4][2], const Unit& u, int wr, int wc, int fr, int fq) const {
        const int row0 = u.pm * BM + wr * 64 + fr, col0 = u.pn * BM + wc * 32 + 4 * fq;
#pragma unroll
        for (int ai = 0; ai < 2; ++ai)
#pragma unroll
            for (int m = 0; m < 4; ++m) { const size_t off = (size_t)(row0 + ai * HALF + m * 16) * ldc + col0;
#pragma unroll
                for (int bj = 0; bj < 2; ++bj)
#pragma unroll
                    for (int n = 0; n < 2; ++n) { f32x4 v = acc[ai][bj][m][n];
                        if (R) { const f32x4 r = *(const f32x4*)(R + off + bj * HALF + n * 16); v += r * ralpha; }
                        *(f32x4*)(C + off + bj * HALF + n * 16) = v; } }
    }
};
struct EpiBf16P {
    static constexpr bool PERM = true, AFTER_DRAIN = false;
    bf16_t* O; int ldc;
    __device__ __forceinline__ void operator()(const f32x4 (&acc)[2][2][4][2], const Unit& u, int wr, int wc, int fr, int fq) const {
        const int row0 = u.pm * BM + wr * 64 + fr, col0 = u.pn * BM + wc * 32 + 8 * fq;
#pragma unroll
        for (int ai = 0; ai < 2; ++ai)
#pragma unroll
            for (int m = 0; m < 4; ++m) { bf16_t* rowp = O + (size_t)(row0 + ai * HALF + m * 16) * ldc + col0;
#pragma unroll
                for (int bj = 0; bj < 2; ++bj) { const f32x4 v0 = acc[ai][bj][m][0], v1 = acc[ai][bj][m][1];
                    u32x4 w; w.x = cvt_pk_bf16(v0[0], v0[1]); w.y = cvt_pk_bf16(v0[2], v0[3]); w.z = cvt_pk_bf16(v1[0], v1[1]); w.w = cvt_pk_bf16(v1[2], v1[3]);
                    *(u32x4*)(rowp + bj * HALF) = w; } }
    }
};

template <int LAYER> struct EpiProj {
    static constexpr bool PERM = true, AFTER_DRAIN = false;
    bf16_t* O; int ldc; const float* cs0; const float* csa; const float* gq; const float* gk; PG8_LAS float* xch;
    __device__ __forceinline__ void operator()(const f32x4 (&acc)[2][2][4][2], const Unit& u, int wr, int wc, int fr, int fq) const {
        const int row0 = u.pm * BM + wr * 64 + fr, col0 = u.pn * BM + wc * 32 + 8 * fq;
        const int pn = u.pn;
        const bool prope = LAYER == 0 ? (pn < 10 || (pn >= 12 && pn < 36)) : (pn < 16);
        const bool dnorm = LAYER == 1 && pn >= 24 && pn < 34;
        float rs[2][4][2];
        float gn[8];
        if (dnorm) {
            const int lrow = fr;
#pragma unroll
            for (int ai = 0; ai < 2; ++ai)
#pragma unroll
                for (int m = 0; m < 4; ++m)
#pragma unroll
                    for (int bj = 0; bj < 2; ++bj) { const f32x4 a = acc[ai][bj][m][0], b = acc[ai][bj][m][1];
                        float q = (a[0] * a[0] + a[1] * a[1]) + (a[2] * a[2] + a[3] * a[3]) + (b[0] * b[0] + b[1] * b[1]) + (b[2] * b[2] + b[3] * b[3]);
                        q += __shfl_xor(q, 16); q += __shfl_xor(q, 32);
                        if (fq == 0) xch[((wr * 128 + (ai * 4 + m) * 16 + lrow) * 2 + bj) * 4 + wc] = q; }
            asm volatile("s_waitcnt lgkmcnt(0)" ::: "memory"); __builtin_amdgcn_s_barrier(); asm volatile("" ::: "memory");
#pragma unroll
            for (int ai = 0; ai < 2; ++ai)
#pragma unroll
                for (int m = 0; m < 4; ++m)
#pragma unroll
                    for (int bj = 0; bj < 2; ++bj) { const f32x4 p = *(const PG8_LAS f32x4*)(xch + ((wr * 128 + (ai * 4 + m) * 16 + lrow) * 2 + bj) * 4);
                        rs[ai][m][bj] = 1.0f / sqrtf(((p[0] + p[1]) + (p[2] + p[3])) * (1.0f / 128.0f) + 1e-6f); }
            const float* g = pn < 32 ? gq : gk;
#pragma unroll
            for (int e = 0; e < 8; ++e) { const int p = wc * 32 + 8 * fq + e; const int orig = (p & 64) + ((p & 63) >> 1) + 32 * (p & 1); gn[e] = g[orig]; }
        }
        const bool rot = dnorm || (prope && wc == 0);
#pragma unroll
        for (int ai = 0; ai < 2; ++ai) {
            f32x4 cs[4][2];
            if (rot) {
#pragma unroll
                for (int m = 0; m < 4; ++m) { const int row = row0 + ai * HALF + m * 16;
                    const float* cp = dnorm ? csa + ((size_t)(wc < 2 ? (row >> 6) : (row & 63)) * 32 + 16 * (wc & 1) + 4 * fq) * 2 : cs0 + ((size_t)row * 16 + 4 * fq) * 2;
                    cs[m][0] = *(const f32x4*)cp; cs[m][1] = *(const f32x4*)(cp + 4); }
            }
#pragma unroll
            for (int m = 0; m < 4; ++m) {
                const int row = row0 + ai * HALF + m * 16;
                bf16_t* rowp = O + (size_t)row * ldc + col0;
                f32x4 c0 = (f32x4){1.f, 0.f, 1.f, 0.f}, c1 = c0;
                if (rot) { c0 = cs[m][0]; c1 = cs[m][1]; }
#pragma unroll
                for (int bj = 0; bj < 2; ++bj) { f32x4 v0 = acc[ai][bj][m][0], v1 = acc[ai][bj][m][1];
                    if (dnorm) { const float r = rs[ai][m][bj];
                        v0[0] *= r * gn[0]; v0[1] *= r * gn[1]; v0[2] *= r * gn[2]; v0[3] *= r * gn[3]; v1[0] *= r * gn[4]; v1[1] *= r * gn[5]; v1[2] *= r * gn[6]; v1[3] *= r * gn[7]; }
                    if (rot) {
                        const float a0 = v0[0] * c0[0] - v0[1] * c0[1], b0 = v0[1] * c0[0] + v0[0] * c0[1];
                        const float a1 = v0[2] * c0[2] - v0[3] * c0[3], b1 = v0[3] * c0[2] + v0[2] * c0[3];
                        const float a2 = v1[0] * c1[0] - v1[1] * c1[1], b2 = v1[1] * c1[0] + v1[0] * c1[1];
                        const float a3 = v1[2] * c1[2] - v1[3] * c1[3], b3 = v1[3] * c1[2] + v1[2] * c1[3];
                        v0 = (f32x4){a0, b0, a1, b1}; v1 = (f32x4){a2, b2, a3, b3}; }
                    u32x4 w; w.x = cvt_pk_bf16(v0[0], v0[1]); w.y = cvt_pk_bf16(v0[2], v0[3]); w.z = cvt_pk_bf16(v1[0], v1[1]); w.w = cvt_pk_bf16(v1[2], v1[3]);
                    *(u32x4*)(rowp + bj * HALF) = w; }
            }
            asm volatile("" ::: "memory");
        }
    }
};
}

__device__ __forceinline__ float bf_lo(unsigned w) { return __uint_as_float(w << 16); }
__device__ __forceinline__ float bf_hi(unsigned w) { return __uint_as_float(w & 0xffff0000u); }
__device__ __forceinline__ unsigned cvtpk_bf16(float lo, float hi) { unsigned r; asm volatile("v_cvt_pk_bf16_f32 %0, %1, %2" : "=v"(r) : "v"(lo), "v"(hi)); return r; }

__device__ __forceinline__ void cvt_rows_bf16(const float* __restrict__ src, bf16_t* __restrict__ dst, size_t n8, int bid, int nb, int tid, int nthr) {
    const size_t stride = (size_t)nb * nthr;
    for (size_t i = (size_t)bid * nthr + tid; i < n8; i += 4 * stride) {
        float4 a[4], b[4];
#pragma unroll
        for (int u = 0; u < 4; ++u) { const size_t j = i + u * stride; if (j < n8) { a[u] = *(const float4*)(src + j * 8); b[u] = *(const float4*)(src + j * 8 + 4); } }
#pragma unroll
        for (int u = 0; u < 4; ++u) { const size_t j = i + u * stride; if (j < n8) {
            u32x4v w; w.x = cvtpk_bf16(a[u].x, a[u].y); w.y = cvtpk_bf16(a[u].z, a[u].w); w.z = cvtpk_bf16(b[u].x, b[u].y); w.w = cvtpk_bf16(b[u].z, b[u].w);
            *(u32x4v*)(dst + j * 8) = w; } }
    }
}
template <class PM>
__device__ __forceinline__ void transpose_cvt(const float* __restrict__ W, bf16_t* __restrict__ Wt, int K, int N, LDSA float* tile0, int bid, int nb, PM pm, const int tid) {
    const int lane = tid & 63, wv = tid >> 6;
    LDSA float* tile = tile0 + wv * 4352;
    const int ntk = K / 64, ntn = N / 64;
    for (int t = bid * 8 + wv; t < ntk * ntn; t += nb * 8) {
        const int k0 = (t % ntk) * 64, n0 = (t / ntk) * 64;
        const int c = (lane & 15) * 4, r0 = lane >> 4;
        float4 v[16];
#pragma unroll
        for (int i = 0; i < 16; ++i) v[i] = *(const float4*)(W + (size_t)(k0 + r0 + 4 * i) * N + n0 + c);
#pragma unroll
        for (int i = 0; i < 16; ++i) { const int r = r0 + 4 * i; tile[r * 65 + c] = v[i].x; tile[r * 65 + c + 1] = v[i].y; tile[r * 65 + c + 2] = v[i].z; tile[r * 65 + c + 3] = v[i].w; }
        asm volatile("s_waitcnt lgkmcnt(0)" ::: "memory");
        const int mode = pm(n0);
#pragma unroll
        for (int h = 0; h < 8; ++h) {
            const int n = (lane >> 3) + 8 * h, kc = (lane & 7) * 8;
            int src = n;
            if (mode == 1) { if (n < 32) src = (n >> 1) + 16 * (n & 1); }
            else if (mode == 2) src = (n >> 1) + 32 * (n & 1);
            float f[8];
#pragma unroll
            for (int j = 0; j < 8; ++j) f[j] = tile[(kc + j) * 65 + src];
            u32x4v w; w.x = cvtpk_bf16(f[0], f[1]); w.y = cvtpk_bf16(f[2], f[3]); w.z = cvtpk_bf16(f[4], f[5]); w.w = cvtpk_bf16(f[6], f[7]);
            *(u32x4v*)(Wt + (size_t)(n0 + n) * K + k0 + kc) = w;
        }
        asm volatile("s_waitcnt lgkmcnt(0)" ::: "memory");
    }
}
struct PermNone { __device__ __forceinline__ int operator()(int) const { return 0; } };
struct PermAB { __device__ __forceinline__ int operator()(int n0) const { const bool rope = n0 < 2560 || (n0 >= 3072 && n0 < 9216); return (rope && (n0 & 127) == 0) ? 1 : 0; } };
struct PermCD { __device__ __forceinline__ int operator()(int n0) const { if (n0 < 4096) return (n0 & 127) == 0 ? 1 : 0; if (n0 >= 6144 && n0 < 8704) return 2; return 0; } };
__device__ __forceinline__ void rope_tables(float* __restrict__ cs0, float* __restrict__ csa, const int bid, const int G, const int tid) {
    for (int i = bid * 512 + tid; i < SEQ * 16; i += G * 512) { float s, c; sincos_rev((double)(i >> 4) * REV_P[i & 15], s, c); *(float2*)(cs0 + (size_t)i * 2) = make_float2(c, s); }
    for (int i = bid * 512 + tid; i < 128 * 32; i += G * 512) { float s, c; sincos_rev((double)(i >> 5) * REV_A[i & 31], s, c); *(float2*)(csa + (size_t)i * 2) = make_float2(c, s); }
}


typedef unsigned v6u_t __attribute__((ext_vector_type(6)));
typedef float f4v_t __attribute__((ext_vector_type(4)));
typedef unsigned v16u_t __attribute__((ext_vector_type(16)));
typedef float v16f_t __attribute__((ext_vector_type(16)));
typedef float v32f_t __attribute__((ext_vector_type(32)));
typedef __bf16 v32b_t __attribute__((ext_vector_type(32)));
constexpr int ROWB = 3072;
constexpr int XT_STRIDE = 68;
constexpr int XT_BYTES = 64 * XT_STRIDE * 4;
__device__ __forceinline__ void table_fp6(const float* __restrict__ src, unsigned char* __restrict__ dst, float* __restrict__ inv, const int rows, LDSA float* xt0, const int bid, const int G, const int tid) {
    const int lane = tid & 63, wv = tid >> 6;
    LDSA float* xt = xt0 + wv * (XT_BYTES / 4);
    for (int r = bid * 8 + wv; r < rows; r += G * 8) {
        float4 v[16]; float am = 0.f;
#pragma unroll
        for (int j = 0; j < 16; ++j) { v[j] = *(const float4*)(src + (size_t)r * DM + j * 256 + lane * 4); am = fmaxf(am, fmaxf(fmaxf(fabsf(v[j].x), fabsf(v[j].y)), fmaxf(fabsf(v[j].z), fabsf(v[j].w)))); }
        am = wave_max(am);
        const float sc = am > 0.f ? 7.0f / am : 1.0f;
#pragma unroll
        for (int j = 0; j < 16; ++j) *(LDSA f4v_t*)(xt + (4 * j + (lane >> 4)) * XT_STRIDE + 4 * (lane & 15)) = (f4v_t){v[j].x * sc, v[j].y * sc, v[j].z * sc, v[j].w * sc};
        asm volatile("s_waitcnt lgkmcnt(0)" ::: "memory");
        v16f_t f0, f1, f2, f3;
#pragma unroll
        for (int k = 0; k < 8; ++k) { const f4v_t a = *(const LDSA f4v_t*)(xt + lane * XT_STRIDE + 4 * k), c = *(const LDSA f4v_t*)(xt + lane * XT_STRIDE + 32 + 4 * k);
            f0[2 * k] = a[0]; f1[2 * k] = a[1]; f0[2 * k + 1] = a[2]; f1[2 * k + 1] = a[3];
            f2[2 * k] = c[0]; f3[2 * k] = c[1]; f2[2 * k + 1] = c[2]; f3[2 * k + 1] = c[3]; }
        asm volatile("s_waitcnt lgkmcnt(0)" ::: "memory");
        const v6u_t w0 = __builtin_amdgcn_cvt_scalef32_2xpk16_fp6_f32(f0, f1, 1.0f), w1 = __builtin_amdgcn_cvt_scalef32_2xpk16_fp6_f32(f2, f3, 1.0f);
        unsigned char* dp = dst + (size_t)r * ROWB + lane * 48;
        u32x4v s0, s1, s2; s0.x = w0[0]; s0.y = w0[1]; s0.z = w0[2]; s0.w = w0[3]; s1.x = w0[4]; s1.y = w0[5]; s1.z = w1[0]; s1.w = w1[1]; s2.x = w1[2]; s2.y = w1[3]; s2.z = w1[4]; s2.w = w1[5];
        *(u32x4v*)dp = s0; *(u32x4v*)(dp + 16) = s1; *(u32x4v*)(dp + 32) = s2;
        if (lane == 0) inv[r] = am > 0.f ? am * (1.0f / 7.0f) : 1.0f;
    }
}

typedef __bf16 bf2_t __attribute__((ext_vector_type(2)));
__device__ __forceinline__ float dot2_bf16(unsigned a, unsigned b, float c) { return __builtin_amdgcn_fdot2_f32_bf16(__builtin_bit_cast(bf2_t, a), __builtin_bit_cast(bf2_t, b), c, false); }
__device__ __forceinline__ float gelu_tanh_f(float x) {
    const float z = 0.7978845608028654f * (x + 0.044715f * x * x * x);
    const float e = __expf(2.0f * z);
    return 0.5f * x * (2.0f - 2.0f / (e + 1.0f));
}
__device__ __forceinline__ int pick_i(int a0, int a1, int k) { return k < 64 ? __builtin_amdgcn_readlane(a0, k) : __builtin_amdgcn_readlane(a1, k - 64); }
__device__ __forceinline__ float pick_f(float a0, float a1, int k) { return __int_as_float(pick_i(__float_as_int(a0), __float_as_int(a1), k)); }
#define PE_LOADROW(dst, base, e) do { const unsigned char* _p = (base) + (size_t)(e) * ROWB + lane * 48; dst[0] = *(const u32x4v*)_p; dst[1] = *(const u32x4v*)(_p + 16); dst[2] = *(const u32x4v*)(_p + 32); } while (0)
__device__ __forceinline__ float pe_dot(const u32x4v (&r)[3], const u32x4v (&x)[8]) {
    float d0 = 0.f, d1 = 0.f, d2 = 0.f, d3 = 0.f;
    { const v6u_t g = {r[0].x, r[0].y, r[0].z, r[0].w, r[1].x, r[1].y};
      const v16u_t z = __builtin_bit_cast(v16u_t, __builtin_amdgcn_cvt_scalef32_pk32_bf16_fp6(g, 1.0f));
#pragma unroll
      for (int k = 0; k < 4; ++k) { const unsigned xa = x[k].x, xb = x[k].y, xc = x[k].z, xd = x[k].w; const unsigned za = z[4 * k], zb = z[4 * k + 1], zc = z[4 * k + 2], zd = z[4 * k + 3];
          d0 = dot2_bf16(za, xa, d0); d1 = dot2_bf16(zb, xb, d1); d2 = dot2_bf16(zc, xc, d2); d3 = dot2_bf16(zd, xd, d3); }
      asm volatile("" : "+v"(d0), "+v"(d1), "+v"(d2), "+v"(d3)); }
    { const v6u_t g = {r[1].z, r[1].w, r[2].x, r[2].y, r[2].z, r[2].w};
      const v16u_t z = __builtin_bit_cast(v16u_t, __builtin_amdgcn_cvt_scalef32_pk32_bf16_fp6(g, 1.0f));
#pragma unroll
      for (int k = 0; k < 4; ++k) { const unsigned xa = x[4 + k].x, xb = x[4 + k].y, xc = x[4 + k].z, xd = x[4 + k].w; const unsigned za = z[4 * k], zb = z[4 * k + 1], zc = z[4 * k + 2], zd = z[4 * k + 3];
          d0 = dot2_bf16(za, xa, d0); d1 = dot2_bf16(zb, xb, d1); d2 = dot2_bf16(zc, xc, d2); d3 = dot2_bf16(zd, xd, d3); } }
    return wave_sum((d0 + d1) + (d2 + d3));
}
#define PE_PIN16(a, b) asm volatile("" : "+v"(a[b + 0]), "+v"(a[b + 1]), "+v"(a[b + 2]), "+v"(a[b + 3]), "+v"(a[b + 4]), "+v"(a[b + 5]), "+v"(a[b + 6]), "+v"(a[b + 7]), \
                                         "+v"(a[b + 8]), "+v"(a[b + 9]), "+v"(a[b + 10]), "+v"(a[b + 11]), "+v"(a[b + 12]), "+v"(a[b + 13]), "+v"(a[b + 14]), "+v"(a[b + 15]))
__device__ __forceinline__ void pe_axpy(float (&acc)[64], const u32x4v (&r)[3], const float w) {
    { const v6u_t g = {r[0].x, r[0].y, r[0].z, r[0].w, r[1].x, r[1].y};
      const v32f_t y = __builtin_amdgcn_cvt_scalef32_pk32_f32_fp6(g, 1.0f);
#pragma unroll
      for (int i = 0; i < 32; ++i) acc[i] = fmaf(w, y[i], acc[i]);
      PE_PIN16(acc, 0); PE_PIN16(acc, 16); }
    { const v6u_t g = {r[1].z, r[1].w, r[2].x, r[2].y, r[2].z, r[2].w};
      const v32f_t y = __builtin_amdgcn_cvt_scalef32_pk32_f32_fp6(g, 1.0f);
#pragma unroll
      for (int i = 0; i < 32; ++i) acc[32 + i] = fmaf(w, y[i], acc[32 + i]);
      PE_PIN16(acc, 32); PE_PIN16(acc, 48); }
}
__device__ __forceinline__ void peer_expert_phase(const float* __restrict__ x1, const bf16_t* __restrict__ x1b, const int* __restrict__ eidx, const float* __restrict__ gate,
                                                  const unsigned char* __restrict__ ub, const unsigned char* __restrict__ vb, const float* __restrict__ isu, const float* __restrict__ isv,
                                                  const float* __restrict__ lg, const float* __restrict__ lb, float* __restrict__ out, bf16_t* __restrict__ outb, LDSA float* xt0, const int bid, const int G, const int tid) {
    const int lane = tid & 63, wv = __builtin_amdgcn_readfirstlane(tid >> 6);
    LDSA float* xt = xt0 + wv * (XT_BYTES / 4);
    for (int t = bid * 8 + wv; t < SEQ; t += G * 8) {
        const int e0 = eidx[(size_t)t * 128 + lane], e1 = eidx[(size_t)t * 128 + 64 + lane];
        const float g0 = gate[(size_t)t * 128 + lane], g1 = gate[(size_t)t * 128 + 64 + lane];
        const float iu0 = isu[e0], iu1 = isu[e1], iv0 = isv[e0], iv1 = isv[e1];
        u32x4v xq[8];
#pragma unroll
        for (int k = 0; k < 8; ++k) xq[k] = *(const u32x4v*)(x1b + (size_t)t * DM + lane * 64 + k * 8);
        float w0 = 0.f, w1 = 0.f;
        u32x4v R0[3], R1[3], R2[3];
#define PE_E(k) pick_i(e0, e1, (k))
#define PE_USTEP(R, k) do { const float d = pe_dot(R, xq) * pick_f(iu0, iu1, (k)); const float w = pick_f(g0, g1, (k)) * gelu_tanh_f(d) * pick_f(iv0, iv1, (k)); \
            if (lane == ((k) & 63)) { if ((k) < 64) w0 = w; else w1 = w; } } while (0)
        PE_LOADROW(R0, ub, PE_E(0)); PE_LOADROW(R1, ub, PE_E(1));
        for (int k = 0; k < 126; k += 3) {
            PE_LOADROW(R2, ub, PE_E(k + 2)); PE_USTEP(R0, k);
            PE_LOADROW(R0, ub, PE_E(k + 3)); PE_USTEP(R1, k + 1);
            PE_LOADROW(R1, ub, PE_E(k + 4)); PE_USTEP(R2, k + 2);
        }
        PE_USTEP(R0, 126); PE_USTEP(R1, 127);
        float acc[64];
#pragma unroll
        for (int i = 0; i < 64; ++i) acc[i] = 0.f;
        PE_LOADROW(R0, vb, PE_E(0)); PE_LOADROW(R1, vb, PE_E(1));
        for (int k = 0; k < 126; k += 3) {
            PE_LOADROW(R2, vb, PE_E(k + 2)); pe_axpy(acc, R0, pick_f(w0, w1, k));
            PE_LOADROW(R0, vb, PE_E(k + 3)); pe_axpy(acc, R1, pick_f(w0, w1, k + 1));
            PE_LOADROW(R1, vb, PE_E(k + 4)); pe_axpy(acc, R2, pick_f(w0, w1, k + 2));
        }
        pe_axpy(acc, R0, pick_f(w0, w1, 126)); pe_axpy(acc, R1, pick_f(w0, w1, 127));
#undef PE_E
#undef PE_USTEP
#pragma unroll
        for (int k = 0; k < 16; ++k) *(LDSA f4v_t*)(xt + lane * XT_STRIDE + 4 * k) = (f4v_t){acc[4 * k], acc[4 * k + 1], acc[4 * k + 2], acc[4 * k + 3]};
        asm volatile("s_waitcnt lgkmcnt(0)" ::: "memory");
        float4 y[16]; float s = 0.f;
#pragma unroll
        for (int j = 0; j < 16; ++j) { const f4v_t f = *(const LDSA f4v_t*)(xt + (4 * j + (lane >> 4)) * XT_STRIDE + 4 * (lane & 15));
            const float4 xv = *(const float4*)(x1 + (size_t)t * DM + j * 256 + lane * 4);
            y[j].x = fmaf(ALPHA, xv.x, f.x); y[j].y = fmaf(ALPHA, xv.y, f.y); y[j].z = fmaf(ALPHA, xv.z, f.z); y[j].w = fmaf(ALPHA, xv.w, f.w);
            s += (y[j].x + y[j].y) + (y[j].z + y[j].w);
            if ((j & 3) == 3) asm volatile("" ::: "memory"); }
        asm volatile("s_waitcnt lgkmcnt(0)" ::: "memory");
        const float mean = wave_sum(s) * (1.0f / DM);
        float qq = 0.f;
#pragma unroll
        for (int j = 0; j < 16; ++j) { const float a = y[j].x - mean, b = y[j].y - mean, c = y[j].z - mean, d = y[j].w - mean; qq += (a * a + b * b) + (c * c + d * d); }
        const float rstd = 1.0f / sqrtf(wave_sum(qq) * (1.0f / DM) + 1e-5f);
#pragma unroll
        for (int j = 0; j < 16; ++j) {
            const int c = j * 256 + lane * 4;
            const float4 ga = *(const float4*)(lg + c), ba = *(const float4*)(lb + c);
            float4 oa; oa.x = (y[j].x - mean) * rstd * ga.x + ba.x; oa.y = (y[j].y - mean) * rstd * ga.y + ba.y; oa.z = (y[j].z - mean) * rstd * ga.z + ba.z; oa.w = (y[j].w - mean) * rstd * ga.w + ba.w;
            *(float4*)(out + (size_t)t * DM + c) = oa;
            if (outb) { uint2 w; w.x = cvtpk_bf16(oa.x, oa.y); w.y = cvtpk_bf16(oa.z, oa.w); *(uint2*)(outb + (size_t)t * DM + c) = w; }
            if ((j & 3) == 3) asm volatile("" ::: "memory");
        }
    }
}

__device__ __forceinline__ void attn1_phase(const bf16_t* __restrict__ hb, bf16_t* __restrict__ abb, float* __restrict__ oc, const float* __restrict__ lq1, const float* __restrict__ lk1, const float* __restrict__ lq2,
                                            const float* __restrict__ lk2, const float* __restrict__ subg, char* lds, const int bid, const int G, const int tid) {
    for (int u = bid; u < 512; u += G) {
        __syncthreads();
        const int kv = u >> 7, g = (u >> 5) & 3, qb = u & 31, hq = kv * 4 + g;
        att::attn_wide_body<9216, 9216, 4096, 1, att::bf16>(hb + (size_t)(qb * 256) * 9216 + 6144 + hq * 128, hb + 8192 + kv * 128, hb + 8704 + kv * 128,
                                                             abb + (size_t)(qb * 256) * 4096 + 2048 + hq * 128, SEQ, lds, tid);
    }
    int tid2 = tid; asm volatile("" : "+v"(tid2));
    const int lane_c = tid2 & 63;
    const float lam = __int_as_float(__builtin_amdgcn_readfirstlane(__float_as_int(__expf(wave_sum(lq1[lane_c] * lk1[lane_c] + lq1[lane_c + 64] * lk1[lane_c + 64])) - __expf(wave_sum(lq2[lane_c] * lk2[lane_c] + lq2[lane_c + 64] * lk2[lane_c + 64])) + LAMBDA_INIT)));
    for (int v = bid; v < 256; v += G) {
        __syncthreads();
        const int h = v >> 5, qb = v & 31;
        float* o1 = oc + (size_t)(qb * 256) * 2048 + h * 256;
        int tid4 = tid2; asm volatile("" : "+v"(tid4));
        att::attn_wide_body<9216, 9216, 2048, 2, float>(hb + (size_t)(qb * 256) * 9216 + h * 256, hb + 2048 + h * 256, hb + 4096 + h * 256, o1, SEQ, lds, tid4);
        __syncthreads();
        int tid3 = tid2; asm volatile("" : "+v"(tid3));
        att::attn_wide_body<9216, 9216, 2048, 2, float, true, 4096>(hb + (size_t)(qb * 256) * 9216 + h * 256 + 128, hb + 2048 + h * 256 + 128, hb + 4096 + h * 256, o1, SEQ, lds, tid3,
                                                                     lam, 1.0f - LAMBDA_INIT, subg, abb + (size_t)(qb * 256) * 4096 + h * 256);
    }
}


__device__ __forceinline__ void attn0_phase(const bf16_t* __restrict__ hb, const float* __restrict__ sink, bf16_t* __restrict__ abb, bf16_t* __restrict__ obg, float* __restrict__ lse, char* lds, const int bid, const int G, const int tid) {
    const long LD = 12288;
    for (int u = bid; u < 512; u += G) {
        __syncthreads();
        const int hq = u >> 5, qb = u & 31, kv = hq >> 2;
        att::attn_banded_body<128>(hb + hq * 128, hb + 2048 + kv * 128, hb + 2560 + kv * 128, LD, SEQ, qb * 256, sink[hq] * (1.0f / att::SCALE), 1.0f, abb + hq * 128, 3072, nullptr, 0, lds, tid);
    }
    int tid2 = tid; asm volatile("" : "+v"(tid2));
    for (int v = bid; v < 768; v += G) {
        __syncthreads();
        const int g = v >> 8, w = v & 255, h = w >> 5, rem = w & 31;
        const int dsh = 2 * g;
        const int nqb_sh = 5 - dsh;
        const int r = rem >> nqb_sh, qb = rem & ((1 << nqb_sh) - 1);
        const int head = 8 * g + h;
        const long rs = LD << dsh;
        att::attn_banded_body<64>(hb + (long)r * LD + 3072 + head * 128, hb + (long)r * LD + 6144 + head * 128, hb + (long)r * LD + 9216 + head * 128, rs, SEQ >> dsh, qb * 256, -1e30f, 0.f,
                                  obg + ((long)(g * 8 + h) * SEQ + r) * 128, (long)128 << dsh, lse + (long)(g * 8 + h) * SEQ + r, (long)1 << dsh, lds, tid2);
    }
}
__device__ __forceinline__ void merge0_phase(const bf16_t* __restrict__ obg, const float* __restrict__ lse, bf16_t* __restrict__ abb, const int bid, const int G, const int tid) {
    const int lane = tid & 63, wv = tid >> 6;
    for (int j = bid * 8 + wv; j < SEQ * 8; j += G * 8) {
        const int h = j >> 13, t = j & (SEQ - 1);
        const float l0 = lse[(size_t)(0 * 8 + h) * SEQ + t], l1 = lse[(size_t)(1 * 8 + h) * SEQ + t], l2 = lse[(size_t)(2 * 8 + h) * SEQ + t];
        const float mx = fmaxf(l0, fmaxf(l1, l2));
        const float e0 = __expf(l0 - mx), e1 = __expf(l1 - mx), e2 = __expf(l2 - mx), inv = 1.0f / (e0 + e1 + e2);
        const unsigned a0 = *(const unsigned*)(obg + ((size_t)(0 * 8 + h) * SEQ + t) * 128 + 2 * lane), a1 = *(const unsigned*)(obg + ((size_t)(1 * 8 + h) * SEQ + t) * 128 + 2 * lane), a2 = *(const unsigned*)(obg + ((size_t)(2 * 8 + h) * SEQ + t) * 128 + 2 * lane);
        const float x = (e0 * bf_lo(a0) + e1 * bf_lo(a1) + e2 * bf_lo(a2)) * inv, y = (e0 * bf_hi(a0) + e1 * bf_hi(a1) + e2 * bf_hi(a2)) * inv;
        *(unsigned*)(abb + (size_t)t * 3072 + 2048 + h * 128 + 2 * lane) = cvtpk_bf16(x, y);
    }
}

__device__ __forceinline__ void post_even_phase(const float* __restrict__ h, bf16_t* __restrict__ hb, const int bid, const int G, const int tid) {
    const int lane = tid & 63, wv = tid >> 6;
    for (int job = bid * 8 + wv; job < SEQ * 96; job += G * 8) {
        const int t = job / 96, blk = job - t * 96;
        const bool rope = (blk < 20) || (blk >= 24 && blk < 72);
        const float2 v = *(const float2*)(h + (size_t)t * 12288 + blk * 128 + 2 * lane);
        float o0 = v.x, o1 = v.y;
        const float p0 = __shfl_xor(v.x, 8), p1 = __shfl_xor(v.y, 8);
        if (rope && lane < 16) {
            const int i0 = (2 * lane) & 15;
            float s0, c0, s1, c1; sincos_rev((double)t * REV_P[i0], s0, c0); sincos_rev((double)t * REV_P[i0 + 1], s1, c1);
            if (lane < 8) { o0 = v.x * c0 - p0 * s0; o1 = v.y * c1 - p1 * s1; }
            else          { o0 = v.x * c0 + p0 * s0; o1 = v.y * c1 + p1 * s1; }
        }
        *(unsigned*)(hb + (size_t)t * 12288 + blk * 128 + 2 * lane) = cvtpk_bf16(o0, o1);
    }
}
__device__ __forceinline__ void post_odd_phase(const float* __restrict__ h, bf16_t* __restrict__ hb, const float* __restrict__ qg, const float* __restrict__ kg, const int bid, const int G, const int tid) {
    const int lane = tid & 63, wv = tid >> 6;
    for (int job = bid * 8 + wv; job < SEQ * 72; job += G * 8) {
        const int t = job / 72, blk = job - t * 72;
        const float2 v = *(const float2*)(h + (size_t)t * 9216 + blk * 128 + 2 * lane);
        float o0 = v.x, o1 = v.y;
        if (blk < 32) {
            const float p0 = __shfl_xor(v.x, 8), p1 = __shfl_xor(v.y, 8);
            if (lane < 16) {
                const int i0 = (2 * lane) & 15;
                float s0, c0, s1, c1; sincos_rev((double)t * REV_P[i0], s0, c0); sincos_rev((double)t * REV_P[i0 + 1], s1, c1);
                if (lane < 8) { o0 = v.x * c0 - p0 * s0; o1 = v.y * c1 - p1 * s1; }
                else          { o0 = v.x * c0 + p0 * s0; o1 = v.y * c1 + p1 * s1; }
            }
        } else if (blk >= 48 && blk < 68) {
            const float* g = blk < 64 ? qg : kg;
            const float ss = wave_sum(v.x * v.x + v.y * v.y) * (1.0f / 128.0f);
            const float rs = 1.0f / sqrtf(ss + 1e-6f);
            const float a0 = v.x * rs * g[2 * lane], a1 = v.y * rs * g[2 * lane + 1];
            const float p0 = __shfl_xor(a0, 16), p1 = __shfl_xor(a1, 16);
            const int i0 = (2 * lane) & 31;
            const double pos = (double)(lane < 32 ? (t >> 6) : (t & 63));
            float s0, c0, s1, c1; sincos_rev(pos * REV_A[i0], s0, c0); sincos_rev(pos * REV_A[i0 + 1], s1, c1);
            if ((lane & 16) == 0) { o0 = a0 * c0 - p0 * s0; o1 = a1 * c1 - p1 * s1; }
            else                  { o0 = a0 * c0 + p0 * s0; o1 = a1 * c1 + p1 * s1; }
        }
        *(unsigned*)(hb + (size_t)t * 9216 + blk * 128 + 2 * lane) = cvtpk_bf16(o0, o1);
    }
}

__device__ __forceinline__ void attn_seg_b(const float q0, const float q1, const bf16_t* __restrict__ Kb, const bf16_t* __restrict__ Vb, const int ld,
                                           const int t, const int step, int jlo, int jhi, float& m, float& l, float& o0, float& o1, const int lane) {
    { const int lo = -(t / step); if (jlo < lo) jlo = lo; const int hi = (SEQ - 1 - t) / step; if (jhi > hi) jhi = hi; }
    for (int j = jlo; j <= jhi; ++j) {
        const size_t tp = (size_t)(t + step * j);
        const unsigned kw = *(const unsigned*)(Kb + tp * ld + 2 * lane), vw = *(const unsigned*)(Vb + tp * ld + 2 * lane);
        const float s = wave_sum(q0 * bf_lo(kw) + q1 * bf_hi(kw)) * ATT_SCALE;
        const float mn = fmaxf(m, s);
        const float al = __expf(m - mn), p = __expf(s - mn);
        l = l * al + p;
        o0 = o0 * al + p * bf_lo(vw); o1 = o1 * al + p * bf_hi(vw);
        m = mn;
    }
}
__device__ __forceinline__ void attn_even_valu_phase(const bf16_t* __restrict__ hb, const float* __restrict__ sink, bf16_t* __restrict__ abb, const int bid, const int G, const int tid) {
    const int lane = tid & 63, wv = tid >> 6;
    const int LD = 12288;
    for (int job = bid * 8 + wv; job < SEQ * 24; job += G * 8) {
        const int hh = job / SEQ, t = job % SEQ;
        float o0 = 0.f, o1 = 0.f, m, l;
        if (hh < 16) {
            const int kv = hh >> 2;
            const unsigned qw = *(const unsigned*)(hb + (size_t)t * LD + hh * 128 + 2 * lane);
            m = sink[hh]; l = 1.f;
            attn_seg_b(bf_lo(qw), bf_hi(qw), hb + 2048 + kv * 128, hb + 2560 + kv * 128, LD, t, 1, -128, 128, m, l, o0, o1, lane);
        } else {
            const int hbh = hh - 16;
            m = -1e30f; l = 0.f;
#pragma unroll
            for (int g = 0; g < 3; ++g) {
                const int head = 8 * g + hbh; const int step = g == 0 ? 1 : (g == 1 ? 4 : 16);
                const unsigned qw = *(const unsigned*)(hb + (size_t)t * LD + 3072 + head * 128 + 2 * lane);
                attn_seg_b(bf_lo(qw), bf_hi(qw), hb + 6144 + head * 128, hb + 9216 + head * 128, LD, t, step, -64, 64, m, l, o0, o1, lane);
            }
        }
        const float il = 1.0f / l;
        *(unsigned*)(abb + (size_t)t * 3072 + hh * 128 + 2 * lane) = cvtpk_bf16(o0 * il, o1 * il);
    }
}

__device__ __forceinline__ void ln_phase(const float* __restrict__ y, const float* __restrict__ g, const float* __restrict__ b, float* __restrict__ out, bf16_t* __restrict__ outb, const int bid, const int G, const int tid) {
    const int lane = tid & 63, wv = tid >> 6;
    for (int t = bid * 8 + wv; t < SEQ; t += G * 8) {
        float4 v[16]; float s = 0.f;
#pragma unroll
        for (int i = 0; i < 16; ++i) { v[i] = *(const float4*)(y + (size_t)t * DM + i * 256 + lane * 4); s += (v[i].x + v[i].y) + (v[i].z + v[i].w); }
        const float mean = wave_sum(s) * (1.0f / DM);
        float q = 0.f;
#pragma unroll
        for (int i = 0; i < 16; ++i) { const float a = v[i].x - mean, bb = v[i].y - mean, c = v[i].z - mean, d = v[i].w - mean; q += (a * a + bb * bb) + (c * c + d * d); }
        const float rstd = 1.0f / sqrtf(wave_sum(q) * (1.0f / DM) + 1e-5f);
#pragma unroll
        for (int i = 0; i < 16; ++i) {
            const float4 gg = *(const float4*)(g + i * 256 + lane * 4), bb = *(const float4*)(b + i * 256 + lane * 4);
            float4 o; o.x = (v[i].x - mean) * rstd * gg.x + bb.x; o.y = (v[i].y - mean) * rstd * gg.y + bb.y; o.z = (v[i].z - mean) * rstd * gg.z + bb.z; o.w = (v[i].w - mean) * rstd * gg.w + bb.w;
            *(float4*)(out + (size_t)t * DM + i * 256 + lane * 4) = o;
            uint2 w; w.x = cvtpk_bf16(o.x, o.y); w.y = cvtpk_bf16(o.z, o.w); *(uint2*)(outb + (size_t)t * DM + i * 256 + lane * 4) = w;
            if ((i & 3) == 3) asm volatile("" ::: "memory");
        }
    }
}

__device__ __forceinline__ void route_valu_phase(const float* __restrict__ q  , const float* __restrict__ keys  , int* __restrict__ eidx, float* __restrict__ gate, const int bid, const int G, const int tid) {
    const int lane = tid & 63, wv = tid >> 6;
    for (int job = bid * 8 + wv; job < SEQ * 8; job += G * 8) {
        const int hh = job & 7, t = job >> 3;
        float sv0 = 0.f, sv1 = 0.f; int si0 = 0, si1 = 0;
#pragma unroll
        for (int c = 0; c < 2; ++c) {
            const float* qq = q + (size_t)t * 2048 + hh * 256 + c * 128;
            const float* k0 = keys + ((size_t)(hh * 2 + c) * 128 + lane) * 128;
            const float* k1 = k0 + 64 * 128;
            float s0 = 0.f, s1 = 0.f;
            for (int d = 0; d < 128; d += 4) {
                const float4 qv = *(const float4*)(qq + d), a = *(const float4*)(k0 + d), b = *(const float4*)(k1 + d);
                s0 += qv.x * a.x + qv.y * a.y + qv.z * a.z + qv.w * a.w;
                s1 += qv.x * b.x + qv.y * b.y + qv.z * b.z + qv.w * b.w;
            }
            float myv = 0.f; int myi = 0;
            for (int k = 0; k < 16; ++k) {
                float bv; int bi;
                if (s1 > s0) { bv = s1; bi = lane + 64; } else { bv = s0; bi = lane; }
#pragma unroll
                for (int o = 32; o >= 1; o >>= 1) {
                    const float ov = __shfl_xor(bv, o); const int oi = __shfl_xor(bi, o);
                    if (ov > bv || (ov == bv && oi < bi)) { bv = ov; bi = oi; }
                }
                if (lane == k) { myv = bv; myi = bi; }
                if (bi == lane) s0 = -3.0e38f;
                if (bi == lane + 64) s1 = -3.0e38f;
            }
            if (c == 0) { sv0 = myv; si0 = myi; } else { sv1 = myv; si1 = myi; }
        }
        float cv0, cv1, cv2, cv3; int ci0, ci1, ci2, ci3;
        { const float a = __shfl(sv0, lane >> 2); const int ai = __shfl(si0, lane >> 2); const int jb = (lane & 3) * 4;
          cv0 = a + __shfl(sv1, jb + 0); ci0 = ai * 128 + __shfl(si1, jb + 0);
          cv1 = a + __shfl(sv1, jb + 1); ci1 = ai * 128 + __shfl(si1, jb + 1);
          cv2 = a + __shfl(sv1, jb + 2); ci2 = ai * 128 + __shfl(si1, jb + 2);
          cv3 = a + __shfl(sv1, jb + 3); ci3 = ai * 128 + __shfl(si1, jb + 3); }
        float tv = 0.f; int te = 0;
        for (int k = 0; k < 16; ++k) {
            float bv = cv0; int bp = lane * 4, be = ci0;
            if (cv1 > bv) { bv = cv1; bp = lane * 4 + 1; be = ci1; }
            if (cv2 > bv) { bv = cv2; bp = lane * 4 + 2; be = ci2; }
            if (cv3 > bv) { bv = cv3; bp = lane * 4 + 3; be = ci3; }
#pragma unroll
            for (int o = 32; o >= 1; o >>= 1) {
                const float ov = __shfl_xor(bv, o); const int op = __shfl_xor(bp, o); const int oe = __shfl_xor(be, o);
                if (ov > bv || (ov == bv && op < bp)) { bv = ov; bp = op; be = oe; }
            }
            if (lane == k) { tv = bv; te = be; }
            if (bp == lane * 4 + 0) cv0 = -3.0e38f;
            if (bp == lane * 4 + 1) cv1 = -3.0e38f;
            if (bp == lane * 4 + 2) cv2 = -3.0e38f;
            if (bp == lane * 4 + 3) cv3 = -3.0e38f;
        }
        const float v = lane < 16 ? tv : -3.0e38f;
        const float mx = wave_max(v);
        const float e = lane < 16 ? __expf(tv - mx) : 0.f;
        const float den = wave_sum(e);
        if (lane < 16) { eidx[(size_t)t * 128 + hh * 16 + lane] = te; gate[(size_t)t * 128 + hh * 16 + lane] = e / den; }
    }
}
namespace rt {
using att::f32x16; using att::bf16x8;
__device__ __forceinline__ float pair_max(float m) {
    auto rr = __builtin_amdgcn_permlane32_swap(__float_as_uint(m), __float_as_uint(m), false, false);
    return fmaxf(__uint_as_float(rr[0]), __uint_as_float(rr[1]));
}
__device__ __forceinline__ int pair_max_i(int m) {
    auto rr = __builtin_amdgcn_permlane32_swap((unsigned)m, (unsigned)m, false, false);
    const int a = (int)rr[0], b = (int)rr[1]; return a > b ? a : b;
}
__device__ __forceinline__ void top16_of_128(f32x16& p0, f32x16& p1, f32x16& p2, f32x16& p3, float (&t)[16]) {
#pragma unroll
    for (int k = 0; k < 16; ++k) {
        float m = p0[0];
#pragma unroll
        for (int r = 1; r < 16; ++r) m = fmaxf(m, p0[r]);
#pragma unroll
        for (int r = 0; r < 16; ++r) m = fmaxf(m, fmaxf(p1[r], fmaxf(p2[r], p3[r])));
        m = pair_max(m);
        t[k] = m;
#pragma unroll
        for (int r = 0; r < 16; ++r) { p0[r] = p0[r] == m ? -3.0e38f : p0[r]; p1[r] = p1[r] == m ? -3.0e38f : p1[r]; p2[r] = p2[r] == m ? -3.0e38f : p2[r]; p3[r] = p3[r] == m ? -3.0e38f : p3[r]; }
    }
}
__device__ __forceinline__ void tag_scores(f32x16& p, const int base, const int hi) {
#pragma unroll
    for (int r = 0; r < 16; ++r) p[r] = __uint_as_float((__float_as_uint(p[r]) & ~0x7Fu) | (unsigned)(base + att::crow(r, hi)));
}
}

__device__ __forceinline__ void route_mfma_phase(const bf16_t* __restrict__ pqb  , const bf16_t* __restrict__ keysb  , int* __restrict__ eidx, float* __restrict__ gate,
                                                 char* lds, const int bid, const int G, const int tid) {
    using namespace rt;
    const int wid = __builtin_amdgcn_readfirstlane(tid >> 6), lane = tid & 63, r32 = lane & 31, hi = lane >> 5;
    att::bf16* K_lds = (att::bf16*)lds;
    for (int u = bid; u < 256; u += G) {
        const int h = u & 7, tb = (u >> 3) * 256;
        const int tok = tb + wid * 32 + r32;
        float t0[16], t1[16];
#pragma unroll
        for (int c = 0; c < 2; ++c) {
            __syncthreads();
            { const bf16_t* kp = keysb + (size_t)(h * 2 + c) * 128 * 128;
              const int row = tid >> 2;
#pragma unroll
              for (int i = 0; i < 4; ++i) { const int sc = ((tid & 3) * 4 + i) * 8;
                  const bf16x8 v = *reinterpret_cast<const bf16x8*>(kp + row * 128 + sc);
                  *(bf16x8*)((char*)K_lds + (row >> 6) * 16384 + KSWZ(row & 63, sc * 2)) = v; } }
            bf16x8 qr[8];
            { const bf16_t* qw = pqb + (size_t)tok * 2048 + h * 256 + c * 128 + hi * 8;
#pragma unroll
              for (int d0 = 0; d0 < 8; ++d0) qr[d0] = *reinterpret_cast<const bf16x8*>(qw + d0 * 16); }
            __syncthreads();
            f32x16 p0, p1, p2, p3;
            att::qkt(p0, p1, K_lds, qr, r32, hi);
            att::qkt(p2, p3, (att::bf16*)((char*)K_lds + 16384), qr, r32, hi);
            tag_scores(p0, 0, hi); tag_scores(p1, 32, hi); tag_scores(p2, 64, hi); tag_scores(p3, 96, hi);
            if (c == 0) top16_of_128(p0, p1, p2, p3, t0); else top16_of_128(p0, p1, p2, p3, t1);
        }
        float v0[16], v1[16]; int k0[16], k1[16];
#pragma unroll
        for (int i = 0; i < 16; ++i) { const unsigned a = __float_as_uint(t0[i]), b = __float_as_uint(t1[i]);
            v0[i] = __uint_as_float(a & ~0x7Fu); v1[i] = __uint_as_float(b & ~0x7Fu); k0[i] = (int)((a & 0x7Fu) << 7); k1[i] = (int)(b & 0x7Fu); }
        float cv[25]; int ce[25];
    { const float s = hi ? (v0[0] + v1[1]) : (v0[0] + v1[0]); cv[0] = __uint_as_float((__float_as_uint(s) & ~0xFFu) | (unsigned)(2 * 0 + hi)); ce[0] = hi ? (k0[0] | k1[1]) : (k0[0] | k1[0]); }
    { const float s = hi ? (v0[0] + v1[3]) : (v0[0] + v1[2]); cv[1] = __uint_as_float((__float_as_uint(s) & ~0xFFu) | (unsigned)(2 * 1 + hi)); ce[1] = hi ? (k0[0] | k1[3]) : (k0[0] | k1[2]); }
    { const float s = hi ? (v0[0] + v1[5]) : (v0[0] + v1[4]); cv[2] = __uint_as_float((__float_as_uint(s) & ~0xFFu) | (unsigned)(2 * 2 + hi)); ce[2] = hi ? (k0[0] | k1[5]) : (k0[0] | k1[4]); }
    { const float s = hi ? (v0[0] + v1[7]) : (v0[0] + v1[6]); cv[3] = __uint_as_float((__float_as_uint(s) & ~0xFFu) | (unsigned)(2 * 3 + hi)); ce[3] = hi ? (k0[0] | k1[7]) : (k0[0] | k1[6]); }
    { const float s = hi ? (v0[0] + v1[9]) : (v0[0] + v1[8]); cv[4] = __uint_as_float((__float_as_uint(s) & ~0xFFu) | (unsigned)(2 * 4 + hi)); ce[4] = hi ? (k0[0] | k1[9]) : (k0[0] | k1[8]); }
    { const float s = hi ? (v0[0] + v1[11]) : (v0[0] + v1[10]); cv[5] = __uint_as_float((__float_as_uint(s) & ~0xFFu) | (unsigned)(2 * 5 + hi)); ce[5] = hi ? (k0[0] | k1[11]) : (k0[0] | k1[10]); }
    { const float s = hi ? (v0[0] + v1[13]) : (v0[0] + v1[12]); cv[6] = __uint_as_float((__float_as_uint(s) & ~0xFFu) | (unsigned)(2 * 6 + hi)); ce[6] = hi ? (k0[0] | k1[13]) : (k0[0] | k1[12]); }
    { const float s = hi ? (v0[0] + v1[15]) : (v0[0] + v1[14]); cv[7] = __uint_as_float((__float_as_uint(s) & ~0xFFu) | (unsigned)(2 * 7 + hi)); ce[7] = hi ? (k0[0] | k1[15]) : (k0[0] | k1[14]); }
    { const float s = hi ? (v0[1] + v1[1]) : (v0[1] + v1[0]); cv[8] = __uint_as_float((__float_as_uint(s) & ~0xFFu) | (unsigned)(2 * 8 + hi)); ce[8] = hi ? (k0[1] | k1[1]) : (k0[1] | k1[0]); }
    { const float s = hi ? (v0[1] + v1[3]) : (v0[1] + v1[2]); cv[9] = __uint_as_float((__float_as_uint(s) & ~0xFFu) | (unsigned)(2 * 9 + hi)); ce[9] = hi ? (k0[1] | k1[3]) : (k0[1] | k1[2]); }
    { const float s = hi ? (v0[1] + v1[5]) : (v0[1] + v1[4]); cv[10] = __uint_as_float((__float_as_uint(s) & ~0xFFu) | (unsigned)(2 * 10 + hi)); ce[10] = hi ? (k0[1] | k1[5]) : (k0[1] | k1[4]); }
    { const float s = hi ? (v0[1] + v1[7]) : (v0[1] + v1[6]); cv[11] = __uint_as_float((__float_as_uint(s) & ~0xFFu) | (unsigned)(2 * 11 + hi)); ce[11] = hi ? (k0[1] | k1[7]) : (k0[1] | k1[6]); }
    { const float s = hi ? (v0[2] + v1[1]) : (v0[2] + v1[0]); cv[12] = __uint_as_float((__float_as_uint(s) & ~0xFFu) | (unsigned)(2 * 12 + hi)); ce[12] = hi ? (k0[2] | k1[1]) : (k0[2] | k1[0]); }
    { const float s = hi ? (v0[2] + v1[3]) : (v0[2] + v1[2]); cv[13] = __uint_as_float((__float_as_uint(s) & ~0xFFu) | (unsigned)(2 * 13 + hi)); ce[13] = hi ? (k0[2] | k1[3]) : (k0[2] | k1[2]); }
    { const float s = hi ? (v0[3] + v1[0]) : (v0[2] + v1[4]); cv[14] = __uint_as_float((__float_as_uint(s) & ~0xFFu) | (unsigned)(2 * 14 + hi)); ce[14] = hi ? (k0[3] | k1[0]) : (k0[2] | k1[4]); }
    { const float s = hi ? (v0[3] + v1[2]) : (v0[3] + v1[1]); cv[15] = __uint_as_float((__float_as_uint(s) & ~0xFFu) | (unsigned)(2 * 15 + hi)); ce[15] = hi ? (k0[3] | k1[2]) : (k0[3] | k1[1]); }
    { const float s = hi ? (v0[4] + v1[0]) : (v0[3] + v1[3]); cv[16] = __uint_as_float((__float_as_uint(s) & ~0xFFu) | (unsigned)(2 * 16 + hi)); ce[16] = hi ? (k0[4] | k1[0]) : (k0[3] | k1[3]); }
    { const float s = hi ? (v0[4] + v1[2]) : (v0[4] + v1[1]); cv[17] = __uint_as_float((__float_as_uint(s) & ~0xFFu) | (unsigned)(2 * 17 + hi)); ce[17] = hi ? (k0[4] | k1[2]) : (k0[4] | k1[1]); }
    { const float s = hi ? (v0[5] + v1[1]) : (v0[5] + v1[0]); cv[18] = __uint_as_float((__float_as_uint(s) & ~0xFFu) | (unsigned)(2 * 18 + hi)); ce[18] = hi ? (k0[5] | k1[1]) : (k0[5] | k1[0]); }
    { const float s = hi ? (v0[6] + v1[1]) : (v0[6] + v1[0]); cv[19] = __uint_as_float((__float_as_uint(s) & ~0xFFu) | (unsigned)(2 * 19 + hi)); ce[19] = hi ? (k0[6] | k1[1]) : (k0[6] | k1[0]); }
    { const float s = hi ? (v0[7] + v1[1]) : (v0[7] + v1[0]); cv[20] = __uint_as_float((__float_as_uint(s) & ~0xFFu) | (unsigned)(2 * 20 + hi)); ce[20] = hi ? (k0[7] | k1[1]) : (k0[7] | k1[0]); }
    { const float s = hi ? (v0[9] + v1[0]) : (v0[8] + v1[0]); cv[21] = __uint_as_float((__float_as_uint(s) & ~0xFFu) | (unsigned)(2 * 21 + hi)); ce[21] = hi ? (k0[9] | k1[0]) : (k0[8] | k1[0]); }
    { const float s = hi ? (v0[11] + v1[0]) : (v0[10] + v1[0]); cv[22] = __uint_as_float((__float_as_uint(s) & ~0xFFu) | (unsigned)(2 * 22 + hi)); ce[22] = hi ? (k0[11] | k1[0]) : (k0[10] | k1[0]); }
    { const float s = hi ? (v0[13] + v1[0]) : (v0[12] + v1[0]); cv[23] = __uint_as_float((__float_as_uint(s) & ~0xFFu) | (unsigned)(2 * 23 + hi)); ce[23] = hi ? (k0[13] | k1[0]) : (k0[12] | k1[0]); }
    { const float s = hi ? (v0[15] + v1[0]) : (v0[14] + v1[0]); cv[24] = __uint_as_float((__float_as_uint(s) & ~0xFFu) | (unsigned)(2 * 24 + hi)); ce[24] = hi ? (k0[15] | k1[0]) : (k0[14] | k1[0]); }
        float ts[16]; int te[16];
#pragma unroll
        for (int k = 0; k < 16; ++k) {
            float m = cv[0];
#pragma unroll
            for (int n = 1; n < 25; ++n) m = fmaxf(m, cv[n]);
            m = pair_max(m);
            int e = -1;
#pragma unroll
            for (int n = 0; n < 25; ++n) { const bool hit = cv[n] == m; e = hit ? ce[n] : e; cv[n] = hit ? -3.0e38f : cv[n]; }
            ts[k] = __uint_as_float(__float_as_uint(m) & ~0xFFu); te[k] = pair_max_i(e);
        }
        float den = 0.f; const float mx = ts[0];
#pragma unroll
        for (int k = 0; k < 16; ++k) { ts[k] = __expf(ts[k] - mx); den += ts[k]; }
        const float inv = 1.0f / den;
        if (hi == 0) { int4* op = (int4*)(eidx + (size_t)tok * 128 + h * 16);
            op[0] = make_int4(te[0], te[1], te[2], te[3]); op[1] = make_int4(te[4], te[5], te[6], te[7]); op[2] = make_int4(te[8], te[9], te[10], te[11]); op[3] = make_int4(te[12], te[13], te[14], te[15]); }
        else { float4* op = (float4*)(gate + (size_t)tok * 128 + h * 16);
            op[0] = make_float4(ts[0] * inv, ts[1] * inv, ts[2] * inv, ts[3] * inv); op[1] = make_float4(ts[4] * inv, ts[5] * inv, ts[6] * inv, ts[7] * inv);
            op[2] = make_float4(ts[8] * inv, ts[9] * inv, ts[10] * inv, ts[11] * inv); op[3] = make_float4(ts[12] * inv, ts[13] * inv, ts[14] * inv, ts[15] * inv); }
    }
}
#ifndef PH_MASK
#define PH_MASK 0xffffffffu
#endif
constexpr int N_PHASES = 20;
__global__ void __launch_bounds__(512, 2) mega(MK a) {
    extern __shared__ __attribute__((aligned(16))) unsigned char lds_raw[];
    LDSA unsigned char* lds = (LDSA unsigned char*)lds_raw;
    const int lo = a.ph_lo, hi = a.ph_hi;
    const int G = gridDim.x, bid = blockIdx.x;
    const int wid_s = __builtin_amdgcn_readfirstlane(threadIdx.x >> 6);
    unsigned char* ws = a.ws;
#define PH_TID() int tid; { int _z = 0; asm volatile("" : "+s"(_z)); tid = wid_s * 64 + (int)__builtin_amdgcn_mbcnt_hi(~0u, __builtin_amdgcn_mbcnt_lo(~0u, (unsigned)_z)); }
#define WSP(T, name, off) T* name; { unsigned char* _b = ws; asm volatile("" : "+s"(_b)); name = (T*)(_b + (off)); }
#define IN(k) ((((PH_MASK) >> (k)) & 1u) && lo <= (k) && (k) < hi)
#define SEAM(k) do { if ((k) + 1 < hi) { PH_TID() xcd_barrier(bar, tid); } } while (0)
    XcdBarrier bar;
    { PH_TID()
      volatile LAS unsigned* st = (volatile LAS unsigned*)(lds + LDS_MISC);
      if (tid == 0) { st[0] = 0u; st[1] = 0u; }
      __syncthreads();
      bar = xcd_barrier_post((unsigned*)(ws + WS_CTL), st, tid); }

    if (IN(0)) {
#ifdef PROBE_PRO2
      for (int rep = 0; rep < 2; ++rep) {
#else
      {
#endif
        PH_TID()
        WSP(bf16_t, xb, WS_XB) WSP(bf16_t, wab, WS_WAB) WSP(bf16_t, woab, WS_WOAB) WSP(bf16_t, wcd, WS_WCD) WSP(bf16_t, wocd, WS_WOCD) WSP(bf16_t, wq, WS_WQ) WSP(unsigned char, ub, WS_UB) WSP(unsigned char, vb, WS_VB) WSP(float, isu, WS_SU) WSP(float, isv, WS_SV)
        cvt_rows_bf16(a.in[0], xb, (size_t)SEQ * DM / 8, bid, G, tid, 512);
        LDSA float* tile = (LDSA float*)lds;
        transpose_cvt(a.in[1], wab, 4096, 12288, tile, bid, G, PermAB(), tid);
        transpose_cvt(a.in[3], woab, 3072, 4096, tile, bid, G, PermNone(), tid);
        transpose_cvt(a.in[4], wcd, 4096, 9216, tile, bid, G, PermCD(), tid);
        transpose_cvt(a.in[12], wocd, 4096, 4096, tile, bid, G, PermNone(), tid);
        transpose_cvt(a.in[15], wq, 4096, 2048, tile, bid, G, PermNone(), tid);
        transpose_cvt(a.in[15] + (size_t)4096 * 2048, wq + (size_t)2048 * 4096, 4096, 2048, tile, bid, G, PermNone(), tid);
        table_fp6(a.in[17], ub, isu, 2 * 16384, (LDSA float*)lds, bid, G, tid);
        table_fp6(a.in[18], vb, isv, 2 * 16384, (LDSA float*)lds, bid, G, tid);
        { WSP(float, cs0, WS_CS0) WSP(float, csa, WS_CSA) rope_tables(cs0, csa, bid, G, tid); }
        { WSP(bf16_t, keyb, WS_KEYB) cvt_rows_bf16(a.in[16], keyb, (size_t)2 * 8 * 2 * 128 * 128 / 8, bid, G, tid, 512); }
      }
        SEAM(0);
    }
    { constexpr int layer = 0;
        const int pb = 1 + 10 * layer;
        if (IN(pb + 0)) {
            PH_TID() WSP(bf16_t, xb, WS_XB) WSP(bf16_t, x2b, WS_X2B) WSP(bf16_t, wab, WS_WAB) WSP(bf16_t, wcd, WS_WCD) WSP(bf16_t, hb, WS_HB) WSP(float, cs0, WS_CS0) WSP(float, csa, WS_CSA)
            if (layer == 0) {
                pg8::Gemm g{xb, wab, SEQ, 12288, 4096}; pg8::StaticOrder S; S.init(SEQ, 12288, G, bid);
                pg8::EpiProj<0> E{hb, 12288, cs0, csa, nullptr, nullptr, (LDSA float*)(lds + LDS_MISC + 64)};
                pg8::gemm_phase<pg8::EpiProj<0>, pg8::StaticOrder>(lds, g, S, E, nullptr, tid);
#ifdef PROBE_GEMM2
                pg8::gemm_phase<pg8::EpiProj<0>, pg8::StaticOrder>(lds, g, S, E, nullptr, tid);
#endif
            } else {
                pg8::Gemm g{x2b, wcd, SEQ, 9216, 4096}; pg8::StaticOrder S; S.init(SEQ, 9216, G, bid);
                pg8::EpiProj<1> E{hb, 9216, cs0, csa, a.in[10], a.in[11], (LDSA float*)(lds + LDS_MISC + 64)};
                pg8::gemm_phase<pg8::EpiProj<1>, pg8::StaticOrder>(lds, g, S, E, nullptr, tid);
            }
            SEAM(pb + 0);
        }
        if (IN(pb + 2)) {
            PH_TID() WSP(bf16_t, hb, WS_HB) WSP(bf16_t, abb, WS_AB) WSP(float, oc, WS_OC)
            if (layer == 0) attn0_phase(hb, a.in[2], abb, (bf16_t*)oc, (float*)((unsigned char*)oc + (size_t)3 * 8 * SEQ * 128 * 2), (char*)lds_raw, bid, G, tid);
#ifdef PROBE_SMALL
            if (layer == 0) { __syncthreads(); int t3 = tid; asm volatile("" : "+v"(t3)); attn0_phase(hb, a.in[2], abb, (bf16_t*)oc, (float*)((unsigned char*)oc + (size_t)3 * 8 * SEQ * 128 * 2), (char*)lds_raw, bid, G, t3); }
#endif
            else attn1_phase(hb, abb, oc, a.in[5], a.in[6], a.in[7], a.in[8], a.in[9], (char*)lds_raw, bid, G, tid);
#ifdef PROBE_ATTN2
            if (layer == 1) { __syncthreads(); int t3 = tid; asm volatile("" : "+v"(t3)); attn1_phase(hb, abb, oc, a.in[5], a.in[6], a.in[7], a.in[8], a.in[9], (char*)lds_raw, bid, G, t3); }
#endif
            SEAM(pb + 2);
        }
        if (layer == 0) {
            if (IN(pb + 3)) {
                PH_TID() WSP(bf16_t, abb, WS_AB) WSP(float, oc, WS_OC)
                merge0_phase((const bf16_t*)oc, (const float*)((unsigned char*)oc + (size_t)3 * 8 * SEQ * 128 * 2), abb, bid, G, tid);
#ifdef PROBE_SMALL
                merge0_phase((const bf16_t*)oc, (const float*)((unsigned char*)oc + (size_t)3 * 8 * SEQ * 128 * 2), abb, bid, G, tid);
#endif
                SEAM(pb + 3);
            }
        } else {
        }
        if (IN(pb + 4)) {
            const int K = layer == 0 ? 3072 : 4096;
            PH_TID() WSP(bf16_t, abb, WS_AB) WSP(bf16_t, woab, WS_WOAB) WSP(bf16_t, wocd, WS_WOCD) WSP(float, ybuf, WS_Y) WSP(float, x2, WS_X2)
            pg8::Gemm g{abb, layer == 0 ? woab : wocd, SEQ, 4096, K}; pg8::StaticOrder S; S.init(SEQ, 4096, G, bid);
            pg8::EpiF32R E{ybuf, 4096, layer == 0 ? a.in[0] : (const float*)x2, ALPHA};
            pg8::gemm_phase<pg8::EpiF32R, pg8::StaticOrder>(lds, g, S, E, nullptr, tid);
            SEAM(pb + 4);
        }
        if (IN(pb + 5)) {
            PH_TID() WSP(float, ybuf, WS_Y) WSP(float, x1, WS_X1) WSP(bf16_t, x1b, WS_X1B)
            ln_phase(ybuf, a.in[13] + layer * DM, a.in[14] + layer * DM, x1, x1b, bid, G, tid);
#ifdef PROBE_SMALL
            ln_phase(ybuf, a.in[13] + layer * DM, a.in[14] + layer * DM, x1, x1b, bid, G, tid);
#endif
            SEAM(pb + 5);
        }
        if (IN(pb + 6)) {
            PH_TID() WSP(bf16_t, x1b, WS_X1B) WSP(bf16_t, wq, WS_WQ) WSP(bf16_t, pqb, WS_PQ)
            pg8::Gemm g{x1b, wq + (size_t)layer * 2048 * 4096, SEQ, 2048, 4096}; pg8::StaticOrder S; S.init(SEQ, 2048, G, bid);
            pg8::EpiBf16P E{pqb, 2048};
            pg8::gemm_phase<pg8::EpiBf16P, pg8::StaticOrder>(lds, g, S, E, nullptr, tid);
            SEAM(pb + 6);
        }
        if (IN(pb + 7)) {
            PH_TID() WSP(bf16_t, pqb, WS_PQ) WSP(bf16_t, keyb, WS_KEYB) WSP(int, eidx, WS_EIDX) WSP(float, gate, WS_GATE)
            route_mfma_phase(pqb, keyb + (size_t)layer * 8 * 2 * 128 * 128, eidx, gate, (char*)lds_raw, bid, G, tid);
#ifdef PROBE_SMALL
            { __syncthreads(); int t3 = tid; asm volatile("" : "+v"(t3)); route_mfma_phase(pqb, keyb + (size_t)layer * 8 * 2 * 128 * 128, eidx, gate, (char*)lds_raw, bid, G, t3); }
#endif
            SEAM(pb + 7);
        }
        if (IN(pb + 8)) {
            PH_TID() WSP(float, x1, WS_X1) WSP(bf16_t, x1b, WS_X1B) WSP(int, eidx, WS_EIDX) WSP(float, gate, WS_GATE) WSP(unsigned char, ub, WS_UB) WSP(unsigned char, vb, WS_VB) WSP(float, isu, WS_SU) WSP(float, isv, WS_SV) WSP(float, x2, WS_X2) WSP(bf16_t, x2b, WS_X2B)
            peer_expert_phase(x1, x1b, eidx, gate, ub + (size_t)layer * 16384 * ROWB, vb + (size_t)layer * 16384 * ROWB, isu + layer * 16384, isv + layer * 16384, a.in[19] + layer * DM, a.in[20] + layer * DM,
                              layer == 0 ? x2 : a.out, layer == 0 ? x2b : (bf16_t*)nullptr, (LDSA float*)lds, bid, G, tid);
            SEAM(pb + 8);
        }
        }
    { constexpr int layer = 1;
        const int pb = 1 + 10 * layer;
        if (IN(pb + 0)) {
            PH_TID() WSP(bf16_t, xb, WS_XB) WSP(bf16_t, x2b, WS_X2B) WSP(bf16_t, wab, WS_WAB) WSP(bf16_t, wcd, WS_WCD) WSP(bf16_t, hb, WS_HB) WSP(float, cs0, WS_CS0) WSP(float, csa, WS_CSA)
            if (layer == 0) {
                pg8::Gemm g{xb, wab, SEQ, 12288, 4096}; pg8::StaticOrder S; S.init(SEQ, 12288, G, bid);
                pg8::EpiProj<0> E{hb, 12288, cs0, csa, nullptr, nullptr, (LDSA float*)(lds + LDS_MISC + 64)};
                pg8::gemm_phase<pg8::EpiProj<0>, pg8::StaticOrder>(lds, g, S, E, nullptr, tid);
#ifdef PROBE_GEMM2
                pg8::gemm_phase<pg8::EpiProj<0>, pg8::StaticOrder>(lds, g, S, E, nullptr, tid);
#endif
            } else {
                pg8::Gemm g{x2b, wcd, SEQ, 9216, 4096}; pg8::StaticOrder S; S.init(SEQ, 9216, G, bid);
                pg8::EpiProj<1> E{hb, 9216, cs0, csa, a.in[10], a.in[11], (LDSA float*)(lds + LDS_MISC + 64)};
                pg8::gemm_phase<pg8::EpiProj<1>, pg8::StaticOrder>(lds, g, S, E, nullptr, tid);
            }
            SEAM(pb + 0);
        }
        if (IN(pb + 2)) {
            PH_TID() WSP(bf16_t, hb, WS_HB) WSP(bf16_t, abb, WS_AB) WSP(float, oc, WS_OC)
            if (layer == 0) attn0_phase(hb, a.in[2], abb, (bf16_t*)oc, (float*)((unsigned char*)oc + (size_t)3 * 8 * SEQ * 128 * 2), (char*)lds_raw, bid, G, tid);
#ifdef PROBE_SMALL
            if (layer == 0) { __syncthreads(); int t3 = tid; asm volatile("" : "+v"(t3)); attn0_phase(hb, a.in[2], abb, (bf16_t*)oc, (float*)((unsigned char*)oc + (size_t)3 * 8 * SEQ * 128 * 2), (char*)lds_raw, bid, G, t3); }
#endif
            else attn1_phase(hb, abb, oc, a.in[5], a.in[6], a.in[7], a.in[8], a.in[9], (char*)lds_raw, bid, G, tid);
#ifdef PROBE_ATTN2
            if (layer == 1) { __syncthreads(); int t3 = tid; asm volatile("" : "+v"(t3)); attn1_phase(hb, abb, oc, a.in[5], a.in[6], a.in[7], a.in[8], a.in[9], (char*)lds_raw, bid, G, t3); }
#endif
            SEAM(pb + 2);
        }
        if (layer == 0) {
            if (IN(pb + 3)) {
                PH_TID() WSP(bf16_t, abb, WS_AB) WSP(float, oc, WS_OC)
                merge0_phase((const bf16_t*)oc, (const float*)((unsigned char*)oc + (size_t)3 * 8 * SEQ * 128 * 2), abb, bid, G, tid);
#ifdef PROBE_SMALL
                merge0_phase((const bf16_t*)oc, (const float*)((unsigned char*)oc + (size_t)3 * 8 * SEQ * 128 * 2), abb, bid, G, tid);
#endif
                SEAM(pb + 3);
            }
        } else {
        }
        if (IN(pb + 4)) {
            const int K = layer == 0 ? 3072 : 4096;
            PH_TID() WSP(bf16_t, abb, WS_AB) WSP(bf16_t, woab, WS_WOAB) WSP(bf16_t, wocd, WS_WOCD) WSP(float, ybuf, WS_Y) WSP(float, x2, WS_X2)
            pg8::Gemm g{abb, layer == 0 ? woab : wocd, SEQ, 4096, K}; pg8::StaticOrder S; S.init(SEQ, 4096, G, bid);
            pg8::EpiF32R E{ybuf, 4096, layer == 0 ? a.in[0] : (const float*)x2, ALPHA};
            pg8::gemm_phase<pg8::EpiF32R, pg8::StaticOrder>(lds, g, S, E, nullptr, tid);
            SEAM(pb + 4);
        }
        if (IN(pb + 5)) {
            PH_TID() WSP(float, ybuf, WS_Y) WSP(float, x1, WS_X1) WSP(bf16_t, x1b, WS_X1B)
            ln_phase(ybuf, a.in[13] + layer * DM, a.in[14] + layer * DM, x1, x1b, bid, G, tid);
#ifdef PROBE_SMALL
            ln_phase(ybuf, a.in[13] + layer * DM, a.in[14] + layer * DM, x1, x1b, bid, G, tid);
#endif
            SEAM(pb + 5);
        }
        if (IN(pb + 6)) {
            PH_TID() WSP(bf16_t, x1b, WS_X1B) WSP(bf16_t, wq, WS_WQ) WSP(bf16_t, pqb, WS_PQ)
            pg8::Gemm g{x1b, wq + (size_t)layer * 2048 * 4096, SEQ, 2048, 4096}; pg8::StaticOrder S; S.init(SEQ, 2048, G, bid);
            pg8::EpiBf16P E{pqb, 2048};
            pg8::gemm_phase<pg8::EpiBf16P, pg8::StaticOrder>(lds, g, S, E, nullptr, tid);
            SEAM(pb + 6);
        }
        if (IN(pb + 7)) {
            PH_TID() WSP(bf16_t, pqb, WS_PQ) WSP(bf16_t, keyb, WS_KEYB) WSP(int, eidx, WS_EIDX) WSP(float, gate, WS_GATE)
            route_mfma_phase(pqb, keyb + (size_t)layer * 8 * 2 * 128 * 128, eidx, gate, (char*)lds_raw, bid, G, tid);
#ifdef PROBE_SMALL
            { __syncthreads(); int t3 = tid; asm volatile("" : "+v"(t3)); route_mfma_phase(pqb, keyb + (size_t)layer * 8 * 2 * 128 * 128, eidx, gate, (char*)lds_raw, bid, G, t3); }
#endif
            SEAM(pb + 7);
        }
        if (IN(pb + 8)) {
            PH_TID() WSP(float, x1, WS_X1) WSP(bf16_t, x1b, WS_X1B) WSP(int, eidx, WS_EIDX) WSP(float, gate, WS_GATE) WSP(unsigned char, ub, WS_UB) WSP(unsigned char, vb, WS_VB) WSP(float, isu, WS_SU) WSP(float, isv, WS_SV) WSP(float, x2, WS_X2) WSP(bf16_t, x2b, WS_X2B)
            peer_expert_phase(x1, x1b, eidx, gate, ub + (size_t)layer * 16384 * ROWB, vb + (size_t)layer * 16384 * ROWB, isu + layer * 16384, isv + layer * 16384, a.in[19] + layer * DM, a.in[20] + layer * DM,
                              layer == 0 ? x2 : a.out, layer == 0 ? x2b : (bf16_t*)nullptr, (LDSA float*)lds, bid, G, tid);
            SEAM(pb + 8);
        }
        }

#ifdef PROBE_FP6
    if (bid == 0 && hi == N_PHASES) {
        PH_TID()
        if (tid == 0) {
            v16f_t s0, s1; float xs[32];
#pragma unroll
            for (int i = 0; i < 32; ++i) { const int e = i >> 3, m = i & 7; const float v = e == 0 ? 0.125f * m : (float)(1 << (e - 1)) * (1.0f + 0.125f * m); xs[i] = v; if (i < 16) s0[i] = v; else s1[i - 16] = v; }
            const v6u_t w = __builtin_amdgcn_cvt_scalef32_2xpk16_fp6_f32(s0, s1, 1.0f);
            const v32f_t y = __builtin_amdgcn_cvt_scalef32_pk32_f32_fp6(w, 1.0f);
            const v16u_t zb = __builtin_bit_cast(v16u_t, __builtin_amdgcn_cvt_scalef32_pk32_bf16_fp6(w, 1.0f));
            const v32f_t y2 = __builtin_amdgcn_cvt_scalef32_pk32_f32_fp6(w, 2.0f);
            const v6u_t w2 = __builtin_amdgcn_cvt_scalef32_2xpk16_fp6_f32(s0, s1, 2.0f);
            const v32f_t y3 = __builtin_amdgcn_cvt_scalef32_pk32_f32_fp6(w2, 1.0f);
            bool id32 = true, id16 = true, il32 = true;
#pragma unroll
            for (int i = 0; i < 32; ++i) { id32 = id32 && (y[i] == xs[i]);
                const unsigned d = zb[i >> 1]; const float b = (i & 1) ? bf_hi(d) : bf_lo(d); id16 = id16 && (b == xs[i]);
                const int src = (i & 1) ? 16 + (i >> 1) : (i >> 1); il32 = il32 && (y[i] == xs[src]); }
            int code = 64;
            if (id32) code += 1; if (id16) code += 2; if (il32) code += 4;
            if (y2[9] == 2.0f * y[9]) code += 8;
            if (y3[20] * 2.0f == y[20]) code += 16;
            if (y[1] == xs[1]) code += 32;
            a.out[0] += (float)code;
        }
    }
#endif
#undef IN
}
#ifndef ONE_LAUNCH
#define ONE_LAUNCH 1
#endif
extern "C" void kernel_launch(void* const* d_in, const int* in_sizes, int n_in, void* d_out, int out_size, void* d_ws, size_t ws_size, hipStream_t stream) {
    static int ready = 0;
    if (!ready) {
        if (ws_size < WS_END) { fprintf(stderr, "kernel_launch: workspace too small: %zu < %zu\n", ws_size, (size_t)WS_END); return; }
        if (hipFuncSetAttribute((const void*)mega, hipFuncAttributeMaxDynamicSharedMemorySize, LDS_BYTES) != hipSuccess) { fprintf(stderr, "kernel_launch: hipFuncSetAttribute failed\n"); return; }
        int per_cu = 0;
        if (hipOccupancyMaxActiveBlocksPerMultiprocessor(&per_cu, (const void*)mega, 512, LDS_BYTES) != hipSuccess || per_cu < 1) fprintf(stderr, "kernel_launch: note: occupancy query reports %d blocks per CU\n", per_cu);
        (void)hipGetLastError();
        ready = 1;
    }
    unsigned char* ws = (unsigned char*)d_ws;
    (void)hipMemsetAsync(ws + WS_CTL, 0, CTL_BYTES, stream);
    MK a{}; for (int i = 0; i < 21; ++i) a.in[i] = (const float*)d_in[i];
    a.out = (float*)d_out; a.ws = ws;
#if ONE_LAUNCH
    a.ph_lo = 0; a.ph_hi = N_PHASES;
    hipLaunchKernelGGL(mega, dim3(256), dim3(512), LDS_BYTES, stream, a);
#else
    for (int k = 0; k < N_PHASES; ++k) { if (k == 10 || k == 2 || k == 12 || k == 14) continue; a.ph_lo = k; a.ph_hi = k + 1; hipLaunchKernelGGL(mega, dim3(256), dim3(512), LDS_BYTES, stream, a); }
#endif
    const hipError_t le = hipPeekAtLastError();
    if (le != hipSuccess) fprintf(stderr, "kernel_launch: launch failed: %s\n", hipGetErrorName(le));
}
```

```cpp
#include <hip/hip_runtime.h>
#include <stdint.h>
#include <cstdio>

#define SEQ 8192
#define DM 4096
#define HD 128
#define ALPHA 1.4142135623730951f
#define LAMBDA_INIT 0.35550906759096934f
#define ATT_SCALE 0.088388347648318440f

__device__ const double REV_P[16] = {0.15915494309189535, 0.0700865215877985, 0.03086376340470123, 0.013591370636193905, 0.005985185712713705, 0.002635675898667414, 0.001160663641240061, 0.0005111175045375439, 0.00022507907903927653, 9.911730936901935e-05, 4.364795279280289e-05, 1.9221100684944863e-05, 8.464330808241401e-06, 3.727408601915352e-06, 1.6414262627950345e-06, 7.228293068832865e-07};
__device__ const double REV_A[32] = {0.15915494309189535, 0.11934937021124886, 0.08949940160889101, 0.06711508300522726, 0.050329212104487035, 0.03774158471741977, 0.0283021958306234, 0.02122365276477766, 0.015915494309189534, 0.011934937021124886, 0.008949940160889102, 0.006711508300522725, 0.005032921210448704, 0.003774158471741977, 0.00283021958306234, 0.0021223652764777662, 0.0015915494309189536, 0.0011934937021124885, 0.0008949940160889102, 0.0006711508300522726, 0.0005032921210448703, 0.00037741584717419774, 0.00028302195830623395, 0.0002122365276477766, 0.00015915494309189535, 0.00011934937021124886, 8.949940160889102e-05, 6.711508300522725e-05, 5.0329212104487035e-05, 3.774158471741978e-05, 2.8302195830623396e-05, 2.122365276477766e-05};

__device__ __forceinline__ void sincos_rev(double rev, float& s, float& c) {
    const double f = rev - floor(rev); const float ff = (float)f;
    s = __builtin_amdgcn_sinf(ff); c = __builtin_amdgcn_cosf(ff);
}
__device__ __forceinline__ float wave_sum(float v) {
#pragma unroll
    for (int o = 32; o >= 1; o >>= 1) v += __shfl_xor(v, o);
    return v;
}
__device__ __forceinline__ float wave_max(float v) {
#pragma unroll
    for (int o = 32; o >= 1; o >>= 1) v = fmaxf(v, __shfl_xor(v, o));
    return v;
}
namespace pg8 {
#define PG8_LAS __attribute__((address_space(3)))
typedef unsigned short bf16_t;
typedef short bf16x8 __attribute__((ext_vector_type(8)));
typedef float f32x4 __attribute__((ext_vector_type(4)));
typedef unsigned u32x4 __attribute__((ext_vector_type(4)));
constexpr int BM = 256, BK = 64, HALF = 128, HTB = HALF * BK * 2  , STAGE_BYTES = 8 * HTB, NXCD = 8, WGM = 8;

__host__ __device__ __forceinline__ int lds_byte(int r, int c) { const int st = (r >> 4) * 2 + (c >> 5), rr = r & 15, cc = c & 31, ob = rr * 64 + cc * 2; return st * 1024 + (ob ^ (((ob >> 9) & 1) << 5)); }
__host__ __device__ __forceinline__ void stage_rc(int b, int& R, int& C) { const int st = b / 1024, sb = b % 1024, swz = sb ^ (((sb >> 9) & 1) << 5); R = (st >> 1) * 16 + swz / 64; C = (st & 1) * 32 + (swz % 64) / 2; }
__host__ __device__ __forceinline__ int perm32(int rho) { const int n = rho >> 4, i = rho & 15; return 8 * (i >> 2) + 4 * n + (i & 3); }

struct Unit { int pm, pn; };
struct Gemm { const bf16_t* A; const bf16_t* Bt; int M, N, K; };

struct StaticOrder {
    int nM, nN, nwg, G, c;
    __host__ __device__ void init(int M, int N, int G_, int c_) { nM = M / BM; nN = N / BM; nwg = nM * nN; G = G_; c = c_; }
    __host__ __device__ bool next(int i, Unit& u) const {
        const long L = (long)i * G + c; if (L >= nwg) return false;
        int wgid = (int)L; { const int q = nwg / NXCD, r = nwg % NXCD, xcd = wgid % NXCD, off = wgid / NXCD; wgid = (xcd < r ? xcd * (q + 1) : r * (q + 1) + (xcd - r) * q) + off; }
        const int nig = WGM * nN, gid = wgid / nig, fm = gid * WGM, gsz = (nM - fm) < WGM ? (nM - fm) : WGM;
        u.pm = fm + ((wgid % nig) % gsz); u.pn = (wgid % nig) / gsz; return true;
    }
    __device__ __forceinline__ void a_ready(const Unit&) const {}
    __device__ __forceinline__ void done(const Unit&) const {}
};
__device__ __forceinline__ unsigned cvt_pk_bf16(float lo, float hi) { unsigned r; asm volatile("v_cvt_pk_bf16_f32 %0, %1, %2" : "=v"(r) : "v"(lo), "v"(hi)); return r; }
typedef float f32x2 __attribute__((ext_vector_type(2)));
template <class Epi, class Sched, bool STAMP = false>
__device__ __forceinline__ void gemm_phase(PG8_LAS unsigned char* lds, const Gemm g, const Sched& S, const Epi& E, unsigned long long* stamps, const int tid_in) {
    const int tid = tid_in, wid = __builtin_amdgcn_readfirstlane(tid >> 6), lane = tid & 63, wr = wid >> 2, wc = wid & 3, fr = lane & 15, fq = lane >> 4;
    const int K = g.K, nt = K / BK;
    int ts_lo = 0, ts_hi = 0, nts = 0; const unsigned long long rt_entry = STAMP ? (unsigned long long)wall_clock64() : 0ull;
#define PG8_STAMP() do { if (STAMP && wid == 0 && nts < 64) { const unsigned long long _c = (unsigned long long)clock64(); \
        ts_lo = (lane == nts) ? (int)(unsigned)_c : ts_lo; ts_hi = (lane == nts) ? (int)(unsigned)(_c >> 32) : ts_hi; ++nts; } } while (0)
    PG8_STAMP();
    unsigned voffA[2], voffB[2];
#pragma unroll
    for (int i = 0; i < 2; ++i) { int R, C; stage_rc(tid * 16 + i * 8192, R, C); const int Rb = Epi::PERM ? ((R & ~31) + perm32(R & 31)) : R;
        voffA[i] = (unsigned)(R * K + C) * 2u; voffB[i] = (unsigned)(Rb * K + C) * 2u; }
    const size_t kstep = (size_t)(BK * 2);
    const size_t hstep = (size_t)HALF * K * 2;
    const size_t tstep = 2 * hstep;
    const unsigned ldsw = (unsigned)wid * 1024u;
    const int aoff = lds_byte(wr * 64 + fr, fq * 8), boff = lds_byte(wc * 32 + fr, fq * 8);
#define PG8_SA(b, h) (((b) * 2 + (h)) * HTB)
#define PG8_SB(b, h) ((4 + (b) * 2 + (h)) * HTB)
#define PG8_STAGE(bufoff, gbase, voff) do { _Pragma("unroll") for (int _i = 0; _i < 2; ++_i) \
        __builtin_amdgcn_global_load_lds((const unsigned*)((const char*)(gbase) + (voff)[_i]), (PG8_LAS unsigned*)(lds + (bufoff) + ldsw + _i * 8192), 16, 0, 0); } while (0)
#define PG8_LDA(dst, b, h) do { _Pragma("unroll") for (int m = 0; m < 4; ++m) _Pragma("unroll") for (int k = 0; k < 2; ++k) dst[m][k] = *(const PG8_LAS bf16x8*)(lds + PG8_SA(b, h) + aoff + m * 2048 + k * 1024); } while (0)
#define PG8_LDB(dst, b, h) do { _Pragma("unroll") for (int n = 0; n < 2; ++n) _Pragma("unroll") for (int k = 0; k < 2; ++k) dst[n][k] = *(const PG8_LAS bf16x8*)(lds + PG8_SB(b, h) + boff + n * 2048 + k * 1024); } while (0)
#define PG8_MMA(ai, bj, At, Bt) do { __builtin_amdgcn_s_setprio(1); _Pragma("unroll") for (int m = 0; m < 4; ++m) _Pragma("unroll") for (int n = 0; n < 2; ++n) _Pragma("unroll") for (int k = 0; k < 2; ++k) \
        acc[ai][bj][m][n] = __builtin_amdgcn_mfma_f32_16x16x32_bf16(Bt[n][k], At[m][k], acc[ai][bj][m][n], 0, 0, 0); __builtin_amdgcn_s_setprio(0); } while (0)
#define PG8_WAIT_V(n) asm volatile("s_waitcnt vmcnt(" #n ")" ::: "memory")
#define PG8_WAIT_L(n) asm volatile("s_waitcnt lgkmcnt(" #n ")" ::: "memory")
#define PG8_BAR __builtin_amdgcn_s_barrier()
#define PG8_SCHED __builtin_amdgcn_sched_barrier(0)
    Unit cur, nxt; int ui = 0;
    if (!S.next(0, cur)) return;
    f32x4 acc[2][2][4][2];
#pragma unroll
    for (int a = 0; a < 2; ++a)
#pragma unroll
        for (int b = 0; b < 2; ++b)
#pragma unroll
            for (int m = 0; m < 4; ++m)
#pragma unroll
                for (int n = 0; n < 2; ++n) acc[a][b][m][n] = (f32x4){0.f, 0.f, 0.f, 0.f};
    bf16x8 At[4][2], B0[2][2], B1[2][2];
    const char* cA = (const char*)g.A + (size_t)cur.pm * tstep; const char* cB = (const char*)g.Bt + (size_t)cur.pn * tstep;
    S.a_ready(cur);
    PG8_STAGE(PG8_SB(0, 0), cB, voffB); PG8_STAGE(PG8_SA(0, 0), cA, voffA); PG8_STAGE(PG8_SB(0, 1), cB + hstep, voffB); PG8_STAGE(PG8_SA(0, 1), cA + hstep, voffA);
    if (wr == 1) PG8_BAR;
    PG8_WAIT_V(4); PG8_BAR;
    PG8_STAGE(PG8_SB(1, 0), cB + kstep, voffB); PG8_STAGE(PG8_SA(1, 0), cA + kstep, voffA); PG8_STAGE(PG8_SB(1, 1), cB + hstep + kstep, voffB);
    PG8_WAIT_V(6); PG8_BAR;
    PG8_STAMP();
    for (;;) {
        const bool has_next = S.next(ui + 1, nxt);
        const char* nA = has_next ? (const char*)g.A + (size_t)nxt.pm * tstep : cA; const char* nB = has_next ? (const char*)g.Bt + (size_t)nxt.pn * tstep : cB;
        for (int t = 0; t < nt; t += 2) {
            const bool last = (t == nt - 2);
            const char* a1 = cA + (size_t)(t + 1) * kstep;
            const char* a2 = last ? nA : cA + (size_t)(t + 2) * kstep; const char* b2 = last ? nB : cB + (size_t)(t + 2) * kstep;
            const char* a3 = a2 + kstep; const char* b3 = b2 + kstep;
            if (last && has_next) S.a_ready(nxt);
            PG8_LDB(B0, 0, 0); PG8_SCHED; PG8_LDA(At, 0, 0); PG8_STAGE(PG8_SA(1, 1), a1 + hstep, voffA);
            PG8_WAIT_L(8); PG8_BAR; PG8_WAIT_L(0); PG8_MMA(0, 0, At, B0); PG8_BAR; PG8_SCHED;
            PG8_LDB(B1, 0, 1); PG8_STAGE(PG8_SB(0, 0), b2, voffB);
            PG8_BAR; PG8_WAIT_L(0); PG8_MMA(0, 1, At, B1); PG8_BAR;
            PG8_LDA(At, 0, 1); PG8_STAGE(PG8_SA(0, 0), a2, voffA);
            PG8_BAR; PG8_WAIT_L(0); PG8_MMA(1, 0, At, B0); PG8_BAR; PG8_SCHED;
            PG8_STAGE(PG8_SB(0, 1), b2 + hstep, voffB);
            PG8_WAIT_V(6); PG8_BAR; PG8_MMA(1, 1, At, B1); PG8_BAR;
            PG8_LDB(B0, 1, 0); PG8_SCHED; PG8_LDA(At, 1, 0); PG8_STAGE(PG8_SA(0, 1), a2 + hstep, voffA);
            PG8_WAIT_L(8); PG8_BAR; PG8_WAIT_L(0); PG8_MMA(0, 0, At, B0); PG8_BAR; PG8_SCHED;
            PG8_LDB(B1, 1, 1); PG8_STAGE(PG8_SB(1, 0), b3, voffB);
            PG8_BAR; PG8_WAIT_L(0); PG8_MMA(0, 1, At, B1); PG8_BAR;
            PG8_LDA(At, 1, 1); PG8_STAGE(PG8_SA(1, 0), a3, voffA);
            PG8_BAR; PG8_WAIT_L(0); PG8_MMA(1, 0, At, B0); PG8_BAR; PG8_SCHED;
            PG8_STAGE(PG8_SB(1, 1), b3 + hstep, voffB);
            PG8_WAIT_V(6); PG8_BAR; PG8_MMA(1, 1, At, B1); PG8_BAR;
        }
        PG8_STAMP();
        if constexpr (!Epi::AFTER_DRAIN) { E(acc, cur, wr, wc, fr, fq); S.done(cur); }
        PG8_STAMP();
        if (!has_next) break;
#pragma unroll
        for (int a = 0; a < 2; ++a)
#pragma unroll
            for (int b = 0; b < 2; ++b)
#pragma unroll
                for (int m = 0; m < 4; ++m)
#pragma unroll
                    for (int n = 0; n < 2; ++n) acc[a][b][m][n] = (f32x4){0.f, 0.f, 0.f, 0.f};
        cur = nxt; cA = nA; cB = nB; ++ui;
    }
    PG8_WAIT_V(0);
    if (wr == 0) PG8_BAR;
    PG8_BAR;
    if constexpr (Epi::AFTER_DRAIN) { E.fused(acc, cur, wr, wc, fr, fq, lds, wid, lane); S.done(cur); }
    PG8_STAMP();
    if (STAMP && wid == 0) { stamps[lane] = lane < nts ? (((unsigned long long)(unsigned)ts_hi << 32) | (unsigned)ts_lo) : 0ull;
        if (lane == 62) stamps[62] = rt_entry; if (lane == 63) stamps[63] = (unsigned long long)wall_clock64(); }
#undef PG8_STAMP
#undef PG8_SA
#undef PG8_SB
#undef PG8_STAGE
#undef PG8_LDA
#undef PG8_LDB
#undef PG8_MMA
#undef PG8_WAIT_V
#undef PG8_WAIT_L
#undef PG8_BAR
#undef PG8_SCHED
}
}
#define XB_TMO      128
#define XB_XCNT(j)  (256  + 64 * (j))
#define XB_XSUB(j)  (1280 + 64 * (j))
#define XB_XGEN(j)  (2304 + 64 * (j))
#define XB_TOP      3328
#define XB_TOPGEN   3392
#define XCD_BAR_WORDS 3456
#define XB_SPIN_CAP (1u << 22)
#define LAS __attribute__((address_space(3)))

__device__ __forceinline__ unsigned xb_ld(unsigned* p)              { return __hip_atomic_load(p, __ATOMIC_RELAXED, __HIP_MEMORY_SCOPE_AGENT); }
__device__ __forceinline__ unsigned xb_add(unsigned* p, unsigned v) { return __hip_atomic_fetch_add(p, v, __ATOMIC_RELAXED, __HIP_MEMORY_SCOPE_AGENT); }
__device__ __forceinline__ unsigned xb_xcc_id() { return (unsigned)__builtin_amdgcn_s_getreg((3 << 11) | 20) & 0xFu; }
#define XB_SPIN(cond, bar) do { unsigned _sp = 0; while (cond) { __builtin_amdgcn_s_sleep(1); \
    if ((++_sp & 255u) == 0u) { if (xb_ld(&(bar)[XB_TMO])) break; if (_sp > XB_SPIN_CAP) { atomicAdd(&(bar)[XB_TMO], 1u); break; } } } } while (0)

struct XcdBarrier {
    unsigned* bar; unsigned x;
    volatile LAS unsigned* st;
};

__device__ __forceinline__ XcdBarrier xcd_barrier_post(unsigned* bar, volatile LAS unsigned* st, const int tid) {
    XcdBarrier b; b.bar = bar; b.x = xb_xcc_id(); b.st = st;
    if (tid == 0) (void)xb_add(&bar[XB_XCNT(b.x)], 1u);
    return b;
}
__device__ __forceinline__ void xcd_barrier_complete(unsigned* bar, unsigned x, unsigned& nloc, unsigned& nx) {
    const unsigned G = gridDim.x * gridDim.y * gridDim.z;
    unsigned sum, cnt, mine, sp = 0u;
    for (;;) {
        sum = 0u; cnt = 0u; mine = 0u;
#pragma unroll
        for (unsigned j = 0; j < 16; ++j) { const unsigned c = xb_ld(&bar[XB_XCNT(j)]); sum += c; cnt += (c > 0u) ? 1u : 0u; mine = (j == x) ? c : mine; }
        if (sum == G) break;
        __builtin_amdgcn_s_sleep(1);
        if ((++sp & 255u) == 0u) { if (xb_ld(&bar[XB_TMO])) break; if (sp > XB_SPIN_CAP) { atomicAdd(&bar[XB_TMO], 1u); break; } }
    }
    nloc = mine > 0u ? mine : 1u; nx = cnt > 0u ? cnt : 1u;
}

__device__ __forceinline__ void xcd_barrier(const XcdBarrier& b, const int tid) {
    asm volatile("s_waitcnt vmcnt(0)" ::: "memory");
    __syncthreads();
    if (tid == 0) {
        unsigned* bar = b.bar;
        __builtin_amdgcn_s_waitcnt(0);
        unsigned nloc = b.st[0], nx = b.st[1];
        if (nloc == 0u) { xcd_barrier_complete(bar, b.x, nloc, nx); b.st[0] = nloc; b.st[1] = nx; }
        const unsigned old = xb_add(&bar[XB_XSUB(b.x)], 1u);
        const unsigned gen = old / nloc;
        if (old + 1u == (gen + 1u) * nloc) {
            __builtin_amdgcn_fence(__ATOMIC_RELEASE, "agent");
            asm volatile("s_waitcnt vmcnt(0)" ::: "memory");
            const unsigned og = xb_add(&bar[XB_TOP], 1u);
            const unsigned tg = og / nx;
            if (og + 1u == (tg + 1u) * nx) xb_add(&bar[XB_TOPGEN], 1u);
            else XB_SPIN(xb_ld(&bar[XB_TOPGEN]) == tg, bar);
            __builtin_amdgcn_fence(__ATOMIC_ACQUIRE, "agent");
            xb_add(&bar[XB_XGEN(b.x)], 1u);
            asm volatile("s_waitcnt vmcnt(0)" ::: "memory");
        } else {
            XB_SPIN(xb_ld(&bar[XB_XGEN(b.x)]) == gen, bar);
            __builtin_amdgcn_fence(__ATOMIC_ACQUIRE, "agent");
            asm volatile("s_waitcnt vmcnt(0)" ::: "memory");
        }
    }
    __syncthreads();
}
namespace att {
using bf16 = unsigned short;
constexpr int   D = 128, NW = 8, QBLK = 32, KVBLK = 64;
constexpr float SCALE = 0.088388347648318440f;
constexpr float THR = 8.f;
constexpr int SDEPTH = 1;
constexpr size_t SHM_V = KVBLK * D * 2, SHM_K = KVBLK * D * 2, SHM_ATTN = 2 * SHM_V + 2 * SHM_K + NW * 64 * 4;
using bf16x8 = __attribute__((ext_vector_type(8))) short;
using s16x4  = __attribute__((ext_vector_type(4))) short;
using f32x16 = __attribute__((ext_vector_type(16))) float;
using f32x8  = __attribute__((ext_vector_type(8))) float;
using u32x4  = __attribute__((ext_vector_type(4))) unsigned;
#define KSWZ(row, colB) ((row) * 256 + ((colB) ^ (((row) & 7) << 4)))
#define SBAR() __builtin_amdgcn_sched_barrier(0)
__device__ __forceinline__ int crow(int r, int hi) { return (r & 3) + 8 * (r >> 2) + 4 * hi; }
__device__ __forceinline__ unsigned cvtpk(float lo, float hi) {
  unsigned r; asm volatile("v_cvt_pk_bf16_f32 %0, %1, %2" : "=v"(r) : "v"(lo), "v"(hi)); return r;
}
template <typename TIn> struct Stage;
template <> struct Stage<bf16>  { using T = bf16x8;
  __device__ static __forceinline__ T ld8(const bf16* p) { return *reinterpret_cast<const bf16x8*>(p); }
  __device__ static __forceinline__ bf16x8 tobf(T x) { return x; } };
template <> struct Stage<float> { using T = f32x8;
  __device__ static __forceinline__ T ld8(const float* p) { return *reinterpret_cast<const f32x8*>(p); }
  __device__ static __forceinline__ bf16x8 tobf(T x) {
    u32x4 w = {cvtpk(x[0], x[1]), cvtpk(x[2], x[3]), cvtpk(x[4], x[5]), cvtpk(x[6], x[7])}; return *reinterpret_cast<bf16x8*>(&w); } };

__device__ __forceinline__ void partialSM(f32x16& p0, f32x16& p1, float& m_reg, float& mn, float& alpha) {
  constexpr float C = SCALE * 1.4426950408889634f;
  float pmax = p0[0]; for (int r = 1; r < 16; ++r) pmax = fmaxf(pmax, p0[r]); for (int r = 0; r < 16; ++r) pmax = fmaxf(pmax, p1[r]);
  { auto rr = __builtin_amdgcn_permlane32_swap(__float_as_uint(pmax), __float_as_uint(pmax), false, false);
    pmax = fmaxf(__uint_as_float(rr[0]), __uint_as_float(rr[1])); }
  if (__builtin_expect(__all(pmax - m_reg <= THR / SCALE), 1)) { mn = m_reg; alpha = 1.f; }
  else { mn = fmaxf(m_reg, pmax); alpha = __builtin_amdgcn_exp2f((m_reg - mn) * C); m_reg = mn; }
  float mnC = -mn * C;
  for (int r = 0; r < 16; ++r) p0[r] = fmaf(p0[r], C, mnC); for (int r = 0; r < 16; ++r) p1[r] = fmaf(p1[r], C, mnC);
  for (int r = 0; r < 16; ++r) p0[r] = __builtin_amdgcn_exp2f(p0[r]);
}
__device__ __forceinline__ void finishSM(f32x16& p0, f32x16& p1, float alpha, float& l_reg, bf16x8& pa0, bf16x8& pa1, bf16x8& pa2, bf16x8& pa3) {
  for (int r = 0; r < 16; ++r) p1[r] = __builtin_amdgcn_exp2f(p1[r]);
  float ps = 0; for (int r = 0; r < 16; ++r) ps += p0[r]; for (int r = 0; r < 16; ++r) ps += p1[r];
  { auto rr = __builtin_amdgcn_permlane32_swap(__float_as_uint(ps), __float_as_uint(ps), false, false);
    ps = __uint_as_float(rr[0]) + __uint_as_float(rr[1]); }
  l_reg = l_reg * alpha + ps;
#define PK4(P, BASE, OUT) do { unsigned a0 = cvtpk(P[BASE + 0], P[BASE + 1]), a1 = cvtpk(P[BASE + 2], P[BASE + 3]);   \
    unsigned b0 = cvtpk(P[BASE + 4], P[BASE + 5]), b1 = cvtpk(P[BASE + 6], P[BASE + 7]);                              \
    auto r0 = __builtin_amdgcn_permlane32_swap(a0, b0, false, false); auto r1 = __builtin_amdgcn_permlane32_swap(a1, b1, false, false); \
    u32x4 w = {r0[0], r1[0], r0[1], r1[1]}; OUT = *reinterpret_cast<bf16x8*>(&w); } while (0)
  PK4(p0, 0, pa0); PK4(p0, 8, pa1); PK4(p1, 0, pa2); PK4(p1, 8, pa3);
#undef PK4
}
__device__ __forceinline__ void qkt(f32x16& p0, f32x16& p1, const bf16* Ks, const bf16x8* qr, int r32, int hi) {
  p0 = f32x16{}; p1 = f32x16{};
  for (int d0 = 0; d0 < 8; ++d0) { int cb = (d0 * 16 + hi * 8) * 2;
    bf16x8 b0 = *reinterpret_cast<const bf16x8*>((const char*)Ks + KSWZ(r32, cb));
    bf16x8 b1 = *reinterpret_cast<const bf16x8*>((const char*)Ks + KSWZ(32 + r32, cb));
    p0 = __builtin_amdgcn_mfma_f32_32x32x16_bf16(b0, qr[d0], p0, 0, 0, 0);
    p1 = __builtin_amdgcn_mfma_f32_32x32x16_bf16(b1, qr[d0], p1, 0, 0, 0); }
}
__device__ __forceinline__ int v_st(int k, int c) { const int kk = (k & ~0xC) | ((k & 4) << 1) | ((k & 8) >> 1); return ((kk >> 3) * 4 + (c >> 5)) * 512 + ((kk & 7) * 32 + (c & 31)) * 2; }
__device__ __forceinline__ int v_rd_base(int lane) { return ((lane & 3) << 3) | (((lane >> 2) & 3) << 6) | (((lane >> 4) & 1) << 5) | (((lane >> 5) & 1) << 8); }
constexpr int v_rd_off(int d0, int ks, int half) { return d0 * 512 + ks * 4096 + half * 2048; }
template <int OFF> __device__ __forceinline__ s16x4 tr_read(int vb) {
  s16x4 r; asm volatile("ds_read_b64_tr_b16 %0, %1 offset:%2" : "=&v"(r) : "v"(vb), "i"(OFF) : "memory"); return r;
}
template <int D0> __device__ __forceinline__ void pv_one(f32x16& od, int vb, bf16x8 pa0, bf16x8 pa1, bf16x8 pa2, bf16x8 pa3) {
  const s16x4 l0 = tr_read<v_rd_off(D0, 0, 0)>(vb), h0 = tr_read<v_rd_off(D0, 0, 1)>(vb), l1 = tr_read<v_rd_off(D0, 1, 0)>(vb), h1 = tr_read<v_rd_off(D0, 1, 1)>(vb);
  const s16x4 l2 = tr_read<v_rd_off(D0, 2, 0)>(vb), h2 = tr_read<v_rd_off(D0, 2, 1)>(vb), l3 = tr_read<v_rd_off(D0, 3, 0)>(vb), h3 = tr_read<v_rd_off(D0, 3, 1)>(vb);
  asm volatile("s_waitcnt lgkmcnt(0)" ::: "memory"); SBAR();
#define PK(L, H) (bf16x8){L[0], L[1], L[2], L[3], H[0], H[1], H[2], H[3]}
  od = __builtin_amdgcn_mfma_f32_32x32x16_bf16(pa0, PK(l0, h0), od, 0, 0, 0);
  od = __builtin_amdgcn_mfma_f32_32x32x16_bf16(pa1, PK(l1, h1), od, 0, 0, 0);
  od = __builtin_amdgcn_mfma_f32_32x32x16_bf16(pa2, PK(l2, h2), od, 0, 0, 0);
  od = __builtin_amdgcn_mfma_f32_32x32x16_bf16(pa3, PK(l3, h3), od, 0, 0, 0);
#undef PK
}
__device__ __forceinline__ void pv_d0(f32x16* o, int vb, bf16x8 pa0, bf16x8 pa1, bf16x8 pa2, bf16x8 pa3) {
  pv_one<0>(o[0], vb, pa0, pa1, pa2, pa3); pv_one<1>(o[1], vb, pa0, pa1, pa2, pa3); pv_one<2>(o[2], vb, pa0, pa1, pa2, pa3); pv_one<3>(o[3], vb, pa0, pa1, pa2, pa3);
}

template <typename TQ, int LDQ, int LDK, int LDO, typename TO>
__device__ __forceinline__ void attn_dense_body(const TQ* __restrict__ Qb, const bf16* __restrict__ Kh, const bf16* __restrict__ Vh,
                                                TO* __restrict__ Ob, int seq, char* lds, const int tid_in) {
  using St = Stage<bf16>; using SQ = Stage<TQ>;
  const int tid = tid_in, wid = tid >> 6, lane = tid & 63, r32 = lane & 31, hi = lane >> 5;
  bf16* V_lds = (bf16*)lds; bf16* K_lds = (bf16*)(lds + 2 * SHM_V);
  float* ws = (float*)(lds + 2 * SHM_V + 2 * SHM_K) + wid * 64; float* li_l = ws; float* al_l = ws + 32;
  float m_reg = -1e30f, l_reg = 0; f32x16 o[4] = {}; bf16x8 qr[8];
  const TQ* Qw = Qb + ((wid * QBLK + r32) * LDQ + hi * 8);
#pragma unroll
  for (int d0 = 0; d0 < 8; ++d0) qr[d0] = SQ::tobf(SQ::ld8(Qw + d0 * 16));
  const int sr = tid >> 4, sc = (tid & 15) * 8, vst0 = v_st(sr, sc), vst1 = v_st(32 + sr, sc);
  const int vb0 = (int)(uintptr_t)V_lds + v_rd_base(lane);
  struct { typename St::T vs0, vs1, ks0, ks1; } sr_[SDEPTH];
#define SLOAD(i, k0) do { sr_[i].vs0 = St::ld8(Vh + (((k0) + sr) * LDK + sc)); sr_[i].vs1 = St::ld8(Vh + (((k0) + 32 + sr) * LDK + sc)); \
    sr_[i].ks0 = St::ld8(Kh + (((k0) + sr) * LDK + sc)); sr_[i].ks1 = St::ld8(Kh + (((k0) + 32 + sr) * LDK + sc)); } while (0)
#define SWRITE(b, i) do { *(bf16x8*)((char*)V_lds + (b) * SHM_V + vst0) = St::tobf(sr_[i].vs0);          \
    *(bf16x8*)((char*)V_lds + (b) * SHM_V + vst1) = St::tobf(sr_[i].vs1); int kc = sc * 2;               \
    *(bf16x8*)((char*)K_lds + (b) * SHM_K + KSWZ(sr, kc)) = St::tobf(sr_[i].ks0);                       \
    *(bf16x8*)((char*)K_lds + (b) * SHM_K + KSWZ(32 + sr, kc)) = St::tobf(sr_[i].ks1); } while (0)
#define SWAIT() do { if constexpr (SDEPTH == 2) asm volatile("s_waitcnt vmcnt(4)" ::: "memory"); else asm volatile("s_waitcnt vmcnt(0)" ::: "memory"); } while (0)
#define RESC(a) do { if (__any((a) < 1.f)) { if (hi == 0) al_l[r32] = (a); asm volatile("s_waitcnt lgkmcnt(0)" ::: "memory"); \
    for (int d = 0; d < 4; ++d) for (int r = 0; r < 16; ++r) o[d][r] *= al_l[crow(r, hi)]; } } while (0)
  f32x16 pA0, pA1, pB0, pB1; float mnA, mnB, alA, alB; bf16x8 pa0, pa1, pa2, pa3; const int NT = seq / KVBLK;
  constexpr int SE = 0, SO = SDEPTH - 1;
  SLOAD(SE, 0); asm volatile("s_waitcnt vmcnt(0)" ::: "memory"); SWRITE(0, SE); __syncthreads();
  qkt(pA0, pA1, K_lds, qr, r32, hi); partialSM(pA0, pA1, m_reg, mnA, alA);
  SLOAD(SO, KVBLK); if constexpr (SDEPTH == 2) { if (2 < NT) SLOAD(SE, 2 * KVBLK); }
  SWAIT(); SWRITE(1, SO); __syncthreads();
  for (int j = 1; j + 1 < NT; j += 2) {
    SBAR(); qkt(pB0, pB1, (bf16*)((char*)K_lds + SHM_K), qr, r32, hi);
    finishSM(pA0, pA1, alA, l_reg, pa0, pa1, pa2, pa3); SBAR();
    SLOAD(SO, (j + SDEPTH) * KVBLK); SBAR();
    pv_d0(o, vb0, pa0, pa1, pa2, pa3); partialSM(pB0, pB1, m_reg, mnB, alB);
    __syncthreads(); SWAIT(); SWRITE(0, SE);
    RESC(alB); __syncthreads();
    SBAR(); qkt(pA0, pA1, K_lds, qr, r32, hi);
    finishSM(pB0, pB1, alB, l_reg, pa0, pa1, pa2, pa3); SBAR();
    if (SDEPTH == 1 || j + 3 < NT) SLOAD(SE, (j + 1 + SDEPTH) * KVBLK); SBAR();
    pv_d0(o, vb0 + (int)SHM_V, pa0, pa1, pa2, pa3); partialSM(pA0, pA1, m_reg, mnA, alA);
    __syncthreads(); SWAIT(); SWRITE(1, SO);
    RESC(alA); __syncthreads();
  }
  SBAR(); qkt(pB0, pB1, (bf16*)((char*)K_lds + SHM_K), qr, r32, hi);
  finishSM(pA0, pA1, alA, l_reg, pa0, pa1, pa2, pa3); SBAR();
  pv_d0(o, vb0, pa0, pa1, pa2, pa3); partialSM(pB0, pB1, m_reg, mnB, alB);
  __syncthreads(); RESC(alB);
  finishSM(pB0, pB1, alB, l_reg, pa0, pa1, pa2, pa3); SBAR();
  pv_d0(o, vb0 + (int)SHM_V, pa0, pa1, pa2, pa3);
  if (hi == 0) li_l[r32] = l_reg; asm volatile("s_waitcnt lgkmcnt(0)" ::: "memory");
  float rli[16];
#pragma unroll
  for (int r = 0; r < 16; ++r) rli[r] = __builtin_amdgcn_rcpf(li_l[crow(r, hi)]);
  TO* Ow = Ob + (wid * QBLK) * LDO;
#pragma unroll
  for (int r = 0; r < 16; ++r) { int orow = crow(r, hi);
    for (int d0 = 0; d0 < 4; ++d0) { const float val = o[d0][r] * rli[r];
      if constexpr (sizeof(TO) == 4) Ow[orow * LDO + d0 * 32 + r32] = val;
      else Ow[orow * LDO + d0 * 32 + r32] = (TO)(cvtpk(val, val) & 0xffffu); } }
#undef SLOAD
#undef SWRITE
#undef SWAIT
#undef RESC
}

template <int WIN>
__device__ __forceinline__ void attn_banded_body(const bf16* __restrict__ Qp, const bf16* __restrict__ Kp, const bf16* __restrict__ Vp, const long rs, const int Lseq, const int P0,
                                                 const float m_init, const float l_init, bf16* __restrict__ Ob, const long os, float* __restrict__ Lp, const long ls, char* lds, const int tid) {
  const int wid = __builtin_amdgcn_readfirstlane(tid >> 6), lane = tid & 63, r32 = lane & 31, hi = lane >> 5;
  constexpr int BT = 32768;
  float* wsf = (float*)(lds + 2 * BT) + wid * 64; float* li_l = wsf; float* al_l = wsf + 32;
  float m_reg = m_init, l_reg = l_init; f32x16 o[4] = {}; bf16x8 qr[8];
  const bf16* Qw = Qp + (long)(P0 + wid * QBLK + r32) * rs + hi * 8;
#pragma unroll
  for (int d0 = 0; d0 < 8; ++d0) qr[d0] = *reinterpret_cast<const bf16x8*>(Qw + d0 * 16);
  const int irs = (int)rs;
  int ksrc[2], vsrc[2];
#pragma unroll
  for (int i = 0; i < 2; ++i) { const int c = 2 * wid + i, row = 4 * c + (lane >> 4), colB = (16 * (lane & 15)) ^ ((row & 7) << 4); ksrc[i] = row * irs + (colB >> 1);
      const int sub = 2 * c + (lane >> 5), kk = ((sub >> 2) << 3) | ((lane & 31) >> 2), k = (kk & ~0xC) | ((kk & 4) << 1) | ((kk & 8) >> 1), col = (sub & 3) * 32 + 8 * (lane & 3); vsrc[i] = k * irs + col; }
  using LP = __attribute__((address_space(3))) unsigned*;
#define BB_DMA(buf, tb) do { const bf16* _kb = Kp + (long)(tb) * rs; const bf16* _vb = Vp + (long)(tb) * rs; char* _l = lds + (buf) * BT; \
    _Pragma("unroll") for (int _i = 0; _i < 2; ++_i) { __builtin_amdgcn_global_load_lds((const unsigned*)(_kb + ksrc[_i]), (LP)(_l + (2 * wid + _i) * 1024), 16, 0, 0); \
                                                       __builtin_amdgcn_global_load_lds((const unsigned*)(_vb + vsrc[_i]), (LP)(_l + 16384 + (2 * wid + _i) * 1024), 16, 0, 0); } } while (0)
  constexpr int NT = (256 + 2 * WIN) / 64, NTW = (2 * WIN + 32 + 63) / 64;
  const int klo = wid >> 1, qpos = P0 + wid * QBLK + r32;
  int kf = 0; while (P0 - WIN + 64 * kf < 0) ++kf;
  int kl = NT - 1; while (P0 - WIN + 64 * kl >= Lseq) --kl;
  BB_DMA(kf & 1, P0 - WIN + 64 * kf);
  for (int k = kf; k <= kl; ++k) {
    const int tb = P0 - WIN + 64 * k;
    asm volatile("s_waitcnt vmcnt(0)" ::: "memory");
    __builtin_amdgcn_s_barrier();
    asm volatile("" ::: "memory");
    if (k < kl) BB_DMA((k + 1) & 1, tb + 64);
    char* tbuf = lds + (k & 1) * BT;
    if (k >= klo && k < klo + NTW) {
      f32x16 p0, p1; float mn, al; bf16x8 pa0, pa1, pa2, pa3;
      qkt(p0, p1, (const bf16*)tbuf, qr, r32, hi);
      if (k == klo || k == klo + NTW - 1) {
#pragma unroll
        for (int r = 0; r < 16; ++r) { const int d = qpos - (tb + crow(r, hi));
          if (d > WIN || d < -WIN) p0[r] = -1e30f;
          if (d - 32 > WIN || d - 32 < -WIN) p1[r] = -1e30f; }
      }
      partialSM(p0, p1, m_reg, mn, al);
      if (__any(al < 1.f)) { if (hi == 0) al_l[r32] = al; asm volatile("s_waitcnt lgkmcnt(0)" ::: "memory");
#pragma unroll
        for (int d = 0; d < 4; ++d)
#pragma unroll
          for (int r = 0; r < 16; ++r) o[d][r] *= al_l[crow(r, hi)]; }
      finishSM(p0, p1, al, l_reg, pa0, pa1, pa2, pa3); SBAR();
      pv_d0(o, (int)(uintptr_t)(tbuf + 16384) + v_rd_base(lane), pa0, pa1, pa2, pa3);
    }
  }
#undef BB_DMA
  if (hi == 0) li_l[r32] = l_reg; asm volatile("s_waitcnt lgkmcnt(0)" ::: "memory");
  float rli[16];
#pragma unroll
  for (int r = 0; r < 16; ++r) rli[r] = __builtin_amdgcn_rcpf(li_l[crow(r, hi)]);
  bf16* Ow = Ob + (long)(P0 + wid * QBLK) * os;
#pragma unroll
  for (int r = 0; r < 16; ++r) { const int orow = crow(r, hi);
#pragma unroll
    for (int d0 = 0; d0 < 4; ++d0) { const float val = o[d0][r] * rli[r]; Ow[(long)orow * os + d0 * 32 + r32] = (bf16)(cvtpk(val, val) & 0xffffu); } }
  if (Lp != nullptr && hi == 0) Lp[(long)(P0 + wid * QBLK + r32) * ls] = m_reg * SCALE + __logf(l_reg);
}

constexpr int WB_TILE = 49152, WB_WS = 2 * WB_TILE;
template <int LDQ, int LDK, int LDO, int NVH, typename TO, bool COMBINE = false, int LDC = 0>
__device__ __forceinline__ void attn_wide_body(const bf16* __restrict__ Qb, const bf16* __restrict__ Kh, const bf16* __restrict__ Vh, TO* __restrict__ Ob, const int seq, char* lds, const int tid,
                                               const float lam = 0.f, const float gsc = 0.f, const float* __restrict__ gain = nullptr, bf16* __restrict__ Cb = nullptr) {
  const int wid = __builtin_amdgcn_readfirstlane(tid >> 6), lane = tid & 63, r32 = lane & 31, hi = lane >> 5;
  float* wsf = (float*)(lds + WB_WS) + wid * 64; float* li_l = wsf; float* al_l = wsf + 32;
  float m_reg = -1e30f, l_reg = 0; f32x16 o[4 * NVH] = {}; bf16x8 qr[8];
  { const bf16* Qw = Qb + ((wid * QBLK + r32) * LDQ + hi * 8);
#pragma unroll
    for (int d0 = 0; d0 < 8; ++d0) qr[d0] = *reinterpret_cast<const bf16x8*>(Qw + d0 * 16); }
  constexpr int NVP = 2 * NVH;
  int ksrc[2], vsrc[NVP];
#pragma unroll
  for (int i = 0; i < 2; ++i) { const int c = 2 * wid + i, row = 4 * c + (lane >> 4), colB = (16 * (lane & 15)) ^ ((row & 7) << 4); ksrc[i] = row * LDK + (colB >> 1); }
#pragma unroll
  for (int i = 0; i < NVP; ++i) { const int pc = wid * NVP + i, hf = pc >> 4, c = pc & 15, sub = 2 * c + (lane >> 5), kk = ((sub >> 2) << 3) | ((lane & 31) >> 2);
      const int k = (kk & ~0xC) | ((kk & 4) << 1) | ((kk & 8) >> 1), col = (sub & 3) * 32 + 8 * (lane & 3); vsrc[i] = k * LDK + hf * 128 + col; }
  using LP = __attribute__((address_space(3))) unsigned*;
#define WB_DMA(buf, key0) do { const bf16* _kb = Kh + (key0) * LDK; const bf16* _vb = Vh + (key0) * LDK; char* _l = lds + (buf) * WB_TILE; \
    _Pragma("unroll") for (int _i = 0; _i < 2; ++_i) __builtin_amdgcn_global_load_lds((const unsigned*)(_kb + ksrc[_i]), (LP)(_l + (2 * wid + _i) * 1024), 16, 0, 0); \
    _Pragma("unroll") for (int _i = 0; _i < NVP; ++_i) __builtin_amdgcn_global_load_lds((const unsigned*)(_vb + vsrc[_i]), (LP)(_l + 16384 + (wid * NVP + _i) * 1024), 16, 0, 0); } while (0)
  const int NT = seq / KVBLK;
  WB_DMA(0, 0);
  for (int j = 0; j < NT; ++j) {
    asm volatile("s_waitcnt vmcnt(0)" ::: "memory");
    __builtin_amdgcn_s_barrier();
    asm volatile("" ::: "memory");
    if (j + 1 < NT) WB_DMA((j + 1) & 1, (j + 1) * KVBLK);
    char* tb = lds + (j & 1) * WB_TILE;
    f32x16 p0, p1; float mn, al; bf16x8 pa0, pa1, pa2, pa3;
    qkt(p0, p1, (const bf16*)tb, qr, r32, hi);
    partialSM(p0, p1, m_reg, mn, al);
    if (__any(al < 1.f)) { if (hi == 0) al_l[r32] = al; asm volatile("s_waitcnt lgkmcnt(0)" ::: "memory");
#pragma unroll
      for (int d = 0; d < 4 * NVH; ++d)
#pragma unroll
        for (int r = 0; r < 16; ++r) o[d][r] *= al_l[crow(r, hi)]; }
    finishSM(p0, p1, al, l_reg, pa0, pa1, pa2, pa3); SBAR();
    const int vb0 = (int)(uintptr_t)(tb + 16384) + v_rd_base(lane);
    pv_one<0>(o[0], vb0, pa0, pa1, pa2, pa3); pv_one<1>(o[1], vb0, pa0, pa1, pa2, pa3); pv_one<2>(o[2], vb0, pa0, pa1, pa2, pa3); pv_one<3>(o[3], vb0, pa0, pa1, pa2, pa3);
    if constexpr (NVH == 2) {
    pv_one<0>(o[4 * (NVH - 1)], vb0 + 16384, pa0, pa1, pa2, pa3); pv_one<1>(o[4 * (NVH - 1) + 1], vb0 + 16384, pa0, pa1, pa2, pa3); pv_one<2>(o[4 * (NVH - 1) + 2], vb0 + 16384, pa0, pa1, pa2, pa3); pv_one<3>(o[4 * (NVH - 1) + 3], vb0 + 16384, pa0, pa1, pa2, pa3); }
  }
#undef WB_DMA
  int te = tid; asm volatile("" : "+v"(te));
  const int wid_e = __builtin_amdgcn_readfirstlane(te >> 6), r32_e = te & 31, hi_e = (te >> 5) & 1;
  float* li_e = (float*)(lds + WB_WS) + wid_e * 64;
  if (hi_e == 0) li_e[r32_e] = l_reg; asm volatile("s_waitcnt lgkmcnt(0)" ::: "memory");
  float rli[16];
#pragma unroll
  for (int r = 0; r < 16; ++r) rli[r] = __builtin_amdgcn_rcpf(li_e[crow(r, hi_e)]);
  TO* Ow = Ob + (wid_e * QBLK) * LDO;
  if constexpr (!COMBINE) {
#pragma unroll
    for (int r = 0; r < 16; ++r) { const int orow = crow(r, hi_e);
#pragma unroll
      for (int d0 = 0; d0 < 4 * NVH; ++d0) { const float val = o[d0][r] * rli[r];
        if constexpr (sizeof(TO) == 4) Ow[orow * LDO + d0 * 32 + r32_e] = val; else Ow[orow * LDO + d0 * 32 + r32_e] = (TO)(cvtpk(val, val) & 0xffffu); } }
  } else {
    static_assert(sizeof(TO) == 4 && NVH == 2, "combine: f32 first-map tile, 256-wide rows");
    float gn[8];
    { const float* g2 = gain; asm volatile("" : "+s"(g2));
#pragma unroll
      for (int d0 = 0; d0 < 8; ++d0) gn[d0] = g2[d0 * 32 + r32_e] * gsc; }
    bf16* Cw; { bf16* c2 = Cb; asm volatile("" : "+s"(c2)); Cw = c2 + (wid_e * QBLK) * LDC; }
    { TO* o2 = Ob; asm volatile("" : "+s"(o2)); Ow = o2 + (wid_e * QBLK) * LDO; }
#pragma unroll
    for (int r = 0; r < 16; ++r) { const int orow = crow(r, hi_e);
      float ss = 0.f;
#pragma unroll
      for (int d0 = 0; d0 < 8; ++d0) { const float o1 = __hip_atomic_load((const float*)Ow + orow * LDO + d0 * 32 + r32_e, __ATOMIC_RELAXED, __HIP_MEMORY_SCOPE_AGENT);
        const float av = o1 - lam * (o[d0][r] * rli[r]); o[d0][r] = av; ss = fmaf(av, av, ss); }
#define WB_SWZ(v, m) __int_as_float(__builtin_amdgcn_ds_swizzle(__float_as_int(v), ((m) << 10) | 0x1F))
      ss += WB_SWZ(ss, 1); ss += WB_SWZ(ss, 2); ss += WB_SWZ(ss, 4); ss += WB_SWZ(ss, 8); ss += WB_SWZ(ss, 16);
#undef WB_SWZ
      const float sc = 1.0f / sqrtf(ss * (1.0f / 256.0f) + 1e-6f);
#pragma unroll
      for (int d0 = 0; d0 < 8; ++d0) { const float val = o[d0][r] * sc * gn[d0]; Cw[orow * LDC + d0 * 32 + r32_e] = (bf16)(cvtpk(val, val) & 0xffffu); }
      asm volatile("" ::: "memory"); }
  }
}
}
typedef unsigned short bf16_t;
typedef unsigned u32x4v __attribute__((ext_vector_type(4)));
#define LDSA __attribute__((address_space(3)))
constexpr size_t al256(size_t x) { return (x + 255) / 256 * 256; }
constexpr size_t WS_CTL  = 0;
constexpr size_t CTL_BYTES = 65536;
constexpr size_t WS_XB   = WS_CTL + CTL_BYTES;
constexpr size_t WS_WAB  = WS_XB + (size_t)SEQ * DM * 2;
constexpr size_t WS_WOAB = WS_WAB + (size_t)12288 * 4096 * 2;
constexpr size_t WS_WCD  = WS_WOAB + (size_t)4096 * 3072 * 2;
constexpr size_t WS_WOCD = WS_WCD + (size_t)9216 * 4096 * 2;
constexpr size_t WS_WQ   = WS_WOCD + (size_t)4096 * 4096 * 2;
constexpr size_t WS_UB   = WS_WQ + (size_t)2 * 2048 * 4096 * 2;
constexpr size_t WS_VB   = WS_UB + (size_t)2 * 16384 * 3072;
constexpr size_t WS_SU   = WS_VB + (size_t)2 * 16384 * 3072;
constexpr size_t WS_SV   = WS_SU + (size_t)2 * 16384 * 4;
constexpr size_t WS_H    = WS_SV + (size_t)2 * 16384 * 4;
constexpr size_t WS_Y    = WS_H;
constexpr size_t WS_PQ   = WS_H + (size_t)SEQ * 4096 * 4;
constexpr size_t WS_OC   = WS_H + (size_t)SEQ * 12288 * 4;
constexpr size_t WS_AB   = WS_OC + (size_t)2 * SEQ * 2048 * 4;
constexpr size_t WS_X1   = WS_AB + (size_t)SEQ * 4096 * 2;
constexpr size_t WS_X1B  = WS_X1 + (size_t)SEQ * 4096 * 4;
constexpr size_t WS_X2   = WS_X1B + (size_t)SEQ * 4096 * 2;
constexpr size_t WS_X2B  = WS_X2 + (size_t)SEQ * 4096 * 4;
constexpr size_t WS_EIDX = WS_X2B + (size_t)SEQ * 4096 * 2;
constexpr size_t WS_GATE = WS_EIDX + (size_t)SEQ * 128 * 4;
constexpr size_t WS_HB   = WS_GATE + (size_t)SEQ * 128 * 4;
constexpr size_t WS_KEYB = WS_HB + (size_t)SEQ * 12288 * 2;
constexpr size_t WS_CS0  = WS_KEYB + (size_t)2 * 8 * 2 * 128 * 128 * 2;
constexpr size_t WS_CSA  = WS_CS0 + (size_t)SEQ * 16 * 8;
constexpr size_t WS_END  = WS_CSA + (size_t)128 * 32 * 8;
static_assert(WS_END <= (size_t)2147483648ull, "workspace");

constexpr int LDS_BYTES = 155648;
constexpr int LDS_MISC = 139264;

struct MK { const float* in[21]; float* out; unsigned char* ws; int ph_lo, ph_hi; };

namespace pg8 {
struct EpiF32R {
    static constexpr bool PERM = false, AFTER_DRAIN = false;
    float* C; int ldc; const float* R; float ralpha;
    __device__ __forceinline__ void operator()(const f32x4 (&acc)[2][2][4][2], const Unit& u, int wr, int wc, int fr, int fq) const {
        const int row0 = u.pm * BM + wr * 64 + fr, col0 = u.pn * BM + wc * 32 + 4 * fq;
#pragma unroll
        for (int ai = 0; ai < 2; ++ai)
#pragma unroll
            for (int m = 0; m < 4; ++m) { const size_t off = (size_t)(row0 + ai * HALF + m * 16) * ldc + col0;
#pragma unroll
                for (int bj = 0; bj < 2; ++bj)
#pragma unroll
                    for (int n = 0; n < 2; ++n) { f32x4 v = acc[ai][bj][m][n];
                        if (R) { const f32x4 r = *(const f32x4*)(R + off + bj * HALF + n * 16); v += r * ralpha; }
                        *(f32x4*)(C + off + bj * HALF + n * 16) = v; } }
    }
};
struct EpiBf16P {
    static constexpr bool PERM = true, AFTER_DRAIN = false;
    bf16_t* O; int ldc;
    __device__ __forceinline__ void operator()(const f32x4 (&acc)[2][2][4][2], const Unit& u, int wr, int wc, int fr, int fq) const {
        const int row0 = u.pm * BM + wr * 64 + fr, col0 = u.pn * BM + wc * 32 + 8 * fq;
#pragma unroll
        for (int ai = 0; ai < 2; ++ai)
#pragma unroll
            for (int m = 0; m < 4; ++m) { bf16_t* rowp = O + (size_t)(row0 + ai * HALF + m * 16) * ldc + col0;
#pragma unroll
                for (int bj = 0; bj < 2; ++bj) { const f32x4 v0 = acc[ai][bj][m][0], v1 = acc[ai][bj][m][1];
                    u32x4 w; w.x = cvt_pk_bf16(v0[0], v0[1]); w.y = cvt_pk_bf16(v0[2], v0[3]); w.z = cvt_pk_bf16(v1[0], v1[1]); w.w = cvt_pk_bf16(v1[2], v1[3]);
                    *(u32x4*)(rowp + bj * HALF) = w; } }
    }
};

template <int LAYER> struct EpiProj {
    static constexpr bool PERM = true, AFTER_DRAIN = false;
    bf16_t* O; int ldc; const float* cs0; const float* csa; const float* gq; const float* gk; PG8_LAS float* xch;
    __device__ __forceinline__ void operator()(const f32x4 (&acc)[2][2][4][2], const Unit& u, int wr, int wc, int fr, int fq) const {
        const int row0 = u.pm * BM + wr * 64 + fr, col0 = u.pn * BM + wc * 32 + 8 * fq;
        const int pn = u.pn;
        const bool prope = LAYER == 0 ? (pn < 10 || (pn >= 12 && pn < 36)) : (pn < 16);
        const bool dnorm = LAYER == 1 && pn >= 24 && pn < 34;
        float rs[2][4][2];
        float gn[8];
        if (dnorm) {
            const int lrow = fr;
#pragma unroll
            for (int ai = 0; ai < 2; ++ai)
#pragma unroll
                for (int m = 0; m < 4; ++m)
#pragma unroll
                    for (int bj = 0; bj < 2; ++bj) { const f32x4 a = acc[ai][bj][m][0], b = acc[ai][bj][m][1];
                        float q = (a[0] * a[0] + a[1] * a[1]) + (a[2] * a[2] + a[3] * a[3]) + (b[0] * b[0] + b[1] * b[1]) + (b[2] * b[2] + b[3] * b[3]);
                        q += __shfl_xor(q, 16); q += __shfl_xor(q, 32);
                        if (fq == 0) xch[((wr * 128 + (ai * 4 + m) * 16 + lrow) * 2 + bj) * 4 + wc] = q; }
            asm volatile("s_waitcnt lgkmcnt(0)" ::: "memory"); __builtin_amdgcn_s_barrier(); asm volatile("" ::: "memory");
#pragma unroll
            for (int ai = 0; ai < 2; ++ai)
#pragma unroll
                for (int m = 0; m < 4; ++m)
#pragma unroll
                    for (int bj = 0; bj < 2; ++bj) { const f32x4 p = *(const PG8_LAS f32x4*)(xch + ((wr * 128 + (ai * 4 + m) * 16 + lrow) * 2 + bj) * 4);
                        rs[ai][m][bj] = 1.0f / sqrtf(((p[0] + p[1]) + (p[2] + p[3])) * (1.0f / 128.0f) + 1e-6f); }
            const float* g = pn < 32 ? gq : gk;
#pragma unroll
            for (int e = 0; e < 8; ++e) { const int p = wc * 32 + 8 * fq + e; const int orig = (p & 64) + ((p & 63) >> 1) + 32 * (p & 1); gn[e] = g[orig]; }
        }
        const bool rot = dnorm || (prope && wc == 0);
#pragma unroll
        for (int ai = 0; ai < 2; ++ai) {
            f32x4 cs[4][2];
            if (rot) {
#pragma unroll
                for (int m = 0; m < 4; ++m) { const int row = row0 + ai * HALF + m * 16;
                    const float* cp = dnorm ? csa + ((size_t)(wc < 2 ? (row >> 6) : (row & 63)) * 32 + 16 * (wc & 1) + 4 * fq) * 2 : cs0 + ((size_t)row * 16 + 4 * fq) * 2;
                    cs[m][0] = *(const f32x4*)cp; cs[m][1] = *(const f32x4*)(cp + 4); }
            }
#pragma unroll
            for (int m = 0; m < 4; ++m) {
                const int row = row0 + ai * HALF + m * 16;
                bf16_t* rowp = O + (size_t)row * ldc + col0;
                f32x4 c0 = (f32x4){1.f, 0.f, 1.f, 0.f}, c1 = c0;
                if (rot) { c0 = cs[m][0]; c1 = cs[m][1]; }
#pragma unroll
                for (int bj = 0; bj < 2; ++bj) { f32x4 v0 = acc[ai][bj][m][0], v1 = acc[ai][bj][m][1];
                    if (dnorm) { const float r = rs[ai][m][bj];
                        v0[0] *= r * gn[0]; v0[1] *= r * gn[1]; v0[2] *= r * gn[2]; v0[3] *= r * gn[3]; v1[0] *= r * gn[4]; v1[1] *= r * gn[5]; v1[2] *= r * gn[6]; v1[3] *= r * gn[7]; }
                    if (rot) {
                        const float a0 = v0[0] * c0[0] - v0[1] * c0[1], b0 = v0[1] * c0[0] + v0[0] * c0[1];
                        const float a1 = v0[2] * c0[2] - v0[3] * c0[3], b1 = v0[3] * c0[2] + v0[2] * c0[3];
                        const float a2 = v1[0] * c1[0] - v1[1] * c1[1], b2 = v1[1] * c1[0] + v1[0] * c1[1];
                        const float a3 = v1[2] * c1[2] - v1[3] * c1[3], b3 = v1[3] * c1[2] + v1[2] * c1[3];
                        v0 = (f32x4){a0, b0, a1, b1}; v1 = (f32x4){a2, b2, a3, b3}; }
                    u32x4 w; w.x = cvt_pk_bf16(v0[0], v0[1]); w.y = cvt_pk_bf16(v0[2], v0[3]); w.z = cvt_pk_bf16(v1[0], v1[1]); w.w = cvt_pk_bf16(v1[2], v1[3]);
                    *(u32x4*)(rowp + bj * HALF) = w; }
            }
            asm volatile("" ::: "memory");
        }
    }
};
}

__device__ __forceinline__ float bf_lo(unsigned w) { return __uint_as_float(w << 16); }
__device__ __forceinline__ float bf_hi(unsigned w) { return __uint_as_float(w & 0xffff0000u); }
__device__ __forceinline__ unsigned cvtpk_bf16(float lo, float hi) { unsigned r; asm volatile("v_cvt_pk_bf16_f32 %0, %1, %2" : "=v"(r) : "v"(lo), "v"(hi)); return r; }

__device__ __forceinline__ void cvt_rows_bf16(const float* __restrict__ src, bf16_t* __restrict__ dst, size_t n8, int bid, int nb, int tid, int nthr) {
    const size_t stride = (size_t)nb * nthr;
    for (size_t i = (size_t)bid * nthr + tid; i < n8; i += 4 * stride) {
        float4 a[4], b[4];
#pragma unroll
        for (int u = 0; u < 4; ++u) { const size_t j = i + u * stride; if (j < n8) { a[u] = *(const float4*)(src + j * 8); b[u] = *(const float4*)(src + j * 8 + 4); } }
#pragma unroll
        for (int u = 0; u < 4; ++u) { const size_t j = i + u * stride; if (j < n8) {
            u32x4v w; w.x = cvtpk_bf16(a[u].x, a[u].y); w.y = cvtpk_bf16(a[u].z, a[u].w); w.z = cvtpk_bf16(b[u].x, b[u].y); w.w = cvtpk_bf16(b[u].z, b[u].w);
            *(u32x4v*)(dst + j * 8) = w; } }
    }
}
template <class PM>
__device__ __forceinline__ void transpose_cvt(const float* __restrict__ W, bf16_t* __restrict__ Wt, int K, int N, LDSA float* tile0, int bid, int nb, PM pm, const int tid) {
    const int lane = tid & 63, wv = tid >> 6;
    LDSA float* tile = tile0 + wv * 4352;
    const int ntk = K / 64, ntn = N / 64;
    for (int t = bid * 8 + wv; t < ntk * ntn; t += nb * 8) {
        const int k0 = (t % ntk) * 64, n0 = (t / ntk) * 64;
        const int c = (lane & 15) * 4, r0 = lane >> 4;
        float4 v[16];
#pragma unroll
        for (int i = 0; i < 16; ++i) v[i] = *(const float4*)(W + (size_t)(k0 + r0 + 4 * i) * N + n0 + c);
#pragma unroll
        for (int i = 0; i < 16; ++i) { const int r = r0 + 4 * i; tile[r * 65 + c] = v[i].x; tile[r * 65 + c + 1] = v[i].y; tile[r * 65 + c + 2] = v[i].z; tile[r * 65 + c + 3] = v[i].w; }
        asm volatile("s_waitcnt lgkmcnt(0)" ::: "memory");
        const int mode = pm(n0);
#pragma unroll
        for (int h = 0; h < 8; ++h) {
            const int n = (lane >> 3) + 8 * h, kc = (lane & 7) * 8;
            int src = n;
            if (mode == 1) { if (n < 32) src = (n >> 1) + 16 * (n & 1); }
            else if (mode == 2) src = (n >> 1) + 32 * (n & 1);
            float f[8];
#pragma unroll
            for (int j = 0; j < 8; ++j) f[j] = tile[(kc + j) * 65 + src];
            u32x4v w; w.x = cvtpk_bf16(f[0], f[1]); w.y = cvtpk_bf16(f[2], f[3]); w.z = cvtpk_bf16(f[4], f[5]); w.w = cvtpk_bf16(f[6], f[7]);
            *(u32x4v*)(Wt + (size_t)(n0 + n) * K + k0 + kc) = w;
        }
        asm volatile("s_waitcnt lgkmcnt(0)" ::: "memory");
    }
}
struct PermNone { __device__ __forceinline__ int operator()(int) const { return 0; } };
struct PermAB { __device__ __forceinline__ int operator()(int n0) const { const bool rope = n0 < 2560 || (n0 >= 3072 && n0 < 9216); return (rope && (n0 & 127) == 0) ? 1 : 0; } };
struct PermCD { __device__ __forceinline__ int operator()(int n0) const { if (n0 < 4096) return (n0 & 127) == 0 ? 1 : 0; if (n0 >= 6144 && n0 < 8704) return 2; return 0; } };
__device__ __forceinline__ void rope_tables(float* __restrict__ cs0, float* __restrict__ csa, const int bid, const int G, const int tid) {
    for (int i = bid * 512 + tid; i < SEQ * 16; i += G * 512) { float s, c; sincos_rev((double)(i >> 4) * REV_P[i & 15], s, c); *(float2*)(cs0 + (size_t)i * 2) = make_float2(c, s); }
    for (int i = bid * 512 + tid; i < 128 * 32; i += G * 512) { float s, c; sincos_rev((double)(i >> 5) * REV_A[i & 31], s, c); *(float2*)(csa + (size_t)i * 2) = make_float2(c, s); }
}


typedef unsigned v6u_t __attribute__((ext_vector_type(6)));
typedef float f4v_t __attribute__((ext_vector_type(4)));
typedef unsigned v16u_t __attribute__((ext_vector_type(16)));
typedef float v16f_t __attribute__((ext_vector_type(16)));
typedef float v32f_t __attribute__((ext_vector_type(32)));
typedef __bf16 v32b_t __attribute__((ext_vector_type(32)));
constexpr int ROWB = 3072;
constexpr int XT_STRIDE = 68;
constexpr int XT_BYTES = 64 * XT_STRIDE * 4;
__device__ __forceinline__ void table_fp6(const float* __restrict__ src, unsigned char* __restrict__ dst, float* __restrict__ inv, const int rows, LDSA float* xt0, const int bid, const int G, const int tid) {
    const int lane = tid & 63, wv = tid >> 6;
    LDSA float* xt = xt0 + wv * (XT_BYTES / 4);
    for (int r = bid * 8 + wv; r < rows; r += G * 8) {
        float4 v[16]; float am = 0.f;
#pragma unroll
        for (int j = 0; j < 16; ++j) { v[j] = *(const float4*)(src + (size_t)r * DM + j * 256 + lane * 4); am = fmaxf(am, fmaxf(fmaxf(fabsf(v[j].x), fabsf(v[j].y)), fmaxf(fabsf(v[j].z), fabsf(v[j].w)))); }
        am = wave_max(am);
        const float sc = am > 0.f ? 7.0f / am : 1.0f;
#pragma unroll
        for (int j = 0; j < 16; ++j) *(LDSA f4v_t*)(xt + (4 * j + (lane >> 4)) * XT_STRIDE + 4 * (lane & 15)) = (f4v_t){v[j].x * sc, v[j].y * sc, v[j].z * sc, v[j].w * sc};
        asm volatile("s_waitcnt lgkmcnt(0)" ::: "memory");
        v16f_t f0, f1, f2, f3;
#pragma unroll
        for (int k = 0; k < 8; ++k) { const f4v_t a = *(const LDSA f4v_t*)(xt + lane * XT_STRIDE + 4 * k), c = *(const LDSA f4v_t*)(xt + lane * XT_STRIDE + 32 + 4 * k);
            f0[2 * k] = a[0]; f1[2 * k] = a[1]; f0[2 * k + 1] = a[2]; f1[2 * k + 1] = a[3];
            f2[2 * k] = c[0]; f3[2 * k] = c[1]; f2[2 * k + 1] = c[2]; f3[2 * k + 1] = c[3]; }
        asm volatile("s_waitcnt lgkmcnt(0)" ::: "memory");
        const v6u_t w0 = __builtin_amdgcn_cvt_scalef32_2xpk16_fp6_f32(f0, f1, 1.0f), w1 = __builtin_amdgcn_cvt_scalef32_2xpk16_fp6_f32(f2, f3, 1.0f);
        unsigned char* dp = dst + (size_t)r * ROWB + lane * 48;
        u32x4v s0, s1, s2; s0.x = w0[0]; s0.y = w0[1]; s0.z = w0[2]; s0.w = w0[3]; s1.x = w0[4]; s1.y = w0[5]; s1.z = w1[0]; s1.w = w1[1]; s2.x = w1[2]; s2.y = w1[3]; s2.z = w1[4]; s2.w = w1[5];
        *(u32x4v*)dp = s0; *(u32x4v*)(dp + 16) = s1; *(u32x4v*)(dp + 32) = s2;
        if (lane == 0) inv[r] = am > 0.f ? am * (1.0f / 7.0f) : 1.0f;
    }
}

typedef __bf16 bf2_t __attribute__((ext_vector_type(2)));
__device__ __forceinline__ float dot2_bf16(unsigned a, unsigned b, float c) { return __builtin_amdgcn_fdot2_f32_bf16(__builtin_bit_cast(bf2_t, a), __builtin_bit_cast(bf2_t, b), c, false); }
__device__ __forceinline__ float gelu_tanh_f(float x) {
    const float z = 0.7978845608028654f * (x + 0.044715f * x * x * x);
    const float e = __expf(2.0f * z);
    return 0.5f * x * (2.0f - 2.0f / (e + 1.0f));
}
__device__ __forceinline__ int pick_i(int a0, int a1, int k) { return k < 64 ? __builtin_amdgcn_readlane(a0, k) : __builtin_amdgcn_readlane(a1, k - 64); }
__device__ __forceinline__ float pick_f(float a0, float a1, int k) { return __int_as_float(pick_i(__float_as_int(a0), __float_as_int(a1), k)); }
#define PE_LOADROW(dst, base, e) do { const unsigned char* _p = (base) + (size_t)(e) * ROWB + lane * 48; dst[0] = *(const u32x4v*)_p; dst[1] = *(const u32x4v*)(_p + 16); dst[2] = *(const u32x4v*)(_p + 32); } while (0)
__device__ __forceinline__ float pe_dot(const u32x4v (&r)[3], const u32x4v (&x)[8]) {
    float d0 = 0.f, d1 = 0.f, d2 = 0.f, d3 = 0.f;
    { const v6u_t g = {r[0].x, r[0].y, r[0].z, r[0].w, r[1].x, r[1].y};
      const v16u_t z = __builtin_bit_cast(v16u_t, __builtin_amdgcn_cvt_scalef32_pk32_bf16_fp6(g, 1.0f));
#pragma unroll
      for (int k = 0; k < 4; ++k) { const unsigned xa = x[k].x, xb = x[k].y, xc = x[k].z, xd = x[k].w; const unsigned za = z[4 * k], zb = z[4 * k + 1], zc = z[4 * k + 2], zd = z[4 * k + 3];
          d0 = dot2_bf16(za, xa, d0); d1 = dot2_bf16(zb, xb, d1); d2 = dot2_bf16(zc, xc, d2); d3 = dot2_bf16(zd, xd, d3); }
      asm volatile("" : "+v"(d0), "+v"(d1), "+v"(d2), "+v"(d3)); }
    { const v6u_t g = {r[1].z, r[1].w, r[2].x, r[2].y, r[2].z, r[2].w};
      const v16u_t z = __builtin_bit_cast(v16u_t, __builtin_amdgcn_cvt_scalef32_pk32_bf16_fp6(g, 1.0f));
#pragma unroll
      for (int k = 0; k < 4; ++k) { const unsigned xa = x[4 + k].x, xb = x[4 + k].y, xc = x[4 + k].z, xd = x[4 + k].w; const unsigned za = z[4 * k], zb = z[4 * k + 1], zc = z[4 * k + 2], zd = z[4 * k + 3];
          d0 = dot2_bf16(za, xa, d0); d1 = dot2_bf16(zb, xb, d1); d2 = dot2_bf16(zc, xc, d2); d3 = dot2_bf16(zd, xd, d3); } }
    return wave_sum((d0 + d1) + (d2 + d3));
}
#define PE_PIN16(a, b) asm volatile("" : "+v"(a[b + 0]), "+v"(a[b + 1]), "+v"(a[b + 2]), "+v"(a[b + 3]), "+v"(a[b + 4]), "+v"(a[b + 5]), "+v"(a[b + 6]), "+v"(a[b + 7]), \
                                         "+v"(a[b + 8]), "+v"(a[b + 9]), "+v"(a[b + 10]), "+v"(a[b + 11]), "+v"(a[b + 12]), "+v"(a[b + 13]), "+v"(a[b + 14]), "+v"(a[b + 15]))
__device__ __forceinline__ void pe_axpy(float (&acc)[64], const u32x4v (&r)[3], const float w) {
    { const v6u_t g = {r[0].x, r[0].y, r[0].z, r[0].w, r[1].x, r[1].y};
      const v32f_t y = __builtin_amdgcn_cvt_scalef32_pk32_f32_fp6(g, 1.0f);
#pragma unroll
      for (int i = 0; i < 32; ++i) acc[i] = fmaf(w, y[i], acc[i]);
      PE_PIN16(acc, 0); PE_PIN16(acc, 16); }
    { const v6u_t g = {r[1].z, r[1].w, r[2].x, r[2].y, r[2].z, r[2].w};
      const v32f_t y = __builtin_amdgcn_cvt_scalef32_pk32_f32_fp6(g, 1.0f);
#pragma unroll
      for (int i = 0; i < 32; ++i) acc[32 + i] = fmaf(w, y[i], acc[32 + i]);
      PE_PIN16(acc, 32); PE_PIN16(acc, 48); }
}
__device__ __forceinline__ void peer_expert_phase(const float* __restrict__ ypre, const float* __restrict__ stats, const float* __restrict__ gm, const float* __restrict__ bm, const bf16_t* __restrict__ x1b, const int* __restrict__ eidx, const float* __restrict__ gate,
                                                  const unsigned char* __restrict__ ub, const unsigned char* __restrict__ vb, const float* __restrict__ isu, const float* __restrict__ isv,
                                                  const float* __restrict__ lg, const float* __restrict__ lb, float* __restrict__ out, bf16_t* __restrict__ outb, LDSA float* xt0, const int bid, const int G, const int tid) {
    const int wv = __builtin_amdgcn_readfirstlane(tid >> 6);
    LDSA float* xt = xt0 + wv * (XT_BYTES / 4);
    for (int t = bid * 8 + wv; t < SEQ; t += G * 8) {
        int tl = tid; asm volatile("" : "+v"(tl));
        const int lane = tl & 63;
        const int e0 = eidx[(size_t)t * 128 + lane], e1 = eidx[(size_t)t * 128 + 64 + lane];
        const float g0 = gate[(size_t)t * 128 + lane], g1 = gate[(size_t)t * 128 + 64 + lane];
        const float iu0 = isu[e0], iu1 = isu[e1], iv0 = isv[e0], iv1 = isv[e1];
        u32x4v xq[8];
#pragma unroll
        for (int k = 0; k < 8; ++k) xq[k] = *(const u32x4v*)(x1b + (size_t)t * DM + lane * 64 + k * 8);
        float w0 = 0.f, w1 = 0.f;
        u32x4v R0[3], R1[3], R2[3], R3[3], R4[3];
#define PE_E(k) pick_i(e0, e1, (k))
#define PE_USTEP(R, k) do { const float d = pe_dot(R, xq) * pick_f(iu0, iu1, (k)); const float w = pick_f(g0, g1, (k)) * gelu_tanh_f(d) * pick_f(iv0, iv1, (k)); \
            if (lane == ((k) & 63)) { if ((k) < 64) w0 = w; else w1 = w; } } while (0)
        PE_LOADROW(R0, ub, PE_E(0)); PE_LOADROW(R1, ub, PE_E(1)); PE_LOADROW(R2, ub, PE_E(2)); PE_LOADROW(R3, ub, PE_E(3));
        for (int k = 0; k < 125; k += 5) {
            if (k + 4 < 128) PE_LOADROW(R4, ub, PE_E(k + 4)); PE_USTEP(R0, k);
            if (k + 5 < 128) PE_LOADROW(R0, ub, PE_E(k + 5)); PE_USTEP(R1, k + 1);
            if (k + 6 < 128) PE_LOADROW(R1, ub, PE_E(k + 6)); PE_USTEP(R2, k + 2);
            if (k + 7 < 128) PE_LOADROW(R2, ub, PE_E(k + 7)); PE_USTEP(R3, k + 3);
            if (k + 8 < 128) PE_LOADROW(R3, ub, PE_E(k + 8)); PE_USTEP(R4, k + 4);
        }
        PE_USTEP(R0, 125); PE_USTEP(R1, 126); PE_USTEP(R2, 127);
        float acc[64];
#pragma unroll
        for (int i = 0; i < 64; ++i) acc[i] = 0.f;
        PE_LOADROW(R0, vb, PE_E(0)); PE_LOADROW(R1, vb, PE_E(1)); PE_LOADROW(R2, vb, PE_E(2)); PE_LOADROW(R3, vb, PE_E(3));
        for (int k = 0; k < 125; k += 5) {
            if (k + 4 < 128) PE_LOADROW(R4, vb, PE_E(k + 4)); pe_axpy(acc, R0, pick_f(w0, w1, k));
            if (k + 5 < 128) PE_LOADROW(R0, vb, PE_E(k + 5)); pe_axpy(acc, R1, pick_f(w0, w1, k + 1));
            if (k + 6 < 128) PE_LOADROW(R1, vb, PE_E(k + 6)); pe_axpy(acc, R2, pick_f(w0, w1, k + 2));
            if (k + 7 < 128) PE_LOADROW(R2, vb, PE_E(k + 7)); pe_axpy(acc, R3, pick_f(w0, w1, k + 3));
            if (k + 8 < 128) PE_LOADROW(R3, vb, PE_E(k + 8)); pe_axpy(acc, R4, pick_f(w0, w1, k + 4));
        }
        pe_axpy(acc, R0, pick_f(w0, w1, 125)); pe_axpy(acc, R1, pick_f(w0, w1, 126)); pe_axpy(acc, R2, pick_f(w0, w1, 127));
#undef PE_E
#undef PE_USTEP
#pragma unroll
        for (int k = 0; k < 16; ++k) *(LDSA f4v_t*)(xt + lane * XT_STRIDE + 4 * k) = (f4v_t){acc[4 * k], acc[4 * k + 1], acc[4 * k + 2], acc[4 * k + 3]};
        asm volatile("s_waitcnt lgkmcnt(0)" ::: "memory");
        float4 y[16]; float s = 0.f; const float2 st = *(const float2*)(stats + (size_t)t * 2);
#pragma unroll
        for (int j = 0; j < 16; ++j) { const f4v_t f = *(const LDSA f4v_t*)(xt + (4 * j + (lane >> 4)) * XT_STRIDE + 4 * (lane & 15));
            const float4 yv = *(const float4*)(ypre + (size_t)t * DM + j * 256 + lane * 4), gv = *(const float4*)(gm + j * 256 + lane * 4), bv = *(const float4*)(bm + j * 256 + lane * 4);
            float4 xv;
            xv.x = (yv.x - st.x) * st.y * gv.x + bv.x; xv.y = (yv.y - st.x) * st.y * gv.y + bv.y; xv.z = (yv.z - st.x) * st.y * gv.z + bv.z; xv.w = (yv.w - st.x) * st.y * gv.w + bv.w;
            y[j].x = fmaf(ALPHA, xv.x, f.x); y[j].y = fmaf(ALPHA, xv.y, f.y); y[j].z = fmaf(ALPHA, xv.z, f.z); y[j].w = fmaf(ALPHA, xv.w, f.w);
            s += (y[j].x + y[j].y) + (y[j].z + y[j].w);
            if (j & 1) asm volatile("" ::: "memory"); }
        asm volatile("s_waitcnt lgkmcnt(0)" ::: "memory");
        const float mean = wave_sum(s) * (1.0f / DM);
        float qq = 0.f;
#pragma unroll
        for (int j = 0; j < 16; ++j) { const float a = y[j].x - mean, b = y[j].y - mean, c = y[j].z - mean, d = y[j].w - mean; qq += (a * a + b * b) + (c * c + d * d); }
        const float rstd = 1.0f / sqrtf(wave_sum(qq) * (1.0f / DM) + 1e-5f);
#pragma unroll
        for (int j = 0; j < 16; ++j) {
            const int c = j * 256 + lane * 4;
            const float4 ga = *(const float4*)(lg + c), ba = *(const float4*)(lb + c);
            float4 oa; oa.x = (y[j].x - mean) * rstd * ga.x + ba.x; oa.y = (y[j].y - mean) * rstd * ga.y + ba.y; oa.z = (y[j].z - mean) * rstd * ga.z + ba.z; oa.w = (y[j].w - mean) * rstd * ga.w + ba.w;
            *(float4*)(out + (size_t)t * DM + c) = oa;
            if (outb) { uint2 w; w.x = cvtpk_bf16(oa.x, oa.y); w.y = cvtpk_bf16(oa.z, oa.w); *(uint2*)(outb + (size_t)t * DM + c) = w; }
            if ((j & 3) == 3) asm volatile("" ::: "memory");
        }
    }
}

__device__ __forceinline__ void attn1_phase(const bf16_t* __restrict__ hb, bf16_t* __restrict__ abb, float* __restrict__ oc, const float* __restrict__ lq1, const float* __restrict__ lk1, const float* __restrict__ lq2,
                                            const float* __restrict__ lk2, const float* __restrict__ subg, char* lds, const int bid, const int G, const int tid) {
    for (int u = bid; u < 512; u += G) {
        __syncthreads();
        const int kv = u >> 7, g = (u >> 5) & 3, qb = u & 31, hq = kv * 4 + g;
        att::attn_wide_body<9216, 9216, 4096, 1, att::bf16>(hb + (size_t)(qb * 256) * 9216 + 6144 + hq * 128, hb + 8192 + kv * 128, hb + 8704 + kv * 128,
                                                             abb + (size_t)(qb * 256) * 4096 + 2048 + hq * 128, SEQ, lds, tid);
    }
    int tid2 = tid; asm volatile("" : "+v"(tid2));
    const int lane_c = tid2 & 63;
    const float lam = __int_as_float(__builtin_amdgcn_readfirstlane(__float_as_int(__expf(wave_sum(lq1[lane_c] * lk1[lane_c] + lq1[lane_c + 64] * lk1[lane_c + 64])) - __expf(wave_sum(lq2[lane_c] * lk2[lane_c] + lq2[lane_c + 64] * lk2[lane_c + 64])) + LAMBDA_INIT)));
    for (int v = bid; v < 256; v += G) {
        __syncthreads();
        const int h = v >> 5, qb = v & 31;
        float* o1 = oc + (size_t)(qb * 256) * 2048 + h * 256;
        int tid4 = tid2; asm volatile("" : "+v"(tid4));
        att::attn_wide_body<9216, 9216, 2048, 2, float>(hb + (size_t)(qb * 256) * 9216 + h * 256, hb + 2048 + h * 256, hb + 4096 + h * 256, o1, SEQ, lds, tid4);
        __syncthreads();
        int tid3 = tid2; asm volatile("" : "+v"(tid3));
        att::attn_wide_body<9216, 9216, 2048, 2, float, true, 4096>(hb + (size_t)(qb * 256) * 9216 + h * 256 + 128, hb + 2048 + h * 256 + 128, hb + 4096 + h * 256, o1, SEQ, lds, tid3,
                                                                     lam, 1.0f - LAMBDA_INIT, subg, abb + (size_t)(qb * 256) * 4096 + h * 256);
    }
}


__device__ __forceinline__ void attn0_phase(const bf16_t* __restrict__ hb, const float* __restrict__ sink, bf16_t* __restrict__ abb, bf16_t* __restrict__ obg, float* __restrict__ lse, char* lds, const int bid, const int G, const int tid) {
    const long LD = 12288;
    for (int u = bid; u < 512; u += G) {
        __syncthreads();
        const int hq = u >> 5, qb = u & 31, kv = hq >> 2;
        att::attn_banded_body<128>(hb + hq * 128, hb + 2048 + kv * 128, hb + 2560 + kv * 128, LD, SEQ, qb * 256, sink[hq] * (1.0f / att::SCALE), 1.0f, abb + hq * 128, 3072, nullptr, 0, lds, tid);
    }
    int tid2 = tid; asm volatile("" : "+v"(tid2));
    for (int v = bid; v < 768; v += G) {
        __syncthreads();
        const int g = v >> 8, w = v & 255, h = w >> 5, rem = w & 31;
        const int dsh = 2 * g;
        const int nqb_sh = 5 - dsh;
        const int r = rem >> nqb_sh, qb = rem & ((1 << nqb_sh) - 1);
        const int head = 8 * g + h;
        const long rs = LD << dsh;
        att::attn_banded_body<64>(hb + (long)r * LD + 3072 + head * 128, hb + (long)r * LD + 6144 + head * 128, hb + (long)r * LD + 9216 + head * 128, rs, SEQ >> dsh, qb * 256, -1e30f, 0.f,
                                  obg + ((long)(g * 8 + h) * SEQ + r) * 128, (long)128 << dsh, lse + (long)(g * 8 + h) * SEQ + r, (long)1 << dsh, lds, tid2);
    }
}
__device__ __forceinline__ void merge0_phase(const bf16_t* __restrict__ obg, const float* __restrict__ lse, bf16_t* __restrict__ abb, const int bid, const int G, const int tid) {
    const int lane = tid & 63, wv = tid >> 6;
    for (int j = bid * 8 + wv; j < SEQ * 8; j += G * 8) {
        const int h = j >> 13, t = j & (SEQ - 1);
        const float l0 = lse[(size_t)(0 * 8 + h) * SEQ + t], l1 = lse[(size_t)(1 * 8 + h) * SEQ + t], l2 = lse[(size_t)(2 * 8 + h) * SEQ + t];
        const float mx = fmaxf(l0, fmaxf(l1, l2));
        const float e0 = __expf(l0 - mx), e1 = __expf(l1 - mx), e2 = __expf(l2 - mx), inv = 1.0f / (e0 + e1 + e2);
        const unsigned a0 = *(const unsigned*)(obg + ((size_t)(0 * 8 + h) * SEQ + t) * 128 + 2 * lane), a1 = *(const unsigned*)(obg + ((size_t)(1 * 8 + h) * SEQ + t) * 128 + 2 * lane), a2 = *(const unsigned*)(obg + ((size_t)(2 * 8 + h) * SEQ + t) * 128 + 2 * lane);
        const float x = (e0 * bf_lo(a0) + e1 * bf_lo(a1) + e2 * bf_lo(a2)) * inv, y = (e0 * bf_hi(a0) + e1 * bf_hi(a1) + e2 * bf_hi(a2)) * inv;
        *(unsigned*)(abb + (size_t)t * 3072 + 2048 + h * 128 + 2 * lane) = cvtpk_bf16(x, y);
    }
}

__device__ __forceinline__ void post_even_phase(const float* __restrict__ h, bf16_t* __restrict__ hb, const int bid, const int G, const int tid) {
    const int lane = tid & 63, wv = tid >> 6;
    for (int job = bid * 8 + wv; job < SEQ * 96; job += G * 8) {
        const int t = job / 96, blk = job - t * 96;
        const bool rope = (blk < 20) || (blk >= 24 && blk < 72);
        const float2 v = *(const float2*)(h + (size_t)t * 12288 + blk * 128 + 2 * lane);
        float o0 = v.x, o1 = v.y;
        const float p0 = __shfl_xor(v.x, 8), p1 = __shfl_xor(v.y, 8);
        if (rope && lane < 16) {
            const int i0 = (2 * lane) & 15;
            float s0, c0, s1, c1; sincos_rev((double)t * REV_P[i0], s0, c0); sincos_rev((double)t * REV_P[i0 + 1], s1, c1);
            if (lane < 8) { o0 = v.x * c0 - p0 * s0; o1 = v.y * c1 - p1 * s1; }
            else          { o0 = v.x * c0 + p0 * s0; o1 = v.y * c1 + p1 * s1; }
        }
        *(unsigned*)(hb + (size_t)t * 12288 + blk * 128 + 2 * lane) = cvtpk_bf16(o0, o1);
    }
}
__device__ __forceinline__ void post_odd_phase(const float* __restrict__ h, bf16_t* __restrict__ hb, const float* __restrict__ qg, const float* __restrict__ kg, const int bid, const int G, const int tid) {
    const int lane = tid & 63, wv = tid >> 6;
    for (int job = bid * 8 + wv; job < SEQ * 72; job += G * 8) {
        const int t = job / 72, blk = job - t * 72;
        const float2 v = *(const float2*)(h + (size_t)t * 9216 + blk * 128 + 2 * lane);
        float o0 = v.x, o1 = v.y;
        if (blk < 32) {
            const float p0 = __shfl_xor(v.x, 8), p1 = __shfl_xor(v.y, 8);
            if (lane < 16) {
                const int i0 = (2 * lane) & 15;
                float s0, c0, s1, c1; sincos_rev((double)t * REV_P[i0], s0, c0); sincos_rev((double)t * REV_P[i0 + 1], s1, c1);
                if (lane < 8) { o0 = v.x * c0 - p0 * s0; o1 = v.y * c1 - p1 * s1; }
                else          { o0 = v.x * c0 + p0 * s0; o1 = v.y * c1 + p1 * s1; }
            }
        } else if (blk >= 48 && blk < 68) {
            const float* g = blk < 64 ? qg : kg;
            const float ss = wave_sum(v.x * v.x + v.y * v.y) * (1.0f / 128.0f);
            const float rs = 1.0f / sqrtf(ss + 1e-6f);
            const float a0 = v.x * rs * g[2 * lane], a1 = v.y * rs * g[2 * lane + 1];
            const float p0 = __shfl_xor(a0, 16), p1 = __shfl_xor(a1, 16);
            const int i0 = (2 * lane) & 31;
            const double pos = (double)(lane < 32 ? (t >> 6) : (t & 63));
            float s0, c0, s1, c1; sincos_rev(pos * REV_A[i0], s0, c0); sincos_rev(pos * REV_A[i0 + 1], s1, c1);
            if ((lane & 16) == 0) { o0 = a0 * c0 - p0 * s0; o1 = a1 * c1 - p1 * s1; }
            else                  { o0 = a0 * c0 + p0 * s0; o1 = a1 * c1 + p1 * s1; }
        }
        *(unsigned*)(hb + (size_t)t * 9216 + blk * 128 + 2 * lane) = cvtpk_bf16(o0, o1);
    }
}

__device__ __forceinline__ void attn_seg_b(const float q0, const float q1, const bf16_t* __restrict__ Kb, const bf16_t* __restrict__ Vb, const int ld,
                                           const int t, const int step, int jlo, int jhi, float& m, float& l, float& o0, float& o1, const int lane) {
    { const int lo = -(t / step); if (jlo < lo) jlo = lo; const int hi = (SEQ - 1 - t) / step; if (jhi > hi) jhi = hi; }
    for (int j = jlo; j <= jhi; ++j) {
        const size_t tp = (size_t)(t + step * j);
        const unsigned kw = *(const unsigned*)(Kb + tp * ld + 2 * lane), vw = *(const unsigned*)(Vb + tp * ld + 2 * lane);
        const float s = wave_sum(q0 * bf_lo(kw) + q1 * bf_hi(kw)) * ATT_SCALE;
        const float mn = fmaxf(m, s);
        const float al = __expf(m - mn), p = __expf(s - mn);
        l = l * al + p;
        o0 = o0 * al + p * bf_lo(vw); o1 = o1 * al + p * bf_hi(vw);
        m = mn;
    }
}
__device__ __forceinline__ void attn_even_valu_phase(const bf16_t* __restrict__ hb, const float* __restrict__ sink, bf16_t* __restrict__ abb, const int bid, const int G, const int tid) {
    const int lane = tid & 63, wv = tid >> 6;
    const int LD = 12288;
    for (int job = bid * 8 + wv; job < SEQ * 24; job += G * 8) {
        const int hh = job / SEQ, t = job % SEQ;
        float o0 = 0.f, o1 = 0.f, m, l;
        if (hh < 16) {
            const int kv = hh >> 2;
            const unsigned qw = *(const unsigned*)(hb + (size_t)t * LD + hh * 128 + 2 * lane);
            m = sink[hh]; l = 1.f;
            attn_seg_b(bf_lo(qw), bf_hi(qw), hb + 2048 + kv * 128, hb + 2560 + kv * 128, LD, t, 1, -128, 128, m, l, o0, o1, lane);
        } else {
            const int hbh = hh - 16;
            m = -1e30f; l = 0.f;
#pragma unroll
            for (int g = 0; g < 3; ++g) {
                const int head = 8 * g + hbh; const int step = g == 0 ? 1 : (g == 1 ? 4 : 16);
                const unsigned qw = *(const unsigned*)(hb + (size_t)t * LD + 3072 + head * 128 + 2 * lane);
                attn_seg_b(bf_lo(qw), bf_hi(qw), hb + 6144 + head * 128, hb + 9216 + head * 128, LD, t, step, -64, 64, m, l, o0, o1, lane);
            }
        }
        const float il = 1.0f / l;
        *(unsigned*)(abb + (size_t)t * 3072 + hh * 128 + 2 * lane) = cvtpk_bf16(o0 * il, o1 * il);
    }
}

__device__ __forceinline__ void ln_phase(const float* __restrict__ y, const float* __restrict__ g, const float* __restrict__ b, float* __restrict__ stats, bf16_t* __restrict__ outb, const int bid, const int G, const int tid) {
    const int lane = tid & 63, wv = tid >> 6;
    for (int t = bid * 8 + wv; t < SEQ; t += G * 8) {
        float4 v[16]; float s = 0.f;
#pragma unroll
        for (int i = 0; i < 16; ++i) { v[i] = *(const float4*)(y + (size_t)t * DM + i * 256 + lane * 4); s += (v[i].x + v[i].y) + (v[i].z + v[i].w); }
        const float mean = wave_sum(s) * (1.0f / DM);
        float q = 0.f;
#pragma unroll
        for (int i = 0; i < 16; ++i) { const float a = v[i].x - mean, bb = v[i].y - mean, c = v[i].z - mean, d = v[i].w - mean; q += (a * a + bb * bb) + (c * c + d * d); }
        const float rstd = 1.0f / sqrtf(wave_sum(q) * (1.0f / DM) + 1e-5f);
        if (lane == 0) *(float2*)(stats + (size_t)t * 2) = make_float2(mean, rstd);
#pragma unroll
        for (int i = 0; i < 16; ++i) {
            const float4 gg = *(const float4*)(g + i * 256 + lane * 4), bb = *(const float4*)(b + i * 256 + lane * 4);
            float4 o; o.x = (v[i].x - mean) * rstd * gg.x + bb.x; o.y = (v[i].y - mean) * rstd * gg.y + bb.y; o.z = (v[i].z - mean) * rstd * gg.z + bb.z; o.w = (v[i].w - mean) * rstd * gg.w + bb.w;
            uint2 w; w.x = cvtpk_bf16(o.x, o.y); w.y = cvtpk_bf16(o.z, o.w); *(uint2*)(outb + (size_t)t * DM + i * 256 + lane * 4) = w;
            if ((i & 3) == 3) asm volatile("" ::: "memory");
        }
    }
}

__device__ __forceinline__ void route_valu_phase(const float* __restrict__ q  , const float* __restrict__ keys  , int* __restrict__ eidx, float* __restrict__ gate, const int bid, const int G, const int tid) {
    const int lane = tid & 63, wv = tid >> 6;
    for (int job = bid * 8 + wv; job < SEQ * 8; job += G * 8) {
        const int hh = job & 7, t = job >> 3;
        float sv0 = 0.f, sv1 = 0.f; int si0 = 0, si1 = 0;
#pragma unroll
        for (int c = 0; c < 2; ++c) {
            const float* qq = q + (size_t)t * 2048 + hh * 256 + c * 128;
            const float* k0 = keys + ((size_t)(hh * 2 + c) * 128 + lane) * 128;
            const float* k1 = k0 + 64 * 128;
            float s0 = 0.f, s1 = 0.f;
            for (int d = 0; d < 128; d += 4) {
                const float4 qv = *(const float4*)(qq + d), a = *(const float4*)(k0 + d), b = *(const float4*)(k1 + d);
                s0 += qv.x * a.x + qv.y * a.y + qv.z * a.z + qv.w * a.w;
                s1 += qv.x * b.x + qv.y * b.y + qv.z * b.z + qv.w * b.w;
            }
            float myv = 0.f; int myi = 0;
            for (int k = 0; k < 16; ++k) {
                float bv; int bi;
                if (s1 > s0) { bv = s1; bi = lane + 64; } else { bv = s0; bi = lane; }
#pragma unroll
                for (int o = 32; o >= 1; o >>= 1) {
                    const float ov = __shfl_xor(bv, o); const int oi = __shfl_xor(bi, o);
                    if (ov > bv || (ov == bv && oi < bi)) { bv = ov; bi = oi; }
                }
                if (lane == k) { myv = bv; myi = bi; }
                if (bi == lane) s0 = -3.0e38f;
                if (bi == lane + 64) s1 = -3.0e38f;
            }
            if (c == 0) { sv0 = myv; si0 = myi; } else { sv1 = myv; si1 = myi; }
        }
        float cv0, cv1, cv2, cv3; int ci0, ci1, ci2, ci3;
        { const float a = __shfl(sv0, lane >> 2); const int ai = __shfl(si0, lane >> 2); const int jb = (lane & 3) * 4;
          cv0 = a + __shfl(sv1, jb + 0); ci0 = ai * 128 + __shfl(si1, jb + 0);
          cv1 = a + __shfl(sv1, jb + 1); ci1 = ai * 128 + __shfl(si1, jb + 1);
          cv2 = a + __shfl(sv1, jb + 2); ci2 = ai * 128 + __shfl(si1, jb + 2);
          cv3 = a + __shfl(sv1, jb + 3); ci3 = ai * 128 + __shfl(si1, jb + 3); }
        float tv = 0.f; int te = 0;
        for (int k = 0; k < 16; ++k) {
            float bv = cv0; int bp = lane * 4, be = ci0;
            if (cv1 > bv) { bv = cv1; bp = lane * 4 + 1; be = ci1; }
            if (cv2 > bv) { bv = cv2; bp = lane * 4 + 2; be = ci2; }
            if (cv3 > bv) { bv = cv3; bp = lane * 4 + 3; be = ci3; }
#pragma unroll
            for (int o = 32; o >= 1; o >>= 1) {
                const float ov = __shfl_xor(bv, o); const int op = __shfl_xor(bp, o); const int oe = __shfl_xor(be, o);
                if (ov > bv || (ov == bv && op < bp)) { bv = ov; bp = op; be = oe; }
            }
            if (lane == k) { tv = bv; te = be; }
            if (bp == lane * 4 + 0) cv0 = -3.0e38f;
            if (bp == lane * 4 + 1) cv1 = -3.0e38f;
            if (bp == lane * 4 + 2) cv2 = -3.0e38f;
            if (bp == lane * 4 + 3) cv3 = -3.0e38f;
        }
        const float v = lane < 16 ? tv : -3.0e38f;
        const float mx = wave_max(v);
        const float e = lane < 16 ? __expf(tv - mx) : 0.f;
        const float den = wave_sum(e);
        if (lane < 16) { eidx[(size_t)t * 128 + hh * 16 + lane] = te; gate[(size_t)t * 128 + hh * 16 + lane] = e / den; }
    }
}
namespace rt {
using att::f32x16; using att::bf16x8;
__device__ __forceinline__ float pair_max(float m) {
    auto rr = __builtin_amdgcn_permlane32_swap(__float_as_uint(m), __float_as_uint(m), false, false);
    return fmaxf(__uint_as_float(rr[0]), __uint_as_float(rr[1]));
}
__device__ __forceinline__ int pair_max_i(int m) {
    auto rr = __builtin_amdgcn_permlane32_swap((unsigned)m, (unsigned)m, false, false);
    const int a = (int)rr[0], b = (int)rr[1]; return a > b ? a : b;
}
__device__ __forceinline__ void top16_of_128(f32x16& p0, f32x16& p1, f32x16& p2, f32x16& p3, float (&t)[16]) {
#pragma unroll
    for (int k = 0; k < 16; ++k) {
        float m = p0[0];
#pragma unroll
        for (int r = 1; r < 16; ++r) m = fmaxf(m, p0[r]);
#pragma unroll
        for (int r = 0; r < 16; ++r) m = fmaxf(m, fmaxf(p1[r], fmaxf(p2[r], p3[r])));
        m = pair_max(m);
        t[k] = m;
#pragma unroll
        for (int r = 0; r < 16; ++r) { p0[r] = p0[r] == m ? -3.0e38f : p0[r]; p1[r] = p1[r] == m ? -3.0e38f : p1[r]; p2[r] = p2[r] == m ? -3.0e38f : p2[r]; p3[r] = p3[r] == m ? -3.0e38f : p3[r]; }
    }
}
__device__ __forceinline__ void tag_scores(f32x16& p, const int base, const int hi) {
#pragma unroll
    for (int r = 0; r < 16; ++r) p[r] = __uint_as_float((__float_as_uint(p[r]) & ~0x7Fu) | (unsigned)(base + att::crow(r, hi)));
}
}

__device__ __forceinline__ void route_mfma_phase(const bf16_t* __restrict__ pqb  , const bf16_t* __restrict__ keysb  , int* __restrict__ eidx, float* __restrict__ gate,
                                                 char* lds, const pg8::StaticOrder& S, const int tid) {
    using namespace rt;
    const int wid = __builtin_amdgcn_readfirstlane(tid >> 6), lane = tid & 63, r32 = lane & 31, hi = lane >> 5;
    att::bf16* K_lds = (att::bf16*)lds;
    pg8::Unit un;
    for (int ui = 0; S.next(ui, un); ++ui) {
        const int h = un.pn, tb = un.pm * 256;
        const int tok = tb + wid * 32 + r32;
        float t0[16], t1[16];
#pragma unroll
        for (int c = 0; c < 2; ++c) {
            __syncthreads();
            { const bf16_t* kp = keysb + (size_t)(h * 2 + c) * 128 * 128;
              const int row = tid >> 2;
#pragma unroll
              for (int i = 0; i < 4; ++i) { const int sc = ((tid & 3) * 4 + i) * 8;
                  const bf16x8 v = *reinterpret_cast<const bf16x8*>(kp + row * 128 + sc);
                  *(bf16x8*)((char*)K_lds + (row >> 6) * 16384 + KSWZ(row & 63, sc * 2)) = v; } }
            bf16x8 qr[8];
            { const bf16_t* qw = pqb + (size_t)tok * 2048 + h * 256 + c * 128 + hi * 8;
#pragma unroll
              for (int d0 = 0; d0 < 8; ++d0) qr[d0] = *reinterpret_cast<const bf16x8*>(qw + d0 * 16); }
            __syncthreads();
            f32x16 p0, p1, p2, p3;
            att::qkt(p0, p1, K_lds, qr, r32, hi);
            att::qkt(p2, p3, (att::bf16*)((char*)K_lds + 16384), qr, r32, hi);
            tag_scores(p0, 0, hi); tag_scores(p1, 32, hi); tag_scores(p2, 64, hi); tag_scores(p3, 96, hi);
            if (c == 0) top16_of_128(p0, p1, p2, p3, t0); else top16_of_128(p0, p1, p2, p3, t1);
        }
        float v0[16], v1[16]; int k0[16], k1[16];
#pragma unroll
        for (int i = 0; i < 16; ++i) { const unsigned a = __float_as_uint(t0[i]), b = __float_as_uint(t1[i]);
            v0[i] = __uint_as_float(a & ~0x7Fu); v1[i] = __uint_as_float(b & ~0x7Fu); k0[i] = (int)((a & 0x7Fu) << 7); k1[i] = (int)(b & 0x7Fu); }
        float cv[25]; int ce[25];
    { const float s = hi ? (v0[0] + v1[1]) : (v0[0] + v1[0]); cv[0] = __uint_as_float((__float_as_uint(s) & ~0xFFu) | (unsigned)(2 * 0 + hi)); ce[0] = hi ? (k0[0] | k1[1]) : (k0[0] | k1[0]); }
    { const float s = hi ? (v0[0] + v1[3]) : (v0[0] + v1[2]); cv[1] = __uint_as_float((__float_as_uint(s) & ~0xFFu) | (unsigned)(2 * 1 + hi)); ce[1] = hi ? (k0[0] | k1[3]) : (k0[0] | k1[2]); }
    { const float s = hi ? (v0[0] + v1[5]) : (v0[0] + v1[4]); cv[2] = __uint_as_float((__float_as_uint(s) & ~0xFFu) | (unsigned)(2 * 2 + hi)); ce[2] = hi ? (k0[0] | k1[5]) : (k0[0] | k1[4]); }
    { const float s = hi ? (v0[0] + v1[7]) : (v0[0] + v1[6]); cv[3] = __uint_as_float((__float_as_uint(s) & ~0xFFu) | (unsigned)(2 * 3 + hi)); ce[3] = hi ? (k0[0] | k1[7]) : (k0[0] | k1[6]); }
    { const float s = hi ? (v0[0] + v1[9]) : (v0[0] + v1[8]); cv[4] = __uint_as_float((__float_as_uint(s) & ~0xFFu) | (unsigned)(2 * 4 + hi)); ce[4] = hi ? (k0[0] | k1[9]) : (k0[0] | k1[8]); }
    { const float s = hi ? (v0[0] + v1[11]) : (v0[0] + v1[10]); cv[5] = __uint_as_float((__float_as_uint(s) & ~0xFFu) | (unsigned)(2 * 5 + hi)); ce[5] = hi ? (k0[0] | k1[11]) : (k0[0] | k1[10]); }
    { const float s = hi ? (v0[0] + v1[13]) : (v0[0] + v1[12]); cv[6] = __uint_as_float((__float_as_uint(s) & ~0xFFu) | (unsigned)(2 * 6 + hi)); ce[6] = hi ? (k0[0] | k1[13]) : (k0[0] | k1[12]); }
    { const float s = hi ? (v0[0] + v1[15]) : (v0[0] + v1[14]); cv[7] = __uint_as_float((__float_as_uint(s) & ~0xFFu) | (unsigned)(2 * 7 + hi)); ce[7] = hi ? (k0[0] | k1[15]) : (k0[0] | k1[14]); }
    { const float s = hi ? (v0[1] + v1[1]) : (v0[1] + v1[0]); cv[8] = __uint_as_float((__float_as_uint(s) & ~0xFFu) | (unsigned)(2 * 8 + hi)); ce[8] = hi ? (k0[1] | k1[1]) : (k0[1] | k1[0]); }
    { const float s = hi ? (v0[1] + v1[3]) : (v0[1] + v1[2]); cv[9] = __uint_as_float((__float_as_uint(s) & ~0xFFu) | (unsigned)(2 * 9 + hi)); ce[9] = hi ? (k0[1] | k1[3]) : (k0[1] | k1[2]); }
    { const float s = hi ? (v0[1] + v1[5]) : (v0[1] + v1[4]); cv[10] = __uint_as_float((__float_as_uint(s) & ~0xFFu) | (unsigned)(2 * 10 + hi)); ce[10] = hi ? (k0[1] | k1[5]) : (k0[1] | k1[4]); }
    { const float s = hi ? (v0[1] + v1[7]) : (v0[1] + v1[6]); cv[11] = __uint_as_float((__float_as_uint(s) & ~0xFFu) | (unsigned)(2 * 11 + hi)); ce[11] = hi ? (k0[1] | k1[7]) : (k0[1] | k1[6]); }
    { const float s = hi ? (v0[2] + v1[1]) : (v0[2] + v1[0]); cv[12] = __uint_as_float((__float_as_uint(s) & ~0xFFu) | (unsigned)(2 * 12 + hi)); ce[12] = hi ? (k0[2] | k1[1]) : (k0[2] | k1[0]); }
    { const float s = hi ? (v0[2] + v1[3]) : (v0[2] + v1[2]); cv[13] = __uint_as_float((__float_as_uint(s) & ~0xFFu) | (unsigned)(2 * 13 + hi)); ce[13] = hi ? (k0[2] | k1[3]) : (k0[2] | k1[2]); }
    { const float s = hi ? (v0[3] + v1[0]) : (v0[2] + v1[4]); cv[14] = __uint_as_float((__float_as_uint(s) & ~0xFFu) | (unsigned)(2 * 14 + hi)); ce[14] = hi ? (k0[3] | k1[0]) : (k0[2] | k1[4]); }
    { const float s = hi ? (v0[3] + v1[2]) : (v0[3] + v1[1]); cv[15] = __uint_as_float((__float_as_uint(s) & ~0xFFu) | (unsigned)(2 * 15 + hi)); ce[15] = hi ? (k0[3] | k1[2]) : (k0[3] | k1[1]); }
    { const float s = hi ? (v0[4] + v1[0]) : (v0[3] + v1[3]); cv[16] = __uint_as_float((__float_as_uint(s) & ~0xFFu) | (unsigned)(2 * 16 + hi)); ce[16] = hi ? (k0[4] | k1[0]) : (k0[3] | k1[3]); }
    { const float s = hi ? (v0[4] + v1[2]) : (v0[4] + v1[1]); cv[17] = __uint_as_float((__float_as_uint(s) & ~0xFFu) | (unsigned)(2 * 17 + hi)); ce[17] = hi ? (k0[4] | k1[2]) : (k0[4] | k1[1]); }
    { const float s = hi ? (v0[5] + v1[1]) : (v0[5] + v1[0]); cv[18] = __uint_as_float((__float_as_uint(s) & ~0xFFu) | (unsigned)(2 * 18 + hi)); ce[18] = hi ? (k0[5] | k1[1]) : (k0[5] | k1[0]); }
    { const float s = hi ? (v0[6] + v1[1]) : (v0[6] + v1[0]); cv[19] = __uint_as_float((__float_as_uint(s) & ~0xFFu) | (unsigned)(2 * 19 + hi)); ce[19] = hi ? (k0[6] | k1[1]) : (k0[6] | k1[0]); }
    { const float s = hi ? (v0[7] + v1[1]) : (v0[7] + v1[0]); cv[20] = __uint_as_float((__float_as_uint(s) & ~0xFFu) | (unsigned)(2 * 20 + hi)); ce[20] = hi ? (k0[7] | k1[1]) : (k0[7] | k1[0]); }
    { const float s = hi ? (v0[9] + v1[0]) : (v0[8] + v1[0]); cv[21] = __uint_as_float((__float_as_uint(s) & ~0xFFu) | (unsigned)(2 * 21 + hi)); ce[21] = hi ? (k0[9] | k1[0]) : (k0[8] | k1[0]); }
    { const float s = hi ? (v0[11] + v1[0]) : (v0[10] + v1[0]); cv[22] = __uint_as_float((__float_as_uint(s) & ~0xFFu) | (unsigned)(2 * 22 + hi)); ce[22] = hi ? (k0[11] | k1[0]) : (k0[10] | k1[0]); }
    { const float s = hi ? (v0[13] + v1[0]) : (v0[12] + v1[0]); cv[23] = __uint_as_float((__float_as_uint(s) & ~0xFFu) | (unsigned)(2 * 23 + hi)); ce[23] = hi ? (k0[13] | k1[0]) : (k0[12] | k1[0]); }
    { const float s = hi ? (v0[15] + v1[0]) : (v0[14] + v1[0]); cv[24] = __uint_as_float((__float_as_uint(s) & ~0xFFu) | (unsigned)(2 * 24 + hi)); ce[24] = hi ? (k0[15] | k1[0]) : (k0[14] | k1[0]); }
        float ts[16]; int te[16];
#pragma unroll
        for (int k = 0; k < 16; ++k) {
            float m = cv[0];
#pragma unroll
            for (int n = 1; n < 25; ++n) m = fmaxf(m, cv[n]);
            m = pair_max(m);
            int e = -1;
#pragma unroll
            for (int n = 0; n < 25; ++n) { const bool hit = cv[n] == m; e = hit ? ce[n] : e; cv[n] = hit ? -3.0e38f : cv[n]; }
            ts[k] = __uint_as_float(__float_as_uint(m) & ~0xFFu); te[k] = pair_max_i(e);
        }
        float den = 0.f; const float mx = ts[0];
#pragma unroll
        for (int k = 0; k < 16; ++k) { ts[k] = __expf(ts[k] - mx); den += ts[k]; }
        const float inv = 1.0f / den;
        if (hi == 0) { int4* op = (int4*)(eidx + (size_t)tok * 128 + h * 16);
            op[0] = make_int4(te[0], te[1], te[2], te[3]); op[1] = make_int4(te[4], te[5], te[6], te[7]); op[2] = make_int4(te[8], te[9], te[10], te[11]); op[3] = make_int4(te[12], te[13], te[14], te[15]); }
        else { float4* op = (float4*)(gate + (size_t)tok * 128 + h * 16);
            op[0] = make_float4(ts[0] * inv, ts[1] * inv, ts[2] * inv, ts[3] * inv); op[1] = make_float4(ts[4] * inv, ts[5] * inv, ts[6] * inv, ts[7] * inv);
            op[2] = make_float4(ts[8] * inv, ts[9] * inv, ts[10] * inv, ts[11] * inv); op[3] = make_float4(ts[12] * inv, ts[13] * inv, ts[14] * inv, ts[15] * inv); }
    }
}
#ifndef PH_MASK
#define PH_MASK 0xffffffffu
#endif
constexpr int N_PHASES = 20;
__global__ void __launch_bounds__(512, 2) mega(MK a) {
    extern __shared__ __attribute__((aligned(16))) unsigned char lds_raw[];
    LDSA unsigned char* lds = (LDSA unsigned char*)lds_raw;
    const int lo = a.ph_lo, hi = a.ph_hi;
    const int G = gridDim.x, bid = blockIdx.x;
    const int wid_s = __builtin_amdgcn_readfirstlane(threadIdx.x >> 6);
    unsigned char* ws = a.ws;
#define PH_TID() int tid; { int _z = 0; asm volatile("" : "+s"(_z)); tid = wid_s * 64 + (int)__builtin_amdgcn_mbcnt_hi(~0u, __builtin_amdgcn_mbcnt_lo(~0u, (unsigned)_z)); }
#define WSP(T, name, off) T* name; { unsigned char* _b = ws; asm volatile("" : "+s"(_b)); name = (T*)(_b + (off)); }
#define IN(k) ((((PH_MASK) >> (k)) & 1u) && lo <= (k) && (k) < hi)
#define SEAM(k) do { if ((k) + 1 < hi) { PH_TID() xcd_barrier(bar, tid); } } while (0)
    XcdBarrier bar;
    { PH_TID()
      volatile LAS unsigned* st = (volatile LAS unsigned*)(lds + LDS_MISC);
      if (tid == 0) { st[0] = 0u; st[1] = 0u; }
      __syncthreads();
      bar = xcd_barrier_post((unsigned*)(ws + WS_CTL), st, tid); }

    if (IN(0)) {
#ifdef PROBE_PRO2
      for (int rep = 0; rep < 2; ++rep) {
#else
      {
#endif
        PH_TID()
        WSP(bf16_t, xb, WS_XB) WSP(bf16_t, wab, WS_WAB) WSP(bf16_t, woab, WS_WOAB) WSP(bf16_t, wcd, WS_WCD) WSP(bf16_t, wocd, WS_WOCD) WSP(bf16_t, wq, WS_WQ) WSP(unsigned char, ub, WS_UB) WSP(unsigned char, vb, WS_VB) WSP(float, isu, WS_SU) WSP(float, isv, WS_SV)
        cvt_rows_bf16(a.in[0], xb, (size_t)SEQ * DM / 8, bid, G, tid, 512);
        LDSA float* tile = (LDSA float*)lds;
        transpose_cvt(a.in[1], wab, 4096, 12288, tile, bid, G, PermAB(), tid);
        transpose_cvt(a.in[3], woab, 3072, 4096, tile, bid, G, PermNone(), tid);
        transpose_cvt(a.in[4], wcd, 4096, 9216, tile, bid, G, PermCD(), tid);
        transpose_cvt(a.in[12], wocd, 4096, 4096, tile, bid, G, PermNone(), tid);
        transpose_cvt(a.in[15], wq, 4096, 2048, tile, bid, G, PermNone(), tid);
        transpose_cvt(a.in[15] + (size_t)4096 * 2048, wq + (size_t)2048 * 4096, 4096, 2048, tile, bid, G, PermNone(), tid);
        table_fp6(a.in[17], ub, isu, 2 * 16384, (LDSA float*)lds, bid, G, tid);
        table_fp6(a.in[18], vb, isv, 2 * 16384, (LDSA float*)lds, bid, G, tid);
        { WSP(float, cs0, WS_CS0) WSP(float, csa, WS_CSA) rope_tables(cs0, csa, bid, G, tid); }
        { WSP(bf16_t, keyb, WS_KEYB) cvt_rows_bf16(a.in[16], keyb, (size_t)2 * 8 * 2 * 128 * 128 / 8, bid, G, tid, 512); }
      }
        SEAM(0);
    }
    { constexpr int layer = 0;
        const int pb = 1 + 10 * layer;
        if (IN(pb + 0)) {
            PH_TID() WSP(bf16_t, xb, WS_XB) WSP(bf16_t, x2b, WS_X2B) WSP(bf16_t, wab, WS_WAB) WSP(bf16_t, wcd, WS_WCD) WSP(bf16_t, hb, WS_HB) WSP(float, cs0, WS_CS0) WSP(float, csa, WS_CSA)
            if (layer == 0) {
                pg8::Gemm g{xb, wab, SEQ, 12288, 4096}; pg8::StaticOrder S; S.init(SEQ, 12288, G, bid);
                pg8::EpiProj<0> E{hb, 12288, cs0, csa, nullptr, nullptr, (LDSA float*)(lds + LDS_MISC + 64)};
                pg8::gemm_phase<pg8::EpiProj<0>, pg8::StaticOrder>(lds, g, S, E, nullptr, tid);
#ifdef PROBE_GEMM2
                pg8::gemm_phase<pg8::EpiProj<0>, pg8::StaticOrder>(lds, g, S, E, nullptr, tid);
#endif
            } else {
                pg8::Gemm g{x2b, wcd, SEQ, 9216, 4096}; pg8::StaticOrder S; S.init(SEQ, 9216, G, bid);
                pg8::EpiProj<1> E{hb, 9216, cs0, csa, a.in[10], a.in[11], (LDSA float*)(lds + LDS_MISC + 64)};
                pg8::gemm_phase<pg8::EpiProj<1>, pg8::StaticOrder>(lds, g, S, E, nullptr, tid);
            }
            SEAM(pb + 0);
        }
        if (IN(pb + 2)) {
            PH_TID() WSP(bf16_t, hb, WS_HB) WSP(bf16_t, abb, WS_AB) WSP(float, oc, WS_OC)
            if (layer == 0) attn0_phase(hb, a.in[2], abb, (bf16_t*)oc, (float*)((unsigned char*)oc + (size_t)3 * 8 * SEQ * 128 * 2), (char*)lds_raw, bid, G, tid);
#ifdef PROBE_SMALL
            if (layer == 0) { __syncthreads(); int t3 = tid; asm volatile("" : "+v"(t3)); attn0_phase(hb, a.in[2], abb, (bf16_t*)oc, (float*)((unsigned char*)oc + (size_t)3 * 8 * SEQ * 128 * 2), (char*)lds_raw, bid, G, t3); }
#endif
            else attn1_phase(hb, abb, oc, a.in[5], a.in[6], a.in[7], a.in[8], a.in[9], (char*)lds_raw, bid, G, tid);
#ifdef PROBE_ATTN2
            if (layer == 1) { __syncthreads(); int t3 = tid; asm volatile("" : "+v"(t3)); attn1_phase(hb, abb, oc, a.in[5], a.in[6], a.in[7], a.in[8], a.in[9], (char*)lds_raw, bid, G, t3); }
#endif
            SEAM(pb + 2);
        }
        if (layer == 0) {
            if (IN(pb + 3)) {
                PH_TID() WSP(bf16_t, abb, WS_AB) WSP(float, oc, WS_OC)
                merge0_phase((const bf16_t*)oc, (const float*)((unsigned char*)oc + (size_t)3 * 8 * SEQ * 128 * 2), abb, bid, G, tid);
#ifdef PROBE_SMALL
                merge0_phase((const bf16_t*)oc, (const float*)((unsigned char*)oc + (size_t)3 * 8 * SEQ * 128 * 2), abb, bid, G, tid);
#endif
                SEAM(pb + 3);
            }
        } else {
        }
        if (IN(pb + 4)) {
            const int K = layer == 0 ? 3072 : 4096;
            PH_TID() WSP(bf16_t, abb, WS_AB) WSP(bf16_t, woab, WS_WOAB) WSP(bf16_t, wocd, WS_WOCD) WSP(float, ybuf, WS_Y) WSP(float, x2, WS_X2)
            pg8::Gemm g{abb, layer == 0 ? woab : wocd, SEQ, 4096, K}; pg8::StaticOrder S; S.init(SEQ, 4096, G, bid);
            pg8::EpiF32R E{ybuf, 4096, layer == 0 ? a.in[0] : (const float*)x2, ALPHA};
            pg8::gemm_phase<pg8::EpiF32R, pg8::StaticOrder>(lds, g, S, E, nullptr, tid);
            SEAM(pb + 4);
        }
        if (IN(pb + 5)) {
            PH_TID() WSP(float, ybuf, WS_Y) WSP(float, stats, WS_X1) WSP(bf16_t, x1b, WS_X1B)
            ln_phase(ybuf, a.in[13] + layer * DM, a.in[14] + layer * DM, stats, x1b, bid, G, tid);
            SEAM(pb + 5);
        }
        if (IN(pb + 6)) {
            PH_TID() WSP(bf16_t, x1b, WS_X1B) WSP(bf16_t, wq, WS_WQ) WSP(bf16_t, pqb, WS_PQ)
            pg8::Gemm g{x1b, wq + (size_t)layer * 2048 * 4096, SEQ, 2048, 4096}; pg8::StaticOrder S; S.init(SEQ, 2048, G, bid);
            pg8::EpiBf16P E{pqb, 2048};
            pg8::gemm_phase<pg8::EpiBf16P, pg8::StaticOrder>(lds, g, S, E, nullptr, tid);
            asm volatile("s_waitcnt vmcnt(0)" ::: "memory"); __syncthreads();
            { WSP(bf16_t, keyb, WS_KEYB) WSP(int, eidx, WS_EIDX) WSP(float, gate, WS_GATE)
              int t4 = tid; asm volatile("" : "+v"(t4));
              route_mfma_phase(pqb, keyb + (size_t)layer * 8 * 2 * 128 * 128, eidx, gate, (char*)lds_raw, S, t4); }
            SEAM(pb + 6);
        }
        if (IN(pb + 8)) {
            PH_TID() WSP(float, ybuf, WS_Y) WSP(float, stats, WS_X1) WSP(bf16_t, x1b, WS_X1B) WSP(int, eidx, WS_EIDX) WSP(float, gate, WS_GATE) WSP(unsigned char, ub, WS_UB) WSP(unsigned char, vb, WS_VB) WSP(float, isu, WS_SU) WSP(float, isv, WS_SV) WSP(float, x2, WS_X2) WSP(bf16_t, x2b, WS_X2B)
            peer_expert_phase(ybuf, stats, a.in[13] + layer * DM, a.in[14] + layer * DM, x1b, eidx, gate, ub + (size_t)layer * 16384 * ROWB, vb + (size_t)layer * 16384 * ROWB, isu + layer * 16384, isv + layer * 16384, a.in[19] + layer * DM, a.in[20] + layer * DM,
                              layer == 0 ? x2 : a.out, layer == 0 ? x2b : (bf16_t*)nullptr, (LDSA float*)lds, bid, G, tid);
            SEAM(pb + 8);
        }
        }
    { constexpr int layer = 1;
        const int pb = 1 + 10 * layer;
        if (IN(pb + 0)) {
            PH_TID() WSP(bf16_t, xb, WS_XB) WSP(bf16_t, x2b, WS_X2B) WSP(bf16_t, wab, WS_WAB) WSP(bf16_t, wcd, WS_WCD) WSP(bf16_t, hb, WS_HB) WSP(float, cs0, WS_CS0) WSP(float, csa, WS_CSA)
            if (layer == 0) {
                pg8::Gemm g{xb, wab, SEQ, 12288, 4096}; pg8::StaticOrder S; S.init(SEQ, 12288, G, bid);
                pg8::EpiProj<0> E{hb, 12288, cs0, csa, nullptr, nullptr, (LDSA float*)(lds + LDS_MISC + 64)};
                pg8::gemm_phase<pg8::EpiProj<0>, pg8::StaticOrder>(lds, g, S, E, nullptr, tid);
#ifdef PROBE_GEMM2
                pg8::gemm_phase<pg8::EpiProj<0>, pg8::StaticOrder>(lds, g, S, E, nullptr, tid);
#endif
            } else {
                pg8::Gemm g{x2b, wcd, SEQ, 9216, 4096}; pg8::StaticOrder S; S.init(SEQ, 9216, G, bid);
                pg8::EpiProj<1> E{hb, 9216, cs0, csa, a.in[10], a.in[11], (LDSA float*)(lds + LDS_MISC + 64)};
                pg8::gemm_phase<pg8::EpiProj<1>, pg8::StaticOrder>(lds, g, S, E, nullptr, tid);
            }
            SEAM(pb + 0);
        }
        if (IN(pb + 2)) {
            PH_TID() WSP(bf16_t, hb, WS_HB) WSP(bf16_t, abb, WS_AB) WSP(float, oc, WS_OC)
            if (layer == 0) attn0_phase(hb, a.in[2], abb, (bf16_t*)oc, (float*)((unsigned char*)oc + (size_t)3 * 8 * SEQ * 128 * 2), (char*)lds_raw, bid, G, tid);
#ifdef PROBE_SMALL
            if (layer == 0) { __syncthreads(); int t3 = tid; asm volatile("" : "+v"(t3)); attn0_phase(hb, a.in[2], abb, (bf16_t*)oc, (float*)((unsigned char*)oc + (size_t)3 * 8 * SEQ * 128 * 2), (char*)lds_raw, bid, G, t3); }
#endif
            else attn1_phase(hb, abb, oc, a.in[5], a.in[6], a.in[7], a.in[8], a.in[9], (char*)lds_raw, bid, G, tid);
#ifdef PROBE_ATTN2
            if (layer == 1) { __syncthreads(); int t3 = tid; asm volatile("" : "+v"(t3)); attn1_phase(hb, abb, oc, a.in[5], a.in[6], a.in[7], a.in[8], a.in[9], (char*)lds_raw, bid, G, t3); }
#endif
            SEAM(pb + 2);
        }
        if (layer == 0) {
            if (IN(pb + 3)) {
                PH_TID() WSP(bf16_t, abb, WS_AB) WSP(float, oc, WS_OC)
                merge0_phase((const bf16_t*)oc, (const float*)((unsigned char*)oc + (size_t)3 * 8 * SEQ * 128 * 2), abb, bid, G, tid);
#ifdef PROBE_SMALL
                merge0_phase((const bf16_t*)oc, (const float*)((unsigned char*)oc + (size_t)3 * 8 * SEQ * 128 * 2), abb, bid, G, tid);
#endif
                SEAM(pb + 3);
            }
        } else {
        }
        if (IN(pb + 4)) {
            const int K = layer == 0 ? 3072 : 4096;
            PH_TID() WSP(bf16_t, abb, WS_AB) WSP(bf16_t, woab, WS_WOAB) WSP(bf16_t, wocd, WS_WOCD) WSP(float, ybuf, WS_Y) WSP(float, x2, WS_X2)
            pg8::Gemm g{abb, layer == 0 ? woab : wocd, SEQ, 4096, K}; pg8::StaticOrder S; S.init(SEQ, 4096, G, bid);
            pg8::EpiF32R E{ybuf, 4096, layer == 0 ? a.in[0] : (const float*)x2, ALPHA};
            pg8::gemm_phase<pg8::EpiF32R, pg8::StaticOrder>(lds, g, S, E, nullptr, tid);
            SEAM(pb + 4);
        }
        if (IN(pb + 5)) {
            PH_TID() WSP(float, ybuf, WS_Y) WSP(float, stats, WS_X1) WSP(bf16_t, x1b, WS_X1B)
            ln_phase(ybuf, a.in[13] + layer * DM, a.in[14] + layer * DM, stats, x1b, bid, G, tid);
            SEAM(pb + 5);
        }
        if (IN(pb + 6)) {
            PH_TID() WSP(bf16_t, x1b, WS_X1B) WSP(bf16_t, wq, WS_WQ) WSP(bf16_t, pqb, WS_PQ)
            pg8::Gemm g{x1b, wq + (size_t)layer * 2048 * 4096, SEQ, 2048, 4096}; pg8::StaticOrder S; S.init(SEQ, 2048, G, bid);
            pg8::EpiBf16P E{pqb, 2048};
            pg8::gemm_phase<pg8::EpiBf16P, pg8::StaticOrder>(lds, g, S, E, nullptr, tid);
            asm volatile("s_waitcnt vmcnt(0)" ::: "memory"); __syncthreads();
            { WSP(bf16_t, keyb, WS_KEYB) WSP(int, eidx, WS_EIDX) WSP(float, gate, WS_GATE)
              int t4 = tid; asm volatile("" : "+v"(t4));
              route_mfma_phase(pqb, keyb + (size_t)layer * 8 * 2 * 128 * 128, eidx, gate, (char*)lds_raw, S, t4); }
            SEAM(pb + 6);
        }
        if (IN(pb + 8)) {
            PH_TID() WSP(float, ybuf, WS_Y) WSP(float, stats, WS_X1) WSP(bf16_t, x1b, WS_X1B) WSP(int, eidx, WS_EIDX) WSP(float, gate, WS_GATE) WSP(unsigned char, ub, WS_UB) WSP(unsigned char, vb, WS_VB) WSP(float, isu, WS_SU) WSP(float, isv, WS_SV) WSP(float, x2, WS_X2) WSP(bf16_t, x2b, WS_X2B)
            peer_expert_phase(ybuf, stats, a.in[13] + layer * DM, a.in[14] + layer * DM, x1b, eidx, gate, ub + (size_t)layer * 16384 * ROWB, vb + (size_t)layer * 16384 * ROWB, isu + layer * 16384, isv + layer * 16384, a.in[19] + layer * DM, a.in[20] + layer * DM,
                              layer == 0 ? x2 : a.out, layer == 0 ? x2b : (bf16_t*)nullptr, (LDSA float*)lds, bid, G, tid);
            SEAM(pb + 8);
        }
        }

#ifdef PROBE_FP6
    if (bid == 0 && hi == N_PHASES) {
        PH_TID()
        if (tid == 0) {
            v16f_t s0, s1; float xs[32];
#pragma unroll
            for (int i = 0; i < 32; ++i) { const int e = i >> 3, m = i & 7; const float v = e == 0 ? 0.125f * m : (float)(1 << (e - 1)) * (1.0f + 0.125f * m); xs[i] = v; if (i < 16) s0[i] = v; else s1[i - 16] = v; }
            const v6u_t w = __builtin_amdgcn_cvt_scalef32_2xpk16_fp6_f32(s0, s1, 1.0f);
            const v32f_t y = __builtin_amdgcn_cvt_scalef32_pk32_f32_fp6(w, 1.0f);
            const v16u_t zb = __builtin_bit_cast(v16u_t, __builtin_amdgcn_cvt_scalef32_pk32_bf16_fp6(w, 1.0f));
            const v32f_t y2 = __builtin_amdgcn_cvt_scalef32_pk32_f32_fp6(w, 2.0f);
            const v6u_t w2 = __builtin_amdgcn_cvt_scalef32_2xpk16_fp6_f32(s0, s1, 2.0f);
            const v32f_t y3 = __builtin_amdgcn_cvt_scalef32_pk32_f32_fp6(w2, 1.0f);
            bool id32 = true, id16 = true, il32 = true;
#pragma unroll
            for (int i = 0; i < 32; ++i) { id32 = id32 && (y[i] == xs[i]);
                const unsigned d = zb[i >> 1]; const float b = (i & 1) ? bf_hi(d) : bf_lo(d); id16 = id16 && (b == xs[i]);
                const int src = (i & 1) ? 16 + (i >> 1) : (i >> 1); il32 = il32 && (y[i] == xs[src]); }
            int code = 64;
            if (id32) code += 1; if (id16) code += 2; if (il32) code += 4;
            if (y2[9] == 2.0f * y[9]) code += 8;
            if (y3[20] * 2.0f == y[20]) code += 16;
            if (y[1] == xs[1]) code += 32;
            a.out[0] += (float)code;
        }
    }
#endif
#undef IN
}
#ifndef ONE_LAUNCH
#define ONE_LAUNCH 1
#endif
extern "C" void kernel_launch(void* const* d_in, const int* in_sizes, int n_in, void* d_out, int out_size, void* d_ws, size_t ws_size, hipStream_t stream) {
    static int ready = 0;
    if (!ready) {
        if (ws_size < WS_END) { fprintf(stderr, "kernel_launch: workspace too small: %zu < %zu\n", ws_size, (size_t)WS_END); return; }
        if (hipFuncSetAttribute((const void*)mega, hipFuncAttributeMaxDynamicSharedMemorySize, LDS_BYTES) != hipSuccess) { fprintf(stderr, "kernel_launch: hipFuncSetAttribute failed\n"); return; }
        int per_cu = 0;
        if (hipOccupancyMaxActiveBlocksPerMultiprocessor(&per_cu, (const void*)mega, 512, LDS_BYTES) != hipSuccess || per_cu < 1) fprintf(stderr, "kernel_launch: note: occupancy query reports %d blocks per CU\n", per_cu);
        (void)hipGetLastError();
        ready = 1;
    }
    unsigned char* ws = (unsigned char*)d_ws;
    (void)hipMemsetAsync(ws + WS_CTL, 0, CTL_BYTES, stream);
    MK a{}; for (int i = 0; i < 21; ++i) a.in[i] = (const float*)d_in[i];
    a.out = (float*)d_out; a.ws = ws;
#if ONE_LAUNCH
    a.ph_lo = 0; a.ph_hi = N_PHASES;
    hipLaunchKernelGGL(mega, dim3(256), dim3(512), LDS_BYTES, stream, a);
#else
    for (int k = 0; k < N_PHASES; ++k) { if (k == 10 || k == 2 || k == 12 || k == 14 || k == 8 || k == 18) continue; a.ph_lo = k; a.ph_hi = k + 1; hipLaunchKernelGGL(mega, dim3(256), dim3(512), LDS_BYTES, stream, a); }
#endif
    const hipError_t le = hipPeekAtLastError();
    if (le != hipSuccess) fprintf(stderr, "kernel_launch: launch failed: %s\n", hipGetErrorName(le));
}
```

```cpp
#include <hip/hip_runtime.h>
#include <stdint.h>
#include <cstdio>

#define SEQ 8192
#define DM 4096
#define HD 128
#define ALPHA 1.4142135623730951f
#define LAMBDA_INIT 0.35550906759096934f
#define ATT_SCALE 0.088388347648318440f

__device__ const double REV_P[16] = {0.15915494309189535, 0.0700865215877985, 0.03086376340470123, 0.013591370636193905, 0.005985185712713705, 0.002635675898667414, 0.001160663641240061, 0.0005111175045375439, 0.00022507907903927653, 9.911730936901935e-05, 4.364795279280289e-05, 1.9221100684944863e-05, 8.464330808241401e-06, 3.727408601915352e-06, 1.6414262627950345e-06, 7.228293068832865e-07};
__device__ const double REV_A[32] = {0.15915494309189535, 0.11934937021124886, 0.08949940160889101, 0.06711508300522726, 0.050329212104487035, 0.03774158471741977, 0.0283021958306234, 0.02122365276477766, 0.015915494309189534, 0.011934937021124886, 0.008949940160889102, 0.006711508300522725, 0.005032921210448704, 0.003774158471741977, 0.00283021958306234, 0.0021223652764777662, 0.0015915494309189536, 0.0011934937021124885, 0.0008949940160889102, 0.0006711508300522726, 0.0005032921210448703, 0.00037741584717419774, 0.00028302195830623395, 0.0002122365276477766, 0.00015915494309189535, 0.00011934937021124886, 8.949940160889102e-05, 6.711508300522725e-05, 5.0329212104487035e-05, 3.774158471741978e-05, 2.8302195830623396e-05, 2.122365276477766e-05};

__device__ __forceinline__ void sincos_rev(double rev, float& s, float& c) {
    const double f = rev - floor(rev); const float ff = (float)f;
    s = __builtin_amdgcn_sinf(ff); c = __builtin_amdgcn_cosf(ff);
}
__device__ __forceinline__ float wave_sum(float v) {
#pragma unroll
    for (int o = 32; o >= 1; o >>= 1) v += __shfl_xor(v, o);
    return v;
}
__device__ __forceinline__ float wave_max(float v) {
#pragma unroll
    for (int o = 32; o >= 1; o >>= 1) v = fmaxf(v, __shfl_xor(v, o));
    return v;
}
namespace pg8 {
#define PG8_LAS __attribute__((address_space(3)))
typedef unsigned short bf16_t;
typedef short bf16x8 __attribute__((ext_vector_type(8)));
typedef float f32x4 __attribute__((ext_vector_type(4)));
typedef unsigned u32x4 __attribute__((ext_vector_type(4)));
constexpr int BM = 256, BK = 64, HALF = 128, HTB = HALF * BK * 2  , STAGE_BYTES = 8 * HTB, NXCD = 8, WGM = 8;

__host__ __device__ __forceinline__ int lds_byte(int r, int c) { const int st = (r >> 4) * 2 + (c >> 5), rr = r & 15, cc = c & 31, ob = rr * 64 + cc * 2; return st * 1024 + (ob ^ (((ob >> 9) & 1) << 5)); }
__host__ __device__ __forceinline__ void stage_rc(int b, int& R, int& C) { const int st = b / 1024, sb = b % 1024, swz = sb ^ (((sb >> 9) & 1) << 5); R = (st >> 1) * 16 + swz / 64; C = (st & 1) * 32 + (swz % 64) / 2; }
__host__ __device__ __forceinline__ int perm32(int rho) { const int n = rho >> 4, i = rho & 15; return 8 * (i >> 2) + 4 * n + (i & 3); }

struct Unit { int pm, pn; };
struct Gemm { const bf16_t* A; const bf16_t* Bt; int M, N, K; };

struct StaticOrder {
    int nM, nN, nwg, G, c;
    __host__ __device__ void init(int M, int N, int G_, int c_) { nM = M / BM; nN = N / BM; nwg = nM * nN; G = G_; c = c_; }
    __host__ __device__ bool next(int i, Unit& u) const {
        const long L = (long)i * G + c; if (L >= nwg) return false;
        int wgid = (int)L; { const int q = nwg / NXCD, r = nwg % NXCD, xcd = wgid % NXCD, off = wgid / NXCD; wgid = (xcd < r ? xcd * (q + 1) : r * (q + 1) + (xcd - r) * q) + off; }
        const int nig = WGM * nN, gid = wgid / nig, fm = gid * WGM, gsz = (nM - fm) < WGM ? (nM - fm) : WGM;
        u.pm = fm + ((wgid % nig) % gsz); u.pn = (wgid % nig) / gsz; return true;
    }
    __device__ __forceinline__ void a_ready(const Unit&) const {}
    __device__ __forceinline__ void done(const Unit&) const {}
};
__device__ __forceinline__ unsigned cvt_pk_bf16(float lo, float hi) { unsigned r; asm volatile("v_cvt_pk_bf16_f32 %0, %1, %2" : "=v"(r) : "v"(lo), "v"(hi)); return r; }
typedef float f32x2 __attribute__((ext_vector_type(2)));
template <class Epi, class Sched, bool STAMP = false>
__device__ __forceinline__ void gemm_phase(PG8_LAS unsigned char* lds, const Gemm g, const Sched& S, const Epi& E, unsigned long long* stamps, const int tid_in) {
    const int tid = tid_in, wid = __builtin_amdgcn_readfirstlane(tid >> 6), lane = tid & 63, wr = wid >> 2, wc = wid & 3, fr = lane & 15, fq = lane >> 4;
    const int K = g.K, nt = K / BK;
    int ts_lo = 0, ts_hi = 0, nts = 0; const unsigned long long rt_entry = STAMP ? (unsigned long long)wall_clock64() : 0ull;
#define PG8_STAMP() do { if (STAMP && wid == 0 && nts < 64) { const unsigned long long _c = (unsigned long long)clock64(); \
        ts_lo = (lane == nts) ? (int)(unsigned)_c : ts_lo; ts_hi = (lane == nts) ? (int)(unsigned)(_c >> 32) : ts_hi; ++nts; } } while (0)
    PG8_STAMP();
    unsigned voffA[2], voffB[2];
#pragma unroll
    for (int i = 0; i < 2; ++i) { int R, C; stage_rc(tid * 16 + i * 8192, R, C); const int Rb = Epi::PERM ? ((R & ~31) + perm32(R & 31)) : R;
        voffA[i] = (unsigned)(R * K + C) * 2u; voffB[i] = (unsigned)(Rb * K + C) * 2u; }
    const size_t kstep = (size_t)(BK * 2);
    const size_t hstep = (size_t)HALF * K * 2;
    const size_t tstep = 2 * hstep;
    const unsigned ldsw = (unsigned)wid * 1024u;
    const int aoff = lds_byte(wr * 64 + fr, fq * 8), boff = lds_byte(wc * 32 + fr, fq * 8);
#define PG8_SA(b, h) (((b) * 2 + (h)) * HTB)
#define PG8_SB(b, h) ((4 + (b) * 2 + (h)) * HTB)
#define PG8_STAGE(bufoff, gbase, voff) do { _Pragma("unroll") for (int _i = 0; _i < 2; ++_i) \
        __builtin_amdgcn_global_load_lds((const unsigned*)((const char*)(gbase) + (voff)[_i]), (PG8_LAS unsigned*)(lds + (bufoff) + ldsw + _i * 8192), 16, 0, 0); } while (0)
#define PG8_LDA(dst, b, h) do { _Pragma("unroll") for (int m = 0; m < 4; ++m) _Pragma("unroll") for (int k = 0; k < 2; ++k) dst[m][k] = *(const PG8_LAS bf16x8*)(lds + PG8_SA(b, h) + aoff + m * 2048 + k * 1024); } while (0)
#define PG8_LDB(dst, b, h) do { _Pragma("unroll") for (int n = 0; n < 2; ++n) _Pragma("unroll") for (int k = 0; k < 2; ++k) dst[n][k] = *(const PG8_LAS bf16x8*)(lds + PG8_SB(b, h) + boff + n * 2048 + k * 1024); } while (0)
#define PG8_MMA(ai, bj, At, Bt) do { __builtin_amdgcn_s_setprio(1); _Pragma("unroll") for (int m = 0; m < 4; ++m) _Pragma("unroll") for (int n = 0; n < 2; ++n) _Pragma("unroll") for (int k = 0; k < 2; ++k) \
        acc[ai][bj][m][n] = __builtin_amdgcn_mfma_f32_16x16x32_bf16(Bt[n][k], At[m][k], acc[ai][bj][m][n], 0, 0, 0); __builtin_amdgcn_s_setprio(0); } while (0)
#define PG8_WAIT_V(n) asm volatile("s_waitcnt vmcnt(" #n ")" ::: "memory")
#define PG8_WAIT_L(n) asm volatile("s_waitcnt lgkmcnt(" #n ")" ::: "memory")
#define PG8_BAR __builtin_amdgcn_s_barrier()
#define PG8_SCHED __builtin_amdgcn_sched_barrier(0)
    Unit cur, nxt; int ui = 0;
    if (!S.next(0, cur)) return;
    f32x4 acc[2][2][4][2];
#pragma unroll
    for (int a = 0; a < 2; ++a)
#pragma unroll
        for (int b = 0; b < 2; ++b)
#pragma unroll
            for (int m = 0; m < 4; ++m)
#pragma unroll
                for (int n = 0; n < 2; ++n) acc[a][b][m][n] = (f32x4){0.f, 0.f, 0.f, 0.f};
    bf16x8 At[4][2], B0[2][2], B1[2][2];
    const char* cA = (const char*)g.A + (size_t)cur.pm * tstep; const char* cB = (const char*)g.Bt + (size_t)cur.pn * tstep;
    S.a_ready(cur);
    PG8_STAGE(PG8_SB(0, 0), cB, voffB); PG8_STAGE(PG8_SA(0, 0), cA, voffA); PG8_STAGE(PG8_SB(0, 1), cB + hstep, voffB); PG8_STAGE(PG8_SA(0, 1), cA + hstep, voffA);
    if (wr == 1) PG8_BAR;
    PG8_WAIT_V(4); PG8_BAR;
    PG8_STAGE(PG8_SB(1, 0), cB + kstep, voffB); PG8_STAGE(PG8_SA(1, 0), cA + kstep, voffA); PG8_STAGE(PG8_SB(1, 1), cB + hstep + kstep, voffB);
    PG8_WAIT_V(6); PG8_BAR;
    PG8_STAMP();
    for (;;) {
        const bool has_next = S.next(ui + 1, nxt);
        const char* nA = has_next ? (const char*)g.A + (size_t)nxt.pm * tstep : cA; const char* nB = has_next ? (const char*)g.Bt + (size_t)nxt.pn * tstep : cB;
        for (int t = 0; t < nt; t += 2) {
            const bool last = (t == nt - 2);
            const char* a1 = cA + (size_t)(t + 1) * kstep;
            const char* a2 = last ? nA : cA + (size_t)(t + 2) * kstep; const char* b2 = last ? nB : cB + (size_t)(t + 2) * kstep;
            const char* a3 = a2 + kstep; const char* b3 = b2 + kstep;
            if (last && has_next) S.a_ready(nxt);
            PG8_LDB(B0, 0, 0); PG8_SCHED; PG8_LDA(At, 0, 0); PG8_STAGE(PG8_SA(1, 1), a1 + hstep, voffA);
            PG8_WAIT_L(8); PG8_BAR; PG8_WAIT_L(0); PG8_MMA(0, 0, At, B0); PG8_BAR; PG8_SCHED;
            PG8_LDB(B1, 0, 1); PG8_STAGE(PG8_SB(0, 0), b2, voffB);
            PG8_BAR; PG8_WAIT_L(0); PG8_MMA(0, 1, At, B1); PG8_BAR;
            PG8_LDA(At, 0, 1); PG8_STAGE(PG8_SA(0, 0), a2, voffA);
            PG8_BAR; PG8_WAIT_L(0); PG8_MMA(1, 0, At, B0); PG8_BAR; PG8_SCHED;
            PG8_STAGE(PG8_SB(0, 1), b2 + hstep, voffB);
            PG8_WAIT_V(6); PG8_BAR; PG8_MMA(1, 1, At, B1); PG8_BAR;
            PG8_LDB(B0, 1, 0); PG8_SCHED; PG8_LDA(At, 1, 0); PG8_STAGE(PG8_SA(0, 1), a2 + hstep, voffA);
            PG8_WAIT_L(8); PG8_BAR; PG8_WAIT_L(0); PG8_MMA(0, 0, At, B0); PG8_BAR; PG8_SCHED;
            PG8_LDB(B1, 1, 1); PG8_STAGE(PG8_SB(1, 0), b3, voffB);
            PG8_BAR; PG8_WAIT_L(0); PG8_MMA(0, 1, At, B1); PG8_BAR;
            PG8_LDA(At, 1, 1); PG8_STAGE(PG8_SA(1, 0), a3, voffA);
            PG8_BAR; PG8_WAIT_L(0); PG8_MMA(1, 0, At, B0); PG8_BAR; PG8_SCHED;
            PG8_STAGE(PG8_SB(1, 1), b3 + hstep, voffB);
            PG8_WAIT_V(6); PG8_BAR; PG8_MMA(1, 1, At, B1); PG8_BAR;
        }
        PG8_STAMP();
        if constexpr (!Epi::AFTER_DRAIN) { E(acc, cur, wr, wc, fr, fq); S.done(cur); }
        PG8_STAMP();
        if (!has_next) break;
#pragma unroll
        for (int a = 0; a < 2; ++a)
#pragma unroll
            for (int b = 0; b < 2; ++b)
#pragma unroll
                for (int m = 0; m < 4; ++m)
#pragma unroll
                    for (int n = 0; n < 2; ++n) acc[a][b][m][n] = (f32x4){0.f, 0.f, 0.f, 0.f};
        cur = nxt; cA = nA; cB = nB; ++ui;
    }
    PG8_WAIT_V(0);
    if (wr == 0) PG8_BAR;
    PG8_BAR;
    if constexpr (Epi::AFTER_DRAIN) { E.fused(acc, cur, wr, wc, fr, fq, lds, wid, lane); S.done(cur); }
    PG8_STAMP();
    if (STAMP && wid == 0) { stamps[lane] = lane < nts ? (((unsigned long long)(unsigned)ts_hi << 32) | (unsigned)ts_lo) : 0ull;
        if (lane == 62) stamps[62] = rt_entry; if (lane == 63) stamps[63] = (unsigned long long)wall_clock64(); }
#undef PG8_STAMP
#undef PG8_SA
#undef PG8_SB
#undef PG8_STAGE
#undef PG8_LDA
#undef PG8_LDB
#undef PG8_MMA
#undef PG8_WAIT_V
#undef PG8_WAIT_L
#undef PG8_BAR
#undef PG8_SCHED
}
}
#define XB_TMO      128
#define XB_XCNT(j)  (256  + 64 * (j))
#define XB_XSUB(j)  (1280 + 64 * (j))
#define XB_XGEN(j)  (2304 + 64 * (j))
#define XB_TOP      3328
#define XB_TOPGEN   3392
#define XCD_BAR_WORDS 3456
#define XB_SPIN_CAP (1u << 22)
#define LAS __attribute__((address_space(3)))

__device__ __forceinline__ unsigned xb_ld(unsigned* p)              { return __hip_atomic_load(p, __ATOMIC_RELAXED, __HIP_MEMORY_SCOPE_AGENT); }
__device__ __forceinline__ unsigned xb_add(unsigned* p, unsigned v) { return __hip_atomic_fetch_add(p, v, __ATOMIC_RELAXED, __HIP_MEMORY_SCOPE_AGENT); }
__device__ __forceinline__ unsigned xb_xcc_id() { return (unsigned)__builtin_amdgcn_s_getreg((3 << 11) | 20) & 0xFu; }
#define XB_SPIN(cond, bar) do { unsigned _sp = 0; while (cond) { __builtin_amdgcn_s_sleep(1); \
    if ((++_sp & 255u) == 0u) { if (xb_ld(&(bar)[XB_TMO])) break; if (_sp > XB_SPIN_CAP) { atomicAdd(&(bar)[XB_TMO], 1u); break; } } } } while (0)

struct XcdBarrier {
    unsigned* bar; unsigned x;
    volatile LAS unsigned* st;
};

__device__ __forceinline__ XcdBarrier xcd_barrier_post(unsigned* bar, volatile LAS unsigned* st, const int tid) {
    XcdBarrier b; b.bar = bar; b.x = xb_xcc_id(); b.st = st;
    if (tid == 0) (void)xb_add(&bar[XB_XCNT(b.x)], 1u);
    return b;
}
__device__ __forceinline__ void xcd_barrier_complete(unsigned* bar, unsigned x, unsigned& nloc, unsigned& nx) {
    const unsigned G = gridDim.x * gridDim.y * gridDim.z;
    unsigned sum, cnt, mine, sp = 0u;
    for (;;) {
        sum = 0u; cnt = 0u; mine = 0u;
#pragma unroll
        for (unsigned j = 0; j < 16; ++j) { const unsigned c = xb_ld(&bar[XB_XCNT(j)]); sum += c; cnt += (c > 0u) ? 1u : 0u; mine = (j == x) ? c : mine; }
        if (sum == G) break;
        __builtin_amdgcn_s_sleep(1);
        if ((++sp & 255u) == 0u) { if (xb_ld(&bar[XB_TMO])) break; if (sp > XB_SPIN_CAP) { atomicAdd(&bar[XB_TMO], 1u); break; } }
    }
    nloc = mine > 0u ? mine : 1u; nx = cnt > 0u ? cnt : 1u;
}

__device__ __forceinline__ void xcd_barrier(const XcdBarrier& b, const int tid) {
    asm volatile("s_waitcnt vmcnt(0)" ::: "memory");
    __syncthreads();
    if (tid == 0) {
        unsigned* bar = b.bar;
        __builtin_amdgcn_s_waitcnt(0);
        unsigned nloc = b.st[0], nx = b.st[1];
        if (nloc == 0u) { xcd_barrier_complete(bar, b.x, nloc, nx); b.st[0] = nloc; b.st[1] = nx; }
        const unsigned old = xb_add(&bar[XB_XSUB(b.x)], 1u);
        const unsigned gen = old / nloc;
        if (old + 1u == (gen + 1u) * nloc) {
            __builtin_amdgcn_fence(__ATOMIC_RELEASE, "agent");
            asm volatile("s_waitcnt vmcnt(0)" ::: "memory");
            const unsigned og = xb_add(&bar[XB_TOP], 1u);
            const unsigned tg = og / nx;
            if (og + 1u == (tg + 1u) * nx) xb_add(&bar[XB_TOPGEN], 1u);
            else XB_SPIN(xb_ld(&bar[XB_TOPGEN]) == tg, bar);
            __builtin_amdgcn_fence(__ATOMIC_ACQUIRE, "agent");
            xb_add(&bar[XB_XGEN(b.x)], 1u);
            asm volatile("s_waitcnt vmcnt(0)" ::: "memory");
        } else {
            XB_SPIN(xb_ld(&bar[XB_XGEN(b.x)]) == gen, bar);
            __builtin_amdgcn_fence(__ATOMIC_ACQUIRE, "agent");
            asm volatile("s_waitcnt vmcnt(0)" ::: "memory");
        }
    }
    __syncthreads();
}
namespace att {
using bf16 = unsigned short;
constexpr int   D = 128, NW = 8, QBLK = 32, KVBLK = 64;
constexpr float SCALE = 0.088388347648318440f;
constexpr float THR = 8.f;
constexpr int SDEPTH = 1;
constexpr size_t SHM_V = KVBLK * D * 2, SHM_K = KVBLK * D * 2, SHM_ATTN = 2 * SHM_V + 2 * SHM_K + NW * 64 * 4;
using bf16x8 = __attribute__((ext_vector_type(8))) short;
using s16x4  = __attribute__((ext_vector_type(4))) short;
using f32x16 = __attribute__((ext_vector_type(16))) float;
using f32x8  = __attribute__((ext_vector_type(8))) float;
using u32x4  = __attribute__((ext_vector_type(4))) unsigned;
#define KSWZ(row, colB) ((row) * 256 + ((colB) ^ (((row) & 7) << 4)))
#define SBAR() __builtin_amdgcn_sched_barrier(0)
__device__ __forceinline__ int crow(int r, int hi) { return (r & 3) + 8 * (r >> 2) + 4 * hi; }
__device__ __forceinline__ unsigned cvtpk(float lo, float hi) {
  unsigned r; asm volatile("v_cvt_pk_bf16_f32 %0, %1, %2" : "=v"(r) : "v"(lo), "v"(hi)); return r;
}
template <typename TIn> struct Stage;
template <> struct Stage<bf16>  { using T = bf16x8;
  __device__ static __forceinline__ T ld8(const bf16* p) { return *reinterpret_cast<const bf16x8*>(p); }
  __device__ static __forceinline__ bf16x8 tobf(T x) { return x; } };
template <> struct Stage<float> { using T = f32x8;
  __device__ static __forceinline__ T ld8(const float* p) { return *reinterpret_cast<const f32x8*>(p); }
  __device__ static __forceinline__ bf16x8 tobf(T x) {
    u32x4 w = {cvtpk(x[0], x[1]), cvtpk(x[2], x[3]), cvtpk(x[4], x[5]), cvtpk(x[6], x[7])}; return *reinterpret_cast<bf16x8*>(&w); } };

__device__ __forceinline__ void partialSM(f32x16& p0, f32x16& p1, float& m_reg, float& mn, float& alpha) {
  constexpr float C = SCALE * 1.4426950408889634f;
  float pmax = p0[0]; for (int r = 1; r < 16; ++r) pmax = fmaxf(pmax, p0[r]); for (int r = 0; r < 16; ++r) pmax = fmaxf(pmax, p1[r]);
  { auto rr = __builtin_amdgcn_permlane32_swap(__float_as_uint(pmax), __float_as_uint(pmax), false, false);
    pmax = fmaxf(__uint_as_float(rr[0]), __uint_as_float(rr[1])); }
  if (__builtin_expect(__all(pmax - m_reg <= THR / SCALE), 1)) { mn = m_reg; alpha = 1.f; }
  else { mn = fmaxf(m_reg, pmax); alpha = __builtin_amdgcn_exp2f((m_reg - mn) * C); m_reg = mn; }
  float mnC = -mn * C;
  for (int r = 0; r < 16; ++r) p0[r] = fmaf(p0[r], C, mnC); for (int r = 0; r < 16; ++r) p1[r] = fmaf(p1[r], C, mnC);
  for (int r = 0; r < 16; ++r) p0[r] = __builtin_amdgcn_exp2f(p0[r]);
}
__device__ __forceinline__ void finishSM(f32x16& p0, f32x16& p1, float alpha, float& l_reg, bf16x8& pa0, bf16x8& pa1, bf16x8& pa2, bf16x8& pa3) {
  for (int r = 0; r < 16; ++r) p1[r] = __builtin_amdgcn_exp2f(p1[r]);
  float ps = 0; for (int r = 0; r < 16; ++r) ps += p0[r]; for (int r = 0; r < 16; ++r) ps += p1[r];
  { auto rr = __builtin_amdgcn_permlane32_swap(__float_as_uint(ps), __float_as_uint(ps), false, false);
    ps = __uint_as_float(rr[0]) + __uint_as_float(rr[1]); }
  l_reg = l_reg * alpha + ps;
#define PK4(P, BASE, OUT) do { unsigned a0 = cvtpk(P[BASE + 0], P[BASE + 1]), a1 = cvtpk(P[BASE + 2], P[BASE + 3]);   \
    unsigned b0 = cvtpk(P[BASE + 4], P[BASE + 5]), b1 = cvtpk(P[BASE + 6], P[BASE + 7]);                              \
    auto r0 = __builtin_amdgcn_permlane32_swap(a0, b0, false, false); auto r1 = __builtin_amdgcn_permlane32_swap(a1, b1, false, false); \
    u32x4 w = {r0[0], r1[0], r0[1], r1[1]}; OUT = *reinterpret_cast<bf16x8*>(&w); } while (0)
  PK4(p0, 0, pa0); PK4(p0, 8, pa1); PK4(p1, 0, pa2); PK4(p1, 8, pa3);
#undef PK4
}
__device__ __forceinline__ void qkt(f32x16& p0, f32x16& p1, const bf16* Ks, const bf16x8* qr, int r32, int hi) {
  p0 = f32x16{}; p1 = f32x16{};
  for (int d0 = 0; d0 < 8; ++d0) { int cb = (d0 * 16 + hi * 8) * 2;
    bf16x8 b0 = *reinterpret_cast<const bf16x8*>((const char*)Ks + KSWZ(r32, cb));
    bf16x8 b1 = *reinterpret_cast<const bf16x8*>((const char*)Ks + KSWZ(32 + r32, cb));
    p0 = __builtin_amdgcn_mfma_f32_32x32x16_bf16(b0, qr[d0], p0, 0, 0, 0);
    p1 = __builtin_amdgcn_mfma_f32_32x32x16_bf16(b1, qr[d0], p1, 0, 0, 0); }
}
__device__ __forceinline__ int v_st(int k, int c) { const int kk = (k & ~0xC) | ((k & 4) << 1) | ((k & 8) >> 1); return ((kk >> 3) * 4 + (c >> 5)) * 512 + ((kk & 7) * 32 + (c & 31)) * 2; }
__device__ __forceinline__ int v_rd_base(int lane) { return ((lane & 3) << 3) | (((lane >> 2) & 3) << 6) | (((lane >> 4) & 1) << 5) | (((lane >> 5) & 1) << 8); }
constexpr int v_rd_off(int d0, int ks, int half) { return d0 * 512 + ks * 4096 + half * 2048; }
template <int OFF> __device__ __forceinline__ s16x4 tr_read(int vb) {
  s16x4 r; asm volatile("ds_read_b64_tr_b16 %0, %1 offset:%2" : "=&v"(r) : "v"(vb), "i"(OFF) : "memory"); return r;
}
template <int D0> __device__ __forceinline__ void pv_one(f32x16& od, int vb, bf16x8 pa0, bf16x8 pa1, bf16x8 pa2, bf16x8 pa3) {
  const s16x4 l0 = tr_read<v_rd_off(D0, 0, 0)>(vb), h0 = tr_read<v_rd_off(D0, 0, 1)>(vb), l1 = tr_read<v_rd_off(D0, 1, 0)>(vb), h1 = tr_read<v_rd_off(D0, 1, 1)>(vb);
  const s16x4 l2 = tr_read<v_rd_off(D0, 2, 0)>(vb), h2 = tr_read<v_rd_off(D0, 2, 1)>(vb), l3 = tr_read<v_rd_off(D0, 3, 0)>(vb), h3 = tr_read<v_rd_off(D0, 3, 1)>(vb);
  asm volatile("s_waitcnt lgkmcnt(0)" ::: "memory"); SBAR();
#define PK(L, H) (bf16x8){L[0], L[1], L[2], L[3], H[0], H[1], H[2], H[3]}
  od = __builtin_amdgcn_mfma_f32_32x32x16_bf16(pa0, PK(l0, h0), od, 0, 0, 0);
  od = __builtin_amdgcn_mfma_f32_32x32x16_bf16(pa1, PK(l1, h1), od, 0, 0, 0);
  od = __builtin_amdgcn_mfma_f32_32x32x16_bf16(pa2, PK(l2, h2), od, 0, 0, 0);
  od = __builtin_amdgcn_mfma_f32_32x32x16_bf16(pa3, PK(l3, h3), od, 0, 0, 0);
#undef PK
}
__device__ __forceinline__ void pv_d0(f32x16* o, int vb, bf16x8 pa0, bf16x8 pa1, bf16x8 pa2, bf16x8 pa3) {
  pv_one<0>(o[0], vb, pa0, pa1, pa2, pa3); pv_one<1>(o[1], vb, pa0, pa1, pa2, pa3); pv_one<2>(o[2], vb, pa0, pa1, pa2, pa3); pv_one<3>(o[3], vb, pa0, pa1, pa2, pa3);
}

template <typename TQ, int LDQ, int LDK, int LDO, typename TO>
__device__ __forceinline__ void attn_dense_body(const TQ* __restrict__ Qb, const bf16* __restrict__ Kh, const bf16* __restrict__ Vh,
                                                TO* __restrict__ Ob, int seq, char* lds, const int tid_in) {
  using St = Stage<bf16>; using SQ = Stage<TQ>;
  const int tid = tid_in, wid = tid >> 6, lane = tid & 63, r32 = lane & 31, hi = lane >> 5;
  bf16* V_lds = (bf16*)lds; bf16* K_lds = (bf16*)(lds + 2 * SHM_V);
  float* ws = (float*)(lds + 2 * SHM_V + 2 * SHM_K) + wid * 64; float* li_l = ws; float* al_l = ws + 32;
  float m_reg = -1e30f, l_reg = 0; f32x16 o[4] = {}; bf16x8 qr[8];
  const TQ* Qw = Qb + ((wid * QBLK + r32) * LDQ + hi * 8);
#pragma unroll
  for (int d0 = 0; d0 < 8; ++d0) qr[d0] = SQ::tobf(SQ::ld8(Qw + d0 * 16));
  const int sr = tid >> 4, sc = (tid & 15) * 8, vst0 = v_st(sr, sc), vst1 = v_st(32 + sr, sc);
  const int vb0 = (int)(uintptr_t)V_lds + v_rd_base(lane);
  struct { typename St::T vs0, vs1, ks0, ks1; } sr_[SDEPTH];
#define SLOAD(i, k0) do { sr_[i].vs0 = St::ld8(Vh + (((k0) + sr) * LDK + sc)); sr_[i].vs1 = St::ld8(Vh + (((k0) + 32 + sr) * LDK + sc)); \
    sr_[i].ks0 = St::ld8(Kh + (((k0) + sr) * LDK + sc)); sr_[i].ks1 = St::ld8(Kh + (((k0) + 32 + sr) * LDK + sc)); } while (0)
#define SWRITE(b, i) do { *(bf16x8*)((char*)V_lds + (b) * SHM_V + vst0) = St::tobf(sr_[i].vs0);          \
    *(bf16x8*)((char*)V_lds + (b) * SHM_V + vst1) = St::tobf(sr_[i].vs1); int kc = sc * 2;               \
    *(bf16x8*)((char*)K_lds + (b) * SHM_K + KSWZ(sr, kc)) = St::tobf(sr_[i].ks0);                       \
    *(bf16x8*)((char*)K_lds + (b) * SHM_K + KSWZ(32 + sr, kc)) = St::tobf(sr_[i].ks1); } while (0)
#define SWAIT() do { if constexpr (SDEPTH == 2) asm volatile("s_waitcnt vmcnt(4)" ::: "memory"); else asm volatile("s_waitcnt vmcnt(0)" ::: "memory"); } while (0)
#define RESC(a) do { if (__any((a) < 1.f)) { if (hi == 0) al_l[r32] = (a); asm volatile("s_waitcnt lgkmcnt(0)" ::: "memory"); \
    for (int d = 0; d < 4; ++d) for (int r = 0; r < 16; ++r) o[d][r] *= al_l[crow(r, hi)]; } } while (0)
  f32x16 pA0, pA1, pB0, pB1; float mnA, mnB, alA, alB; bf16x8 pa0, pa1, pa2, pa3; const int NT = seq / KVBLK;
  constexpr int SE = 0, SO = SDEPTH - 1;
  SLOAD(SE, 0); asm volatile("s_waitcnt vmcnt(0)" ::: "memory"); SWRITE(0, SE); __syncthreads();
  qkt(pA0, pA1, K_lds, qr, r32, hi); partialSM(pA0, pA1, m_reg, mnA, alA);
  SLOAD(SO, KVBLK); if constexpr (SDEPTH == 2) { if (2 < NT) SLOAD(SE, 2 * KVBLK); }
  SWAIT(); SWRITE(1, SO); __syncthreads();
  for (int j = 1; j + 1 < NT; j += 2) {
    SBAR(); qkt(pB0, pB1, (bf16*)((char*)K_lds + SHM_K), qr, r32, hi);
    finishSM(pA0, pA1, alA, l_reg, pa0, pa1, pa2, pa3); SBAR();
    SLOAD(SO, (j + SDEPTH) * KVBLK); SBAR();
    pv_d0(o, vb0, pa0, pa1, pa2, pa3); partialSM(pB0, pB1, m_reg, mnB, alB);
    __syncthreads(); SWAIT(); SWRITE(0, SE);
    RESC(alB); __syncthreads();
    SBAR(); qkt(pA0, pA1, K_lds, qr, r32, hi);
    finishSM(pB0, pB1, alB, l_reg, pa0, pa1, pa2, pa3); SBAR();
    if (SDEPTH == 1 || j + 3 < NT) SLOAD(SE, (j + 1 + SDEPTH) * KVBLK); SBAR();
    pv_d0(o, vb0 + (int)SHM_V, pa0, pa1, pa2, pa3); partialSM(pA0, pA1, m_reg, mnA, alA);
    __syncthreads(); SWAIT(); SWRITE(1, SO);
    RESC(alA); __syncthreads();
  }
  SBAR(); qkt(pB0, pB1, (bf16*)((char*)K_lds + SHM_K), qr, r32, hi);
  finishSM(pA0, pA1, alA, l_reg, pa0, pa1, pa2, pa3); SBAR();
  pv_d0(o, vb0, pa0, pa1, pa2, pa3); partialSM(pB0, pB1, m_reg, mnB, alB);
  __syncthreads(); RESC(alB);
  finishSM(pB0, pB1, alB, l_reg, pa0, pa1, pa2, pa3); SBAR();
  pv_d0(o, vb0 + (int)SHM_V, pa0, pa1, pa2, pa3);
  if (hi == 0) li_l[r32] = l_reg; asm volatile("s_waitcnt lgkmcnt(0)" ::: "memory");
  float rli[16];
#pragma unroll
  for (int r = 0; r < 16; ++r) rli[r] = __builtin_amdgcn_rcpf(li_l[crow(r, hi)]);
  TO* Ow = Ob + (wid * QBLK) * LDO;
#pragma unroll
  for (int r = 0; r < 16; ++r) { int orow = crow(r, hi);
    for (int d0 = 0; d0 < 4; ++d0) { const float val = o[d0][r] * rli[r];
      if constexpr (sizeof(TO) == 4) Ow[orow * LDO + d0 * 32 + r32] = val;
      else Ow[orow * LDO + d0 * 32 + r32] = (TO)(cvtpk(val, val) & 0xffffu); } }
#undef SLOAD
#undef SWRITE
#undef SWAIT
#undef RESC
}

template <int WIN>
__device__ __forceinline__ void attn_banded_body(const bf16* __restrict__ Qp, const bf16* __restrict__ Kp, const bf16* __restrict__ Vp, const long rs, const int Lseq, const int P0,
                                                 const float m_init, const float l_init, bf16* __restrict__ Ob, const long os, float* __restrict__ Lp, const long ls, char* lds, const int tid) {
  const int wid = __builtin_amdgcn_readfirstlane(tid >> 6), lane = tid & 63, r32 = lane & 31, hi = lane >> 5;
  constexpr int BT = 32768;
  float* wsf = (float*)(lds + 2 * BT) + wid * 64; float* li_l = wsf; float* al_l = wsf + 32;
  float m_reg = m_init, l_reg = l_init; f32x16 o[4] = {}; bf16x8 qr[8];
  const bf16* Qw = Qp + (long)(P0 + wid * QBLK + r32) * rs + hi * 8;
#pragma unroll
  for (int d0 = 0; d0 < 8; ++d0) qr[d0] = *reinterpret_cast<const bf16x8*>(Qw + d0 * 16);
  const int irs = (int)rs;
  int ksrc[2], vsrc[2];
#pragma unroll
  for (int i = 0; i < 2; ++i) { const int c = 2 * wid + i, row = 4 * c + (lane >> 4), colB = (16 * (lane & 15)) ^ ((row & 7) << 4); ksrc[i] = row * irs + (colB >> 1);
      const int sub = 2 * c + (lane >> 5), kk = ((sub >> 2) << 3) | ((lane & 31) >> 2), k = (kk & ~0xC) | ((kk & 4) << 1) | ((kk & 8) >> 1), col = (sub & 3) * 32 + 8 * (lane & 3); vsrc[i] = k * irs + col; }
  using LP = __attribute__((address_space(3))) unsigned*;
#define BB_DMA(buf, tb) do { const bf16* _kb = Kp + (long)(tb) * rs; const bf16* _vb = Vp + (long)(tb) * rs; char* _l = lds + (buf) * BT; \
    _Pragma("unroll") for (int _i = 0; _i < 2; ++_i) { __builtin_amdgcn_global_load_lds((const unsigned*)(_kb + ksrc[_i]), (LP)(_l + (2 * wid + _i) * 1024), 16, 0, 0); \
                                                       __builtin_amdgcn_global_load_lds((const unsigned*)(_vb + vsrc[_i]), (LP)(_l + 16384 + (2 * wid + _i) * 1024), 16, 0, 0); } } while (0)
  constexpr int NT = (256 + 2 * WIN) / 64, NTW = (2 * WIN + 32 + 63) / 64;
  const int klo = wid >> 1, qpos = P0 + wid * QBLK + r32;
  int kf = 0; while (P0 - WIN + 64 * kf < 0) ++kf;
  int kl = NT - 1; while (P0 - WIN + 64 * kl >= Lseq) --kl;
  BB_DMA(kf & 1, P0 - WIN + 64 * kf);
  for (int k = kf; k <= kl; ++k) {
    const int tb = P0 - WIN + 64 * k;
    asm volatile("s_waitcnt vmcnt(0)" ::: "memory");
    __builtin_amdgcn_s_barrier();
    asm volatile("" ::: "memory");
    if (k < kl) BB_DMA((k + 1) & 1, tb + 64);
    char* tbuf = lds + (k & 1) * BT;
    if (k >= klo && k < klo + NTW) {
      f32x16 p0, p1; float mn, al; bf16x8 pa0, pa1, pa2, pa3;
      qkt(p0, p1, (const bf16*)tbuf, qr, r32, hi);
      if (k == klo || k == klo + NTW - 1) {
#pragma unroll
        for (int r = 0; r < 16; ++r) { const int d = qpos - (tb + crow(r, hi));
          if (d > WIN || d < -WIN) p0[r] = -1e30f;
          if (d - 32 > WIN || d - 32 < -WIN) p1[r] = -1e30f; }
      }
      partialSM(p0, p1, m_reg, mn, al);
      if (__any(al < 1.f)) { if (hi == 0) al_l[r32] = al; asm volatile("s_waitcnt lgkmcnt(0)" ::: "memory");
#pragma unroll
        for (int d = 0; d < 4; ++d)
#pragma unroll
          for (int r = 0; r < 16; ++r) o[d][r] *= al_l[crow(r, hi)]; }
      finishSM(p0, p1, al, l_reg, pa0, pa1, pa2, pa3); SBAR();
      pv_d0(o, (int)(uintptr_t)(tbuf + 16384) + v_rd_base(lane), pa0, pa1, pa2, pa3);
    }
  }
#undef BB_DMA
  if (hi == 0) li_l[r32] = l_reg; asm volatile("s_waitcnt lgkmcnt(0)" ::: "memory");
  float rli[16];
#pragma unroll
  for (int r = 0; r < 16; ++r) rli[r] = __builtin_amdgcn_rcpf(li_l[crow(r, hi)]);
  bf16* Ow = Ob + (long)(P0 + wid * QBLK) * os;
#pragma unroll
  for (int r = 0; r < 16; ++r) { const int orow = crow(r, hi);
#pragma unroll
    for (int d0 = 0; d0 < 4; ++d0) { const float val = o[d0][r] * rli[r]; Ow[(long)orow * os + d0 * 32 + r32] = (bf16)(cvtpk(val, val) & 0xffffu); } }
  if (Lp != nullptr && hi == 0) Lp[(long)(P0 + wid * QBLK + r32) * ls] = m_reg * SCALE + __logf(l_reg);
}

constexpr int WB_TILE = 49152, WB_WS = 2 * WB_TILE;
template <int LDQ, int LDK, int LDO, int NVH, typename TO, bool COMBINE = false, int LDC = 0>
__device__ __forceinline__ void attn_wide_body(const bf16* __restrict__ Qb, const bf16* __restrict__ Kh, const bf16* __restrict__ Vh, TO* __restrict__ Ob, const int seq, char* lds, const int tid,
                                               const float lam = 0.f, const float gsc = 0.f, const float* __restrict__ gain = nullptr, bf16* __restrict__ Cb = nullptr) {
  const int wid = __builtin_amdgcn_readfirstlane(tid >> 6), lane = tid & 63, r32 = lane & 31, hi = lane >> 5;
  float* wsf = (float*)(lds + WB_WS) + wid * 64; float* li_l = wsf; float* al_l = wsf + 32;
  float m_reg = -1e30f, l_reg = 0; f32x16 o[4 * NVH] = {}; bf16x8 qr[8];
  { const bf16* Qw = Qb + ((wid * QBLK + r32) * LDQ + hi * 8);
#pragma unroll
    for (int d0 = 0; d0 < 8; ++d0) qr[d0] = *reinterpret_cast<const bf16x8*>(Qw + d0 * 16); }
  constexpr int NVP = 2 * NVH;
  int ksrc[2], vsrc[NVP];
#pragma unroll
  for (int i = 0; i < 2; ++i) { const int c = 2 * wid + i, row = 4 * c + (lane >> 4), colB = (16 * (lane & 15)) ^ ((row & 7) << 4); ksrc[i] = row * LDK + (colB >> 1); }
#pragma unroll
  for (int i = 0; i < NVP; ++i) { const int pc = wid * NVP + i, hf = pc >> 4, c = pc & 15, sub = 2 * c + (lane >> 5), kk = ((sub >> 2) << 3) | ((lane & 31) >> 2);
      const int k = (kk & ~0xC) | ((kk & 4) << 1) | ((kk & 8) >> 1), col = (sub & 3) * 32 + 8 * (lane & 3); vsrc[i] = k * LDK + hf * 128 + col; }
  using LP = __attribute__((address_space(3))) unsigned*;
#define WB_DMA(buf, key0) do { const bf16* _kb = Kh + (key0) * LDK; const bf16* _vb = Vh + (key0) * LDK; char* _l = lds + (buf) * WB_TILE; \
    _Pragma("unroll") for (int _i = 0; _i < 2; ++_i) __builtin_amdgcn_global_load_lds((const unsigned*)(_kb + ksrc[_i]), (LP)(_l + (2 * wid + _i) * 1024), 16, 0, 0); \
    _Pragma("unroll") for (int _i = 0; _i < NVP; ++_i) __builtin_amdgcn_global_load_lds((const unsigned*)(_vb + vsrc[_i]), (LP)(_l + 16384 + (wid * NVP + _i) * 1024), 16, 0, 0); } while (0)
  const int NT = seq / KVBLK;
  WB_DMA(0, 0);
  for (int j = 0; j < NT; ++j) {
    asm volatile("s_waitcnt vmcnt(0)" ::: "memory");
    __builtin_amdgcn_s_barrier();
    asm volatile("" ::: "memory");
    if (j + 1 < NT) WB_DMA((j + 1) & 1, (j + 1) * KVBLK);
    char* tb = lds + (j & 1) * WB_TILE;
    f32x16 p0, p1; float mn, al; bf16x8 pa0, pa1, pa2, pa3;
    qkt(p0, p1, (const bf16*)tb, qr, r32, hi);
    partialSM(p0, p1, m_reg, mn, al);
    if (__any(al < 1.f)) { if (hi == 0) al_l[r32] = al; asm volatile("s_waitcnt lgkmcnt(0)" ::: "memory");
#pragma unroll
      for (int d = 0; d < 4 * NVH; ++d)
#pragma unroll
        for (int r = 0; r < 16; ++r) o[d][r] *= al_l[crow(r, hi)]; }
    finishSM(p0, p1, al, l_reg, pa0, pa1, pa2, pa3); SBAR();
    const int vb0 = (int)(uintptr_t)(tb + 16384) + v_rd_base(lane);
    pv_one<0>(o[0], vb0, pa0, pa1, pa2, pa3); pv_one<1>(o[1], vb0, pa0, pa1, pa2, pa3); pv_one<2>(o[2], vb0, pa0, pa1, pa2, pa3); pv_one<3>(o[3], vb0, pa0, pa1, pa2, pa3);
    if constexpr (NVH == 2) {
    pv_one<0>(o[4 * (NVH - 1)], vb0 + 16384, pa0, pa1, pa2, pa3); pv_one<1>(o[4 * (NVH - 1) + 1], vb0 + 16384, pa0, pa1, pa2, pa3); pv_one<2>(o[4 * (NVH - 1) + 2], vb0 + 16384, pa0, pa1, pa2, pa3); pv_one<3>(o[4 * (NVH - 1) + 3], vb0 + 16384, pa0, pa1, pa2, pa3); }
  }
#undef WB_DMA
  int te = tid; asm volatile("" : "+v"(te));
  const int wid_e = __builtin_amdgcn_readfirstlane(te >> 6), r32_e = te & 31, hi_e = (te >> 5) & 1;
  float* li_e = (float*)(lds + WB_WS) + wid_e * 64;
  if (hi_e == 0) li_e[r32_e] = l_reg; asm volatile("s_waitcnt lgkmcnt(0)" ::: "memory");
  float rli[16];
#pragma unroll
  for (int r = 0; r < 16; ++r) rli[r] = __builtin_amdgcn_rcpf(li_e[crow(r, hi_e)]);
  TO* Ow = Ob + (wid_e * QBLK) * LDO;
  if constexpr (!COMBINE) {
#pragma unroll
    for (int r = 0; r < 16; ++r) { const int orow = crow(r, hi_e);
#pragma unroll
      for (int d0 = 0; d0 < 4 * NVH; ++d0) { const float val = o[d0][r] * rli[r];
        if constexpr (sizeof(TO) == 4) Ow[orow * LDO + d0 * 32 + r32_e] = val; else Ow[orow * LDO + d0 * 32 + r32_e] = (TO)(cvtpk(val, val) & 0xffffu); } }
  } else {
    static_assert(sizeof(TO) == 4 && NVH == 2, "combine: f32 first-map tile, 256-wide rows");
    float gn[8];
    { const float* g2 = gain; asm volatile("" : "+s"(g2));
#pragma unroll
      for (int d0 = 0; d0 < 8; ++d0) gn[d0] = g2[d0 * 32 + r32_e] * gsc; }
    bf16* Cw; { bf16* c2 = Cb; asm volatile("" : "+s"(c2)); Cw = c2 + (wid_e * QBLK) * LDC; }
    { TO* o2 = Ob; asm volatile("" : "+s"(o2)); Ow = o2 + (wid_e * QBLK) * LDO; }
#pragma unroll
    for (int r = 0; r < 16; ++r) { const int orow = crow(r, hi_e);
      float ss = 0.f;
#pragma unroll
      for (int d0 = 0; d0 < 8; ++d0) { const float o1 = __hip_atomic_load((const float*)Ow + orow * LDO + d0 * 32 + r32_e, __ATOMIC_RELAXED, __HIP_MEMORY_SCOPE_AGENT);
        const float av = o1 - lam * (o[d0][r] * rli[r]); o[d0][r] = av; ss = fmaf(av, av, ss); }
#define WB_SWZ(v, m) __int_as_float(__builtin_amdgcn_ds_swizzle(__float_as_int(v), ((m) << 10) | 0x1F))
      ss += WB_SWZ(ss, 1); ss += WB_SWZ(ss, 2); ss += WB_SWZ(ss, 4); ss += WB_SWZ(ss, 8); ss += WB_SWZ(ss, 16);
#undef WB_SWZ
      const float sc = 1.0f / sqrtf(ss * (1.0f / 256.0f) + 1e-6f);
#pragma unroll
      for (int d0 = 0; d0 < 8; ++d0) { const float val = o[d0][r] * sc * gn[d0]; Cw[orow * LDC + d0 * 32 + r32_e] = (bf16)(cvtpk(val, val) & 0xffffu); }
      asm volatile("" ::: "memory"); }
  }
}
}
typedef unsigned short bf16_t;
typedef unsigned u32x4v __attribute__((ext_vector_type(4)));
#define LDSA __attribute__((address_space(3)))
constexpr size_t al256(size_t x) { return (x + 255) / 256 * 256; }
constexpr size_t WS_CTL  = 0;
constexpr size_t CTL_BYTES = 65536;
constexpr size_t WS_XB   = WS_CTL + CTL_BYTES;
constexpr size_t WS_WAB  = WS_XB + (size_t)SEQ * DM * 2;
constexpr size_t WS_WOAB = WS_WAB + (size_t)12288 * 4096 * 2;
constexpr size_t WS_WCD  = WS_WOAB + (size_t)4096 * 3072 * 2;
constexpr size_t WS_WOCD = WS_WCD + (size_t)9216 * 4096 * 2;
constexpr size_t WS_WQ   = WS_WOCD + (size_t)4096 * 4096 * 2;
constexpr size_t WS_UB   = WS_WQ + (size_t)2 * 2048 * 4096 * 2;
constexpr size_t WS_VB   = WS_UB + (size_t)2 * 16384 * 3072;
constexpr size_t WS_SU   = WS_VB + (size_t)2 * 16384 * 3072;
constexpr size_t WS_SV   = WS_SU + (size_t)2 * 16384 * 4;
constexpr size_t WS_H    = WS_SV + (size_t)2 * 16384 * 4;
constexpr size_t WS_Y    = WS_H;
constexpr size_t WS_PQ   = WS_H + (size_t)SEQ * 4096 * 4;
constexpr size_t WS_OC   = WS_H + (size_t)SEQ * 12288 * 4;
constexpr size_t WS_AB   = WS_OC + (size_t)2 * SEQ * 2048 * 4;
constexpr size_t WS_X1   = WS_AB + (size_t)SEQ * 4096 * 2;
constexpr size_t WS_X1B  = WS_X1 + (size_t)SEQ * 4096 * 4;
constexpr size_t WS_X2   = WS_X1B + (size_t)SEQ * 4096 * 2;
constexpr size_t WS_X2B  = WS_X2 + (size_t)SEQ * 4096 * 4;
constexpr size_t WS_EIDX = WS_X2B + (size_t)SEQ * 4096 * 2;
constexpr size_t WS_GATE = WS_EIDX + (size_t)SEQ * 128 * 4;
constexpr size_t WS_HB   = WS_GATE + (size_t)SEQ * 128 * 4;
constexpr size_t WS_KEYB = WS_HB + (size_t)SEQ * 12288 * 2;
constexpr size_t WS_CS0  = WS_KEYB + (size_t)2 * 8 * 2 * 128 * 128 * 2;
constexpr size_t WS_CSA  = WS_CS0 + (size_t)SEQ * 16 * 8;
constexpr size_t WS_END  = WS_CSA + (size_t)128 * 32 * 8;
static_assert(WS_END <= (size_t)2147483648ull, "workspace");

constexpr int LDS_BYTES = 155648;
constexpr int LDS_MISC = 139264;

struct MK { const float* in[21]; float* out; unsigned char* ws; int ph_lo, ph_hi; };

namespace pg8 {
struct EpiF32R {
    static constexpr bool PERM = false, AFTER_DRAIN = false;
    float* C; int ldc; const float* R; float ralpha;
    __device__ __forceinline__ void operator()(const f32x4 (&acc)[2][2][4][2], const Unit& u, int wr, int wc, int fr, int fq) const {
        const int row0 = u.pm * BM + wr * 64 + fr, col0 = u.pn * BM + wc * 32 + 4 * fq;
#pragma unroll
        for (int ai = 0; ai < 2; ++ai)
#pragma unroll
            for (int m = 0; m < 4; ++m) { const size_t off = (size_t)(row0 + ai * HALF + m * 16) * ldc + col0;
#pragma unroll
                for (int bj = 0; bj < 2; ++bj)
#pragma unroll
                    for (int n = 0; n < 2; ++n) { f32x4 v = acc[ai][bj][m][n];
                        if (R) { const f32x4 r = *(const f32x4*)(R + off + bj * HALF + n * 16); v += r * ralpha; }
                        *(f32x4*)(C + off + bj * HALF + n * 16) = v; } }
    }
};
struct EpiBf16P {
    static constexpr bool PERM = true, AFTER_DRAIN = false;
    bf16_t* O; int ldc;
    __device__ __forceinline__ void operator()(const f32x4 (&acc)[2][2][4][2], const Unit& u, int wr, int wc, int fr, int fq) const {
        const int row0 = u.pm * BM + wr * 64 + fr, col0 = u.pn * BM + wc * 32 + 8 * fq;
#pragma unroll
        for (int ai = 0; ai < 2; ++ai)
#pragma unroll
            for (int m = 0; m < 4; ++m) { bf16_t* rowp = O + (size_t)(row0 + ai * HALF + m * 16) * ldc + col0;
#pragma unroll
                for (int bj = 0; bj < 2; ++bj) { const f32x4 v0 = acc[ai][bj][m][0], v1 = acc[ai][bj][m][1];
                    u32x4 w; w.x = cvt_pk_bf16(v0[0], v0[1]); w.y = cvt_pk_bf16(v0[2], v0[3]); w.z = cvt_pk_bf16(v1[0], v1[1]); w.w = cvt_pk_bf16(v1[2], v1[3]);
                    *(u32x4*)(rowp + bj * HALF) = w; } }
    }
};

template <int LAYER> struct EpiProj {
    static constexpr bool PERM = true, AFTER_DRAIN = false;
    bf16_t* O; int ldc; const float* cs0; const float* csa; const float* gq; const float* gk; PG8_LAS float* xch;
    __device__ __forceinline__ void operator()(const f32x4 (&acc)[2][2][4][2], const Unit& u, int wr, int wc, int fr, int fq) const {
        const int row0 = u.pm * BM + wr * 64 + fr, col0 = u.pn * BM + wc * 32 + 8 * fq;
        const int pn = u.pn;
        const bool prope = LAYER == 0 ? (pn < 10 || (pn >= 12 && pn < 36)) : (pn < 16);
        const bool dnorm = LAYER == 1 && pn >= 24 && pn < 34;
        float rs[2][4][2];
        float gn[8];
        if (dnorm) {
            const int lrow = fr;
#pragma unroll
            for (int ai = 0; ai < 2; ++ai)
#pragma unroll
                for (int m = 0; m < 4; ++m)
#pragma unroll
                    for (int bj = 0; bj < 2; ++bj) { const f32x4 a = acc[ai][bj][m][0], b = acc[ai][bj][m][1];
                        float q = (a[0] * a[0] + a[1] * a[1]) + (a[2] * a[2] + a[3] * a[3]) + (b[0] * b[0] + b[1] * b[1]) + (b[2] * b[2] + b[3] * b[3]);
                        q += __shfl_xor(q, 16); q += __shfl_xor(q, 32);
                        if (fq == 0) xch[((wr * 128 + (ai * 4 + m) * 16 + lrow) * 2 + bj) * 4 + wc] = q; }
            asm volatile("s_waitcnt lgkmcnt(0)" ::: "memory"); __builtin_amdgcn_s_barrier(); asm volatile("" ::: "memory");
#pragma unroll
            for (int ai = 0; ai < 2; ++ai)
#pragma unroll
                for (int m = 0; m < 4; ++m)
#pragma unroll
                    for (int bj = 0; bj < 2; ++bj) { const f32x4 p = *(const PG8_LAS f32x4*)(xch + ((wr * 128 + (ai * 4 + m) * 16 + lrow) * 2 + bj) * 4);
                        rs[ai][m][bj] = 1.0f / sqrtf(((p[0] + p[1]) + (p[2] + p[3])) * (1.0f / 128.0f) + 1e-6f); }
            const float* g = pn < 32 ? gq : gk;
#pragma unroll
            for (int e = 0; e < 8; ++e) { const int p = wc * 32 + 8 * fq + e; const int orig = (p & 64) + ((p & 63) >> 1) + 32 * (p & 1); gn[e] = g[orig]; }
        }
        const bool rot = dnorm || (prope && wc == 0);
#pragma unroll
        for (int ai = 0; ai < 2; ++ai) {
            f32x4 cs[4][2];
            if (rot) {
#pragma unroll
                for (int m = 0; m < 4; ++m) { const int row = row0 + ai * HALF + m * 16;
                    const float* cp = dnorm ? csa + ((size_t)(wc < 2 ? (row >> 6) : (row & 63)) * 32 + 16 * (wc & 1) + 4 * fq) * 2 : cs0 + ((size_t)row * 16 + 4 * fq) * 2;
                    cs[m][0] = *(const f32x4*)cp; cs[m][1] = *(const f32x4*)(cp + 4); }
            }
#pragma unroll
            for (int m = 0; m < 4; ++m) {
                const int row = row0 + ai * HALF + m * 16;
                bf16_t* rowp = O + (size_t)row * ldc + col0;
                f32x4 c0 = (f32x4){1.f, 0.f, 1.f, 0.f}, c1 = c0;
                if (rot) { c0 = cs[m][0]; c1 = cs[m][1]; }
#pragma unroll
                for (int bj = 0; bj < 2; ++bj) { f32x4 v0 = acc[ai][bj][m][0], v1 = acc[ai][bj][m][1];
                    if (dnorm) { const float r = rs[ai][m][bj];
                        v0[0] *= r * gn[0]; v0[1] *= r * gn[1]; v0[2] *= r * gn[2]; v0[3] *= r * gn[3]; v1[0] *= r * gn[4]; v1[1] *= r * gn[5]; v1[2] *= r * gn[6]; v1[3] *= r * gn[7]; }
                    if (rot) {
                        const float a0 = v0[0] * c0[0] - v0[1] * c0[1], b0 = v0[1] * c0[0] + v0[0] * c0[1];
                        const float a1 = v0[2] * c0[2] - v0[3] * c0[3], b1 = v0[3] * c0[2] + v0[2] * c0[3];
                        const float a2 = v1[0] * c1[0] - v1[1] * c1[1], b2 = v1[1] * c1[0] + v1[0] * c1[1];
                        const float a3 = v1[2] * c1[2] - v1[3] * c1[3], b3 = v1[3] * c1[2] + v1[2] * c1[3];
                        v0 = (f32x4){a0, b0, a1, b1}; v1 = (f32x4){a2, b2, a3, b3}; }
                    u32x4 w; w.x = cvt_pk_bf16(v0[0], v0[1]); w.y = cvt_pk_bf16(v0[2], v0[3]); w.z = cvt_pk_bf16(v1[0], v1[1]); w.w = cvt_pk_bf16(v1[2], v1[3]);
                    *(u32x4*)(rowp + bj * HALF) = w; }
            }
            asm volatile("" ::: "memory");
        }
    }
};
}

__device__ __forceinline__ float bf_lo(unsigned w) { return __uint_as_float(w << 16); }
__device__ __forceinline__ float bf_hi(unsigned w) { return __uint_as_float(w & 0xffff0000u); }
__device__ __forceinline__ unsigned cvtpk_bf16(float lo, float hi) { unsigned r; asm volatile("v_cvt_pk_bf16_f32 %0, %1, %2" : "=v"(r) : "v"(lo), "v"(hi)); return r; }

__device__ __forceinline__ void cvt_rows_bf16(const float* __restrict__ src, bf16_t* __restrict__ dst, size_t n8, int bid, int nb, int tid, int nthr) {
    const size_t stride = (size_t)nb * nthr;
    for (size_t i = (size_t)bid * nthr + tid; i < n8; i += 4 * stride) {
        float4 a[4], b[4];
#pragma unroll
        for (int u = 0; u < 4; ++u) { const size_t j = i + u * stride; if (j < n8) { a[u] = *(const float4*)(src + j * 8); b[u] = *(const float4*)(src + j * 8 + 4); } }
#pragma unroll
        for (int u = 0; u < 4; ++u) { const size_t j = i + u * stride; if (j < n8) {
            u32x4v w; w.x = cvtpk_bf16(a[u].x, a[u].y); w.y = cvtpk_bf16(a[u].z, a[u].w); w.z = cvtpk_bf16(b[u].x, b[u].y); w.w = cvtpk_bf16(b[u].z, b[u].w);
            *(u32x4v*)(dst + j * 8) = w; } }
    }
}
template <class PM>
__device__ __forceinline__ void transpose_cvt(const float* __restrict__ W, bf16_t* __restrict__ Wt, int K, int N, LDSA float* tile0, int bid, int nb, PM pm, const int tid) {
    const int lane = tid & 63, wv = tid >> 6;
    LDSA float* tile = tile0 + wv * 4352;
    const int ntk = K / 64, ntn = N / 64;
    for (int t = bid * 8 + wv; t < ntk * ntn; t += nb * 8) {
        const int k0 = (t % ntk) * 64, n0 = (t / ntk) * 64;
        const int c = (lane & 15) * 4, r0 = lane >> 4;
        float4 v[16];
#pragma unroll
        for (int i = 0; i < 16; ++i) v[i] = *(const float4*)(W + (size_t)(k0 + r0 + 4 * i) * N + n0 + c);
#pragma unroll
        for (int i = 0; i < 16; ++i) { const int r = r0 + 4 * i; tile[r * 65 + c] = v[i].x; tile[r * 65 + c + 1] = v[i].y; tile[r * 65 + c + 2] = v[i].z; tile[r * 65 + c + 3] = v[i].w; }
        asm volatile("s_waitcnt lgkmcnt(0)" ::: "memory");
        const int mode = pm(n0);
#pragma unroll
        for (int h = 0; h < 8; ++h) {
            const int n = (lane >> 3) + 8 * h, kc = (lane & 7) * 8;
            int src = n;
            if (mode == 1) { if (n < 32) src = (n >> 1) + 16 * (n & 1); }
            else if (mode == 2) src = (n >> 1) + 32 * (n & 1);
            float f[8];
#pragma unroll
            for (int j = 0; j < 8; ++j) f[j] = tile[(kc + j) * 65 + src];
            u32x4v w; w.x = cvtpk_bf16(f[0], f[1]); w.y = cvtpk_bf16(f[2], f[3]); w.z = cvtpk_bf16(f[4], f[5]); w.w = cvtpk_bf16(f[6], f[7]);
            *(u32x4v*)(Wt + (size_t)(n0 + n) * K + k0 + kc) = w;
        }
        asm volatile("s_waitcnt lgkmcnt(0)" ::: "memory");
    }
}
struct PermNone { __device__ __forceinline__ int operator()(int) const { return 0; } };
struct PermAB { __device__ __forceinline__ int operator()(int n0) const { const bool rope = n0 < 2560 || (n0 >= 3072 && n0 < 9216); return (rope && (n0 & 127) == 0) ? 1 : 0; } };
struct PermCD { __device__ __forceinline__ int operator()(int n0) const { if (n0 < 4096) return (n0 & 127) == 0 ? 1 : 0; if (n0 >= 6144 && n0 < 8704) return 2; return 0; } };
__device__ __forceinline__ void rope_tables(float* __restrict__ cs0, float* __restrict__ csa, const int bid, const int G, const int tid) {
    for (int i = bid * 512 + tid; i < SEQ * 16; i += G * 512) { float s, c; sincos_rev((double)(i >> 4) * REV_P[i & 15], s, c); *(float2*)(cs0 + (size_t)i * 2) = make_float2(c, s); }
    for (int i = bid * 512 + tid; i < 128 * 32; i += G * 512) { float s, c; sincos_rev((double)(i >> 5) * REV_A[i & 31], s, c); *(float2*)(csa + (size_t)i * 2) = make_float2(c, s); }
}


typedef unsigned v6u_t __attribute__((ext_vector_type(6)));
typedef float f4v_t __attribute__((ext_vector_type(4)));
typedef unsigned v16u_t __attribute__((ext_vector_type(16)));
typedef float v16f_t __attribute__((ext_vector_type(16)));
typedef float v32f_t __attribute__((ext_vector_type(32)));
typedef __bf16 v32b_t __attribute__((ext_vector_type(32)));
constexpr int ROWB = 3072;
constexpr int XT_STRIDE = 68;
constexpr int XT_BYTES = 64 * XT_STRIDE * 4;
__device__ __forceinline__ void table_fp6(const float* __restrict__ src, unsigned char* __restrict__ dst, float* __restrict__ inv, const int rows, LDSA float* xt0, const int bid, const int G, const int tid) {
    const int lane = tid & 63, wv = tid >> 6;
    LDSA float* xt = xt0 + wv * (XT_BYTES / 4);
    for (int r = bid * 8 + wv; r < rows; r += G * 8) {
        float4 v[16]; float am = 0.f;
#pragma unroll
        for (int j = 0; j < 16; ++j) { v[j] = *(const float4*)(src + (size_t)r * DM + j * 256 + lane * 4); am = fmaxf(am, fmaxf(fmaxf(fabsf(v[j].x), fabsf(v[j].y)), fmaxf(fabsf(v[j].z), fabsf(v[j].w)))); }
        am = wave_max(am);
        const float sc = am > 0.f ? 7.0f / am : 1.0f;
#pragma unroll
        for (int j = 0; j < 16; ++j) *(LDSA f4v_t*)(xt + (4 * j + (lane >> 4)) * XT_STRIDE + 4 * (lane & 15)) = (f4v_t){v[j].x * sc, v[j].y * sc, v[j].z * sc, v[j].w * sc};
        asm volatile("s_waitcnt lgkmcnt(0)" ::: "memory");
        v16f_t f0, f1, f2, f3;
#pragma unroll
        for (int k = 0; k < 8; ++k) { const f4v_t a = *(const LDSA f4v_t*)(xt + lane * XT_STRIDE + 4 * k), c = *(const LDSA f4v_t*)(xt + lane * XT_STRIDE + 32 + 4 * k);
            f0[2 * k] = a[0]; f1[2 * k] = a[1]; f0[2 * k + 1] = a[2]; f1[2 * k + 1] = a[3];
            f2[2 * k] = c[0]; f3[2 * k] = c[1]; f2[2 * k + 1] = c[2]; f3[2 * k + 1] = c[3]; }
        asm volatile("s_waitcnt lgkmcnt(0)" ::: "memory");
        const v6u_t w0 = __builtin_amdgcn_cvt_scalef32_2xpk16_fp6_f32(f0, f1, 1.0f), w1 = __builtin_amdgcn_cvt_scalef32_2xpk16_fp6_f32(f2, f3, 1.0f);
        unsigned char* dp = dst + (size_t)r * ROWB + lane * 48;
        u32x4v s0, s1, s2; s0.x = w0[0]; s0.y = w0[1]; s0.z = w0[2]; s0.w = w0[3]; s1.x = w0[4]; s1.y = w0[5]; s1.z = w1[0]; s1.w = w1[1]; s2.x = w1[2]; s2.y = w1[3]; s2.z = w1[4]; s2.w = w1[5];
        *(u32x4v*)dp = s0; *(u32x4v*)(dp + 16) = s1; *(u32x4v*)(dp + 32) = s2;
        if (lane == 0) inv[r] = am > 0.f ? am * (1.0f / 7.0f) : 1.0f;
    }
}

typedef __bf16 bf2_t __attribute__((ext_vector_type(2)));
__device__ __forceinline__ float dot2_bf16(unsigned a, unsigned b, float c) { return __builtin_amdgcn_fdot2_f32_bf16(__builtin_bit_cast(bf2_t, a), __builtin_bit_cast(bf2_t, b), c, false); }
__device__ __forceinline__ float gelu_tanh_f(float x) {
    const float z = 0.7978845608028654f * (x + 0.044715f * x * x * x);
    const float e = __expf(2.0f * z);
    return 0.5f * x * (2.0f - 2.0f / (e + 1.0f));
}
__device__ __forceinline__ int pick_i(int a0, int a1, int k) { return k < 64 ? __builtin_amdgcn_readlane(a0, k) : __builtin_amdgcn_readlane(a1, k - 64); }
__device__ __forceinline__ float pick_f(float a0, float a1, int k) { return __int_as_float(pick_i(__float_as_int(a0), __float_as_int(a1), k)); }
#define PE_LOADROW(dst, base, e) do { const unsigned char* _p = (base) + (size_t)(e) * ROWB + lane * 48; dst[0] = *(const u32x4v*)_p; dst[1] = *(const u32x4v*)(_p + 16); dst[2] = *(const u32x4v*)(_p + 32); } while (0)
__device__ __forceinline__ float pe_dot(const u32x4v (&r)[3], const u32x4v (&x)[8]) {
    float d0 = 0.f, d1 = 0.f, d2 = 0.f, d3 = 0.f;
    { const v6u_t g = {r[0].x, r[0].y, r[0].z, r[0].w, r[1].x, r[1].y};
      const v16u_t z = __builtin_bit_cast(v16u_t, __builtin_amdgcn_cvt_scalef32_pk32_bf16_fp6(g, 1.0f));
#pragma unroll
      for (int k = 0; k < 4; ++k) { const unsigned xa = x[k].x, xb = x[k].y, xc = x[k].z, xd = x[k].w; const unsigned za = z[4 * k], zb = z[4 * k + 1], zc = z[4 * k + 2], zd = z[4 * k + 3];
          d0 = dot2_bf16(za, xa, d0); d1 = dot2_bf16(zb, xb, d1); d2 = dot2_bf16(zc, xc, d2); d3 = dot2_bf16(zd, xd, d3); }
      asm volatile("" : "+v"(d0), "+v"(d1), "+v"(d2), "+v"(d3)); }
    { const v6u_t g = {r[1].z, r[1].w, r[2].x, r[2].y, r[2].z, r[2].w};
      const v16u_t z = __builtin_bit_cast(v16u_t, __builtin_amdgcn_cvt_scalef32_pk32_bf16_fp6(g, 1.0f));
#pragma unroll
      for (int k = 0; k < 4; ++k) { const unsigned xa = x[4 + k].x, xb = x[4 + k].y, xc = x[4 + k].z, xd = x[4 + k].w; const unsigned za = z[4 * k], zb = z[4 * k + 1], zc = z[4 * k + 2], zd = z[4 * k + 3];
          d0 = dot2_bf16(za, xa, d0); d1 = dot2_bf16(zb, xb, d1); d2 = dot2_bf16(zc, xc, d2); d3 = dot2_bf16(zd, xd, d3); } }
    return wave_sum((d0 + d1) + (d2 + d3));
}
#define PE_PIN16(a, b) asm volatile("" : "+v"(a[b + 0]), "+v"(a[b + 1]), "+v"(a[b + 2]), "+v"(a[b + 3]), "+v"(a[b + 4]), "+v"(a[b + 5]), "+v"(a[b + 6]), "+v"(a[b + 7]), \
                                         "+v"(a[b + 8]), "+v"(a[b + 9]), "+v"(a[b + 10]), "+v"(a[b + 11]), "+v"(a[b + 12]), "+v"(a[b + 13]), "+v"(a[b + 14]), "+v"(a[b + 15]))
__device__ __forceinline__ void pe_axpy(float (&acc)[64], const u32x4v (&r)[3], const float w) {
    { const v6u_t g = {r[0].x, r[0].y, r[0].z, r[0].w, r[1].x, r[1].y};
      const v32f_t y = __builtin_amdgcn_cvt_scalef32_pk32_f32_fp6(g, 1.0f);
#pragma unroll
      for (int i = 0; i < 32; ++i) acc[i] = fmaf(w, y[i], acc[i]);
      PE_PIN16(acc, 0); PE_PIN16(acc, 16); }
    { const v6u_t g = {r[1].z, r[1].w, r[2].x, r[2].y, r[2].z, r[2].w};
      const v32f_t y = __builtin_amdgcn_cvt_scalef32_pk32_f32_fp6(g, 1.0f);
#pragma unroll
      for (int i = 0; i < 32; ++i) acc[32 + i] = fmaf(w, y[i], acc[32 + i]);
      PE_PIN16(acc, 32); PE_PIN16(acc, 48); }
}
__device__ __forceinline__ void wave_sort128(unsigned& a0, unsigned& a1, const int lane) {
#pragma unroll
    for (int k = 2; k <= 128; k <<= 1) {
#pragma unroll
        for (int j = k >> 1; j > 0; j >>= 1) {
            if (j == 64) { const unsigned lo = a0 < a1 ? a0 : a1, hi = a0 < a1 ? a1 : a0; a0 = lo; a1 = hi; }
            else {
                const unsigned o0 = (unsigned)__shfl_xor((int)a0, j), o1 = (unsigned)__shfl_xor((int)a1, j);
                const bool lowhalf = (lane & j) == 0;
                const bool up0 = k >= 128 ? true : ((lane & k) == 0);
                const bool up1 = k >= 128 ? true : (k == 64 ? false : ((lane & k) == 0));
                const bool min0 = lowhalf == up0, min1 = lowhalf == up1;
                const unsigned mn0 = a0 < o0 ? a0 : o0, mx0 = a0 < o0 ? o0 : a0, mn1 = a1 < o1 ? a1 : o1, mx1 = a1 < o1 ? o1 : a1;
                a0 = min0 ? mn0 : mx0; a1 = min1 ? mn1 : mx1;
            }
        }
    }
}
__device__ __forceinline__ void peer_expert_phase(const float* __restrict__ ypre, const float* __restrict__ stats, const float* __restrict__ gm, const float* __restrict__ bm, const bf16_t* __restrict__ x1b, const int* __restrict__ eidx, const float* __restrict__ gate,
                                                  const unsigned char* __restrict__ ub, const unsigned char* __restrict__ vb, const float* __restrict__ isu, const float* __restrict__ isv,
                                                  const float* __restrict__ lg, const float* __restrict__ lb, float* __restrict__ out, bf16_t* __restrict__ outb, LDSA float* xt0, const int bid, const int G, const int tid) {
    const int wv = __builtin_amdgcn_readfirstlane(tid >> 6);
    LDSA float* xt = xt0 + wv * (XT_BYTES / 4);
    for (int t = bid * 8 + wv; t < SEQ; t += G * 8) {
        int tl = tid; asm volatile("" : "+v"(tl));
        const int lane = tl & 63;
        int e0, e1; float g0, g1;
        { const int r0 = eidx[(size_t)t * 128 + lane], r1 = eidx[(size_t)t * 128 + 64 + lane];
          const float h0 = gate[(size_t)t * 128 + lane], h1 = gate[(size_t)t * 128 + 64 + lane];
          unsigned a0 = ((unsigned)r0 << 7) | (unsigned)lane, a1 = ((unsigned)r1 << 7) | (unsigned)(64 + lane);
          wave_sort128(a0, a1, lane);
          e0 = (int)(a0 >> 7); e1 = (int)(a1 >> 7);
          const int k0 = (int)(a0 & 127u), k1 = (int)(a1 & 127u);
          const float p00 = __shfl(h0, k0 & 63), p01 = __shfl(h1, k0 & 63), p10 = __shfl(h0, k1 & 63), p11 = __shfl(h1, k1 & 63);
          g0 = k0 < 64 ? p00 : p01; g1 = k1 < 64 ? p10 : p11; }
        const float iu0 = isu[e0], iu1 = isu[e1], iv0 = isv[e0], iv1 = isv[e1];
        u32x4v xq[8];
#pragma unroll
        for (int k = 0; k < 8; ++k) xq[k] = *(const u32x4v*)(x1b + (size_t)t * DM + lane * 64 + k * 8);
        float w0 = 0.f, w1 = 0.f;
        u32x4v R0[3], R1[3], R2[3], R3[3], R4[3];
#define PE_E(k) pick_i(e0, e1, (k))
#define PE_USTEP(R, k) do { const float d = pe_dot(R, xq) * pick_f(iu0, iu1, (k)); const float w = pick_f(g0, g1, (k)) * gelu_tanh_f(d) * pick_f(iv0, iv1, (k)); \
            if (lane == ((k) & 63)) { if ((k) < 64) w0 = w; else w1 = w; } } while (0)
        PE_LOADROW(R0, ub, PE_E(0)); PE_LOADROW(R1, ub, PE_E(1)); PE_LOADROW(R2, ub, PE_E(2)); PE_LOADROW(R3, ub, PE_E(3));
        for (int k = 0; k < 125; k += 5) {
            if (k + 4 < 128) PE_LOADROW(R4, ub, PE_E(k + 4)); PE_USTEP(R0, k);
            if (k + 5 < 128) PE_LOADROW(R0, ub, PE_E(k + 5)); PE_USTEP(R1, k + 1);
            if (k + 6 < 128) PE_LOADROW(R1, ub, PE_E(k + 6)); PE_USTEP(R2, k + 2);
            if (k + 7 < 128) PE_LOADROW(R2, ub, PE_E(k + 7)); PE_USTEP(R3, k + 3);
            if (k + 8 < 128) PE_LOADROW(R3, ub, PE_E(k + 8)); PE_USTEP(R4, k + 4);
        }
        PE_USTEP(R0, 125); PE_USTEP(R1, 126); PE_USTEP(R2, 127);
        float acc[64];
#pragma unroll
        for (int i = 0; i < 64; ++i) acc[i] = 0.f;
        PE_LOADROW(R0, vb, PE_E(0)); PE_LOADROW(R1, vb, PE_E(1)); PE_LOADROW(R2, vb, PE_E(2)); PE_LOADROW(R3, vb, PE_E(3));
        for (int k = 0; k < 125; k += 5) {
            if (k + 4 < 128) PE_LOADROW(R4, vb, PE_E(k + 4)); pe_axpy(acc, R0, pick_f(w0, w1, k));
            if (k + 5 < 128) PE_LOADROW(R0, vb, PE_E(k + 5)); pe_axpy(acc, R1, pick_f(w0, w1, k + 1));
            if (k + 6 < 128) PE_LOADROW(R1, vb, PE_E(k + 6)); pe_axpy(acc, R2, pick_f(w0, w1, k + 2));
            if (k + 7 < 128) PE_LOADROW(R2, vb, PE_E(k + 7)); pe_axpy(acc, R3, pick_f(w0, w1, k + 3));
            if (k + 8 < 128) PE_LOADROW(R3, vb, PE_E(k + 8)); pe_axpy(acc, R4, pick_f(w0, w1, k + 4));
        }
        pe_axpy(acc, R0, pick_f(w0, w1, 125)); pe_axpy(acc, R1, pick_f(w0, w1, 126)); pe_axpy(acc, R2, pick_f(w0, w1, 127));
#undef PE_E
#undef PE_USTEP
#pragma unroll
        for (int k = 0; k < 16; ++k) *(LDSA f4v_t*)(xt + lane * XT_STRIDE + 4 * k) = (f4v_t){acc[4 * k], acc[4 * k + 1], acc[4 * k + 2], acc[4 * k + 3]};
        asm volatile("s_waitcnt lgkmcnt(0)" ::: "memory");
        float4 y[16]; float s = 0.f; const float2 st = *(const float2*)(stats + (size_t)t * 2);
#pragma unroll
        for (int j = 0; j < 16; ++j) { const f4v_t f = *(const LDSA f4v_t*)(xt + (4 * j + (lane >> 4)) * XT_STRIDE + 4 * (lane & 15));
            const float4 yv = *(const float4*)(ypre + (size_t)t * DM + j * 256 + lane * 4), gv = *(const float4*)(gm + j * 256 + lane * 4), bv = *(const float4*)(bm + j * 256 + lane * 4);
            float4 xv;
            xv.x = (yv.x - st.x) * st.y * gv.x + bv.x; xv.y = (yv.y - st.x) * st.y * gv.y + bv.y; xv.z = (yv.z - st.x) * st.y * gv.z + bv.z; xv.w = (yv.w - st.x) * st.y * gv.w + bv.w;
            y[j].x = fmaf(ALPHA, xv.x, f.x); y[j].y = fmaf(ALPHA, xv.y, f.y); y[j].z = fmaf(ALPHA, xv.z, f.z); y[j].w = fmaf(ALPHA, xv.w, f.w);
            s += (y[j].x + y[j].y) + (y[j].z + y[j].w);
            if (j & 1) asm volatile("" ::: "memory"); }
        asm volatile("s_waitcnt lgkmcnt(0)" ::: "memory");
        const float mean = wave_sum(s) * (1.0f / DM);
        float qq = 0.f;
#pragma unroll
        for (int j = 0; j < 16; ++j) { const float a = y[j].x - mean, b = y[j].y - mean, c = y[j].z - mean, d = y[j].w - mean; qq += (a * a + b * b) + (c * c + d * d); }
        const float rstd = 1.0f / sqrtf(wave_sum(qq) * (1.0f / DM) + 1e-5f);
#pragma unroll
        for (int j = 0; j < 16; ++j) {
            const int c = j * 256 + lane * 4;
            const float4 ga = *(const float4*)(lg + c), ba = *(const float4*)(lb + c);
            float4 oa; oa.x = (y[j].x - mean) * rstd * ga.x + ba.x; oa.y = (y[j].y - mean) * rstd * ga.y + ba.y; oa.z = (y[j].z - mean) * rstd * ga.z + ba.z; oa.w = (y[j].w - mean) * rstd * ga.w + ba.w;
            *(float4*)(out + (size_t)t * DM + c) = oa;
            if (outb) { uint2 w; w.x = cvtpk_bf16(oa.x, oa.y); w.y = cvtpk_bf16(oa.z, oa.w); *(uint2*)(outb + (size_t)t * DM + c) = w; }
            if ((j & 3) == 3) asm volatile("" ::: "memory");
        }
    }
}

__device__ __forceinline__ void attn1_phase(const bf16_t* __restrict__ hb, bf16_t* __restrict__ abb, float* __restrict__ oc, const float* __restrict__ lq1, const float* __restrict__ lk1, const float* __restrict__ lq2,
                                            const float* __restrict__ lk2, const float* __restrict__ subg, char* lds, const int bid, const int G, const int tid) {
    for (int u = bid; u < 512; u += G) {
        __syncthreads();
        const int kv = u >> 7, g = (u >> 5) & 3, qb = u & 31, hq = kv * 4 + g;
        att::attn_wide_body<9216, 9216, 4096, 1, att::bf16>(hb + (size_t)(qb * 256) * 9216 + 6144 + hq * 128, hb + 8192 + kv * 128, hb + 8704 + kv * 128,
                                                             abb + (size_t)(qb * 256) * 4096 + 2048 + hq * 128, SEQ, lds, tid);
    }
    int tid2 = tid; asm volatile("" : "+v"(tid2));
    const int lane_c = tid2 & 63;
    const float lam = __int_as_float(__builtin_amdgcn_readfirstlane(__float_as_int(__expf(wave_sum(lq1[lane_c] * lk1[lane_c] + lq1[lane_c + 64] * lk1[lane_c + 64])) - __expf(wave_sum(lq2[lane_c] * lk2[lane_c] + lq2[lane_c + 64] * lk2[lane_c + 64])) + LAMBDA_INIT)));
    for (int v = bid; v < 256; v += G) {
        __syncthreads();
        const int h = v >> 5, qb = v & 31;
        float* o1 = oc + (size_t)(qb * 256) * 2048 + h * 256;
        int tid4 = tid2; asm volatile("" : "+v"(tid4));
        att::attn_wide_body<9216, 9216, 2048, 2, float>(hb + (size_t)(qb * 256) * 9216 + h * 256, hb + 2048 + h * 256, hb + 4096 + h * 256, o1, SEQ, lds, tid4);
        __syncthreads();
        int tid3 = tid2; asm volatile("" : "+v"(tid3));
        att::attn_wide_body<9216, 9216, 2048, 2, float, true, 4096>(hb + (size_t)(qb * 256) * 9216 + h * 256 + 128, hb + 2048 + h * 256 + 128, hb + 4096 + h * 256, o1, SEQ, lds, tid3,
                                                                     lam, 1.0f - LAMBDA_INIT, subg, abb + (size_t)(qb * 256) * 4096 + h * 256);
    }
}


__device__ __forceinline__ void attn0_phase(const bf16_t* __restrict__ hb, const float* __restrict__ sink, bf16_t* __restrict__ abb, bf16_t* __restrict__ obg, float* __restrict__ lse, char* lds, const int bid, const int G, const int tid) {
    const long LD = 12288;
    for (int u = bid; u < 512; u += G) {
        __syncthreads();
        const int hq = u >> 5, qb = u & 31, kv = hq >> 2;
        att::attn_banded_body<128>(hb + hq * 128, hb + 2048 + kv * 128, hb + 2560 + kv * 128, LD, SEQ, qb * 256, sink[hq] * (1.0f / att::SCALE), 1.0f, abb + hq * 128, 3072, nullptr, 0, lds, tid);
    }
    int tid2 = tid; asm volatile("" : "+v"(tid2));
    for (int v = bid; v < 768; v += G) {
        __syncthreads();
        const int g = v >> 8, w = v & 255, h = w >> 5, rem = w & 31;
        const int dsh = 2 * g;
        const int nqb_sh = 5 - dsh;
        const int r = rem >> nqb_sh, qb = rem & ((1 << nqb_sh) - 1);
        const int head = 8 * g + h;
        const long rs = LD << dsh;
        att::attn_banded_body<64>(hb + (long)r * LD + 3072 + head * 128, hb + (long)r * LD + 6144 + head * 128, hb + (long)r * LD + 9216 + head * 128, rs, SEQ >> dsh, qb * 256, -1e30f, 0.f,
                                  obg + ((long)(g * 8 + h) * SEQ + r) * 128, (long)128 << dsh, lse + (long)(g * 8 + h) * SEQ + r, (long)1 << dsh, lds, tid2);
    }
}
__device__ __forceinline__ void merge0_phase(const bf16_t* __restrict__ obg, const float* __restrict__ lse, bf16_t* __restrict__ abb, const int bid, const int G, const int tid) {
    const int lane = tid & 63, wv = tid >> 6;
    for (int j = bid * 8 + wv; j < SEQ * 8; j += G * 8) {
        const int h = j >> 13, t = j & (SEQ - 1);
        const float l0 = lse[(size_t)(0 * 8 + h) * SEQ + t], l1 = lse[(size_t)(1 * 8 + h) * SEQ + t], l2 = lse[(size_t)(2 * 8 + h) * SEQ + t];
        const float mx = fmaxf(l0, fmaxf(l1, l2));
        const float e0 = __expf(l0 - mx), e1 = __expf(l1 - mx), e2 = __expf(l2 - mx), inv = 1.0f / (e0 + e1 + e2);
        const unsigned a0 = *(const unsigned*)(obg + ((size_t)(0 * 8 + h) * SEQ + t) * 128 + 2 * lane), a1 = *(const unsigned*)(obg + ((size_t)(1 * 8 + h) * SEQ + t) * 128 + 2 * lane), a2 = *(const unsigned*)(obg + ((size_t)(2 * 8 + h) * SEQ + t) * 128 + 2 * lane);
        const float x = (e0 * bf_lo(a0) + e1 * bf_lo(a1) + e2 * bf_lo(a2)) * inv, y = (e0 * bf_hi(a0) + e1 * bf_hi(a1) + e2 * bf_hi(a2)) * inv;
        *(unsigned*)(abb + (size_t)t * 3072 + 2048 + h * 128 + 2 * lane) = cvtpk_bf16(x, y);
    }
}

__device__ __forceinline__ void post_even_phase(const float* __restrict__ h, bf16_t* __restrict__ hb, const int bid, const int G, const int tid) {
    const int lane = tid & 63, wv = tid >> 6;
    for (int job = bid * 8 + wv; job < SEQ * 96; job += G * 8) {
        const int t = job / 96, blk = job - t * 96;
        const bool rope = (blk < 20) || (blk >= 24 && blk < 72);
        const float2 v = *(const float2*)(h + (size_t)t * 12288 + blk * 128 + 2 * lane);
        float o0 = v.x, o1 = v.y;
        const float p0 = __shfl_xor(v.x, 8), p1 = __shfl_xor(v.y, 8);
        if (rope && lane < 16) {
            const int i0 = (2 * lane) & 15;
            float s0, c0, s1, c1; sincos_rev((double)t * REV_P[i0], s0, c0); sincos_rev((double)t * REV_P[i0 + 1], s1, c1);
            if (lane < 8) { o0 = v.x * c0 - p0 * s0; o1 = v.y * c1 - p1 * s1; }
            else          { o0 = v.x * c0 + p0 * s0; o1 = v.y * c1 + p1 * s1; }
        }
        *(unsigned*)(hb + (size_t)t * 12288 + blk * 128 + 2 * lane) = cvtpk_bf16(o0, o1);
    }
}
__device__ __forceinline__ void post_odd_phase(const float* __restrict__ h, bf16_t* __restrict__ hb, const float* __restrict__ qg, const float* __restrict__ kg, const int bid, const int G, const int tid) {
    const int lane = tid & 63, wv = tid >> 6;
    for (int job = bid * 8 + wv; job < SEQ * 72; job += G * 8) {
        const int t = job / 72, blk = job - t * 72;
        const float2 v = *(const float2*)(h + (size_t)t * 9216 + blk * 128 + 2 * lane);
        float o0 = v.x, o1 = v.y;
        if (blk < 32) {
            const float p0 = __shfl_xor(v.x, 8), p1 = __shfl_xor(v.y, 8);
            if (lane < 16) {
                const int i0 = (2 * lane) & 15;
                float s0, c0, s1, c1; sincos_rev((double)t * REV_P[i0], s0, c0); sincos_rev((double)t * REV_P[i0 + 1], s1, c1);
                if (lane < 8) { o0 = v.x * c0 - p0 * s0; o1 = v.y * c1 - p1 * s1; }
                else          { o0 = v.x * c0 + p0 * s0; o1 = v.y * c1 + p1 * s1; }
            }
        } else if (blk >= 48 && blk < 68) {
            const float* g = blk < 64 ? qg : kg;
            const float ss = wave_sum(v.x * v.x + v.y * v.y) * (1.0f / 128.0f);
            const float rs = 1.0f / sqrtf(ss + 1e-6f);
            const float a0 = v.x * rs * g[2 * lane], a1 = v.y * rs * g[2 * lane + 1];
            const float p0 = __shfl_xor(a0, 16), p1 = __shfl_xor(a1, 16);
            const int i0 = (2 * lane) & 31;
            const double pos = (double)(lane < 32 ? (t >> 6) : (t & 63));
            float s0, c0, s1, c1; sincos_rev(pos * REV_A[i0], s0, c0); sincos_rev(pos * REV_A[i0 + 1], s1, c1);
            if ((lane & 16) == 0) { o0 = a0 * c0 - p0 * s0; o1 = a1 * c1 - p1 * s1; }
            else                  { o0 = a0 * c0 + p0 * s0; o1 = a1 * c1 + p1 * s1; }
        }
        *(unsigned*)(hb + (size_t)t * 9216 + blk * 128 + 2 * lane) = cvtpk_bf16(o0, o1);
    }
}

__device__ __forceinline__ void attn_seg_b(const float q0, const float q1, const bf16_t* __restrict__ Kb, const bf16_t* __restrict__ Vb, const int ld,
                                           const int t, const int step, int jlo, int jhi, float& m, float& l, float& o0, float& o1, const int lane) {
    { const int lo = -(t / step); if (jlo < lo) jlo = lo; const int hi = (SEQ - 1 - t) / step; if (jhi > hi) jhi = hi; }
    for (int j = jlo; j <= jhi; ++j) {
        const size_t tp = (size_t)(t + step * j);
        const unsigned kw = *(const unsigned*)(Kb + tp * ld + 2 * lane), vw = *(const unsigned*)(Vb + tp * ld + 2 * lane);
        const float s = wave_sum(q0 * bf_lo(kw) + q1 * bf_hi(kw)) * ATT_SCALE;
        const float mn = fmaxf(m, s);
        const float al = __expf(m - mn), p = __expf(s - mn);
        l = l * al + p;
        o0 = o0 * al + p * bf_lo(vw); o1 = o1 * al + p * bf_hi(vw);
        m = mn;
    }
}
__device__ __forceinline__ void attn_even_valu_phase(const bf16_t* __restrict__ hb, const float* __restrict__ sink, bf16_t* __restrict__ abb, const int bid, const int G, const int tid) {
    const int lane = tid & 63, wv = tid >> 6;
    const int LD = 12288;
    for (int job = bid * 8 + wv; job < SEQ * 24; job += G * 8) {
        const int hh = job / SEQ, t = job % SEQ;
        float o0 = 0.f, o1 = 0.f, m, l;
        if (hh < 16) {
            const int kv = hh >> 2;
            const unsigned qw = *(const unsigned*)(hb + (size_t)t * LD + hh * 128 + 2 * lane);
            m = sink[hh]; l = 1.f;
            attn_seg_b(bf_lo(qw), bf_hi(qw), hb + 2048 + kv * 128, hb + 2560 + kv * 128, LD, t, 1, -128, 128, m, l, o0, o1, lane);
        } else {
            const int hbh = hh - 16;
            m = -1e30f; l = 0.f;
#pragma unroll
            for (int g = 0; g < 3; ++g) {
                const int head = 8 * g + hbh; const int step = g == 0 ? 1 : (g == 1 ? 4 : 16);
                const unsigned qw = *(const unsigned*)(hb + (size_t)t * LD + 3072 + head * 128 + 2 * lane);
                attn_seg_b(bf_lo(qw), bf_hi(qw), hb + 6144 + head * 128, hb + 9216 + head * 128, LD, t, step, -64, 64, m, l, o0, o1, lane);
            }
        }
        const float il = 1.0f / l;
        *(unsigned*)(abb + (size_t)t * 3072 + hh * 128 + 2 * lane) = cvtpk_bf16(o0 * il, o1 * il);
    }
}

__device__ __forceinline__ void ln_phase(const float* __restrict__ y, const float* __restrict__ g, const float* __restrict__ b, float* __restrict__ stats, bf16_t* __restrict__ outb, const int bid, const int G, const int tid) {
    const int lane = tid & 63, wv = tid >> 6;
    for (int t = bid * 8 + wv; t < SEQ; t += G * 8) {
        float4 v[16]; float s = 0.f;
#pragma unroll
        for (int i = 0; i < 16; ++i) { v[i] = *(const float4*)(y + (size_t)t * DM + i * 256 + lane * 4); s += (v[i].x + v[i].y) + (v[i].z + v[i].w); }
        const float mean = wave_sum(s) * (1.0f / DM);
        float q = 0.f;
#pragma unroll
        for (int i = 0; i < 16; ++i) { const float a = v[i].x - mean, bb = v[i].y - mean, c = v[i].z - mean, d = v[i].w - mean; q += (a * a + bb * bb) + (c * c + d * d); }
        const float rstd = 1.0f / sqrtf(wave_sum(q) * (1.0f / DM) + 1e-5f);
        if (lane == 0) *(float2*)(stats + (size_t)t * 2) = make_float2(mean, rstd);
#pragma unroll
        for (int i = 0; i < 16; ++i) {
            const float4 gg = *(const float4*)(g + i * 256 + lane * 4), bb = *(const float4*)(b + i * 256 + lane * 4);
            float4 o; o.x = (v[i].x - mean) * rstd * gg.x + bb.x; o.y = (v[i].y - mean) * rstd * gg.y + bb.y; o.z = (v[i].z - mean) * rstd * gg.z + bb.z; o.w = (v[i].w - mean) * rstd * gg.w + bb.w;
            uint2 w; w.x = cvtpk_bf16(o.x, o.y); w.y = cvtpk_bf16(o.z, o.w); *(uint2*)(outb + (size_t)t * DM + i * 256 + lane * 4) = w;
            if ((i & 3) == 3) asm volatile("" ::: "memory");
        }
    }
}

__device__ __forceinline__ void route_valu_phase(const float* __restrict__ q  , const float* __restrict__ keys  , int* __restrict__ eidx, float* __restrict__ gate, const int bid, const int G, const int tid) {
    const int lane = tid & 63, wv = tid >> 6;
    for (int job = bid * 8 + wv; job < SEQ * 8; job += G * 8) {
        const int hh = job & 7, t = job >> 3;
        float sv0 = 0.f, sv1 = 0.f; int si0 = 0, si1 = 0;
#pragma unroll
        for (int c = 0; c < 2; ++c) {
            const float* qq = q + (size_t)t * 2048 + hh * 256 + c * 128;
            const float* k0 = keys + ((size_t)(hh * 2 + c) * 128 + lane) * 128;
            const float* k1 = k0 + 64 * 128;
            float s0 = 0.f, s1 = 0.f;
            for (int d = 0; d < 128; d += 4) {
                const float4 qv = *(const float4*)(qq + d), a = *(const float4*)(k0 + d), b = *(const float4*)(k1 + d);
                s0 += qv.x * a.x + qv.y * a.y + qv.z * a.z + qv.w * a.w;
                s1 += qv.x * b.x + qv.y * b.y + qv.z * b.z + qv.w * b.w;
            }
            float myv = 0.f; int myi = 0;
            for (int k = 0; k < 16; ++k) {
                float bv; int bi;
                if (s1 > s0) { bv = s1; bi = lane + 64; } else { bv = s0; bi = lane; }
#pragma unroll
                for (int o = 32; o >= 1; o >>= 1) {
                    const float ov = __shfl_xor(bv, o); const int oi = __shfl_xor(bi, o);
                    if (ov > bv || (ov == bv && oi < bi)) { bv = ov; bi = oi; }
                }
                if (lane == k) { myv = bv; myi = bi; }
                if (bi == lane) s0 = -3.0e38f;
                if (bi == lane + 64) s1 = -3.0e38f;
            }
            if (c == 0) { sv0 = myv; si0 = myi; } else { sv1 = myv; si1 = myi; }
        }
        float cv0, cv1, cv2, cv3; int ci0, ci1, ci2, ci3;
        { const float a = __shfl(sv0, lane >> 2); const int ai = __shfl(si0, lane >> 2); const int jb = (lane & 3) * 4;
          cv0 = a + __shfl(sv1, jb + 0); ci0 = ai * 128 + __shfl(si1, jb + 0);
          cv1 = a + __shfl(sv1, jb + 1); ci1 = ai * 128 + __shfl(si1, jb + 1);
          cv2 = a + __shfl(sv1, jb + 2); ci2 = ai * 128 + __shfl(si1, jb + 2);
          cv3 = a + __shfl(sv1, jb + 3); ci3 = ai * 128 + __shfl(si1, jb + 3); }
        float tv = 0.f; int te = 0;
        for (int k = 0; k < 16; ++k) {
            float bv = cv0; int bp = lane * 4, be = ci0;
            if (cv1 > bv) { bv = cv1; bp = lane * 4 + 1; be = ci1; }
            if (cv2 > bv) { bv = cv2; bp = lane * 4 + 2; be = ci2; }
            if (cv3 > bv) { bv = cv3; bp = lane * 4 + 3; be = ci3; }
#pragma unroll
            for (int o = 32; o >= 1; o >>= 1) {
                const float ov = __shfl_xor(bv, o); const int op = __shfl_xor(bp, o); const int oe = __shfl_xor(be, o);
                if (ov > bv || (ov == bv && op < bp)) { bv = ov; bp = op; be = oe; }
            }
            if (lane == k) { tv = bv; te = be; }
            if (bp == lane * 4 + 0) cv0 = -3.0e38f;
            if (bp == lane * 4 + 1) cv1 = -3.0e38f;
            if (bp == lane * 4 + 2) cv2 = -3.0e38f;
            if (bp == lane * 4 + 3) cv3 = -3.0e38f;
        }
        const float v = lane < 16 ? tv : -3.0e38f;
        const float mx = wave_max(v);
        const float e = lane < 16 ? __expf(tv - mx) : 0.f;
        const float den = wave_sum(e);
        if (lane < 16) { eidx[(size_t)t * 128 + hh * 16 + lane] = te; gate[(size_t)t * 128 + hh * 16 + lane] = e / den; }
    }
}
namespace rt {
using att::f32x16; using att::bf16x8;
__device__ __forceinline__ float pair_max(float m) {
    auto rr = __builtin_amdgcn_permlane32_swap(__float_as_uint(m), __float_as_uint(m), false, false);
    return fmaxf(__uint_as_float(rr[0]), __uint_as_float(rr[1]));
}
__device__ __forceinline__ int pair_max_i(int m) {
    auto rr = __builtin_amdgcn_permlane32_swap((unsigned)m, (unsigned)m, false, false);
    const int a = (int)rr[0], b = (int)rr[1]; return a > b ? a : b;
}
__device__ __forceinline__ void top16_of_128(f32x16& p0, f32x16& p1, f32x16& p2, f32x16& p3, float (&t)[16]) {
#pragma unroll
    for (int k = 0; k < 16; ++k) {
        float m = p0[0];
#pragma unroll
        for (int r = 1; r < 16; ++r) m = fmaxf(m, p0[r]);
#pragma unroll
        for (int r = 0; r < 16; ++r) m = fmaxf(m, fmaxf(p1[r], fmaxf(p2[r], p3[r])));
        m = pair_max(m);
        t[k] = m;
#pragma unroll
        for (int r = 0; r < 16; ++r) { p0[r] = p0[r] == m ? -3.0e38f : p0[r]; p1[r] = p1[r] == m ? -3.0e38f : p1[r]; p2[r] = p2[r] == m ? -3.0e38f : p2[r]; p3[r] = p3[r] == m ? -3.0e38f : p3[r]; }
    }
}
__device__ __forceinline__ void tag_scores(f32x16& p, const int base, const int hi) {
#pragma unroll
    for (int r = 0; r < 16; ++r) p[r] = __uint_as_float((__float_as_uint(p[r]) & ~0x7Fu) | (unsigned)(base + att::crow(r, hi)));
}
}

__device__ __forceinline__ void route_mfma_phase(const bf16_t* __restrict__ pqb  , const bf16_t* __restrict__ keysb  , int* __restrict__ eidx, float* __restrict__ gate,
                                                 char* lds, const pg8::StaticOrder& S, const int tid) {
    using namespace rt;
    const int wid = __builtin_amdgcn_readfirstlane(tid >> 6), lane = tid & 63, r32 = lane & 31, hi = lane >> 5;
    att::bf16* K_lds = (att::bf16*)lds;
    pg8::Unit un;
    for (int ui = 0; S.next(ui, un); ++ui) {
        const int h = un.pn, tb = un.pm * 256;
        const int tok = tb + wid * 32 + r32;
        float t0[16], t1[16];
#pragma unroll
        for (int c = 0; c < 2; ++c) {
            __syncthreads();
            { const bf16_t* kp = keysb + (size_t)(h * 2 + c) * 128 * 128;
              const int row = tid >> 2;
#pragma unroll
              for (int i = 0; i < 4; ++i) { const int sc = ((tid & 3) * 4 + i) * 8;
                  const bf16x8 v = *reinterpret_cast<const bf16x8*>(kp + row * 128 + sc);
                  *(bf16x8*)((char*)K_lds + (row >> 6) * 16384 + KSWZ(row & 63, sc * 2)) = v; } }
            bf16x8 qr[8];
            { const bf16_t* qw = pqb + (size_t)tok * 2048 + h * 256 + c * 128 + hi * 8;
#pragma unroll
              for (int d0 = 0; d0 < 8; ++d0) qr[d0] = *reinterpret_cast<const bf16x8*>(qw + d0 * 16); }
            __syncthreads();
            f32x16 p0, p1, p2, p3;
            att::qkt(p0, p1, K_lds, qr, r32, hi);
            att::qkt(p2, p3, (att::bf16*)((char*)K_lds + 16384), qr, r32, hi);
            tag_scores(p0, 0, hi); tag_scores(p1, 32, hi); tag_scores(p2, 64, hi); tag_scores(p3, 96, hi);
            if (c == 0) top16_of_128(p0, p1, p2, p3, t0); else top16_of_128(p0, p1, p2, p3, t1);
        }
        float v0[16], v1[16]; int k0[16], k1[16];
#pragma unroll
        for (int i = 0; i < 16; ++i) { const unsigned a = __float_as_uint(t0[i]), b = __float_as_uint(t1[i]);
            v0[i] = __uint_as_float(a & ~0x7Fu); v1[i] = __uint_as_float(b & ~0x7Fu); k0[i] = (int)((a & 0x7Fu) << 7); k1[i] = (int)(b & 0x7Fu); }
        float cv[25]; int ce[25];
    { const float s = hi ? (v0[0] + v1[1]) : (v0[0] + v1[0]); cv[0] = __uint_as_float((__float_as_uint(s) & ~0xFFu) | (unsigned)(2 * 0 + hi)); ce[0] = hi ? (k0[0] | k1[1]) : (k0[0] | k1[0]); }
    { const float s = hi ? (v0[0] + v1[3]) : (v0[0] + v1[2]); cv[1] = __uint_as_float((__float_as_uint(s) & ~0xFFu) | (unsigned)(2 * 1 + hi)); ce[1] = hi ? (k0[0] | k1[3]) : (k0[0] | k1[2]); }
    { const float s = hi ? (v0[0] + v1[5]) : (v0[0] + v1[4]); cv[2] = __uint_as_float((__float_as_uint(s) & ~0xFFu) | (unsigned)(2 * 2 + hi)); ce[2] = hi ? (k0[0] | k1[5]) : (k0[0] | k1[4]); }
    { const float s = hi ? (v0[0] + v1[7]) : (v0[0] + v1[6]); cv[3] = __uint_as_float((__float_as_uint(s) & ~0xFFu) | (unsigned)(2 * 3 + hi)); ce[3] = hi ? (k0[0] | k1[7]) : (k0[0] | k1[6]); }
    { const float s = hi ? (v0[0] + v1[9]) : (v0[0] + v1[8]); cv[4] = __uint_as_float((__float_as_uint(s) & ~0xFFu) | (unsigned)(2 * 4 + hi)); ce[4] = hi ? (k0[0] | k1[9]) : (k0[0] | k1[8]); }
    { const float s = hi ? (v0[0] + v1[11]) : (v0[0] + v1[10]); cv[5] = __uint_as_float((__float_as_uint(s) & ~0xFFu) | (unsigned)(2 * 5 + hi)); ce[5] = hi ? (k0[0] | k1[11]) : (k0[0] | k1[10]); }
    { const float s = hi ? (v0[0] + v1[13]) : (v0[0] + v1[12]); cv[6] = __uint_as_float((__float_as_uint(s) & ~0xFFu) | (unsigned)(2 * 6 + hi)); ce[6] = hi ? (k0[0] | k1[13]) : (k0[0] | k1[12]); }
    { const float s = hi ? (v0[0] + v1[15]) : (v0[0] + v1[14]); cv[7] = __uint_as_float((__float_as_uint(s) & ~0xFFu) | (unsigned)(2 * 7 + hi)); ce[7] = hi ? (k0[0] | k1[15]) : (k0[0] | k1[14]); }
    { const float s = hi ? (v0[1] + v1[1]) : (v0[1] + v1[0]); cv[8] = __uint_as_float((__float_as_uint(s) & ~0xFFu) | (unsigned)(2 * 8 + hi)); ce[8] = hi ? (k0[1] | k1[1]) : (k0[1] | k1[0]); }
    { const float s = hi ? (v0[1] + v1[3]) : (v0[1] + v1[2]); cv[9] = __uint_as_float((__float_as_uint(s) & ~0xFFu) | (unsigned)(2 * 9 + hi)); ce[9] = hi ? (k0[1] | k1[3]) : (k0[1] | k1[2]); }
    { const float s = hi ? (v0[1] + v1[5]) : (v0[1] + v1[4]); cv[10] = __uint_as_float((__float_as_uint(s) & ~0xFFu) | (unsigned)(2 * 10 + hi)); ce[10] = hi ? (k0[1] | k1[5]) : (k0[1] | k1[4]); }
    { const float s = hi ? (v0[1] + v1[7]) : (v0[1] + v1[6]); cv[11] = __uint_as_float((__float_as_uint(s) & ~0xFFu) | (unsigned)(2 * 11 + hi)); ce[11] = hi ? (k0[1] | k1[7]) : (k0[1] | k1[6]); }
    { const float s = hi ? (v0[2] + v1[1]) : (v0[2] + v1[0]); cv[12] = __uint_as_float((__float_as_uint(s) & ~0xFFu) | (unsigned)(2 * 12 + hi)); ce[12] = hi ? (k0[2] | k1[1]) : (k0[2] | k1[0]); }
    { const float s = hi ? (v0[2] + v1[3]) : (v0[2] + v1[2]); cv[13] = __uint_as_float((__float_as_uint(s) & ~0xFFu) | (unsigned)(2 * 13 + hi)); ce[13] = hi ? (k0[2] | k1[3]) : (k0[2] | k1[2]); }
    { const float s = hi ? (v0[3] + v1[0]) : (v0[2] + v1[4]); cv[14] = __uint_as_float((__float_as_uint(s) & ~0xFFu) | (unsigned)(2 * 14 + hi)); ce[14] = hi ? (k0[3] | k1[0]) : (k0[2] | k1[4]); }
    { const float s = hi ? (v0[3] + v1[2]) : (v0[3] + v1[1]); cv[15] = __uint_as_float((__float_as_uint(s) & ~0xFFu) | (unsigned)(2 * 15 + hi)); ce[15] = hi ? (k0[3] | k1[2]) : (k0[3] | k1[1]); }
    { const float s = hi ? (v0[4] + v1[0]) : (v0[3] + v1[3]); cv[16] = __uint_as_float((__float_as_uint(s) & ~0xFFu) | (unsigned)(2 * 16 + hi)); ce[16] = hi ? (k0[4] | k1[0]) : (k0[3] | k1[3]); }
    { const float s = hi ? (v0[4] + v1[2]) : (v0[4] + v1[1]); cv[17] = __uint_as_float((__float_as_uint(s) & ~0xFFu) | (unsigned)(2 * 17 + hi)); ce[17] = hi ? (k0[4] | k1[2]) : (k0[4] | k1[1]); }
    { const float s = hi ? (v0[5] + v1[1]) : (v0[5] + v1[0]); cv[18] = __uint_as_float((__float_as_uint(s) & ~0xFFu) | (unsigned)(2 * 18 + hi)); ce[18] = hi ? (k0[5] | k1[1]) : (k0[5] | k1[0]); }
    { const float s = hi ? (v0[6] + v1[1]) : (v0[6] + v1[0]); cv[19] = __uint_as_float((__float_as_uint(s) & ~0xFFu) | (unsigned)(2 * 19 + hi)); ce[19] = hi ? (k0[6] | k1[1]) : (k0[6] | k1[0]); }
    { const float s = hi ? (v0[7] + v1[1]) : (v0[7] + v1[0]); cv[20] = __uint_as_float((__float_as_uint(s) & ~0xFFu) | (unsigned)(2 * 20 + hi)); ce[20] = hi ? (k0[7] | k1[1]) : (k0[7] | k1[0]); }
    { const float s = hi ? (v0[9] + v1[0]) : (v0[8] + v1[0]); cv[21] = __uint_as_float((__float_as_uint(s) & ~0xFFu) | (unsigned)(2 * 21 + hi)); ce[21] = hi ? (k0[9] | k1[0]) : (k0[8] | k1[0]); }
    { const float s = hi ? (v0[11] + v1[0]) : (v0[10] + v1[0]); cv[22] = __uint_as_float((__float_as_uint(s) & ~0xFFu) | (unsigned)(2 * 22 + hi)); ce[22] = hi ? (k0[11] | k1[0]) : (k0[10] | k1[0]); }
    { const float s = hi ? (v0[13] + v1[0]) : (v0[12] + v1[0]); cv[23] = __uint_as_float((__float_as_uint(s) & ~0xFFu) | (unsigned)(2 * 23 + hi)); ce[23] = hi ? (k0[13] | k1[0]) : (k0[12] | k1[0]); }
    { const float s = hi ? (v0[15] + v1[0]) : (v0[14] + v1[0]); cv[24] = __uint_as_float((__float_as_uint(s) & ~0xFFu) | (unsigned)(2 * 24 + hi)); ce[24] = hi ? (k0[15] | k1[0]) : (k0[14] | k1[0]); }
        float ts[16]; int te[16];
#pragma unroll
        for (int k = 0; k < 16; ++k) {
            float m = cv[0];
#pragma unroll
            for (int n = 1; n < 25; ++n) m = fmaxf(m, cv[n]);
            m = pair_max(m);
            int e = -1;
#pragma unroll
            for (int n = 0; n < 25; ++n) { const bool hit = cv[n] == m; e = hit ? ce[n] : e; cv[n] = hit ? -3.0e38f : cv[n]; }
            ts[k] = __uint_as_float(__float_as_uint(m) & ~0xFFu); te[k] = pair_max_i(e);
        }
        float den = 0.f; const float mx = ts[0];
#pragma unroll
        for (int k = 0; k < 16; ++k) { ts[k] = __expf(ts[k] - mx); den += ts[k]; }
        const float inv = 1.0f / den;
        if (hi == 0) { int4* op = (int4*)(eidx + (size_t)tok * 128 + h * 16);
            op[0] = make_int4(te[0], te[1], te[2], te[3]); op[1] = make_int4(te[4], te[5], te[6], te[7]); op[2] = make_int4(te[8], te[9], te[10], te[11]); op[3] = make_int4(te[12], te[13], te[14], te[15]); }
        else { float4* op = (float4*)(gate + (size_t)tok * 128 + h * 16);
            op[0] = make_float4(ts[0] * inv, ts[1] * inv, ts[2] * inv, ts[3] * inv); op[1] = make_float4(ts[4] * inv, ts[5] * inv, ts[6] * inv, ts[7] * inv);
            op[2] = make_float4(ts[8] * inv, ts[9] * inv, ts[10] * inv, ts[11] * inv); op[3] = make_float4(ts[12] * inv, ts[13] * inv, ts[14] * inv, ts[15] * inv); }
    }
}
#ifndef PH_MASK
#define PH_MASK 0xffffffffu
#endif
constexpr int N_PHASES = 20;
__global__ void __launch_bounds__(512, 2) mega(MK a) {
    extern __shared__ __attribute__((aligned(16))) unsigned char lds_raw[];
    LDSA unsigned char* lds = (LDSA unsigned char*)lds_raw;
    const int lo = a.ph_lo, hi = a.ph_hi;
    const int G = gridDim.x, bid = blockIdx.x;
    const int wid_s = __builtin_amdgcn_readfirstlane(threadIdx.x >> 6);
    unsigned char* ws = a.ws;
#define PH_TID() int tid; { int _z = 0; asm volatile("" : "+s"(_z)); tid = wid_s * 64 + (int)__builtin_amdgcn_mbcnt_hi(~0u, __builtin_amdgcn_mbcnt_lo(~0u, (unsigned)_z)); }
#define WSP(T, name, off) T* name; { unsigned char* _b = ws; asm volatile("" : "+s"(_b)); name = (T*)(_b + (off)); }
#define IN(k) ((((PH_MASK) >> (k)) & 1u) && lo <= (k) && (k) < hi)
#define SEAM(k) do { if ((k) + 1 < hi) { PH_TID() xcd_barrier(bar, tid); } } while (0)
    XcdBarrier bar;
    { PH_TID()
      volatile LAS unsigned* st = (volatile LAS unsigned*)(lds + LDS_MISC);
      if (tid == 0) { st[0] = 0u; st[1] = 0u; }
      __syncthreads();
      bar = xcd_barrier_post((unsigned*)(ws + WS_CTL), st, tid); }

    if (IN(0)) {
#ifdef PROBE_PRO2
      for (int rep = 0; rep < 2; ++rep) {
#else
      {
#endif
        PH_TID()
        WSP(bf16_t, xb, WS_XB) WSP(bf16_t, wab, WS_WAB) WSP(bf16_t, woab, WS_WOAB) WSP(bf16_t, wcd, WS_WCD) WSP(bf16_t, wocd, WS_WOCD) WSP(bf16_t, wq, WS_WQ) WSP(unsigned char, ub, WS_UB) WSP(unsigned char, vb, WS_VB) WSP(float, isu, WS_SU) WSP(float, isv, WS_SV)
        cvt_rows_bf16(a.in[0], xb, (size_t)SEQ * DM / 8, bid, G, tid, 512);
        LDSA float* tile = (LDSA float*)lds;
        transpose_cvt(a.in[1], wab, 4096, 12288, tile, bid, G, PermAB(), tid);
        transpose_cvt(a.in[3], woab, 3072, 4096, tile, bid, G, PermNone(), tid);
        transpose_cvt(a.in[4], wcd, 4096, 9216, tile, bid, G, PermCD(), tid);
        transpose_cvt(a.in[12], wocd, 4096, 4096, tile, bid, G, PermNone(), tid);
        transpose_cvt(a.in[15], wq, 4096, 2048, tile, bid, G, PermNone(), tid);
        transpose_cvt(a.in[15] + (size_t)4096 * 2048, wq + (size_t)2048 * 4096, 4096, 2048, tile, bid, G, PermNone(), tid);
        table_fp6(a.in[17], ub, isu, 2 * 16384, (LDSA float*)lds, bid, G, tid);
        table_fp6(a.in[18], vb, isv, 2 * 16384, (LDSA float*)lds, bid, G, tid);
        { WSP(float, cs0, WS_CS0) WSP(float, csa, WS_CSA) rope_tables(cs0, csa, bid, G, tid); }
        { WSP(bf16_t, keyb, WS_KEYB) cvt_rows_bf16(a.in[16], keyb, (size_t)2 * 8 * 2 * 128 * 128 / 8, bid, G, tid, 512); }
      }
        SEAM(0);
    }
    { constexpr int layer = 0;
        const int pb = 1 + 10 * layer;
        if (IN(pb + 0)) {
            PH_TID() WSP(bf16_t, xb, WS_XB) WSP(bf16_t, x2b, WS_X2B) WSP(bf16_t, wab, WS_WAB) WSP(bf16_t, wcd, WS_WCD) WSP(bf16_t, hb, WS_HB) WSP(float, cs0, WS_CS0) WSP(float, csa, WS_CSA)
            if (layer == 0) {
                pg8::Gemm g{xb, wab, SEQ, 12288, 4096}; pg8::StaticOrder S; S.init(SEQ, 12288, G, bid);
                pg8::EpiProj<0> E{hb, 12288, cs0, csa, nullptr, nullptr, (LDSA float*)(lds + LDS_MISC + 64)};
                pg8::gemm_phase<pg8::EpiProj<0>, pg8::StaticOrder>(lds, g, S, E, nullptr, tid);
#ifdef PROBE_GEMM2
                pg8::gemm_phase<pg8::EpiProj<0>, pg8::StaticOrder>(lds, g, S, E, nullptr, tid);
#endif
            } else {
                pg8::Gemm g{x2b, wcd, SEQ, 9216, 4096}; pg8::StaticOrder S; S.init(SEQ, 9216, G, bid);
                pg8::EpiProj<1> E{hb, 9216, cs0, csa, a.in[10], a.in[11], (LDSA float*)(lds + LDS_MISC + 64)};
                pg8::gemm_phase<pg8::EpiProj<1>, pg8::StaticOrder>(lds, g, S, E, nullptr, tid);
            }
            SEAM(pb + 0);
        }
        if (IN(pb + 2)) {
            PH_TID() WSP(bf16_t, hb, WS_HB) WSP(bf16_t, abb, WS_AB) WSP(float, oc, WS_OC)
            if (layer == 0) attn0_phase(hb, a.in[2], abb, (bf16_t*)oc, (float*)((unsigned char*)oc + (size_t)3 * 8 * SEQ * 128 * 2), (char*)lds_raw, bid, G, tid);
#ifdef PROBE_SMALL
            if (layer == 0) { __syncthreads(); int t3 = tid; asm volatile("" : "+v"(t3)); attn0_phase(hb, a.in[2], abb, (bf16_t*)oc, (float*)((unsigned char*)oc + (size_t)3 * 8 * SEQ * 128 * 2), (char*)lds_raw, bid, G, t3); }
#endif
            else attn1_phase(hb, abb, oc, a.in[5], a.in[6], a.in[7], a.in[8], a.in[9], (char*)lds_raw, bid, G, tid);
#ifdef PROBE_ATTN2
            if (layer == 1) { __syncthreads(); int t3 = tid; asm volatile("" : "+v"(t3)); attn1_phase(hb, abb, oc, a.in[5], a.in[6], a.in[7], a.in[8], a.in[9], (char*)lds_raw, bid, G, t3); }
#endif
            SEAM(pb + 2);
        }
        if (layer == 0) {
            if (IN(pb + 3)) {
                PH_TID() WSP(bf16_t, abb, WS_AB) WSP(float, oc, WS_OC)
                merge0_phase((const bf16_t*)oc, (const float*)((unsigned char*)oc + (size_t)3 * 8 * SEQ * 128 * 2), abb, bid, G, tid);
#ifdef PROBE_SMALL
                merge0_phase((const bf16_t*)oc, (const float*)((unsigned char*)oc + (size_t)3 * 8 * SEQ * 128 * 2), abb, bid, G, tid);
#endif
                SEAM(pb + 3);
            }
        } else {
        }
        if (IN(pb + 4)) {
            const int K = layer == 0 ? 3072 : 4096;
            PH_TID() WSP(bf16_t, abb, WS_AB) WSP(bf16_t, woab, WS_WOAB) WSP(bf16_t, wocd, WS_WOCD) WSP(float, ybuf, WS_Y) WSP(float, x2, WS_X2)
            pg8::Gemm g{abb, layer == 0 ? woab : wocd, SEQ, 4096, K}; pg8::StaticOrder S; S.init(SEQ, 4096, G, bid);
            pg8::EpiF32R E{ybuf, 4096, layer == 0 ? a.in[0] : (const float*)x2, ALPHA};
            pg8::gemm_phase<pg8::EpiF32R, pg8::StaticOrder>(lds, g, S, E, nullptr, tid);
            SEAM(pb + 4);
        }
        if (IN(pb + 5)) {
            PH_TID() WSP(float, ybuf, WS_Y) WSP(float, stats, WS_X1) WSP(bf16_t, x1b, WS_X1B)
            ln_phase(ybuf, a.in[13] + layer * DM, a.in[14] + layer * DM, stats, x1b, bid, G, tid);
            SEAM(pb + 5);
        }
        if (IN(pb + 6)) {
            PH_TID() WSP(bf16_t, x1b, WS_X1B) WSP(bf16_t, wq, WS_WQ) WSP(bf16_t, pqb, WS_PQ)
            pg8::Gemm g{x1b, wq + (size_t)layer * 2048 * 4096, SEQ, 2048, 4096}; pg8::StaticOrder S; S.init(SEQ, 2048, G, bid);
            pg8::EpiBf16P E{pqb, 2048};
            pg8::gemm_phase<pg8::EpiBf16P, pg8::StaticOrder>(lds, g, S, E, nullptr, tid);
            asm volatile("s_waitcnt vmcnt(0)" ::: "memory"); __syncthreads();
            { WSP(bf16_t, keyb, WS_KEYB) WSP(int, eidx, WS_EIDX) WSP(float, gate, WS_GATE)
              int t4 = tid; asm volatile("" : "+v"(t4));
              route_mfma_phase(pqb, keyb + (size_t)layer * 8 * 2 * 128 * 128, eidx, gate, (char*)lds_raw, S, t4); }
            SEAM(pb + 6);
        }
        if (IN(pb + 8)) {
            PH_TID() WSP(float, ybuf, WS_Y) WSP(float, stats, WS_X1) WSP(bf16_t, x1b, WS_X1B) WSP(int, eidx, WS_EIDX) WSP(float, gate, WS_GATE) WSP(unsigned char, ub, WS_UB) WSP(unsigned char, vb, WS_VB) WSP(float, isu, WS_SU) WSP(float, isv, WS_SV) WSP(float, x2, WS_X2) WSP(bf16_t, x2b, WS_X2B)
            peer_expert_phase(ybuf, stats, a.in[13] + layer * DM, a.in[14] + layer * DM, x1b, eidx, gate, ub + (size_t)layer * 16384 * ROWB, vb + (size_t)layer * 16384 * ROWB, isu + layer * 16384, isv + layer * 16384, a.in[19] + layer * DM, a.in[20] + layer * DM,
                              layer == 0 ? x2 : a.out, layer == 0 ? x2b : (bf16_t*)nullptr, (LDSA float*)lds, bid, G, tid);
            SEAM(pb + 8);
        }
        }
    { constexpr int layer = 1;
        const int pb = 1 + 10 * layer;
        if (IN(pb + 0)) {
            PH_TID() WSP(bf16_t, xb, WS_XB) WSP(bf16_t, x2b, WS_X2B) WSP(bf16_t, wab, WS_WAB) WSP(bf16_t, wcd, WS_WCD) WSP(bf16_t, hb, WS_HB) WSP(float, cs0, WS_CS0) WSP(float, csa, WS_CSA)
            if (layer == 0) {
                pg8::Gemm g{xb, wab, SEQ, 12288, 4096}; pg8::StaticOrder S; S.init(SEQ, 12288, G, bid);
                pg8::EpiProj<0> E{hb, 12288, cs0, csa, nullptr, nullptr, (LDSA float*)(lds + LDS_MISC + 64)};
                pg8::gemm_phase<pg8::EpiProj<0>, pg8::StaticOrder>(lds, g, S, E, nullptr, tid);
#ifdef PROBE_GEMM2
                pg8::gemm_phase<pg8::EpiProj<0>, pg8::StaticOrder>(lds, g, S, E, nullptr, tid);
#endif
            } else {
                pg8::Gemm g{x2b, wcd, SEQ, 9216, 4096}; pg8::StaticOrder S; S.init(SEQ, 9216, G, bid);
                pg8::EpiProj<1> E{hb, 9216, cs0, csa, a.in[10], a.in[11], (LDSA float*)(lds + LDS_MISC + 64)};
                pg8::gemm_phase<pg8::EpiProj<1>, pg8::StaticOrder>(lds, g, S, E, nullptr, tid);
            }
            SEAM(pb + 0);
        }
        if (IN(pb + 2)) {
            PH_TID() WSP(bf16_t, hb, WS_HB) WSP(bf16_t, abb, WS_AB) WSP(float, oc, WS_OC)
            if (layer == 0) attn0_phase(hb, a.in[2], abb, (bf16_t*)oc, (float*)((unsigned char*)oc + (size_t)3 * 8 * SEQ * 128 * 2), (char*)lds_raw, bid, G, tid);
#ifdef PROBE_SMALL
            if (layer == 0) { __syncthreads(); int t3 = tid; asm volatile("" : "+v"(t3)); attn0_phase(hb, a.in[2], abb, (bf16_t*)oc, (float*)((unsigned char*)oc + (size_t)3 * 8 * SEQ * 128 * 2), (char*)lds_raw, bid, G, t3); }
#endif
            else attn1_phase(hb, abb, oc, a.in[5], a.in[6], a.in[7], a.in[8], a.in[9], (char*)lds_raw, bid, G, tid);
#ifdef PROBE_ATTN2
            if (layer == 1) { __syncthreads(); int t3 = tid; asm volatile("" : "+v"(t3)); attn1_phase(hb, abb, oc, a.in[5], a.in[6], a.in[7], a.in[8], a.in[9], (char*)lds_raw, bid, G, t3); }
#endif
            SEAM(pb + 2);
        }
        if (layer == 0) {
            if (IN(pb + 3)) {
                PH_TID() WSP(bf16_t, abb, WS_AB) WSP(float, oc, WS_OC)
                merge0_phase((const bf16_t*)oc, (const float*)((unsigned char*)oc + (size_t)3 * 8 * SEQ * 128 * 2), abb, bid, G, tid);
#ifdef PROBE_SMALL
                merge0_phase((const bf16_t*)oc, (const float*)((unsigned char*)oc + (size_t)3 * 8 * SEQ * 128 * 2), abb, bid, G, tid);
#endif
                SEAM(pb + 3);
            }
        } else {
        }
        if (IN(pb + 4)) {
            const int K = layer == 0 ? 3072 : 4096;
            PH_TID() WSP(bf16_t, abb, WS_AB) WSP(bf16_t, woab, WS_WOAB) WSP(bf16_t, wocd, WS_WOCD) WSP(float, ybuf, WS_Y) WSP(float, x2, WS_X2)
            pg8::Gemm g{abb, layer == 0 ? woab : wocd, SEQ, 4096, K}; pg8::StaticOrder S; S.init(SEQ, 4096, G, bid);
            pg8::EpiF32R E{ybuf, 4096, layer == 0 ? a.in[0] : (const float*)x2, ALPHA};
            pg8::gemm_phase<pg8::EpiF32R, pg8::StaticOrder>(lds, g, S, E, nullptr, tid);
            SEAM(pb + 4);
        }
        if (IN(pb + 5)) {
            PH_TID() WSP(float, ybuf, WS_Y) WSP(float, stats, WS_X1) WSP(bf16_t, x1b, WS_X1B)
            ln_phase(ybuf, a.in[13] + layer * DM, a.in[14] + layer * DM, stats, x1b, bid, G, tid);
            SEAM(pb + 5);
        }
        if (IN(pb + 6)) {
            PH_TID() WSP(bf16_t, x1b, WS_X1B) WSP(bf16_t, wq, WS_WQ) WSP(bf16_t, pqb, WS_PQ)
            pg8::Gemm g{x1b, wq + (size_t)layer * 2048 * 4096, SEQ, 2048, 4096}; pg8::StaticOrder S; S.init(SEQ, 2048, G, bid);
            pg8::EpiBf16P E{pqb, 2048};
            pg8::gemm_phase<pg8::EpiBf16P, pg8::StaticOrder>(lds, g, S, E, nullptr, tid);
            asm volatile("s_waitcnt vmcnt(0)" ::: "memory"); __syncthreads();
            { WSP(bf16_t, keyb, WS_KEYB) WSP(int, eidx, WS_EIDX) WSP(float, gate, WS_GATE)
              int t4 = tid; asm volatile("" : "+v"(t4));
              route_mfma_phase(pqb, keyb + (size_t)layer * 8 * 2 * 128 * 128, eidx, gate, (char*)lds_raw, S, t4); }
            SEAM(pb + 6);
        }
        if (IN(pb + 8)) {
            PH_TID() WSP(float, ybuf, WS_Y) WSP(float, stats, WS_X1) WSP(bf16_t, x1b, WS_X1B) WSP(int, eidx, WS_EIDX) WSP(float, gate, WS_GATE) WSP(unsigned char, ub, WS_UB) WSP(unsigned char, vb, WS_VB) WSP(float, isu, WS_SU) WSP(float, isv, WS_SV) WSP(float, x2, WS_X2) WSP(bf16_t, x2b, WS_X2B)
            peer_expert_phase(ybuf, stats, a.in[13] + layer * DM, a.in[14] + layer * DM, x1b, eidx, gate, ub + (size_t)layer * 16384 * ROWB, vb + (size_t)layer * 16384 * ROWB, isu + layer * 16384, isv + layer * 16384, a.in[19] + layer * DM, a.in[20] + layer * DM,
                              layer == 0 ? x2 : a.out, layer == 0 ? x2b : (bf16_t*)nullptr, (LDSA float*)lds, bid, G, tid);
            SEAM(pb + 8);
        }
        }

#ifdef PROBE_FP6
    if (bid == 0 && hi == N_PHASES) {
        PH_TID()
        if (tid == 0) {
            v16f_t s0, s1; float xs[32];
#pragma unroll
            for (int i = 0; i < 32; ++i) { const int e = i >> 3, m = i & 7; const float v = e == 0 ? 0.125f * m : (float)(1 << (e - 1)) * (1.0f + 0.125f * m); xs[i] = v; if (i < 16) s0[i] = v; else s1[i - 16] = v; }
            const v6u_t w = __builtin_amdgcn_cvt_scalef32_2xpk16_fp6_f32(s0, s1, 1.0f);
            const v32f_t y = __builtin_amdgcn_cvt_scalef32_pk32_f32_fp6(w, 1.0f);
            const v16u_t zb = __builtin_bit_cast(v16u_t, __builtin_amdgcn_cvt_scalef32_pk32_bf16_fp6(w, 1.0f));
            const v32f_t y2 = __builtin_amdgcn_cvt_scalef32_pk32_f32_fp6(w, 2.0f);
            const v6u_t w2 = __builtin_amdgcn_cvt_scalef32_2xpk16_fp6_f32(s0, s1, 2.0f);
            const v32f_t y3 = __builtin_amdgcn_cvt_scalef32_pk32_f32_fp6(w2, 1.0f);
            bool id32 = true, id16 = true, il32 = true;
#pragma unroll
            for (int i = 0; i < 32; ++i) { id32 = id32 && (y[i] == xs[i]);
                const unsigned d = zb[i >> 1]; const float b = (i & 1) ? bf_hi(d) : bf_lo(d); id16 = id16 && (b == xs[i]);
                const int src = (i & 1) ? 16 + (i >> 1) : (i >> 1); il32 = il32 && (y[i] == xs[src]); }
            int code = 64;
            if (id32) code += 1; if (id16) code += 2; if (il32) code += 4;
            if (y2[9] == 2.0f * y[9]) code += 8;
            if (y3[20] * 2.0f == y[20]) code += 16;
            if (y[1] == xs[1]) code += 32;
            a.out[0] += (float)code;
        }
    }
#endif
#undef IN
}
#ifndef ONE_LAUNCH
#define ONE_LAUNCH 1
#endif
extern "C" void kernel_launch(void* const* d_in, const int* in_sizes, int n_in, void* d_out, int out_size, void* d_ws, size_t ws_size, hipStream_t stream) {
    static int ready = 0;
    if (!ready) {
        if (ws_size < WS_END) { fprintf(stderr, "kernel_launch: workspace too small: %zu < %zu\n", ws_size, (size_t)WS_END); return; }
        if (hipFuncSetAttribute((const void*)mega, hipFuncAttributeMaxDynamicSharedMemorySize, LDS_BYTES) != hipSuccess) { fprintf(stderr, "kernel_launch: hipFuncSetAttribute failed\n"); return; }
        int per_cu = 0;
        if (hipOccupancyMaxActiveBlocksPerMultiprocessor(&per_cu, (const void*)mega, 512, LDS_BYTES) != hipSuccess || per_cu < 1) fprintf(stderr, "kernel_launch: note: occupancy query reports %d blocks per CU\n", per_cu);
        (void)hipGetLastError();
        ready = 1;
    }
    unsigned char* ws = (unsigned char*)d_ws;
    (void)hipMemsetAsync(ws + WS_CTL, 0, CTL_BYTES, stream);
    MK a{}; for (int i = 0; i < 21; ++i) a.in[i] = (const float*)d_in[i];
    a.out = (float*)d_out; a.ws = ws;
#if ONE_LAUNCH
    a.ph_lo = 0; a.ph_hi = N_PHASES;
    hipLaunchKernelGGL(mega, dim3(256), dim3(512), LDS_BYTES, stream, a);
#else
    for (int k = 0; k < N_PHASES; ++k) { if (k == 10 || k == 2 || k == 12 || k == 14 || k == 8 || k == 18) continue; a.ph_lo = k; a.ph_hi = k + 1; hipLaunchKernelGGL(mega, dim3(256), dim3(512), LDS_BYTES, stream, a); }
#endif
    const hipError_t le = hipPeekAtLastError();
    if (le != hipSuccess) fprintf(stderr, "kernel_launch: launch failed: %s\n", hipGetErrorName(le));
}
```

```cpp
#include <hip/hip_runtime.h>
#include <stdint.h>
#include <cstdio>

#define SEQ 8192
#define DM 4096
#define HD 128
#define ALPHA 1.4142135623730951f
#define LAMBDA_INIT 0.35550906759096934f
#define ATT_SCALE 0.088388347648318440f

__device__ const double REV_P[16] = {0.15915494309189535, 0.0700865215877985, 0.03086376340470123, 0.013591370636193905, 0.005985185712713705, 0.002635675898667414, 0.001160663641240061, 0.0005111175045375439, 0.00022507907903927653, 9.911730936901935e-05, 4.364795279280289e-05, 1.9221100684944863e-05, 8.464330808241401e-06, 3.727408601915352e-06, 1.6414262627950345e-06, 7.228293068832865e-07};
__device__ const double REV_A[32] = {0.15915494309189535, 0.11934937021124886, 0.08949940160889101, 0.06711508300522726, 0.050329212104487035, 0.03774158471741977, 0.0283021958306234, 0.02122365276477766, 0.015915494309189534, 0.011934937021124886, 0.008949940160889102, 0.006711508300522725, 0.005032921210448704, 0.003774158471741977, 0.00283021958306234, 0.0021223652764777662, 0.0015915494309189536, 0.0011934937021124885, 0.0008949940160889102, 0.0006711508300522726, 0.0005032921210448703, 0.00037741584717419774, 0.00028302195830623395, 0.0002122365276477766, 0.00015915494309189535, 0.00011934937021124886, 8.949940160889102e-05, 6.711508300522725e-05, 5.0329212104487035e-05, 3.774158471741978e-05, 2.8302195830623396e-05, 2.122365276477766e-05};

__device__ __forceinline__ void sincos_rev(double rev, float& s, float& c) {
    const double f = rev - floor(rev); const float ff = (float)f;
    s = __builtin_amdgcn_sinf(ff); c = __builtin_amdgcn_cosf(ff);
}
__device__ __forceinline__ float wave_sum(float v) {
#pragma unroll
    for (int o = 32; o >= 1; o >>= 1) v += __shfl_xor(v, o);
    return v;
}
__device__ __forceinline__ float wave_max(float v) {
#pragma unroll
    for (int o = 32; o >= 1; o >>= 1) v = fmaxf(v, __shfl_xor(v, o));
    return v;
}
namespace pg8 {
#define PG8_LAS __attribute__((address_space(3)))
typedef unsigned short bf16_t;
typedef short bf16x8 __attribute__((ext_vector_type(8)));
typedef float f32x4 __attribute__((ext_vector_type(4)));
typedef unsigned u32x4 __attribute__((ext_vector_type(4)));
constexpr int BM = 256, BK = 64, HALF = 128, HTB = HALF * BK * 2  , STAGE_BYTES = 8 * HTB, NXCD = 8, WGM = 8;

__host__ __device__ __forceinline__ int lds_byte(int r, int c) { const int st = (r >> 4) * 2 + (c >> 5), rr = r & 15, cc = c & 31, ob = rr * 64 + cc * 2; return st * 1024 + (ob ^ (((ob >> 9) & 1) << 5)); }
__host__ __device__ __forceinline__ void stage_rc(int b, int& R, int& C) { const int st = b / 1024, sb = b % 1024, swz = sb ^ (((sb >> 9) & 1) << 5); R = (st >> 1) * 16 + swz / 64; C = (st & 1) * 32 + (swz % 64) / 2; }
__host__ __device__ __forceinline__ int perm32(int rho) { const int n = rho >> 4, i = rho & 15; return 8 * (i >> 2) + 4 * n + (i & 3); }

struct Unit { int pm, pn; };
struct Gemm { const bf16_t* A; const bf16_t* Bt; int M, N, K; };

struct StaticOrder {
    int nM, nN, nwg, G, c;
    __host__ __device__ void init(int M, int N, int G_, int c_) { nM = M / BM; nN = N / BM; nwg = nM * nN; G = G_; c = c_; }
    __host__ __device__ bool next(int i, Unit& u) const {
        const long L = (long)i * G + c; if (L >= nwg) return false;
        int wgid = (int)L; { const int q = nwg / NXCD, r = nwg % NXCD, xcd = wgid % NXCD, off = wgid / NXCD; wgid = (xcd < r ? xcd * (q + 1) : r * (q + 1) + (xcd - r) * q) + off; }
        const int nig = WGM * nN, gid = wgid / nig, fm = gid * WGM, gsz = (nM - fm) < WGM ? (nM - fm) : WGM;
        u.pm = fm + ((wgid % nig) % gsz); u.pn = (wgid % nig) / gsz; return true;
    }
    __device__ __forceinline__ void a_ready(const Unit&) const {}
    __device__ __forceinline__ void done(const Unit&) const {}
};
__device__ __forceinline__ unsigned cvt_pk_bf16(float lo, float hi) { unsigned r; asm volatile("v_cvt_pk_bf16_f32 %0, %1, %2" : "=v"(r) : "v"(lo), "v"(hi)); return r; }
typedef float f32x2 __attribute__((ext_vector_type(2)));
template <class Epi, class Sched, bool STAMP = false>
__device__ __forceinline__ void gemm_phase(PG8_LAS unsigned char* lds, const Gemm g, const Sched& S, const Epi& E, unsigned long long* stamps, const int tid_in) {
    const int tid = tid_in, wid = __builtin_amdgcn_readfirstlane(tid >> 6), lane = tid & 63, wr = wid >> 2, wc = wid & 3, fr = lane & 15, fq = lane >> 4;
    const int K = g.K, nt = K / BK;
    int ts_lo = 0, ts_hi = 0, nts = 0; const unsigned long long rt_entry = STAMP ? (unsigned long long)wall_clock64() : 0ull;
#define PG8_STAMP() do { if (STAMP && wid == 0 && nts < 64) { const unsigned long long _c = (unsigned long long)clock64(); \
        ts_lo = (lane == nts) ? (int)(unsigned)_c : ts_lo; ts_hi = (lane == nts) ? (int)(unsigned)(_c >> 32) : ts_hi; ++nts; } } while (0)
    PG8_STAMP();
    unsigned voffA[2], voffB[2];
#pragma unroll
    for (int i = 0; i < 2; ++i) { int R, C; stage_rc(tid * 16 + i * 8192, R, C); const int Rb = Epi::PERM ? ((R & ~31) + perm32(R & 31)) : R;
        voffA[i] = (unsigned)(R * K + C) * 2u; voffB[i] = (unsigned)(Rb * K + C) * 2u; }
    const size_t kstep = (size_t)(BK * 2);
    const size_t hstep = (size_t)HALF * K * 2;
    const size_t tstep = 2 * hstep;
    const unsigned ldsw = (unsigned)wid * 1024u;
    const int aoff = lds_byte(wr * 64 + fr, fq * 8), boff = lds_byte(wc * 32 + fr, fq * 8);
#define PG8_SA(b, h) (((b) * 2 + (h)) * HTB)
#define PG8_SB(b, h) ((4 + (b) * 2 + (h)) * HTB)
#define PG8_STAGE(bufoff, gbase, voff) do { _Pragma("unroll") for (int _i = 0; _i < 2; ++_i) \
        __builtin_amdgcn_global_load_lds((const unsigned*)((const char*)(gbase) + (voff)[_i]), (PG8_LAS unsigned*)(lds + (bufoff) + ldsw + _i * 8192), 16, 0, 0); } while (0)
#define PG8_LDA(dst, b, h) do { _Pragma("unroll") for (int m = 0; m < 4; ++m) _Pragma("unroll") for (int k = 0; k < 2; ++k) dst[m][k] = *(const PG8_LAS bf16x8*)(lds + PG8_SA(b, h) + aoff + m * 2048 + k * 1024); } while (0)
#define PG8_LDB(dst, b, h) do { _Pragma("unroll") for (int n = 0; n < 2; ++n) _Pragma("unroll") for (int k = 0; k < 2; ++k) dst[n][k] = *(const PG8_LAS bf16x8*)(lds + PG8_SB(b, h) + boff + n * 2048 + k * 1024); } while (0)
#define PG8_MMA(ai, bj, At, Bt) do { __builtin_amdgcn_s_setprio(1); _Pragma("unroll") for (int m = 0; m < 4; ++m) _Pragma("unroll") for (int n = 0; n < 2; ++n) _Pragma("unroll") for (int k = 0; k < 2; ++k) \
        acc[ai][bj][m][n] = __builtin_amdgcn_mfma_f32_16x16x32_bf16(Bt[n][k], At[m][k], acc[ai][bj][m][n], 0, 0, 0); __builtin_amdgcn_s_setprio(0); } while (0)
#define PG8_WAIT_V(n) asm volatile("s_waitcnt vmcnt(" #n ")" ::: "memory")
#define PG8_WAIT_L(n) asm volatile("s_waitcnt lgkmcnt(" #n ")" ::: "memory")
#define PG8_BAR __builtin_amdgcn_s_barrier()
#define PG8_SCHED __builtin_amdgcn_sched_barrier(0)
    Unit cur, nxt; int ui = 0;
    if (!S.next(0, cur)) return;
    f32x4 acc[2][2][4][2];
#pragma unroll
    for (int a = 0; a < 2; ++a)
#pragma unroll
        for (int b = 0; b < 2; ++b)
#pragma unroll
            for (int m = 0; m < 4; ++m)
#pragma unroll
                for (int n = 0; n < 2; ++n) acc[a][b][m][n] = (f32x4){0.f, 0.f, 0.f, 0.f};
    bf16x8 At[4][2], B0[2][2], B1[2][2];
    const char* cA = (const char*)g.A + (size_t)cur.pm * tstep; const char* cB = (const char*)g.Bt + (size_t)cur.pn * tstep;
    S.a_ready(cur);
    PG8_STAGE(PG8_SB(0, 0), cB, voffB); PG8_STAGE(PG8_SA(0, 0), cA, voffA); PG8_STAGE(PG8_SB(0, 1), cB + hstep, voffB); PG8_STAGE(PG8_SA(0, 1), cA + hstep, voffA);
    if (wr == 1) PG8_BAR;
    PG8_WAIT_V(4); PG8_BAR;
    PG8_STAGE(PG8_SB(1, 0), cB + kstep, voffB); PG8_STAGE(PG8_SA(1, 0), cA + kstep, voffA); PG8_STAGE(PG8_SB(1, 1), cB + hstep + kstep, voffB);
    PG8_WAIT_V(6); PG8_BAR;
    PG8_STAMP();
    for (;;) {
        const bool has_next = S.next(ui + 1, nxt);
        const char* nA = has_next ? (const char*)g.A + (size_t)nxt.pm * tstep : cA; const char* nB = has_next ? (const char*)g.Bt + (size_t)nxt.pn * tstep : cB;
        for (int t = 0; t < nt; t += 2) {
            const bool last = (t == nt - 2);
            const char* a1 = cA + (size_t)(t + 1) * kstep;
            const char* a2 = last ? nA : cA + (size_t)(t + 2) * kstep; const char* b2 = last ? nB : cB + (size_t)(t + 2) * kstep;
            const char* a3 = a2 + kstep; const char* b3 = b2 + kstep;
            if (last && has_next) S.a_ready(nxt);
            PG8_LDB(B0, 0, 0); PG8_SCHED; PG8_LDA(At, 0, 0); PG8_STAGE(PG8_SA(1, 1), a1 + hstep, voffA);
            PG8_WAIT_L(8); PG8_BAR; PG8_WAIT_L(0); PG8_MMA(0, 0, At, B0); PG8_BAR; PG8_SCHED;
            PG8_LDB(B1, 0, 1); PG8_STAGE(PG8_SB(0, 0), b2, voffB);
            PG8_BAR; PG8_WAIT_L(0); PG8_MMA(0, 1, At, B1); PG8_BAR;
            PG8_LDA(At, 0, 1); PG8_STAGE(PG8_SA(0, 0), a2, voffA);
            PG8_BAR; PG8_WAIT_L(0); PG8_MMA(1, 0, At, B0); PG8_BAR; PG8_SCHED;
            PG8_STAGE(PG8_SB(0, 1), b2 + hstep, voffB);
            PG8_WAIT_V(6); PG8_BAR; PG8_MMA(1, 1, At, B1); PG8_BAR;
            PG8_LDB(B0, 1, 0); PG8_SCHED; PG8_LDA(At, 1, 0); PG8_STAGE(PG8_SA(0, 1), a2 + hstep, voffA);
            PG8_WAIT_L(8); PG8_BAR; PG8_WAIT_L(0); PG8_MMA(0, 0, At, B0); PG8_BAR; PG8_SCHED;
            PG8_LDB(B1, 1, 1); PG8_STAGE(PG8_SB(1, 0), b3, voffB);
            PG8_BAR; PG8_WAIT_L(0); PG8_MMA(0, 1, At, B1); PG8_BAR;
            PG8_LDA(At, 1, 1); PG8_STAGE(PG8_SA(1, 0), a3, voffA);
            PG8_BAR; PG8_WAIT_L(0); PG8_MMA(1, 0, At, B0); PG8_BAR; PG8_SCHED;
            PG8_STAGE(PG8_SB(1, 1), b3 + hstep, voffB);
            PG8_WAIT_V(6); PG8_BAR; PG8_MMA(1, 1, At, B1); PG8_BAR;
        }
        PG8_STAMP();
        if constexpr (!Epi::AFTER_DRAIN) { E(acc, cur, wr, wc, fr, fq); S.done(cur); }
        PG8_STAMP();
        if (!has_next) break;
#pragma unroll
        for (int a = 0; a < 2; ++a)
#pragma unroll
            for (int b = 0; b < 2; ++b)
#pragma unroll
                for (int m = 0; m < 4; ++m)
#pragma unroll
                    for (int n = 0; n < 2; ++n) acc[a][b][m][n] = (f32x4){0.f, 0.f, 0.f, 0.f};
        cur = nxt; cA = nA; cB = nB; ++ui;
    }
    PG8_WAIT_V(0);
    if (wr == 0) PG8_BAR;
    PG8_BAR;
    if constexpr (Epi::AFTER_DRAIN) { E.fused(acc, cur, wr, wc, fr, fq, lds, wid, lane); S.done(cur); }
    PG8_STAMP();
    if (STAMP && wid == 0) { stamps[lane] = lane < nts ? (((unsigned long long)(unsigned)ts_hi << 32) | (unsigned)ts_lo) : 0ull;
        if (lane == 62) stamps[62] = rt_entry; if (lane == 63) stamps[63] = (unsigned long long)wall_clock64(); }
#undef PG8_STAMP
#undef PG8_SA
#undef PG8_SB
#undef PG8_STAGE
#undef PG8_LDA
#undef PG8_LDB
#undef PG8_MMA
#undef PG8_WAIT_V
#undef PG8_WAIT_L
#undef PG8_BAR
#undef PG8_SCHED
}
}
#define XB_TMO      128
#define XB_XCNT(j)  (256  + 64 * (j))
#define XB_XSUB(j)  (1280 + 64 * (j))
#define XB_XGEN(j)  (2304 + 64 * (j))
#define XB_TOP      3328
#define XB_TOPGEN   3392
#define XCD_BAR_WORDS 3456
#define XB_SPIN_CAP (1u << 22)
#define LAS __attribute__((address_space(3)))

__device__ __forceinline__ unsigned xb_ld(unsigned* p)              { return __hip_atomic_load(p, __ATOMIC_RELAXED, __HIP_MEMORY_SCOPE_AGENT); }
__device__ __forceinline__ unsigned xb_add(unsigned* p, unsigned v) { return __hip_atomic_fetch_add(p, v, __ATOMIC_RELAXED, __HIP_MEMORY_SCOPE_AGENT); }
__device__ __forceinline__ unsigned xb_xcc_id() { return (unsigned)__builtin_amdgcn_s_getreg((3 << 11) | 20) & 0xFu; }
#define XB_SPIN(cond, bar) do { unsigned _sp = 0; while (cond) { __builtin_amdgcn_s_sleep(1); \
    if ((++_sp & 255u) == 0u) { if (xb_ld(&(bar)[XB_TMO])) break; if (_sp > XB_SPIN_CAP) { atomicAdd(&(bar)[XB_TMO], 1u); break; } } } } while (0)

struct XcdBarrier {
    unsigned* bar; unsigned x;
    volatile LAS unsigned* st;
};

__device__ __forceinline__ XcdBarrier xcd_barrier_post(unsigned* bar, volatile LAS unsigned* st, const int tid) {
    XcdBarrier b; b.bar = bar; b.x = xb_xcc_id(); b.st = st;
    if (tid == 0) (void)xb_add(&bar[XB_XCNT(b.x)], 1u);
    return b;
}
__device__ __forceinline__ void xcd_barrier_complete(unsigned* bar, unsigned x, unsigned& nloc, unsigned& nx) {
    const unsigned G = gridDim.x * gridDim.y * gridDim.z;
    unsigned sum, cnt, mine, sp = 0u;
    for (;;) {
        sum = 0u; cnt = 0u; mine = 0u;
#pragma unroll
        for (unsigned j = 0; j < 16; ++j) { const unsigned c = xb_ld(&bar[XB_XCNT(j)]); sum += c; cnt += (c > 0u) ? 1u : 0u; mine = (j == x) ? c : mine; }
        if (sum == G) break;
        __builtin_amdgcn_s_sleep(1);
        if ((++sp & 255u) == 0u) { if (xb_ld(&bar[XB_TMO])) break; if (sp > XB_SPIN_CAP) { atomicAdd(&bar[XB_TMO], 1u); break; } }
    }
    nloc = mine > 0u ? mine : 1u; nx = cnt > 0u ? cnt : 1u;
}

__device__ __forceinline__ void xcd_barrier(const XcdBarrier& b, const int tid) {
    asm volatile("s_waitcnt vmcnt(0)" ::: "memory");
    __syncthreads();
    if (tid == 0) {
        unsigned* bar = b.bar;
        __builtin_amdgcn_s_waitcnt(0);
        unsigned nloc = b.st[0], nx = b.st[1];
        if (nloc == 0u) { xcd_barrier_complete(bar, b.x, nloc, nx); b.st[0] = nloc; b.st[1] = nx; }
        const unsigned old = xb_add(&bar[XB_XSUB(b.x)], 1u);
        const unsigned gen = old / nloc;
        if (old + 1u == (gen + 1u) * nloc) {
            __builtin_amdgcn_fence(__ATOMIC_RELEASE, "agent");
            asm volatile("s_waitcnt vmcnt(0)" ::: "memory");
            const unsigned og = xb_add(&bar[XB_TOP], 1u);
            const unsigned tg = og / nx;
            if (og + 1u == (tg + 1u) * nx) xb_add(&bar[XB_TOPGEN], 1u);
            else XB_SPIN(xb_ld(&bar[XB_TOPGEN]) == tg, bar);
            __builtin_amdgcn_fence(__ATOMIC_ACQUIRE, "agent");
            xb_add(&bar[XB_XGEN(b.x)], 1u);
            asm volatile("s_waitcnt vmcnt(0)" ::: "memory");
        } else {
            XB_SPIN(xb_ld(&bar[XB_XGEN(b.x)]) == gen, bar);
            __builtin_amdgcn_fence(__ATOMIC_ACQUIRE, "agent");
            asm volatile("s_waitcnt vmcnt(0)" ::: "memory");
        }
    }
    __syncthreads();
}
namespace att {
using bf16 = unsigned short;
constexpr int   D = 128, NW = 8, QBLK = 32, KVBLK = 64;
constexpr float SCALE = 0.088388347648318440f;
constexpr float THR = 8.f;
constexpr int SDEPTH = 1;
constexpr size_t SHM_V = KVBLK * D * 2, SHM_K = KVBLK * D * 2, SHM_ATTN = 2 * SHM_V + 2 * SHM_K + NW * 64 * 4;
using bf16x8 = __attribute__((ext_vector_type(8))) short;
using s16x4  = __attribute__((ext_vector_type(4))) short;
using f32x16 = __attribute__((ext_vector_type(16))) float;
using f32x8  = __attribute__((ext_vector_type(8))) float;
using u32x4  = __attribute__((ext_vector_type(4))) unsigned;
#define KSWZ(row, colB) ((row) * 256 + ((colB) ^ (((row) & 7) << 4)))
#define SBAR() __builtin_amdgcn_sched_barrier(0)
__device__ __forceinline__ int crow(int r, int hi) { return (r & 3) + 8 * (r >> 2) + 4 * hi; }
__device__ __forceinline__ unsigned cvtpk(float lo, float hi) {
  unsigned r; asm volatile("v_cvt_pk_bf16_f32 %0, %1, %2" : "=v"(r) : "v"(lo), "v"(hi)); return r;
}
template <typename TIn> struct Stage;
template <> struct Stage<bf16>  { using T = bf16x8;
  __device__ static __forceinline__ T ld8(const bf16* p) { return *reinterpret_cast<const bf16x8*>(p); }
  __device__ static __forceinline__ bf16x8 tobf(T x) { return x; } };
template <> struct Stage<float> { using T = f32x8;
  __device__ static __forceinline__ T ld8(const float* p) { return *reinterpret_cast<const f32x8*>(p); }
  __device__ static __forceinline__ bf16x8 tobf(T x) {
    u32x4 w = {cvtpk(x[0], x[1]), cvtpk(x[2], x[3]), cvtpk(x[4], x[5]), cvtpk(x[6], x[7])}; return *reinterpret_cast<bf16x8*>(&w); } };

__device__ __forceinline__ void partialSM(f32x16& p0, f32x16& p1, float& m_reg, float& mn, float& alpha) {
  constexpr float C = SCALE * 1.4426950408889634f;
  float pmax = p0[0]; for (int r = 1; r < 16; ++r) pmax = fmaxf(pmax, p0[r]); for (int r = 0; r < 16; ++r) pmax = fmaxf(pmax, p1[r]);
  { auto rr = __builtin_amdgcn_permlane32_swap(__float_as_uint(pmax), __float_as_uint(pmax), false, false);
    pmax = fmaxf(__uint_as_float(rr[0]), __uint_as_float(rr[1])); }
  if (__builtin_expect(__all(pmax - m_reg <= THR / SCALE), 1)) { mn = m_reg; alpha = 1.f; }
  else { mn = fmaxf(m_reg, pmax); alpha = __builtin_amdgcn_exp2f((m_reg - mn) * C); m_reg = mn; }
  float mnC = -mn * C;
  for (int r = 0; r < 16; ++r) p0[r] = fmaf(p0[r], C, mnC); for (int r = 0; r < 16; ++r) p1[r] = fmaf(p1[r], C, mnC);
  for (int r = 0; r < 16; ++r) p0[r] = __builtin_amdgcn_exp2f(p0[r]);
}
__device__ __forceinline__ void finishSM(f32x16& p0, f32x16& p1, float alpha, float& l_reg, bf16x8& pa0, bf16x8& pa1, bf16x8& pa2, bf16x8& pa3) {
  for (int r = 0; r < 16; ++r) p1[r] = __builtin_amdgcn_exp2f(p1[r]);
  float ps = 0; for (int r = 0; r < 16; ++r) ps += p0[r]; for (int r = 0; r < 16; ++r) ps += p1[r];
  { auto rr = __builtin_amdgcn_permlane32_swap(__float_as_uint(ps), __float_as_uint(ps), false, false);
    ps = __uint_as_float(rr[0]) + __uint_as_float(rr[1]); }
  l_reg = l_reg * alpha + ps;
#define PK4(P, BASE, OUT) do { unsigned a0 = cvtpk(P[BASE + 0], P[BASE + 1]), a1 = cvtpk(P[BASE + 2], P[BASE + 3]);   \
    unsigned b0 = cvtpk(P[BASE + 4], P[BASE + 5]), b1 = cvtpk(P[BASE + 6], P[BASE + 7]);                              \
    auto r0 = __builtin_amdgcn_permlane32_swap(a0, b0, false, false); auto r1 = __builtin_amdgcn_permlane32_swap(a1, b1, false, false); \
    u32x4 w = {r0[0], r1[0], r0[1], r1[1]}; OUT = *reinterpret_cast<bf16x8*>(&w); } while (0)
  PK4(p0, 0, pa0); PK4(p0, 8, pa1); PK4(p1, 0, pa2); PK4(p1, 8, pa3);
#undef PK4
}
__device__ __forceinline__ void qkt(f32x16& p0, f32x16& p1, const bf16* Ks, const bf16x8* qr, int r32, int hi) {
  p0 = f32x16{}; p1 = f32x16{};
  bf16x8 c0 = *reinterpret_cast<const bf16x8*>((const char*)Ks + KSWZ(r32, (hi * 8) * 2)), c1 = *reinterpret_cast<const bf16x8*>((const char*)Ks + KSWZ(32 + r32, (hi * 8) * 2));
#pragma unroll
  for (int d0 = 0; d0 < 8; ++d0) {
    bf16x8 n0 = c0, n1 = c1;
    if (d0 < 7) { const int cb = ((d0 + 1) * 16 + hi * 8) * 2;
      n0 = *reinterpret_cast<const bf16x8*>((const char*)Ks + KSWZ(r32, cb)); n1 = *reinterpret_cast<const bf16x8*>((const char*)Ks + KSWZ(32 + r32, cb)); }
    p0 = __builtin_amdgcn_mfma_f32_32x32x16_bf16(c0, qr[d0], p0, 0, 0, 0);
    p1 = __builtin_amdgcn_mfma_f32_32x32x16_bf16(c1, qr[d0], p1, 0, 0, 0);
    c0 = n0; c1 = n1; }
}
template <int OFF> __device__ __forceinline__ bf16x8 k_read(const int addr) {
  bf16x8 r; asm volatile("ds_read_b128 %0, %1 offset:%2" : "=&v"(r) : "v"(addr), "i"(OFF) : "memory"); return r;
}
template <int D0> __device__ __forceinline__ void qkt_step(f32x16& p0, f32x16& p1, const int (&a)[4], const bf16x8* qr, bf16x8 c0, bf16x8 c1) {
  bf16x8 n0 = c0, n1 = c1;
  if constexpr (D0 < 7) { n0 = k_read<((D0 + 1) >> 2) * 128>(a[(D0 + 1) & 3]); n1 = k_read<((D0 + 1) >> 2) * 128 + 8192>(a[(D0 + 1) & 3]); asm volatile("s_waitcnt lgkmcnt(2)" ::: "memory"); }
  else asm volatile("s_waitcnt lgkmcnt(0)" ::: "memory");
  SBAR();
  p0 = __builtin_amdgcn_mfma_f32_32x32x16_bf16(c0, qr[D0], p0, 0, 0, 0);
  p1 = __builtin_amdgcn_mfma_f32_32x32x16_bf16(c1, qr[D0], p1, 0, 0, 0);
  if constexpr (D0 < 7) qkt_step<D0 + 1>(p0, p1, a, qr, n0, n1);
}
__device__ __forceinline__ void qkt_pipe(f32x16& p0, f32x16& p1, const int ka, const bf16x8* qr, const int r32, const int hi) {
  p0 = f32x16{}; p1 = f32x16{};
  int a[4];
#pragma unroll
  for (int q = 0; q < 4; ++q) a[q] = ka + r32 * 256 + ((q * 32 + hi * 16) ^ ((r32 & 7) << 4));
  const bf16x8 c0 = k_read<0>(a[0]), c1 = k_read<8192>(a[0]);
  qkt_step<0>(p0, p1, a, qr, c0, c1);
}
__device__ __forceinline__ int v_st(int k, int c) { const int kk = (k & ~0xC) | ((k & 4) << 1) | ((k & 8) >> 1); return ((kk >> 3) * 4 + (c >> 5)) * 512 + ((kk & 7) * 32 + (c & 31)) * 2; }
__device__ __forceinline__ int v_rd_base(int lane) { return ((lane & 3) << 3) | (((lane >> 2) & 3) << 6) | (((lane >> 4) & 1) << 5) | (((lane >> 5) & 1) << 8); }
constexpr int v_rd_off(int d0, int ks, int half) { return d0 * 512 + ks * 4096 + half * 2048; }
template <int OFF> __device__ __forceinline__ s16x4 tr_read(int vb) {
  s16x4 r; asm volatile("ds_read_b64_tr_b16 %0, %1 offset:%2" : "=&v"(r) : "v"(vb), "i"(OFF) : "memory"); return r;
}
template <int D0> __device__ __forceinline__ void pv_one(f32x16& od, int vb, bf16x8 pa0, bf16x8 pa1, bf16x8 pa2, bf16x8 pa3) {
  const s16x4 l0 = tr_read<v_rd_off(D0, 0, 0)>(vb), h0 = tr_read<v_rd_off(D0, 0, 1)>(vb), l1 = tr_read<v_rd_off(D0, 1, 0)>(vb), h1 = tr_read<v_rd_off(D0, 1, 1)>(vb);
  const s16x4 l2 = tr_read<v_rd_off(D0, 2, 0)>(vb), h2 = tr_read<v_rd_off(D0, 2, 1)>(vb), l3 = tr_read<v_rd_off(D0, 3, 0)>(vb), h3 = tr_read<v_rd_off(D0, 3, 1)>(vb);
  asm volatile("s_waitcnt lgkmcnt(0)" ::: "memory"); SBAR();
#define PK(L, H) (bf16x8){L[0], L[1], L[2], L[3], H[0], H[1], H[2], H[3]}
  od = __builtin_amdgcn_mfma_f32_32x32x16_bf16(pa0, PK(l0, h0), od, 0, 0, 0);
  od = __builtin_amdgcn_mfma_f32_32x32x16_bf16(pa1, PK(l1, h1), od, 0, 0, 0);
  od = __builtin_amdgcn_mfma_f32_32x32x16_bf16(pa2, PK(l2, h2), od, 0, 0, 0);
  od = __builtin_amdgcn_mfma_f32_32x32x16_bf16(pa3, PK(l3, h3), od, 0, 0, 0);
#undef PK
}
__device__ __forceinline__ void pv_d0(f32x16* o, int vb, bf16x8 pa0, bf16x8 pa1, bf16x8 pa2, bf16x8 pa3) {
  pv_one<0>(o[0], vb, pa0, pa1, pa2, pa3); pv_one<1>(o[1], vb, pa0, pa1, pa2, pa3); pv_one<2>(o[2], vb, pa0, pa1, pa2, pa3); pv_one<3>(o[3], vb, pa0, pa1, pa2, pa3);
}

template <int B> __device__ __forceinline__ void pv_rd8(s16x4 (&f)[8], const int vb) {
  constexpr int D0 = B & 3, HB = (B >> 2) * 16384;
  f[0] = tr_read<HB + v_rd_off(D0, 0, 0)>(vb); f[1] = tr_read<HB + v_rd_off(D0, 0, 1)>(vb); f[2] = tr_read<HB + v_rd_off(D0, 1, 0)>(vb); f[3] = tr_read<HB + v_rd_off(D0, 1, 1)>(vb);
  f[4] = tr_read<HB + v_rd_off(D0, 2, 0)>(vb); f[5] = tr_read<HB + v_rd_off(D0, 2, 1)>(vb); f[6] = tr_read<HB + v_rd_off(D0, 3, 0)>(vb); f[7] = tr_read<HB + v_rd_off(D0, 3, 1)>(vb);
}
__device__ __forceinline__ void pv_mma4(f32x16& od, const s16x4 (&f)[8], bf16x8 pa0, bf16x8 pa1, bf16x8 pa2, bf16x8 pa3) {
#define PK(L, H) (bf16x8){L[0], L[1], L[2], L[3], H[0], H[1], H[2], H[3]}
  od = __builtin_amdgcn_mfma_f32_32x32x16_bf16(pa0, PK(f[0], f[1]), od, 0, 0, 0);
  od = __builtin_amdgcn_mfma_f32_32x32x16_bf16(pa1, PK(f[2], f[3]), od, 0, 0, 0);
  od = __builtin_amdgcn_mfma_f32_32x32x16_bf16(pa2, PK(f[4], f[5]), od, 0, 0, 0);
  od = __builtin_amdgcn_mfma_f32_32x32x16_bf16(pa3, PK(f[6], f[7]), od, 0, 0, 0);
#undef PK
}
template <int B, int NB> __device__ __forceinline__ void pv_pipe_step(f32x16* o, s16x4 (&cur)[8], s16x4 (&nxt)[8], const int vb, bf16x8 pa0, bf16x8 pa1, bf16x8 pa2, bf16x8 pa3) {
  if constexpr (B + 1 < NB) { pv_rd8<B + 1>(nxt, vb); asm volatile("s_waitcnt lgkmcnt(8)" ::: "memory"); }
  else asm volatile("s_waitcnt lgkmcnt(0)" ::: "memory");
  SBAR();
  pv_mma4(o[B], cur, pa0, pa1, pa2, pa3);
  if constexpr (B + 1 < NB) pv_pipe_step<B + 1, NB>(o, nxt, cur, vb, pa0, pa1, pa2, pa3);
}
template <int NB> __device__ __forceinline__ void pv_pipe(f32x16* o, const int vb, bf16x8 pa0, bf16x8 pa1, bf16x8 pa2, bf16x8 pa3) {
  s16x4 fa[8], fb[8];
  pv_rd8<0>(fa, vb);
  pv_pipe_step<0, NB>(o, fa, fb, vb, pa0, pa1, pa2, pa3);
}

template <typename TQ, int LDQ, int LDK, int LDO, typename TO>
__device__ __forceinline__ void attn_dense_body(const TQ* __restrict__ Qb, const bf16* __restrict__ Kh, const bf16* __restrict__ Vh,
                                                TO* __restrict__ Ob, int seq, char* lds, const int tid_in) {
  using St = Stage<bf16>; using SQ = Stage<TQ>;
  const int tid = tid_in, wid = tid >> 6, lane = tid & 63, r32 = lane & 31, hi = lane >> 5;
  bf16* V_lds = (bf16*)lds; bf16* K_lds = (bf16*)(lds + 2 * SHM_V);
  float* ws = (float*)(lds + 2 * SHM_V + 2 * SHM_K) + wid * 64; float* li_l = ws; float* al_l = ws + 32;
  float m_reg = -1e30f, l_reg = 0; f32x16 o[4] = {}; bf16x8 qr[8];
  const TQ* Qw = Qb + ((wid * QBLK + r32) * LDQ + hi * 8);
#pragma unroll
  for (int d0 = 0; d0 < 8; ++d0) qr[d0] = SQ::tobf(SQ::ld8(Qw + d0 * 16));
  const int sr = tid >> 4, sc = (tid & 15) * 8, vst0 = v_st(sr, sc), vst1 = v_st(32 + sr, sc);
  const int vb0 = (int)(uintptr_t)V_lds + v_rd_base(lane);
  struct { typename St::T vs0, vs1, ks0, ks1; } sr_[SDEPTH];
#define SLOAD(i, k0) do { sr_[i].vs0 = St::ld8(Vh + (((k0) + sr) * LDK + sc)); sr_[i].vs1 = St::ld8(Vh + (((k0) + 32 + sr) * LDK + sc)); \
    sr_[i].ks0 = St::ld8(Kh + (((k0) + sr) * LDK + sc)); sr_[i].ks1 = St::ld8(Kh + (((k0) + 32 + sr) * LDK + sc)); } while (0)
#define SWRITE(b, i) do { *(bf16x8*)((char*)V_lds + (b) * SHM_V + vst0) = St::tobf(sr_[i].vs0);          \
    *(bf16x8*)((char*)V_lds + (b) * SHM_V + vst1) = St::tobf(sr_[i].vs1); int kc = sc * 2;               \
    *(bf16x8*)((char*)K_lds + (b) * SHM_K + KSWZ(sr, kc)) = St::tobf(sr_[i].ks0);                       \
    *(bf16x8*)((char*)K_lds + (b) * SHM_K + KSWZ(32 + sr, kc)) = St::tobf(sr_[i].ks1); } while (0)
#define SWAIT() do { if constexpr (SDEPTH == 2) asm volatile("s_waitcnt vmcnt(4)" ::: "memory"); else asm volatile("s_waitcnt vmcnt(0)" ::: "memory"); } while (0)
#define RESC(a) do { if (__any((a) < 1.f)) { if (hi == 0) al_l[r32] = (a); asm volatile("s_waitcnt lgkmcnt(0)" ::: "memory"); \
    for (int d = 0; d < 4; ++d) for (int r = 0; r < 16; ++r) o[d][r] *= al_l[crow(r, hi)]; } } while (0)
  f32x16 pA0, pA1, pB0, pB1; float mnA, mnB, alA, alB; bf16x8 pa0, pa1, pa2, pa3; const int NT = seq / KVBLK;
  constexpr int SE = 0, SO = SDEPTH - 1;
  SLOAD(SE, 0); asm volatile("s_waitcnt vmcnt(0)" ::: "memory"); SWRITE(0, SE); __syncthreads();
  qkt(pA0, pA1, K_lds, qr, r32, hi); partialSM(pA0, pA1, m_reg, mnA, alA);
  SLOAD(SO, KVBLK); if constexpr (SDEPTH == 2) { if (2 < NT) SLOAD(SE, 2 * KVBLK); }
  SWAIT(); SWRITE(1, SO); __syncthreads();
  for (int j = 1; j + 1 < NT; j += 2) {
    SBAR(); qkt(pB0, pB1, (bf16*)((char*)K_lds + SHM_K), qr, r32, hi);
    finishSM(pA0, pA1, alA, l_reg, pa0, pa1, pa2, pa3); SBAR();
    SLOAD(SO, (j + SDEPTH) * KVBLK); SBAR();
    pv_d0(o, vb0, pa0, pa1, pa2, pa3); partialSM(pB0, pB1, m_reg, mnB, alB);
    __syncthreads(); SWAIT(); SWRITE(0, SE);
    RESC(alB); __syncthreads();
    SBAR(); qkt(pA0, pA1, K_lds, qr, r32, hi);
    finishSM(pB0, pB1, alB, l_reg, pa0, pa1, pa2, pa3); SBAR();
    if (SDEPTH == 1 || j + 3 < NT) SLOAD(SE, (j + 1 + SDEPTH) * KVBLK); SBAR();
    pv_d0(o, vb0 + (int)SHM_V, pa0, pa1, pa2, pa3); partialSM(pA0, pA1, m_reg, mnA, alA);
    __syncthreads(); SWAIT(); SWRITE(1, SO);
    RESC(alA); __syncthreads();
  }
  SBAR(); qkt(pB0, pB1, (bf16*)((char*)K_lds + SHM_K), qr, r32, hi);
  finishSM(pA0, pA1, alA, l_reg, pa0, pa1, pa2, pa3); SBAR();
  pv_d0(o, vb0, pa0, pa1, pa2, pa3); partialSM(pB0, pB1, m_reg, mnB, alB);
  __syncthreads(); RESC(alB);
  finishSM(pB0, pB1, alB, l_reg, pa0, pa1, pa2, pa3); SBAR();
  pv_d0(o, vb0 + (int)SHM_V, pa0, pa1, pa2, pa3);
  if (hi == 0) li_l[r32] = l_reg; asm volatile("s_waitcnt lgkmcnt(0)" ::: "memory");
  float rli[16];
#pragma unroll
  for (int r = 0; r < 16; ++r) rli[r] = __builtin_amdgcn_rcpf(li_l[crow(r, hi)]);
  TO* Ow = Ob + (wid * QBLK) * LDO;
#pragma unroll
  for (int r = 0; r < 16; ++r) { int orow = crow(r, hi);
    for (int d0 = 0; d0 < 4; ++d0) { const float val = o[d0][r] * rli[r];
      if constexpr (sizeof(TO) == 4) Ow[orow * LDO + d0 * 32 + r32] = val;
      else Ow[orow * LDO + d0 * 32 + r32] = (TO)(cvtpk(val, val) & 0xffffu); } }
#undef SLOAD
#undef SWRITE
#undef SWAIT
#undef RESC
}

template <int WIN>
__device__ __forceinline__ void attn_banded_body(const bf16* __restrict__ Qp, const bf16* __restrict__ Kp, const bf16* __restrict__ Vp, const long rs, const int Lseq, const int P0,
                                                 const float m_init, const float l_init, bf16* __restrict__ Ob, const long os, float* __restrict__ Lp, const long ls, char* lds, const int tid) {
  const int wid = __builtin_amdgcn_readfirstlane(tid >> 6), lane = tid & 63, r32 = lane & 31, hi = lane >> 5;
  constexpr int BT = 32768;
  float* wsf = (float*)(lds + 2 * BT) + wid * 64; float* li_l = wsf; float* al_l = wsf + 32;
  float m_reg = m_init, l_reg = l_init; f32x16 o[4] = {}; bf16x8 qr[8];
  const bf16* Qw = Qp + (long)(P0 + wid * QBLK + r32) * rs + hi * 8;
#pragma unroll
  for (int d0 = 0; d0 < 8; ++d0) qr[d0] = *reinterpret_cast<const bf16x8*>(Qw + d0 * 16);
  const int irs = (int)rs;
  int ksrc[2], vsrc[2];
#pragma unroll
  for (int i = 0; i < 2; ++i) { const int c = 2 * wid + i, row = 4 * c + (lane >> 4), colB = (16 * (lane & 15)) ^ ((row & 7) << 4); ksrc[i] = row * irs + (colB >> 1);
      const int sub = 2 * c + (lane >> 5), kk = ((sub >> 2) << 3) | ((lane & 31) >> 2), k = (kk & ~0xC) | ((kk & 4) << 1) | ((kk & 8) >> 1), col = (sub & 3) * 32 + 8 * (lane & 3); vsrc[i] = k * irs + col; }
  using LP = __attribute__((address_space(3))) unsigned*;
#define BB_DMA(buf, tb) do { const bf16* _kb = Kp + (long)(tb) * rs; const bf16* _vb = Vp + (long)(tb) * rs; char* _l = lds + (buf) * BT; \
    _Pragma("unroll") for (int _i = 0; _i < 2; ++_i) { __builtin_amdgcn_global_load_lds((const unsigned*)(_kb + ksrc[_i]), (LP)(_l + (2 * wid + _i) * 1024), 16, 0, 0); \
                                                       __builtin_amdgcn_global_load_lds((const unsigned*)(_vb + vsrc[_i]), (LP)(_l + 16384 + (2 * wid + _i) * 1024), 16, 0, 0); } } while (0)
  constexpr int NT = (256 + 2 * WIN) / 64, NTW = (2 * WIN + 32 + 63) / 64;
  const int klo = wid >> 1, qpos = P0 + wid * QBLK + r32;
  int kf = 0; while (P0 - WIN + 64 * kf < 0) ++kf;
  int kl = NT - 1; while (P0 - WIN + 64 * kl >= Lseq) --kl;
  BB_DMA(kf & 1, P0 - WIN + 64 * kf);
  for (int k = kf; k <= kl; ++k) {
    const int tb = P0 - WIN + 64 * k;
    asm volatile("s_waitcnt vmcnt(0)" ::: "memory");
    __builtin_amdgcn_s_barrier();
    asm volatile("" ::: "memory");
    if (k < kl) BB_DMA((k + 1) & 1, tb + 64);
    char* tbuf = lds + (k & 1) * BT;
    if (k >= klo && k < klo + NTW) {
      f32x16 p0, p1; float mn, al; bf16x8 pa0, pa1, pa2, pa3;
      qkt_pipe(p0, p1, (int)(uintptr_t)tbuf, qr, r32, hi);
      if (k == klo || k == klo + NTW - 1) {
#pragma unroll
        for (int r = 0; r < 16; ++r) { const int d = qpos - (tb + crow(r, hi));
          if (d > WIN || d < -WIN) p0[r] = -1e30f;
          if (d - 32 > WIN || d - 32 < -WIN) p1[r] = -1e30f; }
      }
      partialSM(p0, p1, m_reg, mn, al);
      if (__any(al < 1.f)) { if (hi == 0) al_l[r32] = al; asm volatile("s_waitcnt lgkmcnt(0)" ::: "memory");
#pragma unroll
        for (int d = 0; d < 4; ++d)
#pragma unroll
          for (int r = 0; r < 16; ++r) o[d][r] *= al_l[crow(r, hi)]; }
      finishSM(p0, p1, al, l_reg, pa0, pa1, pa2, pa3); SBAR();
      pv_pipe<4>(o, (int)(uintptr_t)(tbuf + 16384) + v_rd_base(lane), pa0, pa1, pa2, pa3);
    }
  }
#undef BB_DMA
  if (hi == 0) li_l[r32] = l_reg; asm volatile("s_waitcnt lgkmcnt(0)" ::: "memory");
  float rli[16];
#pragma unroll
  for (int r = 0; r < 16; ++r) rli[r] = __builtin_amdgcn_rcpf(li_l[crow(r, hi)]);
  bf16* Ow = Ob + (long)(P0 + wid * QBLK) * os;
#pragma unroll
  for (int r = 0; r < 16; ++r) { const int orow = crow(r, hi);
#pragma unroll
    for (int d0 = 0; d0 < 4; ++d0) { const float val = o[d0][r] * rli[r]; Ow[(long)orow * os + d0 * 32 + r32] = (bf16)(cvtpk(val, val) & 0xffffu); } }
  if (Lp != nullptr && hi == 0) Lp[(long)(P0 + wid * QBLK + r32) * ls] = m_reg * SCALE + __logf(l_reg);
}

constexpr int WB_TILE = 49152, WB_WS = 2 * WB_TILE;
template <int LDQ, int LDK, int LDO, int NVH, typename TO, bool COMBINE = false, int LDC = 0>
__device__ __forceinline__ void attn_wide_body(const bf16* __restrict__ Qb, const bf16* __restrict__ Kh, const bf16* __restrict__ Vh, TO* __restrict__ Ob, const int seq, char* lds, const int tid,
                                               const float lam = 0.f, const float gsc = 0.f, const float* __restrict__ gain = nullptr, bf16* __restrict__ Cb = nullptr) {
  const int wid = __builtin_amdgcn_readfirstlane(tid >> 6), lane = tid & 63, r32 = lane & 31, hi = lane >> 5;
  float* wsf = (float*)(lds + WB_WS) + wid * 64; float* li_l = wsf; float* al_l = wsf + 32;
  float m_reg = -1e30f, l_reg = 0; f32x16 o[4 * NVH] = {}; bf16x8 qr[8];
  { const bf16* Qw = Qb + ((wid * QBLK + r32) * LDQ + hi * 8);
#pragma unroll
    for (int d0 = 0; d0 < 8; ++d0) qr[d0] = *reinterpret_cast<const bf16x8*>(Qw + d0 * 16); }
  constexpr int NVP = 2 * NVH;
  int ksrc[2], vsrc[NVP];
#pragma unroll
  for (int i = 0; i < 2; ++i) { const int c = 2 * wid + i, row = 4 * c + (lane >> 4), colB = (16 * (lane & 15)) ^ ((row & 7) << 4); ksrc[i] = row * LDK + (colB >> 1); }
#pragma unroll
  for (int i = 0; i < NVP; ++i) { const int pc = wid * NVP + i, hf = pc >> 4, c = pc & 15, sub = 2 * c + (lane >> 5), kk = ((sub >> 2) << 3) | ((lane & 31) >> 2);
      const int k = (kk & ~0xC) | ((kk & 4) << 1) | ((kk & 8) >> 1), col = (sub & 3) * 32 + 8 * (lane & 3); vsrc[i] = k * LDK + hf * 128 + col; }
  using LP = __attribute__((address_space(3))) unsigned*;
#define WB_DMA(buf, key0) do { const bf16* _kb = Kh + (key0) * LDK; const bf16* _vb = Vh + (key0) * LDK; char* _l = lds + (buf) * WB_TILE; \
    _Pragma("unroll") for (int _i = 0; _i < 2; ++_i) __builtin_amdgcn_global_load_lds((const unsigned*)(_kb + ksrc[_i]), (LP)(_l + (2 * wid + _i) * 1024), 16, 0, 0); \
    _Pragma("unroll") for (int _i = 0; _i < NVP; ++_i) __builtin_amdgcn_global_load_lds((const unsigned*)(_vb + vsrc[_i]), (LP)(_l + 16384 + (wid * NVP + _i) * 1024), 16, 0, 0); } while (0)
  const int NT = seq / KVBLK;
  WB_DMA(0, 0);
  for (int j = 0; j < NT; ++j) {
    asm volatile("s_waitcnt vmcnt(0)" ::: "memory");
    __builtin_amdgcn_s_barrier();
    asm volatile("" ::: "memory");
    if (j + 1 < NT) WB_DMA((j + 1) & 1, (j + 1) * KVBLK);
    char* tb = lds + (j & 1) * WB_TILE;
    f32x16 p0, p1; float mn, al; bf16x8 pa0, pa1, pa2, pa3;
    qkt_pipe(p0, p1, (int)(uintptr_t)tb, qr, r32, hi);
    partialSM(p0, p1, m_reg, mn, al);
    if (__any(al < 1.f)) { if (hi == 0) al_l[r32] = al; asm volatile("s_waitcnt lgkmcnt(0)" ::: "memory");
#pragma unroll
      for (int d = 0; d < 4 * NVH; ++d)
#pragma unroll
        for (int r = 0; r < 16; ++r) o[d][r] *= al_l[crow(r, hi)]; }
    finishSM(p0, p1, al, l_reg, pa0, pa1, pa2, pa3); SBAR();
    const int vb0 = (int)(uintptr_t)(tb + 16384) + v_rd_base(lane);
    pv_pipe<4 * NVH>(o, vb0, pa0, pa1, pa2, pa3);
  }
#undef WB_DMA
  int te = tid; asm volatile("" : "+v"(te));
  const int wid_e = __builtin_amdgcn_readfirstlane(te >> 6), r32_e = te & 31, hi_e = (te >> 5) & 1;
  float* li_e = (float*)(lds + WB_WS) + wid_e * 64;
  if (hi_e == 0) li_e[r32_e] = l_reg; asm volatile("s_waitcnt lgkmcnt(0)" ::: "memory");
  float rli[16];
#pragma unroll
  for (int r = 0; r < 16; ++r) rli[r] = __builtin_amdgcn_rcpf(li_e[crow(r, hi_e)]);
  TO* Ow = Ob + (wid_e * QBLK) * LDO;
  if constexpr (!COMBINE) {
#pragma unroll
    for (int r = 0; r < 16; ++r) { const int orow = crow(r, hi_e);
#pragma unroll
      for (int d0 = 0; d0 < 4 * NVH; ++d0) { const float val = o[d0][r] * rli[r];
        if constexpr (sizeof(TO) == 4) Ow[orow * LDO + d0 * 32 + r32_e] = val; else Ow[orow * LDO + d0 * 32 + r32_e] = (TO)(cvtpk(val, val) & 0xffffu); } }
  } else {
    static_assert(sizeof(TO) == 4 && NVH == 2, "combine: f32 first-map tile, 256-wide rows");
    float gn[8];
    { const float* g2 = gain; asm volatile("" : "+s"(g2));
#pragma unroll
      for (int d0 = 0; d0 < 8; ++d0) gn[d0] = g2[d0 * 32 + r32_e] * gsc; }
    bf16* Cw; { bf16* c2 = Cb; asm volatile("" : "+s"(c2)); Cw = c2 + (wid_e * QBLK) * LDC; }
    { TO* o2 = Ob; asm volatile("" : "+s"(o2)); Ow = o2 + (wid_e * QBLK) * LDO; }
#pragma unroll
    for (int r = 0; r < 16; ++r) { const int orow = crow(r, hi_e);
      float ss = 0.f;
#pragma unroll
      for (int d0 = 0; d0 < 8; ++d0) { const float o1 = __hip_atomic_load((const float*)Ow + orow * LDO + d0 * 32 + r32_e, __ATOMIC_RELAXED, __HIP_MEMORY_SCOPE_AGENT);
        const float av = o1 - lam * (o[d0][r] * rli[r]); o[d0][r] = av; ss = fmaf(av, av, ss); }
#define WB_SWZ(v, m) __int_as_float(__builtin_amdgcn_ds_swizzle(__float_as_int(v), ((m) << 10) | 0x1F))
      ss += WB_SWZ(ss, 1); ss += WB_SWZ(ss, 2); ss += WB_SWZ(ss, 4); ss += WB_SWZ(ss, 8); ss += WB_SWZ(ss, 16);
#undef WB_SWZ
      const float sc = 1.0f / sqrtf(ss * (1.0f / 256.0f) + 1e-6f);
#pragma unroll
      for (int d0 = 0; d0 < 8; ++d0) { const float val = o[d0][r] * sc * gn[d0]; Cw[orow * LDC + d0 * 32 + r32_e] = (bf16)(cvtpk(val, val) & 0xffffu); }
      asm volatile("" ::: "memory"); }
  }
}
}
typedef unsigned short bf16_t;
typedef unsigned u32x4v __attribute__((ext_vector_type(4)));
#define LDSA __attribute__((address_space(3)))
constexpr size_t al256(size_t x) { return (x + 255) / 256 * 256; }
constexpr size_t WS_CTL  = 0;
constexpr size_t CTL_BYTES = 65536;
constexpr size_t WS_XB   = WS_CTL + CTL_BYTES;
constexpr size_t WS_WAB  = WS_XB + (size_t)SEQ * DM * 2;
constexpr size_t WS_WOAB = WS_WAB + (size_t)12288 * 4096 * 2;
constexpr size_t WS_WCD  = WS_WOAB + (size_t)4096 * 3072 * 2;
constexpr size_t WS_WOCD = WS_WCD + (size_t)9216 * 4096 * 2;
constexpr size_t WS_WQ   = WS_WOCD + (size_t)4096 * 4096 * 2;
constexpr size_t WS_UB   = WS_WQ + (size_t)2 * 2048 * 4096 * 2;
constexpr size_t WS_VB   = WS_UB + (size_t)2 * 16384 * 3072;
constexpr size_t WS_SU   = WS_VB + (size_t)2 * 16384 * 3072;
constexpr size_t WS_SV   = WS_SU + (size_t)2 * 16384 * 4;
constexpr size_t WS_H    = WS_SV + (size_t)2 * 16384 * 4;
constexpr size_t WS_Y    = WS_H;
constexpr size_t WS_PQ   = WS_H + (size_t)SEQ * 4096 * 4;
constexpr size_t WS_OC   = WS_H + (size_t)SEQ * 12288 * 4;
constexpr size_t WS_AB   = WS_OC + (size_t)2 * SEQ * 2048 * 4;
constexpr size_t WS_X1   = WS_AB + (size_t)SEQ * 4096 * 2;
constexpr size_t WS_X1B  = WS_X1 + (size_t)SEQ * 4096 * 4;
constexpr size_t WS_X2   = WS_X1B + (size_t)SEQ * 4096 * 2;
constexpr size_t WS_X2B  = WS_X2 + (size_t)SEQ * 4096 * 4;
constexpr size_t WS_EIDX = WS_X2B + (size_t)SEQ * 4096 * 2;
constexpr size_t WS_GATE = WS_EIDX + (size_t)SEQ * 128 * 4;
constexpr size_t WS_HB   = WS_GATE + (size_t)SEQ * 128 * 4;
constexpr size_t WS_KEYB = WS_HB + (size_t)SEQ * 12288 * 2;
constexpr size_t WS_CS0  = WS_KEYB + (size_t)2 * 8 * 2 * 128 * 128 * 2;
constexpr size_t WS_CSA  = WS_CS0 + (size_t)SEQ * 16 * 8;
constexpr size_t WS_END  = WS_CSA + (size_t)128 * 32 * 8;
static_assert(WS_END <= (size_t)2147483648ull, "workspace");

constexpr int LDS_BYTES = 155648;
constexpr int LDS_MISC = 139264;

struct MK { const float* in[21]; float* out; unsigned char* ws; int ph_lo, ph_hi; };

namespace pg8 {
struct EpiF32R {
    static constexpr bool PERM = false, AFTER_DRAIN = false;
    float* C; int ldc; const float* R; float ralpha;
    __device__ __forceinline__ void operator()(const f32x4 (&acc)[2][2][4][2], const Unit& u, int wr, int wc, int fr, int fq) const {
        const int row0 = u.pm * BM + wr * 64 + fr, col0 = u.pn * BM + wc * 32 + 4 * fq;
#pragma unroll
        for (int ai = 0; ai < 2; ++ai)
#pragma unroll
            for (int m = 0; m < 4; ++m) { const size_t off = (size_t)(row0 + ai * HALF + m * 16) * ldc + col0;
#pragma unroll
                for (int bj = 0; bj < 2; ++bj)
#pragma unroll
                    for (int n = 0; n < 2; ++n) { f32x4 v = acc[ai][bj][m][n];
                        if (R) { const f32x4 r = *(const f32x4*)(R + off + bj * HALF + n * 16); v += r * ralpha; }
                        *(f32x4*)(C + off + bj * HALF + n * 16) = v; } }
    }
};
struct EpiBf16P {
    static constexpr bool PERM = true, AFTER_DRAIN = false;
    bf16_t* O; int ldc;
    __device__ __forceinline__ void operator()(const f32x4 (&acc)[2][2][4][2], const Unit& u, int wr, int wc, int fr, int fq) const {
        const int row0 = u.pm * BM + wr * 64 + fr, col0 = u.pn * BM + wc * 32 + 8 * fq;
#pragma unroll
        for (int ai = 0; ai < 2; ++ai)
#pragma unroll
            for (int m = 0; m < 4; ++m) { bf16_t* rowp = O + (size_t)(row0 + ai * HALF + m * 16) * ldc + col0;
#pragma unroll
                for (int bj = 0; bj < 2; ++bj) { const f32x4 v0 = acc[ai][bj][m][0], v1 = acc[ai][bj][m][1];
                    u32x4 w; w.x = cvt_pk_bf16(v0[0], v0[1]); w.y = cvt_pk_bf16(v0[2], v0[3]); w.z = cvt_pk_bf16(v1[0], v1[1]); w.w = cvt_pk_bf16(v1[2], v1[3]);
                    *(u32x4*)(rowp + bj * HALF) = w; } }
    }
};

template <int LAYER> struct EpiProj {
    static constexpr bool PERM = true, AFTER_DRAIN = false;
    bf16_t* O; int ldc; const float* cs0; const float* csa; const float* gq; const float* gk; PG8_LAS float* xch;
    __device__ __forceinline__ void operator()(const f32x4 (&acc)[2][2][4][2], const Unit& u, int wr, int wc, int fr, int fq) const {
        const int row0 = u.pm * BM + wr * 64 + fr, col0 = u.pn * BM + wc * 32 + 8 * fq;
        const int pn = u.pn;
        const bool prope = LAYER == 0 ? (pn < 10 || (pn >= 12 && pn < 36)) : (pn < 16);
        const bool dnorm = LAYER == 1 && pn >= 24 && pn < 34;
        float rs[2][4][2];
        float gn[8];
        if (dnorm) {
            const int lrow = fr;
#pragma unroll
            for (int ai = 0; ai < 2; ++ai)
#pragma unroll
                for (int m = 0; m < 4; ++m)
#pragma unroll
                    for (int bj = 0; bj < 2; ++bj) { const f32x4 a = acc[ai][bj][m][0], b = acc[ai][bj][m][1];
                        float q = (a[0] * a[0] + a[1] * a[1]) + (a[2] * a[2] + a[3] * a[3]) + (b[0] * b[0] + b[1] * b[1]) + (b[2] * b[2] + b[3] * b[3]);
                        q += __shfl_xor(q, 16); q += __shfl_xor(q, 32);
                        if (fq == 0) xch[((wr * 128 + (ai * 4 + m) * 16 + lrow) * 2 + bj) * 4 + wc] = q; }
            asm volatile("s_waitcnt lgkmcnt(0)" ::: "memory"); __builtin_amdgcn_s_barrier(); asm volatile("" ::: "memory");
#pragma unroll
            for (int ai = 0; ai < 2; ++ai)
#pragma unroll
                for (int m = 0; m < 4; ++m)
#pragma unroll
                    for (int bj = 0; bj < 2; ++bj) { const f32x4 p = *(const PG8_LAS f32x4*)(xch + ((wr * 128 + (ai * 4 + m) * 16 + lrow) * 2 + bj) * 4);
                        rs[ai][m][bj] = 1.0f / sqrtf(((p[0] + p[1]) + (p[2] + p[3])) * (1.0f / 128.0f) + 1e-6f); }
            const float* g = pn < 32 ? gq : gk;
#pragma unroll
            for (int e = 0; e < 8; ++e) { const int p = wc * 32 + 8 * fq + e; const int orig = (p & 64) + ((p & 63) >> 1) + 32 * (p & 1); gn[e] = g[orig]; }
        }
        const bool rot = dnorm || (prope && wc == 0);
#pragma unroll
        for (int ai = 0; ai < 2; ++ai) {
            f32x4 cs[4][2];
            if (rot) {
#pragma unroll
                for (int m = 0; m < 4; ++m) { const int row = row0 + ai * HALF + m * 16;
                    const float* cp = dnorm ? csa + ((size_t)(wc < 2 ? (row >> 6) : (row & 63)) * 32 + 16 * (wc & 1) + 4 * fq) * 2 : cs0 + ((size_t)row * 16 + 4 * fq) * 2;
                    cs[m][0] = *(const f32x4*)cp; cs[m][1] = *(const f32x4*)(cp + 4); }
            }
#pragma unroll
            for (int m = 0; m < 4; ++m) {
                const int row = row0 + ai * HALF + m * 16;
                bf16_t* rowp = O + (size_t)row * ldc + col0;
                f32x4 c0 = (f32x4){1.f, 0.f, 1.f, 0.f}, c1 = c0;
                if (rot) { c0 = cs[m][0]; c1 = cs[m][1]; }
#pragma unroll
                for (int bj = 0; bj < 2; ++bj) { f32x4 v0 = acc[ai][bj][m][0], v1 = acc[ai][bj][m][1];
                    if (dnorm) { const float r = rs[ai][m][bj];
                        v0[0] *= r * gn[0]; v0[1] *= r * gn[1]; v0[2] *= r * gn[2]; v0[3] *= r * gn[3]; v1[0] *= r * gn[4]; v1[1] *= r * gn[5]; v1[2] *= r * gn[6]; v1[3] *= r * gn[7]; }
                    if (rot) {
                        const float a0 = v0[0] * c0[0] - v0[1] * c0[1], b0 = v0[1] * c0[0] + v0[0] * c0[1];
                        const float a1 = v0[2] * c0[2] - v0[3] * c0[3], b1 = v0[3] * c0[2] + v0[2] * c0[3];
                        const float a2 = v1[0] * c1[0] - v1[1] * c1[1], b2 = v1[1] * c1[0] + v1[0] * c1[1];
                        const float a3 = v1[2] * c1[2] - v1[3] * c1[3], b3 = v1[3] * c1[2] + v1[2] * c1[3];
                        v0 = (f32x4){a0, b0, a1, b1}; v1 = (f32x4){a2, b2, a3, b3}; }
                    u32x4 w; w.x = cvt_pk_bf16(v0[0], v0[1]); w.y = cvt_pk_bf16(v0[2], v0[3]); w.z = cvt_pk_bf16(v1[0], v1[1]); w.w = cvt_pk_bf16(v1[2], v1[3]);
                    *(u32x4*)(rowp + bj * HALF) = w; }
            }
            asm volatile("" ::: "memory");
        }
    }
};
}

__device__ __forceinline__ float bf_lo(unsigned w) { return __uint_as_float(w << 16); }
__device__ __forceinline__ float bf_hi(unsigned w) { return __uint_as_float(w & 0xffff0000u); }
__device__ __forceinline__ unsigned cvtpk_bf16(float lo, float hi) { unsigned r; asm volatile("v_cvt_pk_bf16_f32 %0, %1, %2" : "=v"(r) : "v"(lo), "v"(hi)); return r; }

__device__ __forceinline__ void cvt_rows_bf16(const float* __restrict__ src, bf16_t* __restrict__ dst, size_t n8, int bid, int nb, int tid, int nthr) {
    const size_t stride = (size_t)nb * nthr;
    for (size_t i = (size_t)bid * nthr + tid; i < n8; i += 4 * stride) {
        float4 a[4], b[4];
#pragma unroll
        for (int u = 0; u < 4; ++u) { const size_t j = i + u * stride; if (j < n8) { a[u] = *(const float4*)(src + j * 8); b[u] = *(const float4*)(src + j * 8 + 4); } }
#pragma unroll
        for (int u = 0; u < 4; ++u) { const size_t j = i + u * stride; if (j < n8) {
            u32x4v w; w.x = cvtpk_bf16(a[u].x, a[u].y); w.y = cvtpk_bf16(a[u].z, a[u].w); w.z = cvtpk_bf16(b[u].x, b[u].y); w.w = cvtpk_bf16(b[u].z, b[u].w);
            *(u32x4v*)(dst + j * 8) = w; } }
    }
}
template <class PM>
__device__ __forceinline__ void transpose_cvt(const float* __restrict__ W, bf16_t* __restrict__ Wt, int K, int N, LDSA float* tile0, int bid, int nb, PM pm, const int tid) {
    const int lane = tid & 63, wv = tid >> 6;
    LDSA float* tile = tile0 + wv * 4352;
    const int ntk = K / 64, ntn = N / 64;
    for (int t = bid * 8 + wv; t < ntk * ntn; t += nb * 8) {
        const int k0 = (t % ntk) * 64, n0 = (t / ntk) * 64;
        const int c = (lane & 15) * 4, r0 = lane >> 4;
        float4 v[16];
#pragma unroll
        for (int i = 0; i < 16; ++i) v[i] = *(const float4*)(W + (size_t)(k0 + r0 + 4 * i) * N + n0 + c);
#pragma unroll
        for (int i = 0; i < 16; ++i) { const int r = r0 + 4 * i; tile[r * 65 + c] = v[i].x; tile[r * 65 + c + 1] = v[i].y; tile[r * 65 + c + 2] = v[i].z; tile[r * 65 + c + 3] = v[i].w; }
        asm volatile("s_waitcnt lgkmcnt(0)" ::: "memory");
        const int mode = pm(n0);
#pragma unroll
        for (int h = 0; h < 8; ++h) {
            const int n = (lane >> 3) + 8 * h, kc = (lane & 7) * 8;
            int src = n;
            if (mode == 1) { if (n < 32) src = (n >> 1) + 16 * (n & 1); }
            else if (mode == 2) src = (n >> 1) + 32 * (n & 1);
            float f[8];
#pragma unroll
            for (int j = 0; j < 8; ++j) f[j] = tile[(kc + j) * 65 + src];
            u32x4v w; w.x = cvtpk_bf16(f[0], f[1]); w.y = cvtpk_bf16(f[2], f[3]); w.z = cvtpk_bf16(f[4], f[5]); w.w = cvtpk_bf16(f[6], f[7]);
            *(u32x4v*)(Wt + (size_t)(n0 + n) * K + k0 + kc) = w;
        }
        asm volatile("s_waitcnt lgkmcnt(0)" ::: "memory");
    }
}
struct PermNone { __device__ __forceinline__ int operator()(int) const { return 0; } };
struct PermAB { __device__ __forceinline__ int operator()(int n0) const { const bool rope = n0 < 2560 || (n0 >= 3072 && n0 < 9216); return (rope && (n0 & 127) == 0) ? 1 : 0; } };
struct PermCD { __device__ __forceinline__ int operator()(int n0) const { if (n0 < 4096) return (n0 & 127) == 0 ? 1 : 0; if (n0 >= 6144 && n0 < 8704) return 2; return 0; } };
__device__ __forceinline__ void rope_tables(float* __restrict__ cs0, float* __restrict__ csa, const int bid, const int G, const int tid) {
    for (int i = bid * 512 + tid; i < SEQ * 16; i += G * 512) { float s, c; sincos_rev((double)(i >> 4) * REV_P[i & 15], s, c); *(float2*)(cs0 + (size_t)i * 2) = make_float2(c, s); }
    for (int i = bid * 512 + tid; i < 128 * 32; i += G * 512) { float s, c; sincos_rev((double)(i >> 5) * REV_A[i & 31], s, c); *(float2*)(csa + (size_t)i * 2) = make_float2(c, s); }
}


typedef unsigned v6u_t __attribute__((ext_vector_type(6)));
typedef float f4v_t __attribute__((ext_vector_type(4)));
typedef unsigned v16u_t __attribute__((ext_vector_type(16)));
typedef float v16f_t __attribute__((ext_vector_type(16)));
typedef float v32f_t __attribute__((ext_vector_type(32)));
typedef __bf16 v32b_t __attribute__((ext_vector_type(32)));
constexpr int ROWB = 3072;
constexpr int XT_STRIDE = 68;
constexpr int XT_BYTES = 64 * XT_STRIDE * 4;
__device__ __forceinline__ void table_fp6(const float* __restrict__ src, unsigned char* __restrict__ dst, float* __restrict__ inv, const int rows, LDSA float* xt0, const int bid, const int G, const int tid) {
    const int lane = tid & 63, wv = tid >> 6;
    LDSA float* xt = xt0 + wv * (XT_BYTES / 4);
    for (int r = bid * 8 + wv; r < rows; r += G * 8) {
        float4 v[16]; float am = 0.f;
#pragma unroll
        for (int j = 0; j < 16; ++j) { v[j] = *(const float4*)(src + (size_t)r * DM + j * 256 + lane * 4); am = fmaxf(am, fmaxf(fmaxf(fabsf(v[j].x), fabsf(v[j].y)), fmaxf(fabsf(v[j].z), fabsf(v[j].w)))); }
        am = wave_max(am);
        const float sc = am > 0.f ? 7.0f / am : 1.0f;
#pragma unroll
        for (int j = 0; j < 16; ++j) *(LDSA f4v_t*)(xt + (4 * j + (lane >> 4)) * XT_STRIDE + 4 * (lane & 15)) = (f4v_t){v[j].x * sc, v[j].y * sc, v[j].z * sc, v[j].w * sc};
        asm volatile("s_waitcnt lgkmcnt(0)" ::: "memory");
        v16f_t f0, f1, f2, f3;
#pragma unroll
        for (int k = 0; k < 8; ++k) { const f4v_t a = *(const LDSA f4v_t*)(xt + lane * XT_STRIDE + 4 * k), c = *(const LDSA f4v_t*)(xt + lane * XT_STRIDE + 32 + 4 * k);
            f0[2 * k] = a[0]; f1[2 * k] = a[1]; f0[2 * k + 1] = a[2]; f1[2 * k + 1] = a[3];
            f2[2 * k] = c[0]; f3[2 * k] = c[1]; f2[2 * k + 1] = c[2]; f3[2 * k + 1] = c[3]; }
        asm volatile("s_waitcnt lgkmcnt(0)" ::: "memory");
        const v6u_t w0 = __builtin_amdgcn_cvt_scalef32_2xpk16_fp6_f32(f0, f1, 1.0f), w1 = __builtin_amdgcn_cvt_scalef32_2xpk16_fp6_f32(f2, f3, 1.0f);
        unsigned char* dp = dst + (size_t)r * ROWB + lane * 48;
        u32x4v s0, s1, s2; s0.x = w0[0]; s0.y = w0[1]; s0.z = w0[2]; s0.w = w0[3]; s1.x = w0[4]; s1.y = w0[5]; s1.z = w1[0]; s1.w = w1[1]; s2.x = w1[2]; s2.y = w1[3]; s2.z = w1[4]; s2.w = w1[5];
        *(u32x4v*)dp = s0; *(u32x4v*)(dp + 16) = s1; *(u32x4v*)(dp + 32) = s2;
        if (lane == 0) inv[r] = am > 0.f ? am * (1.0f / 7.0f) : 1.0f;
    }
}

typedef __bf16 bf2_t __attribute__((ext_vector_type(2)));
__device__ __forceinline__ float dot2_bf16(unsigned a, unsigned b, float c) { return __builtin_amdgcn_fdot2_f32_bf16(__builtin_bit_cast(bf2_t, a), __builtin_bit_cast(bf2_t, b), c, false); }
__device__ __forceinline__ float gelu_tanh_f(float x) {
    const float z = 0.7978845608028654f * (x + 0.044715f * x * x * x);
    const float e = __expf(2.0f * z);
    return 0.5f * x * (2.0f - 2.0f / (e + 1.0f));
}
__device__ __forceinline__ int pick_i(int a0, int a1, int k) { return k < 64 ? __builtin_amdgcn_readlane(a0, k) : __builtin_amdgcn_readlane(a1, k - 64); }
__device__ __forceinline__ float pick_f(float a0, float a1, int k) { return __int_as_float(pick_i(__float_as_int(a0), __float_as_int(a1), k)); }
#define PE_LOADROW(dst, base, e) do { const unsigned char* _p = (base) + (size_t)(e) * ROWB + lane * 48; dst[0] = *(const u32x4v*)_p; dst[1] = *(const u32x4v*)(_p + 16); dst[2] = *(const u32x4v*)(_p + 32); } while (0)
__device__ __forceinline__ float pe_dot(const u32x4v (&r)[3], const u32x4v (&x)[8]) {
    float d0 = 0.f, d1 = 0.f, d2 = 0.f, d3 = 0.f;
    { const v6u_t g = {r[0].x, r[0].y, r[0].z, r[0].w, r[1].x, r[1].y};
      const v16u_t z = __builtin_bit_cast(v16u_t, __builtin_amdgcn_cvt_scalef32_pk32_bf16_fp6(g, 1.0f));
#pragma unroll
      for (int k = 0; k < 4; ++k) { const unsigned xa = x[k].x, xb = x[k].y, xc = x[k].z, xd = x[k].w; const unsigned za = z[4 * k], zb = z[4 * k + 1], zc = z[4 * k + 2], zd = z[4 * k + 3];
          d0 = dot2_bf16(za, xa, d0); d1 = dot2_bf16(zb, xb, d1); d2 = dot2_bf16(zc, xc, d2); d3 = dot2_bf16(zd, xd, d3); }
      asm volatile("" : "+v"(d0), "+v"(d1), "+v"(d2), "+v"(d3)); }
    { const v6u_t g = {r[1].z, r[1].w, r[2].x, r[2].y, r[2].z, r[2].w};
      const v16u_t z = __builtin_bit_cast(v16u_t, __builtin_amdgcn_cvt_scalef32_pk32_bf16_fp6(g, 1.0f));
#pragma unroll
      for (int k = 0; k < 4; ++k) { const unsigned xa = x[4 + k].x, xb = x[4 + k].y, xc = x[4 + k].z, xd = x[4 + k].w; const unsigned za = z[4 * k], zb = z[4 * k + 1], zc = z[4 * k + 2], zd = z[4 * k + 3];
          d0 = dot2_bf16(za, xa, d0); d1 = dot2_bf16(zb, xb, d1); d2 = dot2_bf16(zc, xc, d2); d3 = dot2_bf16(zd, xd, d3); } }
    return wave_sum((d0 + d1) + (d2 + d3));
}
#define PE_PIN16(a, b) asm volatile("" : "+v"(a[b + 0]), "+v"(a[b + 1]), "+v"(a[b + 2]), "+v"(a[b + 3]), "+v"(a[b + 4]), "+v"(a[b + 5]), "+v"(a[b + 6]), "+v"(a[b + 7]), \
                                         "+v"(a[b + 8]), "+v"(a[b + 9]), "+v"(a[b + 10]), "+v"(a[b + 11]), "+v"(a[b + 12]), "+v"(a[b + 13]), "+v"(a[b + 14]), "+v"(a[b + 15]))
__device__ __forceinline__ void pe_axpy(float (&acc)[64], const u32x4v (&r)[3], const float w) {
    { const v6u_t g = {r[0].x, r[0].y, r[0].z, r[0].w, r[1].x, r[1].y};
      const v32f_t y = __builtin_amdgcn_cvt_scalef32_pk32_f32_fp6(g, 1.0f);
#pragma unroll
      for (int i = 0; i < 32; ++i) acc[i] = fmaf(w, y[i], acc[i]);
      PE_PIN16(acc, 0); PE_PIN16(acc, 16); }
    { const v6u_t g = {r[1].z, r[1].w, r[2].x, r[2].y, r[2].z, r[2].w};
      const v32f_t y = __builtin_amdgcn_cvt_scalef32_pk32_f32_fp6(g, 1.0f);
#pragma unroll
      for (int i = 0; i < 32; ++i) acc[32 + i] = fmaf(w, y[i], acc[32 + i]);
      PE_PIN16(acc, 32); PE_PIN16(acc, 48); }
}
__device__ __forceinline__ void wave_sort128(unsigned& a0, unsigned& a1, const int lane) {
#pragma unroll
    for (int k = 2; k <= 128; k <<= 1) {
#pragma unroll
        for (int j = k >> 1; j > 0; j >>= 1) {
            if (j == 64) { const unsigned lo = a0 < a1 ? a0 : a1, hi = a0 < a1 ? a1 : a0; a0 = lo; a1 = hi; }
            else {
                const unsigned o0 = (unsigned)__shfl_xor((int)a0, j), o1 = (unsigned)__shfl_xor((int)a1, j);
                const bool lowhalf = (lane & j) == 0;
                const bool up0 = k >= 128 ? true : ((lane & k) == 0);
                const bool up1 = k >= 128 ? true : (k == 64 ? false : ((lane & k) == 0));
                const bool min0 = lowhalf == up0, min1 = lowhalf == up1;
                const unsigned mn0 = a0 < o0 ? a0 : o0, mx0 = a0 < o0 ? o0 : a0, mn1 = a1 < o1 ? a1 : o1, mx1 = a1 < o1 ? o1 : a1;
                a0 = min0 ? mn0 : mx0; a1 = min1 ? mn1 : mx1;
            }
        }
    }
}
__device__ __forceinline__ void peer_expert_phase(const float* __restrict__ ypre, const float* __restrict__ stats, const float* __restrict__ gm, const float* __restrict__ bm, const bf16_t* __restrict__ x1b, int* __restrict__ eidx, float* __restrict__ gate,
                                                  const unsigned char* __restrict__ ub, const unsigned char* __restrict__ vb, const float* __restrict__ isu, const float* __restrict__ isv,
                                                  const float* __restrict__ lg, const float* __restrict__ lb, float* __restrict__ out, bf16_t* __restrict__ outb, LDSA float* xt0, const int bid, const int G, const int tid) {
    const int wv = __builtin_amdgcn_readfirstlane(tid >> 6);
    LDSA float* xt = xt0 + wv * (XT_BYTES / 4);
#define PE_POS(k) (rev ? 127 - (k) : (k))
#define PE_E(k) pick_i(e0, e1, PE_POS(k))
    int jt = 0;
    for (int t = bid * 8 + wv; t < SEQ; t += G * 8, ++jt) {
        int tl = tid; asm volatile("" : "+v"(tl));
        const int lane = tl & 63;
        const bool rev = (jt & 1) != 0;
        int e0, e1; float g0, g1;
        { const int r0 = eidx[(size_t)t * 128 + lane], r1 = eidx[(size_t)t * 128 + 64 + lane];
          const float h0 = gate[(size_t)t * 128 + lane], h1 = gate[(size_t)t * 128 + 64 + lane];
          unsigned a0 = ((unsigned)r0 << 7) | (unsigned)lane, a1 = ((unsigned)r1 << 7) | (unsigned)(64 + lane);
          wave_sort128(a0, a1, lane);
          e0 = (int)(a0 >> 7); e1 = (int)(a1 >> 7);
          const int k0 = (int)(a0 & 127u), k1 = (int)(a1 & 127u);
          const float p00 = __shfl(h0, k0 & 63), p01 = __shfl(h1, k0 & 63), p10 = __shfl(h0, k1 & 63), p11 = __shfl(h1, k1 & 63);
          g0 = k0 < 64 ? p00 : p01; g1 = k1 < 64 ? p10 : p11; }
        const float iu0 = isu[e0], iu1 = isu[e1], iv0 = isv[e0], iv1 = isv[e1];
        u32x4v xq[8];
#pragma unroll
        for (int k = 0; k < 8; ++k) xq[k] = *(const u32x4v*)(x1b + (size_t)t * DM + lane * 64 + k * 8);
        float w0 = 0.f, w1 = 0.f;
        u32x4v R0[3], R1[3], R2[3], R3[3], R4[3];
#define PE_USTEP(R, k) do { const int kk = PE_POS(k); const float d = pe_dot(R, xq) * pick_f(iu0, iu1, kk); const float w = pick_f(g0, g1, kk) * gelu_tanh_f(d) * pick_f(iv0, iv1, kk); \
            if (lane == (kk & 63)) { if (kk < 64) w0 = w; else w1 = w; } } while (0)
        PE_LOADROW(R0, ub, PE_E(0)); PE_LOADROW(R1, ub, PE_E(1)); PE_LOADROW(R2, ub, PE_E(2)); PE_LOADROW(R3, ub, PE_E(3));
        for (int k = 0; k < 125; k += 5) {
            if (k + 4 < 128) PE_LOADROW(R4, ub, PE_E(k + 4)); PE_USTEP(R0, k);
            if (k + 5 < 128) PE_LOADROW(R0, ub, PE_E(k + 5)); PE_USTEP(R1, k + 1);
            if (k + 6 < 128) PE_LOADROW(R1, ub, PE_E(k + 6)); PE_USTEP(R2, k + 2);
            if (k + 7 < 128) PE_LOADROW(R2, ub, PE_E(k + 7)); PE_USTEP(R3, k + 3);
            if (k + 8 < 128) PE_LOADROW(R3, ub, PE_E(k + 8)); PE_USTEP(R4, k + 4);
        }
        PE_USTEP(R0, 125); PE_USTEP(R1, 126); PE_USTEP(R2, 127);
#undef PE_USTEP
        eidx[(size_t)t * 128 + lane] = e0; eidx[(size_t)t * 128 + 64 + lane] = e1;
        gate[(size_t)t * 128 + lane] = w0; gate[(size_t)t * 128 + 64 + lane] = w1;
    }
    asm volatile("s_waitcnt vmcnt(0)" ::: "memory");
    for (int t = bid * 8 + wv; t < SEQ; t += G * 8, ++jt) {
        int tl = tid; asm volatile("" : "+v"(tl));
        const int lane = tl & 63;
        const bool rev = (jt & 1) != 0;
        const int e0 = __builtin_nontemporal_load(eidx + (size_t)t * 128 + lane), e1 = __builtin_nontemporal_load(eidx + (size_t)t * 128 + 64 + lane);
        const float w0 = __builtin_nontemporal_load(gate + (size_t)t * 128 + lane), w1 = __builtin_nontemporal_load(gate + (size_t)t * 128 + 64 + lane);
        u32x4v R0[3], R1[3], R2[3], R3[3], R4[3];
        float acc[64];
#pragma unroll
        for (int i = 0; i < 64; ++i) acc[i] = 0.f;
        PE_LOADROW(R0, vb, PE_E(0)); PE_LOADROW(R1, vb, PE_E(1)); PE_LOADROW(R2, vb, PE_E(2)); PE_LOADROW(R3, vb, PE_E(3));
        for (int k = 0; k < 125; k += 5) {
            if (k + 4 < 128) PE_LOADROW(R4, vb, PE_E(k + 4)); pe_axpy(acc, R0, pick_f(w0, w1, PE_POS(k)));
            if (k + 5 < 128) PE_LOADROW(R0, vb, PE_E(k + 5)); pe_axpy(acc, R1, pick_f(w0, w1, PE_POS(k + 1)));
            if (k + 6 < 128) PE_LOADROW(R1, vb, PE_E(k + 6)); pe_axpy(acc, R2, pick_f(w0, w1, PE_POS(k + 2)));
            if (k + 7 < 128) PE_LOADROW(R2, vb, PE_E(k + 7)); pe_axpy(acc, R3, pick_f(w0, w1, PE_POS(k + 3)));
            if (k + 8 < 128) PE_LOADROW(R3, vb, PE_E(k + 8)); pe_axpy(acc, R4, pick_f(w0, w1, PE_POS(k + 4)));
        }
        pe_axpy(acc, R0, pick_f(w0, w1, PE_POS(125))); pe_axpy(acc, R1, pick_f(w0, w1, PE_POS(126))); pe_axpy(acc, R2, pick_f(w0, w1, PE_POS(127)));
#pragma unroll
        for (int k = 0; k < 16; ++k) *(LDSA f4v_t*)(xt + lane * XT_STRIDE + 4 * k) = (f4v_t){acc[4 * k], acc[4 * k + 1], acc[4 * k + 2], acc[4 * k + 3]};
        asm volatile("s_waitcnt lgkmcnt(0)" ::: "memory");
        float4 y[16]; float s = 0.f; const float2 st = *(const float2*)(stats + (size_t)t * 2);
#pragma unroll
        for (int j = 0; j < 16; ++j) { const f4v_t f = *(const LDSA f4v_t*)(xt + (4 * j + (lane >> 4)) * XT_STRIDE + 4 * (lane & 15));
            const float4 yv = *(const float4*)(ypre + (size_t)t * DM + j * 256 + lane * 4), gv = *(const float4*)(gm + j * 256 + lane * 4), bv = *(const float4*)(bm + j * 256 + lane * 4);
            float4 xv;
            xv.x = (yv.x - st.x) * st.y * gv.x + bv.x; xv.y = (yv.y - st.x) * st.y * gv.y + bv.y; xv.z = (yv.z - st.x) * st.y * gv.z + bv.z; xv.w = (yv.w - st.x) * st.y * gv.w + bv.w;
            y[j].x = fmaf(ALPHA, xv.x, f.x); y[j].y = fmaf(ALPHA, xv.y, f.y); y[j].z = fmaf(ALPHA, xv.z, f.z); y[j].w = fmaf(ALPHA, xv.w, f.w);
            s += (y[j].x + y[j].y) + (y[j].z + y[j].w);
            if (j & 1) asm volatile("" ::: "memory"); }
        asm volatile("s_waitcnt lgkmcnt(0)" ::: "memory");
        const float mean = wave_sum(s) * (1.0f / DM);
        float qq = 0.f;
#pragma unroll
        for (int j = 0; j < 16; ++j) { const float a = y[j].x - mean, b = y[j].y - mean, c = y[j].z - mean, d = y[j].w - mean; qq += (a * a + b * b) + (c * c + d * d); }
        const float rstd = 1.0f / sqrtf(wave_sum(qq) * (1.0f / DM) + 1e-5f);
#pragma unroll
        for (int j = 0; j < 16; ++j) {
            const int c = j * 256 + lane * 4;
            const float4 ga = *(const float4*)(lg + c), ba = *(const float4*)(lb + c);
            float4 oa; oa.x = (y[j].x - mean) * rstd * ga.x + ba.x; oa.y = (y[j].y - mean) * rstd * ga.y + ba.y; oa.z = (y[j].z - mean) * rstd * ga.z + ba.z; oa.w = (y[j].w - mean) * rstd * ga.w + ba.w;
            *(float4*)(out + (size_t)t * DM + c) = oa;
            if (outb) { uint2 w; w.x = cvtpk_bf16(oa.x, oa.y); w.y = cvtpk_bf16(oa.z, oa.w); *(uint2*)(outb + (size_t)t * DM + c) = w; }
            if ((j & 3) == 3) asm volatile("" ::: "memory");
        }
    }
#undef PE_E
#undef PE_POS
}

__device__ __forceinline__ void attn1_phase(const bf16_t* __restrict__ hb, bf16_t* __restrict__ abb, float* __restrict__ oc, const float* __restrict__ lq1, const float* __restrict__ lk1, const float* __restrict__ lq2,
                                            const float* __restrict__ lk2, const float* __restrict__ subg, char* lds, const int bid, const int G, const int tid) {
    for (int u = bid; u < 512; u += G) {
        __syncthreads();
        const int kv = u >> 7, g = (u >> 5) & 3, qb = u & 31, hq = kv * 4 + g;
        att::attn_wide_body<9216, 9216, 4096, 1, att::bf16>(hb + (size_t)(qb * 256) * 9216 + 6144 + hq * 128, hb + 8192 + kv * 128, hb + 8704 + kv * 128,
                                                             abb + (size_t)(qb * 256) * 4096 + 2048 + hq * 128, SEQ, lds, tid);
    }
    int tid2 = tid; asm volatile("" : "+v"(tid2));
    const int lane_c = tid2 & 63;
    const float lam = __int_as_float(__builtin_amdgcn_readfirstlane(__float_as_int(__expf(wave_sum(lq1[lane_c] * lk1[lane_c] + lq1[lane_c + 64] * lk1[lane_c + 64])) - __expf(wave_sum(lq2[lane_c] * lk2[lane_c] + lq2[lane_c + 64] * lk2[lane_c + 64])) + LAMBDA_INIT)));
    for (int v = bid; v < 256; v += G) {
        __syncthreads();
        const int h = v >> 5, qb = v & 31;
        float* o1 = oc + (size_t)(qb * 256) * 2048 + h * 256;
        int tid4 = tid2; asm volatile("" : "+v"(tid4));
        att::attn_wide_body<9216, 9216, 2048, 2, float>(hb + (size_t)(qb * 256) * 9216 + h * 256, hb + 2048 + h * 256, hb + 4096 + h * 256, o1, SEQ, lds, tid4);
        __syncthreads();
        int tid3 = tid2; asm volatile("" : "+v"(tid3));
        att::attn_wide_body<9216, 9216, 2048, 2, float, true, 4096>(hb + (size_t)(qb * 256) * 9216 + h * 256 + 128, hb + 2048 + h * 256 + 128, hb + 4096 + h * 256, o1, SEQ, lds, tid3,
                                                                     lam, 1.0f - LAMBDA_INIT, subg, abb + (size_t)(qb * 256) * 4096 + h * 256);
    }
}


__device__ __forceinline__ void attn0_phase(const bf16_t* __restrict__ hb, const float* __restrict__ sink, bf16_t* __restrict__ abb, bf16_t* __restrict__ obg, float* __restrict__ lse, char* lds, const int bid, const int G, const int tid) {
    const long LD = 12288;
    for (int u = bid; u < 512; u += G) {
        __syncthreads();
        const int hq = u >> 5, qb = u & 31, kv = hq >> 2;
        att::attn_banded_body<128>(hb + hq * 128, hb + 2048 + kv * 128, hb + 2560 + kv * 128, LD, SEQ, qb * 256, sink[hq] * (1.0f / att::SCALE), 1.0f, abb + hq * 128, 3072, nullptr, 0, lds, tid);
    }
    int tid2 = tid; asm volatile("" : "+v"(tid2));
    for (int v = bid; v < 768; v += G) {
        __syncthreads();
        const int g = v >> 8, w = v & 255, h = w >> 5, rem = w & 31;
        const int dsh = 2 * g;
        const int nqb_sh = 5 - dsh;
        const int r = rem >> nqb_sh, qb = rem & ((1 << nqb_sh) - 1);
        const int head = 8 * g + h;
        const long rs = LD << dsh;
        att::attn_banded_body<64>(hb + (long)r * LD + 3072 + head * 128, hb + (long)r * LD + 6144 + head * 128, hb + (long)r * LD + 9216 + head * 128, rs, SEQ >> dsh, qb * 256, -1e30f, 0.f,
                                  obg + ((long)(g * 8 + h) * SEQ + r) * 128, (long)128 << dsh, lse + (long)(g * 8 + h) * SEQ + r, (long)1 << dsh, lds, tid2);
    }
}
__device__ __forceinline__ void merge0_phase(const bf16_t* __restrict__ obg, const float* __restrict__ lse, bf16_t* __restrict__ abb, const int bid, const int G, const int tid) {
    const int lane = tid & 63, wv = tid >> 6;
    for (int j = bid * 8 + wv; j < SEQ * 8; j += G * 8) {
        const int h = j >> 13, t = j & (SEQ - 1);
        const float l0 = lse[(size_t)(0 * 8 + h) * SEQ + t], l1 = lse[(size_t)(1 * 8 + h) * SEQ + t], l2 = lse[(size_t)(2 * 8 + h) * SEQ + t];
        const float mx = fmaxf(l0, fmaxf(l1, l2));
        const float e0 = __expf(l0 - mx), e1 = __expf(l1 - mx), e2 = __expf(l2 - mx), inv = 1.0f / (e0 + e1 + e2);
        const unsigned a0 = *(const unsigned*)(obg + ((size_t)(0 * 8 + h) * SEQ + t) * 128 + 2 * lane), a1 = *(const unsigned*)(obg + ((size_t)(1 * 8 + h) * SEQ + t) * 128 + 2 * lane), a2 = *(const unsigned*)(obg + ((size_t)(2 * 8 + h) * SEQ + t) * 128 + 2 * lane);
        const float x = (e0 * bf_lo(a0) + e1 * bf_lo(a1) + e2 * bf_lo(a2)) * inv, y = (e0 * bf_hi(a0) + e1 * bf_hi(a1) + e2 * bf_hi(a2)) * inv;
        *(unsigned*)(abb + (size_t)t * 3072 + 2048 + h * 128 + 2 * lane) = cvtpk_bf16(x, y);
    }
}

__device__ __forceinline__ void post_even_phase(const float* __restrict__ h, bf16_t* __restrict__ hb, const int bid, const int G, const int tid) {
    const int lane = tid & 63, wv = tid >> 6;
    for (int job = bid * 8 + wv; job < SEQ * 96; job += G * 8) {
        const int t = job / 96, blk = job - t * 96;
        const bool rope = (blk < 20) || (blk >= 24 && blk < 72);
        const float2 v = *(const float2*)(h + (size_t)t * 12288 + blk * 128 + 2 * lane);
        float o0 = v.x, o1 = v.y;
        const float p0 = __shfl_xor(v.x, 8), p1 = __shfl_xor(v.y, 8);
        if (rope && lane < 16) {
            const int i0 = (2 * lane) & 15;
            float s0, c0, s1, c1; sincos_rev((double)t * REV_P[i0], s0, c0); sincos_rev((double)t * REV_P[i0 + 1], s1, c1);
            if (lane < 8) { o0 = v.x * c0 - p0 * s0; o1 = v.y * c1 - p1 * s1; }
            else          { o0 = v.x * c0 + p0 * s0; o1 = v.y * c1 + p1 * s1; }
        }
        *(unsigned*)(hb + (size_t)t * 12288 + blk * 128 + 2 * lane) = cvtpk_bf16(o0, o1);
    }
}
__device__ __forceinline__ void post_odd_phase(const float* __restrict__ h, bf16_t* __restrict__ hb, const float* __restrict__ qg, const float* __restrict__ kg, const int bid, const int G, const int tid) {
    const int lane = tid & 63, wv = tid >> 6;
    for (int job = bid * 8 + wv; job < SEQ * 72; job += G * 8) {
        const int t = job / 72, blk = job - t * 72;
        const float2 v = *(const float2*)(h + (size_t)t * 9216 + blk * 128 + 2 * lane);
        float o0 = v.x, o1 = v.y;
        if (blk < 32) {
            const float p0 = __shfl_xor(v.x, 8), p1 = __shfl_xor(v.y, 8);
            if (lane < 16) {
                const int i0 = (2 * lane) & 15;
                float s0, c0, s1, c1; sincos_rev((double)t * REV_P[i0], s0, c0); sincos_rev((double)t * REV_P[i0 + 1], s1, c1);
                if (lane < 8) { o0 = v.x * c0 - p0 * s0; o1 = v.y * c1 - p1 * s1; }
                else          { o0 = v.x * c0 + p0 * s0; o1 = v.y * c1 + p1 * s1; }
            }
        } else if (blk >= 48 && blk < 68) {
            const float* g = blk < 64 ? qg : kg;
            const float ss = wave_sum(v.x * v.x + v.y * v.y) * (1.0f / 128.0f);
            const float rs = 1.0f / sqrtf(ss + 1e-6f);
            const float a0 = v.x * rs * g[2 * lane], a1 = v.y * rs * g[2 * lane + 1];
            const float p0 = __shfl_xor(a0, 16), p1 = __shfl_xor(a1, 16);
            const int i0 = (2 * lane) & 31;
            const double pos = (double)(lane < 32 ? (t >> 6) : (t & 63));
            float s0, c0, s1, c1; sincos_rev(pos * REV_A[i0], s0, c0); sincos_rev(pos * REV_A[i0 + 1], s1, c1);
            if ((lane & 16) == 0) { o0 = a0 * c0 - p0 * s0; o1 = a1 * c1 - p1 * s1; }
            else                  { o0 = a0 * c0 + p0 * s0; o1 = a1 * c1 + p1 * s1; }
        }
        *(unsigned*)(hb + (size_t)t * 9216 + blk * 128 + 2 * lane) = cvtpk_bf16(o0, o1);
    }
}

__device__ __forceinline__ void attn_seg_b(const float q0, const float q1, const bf16_t* __restrict__ Kb, const bf16_t* __restrict__ Vb, const int ld,
                                           const int t, const int step, int jlo, int jhi, float& m, float& l, float& o0, float& o1, const int lane) {
    { const int lo = -(t / step); if (jlo < lo) jlo = lo; const int hi = (SEQ - 1 - t) / step; if (jhi > hi) jhi = hi; }
    for (int j = jlo; j <= jhi; ++j) {
        const size_t tp = (size_t)(t + step * j);
        const unsigned kw = *(const unsigned*)(Kb + tp * ld + 2 * lane), vw = *(const unsigned*)(Vb + tp * ld + 2 * lane);
        const float s = wave_sum(q0 * bf_lo(kw) + q1 * bf_hi(kw)) * ATT_SCALE;
        const float mn = fmaxf(m, s);
        const float al = __expf(m - mn), p = __expf(s - mn);
        l = l * al + p;
        o0 = o0 * al + p * bf_lo(vw); o1 = o1 * al + p * bf_hi(vw);
        m = mn;
    }
}
__device__ __forceinline__ void attn_even_valu_phase(const bf16_t* __restrict__ hb, const float* __restrict__ sink, bf16_t* __restrict__ abb, const int bid, const int G, const int tid) {
    const int lane = tid & 63, wv = tid >> 6;
    const int LD = 12288;
    for (int job = bid * 8 + wv; job < SEQ * 24; job += G * 8) {
        const int hh = job / SEQ, t = job % SEQ;
        float o0 = 0.f, o1 = 0.f, m, l;
        if (hh < 16) {
            const int kv = hh >> 2;
            const unsigned qw = *(const unsigned*)(hb + (size_t)t * LD + hh * 128 + 2 * lane);
            m = sink[hh]; l = 1.f;
            attn_seg_b(bf_lo(qw), bf_hi(qw), hb + 2048 + kv * 128, hb + 2560 + kv * 128, LD, t, 1, -128, 128, m, l, o0, o1, lane);
        } else {
            const int hbh = hh - 16;
            m = -1e30f; l = 0.f;
#pragma unroll
            for (int g = 0; g < 3; ++g) {
                const int head = 8 * g + hbh; const int step = g == 0 ? 1 : (g == 1 ? 4 : 16);
                const unsigned qw = *(const unsigned*)(hb + (size_t)t * LD + 3072 + head * 128 + 2 * lane);
                attn_seg_b(bf_lo(qw), bf_hi(qw), hb + 6144 + head * 128, hb + 9216 + head * 128, LD, t, step, -64, 64, m, l, o0, o1, lane);
            }
        }
        const float il = 1.0f / l;
        *(unsigned*)(abb + (size_t)t * 3072 + hh * 128 + 2 * lane) = cvtpk_bf16(o0 * il, o1 * il);
    }
}

__device__ __forceinline__ void ln_phase(const float* __restrict__ y, const float* __restrict__ g, const float* __restrict__ b, float* __restrict__ stats, bf16_t* __restrict__ outb, const int bid, const int G, const int tid) {
    const int lane = tid & 63, wv = tid >> 6;
    for (int t = bid * 8 + wv; t < SEQ; t += G * 8) {
        float4 v[16]; float s = 0.f;
#pragma unroll
        for (int i = 0; i < 16; ++i) { v[i] = *(const float4*)(y + (size_t)t * DM + i * 256 + lane * 4); s += (v[i].x + v[i].y) + (v[i].z + v[i].w); }
        const float mean = wave_sum(s) * (1.0f / DM);
        float q = 0.f;
#pragma unroll
        for (int i = 0; i < 16; ++i) { const float a = v[i].x - mean, bb = v[i].y - mean, c = v[i].z - mean, d = v[i].w - mean; q += (a * a + bb * bb) + (c * c + d * d); }
        const float rstd = 1.0f / sqrtf(wave_sum(q) * (1.0f / DM) + 1e-5f);
        if (lane == 0) *(float2*)(stats + (size_t)t * 2) = make_float2(mean, rstd);
#pragma unroll
        for (int i = 0; i < 16; ++i) {
            const float4 gg = *(const float4*)(g + i * 256 + lane * 4), bb = *(const float4*)(b + i * 256 + lane * 4);
            float4 o; o.x = (v[i].x - mean) * rstd * gg.x + bb.x; o.y = (v[i].y - mean) * rstd * gg.y + bb.y; o.z = (v[i].z - mean) * rstd * gg.z + bb.z; o.w = (v[i].w - mean) * rstd * gg.w + bb.w;
            uint2 w; w.x = cvtpk_bf16(o.x, o.y); w.y = cvtpk_bf16(o.z, o.w); *(uint2*)(outb + (size_t)t * DM + i * 256 + lane * 4) = w;
            if ((i & 3) == 3) asm volatile("" ::: "memory");
        }
    }
}

__device__ __forceinline__ void route_valu_phase(const float* __restrict__ q  , const float* __restrict__ keys  , int* __restrict__ eidx, float* __restrict__ gate, const int bid, const int G, const int tid) {
    const int lane = tid & 63, wv = tid >> 6;
    for (int job = bid * 8 + wv; job < SEQ * 8; job += G * 8) {
        const int hh = job & 7, t = job >> 3;
        float sv0 = 0.f, sv1 = 0.f; int si0 = 0, si1 = 0;
#pragma unroll
        for (int c = 0; c < 2; ++c) {
            const float* qq = q + (size_t)t * 2048 + hh * 256 + c * 128;
            const float* k0 = keys + ((size_t)(hh * 2 + c) * 128 + lane) * 128;
            const float* k1 = k0 + 64 * 128;
            float s0 = 0.f, s1 = 0.f;
            for (int d = 0; d < 128; d += 4) {
                const float4 qv = *(const float4*)(qq + d), a = *(const float4*)(k0 + d), b = *(const float4*)(k1 + d);
                s0 += qv.x * a.x + qv.y * a.y + qv.z * a.z + qv.w * a.w;
                s1 += qv.x * b.x + qv.y * b.y + qv.z * b.z + qv.w * b.w;
            }
            float myv = 0.f; int myi = 0;
            for (int k = 0; k < 16; ++k) {
                float bv; int bi;
                if (s1 > s0) { bv = s1; bi = lane + 64; } else { bv = s0; bi = lane; }
#pragma unroll
                for (int o = 32; o >= 1; o >>= 1) {
                    const float ov = __shfl_xor(bv, o); const int oi = __shfl_xor(bi, o);
                    if (ov > bv || (ov == bv && oi < bi)) { bv = ov; bi = oi; }
                }
                if (lane == k) { myv = bv; myi = bi; }
                if (bi == lane) s0 = -3.0e38f;
                if (bi == lane + 64) s1 = -3.0e38f;
            }
            if (c == 0) { sv0 = myv; si0 = myi; } else { sv1 = myv; si1 = myi; }
        }
        float cv0, cv1, cv2, cv3; int ci0, ci1, ci2, ci3;
        { const float a = __shfl(sv0, lane >> 2); const int ai = __shfl(si0, lane >> 2); const int jb = (lane & 3) * 4;
          cv0 = a + __shfl(sv1, jb + 0); ci0 = ai * 128 + __shfl(si1, jb + 0);
          cv1 = a + __shfl(sv1, jb + 1); ci1 = ai * 128 + __shfl(si1, jb + 1);
          cv2 = a + __shfl(sv1, jb + 2); ci2 = ai * 128 + __shfl(si1, jb + 2);
          cv3 = a + __shfl(sv1, jb + 3); ci3 = ai * 128 + __shfl(si1, jb + 3); }
        float tv = 0.f; int te = 0;
        for (int k = 0; k < 16; ++k) {
            float bv = cv0; int bp = lane * 4, be = ci0;
            if (cv1 > bv) { bv = cv1; bp = lane * 4 + 1; be = ci1; }
            if (cv2 > bv) { bv = cv2; bp = lane * 4 + 2; be = ci2; }
            if (cv3 > bv) { bv = cv3; bp = lane * 4 + 3; be = ci3; }
#pragma unroll
            for (int o = 32; o >= 1; o >>= 1) {
                const float ov = __shfl_xor(bv, o); const int op = __shfl_xor(bp, o); const int oe = __shfl_xor(be, o);
                if (ov > bv || (ov == bv && op < bp)) { bv = ov; bp = op; be = oe; }
            }
            if (lane == k) { tv = bv; te = be; }
            if (bp == lane * 4 + 0) cv0 = -3.0e38f;
            if (bp == lane * 4 + 1) cv1 = -3.0e38f;
            if (bp == lane * 4 + 2) cv2 = -3.0e38f;
            if (bp == lane * 4 + 3) cv3 = -3.0e38f;
        }
        const float v = lane < 16 ? tv : -3.0e38f;
        const float mx = wave_max(v);
        const float e = lane < 16 ? __expf(tv - mx) : 0.f;
        const float den = wave_sum(e);
        if (lane < 16) { eidx[(size_t)t * 128 + hh * 16 + lane] = te; gate[(size_t)t * 128 + hh * 16 + lane] = e / den; }
    }
}
namespace rt {
using att::f32x16; using att::bf16x8;
__device__ __forceinline__ float pair_max(float m) {
    auto rr = __builtin_amdgcn_permlane32_swap(__float_as_uint(m), __float_as_uint(m), false, false);
    return fmaxf(__uint_as_float(rr[0]), __uint_as_float(rr[1]));
}
__device__ __forceinline__ int pair_max_i(int m) {
    auto rr = __builtin_amdgcn_permlane32_swap((unsigned)m, (unsigned)m, false, false);
    const int a = (int)rr[0], b = (int)rr[1]; return a > b ? a : b;
}
__device__ __forceinline__ void top16_of_128(f32x16& p0, f32x16& p1, f32x16& p2, f32x16& p3, float (&t)[16]) {
#pragma unroll
    for (int k = 0; k < 16; ++k) {
        float m = p0[0];
#pragma unroll
        for (int r = 1; r < 16; ++r) m = fmaxf(m, p0[r]);
#pragma unroll
        for (int r = 0; r < 16; ++r) m = fmaxf(m, fmaxf(p1[r], fmaxf(p2[r], p3[r])));
        m = pair_max(m);
        t[k] = m;
#pragma unroll
        for (int r = 0; r < 16; ++r) { p0[r] = p0[r] == m ? -3.0e38f : p0[r]; p1[r] = p1[r] == m ? -3.0e38f : p1[r]; p2[r] = p2[r] == m ? -3.0e38f : p2[r]; p3[r] = p3[r] == m ? -3.0e38f : p3[r]; }
    }
}
__device__ __forceinline__ void tag_scores(f32x16& p, const int base, const int hi) {
#pragma unroll
    for (int r = 0; r < 16; ++r) p[r] = __uint_as_float((__float_as_uint(p[r]) & ~0x7Fu) | (unsigned)(base + att::crow(r, hi)));
}
}

__device__ __forceinline__ void route_mfma_phase(const bf16_t* __restrict__ pqb  , const bf16_t* __restrict__ keysb  , int* __restrict__ eidx, float* __restrict__ gate,
                                                 char* lds, const pg8::StaticOrder& S, const int tid) {
    using namespace rt;
    const int wid = __builtin_amdgcn_readfirstlane(tid >> 6), lane = tid & 63, r32 = lane & 31, hi = lane >> 5;
    att::bf16* K_lds = (att::bf16*)lds;
    pg8::Unit un;
    for (int ui = 0; S.next(ui, un); ++ui) {
        const int h = un.pn, tb = un.pm * 256;
        const int tok = tb + wid * 32 + r32;
        float t0[16], t1[16];
#pragma unroll
        for (int c = 0; c < 2; ++c) {
            __syncthreads();
            { const bf16_t* kp = keysb + (size_t)(h * 2 + c) * 128 * 128;
              const int row = tid >> 2;
#pragma unroll
              for (int i = 0; i < 4; ++i) { const int sc = ((tid & 3) * 4 + i) * 8;
                  const bf16x8 v = *reinterpret_cast<const bf16x8*>(kp + row * 128 + sc);
                  *(bf16x8*)((char*)K_lds + (row >> 6) * 16384 + KSWZ(row & 63, sc * 2)) = v; } }
            bf16x8 qr[8];
            { const bf16_t* qw = pqb + (size_t)tok * 2048 + h * 256 + c * 128 + hi * 8;
#pragma unroll
              for (int d0 = 0; d0 < 8; ++d0) qr[d0] = *reinterpret_cast<const bf16x8*>(qw + d0 * 16); }
            __syncthreads();
            f32x16 p0, p1, p2, p3;
            att::qkt_pipe(p0, p1, (int)(uintptr_t)K_lds, qr, r32, hi);
            att::qkt_pipe(p2, p3, (int)(uintptr_t)K_lds + 16384, qr, r32, hi);
            tag_scores(p0, 0, hi); tag_scores(p1, 32, hi); tag_scores(p2, 64, hi); tag_scores(p3, 96, hi);
            if (c == 0) top16_of_128(p0, p1, p2, p3, t0); else top16_of_128(p0, p1, p2, p3, t1);
        }
        float v0[16], v1[16]; int k0[16], k1[16];
#pragma unroll
        for (int i = 0; i < 16; ++i) { const unsigned a = __float_as_uint(t0[i]), b = __float_as_uint(t1[i]);
            v0[i] = __uint_as_float(a & ~0x7Fu); v1[i] = __uint_as_float(b & ~0x7Fu); k0[i] = (int)((a & 0x7Fu) << 7); k1[i] = (int)(b & 0x7Fu); }
        float cv[25]; int ce[25];
    { const float s = hi ? (v0[0] + v1[1]) : (v0[0] + v1[0]); cv[0] = __uint_as_float((__float_as_uint(s) & ~0xFFu) | (unsigned)(2 * 0 + hi)); ce[0] = hi ? (k0[0] | k1[1]) : (k0[0] | k1[0]); }
    { const float s = hi ? (v0[0] + v1[3]) : (v0[0] + v1[2]); cv[1] = __uint_as_float((__float_as_uint(s) & ~0xFFu) | (unsigned)(2 * 1 + hi)); ce[1] = hi ? (k0[0] | k1[3]) : (k0[0] | k1[2]); }
    { const float s = hi ? (v0[0] + v1[5]) : (v0[0] + v1[4]); cv[2] = __uint_as_float((__float_as_uint(s) & ~0xFFu) | (unsigned)(2 * 2 + hi)); ce[2] = hi ? (k0[0] | k1[5]) : (k0[0] | k1[4]); }
    { const float s = hi ? (v0[0] + v1[7]) : (v0[0] + v1[6]); cv[3] = __uint_as_float((__float_as_uint(s) & ~0xFFu) | (unsigned)(2 * 3 + hi)); ce[3] = hi ? (k0[0] | k1[7]) : (k0[0] | k1[6]); }
    { const float s = hi ? (v0[0] + v1[9]) : (v0[0] + v1[8]); cv[4] = __uint_as_float((__float_as_uint(s) & ~0xFFu) | (unsigned)(2 * 4 + hi)); ce[4] = hi ? (k0[0] | k1[9]) : (k0[0] | k1[8]); }
    { const float s = hi ? (v0[0] + v1[11]) : (v0[0] + v1[10]); cv[5] = __uint_as_float((__float_as_uint(s) & ~0xFFu) | (unsigned)(2 * 5 + hi)); ce[5] = hi ? (k0[0] | k1[11]) : (k0[0] | k1[10]); }
    { const float s = hi ? (v0[0] + v1[13]) : (v0[0] + v1[12]); cv[6] = __uint_as_float((__float_as_uint(s) & ~0xFFu) | (unsigned)(2 * 6 + hi)); ce[6] = hi ? (k0[0] | k1[13]) : (k0[0] | k1[12]); }
    { const float s = hi ? (v0[0] + v1[15]) : (v0[0] + v1[14]); cv[7] = __uint_as_float((__float_as_uint(s) & ~0xFFu) | (unsigned)(2 * 7 + hi)); ce[7] = hi ? (k0[0] | k1[15]) : (k0[0] | k1[14]); }
    { const float s = hi ? (v0[1] + v1[1]) : (v0[1] + v1[0]); cv[8] = __uint_as_float((__float_as_uint(s) & ~0xFFu) | (unsigned)(2 * 8 + hi)); ce[8] = hi ? (k0[1] | k1[1]) : (k0[1] | k1[0]); }
    { const float s = hi ? (v0[1] + v1[3]) : (v0[1] + v1[2]); cv[9] = __uint_as_float((__float_as_uint(s) & ~0xFFu) | (unsigned)(2 * 9 + hi)); ce[9] = hi ? (k0[1] | k1[3]) : (k0[1] | k1[2]); }
    { const float s = hi ? (v0[1] + v1[5]) : (v0[1] + v1[4]); cv[10] = __uint_as_float((__float_as_uint(s) & ~0xFFu) | (unsigned)(2 * 10 + hi)); ce[10] = hi ? (k0[1] | k1[5]) : (k0[1] | k1[4]); }
    { const float s = hi ? (v0[1] + v1[7]) : (v0[1] + v1[6]); cv[11] = __uint_as_float((__float_as_uint(s) & ~0xFFu) | (unsigned)(2 * 11 + hi)); ce[11] = hi ? (k0[1] | k1[7]) : (k0[1] | k1[6]); }
    { const float s = hi ? (v0[2] + v1[1]) : (v0[2] + v1[0]); cv[12] = __uint_as_float((__float_as_uint(s) & ~0xFFu) | (unsigned)(2 * 12 + hi)); ce[12] = hi ? (k0[2] | k1[1]) : (k0[2] | k1[0]); }
    { const float s = hi ? (v0[2] + v1[3]) : (v0[2] + v1[2]); cv[13] = __uint_as_float((__float_as_uint(s) & ~0xFFu) | (unsigned)(2 * 13 + hi)); ce[13] = hi ? (k0[2] | k1[3]) : (k0[2] | k1[2]); }
    { const float s = hi ? (v0[3] + v1[0]) : (v0[2] + v1[4]); cv[14] = __uint_as_float((__float_as_uint(s) & ~0xFFu) | (unsigned)(2 * 14 + hi)); ce[14] = hi ? (k0[3] | k1[0]) : (k0[2] | k1[4]); }
    { const float s = hi ? (v0[3] + v1[2]) : (v0[3] + v1[1]); cv[15] = __uint_as_float((__float_as_uint(s) & ~0xFFu) | (unsigned)(2 * 15 + hi)); ce[15] = hi ? (k0[3] | k1[2]) : (k0[3] | k1[1]); }
    { const float s = hi ? (v0[4] + v1[0]) : (v0[3] + v1[3]); cv[16] = __uint_as_float((__float_as_uint(s) & ~0xFFu) | (unsigned)(2 * 16 + hi)); ce[16] = hi ? (k0[4] | k1[0]) : (k0[3] | k1[3]); }
    { const float s = hi ? (v0[4] + v1[2]) : (v0[4] + v1[1]); cv[17] = __uint_as_float((__float_as_uint(s) & ~0xFFu) | (unsigned)(2 * 17 + hi)); ce[17] = hi ? (k0[4] | k1[2]) : (k0[4] | k1[1]); }
    { const float s = hi ? (v0[5] + v1[1]) : (v0[5] + v1[0]); cv[18] = __uint_as_float((__float_as_uint(s) & ~0xFFu) | (unsigned)(2 * 18 + hi)); ce[18] = hi ? (k0[5] | k1[1]) : (k0[5] | k1[0]); }
    { const float s = hi ? (v0[6] + v1[1]) : (v0[6] + v1[0]); cv[19] = __uint_as_float((__float_as_uint(s) & ~0xFFu) | (unsigned)(2 * 19 + hi)); ce[19] = hi ? (k0[6] | k1[1]) : (k0[6] | k1[0]); }
    { const float s = hi ? (v0[7] + v1[1]) : (v0[7] + v1[0]); cv[20] = __uint_as_float((__float_as_uint(s) & ~0xFFu) | (unsigned)(2 * 20 + hi)); ce[20] = hi ? (k0[7] | k1[1]) : (k0[7] | k1[0]); }
    { const float s = hi ? (v0[9] + v1[0]) : (v0[8] + v1[0]); cv[21] = __uint_as_float((__float_as_uint(s) & ~0xFFu) | (unsigned)(2 * 21 + hi)); ce[21] = hi ? (k0[9] | k1[0]) : (k0[8] | k1[0]); }
    { const float s = hi ? (v0[11] + v1[0]) : (v0[10] + v1[0]); cv[22] = __uint_as_float((__float_as_uint(s) & ~0xFFu) | (unsigned)(2 * 22 + hi)); ce[22] = hi ? (k0[11] | k1[0]) : (k0[10] | k1[0]); }
    { const float s = hi ? (v0[13] + v1[0]) : (v0[12] + v1[0]); cv[23] = __uint_as_float((__float_as_uint(s) & ~0xFFu) | (unsigned)(2 * 23 + hi)); ce[23] = hi ? (k0[13] | k1[0]) : (k0[12] | k1[0]); }
    { const float s = hi ? (v0[15] + v1[0]) : (v0[14] + v1[0]); cv[24] = __uint_as_float((__float_as_uint(s) & ~0xFFu) | (unsigned)(2 * 24 + hi)); ce[24] = hi ? (k0[15] | k1[0]) : (k0[14] | k1[0]); }
        float ts[16]; int te[16];
#pragma unroll
        for (int k = 0; k < 16; ++k) {
            float m = cv[0];
#pragma unroll
            for (int n = 1; n < 25; ++n) m = fmaxf(m, cv[n]);
            m = pair_max(m);
            int e = -1;
#pragma unroll
            for (int n = 0; n < 25; ++n) { const bool hit = cv[n] == m; e = hit ? ce[n] : e; cv[n] = hit ? -3.0e38f : cv[n]; }
            ts[k] = __uint_as_float(__float_as_uint(m) & ~0xFFu); te[k] = pair_max_i(e);
        }
        float den = 0.f; const float mx = ts[0];
#pragma unroll
        for (int k = 0; k < 16; ++k) { ts[k] = __expf(ts[k] - mx); den += ts[k]; }
        const float inv = 1.0f / den;
        if (hi == 0) { int4* op = (int4*)(eidx + (size_t)tok * 128 + h * 16);
            op[0] = make_int4(te[0], te[1], te[2], te[3]); op[1] = make_int4(te[4], te[5], te[6], te[7]); op[2] = make_int4(te[8], te[9], te[10], te[11]); op[3] = make_int4(te[12], te[13], te[14], te[15]); }
        else { float4* op = (float4*)(gate + (size_t)tok * 128 + h * 16);
            op[0] = make_float4(ts[0] * inv, ts[1] * inv, ts[2] * inv, ts[3] * inv); op[1] = make_float4(ts[4] * inv, ts[5] * inv, ts[6] * inv, ts[7] * inv);
            op[2] = make_float4(ts[8] * inv, ts[9] * inv, ts[10] * inv, ts[11] * inv); op[3] = make_float4(ts[12] * inv, ts[13] * inv, ts[14] * inv, ts[15] * inv); }
    }
}
#ifndef PH_MASK
#define PH_MASK 0xffffffffu
#endif
constexpr int N_PHASES = 20;
__global__ void __launch_bounds__(512, 2) mega(MK a) {
    extern __shared__ __attribute__((aligned(16))) unsigned char lds_raw[];
    LDSA unsigned char* lds = (LDSA unsigned char*)lds_raw;
    const int lo = a.ph_lo, hi = a.ph_hi;
    const int G = gridDim.x, bid = blockIdx.x;
    const int wid_s = __builtin_amdgcn_readfirstlane(threadIdx.x >> 6);
    unsigned char* ws = a.ws;
#define PH_TID() int tid; { int _z = 0; asm volatile("" : "+s"(_z)); tid = wid_s * 64 + (int)__builtin_amdgcn_mbcnt_hi(~0u, __builtin_amdgcn_mbcnt_lo(~0u, (unsigned)_z)); }
#define WSP(T, name, off) T* name; { unsigned char* _b = ws; asm volatile("" : "+s"(_b)); name = (T*)(_b + (off)); }
#define IN(k) ((((PH_MASK) >> (k)) & 1u) && lo <= (k) && (k) < hi)
#define SEAM(k) do { if ((k) + 1 < hi) { PH_TID() xcd_barrier(bar, tid); } } while (0)
    XcdBarrier bar;
    { PH_TID()
      volatile LAS unsigned* st = (volatile LAS unsigned*)(lds + LDS_MISC);
      if (tid == 0) { st[0] = 0u; st[1] = 0u; }
      __syncthreads();
      bar = xcd_barrier_post((unsigned*)(ws + WS_CTL), st, tid); }

    if (IN(0)) {
#ifdef PROBE_PRO2
      for (int rep = 0; rep < 2; ++rep) {
#else
      {
#endif
        PH_TID()
        WSP(bf16_t, xb, WS_XB) WSP(bf16_t, wab, WS_WAB) WSP(bf16_t, woab, WS_WOAB) WSP(bf16_t, wcd, WS_WCD) WSP(bf16_t, wocd, WS_WOCD) WSP(bf16_t, wq, WS_WQ) WSP(unsigned char, ub, WS_UB) WSP(unsigned char, vb, WS_VB) WSP(float, isu, WS_SU) WSP(float, isv, WS_SV)
        cvt_rows_bf16(a.in[0], xb, (size_t)SEQ * DM / 8, bid, G, tid, 512);
        LDSA float* tile = (LDSA float*)lds;
        transpose_cvt(a.in[1], wab, 4096, 12288, tile, bid, G, PermAB(), tid);
        transpose_cvt(a.in[3], woab, 3072, 4096, tile, bid, G, PermNone(), tid);
        transpose_cvt(a.in[4], wcd, 4096, 9216, tile, bid, G, PermCD(), tid);
        transpose_cvt(a.in[12], wocd, 4096, 4096, tile, bid, G, PermNone(), tid);
        transpose_cvt(a.in[15], wq, 4096, 2048, tile, bid, G, PermNone(), tid);
        transpose_cvt(a.in[15] + (size_t)4096 * 2048, wq + (size_t)2048 * 4096, 4096, 2048, tile, bid, G, PermNone(), tid);
        table_fp6(a.in[17], ub, isu, 2 * 16384, (LDSA float*)lds, bid, G, tid);
        table_fp6(a.in[18], vb, isv, 2 * 16384, (LDSA float*)lds, bid, G, tid);
        { WSP(float, cs0, WS_CS0) WSP(float, csa, WS_CSA) rope_tables(cs0, csa, bid, G, tid); }
        { WSP(bf16_t, keyb, WS_KEYB) cvt_rows_bf16(a.in[16], keyb, (size_t)2 * 8 * 2 * 128 * 128 / 8, bid, G, tid, 512); }
      }
        SEAM(0);
    }
    { constexpr int layer = 0;
        const int pb = 1 + 10 * layer;
        if (IN(pb + 0)) {
            PH_TID() WSP(bf16_t, xb, WS_XB) WSP(bf16_t, x2b, WS_X2B) WSP(bf16_t, wab, WS_WAB) WSP(bf16_t, wcd, WS_WCD) WSP(bf16_t, hb, WS_HB) WSP(float, cs0, WS_CS0) WSP(float, csa, WS_CSA)
            if (layer == 0) {
                pg8::Gemm g{xb, wab, SEQ, 12288, 4096}; pg8::StaticOrder S; S.init(SEQ, 12288, G, bid);
                pg8::EpiProj<0> E{hb, 12288, cs0, csa, nullptr, nullptr, (LDSA float*)(lds + LDS_MISC + 64)};
                pg8::gemm_phase<pg8::EpiProj<0>, pg8::StaticOrder>(lds, g, S, E, nullptr, tid);
#ifdef PROBE_GEMM2
                pg8::gemm_phase<pg8::EpiProj<0>, pg8::StaticOrder>(lds, g, S, E, nullptr, tid);
#endif
            } else {
                pg8::Gemm g{x2b, wcd, SEQ, 9216, 4096}; pg8::StaticOrder S; S.init(SEQ, 9216, G, bid);
                pg8::EpiProj<1> E{hb, 9216, cs0, csa, a.in[10], a.in[11], (LDSA float*)(lds + LDS_MISC + 64)};
                pg8::gemm_phase<pg8::EpiProj<1>, pg8::StaticOrder>(lds, g, S, E, nullptr, tid);
            }
            SEAM(pb + 0);
        }
        if (IN(pb + 2)) {
            PH_TID() WSP(bf16_t, hb, WS_HB) WSP(bf16_t, abb, WS_AB) WSP(float, oc, WS_OC)
            if (layer == 0) attn0_phase(hb, a.in[2], abb, (bf16_t*)oc, (float*)((unsigned char*)oc + (size_t)3 * 8 * SEQ * 128 * 2), (char*)lds_raw, bid, G, tid);
#ifdef PROBE_SMALL
            if (layer == 0) { __syncthreads(); int t3 = tid; asm volatile("" : "+v"(t3)); attn0_phase(hb, a.in[2], abb, (bf16_t*)oc, (float*)((unsigned char*)oc + (size_t)3 * 8 * SEQ * 128 * 2), (char*)lds_raw, bid, G, t3); }
#endif
            else attn1_phase(hb, abb, oc, a.in[5], a.in[6], a.in[7], a.in[8], a.in[9], (char*)lds_raw, bid, G, tid);
#ifdef PROBE_ATTN2
            if (layer == 1) { __syncthreads(); int t3 = tid; asm volatile("" : "+v"(t3)); attn1_phase(hb, abb, oc, a.in[5], a.in[6], a.in[7], a.in[8], a.in[9], (char*)lds_raw, bid, G, t3); }
#endif
            SEAM(pb + 2);
        }
        if (layer == 0) {
            if (IN(pb + 3)) {
                PH_TID() WSP(bf16_t, abb, WS_AB) WSP(float, oc, WS_OC)
                merge0_phase((const bf16_t*)oc, (const float*)((unsigned char*)oc + (size_t)3 * 8 * SEQ * 128 * 2), abb, bid, G, tid);
#ifdef PROBE_SMALL
                merge0_phase((const bf16_t*)oc, (const float*)((unsigned char*)oc + (size_t)3 * 8 * SEQ * 128 * 2), abb, bid, G, tid);
#endif
                SEAM(pb + 3);
            }
        } else {
        }
        if (IN(pb + 4)) {
            const int K = layer == 0 ? 3072 : 4096;
            PH_TID() WSP(bf16_t, abb, WS_AB) WSP(bf16_t, woab, WS_WOAB) WSP(bf16_t, wocd, WS_WOCD) WSP(float, ybuf, WS_Y) WSP(float, x2, WS_X2)
            pg8::Gemm g{abb, layer == 0 ? woab : wocd, SEQ, 4096, K}; pg8::StaticOrder S; S.init(SEQ, 4096, G, bid);
            pg8::EpiF32R E{ybuf, 4096, layer == 0 ? a.in[0] : (const float*)x2, ALPHA};
            pg8::gemm_phase<pg8::EpiF32R, pg8::StaticOrder>(lds, g, S, E, nullptr, tid);
            SEAM(pb + 4);
        }
        if (IN(pb + 5)) {
            PH_TID() WSP(float, ybuf, WS_Y) WSP(float, stats, WS_X1) WSP(bf16_t, x1b, WS_X1B)
            ln_phase(ybuf, a.in[13] + layer * DM, a.in[14] + layer * DM, stats, x1b, bid, G, tid);
            SEAM(pb + 5);
        }
        if (IN(pb + 6)) {
            PH_TID() WSP(bf16_t, x1b, WS_X1B) WSP(bf16_t, wq, WS_WQ) WSP(bf16_t, pqb, WS_PQ)
            pg8::Gemm g{x1b, wq + (size_t)layer * 2048 * 4096, SEQ, 2048, 4096}; pg8::StaticOrder S; S.init(SEQ, 2048, G, bid);
            pg8::EpiBf16P E{pqb, 2048};
            pg8::gemm_phase<pg8::EpiBf16P, pg8::StaticOrder>(lds, g, S, E, nullptr, tid);
            asm volatile("s_waitcnt vmcnt(0)" ::: "memory"); __syncthreads();
            { WSP(bf16_t, keyb, WS_KEYB) WSP(int, eidx, WS_EIDX) WSP(float, gate, WS_GATE)
              int t4 = tid; asm volatile("" : "+v"(t4));
              route_mfma_phase(pqb, keyb + (size_t)layer * 8 * 2 * 128 * 128, eidx, gate, (char*)lds_raw, S, t4); }
            SEAM(pb + 6);
        }
        if (IN(pb + 8)) {
            PH_TID() WSP(float, ybuf, WS_Y) WSP(float, stats, WS_X1) WSP(bf16_t, x1b, WS_X1B) WSP(int, eidx, WS_EIDX) WSP(float, gate, WS_GATE) WSP(unsigned char, ub, WS_UB) WSP(unsigned char, vb, WS_VB) WSP(float, isu, WS_SU) WSP(float, isv, WS_SV) WSP(float, x2, WS_X2) WSP(bf16_t, x2b, WS_X2B)
            peer_expert_phase(ybuf, stats, a.in[13] + layer * DM, a.in[14] + layer * DM, x1b, eidx, gate, ub + (size_t)layer * 16384 * ROWB, vb + (size_t)layer * 16384 * ROWB, isu + layer * 16384, isv + layer * 16384, a.in[19] + layer * DM, a.in[20] + layer * DM,
                              layer == 0 ? x2 : a.out, layer == 0 ? x2b : (bf16_t*)nullptr, (LDSA float*)lds, bid, G, tid);
            SEAM(pb + 8);
        }
        }
    { constexpr int layer = 1;
        const int pb = 1 + 10 * layer;
        if (IN(pb + 0)) {
            PH_TID() WSP(bf16_t, xb, WS_XB) WSP(bf16_t, x2b, WS_X2B) WSP(bf16_t, wab, WS_WAB) WSP(bf16_t, wcd, WS_WCD) WSP(bf16_t, hb, WS_HB) WSP(float, cs0, WS_CS0) WSP(float, csa, WS_CSA)
            if (layer == 0) {
                pg8::Gemm g{xb, wab, SEQ, 12288, 4096}; pg8::StaticOrder S; S.init(SEQ, 12288, G, bid);
                pg8::EpiProj<0> E{hb, 12288, cs0, csa, nullptr, nullptr, (LDSA float*)(lds + LDS_MISC + 64)};
                pg8::gemm_phase<pg8::EpiProj<0>, pg8::StaticOrder>(lds, g, S, E, nullptr, tid);
#ifdef PROBE_GEMM2
                pg8::gemm_phase<pg8::EpiProj<0>, pg8::StaticOrder>(lds, g, S, E, nullptr, tid);
#endif
            } else {
                pg8::Gemm g{x2b, wcd, SEQ, 9216, 4096}; pg8::StaticOrder S; S.init(SEQ, 9216, G, bid);
                pg8::EpiProj<1> E{hb, 9216, cs0, csa, a.in[10], a.in[11], (LDSA float*)(lds + LDS_MISC + 64)};
                pg8::gemm_phase<pg8::EpiProj<1>, pg8::StaticOrder>(lds, g, S, E, nullptr, tid);
            }
            SEAM(pb + 0);
        }
        if (IN(pb + 2)) {
            PH_TID() WSP(bf16_t, hb, WS_HB) WSP(bf16_t, abb, WS_AB) WSP(float, oc, WS_OC)
            if (layer == 0) attn0_phase(hb, a.in[2], abb, (bf16_t*)oc, (float*)((unsigned char*)oc + (size_t)3 * 8 * SEQ * 128 * 2), (char*)lds_raw, bid, G, tid);
#ifdef PROBE_SMALL
            if (layer == 0) { __syncthreads(); int t3 = tid; asm volatile("" : "+v"(t3)); attn0_phase(hb, a.in[2], abb, (bf16_t*)oc, (float*)((unsigned char*)oc + (size_t)3 * 8 * SEQ * 128 * 2), (char*)lds_raw, bid, G, t3); }
#endif
            else attn1_phase(hb, abb, oc, a.in[5], a.in[6], a.in[7], a.in[8], a.in[9], (char*)lds_raw, bid, G, tid);
#ifdef PROBE_ATTN2
            if (layer == 1) { __syncthreads(); int t3 = tid; asm volatile("" : "+v"(t3)); attn1_phase(hb, abb, oc, a.in[5], a.in[6], a.in[7], a.in[8], a.in[9], (char*)lds_raw, bid, G, t3); }
#endif
            SEAM(pb + 2);
        }
        if (layer == 0) {
            if (IN(pb + 3)) {
                PH_TID() WSP(bf16_t, abb, WS_AB) WSP(float, oc, WS_OC)
                merge0_phase((const bf16_t*)oc, (const float*)((unsigned char*)oc + (size_t)3 * 8 * SEQ * 128 * 2), abb, bid, G, tid);
#ifdef PROBE_SMALL
                merge0_phase((const bf16_t*)oc, (const float*)((unsigned char*)oc + (size_t)3 * 8 * SEQ * 128 * 2), abb, bid, G, tid);
#endif
                SEAM(pb + 3);
            }
        } else {
        }
        if (IN(pb + 4)) {
            const int K = layer == 0 ? 3072 : 4096;
            PH_TID() WSP(bf16_t, abb, WS_AB) WSP(bf16_t, woab, WS_WOAB) WSP(bf16_t, wocd, WS_WOCD) WSP(float, ybuf, WS_Y) WSP(float, x2, WS_X2)
            pg8::Gemm g{abb, layer == 0 ? woab : wocd, SEQ, 4096, K}; pg8::StaticOrder S; S.init(SEQ, 4096, G, bid);
            pg8::EpiF32R E{ybuf, 4096, layer == 0 ? a.in[0] : (const float*)x2, ALPHA};
            pg8::gemm_phase<pg8::EpiF32R, pg8::StaticOrder>(lds, g, S, E, nullptr, tid);
            SEAM(pb + 4);
        }
        if (IN(pb + 5)) {
            PH_TID() WSP(float, ybuf, WS_Y) WSP(float, stats, WS_X1) WSP(bf16_t, x1b, WS_X1B)
            ln_phase(ybuf, a.in[13] + layer * DM, a.in[14] + layer * DM, stats, x1b, bid, G, tid);
            SEAM(pb + 5);
        }
        if (IN(pb + 6)) {
            PH_TID() WSP(bf16_t, x1b, WS_X1B) WSP(bf16_t, wq, WS_WQ) WSP(bf16_t, pqb, WS_PQ)
            pg8::Gemm g{x1b, wq + (size_t)layer * 2048 * 4096, SEQ, 2048, 4096}; pg8::StaticOrder S; S.init(SEQ, 2048, G, bid);
            pg8::EpiBf16P E{pqb, 2048};
            pg8::gemm_phase<pg8::EpiBf16P, pg8::StaticOrder>(lds, g, S, E, nullptr, tid);
            asm volatile("s_waitcnt vmcnt(0)" ::: "memory"); __syncthreads();
            { WSP(bf16_t, keyb, WS_KEYB) WSP(int, eidx, WS_EIDX) WSP(float, gate, WS_GATE)
              int t4 = tid; asm volatile("" : "+v"(t4));
              route_mfma_phase(pqb, keyb + (size_t)layer * 8 * 2 * 128 * 128, eidx, gate, (char*)lds_raw, S, t4); }
            SEAM(pb + 6);
        }
        if (IN(pb + 8)) {
            PH_TID() WSP(float, ybuf, WS_Y) WSP(float, stats, WS_X1) WSP(bf16_t, x1b, WS_X1B) WSP(int, eidx, WS_EIDX) WSP(float, gate, WS_GATE) WSP(unsigned char, ub, WS_UB) WSP(unsigned char, vb, WS_VB) WSP(float, isu, WS_SU) WSP(float, isv, WS_SV) WSP(float, x2, WS_X2) WSP(bf16_t, x2b, WS_X2B)
            peer_expert_phase(ybuf, stats, a.in[13] + layer * DM, a.in[14] + layer * DM, x1b, eidx, gate, ub + (size_t)layer * 16384 * ROWB, vb + (size_t)layer * 16384 * ROWB, isu + layer * 16384, isv + layer * 16384, a.in[19] + layer * DM, a.in[20] + layer * DM,
                              layer == 0 ? x2 : a.out, layer == 0 ? x2b : (bf16_t*)nullptr, (LDSA float*)lds, bid, G, tid);
            SEAM(pb + 8);
        }
        }

#ifdef PROBE_FP6
    if (bid == 0 && hi == N_PHASES) {
        PH_TID()
        if (tid == 0) {
            v16f_t s0, s1; float xs[32];
#pragma unroll
            for (int i = 0; i < 32; ++i) { const int e = i >> 3, m = i & 7; const float v = e == 0 ? 0.125f * m : (float)(1 << (e - 1)) * (1.0f + 0.125f * m); xs[i] = v; if (i < 16) s0[i] = v; else s1[i - 16] = v; }
            const v6u_t w = __builtin_amdgcn_cvt_scalef32_2xpk16_fp6_f32(s0, s1, 1.0f);
            const v32f_t y = __builtin_amdgcn_cvt_scalef32_pk32_f32_fp6(w, 1.0f);
            const v16u_t zb = __builtin_bit_cast(v16u_t, __builtin_amdgcn_cvt_scalef32_pk32_bf16_fp6(w, 1.0f));
            const v32f_t y2 = __builtin_amdgcn_cvt_scalef32_pk32_f32_fp6(w, 2.0f);
            const v6u_t w2 = __builtin_amdgcn_cvt_scalef32_2xpk16_fp6_f32(s0, s1, 2.0f);
            const v32f_t y3 = __builtin_amdgcn_cvt_scalef32_pk32_f32_fp6(w2, 1.0f);
            bool id32 = true, id16 = true, il32 = true;
#pragma unroll
            for (int i = 0; i < 32; ++i) { id32 = id32 && (y[i] == xs[i]);
                const unsigned d = zb[i >> 1]; const float b = (i & 1) ? bf_hi(d) : bf_lo(d); id16 = id16 && (b == xs[i]);
                const int src = (i & 1) ? 16 + (i >> 1) : (i >> 1); il32 = il32 && (y[i] == xs[src]); }
            int code = 64;
            if (id32) code += 1; if (id16) code += 2; if (il32) code += 4;
            if (y2[9] == 2.0f * y[9]) code += 8;
            if (y3[20] * 2.0f == y[20]) code += 16;
            if (y[1] == xs[1]) code += 32;
            a.out[0] += (float)code;
        }
    }
#endif
#undef IN
}
#ifndef ONE_LAUNCH
#define ONE_LAUNCH 1
#endif
extern "C" void kernel_launch(void* const* d_in, const int* in_sizes, int n_in, void* d_out, int out_size, void* d_ws, size_t ws_size, hipStream_t stream) {
    static int ready = 0;
    if (!ready) {
        if (ws_size < WS_END) { fprintf(stderr, "kernel_launch: workspace too small: %zu < %zu\n", ws_size, (size_t)WS_END); return; }
        if (hipFuncSetAttribute((const void*)mega, hipFuncAttributeMaxDynamicSharedMemorySize, LDS_BYTES) != hipSuccess) { fprintf(stderr, "kernel_launch: hipFuncSetAttribute failed\n"); return; }
        int per_cu = 0;
        if (hipOccupancyMaxActiveBlocksPerMultiprocessor(&per_cu, (const void*)mega, 512, LDS_BYTES) != hipSuccess || per_cu < 1) fprintf(stderr, "kernel_launch: note: occupancy query reports %d blocks per CU\n", per_cu);
        (void)hipGetLastError();
        ready = 1;
    }
    unsigned char* ws = (unsigned char*)d_ws;
    (void)hipMemsetAsync(ws + WS_CTL, 0, CTL_BYTES, stream);
    MK a{}; for (int i = 0; i < 21; ++i) a.in[i] = (const float*)d_in[i];
    a.out = (float*)d_out; a.ws = ws;
#if ONE_LAUNCH
    a.ph_lo = 0; a.ph_hi = N_PHASES;
    hipLaunchKernelGGL(mega, dim3(256), dim3(512), LDS_BYTES, stream, a);
#else
    for (int k = 0; k < N_PHASES; ++k) { if (k == 10 || k == 2 || k == 12 || k == 14 || k == 8 || k == 18) continue; a.ph_lo = k; a.ph_hi = k + 1; hipLaunchKernelGGL(mega, dim3(256), dim3(512), LDS_BYTES, stream, a); }
#endif
    const hipError_t le = hipPeekAtLastError();
    if (le != hipSuccess) fprintf(stderr, "kernel_launch: launch failed: %s\n", hipGetErrorName(le));
}
```

```cpp
#include <hip/hip_runtime.h>
#include <stdint.h>
#include <cstdio>

#define SEQ 8192
#define DM 4096
#define HD 128
#define ALPHA 1.4142135623730951f
#define LAMBDA_INIT 0.35550906759096934f
#define ATT_SCALE 0.088388347648318440f

__device__ const double REV_P[16] = {0.15915494309189535, 0.0700865215877985, 0.03086376340470123, 0.013591370636193905, 0.005985185712713705, 0.002635675898667414, 0.001160663641240061, 0.0005111175045375439, 0.00022507907903927653, 9.911730936901935e-05, 4.364795279280289e-05, 1.9221100684944863e-05, 8.464330808241401e-06, 3.727408601915352e-06, 1.6414262627950345e-06, 7.228293068832865e-07};
__device__ const double REV_A[32] = {0.15915494309189535, 0.11934937021124886, 0.08949940160889101, 0.06711508300522726, 0.050329212104487035, 0.03774158471741977, 0.0283021958306234, 0.02122365276477766, 0.015915494309189534, 0.011934937021124886, 0.008949940160889102, 0.006711508300522725, 0.005032921210448704, 0.003774158471741977, 0.00283021958306234, 0.0021223652764777662, 0.0015915494309189536, 0.0011934937021124885, 0.0008949940160889102, 0.0006711508300522726, 0.0005032921210448703, 0.00037741584717419774, 0.00028302195830623395, 0.0002122365276477766, 0.00015915494309189535, 0.00011934937021124886, 8.949940160889102e-05, 6.711508300522725e-05, 5.0329212104487035e-05, 3.774158471741978e-05, 2.8302195830623396e-05, 2.122365276477766e-05};

__device__ __forceinline__ void sincos_rev(double rev, float& s, float& c) {
    const double f = rev - floor(rev); const float ff = (float)f;
    s = __builtin_amdgcn_sinf(ff); c = __builtin_amdgcn_cosf(ff);
}
__device__ __forceinline__ float wave_sum(float v) {
#pragma unroll
    for (int o = 32; o >= 1; o >>= 1) v += __shfl_xor(v, o);
    return v;
}
__device__ __forceinline__ float wave_max(float v) {
#pragma unroll
    for (int o = 32; o >= 1; o >>= 1) v = fmaxf(v, __shfl_xor(v, o));
    return v;
}
namespace pg8 {
#define PG8_LAS __attribute__((address_space(3)))
typedef unsigned short bf16_t;
typedef short bf16x8 __attribute__((ext_vector_type(8)));
typedef float f32x4 __attribute__((ext_vector_type(4)));
typedef unsigned u32x4 __attribute__((ext_vector_type(4)));
constexpr int BM = 256, BK = 64, HALF = 128, HTB = HALF * BK * 2  , STAGE_BYTES = 8 * HTB, NXCD = 8, WGM = 8;

__host__ __device__ __forceinline__ int lds_byte(int r, int c) { const int st = (r >> 4) * 2 + (c >> 5), rr = r & 15, cc = c & 31, ob = rr * 64 + cc * 2; return st * 1024 + (ob ^ (((ob >> 9) & 1) << 5)); }
__host__ __device__ __forceinline__ void stage_rc(int b, int& R, int& C) { const int st = b / 1024, sb = b % 1024, swz = sb ^ (((sb >> 9) & 1) << 5); R = (st >> 1) * 16 + swz / 64; C = (st & 1) * 32 + (swz % 64) / 2; }
__host__ __device__ __forceinline__ int perm32(int rho) { const int n = rho >> 4, i = rho & 15; return 8 * (i >> 2) + 4 * n + (i & 3); }

struct Unit { int pm, pn; };
struct Gemm { const bf16_t* A; const bf16_t* Bt; int M, N, K; };

struct StaticOrder {
    int nM, nN, nwg, G, c;
    __host__ __device__ void init(int M, int N, int G_, int c_) { nM = M / BM; nN = N / BM; nwg = nM * nN; G = G_; c = c_; }
    __host__ __device__ bool next(int i, Unit& u) const {
        const long L = (long)i * G + c; if (L >= nwg) return false;
        int wgid = (int)L; { const int q = nwg / NXCD, r = nwg % NXCD, xcd = wgid % NXCD, off = wgid / NXCD; wgid = (xcd < r ? xcd * (q + 1) : r * (q + 1) + (xcd - r) * q) + off; }
        const int nig = WGM * nN, gid = wgid / nig, fm = gid * WGM, gsz = (nM - fm) < WGM ? (nM - fm) : WGM;
        u.pm = fm + ((wgid % nig) % gsz); u.pn = (wgid % nig) / gsz; return true;
    }
    __device__ __forceinline__ void a_ready(const Unit&) const {}
    __device__ __forceinline__ void done(const Unit&) const {}
};
__device__ __forceinline__ unsigned cvt_pk_bf16(float lo, float hi) { unsigned r; asm volatile("v_cvt_pk_bf16_f32 %0, %1, %2" : "=v"(r) : "v"(lo), "v"(hi)); return r; }
typedef float f32x2 __attribute__((ext_vector_type(2)));
template <class Epi, class Sched, bool STAMP = false>
__device__ __forceinline__ void gemm_phase(PG8_LAS unsigned char* lds, const Gemm g, const Sched& S, const Epi& E, unsigned long long* stamps, const int tid_in) {
    const int tid = tid_in, wid = __builtin_amdgcn_readfirstlane(tid >> 6), lane = tid & 63, wr = wid >> 2, wc = wid & 3, fr = lane & 15, fq = lane >> 4;
    const int K = g.K, nt = K / BK;
    int ts_lo = 0, ts_hi = 0, nts = 0; const unsigned long long rt_entry = STAMP ? (unsigned long long)wall_clock64() : 0ull;
#define PG8_STAMP() do { if (STAMP && wid == 0 && nts < 64) { const unsigned long long _c = (unsigned long long)clock64(); \
        ts_lo = (lane == nts) ? (int)(unsigned)_c : ts_lo; ts_hi = (lane == nts) ? (int)(unsigned)(_c >> 32) : ts_hi; ++nts; } } while (0)
    PG8_STAMP();
    unsigned voffA[2], voffB[2];
#pragma unroll
    for (int i = 0; i < 2; ++i) { int R, C; stage_rc(tid * 16 + i * 8192, R, C); const int Rb = Epi::PERM ? ((R & ~31) + perm32(R & 31)) : R;
        voffA[i] = (unsigned)(R * K + C) * 2u; voffB[i] = (unsigned)(Rb * K + C) * 2u; }
    const size_t kstep = (size_t)(BK * 2);
    const size_t hstep = (size_t)HALF * K * 2;
    const size_t tstep = 2 * hstep;
    const unsigned ldsw = (unsigned)wid * 1024u;
    const int aoff = lds_byte(wr * 64 + fr, fq * 8), boff = lds_byte(wc * 32 + fr, fq * 8);
#define PG8_SA(b, h) (((b) * 2 + (h)) * HTB)
#define PG8_SB(b, h) ((4 + (b) * 2 + (h)) * HTB)
#define PG8_STAGE(bufoff, gbase, voff) do { _Pragma("unroll") for (int _i = 0; _i < 2; ++_i) \
        __builtin_amdgcn_global_load_lds((const unsigned*)((const char*)(gbase) + (voff)[_i]), (PG8_LAS unsigned*)(lds + (bufoff) + ldsw + _i * 8192), 16, 0, 0); } while (0)
#define PG8_LDA(dst, b, h) do { _Pragma("unroll") for (int m = 0; m < 4; ++m) _Pragma("unroll") for (int k = 0; k < 2; ++k) dst[m][k] = *(const PG8_LAS bf16x8*)(lds + PG8_SA(b, h) + aoff + m * 2048 + k * 1024); } while (0)
#define PG8_LDB(dst, b, h) do { _Pragma("unroll") for (int n = 0; n < 2; ++n) _Pragma("unroll") for (int k = 0; k < 2; ++k) dst[n][k] = *(const PG8_LAS bf16x8*)(lds + PG8_SB(b, h) + boff + n * 2048 + k * 1024); } while (0)
#define PG8_MMA(ai, bj, At, Bt) do { __builtin_amdgcn_s_setprio(1); _Pragma("unroll") for (int m = 0; m < 4; ++m) _Pragma("unroll") for (int n = 0; n < 2; ++n) _Pragma("unroll") for (int k = 0; k < 2; ++k) \
        acc[ai][bj][m][n] = __builtin_amdgcn_mfma_f32_16x16x32_bf16(Bt[n][k], At[m][k], acc[ai][bj][m][n], 0, 0, 0); __builtin_amdgcn_s_setprio(0); } while (0)
#define PG8_WAIT_V(n) asm volatile("s_waitcnt vmcnt(" #n ")" ::: "memory")
#define PG8_WAIT_L(n) asm volatile("s_waitcnt lgkmcnt(" #n ")" ::: "memory")
#define PG8_BAR __builtin_amdgcn_s_barrier()
#define PG8_SCHED __builtin_amdgcn_sched_barrier(0)
    Unit cur, nxt; int ui = 0;
    if (!S.next(0, cur)) return;
    f32x4 acc[2][2][4][2];
#pragma unroll
    for (int a = 0; a < 2; ++a)
#pragma unroll
        for (int b = 0; b < 2; ++b)
#pragma unroll
            for (int m = 0; m < 4; ++m)
#pragma unroll
                for (int n = 0; n < 2; ++n) acc[a][b][m][n] = (f32x4){0.f, 0.f, 0.f, 0.f};
    bf16x8 At[4][2], B0[2][2], B1[2][2];
    const char* cA = (const char*)g.A + (size_t)cur.pm * tstep; const char* cB = (const char*)g.Bt + (size_t)cur.pn * tstep;
    S.a_ready(cur);
    PG8_STAGE(PG8_SB(0, 0), cB, voffB); PG8_STAGE(PG8_SA(0, 0), cA, voffA); PG8_STAGE(PG8_SB(0, 1), cB + hstep, voffB); PG8_STAGE(PG8_SA(0, 1), cA + hstep, voffA);
    if (wr == 1) PG8_BAR;
    PG8_WAIT_V(4); PG8_BAR;
    PG8_STAGE(PG8_SB(1, 0), cB + kstep, voffB); PG8_STAGE(PG8_SA(1, 0), cA + kstep, voffA); PG8_STAGE(PG8_SB(1, 1), cB + hstep + kstep, voffB);
    PG8_WAIT_V(6); PG8_BAR;
    PG8_STAMP();
    for (;;) {
        const bool has_next = S.next(ui + 1, nxt);
        const char* nA = has_next ? (const char*)g.A + (size_t)nxt.pm * tstep : cA; const char* nB = has_next ? (const char*)g.Bt + (size_t)nxt.pn * tstep : cB;
        for (int t = 0; t < nt; t += 2) {
            const bool last = (t == nt - 2);
            const char* a1 = cA + (size_t)(t + 1) * kstep;
            const char* a2 = last ? nA : cA + (size_t)(t + 2) * kstep; const char* b2 = last ? nB : cB + (size_t)(t + 2) * kstep;
            const char* a3 = a2 + kstep; const char* b3 = b2 + kstep;
            if (last && has_next) S.a_ready(nxt);
            PG8_LDB(B0, 0, 0); PG8_SCHED; PG8_LDA(At, 0, 0); PG8_STAGE(PG8_SA(1, 1), a1 + hstep, voffA);
            PG8_WAIT_L(8); PG8_BAR; PG8_WAIT_L(0); PG8_MMA(0, 0, At, B0); PG8_BAR; PG8_SCHED;
            PG8_LDB(B1, 0, 1); PG8_STAGE(PG8_SB(0, 0), b2, voffB);
            PG8_BAR; PG8_WAIT_L(0); PG8_MMA(0, 1, At, B1); PG8_BAR;
            PG8_LDA(At, 0, 1); PG8_STAGE(PG8_SA(0, 0), a2, voffA);
            PG8_BAR; PG8_WAIT_L(0); PG8_MMA(1, 0, At, B0); PG8_BAR; PG8_SCHED;
            PG8_STAGE(PG8_SB(0, 1), b2 + hstep, voffB);
            PG8_WAIT_V(6); PG8_BAR; PG8_MMA(1, 1, At, B1); PG8_BAR;
            PG8_LDB(B0, 1, 0); PG8_SCHED; PG8_LDA(At, 1, 0); PG8_STAGE(PG8_SA(0, 1), a2 + hstep, voffA);
            PG8_WAIT_L(8); PG8_BAR; PG8_WAIT_L(0); PG8_MMA(0, 0, At, B0); PG8_BAR; PG8_SCHED;
            PG8_LDB(B1, 1, 1); PG8_STAGE(PG8_SB(1, 0), b3, voffB);
            PG8_BAR; PG8_WAIT_L(0); PG8_MMA(0, 1, At, B1); PG8_BAR;
            PG8_LDA(At, 1, 1); PG8_STAGE(PG8_SA(1, 0), a3, voffA);
            PG8_BAR; PG8_WAIT_L(0); PG8_MMA(1, 0, At, B0); PG8_BAR; PG8_SCHED;
            PG8_STAGE(PG8_SB(1, 1), b3 + hstep, voffB);
            PG8_WAIT_V(6); PG8_BAR; PG8_MMA(1, 1, At, B1); PG8_BAR;
        }
        PG8_STAMP();
        if constexpr (!Epi::AFTER_DRAIN) { E(acc, cur, wr, wc, fr, fq); S.done(cur); }
        PG8_STAMP();
        if (!has_next) break;
#pragma unroll
        for (int a = 0; a < 2; ++a)
#pragma unroll
            for (int b = 0; b < 2; ++b)
#pragma unroll
                for (int m = 0; m < 4; ++m)
#pragma unroll
                    for (int n = 0; n < 2; ++n) acc[a][b][m][n] = (f32x4){0.f, 0.f, 0.f, 0.f};
        cur = nxt; cA = nA; cB = nB; ++ui;
    }
    PG8_WAIT_V(0);
    if (wr == 0) PG8_BAR;
    PG8_BAR;
    if constexpr (Epi::AFTER_DRAIN) { E.fused(acc, cur, wr, wc, fr, fq, lds, wid, lane); S.done(cur); }
    PG8_STAMP();
    if (STAMP && wid == 0) { stamps[lane] = lane < nts ? (((unsigned long long)(unsigned)ts_hi << 32) | (unsigned)ts_lo) : 0ull;
        if (lane == 62) stamps[62] = rt_entry; if (lane == 63) stamps[63] = (unsigned long long)wall_clock64(); }
#undef PG8_STAMP
#undef PG8_SA
#undef PG8_SB
#undef PG8_STAGE
#undef PG8_LDA
#undef PG8_LDB
#undef PG8_MMA
#undef PG8_WAIT_V
#undef PG8_WAIT_L
#undef PG8_BAR
#undef PG8_SCHED
}
}
#define XB_TMO      128
#define XB_XCNT(j)  (256  + 64 * (j))
#define XB_XSUB(j)  (1280 + 64 * (j))
#define XB_XGEN(j)  (2304 + 64 * (j))
#define XB_TOP      3328
#define XB_TOPGEN   3392
#define XCD_BAR_WORDS 3456
#define XB_SPIN_CAP (1u << 22)
#define LAS __attribute__((address_space(3)))

__device__ __forceinline__ unsigned xb_ld(unsigned* p)              { return __hip_atomic_load(p, __ATOMIC_RELAXED, __HIP_MEMORY_SCOPE_AGENT); }
__device__ __forceinline__ unsigned xb_add(unsigned* p, unsigned v) { return __hip_atomic_fetch_add(p, v, __ATOMIC_RELAXED, __HIP_MEMORY_SCOPE_AGENT); }
__device__ __forceinline__ unsigned xb_xcc_id() { return (unsigned)__builtin_amdgcn_s_getreg((3 << 11) | 20) & 0xFu; }
#define XB_SPIN(cond, bar) do { unsigned _sp = 0; while (cond) { __builtin_amdgcn_s_sleep(1); \
    if ((++_sp & 255u) == 0u) { if (xb_ld(&(bar)[XB_TMO])) break; if (_sp > XB_SPIN_CAP) { atomicAdd(&(bar)[XB_TMO], 1u); break; } } } } while (0)

struct XcdBarrier {
    unsigned* bar; unsigned x;
    volatile LAS unsigned* st;
};

__device__ __forceinline__ XcdBarrier xcd_barrier_post(unsigned* bar, volatile LAS unsigned* st, const int tid) {
    XcdBarrier b; b.bar = bar; b.x = xb_xcc_id(); b.st = st;
    if (tid == 0) (void)xb_add(&bar[XB_XCNT(b.x)], 1u);
    return b;
}
__device__ __forceinline__ void xcd_barrier_complete(unsigned* bar, unsigned x, unsigned& nloc, unsigned& nx) {
    const unsigned G = gridDim.x * gridDim.y * gridDim.z;
    unsigned sum, cnt, mine, sp = 0u;
    for (;;) {
        sum = 0u; cnt = 0u; mine = 0u;
#pragma unroll
        for (unsigned j = 0; j < 16; ++j) { const unsigned c = xb_ld(&bar[XB_XCNT(j)]); sum += c; cnt += (c > 0u) ? 1u : 0u; mine = (j == x) ? c : mine; }
        if (sum == G) break;
        __builtin_amdgcn_s_sleep(1);
        if ((++sp & 255u) == 0u) { if (xb_ld(&bar[XB_TMO])) break; if (sp > XB_SPIN_CAP) { atomicAdd(&bar[XB_TMO], 1u); break; } }
    }
    nloc = mine > 0u ? mine : 1u; nx = cnt > 0u ? cnt : 1u;
}

__device__ __forceinline__ void xcd_barrier(const XcdBarrier& b, const int tid) {
    asm volatile("s_waitcnt vmcnt(0)" ::: "memory");
    __syncthreads();
    if (tid == 0) {
        unsigned* bar = b.bar;
        __builtin_amdgcn_s_waitcnt(0);
        unsigned nloc = b.st[0], nx = b.st[1];
        if (nloc == 0u) { xcd_barrier_complete(bar, b.x, nloc, nx); b.st[0] = nloc; b.st[1] = nx; }
        const unsigned old = xb_add(&bar[XB_XSUB(b.x)], 1u);
        const unsigned gen = old / nloc;
        if (old + 1u == (gen + 1u) * nloc) {
            __builtin_amdgcn_fence(__ATOMIC_RELEASE, "agent");
            asm volatile("s_waitcnt vmcnt(0)" ::: "memory");
            const unsigned og = xb_add(&bar[XB_TOP], 1u);
            const unsigned tg = og / nx;
            if (og + 1u == (tg + 1u) * nx) xb_add(&bar[XB_TOPGEN], 1u);
            else XB_SPIN(xb_ld(&bar[XB_TOPGEN]) == tg, bar);
            __builtin_amdgcn_fence(__ATOMIC_ACQUIRE, "agent");
            xb_add(&bar[XB_XGEN(b.x)], 1u);
            asm volatile("s_waitcnt vmcnt(0)" ::: "memory");
        } else {
            XB_SPIN(xb_ld(&bar[XB_XGEN(b.x)]) == gen, bar);
            __builtin_amdgcn_fence(__ATOMIC_ACQUIRE, "agent");
            asm volatile("s_waitcnt vmcnt(0)" ::: "memory");
        }
    }
    __syncthreads();
}
namespace att {
using bf16 = unsigned short;
constexpr int   D = 128, NW = 8, QBLK = 32, KVBLK = 64;
constexpr float SCALE = 0.088388347648318440f;
constexpr float THR = 8.f;
constexpr int SDEPTH = 1;
constexpr size_t SHM_V = KVBLK * D * 2, SHM_K = KVBLK * D * 2, SHM_ATTN = 2 * SHM_V + 2 * SHM_K + NW * 64 * 4;
using bf16x8 = __attribute__((ext_vector_type(8))) short;
using s16x4  = __attribute__((ext_vector_type(4))) short;
using f32x16 = __attribute__((ext_vector_type(16))) float;
using f32x8  = __attribute__((ext_vector_type(8))) float;
using u32x4  = __attribute__((ext_vector_type(4))) unsigned;
#define KSWZ(row, colB) ((row) * 256 + ((colB) ^ (((row) & 7) << 4)))
#define SBAR() __builtin_amdgcn_sched_barrier(0)
__device__ __forceinline__ int crow(int r, int hi) { return (r & 3) + 8 * (r >> 2) + 4 * hi; }
__device__ __forceinline__ unsigned cvtpk(float lo, float hi) {
  unsigned r; asm volatile("v_cvt_pk_bf16_f32 %0, %1, %2" : "=v"(r) : "v"(lo), "v"(hi)); return r;
}
template <typename TIn> struct Stage;
template <> struct Stage<bf16>  { using T = bf16x8;
  __device__ static __forceinline__ T ld8(const bf16* p) { return *reinterpret_cast<const bf16x8*>(p); }
  __device__ static __forceinline__ bf16x8 tobf(T x) { return x; } };
template <> struct Stage<float> { using T = f32x8;
  __device__ static __forceinline__ T ld8(const float* p) { return *reinterpret_cast<const f32x8*>(p); }
  __device__ static __forceinline__ bf16x8 tobf(T x) {
    u32x4 w = {cvtpk(x[0], x[1]), cvtpk(x[2], x[3]), cvtpk(x[4], x[5]), cvtpk(x[6], x[7])}; return *reinterpret_cast<bf16x8*>(&w); } };

__device__ __forceinline__ void partialSM(f32x16& p0, f32x16& p1, float& m_reg, float& mn, float& alpha) {
  constexpr float C = SCALE * 1.4426950408889634f;
  float pmax = p0[0]; for (int r = 1; r < 16; ++r) pmax = fmaxf(pmax, p0[r]); for (int r = 0; r < 16; ++r) pmax = fmaxf(pmax, p1[r]);
  { auto rr = __builtin_amdgcn_permlane32_swap(__float_as_uint(pmax), __float_as_uint(pmax), false, false);
    pmax = fmaxf(__uint_as_float(rr[0]), __uint_as_float(rr[1])); }
  if (__builtin_expect(__all(pmax - m_reg <= THR / SCALE), 1)) { mn = m_reg; alpha = 1.f; }
  else { mn = fmaxf(m_reg, pmax); alpha = __builtin_amdgcn_exp2f((m_reg - mn) * C); m_reg = mn; }
  float mnC = -mn * C;
  for (int r = 0; r < 16; ++r) p0[r] = fmaf(p0[r], C, mnC); for (int r = 0; r < 16; ++r) p1[r] = fmaf(p1[r], C, mnC);
  for (int r = 0; r < 16; ++r) p0[r] = __builtin_amdgcn_exp2f(p0[r]);
}
__device__ __forceinline__ void finishSM(f32x16& p0, f32x16& p1, float alpha, float& l_reg, bf16x8& pa0, bf16x8& pa1, bf16x8& pa2, bf16x8& pa3) {
  for (int r = 0; r < 16; ++r) p1[r] = __builtin_amdgcn_exp2f(p1[r]);
  float ps = 0; for (int r = 0; r < 16; ++r) ps += p0[r]; for (int r = 0; r < 16; ++r) ps += p1[r];
  { auto rr = __builtin_amdgcn_permlane32_swap(__float_as_uint(ps), __float_as_uint(ps), false, false);
    ps = __uint_as_float(rr[0]) + __uint_as_float(rr[1]); }
  l_reg = l_reg * alpha + ps;
#define PK4(P, BASE, OUT) do { unsigned a0 = cvtpk(P[BASE + 0], P[BASE + 1]), a1 = cvtpk(P[BASE + 2], P[BASE + 3]);   \
    unsigned b0 = cvtpk(P[BASE + 4], P[BASE + 5]), b1 = cvtpk(P[BASE + 6], P[BASE + 7]);                              \
    auto r0 = __builtin_amdgcn_permlane32_swap(a0, b0, false, false); auto r1 = __builtin_amdgcn_permlane32_swap(a1, b1, false, false); \
    u32x4 w = {r0[0], r1[0], r0[1], r1[1]}; OUT = *reinterpret_cast<bf16x8*>(&w); } while (0)
  PK4(p0, 0, pa0); PK4(p0, 8, pa1); PK4(p1, 0, pa2); PK4(p1, 8, pa3);
#undef PK4
}
__device__ __forceinline__ void qkt(f32x16& p0, f32x16& p1, const bf16* Ks, const bf16x8* qr, int r32, int hi) {
  p0 = f32x16{}; p1 = f32x16{};
  bf16x8 c0 = *reinterpret_cast<const bf16x8*>((const char*)Ks + KSWZ(r32, (hi * 8) * 2)), c1 = *reinterpret_cast<const bf16x8*>((const char*)Ks + KSWZ(32 + r32, (hi * 8) * 2));
#pragma unroll
  for (int d0 = 0; d0 < 8; ++d0) {
    bf16x8 n0 = c0, n1 = c1;
    if (d0 < 7) { const int cb = ((d0 + 1) * 16 + hi * 8) * 2;
      n0 = *reinterpret_cast<const bf16x8*>((const char*)Ks + KSWZ(r32, cb)); n1 = *reinterpret_cast<const bf16x8*>((const char*)Ks + KSWZ(32 + r32, cb)); }
    p0 = __builtin_amdgcn_mfma_f32_32x32x16_bf16(c0, qr[d0], p0, 0, 0, 0);
    p1 = __builtin_amdgcn_mfma_f32_32x32x16_bf16(c1, qr[d0], p1, 0, 0, 0);
    c0 = n0; c1 = n1; }
}
template <int OFF> __device__ __forceinline__ bf16x8 k_read(const int addr) {
  bf16x8 r; asm volatile("ds_read_b128 %0, %1 offset:%2" : "=&v"(r) : "v"(addr), "i"(OFF) : "memory"); return r;
}
template <int D0> __device__ __forceinline__ void qkt_step(f32x16& p0, f32x16& p1, const int (&a)[4], const bf16x8* qr, bf16x8 c0, bf16x8 c1) {
  bf16x8 n0 = c0, n1 = c1;
  if constexpr (D0 < 7) { n0 = k_read<((D0 + 1) >> 2) * 128>(a[(D0 + 1) & 3]); n1 = k_read<((D0 + 1) >> 2) * 128 + 8192>(a[(D0 + 1) & 3]); asm volatile("s_waitcnt lgkmcnt(2)" ::: "memory"); }
  else asm volatile("s_waitcnt lgkmcnt(0)" ::: "memory");
  SBAR();
  p0 = __builtin_amdgcn_mfma_f32_32x32x16_bf16(c0, qr[D0], p0, 0, 0, 0);
  p1 = __builtin_amdgcn_mfma_f32_32x32x16_bf16(c1, qr[D0], p1, 0, 0, 0);
  if constexpr (D0 < 7) qkt_step<D0 + 1>(p0, p1, a, qr, n0, n1);
}
__device__ __forceinline__ void qkt_pipe(f32x16& p0, f32x16& p1, const int ka, const bf16x8* qr, const int r32, const int hi) {
  p0 = f32x16{}; p1 = f32x16{};
  int a[4];
#pragma unroll
  for (int q = 0; q < 4; ++q) a[q] = ka + r32 * 256 + ((q * 32 + hi * 16) ^ ((r32 & 7) << 4));
  const bf16x8 c0 = k_read<0>(a[0]), c1 = k_read<8192>(a[0]);
  qkt_step<0>(p0, p1, a, qr, c0, c1);
}
__device__ __forceinline__ int v_st(int k, int c) { const int kk = (k & ~0xC) | ((k & 4) << 1) | ((k & 8) >> 1); return ((kk >> 3) * 4 + (c >> 5)) * 512 + ((kk & 7) * 32 + (c & 31)) * 2; }
__device__ __forceinline__ int v_rd_base(int lane) { return ((lane & 3) << 3) | (((lane >> 2) & 3) << 6) | (((lane >> 4) & 1) << 5) | (((lane >> 5) & 1) << 8); }
constexpr int v_rd_off(int d0, int ks, int half) { return d0 * 512 + ks * 4096 + half * 2048; }
template <int OFF> __device__ __forceinline__ s16x4 tr_read(int vb) {
  s16x4 r; asm volatile("ds_read_b64_tr_b16 %0, %1 offset:%2" : "=&v"(r) : "v"(vb), "i"(OFF) : "memory"); return r;
}
template <int D0> __device__ __forceinline__ void pv_one(f32x16& od, int vb, bf16x8 pa0, bf16x8 pa1, bf16x8 pa2, bf16x8 pa3) {
  const s16x4 l0 = tr_read<v_rd_off(D0, 0, 0)>(vb), h0 = tr_read<v_rd_off(D0, 0, 1)>(vb), l1 = tr_read<v_rd_off(D0, 1, 0)>(vb), h1 = tr_read<v_rd_off(D0, 1, 1)>(vb);
  const s16x4 l2 = tr_read<v_rd_off(D0, 2, 0)>(vb), h2 = tr_read<v_rd_off(D0, 2, 1)>(vb), l3 = tr_read<v_rd_off(D0, 3, 0)>(vb), h3 = tr_read<v_rd_off(D0, 3, 1)>(vb);
  asm volatile("s_waitcnt lgkmcnt(0)" ::: "memory"); SBAR();
#define PK(L, H) (bf16x8){L[0], L[1], L[2], L[3], H[0], H[1], H[2], H[3]}
  od = __builtin_amdgcn_mfma_f32_32x32x16_bf16(pa0, PK(l0, h0), od, 0, 0, 0);
  od = __builtin_amdgcn_mfma_f32_32x32x16_bf16(pa1, PK(l1, h1), od, 0, 0, 0);
  od = __builtin_amdgcn_mfma_f32_32x32x16_bf16(pa2, PK(l2, h2), od, 0, 0, 0);
  od = __builtin_amdgcn_mfma_f32_32x32x16_bf16(pa3, PK(l3, h3), od, 0, 0, 0);
#undef PK
}
__device__ __forceinline__ void pv_d0(f32x16* o, int vb, bf16x8 pa0, bf16x8 pa1, bf16x8 pa2, bf16x8 pa3) {
  pv_one<0>(o[0], vb, pa0, pa1, pa2, pa3); pv_one<1>(o[1], vb, pa0, pa1, pa2, pa3); pv_one<2>(o[2], vb, pa0, pa1, pa2, pa3); pv_one<3>(o[3], vb, pa0, pa1, pa2, pa3);
}

template <int B> __device__ __forceinline__ void pv_rd8(s16x4 (&f)[8], const int vb) {
  constexpr int D0 = B & 3, HB = (B >> 2) * 16384;
  f[0] = tr_read<HB + v_rd_off(D0, 0, 0)>(vb); f[1] = tr_read<HB + v_rd_off(D0, 0, 1)>(vb); f[2] = tr_read<HB + v_rd_off(D0, 1, 0)>(vb); f[3] = tr_read<HB + v_rd_off(D0, 1, 1)>(vb);
  f[4] = tr_read<HB + v_rd_off(D0, 2, 0)>(vb); f[5] = tr_read<HB + v_rd_off(D0, 2, 1)>(vb); f[6] = tr_read<HB + v_rd_off(D0, 3, 0)>(vb); f[7] = tr_read<HB + v_rd_off(D0, 3, 1)>(vb);
}
__device__ __forceinline__ void pv_mma4(f32x16& od, const s16x4 (&f)[8], bf16x8 pa0, bf16x8 pa1, bf16x8 pa2, bf16x8 pa3) {
#define PK(L, H) (bf16x8){L[0], L[1], L[2], L[3], H[0], H[1], H[2], H[3]}
  od = __builtin_amdgcn_mfma_f32_32x32x16_bf16(pa0, PK(f[0], f[1]), od, 0, 0, 0);
  od = __builtin_amdgcn_mfma_f32_32x32x16_bf16(pa1, PK(f[2], f[3]), od, 0, 0, 0);
  od = __builtin_amdgcn_mfma_f32_32x32x16_bf16(pa2, PK(f[4], f[5]), od, 0, 0, 0);
  od = __builtin_amdgcn_mfma_f32_32x32x16_bf16(pa3, PK(f[6], f[7]), od, 0, 0, 0);
#undef PK
}
template <int B, int NB> __device__ __forceinline__ void pv_pipe_step(f32x16* o, s16x4 (&cur)[8], s16x4 (&nxt)[8], const int vb, bf16x8 pa0, bf16x8 pa1, bf16x8 pa2, bf16x8 pa3) {
  if constexpr (B + 1 < NB) { pv_rd8<B + 1>(nxt, vb); asm volatile("s_waitcnt lgkmcnt(8)" ::: "memory"); }
  else asm volatile("s_waitcnt lgkmcnt(0)" ::: "memory");
  SBAR();
  pv_mma4(o[B], cur, pa0, pa1, pa2, pa3);
  if constexpr (B + 1 < NB) pv_pipe_step<B + 1, NB>(o, nxt, cur, vb, pa0, pa1, pa2, pa3);
}
template <int NB> __device__ __forceinline__ void pv_pipe(f32x16* o, const int vb, bf16x8 pa0, bf16x8 pa1, bf16x8 pa2, bf16x8 pa3) {
  s16x4 fa[8], fb[8];
  pv_rd8<0>(fa, vb);
  pv_pipe_step<0, NB>(o, fa, fb, vb, pa0, pa1, pa2, pa3);
}

template <typename TQ, int LDQ, int LDK, int LDO, typename TO>
__device__ __forceinline__ void attn_dense_body(const TQ* __restrict__ Qb, const bf16* __restrict__ Kh, const bf16* __restrict__ Vh,
                                                TO* __restrict__ Ob, int seq, char* lds, const int tid_in) {
  using St = Stage<bf16>; using SQ = Stage<TQ>;
  const int tid = tid_in, wid = tid >> 6, lane = tid & 63, r32 = lane & 31, hi = lane >> 5;
  bf16* V_lds = (bf16*)lds; bf16* K_lds = (bf16*)(lds + 2 * SHM_V);
  float* ws = (float*)(lds + 2 * SHM_V + 2 * SHM_K) + wid * 64; float* li_l = ws; float* al_l = ws + 32;
  float m_reg = -1e30f, l_reg = 0; f32x16 o[4] = {}; bf16x8 qr[8];
  const TQ* Qw = Qb + ((wid * QBLK + r32) * LDQ + hi * 8);
#pragma unroll
  for (int d0 = 0; d0 < 8; ++d0) qr[d0] = SQ::tobf(SQ::ld8(Qw + d0 * 16));
  const int sr = tid >> 4, sc = (tid & 15) * 8, vst0 = v_st(sr, sc), vst1 = v_st(32 + sr, sc);
  const int vb0 = (int)(uintptr_t)V_lds + v_rd_base(lane);
  struct { typename St::T vs0, vs1, ks0, ks1; } sr_[SDEPTH];
#define SLOAD(i, k0) do { sr_[i].vs0 = St::ld8(Vh + (((k0) + sr) * LDK + sc)); sr_[i].vs1 = St::ld8(Vh + (((k0) + 32 + sr) * LDK + sc)); \
    sr_[i].ks0 = St::ld8(Kh + (((k0) + sr) * LDK + sc)); sr_[i].ks1 = St::ld8(Kh + (((k0) + 32 + sr) * LDK + sc)); } while (0)
#define SWRITE(b, i) do { *(bf16x8*)((char*)V_lds + (b) * SHM_V + vst0) = St::tobf(sr_[i].vs0);          \
    *(bf16x8*)((char*)V_lds + (b) * SHM_V + vst1) = St::tobf(sr_[i].vs1); int kc = sc * 2;               \
    *(bf16x8*)((char*)K_lds + (b) * SHM_K + KSWZ(sr, kc)) = St::tobf(sr_[i].ks0);                       \
    *(bf16x8*)((char*)K_lds + (b) * SHM_K + KSWZ(32 + sr, kc)) = St::tobf(sr_[i].ks1); } while (0)
#define SWAIT() do { if constexpr (SDEPTH == 2) asm volatile("s_waitcnt vmcnt(4)" ::: "memory"); else asm volatile("s_waitcnt vmcnt(0)" ::: "memory"); } while (0)
#define RESC(a) do { if (__any((a) < 1.f)) { if (hi == 0) al_l[r32] = (a); asm volatile("s_waitcnt lgkmcnt(0)" ::: "memory"); \
    for (int d = 0; d < 4; ++d) for (int r = 0; r < 16; ++r) o[d][r] *= al_l[crow(r, hi)]; } } while (0)
  f32x16 pA0, pA1, pB0, pB1; float mnA, mnB, alA, alB; bf16x8 pa0, pa1, pa2, pa3; const int NT = seq / KVBLK;
  constexpr int SE = 0, SO = SDEPTH - 1;
  SLOAD(SE, 0); asm volatile("s_waitcnt vmcnt(0)" ::: "memory"); SWRITE(0, SE); __syncthreads();
  qkt(pA0, pA1, K_lds, qr, r32, hi); partialSM(pA0, pA1, m_reg, mnA, alA);
  SLOAD(SO, KVBLK); if constexpr (SDEPTH == 2) { if (2 < NT) SLOAD(SE, 2 * KVBLK); }
  SWAIT(); SWRITE(1, SO); __syncthreads();
  for (int j = 1; j + 1 < NT; j += 2) {
    SBAR(); qkt(pB0, pB1, (bf16*)((char*)K_lds + SHM_K), qr, r32, hi);
    finishSM(pA0, pA1, alA, l_reg, pa0, pa1, pa2, pa3); SBAR();
    SLOAD(SO, (j + SDEPTH) * KVBLK); SBAR();
    pv_d0(o, vb0, pa0, pa1, pa2, pa3); partialSM(pB0, pB1, m_reg, mnB, alB);
    __syncthreads(); SWAIT(); SWRITE(0, SE);
    RESC(alB); __syncthreads();
    SBAR(); qkt(pA0, pA1, K_lds, qr, r32, hi);
    finishSM(pB0, pB1, alB, l_reg, pa0, pa1, pa2, pa3); SBAR();
    if (SDEPTH == 1 || j + 3 < NT) SLOAD(SE, (j + 1 + SDEPTH) * KVBLK); SBAR();
    pv_d0(o, vb0 + (int)SHM_V, pa0, pa1, pa2, pa3); partialSM(pA0, pA1, m_reg, mnA, alA);
    __syncthreads(); SWAIT(); SWRITE(1, SO);
    RESC(alA); __syncthreads();
  }
  SBAR(); qkt(pB0, pB1, (bf16*)((char*)K_lds + SHM_K), qr, r32, hi);
  finishSM(pA0, pA1, alA, l_reg, pa0, pa1, pa2, pa3); SBAR();
  pv_d0(o, vb0, pa0, pa1, pa2, pa3); partialSM(pB0, pB1, m_reg, mnB, alB);
  __syncthreads(); RESC(alB);
  finishSM(pB0, pB1, alB, l_reg, pa0, pa1, pa2, pa3); SBAR();
  pv_d0(o, vb0 + (int)SHM_V, pa0, pa1, pa2, pa3);
  if (hi == 0) li_l[r32] = l_reg; asm volatile("s_waitcnt lgkmcnt(0)" ::: "memory");
  float rli[16];
#pragma unroll
  for (int r = 0; r < 16; ++r) rli[r] = __builtin_amdgcn_rcpf(li_l[crow(r, hi)]);
  TO* Ow = Ob + (wid * QBLK) * LDO;
#pragma unroll
  for (int r = 0; r < 16; ++r) { int orow = crow(r, hi);
    for (int d0 = 0; d0 < 4; ++d0) { const float val = o[d0][r] * rli[r];
      if constexpr (sizeof(TO) == 4) Ow[orow * LDO + d0 * 32 + r32] = val;
      else Ow[orow * LDO + d0 * 32 + r32] = (TO)(cvtpk(val, val) & 0xffffu); } }
#undef SLOAD
#undef SWRITE
#undef SWAIT
#undef RESC
}

template <int WIN>
__device__ __forceinline__ void attn_banded_body(const bf16* __restrict__ Qp, const bf16* __restrict__ Kp, const bf16* __restrict__ Vp, const long rs, const int Lseq, const int P0,
                                                 const float m_init, const float l_init, bf16* __restrict__ Ob, const long os, float* __restrict__ Lp, const long ls, char* lds, const int tid) {
  const int wid = __builtin_amdgcn_readfirstlane(tid >> 6), lane = tid & 63, r32 = lane & 31, hi = lane >> 5;
  constexpr int BT = 32768;
  float* wsf = (float*)(lds + 2 * BT) + wid * 64; float* li_l = wsf; float* al_l = wsf + 32;
  float m_reg = m_init, l_reg = l_init; f32x16 o[4] = {}; bf16x8 qr[8];
  const bf16* Qw = Qp + (long)(P0 + wid * QBLK + r32) * rs + hi * 8;
#pragma unroll
  for (int d0 = 0; d0 < 8; ++d0) qr[d0] = *reinterpret_cast<const bf16x8*>(Qw + d0 * 16);
  const int irs = (int)rs;
  int ksrc[2], vsrc[2];
#pragma unroll
  for (int i = 0; i < 2; ++i) { const int c = 2 * wid + i, row = 4 * c + (lane >> 4), colB = (16 * (lane & 15)) ^ ((row & 7) << 4); ksrc[i] = row * irs + (colB >> 1);
      const int sub = 2 * c + (lane >> 5), kk = ((sub >> 2) << 3) | ((lane & 31) >> 2), k = (kk & ~0xC) | ((kk & 4) << 1) | ((kk & 8) >> 1), col = (sub & 3) * 32 + 8 * (lane & 3); vsrc[i] = k * irs + col; }
  using LP = __attribute__((address_space(3))) unsigned*;
#define BB_DMA(buf, tb) do { const bf16* _kb = Kp + (long)(tb) * rs; const bf16* _vb = Vp + (long)(tb) * rs; char* _l = lds + (buf) * BT; \
    _Pragma("unroll") for (int _i = 0; _i < 2; ++_i) { __builtin_amdgcn_global_load_lds((const unsigned*)(_kb + ksrc[_i]), (LP)(_l + (2 * wid + _i) * 1024), 16, 0, 0); \
                                                       __builtin_amdgcn_global_load_lds((const unsigned*)(_vb + vsrc[_i]), (LP)(_l + 16384 + (2 * wid + _i) * 1024), 16, 0, 0); } } while (0)
  constexpr int NT = (256 + 2 * WIN) / 64, NTW = (2 * WIN + 32 + 63) / 64;
  const int klo = wid >> 1, qpos = P0 + wid * QBLK + r32;
  int kf = 0; while (P0 - WIN + 64 * kf < 0) ++kf;
  int kl = NT - 1; while (P0 - WIN + 64 * kl >= Lseq) --kl;
  BB_DMA(kf & 1, P0 - WIN + 64 * kf);
  for (int k = kf; k <= kl; ++k) {
    const int tb = P0 - WIN + 64 * k;
    asm volatile("s_waitcnt vmcnt(0)" ::: "memory");
    __builtin_amdgcn_s_barrier();
    asm volatile("" ::: "memory");
    if (k < kl) BB_DMA((k + 1) & 1, tb + 64);
    char* tbuf = lds + (k & 1) * BT;
    if (k >= klo && k < klo + NTW) {
      f32x16 p0, p1; float mn, al; bf16x8 pa0, pa1, pa2, pa3;
      qkt_pipe(p0, p1, (int)(uintptr_t)tbuf, qr, r32, hi);
      if (k == klo || k == klo + NTW - 1) {
#pragma unroll
        for (int r = 0; r < 16; ++r) { const int d = qpos - (tb + crow(r, hi));
          if (d > WIN || d < -WIN) p0[r] = -1e30f;
          if (d - 32 > WIN || d - 32 < -WIN) p1[r] = -1e30f; }
      }
      partialSM(p0, p1, m_reg, mn, al);
      if (__any(al < 1.f)) { if (hi == 0) al_l[r32] = al; asm volatile("s_waitcnt lgkmcnt(0)" ::: "memory");
#pragma unroll
        for (int d = 0; d < 4; ++d)
#pragma unroll
          for (int r = 0; r < 16; ++r) o[d][r] *= al_l[crow(r, hi)]; }
      finishSM(p0, p1, al, l_reg, pa0, pa1, pa2, pa3); SBAR();
      pv_pipe<4>(o, (int)(uintptr_t)(tbuf + 16384) + v_rd_base(lane), pa0, pa1, pa2, pa3);
    }
  }
#undef BB_DMA
  if (hi == 0) li_l[r32] = l_reg; asm volatile("s_waitcnt lgkmcnt(0)" ::: "memory");
  float rli[16];
#pragma unroll
  for (int r = 0; r < 16; ++r) rli[r] = __builtin_amdgcn_rcpf(li_l[crow(r, hi)]);
  bf16* Ow = Ob + (long)(P0 + wid * QBLK) * os;
#pragma unroll
  for (int r = 0; r < 16; ++r) { const int orow = crow(r, hi);
#pragma unroll
    for (int d0 = 0; d0 < 4; ++d0) { const float val = o[d0][r] * rli[r]; ((__attribute__((address_space(1))) bf16*)Ow)[(long)orow * os + d0 * 32 + r32] = (bf16)(cvtpk(val, val) & 0xffffu); } }
  if (Lp != nullptr && hi == 0) Lp[(long)(P0 + wid * QBLK + r32) * ls] = m_reg * SCALE + __logf(l_reg);
}

constexpr int WB_TILE = 49152, WB_WS = 2 * WB_TILE;
template <int LDQ, int LDK, int LDO, int NVH, typename TO, bool COMBINE = false, int LDC = 0>
__device__ __forceinline__ void attn_wide_body(const bf16* __restrict__ Qb, const bf16* __restrict__ Kh, const bf16* __restrict__ Vh, TO* __restrict__ Ob, const int seq, char* lds, const int tid,
                                               const float lam = 0.f, const float gsc = 0.f, const float* __restrict__ gain = nullptr, bf16* __restrict__ Cb = nullptr) {
  const int wid = __builtin_amdgcn_readfirstlane(tid >> 6), lane = tid & 63, r32 = lane & 31, hi = lane >> 5;
  float* wsf = (float*)(lds + WB_WS) + wid * 64; float* li_l = wsf; float* al_l = wsf + 32;
  float m_reg = -1e30f, l_reg = 0; f32x16 o[4 * NVH] = {}; bf16x8 qr[8];
  { const bf16* Qw = Qb + ((wid * QBLK + r32) * LDQ + hi * 8);
#pragma unroll
    for (int d0 = 0; d0 < 8; ++d0) qr[d0] = *reinterpret_cast<const bf16x8*>(Qw + d0 * 16); }
  constexpr int NVP = 2 * NVH;
  int ksrc[2], vsrc[NVP];
#pragma unroll
  for (int i = 0; i < 2; ++i) { const int c = 2 * wid + i, row = 4 * c + (lane >> 4), colB = (16 * (lane & 15)) ^ ((row & 7) << 4); ksrc[i] = row * LDK + (colB >> 1); }
#pragma unroll
  for (int i = 0; i < NVP; ++i) { const int pc = wid * NVP + i, hf = pc >> 4, c = pc & 15, sub = 2 * c + (lane >> 5), kk = ((sub >> 2) << 3) | ((lane & 31) >> 2);
      const int k = (kk & ~0xC) | ((kk & 4) << 1) | ((kk & 8) >> 1), col = (sub & 3) * 32 + 8 * (lane & 3); vsrc[i] = k * LDK + hf * 128 + col; }
  using LP = __attribute__((address_space(3))) unsigned*;
#define WB_DMA(buf, key0) do { const bf16* _kb = Kh + (key0) * LDK; const bf16* _vb = Vh + (key0) * LDK; char* _l = lds + (buf) * WB_TILE; \
    _Pragma("unroll") for (int _i = 0; _i < 2; ++_i) __builtin_amdgcn_global_load_lds((const unsigned*)(_kb + ksrc[_i]), (LP)(_l + (2 * wid + _i) * 1024), 16, 0, 0); \
    _Pragma("unroll") for (int _i = 0; _i < NVP; ++_i) __builtin_amdgcn_global_load_lds((const unsigned*)(_vb + vsrc[_i]), (LP)(_l + 16384 + (wid * NVP + _i) * 1024), 16, 0, 0); } while (0)
  const int NT = seq / KVBLK;
  WB_DMA(0, 0);
  for (int j = 0; j < NT; ++j) {
    asm volatile("s_waitcnt vmcnt(0)" ::: "memory");
    __builtin_amdgcn_s_barrier();
    asm volatile("" ::: "memory");
    if (j + 1 < NT) WB_DMA((j + 1) & 1, (j + 1) * KVBLK);
    char* tb = lds + (j & 1) * WB_TILE;
    f32x16 p0, p1; float mn, al; bf16x8 pa0, pa1, pa2, pa3;
    qkt_pipe(p0, p1, (int)(uintptr_t)tb, qr, r32, hi);
    partialSM(p0, p1, m_reg, mn, al);
    if (__any(al < 1.f)) { if (hi == 0) al_l[r32] = al; asm volatile("s_waitcnt lgkmcnt(0)" ::: "memory");
#pragma unroll
      for (int d = 0; d < 4 * NVH; ++d)
#pragma unroll
        for (int r = 0; r < 16; ++r) o[d][r] *= al_l[crow(r, hi)]; }
    finishSM(p0, p1, al, l_reg, pa0, pa1, pa2, pa3); SBAR();
    const int vb0 = (int)(uintptr_t)(tb + 16384) + v_rd_base(lane);
    pv_pipe<4 * NVH>(o, vb0, pa0, pa1, pa2, pa3);
  }
#undef WB_DMA
  int te = tid; asm volatile("" : "+v"(te));
  const int wid_e = __builtin_amdgcn_readfirstlane(te >> 6), r32_e = te & 31, hi_e = (te >> 5) & 1;
  float* li_e = (float*)(lds + WB_WS) + wid_e * 64;
  if (hi_e == 0) li_e[r32_e] = l_reg; asm volatile("s_waitcnt lgkmcnt(0)" ::: "memory");
  float rli[16];
#pragma unroll
  for (int r = 0; r < 16; ++r) rli[r] = __builtin_amdgcn_rcpf(li_e[crow(r, hi_e)]);
  TO* Ow = Ob + (wid_e * QBLK) * LDO;
  if constexpr (!COMBINE) {
#pragma unroll
    for (int r = 0; r < 16; ++r) { const int orow = crow(r, hi_e);
#pragma unroll
      for (int d0 = 0; d0 < 4 * NVH; ++d0) { const float val = o[d0][r] * rli[r];
        if constexpr (sizeof(TO) == 4) ((__attribute__((address_space(1))) TO*)Ow)[orow * LDO + d0 * 32 + r32_e] = val; else ((__attribute__((address_space(1))) TO*)Ow)[orow * LDO + d0 * 32 + r32_e] = (TO)(cvtpk(val, val) & 0xffffu); } }
  } else {
    static_assert(sizeof(TO) == 4 && NVH == 2, "combine: f32 first-map tile, 256-wide rows");
    float gn[8];
    { const float* g2 = gain; asm volatile("" : "+s"(g2));
#pragma unroll
      for (int d0 = 0; d0 < 8; ++d0) gn[d0] = g2[d0 * 32 + r32_e] * gsc; }
    bf16* Cw; { bf16* c2 = Cb; asm volatile("" : "+s"(c2)); Cw = c2 + (wid_e * QBLK) * LDC; }
    { TO* o2 = Ob; asm volatile("" : "+s"(o2)); Ow = o2 + (wid_e * QBLK) * LDO; }
#pragma unroll
    for (int r = 0; r < 16; ++r) { const int orow = crow(r, hi_e);
      float ss = 0.f;
#pragma unroll
      for (int d0 = 0; d0 < 8; ++d0) { const float o1 = __hip_atomic_load((const __attribute__((address_space(1))) float*)Ow + orow * LDO + d0 * 32 + r32_e, __ATOMIC_RELAXED, __HIP_MEMORY_SCOPE_AGENT);
        const float av = o1 - lam * (o[d0][r] * rli[r]); o[d0][r] = av; ss = fmaf(av, av, ss); }
#define WB_SWZ(v, m) __int_as_float(__builtin_amdgcn_ds_swizzle(__float_as_int(v), ((m) << 10) | 0x1F))
      ss += WB_SWZ(ss, 1); ss += WB_SWZ(ss, 2); ss += WB_SWZ(ss, 4); ss += WB_SWZ(ss, 8); ss += WB_SWZ(ss, 16);
#undef WB_SWZ
      const float sc = 1.0f / sqrtf(ss * (1.0f / 256.0f) + 1e-6f);
#pragma unroll
      for (int d0 = 0; d0 < 8; ++d0) { const float val = o[d0][r] * sc * gn[d0]; ((__attribute__((address_space(1))) bf16*)Cw)[orow * LDC + d0 * 32 + r32_e] = (bf16)(cvtpk(val, val) & 0xffffu); }
      asm volatile("" ::: "memory"); }
  }
}
}
typedef unsigned short bf16_t;
typedef unsigned u32x4v __attribute__((ext_vector_type(4)));
#define LDSA __attribute__((address_space(3)))
#define GLB __attribute__((address_space(1)))
constexpr size_t al256(size_t x) { return (x + 255) / 256 * 256; }
constexpr size_t WS_CTL  = 0;
constexpr size_t CTL_BYTES = 65536;
constexpr size_t WS_XB   = WS_CTL + CTL_BYTES;
constexpr size_t WS_WAB  = WS_XB + (size_t)SEQ * DM * 2;
constexpr size_t WS_WOAB = WS_WAB + (size_t)12288 * 4096 * 2;
constexpr size_t WS_WCD  = WS_WOAB + (size_t)4096 * 3072 * 2;
constexpr size_t WS_WOCD = WS_WCD + (size_t)9216 * 4096 * 2;
constexpr size_t WS_WQ   = WS_WOCD + (size_t)4096 * 4096 * 2;
constexpr size_t WS_UB   = WS_WQ + (size_t)2 * 2048 * 4096 * 2;
constexpr size_t WS_VB   = WS_UB + (size_t)2 * 16384 * 3072;
constexpr size_t WS_SU   = WS_VB + (size_t)2 * 16384 * 3072;
constexpr size_t WS_SV   = WS_SU + (size_t)2 * 16384 * 4;
constexpr size_t WS_H    = WS_SV + (size_t)2 * 16384 * 4;
constexpr size_t WS_Y    = WS_H;
constexpr size_t WS_PQ   = WS_H + (size_t)SEQ * 4096 * 4;
constexpr size_t WS_OC   = WS_H + (size_t)SEQ * 12288 * 4;
constexpr size_t WS_AB   = WS_OC + (size_t)2 * SEQ * 2048 * 4;
constexpr size_t WS_X1   = WS_AB + (size_t)SEQ * 4096 * 2;
constexpr size_t WS_X1B  = WS_X1 + (size_t)SEQ * 4096 * 4;
constexpr size_t WS_X2   = WS_X1B + (size_t)SEQ * 4096 * 2;
constexpr size_t WS_X2B  = WS_X2 + (size_t)SEQ * 4096 * 4;
constexpr size_t WS_EIDX = WS_X2B + (size_t)SEQ * 4096 * 2;
constexpr size_t WS_GATE = WS_EIDX + (size_t)SEQ * 128 * 4;
constexpr size_t WS_HB   = WS_GATE + (size_t)SEQ * 128 * 4;
constexpr size_t WS_KEYB = WS_HB + (size_t)SEQ * 12288 * 2;
constexpr size_t WS_CS0  = WS_KEYB + (size_t)2 * 8 * 2 * 128 * 128 * 2;
constexpr size_t WS_CSA  = WS_CS0 + (size_t)SEQ * 16 * 8;
constexpr size_t WS_END  = WS_CSA + (size_t)128 * 32 * 8;
static_assert(WS_END <= (size_t)2147483648ull, "workspace");

constexpr int LDS_BYTES = 155648;
constexpr int LDS_MISC = 139264;

struct MK { const float* in[21]; float* out; unsigned char* ws; int ph_lo, ph_hi; };

namespace pg8 {
struct EpiF32R {
    static constexpr bool PERM = false, AFTER_DRAIN = false;
    float* C; int ldc; const float* R; float ralpha;
    __device__ __forceinline__ void operator()(const f32x4 (&acc)[2][2][4][2], const Unit& u, int wr, int wc, int fr, int fq) const {
        const int row0 = u.pm * BM + wr * 64 + fr, col0 = u.pn * BM + wc * 32 + 4 * fq;
#pragma unroll
        for (int ai = 0; ai < 2; ++ai)
#pragma unroll
            for (int m = 0; m < 4; ++m) { const size_t off = (size_t)(row0 + ai * HALF + m * 16) * ldc + col0;
#pragma unroll
                for (int bj = 0; bj < 2; ++bj)
#pragma unroll
                    for (int n = 0; n < 2; ++n) { f32x4 v = acc[ai][bj][m][n];
                        if (R) { const f32x4 r = *(const GLB f32x4*)(R + off + bj * HALF + n * 16); v += r * ralpha; }
                        *(GLB f32x4*)(C + off + bj * HALF + n * 16) = v; } }
    }
};
struct EpiBf16P {
    static constexpr bool PERM = true, AFTER_DRAIN = false;
    bf16_t* O; int ldc;
    __device__ __forceinline__ void operator()(const f32x4 (&acc)[2][2][4][2], const Unit& u, int wr, int wc, int fr, int fq) const {
        const int row0 = u.pm * BM + wr * 64 + fr, col0 = u.pn * BM + wc * 32 + 8 * fq;
#pragma unroll
        for (int ai = 0; ai < 2; ++ai)
#pragma unroll
            for (int m = 0; m < 4; ++m) { bf16_t* rowp = O + (size_t)(row0 + ai * HALF + m * 16) * ldc + col0;
#pragma unroll
                for (int bj = 0; bj < 2; ++bj) { const f32x4 v0 = acc[ai][bj][m][0], v1 = acc[ai][bj][m][1];
                    u32x4 w; w.x = cvt_pk_bf16(v0[0], v0[1]); w.y = cvt_pk_bf16(v0[2], v0[3]); w.z = cvt_pk_bf16(v1[0], v1[1]); w.w = cvt_pk_bf16(v1[2], v1[3]);
                    *(GLB u32x4*)(rowp + bj * HALF) = w; } }
    }
};

template <int LAYER> struct EpiProj {
    static constexpr bool PERM = true, AFTER_DRAIN = false;
    bf16_t* O; int ldc; const float* cs0; const float* csa; const float* gq; const float* gk; PG8_LAS float* xch;
    __device__ __forceinline__ void operator()(const f32x4 (&acc)[2][2][4][2], const Unit& u, int wr, int wc, int fr, int fq) const {
        const int row0 = u.pm * BM + wr * 64 + fr, col0 = u.pn * BM + wc * 32 + 8 * fq;
        const int pn = u.pn;
        const bool prope = LAYER == 0 ? (pn < 10 || (pn >= 12 && pn < 36)) : (pn < 16);
        const bool dnorm = LAYER == 1 && pn >= 24 && pn < 34;
        float rs[2][4][2];
        float gn[8];
        if (dnorm) {
            const int lrow = fr;
#pragma unroll
            for (int ai = 0; ai < 2; ++ai)
#pragma unroll
                for (int m = 0; m < 4; ++m)
#pragma unroll
                    for (int bj = 0; bj < 2; ++bj) { const f32x4 a = acc[ai][bj][m][0], b = acc[ai][bj][m][1];
                        float q = (a[0] * a[0] + a[1] * a[1]) + (a[2] * a[2] + a[3] * a[3]) + (b[0] * b[0] + b[1] * b[1]) + (b[2] * b[2] + b[3] * b[3]);
                        q += __shfl_xor(q, 16); q += __shfl_xor(q, 32);
                        if (fq == 0) xch[((wr * 128 + (ai * 4 + m) * 16 + lrow) * 2 + bj) * 4 + wc] = q; }
            asm volatile("s_waitcnt lgkmcnt(0)" ::: "memory"); __builtin_amdgcn_s_barrier(); asm volatile("" ::: "memory");
#pragma unroll
            for (int ai = 0; ai < 2; ++ai)
#pragma unroll
                for (int m = 0; m < 4; ++m)
#pragma unroll
                    for (int bj = 0; bj < 2; ++bj) { const f32x4 p = *(const PG8_LAS f32x4*)(xch + ((wr * 128 + (ai * 4 + m) * 16 + lrow) * 2 + bj) * 4);
                        rs[ai][m][bj] = 1.0f / sqrtf(((p[0] + p[1]) + (p[2] + p[3])) * (1.0f / 128.0f) + 1e-6f); }
            const float* g = pn < 32 ? gq : gk;
#pragma unroll
            for (int e = 0; e < 8; ++e) { const int p = wc * 32 + 8 * fq + e; const int orig = (p & 64) + ((p & 63) >> 1) + 32 * (p & 1); gn[e] = g[orig]; }
        }
        const bool rot = dnorm || (prope && wc == 0);
#pragma unroll
        for (int ai = 0; ai < 2; ++ai) {
            f32x4 cs[4][2];
            if (rot) {
#pragma unroll
                for (int m = 0; m < 4; ++m) { const int row = row0 + ai * HALF + m * 16;
                    const float* cp = dnorm ? csa + ((size_t)(wc < 2 ? (row >> 6) : (row & 63)) * 32 + 16 * (wc & 1) + 4 * fq) * 2 : cs0 + ((size_t)row * 16 + 4 * fq) * 2;
                    cs[m][0] = *(const GLB f32x4*)cp; cs[m][1] = *(const GLB f32x4*)(cp + 4); }
            }
#pragma unroll
            for (int m = 0; m < 4; ++m) {
                const int row = row0 + ai * HALF + m * 16;
                bf16_t* rowp = O + (size_t)row * ldc + col0;
                f32x4 c0 = (f32x4){1.f, 0.f, 1.f, 0.f}, c1 = c0;
                if (rot) { c0 = cs[m][0]; c1 = cs[m][1]; }
#pragma unroll
                for (int bj = 0; bj < 2; ++bj) { f32x4 v0 = acc[ai][bj][m][0], v1 = acc[ai][bj][m][1];
                    if (dnorm) { const float r = rs[ai][m][bj];
                        v0[0] *= r * gn[0]; v0[1] *= r * gn[1]; v0[2] *= r * gn[2]; v0[3] *= r * gn[3]; v1[0] *= r * gn[4]; v1[1] *= r * gn[5]; v1[2] *= r * gn[6]; v1[3] *= r * gn[7]; }
                    if (rot) {
                        const float a0 = v0[0] * c0[0] - v0[1] * c0[1], b0 = v0[1] * c0[0] + v0[0] * c0[1];
                        const float a1 = v0[2] * c0[2] - v0[3] * c0[3], b1 = v0[3] * c0[2] + v0[2] * c0[3];
                        const float a2 = v1[0] * c1[0] - v1[1] * c1[1], b2 = v1[1] * c1[0] + v1[0] * c1[1];
                        const float a3 = v1[2] * c1[2] - v1[3] * c1[3], b3 = v1[3] * c1[2] + v1[2] * c1[3];
                        v0 = (f32x4){a0, b0, a1, b1}; v1 = (f32x4){a2, b2, a3, b3}; }
                    u32x4 w; w.x = cvt_pk_bf16(v0[0], v0[1]); w.y = cvt_pk_bf16(v0[2], v0[3]); w.z = cvt_pk_bf16(v1[0], v1[1]); w.w = cvt_pk_bf16(v1[2], v1[3]);
                    *(GLB u32x4*)(rowp + bj * HALF) = w; }
            }
            asm volatile("" ::: "memory");
        }
    }
};
}

__device__ __forceinline__ float bf_lo(unsigned w) { return __uint_as_float(w << 16); }
__device__ __forceinline__ float bf_hi(unsigned w) { return __uint_as_float(w & 0xffff0000u); }
__device__ __forceinline__ unsigned cvtpk_bf16(float lo, float hi) { unsigned r; asm volatile("v_cvt_pk_bf16_f32 %0, %1, %2" : "=v"(r) : "v"(lo), "v"(hi)); return r; }

__device__ __forceinline__ void cvt_rows_bf16(const float* __restrict__ src, bf16_t* __restrict__ dst, size_t n8, int bid, int nb, int tid, int nthr) {
    const size_t stride = (size_t)nb * nthr;
    for (size_t i = (size_t)bid * nthr + tid; i < n8; i += 4 * stride) {
        float4 a[4], b[4];
#pragma unroll
        for (int u = 0; u < 4; ++u) { const size_t j = i + u * stride; if (j < n8) { a[u] = *(const float4*)(src + j * 8); b[u] = *(const float4*)(src + j * 8 + 4); } }
#pragma unroll
        for (int u = 0; u < 4; ++u) { const size_t j = i + u * stride; if (j < n8) {
            u32x4v w; w.x = cvtpk_bf16(a[u].x, a[u].y); w.y = cvtpk_bf16(a[u].z, a[u].w); w.z = cvtpk_bf16(b[u].x, b[u].y); w.w = cvtpk_bf16(b[u].z, b[u].w);
            *(u32x4v*)(dst + j * 8) = w; } }
    }
}
template <class PM>
__device__ __forceinline__ void transpose_cvt(const float* __restrict__ W, bf16_t* __restrict__ Wt, int K, int N, LDSA float* tile0, int bid, int nb, PM pm, const int tid) {
    const int lane = tid & 63, wv = tid >> 6;
    LDSA float* tile = tile0 + wv * 4352;
    const int ntk = K / 64, ntn = N / 64;
    for (int t = bid * 8 + wv; t < ntk * ntn; t += nb * 8) {
        const int k0 = (t % ntk) * 64, n0 = (t / ntk) * 64;
        const int c = (lane & 15) * 4, r0 = lane >> 4;
        float4 v[16];
#pragma unroll
        for (int i = 0; i < 16; ++i) v[i] = *(const float4*)(W + (size_t)(k0 + r0 + 4 * i) * N + n0 + c);
#pragma unroll
        for (int i = 0; i < 16; ++i) { const int r = r0 + 4 * i; tile[r * 65 + c] = v[i].x; tile[r * 65 + c + 1] = v[i].y; tile[r * 65 + c + 2] = v[i].z; tile[r * 65 + c + 3] = v[i].w; }
        asm volatile("s_waitcnt lgkmcnt(0)" ::: "memory");
        const int mode = pm(n0);
#pragma unroll
        for (int h = 0; h < 8; ++h) {
            const int n = (lane >> 3) + 8 * h, kc = (lane & 7) * 8;
            int src = n;
            if (mode == 1) { if (n < 32) src = (n >> 1) + 16 * (n & 1); }
            else if (mode == 2) src = (n >> 1) + 32 * (n & 1);
            float f[8];
#pragma unroll
            for (int j = 0; j < 8; ++j) f[j] = tile[(kc + j) * 65 + src];
            u32x4v w; w.x = cvtpk_bf16(f[0], f[1]); w.y = cvtpk_bf16(f[2], f[3]); w.z = cvtpk_bf16(f[4], f[5]); w.w = cvtpk_bf16(f[6], f[7]);
            *(u32x4v*)(Wt + (size_t)(n0 + n) * K + k0 + kc) = w;
        }
        asm volatile("s_waitcnt lgkmcnt(0)" ::: "memory");
    }
}
struct PermNone { __device__ __forceinline__ int operator()(int) const { return 0; } };
struct PermAB { __device__ __forceinline__ int operator()(int n0) const { const bool rope = n0 < 2560 || (n0 >= 3072 && n0 < 9216); return (rope && (n0 & 127) == 0) ? 1 : 0; } };
struct PermCD { __device__ __forceinline__ int operator()(int n0) const { if (n0 < 4096) return (n0 & 127) == 0 ? 1 : 0; if (n0 >= 6144 && n0 < 8704) return 2; return 0; } };
__device__ __forceinline__ void rope_tables(float* __restrict__ cs0, float* __restrict__ csa, const int bid, const int G, const int tid) {
    for (int i = bid * 512 + tid; i < SEQ * 16; i += G * 512) { float s, c; sincos_rev((double)(i >> 4) * REV_P[i & 15], s, c); *(float2*)(cs0 + (size_t)i * 2) = make_float2(c, s); }
    for (int i = bid * 512 + tid; i < 128 * 32; i += G * 512) { float s, c; sincos_rev((double)(i >> 5) * REV_A[i & 31], s, c); *(float2*)(csa + (size_t)i * 2) = make_float2(c, s); }
}


typedef unsigned v6u_t __attribute__((ext_vector_type(6)));
typedef float f4v_t __attribute__((ext_vector_type(4)));
typedef unsigned v16u_t __attribute__((ext_vector_type(16)));
typedef float v16f_t __attribute__((ext_vector_type(16)));
typedef float v32f_t __attribute__((ext_vector_type(32)));
typedef __bf16 v32b_t __attribute__((ext_vector_type(32)));
constexpr int ROWB = 3072;
constexpr int XT_STRIDE = 68;
constexpr int XT_BYTES = 64 * XT_STRIDE * 4;
__device__ __forceinline__ void table_fp6(const float* __restrict__ src, unsigned char* __restrict__ dst, float* __restrict__ inv, const int rows, LDSA float* xt0, const int bid, const int G, const int tid) {
    const int lane = tid & 63, wv = tid >> 6;
    LDSA float* xt = xt0 + wv * (XT_BYTES / 4);
    for (int r = bid * 8 + wv; r < rows; r += G * 8) {
        float4 v[16]; float am = 0.f;
#pragma unroll
        for (int j = 0; j < 16; ++j) { v[j] = *(const float4*)(src + (size_t)r * DM + j * 256 + lane * 4); am = fmaxf(am, fmaxf(fmaxf(fabsf(v[j].x), fabsf(v[j].y)), fmaxf(fabsf(v[j].z), fabsf(v[j].w)))); }
        am = wave_max(am);
        const float sc = am > 0.f ? 7.0f / am : 1.0f;
#pragma unroll
        for (int j = 0; j < 16; ++j) *(LDSA f4v_t*)(xt + (4 * j + (lane >> 4)) * XT_STRIDE + 4 * (lane & 15)) = (f4v_t){v[j].x * sc, v[j].y * sc, v[j].z * sc, v[j].w * sc};
        asm volatile("s_waitcnt lgkmcnt(0)" ::: "memory");
        v16f_t f0, f1, f2, f3;
#pragma unroll
        for (int k = 0; k < 8; ++k) { const f4v_t a = *(const LDSA f4v_t*)(xt + lane * XT_STRIDE + 4 * k), c = *(const LDSA f4v_t*)(xt + lane * XT_STRIDE + 32 + 4 * k);
            f0[2 * k] = a[0]; f1[2 * k] = a[1]; f0[2 * k + 1] = a[2]; f1[2 * k + 1] = a[3];
            f2[2 * k] = c[0]; f3[2 * k] = c[1]; f2[2 * k + 1] = c[2]; f3[2 * k + 1] = c[3]; }
        asm volatile("s_waitcnt lgkmcnt(0)" ::: "memory");
        const v6u_t w0 = __builtin_amdgcn_cvt_scalef32_2xpk16_fp6_f32(f0, f1, 1.0f), w1 = __builtin_amdgcn_cvt_scalef32_2xpk16_fp6_f32(f2, f3, 1.0f);
        unsigned char* dp = dst + (size_t)r * ROWB + lane * 48;
        u32x4v s0, s1, s2; s0.x = w0[0]; s0.y = w0[1]; s0.z = w0[2]; s0.w = w0[3]; s1.x = w0[4]; s1.y = w0[5]; s1.z = w1[0]; s1.w = w1[1]; s2.x = w1[2]; s2.y = w1[3]; s2.z = w1[4]; s2.w = w1[5];
        *(u32x4v*)dp = s0; *(u32x4v*)(dp + 16) = s1; *(u32x4v*)(dp + 32) = s2;
        if (lane == 0) inv[r] = am > 0.f ? am * (1.0f / 7.0f) : 1.0f;
    }
}

typedef __bf16 bf2_t __attribute__((ext_vector_type(2)));
__device__ __forceinline__ float dot2_bf16(unsigned a, unsigned b, float c) { return __builtin_amdgcn_fdot2_f32_bf16(__builtin_bit_cast(bf2_t, a), __builtin_bit_cast(bf2_t, b), c, false); }
__device__ __forceinline__ float gelu_tanh_f(float x) {
    const float z = 0.7978845608028654f * (x + 0.044715f * x * x * x);
    const float e = __expf(2.0f * z);
    return 0.5f * x * (2.0f - 2.0f / (e + 1.0f));
}
__device__ __forceinline__ int pick_i(int a0, int a1, int k) { return k < 64 ? __builtin_amdgcn_readlane(a0, k) : __builtin_amdgcn_readlane(a1, k - 64); }
__device__ __forceinline__ float pick_f(float a0, float a1, int k) { return __int_as_float(pick_i(__float_as_int(a0), __float_as_int(a1), k)); }
typedef const __attribute__((address_space(1))) u32x4v* gu32x4p;
#define PE_LOADROW(dst, base, e) do { const unsigned char* _p = (base) + (size_t)(e) * ROWB + lane * 48; dst[0] = *(gu32x4p)_p; dst[1] = *(gu32x4p)(_p + 16); dst[2] = *(gu32x4p)(_p + 32); } while (0)
__device__ __forceinline__ float pe_dot(const u32x4v (&r)[3], const u32x4v (&x)[8]) {
    float d0 = 0.f, d1 = 0.f, d2 = 0.f, d3 = 0.f;
    { const v6u_t g = {r[0].x, r[0].y, r[0].z, r[0].w, r[1].x, r[1].y};
      const v16u_t z = __builtin_bit_cast(v16u_t, __builtin_amdgcn_cvt_scalef32_pk32_bf16_fp6(g, 1.0f));
#pragma unroll
      for (int k = 0; k < 4; ++k) { const unsigned xa = x[k].x, xb = x[k].y, xc = x[k].z, xd = x[k].w; const unsigned za = z[4 * k], zb = z[4 * k + 1], zc = z[4 * k + 2], zd = z[4 * k + 3];
          d0 = dot2_bf16(za, xa, d0); d1 = dot2_bf16(zb, xb, d1); d2 = dot2_bf16(zc, xc, d2); d3 = dot2_bf16(zd, xd, d3); }
      asm volatile("" : "+v"(d0), "+v"(d1), "+v"(d2), "+v"(d3)); }
    { const v6u_t g = {r[1].z, r[1].w, r[2].x, r[2].y, r[2].z, r[2].w};
      const v16u_t z = __builtin_bit_cast(v16u_t, __builtin_amdgcn_cvt_scalef32_pk32_bf16_fp6(g, 1.0f));
#pragma unroll
      for (int k = 0; k < 4; ++k) { const unsigned xa = x[4 + k].x, xb = x[4 + k].y, xc = x[4 + k].z, xd = x[4 + k].w; const unsigned za = z[4 * k], zb = z[4 * k + 1], zc = z[4 * k + 2], zd = z[4 * k + 3];
          d0 = dot2_bf16(za, xa, d0); d1 = dot2_bf16(zb, xb, d1); d2 = dot2_bf16(zc, xc, d2); d3 = dot2_bf16(zd, xd, d3); } }
    return wave_sum((d0 + d1) + (d2 + d3));
}
#define PE_PIN16(a, b) asm volatile("" : "+v"(a[b + 0]), "+v"(a[b + 1]), "+v"(a[b + 2]), "+v"(a[b + 3]), "+v"(a[b + 4]), "+v"(a[b + 5]), "+v"(a[b + 6]), "+v"(a[b + 7]), \
                                         "+v"(a[b + 8]), "+v"(a[b + 9]), "+v"(a[b + 10]), "+v"(a[b + 11]), "+v"(a[b + 12]), "+v"(a[b + 13]), "+v"(a[b + 14]), "+v"(a[b + 15]))
__device__ __forceinline__ void pe_axpy(float (&acc)[64], const u32x4v (&r)[3], const float w) {
    { const v6u_t g = {r[0].x, r[0].y, r[0].z, r[0].w, r[1].x, r[1].y};
      const v32f_t y = __builtin_amdgcn_cvt_scalef32_pk32_f32_fp6(g, 1.0f);
#pragma unroll
      for (int i = 0; i < 32; ++i) acc[i] = fmaf(w, y[i], acc[i]);
      PE_PIN16(acc, 0); PE_PIN16(acc, 16); }
    { const v6u_t g = {r[1].z, r[1].w, r[2].x, r[2].y, r[2].z, r[2].w};
      const v32f_t y = __builtin_amdgcn_cvt_scalef32_pk32_f32_fp6(g, 1.0f);
#pragma unroll
      for (int i = 0; i < 32; ++i) acc[32 + i] = fmaf(w, y[i], acc[32 + i]);
      PE_PIN16(acc, 32); PE_PIN16(acc, 48); }
}
__device__ __forceinline__ void wave_sort128(unsigned& a0, unsigned& a1, const int lane) {
#pragma unroll
    for (int k = 2; k <= 128; k <<= 1) {
#pragma unroll
        for (int j = k >> 1; j > 0; j >>= 1) {
            if (j == 64) { const unsigned lo = a0 < a1 ? a0 : a1, hi = a0 < a1 ? a1 : a0; a0 = lo; a1 = hi; }
            else {
                const unsigned o0 = (unsigned)__shfl_xor((int)a0, j), o1 = (unsigned)__shfl_xor((int)a1, j);
                const bool lowhalf = (lane & j) == 0;
                const bool up0 = k >= 128 ? true : ((lane & k) == 0);
                const bool up1 = k >= 128 ? true : (k == 64 ? false : ((lane & k) == 0));
                const bool min0 = lowhalf == up0, min1 = lowhalf == up1;
                const unsigned mn0 = a0 < o0 ? a0 : o0, mx0 = a0 < o0 ? o0 : a0, mn1 = a1 < o1 ? a1 : o1, mx1 = a1 < o1 ? o1 : a1;
                a0 = min0 ? mn0 : mx0; a1 = min1 ? mn1 : mx1;
            }
        }
    }
}
__device__ __forceinline__ void peer_expert_phase(const float* __restrict__ ypre, const float* __restrict__ stats, const float* __restrict__ gm, const float* __restrict__ bm, const bf16_t* __restrict__ x1b, int* __restrict__ eidx, float* __restrict__ gate,
                                                  const unsigned char* __restrict__ ub, const unsigned char* __restrict__ vb, const float* __restrict__ isu, const float* __restrict__ isv,
                                                  const float* __restrict__ lg, const float* __restrict__ lb, float* __restrict__ out, bf16_t* __restrict__ outb, LDSA float* xt0, const int bid, const int G, const int tid) {
    const int wv = __builtin_amdgcn_readfirstlane(tid >> 6);
    LDSA float* xt = xt0 + wv * (XT_BYTES / 4);
#define PE_POS(k) (rev ? 127 - (k) : (k))
#define PE_E(k) pick_i(e0, e1, PE_POS(k))
    int jt = 0;
    for (int t = bid * 8 + wv; t < SEQ; t += G * 8, ++jt) {
        int tl = tid; asm volatile("" : "+v"(tl));
        const int lane = tl & 63;
        const bool rev = (jt & 1) != 0;
        int e0, e1; float g0, g1;
        { const int r0 = eidx[(size_t)t * 128 + lane], r1 = eidx[(size_t)t * 128 + 64 + lane];
          const float h0 = gate[(size_t)t * 128 + lane], h1 = gate[(size_t)t * 128 + 64 + lane];
          unsigned a0 = ((unsigned)r0 << 7) | (unsigned)lane, a1 = ((unsigned)r1 << 7) | (unsigned)(64 + lane);
          wave_sort128(a0, a1, lane);
          e0 = (int)(a0 >> 7); e1 = (int)(a1 >> 7);
          const int k0 = (int)(a0 & 127u), k1 = (int)(a1 & 127u);
          const float p00 = __shfl(h0, k0 & 63), p01 = __shfl(h1, k0 & 63), p10 = __shfl(h0, k1 & 63), p11 = __shfl(h1, k1 & 63);
          g0 = k0 < 64 ? p00 : p01; g1 = k1 < 64 ? p10 : p11; }
        const float iu0 = isu[e0], iu1 = isu[e1], iv0 = isv[e0], iv1 = isv[e1];
        u32x4v xq[8];
#pragma unroll
        for (int k = 0; k < 8; ++k) xq[k] = *(const u32x4v*)(x1b + (size_t)t * DM + lane * 64 + k * 8);
        float w0 = 0.f, w1 = 0.f;
        u32x4v R0[3], R1[3], R2[3], R3[3], R4[3];
#define PE_USTEP(R, k) do { const int kk = PE_POS(k); const float d = pe_dot(R, xq) * pick_f(iu0, iu1, kk); const float w = pick_f(g0, g1, kk) * gelu_tanh_f(d) * pick_f(iv0, iv1, kk); \
            if (lane == (kk & 63)) { if (kk < 64) w0 = w; else w1 = w; } } while (0)
        PE_LOADROW(R0, ub, PE_E(0)); PE_LOADROW(R1, ub, PE_E(1)); PE_LOADROW(R2, ub, PE_E(2)); PE_LOADROW(R3, ub, PE_E(3));
        for (int k = 0; k < 125; k += 5) {
            if (k + 4 < 128) PE_LOADROW(R4, ub, PE_E(k + 4)); PE_USTEP(R0, k);
            if (k + 5 < 128) PE_LOADROW(R0, ub, PE_E(k + 5)); PE_USTEP(R1, k + 1);
            if (k + 6 < 128) PE_LOADROW(R1, ub, PE_E(k + 6)); PE_USTEP(R2, k + 2);
            if (k + 7 < 128) PE_LOADROW(R2, ub, PE_E(k + 7)); PE_USTEP(R3, k + 3);
            if (k + 8 < 128) PE_LOADROW(R3, ub, PE_E(k + 8)); PE_USTEP(R4, k + 4);
        }
        PE_USTEP(R0, 125); PE_USTEP(R1, 126); PE_USTEP(R2, 127);
#undef PE_USTEP
        eidx[(size_t)t * 128 + lane] = e0; eidx[(size_t)t * 128 + 64 + lane] = e1;
        gate[(size_t)t * 128 + lane] = w0; gate[(size_t)t * 128 + 64 + lane] = w1;
    }
    asm volatile("s_waitcnt vmcnt(0)" ::: "memory");
    for (int t = bid * 8 + wv; t < SEQ; t += G * 8, ++jt) {
        int tl = tid; asm volatile("" : "+v"(tl));
        const int lane = tl & 63;
        const bool rev = (jt & 1) != 0;
        const int e0 = __builtin_nontemporal_load(eidx + (size_t)t * 128 + lane), e1 = __builtin_nontemporal_load(eidx + (size_t)t * 128 + 64 + lane);
        const float w0 = __builtin_nontemporal_load(gate + (size_t)t * 128 + lane), w1 = __builtin_nontemporal_load(gate + (size_t)t * 128 + 64 + lane);
        u32x4v R0[3], R1[3], R2[3], R3[3], R4[3];
        float acc[64];
#pragma unroll
        for (int i = 0; i < 64; ++i) acc[i] = 0.f;
        PE_LOADROW(R0, vb, PE_E(0)); PE_LOADROW(R1, vb, PE_E(1)); PE_LOADROW(R2, vb, PE_E(2)); PE_LOADROW(R3, vb, PE_E(3));
        for (int k = 0; k < 125; k += 5) {
            if (k + 4 < 128) PE_LOADROW(R4, vb, PE_E(k + 4)); pe_axpy(acc, R0, pick_f(w0, w1, PE_POS(k)));
            if (k + 5 < 128) PE_LOADROW(R0, vb, PE_E(k + 5)); pe_axpy(acc, R1, pick_f(w0, w1, PE_POS(k + 1)));
            if (k + 6 < 128) PE_LOADROW(R1, vb, PE_E(k + 6)); pe_axpy(acc, R2, pick_f(w0, w1, PE_POS(k + 2)));
            if (k + 7 < 128) PE_LOADROW(R2, vb, PE_E(k + 7)); pe_axpy(acc, R3, pick_f(w0, w1, PE_POS(k + 3)));
            if (k + 8 < 128) PE_LOADROW(R3, vb, PE_E(k + 8)); pe_axpy(acc, R4, pick_f(w0, w1, PE_POS(k + 4)));
        }
        pe_axpy(acc, R0, pick_f(w0, w1, PE_POS(125))); pe_axpy(acc, R1, pick_f(w0, w1, PE_POS(126))); pe_axpy(acc, R2, pick_f(w0, w1, PE_POS(127)));
#pragma unroll
        for (int k = 0; k < 16; ++k) *(LDSA f4v_t*)(xt + lane * XT_STRIDE + 4 * k) = (f4v_t){acc[4 * k], acc[4 * k + 1], acc[4 * k + 2], acc[4 * k + 3]};
        asm volatile("s_waitcnt lgkmcnt(0)" ::: "memory");
        float4 y[16]; float s = 0.f; const float2 st = *(const float2*)(stats + (size_t)t * 2);
#pragma unroll
        for (int j = 0; j < 16; ++j) { const f4v_t f = *(const LDSA f4v_t*)(xt + (4 * j + (lane >> 4)) * XT_STRIDE + 4 * (lane & 15));
            const float4 yv = *(const float4*)(ypre + (size_t)t * DM + j * 256 + lane * 4), gv = *(const float4*)(gm + j * 256 + lane * 4), bv = *(const float4*)(bm + j * 256 + lane * 4);
            float4 xv;
            xv.x = (yv.x - st.x) * st.y * gv.x + bv.x; xv.y = (yv.y - st.x) * st.y * gv.y + bv.y; xv.z = (yv.z - st.x) * st.y * gv.z + bv.z; xv.w = (yv.w - st.x) * st.y * gv.w + bv.w;
            y[j].x = fmaf(ALPHA, xv.x, f.x); y[j].y = fmaf(ALPHA, xv.y, f.y); y[j].z = fmaf(ALPHA, xv.z, f.z); y[j].w = fmaf(ALPHA, xv.w, f.w);
            s += (y[j].x + y[j].y) + (y[j].z + y[j].w);
            if (j & 1) asm volatile("" ::: "memory"); }
        asm volatile("s_waitcnt lgkmcnt(0)" ::: "memory");
        const float mean = wave_sum(s) * (1.0f / DM);
        float qq = 0.f;
#pragma unroll
        for (int j = 0; j < 16; ++j) { const float a = y[j].x - mean, b = y[j].y - mean, c = y[j].z - mean, d = y[j].w - mean; qq += (a * a + b * b) + (c * c + d * d); }
        const float rstd = 1.0f / sqrtf(wave_sum(qq) * (1.0f / DM) + 1e-5f);
#pragma unroll
        for (int j = 0; j < 16; ++j) {
            const int c = j * 256 + lane * 4;
            const float4 ga = *(const float4*)(lg + c), ba = *(const float4*)(lb + c);
            float4 oa; oa.x = (y[j].x - mean) * rstd * ga.x + ba.x; oa.y = (y[j].y - mean) * rstd * ga.y + ba.y; oa.z = (y[j].z - mean) * rstd * ga.z + ba.z; oa.w = (y[j].w - mean) * rstd * ga.w + ba.w;
            *(float4*)(out + (size_t)t * DM + c) = oa;
            if (outb) { uint2 w; w.x = cvtpk_bf16(oa.x, oa.y); w.y = cvtpk_bf16(oa.z, oa.w); *(uint2*)(outb + (size_t)t * DM + c) = w; }
            if ((j & 3) == 3) asm volatile("" ::: "memory");
        }
    }
#undef PE_E
#undef PE_POS
}

__device__ __forceinline__ void attn1_phase(const bf16_t* __restrict__ hb, bf16_t* __restrict__ abb, float* __restrict__ oc, const float* __restrict__ lq1, const float* __restrict__ lk1, const float* __restrict__ lq2,
                                            const float* __restrict__ lk2, const float* __restrict__ subg, char* lds, const int bid, const int G, const int tid) {
    for (int u = bid; u < 512; u += G) {
        __syncthreads();
        const int kv = u >> 7, g = (u >> 5) & 3, qb = u & 31, hq = kv * 4 + g;
        att::attn_wide_body<9216, 9216, 4096, 1, att::bf16>(hb + (size_t)(qb * 256) * 9216 + 6144 + hq * 128, hb + 8192 + kv * 128, hb + 8704 + kv * 128,
                                                             abb + (size_t)(qb * 256) * 4096 + 2048 + hq * 128, SEQ, lds, tid);
    }
    int tid2 = tid; asm volatile("" : "+v"(tid2));
    const int lane_c = tid2 & 63;
    const float lam = __int_as_float(__builtin_amdgcn_readfirstlane(__float_as_int(__expf(wave_sum(lq1[lane_c] * lk1[lane_c] + lq1[lane_c + 64] * lk1[lane_c + 64])) - __expf(wave_sum(lq2[lane_c] * lk2[lane_c] + lq2[lane_c + 64] * lk2[lane_c + 64])) + LAMBDA_INIT)));
    for (int v = bid; v < 256; v += G) {
        __syncthreads();
        const int h = v >> 5, qb = v & 31;
        float* o1 = oc + (size_t)(qb * 256) * 2048 + h * 256;
        int tid4 = tid2; asm volatile("" : "+v"(tid4));
        att::attn_wide_body<9216, 9216, 2048, 2, float>(hb + (size_t)(qb * 256) * 9216 + h * 256, hb + 2048 + h * 256, hb + 4096 + h * 256, o1, SEQ, lds, tid4);
        __syncthreads();
        int tid3 = tid2; asm volatile("" : "+v"(tid3));
        att::attn_wide_body<9216, 9216, 2048, 2, float, true, 4096>(hb + (size_t)(qb * 256) * 9216 + h * 256 + 128, hb + 2048 + h * 256 + 128, hb + 4096 + h * 256, o1, SEQ, lds, tid3,
                                                                     lam, 1.0f - LAMBDA_INIT, subg, abb + (size_t)(qb * 256) * 4096 + h * 256);
    }
}


__device__ __forceinline__ void attn0_phase(const bf16_t* __restrict__ hb, const float* __restrict__ sink, bf16_t* __restrict__ abb, bf16_t* __restrict__ obg, float* __restrict__ lse, char* lds, const int bid, const int G, const int tid) {
    const long LD = 12288;
    for (int u = bid; u < 512; u += G) {
        __syncthreads();
        const int hq = u >> 5, qb = u & 31, kv = hq >> 2;
        att::attn_banded_body<128>(hb + hq * 128, hb + 2048 + kv * 128, hb + 2560 + kv * 128, LD, SEQ, qb * 256, sink[hq] * (1.0f / att::SCALE), 1.0f, abb + hq * 128, 3072, nullptr, 0, lds, tid);
    }
    int tid2 = tid; asm volatile("" : "+v"(tid2));
    for (int v = bid; v < 768; v += G) {
        __syncthreads();
        const int g = v >> 8, w = v & 255, h = w >> 5, rem = w & 31;
        const int dsh = 2 * g;
        const int nqb_sh = 5 - dsh;
        const int r = rem >> nqb_sh, qb = rem & ((1 << nqb_sh) - 1);
        const int head = 8 * g + h;
        const long rs = LD << dsh;
        att::attn_banded_body<64>(hb + (long)r * LD + 3072 + head * 128, hb + (long)r * LD + 6144 + head * 128, hb + (long)r * LD + 9216 + head * 128, rs, SEQ >> dsh, qb * 256, -1e30f, 0.f,
                                  obg + ((long)(g * 8 + h) * SEQ + r) * 128, (long)128 << dsh, lse + (long)(g * 8 + h) * SEQ + r, (long)1 << dsh, lds, tid2);
    }
}
__device__ __forceinline__ void merge0_phase(const bf16_t* __restrict__ obg, const float* __restrict__ lse, bf16_t* __restrict__ abb, const int bid, const int G, const int tid) {
    const int lane = tid & 63, wv = tid >> 6;
    for (int j = bid * 8 + wv; j < SEQ * 8; j += G * 8) {
        const int h = j >> 13, t = j & (SEQ - 1);
        const float l0 = lse[(size_t)(0 * 8 + h) * SEQ + t], l1 = lse[(size_t)(1 * 8 + h) * SEQ + t], l2 = lse[(size_t)(2 * 8 + h) * SEQ + t];
        const float mx = fmaxf(l0, fmaxf(l1, l2));
        const float e0 = __expf(l0 - mx), e1 = __expf(l1 - mx), e2 = __expf(l2 - mx), inv = 1.0f / (e0 + e1 + e2);
        const unsigned a0 = *(const unsigned*)(obg + ((size_t)(0 * 8 + h) * SEQ + t) * 128 + 2 * lane), a1 = *(const unsigned*)(obg + ((size_t)(1 * 8 + h) * SEQ + t) * 128 + 2 * lane), a2 = *(const unsigned*)(obg + ((size_t)(2 * 8 + h) * SEQ + t) * 128 + 2 * lane);
        const float x = (e0 * bf_lo(a0) + e1 * bf_lo(a1) + e2 * bf_lo(a2)) * inv, y = (e0 * bf_hi(a0) + e1 * bf_hi(a1) + e2 * bf_hi(a2)) * inv;
        *(unsigned*)(abb + (size_t)t * 3072 + 2048 + h * 128 + 2 * lane) = cvtpk_bf16(x, y);
    }
}

__device__ __forceinline__ void post_even_phase(const float* __restrict__ h, bf16_t* __restrict__ hb, const int bid, const int G, const int tid) {
    const int lane = tid & 63, wv = tid >> 6;
    for (int job = bid * 8 + wv; job < SEQ * 96; job += G * 8) {
        const int t = job / 96, blk = job - t * 96;
        const bool rope = (blk < 20) || (blk >= 24 && blk < 72);
        const float2 v = *(const float2*)(h + (size_t)t * 12288 + blk * 128 + 2 * lane);
        float o0 = v.x, o1 = v.y;
        const float p0 = __shfl_xor(v.x, 8), p1 = __shfl_xor(v.y, 8);
        if (rope && lane < 16) {
            const int i0 = (2 * lane) & 15;
            float s0, c0, s1, c1; sincos_rev((double)t * REV_P[i0], s0, c0); sincos_rev((double)t * REV_P[i0 + 1], s1, c1);
            if (lane < 8) { o0 = v.x * c0 - p0 * s0; o1 = v.y * c1 - p1 * s1; }
            else          { o0 = v.x * c0 + p0 * s0; o1 = v.y * c1 + p1 * s1; }
        }
        *(unsigned*)(hb + (size_t)t * 12288 + blk * 128 + 2 * lane) = cvtpk_bf16(o0, o1);
    }
}
__device__ __forceinline__ void post_odd_phase(const float* __restrict__ h, bf16_t* __restrict__ hb, const float* __restrict__ qg, const float* __restrict__ kg, const int bid, const int G, const int tid) {
    const int lane = tid & 63, wv = tid >> 6;
    for (int job = bid * 8 + wv; job < SEQ * 72; job += G * 8) {
        const int t = job / 72, blk = job - t * 72;
        const float2 v = *(const float2*)(h + (size_t)t * 9216 + blk * 128 + 2 * lane);
        float o0 = v.x, o1 = v.y;
        if (blk < 32) {
            const float p0 = __shfl_xor(v.x, 8), p1 = __shfl_xor(v.y, 8);
            if (lane < 16) {
                const int i0 = (2 * lane) & 15;
                float s0, c0, s1, c1; sincos_rev((double)t * REV_P[i0], s0, c0); sincos_rev((double)t * REV_P[i0 + 1], s1, c1);
                if (lane < 8) { o0 = v.x * c0 - p0 * s0; o1 = v.y * c1 - p1 * s1; }
                else          { o0 = v.x * c0 + p0 * s0; o1 = v.y * c1 + p1 * s1; }
            }
        } else if (blk >= 48 && blk < 68) {
            const float* g = blk < 64 ? qg : kg;
            const float ss = wave_sum(v.x * v.x + v.y * v.y) * (1.0f / 128.0f);
            const float rs = 1.0f / sqrtf(ss + 1e-6f);
            const float a0 = v.x * rs * g[2 * lane], a1 = v.y * rs * g[2 * lane + 1];
            const float p0 = __shfl_xor(a0, 16), p1 = __shfl_xor(a1, 16);
            const int i0 = (2 * lane) & 31;
            const double pos = (double)(lane < 32 ? (t >> 6) : (t & 63));
            float s0, c0, s1, c1; sincos_rev(pos * REV_A[i0], s0, c0); sincos_rev(pos * REV_A[i0 + 1], s1, c1);
            if ((lane & 16) == 0) { o0 = a0 * c0 - p0 * s0; o1 = a1 * c1 - p1 * s1; }
            else                  { o0 = a0 * c0 + p0 * s0; o1 = a1 * c1 + p1 * s1; }
        }
        *(unsigned*)(hb + (size_t)t * 9216 + blk * 128 + 2 * lane) = cvtpk_bf16(o0, o1);
    }
}

__device__ __forceinline__ void attn_seg_b(const float q0, const float q1, const bf16_t* __restrict__ Kb, const bf16_t* __restrict__ Vb, const int ld,
                                           const int t, const int step, int jlo, int jhi, float& m, float& l, float& o0, float& o1, const int lane) {
    { const int lo = -(t / step); if (jlo < lo) jlo = lo; const int hi = (SEQ - 1 - t) / step; if (jhi > hi) jhi = hi; }
    for (int j = jlo; j <= jhi; ++j) {
        const size_t tp = (size_t)(t + step * j);
        const unsigned kw = *(const unsigned*)(Kb + tp * ld + 2 * lane), vw = *(const unsigned*)(Vb + tp * ld + 2 * lane);
        const float s = wave_sum(q0 * bf_lo(kw) + q1 * bf_hi(kw)) * ATT_SCALE;
        const float mn = fmaxf(m, s);
        const float al = __expf(m - mn), p = __expf(s - mn);
        l = l * al + p;
        o0 = o0 * al + p * bf_lo(vw); o1 = o1 * al + p * bf_hi(vw);
        m = mn;
    }
}
__device__ __forceinline__ void attn_even_valu_phase(const bf16_t* __restrict__ hb, const float* __restrict__ sink, bf16_t* __restrict__ abb, const int bid, const int G, const int tid) {
    const int lane = tid & 63, wv = tid >> 6;
    const int LD = 12288;
    for (int job = bid * 8 + wv; job < SEQ * 24; job += G * 8) {
        const int hh = job / SEQ, t = job % SEQ;
        float o0 = 0.f, o1 = 0.f, m, l;
        if (hh < 16) {
            const int kv = hh >> 2;
            const unsigned qw = *(const unsigned*)(hb + (size_t)t * LD + hh * 128 + 2 * lane);
            m = sink[hh]; l = 1.f;
            attn_seg_b(bf_lo(qw), bf_hi(qw), hb + 2048 + kv * 128, hb + 2560 + kv * 128, LD, t, 1, -128, 128, m, l, o0, o1, lane);
        } else {
            const int hbh = hh - 16;
            m = -1e30f; l = 0.f;
#pragma unroll
            for (int g = 0; g < 3; ++g) {
                const int head = 8 * g + hbh; const int step = g == 0 ? 1 : (g == 1 ? 4 : 16);
                const unsigned qw = *(const unsigned*)(hb + (size_t)t * LD + 3072 + head * 128 + 2 * lane);
                attn_seg_b(bf_lo(qw), bf_hi(qw), hb + 6144 + head * 128, hb + 9216 + head * 128, LD, t, step, -64, 64, m, l, o0, o1, lane);
            }
        }
        const float il = 1.0f / l;
        *(unsigned*)(abb + (size_t)t * 3072 + hh * 128 + 2 * lane) = cvtpk_bf16(o0 * il, o1 * il);
    }
}

__device__ __forceinline__ void ln_phase(const float* __restrict__ y, const float* __restrict__ g, const float* __restrict__ b, float* __restrict__ stats, bf16_t* __restrict__ outb, const int bid, const int G, const int tid) {
    const int lane = tid & 63, wv = tid >> 6;
    for (int t = bid * 8 + wv; t < SEQ; t += G * 8) {
        float4 v[16]; float s = 0.f;
#pragma unroll
        for (int i = 0; i < 16; ++i) { v[i] = *(const float4*)(y + (size_t)t * DM + i * 256 + lane * 4); s += (v[i].x + v[i].y) + (v[i].z + v[i].w); }
        const float mean = wave_sum(s) * (1.0f / DM);
        float q = 0.f;
#pragma unroll
        for (int i = 0; i < 16; ++i) { const float a = v[i].x - mean, bb = v[i].y - mean, c = v[i].z - mean, d = v[i].w - mean; q += (a * a + bb * bb) + (c * c + d * d); }
        const float rstd = 1.0f / sqrtf(wave_sum(q) * (1.0f / DM) + 1e-5f);
        if (lane == 0) *(float2*)(stats + (size_t)t * 2) = make_float2(mean, rstd);
#pragma unroll
        for (int i = 0; i < 16; ++i) {
            const float4 gg = *(const float4*)(g + i * 256 + lane * 4), bb = *(const float4*)(b + i * 256 + lane * 4);
            float4 o; o.x = (v[i].x - mean) * rstd * gg.x + bb.x; o.y = (v[i].y - mean) * rstd * gg.y + bb.y; o.z = (v[i].z - mean) * rstd * gg.z + bb.z; o.w = (v[i].w - mean) * rstd * gg.w + bb.w;
            uint2 w; w.x = cvtpk_bf16(o.x, o.y); w.y = cvtpk_bf16(o.z, o.w); *(uint2*)(outb + (size_t)t * DM + i * 256 + lane * 4) = w;
            if ((i & 3) == 3) asm volatile("" ::: "memory");
        }
    }
}

__device__ __forceinline__ void route_valu_phase(const float* __restrict__ q  , const float* __restrict__ keys  , int* __restrict__ eidx, float* __restrict__ gate, const int bid, const int G, const int tid) {
    const int lane = tid & 63, wv = tid >> 6;
    for (int job = bid * 8 + wv; job < SEQ * 8; job += G * 8) {
        const int hh = job & 7, t = job >> 3;
        float sv0 = 0.f, sv1 = 0.f; int si0 = 0, si1 = 0;
#pragma unroll
        for (int c = 0; c < 2; ++c) {
            const float* qq = q + (size_t)t * 2048 + hh * 256 + c * 128;
            const float* k0 = keys + ((size_t)(hh * 2 + c) * 128 + lane) * 128;
            const float* k1 = k0 + 64 * 128;
            float s0 = 0.f, s1 = 0.f;
            for (int d = 0; d < 128; d += 4) {
                const float4 qv = *(const float4*)(qq + d), a = *(const float4*)(k0 + d), b = *(const float4*)(k1 + d);
                s0 += qv.x * a.x + qv.y * a.y + qv.z * a.z + qv.w * a.w;
                s1 += qv.x * b.x + qv.y * b.y + qv.z * b.z + qv.w * b.w;
            }
            float myv = 0.f; int myi = 0;
            for (int k = 0; k < 16; ++k) {
                float bv; int bi;
                if (s1 > s0) { bv = s1; bi = lane + 64; } else { bv = s0; bi = lane; }
#pragma unroll
                for (int o = 32; o >= 1; o >>= 1) {
                    const float ov = __shfl_xor(bv, o); const int oi = __shfl_xor(bi, o);
                    if (ov > bv || (ov == bv && oi < bi)) { bv = ov; bi = oi; }
                }
                if (lane == k) { myv = bv; myi = bi; }
                if (bi == lane) s0 = -3.0e38f;
                if (bi == lane + 64) s1 = -3.0e38f;
            }
            if (c == 0) { sv0 = myv; si0 = myi; } else { sv1 = myv; si1 = myi; }
        }
        float cv0, cv1, cv2, cv3; int ci0, ci1, ci2, ci3;
        { const float a = __shfl(sv0, lane >> 2); const int ai = __shfl(si0, lane >> 2); const int jb = (lane & 3) * 4;
          cv0 = a + __shfl(sv1, jb + 0); ci0 = ai * 128 + __shfl(si1, jb + 0);
          cv1 = a + __shfl(sv1, jb + 1); ci1 = ai * 128 + __shfl(si1, jb + 1);
          cv2 = a + __shfl(sv1, jb + 2); ci2 = ai * 128 + __shfl(si1, jb + 2);
          cv3 = a + __shfl(sv1, jb + 3); ci3 = ai * 128 + __shfl(si1, jb + 3); }
        float tv = 0.f; int te = 0;
        for (int k = 0; k < 16; ++k) {
            float bv = cv0; int bp = lane * 4, be = ci0;
            if (cv1 > bv) { bv = cv1; bp = lane * 4 + 1; be = ci1; }
            if (cv2 > bv) { bv = cv2; bp = lane * 4 + 2; be = ci2; }
            if (cv3 > bv) { bv = cv3; bp = lane * 4 + 3; be = ci3; }
#pragma unroll
            for (int o = 32; o >= 1; o >>= 1) {
                const float ov = __shfl_xor(bv, o); const int op = __shfl_xor(bp, o); const int oe = __shfl_xor(be, o);
                if (ov > bv || (ov == bv && op < bp)) { bv = ov; bp = op; be = oe; }
            }
            if (lane == k) { tv = bv; te = be; }
            if (bp == lane * 4 + 0) cv0 = -3.0e38f;
            if (bp == lane * 4 + 1) cv1 = -3.0e38f;
            if (bp == lane * 4 + 2) cv2 = -3.0e38f;
            if (bp == lane * 4 + 3) cv3 = -3.0e38f;
        }
        const float v = lane < 16 ? tv : -3.0e38f;
        const float mx = wave_max(v);
        const float e = lane < 16 ? __expf(tv - mx) : 0.f;
        const float den = wave_sum(e);
        if (lane < 16) { eidx[(size_t)t * 128 + hh * 16 + lane] = te; gate[(size_t)t * 128 + hh * 16 + lane] = e / den; }
    }
}
namespace rt {
using att::f32x16; using att::bf16x8;
__device__ __forceinline__ float pair_max(float m) {
    auto rr = __builtin_amdgcn_permlane32_swap(__float_as_uint(m), __float_as_uint(m), false, false);
    return fmaxf(__uint_as_float(rr[0]), __uint_as_float(rr[1]));
}
__device__ __forceinline__ int pair_max_i(int m) {
    auto rr = __builtin_amdgcn_permlane32_swap((unsigned)m, (unsigned)m, false, false);
    const int a = (int)rr[0], b = (int)rr[1]; return a > b ? a : b;
}
__device__ __forceinline__ void top16_of_128(f32x16& p0, f32x16& p1, f32x16& p2, f32x16& p3, float (&t)[16]) {
#pragma unroll
    for (int k = 0; k < 16; ++k) {
        float m = p0[0];
#pragma unroll
        for (int r = 1; r < 16; ++r) m = fmaxf(m, p0[r]);
#pragma unroll
        for (int r = 0; r < 16; ++r) m = fmaxf(m, fmaxf(p1[r], fmaxf(p2[r], p3[r])));
        m = pair_max(m);
        t[k] = m;
#pragma unroll
        for (int r = 0; r < 16; ++r) { p0[r] = p0[r] == m ? -3.0e38f : p0[r]; p1[r] = p1[r] == m ? -3.0e38f : p1[r]; p2[r] = p2[r] == m ? -3.0e38f : p2[r]; p3[r] = p3[r] == m ? -3.0e38f : p3[r]; }
    }
}
__device__ __forceinline__ void tag_scores(f32x16& p, const int base, const int hi) {
#pragma unroll
    for (int r = 0; r < 16; ++r) p[r] = __uint_as_float((__float_as_uint(p[r]) & ~0x7Fu) | (unsigned)(base + att::crow(r, hi)));
}
}

__device__ __forceinline__ void route_mfma_phase(const bf16_t* __restrict__ pqb  , const bf16_t* __restrict__ keysb  , int* __restrict__ eidx, float* __restrict__ gate,
                                                 char* lds, const pg8::StaticOrder& S, const int tid) {
    using namespace rt;
    const int wid = __builtin_amdgcn_readfirstlane(tid >> 6), lane = tid & 63, r32 = lane & 31, hi = lane >> 5;
    att::bf16* K_lds = (att::bf16*)lds;
    pg8::Unit un;
    for (int ui = 0; S.next(ui, un); ++ui) {
        const int h = un.pn, tb = un.pm * 256;
        const int tok = tb + wid * 32 + r32;
        float t0[16], t1[16];
#pragma unroll
        for (int c = 0; c < 2; ++c) {
            __syncthreads();
            { const bf16_t* kp = keysb + (size_t)(h * 2 + c) * 128 * 128;
              const int row = tid >> 2;
#pragma unroll
              for (int i = 0; i < 4; ++i) { const int sc = ((tid & 3) * 4 + i) * 8;
                  const bf16x8 v = *reinterpret_cast<const bf16x8*>(kp + row * 128 + sc);
                  *(bf16x8*)((char*)K_lds + (row >> 6) * 16384 + KSWZ(row & 63, sc * 2)) = v; } }
            bf16x8 qr[8];
            { const bf16_t* qw = pqb + (size_t)tok * 2048 + h * 256 + c * 128 + hi * 8;
#pragma unroll
              for (int d0 = 0; d0 < 8; ++d0) qr[d0] = *reinterpret_cast<const bf16x8*>(qw + d0 * 16); }
            __syncthreads();
            f32x16 p0, p1, p2, p3;
            att::qkt_pipe(p0, p1, (int)(uintptr_t)K_lds, qr, r32, hi);
            att::qkt_pipe(p2, p3, (int)(uintptr_t)K_lds + 16384, qr, r32, hi);
            tag_scores(p0, 0, hi); tag_scores(p1, 32, hi); tag_scores(p2, 64, hi); tag_scores(p3, 96, hi);
            if (c == 0) top16_of_128(p0, p1, p2, p3, t0); else top16_of_128(p0, p1, p2, p3, t1);
        }
        float v0[16], v1[16]; int k0[16], k1[16];
#pragma unroll
        for (int i = 0; i < 16; ++i) { const unsigned a = __float_as_uint(t0[i]), b = __float_as_uint(t1[i]);
            v0[i] = __uint_as_float(a & ~0x7Fu); v1[i] = __uint_as_float(b & ~0x7Fu); k0[i] = (int)((a & 0x7Fu) << 7); k1[i] = (int)(b & 0x7Fu); }
        float cv[25]; int ce[25];
    { const float s = hi ? (v0[0] + v1[1]) : (v0[0] + v1[0]); cv[0] = __uint_as_float((__float_as_uint(s) & ~0xFFu) | (unsigned)(2 * 0 + hi)); ce[0] = hi ? (k0[0] | k1[1]) : (k0[0] | k1[0]); }
    { const float s = hi ? (v0[0] + v1[3]) : (v0[0] + v1[2]); cv[1] = __uint_as_float((__float_as_uint(s) & ~0xFFu) | (unsigned)(2 * 1 + hi)); ce[1] = hi ? (k0[0] | k1[3]) : (k0[0] | k1[2]); }
    { const float s = hi ? (v0[0] + v1[5]) : (v0[0] + v1[4]); cv[2] = __uint_as_float((__float_as_uint(s) & ~0xFFu) | (unsigned)(2 * 2 + hi)); ce[2] = hi ? (k0[0] | k1[5]) : (k0[0] | k1[4]); }
    { const float s = hi ? (v0[0] + v1[7]) : (v0[0] + v1[6]); cv[3] = __uint_as_float((__float_as_uint(s) & ~0xFFu) | (unsigned)(2 * 3 + hi)); ce[3] = hi ? (k0[0] | k1[7]) : (k0[0] | k1[6]); }
    { const float s = hi ? (v0[0] + v1[9]) : (v0[0] + v1[8]); cv[4] = __uint_as_float((__float_as_uint(s) & ~0xFFu) | (unsigned)(2 * 4 + hi)); ce[4] = hi ? (k0[0] | k1[9]) : (k0[0] | k1[8]); }
    { const float s = hi ? (v0[0] + v1[11]) : (v0[0] + v1[10]); cv[5] = __uint_as_float((__float_as_uint(s) & ~0xFFu) | (unsigned)(2 * 5 + hi)); ce[5] = hi ? (k0[0] | k1[11]) : (k0[0] | k1[10]); }
    { const float s = hi ? (v0[0] + v1[13]) : (v0[0] + v1[12]); cv[6] = __uint_as_float((__float_as_uint(s) & ~0xFFu) | (unsigned)(2 * 6 + hi)); ce[6] = hi ? (k0[0] | k1[13]) : (k0[0] | k1[12]); }
    { const float s = hi ? (v0[0] + v1[15]) : (v0[0] + v1[14]); cv[7] = __uint_as_float((__float_as_uint(s) & ~0xFFu) | (unsigned)(2 * 7 + hi)); ce[7] = hi ? (k0[0] | k1[15]) : (k0[0] | k1[14]); }
    { const float s = hi ? (v0[1] + v1[1]) : (v0[1] + v1[0]); cv[8] = __uint_as_float((__float_as_uint(s) & ~0xFFu) | (unsigned)(2 * 8 + hi)); ce[8] = hi ? (k0[1] | k1[1]) : (k0[1] | k1[0]); }
    { const float s = hi ? (v0[1] + v1[3]) : (v0[1] + v1[2]); cv[9] = __uint_as_float((__float_as_uint(s) & ~0xFFu) | (unsigned)(2 * 9 + hi)); ce[9] = hi ? (k0[1] | k1[3]) : (k0[1] | k1[2]); }
    { const float s = hi ? (v0[1] + v1[5]) : (v0[1] + v1[4]); cv[10] = __uint_as_float((__float_as_uint(s) & ~0xFFu) | (unsigned)(2 * 10 + hi)); ce[10] = hi ? (k0[1] | k1[5]) : (k0[1] | k1[4]); }
    { const float s = hi ? (v0[1] + v1[7]) : (v0[1] + v1[6]); cv[11] = __uint_as_float((__float_as_uint(s) & ~0xFFu) | (unsigned)(2 * 11 + hi)); ce[11] = hi ? (k0[1] | k1[7]) : (k0[1] | k1[6]); }
    { const float s = hi ? (v0[2] + v1[1]) : (v0[2] + v1[0]); cv[12] = __uint_as_float((__float_as_uint(s) & ~0xFFu) | (unsigned)(2 * 12 + hi)); ce[12] = hi ? (k0[2] | k1[1]) : (k0[2] | k1[0]); }
    { const float s = hi ? (v0[2] + v1[3]) : (v0[2] + v1[2]); cv[13] = __uint_as_float((__float_as_uint(s) & ~0xFFu) | (unsigned)(2 * 13 + hi)); ce[13] = hi ? (k0[2] | k1[3]) : (k0[2] | k1[2]); }
    { const float s = hi ? (v0[3] + v1[0]) : (v0[2] + v1[4]); cv[14] = __uint_as_float((__float_as_uint(s) & ~0xFFu) | (unsigned)(2 * 14 + hi)); ce[14] = hi ? (k0[3] | k1[0]) : (k0[2] | k1[4]); }
    { const float s = hi ? (v0[3] + v1[2]) : (v0[3] + v1[1]); cv[15] = __uint_as_float((__float_as_uint(s) & ~0xFFu) | (unsigned)(2 * 15 + hi)); ce[15] = hi ? (k0[3] | k1[2]) : (k0[3] | k1[1]); }
    { const float s = hi ? (v0[4] + v1[0]) : (v0[3] + v1[3]); cv[16] = __uint_as_float((__float_as_uint(s) & ~0xFFu) | (unsigned)(2 * 16 + hi)); ce[16] = hi ? (k0[4] | k1[0]) : (k0[3] | k1[3]); }
    { const float s = hi ? (v0[4] + v1[2]) : (v0[4] + v1[1]); cv[17] = __uint_as_float((__float_as_uint(s) & ~0xFFu) | (unsigned)(2 * 17 + hi)); ce[17] = hi ? (k0[4] | k1[2]) : (k0[4] | k1[1]); }
    { const float s = hi ? (v0[5] + v1[1]) : (v0[5] + v1[0]); cv[18] = __uint_as_float((__float_as_uint(s) & ~0xFFu) | (unsigned)(2 * 18 + hi)); ce[18] = hi ? (k0[5] | k1[1]) : (k0[5] | k1[0]); }
    { const float s = hi ? (v0[6] + v1[1]) : (v0[6] + v1[0]); cv[19] = __uint_as_float((__float_as_uint(s) & ~0xFFu) | (unsigned)(2 * 19 + hi)); ce[19] = hi ? (k0[6] | k1[1]) : (k0[6] | k1[0]); }
    { const float s = hi ? (v0[7] + v1[1]) : (v0[7] + v1[0]); cv[20] = __uint_as_float((__float_as_uint(s) & ~0xFFu) | (unsigned)(2 * 20 + hi)); ce[20] = hi ? (k0[7] | k1[1]) : (k0[7] | k1[0]); }
    { const float s = hi ? (v0[9] + v1[0]) : (v0[8] + v1[0]); cv[21] = __uint_as_float((__float_as_uint(s) & ~0xFFu) | (unsigned)(2 * 21 + hi)); ce[21] = hi ? (k0[9] | k1[0]) : (k0[8] | k1[0]); }
    { const float s = hi ? (v0[11] + v1[0]) : (v0[10] + v1[0]); cv[22] = __uint_as_float((__float_as_uint(s) & ~0xFFu) | (unsigned)(2 * 22 + hi)); ce[22] = hi ? (k0[11] | k1[0]) : (k0[10] | k1[0]); }
    { const float s = hi ? (v0[13] + v1[0]) : (v0[12] + v1[0]); cv[23] = __uint_as_float((__float_as_uint(s) & ~0xFFu) | (unsigned)(2 * 23 + hi)); ce[23] = hi ? (k0[13] | k1[0]) : (k0[12] | k1[0]); }
    { const float s = hi ? (v0[15] + v1[0]) : (v0[14] + v1[0]); cv[24] = __uint_as_float((__float_as_uint(s) & ~0xFFu) | (unsigned)(2 * 24 + hi)); ce[24] = hi ? (k0[15] | k1[0]) : (k0[14] | k1[0]); }
        float ts[16]; int te[16];
#pragma unroll
        for (int k = 0; k < 16; ++k) {
            float m = cv[0];
#pragma unroll
            for (int n = 1; n < 25; ++n) m = fmaxf(m, cv[n]);
            m = pair_max(m);
            int e = -1;
#pragma unroll
            for (int n = 0; n < 25; ++n) { const bool hit = cv[n] == m; e = hit ? ce[n] : e; cv[n] = hit ? -3.0e38f : cv[n]; }
            ts[k] = __uint_as_float(__float_as_uint(m) & ~0xFFu); te[k] = pair_max_i(e);
        }
        float den = 0.f; const float mx = ts[0];
#pragma unroll
        for (int k = 0; k < 16; ++k) { ts[k] = __expf(ts[k] - mx); den += ts[k]; }
        const float inv = 1.0f / den;
        if (hi == 0) { int4* op = (int4*)(eidx + (size_t)tok * 128 + h * 16);
            op[0] = make_int4(te[0], te[1], te[2], te[3]); op[1] = make_int4(te[4], te[5], te[6], te[7]); op[2] = make_int4(te[8], te[9], te[10], te[11]); op[3] = make_int4(te[12], te[13], te[14], te[15]); }
        else { float4* op = (float4*)(gate + (size_t)tok * 128 + h * 16);
            op[0] = make_float4(ts[0] * inv, ts[1] * inv, ts[2] * inv, ts[3] * inv); op[1] = make_float4(ts[4] * inv, ts[5] * inv, ts[6] * inv, ts[7] * inv);
            op[2] = make_float4(ts[8] * inv, ts[9] * inv, ts[10] * inv, ts[11] * inv); op[3] = make_float4(ts[12] * inv, ts[13] * inv, ts[14] * inv, ts[15] * inv); }
    }
}
#ifndef PH_MASK
#define PH_MASK 0xffffffffu
#endif
constexpr int N_PHASES = 20;
__global__ void __launch_bounds__(512, 2) mega(MK a) {
    extern __shared__ __attribute__((aligned(16))) unsigned char lds_raw[];
    LDSA unsigned char* lds = (LDSA unsigned char*)lds_raw;
    const int lo = a.ph_lo, hi = a.ph_hi;
    const int G = gridDim.x, bid = blockIdx.x;
    const int wid_s = __builtin_amdgcn_readfirstlane(threadIdx.x >> 6);
    unsigned char* ws = a.ws;
#define PH_TID() int tid; { int _z = 0; asm volatile("" : "+s"(_z)); tid = wid_s * 64 + (int)__builtin_amdgcn_mbcnt_hi(~0u, __builtin_amdgcn_mbcnt_lo(~0u, (unsigned)_z)); }
#define WSP(T, name, off) T* name; { unsigned char* _b = ws; asm volatile("" : "+s"(_b)); name = (T*)(_b + (off)); }
#define IN(k) ((((PH_MASK) >> (k)) & 1u) && lo <= (k) && (k) < hi)
#define SEAM(k) do { if ((k) + 1 < hi) { PH_TID() xcd_barrier(bar, tid); } } while (0)
    XcdBarrier bar;
    { PH_TID()
      volatile LAS unsigned* st = (volatile LAS unsigned*)(lds + LDS_MISC);
      if (tid == 0) { st[0] = 0u; st[1] = 0u; }
      __syncthreads();
      bar = xcd_barrier_post((unsigned*)(ws + WS_CTL), st, tid); }

    if (IN(0)) {
#ifdef PROBE_PRO2
      for (int rep = 0; rep < 2; ++rep) {
#else
      {
#endif
        PH_TID()
        WSP(bf16_t, xb, WS_XB) WSP(bf16_t, wab, WS_WAB) WSP(bf16_t, woab, WS_WOAB) WSP(bf16_t, wcd, WS_WCD) WSP(bf16_t, wocd, WS_WOCD) WSP(bf16_t, wq, WS_WQ) WSP(unsigned char, ub, WS_UB) WSP(unsigned char, vb, WS_VB) WSP(float, isu, WS_SU) WSP(float, isv, WS_SV)
        cvt_rows_bf16(a.in[0], xb, (size_t)SEQ * DM / 8, bid, G, tid, 512);
        LDSA float* tile = (LDSA float*)lds;
        transpose_cvt(a.in[1], wab, 4096, 12288, tile, bid, G, PermAB(), tid);
        transpose_cvt(a.in[3], woab, 3072, 4096, tile, bid, G, PermNone(), tid);
        transpose_cvt(a.in[4], wcd, 4096, 9216, tile, bid, G, PermCD(), tid);
        transpose_cvt(a.in[12], wocd, 4096, 4096, tile, bid, G, PermNone(), tid);
        transpose_cvt(a.in[15], wq, 4096, 2048, tile, bid, G, PermNone(), tid);
        transpose_cvt(a.in[15] + (size_t)4096 * 2048, wq + (size_t)2048 * 4096, 4096, 2048, tile, bid, G, PermNone(), tid);
        table_fp6(a.in[17], ub, isu, 2 * 16384, (LDSA float*)lds, bid, G, tid);
        { const int nu1 = (SEQ / 256) * (9216 / 256); const bool slack = (nu1 % G) != 0 && (nu1 % G) <= G / 2;
          table_fp6(a.in[18], vb, isv, slack ? 16384 : 2 * 16384, (LDSA float*)lds, bid, G, tid); }
        { WSP(float, cs0, WS_CS0) WSP(float, csa, WS_CSA) rope_tables(cs0, csa, bid, G, tid); }
        { WSP(bf16_t, keyb, WS_KEYB) cvt_rows_bf16(a.in[16], keyb, (size_t)2 * 8 * 2 * 128 * 128 / 8, bid, G, tid, 512); }
      }
        SEAM(0);
    }
    { constexpr int layer = 0;
        const int pb = 1 + 10 * layer;
        if (IN(pb + 0)) {
            PH_TID() WSP(bf16_t, xb, WS_XB) WSP(bf16_t, x2b, WS_X2B) WSP(bf16_t, wab, WS_WAB) WSP(bf16_t, wcd, WS_WCD) WSP(bf16_t, hb, WS_HB) WSP(float, cs0, WS_CS0) WSP(float, csa, WS_CSA)
            if (layer == 0) {
                pg8::Gemm g{xb, wab, SEQ, 12288, 4096}; pg8::StaticOrder S; S.init(SEQ, 12288, G, bid);
                pg8::EpiProj<0> E{hb, 12288, cs0, csa, nullptr, nullptr, (LDSA float*)(lds + LDS_MISC + 64)};
                pg8::gemm_phase<pg8::EpiProj<0>, pg8::StaticOrder>(lds, g, S, E, nullptr, tid);
#ifdef PROBE_GEMM2
                pg8::gemm_phase<pg8::EpiProj<0>, pg8::StaticOrder>(lds, g, S, E, nullptr, tid);
#endif
            } else {
                pg8::Gemm g{x2b, wcd, SEQ, 9216, 4096}; pg8::StaticOrder S; S.init(SEQ, 9216, G, bid);
                pg8::EpiProj<1> E{hb, 9216, cs0, csa, a.in[10], a.in[11], (LDSA float*)(lds + LDS_MISC + 64)};
                pg8::gemm_phase<pg8::EpiProj<1>, pg8::StaticOrder>(lds, g, S, E, nullptr, tid);
                { const int nu1 = (SEQ / 256) * (9216 / 256), busy = nu1 % G; const bool slack = busy != 0 && busy <= G / 2;
                  if (slack && bid >= busy) {
                      WSP(unsigned char, vb1, WS_VB) WSP(float, isv1, WS_SV)
                      int t5; { int _z = 0; asm volatile("" : "+s"(_z)); t5 = wid_s * 64 + (int)__builtin_amdgcn_mbcnt_hi(~0u, __builtin_amdgcn_mbcnt_lo(~0u, (unsigned)_z)); }
                      table_fp6(a.in[18] + (size_t)16384 * DM, vb1 + (size_t)16384 * ROWB, isv1 + 16384, 16384, (LDSA float*)lds, bid - busy, G - busy, t5); } }
            }
            SEAM(pb + 0);
        }
        if (IN(pb + 2)) {
            PH_TID() WSP(bf16_t, hb, WS_HB) WSP(bf16_t, abb, WS_AB) WSP(float, oc, WS_OC)
            if (layer == 0) attn0_phase(hb, a.in[2], abb, (bf16_t*)oc, (float*)((unsigned char*)oc + (size_t)3 * 8 * SEQ * 128 * 2), (char*)lds_raw, bid, G, tid);
#ifdef PROBE_SMALL
            if (layer == 0) { __syncthreads(); int t3 = tid; asm volatile("" : "+v"(t3)); attn0_phase(hb, a.in[2], abb, (bf16_t*)oc, (float*)((unsigned char*)oc + (size_t)3 * 8 * SEQ * 128 * 2), (char*)lds_raw, bid, G, t3); }
#endif
            else attn1_phase(hb, abb, oc, a.in[5], a.in[6], a.in[7], a.in[8], a.in[9], (char*)lds_raw, bid, G, tid);
#ifdef PROBE_ATTN2
            if (layer == 1) { __syncthreads(); int t3 = tid; asm volatile("" : "+v"(t3)); attn1_phase(hb, abb, oc, a.in[5], a.in[6], a.in[7], a.in[8], a.in[9], (char*)lds_raw, bid, G, t3); }
#endif
            SEAM(pb + 2);
        }
        if (layer == 0) {
            if (IN(pb + 3)) {
                PH_TID() WSP(bf16_t, abb, WS_AB) WSP(float, oc, WS_OC)
                merge0_phase((const bf16_t*)oc, (const float*)((unsigned char*)oc + (size_t)3 * 8 * SEQ * 128 * 2), abb, bid, G, tid);
#ifdef PROBE_SMALL
                merge0_phase((const bf16_t*)oc, (const float*)((unsigned char*)oc + (size_t)3 * 8 * SEQ * 128 * 2), abb, bid, G, tid);
#endif
                SEAM(pb + 3);
            }
        } else {
        }
        if (IN(pb + 4)) {
            const int K = layer == 0 ? 3072 : 4096;
            PH_TID() WSP(bf16_t, abb, WS_AB) WSP(bf16_t, woab, WS_WOAB) WSP(bf16_t, wocd, WS_WOCD) WSP(float, ybuf, WS_Y) WSP(float, x2, WS_X2)
            pg8::Gemm g{abb, layer == 0 ? woab : wocd, SEQ, 4096, K}; pg8::StaticOrder S; S.init(SEQ, 4096, G, bid);
            pg8::EpiF32R E{ybuf, 4096, layer == 0 ? a.in[0] : (const float*)x2, ALPHA};
            pg8::gemm_phase<pg8::EpiF32R, pg8::StaticOrder>(lds, g, S, E, nullptr, tid);
            SEAM(pb + 4);
        }
        if (IN(pb + 5)) {
            PH_TID() WSP(float, ybuf, WS_Y) WSP(float, stats, WS_X1) WSP(bf16_t, x1b, WS_X1B)
            ln_phase(ybuf, a.in[13] + layer * DM, a.in[14] + layer * DM, stats, x1b, bid, G, tid);
            SEAM(pb + 5);
        }
        if (IN(pb + 6)) {
            PH_TID() WSP(bf16_t, x1b, WS_X1B) WSP(bf16_t, wq, WS_WQ) WSP(bf16_t, pqb, WS_PQ)
            pg8::Gemm g{x1b, wq + (size_t)layer * 2048 * 4096, SEQ, 2048, 4096}; pg8::StaticOrder S; S.init(SEQ, 2048, G, bid);
            pg8::EpiBf16P E{pqb, 2048};
            pg8::gemm_phase<pg8::EpiBf16P, pg8::StaticOrder>(lds, g, S, E, nullptr, tid);
            asm volatile("s_waitcnt vmcnt(0)" ::: "memory"); __syncthreads();
            { WSP(bf16_t, keyb, WS_KEYB) WSP(int, eidx, WS_EIDX) WSP(float, gate, WS_GATE)
              int t4 = tid; asm volatile("" : "+v"(t4));
              route_mfma_phase(pqb, keyb + (size_t)layer * 8 * 2 * 128 * 128, eidx, gate, (char*)lds_raw, S, t4); }
            SEAM(pb + 6);
        }
        if (IN(pb + 8)) {
            PH_TID() WSP(float, ybuf, WS_Y) WSP(float, stats, WS_X1) WSP(bf16_t, x1b, WS_X1B) WSP(int, eidx, WS_EIDX) WSP(float, gate, WS_GATE) WSP(unsigned char, ub, WS_UB) WSP(unsigned char, vb, WS_VB) WSP(float, isu, WS_SU) WSP(float, isv, WS_SV) WSP(float, x2, WS_X2) WSP(bf16_t, x2b, WS_X2B)
            peer_expert_phase(ybuf, stats, a.in[13] + layer * DM, a.in[14] + layer * DM, x1b, eidx, gate, ub + (size_t)layer * 16384 * ROWB, vb + (size_t)layer * 16384 * ROWB, isu + layer * 16384, isv + layer * 16384, a.in[19] + layer * DM, a.in[20] + layer * DM,
                              layer == 0 ? x2 : a.out, layer == 0 ? x2b : (bf16_t*)nullptr, (LDSA float*)lds, bid, G, tid);
            SEAM(pb + 8);
        }
        }
    { constexpr int layer = 1;
        const int pb = 1 + 10 * layer;
        if (IN(pb + 0)) {
            PH_TID() WSP(bf16_t, xb, WS_XB) WSP(bf16_t, x2b, WS_X2B) WSP(bf16_t, wab, WS_WAB) WSP(bf16_t, wcd, WS_WCD) WSP(bf16_t, hb, WS_HB) WSP(float, cs0, WS_CS0) WSP(float, csa, WS_CSA)
            if (layer == 0) {
                pg8::Gemm g{xb, wab, SEQ, 12288, 4096}; pg8::StaticOrder S; S.init(SEQ, 12288, G, bid);
                pg8::EpiProj<0> E{hb, 12288, cs0, csa, nullptr, nullptr, (LDSA float*)(lds + LDS_MISC + 64)};
                pg8::gemm_phase<pg8::EpiProj<0>, pg8::StaticOrder>(lds, g, S, E, nullptr, tid);
#ifdef PROBE_GEMM2
                pg8::gemm_phase<pg8::EpiProj<0>, pg8::StaticOrder>(lds, g, S, E, nullptr, tid);
#endif
            } else {
                pg8::Gemm g{x2b, wcd, SEQ, 9216, 4096}; pg8::StaticOrder S; S.init(SEQ, 9216, G, bid);
                pg8::EpiProj<1> E{hb, 9216, cs0, csa, a.in[10], a.in[11], (LDSA float*)(lds + LDS_MISC + 64)};
                pg8::gemm_phase<pg8::EpiProj<1>, pg8::StaticOrder>(lds, g, S, E, nullptr, tid);
                { const int nu1 = (SEQ / 256) * (9216 / 256), busy = nu1 % G; const bool slack = busy != 0 && busy <= G / 2;
                  if (slack && bid >= busy) {
                      WSP(unsigned char, vb1, WS_VB) WSP(float, isv1, WS_SV)
                      int t5; { int _z = 0; asm volatile("" : "+s"(_z)); t5 = wid_s * 64 + (int)__builtin_amdgcn_mbcnt_hi(~0u, __builtin_amdgcn_mbcnt_lo(~0u, (unsigned)_z)); }
                      table_fp6(a.in[18] + (size_t)16384 * DM, vb1 + (size_t)16384 * ROWB, isv1 + 16384, 16384, (LDSA float*)lds, bid - busy, G - busy, t5); } }
            }
            SEAM(pb + 0);
        }
        if (IN(pb + 2)) {
            PH_TID() WSP(bf16_t, hb, WS_HB) WSP(bf16_t, abb, WS_AB) WSP(float, oc, WS_OC)
            if (layer == 0) attn0_phase(hb, a.in[2], abb, (bf16_t*)oc, (float*)((unsigned char*)oc + (size_t)3 * 8 * SEQ * 128 * 2), (char*)lds_raw, bid, G, tid);
#ifdef PROBE_SMALL
            if (layer == 0) { __syncthreads(); int t3 = tid; asm volatile("" : "+v"(t3)); attn0_phase(hb, a.in[2], abb, (bf16_t*)oc, (float*)((unsigned char*)oc + (size_t)3 * 8 * SEQ * 128 * 2), (char*)lds_raw, bid, G, t3); }
#endif
            else attn1_phase(hb, abb, oc, a.in[5], a.in[6], a.in[7], a.in[8], a.in[9], (char*)lds_raw, bid, G, tid);
#ifdef PROBE_ATTN2
            if (layer == 1) { __syncthreads(); int t3 = tid; asm volatile("" : "+v"(t3)); attn1_phase(hb, abb, oc, a.in[5], a.in[6], a.in[7], a.in[8], a.in[9], (char*)lds_raw, bid, G, t3); }
#endif
            SEAM(pb + 2);
        }
        if (layer == 0) {
            if (IN(pb + 3)) {
                PH_TID() WSP(bf16_t, abb, WS_AB) WSP(float, oc, WS_OC)
                merge0_phase((const bf16_t*)oc, (const float*)((unsigned char*)oc + (size_t)3 * 8 * SEQ * 128 * 2), abb, bid, G, tid);
#ifdef PROBE_SMALL
                merge0_phase((const bf16_t*)oc, (const float*)((unsigned char*)oc + (size_t)3 * 8 * SEQ * 128 * 2), abb, bid, G, tid);
#endif
                SEAM(pb + 3);
            }
        } else {
        }
        if (IN(pb + 4)) {
            const int K = layer == 0 ? 3072 : 4096;
            PH_TID() WSP(bf16_t, abb, WS_AB) WSP(bf16_t, woab, WS_WOAB) WSP(bf16_t, wocd, WS_WOCD) WSP(float, ybuf, WS_Y) WSP(float, x2, WS_X2)
            pg8::Gemm g{abb, layer == 0 ? woab : wocd, SEQ, 4096, K}; pg8::StaticOrder S; S.init(SEQ, 4096, G, bid);
            pg8::EpiF32R E{ybuf, 4096, layer == 0 ? a.in[0] : (const float*)x2, ALPHA};
            pg8::gemm_phase<pg8::EpiF32R, pg8::StaticOrder>(lds, g, S, E, nullptr, tid);
            SEAM(pb + 4);
        }
        if (IN(pb + 5)) {
            PH_TID() WSP(float, ybuf, WS_Y) WSP(float, stats, WS_X1) WSP(bf16_t, x1b, WS_X1B)
            ln_phase(ybuf, a.in[13] + layer * DM, a.in[14] + layer * DM, stats, x1b, bid, G, tid);
            SEAM(pb + 5);
        }
        if (IN(pb + 6)) {
            PH_TID() WSP(bf16_t, x1b, WS_X1B) WSP(bf16_t, wq, WS_WQ) WSP(bf16_t, pqb, WS_PQ)
            pg8::Gemm g{x1b, wq + (size_t)layer * 2048 * 4096, SEQ, 2048, 4096}; pg8::StaticOrder S; S.init(SEQ, 2048, G, bid);
            pg8::EpiBf16P E{pqb, 2048};
            pg8::gemm_phase<pg8::EpiBf16P, pg8::StaticOrder>(lds, g, S, E, nullptr, tid);
            asm volatile("s_waitcnt vmcnt(0)" ::: "memory"); __syncthreads();
            { WSP(bf16_t, keyb, WS_KEYB) WSP(int, eidx, WS_EIDX) WSP(float, gate, WS_GATE)
              int t4 = tid; asm volatile("" : "+v"(t4));
              route_mfma_phase(pqb, keyb + (size_t)layer * 8 * 2 * 128 * 128, eidx, gate, (char*)lds_raw, S, t4); }
            SEAM(pb + 6);
        }
        if (IN(pb + 8)) {
            PH_TID() WSP(float, ybuf, WS_Y) WSP(float, stats, WS_X1) WSP(bf16_t, x1b, WS_X1B) WSP(int, eidx, WS_EIDX) WSP(float, gate, WS_GATE) WSP(unsigned char, ub, WS_UB) WSP(unsigned char, vb, WS_VB) WSP(float, isu, WS_SU) WSP(float, isv, WS_SV) WSP(float, x2, WS_X2) WSP(bf16_t, x2b, WS_X2B)
            peer_expert_phase(ybuf, stats, a.in[13] + layer * DM, a.in[14] + layer * DM, x1b, eidx, gate, ub + (size_t)layer * 16384 * ROWB, vb + (size_t)layer * 16384 * ROWB, isu + layer * 16384, isv + layer * 16384, a.in[19] + layer * DM, a.in[20] + layer * DM,
                              layer == 0 ? x2 : a.out, layer == 0 ? x2b : (bf16_t*)nullptr, (LDSA float*)lds, bid, G, tid);
            SEAM(pb + 8);
        }
        }

#ifdef PROBE_FP6
    if (bid == 0 && hi == N_PHASES) {
        PH_TID()
        if (tid == 0) {
            v16f_t s0, s1; float xs[32];
#pragma unroll
            for (int i = 0; i < 32; ++i) { const int e = i >> 3, m = i & 7; const float v = e == 0 ? 0.125f * m : (float)(1 << (e - 1)) * (1.0f + 0.125f * m); xs[i] = v; if (i < 16) s0[i] = v; else s1[i - 16] = v; }
            const v6u_t w = __builtin_amdgcn_cvt_scalef32_2xpk16_fp6_f32(s0, s1, 1.0f);
            const v32f_t y = __builtin_amdgcn_cvt_scalef32_pk32_f32_fp6(w, 1.0f);
            const v16u_t zb = __builtin_bit_cast(v16u_t, __builtin_amdgcn_cvt_scalef32_pk32_bf16_fp6(w, 1.0f));
            const v32f_t y2 = __builtin_amdgcn_cvt_scalef32_pk32_f32_fp6(w, 2.0f);
            const v6u_t w2 = __builtin_amdgcn_cvt_scalef32_2xpk16_fp6_f32(s0, s1, 2.0f);
            const v32f_t y3 = __builtin_amdgcn_cvt_scalef32_pk32_f32_fp6(w2, 1.0f);
            bool id32 = true, id16 = true, il32 = true;
#pragma unroll
            for (int i = 0; i < 32; ++i) { id32 = id32 && (y[i] == xs[i]);
                const unsigned d = zb[i >> 1]; const float b = (i & 1) ? bf_hi(d) : bf_lo(d); id16 = id16 && (b == xs[i]);
                const int src = (i & 1) ? 16 + (i >> 1) : (i >> 1); il32 = il32 && (y[i] == xs[src]); }
            int code = 64;
            if (id32) code += 1; if (id16) code += 2; if (il32) code += 4;
            if (y2[9] == 2.0f * y[9]) code += 8;
            if (y3[20] * 2.0f == y[20]) code += 16;
            if (y[1] == xs[1]) code += 32;
            a.out[0] += (float)code;
        }
    }
#endif
#undef IN
}
#ifndef ONE_LAUNCH
#define ONE_LAUNCH 1
#endif
extern "C" void kernel_launch(void* const* d_in, const int* in_sizes, int n_in, void* d_out, int out_size, void* d_ws, size_t ws_size, hipStream_t stream) {
    static int ready = 0;
    if (!ready) {
        if (ws_size < WS_END) { fprintf(stderr, "kernel_launch: workspace too small: %zu < %zu\n", ws_size, (size_t)WS_END); return; }
        if (hipFuncSetAttribute((const void*)mega, hipFuncAttributeMaxDynamicSharedMemorySize, LDS_BYTES) != hipSuccess) { fprintf(stderr, "kernel_launch: hipFuncSetAttribute failed\n"); return; }
        int per_cu = 0;
        if (hipOccupancyMaxActiveBlocksPerMultiprocessor(&per_cu, (const void*)mega, 512, LDS_BYTES) != hipSuccess || per_cu < 1) fprintf(stderr, "kernel_launch: note: occupancy query reports %d blocks per CU\n", per_cu);
        (void)hipGetLastError();
        ready = 1;
    }
    unsigned char* ws = (unsigned char*)d_ws;
    (void)hipMemsetAsync(ws + WS_CTL, 0, CTL_BYTES, stream);
    MK a{}; for (int i = 0; i < 21; ++i) a.in[i] = (const float*)d_in[i];
    a.out = (float*)d_out; a.ws = ws;
#if ONE_LAUNCH
    a.ph_lo = 0; a.ph_hi = N_PHASES;
    hipLaunchKernelGGL(mega, dim3(256), dim3(512), LDS_BYTES, stream, a);
#else
    for (int k = 0; k < N_PHASES; ++k) { if (k == 10 || k == 2 || k == 12 || k == 14 || k == 8 || k == 18) continue; a.ph_lo = k; a.ph_hi = k + 1; hipLaunchKernelGGL(mega, dim3(256), dim3(512), LDS_BYTES, stream, a); }
#endif
    const hipError_t le = hipPeekAtLastError();
    if (le != hipSuccess) fprintf(stderr, "kernel_launch: launch failed: %s\n", hipGetErrorName(le));
}
```

```cpp
#include <hip/hip_runtime.h>
#include <stdint.h>
#include <cstdio>

#define SEQ 8192
#define DM 4096
#define HD 128
#define ALPHA 1.4142135623730951f
#define LAMBDA_INIT 0.35550906759096934f
#define ATT_SCALE 0.088388347648318440f

__device__ const double REV_P[16] = {0.15915494309189535, 0.0700865215877985, 0.03086376340470123, 0.013591370636193905, 0.005985185712713705, 0.002635675898667414, 0.001160663641240061, 0.0005111175045375439, 0.00022507907903927653, 9.911730936901935e-05, 4.364795279280289e-05, 1.9221100684944863e-05, 8.464330808241401e-06, 3.727408601915352e-06, 1.6414262627950345e-06, 7.228293068832865e-07};
__device__ const double REV_A[32] = {0.15915494309189535, 0.11934937021124886, 0.08949940160889101, 0.06711508300522726, 0.050329212104487035, 0.03774158471741977, 0.0283021958306234, 0.02122365276477766, 0.015915494309189534, 0.011934937021124886, 0.008949940160889102, 0.006711508300522725, 0.005032921210448704, 0.003774158471741977, 0.00283021958306234, 0.0021223652764777662, 0.0015915494309189536, 0.0011934937021124885, 0.0008949940160889102, 0.0006711508300522726, 0.0005032921210448703, 0.00037741584717419774, 0.00028302195830623395, 0.0002122365276477766, 0.00015915494309189535, 0.00011934937021124886, 8.949940160889102e-05, 6.711508300522725e-05, 5.0329212104487035e-05, 3.774158471741978e-05, 2.8302195830623396e-05, 2.122365276477766e-05};

__device__ __forceinline__ void sincos_rev(double rev, float& s, float& c) {
    const double f = rev - floor(rev); const float ff = (float)f;
    s = __builtin_amdgcn_sinf(ff); c = __builtin_amdgcn_cosf(ff);
}
__device__ __forceinline__ float wave_sum(float v) {
#pragma unroll
    for (int o = 32; o >= 1; o >>= 1) v += __shfl_xor(v, o);
    return v;
}
__device__ __forceinline__ float wave_max(float v) {
#pragma unroll
    for (int o = 32; o >= 1; o >>= 1) v = fmaxf(v, __shfl_xor(v, o));
    return v;
}
namespace pg8 {
#define PG8_LAS __attribute__((address_space(3)))
typedef unsigned short bf16_t;
typedef short bf16x8 __attribute__((ext_vector_type(8)));
typedef float f32x4 __attribute__((ext_vector_type(4)));
typedef unsigned u32x4 __attribute__((ext_vector_type(4)));
constexpr int BM = 256, BK = 64, HALF = 128, HTB = HALF * BK * 2  , STAGE_BYTES = 8 * HTB, NXCD = 8, WGM = 8;

__host__ __device__ __forceinline__ int lds_byte(int r, int c) { const int st = (r >> 4) * 2 + (c >> 5), rr = r & 15, cc = c & 31, ob = rr * 64 + cc * 2; return st * 1024 + (ob ^ (((ob >> 9) & 1) << 5)); }
__host__ __device__ __forceinline__ void stage_rc(int b, int& R, int& C) { const int st = b / 1024, sb = b % 1024, swz = sb ^ (((sb >> 9) & 1) << 5); R = (st >> 1) * 16 + swz / 64; C = (st & 1) * 32 + (swz % 64) / 2; }
__host__ __device__ __forceinline__ int perm32(int rho) { const int n = rho >> 4, i = rho & 15; return 8 * (i >> 2) + 4 * n + (i & 3); }

struct Unit { int pm, pn; };
struct Gemm { const bf16_t* A; const bf16_t* Bt; int M, N, K; };

struct StaticOrder {
    int nM, nN, nwg, G, c;
    __host__ __device__ void init(int M, int N, int G_, int c_) { nM = M / BM; nN = N / BM; nwg = nM * nN; G = G_; c = c_; }
    __host__ __device__ bool next(int i, Unit& u) const {
        const long L = (long)i * G + c; if (L >= nwg) return false;
        int wgid = (int)L; { const int q = nwg / NXCD, r = nwg % NXCD, xcd = wgid % NXCD, off = wgid / NXCD; wgid = (xcd < r ? xcd * (q + 1) : r * (q + 1) + (xcd - r) * q) + off; }
        const int nig = WGM * nN, gid = wgid / nig, fm = gid * WGM, gsz = (nM - fm) < WGM ? (nM - fm) : WGM;
        u.pm = fm + ((wgid % nig) % gsz); u.pn = (wgid % nig) / gsz; return true;
    }
    __device__ __forceinline__ void a_ready(const Unit&) const {}
    __device__ __forceinline__ void done(const Unit&) const {}
};
__device__ __forceinline__ unsigned cvt_pk_bf16(float lo, float hi) { unsigned r; asm volatile("v_cvt_pk_bf16_f32 %0, %1, %2" : "=v"(r) : "v"(lo), "v"(hi)); return r; }
typedef float f32x2 __attribute__((ext_vector_type(2)));
template <class Epi, class Sched, bool STAMP = false>
__device__ __forceinline__ void gemm_phase(PG8_LAS unsigned char* lds, const Gemm g, const Sched& S, const Epi& E, unsigned long long* stamps, const int tid_in) {
    const int tid = tid_in, wid = __builtin_amdgcn_readfirstlane(tid >> 6), lane = tid & 63, wr = wid >> 2, wc = wid & 3, fr = lane & 15, fq = lane >> 4;
    const int K = g.K, nt = K / BK;
    int ts_lo = 0, ts_hi = 0, nts = 0; const unsigned long long rt_entry = STAMP ? (unsigned long long)wall_clock64() : 0ull;
#define PG8_STAMP() do { if (STAMP && wid == 0 && nts < 64) { const unsigned long long _c = (unsigned long long)clock64(); \
        ts_lo = (lane == nts) ? (int)(unsigned)_c : ts_lo; ts_hi = (lane == nts) ? (int)(unsigned)(_c >> 32) : ts_hi; ++nts; } } while (0)
    PG8_STAMP();
    unsigned voffA[2], voffB[2];
#pragma unroll
    for (int i = 0; i < 2; ++i) { int R, C; stage_rc(tid * 16 + i * 8192, R, C); const int Rb = Epi::PERM ? ((R & ~31) + perm32(R & 31)) : R;
        voffA[i] = (unsigned)(R * K + C) * 2u; voffB[i] = (unsigned)(Rb * K + C) * 2u; }
    const size_t kstep = (size_t)(BK * 2);
    const size_t hstep = (size_t)HALF * K * 2;
    const size_t tstep = 2 * hstep;
    const unsigned ldsw = (unsigned)wid * 1024u;
    const int aoff = lds_byte(wr * 64 + fr, fq * 8), boff = lds_byte(wc * 32 + fr, fq * 8);
#define PG8_SA(b, h) (((b) * 2 + (h)) * HTB)
#define PG8_SB(b, h) ((4 + (b) * 2 + (h)) * HTB)
#define PG8_STAGE(bufoff, gbase, voff) do { _Pragma("unroll") for (int _i = 0; _i < 2; ++_i) \
        __builtin_amdgcn_global_load_lds((const unsigned*)((const char*)(gbase) + (voff)[_i]), (PG8_LAS unsigned*)(lds + (bufoff) + ldsw + _i * 8192), 16, 0, 0); } while (0)
#define PG8_LDA(dst, b, h) do { _Pragma("unroll") for (int m = 0; m < 4; ++m) _Pragma("unroll") for (int k = 0; k < 2; ++k) dst[m][k] = *(const PG8_LAS bf16x8*)(lds + PG8_SA(b, h) + aoff + m * 2048 + k * 1024); } while (0)
#define PG8_LDB(dst, b, h) do { _Pragma("unroll") for (int n = 0; n < 2; ++n) _Pragma("unroll") for (int k = 0; k < 2; ++k) dst[n][k] = *(const PG8_LAS bf16x8*)(lds + PG8_SB(b, h) + boff + n * 2048 + k * 1024); } while (0)
#define PG8_MMA(ai, bj, At, Bt) do { __builtin_amdgcn_s_setprio(1); _Pragma("unroll") for (int m = 0; m < 4; ++m) _Pragma("unroll") for (int n = 0; n < 2; ++n) _Pragma("unroll") for (int k = 0; k < 2; ++k) \
        acc[ai][bj][m][n] = __builtin_amdgcn_mfma_f32_16x16x32_bf16(Bt[n][k], At[m][k], acc[ai][bj][m][n], 0, 0, 0); __builtin_amdgcn_s_setprio(0); } while (0)
#define PG8_WAIT_V(n) asm volatile("s_waitcnt vmcnt(" #n ")" ::: "memory")
#define PG8_WAIT_L(n) asm volatile("s_waitcnt lgkmcnt(" #n ")" ::: "memory")
#define PG8_BAR __builtin_amdgcn_s_barrier()
#define PG8_SCHED __builtin_amdgcn_sched_barrier(0)
    Unit cur, nxt; int ui = 0;
    if (!S.next(0, cur)) return;
    f32x4 acc[2][2][4][2];
#pragma unroll
    for (int a = 0; a < 2; ++a)
#pragma unroll
        for (int b = 0; b < 2; ++b)
#pragma unroll
            for (int m = 0; m < 4; ++m)
#pragma unroll
                for (int n = 0; n < 2; ++n) acc[a][b][m][n] = (f32x4){0.f, 0.f, 0.f, 0.f};
    bf16x8 At[4][2], B0[2][2], B1[2][2];
    const char* cA = (const char*)g.A + (size_t)cur.pm * tstep; const char* cB = (const char*)g.Bt + (size_t)cur.pn * tstep;
    S.a_ready(cur);
    PG8_STAGE(PG8_SB(0, 0), cB, voffB); PG8_STAGE(PG8_SA(0, 0), cA, voffA); PG8_STAGE(PG8_SB(0, 1), cB + hstep, voffB); PG8_STAGE(PG8_SA(0, 1), cA + hstep, voffA);
    if (wr == 1) PG8_BAR;
    PG8_WAIT_V(4); PG8_BAR;
    PG8_STAGE(PG8_SB(1, 0), cB + kstep, voffB); PG8_STAGE(PG8_SA(1, 0), cA + kstep, voffA); PG8_STAGE(PG8_SB(1, 1), cB + hstep + kstep, voffB);
    PG8_WAIT_V(6); PG8_BAR;
    PG8_STAMP();
    for (;;) {
        const bool has_next = S.next(ui + 1, nxt);
        const char* nA = has_next ? (const char*)g.A + (size_t)nxt.pm * tstep : cA; const char* nB = has_next ? (const char*)g.Bt + (size_t)nxt.pn * tstep : cB;
        for (int t = 0; t < nt; t += 2) {
            const bool last = (t == nt - 2);
            const char* a1 = cA + (size_t)(t + 1) * kstep;
            const char* a2 = last ? nA : cA + (size_t)(t + 2) * kstep; const char* b2 = last ? nB : cB + (size_t)(t + 2) * kstep;
            const char* a3 = a2 + kstep; const char* b3 = b2 + kstep;
            if (last && has_next) S.a_ready(nxt);
            PG8_LDB(B0, 0, 0); PG8_SCHED; PG8_LDA(At, 0, 0); PG8_STAGE(PG8_SA(1, 1), a1 + hstep, voffA);
            PG8_WAIT_L(8); PG8_BAR; PG8_WAIT_L(0); PG8_MMA(0, 0, At, B0); PG8_BAR; PG8_SCHED;
            PG8_LDB(B1, 0, 1); PG8_STAGE(PG8_SB(0, 0), b2, voffB);
            PG8_BAR; PG8_WAIT_L(0); PG8_MMA(0, 1, At, B1); PG8_BAR;
            PG8_LDA(At, 0, 1); PG8_STAGE(PG8_SA(0, 0), a2, voffA);
            PG8_BAR; PG8_WAIT_L(0); PG8_MMA(1, 0, At, B0); PG8_BAR; PG8_SCHED;
            PG8_STAGE(PG8_SB(0, 1), b2 + hstep, voffB);
            PG8_WAIT_V(6); PG8_BAR; PG8_MMA(1, 1, At, B1); PG8_BAR;
            PG8_LDB(B0, 1, 0); PG8_SCHED; PG8_LDA(At, 1, 0); PG8_STAGE(PG8_SA(0, 1), a2 + hstep, voffA);
            PG8_WAIT_L(8); PG8_BAR; PG8_WAIT_L(0); PG8_MMA(0, 0, At, B0); PG8_BAR; PG8_SCHED;
            PG8_LDB(B1, 1, 1); PG8_STAGE(PG8_SB(1, 0), b3, voffB);
            PG8_BAR; PG8_WAIT_L(0); PG8_MMA(0, 1, At, B1); PG8_BAR;
            PG8_LDA(At, 1, 1); PG8_STAGE(PG8_SA(1, 0), a3, voffA);
            PG8_BAR; PG8_WAIT_L(0); PG8_MMA(1, 0, At, B0); PG8_BAR; PG8_SCHED;
            PG8_STAGE(PG8_SB(1, 1), b3 + hstep, voffB);
            PG8_WAIT_V(6); PG8_BAR; PG8_MMA(1, 1, At, B1); PG8_BAR;
        }
        PG8_STAMP();
        if constexpr (!Epi::AFTER_DRAIN) { E(acc, cur, wr, wc, fr, fq); S.done(cur); }
        PG8_STAMP();
        if (!has_next) break;
#pragma unroll
        for (int a = 0; a < 2; ++a)
#pragma unroll
            for (int b = 0; b < 2; ++b)
#pragma unroll
                for (int m = 0; m < 4; ++m)
#pragma unroll
                    for (int n = 0; n < 2; ++n) acc[a][b][m][n] = (f32x4){0.f, 0.f, 0.f, 0.f};
        cur = nxt; cA = nA; cB = nB; ++ui;
    }
    PG8_WAIT_V(0);
    if (wr == 0) PG8_BAR;
    PG8_BAR;
    if constexpr (Epi::AFTER_DRAIN) { E.fused(acc, cur, wr, wc, fr, fq, lds, wid, lane); S.done(cur); }
    PG8_STAMP();
    if (STAMP && wid == 0) { stamps[lane] = lane < nts ? (((unsigned long long)(unsigned)ts_hi << 32) | (unsigned)ts_lo) : 0ull;
        if (lane == 62) stamps[62] = rt_entry; if (lane == 63) stamps[63] = (unsigned long long)wall_clock64(); }
#undef PG8_STAMP
#undef PG8_SA
#undef PG8_SB
#undef PG8_STAGE
#undef PG8_LDA
#undef PG8_LDB
#undef PG8_MMA
#undef PG8_WAIT_V
#undef PG8_WAIT_L
#undef PG8_BAR
#undef PG8_SCHED
}
}
#define XB_TMO      128
#define XB_XCNT(j)  (256  + 64 * (j))
#define XB_XSUB(j)  (1280 + 64 * (j))
#define XB_XGEN(j)  (2304 + 64 * (j))
#define XB_TOP      3328
#define XB_TOPGEN   3392
#define XCD_BAR_WORDS 3456
#define XB_SPIN_CAP (1u << 22)
#define LAS __attribute__((address_space(3)))

__device__ __forceinline__ unsigned xb_ld(unsigned* p)              { return __hip_atomic_load(p, __ATOMIC_RELAXED, __HIP_MEMORY_SCOPE_AGENT); }
__device__ __forceinline__ unsigned xb_add(unsigned* p, unsigned v) { return __hip_atomic_fetch_add(p, v, __ATOMIC_RELAXED, __HIP_MEMORY_SCOPE_AGENT); }
__device__ __forceinline__ unsigned xb_xcc_id() { return (unsigned)__builtin_amdgcn_s_getreg((3 << 11) | 20) & 0xFu; }
#define XB_SPIN(cond, bar) do { unsigned _sp = 0; while (cond) { __builtin_amdgcn_s_sleep(1); \
    if ((++_sp & 255u) == 0u) { if (xb_ld(&(bar)[XB_TMO])) break; if (_sp > XB_SPIN_CAP) { atomicAdd(&(bar)[XB_TMO], 1u); break; } } } } while (0)

struct XcdBarrier {
    unsigned* bar; unsigned x;
    volatile LAS unsigned* st;
};

__device__ __forceinline__ XcdBarrier xcd_barrier_post(unsigned* bar, volatile LAS unsigned* st, const int tid) {
    XcdBarrier b; b.bar = bar; b.x = xb_xcc_id(); b.st = st;
    if (tid == 0) (void)xb_add(&bar[XB_XCNT(b.x)], 1u);
    return b;
}
__device__ __forceinline__ void xcd_barrier_complete(unsigned* bar, unsigned x, unsigned& nloc, unsigned& nx) {
    const unsigned G = gridDim.x * gridDim.y * gridDim.z;
    unsigned sum, cnt, mine, sp = 0u;
    for (;;) {
        sum = 0u; cnt = 0u; mine = 0u;
#pragma unroll
        for (unsigned j = 0; j < 16; ++j) { const unsigned c = xb_ld(&bar[XB_XCNT(j)]); sum += c; cnt += (c > 0u) ? 1u : 0u; mine = (j == x) ? c : mine; }
        if (sum == G) break;
        __builtin_amdgcn_s_sleep(1);
        if ((++sp & 255u) == 0u) { if (xb_ld(&bar[XB_TMO])) break; if (sp > XB_SPIN_CAP) { atomicAdd(&bar[XB_TMO], 1u); break; } }
    }
    nloc = mine > 0u ? mine : 1u; nx = cnt > 0u ? cnt : 1u;
}

__device__ __forceinline__ void xcd_barrier(const XcdBarrier& b, const int tid) {
    asm volatile("s_waitcnt vmcnt(0)" ::: "memory");
    __syncthreads();
    if (tid == 0) {
        unsigned* bar = b.bar;
        __builtin_amdgcn_s_waitcnt(0);
        unsigned nloc = b.st[0], nx = b.st[1];
        if (nloc == 0u) { xcd_barrier_complete(bar, b.x, nloc, nx); b.st[0] = nloc; b.st[1] = nx; }
        const unsigned old = xb_add(&bar[XB_XSUB(b.x)], 1u);
        const unsigned gen = old / nloc;
        if (old + 1u == (gen + 1u) * nloc) {
            __builtin_amdgcn_fence(__ATOMIC_RELEASE, "agent");
            asm volatile("s_waitcnt vmcnt(0)" ::: "memory");
            const unsigned og = xb_add(&bar[XB_TOP], 1u);
            const unsigned tg = og / nx;
            if (og + 1u == (tg + 1u) * nx) xb_add(&bar[XB_TOPGEN], 1u);
            else XB_SPIN(xb_ld(&bar[XB_TOPGEN]) == tg, bar);
            __builtin_amdgcn_fence(__ATOMIC_ACQUIRE, "agent");
            xb_add(&bar[XB_XGEN(b.x)], 1u);
            asm volatile("s_waitcnt vmcnt(0)" ::: "memory");
        } else {
            XB_SPIN(xb_ld(&bar[XB_XGEN(b.x)]) == gen, bar);
            __builtin_amdgcn_fence(__ATOMIC_ACQUIRE, "agent");
            asm volatile("s_waitcnt vmcnt(0)" ::: "memory");
        }
    }
    __syncthreads();
}
namespace att {
using bf16 = unsigned short;
constexpr int   D = 128, NW = 8, QBLK = 32, KVBLK = 64;
constexpr float SCALE = 0.088388347648318440f;
constexpr float THR = 8.f;
constexpr int SDEPTH = 1;
constexpr size_t SHM_V = KVBLK * D * 2, SHM_K = KVBLK * D * 2, SHM_ATTN = 2 * SHM_V + 2 * SHM_K + NW * 64 * 4;
using bf16x8 = __attribute__((ext_vector_type(8))) short;
using s16x4  = __attribute__((ext_vector_type(4))) short;
using f32x16 = __attribute__((ext_vector_type(16))) float;
using f32x8  = __attribute__((ext_vector_type(8))) float;
using u32x4  = __attribute__((ext_vector_type(4))) unsigned;
#define KSWZ(row, colB) ((row) * 256 + ((colB) ^ (((row) & 7) << 4)))
#define SBAR() __builtin_amdgcn_sched_barrier(0)
__device__ __forceinline__ int crow(int r, int hi) { return (r & 3) + 8 * (r >> 2) + 4 * hi; }
__device__ __forceinline__ unsigned cvtpk(float lo, float hi) {
  unsigned r; asm volatile("v_cvt_pk_bf16_f32 %0, %1, %2" : "=v"(r) : "v"(lo), "v"(hi)); return r;
}
template <typename TIn> struct Stage;
template <> struct Stage<bf16>  { using T = bf16x8;
  __device__ static __forceinline__ T ld8(const bf16* p) { return *reinterpret_cast<const bf16x8*>(p); }
  __device__ static __forceinline__ bf16x8 tobf(T x) { return x; } };
template <> struct Stage<float> { using T = f32x8;
  __device__ static __forceinline__ T ld8(const float* p) { return *reinterpret_cast<const f32x8*>(p); }
  __device__ static __forceinline__ bf16x8 tobf(T x) {
    u32x4 w = {cvtpk(x[0], x[1]), cvtpk(x[2], x[3]), cvtpk(x[4], x[5]), cvtpk(x[6], x[7])}; return *reinterpret_cast<bf16x8*>(&w); } };

__device__ __forceinline__ void partialSM(f32x16& p0, f32x16& p1, float& m_reg, float& mn, float& alpha) {
  constexpr float C = SCALE * 1.4426950408889634f;
  float pmax = p0[0]; for (int r = 1; r < 16; ++r) pmax = fmaxf(pmax, p0[r]); for (int r = 0; r < 16; ++r) pmax = fmaxf(pmax, p1[r]);
  { auto rr = __builtin_amdgcn_permlane32_swap(__float_as_uint(pmax), __float_as_uint(pmax), false, false);
    pmax = fmaxf(__uint_as_float(rr[0]), __uint_as_float(rr[1])); }
  if (__builtin_expect(__all(pmax - m_reg <= THR / SCALE), 1)) { mn = m_reg; alpha = 1.f; }
  else { mn = fmaxf(m_reg, pmax); alpha = __builtin_amdgcn_exp2f((m_reg - mn) * C); m_reg = mn; }
  float mnC = -mn * C;
  for (int r = 0; r < 16; ++r) p0[r] = fmaf(p0[r], C, mnC); for (int r = 0; r < 16; ++r) p1[r] = fmaf(p1[r], C, mnC);
  for (int r = 0; r < 16; ++r) p0[r] = __builtin_amdgcn_exp2f(p0[r]);
}
__device__ __forceinline__ void finishSM(f32x16& p0, f32x16& p1, float alpha, float& l_reg, bf16x8& pa0, bf16x8& pa1, bf16x8& pa2, bf16x8& pa3) {
  for (int r = 0; r < 16; ++r) p1[r] = __builtin_amdgcn_exp2f(p1[r]);
  float ps = 0; for (int r = 0; r < 16; ++r) ps += p0[r]; for (int r = 0; r < 16; ++r) ps += p1[r];
  { auto rr = __builtin_amdgcn_permlane32_swap(__float_as_uint(ps), __float_as_uint(ps), false, false);
    ps = __uint_as_float(rr[0]) + __uint_as_float(rr[1]); }
  l_reg = l_reg * alpha + ps;
#define PK4(P, BASE, OUT) do { unsigned a0 = cvtpk(P[BASE + 0], P[BASE + 1]), a1 = cvtpk(P[BASE + 2], P[BASE + 3]);   \
    unsigned b0 = cvtpk(P[BASE + 4], P[BASE + 5]), b1 = cvtpk(P[BASE + 6], P[BASE + 7]);                              \
    auto r0 = __builtin_amdgcn_permlane32_swap(a0, b0, false, false); auto r1 = __builtin_amdgcn_permlane32_swap(a1, b1, false, false); \
    u32x4 w = {r0[0], r1[0], r0[1], r1[1]}; OUT = *reinterpret_cast<bf16x8*>(&w); } while (0)
  PK4(p0, 0, pa0); PK4(p0, 8, pa1); PK4(p1, 0, pa2); PK4(p1, 8, pa3);
#undef PK4
}
__device__ __forceinline__ void qkt(f32x16& p0, f32x16& p1, const bf16* Ks, const bf16x8* qr, int r32, int hi) {
  p0 = f32x16{}; p1 = f32x16{};
  bf16x8 c0 = *reinterpret_cast<const bf16x8*>((const char*)Ks + KSWZ(r32, (hi * 8) * 2)), c1 = *reinterpret_cast<const bf16x8*>((const char*)Ks + KSWZ(32 + r32, (hi * 8) * 2));
#pragma unroll
  for (int d0 = 0; d0 < 8; ++d0) {
    bf16x8 n0 = c0, n1 = c1;
    if (d0 < 7) { const int cb = ((d0 + 1) * 16 + hi * 8) * 2;
      n0 = *reinterpret_cast<const bf16x8*>((const char*)Ks + KSWZ(r32, cb)); n1 = *reinterpret_cast<const bf16x8*>((const char*)Ks + KSWZ(32 + r32, cb)); }
    p0 = __builtin_amdgcn_mfma_f32_32x32x16_bf16(c0, qr[d0], p0, 0, 0, 0);
    p1 = __builtin_amdgcn_mfma_f32_32x32x16_bf16(c1, qr[d0], p1, 0, 0, 0);
    c0 = n0; c1 = n1; }
}
template <int OFF> __device__ __forceinline__ bf16x8 k_read(const int addr) {
  bf16x8 r; asm volatile("ds_read_b128 %0, %1 offset:%2" : "=&v"(r) : "v"(addr), "i"(OFF) : "memory"); return r;
}
template <int D0> __device__ __forceinline__ void qkt_step(f32x16& p0, f32x16& p1, const int (&a)[4], const bf16x8* qr, bf16x8 c0, bf16x8 c1) {
  bf16x8 n0 = c0, n1 = c1;
  if constexpr (D0 < 7) { n0 = k_read<((D0 + 1) >> 2) * 128>(a[(D0 + 1) & 3]); n1 = k_read<((D0 + 1) >> 2) * 128 + 8192>(a[(D0 + 1) & 3]); asm volatile("s_waitcnt lgkmcnt(2)" ::: "memory"); }
  else asm volatile("s_waitcnt lgkmcnt(0)" ::: "memory");
  SBAR();
  p0 = __builtin_amdgcn_mfma_f32_32x32x16_bf16(c0, qr[D0], p0, 0, 0, 0);
  p1 = __builtin_amdgcn_mfma_f32_32x32x16_bf16(c1, qr[D0], p1, 0, 0, 0);
  if constexpr (D0 < 7) qkt_step<D0 + 1>(p0, p1, a, qr, n0, n1);
}
__device__ __forceinline__ void qkt_pipe(f32x16& p0, f32x16& p1, const int ka, const bf16x8* qr, const int r32, const int hi) {
  p0 = f32x16{}; p1 = f32x16{};
  int a[4];
#pragma unroll
  for (int q = 0; q < 4; ++q) a[q] = ka + r32 * 256 + ((q * 32 + hi * 16) ^ ((r32 & 7) << 4));
  const bf16x8 c0 = k_read<0>(a[0]), c1 = k_read<8192>(a[0]);
  qkt_step<0>(p0, p1, a, qr, c0, c1);
}
__device__ __forceinline__ int v_st(int k, int c) { const int kk = (k & ~0xC) | ((k & 4) << 1) | ((k & 8) >> 1); return ((kk >> 3) * 4 + (c >> 5)) * 512 + ((kk & 7) * 32 + (c & 31)) * 2; }
__device__ __forceinline__ int v_rd_base(int lane) { return ((lane & 3) << 3) | (((lane >> 2) & 3) << 6) | (((lane >> 4) & 1) << 5) | (((lane >> 5) & 1) << 8); }
constexpr int v_rd_off(int d0, int ks, int half) { return d0 * 512 + ks * 4096 + half * 2048; }
template <int OFF> __device__ __forceinline__ s16x4 tr_read(int vb) {
  s16x4 r; asm volatile("ds_read_b64_tr_b16 %0, %1 offset:%2" : "=&v"(r) : "v"(vb), "i"(OFF) : "memory"); return r;
}
template <int D0> __device__ __forceinline__ void pv_one(f32x16& od, int vb, bf16x8 pa0, bf16x8 pa1, bf16x8 pa2, bf16x8 pa3) {
  const s16x4 l0 = tr_read<v_rd_off(D0, 0, 0)>(vb), h0 = tr_read<v_rd_off(D0, 0, 1)>(vb), l1 = tr_read<v_rd_off(D0, 1, 0)>(vb), h1 = tr_read<v_rd_off(D0, 1, 1)>(vb);
  const s16x4 l2 = tr_read<v_rd_off(D0, 2, 0)>(vb), h2 = tr_read<v_rd_off(D0, 2, 1)>(vb), l3 = tr_read<v_rd_off(D0, 3, 0)>(vb), h3 = tr_read<v_rd_off(D0, 3, 1)>(vb);
  asm volatile("s_waitcnt lgkmcnt(0)" ::: "memory"); SBAR();
#define PK(L, H) (bf16x8){L[0], L[1], L[2], L[3], H[0], H[1], H[2], H[3]}
  od = __builtin_amdgcn_mfma_f32_32x32x16_bf16(pa0, PK(l0, h0), od, 0, 0, 0);
  od = __builtin_amdgcn_mfma_f32_32x32x16_bf16(pa1, PK(l1, h1), od, 0, 0, 0);
  od = __builtin_amdgcn_mfma_f32_32x32x16_bf16(pa2, PK(l2, h2), od, 0, 0, 0);
  od = __builtin_amdgcn_mfma_f32_32x32x16_bf16(pa3, PK(l3, h3), od, 0, 0, 0);
#undef PK
}
__device__ __forceinline__ void pv_d0(f32x16* o, int vb, bf16x8 pa0, bf16x8 pa1, bf16x8 pa2, bf16x8 pa3) {
  pv_one<0>(o[0], vb, pa0, pa1, pa2, pa3); pv_one<1>(o[1], vb, pa0, pa1, pa2, pa3); pv_one<2>(o[2], vb, pa0, pa1, pa2, pa3); pv_one<3>(o[3], vb, pa0, pa1, pa2, pa3);
}

template <int B> __device__ __forceinline__ void pv_rd8(s16x4 (&f)[8], const int vb) {
  constexpr int D0 = B & 3, HB = (B >> 2) * 16384;
  f[0] = tr_read<HB + v_rd_off(D0, 0, 0)>(vb); f[1] = tr_read<HB + v_rd_off(D0, 0, 1)>(vb); f[2] = tr_read<HB + v_rd_off(D0, 1, 0)>(vb); f[3] = tr_read<HB + v_rd_off(D0, 1, 1)>(vb);
  f[4] = tr_read<HB + v_rd_off(D0, 2, 0)>(vb); f[5] = tr_read<HB + v_rd_off(D0, 2, 1)>(vb); f[6] = tr_read<HB + v_rd_off(D0, 3, 0)>(vb); f[7] = tr_read<HB + v_rd_off(D0, 3, 1)>(vb);
}
__device__ __forceinline__ void pv_mma4(f32x16& od, const s16x4 (&f)[8], bf16x8 pa0, bf16x8 pa1, bf16x8 pa2, bf16x8 pa3) {
#define PK(L, H) (bf16x8){L[0], L[1], L[2], L[3], H[0], H[1], H[2], H[3]}
  od = __builtin_amdgcn_mfma_f32_32x32x16_bf16(pa0, PK(f[0], f[1]), od, 0, 0, 0);
  od = __builtin_amdgcn_mfma_f32_32x32x16_bf16(pa1, PK(f[2], f[3]), od, 0, 0, 0);
  od = __builtin_amdgcn_mfma_f32_32x32x16_bf16(pa2, PK(f[4], f[5]), od, 0, 0, 0);
  od = __builtin_amdgcn_mfma_f32_32x32x16_bf16(pa3, PK(f[6], f[7]), od, 0, 0, 0);
#undef PK
}
template <int B, int NB> __device__ __forceinline__ void pv_pipe_step(f32x16* o, s16x4 (&cur)[8], s16x4 (&nxt)[8], const int vb, bf16x8 pa0, bf16x8 pa1, bf16x8 pa2, bf16x8 pa3) {
  if constexpr (B + 1 < NB) { pv_rd8<B + 1>(nxt, vb); asm volatile("s_waitcnt lgkmcnt(8)" ::: "memory"); }
  else asm volatile("s_waitcnt lgkmcnt(0)" ::: "memory");
  SBAR();
  pv_mma4(o[B], cur, pa0, pa1, pa2, pa3);
  if constexpr (B + 1 < NB) pv_pipe_step<B + 1, NB>(o, nxt, cur, vb, pa0, pa1, pa2, pa3);
}
template <int NB> __device__ __forceinline__ void pv_pipe(f32x16* o, const int vb, bf16x8 pa0, bf16x8 pa1, bf16x8 pa2, bf16x8 pa3) {
  s16x4 fa[8], fb[8];
  pv_rd8<0>(fa, vb);
  pv_pipe_step<0, NB>(o, fa, fb, vb, pa0, pa1, pa2, pa3);
}

template <typename TQ, int LDQ, int LDK, int LDO, typename TO>
__device__ __forceinline__ void attn_dense_body(const TQ* __restrict__ Qb, const bf16* __restrict__ Kh, const bf16* __restrict__ Vh,
                                                TO* __restrict__ Ob, int seq, char* lds, const int tid_in) {
  using St = Stage<bf16>; using SQ = Stage<TQ>;
  const int tid = tid_in, wid = tid >> 6, lane = tid & 63, r32 = lane & 31, hi = lane >> 5;
  bf16* V_lds = (bf16*)lds; bf16* K_lds = (bf16*)(lds + 2 * SHM_V);
  float* ws = (float*)(lds + 2 * SHM_V + 2 * SHM_K) + wid * 64; float* li_l = ws; float* al_l = ws + 32;
  float m_reg = -1e30f, l_reg = 0; f32x16 o[4] = {}; bf16x8 qr[8];
  const TQ* Qw = Qb + ((wid * QBLK + r32) * LDQ + hi * 8);
#pragma unroll
  for (int d0 = 0; d0 < 8; ++d0) qr[d0] = SQ::tobf(SQ::ld8(Qw + d0 * 16));
  const int sr = tid >> 4, sc = (tid & 15) * 8, vst0 = v_st(sr, sc), vst1 = v_st(32 + sr, sc);
  const int vb0 = (int)(uintptr_t)V_lds + v_rd_base(lane);
  struct { typename St::T vs0, vs1, ks0, ks1; } sr_[SDEPTH];
#define SLOAD(i, k0) do { sr_[i].vs0 = St::ld8(Vh + (((k0) + sr) * LDK + sc)); sr_[i].vs1 = St::ld8(Vh + (((k0) + 32 + sr) * LDK + sc)); \
    sr_[i].ks0 = St::ld8(Kh + (((k0) + sr) * LDK + sc)); sr_[i].ks1 = St::ld8(Kh + (((k0) + 32 + sr) * LDK + sc)); } while (0)
#define SWRITE(b, i) do { *(bf16x8*)((char*)V_lds + (b) * SHM_V + vst0) = St::tobf(sr_[i].vs0);          \
    *(bf16x8*)((char*)V_lds + (b) * SHM_V + vst1) = St::tobf(sr_[i].vs1); int kc = sc * 2;               \
    *(bf16x8*)((char*)K_lds + (b) * SHM_K + KSWZ(sr, kc)) = St::tobf(sr_[i].ks0);                       \
    *(bf16x8*)((char*)K_lds + (b) * SHM_K + KSWZ(32 + sr, kc)) = St::tobf(sr_[i].ks1); } while (0)
#define SWAIT() do { if constexpr (SDEPTH == 2) asm volatile("s_waitcnt vmcnt(4)" ::: "memory"); else asm volatile("s_waitcnt vmcnt(0)" ::: "memory"); } while (0)
#define RESC(a) do { if (__any((a) < 1.f)) { if (hi == 0) al_l[r32] = (a); asm volatile("s_waitcnt lgkmcnt(0)" ::: "memory"); \
    for (int d = 0; d < 4; ++d) for (int r = 0; r < 16; ++r) o[d][r] *= al_l[crow(r, hi)]; } } while (0)
  f32x16 pA0, pA1, pB0, pB1; float mnA, mnB, alA, alB; bf16x8 pa0, pa1, pa2, pa3; const int NT = seq / KVBLK;
  constexpr int SE = 0, SO = SDEPTH - 1;
  SLOAD(SE, 0); asm volatile("s_waitcnt vmcnt(0)" ::: "memory"); SWRITE(0, SE); __syncthreads();
  qkt(pA0, pA1, K_lds, qr, r32, hi); partialSM(pA0, pA1, m_reg, mnA, alA);
  SLOAD(SO, KVBLK); if constexpr (SDEPTH == 2) { if (2 < NT) SLOAD(SE, 2 * KVBLK); }
  SWAIT(); SWRITE(1, SO); __syncthreads();
  for (int j = 1; j + 1 < NT; j += 2) {
    SBAR(); qkt(pB0, pB1, (bf16*)((char*)K_lds + SHM_K), qr, r32, hi);
    finishSM(pA0, pA1, alA, l_reg, pa0, pa1, pa2, pa3); SBAR();
    SLOAD(SO, (j + SDEPTH) * KVBLK); SBAR();
    pv_d0(o, vb0, pa0, pa1, pa2, pa3); partialSM(pB0, pB1, m_reg, mnB, alB);
    __syncthreads(); SWAIT(); SWRITE(0, SE);
    RESC(alB); __syncthreads();
    SBAR(); qkt(pA0, pA1, K_lds, qr, r32, hi);
    finishSM(pB0, pB1, alB, l_reg, pa0, pa1, pa2, pa3); SBAR();
    if (SDEPTH == 1 || j + 3 < NT) SLOAD(SE, (j + 1 + SDEPTH) * KVBLK); SBAR();
    pv_d0(o, vb0 + (int)SHM_V, pa0, pa1, pa2, pa3); partialSM(pA0, pA1, m_reg, mnA, alA);
    __syncthreads(); SWAIT(); SWRITE(1, SO);
    RESC(alA); __syncthreads();
  }
  SBAR(); qkt(pB0, pB1, (bf16*)((char*)K_lds + SHM_K), qr, r32, hi);
  finishSM(pA0, pA1, alA, l_reg, pa0, pa1, pa2, pa3); SBAR();
  pv_d0(o, vb0, pa0, pa1, pa2, pa3); partialSM(pB0, pB1, m_reg, mnB, alB);
  __syncthreads(); RESC(alB);
  finishSM(pB0, pB1, alB, l_reg, pa0, pa1, pa2, pa3); SBAR();
  pv_d0(o, vb0 + (int)SHM_V, pa0, pa1, pa2, pa3);
  if (hi == 0) li_l[r32] = l_reg; asm volatile("s_waitcnt lgkmcnt(0)" ::: "memory");
  float rli[16];
#pragma unroll
  for (int r = 0; r < 16; ++r) rli[r] = __builtin_amdgcn_rcpf(li_l[crow(r, hi)]);
  TO* Ow = Ob + (wid * QBLK) * LDO;
#pragma unroll
  for (int r = 0; r < 16; ++r) { int orow = crow(r, hi);
    for (int d0 = 0; d0 < 4; ++d0) { const float val = o[d0][r] * rli[r];
      if constexpr (sizeof(TO) == 4) Ow[orow * LDO + d0 * 32 + r32] = val;
      else Ow[orow * LDO + d0 * 32 + r32] = (TO)(cvtpk(val, val) & 0xffffu); } }
#undef SLOAD
#undef SWRITE
#undef SWAIT
#undef RESC
}

template <int WIN>
__device__ __forceinline__ void attn_banded_body(const bf16* __restrict__ Qp, const bf16* __restrict__ Kp, const bf16* __restrict__ Vp, const long rs, const int Lseq, const int P0,
                                                 const float m_init, const float l_init, bf16* __restrict__ Ob, const long os, float* __restrict__ Lp, const long ls, char* lds, const int tid) {
  const int wid = __builtin_amdgcn_readfirstlane(tid >> 6), lane = tid & 63, r32 = lane & 31, hi = lane >> 5;
  constexpr int BT = 32768;
  float* wsf = (float*)(lds + 2 * BT) + wid * 64; float* li_l = wsf; float* al_l = wsf + 32;
  float m_reg = m_init, l_reg = l_init; f32x16 o[4] = {}; bf16x8 qr[8];
  const bf16* Qw = Qp + (long)(P0 + wid * QBLK + r32) * rs + hi * 8;
#pragma unroll
  for (int d0 = 0; d0 < 8; ++d0) qr[d0] = *reinterpret_cast<const bf16x8*>(Qw + d0 * 16);
  const int irs = (int)rs;
  int ksrc[2], vsrc[2];
#pragma unroll
  for (int i = 0; i < 2; ++i) { const int c = 2 * wid + i, row = 4 * c + (lane >> 4), colB = (16 * (lane & 15)) ^ ((row & 7) << 4); ksrc[i] = row * irs + (colB >> 1);
      const int sub = 2 * c + (lane >> 5), kk = ((sub >> 2) << 3) | ((lane & 31) >> 2), k = (kk & ~0xC) | ((kk & 4) << 1) | ((kk & 8) >> 1), col = (sub & 3) * 32 + 8 * (lane & 3); vsrc[i] = k * irs + col; }
  using LP = __attribute__((address_space(3))) unsigned*;
#define BB_DMA(buf, tb) do { const bf16* _kb = Kp + (long)(tb) * rs; const bf16* _vb = Vp + (long)(tb) * rs; char* _l = lds + (buf) * BT; \
    _Pragma("unroll") for (int _i = 0; _i < 2; ++_i) { __builtin_amdgcn_global_load_lds((const unsigned*)(_kb + ksrc[_i]), (LP)(_l + (2 * wid + _i) * 1024), 16, 0, 0); \
                                                       __builtin_amdgcn_global_load_lds((const unsigned*)(_vb + vsrc[_i]), (LP)(_l + 16384 + (2 * wid + _i) * 1024), 16, 0, 0); } } while (0)
  constexpr int NT = (256 + 2 * WIN) / 64, NTW = (2 * WIN + 32 + 63) / 64;
  const int klo = wid >> 1, qpos = P0 + wid * QBLK + r32;
  int kf = 0; while (P0 - WIN + 64 * kf < 0) ++kf;
  int kl = NT - 1; while (P0 - WIN + 64 * kl >= Lseq) --kl;
  BB_DMA(kf & 1, P0 - WIN + 64 * kf);
  for (int k = kf; k <= kl; ++k) {
    const int tb = P0 - WIN + 64 * k;
    asm volatile("s_waitcnt vmcnt(0)" ::: "memory");
    __builtin_amdgcn_s_barrier();
    asm volatile("" ::: "memory");
    if (k < kl) BB_DMA((k + 1) & 1, tb + 64);
    char* tbuf = lds + (k & 1) * BT;
    if (k >= klo && k < klo + NTW) {
      f32x16 p0, p1; float mn, al; bf16x8 pa0, pa1, pa2, pa3;
      qkt_pipe(p0, p1, (int)(uintptr_t)tbuf, qr, r32, hi);
      if (k == klo || k == klo + NTW - 1) {
#pragma unroll
        for (int r = 0; r < 16; ++r) { const int d = qpos - (tb + crow(r, hi));
          if (d > WIN || d < -WIN) p0[r] = -1e30f;
          if (d - 32 > WIN || d - 32 < -WIN) p1[r] = -1e30f; }
      }
      partialSM(p0, p1, m_reg, mn, al);
      if (__any(al < 1.f)) { if (hi == 0) al_l[r32] = al; asm volatile("s_waitcnt lgkmcnt(0)" ::: "memory");
#pragma unroll
        for (int d = 0; d < 4; ++d)
#pragma unroll
          for (int r = 0; r < 16; ++r) o[d][r] *= al_l[crow(r, hi)]; }
      finishSM(p0, p1, al, l_reg, pa0, pa1, pa2, pa3); SBAR();
      pv_pipe<4>(o, (int)(uintptr_t)(tbuf + 16384) + v_rd_base(lane), pa0, pa1, pa2, pa3);
    }
  }
#undef BB_DMA
  if (hi == 0) li_l[r32] = l_reg; asm volatile("s_waitcnt lgkmcnt(0)" ::: "memory");
  float rli[16];
#pragma unroll
  for (int r = 0; r < 16; ++r) rli[r] = __builtin_amdgcn_rcpf(li_l[crow(r, hi)]);
  bf16* Ow = Ob + (long)(P0 + wid * QBLK) * os;
#pragma unroll
  for (int r = 0; r < 16; ++r) { const int orow = crow(r, hi);
#pragma unroll
    for (int d0 = 0; d0 < 4; ++d0) { const float val = o[d0][r] * rli[r]; ((__attribute__((address_space(1))) bf16*)Ow)[(long)orow * os + d0 * 32 + r32] = (bf16)(cvtpk(val, val) & 0xffffu); } }
  if (Lp != nullptr && hi == 0) Lp[(long)(P0 + wid * QBLK + r32) * ls] = m_reg * SCALE + __logf(l_reg);
}

constexpr int WB_TILE = 49152, WB_WS = 2 * WB_TILE;
template <int LDQ, int LDK, int LDO, int NVH, typename TO, bool COMBINE = false, int LDC = 0>
__device__ __forceinline__ void attn_wide_body(const bf16* __restrict__ Qb, const bf16* __restrict__ Kh, const bf16* __restrict__ Vh, TO* __restrict__ Ob, const int seq, char* lds, const int tid,
                                               const float lam = 0.f, const float gsc = 0.f, const float* __restrict__ gain = nullptr, bf16* __restrict__ Cb = nullptr) {
  const int wid = __builtin_amdgcn_readfirstlane(tid >> 6), lane = tid & 63, r32 = lane & 31, hi = lane >> 5;
  float* wsf = (float*)(lds + WB_WS) + wid * 64; float* li_l = wsf; float* al_l = wsf + 32;
  float m_reg = -1e30f, l_reg = 0; f32x16 o[4 * NVH] = {}; bf16x8 qr[8];
  { const bf16* Qw = Qb + ((wid * QBLK + r32) * LDQ + hi * 8);
#pragma unroll
    for (int d0 = 0; d0 < 8; ++d0) qr[d0] = *reinterpret_cast<const bf16x8*>(Qw + d0 * 16); }
  constexpr int NVP = 2 * NVH;
  int ksrc[2], vsrc[NVP];
#pragma unroll
  for (int i = 0; i < 2; ++i) { const int c = 2 * wid + i, row = 4 * c + (lane >> 4), colB = (16 * (lane & 15)) ^ ((row & 7) << 4); ksrc[i] = row * LDK + (colB >> 1); }
#pragma unroll
  for (int i = 0; i < NVP; ++i) { const int pc = wid * NVP + i, hf = pc >> 4, c = pc & 15, sub = 2 * c + (lane >> 5), kk = ((sub >> 2) << 3) | ((lane & 31) >> 2);
      const int k = (kk & ~0xC) | ((kk & 4) << 1) | ((kk & 8) >> 1), col = (sub & 3) * 32 + 8 * (lane & 3); vsrc[i] = k * LDK + hf * 128 + col; }
  using LP = __attribute__((address_space(3))) unsigned*;
#define WB_DMA(buf, key0) do { const bf16* _kb = Kh + (key0) * LDK; const bf16* _vb = Vh + (key0) * LDK; char* _l = lds + (buf) * WB_TILE; \
    _Pragma("unroll") for (int _i = 0; _i < 2; ++_i) __builtin_amdgcn_global_load_lds((const unsigned*)(_kb + ksrc[_i]), (LP)(_l + (2 * wid + _i) * 1024), 16, 0, 0); \
    _Pragma("unroll") for (int _i = 0; _i < NVP; ++_i) __builtin_amdgcn_global_load_lds((const unsigned*)(_vb + vsrc[_i]), (LP)(_l + 16384 + (wid * NVP + _i) * 1024), 16, 0, 0); } while (0)
  const int NT = seq / KVBLK;
  WB_DMA(0, 0);
  for (int j = 0; j < NT; ++j) {
    asm volatile("s_waitcnt vmcnt(0)" ::: "memory");
    __builtin_amdgcn_s_barrier();
    asm volatile("" ::: "memory");
    if (j + 1 < NT) WB_DMA((j + 1) & 1, (j + 1) * KVBLK);
    char* tb = lds + (j & 1) * WB_TILE;
    f32x16 p0, p1; float mn, al; bf16x8 pa0, pa1, pa2, pa3;
    qkt_pipe(p0, p1, (int)(uintptr_t)tb, qr, r32, hi);
    partialSM(p0, p1, m_reg, mn, al);
    if (__any(al < 1.f)) { if (hi == 0) al_l[r32] = al; asm volatile("s_waitcnt lgkmcnt(0)" ::: "memory");
#pragma unroll
      for (int d = 0; d < 4 * NVH; ++d)
#pragma unroll
        for (int r = 0; r < 16; ++r) o[d][r] *= al_l[crow(r, hi)]; }
    finishSM(p0, p1, al, l_reg, pa0, pa1, pa2, pa3); SBAR();
    const int vb0 = (int)(uintptr_t)(tb + 16384) + v_rd_base(lane);
    pv_pipe<4 * NVH>(o, vb0, pa0, pa1, pa2, pa3);
  }
#undef WB_DMA
  int te = tid; asm volatile("" : "+v"(te));
  const int wid_e = __builtin_amdgcn_readfirstlane(te >> 6), r32_e = te & 31, hi_e = (te >> 5) & 1;
  float* li_e = (float*)(lds + WB_WS) + wid_e * 64;
  if (hi_e == 0) li_e[r32_e] = l_reg; asm volatile("s_waitcnt lgkmcnt(0)" ::: "memory");
  float rli[16];
#pragma unroll
  for (int r = 0; r < 16; ++r) rli[r] = __builtin_amdgcn_rcpf(li_e[crow(r, hi_e)]);
  TO* Ow = Ob + (wid_e * QBLK) * LDO;
  if constexpr (!COMBINE) {
#pragma unroll
    for (int r = 0; r < 16; ++r) { const int orow = crow(r, hi_e);
#pragma unroll
      for (int d0 = 0; d0 < 4 * NVH; ++d0) { const float val = o[d0][r] * rli[r];
        if constexpr (sizeof(TO) == 4) ((__attribute__((address_space(1))) TO*)Ow)[orow * LDO + d0 * 32 + r32_e] = val; else ((__attribute__((address_space(1))) TO*)Ow)[orow * LDO + d0 * 32 + r32_e] = (TO)(cvtpk(val, val) & 0xffffu); } }
  } else {
    static_assert(sizeof(TO) == 4 && NVH == 2, "combine: f32 first-map tile, 256-wide rows");
    float gn[8];
    { const float* g2 = gain; asm volatile("" : "+s"(g2));
#pragma unroll
      for (int d0 = 0; d0 < 8; ++d0) gn[d0] = g2[d0 * 32 + r32_e] * gsc; }
    bf16* Cw; { bf16* c2 = Cb; asm volatile("" : "+s"(c2)); Cw = c2 + (wid_e * QBLK) * LDC; }
    { TO* o2 = Ob; asm volatile("" : "+s"(o2)); Ow = o2 + (wid_e * QBLK) * LDO; }
#pragma unroll
    for (int r = 0; r < 16; ++r) { const int orow = crow(r, hi_e);
      float ss = 0.f;
#pragma unroll
      for (int d0 = 0; d0 < 8; ++d0) { const float o1 = __hip_atomic_load((const __attribute__((address_space(1))) float*)Ow + orow * LDO + d0 * 32 + r32_e, __ATOMIC_RELAXED, __HIP_MEMORY_SCOPE_AGENT);
        const float av = o1 - lam * (o[d0][r] * rli[r]); o[d0][r] = av; ss = fmaf(av, av, ss); }
#define WB_SWZ(v, m) __int_as_float(__builtin_amdgcn_ds_swizzle(__float_as_int(v), ((m) << 10) | 0x1F))
      ss += WB_SWZ(ss, 1); ss += WB_SWZ(ss, 2); ss += WB_SWZ(ss, 4); ss += WB_SWZ(ss, 8); ss += WB_SWZ(ss, 16);
#undef WB_SWZ
      const float sc = 1.0f / sqrtf(ss * (1.0f / 256.0f) + 1e-6f);
#pragma unroll
      for (int d0 = 0; d0 < 8; ++d0) { const float val = o[d0][r] * sc * gn[d0]; ((__attribute__((address_space(1))) bf16*)Cw)[orow * LDC + d0 * 32 + r32_e] = (bf16)(cvtpk(val, val) & 0xffffu); }
      asm volatile("" ::: "memory"); }
  }
}
}
typedef unsigned short bf16_t;
typedef unsigned u32x4v __attribute__((ext_vector_type(4)));
#define LDSA __attribute__((address_space(3)))
#define GLB __attribute__((address_space(1)))
constexpr size_t al256(size_t x) { return (x + 255) / 256 * 256; }
constexpr size_t WS_CTL  = 0;
constexpr size_t CTL_BYTES = 65536;
constexpr size_t WS_XB   = WS_CTL + CTL_BYTES;
constexpr size_t WS_WAB  = WS_XB + (size_t)SEQ * DM * 2;
constexpr size_t WS_WOAB = WS_WAB + (size_t)12288 * 4096 * 2;
constexpr size_t WS_WCD  = WS_WOAB + (size_t)4096 * 3072 * 2;
constexpr size_t WS_WOCD = WS_WCD + (size_t)9216 * 4096 * 2;
constexpr size_t WS_WQ   = WS_WOCD + (size_t)4096 * 4096 * 2;
constexpr size_t WS_UB   = WS_WQ + (size_t)2 * 2048 * 4096 * 2;
constexpr size_t WS_VB   = WS_UB + (size_t)2 * 16384 * 3072;
constexpr size_t WS_SU   = WS_VB + (size_t)2 * 16384 * 3072;
constexpr size_t WS_SV   = WS_SU + (size_t)2 * 16384 * 4;
constexpr size_t WS_H    = WS_SV + (size_t)2 * 16384 * 4;
constexpr size_t WS_Y    = WS_H;
constexpr size_t WS_PQ   = WS_H + (size_t)SEQ * 4096 * 4;
constexpr size_t WS_OC   = WS_H + (size_t)SEQ * 12288 * 4;
constexpr size_t WS_AB   = WS_OC + (size_t)2 * SEQ * 2048 * 4;
constexpr size_t WS_X1   = WS_AB + (size_t)SEQ * 4096 * 2;
constexpr size_t WS_X1B  = WS_X1 + (size_t)SEQ * 4096 * 4;
constexpr size_t WS_X2   = WS_X1B + (size_t)SEQ * 4096 * 2;
constexpr size_t WS_X2B  = WS_X2 + (size_t)SEQ * 4096 * 4;
constexpr size_t WS_EIDX = WS_X2B + (size_t)SEQ * 4096 * 2;
constexpr size_t WS_GATE = WS_EIDX + (size_t)SEQ * 128 * 4;
constexpr size_t WS_HB   = WS_GATE + (size_t)SEQ * 128 * 4;
constexpr size_t WS_KEYB = WS_HB + (size_t)SEQ * 12288 * 2;
constexpr size_t WS_CS0  = WS_KEYB + (size_t)2 * 8 * 2 * 128 * 128 * 2;
constexpr size_t WS_CSA  = WS_CS0 + (size_t)SEQ * 16 * 8;
constexpr size_t WS_END  = WS_CSA + (size_t)128 * 32 * 8;
static_assert(WS_END <= (size_t)2147483648ull, "workspace");

constexpr int LDS_BYTES = 155648;
constexpr int LDS_MISC = 139264;

struct MK { const float* in[21]; float* out; unsigned char* ws; int ph_lo, ph_hi; };

namespace pg8 {
struct EpiF32R {
    static constexpr bool PERM = false, AFTER_DRAIN = false;
    float* C; int ldc; const float* R; float ralpha;
    __device__ __forceinline__ void operator()(const f32x4 (&acc)[2][2][4][2], const Unit& u, int wr, int wc, int fr, int fq) const {
        const int row0 = u.pm * BM + wr * 64 + fr, col0 = u.pn * BM + wc * 32 + 4 * fq;
#pragma unroll
        for (int ai = 0; ai < 2; ++ai)
#pragma unroll
            for (int m = 0; m < 4; ++m) { const size_t off = (size_t)(row0 + ai * HALF + m * 16) * ldc + col0;
#pragma unroll
                for (int bj = 0; bj < 2; ++bj)
#pragma unroll
                    for (int n = 0; n < 2; ++n) { f32x4 v = acc[ai][bj][m][n];
                        if (R) { const f32x4 r = *(const GLB f32x4*)(R + off + bj * HALF + n * 16); v += r * ralpha; }
                        *(GLB f32x4*)(C + off + bj * HALF + n * 16) = v; } }
    }
};
struct EpiBf16P {
    static constexpr bool PERM = true, AFTER_DRAIN = false;
    bf16_t* O; int ldc;
    __device__ __forceinline__ void operator()(const f32x4 (&acc)[2][2][4][2], const Unit& u, int wr, int wc, int fr, int fq) const {
        const int row0 = u.pm * BM + wr * 64 + fr, col0 = u.pn * BM + wc * 32 + 8 * fq;
#pragma unroll
        for (int ai = 0; ai < 2; ++ai)
#pragma unroll
            for (int m = 0; m < 4; ++m) { bf16_t* rowp = O + (size_t)(row0 + ai * HALF + m * 16) * ldc + col0;
#pragma unroll
                for (int bj = 0; bj < 2; ++bj) { const f32x4 v0 = acc[ai][bj][m][0], v1 = acc[ai][bj][m][1];
                    u32x4 w; w.x = cvt_pk_bf16(v0[0], v0[1]); w.y = cvt_pk_bf16(v0[2], v0[3]); w.z = cvt_pk_bf16(v1[0], v1[1]); w.w = cvt_pk_bf16(v1[2], v1[3]);
                    *(GLB u32x4*)(rowp + bj * HALF) = w; } }
    }
};

template <int LAYER> struct EpiProj {
    static constexpr bool PERM = true, AFTER_DRAIN = false;
    bf16_t* O; int ldc; const float* cs0; const float* csa; const float* gq; const float* gk; PG8_LAS float* xch;
    __device__ __forceinline__ void operator()(const f32x4 (&acc)[2][2][4][2], const Unit& u, int wr, int wc, int fr, int fq) const {
        const int row0 = u.pm * BM + wr * 64 + fr, col0 = u.pn * BM + wc * 32 + 8 * fq;
        const int pn = u.pn;
        const bool prope = LAYER == 0 ? (pn < 10 || (pn >= 12 && pn < 36)) : (pn < 16);
        const bool dnorm = LAYER == 1 && pn >= 24 && pn < 34;
        float rs[2][4][2];
        float gn[8];
        if (dnorm) {
            const int lrow = fr;
#pragma unroll
            for (int ai = 0; ai < 2; ++ai)
#pragma unroll
                for (int m = 0; m < 4; ++m)
#pragma unroll
                    for (int bj = 0; bj < 2; ++bj) { const f32x4 a = acc[ai][bj][m][0], b = acc[ai][bj][m][1];
                        float q = (a[0] * a[0] + a[1] * a[1]) + (a[2] * a[2] + a[3] * a[3]) + (b[0] * b[0] + b[1] * b[1]) + (b[2] * b[2] + b[3] * b[3]);
                        q += __shfl_xor(q, 16); q += __shfl_xor(q, 32);
                        if (fq == 0) xch[((wr * 128 + (ai * 4 + m) * 16 + lrow) * 2 + bj) * 4 + wc] = q; }
            asm volatile("s_waitcnt lgkmcnt(0)" ::: "memory"); __builtin_amdgcn_s_barrier(); asm volatile("" ::: "memory");
#pragma unroll
            for (int ai = 0; ai < 2; ++ai)
#pragma unroll
                for (int m = 0; m < 4; ++m)
#pragma unroll
                    for (int bj = 0; bj < 2; ++bj) { const f32x4 p = *(const PG8_LAS f32x4*)(xch + ((wr * 128 + (ai * 4 + m) * 16 + lrow) * 2 + bj) * 4);
                        rs[ai][m][bj] = 1.0f / sqrtf(((p[0] + p[1]) + (p[2] + p[3])) * (1.0f / 128.0f) + 1e-6f); }
            const float* g = pn < 32 ? gq : gk;
#pragma unroll
            for (int e = 0; e < 8; ++e) { const int p = wc * 32 + 8 * fq + e; const int orig = (p & 64) + ((p & 63) >> 1) + 32 * (p & 1); gn[e] = g[orig]; }
        }
        const bool rot = dnorm || (prope && wc == 0);
#pragma unroll
        for (int ai = 0; ai < 2; ++ai) {
            f32x4 cs[4][2];
            if (rot) {
#pragma unroll
                for (int m = 0; m < 4; ++m) { const int row = row0 + ai * HALF + m * 16;
                    const float* cp = dnorm ? csa + ((size_t)(wc < 2 ? (row >> 6) : (row & 63)) * 32 + 16 * (wc & 1) + 4 * fq) * 2 : cs0 + ((size_t)row * 16 + 4 * fq) * 2;
                    cs[m][0] = *(const GLB f32x4*)cp; cs[m][1] = *(const GLB f32x4*)(cp + 4); }
            }
#pragma unroll
            for (int m = 0; m < 4; ++m) {
                const int row = row0 + ai * HALF + m * 16;
                bf16_t* rowp = O + (size_t)row * ldc + col0;
                f32x4 c0 = (f32x4){1.f, 0.f, 1.f, 0.f}, c1 = c0;
                if (rot) { c0 = cs[m][0]; c1 = cs[m][1]; }
#pragma unroll
                for (int bj = 0; bj < 2; ++bj) { f32x4 v0 = acc[ai][bj][m][0], v1 = acc[ai][bj][m][1];
                    if (dnorm) { const float r = rs[ai][m][bj];
                        v0[0] *= r * gn[0]; v0[1] *= r * gn[1]; v0[2] *= r * gn[2]; v0[3] *= r * gn[3]; v1[0] *= r * gn[4]; v1[1] *= r * gn[5]; v1[2] *= r * gn[6]; v1[3] *= r * gn[7]; }
                    if (rot) {
                        const float a0 = v0[0] * c0[0] - v0[1] * c0[1], b0 = v0[1] * c0[0] + v0[0] * c0[1];
                        const float a1 = v0[2] * c0[2] - v0[3] * c0[3], b1 = v0[3] * c0[2] + v0[2] * c0[3];
                        const float a2 = v1[0] * c1[0] - v1[1] * c1[1], b2 = v1[1] * c1[0] + v1[0] * c1[1];
                        const float a3 = v1[2] * c1[2] - v1[3] * c1[3], b3 = v1[3] * c1[2] + v1[2] * c1[3];
                        v0 = (f32x4){a0, b0, a1, b1}; v1 = (f32x4){a2, b2, a3, b3}; }
                    u32x4 w; w.x = cvt_pk_bf16(v0[0], v0[1]); w.y = cvt_pk_bf16(v0[2], v0[3]); w.z = cvt_pk_bf16(v1[0], v1[1]); w.w = cvt_pk_bf16(v1[2], v1[3]);
                    *(GLB u32x4*)(rowp + bj * HALF) = w; }
            }
            asm volatile("" ::: "memory");
        }
    }
};
}

__device__ __forceinline__ float bf_lo(unsigned w) { return __uint_as_float(w << 16); }
__device__ __forceinline__ float bf_hi(unsigned w) { return __uint_as_float(w & 0xffff0000u); }
__device__ __forceinline__ unsigned cvtpk_bf16(float lo, float hi) { unsigned r; asm volatile("v_cvt_pk_bf16_f32 %0, %1, %2" : "=v"(r) : "v"(lo), "v"(hi)); return r; }

__device__ __forceinline__ void cvt_rows_bf16(const float* __restrict__ src, bf16_t* __restrict__ dst, size_t n8, int bid, int nb, int tid, int nthr) {
    const size_t stride = (size_t)nb * nthr;
    for (size_t i = (size_t)bid * nthr + tid; i < n8; i += 4 * stride) {
        float4 a[4], b[4];
#pragma unroll
        for (int u = 0; u < 4; ++u) { const size_t j = i + u * stride; if (j < n8) { a[u] = *(const float4*)(src + j * 8); b[u] = *(const float4*)(src + j * 8 + 4); } }
#pragma unroll
        for (int u = 0; u < 4; ++u) { const size_t j = i + u * stride; if (j < n8) {
            u32x4v w; w.x = cvtpk_bf16(a[u].x, a[u].y); w.y = cvtpk_bf16(a[u].z, a[u].w); w.z = cvtpk_bf16(b[u].x, b[u].y); w.w = cvtpk_bf16(b[u].z, b[u].w);
            *(u32x4v*)(dst + j * 8) = w; } }
    }
}
template <class PM>
__device__ __forceinline__ void transpose_cvt(const float* __restrict__ W, bf16_t* __restrict__ Wt, int K, int N, LDSA float* tile0, int bid, int nb, PM pm, const int tid) {
    const int lane = tid & 63, wv = tid >> 6;
    LDSA float* tile = tile0 + wv * 4352;
    const int ntk = K / 64, ntn = N / 64;
    for (int t = bid * 8 + wv; t < ntk * ntn; t += nb * 8) {
        const int k0 = (t % ntk) * 64, n0 = (t / ntk) * 64;
        const int c = (lane & 15) * 4, r0 = lane >> 4;
        float4 v[16];
#pragma unroll
        for (int i = 0; i < 16; ++i) v[i] = *(const float4*)(W + (size_t)(k0 + r0 + 4 * i) * N + n0 + c);
#pragma unroll
        for (int i = 0; i < 16; ++i) { const int r = r0 + 4 * i; tile[r * 65 + c] = v[i].x; tile[r * 65 + c + 1] = v[i].y; tile[r * 65 + c + 2] = v[i].z; tile[r * 65 + c + 3] = v[i].w; }
        asm volatile("s_waitcnt lgkmcnt(0)" ::: "memory");
        const int mode = pm(n0);
#pragma unroll
        for (int h = 0; h < 8; ++h) {
            const int n = (lane >> 3) + 8 * h, kc = (lane & 7) * 8;
            int src = n;
            if (mode == 1) { if (n < 32) src = (n >> 1) + 16 * (n & 1); }
            else if (mode == 2) src = (n >> 1) + 32 * (n & 1);
            float f[8];
#pragma unroll
            for (int j = 0; j < 8; ++j) f[j] = tile[(kc + j) * 65 + src];
            u32x4v w; w.x = cvtpk_bf16(f[0], f[1]); w.y = cvtpk_bf16(f[2], f[3]); w.z = cvtpk_bf16(f[4], f[5]); w.w = cvtpk_bf16(f[6], f[7]);
            *(u32x4v*)(Wt + (size_t)(n0 + n) * K + k0 + kc) = w;
        }
        asm volatile("s_waitcnt lgkmcnt(0)" ::: "memory");
    }
}
struct PermNone { __device__ __forceinline__ int operator()(int) const { return 0; } };
struct PermAB { __device__ __forceinline__ int operator()(int n0) const { const bool rope = n0 < 2560 || (n0 >= 3072 && n0 < 9216); return (rope && (n0 & 127) == 0) ? 1 : 0; } };
struct PermCD { __device__ __forceinline__ int operator()(int n0) const { if (n0 < 4096) return (n0 & 127) == 0 ? 1 : 0; if (n0 >= 6144 && n0 < 8704) return 2; return 0; } };
__device__ __forceinline__ void rope_tables(float* __restrict__ cs0, float* __restrict__ csa, const int bid, const int G, const int tid) {
    for (int i = bid * 512 + tid; i < SEQ * 16; i += G * 512) { float s, c; sincos_rev((double)(i >> 4) * REV_P[i & 15], s, c); *(float2*)(cs0 + (size_t)i * 2) = make_float2(c, s); }
    for (int i = bid * 512 + tid; i < 128 * 32; i += G * 512) { float s, c; sincos_rev((double)(i >> 5) * REV_A[i & 31], s, c); *(float2*)(csa + (size_t)i * 2) = make_float2(c, s); }
}


typedef unsigned v6u_t __attribute__((ext_vector_type(6)));
typedef float f4v_t __attribute__((ext_vector_type(4)));
typedef unsigned v16u_t __attribute__((ext_vector_type(16)));
typedef float v16f_t __attribute__((ext_vector_type(16)));
typedef float v32f_t __attribute__((ext_vector_type(32)));
typedef __bf16 v32b_t __attribute__((ext_vector_type(32)));
constexpr int ROWB = 3072;
constexpr int XT_STRIDE = 68;
constexpr int XT_BYTES = 64 * XT_STRIDE * 4;
__device__ __forceinline__ void table_fp6(const float* __restrict__ src, unsigned char* __restrict__ dst, float* __restrict__ inv, const int rows, LDSA float* xt0, const int bid, const int G, const int tid) {
    const int lane = tid & 63, wv = tid >> 6;
    LDSA float* xt = xt0 + wv * (XT_BYTES / 4);
    for (int r = bid * 8 + wv; r < rows; r += G * 8) {
        float4 v[16]; float am = 0.f;
#pragma unroll
        for (int j = 0; j < 16; ++j) { v[j] = *(const float4*)(src + (size_t)r * DM + j * 256 + lane * 4); am = fmaxf(am, fmaxf(fmaxf(fabsf(v[j].x), fabsf(v[j].y)), fmaxf(fabsf(v[j].z), fabsf(v[j].w)))); }
        am = wave_max(am);
        const float sc = am > 0.f ? 7.0f / am : 1.0f;
#pragma unroll
        for (int j = 0; j < 16; ++j) *(LDSA f4v_t*)(xt + (4 * j + (lane >> 4)) * XT_STRIDE + 4 * (lane & 15)) = (f4v_t){v[j].x * sc, v[j].y * sc, v[j].z * sc, v[j].w * sc};
        asm volatile("s_waitcnt lgkmcnt(0)" ::: "memory");
        v16f_t f0, f1, f2, f3;
#pragma unroll
        for (int k = 0; k < 8; ++k) { const f4v_t a = *(const LDSA f4v_t*)(xt + lane * XT_STRIDE + 4 * k), c = *(const LDSA f4v_t*)(xt + lane * XT_STRIDE + 32 + 4 * k);
            f0[2 * k] = a[0]; f1[2 * k] = a[1]; f0[2 * k + 1] = a[2]; f1[2 * k + 1] = a[3];
            f2[2 * k] = c[0]; f3[2 * k] = c[1]; f2[2 * k + 1] = c[2]; f3[2 * k + 1] = c[3]; }
        asm volatile("s_waitcnt lgkmcnt(0)" ::: "memory");
        const v6u_t w0 = __builtin_amdgcn_cvt_scalef32_2xpk16_fp6_f32(f0, f1, 1.0f), w1 = __builtin_amdgcn_cvt_scalef32_2xpk16_fp6_f32(f2, f3, 1.0f);
        unsigned char* dp = dst + (size_t)r * ROWB + lane * 48;
        u32x4v s0, s1, s2; s0.x = w0[0]; s0.y = w0[1]; s0.z = w0[2]; s0.w = w0[3]; s1.x = w0[4]; s1.y = w0[5]; s1.z = w1[0]; s1.w = w1[1]; s2.x = w1[2]; s2.y = w1[3]; s2.z = w1[4]; s2.w = w1[5];
        *(u32x4v*)dp = s0; *(u32x4v*)(dp + 16) = s1; *(u32x4v*)(dp + 32) = s2;
        if (lane == 0) inv[r] = am > 0.f ? am * (1.0f / 7.0f) : 1.0f;
    }
}

typedef __bf16 bf2_t __attribute__((ext_vector_type(2)));
__device__ __forceinline__ float dot2_bf16(unsigned a, unsigned b, float c) { return __builtin_amdgcn_fdot2_f32_bf16(__builtin_bit_cast(bf2_t, a), __builtin_bit_cast(bf2_t, b), c, false); }
__device__ __forceinline__ float gelu_tanh_f(float x) {
    const float z = 0.7978845608028654f * (x + 0.044715f * x * x * x);
    const float e = __expf(2.0f * z);
    return 0.5f * x * (2.0f - 2.0f / (e + 1.0f));
}
__device__ __forceinline__ int pick_i(int a0, int a1, int k) { return k < 64 ? __builtin_amdgcn_readlane(a0, k) : __builtin_amdgcn_readlane(a1, k - 64); }
__device__ __forceinline__ float pick_f(float a0, float a1, int k) { return __int_as_float(pick_i(__float_as_int(a0), __float_as_int(a1), k)); }
__device__ __forceinline__ float dpp_shr(float v, const int ctrl_sel) {
    const int iv = __builtin_bit_cast(int, v); int r;
    switch (ctrl_sel) { case 1: r = __builtin_amdgcn_update_dpp(0, iv, 0x111, 0xf, 0xf, true); break; case 2: r = __builtin_amdgcn_update_dpp(0, iv, 0x112, 0xf, 0xf, true); break;
                        case 4: r = __builtin_amdgcn_update_dpp(0, iv, 0x114, 0xf, 0xf, true); break; default: r = __builtin_amdgcn_update_dpp(0, iv, 0x118, 0xf, 0xf, true); break; }
    return __builtin_bit_cast(float, r);
}
__device__ __forceinline__ float wave_sum_u(float v) {
    v += dpp_shr(v, 1); v += dpp_shr(v, 2); v += dpp_shr(v, 4); v += dpp_shr(v, 8);
    v += __builtin_bit_cast(float, __builtin_amdgcn_update_dpp(0, __builtin_bit_cast(int, v), 0x142, 0xa, 0xf, false));
    v += __builtin_bit_cast(float, __builtin_amdgcn_update_dpp(0, __builtin_bit_cast(int, v), 0x143, 0xc, 0xf, false));
    return __builtin_bit_cast(float, __builtin_amdgcn_readlane(__builtin_bit_cast(int, v), 63));
}
typedef const __attribute__((address_space(1))) u32x4v* gu32x4p;
#define PE_LOADROW(dst, base, e) do { const unsigned char* _p = (base) + (size_t)(e) * ROWB + lane * 48; dst[0] = *(gu32x4p)_p; dst[1] = *(gu32x4p)(_p + 16); dst[2] = *(gu32x4p)(_p + 32); } while (0)
__device__ __forceinline__ float pe_dot(const u32x4v (&r)[3], const u32x4v (&x)[8]) {
    float d0 = 0.f, d1 = 0.f, d2 = 0.f, d3 = 0.f;
    { const v6u_t g = {r[0].x, r[0].y, r[0].z, r[0].w, r[1].x, r[1].y};
      const v16u_t z = __builtin_bit_cast(v16u_t, __builtin_amdgcn_cvt_scalef32_pk32_bf16_fp6(g, 1.0f));
#pragma unroll
      for (int k = 0; k < 4; ++k) { const unsigned xa = x[k].x, xb = x[k].y, xc = x[k].z, xd = x[k].w; const unsigned za = z[4 * k], zb = z[4 * k + 1], zc = z[4 * k + 2], zd = z[4 * k + 3];
          d0 = dot2_bf16(za, xa, d0); d1 = dot2_bf16(zb, xb, d1); d2 = dot2_bf16(zc, xc, d2); d3 = dot2_bf16(zd, xd, d3); }
    }
    { const v6u_t g = {r[1].z, r[1].w, r[2].x, r[2].y, r[2].z, r[2].w};
      const v16u_t z = __builtin_bit_cast(v16u_t, __builtin_amdgcn_cvt_scalef32_pk32_bf16_fp6(g, 1.0f));
#pragma unroll
      for (int k = 0; k < 4; ++k) { const unsigned xa = x[4 + k].x, xb = x[4 + k].y, xc = x[4 + k].z, xd = x[4 + k].w; const unsigned za = z[4 * k], zb = z[4 * k + 1], zc = z[4 * k + 2], zd = z[4 * k + 3];
          d0 = dot2_bf16(za, xa, d0); d1 = dot2_bf16(zb, xb, d1); d2 = dot2_bf16(zc, xc, d2); d3 = dot2_bf16(zd, xd, d3); } }
    return wave_sum_u((d0 + d1) + (d2 + d3));
}
#define PE_PIN16(a, b) asm volatile("" : "+v"(a[b + 0]), "+v"(a[b + 1]), "+v"(a[b + 2]), "+v"(a[b + 3]), "+v"(a[b + 4]), "+v"(a[b + 5]), "+v"(a[b + 6]), "+v"(a[b + 7]), \
                                         "+v"(a[b + 8]), "+v"(a[b + 9]), "+v"(a[b + 10]), "+v"(a[b + 11]), "+v"(a[b + 12]), "+v"(a[b + 13]), "+v"(a[b + 14]), "+v"(a[b + 15]))
__device__ __forceinline__ void pe_axpy(float (&acc)[64], const u32x4v (&r)[3], const float w) {
    { const v6u_t g = {r[0].x, r[0].y, r[0].z, r[0].w, r[1].x, r[1].y};
      const v32f_t y = __builtin_amdgcn_cvt_scalef32_pk32_f32_fp6(g, 1.0f);
#pragma unroll
      for (int i = 0; i < 32; ++i) acc[i] = fmaf(w, y[i], acc[i]);
      PE_PIN16(acc, 0); PE_PIN16(acc, 16); }
    { const v6u_t g = {r[1].z, r[1].w, r[2].x, r[2].y, r[2].z, r[2].w};
      const v32f_t y = __builtin_amdgcn_cvt_scalef32_pk32_f32_fp6(g, 1.0f);
#pragma unroll
      for (int i = 0; i < 32; ++i) acc[32 + i] = fmaf(w, y[i], acc[32 + i]);
      PE_PIN16(acc, 32); PE_PIN16(acc, 48); }
}
__device__ __forceinline__ void wave_sort128(unsigned& a0, unsigned& a1, const int lane) {
#pragma unroll
    for (int k = 2; k <= 128; k <<= 1) {
#pragma unroll
        for (int j = k >> 1; j > 0; j >>= 1) {
            if (j == 64) { const unsigned lo = a0 < a1 ? a0 : a1, hi = a0 < a1 ? a1 : a0; a0 = lo; a1 = hi; }
            else {
                const unsigned o0 = (unsigned)__shfl_xor((int)a0, j), o1 = (unsigned)__shfl_xor((int)a1, j);
                const bool lowhalf = (lane & j) == 0;
                const bool up0 = k >= 128 ? true : ((lane & k) == 0);
                const bool up1 = k >= 128 ? true : (k == 64 ? false : ((lane & k) == 0));
                const bool min0 = lowhalf == up0, min1 = lowhalf == up1;
                const unsigned mn0 = a0 < o0 ? a0 : o0, mx0 = a0 < o0 ? o0 : a0, mn1 = a1 < o1 ? a1 : o1, mx1 = a1 < o1 ? o1 : a1;
                a0 = min0 ? mn0 : mx0; a1 = min1 ? mn1 : mx1;
            }
        }
    }
}
__device__ __forceinline__ void peer_expert_phase(const float* __restrict__ ypre, const float* __restrict__ stats, const float* __restrict__ gm, const float* __restrict__ bm, const bf16_t* __restrict__ x1b, int* __restrict__ eidx, float* __restrict__ gate,
                                                  const unsigned char* __restrict__ ub, const unsigned char* __restrict__ vb, const float* __restrict__ isu, const float* __restrict__ isv,
                                                  const float* __restrict__ lg, const float* __restrict__ lb, float* __restrict__ out, bf16_t* __restrict__ outb, LDSA float* xt0, const int bid, const int G, const int tid) {
    const int wv = __builtin_amdgcn_readfirstlane(tid >> 6);
    LDSA float* xt = xt0 + wv * (XT_BYTES / 4);
#define PE_POS(k) (rev ? 127 - (k) : (k))
#define PE_E(k) pick_i(e0, e1, PE_POS(k))
    int jt = 0;
    for (int t = bid * 8 + wv; t < SEQ; t += G * 8, ++jt) {
        int tl = tid; asm volatile("" : "+v"(tl));
        const int lane = tl & 63;
        const bool rev = (jt & 1) != 0;
        int e0, e1; float g0, g1;
        { const int r0 = eidx[(size_t)t * 128 + lane], r1 = eidx[(size_t)t * 128 + 64 + lane];
          const float h0 = gate[(size_t)t * 128 + lane], h1 = gate[(size_t)t * 128 + 64 + lane];
          unsigned a0 = ((unsigned)r0 << 7) | (unsigned)lane, a1 = ((unsigned)r1 << 7) | (unsigned)(64 + lane);
          wave_sort128(a0, a1, lane);
          e0 = (int)(a0 >> 7); e1 = (int)(a1 >> 7);
          const int k0 = (int)(a0 & 127u), k1 = (int)(a1 & 127u);
          const float p00 = __shfl(h0, k0 & 63), p01 = __shfl(h1, k0 & 63), p10 = __shfl(h0, k1 & 63), p11 = __shfl(h1, k1 & 63);
          g0 = k0 < 64 ? p00 : p01; g1 = k1 < 64 ? p10 : p11; }
        const float iu0 = isu[e0], iu1 = isu[e1], iv0 = isv[e0], iv1 = isv[e1];
        u32x4v xq[8];
#pragma unroll
        for (int k = 0; k < 8; ++k) xq[k] = *(const u32x4v*)(x1b + (size_t)t * DM + lane * 64 + k * 8);
        float w0 = 0.f, w1 = 0.f;
        u32x4v R0[3], R1[3], R2[3], R3[3], R4[3];
#define PE_USTEP(R, k) do { const int kk = PE_POS(k); const float d = pe_dot(R, xq) * pick_f(iu0, iu1, kk); const float w = pick_f(g0, g1, kk) * gelu_tanh_f(d) * pick_f(iv0, iv1, kk); \
            if (lane == (kk & 63)) { if (kk < 64) w0 = w; else w1 = w; } } while (0)
        PE_LOADROW(R0, ub, PE_E(0)); PE_LOADROW(R1, ub, PE_E(1)); PE_LOADROW(R2, ub, PE_E(2)); PE_LOADROW(R3, ub, PE_E(3));
        for (int k = 0; k < 125; k += 5) {
            if (k + 4 < 128) PE_LOADROW(R4, ub, PE_E(k + 4)); PE_USTEP(R0, k);
            if (k + 5 < 128) PE_LOADROW(R0, ub, PE_E(k + 5)); PE_USTEP(R1, k + 1);
            if (k + 6 < 128) PE_LOADROW(R1, ub, PE_E(k + 6)); PE_USTEP(R2, k + 2);
            if (k + 7 < 128) PE_LOADROW(R2, ub, PE_E(k + 7)); PE_USTEP(R3, k + 3);
            if (k + 8 < 128) PE_LOADROW(R3, ub, PE_E(k + 8)); PE_USTEP(R4, k + 4);
        }
        PE_USTEP(R0, 125); PE_USTEP(R1, 126); PE_USTEP(R2, 127);
#undef PE_USTEP
        eidx[(size_t)t * 128 + lane] = e0; eidx[(size_t)t * 128 + 64 + lane] = e1;
        gate[(size_t)t * 128 + lane] = w0; gate[(size_t)t * 128 + 64 + lane] = w1;
    }
    asm volatile("s_waitcnt vmcnt(0)" ::: "memory");
    for (int t = bid * 8 + wv; t < SEQ; t += G * 8, ++jt) {
        int tl = tid; asm volatile("" : "+v"(tl));
        const int lane = tl & 63;
        const bool rev = (jt & 1) != 0;
        const int e0 = __builtin_nontemporal_load(eidx + (size_t)t * 128 + lane), e1 = __builtin_nontemporal_load(eidx + (size_t)t * 128 + 64 + lane);
        const float w0 = __builtin_nontemporal_load(gate + (size_t)t * 128 + lane), w1 = __builtin_nontemporal_load(gate + (size_t)t * 128 + 64 + lane);
        u32x4v R0[3], R1[3], R2[3], R3[3], R4[3];
        float acc[64];
#pragma unroll
        for (int i = 0; i < 64; ++i) acc[i] = 0.f;
        PE_LOADROW(R0, vb, PE_E(0)); PE_LOADROW(R1, vb, PE_E(1)); PE_LOADROW(R2, vb, PE_E(2)); PE_LOADROW(R3, vb, PE_E(3));
        for (int k = 0; k < 125; k += 5) {
            if (k + 4 < 128) PE_LOADROW(R4, vb, PE_E(k + 4)); pe_axpy(acc, R0, pick_f(w0, w1, PE_POS(k)));
            if (k + 5 < 128) PE_LOADROW(R0, vb, PE_E(k + 5)); pe_axpy(acc, R1, pick_f(w0, w1, PE_POS(k + 1)));
            if (k + 6 < 128) PE_LOADROW(R1, vb, PE_E(k + 6)); pe_axpy(acc, R2, pick_f(w0, w1, PE_POS(k + 2)));
            if (k + 7 < 128) PE_LOADROW(R2, vb, PE_E(k + 7)); pe_axpy(acc, R3, pick_f(w0, w1, PE_POS(k + 3)));
            if (k + 8 < 128) PE_LOADROW(R3, vb, PE_E(k + 8)); pe_axpy(acc, R4, pick_f(w0, w1, PE_POS(k + 4)));
        }
        pe_axpy(acc, R0, pick_f(w0, w1, PE_POS(125))); pe_axpy(acc, R1, pick_f(w0, w1, PE_POS(126))); pe_axpy(acc, R2, pick_f(w0, w1, PE_POS(127)));
#pragma unroll
        for (int k = 0; k < 16; ++k) *(LDSA f4v_t*)(xt + lane * XT_STRIDE + 4 * k) = (f4v_t){acc[4 * k], acc[4 * k + 1], acc[4 * k + 2], acc[4 * k + 3]};
        asm volatile("s_waitcnt lgkmcnt(0)" ::: "memory");
        float4 y[16]; float s = 0.f; const float2 st = *(const float2*)(stats + (size_t)t * 2);
#pragma unroll
        for (int j = 0; j < 16; ++j) { const f4v_t f = *(const LDSA f4v_t*)(xt + (4 * j + (lane >> 4)) * XT_STRIDE + 4 * (lane & 15));
            const float4 yv = *(const float4*)(ypre + (size_t)t * DM + j * 256 + lane * 4), gv = *(const float4*)(gm + j * 256 + lane * 4), bv = *(const float4*)(bm + j * 256 + lane * 4);
            float4 xv;
            xv.x = (yv.x - st.x) * st.y * gv.x + bv.x; xv.y = (yv.y - st.x) * st.y * gv.y + bv.y; xv.z = (yv.z - st.x) * st.y * gv.z + bv.z; xv.w = (yv.w - st.x) * st.y * gv.w + bv.w;
            y[j].x = fmaf(ALPHA, xv.x, f.x); y[j].y = fmaf(ALPHA, xv.y, f.y); y[j].z = fmaf(ALPHA, xv.z, f.z); y[j].w = fmaf(ALPHA, xv.w, f.w);
            s += (y[j].x + y[j].y) + (y[j].z + y[j].w);
            if (j & 1) asm volatile("" ::: "memory"); }
        asm volatile("s_waitcnt lgkmcnt(0)" ::: "memory");
        const float mean = wave_sum(s) * (1.0f / DM);
        float qq = 0.f;
#pragma unroll
        for (int j = 0; j < 16; ++j) { const float a = y[j].x - mean, b = y[j].y - mean, c = y[j].z - mean, d = y[j].w - mean; qq += (a * a + b * b) + (c * c + d * d); }
        const float rstd = 1.0f / sqrtf(wave_sum(qq) * (1.0f / DM) + 1e-5f);
#pragma unroll
        for (int j = 0; j < 16; ++j) {
            const int c = j * 256 + lane * 4;
            const float4 ga = *(const float4*)(lg + c), ba = *(const float4*)(lb + c);
            float4 oa; oa.x = (y[j].x - mean) * rstd * ga.x + ba.x; oa.y = (y[j].y - mean) * rstd * ga.y + ba.y; oa.z = (y[j].z - mean) * rstd * ga.z + ba.z; oa.w = (y[j].w - mean) * rstd * ga.w + ba.w;
            *(float4*)(out + (size_t)t * DM + c) = oa;
            if (outb) { uint2 w; w.x = cvtpk_bf16(oa.x, oa.y); w.y = cvtpk_bf16(oa.z, oa.w); *(uint2*)(outb + (size_t)t * DM + c) = w; }
            if ((j & 3) == 3) asm volatile("" ::: "memory");
        }
    }
#undef PE_E
#undef PE_POS
}

__device__ __forceinline__ void attn1_phase(const bf16_t* __restrict__ hb, bf16_t* __restrict__ abb, float* __restrict__ oc, const float* __restrict__ lq1, const float* __restrict__ lk1, const float* __restrict__ lq2,
                                            const float* __restrict__ lk2, const float* __restrict__ subg, char* lds, const int bid, const int G, const int tid) {
    for (int u = bid; u < 512; u += G) {
        __syncthreads();
        const int kv = u >> 7, g = (u >> 5) & 3, qb = u & 31, hq = kv * 4 + g;
        att::attn_wide_body<9216, 9216, 4096, 1, att::bf16>(hb + (size_t)(qb * 256) * 9216 + 6144 + hq * 128, hb + 8192 + kv * 128, hb + 8704 + kv * 128,
                                                             abb + (size_t)(qb * 256) * 4096 + 2048 + hq * 128, SEQ, lds, tid);
    }
    int tid2 = tid; asm volatile("" : "+v"(tid2));
    const int lane_c = tid2 & 63;
    const float lam = __int_as_float(__builtin_amdgcn_readfirstlane(__float_as_int(__expf(wave_sum(lq1[lane_c] * lk1[lane_c] + lq1[lane_c + 64] * lk1[lane_c + 64])) - __expf(wave_sum(lq2[lane_c] * lk2[lane_c] + lq2[lane_c + 64] * lk2[lane_c + 64])) + LAMBDA_INIT)));
    for (int v = bid; v < 256; v += G) {
        __syncthreads();
        const int h = v >> 5, qb = v & 31;
        float* o1 = oc + (size_t)(qb * 256) * 2048 + h * 256;
        int tid4 = tid2; asm volatile("" : "+v"(tid4));
        att::attn_wide_body<9216, 9216, 2048, 2, float>(hb + (size_t)(qb * 256) * 9216 + h * 256, hb + 2048 + h * 256, hb + 4096 + h * 256, o1, SEQ, lds, tid4);
        __syncthreads();
        int tid3 = tid2; asm volatile("" : "+v"(tid3));
        att::attn_wide_body<9216, 9216, 2048, 2, float, true, 4096>(hb + (size_t)(qb * 256) * 9216 + h * 256 + 128, hb + 2048 + h * 256 + 128, hb + 4096 + h * 256, o1, SEQ, lds, tid3,
                                                                     lam, 1.0f - LAMBDA_INIT, subg, abb + (size_t)(qb * 256) * 4096 + h * 256);
    }
}


__device__ __forceinline__ void attn0_phase(const bf16_t* __restrict__ hb, const float* __restrict__ sink, bf16_t* __restrict__ abb, bf16_t* __restrict__ obg, float* __restrict__ lse, char* lds, const int bid, const int G, const int tid) {
    const long LD = 12288;
    for (int u = bid; u < 512; u += G) {
        __syncthreads();
        const int hq = u >> 5, qb = u & 31, kv = hq >> 2;
        att::attn_banded_body<128>(hb + hq * 128, hb + 2048 + kv * 128, hb + 2560 + kv * 128, LD, SEQ, qb * 256, sink[hq] * (1.0f / att::SCALE), 1.0f, abb + hq * 128, 3072, nullptr, 0, lds, tid);
    }
    int tid2 = tid; asm volatile("" : "+v"(tid2));
    for (int v = bid; v < 768; v += G) {
        __syncthreads();
        const int g = v >> 8, w = v & 255, h = w >> 5, rem = w & 31;
        const int dsh = 2 * g;
        const int nqb_sh = 5 - dsh;
        const int r = rem >> nqb_sh, qb = rem & ((1 << nqb_sh) - 1);
        const int head = 8 * g + h;
        const long rs = LD << dsh;
        att::attn_banded_body<64>(hb + (long)r * LD + 3072 + head * 128, hb + (long)r * LD + 6144 + head * 128, hb + (long)r * LD + 9216 + head * 128, rs, SEQ >> dsh, qb * 256, -1e30f, 0.f,
                                  obg + ((long)(g * 8 + h) * SEQ + r) * 128, (long)128 << dsh, lse + (long)(g * 8 + h) * SEQ + r, (long)1 << dsh, lds, tid2);
    }
}
__device__ __forceinline__ void merge0_phase(const bf16_t* __restrict__ obg, const float* __restrict__ lse, bf16_t* __restrict__ abb, const int bid, const int G, const int tid) {
    const int lane = tid & 63, wv = tid >> 6;
    for (int j = bid * 8 + wv; j < SEQ * 8; j += G * 8) {
        const int h = j >> 13, t = j & (SEQ - 1);
        const float l0 = lse[(size_t)(0 * 8 + h) * SEQ + t], l1 = lse[(size_t)(1 * 8 + h) * SEQ + t], l2 = lse[(size_t)(2 * 8 + h) * SEQ + t];
        const float mx = fmaxf(l0, fmaxf(l1, l2));
        const float e0 = __expf(l0 - mx), e1 = __expf(l1 - mx), e2 = __expf(l2 - mx), inv = 1.0f / (e0 + e1 + e2);
        const unsigned a0 = *(const unsigned*)(obg + ((size_t)(0 * 8 + h) * SEQ + t) * 128 + 2 * lane), a1 = *(const unsigned*)(obg + ((size_t)(1 * 8 + h) * SEQ + t) * 128 + 2 * lane), a2 = *(const unsigned*)(obg + ((size_t)(2 * 8 + h) * SEQ + t) * 128 + 2 * lane);
        const float x = (e0 * bf_lo(a0) + e1 * bf_lo(a1) + e2 * bf_lo(a2)) * inv, y = (e0 * bf_hi(a0) + e1 * bf_hi(a1) + e2 * bf_hi(a2)) * inv;
        *(unsigned*)(abb + (size_t)t * 3072 + 2048 + h * 128 + 2 * lane) = cvtpk_bf16(x, y);
    }
}

__device__ __forceinline__ void post_even_phase(const float* __restrict__ h, bf16_t* __restrict__ hb, const int bid, const int G, const int tid) {
    const int lane = tid & 63, wv = tid >> 6;
    for (int job = bid * 8 + wv; job < SEQ * 96; job += G * 8) {
        const int t = job / 96, blk = job - t * 96;
        const bool rope = (blk < 20) || (blk >= 24 && blk < 72);
        const float2 v = *(const float2*)(h + (size_t)t * 12288 + blk * 128 + 2 * lane);
        float o0 = v.x, o1 = v.y;
        const float p0 = __shfl_xor(v.x, 8), p1 = __shfl_xor(v.y, 8);
        if (rope && lane < 16) {
            const int i0 = (2 * lane) & 15;
            float s0, c0, s1, c1; sincos_rev((double)t * REV_P[i0], s0, c0); sincos_rev((double)t * REV_P[i0 + 1], s1, c1);
            if (lane < 8) { o0 = v.x * c0 - p0 * s0; o1 = v.y * c1 - p1 * s1; }
            else          { o0 = v.x * c0 + p0 * s0; o1 = v.y * c1 + p1 * s1; }
        }
        *(unsigned*)(hb + (size_t)t * 12288 + blk * 128 + 2 * lane) = cvtpk_bf16(o0, o1);
    }
}
__device__ __forceinline__ void post_odd_phase(const float* __restrict__ h, bf16_t* __restrict__ hb, const float* __restrict__ qg, const float* __restrict__ kg, const int bid, const int G, const int tid) {
    const int lane = tid & 63, wv = tid >> 6;
    for (int job = bid * 8 + wv; job < SEQ * 72; job += G * 8) {
        const int t = job / 72, blk = job - t * 72;
        const float2 v = *(const float2*)(h + (size_t)t * 9216 + blk * 128 + 2 * lane);
        float o0 = v.x, o1 = v.y;
        if (blk < 32) {
            const float p0 = __shfl_xor(v.x, 8), p1 = __shfl_xor(v.y, 8);
            if (lane < 16) {
                const int i0 = (2 * lane) & 15;
                float s0, c0, s1, c1; sincos_rev((double)t * REV_P[i0], s0, c0); sincos_rev((double)t * REV_P[i0 + 1], s1, c1);
                if (lane < 8) { o0 = v.x * c0 - p0 * s0; o1 = v.y * c1 - p1 * s1; }
                else          { o0 = v.x * c0 + p0 * s0; o1 = v.y * c1 + p1 * s1; }
            }
        } else if (blk >= 48 && blk < 68) {
            const float* g = blk < 64 ? qg : kg;
            const float ss = wave_sum(v.x * v.x + v.y * v.y) * (1.0f / 128.0f);
            const float rs = 1.0f / sqrtf(ss + 1e-6f);
            const float a0 = v.x * rs * g[2 * lane], a1 = v.y * rs * g[2 * lane + 1];
            const float p0 = __shfl_xor(a0, 16), p1 = __shfl_xor(a1, 16);
            const int i0 = (2 * lane) & 31;
            const double pos = (double)(lane < 32 ? (t >> 6) : (t & 63));
            float s0, c0, s1, c1; sincos_rev(pos * REV_A[i0], s0, c0); sincos_rev(pos * REV_A[i0 + 1], s1, c1);
            if ((lane & 16) == 0) { o0 = a0 * c0 - p0 * s0; o1 = a1 * c1 - p1 * s1; }
            else                  { o0 = a0 * c0 + p0 * s0; o1 = a1 * c1 + p1 * s1; }
        }
        *(unsigned*)(hb + (size_t)t * 9216 + blk * 128 + 2 * lane) = cvtpk_bf16(o0, o1);
    }
}

__device__ __forceinline__ void attn_seg_b(const float q0, const float q1, const bf16_t* __restrict__ Kb, const bf16_t* __restrict__ Vb, const int ld,
                                           const int t, const int step, int jlo, int jhi, float& m, float& l, float& o0, float& o1, const int lane) {
    { const int lo = -(t / step); if (jlo < lo) jlo = lo; const int hi = (SEQ - 1 - t) / step; if (jhi > hi) jhi = hi; }
    for (int j = jlo; j <= jhi; ++j) {
        const size_t tp = (size_t)(t + step * j);
        const unsigned kw = *(const unsigned*)(Kb + tp * ld + 2 * lane), vw = *(const unsigned*)(Vb + tp * ld + 2 * lane);
        const float s = wave_sum(q0 * bf_lo(kw) + q1 * bf_hi(kw)) * ATT_SCALE;
        const float mn = fmaxf(m, s);
        const float al = __expf(m - mn), p = __expf(s - mn);
        l = l * al + p;
        o0 = o0 * al + p * bf_lo(vw); o1 = o1 * al + p * bf_hi(vw);
        m = mn;
    }
}
__device__ __forceinline__ void attn_even_valu_phase(const bf16_t* __restrict__ hb, const float* __restrict__ sink, bf16_t* __restrict__ abb, const int bid, const int G, const int tid) {
    const int lane = tid & 63, wv = tid >> 6;
    const int LD = 12288;
    for (int job = bid * 8 + wv; job < SEQ * 24; job += G * 8) {
        const int hh = job / SEQ, t = job % SEQ;
        float o0 = 0.f, o1 = 0.f, m, l;
        if (hh < 16) {
            const int kv = hh >> 2;
            const unsigned qw = *(const unsigned*)(hb + (size_t)t * LD + hh * 128 + 2 * lane);
            m = sink[hh]; l = 1.f;
            attn_seg_b(bf_lo(qw), bf_hi(qw), hb + 2048 + kv * 128, hb + 2560 + kv * 128, LD, t, 1, -128, 128, m, l, o0, o1, lane);
        } else {
            const int hbh = hh - 16;
            m = -1e30f; l = 0.f;
#pragma unroll
            for (int g = 0; g < 3; ++g) {
                const int head = 8 * g + hbh; const int step = g == 0 ? 1 : (g == 1 ? 4 : 16);
                const unsigned qw = *(const unsigned*)(hb + (size_t)t * LD + 3072 + head * 128 + 2 * lane);
                attn_seg_b(bf_lo(qw), bf_hi(qw), hb + 6144 + head * 128, hb + 9216 + head * 128, LD, t, step, -64, 64, m, l, o0, o1, lane);
            }
        }
        const float il = 1.0f / l;
        *(unsigned*)(abb + (size_t)t * 3072 + hh * 128 + 2 * lane) = cvtpk_bf16(o0 * il, o1 * il);
    }
}

__device__ __forceinline__ void ln_phase(const float* __restrict__ y, const float* __restrict__ g, const float* __restrict__ b, float* __restrict__ stats, bf16_t* __restrict__ outb, const int bid, const int G, const int tid) {
    const int lane = tid & 63, wv = tid >> 6;
    for (int t = bid * 8 + wv; t < SEQ; t += G * 8) {
        float4 v[16]; float s = 0.f;
#pragma unroll
        for (int i = 0; i < 16; ++i) { v[i] = *(const float4*)(y + (size_t)t * DM + i * 256 + lane * 4); s += (v[i].x + v[i].y) + (v[i].z + v[i].w); }
        const float mean = wave_sum(s) * (1.0f / DM);
        float q = 0.f;
#pragma unroll
        for (int i = 0; i < 16; ++i) { const float a = v[i].x - mean, bb = v[i].y - mean, c = v[i].z - mean, d = v[i].w - mean; q += (a * a + bb * bb) + (c * c + d * d); }
        const float rstd = 1.0f / sqrtf(wave_sum(q) * (1.0f / DM) + 1e-5f);
        if (lane == 0) *(float2*)(stats + (size_t)t * 2) = make_float2(mean, rstd);
#pragma unroll
        for (int i = 0; i < 16; ++i) {
            const float4 gg = *(const float4*)(g + i * 256 + lane * 4), bb = *(const float4*)(b + i * 256 + lane * 4);
            float4 o; o.x = (v[i].x - mean) * rstd * gg.x + bb.x; o.y = (v[i].y - mean) * rstd * gg.y + bb.y; o.z = (v[i].z - mean) * rstd * gg.z + bb.z; o.w = (v[i].w - mean) * rstd * gg.w + bb.w;
            uint2 w; w.x = cvtpk_bf16(o.x, o.y); w.y = cvtpk_bf16(o.z, o.w); *(uint2*)(outb + (size_t)t * DM + i * 256 + lane * 4) = w;
            if ((i & 3) == 3) asm volatile("" ::: "memory");
        }
    }
}

__device__ __forceinline__ void route_valu_phase(const float* __restrict__ q  , const float* __restrict__ keys  , int* __restrict__ eidx, float* __restrict__ gate, const int bid, const int G, const int tid) {
    const int lane = tid & 63, wv = tid >> 6;
    for (int job = bid * 8 + wv; job < SEQ * 8; job += G * 8) {
        const int hh = job & 7, t = job >> 3;
        float sv0 = 0.f, sv1 = 0.f; int si0 = 0, si1 = 0;
#pragma unroll
        for (int c = 0; c < 2; ++c) {
            const float* qq = q + (size_t)t * 2048 + hh * 256 + c * 128;
            const float* k0 = keys + ((size_t)(hh * 2 + c) * 128 + lane) * 128;
            const float* k1 = k0 + 64 * 128;
            float s0 = 0.f, s1 = 0.f;
            for (int d = 0; d < 128; d += 4) {
                const float4 qv = *(const float4*)(qq + d), a = *(const float4*)(k0 + d), b = *(const float4*)(k1 + d);
                s0 += qv.x * a.x + qv.y * a.y + qv.z * a.z + qv.w * a.w;
                s1 += qv.x * b.x + qv.y * b.y + qv.z * b.z + qv.w * b.w;
            }
            float myv = 0.f; int myi = 0;
            for (int k = 0; k < 16; ++k) {
                float bv; int bi;
                if (s1 > s0) { bv = s1; bi = lane + 64; } else { bv = s0; bi = lane; }
#pragma unroll
                for (int o = 32; o >= 1; o >>= 1) {
                    const float ov = __shfl_xor(bv, o); const int oi = __shfl_xor(bi, o);
                    if (ov > bv || (ov == bv && oi < bi)) { bv = ov; bi = oi; }
                }
                if (lane == k) { myv = bv; myi = bi; }
                if (bi == lane) s0 = -3.0e38f;
                if (bi == lane + 64) s1 = -3.0e38f;
            }
            if (c == 0) { sv0 = myv; si0 = myi; } else { sv1 = myv; si1 = myi; }
        }
        float cv0, cv1, cv2, cv3; int ci0, ci1, ci2, ci3;
        { const float a = __shfl(sv0, lane >> 2); const int ai = __shfl(si0, lane >> 2); const int jb = (lane & 3) * 4;
          cv0 = a + __shfl(sv1, jb + 0); ci0 = ai * 128 + __shfl(si1, jb + 0);
          cv1 = a + __shfl(sv1, jb + 1); ci1 = ai * 128 + __shfl(si1, jb + 1);
          cv2 = a + __shfl(sv1, jb + 2); ci2 = ai * 128 + __shfl(si1, jb + 2);
          cv3 = a + __shfl(sv1, jb + 3); ci3 = ai * 128 + __shfl(si1, jb + 3); }
        float tv = 0.f; int te = 0;
        for (int k = 0; k < 16; ++k) {
            float bv = cv0; int bp = lane * 4, be = ci0;
            if (cv1 > bv) { bv = cv1; bp = lane * 4 + 1; be = ci1; }
            if (cv2 > bv) { bv = cv2; bp = lane * 4 + 2; be = ci2; }
            if (cv3 > bv) { bv = cv3; bp = lane * 4 + 3; be = ci3; }
#pragma unroll
            for (int o = 32; o >= 1; o >>= 1) {
                const float ov = __shfl_xor(bv, o); const int op = __shfl_xor(bp, o); const int oe = __shfl_xor(be, o);
                if (ov > bv || (ov == bv && op < bp)) { bv = ov; bp = op; be = oe; }
            }
            if (lane == k) { tv = bv; te = be; }
            if (bp == lane * 4 + 0) cv0 = -3.0e38f;
            if (bp == lane * 4 + 1) cv1 = -3.0e38f;
            if (bp == lane * 4 + 2) cv2 = -3.0e38f;
            if (bp == lane * 4 + 3) cv3 = -3.0e38f;
        }
        const float v = lane < 16 ? tv : -3.0e38f;
        const float mx = wave_max(v);
        const float e = lane < 16 ? __expf(tv - mx) : 0.f;
        const float den = wave_sum(e);
        if (lane < 16) { eidx[(size_t)t * 128 + hh * 16 + lane] = te; gate[(size_t)t * 128 + hh * 16 + lane] = e / den; }
    }
}
namespace rt {
using att::f32x16; using att::bf16x8;
__device__ __forceinline__ float pair_max(float m) {
    auto rr = __builtin_amdgcn_permlane32_swap(__float_as_uint(m), __float_as_uint(m), false, false);
    return fmaxf(__uint_as_float(rr[0]), __uint_as_float(rr[1]));
}
__device__ __forceinline__ int pair_max_i(int m) {
    auto rr = __builtin_amdgcn_permlane32_swap((unsigned)m, (unsigned)m, false, false);
    const int a = (int)rr[0], b = (int)rr[1]; return a > b ? a : b;
}
__device__ __forceinline__ void top16_of_128(f32x16& p0, f32x16& p1, f32x16& p2, f32x16& p3, float (&t)[16]) {
#pragma unroll
    for (int k = 0; k < 16; ++k) {
        float m = p0[0];
#pragma unroll
        for (int r = 1; r < 16; ++r) m = fmaxf(m, p0[r]);
#pragma unroll
        for (int r = 0; r < 16; ++r) m = fmaxf(m, fmaxf(p1[r], fmaxf(p2[r], p3[r])));
        m = pair_max(m);
        t[k] = m;
#pragma unroll
        for (int r = 0; r < 16; ++r) { p0[r] = p0[r] == m ? -3.0e38f : p0[r]; p1[r] = p1[r] == m ? -3.0e38f : p1[r]; p2[r] = p2[r] == m ? -3.0e38f : p2[r]; p3[r] = p3[r] == m ? -3.0e38f : p3[r]; }
    }
}
__device__ __forceinline__ void tag_scores(f32x16& p, const int base, const int hi) {
#pragma unroll
    for (int r = 0; r < 16; ++r) p[r] = __uint_as_float((__float_as_uint(p[r]) & ~0x7Fu) | (unsigned)(base + att::crow(r, hi)));
}
}

__device__ __forceinline__ void route_mfma_phase(const bf16_t* __restrict__ pqb  , const bf16_t* __restrict__ keysb  , int* __restrict__ eidx, float* __restrict__ gate,
                                                 char* lds, const pg8::StaticOrder& S, const int tid) {
    using namespace rt;
    const int wid = __builtin_amdgcn_readfirstlane(tid >> 6), lane = tid & 63, r32 = lane & 31, hi = lane >> 5;
    att::bf16* K_lds = (att::bf16*)lds;
    pg8::Unit un;
    for (int ui = 0; S.next(ui, un); ++ui) {
        const int h = un.pn, tb = un.pm * 256;
        const int tok = tb + wid * 32 + r32;
        float t0[16], t1[16];
#pragma unroll
        for (int c = 0; c < 2; ++c) {
            __syncthreads();
            { const bf16_t* kp = keysb + (size_t)(h * 2 + c) * 128 * 128;
              const int row = tid >> 2;
#pragma unroll
              for (int i = 0; i < 4; ++i) { const int sc = ((tid & 3) * 4 + i) * 8;
                  const bf16x8 v = *reinterpret_cast<const bf16x8*>(kp + row * 128 + sc);
                  *(bf16x8*)((char*)K_lds + (row >> 6) * 16384 + KSWZ(row & 63, sc * 2)) = v; } }
            bf16x8 qr[8];
            { const bf16_t* qw = pqb + (size_t)tok * 2048 + h * 256 + c * 128 + hi * 8;
#pragma unroll
              for (int d0 = 0; d0 < 8; ++d0) qr[d0] = *reinterpret_cast<const bf16x8*>(qw + d0 * 16); }
            __syncthreads();
            f32x16 p0, p1, p2, p3;
            att::qkt_pipe(p0, p1, (int)(uintptr_t)K_lds, qr, r32, hi);
            att::qkt_pipe(p2, p3, (int)(uintptr_t)K_lds + 16384, qr, r32, hi);
            tag_scores(p0, 0, hi); tag_scores(p1, 32, hi); tag_scores(p2, 64, hi); tag_scores(p3, 96, hi);
            if (c == 0) top16_of_128(p0, p1, p2, p3, t0); else top16_of_128(p0, p1, p2, p3, t1);
        }
        float v0[16], v1[16]; int k0[16], k1[16];
#pragma unroll
        for (int i = 0; i < 16; ++i) { const unsigned a = __float_as_uint(t0[i]), b = __float_as_uint(t1[i]);
            v0[i] = __uint_as_float(a & ~0x7Fu); v1[i] = __uint_as_float(b & ~0x7Fu); k0[i] = (int)((a & 0x7Fu) << 7); k1[i] = (int)(b & 0x7Fu); }
        float cv[25]; int ce[25];
    { const float s = hi ? (v0[0] + v1[1]) : (v0[0] + v1[0]); cv[0] = __uint_as_float((__float_as_uint(s) & ~0xFFu) | (unsigned)(2 * 0 + hi)); ce[0] = hi ? (k0[0] | k1[1]) : (k0[0] | k1[0]); }
    { const float s = hi ? (v0[0] + v1[3]) : (v0[0] + v1[2]); cv[1] = __uint_as_float((__float_as_uint(s) & ~0xFFu) | (unsigned)(2 * 1 + hi)); ce[1] = hi ? (k0[0] | k1[3]) : (k0[0] | k1[2]); }
    { const float s = hi ? (v0[0] + v1[5]) : (v0[0] + v1[4]); cv[2] = __uint_as_float((__float_as_uint(s) & ~0xFFu) | (unsigned)(2 * 2 + hi)); ce[2] = hi ? (k0[0] | k1[5]) : (k0[0] | k1[4]); }
    { const float s = hi ? (v0[0] + v1[7]) : (v0[0] + v1[6]); cv[3] = __uint_as_float((__float_as_uint(s) & ~0xFFu) | (unsigned)(2 * 3 + hi)); ce[3] = hi ? (k0[0] | k1[7]) : (k0[0] | k1[6]); }
    { const float s = hi ? (v0[0] + v1[9]) : (v0[0] + v1[8]); cv[4] = __uint_as_float((__float_as_uint(s) & ~0xFFu) | (unsigned)(2 * 4 + hi)); ce[4] = hi ? (k0[0] | k1[9]) : (k0[0] | k1[8]); }
    { const float s = hi ? (v0[0] + v1[11]) : (v0[0] + v1[10]); cv[5] = __uint_as_float((__float_as_uint(s) & ~0xFFu) | (unsigned)(2 * 5 + hi)); ce[5] = hi ? (k0[0] | k1[11]) : (k0[0] | k1[10]); }
    { const float s = hi ? (v0[0] + v1[13]) : (v0[0] + v1[12]); cv[6] = __uint_as_float((__float_as_uint(s) & ~0xFFu) | (unsigned)(2 * 6 + hi)); ce[6] = hi ? (k0[0] | k1[13]) : (k0[0] | k1[12]); }
    { const float s = hi ? (v0[0] + v1[15]) : (v0[0] + v1[14]); cv[7] = __uint_as_float((__float_as_uint(s) & ~0xFFu) | (unsigned)(2 * 7 + hi)); ce[7] = hi ? (k0[0] | k1[15]) : (k0[0] | k1[14]); }
    { const float s = hi ? (v0[1] + v1[1]) : (v0[1] + v1[0]); cv[8] = __uint_as_float((__float_as_uint(s) & ~0xFFu) | (unsigned)(2 * 8 + hi)); ce[8] = hi ? (k0[1] | k1[1]) : (k0[1] | k1[0]); }
    { const float s = hi ? (v0[1] + v1[3]) : (v0[1] + v1[2]); cv[9] = __uint_as_float((__float_as_uint(s) & ~0xFFu) | (unsigned)(2 * 9 + hi)); ce[9] = hi ? (k0[1] | k1[3]) : (k0[1] | k1[2]); }
    { const float s = hi ? (v0[1] + v1[5]) : (v0[1] + v1[4]); cv[10] = __uint_as_float((__float_as_uint(s) & ~0xFFu) | (unsigned)(2 * 10 + hi)); ce[10] = hi ? (k0[1] | k1[5]) : (k0[1] | k1[4]); }
    { const float s = hi ? (v0[1] + v1[7]) : (v0[1] + v1[6]); cv[11] = __uint_as_float((__float_as_uint(s) & ~0xFFu) | (unsigned)(2 * 11 + hi)); ce[11] = hi ? (k0[1] | k1[7]) : (k0[1] | k1[6]); }
    { const float s = hi ? (v0[2] + v1[1]) : (v0[2] + v1[0]); cv[12] = __uint_as_float((__float_as_uint(s) & ~0xFFu) | (unsigned)(2 * 12 + hi)); ce[12] = hi ? (k0[2] | k1[1]) : (k0[2] | k1[0]); }
    { const float s = hi ? (v0[2] + v1[3]) : (v0[2] + v1[2]); cv[13] = __uint_as_float((__float_as_uint(s) & ~0xFFu) | (unsigned)(2 * 13 + hi)); ce[13] = hi ? (k0[2] | k1[3]) : (k0[2] | k1[2]); }
    { const float s = hi ? (v0[3] + v1[0]) : (v0[2] + v1[4]); cv[14] = __uint_as_float((__float_as_uint(s) & ~0xFFu) | (unsigned)(2 * 14 + hi)); ce[14] = hi ? (k0[3] | k1[0]) : (k0[2] | k1[4]); }
    { const float s = hi ? (v0[3] + v1[2]) : (v0[3] + v1[1]); cv[15] = __uint_as_float((__float_as_uint(s) & ~0xFFu) | (unsigned)(2 * 15 + hi)); ce[15] = hi ? (k0[3] | k1[2]) : (k0[3] | k1[1]); }
    { const float s = hi ? (v0[4] + v1[0]) : (v0[3] + v1[3]); cv[16] = __uint_as_float((__float_as_uint(s) & ~0xFFu) | (unsigned)(2 * 16 + hi)); ce[16] = hi ? (k0[4] | k1[0]) : (k0[3] | k1[3]); }
    { const float s = hi ? (v0[4] + v1[2]) : (v0[4] + v1[1]); cv[17] = __uint_as_float((__float_as_uint(s) & ~0xFFu) | (unsigned)(2 * 17 + hi)); ce[17] = hi ? (k0[4] | k1[2]) : (k0[4] | k1[1]); }
    { const float s = hi ? (v0[5] + v1[1]) : (v0[5] + v1[0]); cv[18] = __uint_as_float((__float_as_uint(s) & ~0xFFu) | (unsigned)(2 * 18 + hi)); ce[18] = hi ? (k0[5] | k1[1]) : (k0[5] | k1[0]); }
    { const float s = hi ? (v0[6] + v1[1]) : (v0[6] + v1[0]); cv[19] = __uint_as_float((__float_as_uint(s) & ~0xFFu) | (unsigned)(2 * 19 + hi)); ce[19] = hi ? (k0[6] | k1[1]) : (k0[6] | k1[0]); }
    { const float s = hi ? (v0[7] + v1[1]) : (v0[7] + v1[0]); cv[20] = __uint_as_float((__float_as_uint(s) & ~0xFFu) | (unsigned)(2 * 20 + hi)); ce[20] = hi ? (k0[7] | k1[1]) : (k0[7] | k1[0]); }
    { const float s = hi ? (v0[9] + v1[0]) : (v0[8] + v1[0]); cv[21] = __uint_as_float((__float_as_uint(s) & ~0xFFu) | (unsigned)(2 * 21 + hi)); ce[21] = hi ? (k0[9] | k1[0]) : (k0[8] | k1[0]); }
    { const float s = hi ? (v0[11] + v1[0]) : (v0[10] + v1[0]); cv[22] = __uint_as_float((__float_as_uint(s) & ~0xFFu) | (unsigned)(2 * 22 + hi)); ce[22] = hi ? (k0[11] | k1[0]) : (k0[10] | k1[0]); }
    { const float s = hi ? (v0[13] + v1[0]) : (v0[12] + v1[0]); cv[23] = __uint_as_float((__float_as_uint(s) & ~0xFFu) | (unsigned)(2 * 23 + hi)); ce[23] = hi ? (k0[13] | k1[0]) : (k0[12] | k1[0]); }
    { const float s = hi ? (v0[15] + v1[0]) : (v0[14] + v1[0]); cv[24] = __uint_as_float((__float_as_uint(s) & ~0xFFu) | (unsigned)(2 * 24 + hi)); ce[24] = hi ? (k0[15] | k1[0]) : (k0[14] | k1[0]); }
        float ts[16]; int te[16];
#pragma unroll
        for (int k = 0; k < 16; ++k) {
            float m = cv[0];
#pragma unroll
            for (int n = 1; n < 25; ++n) m = fmaxf(m, cv[n]);
            m = pair_max(m);
            int e = -1;
#pragma unroll
            for (int n = 0; n < 25; ++n) { const bool hit = cv[n] == m; e = hit ? ce[n] : e; cv[n] = hit ? -3.0e38f : cv[n]; }
            ts[k] = __uint_as_float(__float_as_uint(m) & ~0xFFu); te[k] = pair_max_i(e);
        }
        float den = 0.f; const float mx = ts[0];
#pragma unroll
        for (int k = 0; k < 16; ++k) { ts[k] = __expf(ts[k] - mx); den += ts[k]; }
        const float inv = 1.0f / den;
        if (hi == 0) { int4* op = (int4*)(eidx + (size_t)tok * 128 + h * 16);
            op[0] = make_int4(te[0], te[1], te[2], te[3]); op[1] = make_int4(te[4], te[5], te[6], te[7]); op[2] = make_int4(te[8], te[9], te[10], te[11]); op[3] = make_int4(te[12], te[13], te[14], te[15]); }
        else { float4* op = (float4*)(gate + (size_t)tok * 128 + h * 16);
            op[0] = make_float4(ts[0] * inv, ts[1] * inv, ts[2] * inv, ts[3] * inv); op[1] = make_float4(ts[4] * inv, ts[5] * inv, ts[6] * inv, ts[7] * inv);
            op[2] = make_float4(ts[8] * inv, ts[9] * inv, ts[10] * inv, ts[11] * inv); op[3] = make_float4(ts[12] * inv, ts[13] * inv, ts[14] * inv, ts[15] * inv); }
    }
}
#ifndef PH_MASK
#define PH_MASK 0xffffffffu
#endif
constexpr int N_PHASES = 20;
__global__ void __launch_bounds__(512, 2) mega(MK a) {
    extern __shared__ __attribute__((aligned(16))) unsigned char lds_raw[];
    LDSA unsigned char* lds = (LDSA unsigned char*)lds_raw;
    const int lo = a.ph_lo, hi = a.ph_hi;
    const int G = gridDim.x, bid = blockIdx.x;
    const int wid_s = __builtin_amdgcn_readfirstlane(threadIdx.x >> 6);
    unsigned char* ws = a.ws;
#define PH_TID() int tid; { int _z = 0; asm volatile("" : "+s"(_z)); tid = wid_s * 64 + (int)__builtin_amdgcn_mbcnt_hi(~0u, __builtin_amdgcn_mbcnt_lo(~0u, (unsigned)_z)); }
#define WSP(T, name, off) T* name; { unsigned char* _b = ws; asm volatile("" : "+s"(_b)); name = (T*)(_b + (off)); }
#define IN(k) ((((PH_MASK) >> (k)) & 1u) && lo <= (k) && (k) < hi)
#define SEAM(k) do { if ((k) + 1 < hi) { PH_TID() xcd_barrier(bar, tid); } } while (0)
    XcdBarrier bar;
    { PH_TID()
      volatile LAS unsigned* st = (volatile LAS unsigned*)(lds + LDS_MISC);
      if (tid == 0) { st[0] = 0u; st[1] = 0u; }
      __syncthreads();
      bar = xcd_barrier_post((unsigned*)(ws + WS_CTL), st, tid); }

    if (IN(0)) {
      {
        PH_TID()
        WSP(bf16_t, xb, WS_XB) WSP(bf16_t, wab, WS_WAB) WSP(bf16_t, woab, WS_WOAB) WSP(bf16_t, wcd, WS_WCD) WSP(bf16_t, wocd, WS_WOCD) WSP(bf16_t, wq, WS_WQ) WSP(unsigned char, ub, WS_UB) WSP(unsigned char, vb, WS_VB) WSP(float, isu, WS_SU) WSP(float, isv, WS_SV)
        cvt_rows_bf16(a.in[0], xb, (size_t)SEQ * DM / 8, bid, G, tid, 512);
        LDSA float* tile = (LDSA float*)lds;
        transpose_cvt(a.in[1], wab, 4096, 12288, tile, bid, G, PermAB(), tid);
        transpose_cvt(a.in[3], woab, 3072, 4096, tile, bid, G, PermNone(), tid);
        transpose_cvt(a.in[4], wcd, 4096, 9216, tile, bid, G, PermCD(), tid);
        transpose_cvt(a.in[12], wocd, 4096, 4096, tile, bid, G, PermNone(), tid);
        transpose_cvt(a.in[15], wq, 4096, 2048, tile, bid, G, PermNone(), tid);
        transpose_cvt(a.in[15] + (size_t)4096 * 2048, wq + (size_t)2048 * 4096, 4096, 2048, tile, bid, G, PermNone(), tid);
        table_fp6(a.in[17], ub, isu, 2 * 16384, (LDSA float*)lds, bid, G, tid);
        { const int nu1 = (SEQ / 256) * (9216 / 256); const bool slack = (nu1 % G) != 0 && (nu1 % G) <= G / 2;
          table_fp6(a.in[18], vb, isv, slack ? 16384 : 2 * 16384, (LDSA float*)lds, bid, G, tid); }
        { WSP(float, cs0, WS_CS0) WSP(float, csa, WS_CSA) rope_tables(cs0, csa, bid, G, tid); }
        { WSP(bf16_t, keyb, WS_KEYB) cvt_rows_bf16(a.in[16], keyb, (size_t)2 * 8 * 2 * 128 * 128 / 8, bid, G, tid, 512); }
      }
        SEAM(0);
    }
    { constexpr int layer = 0;
        const int pb = 1 + 10 * layer;
        if (IN(pb + 0)) {
            PH_TID() WSP(bf16_t, xb, WS_XB) WSP(bf16_t, x2b, WS_X2B) WSP(bf16_t, wab, WS_WAB) WSP(bf16_t, wcd, WS_WCD) WSP(bf16_t, hb, WS_HB) WSP(float, cs0, WS_CS0) WSP(float, csa, WS_CSA)
            if (layer == 0) {
                pg8::Gemm g{xb, wab, SEQ, 12288, 4096}; pg8::StaticOrder S; S.init(SEQ, 12288, G, bid);
                pg8::EpiProj<0> E{hb, 12288, cs0, csa, nullptr, nullptr, (LDSA float*)(lds + LDS_MISC + 64)};
                pg8::gemm_phase<pg8::EpiProj<0>, pg8::StaticOrder>(lds, g, S, E, nullptr, tid);
            } else {
                pg8::Gemm g{x2b, wcd, SEQ, 9216, 4096}; pg8::StaticOrder S; S.init(SEQ, 9216, G, bid);
                pg8::EpiProj<1> E{hb, 9216, cs0, csa, a.in[10], a.in[11], (LDSA float*)(lds + LDS_MISC + 64)};
                pg8::gemm_phase<pg8::EpiProj<1>, pg8::StaticOrder>(lds, g, S, E, nullptr, tid);
                { const int nu1 = (SEQ / 256) * (9216 / 256), busy = nu1 % G; const bool slack = busy != 0 && busy <= G / 2;
                  if (slack && bid >= busy) {
                      WSP(unsigned char, vb1, WS_VB) WSP(float, isv1, WS_SV)
                      int t5; { int _z = 0; asm volatile("" : "+s"(_z)); t5 = wid_s * 64 + (int)__builtin_amdgcn_mbcnt_hi(~0u, __builtin_amdgcn_mbcnt_lo(~0u, (unsigned)_z)); }
                      table_fp6(a.in[18] + (size_t)16384 * DM, vb1 + (size_t)16384 * ROWB, isv1 + 16384, 16384, (LDSA float*)lds, bid - busy, G - busy, t5); } }
            }
            SEAM(pb + 0);
        }
        if (IN(pb + 2)) {
            PH_TID() WSP(bf16_t, hb, WS_HB) WSP(bf16_t, abb, WS_AB) WSP(float, oc, WS_OC)
            if (layer == 0) attn0_phase(hb, a.in[2], abb, (bf16_t*)oc, (float*)((unsigned char*)oc + (size_t)3 * 8 * SEQ * 128 * 2), (char*)lds_raw, bid, G, tid);
            else attn1_phase(hb, abb, oc, a.in[5], a.in[6], a.in[7], a.in[8], a.in[9], (char*)lds_raw, bid, G, tid);
            SEAM(pb + 2);
        }
        if (layer == 0) {
            if (IN(pb + 3)) {
                PH_TID() WSP(bf16_t, abb, WS_AB) WSP(float, oc, WS_OC)
                merge0_phase((const bf16_t*)oc, (const float*)((unsigned char*)oc + (size_t)3 * 8 * SEQ * 128 * 2), abb, bid, G, tid);
                SEAM(pb + 3);
            }
        } else {
        }
        if (IN(pb + 4)) {
            const int K = layer == 0 ? 3072 : 4096;
            PH_TID() WSP(bf16_t, abb, WS_AB) WSP(bf16_t, woab, WS_WOAB) WSP(bf16_t, wocd, WS_WOCD) WSP(float, ybuf, WS_Y) WSP(float, x2, WS_X2)
            pg8::Gemm g{abb, layer == 0 ? woab : wocd, SEQ, 4096, K}; pg8::StaticOrder S; S.init(SEQ, 4096, G, bid);
            pg8::EpiF32R E{ybuf, 4096, layer == 0 ? a.in[0] : (const float*)x2, ALPHA};
            pg8::gemm_phase<pg8::EpiF32R, pg8::StaticOrder>(lds, g, S, E, nullptr, tid);
            SEAM(pb + 4);
        }
        if (IN(pb + 5)) {
            PH_TID() WSP(float, ybuf, WS_Y) WSP(float, stats, WS_X1) WSP(bf16_t, x1b, WS_X1B)
            ln_phase(ybuf, a.in[13] + layer * DM, a.in[14] + layer * DM, stats, x1b, bid, G, tid);
            SEAM(pb + 5);
        }
        if (IN(pb + 6)) {
            PH_TID() WSP(bf16_t, x1b, WS_X1B) WSP(bf16_t, wq, WS_WQ) WSP(bf16_t, pqb, WS_PQ)
            pg8::Gemm g{x1b, wq + (size_t)layer * 2048 * 4096, SEQ, 2048, 4096}; pg8::StaticOrder S; S.init(SEQ, 2048, G, bid);
            pg8::EpiBf16P E{pqb, 2048};
            pg8::gemm_phase<pg8::EpiBf16P, pg8::StaticOrder>(lds, g, S, E, nullptr, tid);
            asm volatile("s_waitcnt vmcnt(0)" ::: "memory"); __syncthreads();
            { WSP(bf16_t, keyb, WS_KEYB) WSP(int, eidx, WS_EIDX) WSP(float, gate, WS_GATE)
              int t4 = tid; asm volatile("" : "+v"(t4));
              route_mfma_phase(pqb, keyb + (size_t)layer * 8 * 2 * 128 * 128, eidx, gate, (char*)lds_raw, S, t4); }
            SEAM(pb + 6);
        }
        if (IN(pb + 8)) {
            PH_TID() WSP(float, ybuf, WS_Y) WSP(float, stats, WS_X1) WSP(bf16_t, x1b, WS_X1B) WSP(int, eidx, WS_EIDX) WSP(float, gate, WS_GATE) WSP(unsigned char, ub, WS_UB) WSP(unsigned char, vb, WS_VB) WSP(float, isu, WS_SU) WSP(float, isv, WS_SV) WSP(float, x2, WS_X2) WSP(bf16_t, x2b, WS_X2B)
            peer_expert_phase(ybuf, stats, a.in[13] + layer * DM, a.in[14] + layer * DM, x1b, eidx, gate, ub + (size_t)layer * 16384 * ROWB, vb + (size_t)layer * 16384 * ROWB, isu + layer * 16384, isv + layer * 16384, a.in[19] + layer * DM, a.in[20] + layer * DM,
                              layer == 0 ? x2 : a.out, layer == 0 ? x2b : (bf16_t*)nullptr, (LDSA float*)lds, bid, G, tid);
            SEAM(pb + 8);
        }
        }
    { constexpr int layer = 1;
        const int pb = 1 + 10 * layer;
        if (IN(pb + 0)) {
            PH_TID() WSP(bf16_t, xb, WS_XB) WSP(bf16_t, x2b, WS_X2B) WSP(bf16_t, wab, WS_WAB) WSP(bf16_t, wcd, WS_WCD) WSP(bf16_t, hb, WS_HB) WSP(float, cs0, WS_CS0) WSP(float, csa, WS_CSA)
            if (layer == 0) {
                pg8::Gemm g{xb, wab, SEQ, 12288, 4096}; pg8::StaticOrder S; S.init(SEQ, 12288, G, bid);
                pg8::EpiProj<0> E{hb, 12288, cs0, csa, nullptr, nullptr, (LDSA float*)(lds + LDS_MISC + 64)};
                pg8::gemm_phase<pg8::EpiProj<0>, pg8::StaticOrder>(lds, g, S, E, nullptr, tid);
            } else {
                pg8::Gemm g{x2b, wcd, SEQ, 9216, 4096}; pg8::StaticOrder S; S.init(SEQ, 9216, G, bid);
                pg8::EpiProj<1> E{hb, 9216, cs0, csa, a.in[10], a.in[11], (LDSA float*)(lds + LDS_MISC + 64)};
                pg8::gemm_phase<pg8::EpiProj<1>, pg8::StaticOrder>(lds, g, S, E, nullptr, tid);
                { const int nu1 = (SEQ / 256) * (9216 / 256), busy = nu1 % G; const bool slack = busy != 0 && busy <= G / 2;
                  if (slack && bid >= busy) {
                      WSP(unsigned char, vb1, WS_VB) WSP(float, isv1, WS_SV)
                      int t5; { int _z = 0; asm volatile("" : "+s"(_z)); t5 = wid_s * 64 + (int)__builtin_amdgcn_mbcnt_hi(~0u, __builtin_amdgcn_mbcnt_lo(~0u, (unsigned)_z)); }
                      table_fp6(a.in[18] + (size_t)16384 * DM, vb1 + (size_t)16384 * ROWB, isv1 + 16384, 16384, (LDSA float*)lds, bid - busy, G - busy, t5); } }
            }
            SEAM(pb + 0);
        }
        if (IN(pb + 2)) {
            PH_TID() WSP(bf16_t, hb, WS_HB) WSP(bf16_t, abb, WS_AB) WSP(float, oc, WS_OC)
            if (layer == 0) attn0_phase(hb, a.in[2], abb, (bf16_t*)oc, (float*)((unsigned char*)oc + (size_t)3 * 8 * SEQ * 128 * 2), (char*)lds_raw, bid, G, tid);
            else attn1_phase(hb, abb, oc, a.in[5], a.in[6], a.in[7], a.in[8], a.in[9], (char*)lds_raw, bid, G, tid);
            SEAM(pb + 2);
        }
        if (layer == 0) {
            if (IN(pb + 3)) {
                PH_TID() WSP(bf16_t, abb, WS_AB) WSP(float, oc, WS_OC)
                merge0_phase((const bf16_t*)oc, (const float*)((unsigned char*)oc + (size_t)3 * 8 * SEQ * 128 * 2), abb, bid, G, tid);
                SEAM(pb + 3);
            }
        } else {
        }
        if (IN(pb + 4)) {
            const int K = layer == 0 ? 3072 : 4096;
            PH_TID() WSP(bf16_t, abb, WS_AB) WSP(bf16_t, woab, WS_WOAB) WSP(bf16_t, wocd, WS_WOCD) WSP(float, ybuf, WS_Y) WSP(float, x2, WS_X2)
            pg8::Gemm g{abb, layer == 0 ? woab : wocd, SEQ, 4096, K}; pg8::StaticOrder S; S.init(SEQ, 4096, G, bid);
            pg8::EpiF32R E{ybuf, 4096, layer == 0 ? a.in[0] : (const float*)x2, ALPHA};
            pg8::gemm_phase<pg8::EpiF32R, pg8::StaticOrder>(lds, g, S, E, nullptr, tid);
            SEAM(pb + 4);
        }
        if (IN(pb + 5)) {
            PH_TID() WSP(float, ybuf, WS_Y) WSP(float, stats, WS_X1) WSP(bf16_t, x1b, WS_X1B)
            ln_phase(ybuf, a.in[13] + layer * DM, a.in[14] + layer * DM, stats, x1b, bid, G, tid);
            SEAM(pb + 5);
        }
        if (IN(pb + 6)) {
            PH_TID() WSP(bf16_t, x1b, WS_X1B) WSP(bf16_t, wq, WS_WQ) WSP(bf16_t, pqb, WS_PQ)
            pg8::Gemm g{x1b, wq + (size_t)layer * 2048 * 4096, SEQ, 2048, 4096}; pg8::StaticOrder S; S.init(SEQ, 2048, G, bid);
            pg8::EpiBf16P E{pqb, 2048};
            pg8::gemm_phase<pg8::EpiBf16P, pg8::StaticOrder>(lds, g, S, E, nullptr, tid);
            asm volatile("s_waitcnt vmcnt(0)" ::: "memory"); __syncthreads();
            { WSP(bf16_t, keyb, WS_KEYB) WSP(int, eidx, WS_EIDX) WSP(float, gate, WS_GATE)
              int t4 = tid; asm volatile("" : "+v"(t4));
              route_mfma_phase(pqb, keyb + (size_t)layer * 8 * 2 * 128 * 128, eidx, gate, (char*)lds_raw, S, t4); }
            SEAM(pb + 6);
        }
        if (IN(pb + 8)) {
            PH_TID() WSP(float, ybuf, WS_Y) WSP(float, stats, WS_X1) WSP(bf16_t, x1b, WS_X1B) WSP(int, eidx, WS_EIDX) WSP(float, gate, WS_GATE) WSP(unsigned char, ub, WS_UB) WSP(unsigned char, vb, WS_VB) WSP(float, isu, WS_SU) WSP(float, isv, WS_SV) WSP(float, x2, WS_X2) WSP(bf16_t, x2b, WS_X2B)
            peer_expert_phase(ybuf, stats, a.in[13] + layer * DM, a.in[14] + layer * DM, x1b, eidx, gate, ub + (size_t)layer * 16384 * ROWB, vb + (size_t)layer * 16384 * ROWB, isu + layer * 16384, isv + layer * 16384, a.in[19] + layer * DM, a.in[20] + layer * DM,
                              layer == 0 ? x2 : a.out, layer == 0 ? x2b : (bf16_t*)nullptr, (LDSA float*)lds, bid, G, tid);
            SEAM(pb + 8);
        }
        }

#undef IN
}
#ifndef ONE_LAUNCH
#define ONE_LAUNCH 1
#endif
extern "C" void kernel_launch(void* const* d_in, const int* in_sizes, int n_in, void* d_out, int out_size, void* d_ws, size_t ws_size, hipStream_t stream) {
    static int ready = 0;
    if (!ready) {
        if (ws_size < WS_END) { fprintf(stderr, "kernel_launch: workspace too small: %zu < %zu\n", ws_size, (size_t)WS_END); return; }
        if (hipFuncSetAttribute((const void*)mega, hipFuncAttributeMaxDynamicSharedMemorySize, LDS_BYTES) != hipSuccess) { fprintf(stderr, "kernel_launch: hipFuncSetAttribute failed\n"); return; }
        int per_cu = 0;
        if (hipOccupancyMaxActiveBlocksPerMultiprocessor(&per_cu, (const void*)mega, 512, LDS_BYTES) != hipSuccess || per_cu < 1) fprintf(stderr, "kernel_launch: note: occupancy query reports %d blocks per CU\n", per_cu);
        (void)hipGetLastError();
        ready = 1;
    }
    unsigned char* ws = (unsigned char*)d_ws;
    (void)hipMemsetAsync(ws + WS_CTL, 0, CTL_BYTES, stream);
    MK a{}; for (int i = 0; i < 21; ++i) a.in[i] = (const float*)d_in[i];
    a.out = (float*)d_out; a.ws = ws;
#if ONE_LAUNCH
    a.ph_lo = 0; a.ph_hi = N_PHASES;
    hipLaunchKernelGGL(mega, dim3(256), dim3(512), LDS_BYTES, stream, a);
#else
    for (int k = 0; k < N_PHASES; ++k) { if (k == 10 || k == 2 || k == 12 || k == 14 || k == 8 || k == 18) continue; a.ph_lo = k; a.ph_hi = k + 1; hipLaunchKernelGGL(mega, dim3(256), dim3(512), LDS_BYTES, stream, a); }
#endif
    const hipError_t le = hipPeekAtLastError();
    if (le != hipSuccess) fprintf(stderr, "kernel_launch: launch failed: %s\n", hipGetErrorName(le));
}
```

```cpp
#include <hip/hip_runtime.h>
#include <stdint.h>
#include <cstdio>

#define SEQ 8192
#define DM 4096
#define HD 128
#define ALPHA 1.4142135623730951f
#define LAMBDA_INIT 0.35550906759096934f
#define ATT_SCALE 0.088388347648318440f

__device__ const double REV_P[16] = {0.15915494309189535, 0.0700865215877985, 0.03086376340470123, 0.013591370636193905, 0.005985185712713705, 0.002635675898667414, 0.001160663641240061, 0.0005111175045375439, 0.00022507907903927653, 9.911730936901935e-05, 4.364795279280289e-05, 1.9221100684944863e-05, 8.464330808241401e-06, 3.727408601915352e-06, 1.6414262627950345e-06, 7.228293068832865e-07};
__device__ const double REV_A[32] = {0.15915494309189535, 0.11934937021124886, 0.08949940160889101, 0.06711508300522726, 0.050329212104487035, 0.03774158471741977, 0.0283021958306234, 0.02122365276477766, 0.015915494309189534, 0.011934937021124886, 0.008949940160889102, 0.006711508300522725, 0.005032921210448704, 0.003774158471741977, 0.00283021958306234, 0.0021223652764777662, 0.0015915494309189536, 0.0011934937021124885, 0.0008949940160889102, 0.0006711508300522726, 0.0005032921210448703, 0.00037741584717419774, 0.00028302195830623395, 0.0002122365276477766, 0.00015915494309189535, 0.00011934937021124886, 8.949940160889102e-05, 6.711508300522725e-05, 5.0329212104487035e-05, 3.774158471741978e-05, 2.8302195830623396e-05, 2.122365276477766e-05};

__device__ __forceinline__ void sincos_rev(double rev, float& s, float& c) {
    const double f = rev - floor(rev); const float ff = (float)f;
    s = __builtin_amdgcn_sinf(ff); c = __builtin_amdgcn_cosf(ff);
}
__device__ __forceinline__ float wave_sum(float v) {
#pragma unroll
    for (int o = 32; o >= 1; o >>= 1) v += __shfl_xor(v, o);
    return v;
}
__device__ __forceinline__ float wave_max(float v) {
#pragma unroll
    for (int o = 32; o >= 1; o >>= 1) v = fmaxf(v, __shfl_xor(v, o));
    return v;
}
namespace pg8 {
#define PG8_LAS __attribute__((address_space(3)))
typedef unsigned short bf16_t;
typedef short bf16x8 __attribute__((ext_vector_type(8)));
typedef float f32x4 __attribute__((ext_vector_type(4)));
typedef unsigned u32x4 __attribute__((ext_vector_type(4)));
constexpr int BM = 256, BK = 64, HALF = 128, HTB = HALF * BK * 2  , STAGE_BYTES = 8 * HTB, NXCD = 8, WGM = 8;

__host__ __device__ __forceinline__ int lds_byte(int r, int c) { const int st = (r >> 4) * 2 + (c >> 5), rr = r & 15, cc = c & 31, ob = rr * 64 + cc * 2; return st * 1024 + (ob ^ (((ob >> 9) & 1) << 5)); }
__host__ __device__ __forceinline__ void stage_rc(int b, int& R, int& C) { const int st = b / 1024, sb = b % 1024, swz = sb ^ (((sb >> 9) & 1) << 5); R = (st >> 1) * 16 + swz / 64; C = (st & 1) * 32 + (swz % 64) / 2; }
__host__ __device__ __forceinline__ int perm32(int rho) { const int n = rho >> 4, i = rho & 15; return 8 * (i >> 2) + 4 * n + (i & 3); }

struct Unit { int pm, pn; };
struct Gemm { const bf16_t* A; const bf16_t* Bt; int M, N, K; };

struct StaticOrder {
    int nM, nN, nwg, G, c;
    __host__ __device__ void init(int M, int N, int G_, int c_) { nM = M / BM; nN = N / BM; nwg = nM * nN; G = G_; c = c_; }
    __host__ __device__ bool next(int i, Unit& u) const {
        const long L = (long)i * G + c; if (L >= nwg) return false;
        int wgid = (int)L; { const int q = nwg / NXCD, r = nwg % NXCD, xcd = wgid % NXCD, off = wgid / NXCD; wgid = (xcd < r ? xcd * (q + 1) : r * (q + 1) + (xcd - r) * q) + off; }
        const int nig = WGM * nN, gid = wgid / nig, fm = gid * WGM, gsz = (nM - fm) < WGM ? (nM - fm) : WGM;
        u.pm = fm + ((wgid % nig) % gsz); u.pn = (wgid % nig) / gsz; return true;
    }
    __device__ __forceinline__ void a_ready(const Unit&) const {}
    __device__ __forceinline__ void done(const Unit&) const {}
};
__device__ __forceinline__ unsigned cvt_pk_bf16(float lo, float hi) { unsigned r; asm volatile("v_cvt_pk_bf16_f32 %0, %1, %2" : "=v"(r) : "v"(lo), "v"(hi)); return r; }
typedef float f32x2 __attribute__((ext_vector_type(2)));
template <class Epi, class Sched, bool STAMP = false>
__device__ __forceinline__ void gemm_phase(PG8_LAS unsigned char* lds, const Gemm g, const Sched& S, const Epi& E, unsigned long long* stamps, const int tid_in) {
    const int tid = tid_in, wid = __builtin_amdgcn_readfirstlane(tid >> 6), lane = tid & 63, wr = wid >> 2, wc = wid & 3, fr = lane & 15, fq = lane >> 4;
    const int K = g.K, nt = K / BK;
    int ts_lo = 0, ts_hi = 0, nts = 0; const unsigned long long rt_entry = STAMP ? (unsigned long long)wall_clock64() : 0ull;
#define PG8_STAMP() do { if (STAMP && wid == 0 && nts < 64) { const unsigned long long _c = (unsigned long long)clock64(); \
        ts_lo = (lane == nts) ? (int)(unsigned)_c : ts_lo; ts_hi = (lane == nts) ? (int)(unsigned)(_c >> 32) : ts_hi; ++nts; } } while (0)
    PG8_STAMP();
    unsigned voffA[2], voffB[2];
#pragma unroll
    for (int i = 0; i < 2; ++i) { int R, C; stage_rc(tid * 16 + i * 8192, R, C); const int Rb = Epi::PERM ? ((R & ~31) + perm32(R & 31)) : R;
        voffA[i] = (unsigned)(R * K + C) * 2u; voffB[i] = (unsigned)(Rb * K + C) * 2u; }
    const size_t kstep = (size_t)(BK * 2);
    const size_t hstep = (size_t)HALF * K * 2;
    const size_t tstep = 2 * hstep;
    const unsigned ldsw = (unsigned)wid * 1024u;
    const int aoff = lds_byte(wr * 64 + fr, fq * 8), boff = lds_byte(wc * 32 + fr, fq * 8);
#define PG8_SA(b, h) (((b) * 2 + (h)) * HTB)
#define PG8_SB(b, h) ((4 + (b) * 2 + (h)) * HTB)
#define PG8_STAGE(bufoff, gbase, voff) do { _Pragma("unroll") for (int _i = 0; _i < 2; ++_i) \
        __builtin_amdgcn_global_load_lds((const unsigned*)((const char*)(gbase) + (voff)[_i]), (PG8_LAS unsigned*)(lds + (bufoff) + ldsw + _i * 8192), 16, 0, 0); } while (0)
#define PG8_LDA(dst, b, h) do { _Pragma("unroll") for (int m = 0; m < 4; ++m) _Pragma("unroll") for (int k = 0; k < 2; ++k) dst[m][k] = *(const PG8_LAS bf16x8*)(lds + PG8_SA(b, h) + aoff + m * 2048 + k * 1024); } while (0)
#define PG8_LDB(dst, b, h) do { _Pragma("unroll") for (int n = 0; n < 2; ++n) _Pragma("unroll") for (int k = 0; k < 2; ++k) dst[n][k] = *(const PG8_LAS bf16x8*)(lds + PG8_SB(b, h) + boff + n * 2048 + k * 1024); } while (0)
#define PG8_MMA(ai, bj, At, Bt) do { __builtin_amdgcn_s_setprio(1); _Pragma("unroll") for (int m = 0; m < 4; ++m) _Pragma("unroll") for (int n = 0; n < 2; ++n) _Pragma("unroll") for (int k = 0; k < 2; ++k) \
        acc[ai][bj][m][n] = __builtin_amdgcn_mfma_f32_16x16x32_bf16(Bt[n][k], At[m][k], acc[ai][bj][m][n], 0, 0, 0); __builtin_amdgcn_s_setprio(0); } while (0)
#define PG8_WAIT_V(n) asm volatile("s_waitcnt vmcnt(" #n ")" ::: "memory")
#define PG8_WAIT_L(n) asm volatile("s_waitcnt lgkmcnt(" #n ")" ::: "memory")
#define PG8_BAR __builtin_amdgcn_s_barrier()
#define PG8_SCHED __builtin_amdgcn_sched_barrier(0)
    Unit cur, nxt; int ui = 0;
    if (!S.next(0, cur)) return;
    f32x4 acc[2][2][4][2];
#pragma unroll
    for (int a = 0; a < 2; ++a)
#pragma unroll
        for (int b = 0; b < 2; ++b)
#pragma unroll
            for (int m = 0; m < 4; ++m)
#pragma unroll
                for (int n = 0; n < 2; ++n) acc[a][b][m][n] = (f32x4){0.f, 0.f, 0.f, 0.f};
    bf16x8 At[4][2], B0[2][2], B1[2][2];
    const char* cA = (const char*)g.A + (size_t)cur.pm * tstep; const char* cB = (const char*)g.Bt + (size_t)cur.pn * tstep;
    S.a_ready(cur);
    PG8_STAGE(PG8_SB(0, 0), cB, voffB); PG8_STAGE(PG8_SA(0, 0), cA, voffA); PG8_STAGE(PG8_SB(0, 1), cB + hstep, voffB); PG8_STAGE(PG8_SA(0, 1), cA + hstep, voffA);
    if (wr == 1) PG8_BAR;
    PG8_WAIT_V(4); PG8_BAR;
    PG8_STAGE(PG8_SB(1, 0), cB + kstep, voffB); PG8_STAGE(PG8_SA(1, 0), cA + kstep, voffA); PG8_STAGE(PG8_SB(1, 1), cB + hstep + kstep, voffB);
    PG8_WAIT_V(6); PG8_BAR;
    PG8_STAMP();
    for (;;) {
        const bool has_next = S.next(ui + 1, nxt);
        const char* nA = has_next ? (const char*)g.A + (size_t)nxt.pm * tstep : cA; const char* nB = has_next ? (const char*)g.Bt + (size_t)nxt.pn * tstep : cB;
        for (int t = 0; t < nt; t += 2) {
            const bool last = (t == nt - 2);
            const char* a1 = cA + (size_t)(t + 1) * kstep;
            const char* a2 = last ? nA : cA + (size_t)(t + 2) * kstep; const char* b2 = last ? nB : cB + (size_t)(t + 2) * kstep;
            const char* a3 = a2 + kstep; const char* b3 = b2 + kstep;
            if (last && has_next) S.a_ready(nxt);
            PG8_LDB(B0, 0, 0); PG8_SCHED; PG8_LDA(At, 0, 0); PG8_STAGE(PG8_SA(1, 1), a1 + hstep, voffA);
            PG8_WAIT_L(8); PG8_BAR; PG8_WAIT_L(0); PG8_MMA(0, 0, At, B0); PG8_BAR; PG8_SCHED;
            PG8_LDB(B1, 0, 1); PG8_STAGE(PG8_SB(0, 0), b2, voffB);
            PG8_BAR; PG8_WAIT_L(0); PG8_MMA(0, 1, At, B1); PG8_BAR;
            PG8_LDA(At, 0, 1); PG8_STAGE(PG8_SA(0, 0), a2, voffA);
            PG8_BAR; PG8_WAIT_L(0); PG8_MMA(1, 0, At, B0); PG8_BAR; PG8_SCHED;
            PG8_STAGE(PG8_SB(0, 1), b2 + hstep, voffB);
            PG8_WAIT_V(6); PG8_BAR; PG8_MMA(1, 1, At, B1); PG8_BAR;
            PG8_LDB(B0, 1, 0); PG8_SCHED; PG8_LDA(At, 1, 0); PG8_STAGE(PG8_SA(0, 1), a2 + hstep, voffA);
            PG8_WAIT_L(8); PG8_BAR; PG8_WAIT_L(0); PG8_MMA(0, 0, At, B0); PG8_BAR; PG8_SCHED;
            PG8_LDB(B1, 1, 1); PG8_STAGE(PG8_SB(1, 0), b3, voffB);
            PG8_BAR; PG8_WAIT_L(0); PG8_MMA(0, 1, At, B1); PG8_BAR;
            PG8_LDA(At, 1, 1); PG8_STAGE(PG8_SA(1, 0), a3, voffA);
            PG8_BAR; PG8_WAIT_L(0); PG8_MMA(1, 0, At, B0); PG8_BAR; PG8_SCHED;
            PG8_STAGE(PG8_SB(1, 1), b3 + hstep, voffB);
            PG8_WAIT_V(6); PG8_BAR; PG8_MMA(1, 1, At, B1); PG8_BAR;
        }
        PG8_STAMP();
        if constexpr (!Epi::AFTER_DRAIN) { E(acc, cur, wr, wc, fr, fq); S.done(cur); }
        PG8_STAMP();
        if (!has_next) break;
#pragma unroll
        for (int a = 0; a < 2; ++a)
#pragma unroll
            for (int b = 0; b < 2; ++b)
#pragma unroll
                for (int m = 0; m < 4; ++m)
#pragma unroll
                    for (int n = 0; n < 2; ++n) acc[a][b][m][n] = (f32x4){0.f, 0.f, 0.f, 0.f};
        cur = nxt; cA = nA; cB = nB; ++ui;
    }
    PG8_WAIT_V(0);
    if (wr == 0) PG8_BAR;
    PG8_BAR;
    if constexpr (Epi::AFTER_DRAIN) { E.fused(acc, cur, wr, wc, fr, fq, lds, wid, lane); S.done(cur); }
    PG8_STAMP();
    if (STAMP && wid == 0) { stamps[lane] = lane < nts ? (((unsigned long long)(unsigned)ts_hi << 32) | (unsigned)ts_lo) : 0ull;
        if (lane == 62) stamps[62] = rt_entry; if (lane == 63) stamps[63] = (unsigned long long)wall_clock64(); }
#undef PG8_STAMP
#undef PG8_SA
#undef PG8_SB
#undef PG8_STAGE
#undef PG8_LDA
#undef PG8_LDB
#undef PG8_MMA
#undef PG8_WAIT_V
#undef PG8_WAIT_L
#undef PG8_BAR
#undef PG8_SCHED
}
}
#define XB_TMO      128
#define XB_XCNT(j)  (256  + 64 * (j))
#define XB_XSUB(j)  (1280 + 64 * (j))
#define XB_XGEN(j)  (2304 + 64 * (j))
#define XB_TOP      3328
#define XB_TOPGEN   3392
#define XCD_BAR_WORDS 3456
#define XB_SPIN_CAP (1u << 22)
#define LAS __attribute__((address_space(3)))

__device__ __forceinline__ unsigned xb_ld(unsigned* p)              { return __hip_atomic_load(p, __ATOMIC_RELAXED, __HIP_MEMORY_SCOPE_AGENT); }
__device__ __forceinline__ unsigned xb_add(unsigned* p, unsigned v) { return __hip_atomic_fetch_add(p, v, __ATOMIC_RELAXED, __HIP_MEMORY_SCOPE_AGENT); }
__device__ __forceinline__ unsigned xb_xcc_id() { return (unsigned)__builtin_amdgcn_s_getreg((3 << 11) | 20) & 0xFu; }
#define XB_SPIN(cond, bar) do { unsigned _sp = 0; while (cond) { __builtin_amdgcn_s_sleep(1); \
    if ((++_sp & 255u) == 0u) { if (xb_ld(&(bar)[XB_TMO])) break; if (_sp > XB_SPIN_CAP) { atomicAdd(&(bar)[XB_TMO], 1u); break; } } } } while (0)

struct XcdBarrier {
    unsigned* bar; unsigned x;
    volatile LAS unsigned* st;
};

__device__ __forceinline__ XcdBarrier xcd_barrier_post(unsigned* bar, volatile LAS unsigned* st, const int tid) {
    XcdBarrier b; b.bar = bar; b.x = xb_xcc_id(); b.st = st;
    if (tid == 0) (void)xb_add(&bar[XB_XCNT(b.x)], 1u);
    return b;
}
__device__ __forceinline__ void xcd_barrier_complete(unsigned* bar, unsigned x, unsigned& nloc, unsigned& nx) {
    const unsigned G = gridDim.x * gridDim.y * gridDim.z;
    unsigned sum, cnt, mine, sp = 0u;
    for (;;) {
        sum = 0u; cnt = 0u; mine = 0u;
#pragma unroll
        for (unsigned j = 0; j < 16; ++j) { const unsigned c = xb_ld(&bar[XB_XCNT(j)]); sum += c; cnt += (c > 0u) ? 1u : 0u; mine = (j == x) ? c : mine; }
        if (sum == G) break;
        __builtin_amdgcn_s_sleep(1);
        if ((++sp & 255u) == 0u) { if (xb_ld(&bar[XB_TMO])) break; if (sp > XB_SPIN_CAP) { atomicAdd(&bar[XB_TMO], 1u); break; } }
    }
    nloc = mine > 0u ? mine : 1u; nx = cnt > 0u ? cnt : 1u;
}

__device__ __forceinline__ void xcd_barrier(const XcdBarrier& b, const int tid) {
    asm volatile("s_waitcnt vmcnt(0)" ::: "memory");
    __syncthreads();
    if (tid == 0) {
        unsigned* bar = b.bar;
        __builtin_amdgcn_s_waitcnt(0);
        unsigned nloc = b.st[0], nx = b.st[1];
        if (nloc == 0u) { xcd_barrier_complete(bar, b.x, nloc, nx); b.st[0] = nloc; b.st[1] = nx; }
        const unsigned old = xb_add(&bar[XB_XSUB(b.x)], 1u);
        const unsigned gen = old / nloc;
        if (old + 1u == (gen + 1u) * nloc) {
            __builtin_amdgcn_fence(__ATOMIC_RELEASE, "agent");
            asm volatile("s_waitcnt vmcnt(0)" ::: "memory");
            const unsigned og = xb_add(&bar[XB_TOP], 1u);
            const unsigned tg = og / nx;
            if (og + 1u == (tg + 1u) * nx) xb_add(&bar[XB_TOPGEN], 1u);
            else XB_SPIN(xb_ld(&bar[XB_TOPGEN]) == tg, bar);
            __builtin_amdgcn_fence(__ATOMIC_ACQUIRE, "agent");
            xb_add(&bar[XB_XGEN(b.x)], 1u);
            asm volatile("s_waitcnt vmcnt(0)" ::: "memory");
        } else {
            XB_SPIN(xb_ld(&bar[XB_XGEN(b.x)]) == gen, bar);
            __builtin_amdgcn_fence(__ATOMIC_ACQUIRE, "agent");
            asm volatile("s_waitcnt vmcnt(0)" ::: "memory");
        }
    }
    __syncthreads();
}
namespace att {
using bf16 = unsigned short;
constexpr int   D = 128, NW = 8, QBLK = 32, KVBLK = 64;
constexpr float SCALE = 0.088388347648318440f;
constexpr float THR = 8.f;
constexpr int SDEPTH = 1;
constexpr size_t SHM_V = KVBLK * D * 2, SHM_K = KVBLK * D * 2, SHM_ATTN = 2 * SHM_V + 2 * SHM_K + NW * 64 * 4;
using bf16x8 = __attribute__((ext_vector_type(8))) short;
using s16x4  = __attribute__((ext_vector_type(4))) short;
using f32x16 = __attribute__((ext_vector_type(16))) float;
using f32x8  = __attribute__((ext_vector_type(8))) float;
using u32x4  = __attribute__((ext_vector_type(4))) unsigned;
#define KSWZ(row, colB) ((row) * 256 + ((colB) ^ (((row) & 7) << 4)))
#define SBAR() __builtin_amdgcn_sched_barrier(0)
__device__ __forceinline__ int crow(int r, int hi) { return (r & 3) + 8 * (r >> 2) + 4 * hi; }
__device__ __forceinline__ unsigned cvtpk(float lo, float hi) {
  unsigned r; asm volatile("v_cvt_pk_bf16_f32 %0, %1, %2" : "=v"(r) : "v"(lo), "v"(hi)); return r;
}
template <typename TIn> struct Stage;
template <> struct Stage<bf16>  { using T = bf16x8;
  __device__ static __forceinline__ T ld8(const bf16* p) { return *reinterpret_cast<const bf16x8*>(p); }
  __device__ static __forceinline__ bf16x8 tobf(T x) { return x; } };
template <> struct Stage<float> { using T = f32x8;
  __device__ static __forceinline__ T ld8(const float* p) { return *reinterpret_cast<const f32x8*>(p); }
  __device__ static __forceinline__ bf16x8 tobf(T x) {
    u32x4 w = {cvtpk(x[0], x[1]), cvtpk(x[2], x[3]), cvtpk(x[4], x[5]), cvtpk(x[6], x[7])}; return *reinterpret_cast<bf16x8*>(&w); } };

__device__ __forceinline__ void partialSM(f32x16& p0, f32x16& p1, float& m_reg, float& mn, float& alpha) {
  constexpr float C = SCALE * 1.4426950408889634f;
  float pmax = p0[0]; for (int r = 1; r < 16; ++r) pmax = fmaxf(pmax, p0[r]); for (int r = 0; r < 16; ++r) pmax = fmaxf(pmax, p1[r]);
  { auto rr = __builtin_amdgcn_permlane32_swap(__float_as_uint(pmax), __float_as_uint(pmax), false, false);
    pmax = fmaxf(__uint_as_float(rr[0]), __uint_as_float(rr[1])); }
  if (__builtin_expect(__all(pmax - m_reg <= THR / SCALE), 1)) { mn = m_reg; alpha = 1.f; }
  else { mn = fmaxf(m_reg, pmax); alpha = __builtin_amdgcn_exp2f((m_reg - mn) * C); m_reg = mn; }
  float mnC = -mn * C;
  for (int r = 0; r < 16; ++r) p0[r] = fmaf(p0[r], C, mnC); for (int r = 0; r < 16; ++r) p1[r] = fmaf(p1[r], C, mnC);
  for (int r = 0; r < 16; ++r) p0[r] = __builtin_amdgcn_exp2f(p0[r]);
}
__device__ __forceinline__ void finishSM(f32x16& p0, f32x16& p1, float alpha, float& l_reg, bf16x8& pa0, bf16x8& pa1, bf16x8& pa2, bf16x8& pa3) {
  for (int r = 0; r < 16; ++r) p1[r] = __builtin_amdgcn_exp2f(p1[r]);
  float ps = 0; for (int r = 0; r < 16; ++r) ps += p0[r]; for (int r = 0; r < 16; ++r) ps += p1[r];
  { auto rr = __builtin_amdgcn_permlane32_swap(__float_as_uint(ps), __float_as_uint(ps), false, false);
    ps = __uint_as_float(rr[0]) + __uint_as_float(rr[1]); }
  l_reg = l_reg * alpha + ps;
#define PK4(P, BASE, OUT) do { unsigned a0 = cvtpk(P[BASE + 0], P[BASE + 1]), a1 = cvtpk(P[BASE + 2], P[BASE + 3]);   \
    unsigned b0 = cvtpk(P[BASE + 4], P[BASE + 5]), b1 = cvtpk(P[BASE + 6], P[BASE + 7]);                              \
    auto r0 = __builtin_amdgcn_permlane32_swap(a0, b0, false, false); auto r1 = __builtin_amdgcn_permlane32_swap(a1, b1, false, false); \
    u32x4 w = {r0[0], r1[0], r0[1], r1[1]}; OUT = *reinterpret_cast<bf16x8*>(&w); } while (0)
  PK4(p0, 0, pa0); PK4(p0, 8, pa1); PK4(p1, 0, pa2); PK4(p1, 8, pa3);
#undef PK4
}
__device__ __forceinline__ void qkt(f32x16& p0, f32x16& p1, const bf16* Ks, const bf16x8* qr, int r32, int hi) {
  p0 = f32x16{}; p1 = f32x16{};
  bf16x8 c0 = *reinterpret_cast<const bf16x8*>((const char*)Ks + KSWZ(r32, (hi * 8) * 2)), c1 = *reinterpret_cast<const bf16x8*>((const char*)Ks + KSWZ(32 + r32, (hi * 8) * 2));
#pragma unroll
  for (int d0 = 0; d0 < 8; ++d0) {
    bf16x8 n0 = c0, n1 = c1;
    if (d0 < 7) { const int cb = ((d0 + 1) * 16 + hi * 8) * 2;
      n0 = *reinterpret_cast<const bf16x8*>((const char*)Ks + KSWZ(r32, cb)); n1 = *reinterpret_cast<const bf16x8*>((const char*)Ks + KSWZ(32 + r32, cb)); }
    p0 = __builtin_amdgcn_mfma_f32_32x32x16_bf16(c0, qr[d0], p0, 0, 0, 0);
    p1 = __builtin_amdgcn_mfma_f32_32x32x16_bf16(c1, qr[d0], p1, 0, 0, 0);
    c0 = n0; c1 = n1; }
}
template <int OFF> __device__ __forceinline__ bf16x8 k_read(const int addr) {
  bf16x8 r; asm volatile("ds_read_b128 %0, %1 offset:%2" : "=&v"(r) : "v"(addr), "i"(OFF) : "memory"); return r;
}
template <int D0> __device__ __forceinline__ void qkt_step(f32x16& p0, f32x16& p1, const int (&a)[4], const bf16x8* qr, bf16x8 c0, bf16x8 c1) {
  bf16x8 n0 = c0, n1 = c1;
  if constexpr (D0 < 7) { n0 = k_read<((D0 + 1) >> 2) * 128>(a[(D0 + 1) & 3]); n1 = k_read<((D0 + 1) >> 2) * 128 + 8192>(a[(D0 + 1) & 3]); asm volatile("s_waitcnt lgkmcnt(2)" ::: "memory"); }
  else asm volatile("s_waitcnt lgkmcnt(0)" ::: "memory");
  SBAR();
  p0 = __builtin_amdgcn_mfma_f32_32x32x16_bf16(c0, qr[D0], p0, 0, 0, 0);
  p1 = __builtin_amdgcn_mfma_f32_32x32x16_bf16(c1, qr[D0], p1, 0, 0, 0);
  if constexpr (D0 < 7) qkt_step<D0 + 1>(p0, p1, a, qr, n0, n1);
}
__device__ __forceinline__ void qkt_pipe(f32x16& p0, f32x16& p1, const int ka, const bf16x8* qr, const int r32, const int hi) {
  p0 = f32x16{}; p1 = f32x16{};
  int a[4];
#pragma unroll
  for (int q = 0; q < 4; ++q) a[q] = ka + r32 * 256 + ((q * 32 + hi * 16) ^ ((r32 & 7) << 4));
  const bf16x8 c0 = k_read<0>(a[0]), c1 = k_read<8192>(a[0]);
  qkt_step<0>(p0, p1, a, qr, c0, c1);
}
__device__ __forceinline__ int v_st(int k, int c) { const int kk = (k & ~0xC) | ((k & 4) << 1) | ((k & 8) >> 1); return ((kk >> 3) * 4 + (c >> 5)) * 512 + ((kk & 7) * 32 + (c & 31)) * 2; }
__device__ __forceinline__ int v_rd_base(int lane) { return ((lane & 3) << 3) | (((lane >> 2) & 3) << 6) | (((lane >> 4) & 1) << 5) | (((lane >> 5) & 1) << 8); }
constexpr int v_rd_off(int d0, int ks, int half) { return d0 * 512 + ks * 4096 + half * 2048; }
template <int OFF> __device__ __forceinline__ s16x4 tr_read(int vb) {
  s16x4 r; asm volatile("ds_read_b64_tr_b16 %0, %1 offset:%2" : "=&v"(r) : "v"(vb), "i"(OFF) : "memory"); return r;
}
template <int D0> __device__ __forceinline__ void pv_one(f32x16& od, int vb, bf16x8 pa0, bf16x8 pa1, bf16x8 pa2, bf16x8 pa3) {
  const s16x4 l0 = tr_read<v_rd_off(D0, 0, 0)>(vb), h0 = tr_read<v_rd_off(D0, 0, 1)>(vb), l1 = tr_read<v_rd_off(D0, 1, 0)>(vb), h1 = tr_read<v_rd_off(D0, 1, 1)>(vb);
  const s16x4 l2 = tr_read<v_rd_off(D0, 2, 0)>(vb), h2 = tr_read<v_rd_off(D0, 2, 1)>(vb), l3 = tr_read<v_rd_off(D0, 3, 0)>(vb), h3 = tr_read<v_rd_off(D0, 3, 1)>(vb);
  asm volatile("s_waitcnt lgkmcnt(0)" ::: "memory"); SBAR();
#define PK(L, H) (bf16x8){L[0], L[1], L[2], L[3], H[0], H[1], H[2], H[3]}
  od = __builtin_amdgcn_mfma_f32_32x32x16_bf16(pa0, PK(l0, h0), od, 0, 0, 0);
  od = __builtin_amdgcn_mfma_f32_32x32x16_bf16(pa1, PK(l1, h1), od, 0, 0, 0);
  od = __builtin_amdgcn_mfma_f32_32x32x16_bf16(pa2, PK(l2, h2), od, 0, 0, 0);
  od = __builtin_amdgcn_mfma_f32_32x32x16_bf16(pa3, PK(l3, h3), od, 0, 0, 0);
#undef PK
}
__device__ __forceinline__ void pv_d0(f32x16* o, int vb, bf16x8 pa0, bf16x8 pa1, bf16x8 pa2, bf16x8 pa3) {
  pv_one<0>(o[0], vb, pa0, pa1, pa2, pa3); pv_one<1>(o[1], vb, pa0, pa1, pa2, pa3); pv_one<2>(o[2], vb, pa0, pa1, pa2, pa3); pv_one<3>(o[3], vb, pa0, pa1, pa2, pa3);
}

template <int B> __device__ __forceinline__ void pv_rd8(s16x4 (&f)[8], const int vb) {
  constexpr int D0 = B & 3, HB = (B >> 2) * 16384;
  f[0] = tr_read<HB + v_rd_off(D0, 0, 0)>(vb); f[1] = tr_read<HB + v_rd_off(D0, 0, 1)>(vb); f[2] = tr_read<HB + v_rd_off(D0, 1, 0)>(vb); f[3] = tr_read<HB + v_rd_off(D0, 1, 1)>(vb);
  f[4] = tr_read<HB + v_rd_off(D0, 2, 0)>(vb); f[5] = tr_read<HB + v_rd_off(D0, 2, 1)>(vb); f[6] = tr_read<HB + v_rd_off(D0, 3, 0)>(vb); f[7] = tr_read<HB + v_rd_off(D0, 3, 1)>(vb);
}
__device__ __forceinline__ void pv_mma4(f32x16& od, const s16x4 (&f)[8], bf16x8 pa0, bf16x8 pa1, bf16x8 pa2, bf16x8 pa3) {
#define PK(L, H) (bf16x8){L[0], L[1], L[2], L[3], H[0], H[1], H[2], H[3]}
  od = __builtin_amdgcn_mfma_f32_32x32x16_bf16(pa0, PK(f[0], f[1]), od, 0, 0, 0);
  od = __builtin_amdgcn_mfma_f32_32x32x16_bf16(pa1, PK(f[2], f[3]), od, 0, 0, 0);
  od = __builtin_amdgcn_mfma_f32_32x32x16_bf16(pa2, PK(f[4], f[5]), od, 0, 0, 0);
  od = __builtin_amdgcn_mfma_f32_32x32x16_bf16(pa3, PK(f[6], f[7]), od, 0, 0, 0);
#undef PK
}
template <int B, int NB> __device__ __forceinline__ void pv_pipe_step(f32x16* o, s16x4 (&cur)[8], s16x4 (&nxt)[8], const int vb, bf16x8 pa0, bf16x8 pa1, bf16x8 pa2, bf16x8 pa3) {
  if constexpr (B + 1 < NB) { pv_rd8<B + 1>(nxt, vb); asm volatile("s_waitcnt lgkmcnt(8)" ::: "memory"); }
  else asm volatile("s_waitcnt lgkmcnt(0)" ::: "memory");
  SBAR();
  pv_mma4(o[B], cur, pa0, pa1, pa2, pa3);
  if constexpr (B + 1 < NB) pv_pipe_step<B + 1, NB>(o, nxt, cur, vb, pa0, pa1, pa2, pa3);
}
template <int NB> __device__ __forceinline__ void pv_pipe(f32x16* o, const int vb, bf16x8 pa0, bf16x8 pa1, bf16x8 pa2, bf16x8 pa3) {
  s16x4 fa[8], fb[8];
  pv_rd8<0>(fa, vb);
  pv_pipe_step<0, NB>(o, fa, fb, vb, pa0, pa1, pa2, pa3);
}

template <typename TQ, int LDQ, int LDK, int LDO, typename TO>
__device__ __forceinline__ void attn_dense_body(const TQ* __restrict__ Qb, const bf16* __restrict__ Kh, const bf16* __restrict__ Vh,
                                                TO* __restrict__ Ob, int seq, char* lds, const int tid_in) {
  using St = Stage<bf16>; using SQ = Stage<TQ>;
  const int tid = tid_in, wid = tid >> 6, lane = tid & 63, r32 = lane & 31, hi = lane >> 5;
  bf16* V_lds = (bf16*)lds; bf16* K_lds = (bf16*)(lds + 2 * SHM_V);
  float* ws = (float*)(lds + 2 * SHM_V + 2 * SHM_K) + wid * 64; float* li_l = ws; float* al_l = ws + 32;
  float m_reg = -1e30f, l_reg = 0; f32x16 o[4] = {}; bf16x8 qr[8];
  const TQ* Qw = Qb + ((wid * QBLK + r32) * LDQ + hi * 8);
#pragma unroll
  for (int d0 = 0; d0 < 8; ++d0) qr[d0] = SQ::tobf(SQ::ld8(Qw + d0 * 16));
  const int sr = tid >> 4, sc = (tid & 15) * 8, vst0 = v_st(sr, sc), vst1 = v_st(32 + sr, sc);
  const int vb0 = (int)(uintptr_t)V_lds + v_rd_base(lane);
  struct { typename St::T vs0, vs1, ks0, ks1; } sr_[SDEPTH];
#define SLOAD(i, k0) do { sr_[i].vs0 = St::ld8(Vh + (((k0) + sr) * LDK + sc)); sr_[i].vs1 = St::ld8(Vh + (((k0) + 32 + sr) * LDK + sc)); \
    sr_[i].ks0 = St::ld8(Kh + (((k0) + sr) * LDK + sc)); sr_[i].ks1 = St::ld8(Kh + (((k0) + 32 + sr) * LDK + sc)); } while (0)
#define SWRITE(b, i) do { *(bf16x8*)((char*)V_lds + (b) * SHM_V + vst0) = St::tobf(sr_[i].vs0);          \
    *(bf16x8*)((char*)V_lds + (b) * SHM_V + vst1) = St::tobf(sr_[i].vs1); int kc = sc * 2;               \
    *(bf16x8*)((char*)K_lds + (b) * SHM_K + KSWZ(sr, kc)) = St::tobf(sr_[i].ks0);                       \
    *(bf16x8*)((char*)K_lds + (b) * SHM_K + KSWZ(32 + sr, kc)) = St::tobf(sr_[i].ks1); } while (0)
#define SWAIT() do { if constexpr (SDEPTH == 2) asm volatile("s_waitcnt vmcnt(4)" ::: "memory"); else asm volatile("s_waitcnt vmcnt(0)" ::: "memory"); } while (0)
#define RESC(a) do { if (__any((a) < 1.f)) { if (hi == 0) al_l[r32] = (a); asm volatile("s_waitcnt lgkmcnt(0)" ::: "memory"); \
    for (int d = 0; d < 4; ++d) for (int r = 0; r < 16; ++r) o[d][r] *= al_l[crow(r, hi)]; } } while (0)
  f32x16 pA0, pA1, pB0, pB1; float mnA, mnB, alA, alB; bf16x8 pa0, pa1, pa2, pa3; const int NT = seq / KVBLK;
  constexpr int SE = 0, SO = SDEPTH - 1;
  SLOAD(SE, 0); asm volatile("s_waitcnt vmcnt(0)" ::: "memory"); SWRITE(0, SE); __syncthreads();
  qkt(pA0, pA1, K_lds, qr, r32, hi); partialSM(pA0, pA1, m_reg, mnA, alA);
  SLOAD(SO, KVBLK); if constexpr (SDEPTH == 2) { if (2 < NT) SLOAD(SE, 2 * KVBLK); }
  SWAIT(); SWRITE(1, SO); __syncthreads();
  for (int j = 1; j + 1 < NT; j += 2) {
    SBAR(); qkt(pB0, pB1, (bf16*)((char*)K_lds + SHM_K), qr, r32, hi);
    finishSM(pA0, pA1, alA, l_reg, pa0, pa1, pa2, pa3); SBAR();
    SLOAD(SO, (j + SDEPTH) * KVBLK); SBAR();
    pv_d0(o, vb0, pa0, pa1, pa2, pa3); partialSM(pB0, pB1, m_reg, mnB, alB);
    __syncthreads(); SWAIT(); SWRITE(0, SE);
    RESC(alB); __syncthreads();
    SBAR(); qkt(pA0, pA1, K_lds, qr, r32, hi);
    finishSM(pB0, pB1, alB, l_reg, pa0, pa1, pa2, pa3); SBAR();
    if (SDEPTH == 1 || j + 3 < NT) SLOAD(SE, (j + 1 + SDEPTH) * KVBLK); SBAR();
    pv_d0(o, vb0 + (int)SHM_V, pa0, pa1, pa2, pa3); partialSM(pA0, pA1, m_reg, mnA, alA);
    __syncthreads(); SWAIT(); SWRITE(1, SO);
    RESC(alA); __syncthreads();
  }
  SBAR(); qkt(pB0, pB1, (bf16*)((char*)K_lds + SHM_K), qr, r32, hi);
  finishSM(pA0, pA1, alA, l_reg, pa0, pa1, pa2, pa3); SBAR();
  pv_d0(o, vb0, pa0, pa1, pa2, pa3); partialSM(pB0, pB1, m_reg, mnB, alB);
  __syncthreads(); RESC(alB);
  finishSM(pB0, pB1, alB, l_reg, pa0, pa1, pa2, pa3); SBAR();
  pv_d0(o, vb0 + (int)SHM_V, pa0, pa1, pa2, pa3);
  if (hi == 0) li_l[r32] = l_reg; asm volatile("s_waitcnt lgkmcnt(0)" ::: "memory");
  float rli[16];
#pragma unroll
  for (int r = 0; r < 16; ++r) rli[r] = __builtin_amdgcn_rcpf(li_l[crow(r, hi)]);
  TO* Ow = Ob + (wid * QBLK) * LDO;
#pragma unroll
  for (int r = 0; r < 16; ++r) { int orow = crow(r, hi);
    for (int d0 = 0; d0 < 4; ++d0) { const float val = o[d0][r] * rli[r];
      if constexpr (sizeof(TO) == 4) Ow[orow * LDO + d0 * 32 + r32] = val;
      else Ow[orow * LDO + d0 * 32 + r32] = (TO)(cvtpk(val, val) & 0xffffu); } }
#undef SLOAD
#undef SWRITE
#undef SWAIT
#undef RESC
}

template <int WIN>
__device__ __forceinline__ void attn_banded_body(const bf16* __restrict__ Qp, const bf16* __restrict__ Kp, const bf16* __restrict__ Vp, const long rs, const int Lseq, const int P0,
                                                 const float m_init, const float l_init, bf16* __restrict__ Ob, const long os, float* __restrict__ Lp, const long ls, char* lds, const int tid) {
  const int wid = __builtin_amdgcn_readfirstlane(tid >> 6), lane = tid & 63, r32 = lane & 31, hi = lane >> 5;
  constexpr int BT = 32768;
  float* wsf = (float*)(lds + 2 * BT) + wid * 64; float* li_l = wsf; float* al_l = wsf + 32;
  float m_reg = m_init, l_reg = l_init; f32x16 o[4] = {}; bf16x8 qr[8];
  const bf16* Qw = Qp + (long)(P0 + wid * QBLK + r32) * rs + hi * 8;
#pragma unroll
  for (int d0 = 0; d0 < 8; ++d0) qr[d0] = *reinterpret_cast<const bf16x8*>(Qw + d0 * 16);
  const int irs = (int)rs;
  int ksrc[2], vsrc[2];
#pragma unroll
  for (int i = 0; i < 2; ++i) { const int c = 2 * wid + i, row = 4 * c + (lane >> 4), colB = (16 * (lane & 15)) ^ ((row & 7) << 4); ksrc[i] = row * irs + (colB >> 1);
      const int sub = 2 * c + (lane >> 5), kk = ((sub >> 2) << 3) | ((lane & 31) >> 2), k = (kk & ~0xC) | ((kk & 4) << 1) | ((kk & 8) >> 1), col = (sub & 3) * 32 + 8 * (lane & 3); vsrc[i] = k * irs + col; }
  using LP = __attribute__((address_space(3))) unsigned*;
#define BB_DMA(buf, tb) do { const bf16* _kb = Kp + (long)(tb) * rs; const bf16* _vb = Vp + (long)(tb) * rs; char* _l = lds + (buf) * BT; \
    _Pragma("unroll") for (int _i = 0; _i < 2; ++_i) { __builtin_amdgcn_global_load_lds((const unsigned*)(_kb + ksrc[_i]), (LP)(_l + (2 * wid + _i) * 1024), 16, 0, 0); \
                                                       __builtin_amdgcn_global_load_lds((const unsigned*)(_vb + vsrc[_i]), (LP)(_l + 16384 + (2 * wid + _i) * 1024), 16, 0, 0); } } while (0)
  constexpr int NT = (256 + 2 * WIN) / 64, NTW = (2 * WIN + 32 + 63) / 64;
  const int klo = wid >> 1, qpos = P0 + wid * QBLK + r32;
  int kf = 0; while (P0 - WIN + 64 * kf < 0) ++kf;
  int kl = NT - 1; while (P0 - WIN + 64 * kl >= Lseq) --kl;
  BB_DMA(kf & 1, P0 - WIN + 64 * kf);
  for (int k = kf; k <= kl; ++k) {
    const int tb = P0 - WIN + 64 * k;
    asm volatile("s_waitcnt vmcnt(0)" ::: "memory");
    __builtin_amdgcn_s_barrier();
    asm volatile("" ::: "memory");
    if (k < kl) BB_DMA((k + 1) & 1, tb + 64);
    char* tbuf = lds + (k & 1) * BT;
    if (k >= klo && k < klo + NTW) {
      f32x16 p0, p1; float mn, al; bf16x8 pa0, pa1, pa2, pa3;
      qkt_pipe(p0, p1, (int)(uintptr_t)tbuf, qr, r32, hi);
      if (k == klo || k == klo + NTW - 1) {
#pragma unroll
        for (int r = 0; r < 16; ++r) { const int d = qpos - (tb + crow(r, hi));
          if (d > WIN || d < -WIN) p0[r] = -1e30f;
          if (d - 32 > WIN || d - 32 < -WIN) p1[r] = -1e30f; }
      }
      partialSM(p0, p1, m_reg, mn, al);
      if (__any(al < 1.f)) { if (hi == 0) al_l[r32] = al; asm volatile("s_waitcnt lgkmcnt(0)" ::: "memory");
#pragma unroll
        for (int d = 0; d < 4; ++d)
#pragma unroll
          for (int r = 0; r < 16; ++r) o[d][r] *= al_l[crow(r, hi)]; }
      finishSM(p0, p1, al, l_reg, pa0, pa1, pa2, pa3); SBAR();
      pv_pipe<4>(o, (int)(uintptr_t)(tbuf + 16384) + v_rd_base(lane), pa0, pa1, pa2, pa3);
    }
  }
#undef BB_DMA
  if (hi == 0) li_l[r32] = l_reg; asm volatile("s_waitcnt lgkmcnt(0)" ::: "memory");
  float rli[16];
#pragma unroll
  for (int r = 0; r < 16; ++r) rli[r] = __builtin_amdgcn_rcpf(li_l[crow(r, hi)]);
  bf16* Ow = Ob + (long)(P0 + wid * QBLK) * os;
#pragma unroll
  for (int r = 0; r < 16; ++r) { const int orow = crow(r, hi);
#pragma unroll
    for (int d0 = 0; d0 < 4; ++d0) { const float val = o[d0][r] * rli[r]; ((__attribute__((address_space(1))) bf16*)Ow)[(long)orow * os + d0 * 32 + r32] = (bf16)(cvtpk(val, val) & 0xffffu); } }
  if (Lp != nullptr && hi == 0) Lp[(long)(P0 + wid * QBLK + r32) * ls] = m_reg * SCALE + __logf(l_reg);
}

constexpr int WB_TILE = 49152, WB_WS = 2 * WB_TILE;
template <int LDQ, int LDK, int LDO, int NVH, typename TO, bool COMBINE = false, int LDC = 0>
__device__ __forceinline__ void attn_wide_body(const bf16* __restrict__ Qb, const bf16* __restrict__ Kh, const bf16* __restrict__ Vh, TO* __restrict__ Ob, const int seq, char* lds, const int tid,
                                               const float lam = 0.f, const float gsc = 0.f, const float* __restrict__ gain = nullptr, bf16* __restrict__ Cb = nullptr) {
  const int wid = __builtin_amdgcn_readfirstlane(tid >> 6), lane = tid & 63, r32 = lane & 31, hi = lane >> 5;
  float* wsf = (float*)(lds + WB_WS) + wid * 64; float* li_l = wsf; float* al_l = wsf + 32;
  float m_reg = -1e30f, l_reg = 0; f32x16 o[4 * NVH] = {}; bf16x8 qr[8];
  { const bf16* Qw = Qb + ((wid * QBLK + r32) * LDQ + hi * 8);
#pragma unroll
    for (int d0 = 0; d0 < 8; ++d0) qr[d0] = *reinterpret_cast<const bf16x8*>(Qw + d0 * 16); }
  constexpr int NVP = 2 * NVH;
  int ksrc[2], vsrc[NVP];
#pragma unroll
  for (int i = 0; i < 2; ++i) { const int c = 2 * wid + i, row = 4 * c + (lane >> 4), colB = (16 * (lane & 15)) ^ ((row & 7) << 4); ksrc[i] = row * LDK + (colB >> 1); }
#pragma unroll
  for (int i = 0; i < NVP; ++i) { const int pc = wid * NVP + i, hf = pc >> 4, c = pc & 15, sub = 2 * c + (lane >> 5), kk = ((sub >> 2) << 3) | ((lane & 31) >> 2);
      const int k = (kk & ~0xC) | ((kk & 4) << 1) | ((kk & 8) >> 1), col = (sub & 3) * 32 + 8 * (lane & 3); vsrc[i] = k * LDK + hf * 128 + col; }
  using LP = __attribute__((address_space(3))) unsigned*;
#define WB_DMA(buf, key0) do { const bf16* _kb = Kh + (key0) * LDK; const bf16* _vb = Vh + (key0) * LDK; char* _l = lds + (buf) * WB_TILE; \
    _Pragma("unroll") for (int _i = 0; _i < 2; ++_i) __builtin_amdgcn_global_load_lds((const unsigned*)(_kb + ksrc[_i]), (LP)(_l + (2 * wid + _i) * 1024), 16, 0, 0); \
    _Pragma("unroll") for (int _i = 0; _i < NVP; ++_i) __builtin_amdgcn_global_load_lds((const unsigned*)(_vb + vsrc[_i]), (LP)(_l + 16384 + (wid * NVP + _i) * 1024), 16, 0, 0); } while (0)
  const int NT = seq / KVBLK;
  WB_DMA(0, 0);
  for (int j = 0; j < NT; ++j) {
    asm volatile("s_waitcnt vmcnt(0)" ::: "memory");
    __builtin_amdgcn_s_barrier();
    asm volatile("" ::: "memory");
    if (j + 1 < NT) WB_DMA((j + 1) & 1, (j + 1) * KVBLK);
    char* tb = lds + (j & 1) * WB_TILE;
    f32x16 p0, p1; float mn, al; bf16x8 pa0, pa1, pa2, pa3;
    qkt_pipe(p0, p1, (int)(uintptr_t)tb, qr, r32, hi);
    partialSM(p0, p1, m_reg, mn, al);
    if (__any(al < 1.f)) { if (hi == 0) al_l[r32] = al; asm volatile("s_waitcnt lgkmcnt(0)" ::: "memory");
#pragma unroll
      for (int d = 0; d < 4 * NVH; ++d)
#pragma unroll
        for (int r = 0; r < 16; ++r) o[d][r] *= al_l[crow(r, hi)]; }
    finishSM(p0, p1, al, l_reg, pa0, pa1, pa2, pa3); SBAR();
    const int vb0 = (int)(uintptr_t)(tb + 16384) + v_rd_base(lane);
    pv_pipe<4 * NVH>(o, vb0, pa0, pa1, pa2, pa3);
  }
#undef WB_DMA
  int te = tid; asm volatile("" : "+v"(te));
  const int wid_e = __builtin_amdgcn_readfirstlane(te >> 6), r32_e = te & 31, hi_e = (te >> 5) & 1;
  float* li_e = (float*)(lds + WB_WS) + wid_e * 64;
  if (hi_e == 0) li_e[r32_e] = l_reg; asm volatile("s_waitcnt lgkmcnt(0)" ::: "memory");
  float rli[16];
#pragma unroll
  for (int r = 0; r < 16; ++r) rli[r] = __builtin_amdgcn_rcpf(li_e[crow(r, hi_e)]);
  TO* Ow = Ob + (wid_e * QBLK) * LDO;
  if constexpr (!COMBINE) {
#pragma unroll
    for (int r = 0; r < 16; ++r) { const int orow = crow(r, hi_e);
#pragma unroll
      for (int d0 = 0; d0 < 4 * NVH; ++d0) { const float val = o[d0][r] * rli[r];
        if constexpr (sizeof(TO) == 4) ((__attribute__((address_space(1))) TO*)Ow)[orow * LDO + d0 * 32 + r32_e] = val; else ((__attribute__((address_space(1))) TO*)Ow)[orow * LDO + d0 * 32 + r32_e] = (TO)(cvtpk(val, val) & 0xffffu); } }
  } else {
    static_assert(sizeof(TO) == 4 && NVH == 2, "combine: f32 first-map tile, 256-wide rows");
    float gn[8];
    { const float* g2 = gain; asm volatile("" : "+s"(g2));
#pragma unroll
      for (int d0 = 0; d0 < 8; ++d0) gn[d0] = g2[d0 * 32 + r32_e] * gsc; }
    bf16* Cw; { bf16* c2 = Cb; asm volatile("" : "+s"(c2)); Cw = c2 + (wid_e * QBLK) * LDC; }
    { TO* o2 = Ob; asm volatile("" : "+s"(o2)); Ow = o2 + (wid_e * QBLK) * LDO; }
#pragma unroll
    for (int r = 0; r < 16; ++r) { const int orow = crow(r, hi_e);
      float ss = 0.f;
#pragma unroll
      for (int d0 = 0; d0 < 8; ++d0) { const float o1 = __hip_atomic_load((const __attribute__((address_space(1))) float*)Ow + orow * LDO + d0 * 32 + r32_e, __ATOMIC_RELAXED, __HIP_MEMORY_SCOPE_AGENT);
        const float av = o1 - lam * (o[d0][r] * rli[r]); o[d0][r] = av; ss = fmaf(av, av, ss); }
#define WB_SWZ(v, m) __int_as_float(__builtin_amdgcn_ds_swizzle(__float_as_int(v), ((m) << 10) | 0x1F))
      ss += WB_SWZ(ss, 1); ss += WB_SWZ(ss, 2); ss += WB_SWZ(ss, 4); ss += WB_SWZ(ss, 8); ss += WB_SWZ(ss, 16);
#undef WB_SWZ
      const float sc = 1.0f / sqrtf(ss * (1.0f / 256.0f) + 1e-6f);
#pragma unroll
      for (int d0 = 0; d0 < 8; ++d0) { const float val = o[d0][r] * sc * gn[d0]; ((__attribute__((address_space(1))) bf16*)Cw)[orow * LDC + d0 * 32 + r32_e] = (bf16)(cvtpk(val, val) & 0xffffu); }
      asm volatile("" ::: "memory"); }
  }
}
}
typedef unsigned short bf16_t;
typedef unsigned u32x4v __attribute__((ext_vector_type(4)));
#define LDSA __attribute__((address_space(3)))
#define GLB __attribute__((address_space(1)))
constexpr size_t al256(size_t x) { return (x + 255) / 256 * 256; }
constexpr size_t WS_CTL  = 0;
constexpr size_t CTL_BYTES = 65536;
constexpr size_t WS_XB   = WS_CTL + CTL_BYTES;
constexpr size_t WS_WAB  = WS_XB + (size_t)SEQ * DM * 2;
constexpr size_t WS_WOAB = WS_WAB + (size_t)12288 * 4096 * 2;
constexpr size_t WS_WCD  = WS_WOAB + (size_t)4096 * 3072 * 2;
constexpr size_t WS_WOCD = WS_WCD + (size_t)9216 * 4096 * 2;
constexpr size_t WS_WQ   = WS_WOCD + (size_t)4096 * 4096 * 2;
constexpr size_t WS_UB   = WS_WQ + (size_t)2 * 2048 * 4096 * 2;
constexpr size_t WS_VB   = WS_UB + (size_t)2 * 16384 * 3072;
constexpr size_t WS_SU   = WS_VB + (size_t)2 * 16384 * 3072;
constexpr size_t WS_SV   = WS_SU + (size_t)2 * 16384 * 4;
constexpr size_t WS_H    = WS_SV + (size_t)2 * 16384 * 4;
constexpr size_t WS_Y    = WS_H;
constexpr size_t WS_PQ   = WS_H + (size_t)SEQ * 4096 * 4;
constexpr size_t WS_OC   = WS_H + (size_t)SEQ * 12288 * 4;
constexpr size_t WS_AB   = WS_OC + (size_t)2 * SEQ * 2048 * 4;
constexpr size_t WS_X1   = WS_AB + (size_t)SEQ * 4096 * 2;
constexpr size_t WS_X1B  = WS_X1 + (size_t)SEQ * 4096 * 4;
constexpr size_t WS_X2   = WS_X1B + (size_t)SEQ * 4096 * 2;
constexpr size_t WS_X2B  = WS_X2 + (size_t)SEQ * 4096 * 4;
constexpr size_t WS_EIDX = WS_X2B + (size_t)SEQ * 4096 * 2;
constexpr size_t WS_GATE = WS_EIDX + (size_t)SEQ * 128 * 4;
constexpr size_t WS_HB   = WS_GATE + (size_t)SEQ * 128 * 4;
constexpr size_t WS_KEYB = WS_HB + (size_t)SEQ * 12288 * 2;
constexpr size_t WS_CS0  = WS_KEYB + (size_t)2 * 8 * 2 * 128 * 128 * 2;
constexpr size_t WS_CSA  = WS_CS0 + (size_t)SEQ * 16 * 8;
constexpr size_t WS_END  = WS_CSA + (size_t)128 * 32 * 8;
static_assert(WS_END <= (size_t)2147483648ull, "workspace");

constexpr int LDS_BYTES = 155648;
constexpr int LDS_MISC = 139264;

struct MK { const float* in[21]; float* out; unsigned char* ws; int ph_lo, ph_hi; };

namespace pg8 {
struct EpiF32R {
    static constexpr bool PERM = false, AFTER_DRAIN = false;
    float* C; int ldc; const float* R; float ralpha;
    __device__ __forceinline__ void operator()(const f32x4 (&acc)[2][2][4][2], const Unit& u, int wr, int wc, int fr, int fq) const {
        const int row0 = u.pm * BM + wr * 64 + fr, col0 = u.pn * BM + wc * 32 + 4 * fq;
#pragma unroll
        for (int ai = 0; ai < 2; ++ai)
#pragma unroll
            for (int mp = 0; mp < 2; ++mp) {
                f32x4 r[2][2][2];
                if (R) {
#pragma unroll
                    for (int mm = 0; mm < 2; ++mm) { const size_t off = (size_t)(row0 + ai * HALF + (2 * mp + mm) * 16) * ldc + col0;
#pragma unroll
                        for (int bj = 0; bj < 2; ++bj)
#pragma unroll
                            for (int n = 0; n < 2; ++n) r[mm][bj][n] = *(const GLB f32x4*)(R + off + bj * HALF + n * 16); }
                }
#pragma unroll
                for (int mm = 0; mm < 2; ++mm) { const int m = 2 * mp + mm; const size_t off = (size_t)(row0 + ai * HALF + m * 16) * ldc + col0;
#pragma unroll
                    for (int bj = 0; bj < 2; ++bj)
#pragma unroll
                        for (int n = 0; n < 2; ++n) { f32x4 v = acc[ai][bj][m][n];
                            if (R) v += r[mm][bj][n] * ralpha;
                            *(GLB f32x4*)(C + off + bj * HALF + n * 16) = v; } }
                asm volatile("" ::: "memory");
            }
    }
};
struct EpiBf16P {
    static constexpr bool PERM = true, AFTER_DRAIN = false;
    bf16_t* O; int ldc;
    __device__ __forceinline__ void operator()(const f32x4 (&acc)[2][2][4][2], const Unit& u, int wr, int wc, int fr, int fq) const {
        const int row0 = u.pm * BM + wr * 64 + fr, col0 = u.pn * BM + wc * 32 + 8 * fq;
#pragma unroll
        for (int ai = 0; ai < 2; ++ai)
#pragma unroll
            for (int m = 0; m < 4; ++m) { bf16_t* rowp = O + (size_t)(row0 + ai * HALF + m * 16) * ldc + col0;
#pragma unroll
                for (int bj = 0; bj < 2; ++bj) { const f32x4 v0 = acc[ai][bj][m][0], v1 = acc[ai][bj][m][1];
                    u32x4 w; w.x = cvt_pk_bf16(v0[0], v0[1]); w.y = cvt_pk_bf16(v0[2], v0[3]); w.z = cvt_pk_bf16(v1[0], v1[1]); w.w = cvt_pk_bf16(v1[2], v1[3]);
                    *(GLB u32x4*)(rowp + bj * HALF) = w; } }
    }
};

template <int LAYER> struct EpiProj {
    static constexpr bool PERM = true, AFTER_DRAIN = false;
    bf16_t* O; int ldc; const float* cs0; const float* csa; const float* gq; const float* gk; PG8_LAS float* xch;
    __device__ __forceinline__ void operator()(const f32x4 (&acc)[2][2][4][2], const Unit& u, int wr, int wc, int fr, int fq) const {
        const int row0 = u.pm * BM + wr * 64 + fr, col0 = u.pn * BM + wc * 32 + 8 * fq;
        const int pn = u.pn;
        const bool prope = LAYER == 0 ? (pn < 10 || (pn >= 12 && pn < 36)) : (pn < 16);
        const bool dnorm = LAYER == 1 && pn >= 24 && pn < 34;
        float rs[2][4][2];
        float gn[8];
        if (dnorm) {
            const int lrow = fr;
#pragma unroll
            for (int ai = 0; ai < 2; ++ai)
#pragma unroll
                for (int m = 0; m < 4; ++m)
#pragma unroll
                    for (int bj = 0; bj < 2; ++bj) { const f32x4 a = acc[ai][bj][m][0], b = acc[ai][bj][m][1];
                        float q = (a[0] * a[0] + a[1] * a[1]) + (a[2] * a[2] + a[3] * a[3]) + (b[0] * b[0] + b[1] * b[1]) + (b[2] * b[2] + b[3] * b[3]);
                        q += __shfl_xor(q, 16); q += __shfl_xor(q, 32);
                        if (fq == 0) xch[((wr * 128 + (ai * 4 + m) * 16 + lrow) * 2 + bj) * 4 + wc] = q; }
            asm volatile("s_waitcnt lgkmcnt(0)" ::: "memory"); __builtin_amdgcn_s_barrier(); asm volatile("" ::: "memory");
#pragma unroll
            for (int ai = 0; ai < 2; ++ai)
#pragma unroll
                for (int m = 0; m < 4; ++m)
#pragma unroll
                    for (int bj = 0; bj < 2; ++bj) { const f32x4 p = *(const PG8_LAS f32x4*)(xch + ((wr * 128 + (ai * 4 + m) * 16 + lrow) * 2 + bj) * 4);
                        rs[ai][m][bj] = 1.0f / sqrtf(((p[0] + p[1]) + (p[2] + p[3])) * (1.0f / 128.0f) + 1e-6f); }
            const float* g = pn < 32 ? gq : gk;
#pragma unroll
            for (int e = 0; e < 8; ++e) { const int p = wc * 32 + 8 * fq + e; const int orig = (p & 64) + ((p & 63) >> 1) + 32 * (p & 1); gn[e] = g[orig]; }
        }
        const bool rot = dnorm || (prope && wc == 0);
#pragma unroll
        for (int ai = 0; ai < 2; ++ai) {
            f32x4 cs[4][2];
            if (rot) {
#pragma unroll
                for (int m = 0; m < 4; ++m) { const int row = row0 + ai * HALF + m * 16;
                    const float* cp = dnorm ? csa + ((size_t)(wc < 2 ? (row >> 6) : (row & 63)) * 32 + 16 * (wc & 1) + 4 * fq) * 2 : cs0 + ((size_t)row * 16 + 4 * fq) * 2;
                    cs[m][0] = *(const GLB f32x4*)cp; cs[m][1] = *(const GLB f32x4*)(cp + 4); }
            }
#pragma unroll
            for (int m = 0; m < 4; ++m) {
                const int row = row0 + ai * HALF + m * 16;
                bf16_t* rowp = O + (size_t)row * ldc + col0;
                f32x4 c0 = (f32x4){1.f, 0.f, 1.f, 0.f}, c1 = c0;
                if (rot) { c0 = cs[m][0]; c1 = cs[m][1]; }
#pragma unroll
                for (int bj = 0; bj < 2; ++bj) { f32x4 v0 = acc[ai][bj][m][0], v1 = acc[ai][bj][m][1];
                    if (dnorm) { const float r = rs[ai][m][bj];
                        v0[0] *= r * gn[0]; v0[1] *= r * gn[1]; v0[2] *= r * gn[2]; v0[3] *= r * gn[3]; v1[0] *= r * gn[4]; v1[1] *= r * gn[5]; v1[2] *= r * gn[6]; v1[3] *= r * gn[7]; }
                    if (rot) {
                        const float a0 = v0[0] * c0[0] - v0[1] * c0[1], b0 = v0[1] * c0[0] + v0[0] * c0[1];
                        const float a1 = v0[2] * c0[2] - v0[3] * c0[3], b1 = v0[3] * c0[2] + v0[2] * c0[3];
                        const float a2 = v1[0] * c1[0] - v1[1] * c1[1], b2 = v1[1] * c1[0] + v1[0] * c1[1];
                        const float a3 = v1[2] * c1[2] - v1[3] * c1[3], b3 = v1[3] * c1[2] + v1[2] * c1[3];
                        v0 = (f32x4){a0, b0, a1, b1}; v1 = (f32x4){a2, b2, a3, b3}; }
                    u32x4 w; w.x = cvt_pk_bf16(v0[0], v0[1]); w.y = cvt_pk_bf16(v0[2], v0[3]); w.z = cvt_pk_bf16(v1[0], v1[1]); w.w = cvt_pk_bf16(v1[2], v1[3]);
                    *(GLB u32x4*)(rowp + bj * HALF) = w; }
            }
            asm volatile("" ::: "memory");
        }
    }
};
}

__device__ __forceinline__ float bf_lo(unsigned w) { return __uint_as_float(w << 16); }
__device__ __forceinline__ float bf_hi(unsigned w) { return __uint_as_float(w & 0xffff0000u); }
__device__ __forceinline__ unsigned cvtpk_bf16(float lo, float hi) { unsigned r; asm volatile("v_cvt_pk_bf16_f32 %0, %1, %2" : "=v"(r) : "v"(lo), "v"(hi)); return r; }

__device__ __forceinline__ void cvt_rows_bf16(const float* __restrict__ src, bf16_t* __restrict__ dst, size_t n8, int bid, int nb, int tid, int nthr) {
    const size_t stride = (size_t)nb * nthr;
    for (size_t i = (size_t)bid * nthr + tid; i < n8; i += 4 * stride) {
        float4 a[4], b[4];
#pragma unroll
        for (int u = 0; u < 4; ++u) { const size_t j = i + u * stride; if (j < n8) { a[u] = *(const float4*)(src + j * 8); b[u] = *(const float4*)(src + j * 8 + 4); } }
#pragma unroll
        for (int u = 0; u < 4; ++u) { const size_t j = i + u * stride; if (j < n8) {
            u32x4v w; w.x = cvtpk_bf16(a[u].x, a[u].y); w.y = cvtpk_bf16(a[u].z, a[u].w); w.z = cvtpk_bf16(b[u].x, b[u].y); w.w = cvtpk_bf16(b[u].z, b[u].w);
            *(u32x4v*)(dst + j * 8) = w; } }
    }
}
template <class PM>
__device__ __forceinline__ void transpose_cvt(const float* __restrict__ W, bf16_t* __restrict__ Wt, int K, int N, LDSA float* tile0, int bid, int nb, PM pm, const int tid) {
    const int lane = tid & 63, wv = tid >> 6;
    LDSA float* tile = tile0 + wv * 4352;
    const int ntk = K / 64, ntn = N / 64;
    for (int t = bid * 8 + wv; t < ntk * ntn; t += nb * 8) {
        const int k0 = (t % ntk) * 64, n0 = (t / ntk) * 64;
        const int c = (lane & 15) * 4, r0 = lane >> 4;
        float4 v[16];
#pragma unroll
        for (int i = 0; i < 16; ++i) v[i] = *(const float4*)(W + (size_t)(k0 + r0 + 4 * i) * N + n0 + c);
#pragma unroll
        for (int i = 0; i < 16; ++i) { const int r = r0 + 4 * i; tile[r * 65 + c] = v[i].x; tile[r * 65 + c + 1] = v[i].y; tile[r * 65 + c + 2] = v[i].z; tile[r * 65 + c + 3] = v[i].w; }
        asm volatile("s_waitcnt lgkmcnt(0)" ::: "memory");
        const int mode = pm(n0);
#pragma unroll
        for (int h = 0; h < 8; ++h) {
            const int n = (lane >> 3) + 8 * h, kc = (lane & 7) * 8;
            int src = n;
            if (mode == 1) { if (n < 32) src = (n >> 1) + 16 * (n & 1); }
            else if (mode == 2) src = (n >> 1) + 32 * (n & 1);
            float f[8];
#pragma unroll
            for (int j = 0; j < 8; ++j) f[j] = tile[(kc + j) * 65 + src];
            u32x4v w; w.x = cvtpk_bf16(f[0], f[1]); w.y = cvtpk_bf16(f[2], f[3]); w.z = cvtpk_bf16(f[4], f[5]); w.w = cvtpk_bf16(f[6], f[7]);
            *(u32x4v*)(Wt + (size_t)(n0 + n) * K + k0 + kc) = w;
        }
        asm volatile("s_waitcnt lgkmcnt(0)" ::: "memory");
    }
}
struct PermNone { __device__ __forceinline__ int operator()(int) const { return 0; } };
struct PermAB { __device__ __forceinline__ int operator()(int n0) const { const bool rope = n0 < 2560 || (n0 >= 3072 && n0 < 9216); return (rope && (n0 & 127) == 0) ? 1 : 0; } };
struct PermCD { __device__ __forceinline__ int operator()(int n0) const { if (n0 < 4096) return (n0 & 127) == 0 ? 1 : 0; if (n0 >= 6144 && n0 < 8704) return 2; return 0; } };
__device__ __forceinline__ void rope_tables(float* __restrict__ cs0, float* __restrict__ csa, const int bid, const int G, const int tid) {
    for (int i = bid * 512 + tid; i < SEQ * 16; i += G * 512) { float s, c; sincos_rev((double)(i >> 4) * REV_P[i & 15], s, c); *(float2*)(cs0 + (size_t)i * 2) = make_float2(c, s); }
    for (int i = bid * 512 + tid; i < 128 * 32; i += G * 512) { float s, c; sincos_rev((double)(i >> 5) * REV_A[i & 31], s, c); *(float2*)(csa + (size_t)i * 2) = make_float2(c, s); }
}


typedef unsigned v6u_t __attribute__((ext_vector_type(6)));
typedef float f4v_t __attribute__((ext_vector_type(4)));
typedef unsigned v16u_t __attribute__((ext_vector_type(16)));
typedef float v16f_t __attribute__((ext_vector_type(16)));
typedef float v32f_t __attribute__((ext_vector_type(32)));
typedef __bf16 v32b_t __attribute__((ext_vector_type(32)));
constexpr int ROWB = 3072;
constexpr int XT_STRIDE = 68;
constexpr int XT_BYTES = 64 * XT_STRIDE * 4;
__device__ __forceinline__ void table_fp6(const float* __restrict__ src, unsigned char* __restrict__ dst, float* __restrict__ inv, const int rows, LDSA float* xt0, const int bid, const int G, const int tid) {
    const int lane = tid & 63, wv = tid >> 6;
    LDSA float* xt = xt0 + wv * (XT_BYTES / 4);
    for (int r = bid * 8 + wv; r < rows; r += G * 8) {
        float4 v[16]; float am = 0.f;
#pragma unroll
        for (int j = 0; j < 16; ++j) { v[j] = *(const float4*)(src + (size_t)r * DM + j * 256 + lane * 4); am = fmaxf(am, fmaxf(fmaxf(fabsf(v[j].x), fabsf(v[j].y)), fmaxf(fabsf(v[j].z), fabsf(v[j].w)))); }
        am = wave_max(am);
        const float sc = am > 0.f ? 7.0f / am : 1.0f;
#pragma unroll
        for (int j = 0; j < 16; ++j) *(LDSA f4v_t*)(xt + (4 * j + (lane >> 4)) * XT_STRIDE + 4 * (lane & 15)) = (f4v_t){v[j].x * sc, v[j].y * sc, v[j].z * sc, v[j].w * sc};
        asm volatile("s_waitcnt lgkmcnt(0)" ::: "memory");
        v16f_t f0, f1, f2, f3;
#pragma unroll
        for (int k = 0; k < 8; ++k) { const f4v_t a = *(const LDSA f4v_t*)(xt + lane * XT_STRIDE + 4 * k), c = *(const LDSA f4v_t*)(xt + lane * XT_STRIDE + 32 + 4 * k);
            f0[2 * k] = a[0]; f1[2 * k] = a[1]; f0[2 * k + 1] = a[2]; f1[2 * k + 1] = a[3];
            f2[2 * k] = c[0]; f3[2 * k] = c[1]; f2[2 * k + 1] = c[2]; f3[2 * k + 1] = c[3]; }
        asm volatile("s_waitcnt lgkmcnt(0)" ::: "memory");
        const v6u_t w0 = __builtin_amdgcn_cvt_scalef32_2xpk16_fp6_f32(f0, f1, 1.0f), w1 = __builtin_amdgcn_cvt_scalef32_2xpk16_fp6_f32(f2, f3, 1.0f);
        unsigned char* dp = dst + (size_t)r * ROWB + lane * 48;
        u32x4v s0, s1, s2; s0.x = w0[0]; s0.y = w0[1]; s0.z = w0[2]; s0.w = w0[3]; s1.x = w0[4]; s1.y = w0[5]; s1.z = w1[0]; s1.w = w1[1]; s2.x = w1[2]; s2.y = w1[3]; s2.z = w1[4]; s2.w = w1[5];
        *(u32x4v*)dp = s0; *(u32x4v*)(dp + 16) = s1; *(u32x4v*)(dp + 32) = s2;
        if (lane == 0) inv[r] = am > 0.f ? am * (1.0f / 7.0f) : 1.0f;
    }
}

typedef __bf16 bf2_t __attribute__((ext_vector_type(2)));
__device__ __forceinline__ float dot2_bf16(unsigned a, unsigned b, float c) { return __builtin_amdgcn_fdot2_f32_bf16(__builtin_bit_cast(bf2_t, a), __builtin_bit_cast(bf2_t, b), c, false); }
__device__ __forceinline__ float gelu_tanh_f(float x) {
    const float z = 0.7978845608028654f * (x + 0.044715f * x * x * x);
    const float e = __expf(2.0f * z);
    return 0.5f * x * (2.0f - 2.0f / (e + 1.0f));
}
__device__ __forceinline__ int pick_i(int a0, int a1, int k) { return k < 64 ? __builtin_amdgcn_readlane(a0, k) : __builtin_amdgcn_readlane(a1, k - 64); }
__device__ __forceinline__ float pick_f(float a0, float a1, int k) { return __int_as_float(pick_i(__float_as_int(a0), __float_as_int(a1), k)); }
__device__ __forceinline__ float dpp_shr(float v, const int ctrl_sel) {
    const int iv = __builtin_bit_cast(int, v); int r;
    switch (ctrl_sel) { case 1: r = __builtin_amdgcn_update_dpp(0, iv, 0x111, 0xf, 0xf, true); break; case 2: r = __builtin_amdgcn_update_dpp(0, iv, 0x112, 0xf, 0xf, true); break;
                        case 4: r = __builtin_amdgcn_update_dpp(0, iv, 0x114, 0xf, 0xf, true); break; default: r = __builtin_amdgcn_update_dpp(0, iv, 0x118, 0xf, 0xf, true); break; }
    return __builtin_bit_cast(float, r);
}
__device__ __forceinline__ float wave_sum_u(float v) {
    v += dpp_shr(v, 1); v += dpp_shr(v, 2); v += dpp_shr(v, 4); v += dpp_shr(v, 8);
    v += __builtin_bit_cast(float, __builtin_amdgcn_update_dpp(0, __builtin_bit_cast(int, v), 0x142, 0xa, 0xf, false));
    v += __builtin_bit_cast(float, __builtin_amdgcn_update_dpp(0, __builtin_bit_cast(int, v), 0x143, 0xc, 0xf, false));
    return __builtin_bit_cast(float, __builtin_amdgcn_readlane(__builtin_bit_cast(int, v), 63));
}
typedef const __attribute__((address_space(1))) u32x4v* gu32x4p;
#define PE_LOADROW(dst, base, e) do { const unsigned char* _p = (base) + (size_t)(e) * ROWB + lane * 48; dst[0] = *(gu32x4p)_p; dst[1] = *(gu32x4p)(_p + 16); dst[2] = *(gu32x4p)(_p + 32); } while (0)
__device__ __forceinline__ float pe_dot(const u32x4v (&r)[3], const u32x4v (&x)[8]) {
    float d0 = 0.f, d1 = 0.f, d2 = 0.f, d3 = 0.f;
    { const v6u_t g = {r[0].x, r[0].y, r[0].z, r[0].w, r[1].x, r[1].y};
      const v16u_t z = __builtin_bit_cast(v16u_t, __builtin_amdgcn_cvt_scalef32_pk32_bf16_fp6(g, 1.0f));
#pragma unroll
      for (int k = 0; k < 4; ++k) { const unsigned xa = x[k].x, xb = x[k].y, xc = x[k].z, xd = x[k].w; const unsigned za = z[4 * k], zb = z[4 * k + 1], zc = z[4 * k + 2], zd = z[4 * k + 3];
          d0 = dot2_bf16(za, xa, d0); d1 = dot2_bf16(zb, xb, d1); d2 = dot2_bf16(zc, xc, d2); d3 = dot2_bf16(zd, xd, d3); }
    }
    { const v6u_t g = {r[1].z, r[1].w, r[2].x, r[2].y, r[2].z, r[2].w};
      const v16u_t z = __builtin_bit_cast(v16u_t, __builtin_amdgcn_cvt_scalef32_pk32_bf16_fp6(g, 1.0f));
#pragma unroll
      for (int k = 0; k < 4; ++k) { const unsigned xa = x[4 + k].x, xb = x[4 + k].y, xc = x[4 + k].z, xd = x[4 + k].w; const unsigned za = z[4 * k], zb = z[4 * k + 1], zc = z[4 * k + 2], zd = z[4 * k + 3];
          d0 = dot2_bf16(za, xa, d0); d1 = dot2_bf16(zb, xb, d1); d2 = dot2_bf16(zc, xc, d2); d3 = dot2_bf16(zd, xd, d3); } }
    return wave_sum_u((d0 + d1) + (d2 + d3));
}
#define PE_PIN16(a, b) asm volatile("" : "+v"(a[b + 0]), "+v"(a[b + 1]), "+v"(a[b + 2]), "+v"(a[b + 3]), "+v"(a[b + 4]), "+v"(a[b + 5]), "+v"(a[b + 6]), "+v"(a[b + 7]), \
                                         "+v"(a[b + 8]), "+v"(a[b + 9]), "+v"(a[b + 10]), "+v"(a[b + 11]), "+v"(a[b + 12]), "+v"(a[b + 13]), "+v"(a[b + 14]), "+v"(a[b + 15]))
__device__ __forceinline__ void pe_axpy(float (&acc)[64], const u32x4v (&r)[3], const float w) {
    { const v6u_t g = {r[0].x, r[0].y, r[0].z, r[0].w, r[1].x, r[1].y};
      const v32f_t y = __builtin_amdgcn_cvt_scalef32_pk32_f32_fp6(g, 1.0f);
#pragma unroll
      for (int i = 0; i < 32; ++i) acc[i] = fmaf(w, y[i], acc[i]);
      PE_PIN16(acc, 0); PE_PIN16(acc, 16); }
    { const v6u_t g = {r[1].z, r[1].w, r[2].x, r[2].y, r[2].z, r[2].w};
      const v32f_t y = __builtin_amdgcn_cvt_scalef32_pk32_f32_fp6(g, 1.0f);
#pragma unroll
      for (int i = 0; i < 32; ++i) acc[32 + i] = fmaf(w, y[i], acc[32 + i]);
      PE_PIN16(acc, 32); PE_PIN16(acc, 48); }
}
__device__ __forceinline__ void wave_sort128(unsigned& a0, unsigned& a1, const int lane) {
#pragma unroll
    for (int k = 2; k <= 128; k <<= 1) {
#pragma unroll
        for (int j = k >> 1; j > 0; j >>= 1) {
            if (j == 64) { const unsigned lo = a0 < a1 ? a0 : a1, hi = a0 < a1 ? a1 : a0; a0 = lo; a1 = hi; }
            else {
                const unsigned o0 = (unsigned)__shfl_xor((int)a0, j), o1 = (unsigned)__shfl_xor((int)a1, j);
                const bool lowhalf = (lane & j) == 0;
                const bool up0 = k >= 128 ? true : ((lane & k) == 0);
                const bool up1 = k >= 128 ? true : (k == 64 ? false : ((lane & k) == 0));
                const bool min0 = lowhalf == up0, min1 = lowhalf == up1;
                const unsigned mn0 = a0 < o0 ? a0 : o0, mx0 = a0 < o0 ? o0 : a0, mn1 = a1 < o1 ? a1 : o1, mx1 = a1 < o1 ? o1 : a1;
                a0 = min0 ? mn0 : mx0; a1 = min1 ? mn1 : mx1;
            }
        }
    }
}
__device__ __forceinline__ void peer_expert_phase(const float* __restrict__ ypre, const float* __restrict__ stats, const float* __restrict__ gm, const float* __restrict__ bm, const bf16_t* __restrict__ x1b, int* __restrict__ eidx, float* __restrict__ gate,
                                                  const unsigned char* __restrict__ ub, const unsigned char* __restrict__ vb, const float* __restrict__ isu, const float* __restrict__ isv,
                                                  const float* __restrict__ lg, const float* __restrict__ lb, float* __restrict__ out, bf16_t* __restrict__ outb, LDSA float* xt0, const int bid, const int G, const int tid) {
    const int wv = __builtin_amdgcn_readfirstlane(tid >> 6);
    LDSA float* xt = xt0 + wv * (XT_BYTES / 4);
#define PE_POS(k) (rev ? 127 - (k) : (k))
#define PE_E(k) pick_i(e0, e1, PE_POS(k))
    int jt = 0;
    for (int t = bid * 8 + wv; t < SEQ; t += G * 8, ++jt) {
        int tl = tid; asm volatile("" : "+v"(tl));
        const int lane = tl & 63;
        const bool rev = (jt & 1) != 0;
        int e0, e1; float g0, g1;
        { const int r0 = eidx[(size_t)t * 128 + lane], r1 = eidx[(size_t)t * 128 + 64 + lane];
          const float h0 = gate[(size_t)t * 128 + lane], h1 = gate[(size_t)t * 128 + 64 + lane];
          unsigned a0 = ((unsigned)r0 << 7) | (unsigned)lane, a1 = ((unsigned)r1 << 7) | (unsigned)(64 + lane);
          wave_sort128(a0, a1, lane);
          e0 = (int)(a0 >> 7); e1 = (int)(a1 >> 7);
          const int k0 = (int)(a0 & 127u), k1 = (int)(a1 & 127u);
          const float p00 = __shfl(h0, k0 & 63), p01 = __shfl(h1, k0 & 63), p10 = __shfl(h0, k1 & 63), p11 = __shfl(h1, k1 & 63);
          g0 = k0 < 64 ? p00 : p01; g1 = k1 < 64 ? p10 : p11; }
        const float iu0 = isu[e0], iu1 = isu[e1], iv0 = isv[e0], iv1 = isv[e1];
        u32x4v xq[8];
#pragma unroll
        for (int k = 0; k < 8; ++k) xq[k] = *(const u32x4v*)(x1b + (size_t)t * DM + lane * 64 + k * 8);
        float w0 = 0.f, w1 = 0.f;
        u32x4v R0[3], R1[3], R2[3], R3[3], R4[3];
#define PE_USTEP(R, k) do { const int kk = PE_POS(k); const float d = pe_dot(R, xq) * pick_f(iu0, iu1, kk); const float w = pick_f(g0, g1, kk) * gelu_tanh_f(d) * pick_f(iv0, iv1, kk); \
            if (lane == (kk & 63)) { if (kk < 64) w0 = w; else w1 = w; } } while (0)
        PE_LOADROW(R0, ub, PE_E(0)); PE_LOADROW(R1, ub, PE_E(1)); PE_LOADROW(R2, ub, PE_E(2)); PE_LOADROW(R3, ub, PE_E(3));
        for (int k = 0; k < 125; k += 5) {
            if (k + 4 < 128) PE_LOADROW(R4, ub, PE_E(k + 4)); PE_USTEP(R0, k);
            if (k + 5 < 128) PE_LOADROW(R0, ub, PE_E(k + 5)); PE_USTEP(R1, k + 1);
            if (k + 6 < 128) PE_LOADROW(R1, ub, PE_E(k + 6)); PE_USTEP(R2, k + 2);
            if (k + 7 < 128) PE_LOADROW(R2, ub, PE_E(k + 7)); PE_USTEP(R3, k + 3);
            if (k + 8 < 128) PE_LOADROW(R3, ub, PE_E(k + 8)); PE_USTEP(R4, k + 4);
        }
        PE_USTEP(R0, 125); PE_USTEP(R1, 126); PE_USTEP(R2, 127);
#undef PE_USTEP
        eidx[(size_t)t * 128 + lane] = e0; eidx[(size_t)t * 128 + 64 + lane] = e1;
        gate[(size_t)t * 128 + lane] = w0; gate[(size_t)t * 128 + 64 + lane] = w1;
    }
    asm volatile("s_waitcnt vmcnt(0)" ::: "memory");
    for (int t = bid * 8 + wv; t < SEQ; t += G * 8, ++jt) {
        int tl = tid; asm volatile("" : "+v"(tl));
        const int lane = tl & 63;
        const bool rev = (jt & 1) != 0;
        const int e0 = __builtin_nontemporal_load(eidx + (size_t)t * 128 + lane), e1 = __builtin_nontemporal_load(eidx + (size_t)t * 128 + 64 + lane);
        const float w0 = __builtin_nontemporal_load(gate + (size_t)t * 128 + lane), w1 = __builtin_nontemporal_load(gate + (size_t)t * 128 + 64 + lane);
        u32x4v R0[3], R1[3], R2[3], R3[3], R4[3];
        float acc[64];
#pragma unroll
        for (int i = 0; i < 64; ++i) acc[i] = 0.f;
        PE_LOADROW(R0, vb, PE_E(0)); PE_LOADROW(R1, vb, PE_E(1)); PE_LOADROW(R2, vb, PE_E(2)); PE_LOADROW(R3, vb, PE_E(3));
        for (int k = 0; k < 125; k += 5) {
            if (k + 4 < 128) PE_LOADROW(R4, vb, PE_E(k + 4)); pe_axpy(acc, R0, pick_f(w0, w1, PE_POS(k)));
            if (k + 5 < 128) PE_LOADROW(R0, vb, PE_E(k + 5)); pe_axpy(acc, R1, pick_f(w0, w1, PE_POS(k + 1)));
            if (k + 6 < 128) PE_LOADROW(R1, vb, PE_E(k + 6)); pe_axpy(acc, R2, pick_f(w0, w1, PE_POS(k + 2)));
            if (k + 7 < 128) PE_LOADROW(R2, vb, PE_E(k + 7)); pe_axpy(acc, R3, pick_f(w0, w1, PE_POS(k + 3)));
            if (k + 8 < 128) PE_LOADROW(R3, vb, PE_E(k + 8)); pe_axpy(acc, R4, pick_f(w0, w1, PE_POS(k + 4)));
        }
        pe_axpy(acc, R0, pick_f(w0, w1, PE_POS(125))); pe_axpy(acc, R1, pick_f(w0, w1, PE_POS(126))); pe_axpy(acc, R2, pick_f(w0, w1, PE_POS(127)));
#pragma unroll
        for (int k = 0; k < 16; ++k) *(LDSA f4v_t*)(xt + lane * XT_STRIDE + 4 * k) = (f4v_t){acc[4 * k], acc[4 * k + 1], acc[4 * k + 2], acc[4 * k + 3]};
        asm volatile("s_waitcnt lgkmcnt(0)" ::: "memory");
        float4 y[16]; float s = 0.f; const float2 st = *(const float2*)(stats + (size_t)t * 2);
#pragma unroll
        for (int j = 0; j < 16; ++j) { const f4v_t f = *(const LDSA f4v_t*)(xt + (4 * j + (lane >> 4)) * XT_STRIDE + 4 * (lane & 15));
            const float4 yv = *(const float4*)(ypre + (size_t)t * DM + j * 256 + lane * 4), gv = *(const float4*)(gm + j * 256 + lane * 4), bv = *(const float4*)(bm + j * 256 + lane * 4);
            float4 xv;
            xv.x = (yv.x - st.x) * st.y * gv.x + bv.x; xv.y = (yv.y - st.x) * st.y * gv.y + bv.y; xv.z = (yv.z - st.x) * st.y * gv.z + bv.z; xv.w = (yv.w - st.x) * st.y * gv.w + bv.w;
            y[j].x = fmaf(ALPHA, xv.x, f.x); y[j].y = fmaf(ALPHA, xv.y, f.y); y[j].z = fmaf(ALPHA, xv.z, f.z); y[j].w = fmaf(ALPHA, xv.w, f.w);
            s += (y[j].x + y[j].y) + (y[j].z + y[j].w);
            if ((j & 3) == 3) asm volatile("" ::: "memory"); }
        asm volatile("s_waitcnt lgkmcnt(0)" ::: "memory");
        const float mean = wave_sum_u(s) * (1.0f / DM);
        float qq = 0.f;
#pragma unroll
        for (int j = 0; j < 16; ++j) { const float a = y[j].x - mean, b = y[j].y - mean, c = y[j].z - mean, d = y[j].w - mean; qq += (a * a + b * b) + (c * c + d * d); }
        const float rstd = 1.0f / sqrtf(wave_sum_u(qq) * (1.0f / DM) + 1e-5f);
#pragma unroll
        for (int j = 0; j < 16; ++j) {
            const int c = j * 256 + lane * 4;
            const float4 ga = *(const float4*)(lg + c), ba = *(const float4*)(lb + c);
            float4 oa; oa.x = (y[j].x - mean) * rstd * ga.x + ba.x; oa.y = (y[j].y - mean) * rstd * ga.y + ba.y; oa.z = (y[j].z - mean) * rstd * ga.z + ba.z; oa.w = (y[j].w - mean) * rstd * ga.w + ba.w;
            *(float4*)(out + (size_t)t * DM + c) = oa;
            if (outb) { uint2 w; w.x = cvtpk_bf16(oa.x, oa.y); w.y = cvtpk_bf16(oa.z, oa.w); *(uint2*)(outb + (size_t)t * DM + c) = w; }
            if ((j & 3) == 3) asm volatile("" ::: "memory");
        }
    }
#undef PE_E
#undef PE_POS
}

__device__ __forceinline__ void attn1_phase(const bf16_t* __restrict__ hb, bf16_t* __restrict__ abb, float* __restrict__ oc, const float* __restrict__ lq1, const float* __restrict__ lk1, const float* __restrict__ lq2,
                                            const float* __restrict__ lk2, const float* __restrict__ subg, char* lds, const int bid, const int G, const int tid) {
    for (int u = bid; u < 512; u += G) {
        __syncthreads();
        const int kv = u >> 7, g = (u >> 5) & 3, qb = u & 31, hq = kv * 4 + g;
        att::attn_wide_body<9216, 9216, 4096, 1, att::bf16>(hb + (size_t)(qb * 256) * 9216 + 6144 + hq * 128, hb + 8192 + kv * 128, hb + 8704 + kv * 128,
                                                             abb + (size_t)(qb * 256) * 4096 + 2048 + hq * 128, SEQ, lds, tid);
    }
    int tid2 = tid; asm volatile("" : "+v"(tid2));
    const int lane_c = tid2 & 63;
    const float lam = __int_as_float(__builtin_amdgcn_readfirstlane(__float_as_int(__expf(wave_sum(lq1[lane_c] * lk1[lane_c] + lq1[lane_c + 64] * lk1[lane_c + 64])) - __expf(wave_sum(lq2[lane_c] * lk2[lane_c] + lq2[lane_c + 64] * lk2[lane_c + 64])) + LAMBDA_INIT)));
    for (int v = bid; v < 256; v += G) {
        __syncthreads();
        const int h = v >> 5, qb = v & 31;
        float* o1 = oc + (size_t)(qb * 256) * 2048 + h * 256;
        int tid4 = tid2; asm volatile("" : "+v"(tid4));
        att::attn_wide_body<9216, 9216, 2048, 2, float>(hb + (size_t)(qb * 256) * 9216 + h * 256, hb + 2048 + h * 256, hb + 4096 + h * 256, o1, SEQ, lds, tid4);
        __syncthreads();
        int tid3 = tid2; asm volatile("" : "+v"(tid3));
        att::attn_wide_body<9216, 9216, 2048, 2, float, true, 4096>(hb + (size_t)(qb * 256) * 9216 + h * 256 + 128, hb + 2048 + h * 256 + 128, hb + 4096 + h * 256, o1, SEQ, lds, tid3,
                                                                     lam, 1.0f - LAMBDA_INIT, subg, abb + (size_t)(qb * 256) * 4096 + h * 256);
    }
}


__device__ __forceinline__ void attn0_phase(const bf16_t* __restrict__ hb, const float* __restrict__ sink, bf16_t* __restrict__ abb, bf16_t* __restrict__ obg, float* __restrict__ lse, char* lds, const int bid, const int G, const int tid) {
    const long LD = 12288;
    for (int u = bid; u < 512; u += G) {
        __syncthreads();
        const int hq = u >> 5, qb = u & 31, kv = hq >> 2;
        att::attn_banded_body<128>(hb + hq * 128, hb + 2048 + kv * 128, hb + 2560 + kv * 128, LD, SEQ, qb * 256, sink[hq] * (1.0f / att::SCALE), 1.0f, abb + hq * 128, 3072, nullptr, 0, lds, tid);
    }
    int tid2 = tid; asm volatile("" : "+v"(tid2));
    for (int v = bid; v < 768; v += G) {
        __syncthreads();
        const int g = v >> 8, w = v & 255, h = w >> 5, rem = w & 31;
        const int dsh = 2 * g;
        const int nqb_sh = 5 - dsh;
        const int r = rem >> nqb_sh, qb = rem & ((1 << nqb_sh) - 1);
        const int head = 8 * g + h;
        const long rs = LD << dsh;
        att::attn_banded_body<64>(hb + (long)r * LD + 3072 + head * 128, hb + (long)r * LD + 6144 + head * 128, hb + (long)r * LD + 9216 + head * 128, rs, SEQ >> dsh, qb * 256, -1e30f, 0.f,
                                  obg + ((long)(g * 8 + h) * SEQ + r) * 128, (long)128 << dsh, lse + (long)(g * 8 + h) * SEQ + r, (long)1 << dsh, lds, tid2);
    }
}
__device__ __forceinline__ void merge0_phase(const bf16_t* __restrict__ obg, const float* __restrict__ lse, bf16_t* __restrict__ abb, const int bid, const int G, const int tid) {
    const int lane = tid & 63, wv = tid >> 6;
    for (int j = bid * 8 + wv; j < SEQ * 8; j += G * 8) {
        const int h = j >> 13, t = j & (SEQ - 1);
        const float l0 = lse[(size_t)(0 * 8 + h) * SEQ + t], l1 = lse[(size_t)(1 * 8 + h) * SEQ + t], l2 = lse[(size_t)(2 * 8 + h) * SEQ + t];
        const float mx = fmaxf(l0, fmaxf(l1, l2));
        const float e0 = __expf(l0 - mx), e1 = __expf(l1 - mx), e2 = __expf(l2 - mx), inv = 1.0f / (e0 + e1 + e2);
        const unsigned a0 = *(const unsigned*)(obg + ((size_t)(0 * 8 + h) * SEQ + t) * 128 + 2 * lane), a1 = *(const unsigned*)(obg + ((size_t)(1 * 8 + h) * SEQ + t) * 128 + 2 * lane), a2 = *(const unsigned*)(obg + ((size_t)(2 * 8 + h) * SEQ + t) * 128 + 2 * lane);
        const float x = (e0 * bf_lo(a0) + e1 * bf_lo(a1) + e2 * bf_lo(a2)) * inv, y = (e0 * bf_hi(a0) + e1 * bf_hi(a1) + e2 * bf_hi(a2)) * inv;
        *(unsigned*)(abb + (size_t)t * 3072 + 2048 + h * 128 + 2 * lane) = cvtpk_bf16(x, y);
    }
}

__device__ __forceinline__ void post_even_phase(const float* __restrict__ h, bf16_t* __restrict__ hb, const int bid, const int G, const int tid) {
    const int lane = tid & 63, wv = tid >> 6;
    for (int job = bid * 8 + wv; job < SEQ * 96; job += G * 8) {
        const int t = job / 96, blk = job - t * 96;
        const bool rope = (blk < 20) || (blk >= 24 && blk < 72);
        const float2 v = *(const float2*)(h + (size_t)t * 12288 + blk * 128 + 2 * lane);
        float o0 = v.x, o1 = v.y;
        const float p0 = __shfl_xor(v.x, 8), p1 = __shfl_xor(v.y, 8);
        if (rope && lane < 16) {
            const int i0 = (2 * lane) & 15;
            float s0, c0, s1, c1; sincos_rev((double)t * REV_P[i0], s0, c0); sincos_rev((double)t * REV_P[i0 + 1], s1, c1);
            if (lane < 8) { o0 = v.x * c0 - p0 * s0; o1 = v.y * c1 - p1 * s1; }
            else          { o0 = v.x * c0 + p0 * s0; o1 = v.y * c1 + p1 * s1; }
        }
        *(unsigned*)(hb + (size_t)t * 12288 + blk * 128 + 2 * lane) = cvtpk_bf16(o0, o1);
    }
}
__device__ __forceinline__ void post_odd_phase(const float* __restrict__ h, bf16_t* __restrict__ hb, const float* __restrict__ qg, const float* __restrict__ kg, const int bid, const int G, const int tid) {
    const int lane = tid & 63, wv = tid >> 6;
    for (int job = bid * 8 + wv; job < SEQ * 72; job += G * 8) {
        const int t = job / 72, blk = job - t * 72;
        const float2 v = *(const float2*)(h + (size_t)t * 9216 + blk * 128 + 2 * lane);
        float o0 = v.x, o1 = v.y;
        if (blk < 32) {
            const float p0 = __shfl_xor(v.x, 8), p1 = __shfl_xor(v.y, 8);
            if (lane < 16) {
                const int i0 = (2 * lane) & 15;
                float s0, c0, s1, c1; sincos_rev((double)t * REV_P[i0], s0, c0); sincos_rev((double)t * REV_P[i0 + 1], s1, c1);
                if (lane < 8) { o0 = v.x * c0 - p0 * s0; o1 = v.y * c1 - p1 * s1; }
                else          { o0 = v.x * c0 + p0 * s0; o1 = v.y * c1 + p1 * s1; }
            }
        } else if (blk >= 48 && blk < 68) {
            const float* g = blk < 64 ? qg : kg;
            const float ss = wave_sum(v.x * v.x + v.y * v.y) * (1.0f / 128.0f);
            const float rs = 1.0f / sqrtf(ss + 1e-6f);
            const float a0 = v.x * rs * g[2 * lane], a1 = v.y * rs * g[2 * lane + 1];
            const float p0 = __shfl_xor(a0, 16), p1 = __shfl_xor(a1, 16);
            const int i0 = (2 * lane) & 31;
            const double pos = (double)(lane < 32 ? (t >> 6) : (t & 63));
            float s0, c0, s1, c1; sincos_rev(pos * REV_A[i0], s0, c0); sincos_rev(pos * REV_A[i0 + 1], s1, c1);
            if ((lane & 16) == 0) { o0 = a0 * c0 - p0 * s0; o1 = a1 * c1 - p1 * s1; }
            else                  { o0 = a0 * c0 + p0 * s0; o1 = a1 * c1 + p1 * s1; }
        }
        *(unsigned*)(hb + (size_t)t * 9216 + blk * 128 + 2 * lane) = cvtpk_bf16(o0, o1);
    }
}

__device__ __forceinline__ void attn_seg_b(const float q0, const float q1, const bf16_t* __restrict__ Kb, const bf16_t* __restrict__ Vb, const int ld,
                                           const int t, const int step, int jlo, int jhi, float& m, float& l, float& o0, float& o1, const int lane) {
    { const int lo = -(t / step); if (jlo < lo) jlo = lo; const int hi = (SEQ - 1 - t) / step; if (jhi > hi) jhi = hi; }
    for (int j = jlo; j <= jhi; ++j) {
        const size_t tp = (size_t)(t + step * j);
        const unsigned kw = *(const unsigned*)(Kb + tp * ld + 2 * lane), vw = *(const unsigned*)(Vb + tp * ld + 2 * lane);
        const float s = wave_sum(q0 * bf_lo(kw) + q1 * bf_hi(kw)) * ATT_SCALE;
        const float mn = fmaxf(m, s);
        const float al = __expf(m - mn), p = __expf(s - mn);
        l = l * al + p;
        o0 = o0 * al + p * bf_lo(vw); o1 = o1 * al + p * bf_hi(vw);
        m = mn;
    }
}
__device__ __forceinline__ void attn_even_valu_phase(const bf16_t* __restrict__ hb, const float* __restrict__ sink, bf16_t* __restrict__ abb, const int bid, const int G, const int tid) {
    const int lane = tid & 63, wv = tid >> 6;
    const int LD = 12288;
    for (int job = bid * 8 + wv; job < SEQ * 24; job += G * 8) {
        const int hh = job / SEQ, t = job % SEQ;
        float o0 = 0.f, o1 = 0.f, m, l;
        if (hh < 16) {
            const int kv = hh >> 2;
            const unsigned qw = *(const unsigned*)(hb + (size_t)t * LD + hh * 128 + 2 * lane);
            m = sink[hh]; l = 1.f;
            attn_seg_b(bf_lo(qw), bf_hi(qw), hb + 2048 + kv * 128, hb + 2560 + kv * 128, LD, t, 1, -128, 128, m, l, o0, o1, lane);
        } else {
            const int hbh = hh - 16;
            m = -1e30f; l = 0.f;
#pragma unroll
            for (int g = 0; g < 3; ++g) {
                const int head = 8 * g + hbh; const int step = g == 0 ? 1 : (g == 1 ? 4 : 16);
                const unsigned qw = *(const unsigned*)(hb + (size_t)t * LD + 3072 + head * 128 + 2 * lane);
                attn_seg_b(bf_lo(qw), bf_hi(qw), hb + 6144 + head * 128, hb + 9216 + head * 128, LD, t, step, -64, 64, m, l, o0, o1, lane);
            }
        }
        const float il = 1.0f / l;
        *(unsigned*)(abb + (size_t)t * 3072 + hh * 128 + 2 * lane) = cvtpk_bf16(o0 * il, o1 * il);
    }
}

__device__ __forceinline__ void ln_phase(const float* __restrict__ y, const float* __restrict__ g, const float* __restrict__ b, float* __restrict__ stats, bf16_t* __restrict__ outb, const int bid, const int G, const int tid) {
    const int lane = tid & 63, wv = tid >> 6;
    for (int t = bid * 8 + wv; t < SEQ; t += G * 8) {
        float4 v[16]; float s = 0.f;
#pragma unroll
        for (int i = 0; i < 16; ++i) { v[i] = *(const float4*)(y + (size_t)t * DM + i * 256 + lane * 4); s += (v[i].x + v[i].y) + (v[i].z + v[i].w); }
        const float mean = wave_sum(s) * (1.0f / DM);
        float q = 0.f;
#pragma unroll
        for (int i = 0; i < 16; ++i) { const float a = v[i].x - mean, bb = v[i].y - mean, c = v[i].z - mean, d = v[i].w - mean; q += (a * a + bb * bb) + (c * c + d * d); }
        const float rstd = 1.0f / sqrtf(wave_sum(q) * (1.0f / DM) + 1e-5f);
        if (lane == 0) *(float2*)(stats + (size_t)t * 2) = make_float2(mean, rstd);
#pragma unroll
        for (int i = 0; i < 16; ++i) {
            const float4 gg = *(const float4*)(g + i * 256 + lane * 4), bb = *(const float4*)(b + i * 256 + lane * 4);
            float4 o; o.x = (v[i].x - mean) * rstd * gg.x + bb.x; o.y = (v[i].y - mean) * rstd * gg.y + bb.y; o.z = (v[i].z - mean) * rstd * gg.z + bb.z; o.w = (v[i].w - mean) * rstd * gg.w + bb.w;
            uint2 w; w.x = cvtpk_bf16(o.x, o.y); w.y = cvtpk_bf16(o.z, o.w); *(uint2*)(outb + (size_t)t * DM + i * 256 + lane * 4) = w;
            if ((i & 3) == 3) asm volatile("" ::: "memory");
        }
    }
}

__device__ __forceinline__ void route_valu_phase(const float* __restrict__ q  , const float* __restrict__ keys  , int* __restrict__ eidx, float* __restrict__ gate, const int bid, const int G, const int tid) {
    const int lane = tid & 63, wv = tid >> 6;
    for (int job = bid * 8 + wv; job < SEQ * 8; job += G * 8) {
        const int hh = job & 7, t = job >> 3;
        float sv0 = 0.f, sv1 = 0.f; int si0 = 0, si1 = 0;
#pragma unroll
        for (int c = 0; c < 2; ++c) {
            const float* qq = q + (size_t)t * 2048 + hh * 256 + c * 128;
            const float* k0 = keys + ((size_t)(hh * 2 + c) * 128 + lane) * 128;
            const float* k1 = k0 + 64 * 128;
            float s0 = 0.f, s1 = 0.f;
            for (int d = 0; d < 128; d += 4) {
                const float4 qv = *(const float4*)(qq + d), a = *(const float4*)(k0 + d), b = *(const float4*)(k1 + d);
                s0 += qv.x * a.x + qv.y * a.y + qv.z * a.z + qv.w * a.w;
                s1 += qv.x * b.x + qv.y * b.y + qv.z * b.z + qv.w * b.w;
            }
            float myv = 0.f; int myi = 0;
            for (int k = 0; k < 16; ++k) {
                float bv; int bi;
                if (s1 > s0) { bv = s1; bi = lane + 64; } else { bv = s0; bi = lane; }
#pragma unroll
                for (int o = 32; o >= 1; o >>= 1) {
                    const float ov = __shfl_xor(bv, o); const int oi = __shfl_xor(bi, o);
                    if (ov > bv || (ov == bv && oi < bi)) { bv = ov; bi = oi; }
                }
                if (lane == k) { myv = bv; myi = bi; }
                if (bi == lane) s0 = -3.0e38f;
                if (bi == lane + 64) s1 = -3.0e38f;
            }
            if (c == 0) { sv0 = myv; si0 = myi; } else { sv1 = myv; si1 = myi; }
        }
        float cv0, cv1, cv2, cv3; int ci0, ci1, ci2, ci3;
        { const float a = __shfl(sv0, lane >> 2); const int ai = __shfl(si0, lane >> 2); const int jb = (lane & 3) * 4;
          cv0 = a + __shfl(sv1, jb + 0); ci0 = ai * 128 + __shfl(si1, jb + 0);
          cv1 = a + __shfl(sv1, jb + 1); ci1 = ai * 128 + __shfl(si1, jb + 1);
          cv2 = a + __shfl(sv1, jb + 2); ci2 = ai * 128 + __shfl(si1, jb + 2);
          cv3 = a + __shfl(sv1, jb + 3); ci3 = ai * 128 + __shfl(si1, jb + 3); }
        float tv = 0.f; int te = 0;
        for (int k = 0; k < 16; ++k) {
            float bv = cv0; int bp = lane * 4, be = ci0;
            if (cv1 > bv) { bv = cv1; bp = lane * 4 + 1; be = ci1; }
            if (cv2 > bv) { bv = cv2; bp = lane * 4 + 2; be = ci2; }
            if (cv3 > bv) { bv = cv3; bp = lane * 4 + 3; be = ci3; }
#pragma unroll
            for (int o = 32; o >= 1; o >>= 1) {
                const float ov = __shfl_xor(bv, o); const int op = __shfl_xor(bp, o); const int oe = __shfl_xor(be, o);
                if (ov > bv || (ov == bv && op < bp)) { bv = ov; bp = op; be = oe; }
            }
            if (lane == k) { tv = bv; te = be; }
            if (bp == lane * 4 + 0) cv0 = -3.0e38f;
            if (bp == lane * 4 + 1) cv1 = -3.0e38f;
            if (bp == lane * 4 + 2) cv2 = -3.0e38f;
            if (bp == lane * 4 + 3) cv3 = -3.0e38f;
        }
        const float v = lane < 16 ? tv : -3.0e38f;
        const float mx = wave_max(v);
        const float e = lane < 16 ? __expf(tv - mx) : 0.f;
        const float den = wave_sum(e);
        if (lane < 16) { eidx[(size_t)t * 128 + hh * 16 + lane] = te; gate[(size_t)t * 128 + hh * 16 + lane] = e / den; }
    }
}
namespace rt {
using att::f32x16; using att::bf16x8;
__device__ __forceinline__ float pair_max(float m) {
    auto rr = __builtin_amdgcn_permlane32_swap(__float_as_uint(m), __float_as_uint(m), false, false);
    return fmaxf(__uint_as_float(rr[0]), __uint_as_float(rr[1]));
}
__device__ __forceinline__ int pair_max_i(int m) {
    auto rr = __builtin_amdgcn_permlane32_swap((unsigned)m, (unsigned)m, false, false);
    const int a = (int)rr[0], b = (int)rr[1]; return a > b ? a : b;
}
__device__ __forceinline__ void top16_of_128(f32x16& p0, f32x16& p1, f32x16& p2, f32x16& p3, float (&t)[16]) {
#pragma unroll
    for (int k = 0; k < 16; ++k) {
        float m = p0[0];
#pragma unroll
        for (int r = 1; r < 16; ++r) m = fmaxf(m, p0[r]);
#pragma unroll
        for (int r = 0; r < 16; ++r) m = fmaxf(m, fmaxf(p1[r], fmaxf(p2[r], p3[r])));
        m = pair_max(m);
        t[k] = m;
#pragma unroll
        for (int r = 0; r < 16; ++r) { p0[r] = p0[r] == m ? -3.0e38f : p0[r]; p1[r] = p1[r] == m ? -3.0e38f : p1[r]; p2[r] = p2[r] == m ? -3.0e38f : p2[r]; p3[r] = p3[r] == m ? -3.0e38f : p3[r]; }
    }
}
__device__ __forceinline__ void tag_scores(f32x16& p, const int base, const int hi) {
#pragma unroll
    for (int r = 0; r < 16; ++r) p[r] = __uint_as_float((__float_as_uint(p[r]) & ~0x7Fu) | (unsigned)(base + att::crow(r, hi)));
}
}

__device__ __forceinline__ void route_mfma_phase(const bf16_t* __restrict__ pqb  , const bf16_t* __restrict__ keysb  , int* __restrict__ eidx, float* __restrict__ gate,
                                                 char* lds, const pg8::StaticOrder& S, const int tid) {
    using namespace rt;
    const int wid = __builtin_amdgcn_readfirstlane(tid >> 6), lane = tid & 63, r32 = lane & 31, hi = lane >> 5;
    att::bf16* K_lds = (att::bf16*)lds;
    pg8::Unit un;
    for (int ui = 0; S.next(ui, un); ++ui) {
        const int h = un.pn, tb = un.pm * 256;
        const int tok = tb + wid * 32 + r32;
        float t0[16], t1[16];
#pragma unroll
        for (int c = 0; c < 2; ++c) {
            __syncthreads();
            { const bf16_t* kp = keysb + (size_t)(h * 2 + c) * 128 * 128;
              const int row = tid >> 2;
#pragma unroll
              for (int i = 0; i < 4; ++i) { const int sc = ((tid & 3) * 4 + i) * 8;
                  const bf16x8 v = *reinterpret_cast<const bf16x8*>(kp + row * 128 + sc);
                  *(bf16x8*)((char*)K_lds + (row >> 6) * 16384 + KSWZ(row & 63, sc * 2)) = v; } }
            bf16x8 qr[8];
            { const bf16_t* qw = pqb + (size_t)tok * 2048 + h * 256 + c * 128 + hi * 8;
#pragma unroll
              for (int d0 = 0; d0 < 8; ++d0) qr[d0] = *reinterpret_cast<const bf16x8*>(qw + d0 * 16); }
            __syncthreads();
            f32x16 p0, p1, p2, p3;
            att::qkt_pipe(p0, p1, (int)(uintptr_t)K_lds, qr, r32, hi);
            att::qkt_pipe(p2, p3, (int)(uintptr_t)K_lds + 16384, qr, r32, hi);
            tag_scores(p0, 0, hi); tag_scores(p1, 32, hi); tag_scores(p2, 64, hi); tag_scores(p3, 96, hi);
            if (c == 0) top16_of_128(p0, p1, p2, p3, t0); else top16_of_128(p0, p1, p2, p3, t1);
        }
        float v0[16], v1[16]; int k0[16], k1[16];
#pragma unroll
        for (int i = 0; i < 16; ++i) { const unsigned a = __float_as_uint(t0[i]), b = __float_as_uint(t1[i]);
            v0[i] = __uint_as_float(a & ~0x7Fu); v1[i] = __uint_as_float(b & ~0x7Fu); k0[i] = (int)((a & 0x7Fu) << 7); k1[i] = (int)(b & 0x7Fu); }
        float cv[25]; int ce[25];
    { const float s = hi ? (v0[0] + v1[1]) : (v0[0] + v1[0]); cv[0] = __uint_as_float((__float_as_uint(s) & ~0xFFu) | (unsigned)(2 * 0 + hi)); ce[0] = hi ? (k0[0] | k1[1]) : (k0[0] | k1[0]); }
    { const float s = hi ? (v0[0] + v1[3]) : (v0[0] + v1[2]); cv[1] = __uint_as_float((__float_as_uint(s) & ~0xFFu) | (unsigned)(2 * 1 + hi)); ce[1] = hi ? (k0[0] | k1[3]) : (k0[0] | k1[2]); }
    { const float s = hi ? (v0[0] + v1[5]) : (v0[0] + v1[4]); cv[2] = __uint_as_float((__float_as_uint(s) & ~0xFFu) | (unsigned)(2 * 2 + hi)); ce[2] = hi ? (k0[0] | k1[5]) : (k0[0] | k1[4]); }
    { const float s = hi ? (v0[0] + v1[7]) : (v0[0] + v1[6]); cv[3] = __uint_as_float((__float_as_uint(s) & ~0xFFu) | (unsigned)(2 * 3 + hi)); ce[3] = hi ? (k0[0] | k1[7]) : (k0[0] | k1[6]); }
    { const float s = hi ? (v0[0] + v1[9]) : (v0[0] + v1[8]); cv[4] = __uint_as_float((__float_as_uint(s) & ~0xFFu) | (unsigned)(2 * 4 + hi)); ce[4] = hi ? (k0[0] | k1[9]) : (k0[0] | k1[8]); }
    { const float s = hi ? (v0[0] + v1[11]) : (v0[0] + v1[10]); cv[5] = __uint_as_float((__float_as_uint(s) & ~0xFFu) | (unsigned)(2 * 5 + hi)); ce[5] = hi ? (k0[0] | k1[11]) : (k0[0] | k1[10]); }
    { const float s = hi ? (v0[0] + v1[13]) : (v0[0] + v1[12]); cv[6] = __uint_as_float((__float_as_uint(s) & ~0xFFu) | (unsigned)(2 * 6 + hi)); ce[6] = hi ? (k0[0] | k1[13]) : (k0[0] | k1[12]); }
    { const float s = hi ? (v0[0] + v1[15]) : (v0[0] + v1[14]); cv[7] = __uint_as_float((__float_as_uint(s) & ~0xFFu) | (unsigned)(2 * 7 + hi)); ce[7] = hi ? (k0[0] | k1[15]) : (k0[0] | k1[14]); }
    { const float s = hi ? (v0[1] + v1[1]) : (v0[1] + v1[0]); cv[8] = __uint_as_float((__float_as_uint(s) & ~0xFFu) | (unsigned)(2 * 8 + hi)); ce[8] = hi ? (k0[1] | k1[1]) : (k0[1] | k1[0]); }
    { const float s = hi ? (v0[1] + v1[3]) : (v0[1] + v1[2]); cv[9] = __uint_as_float((__float_as_uint(s) & ~0xFFu) | (unsigned)(2 * 9 + hi)); ce[9] = hi ? (k0[1] | k1[3]) : (k0[1] | k1[2]); }
    { const float s = hi ? (v0[1] + v1[5]) : (v0[1] + v1[4]); cv[10] = __uint_as_float((__float_as_uint(s) & ~0xFFu) | (unsigned)(2 * 10 + hi)); ce[10] = hi ? (k0[1] | k1[5]) : (k0[1] | k1[4]); }
    { const float s = hi ? (v0[1] + v1[7]) : (v0[1] + v1[6]); cv[11] = __uint_as_float((__float_as_uint(s) & ~0xFFu) | (unsigned)(2 * 11 + hi)); ce[11] = hi ? (k0[1] | k1[7]) : (k0[1] | k1[6]); }
    { const float s = hi ? (v0[2] + v1[1]) : (v0[2] + v1[0]); cv[12] = __uint_as_float((__float_as_uint(s) & ~0xFFu) | (unsigned)(2 * 12 + hi)); ce[12] = hi ? (k0[2] | k1[1]) : (k0[2] | k1[0]); }
    { const float s = hi ? (v0[2] + v1[3]) : (v0[2] + v1[2]); cv[13] = __uint_as_float((__float_as_uint(s) & ~0xFFu) | (unsigned)(2 * 13 + hi)); ce[13] = hi ? (k0[2] | k1[3]) : (k0[2] | k1[2]); }
    { const float s = hi ? (v0[3] + v1[0]) : (v0[2] + v1[4]); cv[14] = __uint_as_float((__float_as_uint(s) & ~0xFFu) | (unsigned)(2 * 14 + hi)); ce[14] = hi ? (k0[3] | k1[0]) : (k0[2] | k1[4]); }
    { const float s = hi ? (v0[3] + v1[2]) : (v0[3] + v1[1]); cv[15] = __uint_as_float((__float_as_uint(s) & ~0xFFu) | (unsigned)(2 * 15 + hi)); ce[15] = hi ? (k0[3] | k1[2]) : (k0[3] | k1[1]); }
    { const float s = hi ? (v0[4] + v1[0]) : (v0[3] + v1[3]); cv[16] = __uint_as_float((__float_as_uint(s) & ~0xFFu) | (unsigned)(2 * 16 + hi)); ce[16] = hi ? (k0[4] | k1[0]) : (k0[3] | k1[3]); }
    { const float s = hi ? (v0[4] + v1[2]) : (v0[4] + v1[1]); cv[17] = __uint_as_float((__float_as_uint(s) & ~0xFFu) | (unsigned)(2 * 17 + hi)); ce[17] = hi ? (k0[4] | k1[2]) : (k0[4] | k1[1]); }
    { const float s = hi ? (v0[5] + v1[1]) : (v0[5] + v1[0]); cv[18] = __uint_as_float((__float_as_uint(s) & ~0xFFu) | (unsigned)(2 * 18 + hi)); ce[18] = hi ? (k0[5] | k1[1]) : (k0[5] | k1[0]); }
    { const float s = hi ? (v0[6] + v1[1]) : (v0[6] + v1[0]); cv[19] = __uint_as_float((__float_as_uint(s) & ~0xFFu) | (unsigned)(2 * 19 + hi)); ce[19] = hi ? (k0[6] | k1[1]) : (k0[6] | k1[0]); }
    { const float s = hi ? (v0[7] + v1[1]) : (v0[7] + v1[0]); cv[20] = __uint_as_float((__float_as_uint(s) & ~0xFFu) | (unsigned)(2 * 20 + hi)); ce[20] = hi ? (k0[7] | k1[1]) : (k0[7] | k1[0]); }
    { const float s = hi ? (v0[9] + v1[0]) : (v0[8] + v1[0]); cv[21] = __uint_as_float((__float_as_uint(s) & ~0xFFu) | (unsigned)(2 * 21 + hi)); ce[21] = hi ? (k0[9] | k1[0]) : (k0[8] | k1[0]); }
    { const float s = hi ? (v0[11] + v1[0]) : (v0[10] + v1[0]); cv[22] = __uint_as_float((__float_as_uint(s) & ~0xFFu) | (unsigned)(2 * 22 + hi)); ce[22] = hi ? (k0[11] | k1[0]) : (k0[10] | k1[0]); }
    { const float s = hi ? (v0[13] + v1[0]) : (v0[12] + v1[0]); cv[23] = __uint_as_float((__float_as_uint(s) & ~0xFFu) | (unsigned)(2 * 23 + hi)); ce[23] = hi ? (k0[13] | k1[0]) : (k0[12] | k1[0]); }
    { const float s = hi ? (v0[15] + v1[0]) : (v0[14] + v1[0]); cv[24] = __uint_as_float((__float_as_uint(s) & ~0xFFu) | (unsigned)(2 * 24 + hi)); ce[24] = hi ? (k0[15] | k1[0]) : (k0[14] | k1[0]); }
        float ts[16]; int te[16];
#pragma unroll
        for (int k = 0; k < 16; ++k) {
            float m = cv[0];
#pragma unroll
            for (int n = 1; n < 25; ++n) m = fmaxf(m, cv[n]);
            m = pair_max(m);
            int e = -1;
#pragma unroll
            for (int n = 0; n < 25; ++n) { const bool hit = cv[n] == m; e = hit ? ce[n] : e; cv[n] = hit ? -3.0e38f : cv[n]; }
            ts[k] = __uint_as_float(__float_as_uint(m) & ~0xFFu); te[k] = pair_max_i(e);
        }
        float den = 0.f; const float mx = ts[0];
#pragma unroll
        for (int k = 0; k < 16; ++k) { ts[k] = __expf(ts[k] - mx); den += ts[k]; }
        const float inv = 1.0f / den;
        if (hi == 0) { int4* op = (int4*)(eidx + (size_t)tok * 128 + h * 16);
            op[0] = make_int4(te[0], te[1], te[2], te[3]); op[1] = make_int4(te[4], te[5], te[6], te[7]); op[2] = make_int4(te[8], te[9], te[10], te[11]); op[3] = make_int4(te[12], te[13], te[14], te[15]); }
        else { float4* op = (float4*)(gate + (size_t)tok * 128 + h * 16);
            op[0] = make_float4(ts[0] * inv, ts[1] * inv, ts[2] * inv, ts[3] * inv); op[1] = make_float4(ts[4] * inv, ts[5] * inv, ts[6] * inv, ts[7] * inv);
            op[2] = make_float4(ts[8] * inv, ts[9] * inv, ts[10] * inv, ts[11] * inv); op[3] = make_float4(ts[12] * inv, ts[13] * inv, ts[14] * inv, ts[15] * inv); }
    }
}
#ifndef PH_MASK
#define PH_MASK 0xffffffffu
#endif
constexpr int N_PHASES = 20;
__global__ void __launch_bounds__(512, 2) mega(MK a) {
    extern __shared__ __attribute__((aligned(16))) unsigned char lds_raw[];
    LDSA unsigned char* lds = (LDSA unsigned char*)lds_raw;
    const int lo = a.ph_lo, hi = a.ph_hi;
    const int G = gridDim.x, bid = blockIdx.x;
    const int wid_s = __builtin_amdgcn_readfirstlane(threadIdx.x >> 6);
    unsigned char* ws = a.ws;
#define PH_TID() int tid; { int _z = 0; asm volatile("" : "+s"(_z)); tid = wid_s * 64 + (int)__builtin_amdgcn_mbcnt_hi(~0u, __builtin_amdgcn_mbcnt_lo(~0u, (unsigned)_z)); }
#define WSP(T, name, off) T* name; { unsigned char* _b = ws; asm volatile("" : "+s"(_b)); name = (T*)(_b + (off)); }
#define IN(k) ((((PH_MASK) >> (k)) & 1u) && lo <= (k) && (k) < hi)
#define SEAM(k) do { if ((k) + 1 < hi) { PH_TID() xcd_barrier(bar, tid); } } while (0)
    XcdBarrier bar;
    { PH_TID()
      volatile LAS unsigned* st = (volatile LAS unsigned*)(lds + LDS_MISC);
      if (tid == 0) { st[0] = 0u; st[1] = 0u; }
      __syncthreads();
      bar = xcd_barrier_post((unsigned*)(ws + WS_CTL), st, tid); }

    if (IN(0)) {
      {
        PH_TID()
        WSP(bf16_t, xb, WS_XB) WSP(bf16_t, wab, WS_WAB) WSP(bf16_t, woab, WS_WOAB) WSP(bf16_t, wcd, WS_WCD) WSP(bf16_t, wocd, WS_WOCD) WSP(bf16_t, wq, WS_WQ) WSP(unsigned char, ub, WS_UB) WSP(unsigned char, vb, WS_VB) WSP(float, isu, WS_SU) WSP(float, isv, WS_SV)
        cvt_rows_bf16(a.in[0], xb, (size_t)SEQ * DM / 8, bid, G, tid, 512);
        LDSA float* tile = (LDSA float*)lds;
        transpose_cvt(a.in[1], wab, 4096, 12288, tile, bid, G, PermAB(), tid);
        transpose_cvt(a.in[3], woab, 3072, 4096, tile, bid, G, PermNone(), tid);
        transpose_cvt(a.in[4], wcd, 4096, 9216, tile, bid, G, PermCD(), tid);
        transpose_cvt(a.in[12], wocd, 4096, 4096, tile, bid, G, PermNone(), tid);
        transpose_cvt(a.in[15], wq, 4096, 2048, tile, bid, G, PermNone(), tid);
        transpose_cvt(a.in[15] + (size_t)4096 * 2048, wq + (size_t)2048 * 4096, 4096, 2048, tile, bid, G, PermNone(), tid);
        table_fp6(a.in[17], ub, isu, 2 * 16384, (LDSA float*)lds, bid, G, tid);
        { const int nu1 = (SEQ / 256) * (9216 / 256); const bool slack = (nu1 % G) != 0 && (nu1 % G) <= G / 2;
          table_fp6(a.in[18], vb, isv, slack ? 16384 : 2 * 16384, (LDSA float*)lds, bid, G, tid); }
        { WSP(float, cs0, WS_CS0) WSP(float, csa, WS_CSA) rope_tables(cs0, csa, bid, G, tid); }
        { WSP(bf16_t, keyb, WS_KEYB) cvt_rows_bf16(a.in[16], keyb, (size_t)2 * 8 * 2 * 128 * 128 / 8, bid, G, tid, 512); }
      }
        SEAM(0);
    }
    { constexpr int layer = 0;
        const int pb = 1 + 10 * layer;
        if (IN(pb + 0)) {
            PH_TID() WSP(bf16_t, xb, WS_XB) WSP(bf16_t, x2b, WS_X2B) WSP(bf16_t, wab, WS_WAB) WSP(bf16_t, wcd, WS_WCD) WSP(bf16_t, hb, WS_HB) WSP(float, cs0, WS_CS0) WSP(float, csa, WS_CSA)
            if (layer == 0) {
                pg8::Gemm g{xb, wab, SEQ, 12288, 4096}; pg8::StaticOrder S; S.init(SEQ, 12288, G, bid);
                pg8::EpiProj<0> E{hb, 12288, cs0, csa, nullptr, nullptr, (LDSA float*)(lds + LDS_MISC + 64)};
                pg8::gemm_phase<pg8::EpiProj<0>, pg8::StaticOrder>(lds, g, S, E, nullptr, tid);
            } else {
                pg8::Gemm g{x2b, wcd, SEQ, 9216, 4096}; pg8::StaticOrder S; S.init(SEQ, 9216, G, bid);
                pg8::EpiProj<1> E{hb, 9216, cs0, csa, a.in[10], a.in[11], (LDSA float*)(lds + LDS_MISC + 64)};
                pg8::gemm_phase<pg8::EpiProj<1>, pg8::StaticOrder>(lds, g, S, E, nullptr, tid);
                { const int nu1 = (SEQ / 256) * (9216 / 256), busy = nu1 % G; const bool slack = busy != 0 && busy <= G / 2;
                  if (slack && bid >= busy) {
                      WSP(unsigned char, vb1, WS_VB) WSP(float, isv1, WS_SV)
                      int t5; { int _z = 0; asm volatile("" : "+s"(_z)); t5 = wid_s * 64 + (int)__builtin_amdgcn_mbcnt_hi(~0u, __builtin_amdgcn_mbcnt_lo(~0u, (unsigned)_z)); }
                      table_fp6(a.in[18] + (size_t)16384 * DM, vb1 + (size_t)16384 * ROWB, isv1 + 16384, 16384, (LDSA float*)lds, bid - busy, G - busy, t5); } }
            }
            SEAM(pb + 0);
        }
        if (IN(pb + 2)) {
            PH_TID() WSP(bf16_t, hb, WS_HB) WSP(bf16_t, abb, WS_AB) WSP(float, oc, WS_OC)
            if (layer == 0) attn0_phase(hb, a.in[2], abb, (bf16_t*)oc, (float*)((unsigned char*)oc + (size_t)3 * 8 * SEQ * 128 * 2), (char*)lds_raw, bid, G, tid);
            else attn1_phase(hb, abb, oc, a.in[5], a.in[6], a.in[7], a.in[8], a.in[9], (char*)lds_raw, bid, G, tid);
            SEAM(pb + 2);
        }
        if (layer == 0) {
            if (IN(pb + 3)) {
                PH_TID() WSP(bf16_t, abb, WS_AB) WSP(float, oc, WS_OC)
                merge0_phase((const bf16_t*)oc, (const float*)((unsigned char*)oc + (size_t)3 * 8 * SEQ * 128 * 2), abb, bid, G, tid);
                SEAM(pb + 3);
            }
        } else {
        }
        if (IN(pb + 4)) {
            const int K = layer == 0 ? 3072 : 4096;
            PH_TID() WSP(bf16_t, abb, WS_AB) WSP(bf16_t, woab, WS_WOAB) WSP(bf16_t, wocd, WS_WOCD) WSP(float, ybuf, WS_Y) WSP(float, x2, WS_X2)
            pg8::Gemm g{abb, layer == 0 ? woab : wocd, SEQ, 4096, K}; pg8::StaticOrder S; S.init(SEQ, 4096, G, bid);
            pg8::EpiF32R E{ybuf, 4096, layer == 0 ? a.in[0] : (const float*)x2, ALPHA};
            pg8::gemm_phase<pg8::EpiF32R, pg8::StaticOrder>(lds, g, S, E, nullptr, tid);
            SEAM(pb + 4);
        }
        if (IN(pb + 5)) {
            PH_TID() WSP(float, ybuf, WS_Y) WSP(float, stats, WS_X1) WSP(bf16_t, x1b, WS_X1B)
            ln_phase(ybuf, a.in[13] + layer * DM, a.in[14] + layer * DM, stats, x1b, bid, G, tid);
            SEAM(pb + 5);
        }
        if (IN(pb + 6)) {
            PH_TID() WSP(bf16_t, x1b, WS_X1B) WSP(bf16_t, wq, WS_WQ) WSP(bf16_t, pqb, WS_PQ)
            pg8::Gemm g{x1b, wq + (size_t)layer * 2048 * 4096, SEQ, 2048, 4096}; pg8::StaticOrder S; S.init(SEQ, 2048, G, bid);
            pg8::EpiBf16P E{pqb, 2048};
            pg8::gemm_phase<pg8::EpiBf16P, pg8::StaticOrder>(lds, g, S, E, nullptr, tid);
            asm volatile("s_waitcnt vmcnt(0)" ::: "memory"); __syncthreads();
            { WSP(bf16_t, keyb, WS_KEYB) WSP(int, eidx, WS_EIDX) WSP(float, gate, WS_GATE)
              int t4 = tid; asm volatile("" : "+v"(t4));
              route_mfma_phase(pqb, keyb + (size_t)layer * 8 * 2 * 128 * 128, eidx, gate, (char*)lds_raw, S, t4); }
            SEAM(pb + 6);
        }
        if (IN(pb + 8)) {
            PH_TID() WSP(float, ybuf, WS_Y) WSP(float, stats, WS_X1) WSP(bf16_t, x1b, WS_X1B) WSP(int, eidx, WS_EIDX) WSP(float, gate, WS_GATE) WSP(unsigned char, ub, WS_UB) WSP(unsigned char, vb, WS_VB) WSP(float, isu, WS_SU) WSP(float, isv, WS_SV) WSP(float, x2, WS_X2) WSP(bf16_t, x2b, WS_X2B)
            peer_expert_phase(ybuf, stats, a.in[13] + layer * DM, a.in[14] + layer * DM, x1b, eidx, gate, ub + (size_t)layer * 16384 * ROWB, vb + (size_t)layer * 16384 * ROWB, isu + layer * 16384, isv + layer * 16384, a.in[19] + layer * DM, a.in[20] + layer * DM,
                              layer == 0 ? x2 : a.out, layer == 0 ? x2b : (bf16_t*)nullptr, (LDSA float*)lds, bid, G, tid);
            SEAM(pb + 8);
        }
        }
    { constexpr int layer = 1;
        const int pb = 1 + 10 * layer;
        if (IN(pb + 0)) {
            PH_TID() WSP(bf16_t, xb, WS_XB) WSP(bf16_t, x2b, WS_X2B) WSP(bf16_t, wab, WS_WAB) WSP(bf16_t, wcd, WS_WCD) WSP(bf16_t, hb, WS_HB) WSP(float, cs0, WS_CS0) WSP(float, csa, WS_CSA)
            if (layer == 0) {
                pg8::Gemm g{xb, wab, SEQ, 12288, 4096}; pg8::StaticOrder S; S.init(SEQ, 12288, G, bid);
                pg8::EpiProj<0> E{hb, 12288, cs0, csa, nullptr, nullptr, (LDSA float*)(lds + LDS_MISC + 64)};
                pg8::gemm_phase<pg8::EpiProj<0>, pg8::StaticOrder>(lds, g, S, E, nullptr, tid);
            } else {
                pg8::Gemm g{x2b, wcd, SEQ, 9216, 4096}; pg8::StaticOrder S; S.init(SEQ, 9216, G, bid);
                pg8::EpiProj<1> E{hb, 9216, cs0, csa, a.in[10], a.in[11], (LDSA float*)(lds + LDS_MISC + 64)};
                pg8::gemm_phase<pg8::EpiProj<1>, pg8::StaticOrder>(lds, g, S, E, nullptr, tid);
                { const int nu1 = (SEQ / 256) * (9216 / 256), busy = nu1 % G; const bool slack = busy != 0 && busy <= G / 2;
                  if (slack && bid >= busy) {
                      WSP(unsigned char, vb1, WS_VB) WSP(float, isv1, WS_SV)
                      int t5; { int _z = 0; asm volatile("" : "+s"(_z)); t5 = wid_s * 64 + (int)__builtin_amdgcn_mbcnt_hi(~0u, __builtin_amdgcn_mbcnt_lo(~0u, (unsigned)_z)); }
                      table_fp6(a.in[18] + (size_t)16384 * DM, vb1 + (size_t)16384 * ROWB, isv1 + 16384, 16384, (LDSA float*)lds, bid - busy, G - busy, t5); } }
            }
            SEAM(pb + 0);
        }
        if (IN(pb + 2)) {
            PH_TID() WSP(bf16_t, hb, WS_HB) WSP(bf16_t, abb, WS_AB) WSP(float, oc, WS_OC)
            if (layer == 0) attn0_phase(hb, a.in[2], abb, (bf16_t*)oc, (float*)((unsigned char*)oc + (size_t)3 * 8 * SEQ * 128 * 2), (char*)lds_raw, bid, G, tid);
            else attn1_phase(hb, abb, oc, a.in[5], a.in[6], a.in[7], a.in[8], a.in[9], (char*)lds_raw, bid, G, tid);
            SEAM(pb + 2);
        }
        if (layer == 0) {
            if (IN(pb + 3)) {
                PH_TID() WSP(bf16_t, abb, WS_AB) WSP(float, oc, WS_OC)
                merge0_phase((const bf16_t*)oc, (const float*)((unsigned char*)oc + (size_t)3 * 8 * SEQ * 128 * 2), abb, bid, G, tid);
                SEAM(pb + 3);
            }
        } else {
        }
        if (IN(pb + 4)) {
            const int K = layer == 0 ? 3072 : 4096;
            PH_TID() WSP(bf16_t, abb, WS_AB) WSP(bf16_t, woab, WS_WOAB) WSP(bf16_t, wocd, WS_WOCD) WSP(float, ybuf, WS_Y) WSP(float, x2, WS_X2)
            pg8::Gemm g{abb, layer == 0 ? woab : wocd, SEQ, 4096, K}; pg8::StaticOrder S; S.init(SEQ, 4096, G, bid);
            pg8::EpiF32R E{ybuf, 4096, layer == 0 ? a.in[0] : (const float*)x2, ALPHA};
            pg8::gemm_phase<pg8::EpiF32R, pg8::StaticOrder>(lds, g, S, E, nullptr, tid);
            SEAM(pb + 4);
        }
        if (IN(pb + 5)) {
            PH_TID() WSP(float, ybuf, WS_Y) WSP(float, stats, WS_X1) WSP(bf16_t, x1b, WS_X1B)
            ln_phase(ybuf, a.in[13] + layer * DM, a.in[14] + layer * DM, stats, x1b, bid, G, tid);
            SEAM(pb + 5);
        }
        if (IN(pb + 6)) {
            PH_TID() WSP(bf16_t, x1b, WS_X1B) WSP(bf16_t, wq, WS_WQ) WSP(bf16_t, pqb, WS_PQ)
            pg8::Gemm g{x1b, wq + (size_t)layer * 2048 * 4096, SEQ, 2048, 4096}; pg8::StaticOrder S; S.init(SEQ, 2048, G, bid);
            pg8::EpiBf16P E{pqb, 2048};
            pg8::gemm_phase<pg8::EpiBf16P, pg8::StaticOrder>(lds, g, S, E, nullptr, tid);
            asm volatile("s_waitcnt vmcnt(0)" ::: "memory"); __syncthreads();
            { WSP(bf16_t, keyb, WS_KEYB) WSP(int, eidx, WS_EIDX) WSP(float, gate, WS_GATE)
              int t4 = tid; asm volatile("" : "+v"(t4));
              route_mfma_phase(pqb, keyb + (size_t)layer * 8 * 2 * 128 * 128, eidx, gate, (char*)lds_raw, S, t4); }
            SEAM(pb + 6);
        }
        if (IN(pb + 8)) {
            PH_TID() WSP(float, ybuf, WS_Y) WSP(float, stats, WS_X1) WSP(bf16_t, x1b, WS_X1B) WSP(int, eidx, WS_EIDX) WSP(float, gate, WS_GATE) WSP(unsigned char, ub, WS_UB) WSP(unsigned char, vb, WS_VB) WSP(float, isu, WS_SU) WSP(float, isv, WS_SV) WSP(float, x2, WS_X2) WSP(bf16_t, x2b, WS_X2B)
            peer_expert_phase(ybuf, stats, a.in[13] + layer * DM, a.in[14] + layer * DM, x1b, eidx, gate, ub + (size_t)layer * 16384 * ROWB, vb + (size_t)layer * 16384 * ROWB, isu + layer * 16384, isv + layer * 16384, a.in[19] + layer * DM, a.in[20] + layer * DM,
                              layer == 0 ? x2 : a.out, layer == 0 ? x2b : (bf16_t*)nullptr, (LDSA float*)lds, bid, G, tid);
            SEAM(pb + 8);
        }
        }

#undef IN
}
#ifndef ONE_LAUNCH
#define ONE_LAUNCH 1
#endif
extern "C" void kernel_launch(void* const* d_in, const int* in_sizes, int n_in, void* d_out, int out_size, void* d_ws, size_t ws_size, hipStream_t stream) {
    static int ready = 0;
    if (!ready) {
        if (ws_size < WS_END) { fprintf(stderr, "kernel_launch: workspace too small: %zu < %zu\n", ws_size, (size_t)WS_END); return; }
        if (hipFuncSetAttribute((const void*)mega, hipFuncAttributeMaxDynamicSharedMemorySize, LDS_BYTES) != hipSuccess) { fprintf(stderr, "kernel_launch: hipFuncSetAttribute failed\n"); return; }
        int per_cu = 0;
        if (hipOccupancyMaxActiveBlocksPerMultiprocessor(&per_cu, (const void*)mega, 512, LDS_BYTES) != hipSuccess || per_cu < 1) fprintf(stderr, "kernel_launch: note: occupancy query reports %d blocks per CU\n", per_cu);
        (void)hipGetLastError();
        ready = 1;
    }
    unsigned char* ws = (unsigned char*)d_ws;
    (void)hipMemsetAsync(ws + WS_CTL, 0, CTL_BYTES, stream);
    MK a{}; for (int i = 0; i < 21; ++i) a.in[i] = (const float*)d_in[i];
    a.out = (float*)d_out; a.ws = ws;
#if ONE_LAUNCH
    a.ph_lo = 0; a.ph_hi = N_PHASES;
    hipLaunchKernelGGL(mega, dim3(256), dim3(512), LDS_BYTES, stream, a);
#else
    for (int k = 0; k < N_PHASES; ++k) { if (k == 10 || k == 2 || k == 12 || k == 14 || k == 8 || k == 18) continue; a.ph_lo = k; a.ph_hi = k + 1; hipLaunchKernelGGL(mega, dim3(256), dim3(512), LDS_BYTES, stream, a); }
#endif
    const hipError_t le = hipPeekAtLastError();
    if (le != hipSuccess) fprintf(stderr, "kernel_launch: launch failed: %s\n", hipGetErrorName(le));
}
```

```cpp
#include <hip/hip_runtime.h>
#include <stdint.h>
#include <cstdio>

#define SEQ 8192
#define DM 4096
#define HD 128
#define ALPHA 1.4142135623730951f
#define LAMBDA_INIT 0.35550906759096934f
#define ATT_SCALE 0.088388347648318440f

__device__ const double REV_P[16] = {0.15915494309189535, 0.0700865215877985, 0.03086376340470123, 0.013591370636193905, 0.005985185712713705, 0.002635675898667414, 0.001160663641240061, 0.0005111175045375439, 0.00022507907903927653, 9.911730936901935e-05, 4.364795279280289e-05, 1.9221100684944863e-05, 8.464330808241401e-06, 3.727408601915352e-06, 1.6414262627950345e-06, 7.228293068832865e-07};
__device__ const double REV_A[32] = {0.15915494309189535, 0.11934937021124886, 0.08949940160889101, 0.06711508300522726, 0.050329212104487035, 0.03774158471741977, 0.0283021958306234, 0.02122365276477766, 0.015915494309189534, 0.011934937021124886, 0.008949940160889102, 0.006711508300522725, 0.005032921210448704, 0.003774158471741977, 0.00283021958306234, 0.0021223652764777662, 0.0015915494309189536, 0.0011934937021124885, 0.0008949940160889102, 0.0006711508300522726, 0.0005032921210448703, 0.00037741584717419774, 0.00028302195830623395, 0.0002122365276477766, 0.00015915494309189535, 0.00011934937021124886, 8.949940160889102e-05, 6.711508300522725e-05, 5.0329212104487035e-05, 3.774158471741978e-05, 2.8302195830623396e-05, 2.122365276477766e-05};

__device__ __forceinline__ void sincos_rev(double rev, float& s, float& c) {
    const double f = rev - floor(rev); const float ff = (float)f;
    s = __builtin_amdgcn_sinf(ff); c = __builtin_amdgcn_cosf(ff);
}
__device__ __forceinline__ float wave_sum(float v) {
#pragma unroll
    for (int o = 32; o >= 1; o >>= 1) v += __shfl_xor(v, o);
    return v;
}
__device__ __forceinline__ float wave_max(float v) {
#pragma unroll
    for (int o = 32; o >= 1; o >>= 1) v = fmaxf(v, __shfl_xor(v, o));
    return v;
}
namespace pg8 {
#define PG8_LAS __attribute__((address_space(3)))
typedef unsigned short bf16_t;
typedef short bf16x8 __attribute__((ext_vector_type(8)));
typedef float f32x4 __attribute__((ext_vector_type(4)));
typedef unsigned u32x4 __attribute__((ext_vector_type(4)));
constexpr int BM = 256, BK = 64, HALF = 128, HTB = HALF * BK * 2  , STAGE_BYTES = 8 * HTB, NXCD = 8, WGM = 8;

__host__ __device__ __forceinline__ int lds_byte(int r, int c) { const int st = (r >> 4) * 2 + (c >> 5), rr = r & 15, cc = c & 31, ob = rr * 64 + cc * 2; return st * 1024 + (ob ^ (((ob >> 9) & 1) << 5)); }
__host__ __device__ __forceinline__ void stage_rc(int b, int& R, int& C) { const int st = b / 1024, sb = b % 1024, swz = sb ^ (((sb >> 9) & 1) << 5); R = (st >> 1) * 16 + swz / 64; C = (st & 1) * 32 + (swz % 64) / 2; }
__host__ __device__ __forceinline__ int perm32(int rho) { const int n = rho >> 4, i = rho & 15; return 8 * (i >> 2) + 4 * n + (i & 3); }

struct Unit { int pm, pn; };
struct Gemm { const bf16_t* A; const bf16_t* Bt; int M, N, K; };

struct StaticOrder {
    int nM, nN, nwg, G, c;
    __host__ __device__ void init(int M, int N, int G_, int c_) { nM = M / BM; nN = N / BM; nwg = nM * nN; G = G_; c = c_; }
    __host__ __device__ bool next(int i, Unit& u) const {
        const long L = (long)i * G + c; if (L >= nwg) return false;
        int wgid = (int)L; { const int q = nwg / NXCD, r = nwg % NXCD, xcd = wgid % NXCD, off = wgid / NXCD; wgid = (xcd < r ? xcd * (q + 1) : r * (q + 1) + (xcd - r) * q) + off; }
        const int nig = WGM * nN, gid = wgid / nig, fm = gid * WGM, gsz = (nM - fm) < WGM ? (nM - fm) : WGM;
        u.pm = fm + ((wgid % nig) % gsz); u.pn = (wgid % nig) / gsz; return true;
    }
    __device__ __forceinline__ void a_ready(const Unit&) const {}
    __device__ __forceinline__ void done(const Unit&) const {}
};
__device__ __forceinline__ unsigned cvt_pk_bf16(float lo, float hi) { unsigned r; asm volatile("v_cvt_pk_bf16_f32 %0, %1, %2" : "=v"(r) : "v"(lo), "v"(hi)); return r; }
typedef float f32x2 __attribute__((ext_vector_type(2)));
template <class Epi, class Sched, bool STAMP = false>
__device__ __forceinline__ void gemm_phase(PG8_LAS unsigned char* lds, const Gemm g, const Sched& S, const Epi& E, unsigned long long* stamps, const int tid_in) {
    const int tid = tid_in, wid = __builtin_amdgcn_readfirstlane(tid >> 6), lane = tid & 63, wr = wid >> 2, wc = wid & 3, fr = lane & 15, fq = lane >> 4;
    const int K = g.K, nt = K / BK;
    int ts_lo = 0, ts_hi = 0, nts = 0; const unsigned long long rt_entry = STAMP ? (unsigned long long)wall_clock64() : 0ull;
#define PG8_STAMP() do { if (STAMP && wid == 0 && nts < 64) { const unsigned long long _c = (unsigned long long)clock64(); \
        ts_lo = (lane == nts) ? (int)(unsigned)_c : ts_lo; ts_hi = (lane == nts) ? (int)(unsigned)(_c >> 32) : ts_hi; ++nts; } } while (0)
    PG8_STAMP();
    unsigned voffA[2], voffB[2];
#pragma unroll
    for (int i = 0; i < 2; ++i) { int R, C; stage_rc(tid * 16 + i * 8192, R, C); const int Rb = Epi::PERM ? ((R & ~31) + perm32(R & 31)) : R;
        voffA[i] = (unsigned)(R * K + C) * 2u; voffB[i] = (unsigned)(Rb * K + C) * 2u; }
    const size_t kstep = (size_t)(BK * 2);
    const size_t hstep = (size_t)HALF * K * 2;
    const size_t tstep = 2 * hstep;
    const unsigned ldsw = (unsigned)wid * 1024u;
    const int aoff = lds_byte(wr * 64 + fr, fq * 8), boff = lds_byte(wc * 32 + fr, fq * 8);
#define PG8_SA(b, h) (((b) * 2 + (h)) * HTB)
#define PG8_SB(b, h) ((4 + (b) * 2 + (h)) * HTB)
#define PG8_STAGE(bufoff, gbase, voff) do { _Pragma("unroll") for (int _i = 0; _i < 2; ++_i) \
        __builtin_amdgcn_global_load_lds((const unsigned*)((const char*)(gbase) + (voff)[_i]), (PG8_LAS unsigned*)(lds + (bufoff) + ldsw + _i * 8192), 16, 0, 0); } while (0)
#define PG8_LDA(dst, b, h) do { _Pragma("unroll") for (int m = 0; m < 4; ++m) _Pragma("unroll") for (int k = 0; k < 2; ++k) dst[m][k] = *(const PG8_LAS bf16x8*)(lds + PG8_SA(b, h) + aoff + m * 2048 + k * 1024); } while (0)
#define PG8_LDB(dst, b, h) do { _Pragma("unroll") for (int n = 0; n < 2; ++n) _Pragma("unroll") for (int k = 0; k < 2; ++k) dst[n][k] = *(const PG8_LAS bf16x8*)(lds + PG8_SB(b, h) + boff + n * 2048 + k * 1024); } while (0)
#define PG8_MMA(ai, bj, At, Bt) do { __builtin_amdgcn_s_setprio(1); _Pragma("unroll") for (int m = 0; m < 4; ++m) _Pragma("unroll") for (int n = 0; n < 2; ++n) _Pragma("unroll") for (int k = 0; k < 2; ++k) \
        acc[ai][bj][m][n] = __builtin_amdgcn_mfma_f32_16x16x32_bf16(Bt[n][k], At[m][k], acc[ai][bj][m][n], 0, 0, 0); __builtin_amdgcn_s_setprio(0); } while (0)
#define PG8_WAIT_V(n) asm volatile("s_waitcnt vmcnt(" #n ")" ::: "memory")
#define PG8_WAIT_L(n) asm volatile("s_waitcnt lgkmcnt(" #n ")" ::: "memory")
#define PG8_BAR __builtin_amdgcn_s_barrier()
#define PG8_SCHED __builtin_amdgcn_sched_barrier(0)
    Unit cur, nxt; int ui = 0;
    if (!S.next(0, cur)) return;
    f32x4 acc[2][2][4][2];
#pragma unroll
    for (int a = 0; a < 2; ++a)
#pragma unroll
        for (int b = 0; b < 2; ++b)
#pragma unroll
            for (int m = 0; m < 4; ++m)
#pragma unroll
                for (int n = 0; n < 2; ++n) acc[a][b][m][n] = (f32x4){0.f, 0.f, 0.f, 0.f};
    bf16x8 At[4][2], B0[2][2], B1[2][2];
    const char* cA = (const char*)g.A + (size_t)cur.pm * tstep; const char* cB = (const char*)g.Bt + (size_t)cur.pn * tstep;
    S.a_ready(cur);
    PG8_STAGE(PG8_SB(0, 0), cB, voffB); PG8_STAGE(PG8_SA(0, 0), cA, voffA); PG8_STAGE(PG8_SB(0, 1), cB + hstep, voffB); PG8_STAGE(PG8_SA(0, 1), cA + hstep, voffA);
    if (wr == 1) PG8_BAR;
    PG8_WAIT_V(4); PG8_BAR;
    PG8_STAGE(PG8_SB(1, 0), cB + kstep, voffB); PG8_STAGE(PG8_SA(1, 0), cA + kstep, voffA); PG8_STAGE(PG8_SB(1, 1), cB + hstep + kstep, voffB);
    PG8_WAIT_V(6); PG8_BAR;
    PG8_STAMP();
    for (;;) {
        const bool has_next = S.next(ui + 1, nxt);
        const char* nA = has_next ? (const char*)g.A + (size_t)nxt.pm * tstep : cA; const char* nB = has_next ? (const char*)g.Bt + (size_t)nxt.pn * tstep : cB;
        for (int t = 0; t < nt; t += 2) {
            const bool last = (t == nt - 2);
            const char* a1 = cA + (size_t)(t + 1) * kstep;
            const char* a2 = last ? nA : cA + (size_t)(t + 2) * kstep; const char* b2 = last ? nB : cB + (size_t)(t + 2) * kstep;
            const char* a3 = a2 + kstep; const char* b3 = b2 + kstep;
            if (last && has_next) S.a_ready(nxt);
            PG8_LDB(B0, 0, 0); PG8_SCHED; PG8_LDA(At, 0, 0); PG8_STAGE(PG8_SA(1, 1), a1 + hstep, voffA);
            PG8_WAIT_L(8); PG8_BAR; PG8_WAIT_L(0); PG8_MMA(0, 0, At, B0); PG8_BAR; PG8_SCHED;
            PG8_LDB(B1, 0, 1); PG8_STAGE(PG8_SB(0, 0), b2, voffB);
            PG8_BAR; PG8_WAIT_L(0); PG8_MMA(0, 1, At, B1); PG8_BAR;
            PG8_LDA(At, 0, 1); PG8_STAGE(PG8_SA(0, 0), a2, voffA);
            PG8_BAR; PG8_WAIT_L(0); PG8_MMA(1, 0, At, B0); PG8_BAR; PG8_SCHED;
            PG8_STAGE(PG8_SB(0, 1), b2 + hstep, voffB);
            PG8_WAIT_V(6); PG8_BAR; PG8_MMA(1, 1, At, B1); PG8_BAR;
            PG8_LDB(B0, 1, 0); PG8_SCHED; PG8_LDA(At, 1, 0); PG8_STAGE(PG8_SA(0, 1), a2 + hstep, voffA);
            PG8_WAIT_L(8); PG8_BAR; PG8_WAIT_L(0); PG8_MMA(0, 0, At, B0); PG8_BAR; PG8_SCHED;
            PG8_LDB(B1, 1, 1); PG8_STAGE(PG8_SB(1, 0), b3, voffB);
            PG8_BAR; PG8_WAIT_L(0); PG8_MMA(0, 1, At, B1); PG8_BAR;
            PG8_LDA(At, 1, 1); PG8_STAGE(PG8_SA(1, 0), a3, voffA);
            PG8_BAR; PG8_WAIT_L(0); PG8_MMA(1, 0, At, B0); PG8_BAR; PG8_SCHED;
            PG8_STAGE(PG8_SB(1, 1), b3 + hstep, voffB);
            PG8_WAIT_V(6); PG8_BAR; PG8_MMA(1, 1, At, B1); PG8_BAR;
        }
        PG8_STAMP();
        if constexpr (!Epi::AFTER_DRAIN) { E(acc, cur, wr, wc, fr, fq); S.done(cur); }
        PG8_STAMP();
        if (!has_next) break;
#pragma unroll
        for (int a = 0; a < 2; ++a)
#pragma unroll
            for (int b = 0; b < 2; ++b)
#pragma unroll
                for (int m = 0; m < 4; ++m)
#pragma unroll
                    for (int n = 0; n < 2; ++n) acc[a][b][m][n] = (f32x4){0.f, 0.f, 0.f, 0.f};
        cur = nxt; cA = nA; cB = nB; ++ui;
    }
    PG8_WAIT_V(0);
    if (wr == 0) PG8_BAR;
    PG8_BAR;
    if constexpr (Epi::AFTER_DRAIN) { E.fused(acc, cur, wr, wc, fr, fq, lds, wid, lane); S.done(cur); }
    PG8_STAMP();
    if (STAMP && wid == 0) { stamps[lane] = lane < nts ? (((unsigned long long)(unsigned)ts_hi << 32) | (unsigned)ts_lo) : 0ull;
        if (lane == 62) stamps[62] = rt_entry; if (lane == 63) stamps[63] = (unsigned long long)wall_clock64(); }
#undef PG8_STAMP
#undef PG8_SA
#undef PG8_SB
#undef PG8_STAGE
#undef PG8_LDA
#undef PG8_LDB
#undef PG8_MMA
#undef PG8_WAIT_V
#undef PG8_WAIT_L
#undef PG8_BAR
#undef PG8_SCHED
}
}
#define XB_TMO      128
#define XB_XCNT(j)  (256  + 64 * (j))
#define XB_XSUB(j)  (1280 + 64 * (j))
#define XB_XGEN(j)  (2304 + 64 * (j))
#define XB_TOP      3328
#define XB_TOPGEN   3392
#define XCD_BAR_WORDS 3456
#define XB_SPIN_CAP (1u << 22)
#define LAS __attribute__((address_space(3)))

__device__ __forceinline__ unsigned xb_ld(unsigned* p)              { return __hip_atomic_load(p, __ATOMIC_RELAXED, __HIP_MEMORY_SCOPE_AGENT); }
__device__ __forceinline__ unsigned xb_add(unsigned* p, unsigned v) { return __hip_atomic_fetch_add(p, v, __ATOMIC_RELAXED, __HIP_MEMORY_SCOPE_AGENT); }
__device__ __forceinline__ unsigned xb_xcc_id() { return (unsigned)__builtin_amdgcn_s_getreg((3 << 11) | 20) & 0xFu; }
#define XB_SPIN(cond, bar) do { unsigned _sp = 0; while (cond) { __builtin_amdgcn_s_sleep(1); \
    if ((++_sp & 255u) == 0u) { if (xb_ld(&(bar)[XB_TMO])) break; if (_sp > XB_SPIN_CAP) { atomicAdd(&(bar)[XB_TMO], 1u); break; } } } } while (0)

struct XcdBarrier {
    unsigned* bar; unsigned x;
    volatile LAS unsigned* st;
};

__device__ __forceinline__ XcdBarrier xcd_barrier_post(unsigned* bar, volatile LAS unsigned* st, const int tid) {
    XcdBarrier b; b.bar = bar; b.x = xb_xcc_id(); b.st = st;
    if (tid == 0) (void)xb_add(&bar[XB_XCNT(b.x)], 1u);
    return b;
}
__device__ __forceinline__ void xcd_barrier_complete(unsigned* bar, unsigned x, unsigned& nloc, unsigned& nx) {
    const unsigned G = gridDim.x * gridDim.y * gridDim.z;
    unsigned sum, cnt, mine, sp = 0u;
    for (;;) {
        sum = 0u; cnt = 0u; mine = 0u;
#pragma unroll
        for (unsigned j = 0; j < 16; ++j) { const unsigned c = xb_ld(&bar[XB_XCNT(j)]); sum += c; cnt += (c > 0u) ? 1u : 0u; mine = (j == x) ? c : mine; }
        if (sum == G) break;
        __builtin_amdgcn_s_sleep(1);
        if ((++sp & 255u) == 0u) { if (xb_ld(&bar[XB_TMO])) break; if (sp > XB_SPIN_CAP) { atomicAdd(&bar[XB_TMO], 1u); break; } }
    }
    nloc = mine > 0u ? mine : 1u; nx = cnt > 0u ? cnt : 1u;
}

__device__ __forceinline__ void xcd_barrier(const XcdBarrier& b, const int tid) {
    asm volatile("s_waitcnt vmcnt(0)" ::: "memory");
    __syncthreads();
    if (tid == 0) {
        unsigned* bar = b.bar;
        __builtin_amdgcn_s_waitcnt(0);
        unsigned nloc = b.st[0], nx = b.st[1];
        if (nloc == 0u) { xcd_barrier_complete(bar, b.x, nloc, nx); b.st[0] = nloc; b.st[1] = nx; }
        const unsigned old = xb_add(&bar[XB_XSUB(b.x)], 1u);
        const unsigned gen = old / nloc;
        if (old + 1u == (gen + 1u) * nloc) {
            __builtin_amdgcn_fence(__ATOMIC_RELEASE, "agent");
            asm volatile("s_waitcnt vmcnt(0)" ::: "memory");
            const unsigned og = xb_add(&bar[XB_TOP], 1u);
            const unsigned tg = og / nx;
            if (og + 1u == (tg + 1u) * nx) xb_add(&bar[XB_TOPGEN], 1u);
            else XB_SPIN(xb_ld(&bar[XB_TOPGEN]) == tg, bar);
            __builtin_amdgcn_fence(__ATOMIC_ACQUIRE, "agent");
            xb_add(&bar[XB_XGEN(b.x)], 1u);
            asm volatile("s_waitcnt vmcnt(0)" ::: "memory");
        } else {
            XB_SPIN(xb_ld(&bar[XB_XGEN(b.x)]) == gen, bar);
            __builtin_amdgcn_fence(__ATOMIC_ACQUIRE, "agent");
            asm volatile("s_waitcnt vmcnt(0)" ::: "memory");
        }
    }
    __syncthreads();
}
namespace att {
using bf16 = unsigned short;
constexpr int   D = 128, NW = 8, QBLK = 32, KVBLK = 64;
constexpr float SCALE = 0.088388347648318440f;
constexpr float THR = 8.f;
constexpr int SDEPTH = 1;
constexpr size_t SHM_V = KVBLK * D * 2, SHM_K = KVBLK * D * 2, SHM_ATTN = 2 * SHM_V + 2 * SHM_K + NW * 64 * 4;
using bf16x8 = __attribute__((ext_vector_type(8))) short;
using s16x4  = __attribute__((ext_vector_type(4))) short;
using f32x16 = __attribute__((ext_vector_type(16))) float;
using f32x8  = __attribute__((ext_vector_type(8))) float;
using u32x4  = __attribute__((ext_vector_type(4))) unsigned;
#define KSWZ(row, colB) ((row) * 256 + ((colB) ^ (((row) & 7) << 4)))
#define SBAR() __builtin_amdgcn_sched_barrier(0)
__device__ __forceinline__ int crow(int r, int hi) { return (r & 3) + 8 * (r >> 2) + 4 * hi; }
__device__ __forceinline__ unsigned cvtpk(float lo, float hi) {
  unsigned r; asm volatile("v_cvt_pk_bf16_f32 %0, %1, %2" : "=v"(r) : "v"(lo), "v"(hi)); return r;
}
template <typename TIn> struct Stage;
template <> struct Stage<bf16>  { using T = bf16x8;
  __device__ static __forceinline__ T ld8(const bf16* p) { return *reinterpret_cast<const bf16x8*>(p); }
  __device__ static __forceinline__ bf16x8 tobf(T x) { return x; } };
template <> struct Stage<float> { using T = f32x8;
  __device__ static __forceinline__ T ld8(const float* p) { return *reinterpret_cast<const f32x8*>(p); }
  __device__ static __forceinline__ bf16x8 tobf(T x) {
    u32x4 w = {cvtpk(x[0], x[1]), cvtpk(x[2], x[3]), cvtpk(x[4], x[5]), cvtpk(x[6], x[7])}; return *reinterpret_cast<bf16x8*>(&w); } };

__device__ __forceinline__ void partialSM(f32x16& p0, f32x16& p1, float& m_reg, float& mn, float& alpha) {
  constexpr float C = SCALE * 1.4426950408889634f;
  float pmax = p0[0]; for (int r = 1; r < 16; ++r) pmax = fmaxf(pmax, p0[r]); for (int r = 0; r < 16; ++r) pmax = fmaxf(pmax, p1[r]);
  { auto rr = __builtin_amdgcn_permlane32_swap(__float_as_uint(pmax), __float_as_uint(pmax), false, false);
    pmax = fmaxf(__uint_as_float(rr[0]), __uint_as_float(rr[1])); }
  if (__builtin_expect(__all(pmax - m_reg <= THR / SCALE), 1)) { mn = m_reg; alpha = 1.f; }
  else { mn = fmaxf(m_reg, pmax); alpha = __builtin_amdgcn_exp2f((m_reg - mn) * C); m_reg = mn; }
  float mnC = -mn * C;
  for (int r = 0; r < 16; ++r) p0[r] = fmaf(p0[r], C, mnC); for (int r = 0; r < 16; ++r) p1[r] = fmaf(p1[r], C, mnC);
  for (int r = 0; r < 16; ++r) p0[r] = __builtin_amdgcn_exp2f(p0[r]);
}
__device__ __forceinline__ void finishSM(f32x16& p0, f32x16& p1, float alpha, float& l_reg, bf16x8& pa0, bf16x8& pa1, bf16x8& pa2, bf16x8& pa3) {
  for (int r = 0; r < 16; ++r) p1[r] = __builtin_amdgcn_exp2f(p1[r]);
  float ps = 0; for (int r = 0; r < 16; ++r) ps += p0[r]; for (int r = 0; r < 16; ++r) ps += p1[r];
  { auto rr = __builtin_amdgcn_permlane32_swap(__float_as_uint(ps), __float_as_uint(ps), false, false);
    ps = __uint_as_float(rr[0]) + __uint_as_float(rr[1]); }
  l_reg = l_reg * alpha + ps;
#define PK4(P, BASE, OUT) do { unsigned a0 = cvtpk(P[BASE + 0], P[BASE + 1]), a1 = cvtpk(P[BASE + 2], P[BASE + 3]);   \
    unsigned b0 = cvtpk(P[BASE + 4], P[BASE + 5]), b1 = cvtpk(P[BASE + 6], P[BASE + 7]);                              \
    auto r0 = __builtin_amdgcn_permlane32_swap(a0, b0, false, false); auto r1 = __builtin_amdgcn_permlane32_swap(a1, b1, false, false); \
    u32x4 w = {r0[0], r1[0], r0[1], r1[1]}; OUT = *reinterpret_cast<bf16x8*>(&w); } while (0)
  PK4(p0, 0, pa0); PK4(p0, 8, pa1); PK4(p1, 0, pa2); PK4(p1, 8, pa3);
#undef PK4
}
__device__ __forceinline__ void qkt(f32x16& p0, f32x16& p1, const bf16* Ks, const bf16x8* qr, int r32, int hi) {
  p0 = f32x16{}; p1 = f32x16{};
  bf16x8 c0 = *reinterpret_cast<const bf16x8*>((const char*)Ks + KSWZ(r32, (hi * 8) * 2)), c1 = *reinterpret_cast<const bf16x8*>((const char*)Ks + KSWZ(32 + r32, (hi * 8) * 2));
#pragma unroll
  for (int d0 = 0; d0 < 8; ++d0) {
    bf16x8 n0 = c0, n1 = c1;
    if (d0 < 7) { const int cb = ((d0 + 1) * 16 + hi * 8) * 2;
      n0 = *reinterpret_cast<const bf16x8*>((const char*)Ks + KSWZ(r32, cb)); n1 = *reinterpret_cast<const bf16x8*>((const char*)Ks + KSWZ(32 + r32, cb)); }
    p0 = __builtin_amdgcn_mfma_f32_32x32x16_bf16(c0, qr[d0], p0, 0, 0, 0);
    p1 = __builtin_amdgcn_mfma_f32_32x32x16_bf16(c1, qr[d0], p1, 0, 0, 0);
    c0 = n0; c1 = n1; }
}
template <int OFF> __device__ __forceinline__ bf16x8 k_read(const int addr) {
  bf16x8 r; asm volatile("ds_read_b128 %0, %1 offset:%2" : "=&v"(r) : "v"(addr), "i"(OFF) : "memory"); return r;
}
template <int D0> __device__ __forceinline__ void qkt_step(f32x16& p0, f32x16& p1, const int (&a)[4], const bf16x8* qr, bf16x8 c0, bf16x8 c1) {
  bf16x8 n0 = c0, n1 = c1;
  if constexpr (D0 < 7) { n0 = k_read<((D0 + 1) >> 2) * 128>(a[(D0 + 1) & 3]); n1 = k_read<((D0 + 1) >> 2) * 128 + 8192>(a[(D0 + 1) & 3]); asm volatile("s_waitcnt lgkmcnt(2)" ::: "memory"); }
  else asm volatile("s_waitcnt lgkmcnt(0)" ::: "memory");
  SBAR();
  p0 = __builtin_amdgcn_mfma_f32_32x32x16_bf16(c0, qr[D0], p0, 0, 0, 0);
  p1 = __builtin_amdgcn_mfma_f32_32x32x16_bf16(c1, qr[D0], p1, 0, 0, 0);
  if constexpr (D0 < 7) qkt_step<D0 + 1>(p0, p1, a, qr, n0, n1);
}
__device__ __forceinline__ void qkt_pipe(f32x16& p0, f32x16& p1, const int ka, const bf16x8* qr, const int r32, const int hi) {
  p0 = f32x16{}; p1 = f32x16{};
  int a[4];
#pragma unroll
  for (int q = 0; q < 4; ++q) a[q] = ka + r32 * 256 + ((q * 32 + hi * 16) ^ ((r32 & 7) << 4));
  const bf16x8 c0 = k_read<0>(a[0]), c1 = k_read<8192>(a[0]);
  qkt_step<0>(p0, p1, a, qr, c0, c1);
}
__device__ __forceinline__ int v_st(int k, int c) { const int kk = (k & ~0xC) | ((k & 4) << 1) | ((k & 8) >> 1); return ((kk >> 3) * 4 + (c >> 5)) * 512 + ((kk & 7) * 32 + (c & 31)) * 2; }
__device__ __forceinline__ int v_rd_base(int lane) { return ((lane & 3) << 3) | (((lane >> 2) & 3) << 6) | (((lane >> 4) & 1) << 5) | (((lane >> 5) & 1) << 8); }
constexpr int v_rd_off(int d0, int ks, int half) { return d0 * 512 + ks * 4096 + half * 2048; }
template <int OFF> __device__ __forceinline__ s16x4 tr_read(int vb) {
  s16x4 r; asm volatile("ds_read_b64_tr_b16 %0, %1 offset:%2" : "=&v"(r) : "v"(vb), "i"(OFF) : "memory"); return r;
}
template <int D0> __device__ __forceinline__ void pv_one(f32x16& od, int vb, bf16x8 pa0, bf16x8 pa1, bf16x8 pa2, bf16x8 pa3) {
  const s16x4 l0 = tr_read<v_rd_off(D0, 0, 0)>(vb), h0 = tr_read<v_rd_off(D0, 0, 1)>(vb), l1 = tr_read<v_rd_off(D0, 1, 0)>(vb), h1 = tr_read<v_rd_off(D0, 1, 1)>(vb);
  const s16x4 l2 = tr_read<v_rd_off(D0, 2, 0)>(vb), h2 = tr_read<v_rd_off(D0, 2, 1)>(vb), l3 = tr_read<v_rd_off(D0, 3, 0)>(vb), h3 = tr_read<v_rd_off(D0, 3, 1)>(vb);
  asm volatile("s_waitcnt lgkmcnt(0)" ::: "memory"); SBAR();
#define PK(L, H) (bf16x8){L[0], L[1], L[2], L[3], H[0], H[1], H[2], H[3]}
  od = __builtin_amdgcn_mfma_f32_32x32x16_bf16(pa0, PK(l0, h0), od, 0, 0, 0);
  od = __builtin_amdgcn_mfma_f32_32x32x16_bf16(pa1, PK(l1, h1), od, 0, 0, 0);
  od = __builtin_amdgcn_mfma_f32_32x32x16_bf16(pa2, PK(l2, h2), od, 0, 0, 0);
  od = __builtin_amdgcn_mfma_f32_32x32x16_bf16(pa3, PK(l3, h3), od, 0, 0, 0);
#undef PK
}
__device__ __forceinline__ void pv_d0(f32x16* o, int vb, bf16x8 pa0, bf16x8 pa1, bf16x8 pa2, bf16x8 pa3) {
  pv_one<0>(o[0], vb, pa0, pa1, pa2, pa3); pv_one<1>(o[1], vb, pa0, pa1, pa2, pa3); pv_one<2>(o[2], vb, pa0, pa1, pa2, pa3); pv_one<3>(o[3], vb, pa0, pa1, pa2, pa3);
}

template <int B> __device__ __forceinline__ void pv_rd8(s16x4 (&f)[8], const int vb) {
  constexpr int D0 = B & 3, HB = (B >> 2) * 16384;
  f[0] = tr_read<HB + v_rd_off(D0, 0, 0)>(vb); f[1] = tr_read<HB + v_rd_off(D0, 0, 1)>(vb); f[2] = tr_read<HB + v_rd_off(D0, 1, 0)>(vb); f[3] = tr_read<HB + v_rd_off(D0, 1, 1)>(vb);
  f[4] = tr_read<HB + v_rd_off(D0, 2, 0)>(vb); f[5] = tr_read<HB + v_rd_off(D0, 2, 1)>(vb); f[6] = tr_read<HB + v_rd_off(D0, 3, 0)>(vb); f[7] = tr_read<HB + v_rd_off(D0, 3, 1)>(vb);
}
__device__ __forceinline__ void pv_mma4(f32x16& od, const s16x4 (&f)[8], bf16x8 pa0, bf16x8 pa1, bf16x8 pa2, bf16x8 pa3) {
#define PK(L, H) (bf16x8){L[0], L[1], L[2], L[3], H[0], H[1], H[2], H[3]}
  od = __builtin_amdgcn_mfma_f32_32x32x16_bf16(pa0, PK(f[0], f[1]), od, 0, 0, 0);
  od = __builtin_amdgcn_mfma_f32_32x32x16_bf16(pa1, PK(f[2], f[3]), od, 0, 0, 0);
  od = __builtin_amdgcn_mfma_f32_32x32x16_bf16(pa2, PK(f[4], f[5]), od, 0, 0, 0);
  od = __builtin_amdgcn_mfma_f32_32x32x16_bf16(pa3, PK(f[6], f[7]), od, 0, 0, 0);
#undef PK
}
template <int B, int NB> __device__ __forceinline__ void pv_pipe_step(f32x16* o, s16x4 (&cur)[8], s16x4 (&nxt)[8], const int vb, bf16x8 pa0, bf16x8 pa1, bf16x8 pa2, bf16x8 pa3) {
  if constexpr (B + 1 < NB) { pv_rd8<B + 1>(nxt, vb); asm volatile("s_waitcnt lgkmcnt(8)" ::: "memory"); }
  else asm volatile("s_waitcnt lgkmcnt(0)" ::: "memory");
  SBAR();
  pv_mma4(o[B], cur, pa0, pa1, pa2, pa3);
  if constexpr (B + 1 < NB) pv_pipe_step<B + 1, NB>(o, nxt, cur, vb, pa0, pa1, pa2, pa3);
}
template <int NB> __device__ __forceinline__ void pv_pipe(f32x16* o, const int vb, bf16x8 pa0, bf16x8 pa1, bf16x8 pa2, bf16x8 pa3) {
  s16x4 fa[8], fb[8];
  pv_rd8<0>(fa, vb);
  pv_pipe_step<0, NB>(o, fa, fb, vb, pa0, pa1, pa2, pa3);
}

template <typename TQ, int LDQ, int LDK, int LDO, typename TO>
__device__ __forceinline__ void attn_dense_body(const TQ* __restrict__ Qb, const bf16* __restrict__ Kh, const bf16* __restrict__ Vh,
                                                TO* __restrict__ Ob, int seq, char* lds, const int tid_in) {
  using St = Stage<bf16>; using SQ = Stage<TQ>;
  const int tid = tid_in, wid = tid >> 6, lane = tid & 63, r32 = lane & 31, hi = lane >> 5;
  bf16* V_lds = (bf16*)lds; bf16* K_lds = (bf16*)(lds + 2 * SHM_V);
  float* ws = (float*)(lds + 2 * SHM_V + 2 * SHM_K) + wid * 64; float* li_l = ws; float* al_l = ws + 32;
  float m_reg = -1e30f, l_reg = 0; f32x16 o[4] = {}; bf16x8 qr[8];
  const TQ* Qw = Qb + ((wid * QBLK + r32) * LDQ + hi * 8);
#pragma unroll
  for (int d0 = 0; d0 < 8; ++d0) qr[d0] = SQ::tobf(SQ::ld8(Qw + d0 * 16));
  const int sr = tid >> 4, sc = (tid & 15) * 8, vst0 = v_st(sr, sc), vst1 = v_st(32 + sr, sc);
  const int vb0 = (int)(uintptr_t)V_lds + v_rd_base(lane);
  struct { typename St::T vs0, vs1, ks0, ks1; } sr_[SDEPTH];
#define SLOAD(i, k0) do { sr_[i].vs0 = St::ld8(Vh + (((k0) + sr) * LDK + sc)); sr_[i].vs1 = St::ld8(Vh + (((k0) + 32 + sr) * LDK + sc)); \
    sr_[i].ks0 = St::ld8(Kh + (((k0) + sr) * LDK + sc)); sr_[i].ks1 = St::ld8(Kh + (((k0) + 32 + sr) * LDK + sc)); } while (0)
#define SWRITE(b, i) do { *(bf16x8*)((char*)V_lds + (b) * SHM_V + vst0) = St::tobf(sr_[i].vs0);          \
    *(bf16x8*)((char*)V_lds + (b) * SHM_V + vst1) = St::tobf(sr_[i].vs1); int kc = sc * 2;               \
    *(bf16x8*)((char*)K_lds + (b) * SHM_K + KSWZ(sr, kc)) = St::tobf(sr_[i].ks0);                       \
    *(bf16x8*)((char*)K_lds + (b) * SHM_K + KSWZ(32 + sr, kc)) = St::tobf(sr_[i].ks1); } while (0)
#define SWAIT() do { if constexpr (SDEPTH == 2) asm volatile("s_waitcnt vmcnt(4)" ::: "memory"); else asm volatile("s_waitcnt vmcnt(0)" ::: "memory"); } while (0)
#define RESC(a) do { if (__any((a) < 1.f)) { if (hi == 0) al_l[r32] = (a); asm volatile("s_waitcnt lgkmcnt(0)" ::: "memory"); \
    for (int d = 0; d < 4; ++d) for (int r = 0; r < 16; ++r) o[d][r] *= al_l[crow(r, hi)]; } } while (0)
  f32x16 pA0, pA1, pB0, pB1; float mnA, mnB, alA, alB; bf16x8 pa0, pa1, pa2, pa3; const int NT = seq / KVBLK;
  constexpr int SE = 0, SO = SDEPTH - 1;
  SLOAD(SE, 0); asm volatile("s_waitcnt vmcnt(0)" ::: "memory"); SWRITE(0, SE); __syncthreads();
  qkt(pA0, pA1, K_lds, qr, r32, hi); partialSM(pA0, pA1, m_reg, mnA, alA);
  SLOAD(SO, KVBLK); if constexpr (SDEPTH == 2) { if (2 < NT) SLOAD(SE, 2 * KVBLK); }
  SWAIT(); SWRITE(1, SO); __syncthreads();
  for (int j = 1; j + 1 < NT; j += 2) {
    SBAR(); qkt(pB0, pB1, (bf16*)((char*)K_lds + SHM_K), qr, r32, hi);
    finishSM(pA0, pA1, alA, l_reg, pa0, pa1, pa2, pa3); SBAR();
    SLOAD(SO, (j + SDEPTH) * KVBLK); SBAR();
    pv_d0(o, vb0, pa0, pa1, pa2, pa3); partialSM(pB0, pB1, m_reg, mnB, alB);
    __syncthreads(); SWAIT(); SWRITE(0, SE);
    RESC(alB); __syncthreads();
    SBAR(); qkt(pA0, pA1, K_lds, qr, r32, hi);
    finishSM(pB0, pB1, alB, l_reg, pa0, pa1, pa2, pa3); SBAR();
    if (SDEPTH == 1 || j + 3 < NT) SLOAD(SE, (j + 1 + SDEPTH) * KVBLK); SBAR();
    pv_d0(o, vb0 + (int)SHM_V, pa0, pa1, pa2, pa3); partialSM(pA0, pA1, m_reg, mnA, alA);
    __syncthreads(); SWAIT(); SWRITE(1, SO);
    RESC(alA); __syncthreads();
  }
  SBAR(); qkt(pB0, pB1, (bf16*)((char*)K_lds + SHM_K), qr, r32, hi);
  finishSM(pA0, pA1, alA, l_reg, pa0, pa1, pa2, pa3); SBAR();
  pv_d0(o, vb0, pa0, pa1, pa2, pa3); partialSM(pB0, pB1, m_reg, mnB, alB);
  __syncthreads(); RESC(alB);
  finishSM(pB0, pB1, alB, l_reg, pa0, pa1, pa2, pa3); SBAR();
  pv_d0(o, vb0 + (int)SHM_V, pa0, pa1, pa2, pa3);
  if (hi == 0) li_l[r32] = l_reg; asm volatile("s_waitcnt lgkmcnt(0)" ::: "memory");
  float rli[16];
#pragma unroll
  for (int r = 0; r < 16; ++r) rli[r] = __builtin_amdgcn_rcpf(li_l[crow(r, hi)]);
  TO* Ow = Ob + (wid * QBLK) * LDO;
#pragma unroll
  for (int r = 0; r < 16; ++r) { int orow = crow(r, hi);
    for (int d0 = 0; d0 < 4; ++d0) { const float val = o[d0][r] * rli[r];
      if constexpr (sizeof(TO) == 4) Ow[orow * LDO + d0 * 32 + r32] = val;
      else Ow[orow * LDO + d0 * 32 + r32] = (TO)(cvtpk(val, val) & 0xffffu); } }
#undef SLOAD
#undef SWRITE
#undef SWAIT
#undef RESC
}

template <int WIN>
__device__ __forceinline__ void attn_banded_body(const bf16* __restrict__ Qp, const bf16* __restrict__ Kp, const bf16* __restrict__ Vp, const long rs, const int Lseq, const int P0,
                                                 const float m_init, const float l_init, bf16* __restrict__ Ob, const long os, float* __restrict__ Lp, const long ls, char* lds, const int tid) {
  const int wid = __builtin_amdgcn_readfirstlane(tid >> 6), lane = tid & 63, r32 = lane & 31, hi = lane >> 5;
  constexpr int BT = 32768;
  float* wsf = (float*)(lds + 2 * BT) + wid * 64; float* li_l = wsf; float* al_l = wsf + 32;
  float m_reg = m_init, l_reg = l_init; f32x16 o[4] = {}; bf16x8 qr[8];
  const bf16* Qw = Qp + (long)(P0 + wid * QBLK + r32) * rs + hi * 8;
#pragma unroll
  for (int d0 = 0; d0 < 8; ++d0) qr[d0] = *reinterpret_cast<const bf16x8*>(Qw + d0 * 16);
  const int irs = (int)rs;
  int ksrc[2], vsrc[2];
#pragma unroll
  for (int i = 0; i < 2; ++i) { const int c = 2 * wid + i, row = 4 * c + (lane >> 4), colB = (16 * (lane & 15)) ^ ((row & 7) << 4); ksrc[i] = row * irs + (colB >> 1);
      const int sub = 2 * c + (lane >> 5), kk = ((sub >> 2) << 3) | ((lane & 31) >> 2), k = (kk & ~0xC) | ((kk & 4) << 1) | ((kk & 8) >> 1), col = (sub & 3) * 32 + 8 * (lane & 3); vsrc[i] = k * irs + col; }
  using LP = __attribute__((address_space(3))) unsigned*;
#define BB_DMA(buf, tb) do { const bf16* _kb = Kp + (long)(tb) * rs; const bf16* _vb = Vp + (long)(tb) * rs; char* _l = lds + (buf) * BT; \
    _Pragma("unroll") for (int _i = 0; _i < 2; ++_i) { __builtin_amdgcn_global_load_lds((const unsigned*)(_kb + ksrc[_i]), (LP)(_l + (2 * wid + _i) * 1024), 16, 0, 0); \
                                                       __builtin_amdgcn_global_load_lds((const unsigned*)(_vb + vsrc[_i]), (LP)(_l + 16384 + (2 * wid + _i) * 1024), 16, 0, 0); } } while (0)
  constexpr int NT = (256 + 2 * WIN) / 64, NTW = (2 * WIN + 32 + 63) / 64;
  const int klo = wid >> 1, qpos = P0 + wid * QBLK + r32;
  int kf = 0; while (P0 - WIN + 64 * kf < 0) ++kf;
  int kl = NT - 1; while (P0 - WIN + 64 * kl >= Lseq) --kl;
  BB_DMA(kf & 1, P0 - WIN + 64 * kf);
  for (int k = kf; k <= kl; ++k) {
    const int tb = P0 - WIN + 64 * k;
    asm volatile("s_waitcnt vmcnt(0)" ::: "memory");
    __builtin_amdgcn_s_barrier();
    asm volatile("" ::: "memory");
    if (k < kl) BB_DMA((k + 1) & 1, tb + 64);
    char* tbuf = lds + (k & 1) * BT;
    if (k >= klo && k < klo + NTW) {
      f32x16 p0, p1; float mn, al; bf16x8 pa0, pa1, pa2, pa3;
      qkt_pipe(p0, p1, (int)(uintptr_t)tbuf, qr, r32, hi);
      if (k == klo || k == klo + NTW - 1) {
#pragma unroll
        for (int r = 0; r < 16; ++r) { const int d = qpos - (tb + crow(r, hi));
          if (d > WIN || d < -WIN) p0[r] = -1e30f;
          if (d - 32 > WIN || d - 32 < -WIN) p1[r] = -1e30f; }
      }
      partialSM(p0, p1, m_reg, mn, al);
      if (__any(al < 1.f)) { if (hi == 0) al_l[r32] = al; asm volatile("s_waitcnt lgkmcnt(0)" ::: "memory");
#pragma unroll
        for (int d = 0; d < 4; ++d)
#pragma unroll
          for (int r = 0; r < 16; ++r) o[d][r] *= al_l[crow(r, hi)]; }
      finishSM(p0, p1, al, l_reg, pa0, pa1, pa2, pa3); SBAR();
      pv_pipe<4>(o, (int)(uintptr_t)(tbuf + 16384) + v_rd_base(lane), pa0, pa1, pa2, pa3);
    }
  }
#undef BB_DMA
  if (hi == 0) li_l[r32] = l_reg; asm volatile("s_waitcnt lgkmcnt(0)" ::: "memory");
  float rli[16];
#pragma unroll
  for (int r = 0; r < 16; ++r) rli[r] = __builtin_amdgcn_rcpf(li_l[crow(r, hi)]);
  bf16* Ow = Ob + (long)(P0 + wid * QBLK) * os;
#pragma unroll
  for (int r = 0; r < 16; ++r) { const int orow = crow(r, hi);
#pragma unroll
    for (int d0 = 0; d0 < 4; ++d0) { const float val = o[d0][r] * rli[r]; ((__attribute__((address_space(1))) bf16*)Ow)[(long)orow * os + d0 * 32 + r32] = (bf16)(cvtpk(val, val) & 0xffffu); } }
  if (Lp != nullptr && hi == 0) Lp[(long)(P0 + wid * QBLK + r32) * ls] = m_reg * SCALE + __logf(l_reg);
}

constexpr int WB_WS = 131072;
template <int LDQ, int LDK, int LDO, int NVH, typename TO, bool COMBINE = false, int LDC = 0, int TPB = 1>
__device__ __forceinline__ void attn_wide_body(const bf16* __restrict__ Qb, const bf16* __restrict__ Kh, const bf16* __restrict__ Vh, TO* __restrict__ Ob, const int seq, char* lds, const int tid,
                                               const float lam = 0.f, const float gsc = 0.f, const float* __restrict__ gain = nullptr, bf16* __restrict__ Cb = nullptr) {
  const int wid = __builtin_amdgcn_readfirstlane(tid >> 6), lane = tid & 63, r32 = lane & 31, hi = lane >> 5;
  float* wsf = (float*)(lds + WB_WS) + wid * 64; float* li_l = wsf; float* al_l = wsf + 32;
  float m_reg = -1e30f, l_reg = 0; f32x16 o[4 * NVH] = {}; bf16x8 qr[8];
  { const bf16* Qw = Qb + ((wid * QBLK + r32) * LDQ + hi * 8);
#pragma unroll
    for (int d0 = 0; d0 < 8; ++d0) qr[d0] = *reinterpret_cast<const bf16x8*>(Qw + d0 * 16); }
  constexpr int NVP = 2 * NVH;
  int ksrc[2], vsrc[NVP];
#pragma unroll
  for (int i = 0; i < 2; ++i) { const int c = 2 * wid + i, row = 4 * c + (lane >> 4), colB = (16 * (lane & 15)) ^ ((row & 7) << 4); ksrc[i] = row * LDK + (colB >> 1); }
#pragma unroll
  for (int i = 0; i < NVP; ++i) { const int pc = wid * NVP + i, hf = pc >> 4, c = pc & 15, sub = 2 * c + (lane >> 5), kk = ((sub >> 2) << 3) | ((lane & 31) >> 2);
      const int k = (kk & ~0xC) | ((kk & 4) << 1) | ((kk & 8) >> 1), col = (sub & 3) * 32 + 8 * (lane & 3); vsrc[i] = k * LDK + hf * 128 + col; }
  using LP = __attribute__((address_space(3))) unsigned*;
  constexpr int WB_ONE = 16384 * (1 + NVH), WB_SUP = TPB * WB_ONE;
  static_assert(2 * WB_SUP <= WB_WS, "ring");
#define WB_DMA(buf, key0) do { _Pragma("unroll") for (int _t = 0; _t < TPB; ++_t) { const bf16* _kb = Kh + ((key0) + _t * KVBLK) * LDK; const bf16* _vb = Vh + ((key0) + _t * KVBLK) * LDK; char* _l = lds + (buf) * WB_SUP + _t * WB_ONE; \
    _Pragma("unroll") for (int _i = 0; _i < 2; ++_i) __builtin_amdgcn_global_load_lds((const unsigned*)(_kb + ksrc[_i]), (LP)(_l + (2 * wid + _i) * 1024), 16, 0, 0); \
    _Pragma("unroll") for (int _i = 0; _i < NVP; ++_i) __builtin_amdgcn_global_load_lds((const unsigned*)(_vb + vsrc[_i]), (LP)(_l + 16384 + (wid * NVP + _i) * 1024), 16, 0, 0); } } while (0)
  const int NG = seq / (KVBLK * TPB);
  WB_DMA(0, 0);
  for (int j = 0; j < NG; ++j) {
    asm volatile("s_waitcnt vmcnt(0)" ::: "memory");
    __builtin_amdgcn_s_barrier();
    asm volatile("" ::: "memory");
    if (j + 1 < NG) WB_DMA((j + 1) & 1, (j + 1) * KVBLK * TPB);
#pragma unroll
    for (int tt = 0; tt < TPB; ++tt) {
    char* tb = lds + (j & 1) * WB_SUP + tt * WB_ONE;
    f32x16 p0, p1; float mn, al; bf16x8 pa0, pa1, pa2, pa3;
    qkt_pipe(p0, p1, (int)(uintptr_t)tb, qr, r32, hi);
    partialSM(p0, p1, m_reg, mn, al);
    if (__any(al < 1.f)) { if (hi == 0) al_l[r32] = al; asm volatile("s_waitcnt lgkmcnt(0)" ::: "memory");
#pragma unroll
      for (int d = 0; d < 4 * NVH; ++d)
#pragma unroll
        for (int r = 0; r < 16; ++r) o[d][r] *= al_l[crow(r, hi)]; }
    finishSM(p0, p1, al, l_reg, pa0, pa1, pa2, pa3); SBAR();
    const int vb0 = (int)(uintptr_t)(tb + 16384) + v_rd_base(lane);
    pv_pipe<4 * NVH>(o, vb0, pa0, pa1, pa2, pa3);
    }
  }
#undef WB_DMA
  int te = tid; asm volatile("" : "+v"(te));
  const int wid_e = __builtin_amdgcn_readfirstlane(te >> 6), r32_e = te & 31, hi_e = (te >> 5) & 1;
  float* li_e = (float*)(lds + WB_WS) + wid_e * 64;
  if (hi_e == 0) li_e[r32_e] = l_reg; asm volatile("s_waitcnt lgkmcnt(0)" ::: "memory");
  float rli[16];
#pragma unroll
  for (int r = 0; r < 16; ++r) rli[r] = __builtin_amdgcn_rcpf(li_e[crow(r, hi_e)]);
  TO* Ow = Ob + (wid_e * QBLK) * LDO;
  if constexpr (!COMBINE) {
#pragma unroll
    for (int r = 0; r < 16; ++r) { const int orow = crow(r, hi_e);
#pragma unroll
      for (int d0 = 0; d0 < 4 * NVH; ++d0) { const float val = o[d0][r] * rli[r];
        if constexpr (sizeof(TO) == 4) ((__attribute__((address_space(1))) TO*)Ow)[orow * LDO + d0 * 32 + r32_e] = val; else ((__attribute__((address_space(1))) TO*)Ow)[orow * LDO + d0 * 32 + r32_e] = (TO)(cvtpk(val, val) & 0xffffu); } }
  } else {
    static_assert(sizeof(TO) == 4 && NVH == 2, "combine: f32 first-map tile, 256-wide rows");
    float gn[8];
    { const float* g2 = gain; asm volatile("" : "+s"(g2));
#pragma unroll
      for (int d0 = 0; d0 < 8; ++d0) gn[d0] = g2[d0 * 32 + r32_e] * gsc; }
    bf16* Cw; { bf16* c2 = Cb; asm volatile("" : "+s"(c2)); Cw = c2 + (wid_e * QBLK) * LDC; }
    { TO* o2 = Ob; asm volatile("" : "+s"(o2)); Ow = o2 + (wid_e * QBLK) * LDO; }
#pragma unroll
    for (int r = 0; r < 16; ++r) { const int orow = crow(r, hi_e);
      float ss = 0.f;
#pragma unroll
      for (int d0 = 0; d0 < 8; ++d0) { const float o1 = __hip_atomic_load((const __attribute__((address_space(1))) float*)Ow + orow * LDO + d0 * 32 + r32_e, __ATOMIC_RELAXED, __HIP_MEMORY_SCOPE_AGENT);
        const float av = o1 - lam * (o[d0][r] * rli[r]); o[d0][r] = av; ss = fmaf(av, av, ss); }
#define WB_SWZ(v, m) __int_as_float(__builtin_amdgcn_ds_swizzle(__float_as_int(v), ((m) << 10) | 0x1F))
      ss += WB_SWZ(ss, 1); ss += WB_SWZ(ss, 2); ss += WB_SWZ(ss, 4); ss += WB_SWZ(ss, 8); ss += WB_SWZ(ss, 16);
#undef WB_SWZ
      const float sc = 1.0f / sqrtf(ss * (1.0f / 256.0f) + 1e-6f);
#pragma unroll
      for (int d0 = 0; d0 < 8; ++d0) { const float val = o[d0][r] * sc * gn[d0]; ((__attribute__((address_space(1))) bf16*)Cw)[orow * LDC + d0 * 32 + r32_e] = (bf16)(cvtpk(val, val) & 0xffffu); }
      asm volatile("" ::: "memory"); }
  }
}
}
typedef unsigned short bf16_t;
typedef unsigned u32x4v __attribute__((ext_vector_type(4)));
#define LDSA __attribute__((address_space(3)))
#define GLB __attribute__((address_space(1)))
constexpr size_t al256(size_t x) { return (x + 255) / 256 * 256; }
constexpr size_t WS_CTL  = 0;
constexpr size_t CTL_BYTES = 65536;
constexpr size_t WS_XB   = WS_CTL + CTL_BYTES;
constexpr size_t WS_WAB  = WS_XB + (size_t)SEQ * DM * 2;
constexpr size_t WS_WOAB = WS_WAB + (size_t)12288 * 4096 * 2;
constexpr size_t WS_WCD  = WS_WOAB + (size_t)4096 * 3072 * 2;
constexpr size_t WS_WOCD = WS_WCD + (size_t)9216 * 4096 * 2;
constexpr size_t WS_WQ   = WS_WOCD + (size_t)4096 * 4096 * 2;
constexpr size_t WS_UB   = WS_WQ + (size_t)2 * 2048 * 4096 * 2;
constexpr size_t WS_VB   = WS_UB + (size_t)2 * 16384 * 3072;
constexpr size_t WS_SU   = WS_VB + (size_t)2 * 16384 * 3072;
constexpr size_t WS_SV   = WS_SU + (size_t)2 * 16384 * 4;
constexpr size_t WS_H    = WS_SV + (size_t)2 * 16384 * 4;
constexpr size_t WS_Y    = WS_H;
constexpr size_t WS_PQ   = WS_H + (size_t)SEQ * 4096 * 4;
constexpr size_t WS_OC   = WS_H + (size_t)SEQ * 12288 * 4;
constexpr size_t WS_AB   = WS_OC + (size_t)2 * SEQ * 2048 * 4;
constexpr size_t WS_X1   = WS_AB + (size_t)SEQ * 4096 * 2;
constexpr size_t WS_X1B  = WS_X1 + (size_t)SEQ * 4096 * 4;
constexpr size_t WS_X2   = WS_X1B + (size_t)SEQ * 4096 * 2;
constexpr size_t WS_X2B  = WS_X2 + (size_t)SEQ * 4096 * 4;
constexpr size_t WS_EIDX = WS_X2B + (size_t)SEQ * 4096 * 2;
constexpr size_t WS_GATE = WS_EIDX + (size_t)SEQ * 128 * 4;
constexpr size_t WS_HB   = WS_GATE + (size_t)SEQ * 128 * 4;
constexpr size_t WS_KEYB = WS_HB + (size_t)SEQ * 12288 * 2;
constexpr size_t WS_CS0  = WS_KEYB + (size_t)2 * 8 * 2 * 128 * 128 * 2;
constexpr size_t WS_CSA  = WS_CS0 + (size_t)SEQ * 16 * 8;
constexpr size_t WS_END  = WS_CSA + (size_t)128 * 32 * 8;
static_assert(WS_END <= (size_t)2147483648ull, "workspace");

constexpr int LDS_BYTES = 155648;
constexpr int LDS_MISC = 139264;

struct MK { const float* in[21]; float* out; unsigned char* ws; int ph_lo, ph_hi; };

namespace pg8 {
struct EpiF32R {
    static constexpr bool PERM = false, AFTER_DRAIN = false;
    float* C; int ldc; const float* R; float ralpha;
    __device__ __forceinline__ void operator()(const f32x4 (&acc)[2][2][4][2], const Unit& u, int wr, int wc, int fr, int fq) const {
        const int row0 = u.pm * BM + wr * 64 + fr, col0 = u.pn * BM + wc * 32 + 4 * fq;
#pragma unroll
        for (int ai = 0; ai < 2; ++ai)
#pragma unroll
            for (int mp = 0; mp < 2; ++mp) {
                f32x4 r[2][2][2];
                if (R) {
#pragma unroll
                    for (int mm = 0; mm < 2; ++mm) { const size_t off = (size_t)(row0 + ai * HALF + (2 * mp + mm) * 16) * ldc + col0;
#pragma unroll
                        for (int bj = 0; bj < 2; ++bj)
#pragma unroll
                            for (int n = 0; n < 2; ++n) r[mm][bj][n] = *(const GLB f32x4*)(R + off + bj * HALF + n * 16); }
                }
#pragma unroll
                for (int mm = 0; mm < 2; ++mm) { const int m = 2 * mp + mm; const size_t off = (size_t)(row0 + ai * HALF + m * 16) * ldc + col0;
#pragma unroll
                    for (int bj = 0; bj < 2; ++bj)
#pragma unroll
                        for (int n = 0; n < 2; ++n) { f32x4 v = acc[ai][bj][m][n];
                            if (R) v += r[mm][bj][n] * ralpha;
                            *(GLB f32x4*)(C + off + bj * HALF + n * 16) = v; } }
                asm volatile("" ::: "memory");
            }
    }
};
struct EpiBf16P {
    static constexpr bool PERM = true, AFTER_DRAIN = false;
    bf16_t* O; int ldc;
    __device__ __forceinline__ void operator()(const f32x4 (&acc)[2][2][4][2], const Unit& u, int wr, int wc, int fr, int fq) const {
        const int row0 = u.pm * BM + wr * 64 + fr, col0 = u.pn * BM + wc * 32 + 8 * fq;
#pragma unroll
        for (int ai = 0; ai < 2; ++ai)
#pragma unroll
            for (int m = 0; m < 4; ++m) { bf16_t* rowp = O + (size_t)(row0 + ai * HALF + m * 16) * ldc + col0;
#pragma unroll
                for (int bj = 0; bj < 2; ++bj) { const f32x4 v0 = acc[ai][bj][m][0], v1 = acc[ai][bj][m][1];
                    u32x4 w; w.x = cvt_pk_bf16(v0[0], v0[1]); w.y = cvt_pk_bf16(v0[2], v0[3]); w.z = cvt_pk_bf16(v1[0], v1[1]); w.w = cvt_pk_bf16(v1[2], v1[3]);
                    *(GLB u32x4*)(rowp + bj * HALF) = w; } }
    }
};

template <int LAYER> struct EpiProj {
    static constexpr bool PERM = true, AFTER_DRAIN = false;
    bf16_t* O; int ldc; const float* cs0; const float* csa; const float* gq; const float* gk; PG8_LAS float* xch;
    __device__ __forceinline__ void operator()(const f32x4 (&acc)[2][2][4][2], const Unit& u, int wr, int wc, int fr, int fq) const {
        const int row0 = u.pm * BM + wr * 64 + fr, col0 = u.pn * BM + wc * 32 + 8 * fq;
        const int pn = u.pn;
        const bool prope = LAYER == 0 ? (pn < 10 || (pn >= 12 && pn < 36)) : (pn < 16);
        const bool dnorm = LAYER == 1 && pn >= 24 && pn < 34;
        float rs[2][4][2];
        float gn[8];
        if (dnorm) {
            const int lrow = fr;
#pragma unroll
            for (int ai = 0; ai < 2; ++ai)
#pragma unroll
                for (int m = 0; m < 4; ++m)
#pragma unroll
                    for (int bj = 0; bj < 2; ++bj) { const f32x4 a = acc[ai][bj][m][0], b = acc[ai][bj][m][1];
                        float q = (a[0] * a[0] + a[1] * a[1]) + (a[2] * a[2] + a[3] * a[3]) + (b[0] * b[0] + b[1] * b[1]) + (b[2] * b[2] + b[3] * b[3]);
                        q += __shfl_xor(q, 16); q += __shfl_xor(q, 32);
                        if (fq == 0) xch[((wr * 128 + (ai * 4 + m) * 16 + lrow) * 2 + bj) * 4 + wc] = q; }
            asm volatile("s_waitcnt lgkmcnt(0)" ::: "memory"); __builtin_amdgcn_s_barrier(); asm volatile("" ::: "memory");
#pragma unroll
            for (int ai = 0; ai < 2; ++ai)
#pragma unroll
                for (int m = 0; m < 4; ++m)
#pragma unroll
                    for (int bj = 0; bj < 2; ++bj) { const f32x4 p = *(const PG8_LAS f32x4*)(xch + ((wr * 128 + (ai * 4 + m) * 16 + lrow) * 2 + bj) * 4);
                        rs[ai][m][bj] = 1.0f / sqrtf(((p[0] + p[1]) + (p[2] + p[3])) * (1.0f / 128.0f) + 1e-6f); }
            const float* g = pn < 32 ? gq : gk;
#pragma unroll
            for (int e = 0; e < 8; ++e) { const int p = wc * 32 + 8 * fq + e; const int orig = (p & 64) + ((p & 63) >> 1) + 32 * (p & 1); gn[e] = g[orig]; }
        }
        const bool rot = dnorm || (prope && wc == 0);
#pragma unroll
        for (int ai = 0; ai < 2; ++ai) {
            f32x4 cs[4][2];
            if (rot) {
#pragma unroll
                for (int m = 0; m < 4; ++m) { const int row = row0 + ai * HALF + m * 16;
                    const float* cp = dnorm ? csa + ((size_t)(wc < 2 ? (row >> 6) : (row & 63)) * 32 + 16 * (wc & 1) + 4 * fq) * 2 : cs0 + ((size_t)row * 16 + 4 * fq) * 2;
                    cs[m][0] = *(const GLB f32x4*)cp; cs[m][1] = *(const GLB f32x4*)(cp + 4); }
            }
#pragma unroll
            for (int m = 0; m < 4; ++m) {
                const int row = row0 + ai * HALF + m * 16;
                bf16_t* rowp = O + (size_t)row * ldc + col0;
                f32x4 c0 = (f32x4){1.f, 0.f, 1.f, 0.f}, c1 = c0;
                if (rot) { c0 = cs[m][0]; c1 = cs[m][1]; }
#pragma unroll
                for (int bj = 0; bj < 2; ++bj) { f32x4 v0 = acc[ai][bj][m][0], v1 = acc[ai][bj][m][1];
                    if (dnorm) { const float r = rs[ai][m][bj];
                        v0[0] *= r * gn[0]; v0[1] *= r * gn[1]; v0[2] *= r * gn[2]; v0[3] *= r * gn[3]; v1[0] *= r * gn[4]; v1[1] *= r * gn[5]; v1[2] *= r * gn[6]; v1[3] *= r * gn[7]; }
                    if (rot) {
                        const float a0 = v0[0] * c0[0] - v0[1] * c0[1], b0 = v0[1] * c0[0] + v0[0] * c0[1];
                        const float a1 = v0[2] * c0[2] - v0[3] * c0[3], b1 = v0[3] * c0[2] + v0[2] * c0[3];
                        const float a2 = v1[0] * c1[0] - v1[1] * c1[1], b2 = v1[1] * c1[0] + v1[0] * c1[1];
                        const float a3 = v1[2] * c1[2] - v1[3] * c1[3], b3 = v1[3] * c1[2] + v1[2] * c1[3];
                        v0 = (f32x4){a0, b0, a1, b1}; v1 = (f32x4){a2, b2, a3, b3}; }
                    u32x4 w; w.x = cvt_pk_bf16(v0[0], v0[1]); w.y = cvt_pk_bf16(v0[2], v0[3]); w.z = cvt_pk_bf16(v1[0], v1[1]); w.w = cvt_pk_bf16(v1[2], v1[3]);
                    *(GLB u32x4*)(rowp + bj * HALF) = w; }
            }
            asm volatile("" ::: "memory");
        }
    }
};
}

__device__ __forceinline__ float bf_lo(unsigned w) { return __uint_as_float(w << 16); }
__device__ __forceinline__ float bf_hi(unsigned w) { return __uint_as_float(w & 0xffff0000u); }
__device__ __forceinline__ unsigned cvtpk_bf16(float lo, float hi) { unsigned r; asm volatile("v_cvt_pk_bf16_f32 %0, %1, %2" : "=v"(r) : "v"(lo), "v"(hi)); return r; }

__device__ __forceinline__ void cvt_rows_bf16(const float* __restrict__ src, bf16_t* __restrict__ dst, size_t n8, int bid, int nb, int tid, int nthr) {
    const size_t stride = (size_t)nb * nthr;
    for (size_t i = (size_t)bid * nthr + tid; i < n8; i += 4 * stride) {
        float4 a[4], b[4];
#pragma unroll
        for (int u = 0; u < 4; ++u) { const size_t j = i + u * stride; if (j < n8) { a[u] = *(const float4*)(src + j * 8); b[u] = *(const float4*)(src + j * 8 + 4); } }
#pragma unroll
        for (int u = 0; u < 4; ++u) { const size_t j = i + u * stride; if (j < n8) {
            u32x4v w; w.x = cvtpk_bf16(a[u].x, a[u].y); w.y = cvtpk_bf16(a[u].z, a[u].w); w.z = cvtpk_bf16(b[u].x, b[u].y); w.w = cvtpk_bf16(b[u].z, b[u].w);
            *(u32x4v*)(dst + j * 8) = w; } }
    }
}
template <class PM>
__device__ __forceinline__ void transpose_cvt(const float* __restrict__ W, bf16_t* __restrict__ Wt, int K, int N, LDSA float* tile0, int bid, int nb, PM pm, const int tid) {
    const int lane = tid & 63, wv = tid >> 6;
    LDSA float* tile = tile0 + wv * 4352;
    const int ntk = K / 64, ntn = N / 64;
    for (int t = bid * 8 + wv; t < ntk * ntn; t += nb * 8) {
        const int k0 = (t % ntk) * 64, n0 = (t / ntk) * 64;
        const int c = (lane & 15) * 4, r0 = lane >> 4;
        float4 v[16];
#pragma unroll
        for (int i = 0; i < 16; ++i) v[i] = *(const float4*)(W + (size_t)(k0 + r0 + 4 * i) * N + n0 + c);
#pragma unroll
        for (int i = 0; i < 16; ++i) { const int r = r0 + 4 * i; tile[r * 65 + c] = v[i].x; tile[r * 65 + c + 1] = v[i].y; tile[r * 65 + c + 2] = v[i].z; tile[r * 65 + c + 3] = v[i].w; }
        asm volatile("s_waitcnt lgkmcnt(0)" ::: "memory");
        const int mode = pm(n0);
#pragma unroll
        for (int h = 0; h < 8; ++h) {
            const int n = (lane >> 3) + 8 * h, kc = (lane & 7) * 8;
            int src = n;
            if (mode == 1) { if (n < 32) src = (n >> 1) + 16 * (n & 1); }
            else if (mode == 2) src = (n >> 1) + 32 * (n & 1);
            float f[8];
#pragma unroll
            for (int j = 0; j < 8; ++j) f[j] = tile[(kc + j) * 65 + src];
            u32x4v w; w.x = cvtpk_bf16(f[0], f[1]); w.y = cvtpk_bf16(f[2], f[3]); w.z = cvtpk_bf16(f[4], f[5]); w.w = cvtpk_bf16(f[6], f[7]);
            *(u32x4v*)(Wt + (size_t)(n0 + n) * K + k0 + kc) = w;
        }
        asm volatile("s_waitcnt lgkmcnt(0)" ::: "memory");
    }
}
struct PermNone { __device__ __forceinline__ int operator()(int) const { return 0; } };
struct PermAB { __device__ __forceinline__ int operator()(int n0) const { const bool rope = n0 < 2560 || (n0 >= 3072 && n0 < 9216); return (rope && (n0 & 127) == 0) ? 1 : 0; } };
struct PermCD { __device__ __forceinline__ int operator()(int n0) const { if (n0 < 4096) return (n0 & 127) == 0 ? 1 : 0; if (n0 >= 6144 && n0 < 8704) return 2; return 0; } };
__device__ __forceinline__ void rope_tables(float* __restrict__ cs0, float* __restrict__ csa, const int bid, const int G, const int tid) {
    for (int i = bid * 512 + tid; i < SEQ * 16; i += G * 512) { float s, c; sincos_rev((double)(i >> 4) * REV_P[i & 15], s, c); *(float2*)(cs0 + (size_t)i * 2) = make_float2(c, s); }
    for (int i = bid * 512 + tid; i < 128 * 32; i += G * 512) { float s, c; sincos_rev((double)(i >> 5) * REV_A[i & 31], s, c); *(float2*)(csa + (size_t)i * 2) = make_float2(c, s); }
}


typedef unsigned v6u_t __attribute__((ext_vector_type(6)));
typedef float f4v_t __attribute__((ext_vector_type(4)));
typedef unsigned v16u_t __attribute__((ext_vector_type(16)));
typedef float v16f_t __attribute__((ext_vector_type(16)));
typedef float v32f_t __attribute__((ext_vector_type(32)));
typedef __bf16 v32b_t __attribute__((ext_vector_type(32)));
constexpr int ROWB = 3072;
constexpr int XT_STRIDE = 68;
constexpr int XT_BYTES = 64 * XT_STRIDE * 4;
__device__ __forceinline__ void table_fp6(const float* __restrict__ src, unsigned char* __restrict__ dst, float* __restrict__ inv, const int rows, LDSA float* xt0, const int bid, const int G, const int tid) {
    const int lane = tid & 63, wv = tid >> 6;
    LDSA float* xt = xt0 + wv * (XT_BYTES / 4);
    for (int r = bid * 8 + wv; r < rows; r += G * 8) {
        float4 v[16]; float am = 0.f;
#pragma unroll
        for (int j = 0; j < 16; ++j) { v[j] = *(const float4*)(src + (size_t)r * DM + j * 256 + lane * 4); am = fmaxf(am, fmaxf(fmaxf(fabsf(v[j].x), fabsf(v[j].y)), fmaxf(fabsf(v[j].z), fabsf(v[j].w)))); }
        am = wave_max(am);
        const float sc = am > 0.f ? 7.0f / am : 1.0f;
#pragma unroll
        for (int j = 0; j < 16; ++j) *(LDSA f4v_t*)(xt + (4 * j + (lane >> 4)) * XT_STRIDE + 4 * (lane & 15)) = (f4v_t){v[j].x * sc, v[j].y * sc, v[j].z * sc, v[j].w * sc};
        asm volatile("s_waitcnt lgkmcnt(0)" ::: "memory");
        v16f_t f0, f1, f2, f3;
#pragma unroll
        for (int k = 0; k < 8; ++k) { const f4v_t a = *(const LDSA f4v_t*)(xt + lane * XT_STRIDE + 4 * k), c = *(const LDSA f4v_t*)(xt + lane * XT_STRIDE + 32 + 4 * k);
            f0[2 * k] = a[0]; f1[2 * k] = a[1]; f0[2 * k + 1] = a[2]; f1[2 * k + 1] = a[3];
            f2[2 * k] = c[0]; f3[2 * k] = c[1]; f2[2 * k + 1] = c[2]; f3[2 * k + 1] = c[3]; }
        asm volatile("s_waitcnt lgkmcnt(0)" ::: "memory");
        const v6u_t w0 = __builtin_amdgcn_cvt_scalef32_2xpk16_fp6_f32(f0, f1, 1.0f), w1 = __builtin_amdgcn_cvt_scalef32_2xpk16_fp6_f32(f2, f3, 1.0f);
        unsigned char* dp = dst + (size_t)r * ROWB + lane * 48;
        u32x4v s0, s1, s2; s0.x = w0[0]; s0.y = w0[1]; s0.z = w0[2]; s0.w = w0[3]; s1.x = w0[4]; s1.y = w0[5]; s1.z = w1[0]; s1.w = w1[1]; s2.x = w1[2]; s2.y = w1[3]; s2.z = w1[4]; s2.w = w1[5];
        *(u32x4v*)dp = s0; *(u32x4v*)(dp + 16) = s1; *(u32x4v*)(dp + 32) = s2;
        if (lane == 0) inv[r] = am > 0.f ? am * (1.0f / 7.0f) : 1.0f;
    }
}

typedef __bf16 bf2_t __attribute__((ext_vector_type(2)));
__device__ __forceinline__ float dot2_bf16(unsigned a, unsigned b, float c) { return __builtin_amdgcn_fdot2_f32_bf16(__builtin_bit_cast(bf2_t, a), __builtin_bit_cast(bf2_t, b), c, false); }
__device__ __forceinline__ float gelu_tanh_f(float x) {
    const float z = 0.7978845608028654f * (x + 0.044715f * x * x * x);
    const float e = __expf(2.0f * z);
    return 0.5f * x * (2.0f - 2.0f / (e + 1.0f));
}
__device__ __forceinline__ int pick_i(int a0, int a1, int k) { return k < 64 ? __builtin_amdgcn_readlane(a0, k) : __builtin_amdgcn_readlane(a1, k - 64); }
__device__ __forceinline__ float pick_f(float a0, float a1, int k) { return __int_as_float(pick_i(__float_as_int(a0), __float_as_int(a1), k)); }
__device__ __forceinline__ float dpp_shr(float v, const int ctrl_sel) {
    const int iv = __builtin_bit_cast(int, v); int r;
    switch (ctrl_sel) { case 1: r = __builtin_amdgcn_update_dpp(0, iv, 0x111, 0xf, 0xf, true); break; case 2: r = __builtin_amdgcn_update_dpp(0, iv, 0x112, 0xf, 0xf, true); break;
                        case 4: r = __builtin_amdgcn_update_dpp(0, iv, 0x114, 0xf, 0xf, true); break; default: r = __builtin_amdgcn_update_dpp(0, iv, 0x118, 0xf, 0xf, true); break; }
    return __builtin_bit_cast(float, r);
}
__device__ __forceinline__ float wave_sum_u(float v) {
    v += dpp_shr(v, 1); v += dpp_shr(v, 2); v += dpp_shr(v, 4); v += dpp_shr(v, 8);
    v += __builtin_bit_cast(float, __builtin_amdgcn_update_dpp(0, __builtin_bit_cast(int, v), 0x142, 0xa, 0xf, false));
    v += __builtin_bit_cast(float, __builtin_amdgcn_update_dpp(0, __builtin_bit_cast(int, v), 0x143, 0xc, 0xf, false));
    return __builtin_bit_cast(float, __builtin_amdgcn_readlane(__builtin_bit_cast(int, v), 63));
}
typedef const __attribute__((address_space(1))) u32x4v* gu32x4p;
#define PE_LOADROW(dst, base, e) do { const unsigned char* _p = (base) + (size_t)(e) * ROWB + lane * 48; dst[0] = *(gu32x4p)_p; dst[1] = *(gu32x4p)(_p + 16); dst[2] = *(gu32x4p)(_p + 32); } while (0)
__device__ __forceinline__ float pe_dot(const u32x4v (&r)[3], const u32x4v (&x)[8]) {
    float d0 = 0.f, d1 = 0.f, d2 = 0.f, d3 = 0.f;
    { const v6u_t g = {r[0].x, r[0].y, r[0].z, r[0].w, r[1].x, r[1].y};
      const v16u_t z = __builtin_bit_cast(v16u_t, __builtin_amdgcn_cvt_scalef32_pk32_bf16_fp6(g, 1.0f));
#pragma unroll
      for (int k = 0; k < 4; ++k) { const unsigned xa = x[k].x, xb = x[k].y, xc = x[k].z, xd = x[k].w; const unsigned za = z[4 * k], zb = z[4 * k + 1], zc = z[4 * k + 2], zd = z[4 * k + 3];
          d0 = dot2_bf16(za, xa, d0); d1 = dot2_bf16(zb, xb, d1); d2 = dot2_bf16(zc, xc, d2); d3 = dot2_bf16(zd, xd, d3); }
    }
    { const v6u_t g = {r[1].z, r[1].w, r[2].x, r[2].y, r[2].z, r[2].w};
      const v16u_t z = __builtin_bit_cast(v16u_t, __builtin_amdgcn_cvt_scalef32_pk32_bf16_fp6(g, 1.0f));
#pragma unroll
      for (int k = 0; k < 4; ++k) { const unsigned xa = x[4 + k].x, xb = x[4 + k].y, xc = x[4 + k].z, xd = x[4 + k].w; const unsigned za = z[4 * k], zb = z[4 * k + 1], zc = z[4 * k + 2], zd = z[4 * k + 3];
          d0 = dot2_bf16(za, xa, d0); d1 = dot2_bf16(zb, xb, d1); d2 = dot2_bf16(zc, xc, d2); d3 = dot2_bf16(zd, xd, d3); } }
    return wave_sum_u((d0 + d1) + (d2 + d3));
}
#define PE_PIN16(a, b) asm volatile("" : "+v"(a[b + 0]), "+v"(a[b + 1]), "+v"(a[b + 2]), "+v"(a[b + 3]), "+v"(a[b + 4]), "+v"(a[b + 5]), "+v"(a[b + 6]), "+v"(a[b + 7]), \
                                         "+v"(a[b + 8]), "+v"(a[b + 9]), "+v"(a[b + 10]), "+v"(a[b + 11]), "+v"(a[b + 12]), "+v"(a[b + 13]), "+v"(a[b + 14]), "+v"(a[b + 15]))
__device__ __forceinline__ void pe_axpy(float (&acc)[64], const u32x4v (&r)[3], const float w) {
    { const v6u_t g = {r[0].x, r[0].y, r[0].z, r[0].w, r[1].x, r[1].y};
      const v32f_t y = __builtin_amdgcn_cvt_scalef32_pk32_f32_fp6(g, 1.0f);
#pragma unroll
      for (int i = 0; i < 32; ++i) acc[i] = fmaf(w, y[i], acc[i]);
      PE_PIN16(acc, 0); PE_PIN16(acc, 16); }
    { const v6u_t g = {r[1].z, r[1].w, r[2].x, r[2].y, r[2].z, r[2].w};
      const v32f_t y = __builtin_amdgcn_cvt_scalef32_pk32_f32_fp6(g, 1.0f);
#pragma unroll
      for (int i = 0; i < 32; ++i) acc[32 + i] = fmaf(w, y[i], acc[32 + i]);
      PE_PIN16(acc, 32); PE_PIN16(acc, 48); }
}
__device__ __forceinline__ void wave_sort128(unsigned& a0, unsigned& a1, const int lane) {
#pragma unroll
    for (int k = 2; k <= 128; k <<= 1) {
#pragma unroll
        for (int j = k >> 1; j > 0; j >>= 1) {
            if (j == 64) { const unsigned lo = a0 < a1 ? a0 : a1, hi = a0 < a1 ? a1 : a0; a0 = lo; a1 = hi; }
            else {
                const unsigned o0 = (unsigned)__shfl_xor((int)a0, j), o1 = (unsigned)__shfl_xor((int)a1, j);
                const bool lowhalf = (lane & j) == 0;
                const bool up0 = k >= 128 ? true : ((lane & k) == 0);
                const bool up1 = k >= 128 ? true : (k == 64 ? false : ((lane & k) == 0));
                const bool min0 = lowhalf == up0, min1 = lowhalf == up1;
                const unsigned mn0 = a0 < o0 ? a0 : o0, mx0 = a0 < o0 ? o0 : a0, mn1 = a1 < o1 ? a1 : o1, mx1 = a1 < o1 ? o1 : a1;
                a0 = min0 ? mn0 : mx0; a1 = min1 ? mn1 : mx1;
            }
        }
    }
}
__device__ __forceinline__ void peer_expert_phase(const float* __restrict__ ypre, const float* __restrict__ stats, const float* __restrict__ gm, const float* __restrict__ bm, const bf16_t* __restrict__ x1b, int* __restrict__ eidx, float* __restrict__ gate,
                                                  const unsigned char* __restrict__ ub, const unsigned char* __restrict__ vb, const float* __restrict__ isu, const float* __restrict__ isv,
                                                  const float* __restrict__ lg, const float* __restrict__ lb, float* __restrict__ out, bf16_t* __restrict__ outb, LDSA float* xt0, const int bid, const int G, const int tid) {
    const int wv = __builtin_amdgcn_readfirstlane(tid >> 6);
    LDSA float* xt = xt0 + wv * (XT_BYTES / 4);
#define PE_POS(k) (rev ? 127 - (k) : (k))
#define PE_E(k) pick_i(e0, e1, PE_POS(k))
    int jt = 0;
    for (int t = bid * 8 + wv; t < SEQ; t += G * 8, ++jt) {
        int tl = tid; asm volatile("" : "+v"(tl));
        const int lane = tl & 63;
        const bool rev = (jt & 1) != 0;
        int e0, e1; float g0, g1;
        { const int r0 = eidx[(size_t)t * 128 + lane], r1 = eidx[(size_t)t * 128 + 64 + lane];
          const float h0 = gate[(size_t)t * 128 + lane], h1 = gate[(size_t)t * 128 + 64 + lane];
          unsigned a0 = ((unsigned)r0 << 7) | (unsigned)lane, a1 = ((unsigned)r1 << 7) | (unsigned)(64 + lane);
          wave_sort128(a0, a1, lane);
          e0 = (int)(a0 >> 7); e1 = (int)(a1 >> 7);
          const int k0 = (int)(a0 & 127u), k1 = (int)(a1 & 127u);
          const float p00 = __shfl(h0, k0 & 63), p01 = __shfl(h1, k0 & 63), p10 = __shfl(h0, k1 & 63), p11 = __shfl(h1, k1 & 63);
          g0 = k0 < 64 ? p00 : p01; g1 = k1 < 64 ? p10 : p11; }
        const float iu0 = isu[e0], iu1 = isu[e1], iv0 = isv[e0], iv1 = isv[e1];
        u32x4v xq[8];
#pragma unroll
        for (int k = 0; k < 8; ++k) xq[k] = *(const u32x4v*)(x1b + (size_t)t * DM + lane * 64 + k * 8);
        float w0 = 0.f, w1 = 0.f;
        u32x4v R0[3], R1[3], R2[3], R3[3], R4[3];
#define PE_USTEP(R, k) do { const int kk = PE_POS(k); const float d = pe_dot(R, xq) * pick_f(iu0, iu1, kk); const float w = pick_f(g0, g1, kk) * gelu_tanh_f(d) * pick_f(iv0, iv1, kk); \
            if (lane == (kk & 63)) { if (kk < 64) w0 = w; else w1 = w; } } while (0)
        PE_LOADROW(R0, ub, PE_E(0)); PE_LOADROW(R1, ub, PE_E(1)); PE_LOADROW(R2, ub, PE_E(2)); PE_LOADROW(R3, ub, PE_E(3));
        for (int k = 0; k < 125; k += 5) {
            if (k + 4 < 128) PE_LOADROW(R4, ub, PE_E(k + 4)); PE_USTEP(R0, k);
            if (k + 5 < 128) PE_LOADROW(R0, ub, PE_E(k + 5)); PE_USTEP(R1, k + 1);
            if (k + 6 < 128) PE_LOADROW(R1, ub, PE_E(k + 6)); PE_USTEP(R2, k + 2);
            if (k + 7 < 128) PE_LOADROW(R2, ub, PE_E(k + 7)); PE_USTEP(R3, k + 3);
            if (k + 8 < 128) PE_LOADROW(R3, ub, PE_E(k + 8)); PE_USTEP(R4, k + 4);
        }
        PE_USTEP(R0, 125); PE_USTEP(R1, 126); PE_USTEP(R2, 127);
#undef PE_USTEP
        eidx[(size_t)t * 128 + lane] = e0; eidx[(size_t)t * 128 + 64 + lane] = e1;
        gate[(size_t)t * 128 + lane] = w0; gate[(size_t)t * 128 + 64 + lane] = w1;
    }
    asm volatile("s_waitcnt vmcnt(0)" ::: "memory");
    for (int t = bid * 8 + wv; t < SEQ; t += G * 8, ++jt) {
        int tl = tid; asm volatile("" : "+v"(tl));
        const int lane = tl & 63;
        const bool rev = (jt & 1) != 0;
        const int e0 = __builtin_nontemporal_load(eidx + (size_t)t * 128 + lane), e1 = __builtin_nontemporal_load(eidx + (size_t)t * 128 + 64 + lane);
        const float w0 = __builtin_nontemporal_load(gate + (size_t)t * 128 + lane), w1 = __builtin_nontemporal_load(gate + (size_t)t * 128 + 64 + lane);
        u32x4v R0[3], R1[3], R2[3], R3[3], R4[3];
        float acc[64];
#pragma unroll
        for (int i = 0; i < 64; ++i) acc[i] = 0.f;
        PE_LOADROW(R0, vb, PE_E(0)); PE_LOADROW(R1, vb, PE_E(1)); PE_LOADROW(R2, vb, PE_E(2)); PE_LOADROW(R3, vb, PE_E(3));
        for (int k = 0; k < 125; k += 5) {
            if (k + 4 < 128) PE_LOADROW(R4, vb, PE_E(k + 4)); pe_axpy(acc, R0, pick_f(w0, w1, PE_POS(k)));
            if (k + 5 < 128) PE_LOADROW(R0, vb, PE_E(k + 5)); pe_axpy(acc, R1, pick_f(w0, w1, PE_POS(k + 1)));
            if (k + 6 < 128) PE_LOADROW(R1, vb, PE_E(k + 6)); pe_axpy(acc, R2, pick_f(w0, w1, PE_POS(k + 2)));
            if (k + 7 < 128) PE_LOADROW(R2, vb, PE_E(k + 7)); pe_axpy(acc, R3, pick_f(w0, w1, PE_POS(k + 3)));
            if (k + 8 < 128) PE_LOADROW(R3, vb, PE_E(k + 8)); pe_axpy(acc, R4, pick_f(w0, w1, PE_POS(k + 4)));
        }
        pe_axpy(acc, R0, pick_f(w0, w1, PE_POS(125))); pe_axpy(acc, R1, pick_f(w0, w1, PE_POS(126))); pe_axpy(acc, R2, pick_f(w0, w1, PE_POS(127)));
#pragma unroll
        for (int k = 0; k < 16; ++k) *(LDSA f4v_t*)(xt + lane * XT_STRIDE + 4 * k) = (f4v_t){acc[4 * k], acc[4 * k + 1], acc[4 * k + 2], acc[4 * k + 3]};
        asm volatile("s_waitcnt lgkmcnt(0)" ::: "memory");
        float4 y[16]; float s = 0.f; const float2 st = *(const float2*)(stats + (size_t)t * 2);
#pragma unroll
        for (int j = 0; j < 16; ++j) { const f4v_t f = *(const LDSA f4v_t*)(xt + (4 * j + (lane >> 4)) * XT_STRIDE + 4 * (lane & 15));
            const float4 yv = *(const float4*)(ypre + (size_t)t * DM + j * 256 + lane * 4), gv = *(const float4*)(gm + j * 256 + lane * 4), bv = *(const float4*)(bm + j * 256 + lane * 4);
            float4 xv;
            xv.x = (yv.x - st.x) * st.y * gv.x + bv.x; xv.y = (yv.y - st.x) * st.y * gv.y + bv.y; xv.z = (yv.z - st.x) * st.y * gv.z + bv.z; xv.w = (yv.w - st.x) * st.y * gv.w + bv.w;
            y[j].x = fmaf(ALPHA, xv.x, f.x); y[j].y = fmaf(ALPHA, xv.y, f.y); y[j].z = fmaf(ALPHA, xv.z, f.z); y[j].w = fmaf(ALPHA, xv.w, f.w);
            s += (y[j].x + y[j].y) + (y[j].z + y[j].w);
            if ((j & 3) == 3) asm volatile("" ::: "memory"); }
        asm volatile("s_waitcnt lgkmcnt(0)" ::: "memory");
        const float mean = wave_sum_u(s) * (1.0f / DM);
        float qq = 0.f;
#pragma unroll
        for (int j = 0; j < 16; ++j) { const float a = y[j].x - mean, b = y[j].y - mean, c = y[j].z - mean, d = y[j].w - mean; qq += (a * a + b * b) + (c * c + d * d); }
        const float rstd = 1.0f / sqrtf(wave_sum_u(qq) * (1.0f / DM) + 1e-5f);
#pragma unroll
        for (int j = 0; j < 16; ++j) {
            const int c = j * 256 + lane * 4;
            const float4 ga = *(const float4*)(lg + c), ba = *(const float4*)(lb + c);
            float4 oa; oa.x = (y[j].x - mean) * rstd * ga.x + ba.x; oa.y = (y[j].y - mean) * rstd * ga.y + ba.y; oa.z = (y[j].z - mean) * rstd * ga.z + ba.z; oa.w = (y[j].w - mean) * rstd * ga.w + ba.w;
            *(float4*)(out + (size_t)t * DM + c) = oa;
            if (outb) { uint2 w; w.x = cvtpk_bf16(oa.x, oa.y); w.y = cvtpk_bf16(oa.z, oa.w); *(uint2*)(outb + (size_t)t * DM + c) = w; }
            if ((j & 3) == 3) asm volatile("" ::: "memory");
        }
    }
#undef PE_E
#undef PE_POS
}

__device__ __forceinline__ void attn1_phase(const bf16_t* __restrict__ hb, bf16_t* __restrict__ abb, float* __restrict__ oc, const float* __restrict__ lq1, const float* __restrict__ lk1, const float* __restrict__ lq2,
                                            const float* __restrict__ lk2, const float* __restrict__ subg, char* lds, const int bid, const int G, const int tid) {
    for (int u = bid; u < 512; u += G) {
        __syncthreads();
        const int kv = u >> 7, g = (u >> 5) & 3, qb = u & 31, hq = kv * 4 + g;
        att::attn_wide_body<9216, 9216, 4096, 1, att::bf16, false, 0, 2>(hb + (size_t)(qb * 256) * 9216 + 6144 + hq * 128, hb + 8192 + kv * 128, hb + 8704 + kv * 128,
                                                             abb + (size_t)(qb * 256) * 4096 + 2048 + hq * 128, SEQ, lds, tid);
    }
    int tid2 = tid; asm volatile("" : "+v"(tid2));
    const int lane_c = tid2 & 63;
    const float lam = __int_as_float(__builtin_amdgcn_readfirstlane(__float_as_int(__expf(wave_sum(lq1[lane_c] * lk1[lane_c] + lq1[lane_c + 64] * lk1[lane_c + 64])) - __expf(wave_sum(lq2[lane_c] * lk2[lane_c] + lq2[lane_c + 64] * lk2[lane_c + 64])) + LAMBDA_INIT)));
    for (int v = bid; v < 256; v += G) {
        __syncthreads();
        const int h = v >> 5, qb = v & 31;
        float* o1 = oc + (size_t)(qb * 256) * 2048 + h * 256;
        int tid4 = tid2; asm volatile("" : "+v"(tid4));
        att::attn_wide_body<9216, 9216, 2048, 2, float>(hb + (size_t)(qb * 256) * 9216 + h * 256, hb + 2048 + h * 256, hb + 4096 + h * 256, o1, SEQ, lds, tid4);
        __syncthreads();
        int tid3 = tid2; asm volatile("" : "+v"(tid3));
        att::attn_wide_body<9216, 9216, 2048, 2, float, true, 4096>(hb + (size_t)(qb * 256) * 9216 + h * 256 + 128, hb + 2048 + h * 256 + 128, hb + 4096 + h * 256, o1, SEQ, lds, tid3,
                                                                     lam, 1.0f - LAMBDA_INIT, subg, abb + (size_t)(qb * 256) * 4096 + h * 256);
    }
}


__device__ __forceinline__ void attn0_phase(const bf16_t* __restrict__ hb, const float* __restrict__ sink, bf16_t* __restrict__ abb, bf16_t* __restrict__ obg, float* __restrict__ lse, char* lds, const int bid, const int G, const int tid) {
    const long LD = 12288;
    for (int u = bid; u < 512; u += G) {
        __syncthreads();
        const int hq = u >> 5, qb = u & 31, kv = hq >> 2;
        att::attn_banded_body<128>(hb + hq * 128, hb + 2048 + kv * 128, hb + 2560 + kv * 128, LD, SEQ, qb * 256, sink[hq] * (1.0f / att::SCALE), 1.0f, abb + hq * 128, 3072, nullptr, 0, lds, tid);
    }
    int tid2 = tid; asm volatile("" : "+v"(tid2));
    for (int v = bid; v < 768; v += G) {
        __syncthreads();
        const int g = v >> 8, w = v & 255, h = w >> 5, rem = w & 31;
        const int dsh = 2 * g;
        const int nqb_sh = 5 - dsh;
        const int r = rem >> nqb_sh, qb = rem & ((1 << nqb_sh) - 1);
        const int head = 8 * g + h;
        const long rs = LD << dsh;
        att::attn_banded_body<64>(hb + (long)r * LD + 3072 + head * 128, hb + (long)r * LD + 6144 + head * 128, hb + (long)r * LD + 9216 + head * 128, rs, SEQ >> dsh, qb * 256, -1e30f, 0.f,
                                  obg + ((long)(g * 8 + h) * SEQ + r) * 128, (long)128 << dsh, lse + (long)(g * 8 + h) * SEQ + r, (long)1 << dsh, lds, tid2);
    }
}
__device__ __forceinline__ void merge0_phase(const bf16_t* __restrict__ obg, const float* __restrict__ lse, bf16_t* __restrict__ abb, const int bid, const int G, const int tid) {
    const int lane = tid & 63, wv = tid >> 6;
    for (int j = bid * 8 + wv; j < SEQ * 8; j += G * 8) {
        const int h = j >> 13, t = j & (SEQ - 1);
        const float l0 = lse[(size_t)(0 * 8 + h) * SEQ + t], l1 = lse[(size_t)(1 * 8 + h) * SEQ + t], l2 = lse[(size_t)(2 * 8 + h) * SEQ + t];
        const float mx = fmaxf(l0, fmaxf(l1, l2));
        const float e0 = __expf(l0 - mx), e1 = __expf(l1 - mx), e2 = __expf(l2 - mx), inv = 1.0f / (e0 + e1 + e2);
        const unsigned a0 = *(const unsigned*)(obg + ((size_t)(0 * 8 + h) * SEQ + t) * 128 + 2 * lane), a1 = *(const unsigned*)(obg + ((size_t)(1 * 8 + h) * SEQ + t) * 128 + 2 * lane), a2 = *(const unsigned*)(obg + ((size_t)(2 * 8 + h) * SEQ + t) * 128 + 2 * lane);
        const float x = (e0 * bf_lo(a0) + e1 * bf_lo(a1) + e2 * bf_lo(a2)) * inv, y = (e0 * bf_hi(a0) + e1 * bf_hi(a1) + e2 * bf_hi(a2)) * inv;
        *(unsigned*)(abb + (size_t)t * 3072 + 2048 + h * 128 + 2 * lane) = cvtpk_bf16(x, y);
    }
}

__device__ __forceinline__ void post_even_phase(const float* __restrict__ h, bf16_t* __restrict__ hb, const int bid, const int G, const int tid) {
    const int lane = tid & 63, wv = tid >> 6;
    for (int job = bid * 8 + wv; job < SEQ * 96; job += G * 8) {
        const int t = job / 96, blk = job - t * 96;
        const bool rope = (blk < 20) || (blk >= 24 && blk < 72);
        const float2 v = *(const float2*)(h + (size_t)t * 12288 + blk * 128 + 2 * lane);
        float o0 = v.x, o1 = v.y;
        const float p0 = __shfl_xor(v.x, 8), p1 = __shfl_xor(v.y, 8);
        if (rope && lane < 16) {
            const int i0 = (2 * lane) & 15;
            float s0, c0, s1, c1; sincos_rev((double)t * REV_P[i0], s0, c0); sincos_rev((double)t * REV_P[i0 + 1], s1, c1);
            if (lane < 8) { o0 = v.x * c0 - p0 * s0; o1 = v.y * c1 - p1 * s1; }
            else          { o0 = v.x * c0 + p0 * s0; o1 = v.y * c1 + p1 * s1; }
        }
        *(unsigned*)(hb + (size_t)t * 12288 + blk * 128 + 2 * lane) = cvtpk_bf16(o0, o1);
    }
}
__device__ __forceinline__ void post_odd_phase(const float* __restrict__ h, bf16_t* __restrict__ hb, const float* __restrict__ qg, const float* __restrict__ kg, const int bid, const int G, const int tid) {
    const int lane = tid & 63, wv = tid >> 6;
    for (int job = bid * 8 + wv; job < SEQ * 72; job += G * 8) {
        const int t = job / 72, blk = job - t * 72;
        const float2 v = *(const float2*)(h + (size_t)t * 9216 + blk * 128 + 2 * lane);
        float o0 = v.x, o1 = v.y;
        if (blk < 32) {
            const float p0 = __shfl_xor(v.x, 8), p1 = __shfl_xor(v.y, 8);
            if (lane < 16) {
                const int i0 = (2 * lane) & 15;
                float s0, c0, s1, c1; sincos_rev((double)t * REV_P[i0], s0, c0); sincos_rev((double)t * REV_P[i0 + 1], s1, c1);
                if (lane < 8) { o0 = v.x * c0 - p0 * s0; o1 = v.y * c1 - p1 * s1; }
                else          { o0 = v.x * c0 + p0 * s0; o1 = v.y * c1 + p1 * s1; }
            }
        } else if (blk >= 48 && blk < 68) {
            const float* g = blk < 64 ? qg : kg;
            const float ss = wave_sum(v.x * v.x + v.y * v.y) * (1.0f / 128.0f);
            const float rs = 1.0f / sqrtf(ss + 1e-6f);
            const float a0 = v.x * rs * g[2 * lane], a1 = v.y * rs * g[2 * lane + 1];
            const float p0 = __shfl_xor(a0, 16), p1 = __shfl_xor(a1, 16);
            const int i0 = (2 * lane) & 31;
            const double pos = (double)(lane < 32 ? (t >> 6) : (t & 63));
            float s0, c0, s1, c1; sincos_rev(pos * REV_A[i0], s0, c0); sincos_rev(pos * REV_A[i0 + 1], s1, c1);
            if ((lane & 16) == 0) { o0 = a0 * c0 - p0 * s0; o1 = a1 * c1 - p1 * s1; }
            else                  { o0 = a0 * c0 + p0 * s0; o1 = a1 * c1 + p1 * s1; }
        }
        *(unsigned*)(hb + (size_t)t * 9216 + blk * 128 + 2 * lane) = cvtpk_bf16(o0, o1);
    }
}

__device__ __forceinline__ void attn_seg_b(const float q0, const float q1, const bf16_t* __restrict__ Kb, const bf16_t* __restrict__ Vb, const int ld,
                                           const int t, const int step, int jlo, int jhi, float& m, float& l, float& o0, float& o1, const int lane) {
    { const int lo = -(t / step); if (jlo < lo) jlo = lo; const int hi = (SEQ - 1 - t) / step; if (jhi > hi) jhi = hi; }
    for (int j = jlo; j <= jhi; ++j) {
        const size_t tp = (size_t)(t + step * j);
        const unsigned kw = *(const unsigned*)(Kb + tp * ld + 2 * lane), vw = *(const unsigned*)(Vb + tp * ld + 2 * lane);
        const float s = wave_sum(q0 * bf_lo(kw) + q1 * bf_hi(kw)) * ATT_SCALE;
        const float mn = fmaxf(m, s);
        const float al = __expf(m - mn), p = __expf(s - mn);
        l = l * al + p;
        o0 = o0 * al + p * bf_lo(vw); o1 = o1 * al + p * bf_hi(vw);
        m = mn;
    }
}
__device__ __forceinline__ void attn_even_valu_phase(const bf16_t* __restrict__ hb, const float* __restrict__ sink, bf16_t* __restrict__ abb, const int bid, const int G, const int tid) {
    const int lane = tid & 63, wv = tid >> 6;
    const int LD = 12288;
    for (int job = bid * 8 + wv; job < SEQ * 24; job += G * 8) {
        const int hh = job / SEQ, t = job % SEQ;
        float o0 = 0.f, o1 = 0.f, m, l;
        if (hh < 16) {
            const int kv = hh >> 2;
            const unsigned qw = *(const unsigned*)(hb + (size_t)t * LD + hh * 128 + 2 * lane);
            m = sink[hh]; l = 1.f;
            attn_seg_b(bf_lo(qw), bf_hi(qw), hb + 2048 + kv * 128, hb + 2560 + kv * 128, LD, t, 1, -128, 128, m, l, o0, o1, lane);
        } else {
            const int hbh = hh - 16;
            m = -1e30f; l = 0.f;
#pragma unroll
            for (int g = 0; g < 3; ++g) {
                const int head = 8 * g + hbh; const int step = g == 0 ? 1 : (g == 1 ? 4 : 16);
                const unsigned qw = *(const unsigned*)(hb + (size_t)t * LD + 3072 + head * 128 + 2 * lane);
                attn_seg_b(bf_lo(qw), bf_hi(qw), hb + 6144 + head * 128, hb + 9216 + head * 128, LD, t, step, -64, 64, m, l, o0, o1, lane);
            }
        }
        const float il = 1.0f / l;
        *(unsigned*)(abb + (size_t)t * 3072 + hh * 128 + 2 * lane) = cvtpk_bf16(o0 * il, o1 * il);
    }
}

__device__ __forceinline__ void ln_phase(const float* __restrict__ y, const float* __restrict__ g, const float* __restrict__ b, float* __restrict__ stats, bf16_t* __restrict__ outb, const int bid, const int G, const int tid) {
    const int lane = tid & 63, wv = tid >> 6;
    for (int t = bid * 8 + wv; t < SEQ; t += G * 8) {
        float4 v[16]; float s = 0.f;
#pragma unroll
        for (int i = 0; i < 16; ++i) { v[i] = *(const float4*)(y + (size_t)t * DM + i * 256 + lane * 4); s += (v[i].x + v[i].y) + (v[i].z + v[i].w); }
        const float mean = wave_sum(s) * (1.0f / DM);
        float q = 0.f;
#pragma unroll
        for (int i = 0; i < 16; ++i) { const float a = v[i].x - mean, bb = v[i].y - mean, c = v[i].z - mean, d = v[i].w - mean; q += (a * a + bb * bb) + (c * c + d * d); }
        const float rstd = 1.0f / sqrtf(wave_sum(q) * (1.0f / DM) + 1e-5f);
        if (lane == 0) *(float2*)(stats + (size_t)t * 2) = make_float2(mean, rstd);
#pragma unroll
        for (int i = 0; i < 16; ++i) {
            const float4 gg = *(const float4*)(g + i * 256 + lane * 4), bb = *(const float4*)(b + i * 256 + lane * 4);
            float4 o; o.x = (v[i].x - mean) * rstd * gg.x + bb.x; o.y = (v[i].y - mean) * rstd * gg.y + bb.y; o.z = (v[i].z - mean) * rstd * gg.z + bb.z; o.w = (v[i].w - mean) * rstd * gg.w + bb.w;
            uint2 w; w.x = cvtpk_bf16(o.x, o.y); w.y = cvtpk_bf16(o.z, o.w); *(uint2*)(outb + (size_t)t * DM + i * 256 + lane * 4) = w;
            if ((i & 3) == 3) asm volatile("" ::: "memory");
        }
    }
}

__device__ __forceinline__ void route_valu_phase(const float* __restrict__ q  , const float* __restrict__ keys  , int* __restrict__ eidx, float* __restrict__ gate, const int bid, const int G, const int tid) {
    const int lane = tid & 63, wv = tid >> 6;
    for (int job = bid * 8 + wv; job < SEQ * 8; job += G * 8) {
        const int hh = job & 7, t = job >> 3;
        float sv0 = 0.f, sv1 = 0.f; int si0 = 0, si1 = 0;
#pragma unroll
        for (int c = 0; c < 2; ++c) {
            const float* qq = q + (size_t)t * 2048 + hh * 256 + c * 128;
            const float* k0 = keys + ((size_t)(hh * 2 + c) * 128 + lane) * 128;
            const float* k1 = k0 + 64 * 128;
            float s0 = 0.f, s1 = 0.f;
            for (int d = 0; d < 128; d += 4) {
                const float4 qv = *(const float4*)(qq + d), a = *(const float4*)(k0 + d), b = *(const float4*)(k1 + d);
                s0 += qv.x * a.x + qv.y * a.y + qv.z * a.z + qv.w * a.w;
                s1 += qv.x * b.x + qv.y * b.y + qv.z * b.z + qv.w * b.w;
            }
            float myv = 0.f; int myi = 0;
            for (int k = 0; k < 16; ++k) {
                float bv; int bi;
                if (s1 > s0) { bv = s1; bi = lane + 64; } else { bv = s0; bi = lane; }
#pragma unroll
                for (int o = 32; o >= 1; o >>= 1) {
                    const float ov = __shfl_xor(bv, o); const int oi = __shfl_xor(bi, o);
                    if (ov > bv || (ov == bv && oi < bi)) { bv = ov; bi = oi; }
                }
                if (lane == k) { myv = bv; myi = bi; }
                if (bi == lane) s0 = -3.0e38f;
                if (bi == lane + 64) s1 = -3.0e38f;
            }
            if (c == 0) { sv0 = myv; si0 = myi; } else { sv1 = myv; si1 = myi; }
        }
        float cv0, cv1, cv2, cv3; int ci0, ci1, ci2, ci3;
        { const float a = __shfl(sv0, lane >> 2); const int ai = __shfl(si0, lane >> 2); const int jb = (lane & 3) * 4;
          cv0 = a + __shfl(sv1, jb + 0); ci0 = ai * 128 + __shfl(si1, jb + 0);
          cv1 = a + __shfl(sv1, jb + 1); ci1 = ai * 128 + __shfl(si1, jb + 1);
          cv2 = a + __shfl(sv1, jb + 2); ci2 = ai * 128 + __shfl(si1, jb + 2);
          cv3 = a + __shfl(sv1, jb + 3); ci3 = ai * 128 + __shfl(si1, jb + 3); }
        float tv = 0.f; int te = 0;
        for (int k = 0; k < 16; ++k) {
            float bv = cv0; int bp = lane * 4, be = ci0;
            if (cv1 > bv) { bv = cv1; bp = lane * 4 + 1; be = ci1; }
            if (cv2 > bv) { bv = cv2; bp = lane * 4 + 2; be = ci2; }
            if (cv3 > bv) { bv = cv3; bp = lane * 4 + 3; be = ci3; }
#pragma unroll
            for (int o = 32; o >= 1; o >>= 1) {
                const float ov = __shfl_xor(bv, o); const int op = __shfl_xor(bp, o); const int oe = __shfl_xor(be, o);
                if (ov > bv || (ov == bv && op < bp)) { bv = ov; bp = op; be = oe; }
            }
            if (lane == k) { tv = bv; te = be; }
            if (bp == lane * 4 + 0) cv0 = -3.0e38f;
            if (bp == lane * 4 + 1) cv1 = -3.0e38f;
            if (bp == lane * 4 + 2) cv2 = -3.0e38f;
            if (bp == lane * 4 + 3) cv3 = -3.0e38f;
        }
        const float v = lane < 16 ? tv : -3.0e38f;
        const float mx = wave_max(v);
        const float e = lane < 16 ? __expf(tv - mx) : 0.f;
        const float den = wave_sum(e);
        if (lane < 16) { eidx[(size_t)t * 128 + hh * 16 + lane] = te; gate[(size_t)t * 128 + hh * 16 + lane] = e / den; }
    }
}
namespace rt {
using att::f32x16; using att::bf16x8;
__device__ __forceinline__ float pair_max(float m) {
    auto rr = __builtin_amdgcn_permlane32_swap(__float_as_uint(m), __float_as_uint(m), false, false);
    return fmaxf(__uint_as_float(rr[0]), __uint_as_float(rr[1]));
}
__device__ __forceinline__ int pair_max_i(int m) {
    auto rr = __builtin_amdgcn_permlane32_swap((unsigned)m, (unsigned)m, false, false);
    const int a = (int)rr[0], b = (int)rr[1]; return a > b ? a : b;
}
__device__ __forceinline__ void top16_of_128(f32x16& p0, f32x16& p1, f32x16& p2, f32x16& p3, float (&t)[16]) {
#pragma unroll
    for (int k = 0; k < 16; ++k) {
        float m = p0[0];
#pragma unroll
        for (int r = 1; r < 16; ++r) m = fmaxf(m, p0[r]);
#pragma unroll
        for (int r = 0; r < 16; ++r) m = fmaxf(m, fmaxf(p1[r], fmaxf(p2[r], p3[r])));
        m = pair_max(m);
        t[k] = m;
#pragma unroll
        for (int r = 0; r < 16; ++r) { p0[r] = p0[r] == m ? -3.0e38f : p0[r]; p1[r] = p1[r] == m ? -3.0e38f : p1[r]; p2[r] = p2[r] == m ? -3.0e38f : p2[r]; p3[r] = p3[r] == m ? -3.0e38f : p3[r]; }
    }
}
__device__ __forceinline__ void tag_scores(f32x16& p, const int base, const int hi) {
#pragma unroll
    for (int r = 0; r < 16; ++r) p[r] = __uint_as_float((__float_as_uint(p[r]) & ~0x7Fu) | (unsigned)(base + att::crow(r, hi)));
}
}

__device__ __forceinline__ void route_mfma_phase(const bf16_t* __restrict__ pqb  , const bf16_t* __restrict__ keysb  , int* __restrict__ eidx, float* __restrict__ gate,
                                                 char* lds, const pg8::StaticOrder& S, const int tid) {
    using namespace rt;
    const int wid = __builtin_amdgcn_readfirstlane(tid >> 6), lane = tid & 63, r32 = lane & 31, hi = lane >> 5;
    att::bf16* K_lds = (att::bf16*)lds;
    pg8::Unit un;
    for (int ui = 0; S.next(ui, un); ++ui) {
        const int h = un.pn, tb = un.pm * 256;
        const int tok = tb + wid * 32 + r32;
        float t0[16], t1[16];
#pragma unroll
        for (int c = 0; c < 2; ++c) {
            __syncthreads();
            { const bf16_t* kp = keysb + (size_t)(h * 2 + c) * 128 * 128;
              const int row = tid >> 2;
#pragma unroll
              for (int i = 0; i < 4; ++i) { const int sc = ((tid & 3) * 4 + i) * 8;
                  const bf16x8 v = *reinterpret_cast<const bf16x8*>(kp + row * 128 + sc);
                  *(bf16x8*)((char*)K_lds + (row >> 6) * 16384 + KSWZ(row & 63, sc * 2)) = v; } }
            bf16x8 qr[8];
            { const bf16_t* qw = pqb + (size_t)tok * 2048 + h * 256 + c * 128 + hi * 8;
#pragma unroll
              for (int d0 = 0; d0 < 8; ++d0) qr[d0] = *reinterpret_cast<const bf16x8*>(qw + d0 * 16); }
            __syncthreads();
            f32x16 p0, p1, p2, p3;
            att::qkt_pipe(p0, p1, (int)(uintptr_t)K_lds, qr, r32, hi);
            att::qkt_pipe(p2, p3, (int)(uintptr_t)K_lds + 16384, qr, r32, hi);
            tag_scores(p0, 0, hi); tag_scores(p1, 32, hi); tag_scores(p2, 64, hi); tag_scores(p3, 96, hi);
            if (c == 0) top16_of_128(p0, p1, p2, p3, t0); else top16_of_128(p0, p1, p2, p3, t1);
        }
        float v0[16], v1[16]; int k0[16], k1[16];
#pragma unroll
        for (int i = 0; i < 16; ++i) { const unsigned a = __float_as_uint(t0[i]), b = __float_as_uint(t1[i]);
            v0[i] = __uint_as_float(a & ~0x7Fu); v1[i] = __uint_as_float(b & ~0x7Fu); k0[i] = (int)((a & 0x7Fu) << 7); k1[i] = (int)(b & 0x7Fu); }
        float cv[25]; int ce[25];
    { const float s = hi ? (v0[0] + v1[1]) : (v0[0] + v1[0]); cv[0] = __uint_as_float((__float_as_uint(s) & ~0xFFu) | (unsigned)(2 * 0 + hi)); ce[0] = hi ? (k0[0] | k1[1]) : (k0[0] | k1[0]); }
    { const float s = hi ? (v0[0] + v1[3]) : (v0[0] + v1[2]); cv[1] = __uint_as_float((__float_as_uint(s) & ~0xFFu) | (unsigned)(2 * 1 + hi)); ce[1] = hi ? (k0[0] | k1[3]) : (k0[0] | k1[2]); }
    { const float s = hi ? (v0[0] + v1[5]) : (v0[0] + v1[4]); cv[2] = __uint_as_float((__float_as_uint(s) & ~0xFFu) | (unsigned)(2 * 2 + hi)); ce[2] = hi ? (k0[0] | k1[5]) : (k0[0] | k1[4]); }
    { const float s = hi ? (v0[0] + v1[7]) : (v0[0] + v1[6]); cv[3] = __uint_as_float((__float_as_uint(s) & ~0xFFu) | (unsigned)(2 * 3 + hi)); ce[3] = hi ? (k0[0] | k1[7]) : (k0[0] | k1[6]); }
    { const float s = hi ? (v0[0] + v1[9]) : (v0[0] + v1[8]); cv[4] = __uint_as_float((__float_as_uint(s) & ~0xFFu) | (unsigned)(2 * 4 + hi)); ce[4] = hi ? (k0[0] | k1[9]) : (k0[0] | k1[8]); }
    { const float s = hi ? (v0[0] + v1[11]) : (v0[0] + v1[10]); cv[5] = __uint_as_float((__float_as_uint(s) & ~0xFFu) | (unsigned)(2 * 5 + hi)); ce[5] = hi ? (k0[0] | k1[11]) : (k0[0] | k1[10]); }
    { const float s = hi ? (v0[0] + v1[13]) : (v0[0] + v1[12]); cv[6] = __uint_as_float((__float_as_uint(s) & ~0xFFu) | (unsigned)(2 * 6 + hi)); ce[6] = hi ? (k0[0] | k1[13]) : (k0[0] | k1[12]); }
    { const float s = hi ? (v0[0] + v1[15]) : (v0[0] + v1[14]); cv[7] = __uint_as_float((__float_as_uint(s) & ~0xFFu) | (unsigned)(2 * 7 + hi)); ce[7] = hi ? (k0[0] | k1[15]) : (k0[0] | k1[14]); }
    { const float s = hi ? (v0[1] + v1[1]) : (v0[1] + v1[0]); cv[8] = __uint_as_float((__float_as_uint(s) & ~0xFFu) | (unsigned)(2 * 8 + hi)); ce[8] = hi ? (k0[1] | k1[1]) : (k0[1] | k1[0]); }
    { const float s = hi ? (v0[1] + v1[3]) : (v0[1] + v1[2]); cv[9] = __uint_as_float((__float_as_uint(s) & ~0xFFu) | (unsigned)(2 * 9 + hi)); ce[9] = hi ? (k0[1] | k1[3]) : (k0[1] | k1[2]); }
    { const float s = hi ? (v0[1] + v1[5]) : (v0[1] + v1[4]); cv[10] = __uint_as_float((__float_as_uint(s) & ~0xFFu) | (unsigned)(2 * 10 + hi)); ce[10] = hi ? (k0[1] | k1[5]) : (k0[1] | k1[4]); }
    { const float s = hi ? (v0[1] + v1[7]) : (v0[1] + v1[6]); cv[11] = __uint_as_float((__float_as_uint(s) & ~0xFFu) | (unsigned)(2 * 11 + hi)); ce[11] = hi ? (k0[1] | k1[7]) : (k0[1] | k1[6]); }
    { const float s = hi ? (v0[2] + v1[1]) : (v0[2] + v1[0]); cv[12] = __uint_as_float((__float_as_uint(s) & ~0xFFu) | (unsigned)(2 * 12 + hi)); ce[12] = hi ? (k0[2] | k1[1]) : (k0[2] | k1[0]); }
    { const float s = hi ? (v0[2] + v1[3]) : (v0[2] + v1[2]); cv[13] = __uint_as_float((__float_as_uint(s) & ~0xFFu) | (unsigned)(2 * 13 + hi)); ce[13] = hi ? (k0[2] | k1[3]) : (k0[2] | k1[2]); }
    { const float s = hi ? (v0[3] + v1[0]) : (v0[2] + v1[4]); cv[14] = __uint_as_float((__float_as_uint(s) & ~0xFFu) | (unsigned)(2 * 14 + hi)); ce[14] = hi ? (k0[3] | k1[0]) : (k0[2] | k1[4]); }
    { const float s = hi ? (v0[3] + v1[2]) : (v0[3] + v1[1]); cv[15] = __uint_as_float((__float_as_uint(s) & ~0xFFu) | (unsigned)(2 * 15 + hi)); ce[15] = hi ? (k0[3] | k1[2]) : (k0[3] | k1[1]); }
    { const float s = hi ? (v0[4] + v1[0]) : (v0[3] + v1[3]); cv[16] = __uint_as_float((__float_as_uint(s) & ~0xFFu) | (unsigned)(2 * 16 + hi)); ce[16] = hi ? (k0[4] | k1[0]) : (k0[3] | k1[3]); }
    { const float s = hi ? (v0[4] + v1[2]) : (v0[4] + v1[1]); cv[17] = __uint_as_float((__float_as_uint(s) & ~0xFFu) | (unsigned)(2 * 17 + hi)); ce[17] = hi ? (k0[4] | k1[2]) : (k0[4] | k1[1]); }
    { const float s = hi ? (v0[5] + v1[1]) : (v0[5] + v1[0]); cv[18] = __uint_as_float((__float_as_uint(s) & ~0xFFu) | (unsigned)(2 * 18 + hi)); ce[18] = hi ? (k0[5] | k1[1]) : (k0[5] | k1[0]); }
    { const float s = hi ? (v0[6] + v1[1]) : (v0[6] + v1[0]); cv[19] = __uint_as_float((__float_as_uint(s) & ~0xFFu) | (unsigned)(2 * 19 + hi)); ce[19] = hi ? (k0[6] | k1[1]) : (k0[6] | k1[0]); }
    { const float s = hi ? (v0[7] + v1[1]) : (v0[7] + v1[0]); cv[20] = __uint_as_float((__float_as_uint(s) & ~0xFFu) | (unsigned)(2 * 20 + hi)); ce[20] = hi ? (k0[7] | k1[1]) : (k0[7] | k1[0]); }
    { const float s = hi ? (v0[9] + v1[0]) : (v0[8] + v1[0]); cv[21] = __uint_as_float((__float_as_uint(s) & ~0xFFu) | (unsigned)(2 * 21 + hi)); ce[21] = hi ? (k0[9] | k1[0]) : (k0[8] | k1[0]); }
    { const float s = hi ? (v0[11] + v1[0]) : (v0[10] + v1[0]); cv[22] = __uint_as_float((__float_as_uint(s) & ~0xFFu) | (unsigned)(2 * 22 + hi)); ce[22] = hi ? (k0[11] | k1[0]) : (k0[10] | k1[0]); }
    { const float s = hi ? (v0[13] + v1[0]) : (v0[12] + v1[0]); cv[23] = __uint_as_float((__float_as_uint(s) & ~0xFFu) | (unsigned)(2 * 23 + hi)); ce[23] = hi ? (k0[13] | k1[0]) : (k0[12] | k1[0]); }
    { const float s = hi ? (v0[15] + v1[0]) : (v0[14] + v1[0]); cv[24] = __uint_as_float((__float_as_uint(s) & ~0xFFu) | (unsigned)(2 * 24 + hi)); ce[24] = hi ? (k0[15] | k1[0]) : (k0[14] | k1[0]); }
        float ts[16]; int te[16];
#pragma unroll
        for (int k = 0; k < 16; ++k) {
            float m = cv[0];
#pragma unroll
            for (int n = 1; n < 25; ++n) m = fmaxf(m, cv[n]);
            m = pair_max(m);
            int e = -1;
#pragma unroll
            for (int n = 0; n < 25; ++n) { const bool hit = cv[n] == m; e = hit ? ce[n] : e; cv[n] = hit ? -3.0e38f : cv[n]; }
            ts[k] = __uint_as_float(__float_as_uint(m) & ~0xFFu); te[k] = pair_max_i(e);
        }
        float den = 0.f; const float mx = ts[0];
#pragma unroll
        for (int k = 0; k < 16; ++k) { ts[k] = __expf(ts[k] - mx); den += ts[k]; }
        const float inv = 1.0f / den;
        if (hi == 0) { int4* op = (int4*)(eidx + (size_t)tok * 128 + h * 16);
            op[0] = make_int4(te[0], te[1], te[2], te[3]); op[1] = make_int4(te[4], te[5], te[6], te[7]); op[2] = make_int4(te[8], te[9], te[10], te[11]); op[3] = make_int4(te[12], te[13], te[14], te[15]); }
        else { float4* op = (float4*)(gate + (size_t)tok * 128 + h * 16);
            op[0] = make_float4(ts[0] * inv, ts[1] * inv, ts[2] * inv, ts[3] * inv); op[1] = make_float4(ts[4] * inv, ts[5] * inv, ts[6] * inv, ts[7] * inv);
            op[2] = make_float4(ts[8] * inv, ts[9] * inv, ts[10] * inv, ts[11] * inv); op[3] = make_float4(ts[12] * inv, ts[13] * inv, ts[14] * inv, ts[15] * inv); }
    }
}
#ifndef PH_MASK
#define PH_MASK 0xffffffffu
#endif
constexpr int N_PHASES = 20;
__global__ void __launch_bounds__(512, 2) mega(MK a) {
    extern __shared__ __attribute__((aligned(16))) unsigned char lds_raw[];
    LDSA unsigned char* lds = (LDSA unsigned char*)lds_raw;
    const int lo = a.ph_lo, hi = a.ph_hi;
    const int G = gridDim.x, bid = blockIdx.x;
    const int wid_s = __builtin_amdgcn_readfirstlane(threadIdx.x >> 6);
    unsigned char* ws = a.ws;
#define PH_TID() int tid; { int _z = 0; asm volatile("" : "+s"(_z)); tid = wid_s * 64 + (int)__builtin_amdgcn_mbcnt_hi(~0u, __builtin_amdgcn_mbcnt_lo(~0u, (unsigned)_z)); }
#define WSP(T, name, off) T* name; { unsigned char* _b = ws; asm volatile("" : "+s"(_b)); name = (T*)(_b + (off)); }
#define IN(k) ((((PH_MASK) >> (k)) & 1u) && lo <= (k) && (k) < hi)
#define SEAM(k) do { if ((k) + 1 < hi) { PH_TID() xcd_barrier(bar, tid); } } while (0)
    XcdBarrier bar;
    { PH_TID()
      volatile LAS unsigned* st = (volatile LAS unsigned*)(lds + LDS_MISC);
      if (tid == 0) { st[0] = 0u; st[1] = 0u; }
      __syncthreads();
      bar = xcd_barrier_post((unsigned*)(ws + WS_CTL), st, tid); }

    if (IN(0)) {
      {
        PH_TID()
        WSP(bf16_t, xb, WS_XB) WSP(bf16_t, wab, WS_WAB) WSP(bf16_t, woab, WS_WOAB) WSP(bf16_t, wcd, WS_WCD) WSP(bf16_t, wocd, WS_WOCD) WSP(bf16_t, wq, WS_WQ) WSP(unsigned char, ub, WS_UB) WSP(unsigned char, vb, WS_VB) WSP(float, isu, WS_SU) WSP(float, isv, WS_SV)
        cvt_rows_bf16(a.in[0], xb, (size_t)SEQ * DM / 8, bid, G, tid, 512);
        LDSA float* tile = (LDSA float*)lds;
        transpose_cvt(a.in[1], wab, 4096, 12288, tile, bid, G, PermAB(), tid);
        transpose_cvt(a.in[3], woab, 3072, 4096, tile, bid, G, PermNone(), tid);
        transpose_cvt(a.in[4], wcd, 4096, 9216, tile, bid, G, PermCD(), tid);
        transpose_cvt(a.in[12], wocd, 4096, 4096, tile, bid, G, PermNone(), tid);
        transpose_cvt(a.in[15], wq, 4096, 2048, tile, bid, G, PermNone(), tid);
        transpose_cvt(a.in[15] + (size_t)4096 * 2048, wq + (size_t)2048 * 4096, 4096, 2048, tile, bid, G, PermNone(), tid);
        table_fp6(a.in[17], ub, isu, 2 * 16384, (LDSA float*)lds, bid, G, tid);
        { const int nu1 = (SEQ / 256) * (9216 / 256); const bool slack = (nu1 % G) != 0 && (nu1 % G) <= G / 2;
          table_fp6(a.in[18], vb, isv, slack ? 16384 : 2 * 16384, (LDSA float*)lds, bid, G, tid); }
        { WSP(float, cs0, WS_CS0) WSP(float, csa, WS_CSA) rope_tables(cs0, csa, bid, G, tid); }
        { WSP(bf16_t, keyb, WS_KEYB) cvt_rows_bf16(a.in[16], keyb, (size_t)2 * 8 * 2 * 128 * 128 / 8, bid, G, tid, 512); }
      }
        SEAM(0);
    }
    { constexpr int layer = 0;
        const int pb = 1 + 10 * layer;
        if (IN(pb + 0)) {
            PH_TID() WSP(bf16_t, xb, WS_XB) WSP(bf16_t, x2b, WS_X2B) WSP(bf16_t, wab, WS_WAB) WSP(bf16_t, wcd, WS_WCD) WSP(bf16_t, hb, WS_HB) WSP(float, cs0, WS_CS0) WSP(float, csa, WS_CSA)
            if (layer == 0) {
                pg8::Gemm g{xb, wab, SEQ, 12288, 4096}; pg8::StaticOrder S; S.init(SEQ, 12288, G, bid);
                pg8::EpiProj<0> E{hb, 12288, cs0, csa, nullptr, nullptr, (LDSA float*)(lds + LDS_MISC + 64)};
                pg8::gemm_phase<pg8::EpiProj<0>, pg8::StaticOrder>(lds, g, S, E, nullptr, tid);
            } else {
                pg8::Gemm g{x2b, wcd, SEQ, 9216, 4096}; pg8::StaticOrder S; S.init(SEQ, 9216, G, bid);
                pg8::EpiProj<1> E{hb, 9216, cs0, csa, a.in[10], a.in[11], (LDSA float*)(lds + LDS_MISC + 64)};
                pg8::gemm_phase<pg8::EpiProj<1>, pg8::StaticOrder>(lds, g, S, E, nullptr, tid);
                { const int nu1 = (SEQ / 256) * (9216 / 256), busy = nu1 % G; const bool slack = busy != 0 && busy <= G / 2;
                  if (slack && bid >= busy) {
                      WSP(unsigned char, vb1, WS_VB) WSP(float, isv1, WS_SV)
                      int t5; { int _z = 0; asm volatile("" : "+s"(_z)); t5 = wid_s * 64 + (int)__builtin_amdgcn_mbcnt_hi(~0u, __builtin_amdgcn_mbcnt_lo(~0u, (unsigned)_z)); }
                      table_fp6(a.in[18] + (size_t)16384 * DM, vb1 + (size_t)16384 * ROWB, isv1 + 16384, 16384, (LDSA float*)lds, bid - busy, G - busy, t5); } }
            }
            SEAM(pb + 0);
        }
        if (IN(pb + 2)) {
            PH_TID() WSP(bf16_t, hb, WS_HB) WSP(bf16_t, abb, WS_AB) WSP(float, oc, WS_OC)
            if (layer == 0) attn0_phase(hb, a.in[2], abb, (bf16_t*)oc, (float*)((unsigned char*)oc + (size_t)3 * 8 * SEQ * 128 * 2), (char*)lds_raw, bid, G, tid);
            else attn1_phase(hb, abb, oc, a.in[5], a.in[6], a.in[7], a.in[8], a.in[9], (char*)lds_raw, bid, G, tid);
            SEAM(pb + 2);
        }
        if (layer == 0) {
            if (IN(pb + 3)) {
                PH_TID() WSP(bf16_t, abb, WS_AB) WSP(float, oc, WS_OC)
                merge0_phase((const bf16_t*)oc, (const float*)((unsigned char*)oc + (size_t)3 * 8 * SEQ * 128 * 2), abb, bid, G, tid);
                SEAM(pb + 3);
            }
        } else {
        }
        if (IN(pb + 4)) {
            const int K = layer == 0 ? 3072 : 4096;
            PH_TID() WSP(bf16_t, abb, WS_AB) WSP(bf16_t, woab, WS_WOAB) WSP(bf16_t, wocd, WS_WOCD) WSP(float, ybuf, WS_Y) WSP(float, x2, WS_X2)
            pg8::Gemm g{abb, layer == 0 ? woab : wocd, SEQ, 4096, K}; pg8::StaticOrder S; S.init(SEQ, 4096, G, bid);
            pg8::EpiF32R E{ybuf, 4096, layer == 0 ? a.in[0] : (const float*)x2, ALPHA};
            pg8::gemm_phase<pg8::EpiF32R, pg8::StaticOrder>(lds, g, S, E, nullptr, tid);
            SEAM(pb + 4);
        }
        if (IN(pb + 5)) {
            PH_TID() WSP(float, ybuf, WS_Y) WSP(float, stats, WS_X1) WSP(bf16_t, x1b, WS_X1B)
            ln_phase(ybuf, a.in[13] + layer * DM, a.in[14] + layer * DM, stats, x1b, bid, G, tid);
            SEAM(pb + 5);
        }
        if (IN(pb + 6)) {
            PH_TID() WSP(bf16_t, x1b, WS_X1B) WSP(bf16_t, wq, WS_WQ) WSP(bf16_t, pqb, WS_PQ)
            pg8::Gemm g{x1b, wq + (size_t)layer * 2048 * 4096, SEQ, 2048, 4096}; pg8::StaticOrder S; S.init(SEQ, 2048, G, bid);
            pg8::EpiBf16P E{pqb, 2048};
            pg8::gemm_phase<pg8::EpiBf16P, pg8::StaticOrder>(lds, g, S, E, nullptr, tid);
            asm volatile("s_waitcnt vmcnt(0)" ::: "memory"); __syncthreads();
            { WSP(bf16_t, keyb, WS_KEYB) WSP(int, eidx, WS_EIDX) WSP(float, gate, WS_GATE)
              int t4 = tid; asm volatile("" : "+v"(t4));
              route_mfma_phase(pqb, keyb + (size_t)layer * 8 * 2 * 128 * 128, eidx, gate, (char*)lds_raw, S, t4); }
            SEAM(pb + 6);
        }
        if (IN(pb + 8)) {
            PH_TID() WSP(float, ybuf, WS_Y) WSP(float, stats, WS_X1) WSP(bf16_t, x1b, WS_X1B) WSP(int, eidx, WS_EIDX) WSP(float, gate, WS_GATE) WSP(unsigned char, ub, WS_UB) WSP(unsigned char, vb, WS_VB) WSP(float, isu, WS_SU) WSP(float, isv, WS_SV) WSP(float, x2, WS_X2) WSP(bf16_t, x2b, WS_X2B)
            peer_expert_phase(ybuf, stats, a.in[13] + layer * DM, a.in[14] + layer * DM, x1b, eidx, gate, ub + (size_t)layer * 16384 * ROWB, vb + (size_t)layer * 16384 * ROWB, isu + layer * 16384, isv + layer * 16384, a.in[19] + layer * DM, a.in[20] + layer * DM,
                              layer == 0 ? x2 : a.out, layer == 0 ? x2b : (bf16_t*)nullptr, (LDSA float*)lds, bid, G, tid);
            SEAM(pb + 8);
        }
        }
    { constexpr int layer = 1;
        const int pb = 1 + 10 * layer;
        if (IN(pb + 0)) {
            PH_TID() WSP(bf16_t, xb, WS_XB) WSP(bf16_t, x2b, WS_X2B) WSP(bf16_t, wab, WS_WAB) WSP(bf16_t, wcd, WS_WCD) WSP(bf16_t, hb, WS_HB) WSP(float, cs0, WS_CS0) WSP(float, csa, WS_CSA)
            if (layer == 0) {
                pg8::Gemm g{xb, wab, SEQ, 12288, 4096}; pg8::StaticOrder S; S.init(SEQ, 12288, G, bid);
                pg8::EpiProj<0> E{hb, 12288, cs0, csa, nullptr, nullptr, (LDSA float*)(lds + LDS_MISC + 64)};
                pg8::gemm_phase<pg8::EpiProj<0>, pg8::StaticOrder>(lds, g, S, E, nullptr, tid);
            } else {
                pg8::Gemm g{x2b, wcd, SEQ, 9216, 4096}; pg8::StaticOrder S; S.init(SEQ, 9216, G, bid);
                pg8::EpiProj<1> E{hb, 9216, cs0, csa, a.in[10], a.in[11], (LDSA float*)(lds + LDS_MISC + 64)};
                pg8::gemm_phase<pg8::EpiProj<1>, pg8::StaticOrder>(lds, g, S, E, nullptr, tid);
                { const int nu1 = (SEQ / 256) * (9216 / 256), busy = nu1 % G; const bool slack = busy != 0 && busy <= G / 2;
                  if (slack && bid >= busy) {
                      WSP(unsigned char, vb1, WS_VB) WSP(float, isv1, WS_SV)
                      int t5; { int _z = 0; asm volatile("" : "+s"(_z)); t5 = wid_s * 64 + (int)__builtin_amdgcn_mbcnt_hi(~0u, __builtin_amdgcn_mbcnt_lo(~0u, (unsigned)_z)); }
                      table_fp6(a.in[18] + (size_t)16384 * DM, vb1 + (size_t)16384 * ROWB, isv1 + 16384, 16384, (LDSA float*)lds, bid - busy, G - busy, t5); } }
            }
            SEAM(pb + 0);
        }
        if (IN(pb + 2)) {
            PH_TID() WSP(bf16_t, hb, WS_HB) WSP(bf16_t, abb, WS_AB) WSP(float, oc, WS_OC)
            if (layer == 0) attn0_phase(hb, a.in[2], abb, (bf16_t*)oc, (float*)((unsigned char*)oc + (size_t)3 * 8 * SEQ * 128 * 2), (char*)lds_raw, bid, G, tid);
            else attn1_phase(hb, abb, oc, a.in[5], a.in[6], a.in[7], a.in[8], a.in[9], (char*)lds_raw, bid, G, tid);
            SEAM(pb + 2);
        }
        if (layer == 0) {
            if (IN(pb + 3)) {
                PH_TID() WSP(bf16_t, abb, WS_AB) WSP(float, oc, WS_OC)
                merge0_phase((const bf16_t*)oc, (const float*)((unsigned char*)oc + (size_t)3 * 8 * SEQ * 128 * 2), abb, bid, G, tid);
                SEAM(pb + 3);
            }
        } else {
        }
        if (IN(pb + 4)) {
            const int K = layer == 0 ? 3072 : 4096;
            PH_TID() WSP(bf16_t, abb, WS_AB) WSP(bf16_t, woab, WS_WOAB) WSP(bf16_t, wocd, WS_WOCD) WSP(float, ybuf, WS_Y) WSP(float, x2, WS_X2)
            pg8::Gemm g{abb, layer == 0 ? woab : wocd, SEQ, 4096, K}; pg8::StaticOrder S; S.init(SEQ, 4096, G, bid);
            pg8::EpiF32R E{ybuf, 4096, layer == 0 ? a.in[0] : (const float*)x2, ALPHA};
            pg8::gemm_phase<pg8::EpiF32R, pg8::StaticOrder>(lds, g, S, E, nullptr, tid);
            SEAM(pb + 4);
        }
        if (IN(pb + 5)) {
            PH_TID() WSP(float, ybuf, WS_Y) WSP(float, stats, WS_X1) WSP(bf16_t, x1b, WS_X1B)
            ln_phase(ybuf, a.in[13] + layer * DM, a.in[14] + layer * DM, stats, x1b, bid, G, tid);
            SEAM(pb + 5);
        }
        if (IN(pb + 6)) {
            PH_TID() WSP(bf16_t, x1b, WS_X1B) WSP(bf16_t, wq, WS_WQ) WSP(bf16_t, pqb, WS_PQ)
            pg8::Gemm g{x1b, wq + (size_t)layer * 2048 * 4096, SEQ, 2048, 4096}; pg8::StaticOrder S; S.init(SEQ, 2048, G, bid);
            pg8::EpiBf16P E{pqb, 2048};
            pg8::gemm_phase<pg8::EpiBf16P, pg8::StaticOrder>(lds, g, S, E, nullptr, tid);
            asm volatile("s_waitcnt vmcnt(0)" ::: "memory"); __syncthreads();
            { WSP(bf16_t, keyb, WS_KEYB) WSP(int, eidx, WS_EIDX) WSP(float, gate, WS_GATE)
              int t4 = tid; asm volatile("" : "+v"(t4));
              route_mfma_phase(pqb, keyb + (size_t)layer * 8 * 2 * 128 * 128, eidx, gate, (char*)lds_raw, S, t4); }
            SEAM(pb + 6);
        }
        if (IN(pb + 8)) {
            PH_TID() WSP(float, ybuf, WS_Y) WSP(float, stats, WS_X1) WSP(bf16_t, x1b, WS_X1B) WSP(int, eidx, WS_EIDX) WSP(float, gate, WS_GATE) WSP(unsigned char, ub, WS_UB) WSP(unsigned char, vb, WS_VB) WSP(float, isu, WS_SU) WSP(float, isv, WS_SV) WSP(float, x2, WS_X2) WSP(bf16_t, x2b, WS_X2B)
            peer_expert_phase(ybuf, stats, a.in[13] + layer * DM, a.in[14] + layer * DM, x1b, eidx, gate, ub + (size_t)layer * 16384 * ROWB, vb + (size_t)layer * 16384 * ROWB, isu + layer * 16384, isv + layer * 16384, a.in[19] + layer * DM, a.in[20] + layer * DM,
                              layer == 0 ? x2 : a.out, layer == 0 ? x2b : (bf16_t*)nullptr, (LDSA float*)lds, bid, G, tid);
            SEAM(pb + 8);
        }
        }

#undef IN
}
#ifndef ONE_LAUNCH
#define ONE_LAUNCH 1
#endif
extern "C" void kernel_launch(void* const* d_in, const int* in_sizes, int n_in, void* d_out, int out_size, void* d_ws, size_t ws_size, hipStream_t stream) {
    static int ready = 0;
    if (!ready) {
        if (ws_size < WS_END) { fprintf(stderr, "kernel_launch: workspace too small: %zu < %zu\n", ws_size, (size_t)WS_END); return; }
        if (hipFuncSetAttribute((const void*)mega, hipFuncAttributeMaxDynamicSharedMemorySize, LDS_BYTES) != hipSuccess) { fprintf(stderr, "kernel_launch: hipFuncSetAttribute failed\n"); return; }
        int per_cu = 0;
        if (hipOccupancyMaxActiveBlocksPerMultiprocessor(&per_cu, (const void*)mega, 512, LDS_BYTES) != hipSuccess || per_cu < 1) fprintf(stderr, "kernel_launch: note: occupancy query reports %d blocks per CU\n", per_cu);
        (void)hipGetLastError();
        ready = 1;
    }
    unsigned char* ws = (unsigned char*)d_ws;
    (void)hipMemsetAsync(ws + WS_CTL, 0, CTL_BYTES, stream);
    MK a{}; for (int i = 0; i < 21; ++i) a.in[i] = (const float*)d_in[i];
    a.out = (float*)d_out; a.ws = ws;
#if ONE_LAUNCH
    a.ph_lo = 0; a.ph_hi = N_PHASES;
    hipLaunchKernelGGL(mega, dim3(256), dim3(512), LDS_BYTES, stream, a);
#else
    for (int k = 0; k < N_PHASES; ++k) { if (k == 10 || k == 2 || k == 12 || k == 14 || k == 8 || k == 18) continue; a.ph_lo = k; a.ph_hi = k + 1; hipLaunchKernelGGL(mega, dim3(256), dim3(512), LDS_BYTES, stream, a); }
#endif
    const hipError_t le = hipPeekAtLastError();
    if (le != hipSuccess) fprintf(stderr, "kernel_launch: launch failed: %s\n", hipGetErrorName(le));
}
```

```cpp
#include <hip/hip_runtime.h>
#include <stdint.h>
#include <cstdio>

#define SEQ 8192
#define DM 4096
#define HD 128
#define ALPHA 1.4142135623730951f
#define LAMBDA_INIT 0.35550906759096934f
#define ATT_SCALE 0.088388347648318440f

__device__ const double REV_P[16] = {0.15915494309189535, 0.0700865215877985, 0.03086376340470123, 0.013591370636193905, 0.005985185712713705, 0.002635675898667414, 0.001160663641240061, 0.0005111175045375439, 0.00022507907903927653, 9.911730936901935e-05, 4.364795279280289e-05, 1.9221100684944863e-05, 8.464330808241401e-06, 3.727408601915352e-06, 1.6414262627950345e-06, 7.228293068832865e-07};
__device__ const double REV_A[32] = {0.15915494309189535, 0.11934937021124886, 0.08949940160889101, 0.06711508300522726, 0.050329212104487035, 0.03774158471741977, 0.0283021958306234, 0.02122365276477766, 0.015915494309189534, 0.011934937021124886, 0.008949940160889102, 0.006711508300522725, 0.005032921210448704, 0.003774158471741977, 0.00283021958306234, 0.0021223652764777662, 0.0015915494309189536, 0.0011934937021124885, 0.0008949940160889102, 0.0006711508300522726, 0.0005032921210448703, 0.00037741584717419774, 0.00028302195830623395, 0.0002122365276477766, 0.00015915494309189535, 0.00011934937021124886, 8.949940160889102e-05, 6.711508300522725e-05, 5.0329212104487035e-05, 3.774158471741978e-05, 2.8302195830623396e-05, 2.122365276477766e-05};

__device__ __forceinline__ void sincos_rev(double rev, float& s, float& c) {
    const double f = rev - floor(rev); const float ff = (float)f;
    s = __builtin_amdgcn_sinf(ff); c = __builtin_amdgcn_cosf(ff);
}
__device__ __forceinline__ float wave_sum(float v) {
#pragma unroll
    for (int o = 32; o >= 1; o >>= 1) v += __shfl_xor(v, o);
    return v;
}
__device__ __forceinline__ float wave_max(float v) {
#pragma unroll
    for (int o = 32; o >= 1; o >>= 1) v = fmaxf(v, __shfl_xor(v, o));
    return v;
}
namespace pg8 {
#define PG8_LAS __attribute__((address_space(3)))
typedef unsigned short bf16_t;
typedef short bf16x8 __attribute__((ext_vector_type(8)));
typedef float f32x4 __attribute__((ext_vector_type(4)));
typedef unsigned u32x4 __attribute__((ext_vector_type(4)));
constexpr int BM = 256, BK = 64, HALF = 128, HTB = HALF * BK * 2  , STAGE_BYTES = 8 * HTB, NXCD = 8, WGM = 8;

__host__ __device__ __forceinline__ int lds_byte(int r, int c) { const int st = (r >> 4) * 2 + (c >> 5), rr = r & 15, cc = c & 31, ob = rr * 64 + cc * 2; return st * 1024 + (ob ^ (((ob >> 9) & 1) << 5)); }
__host__ __device__ __forceinline__ void stage_rc(int b, int& R, int& C) { const int st = b / 1024, sb = b % 1024, swz = sb ^ (((sb >> 9) & 1) << 5); R = (st >> 1) * 16 + swz / 64; C = (st & 1) * 32 + (swz % 64) / 2; }
__host__ __device__ __forceinline__ int perm32(int rho) { const int n = rho >> 4, i = rho & 15; return 8 * (i >> 2) + 4 * n + (i & 3); }

struct Unit { int pm, pn; };
struct Gemm { const bf16_t* A; const bf16_t* Bt; int M, N, K; };

struct StaticOrder {
    int nM, nN, nwg, G, c;
    __host__ __device__ void init(int M, int N, int G_, int c_) { nM = M / BM; nN = N / BM; nwg = nM * nN; G = G_; c = c_; }
    __host__ __device__ bool next(int i, Unit& u) const {
        const long L = (long)i * G + c; if (L >= nwg) return false;
        int wgid = (int)L; { const int q = nwg / NXCD, r = nwg % NXCD, xcd = wgid % NXCD, off = wgid / NXCD; wgid = (xcd < r ? xcd * (q + 1) : r * (q + 1) + (xcd - r) * q) + off; }
        const int nig = WGM * nN, gid = wgid / nig, fm = gid * WGM, gsz = (nM - fm) < WGM ? (nM - fm) : WGM;
        u.pm = fm + ((wgid % nig) % gsz); u.pn = (wgid % nig) / gsz; return true;
    }
    __device__ __forceinline__ void a_ready(const Unit&) const {}
    __device__ __forceinline__ void done(const Unit&) const {}
};
__device__ __forceinline__ unsigned cvt_pk_bf16(float lo, float hi) { unsigned r; asm volatile("v_cvt_pk_bf16_f32 %0, %1, %2" : "=v"(r) : "v"(lo), "v"(hi)); return r; }
typedef float f32x2 __attribute__((ext_vector_type(2)));
template <class Epi, class Sched, bool STAMP = false>
__device__ __forceinline__ void gemm_phase(PG8_LAS unsigned char* lds, const Gemm g, const Sched& S, const Epi& E, unsigned long long* stamps, const int tid_in) {
    const int tid = tid_in, wid = __builtin_amdgcn_readfirstlane(tid >> 6), lane = tid & 63, wr = wid >> 2, wc = wid & 3, fr = lane & 15, fq = lane >> 4;
    const int K = g.K, nt = K / BK;
    int ts_lo = 0, ts_hi = 0, nts = 0; const unsigned long long rt_entry = STAMP ? (unsigned long long)wall_clock64() : 0ull;
#define PG8_STAMP() do { if (STAMP && wid == 0 && nts < 64) { const unsigned long long _c = (unsigned long long)clock64(); \
        ts_lo = (lane == nts) ? (int)(unsigned)_c : ts_lo; ts_hi = (lane == nts) ? (int)(unsigned)(_c >> 32) : ts_hi; ++nts; } } while (0)
    PG8_STAMP();
    unsigned voffA[2], voffB[2];
#pragma unroll
    for (int i = 0; i < 2; ++i) { int R, C; stage_rc(tid * 16 + i * 8192, R, C); const int Rb = Epi::PERM ? ((R & ~31) + perm32(R & 31)) : R;
        voffA[i] = (unsigned)(R * K + C) * 2u; voffB[i] = (unsigned)(Rb * K + C) * 2u; }
    const size_t kstep = (size_t)(BK * 2);
    const size_t hstep = (size_t)HALF * K * 2;
    const size_t tstep = 2 * hstep;
    const unsigned ldsw = (unsigned)wid * 1024u;
    const int aoff = lds_byte(wr * 64 + fr, fq * 8), boff = lds_byte(wc * 32 + fr, fq * 8);
#define PG8_SA(b, h) (((b) * 2 + (h)) * HTB)
#define PG8_SB(b, h) ((4 + (b) * 2 + (h)) * HTB)
#define PG8_STAGE(bufoff, gbase, voff) do { _Pragma("unroll") for (int _i = 0; _i < 2; ++_i) \
        __builtin_amdgcn_global_load_lds((const unsigned*)((const char*)(gbase) + (voff)[_i]), (PG8_LAS unsigned*)(lds + (bufoff) + ldsw + _i * 8192), 16, 0, 0); } while (0)
#define PG8_LDA(dst, b, h) do { _Pragma("unroll") for (int m = 0; m < 4; ++m) _Pragma("unroll") for (int k = 0; k < 2; ++k) dst[m][k] = *(const PG8_LAS bf16x8*)(lds + PG8_SA(b, h) + aoff + m * 2048 + k * 1024); } while (0)
#define PG8_LDB(dst, b, h) do { _Pragma("unroll") for (int n = 0; n < 2; ++n) _Pragma("unroll") for (int k = 0; k < 2; ++k) dst[n][k] = *(const PG8_LAS bf16x8*)(lds + PG8_SB(b, h) + boff + n * 2048 + k * 1024); } while (0)
#define PG8_MMA(ai, bj, At, Bt) do { __builtin_amdgcn_s_setprio(1); _Pragma("unroll") for (int m = 0; m < 4; ++m) _Pragma("unroll") for (int n = 0; n < 2; ++n) _Pragma("unroll") for (int k = 0; k < 2; ++k) \
        acc[ai][bj][m][n] = __builtin_amdgcn_mfma_f32_16x16x32_bf16(Bt[n][k], At[m][k], acc[ai][bj][m][n], 0, 0, 0); __builtin_amdgcn_s_setprio(0); } while (0)
#define PG8_WAIT_V(n) asm volatile("s_waitcnt vmcnt(" #n ")" ::: "memory")
#define PG8_WAIT_L(n) asm volatile("s_waitcnt lgkmcnt(" #n ")" ::: "memory")
#define PG8_BAR __builtin_amdgcn_s_barrier()
#define PG8_SCHED __builtin_amdgcn_sched_barrier(0)
    Unit cur, nxt; int ui = 0;
    if (!S.next(0, cur)) return;
    f32x4 acc[2][2][4][2];
#pragma unroll
    for (int a = 0; a < 2; ++a)
#pragma unroll
        for (int b = 0; b < 2; ++b)
#pragma unroll
            for (int m = 0; m < 4; ++m)
#pragma unroll
                for (int n = 0; n < 2; ++n) acc[a][b][m][n] = (f32x4){0.f, 0.f, 0.f, 0.f};
    bf16x8 At[4][2], B0[2][2], B1[2][2];
    const char* cA = (const char*)g.A + (size_t)cur.pm * tstep; const char* cB = (const char*)g.Bt + (size_t)cur.pn * tstep;
    S.a_ready(cur);
    PG8_STAGE(PG8_SB(0, 0), cB, voffB); PG8_STAGE(PG8_SA(0, 0), cA, voffA); PG8_STAGE(PG8_SB(0, 1), cB + hstep, voffB); PG8_STAGE(PG8_SA(0, 1), cA + hstep, voffA);
    if (wr == 1) PG8_BAR;
    PG8_WAIT_V(4); PG8_BAR;
    PG8_STAGE(PG8_SB(1, 0), cB + kstep, voffB); PG8_STAGE(PG8_SA(1, 0), cA + kstep, voffA); PG8_STAGE(PG8_SB(1, 1), cB + hstep + kstep, voffB);
    PG8_WAIT_V(6); PG8_BAR;
    PG8_STAMP();
    for (;;) {
        const bool has_next = S.next(ui + 1, nxt);
        const char* nA = has_next ? (const char*)g.A + (size_t)nxt.pm * tstep : cA; const char* nB = has_next ? (const char*)g.Bt + (size_t)nxt.pn * tstep : cB;
        for (int t = 0; t < nt; t += 2) {
            const bool last = (t == nt - 2);
            const char* a1 = cA + (size_t)(t + 1) * kstep;
            const char* a2 = last ? nA : cA + (size_t)(t + 2) * kstep; const char* b2 = last ? nB : cB + (size_t)(t + 2) * kstep;
            const char* a3 = a2 + kstep; const char* b3 = b2 + kstep;
            if (last && has_next) S.a_ready(nxt);
            PG8_LDB(B0, 0, 0); PG8_SCHED; PG8_LDA(At, 0, 0); PG8_STAGE(PG8_SA(1, 1), a1 + hstep, voffA);
            PG8_WAIT_L(8); PG8_BAR; PG8_WAIT_L(0); PG8_MMA(0, 0, At, B0); PG8_BAR; PG8_SCHED;
            PG8_LDB(B1, 0, 1); PG8_STAGE(PG8_SB(0, 0), b2, voffB);
            PG8_BAR; PG8_WAIT_L(0); PG8_MMA(0, 1, At, B1); PG8_BAR;
            PG8_LDA(At, 0, 1); PG8_STAGE(PG8_SA(0, 0), a2, voffA);
            PG8_BAR; PG8_WAIT_L(0); PG8_MMA(1, 0, At, B0); PG8_BAR; PG8_SCHED;
            PG8_STAGE(PG8_SB(0, 1), b2 + hstep, voffB);
            PG8_WAIT_V(6); PG8_BAR; PG8_MMA(1, 1, At, B1); PG8_BAR;
            PG8_LDB(B0, 1, 0); PG8_SCHED; PG8_LDA(At, 1, 0); PG8_STAGE(PG8_SA(0, 1), a2 + hstep, voffA);
            PG8_WAIT_L(8); PG8_BAR; PG8_WAIT_L(0); PG8_MMA(0, 0, At, B0); PG8_BAR; PG8_SCHED;
            PG8_LDB(B1, 1, 1); PG8_STAGE(PG8_SB(1, 0), b3, voffB);
            PG8_BAR; PG8_WAIT_L(0); PG8_MMA(0, 1, At, B1); PG8_BAR;
            PG8_LDA(At, 1, 1); PG8_STAGE(PG8_SA(1, 0), a3, voffA);
            PG8_BAR; PG8_WAIT_L(0); PG8_MMA(1, 0, At, B0); PG8_BAR; PG8_SCHED;
            PG8_STAGE(PG8_SB(1, 1), b3 + hstep, voffB);
            PG8_WAIT_V(6); PG8_BAR; PG8_MMA(1, 1, At, B1); PG8_BAR;
        }
        PG8_STAMP();
        if constexpr (!Epi::AFTER_DRAIN) { E(acc, cur, wr, wc, fr, fq); S.done(cur); }
        PG8_STAMP();
        if (!has_next) break;
#pragma unroll
        for (int a = 0; a < 2; ++a)
#pragma unroll
            for (int b = 0; b < 2; ++b)
#pragma unroll
                for (int m = 0; m < 4; ++m)
#pragma unroll
                    for (int n = 0; n < 2; ++n) acc[a][b][m][n] = (f32x4){0.f, 0.f, 0.f, 0.f};
        cur = nxt; cA = nA; cB = nB; ++ui;
    }
    PG8_WAIT_V(0);
    if (wr == 0) PG8_BAR;
    PG8_BAR;
    if constexpr (Epi::AFTER_DRAIN) { E.fused(acc, cur, wr, wc, fr, fq, lds, wid, lane); S.done(cur); }
    PG8_STAMP();
    if (STAMP && wid == 0) { stamps[lane] = lane < nts ? (((unsigned long long)(unsigned)ts_hi << 32) | (unsigned)ts_lo) : 0ull;
        if (lane == 62) stamps[62] = rt_entry; if (lane == 63) stamps[63] = (unsigned long long)wall_clock64(); }
#undef PG8_STAMP
#undef PG8_SA
#undef PG8_SB
#undef PG8_STAGE
#undef PG8_LDA
#undef PG8_LDB
#undef PG8_MMA
#undef PG8_WAIT_V
#undef PG8_WAIT_L
#undef PG8_BAR
#undef PG8_SCHED
}
}
#define XB_TMO      128
#define XB_XCNT(j)  (256  + 64 * (j))
#define XB_XSUB(j)  (1280 + 64 * (j))
#define XB_XGEN(j)  (2304 + 64 * (j))
#define XB_TOP      3328
#define XB_TOPGEN   3392
#define XCD_BAR_WORDS 3456
#define XB_SPIN_CAP (1u << 22)
#define LAS __attribute__((address_space(3)))

__device__ __forceinline__ unsigned xb_ld(unsigned* p)              { return __hip_atomic_load(p, __ATOMIC_RELAXED, __HIP_MEMORY_SCOPE_AGENT); }
__device__ __forceinline__ unsigned xb_add(unsigned* p, unsigned v) { return __hip_atomic_fetch_add(p, v, __ATOMIC_RELAXED, __HIP_MEMORY_SCOPE_AGENT); }
__device__ __forceinline__ unsigned xb_xcc_id() { return (unsigned)__builtin_amdgcn_s_getreg((3 << 11) | 20) & 0xFu; }
#define XB_SPIN(cond, bar) do { unsigned _sp = 0; while (cond) { __builtin_amdgcn_s_sleep(1); \
    if ((++_sp & 255u) == 0u) { if (xb_ld(&(bar)[XB_TMO])) break; if (_sp > XB_SPIN_CAP) { atomicAdd(&(bar)[XB_TMO], 1u); break; } } } } while (0)

struct XcdBarrier {
    unsigned* bar; unsigned x;
    volatile LAS unsigned* st;
};

__device__ __forceinline__ XcdBarrier xcd_barrier_post(unsigned* bar, volatile LAS unsigned* st, const int tid) {
    XcdBarrier b; b.bar = bar; b.x = xb_xcc_id(); b.st = st;
    if (tid == 0) (void)xb_add(&bar[XB_XCNT(b.x)], 1u);
    return b;
}
__device__ __forceinline__ void xcd_barrier_complete(unsigned* bar, unsigned x, unsigned& nloc, unsigned& nx) {
    const unsigned G = gridDim.x * gridDim.y * gridDim.z;
    unsigned sum, cnt, mine, sp = 0u;
    for (;;) {
        sum = 0u; cnt = 0u; mine = 0u;
#pragma unroll
        for (unsigned j = 0; j < 16; ++j) { const unsigned c = xb_ld(&bar[XB_XCNT(j)]); sum += c; cnt += (c > 0u) ? 1u : 0u; mine = (j == x) ? c : mine; }
        if (sum == G) break;
        __builtin_amdgcn_s_sleep(1);
        if ((++sp & 255u) == 0u) { if (xb_ld(&bar[XB_TMO])) break; if (sp > XB_SPIN_CAP) { atomicAdd(&bar[XB_TMO], 1u); break; } }
    }
    nloc = mine > 0u ? mine : 1u; nx = cnt > 0u ? cnt : 1u;
}

__device__ __forceinline__ void xcd_barrier(const XcdBarrier& b, const int tid) {
    asm volatile("s_waitcnt vmcnt(0)" ::: "memory");
    __syncthreads();
    if (tid == 0) {
        unsigned* bar = b.bar;
        __builtin_amdgcn_s_waitcnt(0);
        unsigned nloc = b.st[0], nx = b.st[1];
        if (nloc == 0u) { xcd_barrier_complete(bar, b.x, nloc, nx); b.st[0] = nloc; b.st[1] = nx; }
        const unsigned old = xb_add(&bar[XB_XSUB(b.x)], 1u);
        const unsigned gen = old / nloc;
        if (old + 1u == (gen + 1u) * nloc) {
            __builtin_amdgcn_fence(__ATOMIC_RELEASE, "agent");
            asm volatile("s_waitcnt vmcnt(0)" ::: "memory");
            const unsigned og = xb_add(&bar[XB_TOP], 1u);
            const unsigned tg = og / nx;
            if (og + 1u == (tg + 1u) * nx) xb_add(&bar[XB_TOPGEN], 1u);
            else XB_SPIN(xb_ld(&bar[XB_TOPGEN]) == tg, bar);
            __builtin_amdgcn_fence(__ATOMIC_ACQUIRE, "agent");
            xb_add(&bar[XB_XGEN(b.x)], 1u);
            asm volatile("s_waitcnt vmcnt(0)" ::: "memory");
        } else {
            XB_SPIN(xb_ld(&bar[XB_XGEN(b.x)]) == gen, bar);
            __builtin_amdgcn_fence(__ATOMIC_ACQUIRE, "agent");
            asm volatile("s_waitcnt vmcnt(0)" ::: "memory");
        }
    }
    __syncthreads();
}
namespace att {
using bf16 = unsigned short;
constexpr int   D = 128, NW = 8, QBLK = 32, KVBLK = 64;
constexpr float SCALE = 0.088388347648318440f;
constexpr float THR = 8.f;
constexpr int SDEPTH = 1;
constexpr size_t SHM_V = KVBLK * D * 2, SHM_K = KVBLK * D * 2, SHM_ATTN = 2 * SHM_V + 2 * SHM_K + NW * 64 * 4;
using bf16x8 = __attribute__((ext_vector_type(8))) short;
using s16x4  = __attribute__((ext_vector_type(4))) short;
using f32x16 = __attribute__((ext_vector_type(16))) float;
using f32x8  = __attribute__((ext_vector_type(8))) float;
using u32x4  = __attribute__((ext_vector_type(4))) unsigned;
#define KSWZ(row, colB) ((row) * 256 + ((colB) ^ (((row) & 7) << 4)))
#define SBAR() __builtin_amdgcn_sched_barrier(0)
__device__ __forceinline__ int crow(int r, int hi) { return (r & 3) + 8 * (r >> 2) + 4 * hi; }
__device__ __forceinline__ unsigned cvtpk(float lo, float hi) {
  unsigned r; asm volatile("v_cvt_pk_bf16_f32 %0, %1, %2" : "=v"(r) : "v"(lo), "v"(hi)); return r;
}
template <typename TIn> struct Stage;
template <> struct Stage<bf16>  { using T = bf16x8;
  __device__ static __forceinline__ T ld8(const bf16* p) { return *reinterpret_cast<const bf16x8*>(p); }
  __device__ static __forceinline__ bf16x8 tobf(T x) { return x; } };
template <> struct Stage<float> { using T = f32x8;
  __device__ static __forceinline__ T ld8(const float* p) { return *reinterpret_cast<const f32x8*>(p); }
  __device__ static __forceinline__ bf16x8 tobf(T x) {
    u32x4 w = {cvtpk(x[0], x[1]), cvtpk(x[2], x[3]), cvtpk(x[4], x[5]), cvtpk(x[6], x[7])}; return *reinterpret_cast<bf16x8*>(&w); } };

__device__ __forceinline__ void partialSM(f32x16& p0, f32x16& p1, float& m_reg, float& mn, float& alpha) {
  constexpr float C = SCALE * 1.4426950408889634f;
  float pmax = p0[0]; for (int r = 1; r < 16; ++r) pmax = fmaxf(pmax, p0[r]); for (int r = 0; r < 16; ++r) pmax = fmaxf(pmax, p1[r]);
  { auto rr = __builtin_amdgcn_permlane32_swap(__float_as_uint(pmax), __float_as_uint(pmax), false, false);
    pmax = fmaxf(__uint_as_float(rr[0]), __uint_as_float(rr[1])); }
  if (__builtin_expect(__all(pmax - m_reg <= THR / SCALE), 1)) { mn = m_reg; alpha = 1.f; }
  else { mn = fmaxf(m_reg, pmax); alpha = __builtin_amdgcn_exp2f((m_reg - mn) * C); m_reg = mn; }
  float mnC = -mn * C;
  for (int r = 0; r < 16; ++r) p0[r] = fmaf(p0[r], C, mnC); for (int r = 0; r < 16; ++r) p1[r] = fmaf(p1[r], C, mnC);
  for (int r = 0; r < 16; ++r) p0[r] = __builtin_amdgcn_exp2f(p0[r]);
}
__device__ __forceinline__ void finishSM(f32x16& p0, f32x16& p1, float alpha, float& l_reg, bf16x8& pa0, bf16x8& pa1, bf16x8& pa2, bf16x8& pa3) {
  for (int r = 0; r < 16; ++r) p1[r] = __builtin_amdgcn_exp2f(p1[r]);
  float ps = 0; for (int r = 0; r < 16; ++r) ps += p0[r]; for (int r = 0; r < 16; ++r) ps += p1[r];
  { auto rr = __builtin_amdgcn_permlane32_swap(__float_as_uint(ps), __float_as_uint(ps), false, false);
    ps = __uint_as_float(rr[0]) + __uint_as_float(rr[1]); }
  l_reg = l_reg * alpha + ps;
#define PK4(P, BASE, OUT) do { unsigned a0 = cvtpk(P[BASE + 0], P[BASE + 1]), a1 = cvtpk(P[BASE + 2], P[BASE + 3]);   \
    unsigned b0 = cvtpk(P[BASE + 4], P[BASE + 5]), b1 = cvtpk(P[BASE + 6], P[BASE + 7]);                              \
    auto r0 = __builtin_amdgcn_permlane32_swap(a0, b0, false, false); auto r1 = __builtin_amdgcn_permlane32_swap(a1, b1, false, false); \
    u32x4 w = {r0[0], r1[0], r0[1], r1[1]}; OUT = *reinterpret_cast<bf16x8*>(&w); } while (0)
  PK4(p0, 0, pa0); PK4(p0, 8, pa1); PK4(p1, 0, pa2); PK4(p1, 8, pa3);
#undef PK4
}
__device__ __forceinline__ void qkt(f32x16& p0, f32x16& p1, const bf16* Ks, const bf16x8* qr, int r32, int hi) {
  p0 = f32x16{}; p1 = f32x16{};
  bf16x8 c0 = *reinterpret_cast<const bf16x8*>((const char*)Ks + KSWZ(r32, (hi * 8) * 2)), c1 = *reinterpret_cast<const bf16x8*>((const char*)Ks + KSWZ(32 + r32, (hi * 8) * 2));
#pragma unroll
  for (int d0 = 0; d0 < 8; ++d0) {
    bf16x8 n0 = c0, n1 = c1;
    if (d0 < 7) { const int cb = ((d0 + 1) * 16 + hi * 8) * 2;
      n0 = *reinterpret_cast<const bf16x8*>((const char*)Ks + KSWZ(r32, cb)); n1 = *reinterpret_cast<const bf16x8*>((const char*)Ks + KSWZ(32 + r32, cb)); }
    p0 = __builtin_amdgcn_mfma_f32_32x32x16_bf16(c0, qr[d0], p0, 0, 0, 0);
    p1 = __builtin_amdgcn_mfma_f32_32x32x16_bf16(c1, qr[d0], p1, 0, 0, 0);
    c0 = n0; c1 = n1; }
}
template <int OFF> __device__ __forceinline__ bf16x8 k_read(const int addr) {
  bf16x8 r; asm volatile("ds_read_b128 %0, %1 offset:%2" : "=&v"(r) : "v"(addr), "i"(OFF) : "memory"); return r;
}
template <int D0> __device__ __forceinline__ void qkt_step(f32x16& p0, f32x16& p1, const int (&a)[4], const bf16x8* qr, bf16x8 c0, bf16x8 c1) {
  bf16x8 n0 = c0, n1 = c1;
  if constexpr (D0 < 7) { n0 = k_read<((D0 + 1) >> 2) * 128>(a[(D0 + 1) & 3]); n1 = k_read<((D0 + 1) >> 2) * 128 + 8192>(a[(D0 + 1) & 3]); asm volatile("s_waitcnt lgkmcnt(2)" ::: "memory"); }
  else asm volatile("s_waitcnt lgkmcnt(0)" ::: "memory");
  SBAR();
  p0 = __builtin_amdgcn_mfma_f32_32x32x16_bf16(c0, qr[D0], p0, 0, 0, 0);
  p1 = __builtin_amdgcn_mfma_f32_32x32x16_bf16(c1, qr[D0], p1, 0, 0, 0);
  if constexpr (D0 < 7) qkt_step<D0 + 1>(p0, p1, a, qr, n0, n1);
}
__device__ __forceinline__ void qkt_pipe(f32x16& p0, f32x16& p1, const int ka, const bf16x8* qr, const int r32, const int hi) {
  p0 = f32x16{}; p1 = f32x16{};
  int a[4];
#pragma unroll
  for (int q = 0; q < 4; ++q) a[q] = ka + r32 * 256 + ((q * 32 + hi * 16) ^ ((r32 & 7) << 4));
  const bf16x8 c0 = k_read<0>(a[0]), c1 = k_read<8192>(a[0]);
  qkt_step<0>(p0, p1, a, qr, c0, c1);
}
__device__ __forceinline__ int v_st(int k, int c) { const int kk = (k & ~0xC) | ((k & 4) << 1) | ((k & 8) >> 1); return ((kk >> 3) * 4 + (c >> 5)) * 512 + ((kk & 7) * 32 + (c & 31)) * 2; }
__device__ __forceinline__ int v_rd_base(int lane) { return ((lane & 3) << 3) | (((lane >> 2) & 3) << 6) | (((lane >> 4) & 1) << 5) | (((lane >> 5) & 1) << 8); }
constexpr int v_rd_off(int d0, int ks, int half) { return d0 * 512 + ks * 4096 + half * 2048; }
template <int OFF> __device__ __forceinline__ s16x4 tr_read(int vb) {
  s16x4 r; asm volatile("ds_read_b64_tr_b16 %0, %1 offset:%2" : "=&v"(r) : "v"(vb), "i"(OFF) : "memory"); return r;
}
template <int D0> __device__ __forceinline__ void pv_one(f32x16& od, int vb, bf16x8 pa0, bf16x8 pa1, bf16x8 pa2, bf16x8 pa3) {
  const s16x4 l0 = tr_read<v_rd_off(D0, 0, 0)>(vb), h0 = tr_read<v_rd_off(D0, 0, 1)>(vb), l1 = tr_read<v_rd_off(D0, 1, 0)>(vb), h1 = tr_read<v_rd_off(D0, 1, 1)>(vb);
  const s16x4 l2 = tr_read<v_rd_off(D0, 2, 0)>(vb), h2 = tr_read<v_rd_off(D0, 2, 1)>(vb), l3 = tr_read<v_rd_off(D0, 3, 0)>(vb), h3 = tr_read<v_rd_off(D0, 3, 1)>(vb);
  asm volatile("s_waitcnt lgkmcnt(0)" ::: "memory"); SBAR();
#define PK(L, H) (bf16x8){L[0], L[1], L[2], L[3], H[0], H[1], H[2], H[3]}
  od = __builtin_amdgcn_mfma_f32_32x32x16_bf16(pa0, PK(l0, h0), od, 0, 0, 0);
  od = __builtin_amdgcn_mfma_f32_32x32x16_bf16(pa1, PK(l1, h1), od, 0, 0, 0);
  od = __builtin_amdgcn_mfma_f32_32x32x16_bf16(pa2, PK(l2, h2), od, 0, 0, 0);
  od = __builtin_amdgcn_mfma_f32_32x32x16_bf16(pa3, PK(l3, h3), od, 0, 0, 0);
#undef PK
}
__device__ __forceinline__ void pv_d0(f32x16* o, int vb, bf16x8 pa0, bf16x8 pa1, bf16x8 pa2, bf16x8 pa3) {
  pv_one<0>(o[0], vb, pa0, pa1, pa2, pa3); pv_one<1>(o[1], vb, pa0, pa1, pa2, pa3); pv_one<2>(o[2], vb, pa0, pa1, pa2, pa3); pv_one<3>(o[3], vb, pa0, pa1, pa2, pa3);
}

template <int B> __device__ __forceinline__ void pv_rd8(s16x4 (&f)[8], const int vb) {
  constexpr int D0 = B & 3, HB = (B >> 2) * 16384;
  f[0] = tr_read<HB + v_rd_off(D0, 0, 0)>(vb); f[1] = tr_read<HB + v_rd_off(D0, 0, 1)>(vb); f[2] = tr_read<HB + v_rd_off(D0, 1, 0)>(vb); f[3] = tr_read<HB + v_rd_off(D0, 1, 1)>(vb);
  f[4] = tr_read<HB + v_rd_off(D0, 2, 0)>(vb); f[5] = tr_read<HB + v_rd_off(D0, 2, 1)>(vb); f[6] = tr_read<HB + v_rd_off(D0, 3, 0)>(vb); f[7] = tr_read<HB + v_rd_off(D0, 3, 1)>(vb);
}
__device__ __forceinline__ void pv_mma4(f32x16& od, const s16x4 (&f)[8], bf16x8 pa0, bf16x8 pa1, bf16x8 pa2, bf16x8 pa3) {
#define PK(L, H) (bf16x8){L[0], L[1], L[2], L[3], H[0], H[1], H[2], H[3]}
  od = __builtin_amdgcn_mfma_f32_32x32x16_bf16(pa0, PK(f[0], f[1]), od, 0, 0, 0);
  od = __builtin_amdgcn_mfma_f32_32x32x16_bf16(pa1, PK(f[2], f[3]), od, 0, 0, 0);
  od = __builtin_amdgcn_mfma_f32_32x32x16_bf16(pa2, PK(f[4], f[5]), od, 0, 0, 0);
  od = __builtin_amdgcn_mfma_f32_32x32x16_bf16(pa3, PK(f[6], f[7]), od, 0, 0, 0);
#undef PK
}
template <int B, int NB> __device__ __forceinline__ void pv_pipe_step(f32x16* o, s16x4 (&cur)[8], s16x4 (&nxt)[8], const int vb, bf16x8 pa0, bf16x8 pa1, bf16x8 pa2, bf16x8 pa3) {
  if constexpr (B + 1 < NB) { pv_rd8<B + 1>(nxt, vb); asm volatile("s_waitcnt lgkmcnt(8)" ::: "memory"); }
  else asm volatile("s_waitcnt lgkmcnt(0)" ::: "memory");
  SBAR();
  pv_mma4(o[B], cur, pa0, pa1, pa2, pa3);
  if constexpr (B + 1 < NB) pv_pipe_step<B + 1, NB>(o, nxt, cur, vb, pa0, pa1, pa2, pa3);
}
template <int NB> __device__ __forceinline__ void pv_pipe(f32x16* o, const int vb, bf16x8 pa0, bf16x8 pa1, bf16x8 pa2, bf16x8 pa3) {
  s16x4 fa[8], fb[8];
  pv_rd8<0>(fa, vb);
  pv_pipe_step<0, NB>(o, fa, fb, vb, pa0, pa1, pa2, pa3);
}

template <typename TQ, int LDQ, int LDK, int LDO, typename TO>
__device__ __forceinline__ void attn_dense_body(const TQ* __restrict__ Qb, const bf16* __restrict__ Kh, const bf16* __restrict__ Vh,
                                                TO* __restrict__ Ob, int seq, char* lds, const int tid_in) {
  using St = Stage<bf16>; using SQ = Stage<TQ>;
  const int tid = tid_in, wid = tid >> 6, lane = tid & 63, r32 = lane & 31, hi = lane >> 5;
  bf16* V_lds = (bf16*)lds; bf16* K_lds = (bf16*)(lds + 2 * SHM_V);
  float* ws = (float*)(lds + 2 * SHM_V + 2 * SHM_K) + wid * 64; float* li_l = ws; float* al_l = ws + 32;
  float m_reg = -1e30f, l_reg = 0; f32x16 o[4] = {}; bf16x8 qr[8];
  const TQ* Qw = Qb + ((wid * QBLK + r32) * LDQ + hi * 8);
#pragma unroll
  for (int d0 = 0; d0 < 8; ++d0) qr[d0] = SQ::tobf(SQ::ld8(Qw + d0 * 16));
  const int sr = tid >> 4, sc = (tid & 15) * 8, vst0 = v_st(sr, sc), vst1 = v_st(32 + sr, sc);
  const int vb0 = (int)(uintptr_t)V_lds + v_rd_base(lane);
  struct { typename St::T vs0, vs1, ks0, ks1; } sr_[SDEPTH];
#define SLOAD(i, k0) do { sr_[i].vs0 = St::ld8(Vh + (((k0) + sr) * LDK + sc)); sr_[i].vs1 = St::ld8(Vh + (((k0) + 32 + sr) * LDK + sc)); \
    sr_[i].ks0 = St::ld8(Kh + (((k0) + sr) * LDK + sc)); sr_[i].ks1 = St::ld8(Kh + (((k0) + 32 + sr) * LDK + sc)); } while (0)
#define SWRITE(b, i) do { *(bf16x8*)((char*)V_lds + (b) * SHM_V + vst0) = St::tobf(sr_[i].vs0);          \
    *(bf16x8*)((char*)V_lds + (b) * SHM_V + vst1) = St::tobf(sr_[i].vs1); int kc = sc * 2;               \
    *(bf16x8*)((char*)K_lds + (b) * SHM_K + KSWZ(sr, kc)) = St::tobf(sr_[i].ks0);                       \
    *(bf16x8*)((char*)K_lds + (b) * SHM_K + KSWZ(32 + sr, kc)) = St::tobf(sr_[i].ks1); } while (0)
#define SWAIT() do { if constexpr (SDEPTH == 2) asm volatile("s_waitcnt vmcnt(4)" ::: "memory"); else asm volatile("s_waitcnt vmcnt(0)" ::: "memory"); } while (0)
#define RESC(a) do { if (__any((a) < 1.f)) { if (hi == 0) al_l[r32] = (a); asm volatile("s_waitcnt lgkmcnt(0)" ::: "memory"); \
    for (int d = 0; d < 4; ++d) for (int r = 0; r < 16; ++r) o[d][r] *= al_l[crow(r, hi)]; } } while (0)
  f32x16 pA0, pA1, pB0, pB1; float mnA, mnB, alA, alB; bf16x8 pa0, pa1, pa2, pa3; const int NT = seq / KVBLK;
  constexpr int SE = 0, SO = SDEPTH - 1;
  SLOAD(SE, 0); asm volatile("s_waitcnt vmcnt(0)" ::: "memory"); SWRITE(0, SE); __syncthreads();
  qkt(pA0, pA1, K_lds, qr, r32, hi); partialSM(pA0, pA1, m_reg, mnA, alA);
  SLOAD(SO, KVBLK); if constexpr (SDEPTH == 2) { if (2 < NT) SLOAD(SE, 2 * KVBLK); }
  SWAIT(); SWRITE(1, SO); __syncthreads();
  for (int j = 1; j + 1 < NT; j += 2) {
    SBAR(); qkt(pB0, pB1, (bf16*)((char*)K_lds + SHM_K), qr, r32, hi);
    finishSM(pA0, pA1, alA, l_reg, pa0, pa1, pa2, pa3); SBAR();
    SLOAD(SO, (j + SDEPTH) * KVBLK); SBAR();
    pv_d0(o, vb0, pa0, pa1, pa2, pa3); partialSM(pB0, pB1, m_reg, mnB, alB);
    __syncthreads(); SWAIT(); SWRITE(0, SE);
    RESC(alB); __syncthreads();
    SBAR(); qkt(pA0, pA1, K_lds, qr, r32, hi);
    finishSM(pB0, pB1, alB, l_reg, pa0, pa1, pa2, pa3); SBAR();
    if (SDEPTH == 1 || j + 3 < NT) SLOAD(SE, (j + 1 + SDEPTH) * KVBLK); SBAR();
    pv_d0(o, vb0 + (int)SHM_V, pa0, pa1, pa2, pa3); partialSM(pA0, pA1, m_reg, mnA, alA);
    __syncthreads(); SWAIT(); SWRITE(1, SO);
    RESC(alA); __syncthreads();
  }
  SBAR(); qkt(pB0, pB1, (bf16*)((char*)K_lds + SHM_K), qr, r32, hi);
  finishSM(pA0, pA1, alA, l_reg, pa0, pa1, pa2, pa3); SBAR();
  pv_d0(o, vb0, pa0, pa1, pa2, pa3); partialSM(pB0, pB1, m_reg, mnB, alB);
  __syncthreads(); RESC(alB);
  finishSM(pB0, pB1, alB, l_reg, pa0, pa1, pa2, pa3); SBAR();
  pv_d0(o, vb0 + (int)SHM_V, pa0, pa1, pa2, pa3);
  if (hi == 0) li_l[r32] = l_reg; asm volatile("s_waitcnt lgkmcnt(0)" ::: "memory");
  float rli[16];
#pragma unroll
  for (int r = 0; r < 16; ++r) rli[r] = __builtin_amdgcn_rcpf(li_l[crow(r, hi)]);
  TO* Ow = Ob + (wid * QBLK) * LDO;
#pragma unroll
  for (int r = 0; r < 16; ++r) { int orow = crow(r, hi);
    for (int d0 = 0; d0 < 4; ++d0) { const float val = o[d0][r] * rli[r];
      if constexpr (sizeof(TO) == 4) Ow[orow * LDO + d0 * 32 + r32] = val;
      else Ow[orow * LDO + d0 * 32 + r32] = (TO)(cvtpk(val, val) & 0xffffu); } }
#undef SLOAD
#undef SWRITE
#undef SWAIT
#undef RESC
}

template <int WIN>
__device__ __forceinline__ void attn_banded_body(const bf16* __restrict__ Qp, const bf16* __restrict__ Kp, const bf16* __restrict__ Vp, const long rs, const int Lseq, const int P0,
                                                 const float m_init, const float l_init, bf16* __restrict__ Ob, const long os, float* __restrict__ Lp, const long ls, char* lds, const int tid) {
  const int wid = __builtin_amdgcn_readfirstlane(tid >> 6), lane = tid & 63, r32 = lane & 31, hi = lane >> 5;
  constexpr int BT = 32768;
  float* wsf = (float*)(lds + 2 * BT) + wid * 64; float* li_l = wsf; float* al_l = wsf + 32;
  float m_reg = m_init, l_reg = l_init; f32x16 o[4] = {}; bf16x8 qr[8];
  const bf16* Qw = Qp + (long)(P0 + wid * QBLK + r32) * rs + hi * 8;
#pragma unroll
  for (int d0 = 0; d0 < 8; ++d0) qr[d0] = *reinterpret_cast<const bf16x8*>(Qw + d0 * 16);
  const int irs = (int)rs;
  int ksrc[2], vsrc[2];
#pragma unroll
  for (int i = 0; i < 2; ++i) { const int c = 2 * wid + i, row = 4 * c + (lane >> 4), colB = (16 * (lane & 15)) ^ ((row & 7) << 4); ksrc[i] = row * irs + (colB >> 1);
      const int sub = 2 * c + (lane >> 5), kk = ((sub >> 2) << 3) | ((lane & 31) >> 2), k = (kk & ~0xC) | ((kk & 4) << 1) | ((kk & 8) >> 1), col = (sub & 3) * 32 + 8 * (lane & 3); vsrc[i] = k * irs + col; }
  using LP = __attribute__((address_space(3))) unsigned*;
#define BB_DMA(buf, tb) do { const bf16* _kb = Kp + (long)(tb) * rs; const bf16* _vb = Vp + (long)(tb) * rs; char* _l = lds + (buf) * BT; \
    _Pragma("unroll") for (int _i = 0; _i < 2; ++_i) { __builtin_amdgcn_global_load_lds((const unsigned*)(_kb + ksrc[_i]), (LP)(_l + (2 * wid + _i) * 1024), 16, 0, 0); \
                                                       __builtin_amdgcn_global_load_lds((const unsigned*)(_vb + vsrc[_i]), (LP)(_l + 16384 + (2 * wid + _i) * 1024), 16, 0, 0); } } while (0)
  constexpr int NT = (256 + 2 * WIN) / 64, NTW = (2 * WIN + 32 + 63) / 64;
  const int klo = wid >> 1, qpos = P0 + wid * QBLK + r32;
  int kf = 0; while (P0 - WIN + 64 * kf < 0) ++kf;
  int kl = NT - 1; while (P0 - WIN + 64 * kl >= Lseq) --kl;
  BB_DMA(kf & 1, P0 - WIN + 64 * kf);
  for (int k = kf; k <= kl; ++k) {
    const int tb = P0 - WIN + 64 * k;
    asm volatile("s_waitcnt vmcnt(0)" ::: "memory");
    __builtin_amdgcn_s_barrier();
    asm volatile("" ::: "memory");
    if (k < kl) BB_DMA((k + 1) & 1, tb + 64);
    char* tbuf = lds + (k & 1) * BT;
    if (k >= klo && k < klo + NTW) {
      f32x16 p0, p1; float mn, al; bf16x8 pa0, pa1, pa2, pa3;
      qkt_pipe(p0, p1, (int)(uintptr_t)tbuf, qr, r32, hi);
      if (k == klo || k == klo + NTW - 1) {
#pragma unroll
        for (int r = 0; r < 16; ++r) { const int d = qpos - (tb + crow(r, hi));
          if (d > WIN || d < -WIN) p0[r] = -1e30f;
          if (d - 32 > WIN || d - 32 < -WIN) p1[r] = -1e30f; }
      }
      partialSM(p0, p1, m_reg, mn, al);
      if (__any(al < 1.f)) { if (hi == 0) al_l[r32] = al; asm volatile("s_waitcnt lgkmcnt(0)" ::: "memory");
#pragma unroll
        for (int d = 0; d < 4; ++d)
#pragma unroll
          for (int r = 0; r < 16; ++r) o[d][r] *= al_l[crow(r, hi)]; }
      finishSM(p0, p1, al, l_reg, pa0, pa1, pa2, pa3); SBAR();
      pv_pipe<4>(o, (int)(uintptr_t)(tbuf + 16384) + v_rd_base(lane), pa0, pa1, pa2, pa3);
    }
  }
#undef BB_DMA
  if (hi == 0) li_l[r32] = l_reg; asm volatile("s_waitcnt lgkmcnt(0)" ::: "memory");
  float rli[16];
#pragma unroll
  for (int r = 0; r < 16; ++r) rli[r] = __builtin_amdgcn_rcpf(li_l[crow(r, hi)]);
  bf16* Ow = Ob + (long)(P0 + wid * QBLK) * os;
#pragma unroll
  for (int r = 0; r < 16; ++r) { const int orow = crow(r, hi);
#pragma unroll
    for (int d0 = 0; d0 < 4; ++d0) { const float val = o[d0][r] * rli[r]; ((__attribute__((address_space(1))) bf16*)Ow)[(long)orow * os + d0 * 32 + r32] = (bf16)(cvtpk(val, val) & 0xffffu); } }
  if (Lp != nullptr && hi == 0) Lp[(long)(P0 + wid * QBLK + r32) * ls] = m_reg * SCALE + __logf(l_reg);
}

constexpr int WB_WS = 131072;
template <int LDQ, int LDK, int LDO, int NVH, typename TO, bool COMBINE = false, int LDC = 0, int TPB = 1>
__device__ __forceinline__ void attn_wide_body(const bf16* __restrict__ Qb, const bf16* __restrict__ Kh, const bf16* __restrict__ Vh, TO* __restrict__ Ob, const int seq, char* lds, const int tid,
                                               const float lam = 0.f, const float gsc = 0.f, const float* __restrict__ gain = nullptr, bf16* __restrict__ Cb = nullptr) {
  const int wid = __builtin_amdgcn_readfirstlane(tid >> 6), lane = tid & 63, r32 = lane & 31, hi = lane >> 5;
  float* wsf = (float*)(lds + WB_WS) + wid * 64; float* li_l = wsf; float* al_l = wsf + 32;
  float m_reg = -1e30f, l_reg = 0; f32x16 o[4 * NVH] = {}; bf16x8 qr[8];
  { const bf16* Qw = Qb + ((wid * QBLK + r32) * LDQ + hi * 8);
#pragma unroll
    for (int d0 = 0; d0 < 8; ++d0) qr[d0] = *reinterpret_cast<const bf16x8*>(Qw + d0 * 16); }
  constexpr int NVP = 2 * NVH;
  int ksrc[2], vsrc[NVP];
#pragma unroll
  for (int i = 0; i < 2; ++i) { const int c = 2 * wid + i, row = 4 * c + (lane >> 4), colB = (16 * (lane & 15)) ^ ((row & 7) << 4); ksrc[i] = row * LDK + (colB >> 1); }
#pragma unroll
  for (int i = 0; i < NVP; ++i) { const int pc = wid * NVP + i, hf = pc >> 4, c = pc & 15, sub = 2 * c + (lane >> 5), kk = ((sub >> 2) << 3) | ((lane & 31) >> 2);
      const int k = (kk & ~0xC) | ((kk & 4) << 1) | ((kk & 8) >> 1), col = (sub & 3) * 32 + 8 * (lane & 3); vsrc[i] = k * LDK + hf * 128 + col; }
  using LP = __attribute__((address_space(3))) unsigned*;
  constexpr int WB_ONE = 16384 * (1 + NVH), WB_SUP = TPB * WB_ONE;
  static_assert(2 * WB_SUP <= WB_WS, "ring");
#define WB_DMA(buf, key0) do { _Pragma("unroll") for (int _t = 0; _t < TPB; ++_t) { const bf16* _kb = Kh + ((key0) + _t * KVBLK) * LDK; const bf16* _vb = Vh + ((key0) + _t * KVBLK) * LDK; char* _l = lds + (buf) * WB_SUP + _t * WB_ONE; \
    _Pragma("unroll") for (int _i = 0; _i < 2; ++_i) __builtin_amdgcn_global_load_lds((const unsigned*)(_kb + ksrc[_i]), (LP)(_l + (2 * wid + _i) * 1024), 16, 0, 0); \
    _Pragma("unroll") for (int _i = 0; _i < NVP; ++_i) __builtin_amdgcn_global_load_lds((const unsigned*)(_vb + vsrc[_i]), (LP)(_l + 16384 + (wid * NVP + _i) * 1024), 16, 0, 0); } } while (0)
  const int NG = seq / (KVBLK * TPB);
  WB_DMA(0, 0);
  for (int j = 0; j < NG; ++j) {
    asm volatile("s_waitcnt vmcnt(0)" ::: "memory");
    __builtin_amdgcn_s_barrier();
    asm volatile("" ::: "memory");
    if (j + 1 < NG) WB_DMA((j + 1) & 1, (j + 1) * KVBLK * TPB);
#pragma unroll
    for (int tt = 0; tt < TPB; ++tt) {
    char* tb = lds + (j & 1) * WB_SUP + tt * WB_ONE;
    f32x16 p0, p1; float mn, al; bf16x8 pa0, pa1, pa2, pa3;
    qkt_pipe(p0, p1, (int)(uintptr_t)tb, qr, r32, hi);
    partialSM(p0, p1, m_reg, mn, al);
    if (__any(al < 1.f)) { if (hi == 0) al_l[r32] = al; asm volatile("s_waitcnt lgkmcnt(0)" ::: "memory");
#pragma unroll
      for (int d = 0; d < 4 * NVH; ++d)
#pragma unroll
        for (int r = 0; r < 16; ++r) o[d][r] *= al_l[crow(r, hi)]; }
    finishSM(p0, p1, al, l_reg, pa0, pa1, pa2, pa3); SBAR();
    const int vb0 = (int)(uintptr_t)(tb + 16384) + v_rd_base(lane);
    pv_pipe<4 * NVH>(o, vb0, pa0, pa1, pa2, pa3);
    }
  }
#undef WB_DMA
  int te = tid; asm volatile("" : "+v"(te));
  const int wid_e = __builtin_amdgcn_readfirstlane(te >> 6), r32_e = te & 31, hi_e = (te >> 5) & 1;
  float* li_e = (float*)(lds + WB_WS) + wid_e * 64;
  if (hi_e == 0) li_e[r32_e] = l_reg; asm volatile("s_waitcnt lgkmcnt(0)" ::: "memory");
  float rli[16];
#pragma unroll
  for (int r = 0; r < 16; ++r) rli[r] = __builtin_amdgcn_rcpf(li_e[crow(r, hi_e)]);
  TO* Ow = Ob + (wid_e * QBLK) * LDO;
  if constexpr (!COMBINE) {
#pragma unroll
    for (int r = 0; r < 16; ++r) { const int orow = crow(r, hi_e);
#pragma unroll
      for (int d0 = 0; d0 < 4 * NVH; ++d0) { const float val = o[d0][r] * rli[r];
        if constexpr (sizeof(TO) == 4) ((__attribute__((address_space(1))) TO*)Ow)[orow * LDO + d0 * 32 + r32_e] = val; else ((__attribute__((address_space(1))) TO*)Ow)[orow * LDO + d0 * 32 + r32_e] = (TO)(cvtpk(val, val) & 0xffffu); } }
  } else {
    static_assert(sizeof(TO) == 4 && NVH == 2, "combine: f32 first-map tile, 256-wide rows");
    float gn[8];
    { const float* g2 = gain; asm volatile("" : "+s"(g2));
#pragma unroll
      for (int d0 = 0; d0 < 8; ++d0) gn[d0] = g2[d0 * 32 + r32_e] * gsc; }
    bf16* Cw; { bf16* c2 = Cb; asm volatile("" : "+s"(c2)); Cw = c2 + (wid_e * QBLK) * LDC; }
    { TO* o2 = Ob; asm volatile("" : "+s"(o2)); Ow = o2 + (wid_e * QBLK) * LDO; }
#pragma unroll
    for (int r = 0; r < 16; ++r) { const int orow = crow(r, hi_e);
      float ss = 0.f;
#pragma unroll
      for (int d0 = 0; d0 < 8; ++d0) { const float o1 = __hip_atomic_load((const __attribute__((address_space(1))) float*)Ow + orow * LDO + d0 * 32 + r32_e, __ATOMIC_RELAXED, __HIP_MEMORY_SCOPE_AGENT);
        const float av = o1 - lam * (o[d0][r] * rli[r]); o[d0][r] = av; ss = fmaf(av, av, ss); }
#define WB_SWZ(v, m) __int_as_float(__builtin_amdgcn_ds_swizzle(__float_as_int(v), ((m) << 10) | 0x1F))
      ss += WB_SWZ(ss, 1); ss += WB_SWZ(ss, 2); ss += WB_SWZ(ss, 4); ss += WB_SWZ(ss, 8); ss += WB_SWZ(ss, 16);
#undef WB_SWZ
      const float sc = 1.0f / sqrtf(ss * (1.0f / 256.0f) + 1e-6f);
#pragma unroll
      for (int d0 = 0; d0 < 8; ++d0) { const float val = o[d0][r] * sc * gn[d0]; ((__attribute__((address_space(1))) bf16*)Cw)[orow * LDC + d0 * 32 + r32_e] = (bf16)(cvtpk(val, val) & 0xffffu); }
      asm volatile("" ::: "memory"); }
  }
}
}
typedef unsigned short bf16_t;
typedef unsigned u32x4v __attribute__((ext_vector_type(4)));
#define LDSA __attribute__((address_space(3)))
#define GLB __attribute__((address_space(1)))
constexpr size_t al256(size_t x) { return (x + 255) / 256 * 256; }
constexpr size_t WS_CTL  = 0;
constexpr size_t CTL_BYTES = 65536;
constexpr size_t WS_XB   = WS_CTL + CTL_BYTES;
constexpr size_t WS_WAB  = WS_XB + (size_t)SEQ * DM * 2;
constexpr size_t WS_WOAB = WS_WAB + (size_t)12288 * 4096 * 2;
constexpr size_t WS_WCD  = WS_WOAB + (size_t)4096 * 3072 * 2;
constexpr size_t WS_WOCD = WS_WCD + (size_t)9216 * 4096 * 2;
constexpr size_t WS_WQ   = WS_WOCD + (size_t)4096 * 4096 * 2;
constexpr size_t WS_UB   = WS_WQ + (size_t)2 * 2048 * 4096 * 2;
constexpr size_t WS_VB   = WS_UB + (size_t)2 * 16384 * 3072;
constexpr size_t WS_SU   = WS_VB + (size_t)2 * 16384 * 3072;
constexpr size_t WS_SV   = WS_SU + (size_t)2 * 16384 * 4;
constexpr size_t WS_H    = WS_SV + (size_t)2 * 16384 * 4;
constexpr size_t WS_Y    = WS_H;
constexpr size_t WS_PQ   = WS_H + (size_t)SEQ * 4096 * 4;
constexpr size_t WS_OC   = WS_H + (size_t)SEQ * 12288 * 4;
constexpr size_t WS_AB   = WS_OC + (size_t)2 * SEQ * 2048 * 4;
constexpr size_t WS_X1   = WS_AB + (size_t)SEQ * 4096 * 2;
constexpr size_t WS_X1B  = WS_X1 + (size_t)SEQ * 4096 * 4;
constexpr size_t WS_X2   = WS_X1B + (size_t)SEQ * 4096 * 2;
constexpr size_t WS_X2B  = WS_X2 + (size_t)SEQ * 4096 * 4;
constexpr size_t WS_EIDX = WS_X2B + (size_t)SEQ * 4096 * 2;
constexpr size_t WS_GATE = WS_EIDX + (size_t)SEQ * 128 * 4;
constexpr size_t WS_HB   = WS_GATE + (size_t)SEQ * 128 * 4;
constexpr size_t WS_KEYB = WS_HB + (size_t)SEQ * 12288 * 2;
constexpr size_t WS_CS0  = WS_KEYB + (size_t)2 * 8 * 2 * 128 * 128 * 2;
constexpr size_t WS_CSA  = WS_CS0 + (size_t)SEQ * 16 * 8;
constexpr size_t WS_END  = WS_CSA + (size_t)128 * 32 * 8;
static_assert(WS_END <= (size_t)2147483648ull, "workspace");

constexpr int LDS_BYTES = 155648;
constexpr int LDS_MISC = 139264;

struct MK { const float* in[21]; float* out; unsigned char* ws; int ph_lo, ph_hi; };

namespace pg8 {
struct EpiF32R {
    static constexpr bool PERM = false, AFTER_DRAIN = false;
    float* C; int ldc; const float* R; float ralpha;
    __device__ __forceinline__ void operator()(const f32x4 (&acc)[2][2][4][2], const Unit& u, int wr, int wc, int fr, int fq) const {
        const int row0 = u.pm * BM + wr * 64 + fr, col0 = u.pn * BM + wc * 32 + 4 * fq;
#pragma unroll
        for (int ai = 0; ai < 2; ++ai)
#pragma unroll
            for (int mp = 0; mp < 2; ++mp) {
                f32x4 r[2][2][2];
                if (R) {
#pragma unroll
                    for (int mm = 0; mm < 2; ++mm) { const size_t off = (size_t)(row0 + ai * HALF + (2 * mp + mm) * 16) * ldc + col0;
#pragma unroll
                        for (int bj = 0; bj < 2; ++bj)
#pragma unroll
                            for (int n = 0; n < 2; ++n) r[mm][bj][n] = *(const GLB f32x4*)(R + off + bj * HALF + n * 16); }
                }
#pragma unroll
                for (int mm = 0; mm < 2; ++mm) { const int m = 2 * mp + mm; const size_t off = (size_t)(row0 + ai * HALF + m * 16) * ldc + col0;
#pragma unroll
                    for (int bj = 0; bj < 2; ++bj)
#pragma unroll
                        for (int n = 0; n < 2; ++n) { f32x4 v = acc[ai][bj][m][n];
                            if (R) v += r[mm][bj][n] * ralpha;
                            *(GLB f32x4*)(C + off + bj * HALF + n * 16) = v; } }
                asm volatile("" ::: "memory");
            }
    }
};
struct EpiBf16R {
    static constexpr bool PERM = true, AFTER_DRAIN = false;
    bf16_t* O; int ldc; const bf16_t* R; float ralpha;
    __device__ __forceinline__ void operator()(const f32x4 (&acc)[2][2][4][2], const Unit& u, int wr, int wc, int fr, int fq) const {
        const int row0 = u.pm * BM + wr * 64 + fr, col0 = u.pn * BM + wc * 32 + 8 * fq;
#pragma unroll
        for (int ai = 0; ai < 2; ++ai) {
            u32x4 r[4][2];
#pragma unroll
            for (int m = 0; m < 4; ++m)
#pragma unroll
                for (int bj = 0; bj < 2; ++bj) r[m][bj] = *(const GLB u32x4*)(R + (size_t)(row0 + ai * HALF + m * 16) * ldc + col0 + bj * HALF);
#pragma unroll
            for (int m = 0; m < 4; ++m) { bf16_t* rowp = O + (size_t)(row0 + ai * HALF + m * 16) * ldc + col0;
#pragma unroll
                for (int bj = 0; bj < 2; ++bj) { const f32x4 v0 = acc[ai][bj][m][0], v1 = acc[ai][bj][m][1]; const u32x4 q = r[m][bj];
                    u32x4 w;
                    w.x = cvt_pk_bf16(v0[0] + ralpha * __uint_as_float(q.x << 16), v0[1] + ralpha * __uint_as_float(q.x & 0xffff0000u));
                    w.y = cvt_pk_bf16(v0[2] + ralpha * __uint_as_float(q.y << 16), v0[3] + ralpha * __uint_as_float(q.y & 0xffff0000u));
                    w.z = cvt_pk_bf16(v1[0] + ralpha * __uint_as_float(q.z << 16), v1[1] + ralpha * __uint_as_float(q.z & 0xffff0000u));
                    w.w = cvt_pk_bf16(v1[2] + ralpha * __uint_as_float(q.w << 16), v1[3] + ralpha * __uint_as_float(q.w & 0xffff0000u));
                    *(GLB u32x4*)(rowp + bj * HALF) = w; } }
            asm volatile("" ::: "memory");
        }
    }
};
struct EpiBf16P {
    static constexpr bool PERM = true, AFTER_DRAIN = false;
    bf16_t* O; int ldc;
    __device__ __forceinline__ void operator()(const f32x4 (&acc)[2][2][4][2], const Unit& u, int wr, int wc, int fr, int fq) const {
        const int row0 = u.pm * BM + wr * 64 + fr, col0 = u.pn * BM + wc * 32 + 8 * fq;
#pragma unroll
        for (int ai = 0; ai < 2; ++ai)
#pragma unroll
            for (int m = 0; m < 4; ++m) { bf16_t* rowp = O + (size_t)(row0 + ai * HALF + m * 16) * ldc + col0;
#pragma unroll
                for (int bj = 0; bj < 2; ++bj) { const f32x4 v0 = acc[ai][bj][m][0], v1 = acc[ai][bj][m][1];
                    u32x4 w; w.x = cvt_pk_bf16(v0[0], v0[1]); w.y = cvt_pk_bf16(v0[2], v0[3]); w.z = cvt_pk_bf16(v1[0], v1[1]); w.w = cvt_pk_bf16(v1[2], v1[3]);
                    *(GLB u32x4*)(rowp + bj * HALF) = w; } }
    }
};

template <int LAYER> struct EpiProj {
    static constexpr bool PERM = true, AFTER_DRAIN = false;
    bf16_t* O; int ldc; const float* cs0; const float* csa; const float* gq; const float* gk; PG8_LAS float* xch;
    __device__ __forceinline__ void operator()(const f32x4 (&acc)[2][2][4][2], const Unit& u, int wr, int wc, int fr, int fq) const {
        const int row0 = u.pm * BM + wr * 64 + fr, col0 = u.pn * BM + wc * 32 + 8 * fq;
        const int pn = u.pn;
        const bool prope = LAYER == 0 ? (pn < 10 || (pn >= 12 && pn < 36)) : (pn < 16);
        const bool dnorm = LAYER == 1 && pn >= 24 && pn < 34;
        float rs[2][4][2];
        float gn[8];
        if (dnorm) {
            const int lrow = fr;
#pragma unroll
            for (int ai = 0; ai < 2; ++ai)
#pragma unroll
                for (int m = 0; m < 4; ++m)
#pragma unroll
                    for (int bj = 0; bj < 2; ++bj) { const f32x4 a = acc[ai][bj][m][0], b = acc[ai][bj][m][1];
                        float q = (a[0] * a[0] + a[1] * a[1]) + (a[2] * a[2] + a[3] * a[3]) + (b[0] * b[0] + b[1] * b[1]) + (b[2] * b[2] + b[3] * b[3]);
                        q += __shfl_xor(q, 16); q += __shfl_xor(q, 32);
                        if (fq == 0) xch[((wr * 128 + (ai * 4 + m) * 16 + lrow) * 2 + bj) * 4 + wc] = q; }
            asm volatile("s_waitcnt lgkmcnt(0)" ::: "memory"); __builtin_amdgcn_s_barrier(); asm volatile("" ::: "memory");
#pragma unroll
            for (int ai = 0; ai < 2; ++ai)
#pragma unroll
                for (int m = 0; m < 4; ++m)
#pragma unroll
                    for (int bj = 0; bj < 2; ++bj) { const f32x4 p = *(const PG8_LAS f32x4*)(xch + ((wr * 128 + (ai * 4 + m) * 16 + lrow) * 2 + bj) * 4);
                        rs[ai][m][bj] = 1.0f / sqrtf(((p[0] + p[1]) + (p[2] + p[3])) * (1.0f / 128.0f) + 1e-6f); }
            const float* g = pn < 32 ? gq : gk;
#pragma unroll
            for (int e = 0; e < 8; ++e) { const int p = wc * 32 + 8 * fq + e; const int orig = (p & 64) + ((p & 63) >> 1) + 32 * (p & 1); gn[e] = g[orig]; }
        }
        const bool rot = dnorm || (prope && wc == 0);
#pragma unroll
        for (int ai = 0; ai < 2; ++ai) {
            f32x4 cs[4][2];
            if (rot) {
#pragma unroll
                for (int m = 0; m < 4; ++m) { const int row = row0 + ai * HALF + m * 16;
                    const float* cp = dnorm ? csa + ((size_t)(wc < 2 ? (row >> 6) : (row & 63)) * 32 + 16 * (wc & 1) + 4 * fq) * 2 : cs0 + ((size_t)row * 16 + 4 * fq) * 2;
                    cs[m][0] = *(const GLB f32x4*)cp; cs[m][1] = *(const GLB f32x4*)(cp + 4); }
            }
#pragma unroll
            for (int m = 0; m < 4; ++m) {
                const int row = row0 + ai * HALF + m * 16;
                bf16_t* rowp = O + (size_t)row * ldc + col0;
                f32x4 c0 = (f32x4){1.f, 0.f, 1.f, 0.f}, c1 = c0;
                if (rot) { c0 = cs[m][0]; c1 = cs[m][1]; }
#pragma unroll
                for (int bj = 0; bj < 2; ++bj) { f32x4 v0 = acc[ai][bj][m][0], v1 = acc[ai][bj][m][1];
                    if (dnorm) { const float r = rs[ai][m][bj];
                        v0[0] *= r * gn[0]; v0[1] *= r * gn[1]; v0[2] *= r * gn[2]; v0[3] *= r * gn[3]; v1[0] *= r * gn[4]; v1[1] *= r * gn[5]; v1[2] *= r * gn[6]; v1[3] *= r * gn[7]; }
                    if (rot) {
                        const float a0 = v0[0] * c0[0] - v0[1] * c0[1], b0 = v0[1] * c0[0] + v0[0] * c0[1];
                        const float a1 = v0[2] * c0[2] - v0[3] * c0[3], b1 = v0[3] * c0[2] + v0[2] * c0[3];
                        const float a2 = v1[0] * c1[0] - v1[1] * c1[1], b2 = v1[1] * c1[0] + v1[0] * c1[1];
                        const float a3 = v1[2] * c1[2] - v1[3] * c1[3], b3 = v1[3] * c1[2] + v1[2] * c1[3];
                        v0 = (f32x4){a0, b0, a1, b1}; v1 = (f32x4){a2, b2, a3, b3}; }
                    u32x4 w; w.x = cvt_pk_bf16(v0[0], v0[1]); w.y = cvt_pk_bf16(v0[2], v0[3]); w.z = cvt_pk_bf16(v1[0], v1[1]); w.w = cvt_pk_bf16(v1[2], v1[3]);
                    *(GLB u32x4*)(rowp + bj * HALF) = w; }
            }
            asm volatile("" ::: "memory");
        }
    }
};
}

__device__ __forceinline__ float bf_lo(unsigned w) { return __uint_as_float(w << 16); }
__device__ __forceinline__ float bf_hi(unsigned w) { return __uint_as_float(w & 0xffff0000u); }
__device__ __forceinline__ unsigned cvtpk_bf16(float lo, float hi) { unsigned r; asm volatile("v_cvt_pk_bf16_f32 %0, %1, %2" : "=v"(r) : "v"(lo), "v"(hi)); return r; }

__device__ __forceinline__ void cvt_rows_bf16(const float* __restrict__ src, bf16_t* __restrict__ dst, size_t n8, int bid, int nb, int tid, int nthr) {
    const size_t stride = (size_t)nb * nthr;
    for (size_t i = (size_t)bid * nthr + tid; i < n8; i += 4 * stride) {
        float4 a[4], b[4];
#pragma unroll
        for (int u = 0; u < 4; ++u) { const size_t j = i + u * stride; if (j < n8) { a[u] = *(const float4*)(src + j * 8); b[u] = *(const float4*)(src + j * 8 + 4); } }
#pragma unroll
        for (int u = 0; u < 4; ++u) { const size_t j = i + u * stride; if (j < n8) {
            u32x4v w; w.x = cvtpk_bf16(a[u].x, a[u].y); w.y = cvtpk_bf16(a[u].z, a[u].w); w.z = cvtpk_bf16(b[u].x, b[u].y); w.w = cvtpk_bf16(b[u].z, b[u].w);
            *(u32x4v*)(dst + j * 8) = w; } }
    }
}
template <class PM>
__device__ __forceinline__ void transpose_cvt(const float* __restrict__ W, bf16_t* __restrict__ Wt, int K, int N, LDSA float* tile0, int bid, int nb, PM pm, const int tid) {
    const int lane = tid & 63, wv = tid >> 6;
    LDSA float* tile = tile0 + wv * 4352;
    const int ntk = K / 64, ntn = N / 64;
    for (int t = bid * 8 + wv; t < ntk * ntn; t += nb * 8) {
        const int k0 = (t % ntk) * 64, n0 = (t / ntk) * 64;
        const int c = (lane & 15) * 4, r0 = lane >> 4;
        float4 v[16];
#pragma unroll
        for (int i = 0; i < 16; ++i) v[i] = *(const float4*)(W + (size_t)(k0 + r0 + 4 * i) * N + n0 + c);
#pragma unroll
        for (int i = 0; i < 16; ++i) { const int r = r0 + 4 * i; tile[r * 65 + c] = v[i].x; tile[r * 65 + c + 1] = v[i].y; tile[r * 65 + c + 2] = v[i].z; tile[r * 65 + c + 3] = v[i].w; }
        asm volatile("s_waitcnt lgkmcnt(0)" ::: "memory");
        const int mode = pm(n0);
#pragma unroll
        for (int h = 0; h < 8; ++h) {
            const int n = (lane >> 3) + 8 * h, kc = (lane & 7) * 8;
            int src = n;
            if (mode == 1) { if (n < 32) src = (n >> 1) + 16 * (n & 1); }
            else if (mode == 2) src = (n >> 1) + 32 * (n & 1);
            float f[8];
#pragma unroll
            for (int j = 0; j < 8; ++j) f[j] = tile[(kc + j) * 65 + src];
            u32x4v w; w.x = cvtpk_bf16(f[0], f[1]); w.y = cvtpk_bf16(f[2], f[3]); w.z = cvtpk_bf16(f[4], f[5]); w.w = cvtpk_bf16(f[6], f[7]);
            *(u32x4v*)(Wt + (size_t)(n0 + n) * K + k0 + kc) = w;
        }
        asm volatile("s_waitcnt lgkmcnt(0)" ::: "memory");
    }
}
struct PermNone { __device__ __forceinline__ int operator()(int) const { return 0; } };
struct PermAB { __device__ __forceinline__ int operator()(int n0) const { const bool rope = n0 < 2560 || (n0 >= 3072 && n0 < 9216); return (rope && (n0 & 127) == 0) ? 1 : 0; } };
struct PermCD { __device__ __forceinline__ int operator()(int n0) const { if (n0 < 4096) return (n0 & 127) == 0 ? 1 : 0; if (n0 >= 6144 && n0 < 8704) return 2; return 0; } };
__device__ __forceinline__ void rope_tables(float* __restrict__ cs0, float* __restrict__ csa, const int bid, const int G, const int tid) {
    for (int i = bid * 512 + tid; i < SEQ * 16; i += G * 512) { float s, c; sincos_rev((double)(i >> 4) * REV_P[i & 15], s, c); *(float2*)(cs0 + (size_t)i * 2) = make_float2(c, s); }
    for (int i = bid * 512 + tid; i < 128 * 32; i += G * 512) { float s, c; sincos_rev((double)(i >> 5) * REV_A[i & 31], s, c); *(float2*)(csa + (size_t)i * 2) = make_float2(c, s); }
}


typedef unsigned v6u_t __attribute__((ext_vector_type(6)));
typedef float f4v_t __attribute__((ext_vector_type(4)));
typedef unsigned v16u_t __attribute__((ext_vector_type(16)));
typedef float v16f_t __attribute__((ext_vector_type(16)));
typedef float v32f_t __attribute__((ext_vector_type(32)));
typedef __bf16 v32b_t __attribute__((ext_vector_type(32)));
constexpr int ROWB = 3072;
constexpr int XT_STRIDE = 68;
constexpr int XT_BYTES = 64 * XT_STRIDE * 4;
__device__ __forceinline__ void table_fp6(const float* __restrict__ src, unsigned char* __restrict__ dst, float* __restrict__ inv, const int rows, LDSA float* xt0, const int bid, const int G, const int tid) {
    const int lane = tid & 63, wv = tid >> 6;
    LDSA float* xt = xt0 + wv * (XT_BYTES / 4);
    for (int r = bid * 8 + wv; r < rows; r += G * 8) {
        float4 v[16]; float am = 0.f;
#pragma unroll
        for (int j = 0; j < 16; ++j) { v[j] = *(const float4*)(src + (size_t)r * DM + j * 256 + lane * 4); am = fmaxf(am, fmaxf(fmaxf(fabsf(v[j].x), fabsf(v[j].y)), fmaxf(fabsf(v[j].z), fabsf(v[j].w)))); }
        am = wave_max(am);
        const float sc = am > 0.f ? 7.0f / am : 1.0f;
#pragma unroll
        for (int j = 0; j < 16; ++j) *(LDSA f4v_t*)(xt + (4 * j + (lane >> 4)) * XT_STRIDE + 4 * (lane & 15)) = (f4v_t){v[j].x * sc, v[j].y * sc, v[j].z * sc, v[j].w * sc};
        asm volatile("s_waitcnt lgkmcnt(0)" ::: "memory");
        v16f_t f0, f1, f2, f3;
#pragma unroll
        for (int k = 0; k < 8; ++k) { const f4v_t a = *(const LDSA f4v_t*)(xt + lane * XT_STRIDE + 4 * k), c = *(const LDSA f4v_t*)(xt + lane * XT_STRIDE + 32 + 4 * k);
            f0[2 * k] = a[0]; f1[2 * k] = a[1]; f0[2 * k + 1] = a[2]; f1[2 * k + 1] = a[3];
            f2[2 * k] = c[0]; f3[2 * k] = c[1]; f2[2 * k + 1] = c[2]; f3[2 * k + 1] = c[3]; }
        asm volatile("s_waitcnt lgkmcnt(0)" ::: "memory");
        const v6u_t w0 = __builtin_amdgcn_cvt_scalef32_2xpk16_fp6_f32(f0, f1, 1.0f), w1 = __builtin_amdgcn_cvt_scalef32_2xpk16_fp6_f32(f2, f3, 1.0f);
        unsigned char* dp = dst + (size_t)r * ROWB + lane * 48;
        u32x4v s0, s1, s2; s0.x = w0[0]; s0.y = w0[1]; s0.z = w0[2]; s0.w = w0[3]; s1.x = w0[4]; s1.y = w0[5]; s1.z = w1[0]; s1.w = w1[1]; s2.x = w1[2]; s2.y = w1[3]; s2.z = w1[4]; s2.w = w1[5];
        *(u32x4v*)dp = s0; *(u32x4v*)(dp + 16) = s1; *(u32x4v*)(dp + 32) = s2;
        if (lane == 0) inv[r] = am > 0.f ? am * (1.0f / 7.0f) : 1.0f;
    }
}

typedef __bf16 bf2_t __attribute__((ext_vector_type(2)));
__device__ __forceinline__ float dot2_bf16(unsigned a, unsigned b, float c) { return __builtin_amdgcn_fdot2_f32_bf16(__builtin_bit_cast(bf2_t, a), __builtin_bit_cast(bf2_t, b), c, false); }
__device__ __forceinline__ float gelu_tanh_f(float x) {
    const float z = 0.7978845608028654f * (x + 0.044715f * x * x * x);
    const float e = __expf(2.0f * z);
    return 0.5f * x * (2.0f - 2.0f / (e + 1.0f));
}
__device__ __forceinline__ int pick_i(int a0, int a1, int k) { return k < 64 ? __builtin_amdgcn_readlane(a0, k) : __builtin_amdgcn_readlane(a1, k - 64); }
__device__ __forceinline__ float pick_f(float a0, float a1, int k) { return __int_as_float(pick_i(__float_as_int(a0), __float_as_int(a1), k)); }
__device__ __forceinline__ float dpp_shr(float v, const int ctrl_sel) {
    const int iv = __builtin_bit_cast(int, v); int r;
    switch (ctrl_sel) { case 1: r = __builtin_amdgcn_update_dpp(0, iv, 0x111, 0xf, 0xf, true); break; case 2: r = __builtin_amdgcn_update_dpp(0, iv, 0x112, 0xf, 0xf, true); break;
                        case 4: r = __builtin_amdgcn_update_dpp(0, iv, 0x114, 0xf, 0xf, true); break; default: r = __builtin_amdgcn_update_dpp(0, iv, 0x118, 0xf, 0xf, true); break; }
    return __builtin_bit_cast(float, r);
}
__device__ __forceinline__ float wave_sum_u(float v) {
    v += dpp_shr(v, 1); v += dpp_shr(v, 2); v += dpp_shr(v, 4); v += dpp_shr(v, 8);
    v += __builtin_bit_cast(float, __builtin_amdgcn_update_dpp(0, __builtin_bit_cast(int, v), 0x142, 0xa, 0xf, false));
    v += __builtin_bit_cast(float, __builtin_amdgcn_update_dpp(0, __builtin_bit_cast(int, v), 0x143, 0xc, 0xf, false));
    return __builtin_bit_cast(float, __builtin_amdgcn_readlane(__builtin_bit_cast(int, v), 63));
}
typedef const __attribute__((address_space(1))) u32x4v* gu32x4p;
#define PE_LOADROW(dst, base, e) do { const unsigned char* _p = (base) + (size_t)(e) * ROWB + lane * 48; dst[0] = *(gu32x4p)_p; dst[1] = *(gu32x4p)(_p + 16); dst[2] = *(gu32x4p)(_p + 32); } while (0)
__device__ __forceinline__ float pe_dot(const u32x4v (&r)[3], const u32x4v (&x)[8]) {
    float d0 = 0.f, d1 = 0.f, d2 = 0.f, d3 = 0.f;
    { const v6u_t g = {r[0].x, r[0].y, r[0].z, r[0].w, r[1].x, r[1].y};
      const v16u_t z = __builtin_bit_cast(v16u_t, __builtin_amdgcn_cvt_scalef32_pk32_bf16_fp6(g, 1.0f));
#pragma unroll
      for (int k = 0; k < 4; ++k) { const unsigned xa = x[k].x, xb = x[k].y, xc = x[k].z, xd = x[k].w; const unsigned za = z[4 * k], zb = z[4 * k + 1], zc = z[4 * k + 2], zd = z[4 * k + 3];
          d0 = dot2_bf16(za, xa, d0); d1 = dot2_bf16(zb, xb, d1); d2 = dot2_bf16(zc, xc, d2); d3 = dot2_bf16(zd, xd, d3); }
    }
    { const v6u_t g = {r[1].z, r[1].w, r[2].x, r[2].y, r[2].z, r[2].w};
      const v16u_t z = __builtin_bit_cast(v16u_t, __builtin_amdgcn_cvt_scalef32_pk32_bf16_fp6(g, 1.0f));
#pragma unroll
      for (int k = 0; k < 4; ++k) { const unsigned xa = x[4 + k].x, xb = x[4 + k].y, xc = x[4 + k].z, xd = x[4 + k].w; const unsigned za = z[4 * k], zb = z[4 * k + 1], zc = z[4 * k + 2], zd = z[4 * k + 3];
          d0 = dot2_bf16(za, xa, d0); d1 = dot2_bf16(zb, xb, d1); d2 = dot2_bf16(zc, xc, d2); d3 = dot2_bf16(zd, xd, d3); } }
    return wave_sum_u((d0 + d1) + (d2 + d3));
}
#define PE_PIN16(a, b) asm volatile("" : "+v"(a[b + 0]), "+v"(a[b + 1]), "+v"(a[b + 2]), "+v"(a[b + 3]), "+v"(a[b + 4]), "+v"(a[b + 5]), "+v"(a[b + 6]), "+v"(a[b + 7]), \
                                         "+v"(a[b + 8]), "+v"(a[b + 9]), "+v"(a[b + 10]), "+v"(a[b + 11]), "+v"(a[b + 12]), "+v"(a[b + 13]), "+v"(a[b + 14]), "+v"(a[b + 15]))
__device__ __forceinline__ void pe_axpy(float (&acc)[64], const u32x4v (&r)[3], const float w) {
    { const v6u_t g = {r[0].x, r[0].y, r[0].z, r[0].w, r[1].x, r[1].y};
      const v32f_t y = __builtin_amdgcn_cvt_scalef32_pk32_f32_fp6(g, 1.0f);
#pragma unroll
      for (int i = 0; i < 32; ++i) acc[i] = fmaf(w, y[i], acc[i]);
      PE_PIN16(acc, 0); PE_PIN16(acc, 16); }
    { const v6u_t g = {r[1].z, r[1].w, r[2].x, r[2].y, r[2].z, r[2].w};
      const v32f_t y = __builtin_amdgcn_cvt_scalef32_pk32_f32_fp6(g, 1.0f);
#pragma unroll
      for (int i = 0; i < 32; ++i) acc[32 + i] = fmaf(w, y[i], acc[32 + i]);
      PE_PIN16(acc, 32); PE_PIN16(acc, 48); }
}
__device__ __forceinline__ void wave_sort128(unsigned& a0, unsigned& a1, const int lane) {
#pragma unroll
    for (int k = 2; k <= 128; k <<= 1) {
#pragma unroll
        for (int j = k >> 1; j > 0; j >>= 1) {
            if (j == 64) { const unsigned lo = a0 < a1 ? a0 : a1, hi = a0 < a1 ? a1 : a0; a0 = lo; a1 = hi; }
            else {
                const unsigned o0 = (unsigned)__shfl_xor((int)a0, j), o1 = (unsigned)__shfl_xor((int)a1, j);
                const bool lowhalf = (lane & j) == 0;
                const bool up0 = k >= 128 ? true : ((lane & k) == 0);
                const bool up1 = k >= 128 ? true : (k == 64 ? false : ((lane & k) == 0));
                const bool min0 = lowhalf == up0, min1 = lowhalf == up1;
                const unsigned mn0 = a0 < o0 ? a0 : o0, mx0 = a0 < o0 ? o0 : a0, mn1 = a1 < o1 ? a1 : o1, mx1 = a1 < o1 ? o1 : a1;
                a0 = min0 ? mn0 : mx0; a1 = min1 ? mn1 : mx1;
            }
        }
    }
}
__device__ __forceinline__ void peer_expert_phase(const bf16_t* __restrict__ ypre, const float* __restrict__ stats, const float* __restrict__ gm, const float* __restrict__ bm, const bf16_t* __restrict__ x1b, int* __restrict__ eidx, float* __restrict__ gate,
                                                  const unsigned char* __restrict__ ub, const unsigned char* __restrict__ vb, const float* __restrict__ isu, const float* __restrict__ isv,
                                                  const float* __restrict__ lg, const float* __restrict__ lb, float* __restrict__ out, bf16_t* __restrict__ outb, LDSA float* xt0, const int bid, const int G, const int tid) {
    const int wv = __builtin_amdgcn_readfirstlane(tid >> 6);
    LDSA float* xt = xt0 + wv * (XT_BYTES / 4);
#define PE_POS(k) (rev ? 127 - (k) : (k))
#define PE_E(k) pick_i(e0, e1, PE_POS(k))
    int jt = 0;
    for (int t = bid * 8 + wv; t < SEQ; t += G * 8, ++jt) {
        int tl = tid; asm volatile("" : "+v"(tl));
        const int lane = tl & 63;
        const bool rev = (jt & 1) != 0;
        int e0, e1; float g0, g1;
        { const int r0 = eidx[(size_t)t * 128 + lane], r1 = eidx[(size_t)t * 128 + 64 + lane];
          const float h0 = gate[(size_t)t * 128 + lane], h1 = gate[(size_t)t * 128 + 64 + lane];
          unsigned a0 = ((unsigned)r0 << 7) | (unsigned)lane, a1 = ((unsigned)r1 << 7) | (unsigned)(64 + lane);
          wave_sort128(a0, a1, lane);
          e0 = (int)(a0 >> 7); e1 = (int)(a1 >> 7);
          const int k0 = (int)(a0 & 127u), k1 = (int)(a1 & 127u);
          const float p00 = __shfl(h0, k0 & 63), p01 = __shfl(h1, k0 & 63), p10 = __shfl(h0, k1 & 63), p11 = __shfl(h1, k1 & 63);
          g0 = k0 < 64 ? p00 : p01; g1 = k1 < 64 ? p10 : p11; }
        const float iu0 = isu[e0], iu1 = isu[e1], iv0 = isv[e0], iv1 = isv[e1];
        u32x4v xq[8];
#pragma unroll
        for (int k = 0; k < 8; ++k) xq[k] = *(const u32x4v*)(x1b + (size_t)t * DM + lane * 64 + k * 8);
        float w0 = 0.f, w1 = 0.f;
        u32x4v R0[3], R1[3], R2[3], R3[3], R4[3];
#define PE_USTEP(R, k) do { const int kk = PE_POS(k); const float d = pe_dot(R, xq) * pick_f(iu0, iu1, kk); const float w = pick_f(g0, g1, kk) * gelu_tanh_f(d) * pick_f(iv0, iv1, kk); \
            if (lane == (kk & 63)) { if (kk < 64) w0 = w; else w1 = w; } } while (0)
        PE_LOADROW(R0, ub, PE_E(0)); PE_LOADROW(R1, ub, PE_E(1)); PE_LOADROW(R2, ub, PE_E(2)); PE_LOADROW(R3, ub, PE_E(3));
        for (int k = 0; k < 125; k += 5) {
            if (k + 4 < 128) PE_LOADROW(R4, ub, PE_E(k + 4)); PE_USTEP(R0, k);
            if (k + 5 < 128) PE_LOADROW(R0, ub, PE_E(k + 5)); PE_USTEP(R1, k + 1);
            if (k + 6 < 128) PE_LOADROW(R1, ub, PE_E(k + 6)); PE_USTEP(R2, k + 2);
            if (k + 7 < 128) PE_LOADROW(R2, ub, PE_E(k + 7)); PE_USTEP(R3, k + 3);
            if (k + 8 < 128) PE_LOADROW(R3, ub, PE_E(k + 8)); PE_USTEP(R4, k + 4);
        }
        PE_USTEP(R0, 125); PE_USTEP(R1, 126); PE_USTEP(R2, 127);
#undef PE_USTEP
        eidx[(size_t)t * 128 + lane] = e0; eidx[(size_t)t * 128 + 64 + lane] = e1;
        gate[(size_t)t * 128 + lane] = w0; gate[(size_t)t * 128 + 64 + lane] = w1;
    }
    asm volatile("s_waitcnt vmcnt(0)" ::: "memory");
    for (int t = bid * 8 + wv; t < SEQ; t += G * 8, ++jt) {
        int tl = tid; asm volatile("" : "+v"(tl));
        const int lane = tl & 63;
        const bool rev = (jt & 1) != 0;
        const int e0 = __builtin_nontemporal_load(eidx + (size_t)t * 128 + lane), e1 = __builtin_nontemporal_load(eidx + (size_t)t * 128 + 64 + lane);
        const float w0 = __builtin_nontemporal_load(gate + (size_t)t * 128 + lane), w1 = __builtin_nontemporal_load(gate + (size_t)t * 128 + 64 + lane);
        u32x4v R0[3], R1[3], R2[3], R3[3], R4[3];
        float acc[64];
#pragma unroll
        for (int i = 0; i < 64; ++i) acc[i] = 0.f;
        PE_LOADROW(R0, vb, PE_E(0)); PE_LOADROW(R1, vb, PE_E(1)); PE_LOADROW(R2, vb, PE_E(2)); PE_LOADROW(R3, vb, PE_E(3));
        for (int k = 0; k < 125; k += 5) {
            if (k + 4 < 128) PE_LOADROW(R4, vb, PE_E(k + 4)); pe_axpy(acc, R0, pick_f(w0, w1, PE_POS(k)));
            if (k + 5 < 128) PE_LOADROW(R0, vb, PE_E(k + 5)); pe_axpy(acc, R1, pick_f(w0, w1, PE_POS(k + 1)));
            if (k + 6 < 128) PE_LOADROW(R1, vb, PE_E(k + 6)); pe_axpy(acc, R2, pick_f(w0, w1, PE_POS(k + 2)));
            if (k + 7 < 128) PE_LOADROW(R2, vb, PE_E(k + 7)); pe_axpy(acc, R3, pick_f(w0, w1, PE_POS(k + 3)));
            if (k + 8 < 128) PE_LOADROW(R3, vb, PE_E(k + 8)); pe_axpy(acc, R4, pick_f(w0, w1, PE_POS(k + 4)));
        }
        pe_axpy(acc, R0, pick_f(w0, w1, PE_POS(125))); pe_axpy(acc, R1, pick_f(w0, w1, PE_POS(126))); pe_axpy(acc, R2, pick_f(w0, w1, PE_POS(127)));
#pragma unroll
        for (int k = 0; k < 16; ++k) *(LDSA f4v_t*)(xt + lane * XT_STRIDE + 4 * k) = (f4v_t){acc[4 * k], acc[4 * k + 1], acc[4 * k + 2], acc[4 * k + 3]};
        asm volatile("s_waitcnt lgkmcnt(0)" ::: "memory");
        float4 y[16]; float s = 0.f; const float2 st = *(const float2*)(stats + (size_t)t * 2);
#pragma unroll
        for (int j = 0; j < 16; ++j) { const f4v_t f = *(const LDSA f4v_t*)(xt + (4 * j + (lane >> 4)) * XT_STRIDE + 4 * (lane & 15));
            const uint2 yw = *(const uint2*)(ypre + (size_t)t * DM + j * 256 + lane * 4); const float4 yv = make_float4(bf_lo(yw.x), bf_hi(yw.x), bf_lo(yw.y), bf_hi(yw.y));
            const float4 gv = *(const float4*)(gm + j * 256 + lane * 4), bv = *(const float4*)(bm + j * 256 + lane * 4);
            float4 xv;
            xv.x = (yv.x - st.x) * st.y * gv.x + bv.x; xv.y = (yv.y - st.x) * st.y * gv.y + bv.y; xv.z = (yv.z - st.x) * st.y * gv.z + bv.z; xv.w = (yv.w - st.x) * st.y * gv.w + bv.w;
            y[j].x = fmaf(ALPHA, xv.x, f.x); y[j].y = fmaf(ALPHA, xv.y, f.y); y[j].z = fmaf(ALPHA, xv.z, f.z); y[j].w = fmaf(ALPHA, xv.w, f.w);
            s += (y[j].x + y[j].y) + (y[j].z + y[j].w);
            if ((j & 3) == 3) asm volatile("" ::: "memory"); }
        asm volatile("s_waitcnt lgkmcnt(0)" ::: "memory");
        const float mean = wave_sum_u(s) * (1.0f / DM);
        float qq = 0.f;
#pragma unroll
        for (int j = 0; j < 16; ++j) { const float a = y[j].x - mean, b = y[j].y - mean, c = y[j].z - mean, d = y[j].w - mean; qq += (a * a + b * b) + (c * c + d * d); }
        const float rstd = 1.0f / sqrtf(wave_sum_u(qq) * (1.0f / DM) + 1e-5f);
#pragma unroll
        for (int j = 0; j < 16; ++j) {
            const int c = j * 256 + lane * 4;
            const float4 ga = *(const float4*)(lg + c), ba = *(const float4*)(lb + c);
            float4 oa; oa.x = (y[j].x - mean) * rstd * ga.x + ba.x; oa.y = (y[j].y - mean) * rstd * ga.y + ba.y; oa.z = (y[j].z - mean) * rstd * ga.z + ba.z; oa.w = (y[j].w - mean) * rstd * ga.w + ba.w;
            if (out) *(float4*)(out + (size_t)t * DM + c) = oa;
            if (outb) { uint2 w; w.x = cvtpk_bf16(oa.x, oa.y); w.y = cvtpk_bf16(oa.z, oa.w); *(uint2*)(outb + (size_t)t * DM + c) = w; }
            if ((j & 3) == 3) asm volatile("" ::: "memory");
        }
    }
#undef PE_E
#undef PE_POS
}

__device__ __forceinline__ void attn1_phase(const bf16_t* __restrict__ hb, bf16_t* __restrict__ abb, float* __restrict__ oc, const float* __restrict__ lq1, const float* __restrict__ lk1, const float* __restrict__ lq2,
                                            const float* __restrict__ lk2, const float* __restrict__ subg, char* lds, const int bid, const int G, const int tid) {
    for (int u = bid; u < 512; u += G) {
        __syncthreads();
        const int kv = u >> 7, g = (u >> 5) & 3, qb = u & 31, hq = kv * 4 + g;
        att::attn_wide_body<9216, 9216, 4096, 1, att::bf16, false, 0, 2>(hb + (size_t)(qb * 256) * 9216 + 6144 + hq * 128, hb + 8192 + kv * 128, hb + 8704 + kv * 128,
                                                             abb + (size_t)(qb * 256) * 4096 + 2048 + hq * 128, SEQ, lds, tid);
    }
    int tid2 = tid; asm volatile("" : "+v"(tid2));
    const int lane_c = tid2 & 63;
    const float lam = __int_as_float(__builtin_amdgcn_readfirstlane(__float_as_int(__expf(wave_sum(lq1[lane_c] * lk1[lane_c] + lq1[lane_c + 64] * lk1[lane_c + 64])) - __expf(wave_sum(lq2[lane_c] * lk2[lane_c] + lq2[lane_c + 64] * lk2[lane_c + 64])) + LAMBDA_INIT)));
    for (int v = bid; v < 256; v += G) {
        __syncthreads();
        const int h = v >> 5, qb = v & 31;
        float* o1 = oc + (size_t)(qb * 256) * 2048 + h * 256;
        int tid4 = tid2; asm volatile("" : "+v"(tid4));
        att::attn_wide_body<9216, 9216, 2048, 2, float>(hb + (size_t)(qb * 256) * 9216 + h * 256, hb + 2048 + h * 256, hb + 4096 + h * 256, o1, SEQ, lds, tid4);
        __syncthreads();
        int tid3 = tid2; asm volatile("" : "+v"(tid3));
        att::attn_wide_body<9216, 9216, 2048, 2, float, true, 4096>(hb + (size_t)(qb * 256) * 9216 + h * 256 + 128, hb + 2048 + h * 256 + 128, hb + 4096 + h * 256, o1, SEQ, lds, tid3,
                                                                     lam, 1.0f - LAMBDA_INIT, subg, abb + (size_t)(qb * 256) * 4096 + h * 256);
    }
}


__device__ __forceinline__ void attn0_phase(const bf16_t* __restrict__ hb, const float* __restrict__ sink, bf16_t* __restrict__ abb, bf16_t* __restrict__ obg, float* __restrict__ lse, char* lds, const int bid, const int G, const int tid) {
    const long LD = 12288;
    for (int u = bid; u < 512; u += G) {
        __syncthreads();
        const int hq = u >> 5, qb = u & 31, kv = hq >> 2;
        att::attn_banded_body<128>(hb + hq * 128, hb + 2048 + kv * 128, hb + 2560 + kv * 128, LD, SEQ, qb * 256, sink[hq] * (1.0f / att::SCALE), 1.0f, abb + hq * 128, 3072, nullptr, 0, lds, tid);
    }
    int tid2 = tid; asm volatile("" : "+v"(tid2));
    for (int v = bid; v < 768; v += G) {
        __syncthreads();
        const int g = v >> 8, w = v & 255, h = w >> 5, rem = w & 31;
        const int dsh = 2 * g;
        const int nqb_sh = 5 - dsh;
        const int r = rem >> nqb_sh, qb = rem & ((1 << nqb_sh) - 1);
        const int head = 8 * g + h;
        const long rs = LD << dsh;
        att::attn_banded_body<64>(hb + (long)r * LD + 3072 + head * 128, hb + (long)r * LD + 6144 + head * 128, hb + (long)r * LD + 9216 + head * 128, rs, SEQ >> dsh, qb * 256, -1e30f, 0.f,
                                  obg + ((long)(g * 8 + h) * SEQ + r) * 128, (long)128 << dsh, lse + (long)(g * 8 + h) * SEQ + r, (long)1 << dsh, lds, tid2);
    }
}
__device__ __forceinline__ void merge0_phase(const bf16_t* __restrict__ obg, const float* __restrict__ lse, bf16_t* __restrict__ abb, const int bid, const int G, const int tid) {
    const int lane = tid & 63, wv = tid >> 6;
    for (int j = bid * 8 + wv; j < SEQ * 8; j += G * 8) {
        const int h = j >> 13, t = j & (SEQ - 1);
        const float l0 = lse[(size_t)(0 * 8 + h) * SEQ + t], l1 = lse[(size_t)(1 * 8 + h) * SEQ + t], l2 = lse[(size_t)(2 * 8 + h) * SEQ + t];
        const float mx = fmaxf(l0, fmaxf(l1, l2));
        const float e0 = __expf(l0 - mx), e1 = __expf(l1 - mx), e2 = __expf(l2 - mx), inv = 1.0f / (e0 + e1 + e2);
        const unsigned a0 = *(const unsigned*)(obg + ((size_t)(0 * 8 + h) * SEQ + t) * 128 + 2 * lane), a1 = *(const unsigned*)(obg + ((size_t)(1 * 8 + h) * SEQ + t) * 128 + 2 * lane), a2 = *(const unsigned*)(obg + ((size_t)(2 * 8 + h) * SEQ + t) * 128 + 2 * lane);
        const float x = (e0 * bf_lo(a0) + e1 * bf_lo(a1) + e2 * bf_lo(a2)) * inv, y = (e0 * bf_hi(a0) + e1 * bf_hi(a1) + e2 * bf_hi(a2)) * inv;
        *(unsigned*)(abb + (size_t)t * 3072 + 2048 + h * 128 + 2 * lane) = cvtpk_bf16(x, y);
    }
}

__device__ __forceinline__ void post_even_phase(const float* __restrict__ h, bf16_t* __restrict__ hb, const int bid, const int G, const int tid) {
    const int lane = tid & 63, wv = tid >> 6;
    for (int job = bid * 8 + wv; job < SEQ * 96; job += G * 8) {
        const int t = job / 96, blk = job - t * 96;
        const bool rope = (blk < 20) || (blk >= 24 && blk < 72);
        const float2 v = *(const float2*)(h + (size_t)t * 12288 + blk * 128 + 2 * lane);
        float o0 = v.x, o1 = v.y;
        const float p0 = __shfl_xor(v.x, 8), p1 = __shfl_xor(v.y, 8);
        if (rope && lane < 16) {
            const int i0 = (2 * lane) & 15;
            float s0, c0, s1, c1; sincos_rev((double)t * REV_P[i0], s0, c0); sincos_rev((double)t * REV_P[i0 + 1], s1, c1);
            if (lane < 8) { o0 = v.x * c0 - p0 * s0; o1 = v.y * c1 - p1 * s1; }
            else          { o0 = v.x * c0 + p0 * s0; o1 = v.y * c1 + p1 * s1; }
        }
        *(unsigned*)(hb + (size_t)t * 12288 + blk * 128 + 2 * lane) = cvtpk_bf16(o0, o1);
    }
}
__device__ __forceinline__ void post_odd_phase(const float* __restrict__ h, bf16_t* __restrict__ hb, const float* __restrict__ qg, const float* __restrict__ kg, const int bid, const int G, const int tid) {
    const int lane = tid & 63, wv = tid >> 6;
    for (int job = bid * 8 + wv; job < SEQ * 72; job += G * 8) {
        const int t = job / 72, blk = job - t * 72;
        const float2 v = *(const float2*)(h + (size_t)t * 9216 + blk * 128 + 2 * lane);
        float o0 = v.x, o1 = v.y;
        if (blk < 32) {
            const float p0 = __shfl_xor(v.x, 8), p1 = __shfl_xor(v.y, 8);
            if (lane < 16) {
                const int i0 = (2 * lane) & 15;
                float s0, c0, s1, c1; sincos_rev((double)t * REV_P[i0], s0, c0); sincos_rev((double)t * REV_P[i0 + 1], s1, c1);
                if (lane < 8) { o0 = v.x * c0 - p0 * s0; o1 = v.y * c1 - p1 * s1; }
                else          { o0 = v.x * c0 + p0 * s0; o1 = v.y * c1 + p1 * s1; }
            }
        } else if (blk >= 48 && blk < 68) {
            const float* g = blk < 64 ? qg : kg;
            const float ss = wave_sum(v.x * v.x + v.y * v.y) * (1.0f / 128.0f);
            const float rs = 1.0f / sqrtf(ss + 1e-6f);
            const float a0 = v.x * rs * g[2 * lane], a1 = v.y * rs * g[2 * lane + 1];
            const float p0 = __shfl_xor(a0, 16), p1 = __shfl_xor(a1, 16);
            const int i0 = (2 * lane) & 31;
            const double pos = (double)(lane < 32 ? (t >> 6) : (t & 63));
            float s0, c0, s1, c1; sincos_rev(pos * REV_A[i0], s0, c0); sincos_rev(pos * REV_A[i0 + 1], s1, c1);
            if ((lane & 16) == 0) { o0 = a0 * c0 - p0 * s0; o1 = a1 * c1 - p1 * s1; }
            else                  { o0 = a0 * c0 + p0 * s0; o1 = a1 * c1 + p1 * s1; }
        }
        *(unsigned*)(hb + (size_t)t * 9216 + blk * 128 + 2 * lane) = cvtpk_bf16(o0, o1);
    }
}

__device__ __forceinline__ void attn_seg_b(const float q0, const float q1, const bf16_t* __restrict__ Kb, const bf16_t* __restrict__ Vb, const int ld,
                                           const int t, const int step, int jlo, int jhi, float& m, float& l, float& o0, float& o1, const int lane) {
    { const int lo = -(t / step); if (jlo < lo) jlo = lo; const int hi = (SEQ - 1 - t) / step; if (jhi > hi) jhi = hi; }
    for (int j = jlo; j <= jhi; ++j) {
        const size_t tp = (size_t)(t + step * j);
        const unsigned kw = *(const unsigned*)(Kb + tp * ld + 2 * lane), vw = *(const unsigned*)(Vb + tp * ld + 2 * lane);
        const float s = wave_sum(q0 * bf_lo(kw) + q1 * bf_hi(kw)) * ATT_SCALE;
        const float mn = fmaxf(m, s);
        const float al = __expf(m - mn), p = __expf(s - mn);
        l = l * al + p;
        o0 = o0 * al + p * bf_lo(vw); o1 = o1 * al + p * bf_hi(vw);
        m = mn;
    }
}
__device__ __forceinline__ void attn_even_valu_phase(const bf16_t* __restrict__ hb, const float* __restrict__ sink, bf16_t* __restrict__ abb, const int bid, const int G, const int tid) {
    const int lane = tid & 63, wv = tid >> 6;
    const int LD = 12288;
    for (int job = bid * 8 + wv; job < SEQ * 24; job += G * 8) {
        const int hh = job / SEQ, t = job % SEQ;
        float o0 = 0.f, o1 = 0.f, m, l;
        if (hh < 16) {
            const int kv = hh >> 2;
            const unsigned qw = *(const unsigned*)(hb + (size_t)t * LD + hh * 128 + 2 * lane);
            m = sink[hh]; l = 1.f;
            attn_seg_b(bf_lo(qw), bf_hi(qw), hb + 2048 + kv * 128, hb + 2560 + kv * 128, LD, t, 1, -128, 128, m, l, o0, o1, lane);
        } else {
            const int hbh = hh - 16;
            m = -1e30f; l = 0.f;
#pragma unroll
            for (int g = 0; g < 3; ++g) {
                const int head = 8 * g + hbh; const int step = g == 0 ? 1 : (g == 1 ? 4 : 16);
                const unsigned qw = *(const unsigned*)(hb + (size_t)t * LD + 3072 + head * 128 + 2 * lane);
                attn_seg_b(bf_lo(qw), bf_hi(qw), hb + 6144 + head * 128, hb + 9216 + head * 128, LD, t, step, -64, 64, m, l, o0, o1, lane);
            }
        }
        const float il = 1.0f / l;
        *(unsigned*)(abb + (size_t)t * 3072 + hh * 128 + 2 * lane) = cvtpk_bf16(o0 * il, o1 * il);
    }
}

__device__ __forceinline__ void ln_phase(const bf16_t* __restrict__ y, const float* __restrict__ g, const float* __restrict__ b, float* __restrict__ stats, bf16_t* __restrict__ outb, const int bid, const int G, const int tid) {
    const int lane = tid & 63, wv = tid >> 6;
    for (int t = bid * 8 + wv; t < SEQ; t += G * 8) {
        float4 v[16]; float s = 0.f;
#pragma unroll
        for (int i = 0; i < 16; ++i) { const uint2 w = *(const uint2*)(y + (size_t)t * DM + i * 256 + lane * 4); v[i] = make_float4(bf_lo(w.x), bf_hi(w.x), bf_lo(w.y), bf_hi(w.y)); s += (v[i].x + v[i].y) + (v[i].z + v[i].w); }
        const float mean = wave_sum(s) * (1.0f / DM);
        float q = 0.f;
#pragma unroll
        for (int i = 0; i < 16; ++i) { const float a = v[i].x - mean, bb = v[i].y - mean, c = v[i].z - mean, d = v[i].w - mean; q += (a * a + bb * bb) + (c * c + d * d); }
        const float rstd = 1.0f / sqrtf(wave_sum(q) * (1.0f / DM) + 1e-5f);
        if (lane == 0) *(float2*)(stats + (size_t)t * 2) = make_float2(mean, rstd);
#pragma unroll
        for (int i = 0; i < 16; ++i) {
            const float4 gg = *(const float4*)(g + i * 256 + lane * 4), bb = *(const float4*)(b + i * 256 + lane * 4);
            float4 o; o.x = (v[i].x - mean) * rstd * gg.x + bb.x; o.y = (v[i].y - mean) * rstd * gg.y + bb.y; o.z = (v[i].z - mean) * rstd * gg.z + bb.z; o.w = (v[i].w - mean) * rstd * gg.w + bb.w;
            uint2 w; w.x = cvtpk_bf16(o.x, o.y); w.y = cvtpk_bf16(o.z, o.w); *(uint2*)(outb + (size_t)t * DM + i * 256 + lane * 4) = w;
            if ((i & 3) == 3) asm volatile("" ::: "memory");
        }
    }
}

__device__ __forceinline__ void route_valu_phase(const float* __restrict__ q  , const float* __restrict__ keys  , int* __restrict__ eidx, float* __restrict__ gate, const int bid, const int G, const int tid) {
    const int lane = tid & 63, wv = tid >> 6;
    for (int job = bid * 8 + wv; job < SEQ * 8; job += G * 8) {
        const int hh = job & 7, t = job >> 3;
        float sv0 = 0.f, sv1 = 0.f; int si0 = 0, si1 = 0;
#pragma unroll
        for (int c = 0; c < 2; ++c) {
            const float* qq = q + (size_t)t * 2048 + hh * 256 + c * 128;
            const float* k0 = keys + ((size_t)(hh * 2 + c) * 128 + lane) * 128;
            const float* k1 = k0 + 64 * 128;
            float s0 = 0.f, s1 = 0.f;
            for (int d = 0; d < 128; d += 4) {
                const float4 qv = *(const float4*)(qq + d), a = *(const float4*)(k0 + d), b = *(const float4*)(k1 + d);
                s0 += qv.x * a.x + qv.y * a.y + qv.z * a.z + qv.w * a.w;
                s1 += qv.x * b.x + qv.y * b.y + qv.z * b.z + qv.w * b.w;
            }
            float myv = 0.f; int myi = 0;
            for (int k = 0; k < 16; ++k) {
                float bv; int bi;
                if (s1 > s0) { bv = s1; bi = lane + 64; } else { bv = s0; bi = lane; }
#pragma unroll
                for (int o = 32; o >= 1; o >>= 1) {
                    const float ov = __shfl_xor(bv, o); const int oi = __shfl_xor(bi, o);
                    if (ov > bv || (ov == bv && oi < bi)) { bv = ov; bi = oi; }
                }
                if (lane == k) { myv = bv; myi = bi; }
                if (bi == lane) s0 = -3.0e38f;
                if (bi == lane + 64) s1 = -3.0e38f;
            }
            if (c == 0) { sv0 = myv; si0 = myi; } else { sv1 = myv; si1 = myi; }
        }
        float cv0, cv1, cv2, cv3; int ci0, ci1, ci2, ci3;
        { const float a = __shfl(sv0, lane >> 2); const int ai = __shfl(si0, lane >> 2); const int jb = (lane & 3) * 4;
          cv0 = a + __shfl(sv1, jb + 0); ci0 = ai * 128 + __shfl(si1, jb + 0);
          cv1 = a + __shfl(sv1, jb + 1); ci1 = ai * 128 + __shfl(si1, jb + 1);
          cv2 = a + __shfl(sv1, jb + 2); ci2 = ai * 128 + __shfl(si1, jb + 2);
          cv3 = a + __shfl(sv1, jb + 3); ci3 = ai * 128 + __shfl(si1, jb + 3); }
        float tv = 0.f; int te = 0;
        for (int k = 0; k < 16; ++k) {
            float bv = cv0; int bp = lane * 4, be = ci0;
            if (cv1 > bv) { bv = cv1; bp = lane * 4 + 1; be = ci1; }
            if (cv2 > bv) { bv = cv2; bp = lane * 4 + 2; be = ci2; }
            if (cv3 > bv) { bv = cv3; bp = lane * 4 + 3; be = ci3; }
#pragma unroll
            for (int o = 32; o >= 1; o >>= 1) {
                const float ov = __shfl_xor(bv, o); const int op = __shfl_xor(bp, o); const int oe = __shfl_xor(be, o);
                if (ov > bv || (ov == bv && op < bp)) { bv = ov; bp = op; be = oe; }
            }
            if (lane == k) { tv = bv; te = be; }
            if (bp == lane * 4 + 0) cv0 = -3.0e38f;
            if (bp == lane * 4 + 1) cv1 = -3.0e38f;
            if (bp == lane * 4 + 2) cv2 = -3.0e38f;
            if (bp == lane * 4 + 3) cv3 = -3.0e38f;
        }
        const float v = lane < 16 ? tv : -3.0e38f;
        const float mx = wave_max(v);
        const float e = lane < 16 ? __expf(tv - mx) : 0.f;
        const float den = wave_sum(e);
        if (lane < 16) { eidx[(size_t)t * 128 + hh * 16 + lane] = te; gate[(size_t)t * 128 + hh * 16 + lane] = e / den; }
    }
}
namespace rt {
using att::f32x16; using att::bf16x8;
__device__ __forceinline__ float pair_max(float m) {
    auto rr = __builtin_amdgcn_permlane32_swap(__float_as_uint(m), __float_as_uint(m), false, false);
    return fmaxf(__uint_as_float(rr[0]), __uint_as_float(rr[1]));
}
__device__ __forceinline__ int pair_max_i(int m) {
    auto rr = __builtin_amdgcn_permlane32_swap((unsigned)m, (unsigned)m, false, false);
    const int a = (int)rr[0], b = (int)rr[1]; return a > b ? a : b;
}
__device__ __forceinline__ void top16_of_128(f32x16& p0, f32x16& p1, f32x16& p2, f32x16& p3, float (&t)[16]) {
#pragma unroll
    for (int k = 0; k < 16; ++k) {
        float m = p0[0];
#pragma unroll
        for (int r = 1; r < 16; ++r) m = fmaxf(m, p0[r]);
#pragma unroll
        for (int r = 0; r < 16; ++r) m = fmaxf(m, fmaxf(p1[r], fmaxf(p2[r], p3[r])));
        m = pair_max(m);
        t[k] = m;
#pragma unroll
        for (int r = 0; r < 16; ++r) { p0[r] = p0[r] == m ? -3.0e38f : p0[r]; p1[r] = p1[r] == m ? -3.0e38f : p1[r]; p2[r] = p2[r] == m ? -3.0e38f : p2[r]; p3[r] = p3[r] == m ? -3.0e38f : p3[r]; }
    }
}
__device__ __forceinline__ void tag_scores(f32x16& p, const int base, const int hi) {
#pragma unroll
    for (int r = 0; r < 16; ++r) p[r] = __uint_as_float((__float_as_uint(p[r]) & ~0x7Fu) | (unsigned)(base + att::crow(r, hi)));
}
}

__device__ __forceinline__ void route_mfma_phase(const bf16_t* __restrict__ pqb  , const bf16_t* __restrict__ keysb  , int* __restrict__ eidx, float* __restrict__ gate,
                                                 char* lds, const pg8::StaticOrder& S, const int tid) {
    using namespace rt;
    const int wid = __builtin_amdgcn_readfirstlane(tid >> 6), lane = tid & 63, r32 = lane & 31, hi = lane >> 5;
    att::bf16* K_lds = (att::bf16*)lds;
    pg8::Unit un;
    for (int ui = 0; S.next(ui, un); ++ui) {
        const int h = un.pn, tb = un.pm * 256;
        const int tok = tb + wid * 32 + r32;
        float t0[16], t1[16];
#pragma unroll
        for (int c = 0; c < 2; ++c) {
            __syncthreads();
            { const bf16_t* kp = keysb + (size_t)(h * 2 + c) * 128 * 128;
              const int row = tid >> 2;
#pragma unroll
              for (int i = 0; i < 4; ++i) { const int sc = ((tid & 3) * 4 + i) * 8;
                  const bf16x8 v = *reinterpret_cast<const bf16x8*>(kp + row * 128 + sc);
                  *(bf16x8*)((char*)K_lds + (row >> 6) * 16384 + KSWZ(row & 63, sc * 2)) = v; } }
            bf16x8 qr[8];
            { const bf16_t* qw = pqb + (size_t)tok * 2048 + h * 256 + c * 128 + hi * 8;
#pragma unroll
              for (int d0 = 0; d0 < 8; ++d0) qr[d0] = *reinterpret_cast<const bf16x8*>(qw + d0 * 16); }
            __syncthreads();
            f32x16 p0, p1, p2, p3;
            att::qkt_pipe(p0, p1, (int)(uintptr_t)K_lds, qr, r32, hi);
            att::qkt_pipe(p2, p3, (int)(uintptr_t)K_lds + 16384, qr, r32, hi);
            tag_scores(p0, 0, hi); tag_scores(p1, 32, hi); tag_scores(p2, 64, hi); tag_scores(p3, 96, hi);
            if (c == 0) top16_of_128(p0, p1, p2, p3, t0); else top16_of_128(p0, p1, p2, p3, t1);
        }
        float v0[16], v1[16]; int k0[16], k1[16];
#pragma unroll
        for (int i = 0; i < 16; ++i) { const unsigned a = __float_as_uint(t0[i]), b = __float_as_uint(t1[i]);
            v0[i] = __uint_as_float(a & ~0x7Fu); v1[i] = __uint_as_float(b & ~0x7Fu); k0[i] = (int)((a & 0x7Fu) << 7); k1[i] = (int)(b & 0x7Fu); }
        float cv[25]; int ce[25];
    { const float s = hi ? (v0[0] + v1[1]) : (v0[0] + v1[0]); cv[0] = __uint_as_float((__float_as_uint(s) & ~0xFFu) | (unsigned)(2 * 0 + hi)); ce[0] = hi ? (k0[0] | k1[1]) : (k0[0] | k1[0]); }
    { const float s = hi ? (v0[0] + v1[3]) : (v0[0] + v1[2]); cv[1] = __uint_as_float((__float_as_uint(s) & ~0xFFu) | (unsigned)(2 * 1 + hi)); ce[1] = hi ? (k0[0] | k1[3]) : (k0[0] | k1[2]); }
    { const float s = hi ? (v0[0] + v1[5]) : (v0[0] + v1[4]); cv[2] = __uint_as_float((__float_as_uint(s) & ~0xFFu) | (unsigned)(2 * 2 + hi)); ce[2] = hi ? (k0[0] | k1[5]) : (k0[0] | k1[4]); }
    { const float s = hi ? (v0[0] + v1[7]) : (v0[0] + v1[6]); cv[3] = __uint_as_float((__float_as_uint(s) & ~0xFFu) | (unsigned)(2 * 3 + hi)); ce[3] = hi ? (k0[0] | k1[7]) : (k0[0] | k1[6]); }
    { const float s = hi ? (v0[0] + v1[9]) : (v0[0] + v1[8]); cv[4] = __uint_as_float((__float_as_uint(s) & ~0xFFu) | (unsigned)(2 * 4 + hi)); ce[4] = hi ? (k0[0] | k1[9]) : (k0[0] | k1[8]); }
    { const float s = hi ? (v0[0] + v1[11]) : (v0[0] + v1[10]); cv[5] = __uint_as_float((__float_as_uint(s) & ~0xFFu) | (unsigned)(2 * 5 + hi)); ce[5] = hi ? (k0[0] | k1[11]) : (k0[0] | k1[10]); }
    { const float s = hi ? (v0[0] + v1[13]) : (v0[0] + v1[12]); cv[6] = __uint_as_float((__float_as_uint(s) & ~0xFFu) | (unsigned)(2 * 6 + hi)); ce[6] = hi ? (k0[0] | k1[13]) : (k0[0] | k1[12]); }
    { const float s = hi ? (v0[0] + v1[15]) : (v0[0] + v1[14]); cv[7] = __uint_as_float((__float_as_uint(s) & ~0xFFu) | (unsigned)(2 * 7 + hi)); ce[7] = hi ? (k0[0] | k1[15]) : (k0[0] | k1[14]); }
    { const float s = hi ? (v0[1] + v1[1]) : (v0[1] + v1[0]); cv[8] = __uint_as_float((__float_as_uint(s) & ~0xFFu) | (unsigned)(2 * 8 + hi)); ce[8] = hi ? (k0[1] | k1[1]) : (k0[1] | k1[0]); }
    { const float s = hi ? (v0[1] + v1[3]) : (v0[1] + v1[2]); cv[9] = __uint_as_float((__float_as_uint(s) & ~0xFFu) | (unsigned)(2 * 9 + hi)); ce[9] = hi ? (k0[1] | k1[3]) : (k0[1] | k1[2]); }
    { const float s = hi ? (v0[1] + v1[5]) : (v0[1] + v1[4]); cv[10] = __uint_as_float((__float_as_uint(s) & ~0xFFu) | (unsigned)(2 * 10 + hi)); ce[10] = hi ? (k0[1] | k1[5]) : (k0[1] | k1[4]); }
    { const float s = hi ? (v0[1] + v1[7]) : (v0[1] + v1[6]); cv[11] = __uint_as_float((__float_as_uint(s) & ~0xFFu) | (unsigned)(2 * 11 + hi)); ce[11] = hi ? (k0[1] | k1[7]) : (k0[1] | k1[6]); }
    { const float s = hi ? (v0[2] + v1[1]) : (v0[2] + v1[0]); cv[12] = __uint_as_float((__float_as_uint(s) & ~0xFFu) | (unsigned)(2 * 12 + hi)); ce[12] = hi ? (k0[2] | k1[1]) : (k0[2] | k1[0]); }
    { const float s = hi ? (v0[2] + v1[3]) : (v0[2] + v1[2]); cv[13] = __uint_as_float((__float_as_uint(s) & ~0xFFu) | (unsigned)(2 * 13 + hi)); ce[13] = hi ? (k0[2] | k1[3]) : (k0[2] | k1[2]); }
    { const float s = hi ? (v0[3] + v1[0]) : (v0[2] + v1[4]); cv[14] = __uint_as_float((__float_as_uint(s) & ~0xFFu) | (unsigned)(2 * 14 + hi)); ce[14] = hi ? (k0[3] | k1[0]) : (k0[2] | k1[4]); }
    { const float s = hi ? (v0[3] + v1[2]) : (v0[3] + v1[1]); cv[15] = __uint_as_float((__float_as_uint(s) & ~0xFFu) | (unsigned)(2 * 15 + hi)); ce[15] = hi ? (k0[3] | k1[2]) : (k0[3] | k1[1]); }
    { const float s = hi ? (v0[4] + v1[0]) : (v0[3] + v1[3]); cv[16] = __uint_as_float((__float_as_uint(s) & ~0xFFu) | (unsigned)(2 * 16 + hi)); ce[16] = hi ? (k0[4] | k1[0]) : (k0[3] | k1[3]); }
    { const float s = hi ? (v0[4] + v1[2]) : (v0[4] + v1[1]); cv[17] = __uint_as_float((__float_as_uint(s) & ~0xFFu) | (unsigned)(2 * 17 + hi)); ce[17] = hi ? (k0[4] | k1[2]) : (k0[4] | k1[1]); }
    { const float s = hi ? (v0[5] + v1[1]) : (v0[5] + v1[0]); cv[18] = __uint_as_float((__float_as_uint(s) & ~0xFFu) | (unsigned)(2 * 18 + hi)); ce[18] = hi ? (k0[5] | k1[1]) : (k0[5] | k1[0]); }
    { const float s = hi ? (v0[6] + v1[1]) : (v0[6] + v1[0]); cv[19] = __uint_as_float((__float_as_uint(s) & ~0xFFu) | (unsigned)(2 * 19 + hi)); ce[19] = hi ? (k0[6] | k1[1]) : (k0[6] | k1[0]); }
    { const float s = hi ? (v0[7] + v1[1]) : (v0[7] + v1[0]); cv[20] = __uint_as_float((__float_as_uint(s) & ~0xFFu) | (unsigned)(2 * 20 + hi)); ce[20] = hi ? (k0[7] | k1[1]) : (k0[7] | k1[0]); }
    { const float s = hi ? (v0[9] + v1[0]) : (v0[8] + v1[0]); cv[21] = __uint_as_float((__float_as_uint(s) & ~0xFFu) | (unsigned)(2 * 21 + hi)); ce[21] = hi ? (k0[9] | k1[0]) : (k0[8] | k1[0]); }
    { const float s = hi ? (v0[11] + v1[0]) : (v0[10] + v1[0]); cv[22] = __uint_as_float((__float_as_uint(s) & ~0xFFu) | (unsigned)(2 * 22 + hi)); ce[22] = hi ? (k0[11] | k1[0]) : (k0[10] | k1[0]); }
    { const float s = hi ? (v0[13] + v1[0]) : (v0[12] + v1[0]); cv[23] = __uint_as_float((__float_as_uint(s) & ~0xFFu) | (unsigned)(2 * 23 + hi)); ce[23] = hi ? (k0[13] | k1[0]) : (k0[12] | k1[0]); }
    { const float s = hi ? (v0[15] + v1[0]) : (v0[14] + v1[0]); cv[24] = __uint_as_float((__float_as_uint(s) & ~0xFFu) | (unsigned)(2 * 24 + hi)); ce[24] = hi ? (k0[15] | k1[0]) : (k0[14] | k1[0]); }
        float ts[16]; int te[16];
#pragma unroll
        for (int k = 0; k < 16; ++k) {
            float m = cv[0];
#pragma unroll
            for (int n = 1; n < 25; ++n) m = fmaxf(m, cv[n]);
            m = pair_max(m);
            int e = -1;
#pragma unroll
            for (int n = 0; n < 25; ++n) { const bool hit = cv[n] == m; e = hit ? ce[n] : e; cv[n] = hit ? -3.0e38f : cv[n]; }
            ts[k] = __uint_as_float(__float_as_uint(m) & ~0xFFu); te[k] = pair_max_i(e);
        }
        float den = 0.f; const float mx = ts[0];
#pragma unroll
        for (int k = 0; k < 16; ++k) { ts[k] = __expf(ts[k] - mx); den += ts[k]; }
        const float inv = 1.0f / den;
        if (hi == 0) { int4* op = (int4*)(eidx + (size_t)tok * 128 + h * 16);
            op[0] = make_int4(te[0], te[1], te[2], te[3]); op[1] = make_int4(te[4], te[5], te[6], te[7]); op[2] = make_int4(te[8], te[9], te[10], te[11]); op[3] = make_int4(te[12], te[13], te[14], te[15]); }
        else { float4* op = (float4*)(gate + (size_t)tok * 128 + h * 16);
            op[0] = make_float4(ts[0] * inv, ts[1] * inv, ts[2] * inv, ts[3] * inv); op[1] = make_float4(ts[4] * inv, ts[5] * inv, ts[6] * inv, ts[7] * inv);
            op[2] = make_float4(ts[8] * inv, ts[9] * inv, ts[10] * inv, ts[11] * inv); op[3] = make_float4(ts[12] * inv, ts[13] * inv, ts[14] * inv, ts[15] * inv); }
    }
}
#ifndef PH_MASK
#define PH_MASK 0xffffffffu
#endif
constexpr int N_PHASES = 20;
__global__ void __launch_bounds__(512, 2) mega(MK a) {
    extern __shared__ __attribute__((aligned(16))) unsigned char lds_raw[];
    LDSA unsigned char* lds = (LDSA unsigned char*)lds_raw;
    const int lo = a.ph_lo, hi = a.ph_hi;
    const int G = gridDim.x, bid = blockIdx.x;
    const int wid_s = __builtin_amdgcn_readfirstlane(threadIdx.x >> 6);
    unsigned char* ws = a.ws;
#define PH_TID() int tid; { int _z = 0; asm volatile("" : "+s"(_z)); tid = wid_s * 64 + (int)__builtin_amdgcn_mbcnt_hi(~0u, __builtin_amdgcn_mbcnt_lo(~0u, (unsigned)_z)); }
#define WSP(T, name, off) T* name; { unsigned char* _b = ws; asm volatile("" : "+s"(_b)); name = (T*)(_b + (off)); }
#define IN(k) ((((PH_MASK) >> (k)) & 1u) && lo <= (k) && (k) < hi)
#define SEAM(k) do { if ((k) + 1 < hi) { PH_TID() xcd_barrier(bar, tid); } } while (0)
    XcdBarrier bar;
    { PH_TID()
      volatile LAS unsigned* st = (volatile LAS unsigned*)(lds + LDS_MISC);
      if (tid == 0) { st[0] = 0u; st[1] = 0u; }
      __syncthreads();
      bar = xcd_barrier_post((unsigned*)(ws + WS_CTL), st, tid); }

    if (IN(0)) {
      {
        PH_TID()
        WSP(bf16_t, xb, WS_XB) WSP(bf16_t, wab, WS_WAB) WSP(bf16_t, woab, WS_WOAB) WSP(bf16_t, wcd, WS_WCD) WSP(bf16_t, wocd, WS_WOCD) WSP(bf16_t, wq, WS_WQ) WSP(unsigned char, ub, WS_UB) WSP(unsigned char, vb, WS_VB) WSP(float, isu, WS_SU) WSP(float, isv, WS_SV)
        cvt_rows_bf16(a.in[0], xb, (size_t)SEQ * DM / 8, bid, G, tid, 512);
        LDSA float* tile = (LDSA float*)lds;
        transpose_cvt(a.in[1], wab, 4096, 12288, tile, bid, G, PermAB(), tid);
        transpose_cvt(a.in[3], woab, 3072, 4096, tile, bid, G, PermNone(), tid);
        transpose_cvt(a.in[4], wcd, 4096, 9216, tile, bid, G, PermCD(), tid);
        transpose_cvt(a.in[12], wocd, 4096, 4096, tile, bid, G, PermNone(), tid);
        transpose_cvt(a.in[15], wq, 4096, 2048, tile, bid, G, PermNone(), tid);
        transpose_cvt(a.in[15] + (size_t)4096 * 2048, wq + (size_t)2048 * 4096, 4096, 2048, tile, bid, G, PermNone(), tid);
        table_fp6(a.in[17], ub, isu, 2 * 16384, (LDSA float*)lds, bid, G, tid);
        { const int nu1 = (SEQ / 256) * (9216 / 256); const bool slack = (nu1 % G) != 0 && (nu1 % G) <= G / 2;
          table_fp6(a.in[18], vb, isv, slack ? 16384 : 2 * 16384, (LDSA float*)lds, bid, G, tid); }
        { WSP(float, cs0, WS_CS0) WSP(float, csa, WS_CSA) rope_tables(cs0, csa, bid, G, tid); }
        { WSP(bf16_t, keyb, WS_KEYB) cvt_rows_bf16(a.in[16], keyb, (size_t)2 * 8 * 2 * 128 * 128 / 8, bid, G, tid, 512); }
      }
        SEAM(0);
    }
    { constexpr int layer = 0;
        const int pb = 1 + 10 * layer;
        if (IN(pb + 0)) {
            PH_TID() WSP(bf16_t, xb, WS_XB) WSP(bf16_t, x2b, WS_X2B) WSP(bf16_t, wab, WS_WAB) WSP(bf16_t, wcd, WS_WCD) WSP(bf16_t, hb, WS_HB) WSP(float, cs0, WS_CS0) WSP(float, csa, WS_CSA)
            if (layer == 0) {
                pg8::Gemm g{xb, wab, SEQ, 12288, 4096}; pg8::StaticOrder S; S.init(SEQ, 12288, G, bid);
                pg8::EpiProj<0> E{hb, 12288, cs0, csa, nullptr, nullptr, (LDSA float*)(lds + LDS_MISC + 64)};
                pg8::gemm_phase<pg8::EpiProj<0>, pg8::StaticOrder>(lds, g, S, E, nullptr, tid);
            } else {
                pg8::Gemm g{x2b, wcd, SEQ, 9216, 4096}; pg8::StaticOrder S; S.init(SEQ, 9216, G, bid);
                pg8::EpiProj<1> E{hb, 9216, cs0, csa, a.in[10], a.in[11], (LDSA float*)(lds + LDS_MISC + 64)};
                pg8::gemm_phase<pg8::EpiProj<1>, pg8::StaticOrder>(lds, g, S, E, nullptr, tid);
                { const int nu1 = (SEQ / 256) * (9216 / 256), busy = nu1 % G; const bool slack = busy != 0 && busy <= G / 2;
                  if (slack && bid >= busy) {
                      WSP(unsigned char, vb1, WS_VB) WSP(float, isv1, WS_SV)
                      int t5; { int _z = 0; asm volatile("" : "+s"(_z)); t5 = wid_s * 64 + (int)__builtin_amdgcn_mbcnt_hi(~0u, __builtin_amdgcn_mbcnt_lo(~0u, (unsigned)_z)); }
                      table_fp6(a.in[18] + (size_t)16384 * DM, vb1 + (size_t)16384 * ROWB, isv1 + 16384, 16384, (LDSA float*)lds, bid - busy, G - busy, t5); } }
            }
            SEAM(pb + 0);
        }
        if (IN(pb + 2)) {
            PH_TID() WSP(bf16_t, hb, WS_HB) WSP(bf16_t, abb, WS_AB) WSP(float, oc, WS_OC)
            if (layer == 0) attn0_phase(hb, a.in[2], abb, (bf16_t*)oc, (float*)((unsigned char*)oc + (size_t)3 * 8 * SEQ * 128 * 2), (char*)lds_raw, bid, G, tid);
            else attn1_phase(hb, abb, oc, a.in[5], a.in[6], a.in[7], a.in[8], a.in[9], (char*)lds_raw, bid, G, tid);
            SEAM(pb + 2);
        }
        if (layer == 0) {
            if (IN(pb + 3)) {
                PH_TID() WSP(bf16_t, abb, WS_AB) WSP(float, oc, WS_OC)
                merge0_phase((const bf16_t*)oc, (const float*)((unsigned char*)oc + (size_t)3 * 8 * SEQ * 128 * 2), abb, bid, G, tid);
                SEAM(pb + 3);
            }
        } else {
        }
        if (IN(pb + 4)) {
            const int K = layer == 0 ? 3072 : 4096;
            PH_TID() WSP(bf16_t, abb, WS_AB) WSP(bf16_t, woab, WS_WOAB) WSP(bf16_t, wocd, WS_WOCD) WSP(bf16_t, ybuf, WS_Y) WSP(bf16_t, xb, WS_XB) WSP(bf16_t, x2b, WS_X2B)
            pg8::Gemm g{abb, layer == 0 ? woab : wocd, SEQ, 4096, K}; pg8::StaticOrder S; S.init(SEQ, 4096, G, bid);
            pg8::EpiBf16R E{ybuf, 4096, layer == 0 ? xb : x2b, ALPHA};
            pg8::gemm_phase<pg8::EpiBf16R, pg8::StaticOrder>(lds, g, S, E, nullptr, tid);
            SEAM(pb + 4);
        }
        if (IN(pb + 5)) {
            PH_TID() WSP(bf16_t, ybuf, WS_Y) WSP(float, stats, WS_X1) WSP(bf16_t, x1b, WS_X1B)
            ln_phase(ybuf, a.in[13] + layer * DM, a.in[14] + layer * DM, stats, x1b, bid, G, tid);
            SEAM(pb + 5);
        }
        if (IN(pb + 6)) {
            PH_TID() WSP(bf16_t, x1b, WS_X1B) WSP(bf16_t, wq, WS_WQ) WSP(bf16_t, pqb, WS_PQ)
            pg8::Gemm g{x1b, wq + (size_t)layer * 2048 * 4096, SEQ, 2048, 4096}; pg8::StaticOrder S; S.init(SEQ, 2048, G, bid);
            pg8::EpiBf16P E{pqb, 2048};
            pg8::gemm_phase<pg8::EpiBf16P, pg8::StaticOrder>(lds, g, S, E, nullptr, tid);
            asm volatile("s_waitcnt vmcnt(0)" ::: "memory"); __syncthreads();
            { WSP(bf16_t, keyb, WS_KEYB) WSP(int, eidx, WS_EIDX) WSP(float, gate, WS_GATE)
              int t4 = tid; asm volatile("" : "+v"(t4));
              route_mfma_phase(pqb, keyb + (size_t)layer * 8 * 2 * 128 * 128, eidx, gate, (char*)lds_raw, S, t4); }
            SEAM(pb + 6);
        }
        if (IN(pb + 8)) {
            PH_TID() WSP(bf16_t, ybuf, WS_Y) WSP(float, stats, WS_X1) WSP(bf16_t, x1b, WS_X1B) WSP(int, eidx, WS_EIDX) WSP(float, gate, WS_GATE) WSP(unsigned char, ub, WS_UB) WSP(unsigned char, vb, WS_VB) WSP(float, isu, WS_SU) WSP(float, isv, WS_SV) WSP(float, x2, WS_X2) WSP(bf16_t, x2b, WS_X2B)
            peer_expert_phase(ybuf, stats, a.in[13] + layer * DM, a.in[14] + layer * DM, x1b, eidx, gate, ub + (size_t)layer * 16384 * ROWB, vb + (size_t)layer * 16384 * ROWB, isu + layer * 16384, isv + layer * 16384, a.in[19] + layer * DM, a.in[20] + layer * DM,
                              layer == 0 ? (float*)nullptr : a.out, layer == 0 ? x2b : (bf16_t*)nullptr, (LDSA float*)lds, bid, G, tid);
            SEAM(pb + 8);
        }
        }
    { constexpr int layer = 1;
        const int pb = 1 + 10 * layer;
        if (IN(pb + 0)) {
            PH_TID() WSP(bf16_t, xb, WS_XB) WSP(bf16_t, x2b, WS_X2B) WSP(bf16_t, wab, WS_WAB) WSP(bf16_t, wcd, WS_WCD) WSP(bf16_t, hb, WS_HB) WSP(float, cs0, WS_CS0) WSP(float, csa, WS_CSA)
            if (layer == 0) {
                pg8::Gemm g{xb, wab, SEQ, 12288, 4096}; pg8::StaticOrder S; S.init(SEQ, 12288, G, bid);
                pg8::EpiProj<0> E{hb, 12288, cs0, csa, nullptr, nullptr, (LDSA float*)(lds + LDS_MISC + 64)};
                pg8::gemm_phase<pg8::EpiProj<0>, pg8::StaticOrder>(lds, g, S, E, nullptr, tid);
            } else {
                pg8::Gemm g{x2b, wcd, SEQ, 9216, 4096}; pg8::StaticOrder S; S.init(SEQ, 9216, G, bid);
                pg8::EpiProj<1> E{hb, 9216, cs0, csa, a.in[10], a.in[11], (LDSA float*)(lds + LDS_MISC + 64)};
                pg8::gemm_phase<pg8::EpiProj<1>, pg8::StaticOrder>(lds, g, S, E, nullptr, tid);
                { const int nu1 = (SEQ / 256) * (9216 / 256), busy = nu1 % G; const bool slack = busy != 0 && busy <= G / 2;
                  if (slack && bid >= busy) {
                      WSP(unsigned char, vb1, WS_VB) WSP(float, isv1, WS_SV)
                      int t5; { int _z = 0; asm volatile("" : "+s"(_z)); t5 = wid_s * 64 + (int)__builtin_amdgcn_mbcnt_hi(~0u, __builtin_amdgcn_mbcnt_lo(~0u, (unsigned)_z)); }
                      table_fp6(a.in[18] + (size_t)16384 * DM, vb1 + (size_t)16384 * ROWB, isv1 + 16384, 16384, (LDSA float*)lds, bid - busy, G - busy, t5); } }
            }
            SEAM(pb + 0);
        }
        if (IN(pb + 2)) {
            PH_TID() WSP(bf16_t, hb, WS_HB) WSP(bf16_t, abb, WS_AB) WSP(float, oc, WS_OC)
            if (layer == 0) attn0_phase(hb, a.in[2], abb, (bf16_t*)oc, (float*)((unsigned char*)oc + (size_t)3 * 8 * SEQ * 128 * 2), (char*)lds_raw, bid, G, tid);
            else attn1_phase(hb, abb, oc, a.in[5], a.in[6], a.in[7], a.in[8], a.in[9], (char*)lds_raw, bid, G, tid);
            SEAM(pb + 2);
        }
        if (layer == 0) {
            if (IN(pb + 3)) {
                PH_TID() WSP(bf16_t, abb, WS_AB) WSP(float, oc, WS_OC)
                merge0_phase((const bf16_t*)oc, (const float*)((unsigned char*)oc + (size_t)3 * 8 * SEQ * 128 * 2), abb, bid, G, tid);
                SEAM(pb + 3);
            }
        } else {
        }
        if (IN(pb + 4)) {
            const int K = layer == 0 ? 3072 : 4096;
            PH_TID() WSP(bf16_t, abb, WS_AB) WSP(bf16_t, woab, WS_WOAB) WSP(bf16_t, wocd, WS_WOCD) WSP(bf16_t, ybuf, WS_Y) WSP(bf16_t, xb, WS_XB) WSP(bf16_t, x2b, WS_X2B)
            pg8::Gemm g{abb, layer == 0 ? woab : wocd, SEQ, 4096, K}; pg8::StaticOrder S; S.init(SEQ, 4096, G, bid);
            pg8::EpiBf16R E{ybuf, 4096, layer == 0 ? xb : x2b, ALPHA};
            pg8::gemm_phase<pg8::EpiBf16R, pg8::StaticOrder>(lds, g, S, E, nullptr, tid);
            SEAM(pb + 4);
        }
        if (IN(pb + 5)) {
            PH_TID() WSP(bf16_t, ybuf, WS_Y) WSP(float, stats, WS_X1) WSP(bf16_t, x1b, WS_X1B)
            ln_phase(ybuf, a.in[13] + layer * DM, a.in[14] + layer * DM, stats, x1b, bid, G, tid);
            SEAM(pb + 5);
        }
        if (IN(pb + 6)) {
            PH_TID() WSP(bf16_t, x1b, WS_X1B) WSP(bf16_t, wq, WS_WQ) WSP(bf16_t, pqb, WS_PQ)
            pg8::Gemm g{x1b, wq + (size_t)layer * 2048 * 4096, SEQ, 2048, 4096}; pg8::StaticOrder S; S.init(SEQ, 2048, G, bid);
            pg8::EpiBf16P E{pqb, 2048};
            pg8::gemm_phase<pg8::EpiBf16P, pg8::StaticOrder>(lds, g, S, E, nullptr, tid);
            asm volatile("s_waitcnt vmcnt(0)" ::: "memory"); __syncthreads();
            { WSP(bf16_t, keyb, WS_KEYB) WSP(int, eidx, WS_EIDX) WSP(float, gate, WS_GATE)
              int t4 = tid; asm volatile("" : "+v"(t4));
              route_mfma_phase(pqb, keyb + (size_t)layer * 8 * 2 * 128 * 128, eidx, gate, (char*)lds_raw, S, t4); }
            SEAM(pb + 6);
        }
        if (IN(pb + 8)) {
            PH_TID() WSP(bf16_t, ybuf, WS_Y) WSP(float, stats, WS_X1) WSP(bf16_t, x1b, WS_X1B) WSP(int, eidx, WS_EIDX) WSP(float, gate, WS_GATE) WSP(unsigned char, ub, WS_UB) WSP(unsigned char, vb, WS_VB) WSP(float, isu, WS_SU) WSP(float, isv, WS_SV) WSP(float, x2, WS_X2) WSP(bf16_t, x2b, WS_X2B)
            peer_expert_phase(ybuf, stats, a.in[13] + layer * DM, a.in[14] + layer * DM, x1b, eidx, gate, ub + (size_t)layer * 16384 * ROWB, vb + (size_t)layer * 16384 * ROWB, isu + layer * 16384, isv + layer * 16384, a.in[19] + layer * DM, a.in[20] + layer * DM,
                              layer == 0 ? (float*)nullptr : a.out, layer == 0 ? x2b : (bf16_t*)nullptr, (LDSA float*)lds, bid, G, tid);
            SEAM(pb + 8);
        }
        }

#undef IN
}
#ifndef ONE_LAUNCH
#define ONE_LAUNCH 1
#endif
extern "C" void kernel_launch(void* const* d_in, const int* in_sizes, int n_in, void* d_out, int out_size, void* d_ws, size_t ws_size, hipStream_t stream) {
    static int ready = 0;
    if (!ready) {
        if (ws_size < WS_END) { fprintf(stderr, "kernel_launch: workspace too small: %zu < %zu\n", ws_size, (size_t)WS_END); return; }
        if (hipFuncSetAttribute((const void*)mega, hipFuncAttributeMaxDynamicSharedMemorySize, LDS_BYTES) != hipSuccess) { fprintf(stderr, "kernel_launch: hipFuncSetAttribute failed\n"); return; }
        int per_cu = 0;
        if (hipOccupancyMaxActiveBlocksPerMultiprocessor(&per_cu, (const void*)mega, 512, LDS_BYTES) != hipSuccess || per_cu < 1) fprintf(stderr, "kernel_launch: note: occupancy query reports %d blocks per CU\n", per_cu);
        (void)hipGetLastError();
        ready = 1;
    }
    unsigned char* ws = (unsigned char*)d_ws;
    (void)hipMemsetAsync(ws + WS_CTL, 0, CTL_BYTES, stream);
    MK a{}; for (int i = 0; i < 21; ++i) a.in[i] = (const float*)d_in[i];
    a.out = (float*)d_out; a.ws = ws;
#if ONE_LAUNCH
    a.ph_lo = 0; a.ph_hi = N_PHASES;
    hipLaunchKernelGGL(mega, dim3(256), dim3(512), LDS_BYTES, stream, a);
#else
    for (int k = 0; k < N_PHASES; ++k) { if (k == 10 || k == 2 || k == 12 || k == 14 || k == 8 || k == 18) continue; a.ph_lo = k; a.ph_hi = k + 1; hipLaunchKernelGGL(mega, dim3(256), dim3(512), LDS_BYTES, stream, a); }
#endif
    const hipError_t le = hipPeekAtLastError();
    if (le != hipSuccess) fprintf(stderr, "kernel_launch: launch failed: %s\n", hipGetErrorName(le));
}
```

```cpp
#include <hip/hip_runtime.h>
#include <stdint.h>
#include <cstdio>

#define SEQ 8192
#define DM 4096
#define HD 128
#define ALPHA 1.4142135623730951f
#define LAMBDA_INIT 0.35550906759096934f
#define ATT_SCALE 0.088388347648318440f

__device__ const double REV_P[16] = {0.15915494309189535, 0.0700865215877985, 0.03086376340470123, 0.013591370636193905, 0.005985185712713705, 0.002635675898667414, 0.001160663641240061, 0.0005111175045375439, 0.00022507907903927653, 9.911730936901935e-05, 4.364795279280289e-05, 1.9221100684944863e-05, 8.464330808241401e-06, 3.727408601915352e-06, 1.6414262627950345e-06, 7.228293068832865e-07};
__device__ const double REV_A[32] = {0.15915494309189535, 0.11934937021124886, 0.08949940160889101, 0.06711508300522726, 0.050329212104487035, 0.03774158471741977, 0.0283021958306234, 0.02122365276477766, 0.015915494309189534, 0.011934937021124886, 0.008949940160889102, 0.006711508300522725, 0.005032921210448704, 0.003774158471741977, 0.00283021958306234, 0.0021223652764777662, 0.0015915494309189536, 0.0011934937021124885, 0.0008949940160889102, 0.0006711508300522726, 0.0005032921210448703, 0.00037741584717419774, 0.00028302195830623395, 0.0002122365276477766, 0.00015915494309189535, 0.00011934937021124886, 8.949940160889102e-05, 6.711508300522725e-05, 5.0329212104487035e-05, 3.774158471741978e-05, 2.8302195830623396e-05, 2.122365276477766e-05};

__device__ __forceinline__ void sincos_rev(double rev, float& s, float& c) {
    const double f = rev - floor(rev); const float ff = (float)f;
    s = __builtin_amdgcn_sinf(ff); c = __builtin_amdgcn_cosf(ff);
}
__device__ __forceinline__ float wave_sum(float v) {
#pragma unroll
    for (int o = 32; o >= 1; o >>= 1) v += __shfl_xor(v, o);
    return v;
}
__device__ __forceinline__ float wave_max(float v) {
#pragma unroll
    for (int o = 32; o >= 1; o >>= 1) v = fmaxf(v, __shfl_xor(v, o));
    return v;
}
namespace pg8 {
#define PG8_LAS __attribute__((address_space(3)))
typedef unsigned short bf16_t;
typedef short bf16x8 __attribute__((ext_vector_type(8)));
typedef float f32x4 __attribute__((ext_vector_type(4)));
typedef unsigned u32x4 __attribute__((ext_vector_type(4)));
constexpr int BM = 256, BK = 64, HALF = 128, HTB = HALF * BK * 2  , STAGE_BYTES = 8 * HTB, NXCD = 8, WGM = 8;

__host__ __device__ __forceinline__ int lds_byte(int r, int c) { const int st = (r >> 4) * 2 + (c >> 5), rr = r & 15, cc = c & 31, ob = rr * 64 + cc * 2; return st * 1024 + (ob ^ (((ob >> 9) & 1) << 5)); }
__host__ __device__ __forceinline__ void stage_rc(int b, int& R, int& C) { const int st = b / 1024, sb = b % 1024, swz = sb ^ (((sb >> 9) & 1) << 5); R = (st >> 1) * 16 + swz / 64; C = (st & 1) * 32 + (swz % 64) / 2; }
__host__ __device__ __forceinline__ int perm32(int rho) { const int n = rho >> 4, i = rho & 15; return 8 * (i >> 2) + 4 * n + (i & 3); }

struct Unit { int pm, pn; };
struct Gemm { const bf16_t* A; const bf16_t* Bt; int M, N, K; };

struct StaticOrder {
    int nM, nN, nwg, G, c;
    __host__ __device__ void init(int M, int N, int G_, int c_) { nM = M / BM; nN = N / BM; nwg = nM * nN; G = G_; c = c_; }
    __host__ __device__ bool next(int i, Unit& u) const {
        const long L = (long)i * G + c; if (L >= nwg) return false;
        int wgid = (int)L; { const int q = nwg / NXCD, r = nwg % NXCD, xcd = wgid % NXCD, off = wgid / NXCD; wgid = (xcd < r ? xcd * (q + 1) : r * (q + 1) + (xcd - r) * q) + off; }
        const int nig = WGM * nN, gid = wgid / nig, fm = gid * WGM, gsz = (nM - fm) < WGM ? (nM - fm) : WGM;
        u.pm = fm + ((wgid % nig) % gsz); u.pn = (wgid % nig) / gsz; return true;
    }
    __device__ __forceinline__ void a_ready(const Unit&) const {}
    __device__ __forceinline__ void done(const Unit&) const {}
};
__device__ __forceinline__ unsigned cvt_pk_bf16(float lo, float hi) { unsigned r; asm volatile("v_cvt_pk_bf16_f32 %0, %1, %2" : "=v"(r) : "v"(lo), "v"(hi)); return r; }
typedef float f32x2 __attribute__((ext_vector_type(2)));
template <class Epi, class Sched, bool STAMP = false>
__device__ __forceinline__ void gemm_phase(PG8_LAS unsigned char* lds, const Gemm g, const Sched& S, const Epi& E, unsigned long long* stamps, const int tid_in) {
    const int tid = tid_in, wid = __builtin_amdgcn_readfirstlane(tid >> 6), lane = tid & 63, wr = wid >> 2, wc = wid & 3, fr = lane & 15, fq = lane >> 4;
    const int K = g.K, nt = K / BK;
    int ts_lo = 0, ts_hi = 0, nts = 0; const unsigned long long rt_entry = STAMP ? (unsigned long long)wall_clock64() : 0ull;
#define PG8_STAMP() do { if (STAMP && wid == 0 && nts < 64) { const unsigned long long _c = (unsigned long long)clock64(); \
        ts_lo = (lane == nts) ? (int)(unsigned)_c : ts_lo; ts_hi = (lane == nts) ? (int)(unsigned)(_c >> 32) : ts_hi; ++nts; } } while (0)
    PG8_STAMP();
    unsigned voffA[2], voffB[2];
#pragma unroll
    for (int i = 0; i < 2; ++i) { int R, C; stage_rc(tid * 16 + i * 8192, R, C); const int Rb = Epi::PERM ? ((R & ~31) + perm32(R & 31)) : R;
        voffA[i] = (unsigned)(R * K + C) * 2u; voffB[i] = (unsigned)(Rb * K + C) * 2u; }
    const size_t kstep = (size_t)(BK * 2);
    const size_t hstep = (size_t)HALF * K * 2;
    const size_t tstep = 2 * hstep;
    const unsigned ldsw = (unsigned)wid * 1024u;
    const int aoff = lds_byte(wr * 64 + fr, fq * 8), boff = lds_byte(wc * 32 + fr, fq * 8);
#define PG8_SA(b, h) (((b) * 2 + (h)) * HTB)
#define PG8_SB(b, h) ((4 + (b) * 2 + (h)) * HTB)
#define PG8_STAGE(bufoff, gbase, voff) do { _Pragma("unroll") for (int _i = 0; _i < 2; ++_i) \
        __builtin_amdgcn_global_load_lds((const unsigned*)((const char*)(gbase) + (voff)[_i]), (PG8_LAS unsigned*)(lds + (bufoff) + ldsw + _i * 8192), 16, 0, 0); } while (0)
#define PG8_LDA(dst, b, h) do { _Pragma("unroll") for (int m = 0; m < 4; ++m) _Pragma("unroll") for (int k = 0; k < 2; ++k) dst[m][k] = *(const PG8_LAS bf16x8*)(lds + PG8_SA(b, h) + aoff + m * 2048 + k * 1024); } while (0)
#define PG8_LDB(dst, b, h) do { _Pragma("unroll") for (int n = 0; n < 2; ++n) _Pragma("unroll") for (int k = 0; k < 2; ++k) dst[n][k] = *(const PG8_LAS bf16x8*)(lds + PG8_SB(b, h) + boff + n * 2048 + k * 1024); } while (0)
#define PG8_MMA(ai, bj, At, Bt) do { __builtin_amdgcn_s_setprio(1); _Pragma("unroll") for (int m = 0; m < 4; ++m) _Pragma("unroll") for (int n = 0; n < 2; ++n) _Pragma("unroll") for (int k = 0; k < 2; ++k) \
        acc[ai][bj][m][n] = __builtin_amdgcn_mfma_f32_16x16x32_bf16(Bt[n][k], At[m][k], acc[ai][bj][m][n], 0, 0, 0); __builtin_amdgcn_s_setprio(0); } while (0)
#define PG8_WAIT_V(n) asm volatile("s_waitcnt vmcnt(" #n ")" ::: "memory")
#define PG8_WAIT_L(n) asm volatile("s_waitcnt lgkmcnt(" #n ")" ::: "memory")
#define PG8_BAR __builtin_amdgcn_s_barrier()
#define PG8_SCHED __builtin_amdgcn_sched_barrier(0)
    Unit cur, nxt; int ui = 0;
    if (!S.next(0, cur)) return;
    f32x4 acc[2][2][4][2];
#pragma unroll
    for (int a = 0; a < 2; ++a)
#pragma unroll
        for (int b = 0; b < 2; ++b)
#pragma unroll
            for (int m = 0; m < 4; ++m)
#pragma unroll
                for (int n = 0; n < 2; ++n) acc[a][b][m][n] = (f32x4){0.f, 0.f, 0.f, 0.f};
    bf16x8 At[4][2], B0[2][2], B1[2][2];
    const char* cA = (const char*)g.A + (size_t)cur.pm * tstep; const char* cB = (const char*)g.Bt + (size_t)cur.pn * tstep;
    S.a_ready(cur);
    PG8_STAGE(PG8_SB(0, 0), cB, voffB); PG8_STAGE(PG8_SA(0, 0), cA, voffA); PG8_STAGE(PG8_SB(0, 1), cB + hstep, voffB); PG8_STAGE(PG8_SA(0, 1), cA + hstep, voffA);
    if (wr == 1) PG8_BAR;
    PG8_WAIT_V(4); PG8_BAR;
    PG8_STAGE(PG8_SB(1, 0), cB + kstep, voffB); PG8_STAGE(PG8_SA(1, 0), cA + kstep, voffA); PG8_STAGE(PG8_SB(1, 1), cB + hstep + kstep, voffB);
    PG8_WAIT_V(6); PG8_BAR;
    PG8_STAMP();
    for (;;) {
        const bool has_next = S.next(ui + 1, nxt);
        const char* nA = has_next ? (const char*)g.A + (size_t)nxt.pm * tstep : cA; const char* nB = has_next ? (const char*)g.Bt + (size_t)nxt.pn * tstep : cB;
        for (int t = 0; t < nt; t += 2) {
            const bool last = (t == nt - 2);
            const char* a1 = cA + (size_t)(t + 1) * kstep;
            const char* a2 = last ? nA : cA + (size_t)(t + 2) * kstep; const char* b2 = last ? nB : cB + (size_t)(t + 2) * kstep;
            const char* a3 = a2 + kstep; const char* b3 = b2 + kstep;
            if (last && has_next) S.a_ready(nxt);
            PG8_LDB(B0, 0, 0); PG8_SCHED; PG8_LDA(At, 0, 0); PG8_STAGE(PG8_SA(1, 1), a1 + hstep, voffA);
            PG8_WAIT_L(8); PG8_BAR; PG8_WAIT_L(0); PG8_MMA(0, 0, At, B0); PG8_BAR; PG8_SCHED;
            PG8_LDB(B1, 0, 1); PG8_STAGE(PG8_SB(0, 0), b2, voffB);
            PG8_BAR; PG8_WAIT_L(0); PG8_MMA(0, 1, At, B1); PG8_BAR;
            PG8_LDA(At, 0, 1); PG8_STAGE(PG8_SA(0, 0), a2, voffA);
            PG8_BAR; PG8_WAIT_L(0); PG8_MMA(1, 0, At, B0); PG8_BAR; PG8_SCHED;
            PG8_STAGE(PG8_SB(0, 1), b2 + hstep, voffB);
            PG8_WAIT_V(6); PG8_BAR; PG8_MMA(1, 1, At, B1); PG8_BAR;
            PG8_LDB(B0, 1, 0); PG8_SCHED; PG8_LDA(At, 1, 0); PG8_STAGE(PG8_SA(0, 1), a2 + hstep, voffA);
            PG8_WAIT_L(8); PG8_BAR; PG8_WAIT_L(0); PG8_MMA(0, 0, At, B0); PG8_BAR; PG8_SCHED;
            PG8_LDB(B1, 1, 1); PG8_STAGE(PG8_SB(1, 0), b3, voffB);
            PG8_BAR; PG8_WAIT_L(0); PG8_MMA(0, 1, At, B1); PG8_BAR;
            PG8_LDA(At, 1, 1); PG8_STAGE(PG8_SA(1, 0), a3, voffA);
            PG8_BAR; PG8_WAIT_L(0); PG8_MMA(1, 0, At, B0); PG8_BAR; PG8_SCHED;
            PG8_STAGE(PG8_SB(1, 1), b3 + hstep, voffB);
            PG8_WAIT_V(6); PG8_BAR; PG8_MMA(1, 1, At, B1); PG8_BAR;
        }
        PG8_STAMP();
        if constexpr (!Epi::AFTER_DRAIN) { E(acc, cur, wr, wc, fr, fq); S.done(cur); }
        PG8_STAMP();
        if (!has_next) break;
#pragma unroll
        for (int a = 0; a < 2; ++a)
#pragma unroll
            for (int b = 0; b < 2; ++b)
#pragma unroll
                for (int m = 0; m < 4; ++m)
#pragma unroll
                    for (int n = 0; n < 2; ++n) acc[a][b][m][n] = (f32x4){0.f, 0.f, 0.f, 0.f};
        cur = nxt; cA = nA; cB = nB; ++ui;
    }
    PG8_WAIT_V(0);
    if (wr == 0) PG8_BAR;
    PG8_BAR;
    if constexpr (Epi::AFTER_DRAIN) { E.fused(acc, cur, wr, wc, fr, fq, lds, wid, lane); S.done(cur); }
    PG8_STAMP();
    if (STAMP && wid == 0) { stamps[lane] = lane < nts ? (((unsigned long long)(unsigned)ts_hi << 32) | (unsigned)ts_lo) : 0ull;
        if (lane == 62) stamps[62] = rt_entry; if (lane == 63) stamps[63] = (unsigned long long)wall_clock64(); }
#undef PG8_STAMP
#undef PG8_SA
#undef PG8_SB
#undef PG8_STAGE
#undef PG8_LDA
#undef PG8_LDB
#undef PG8_MMA
#undef PG8_WAIT_V
#undef PG8_WAIT_L
#undef PG8_BAR
#undef PG8_SCHED
}
}
#define XB_TMO      128
#define XB_XCNT(j)  (256  + 64 * (j))
#define XB_XSUB(j)  (1280 + 64 * (j))
#define XB_XGEN(j)  (2304 + 64 * (j))
#define XB_TOP      3328
#define XB_TOPGEN   3392
#define XCD_BAR_WORDS 3456
#define XB_SPIN_CAP (1u << 22)
#define LAS __attribute__((address_space(3)))

__device__ __forceinline__ unsigned xb_ld(unsigned* p)              { return __hip_atomic_load(p, __ATOMIC_RELAXED, __HIP_MEMORY_SCOPE_AGENT); }
__device__ __forceinline__ unsigned xb_add(unsigned* p, unsigned v) { return __hip_atomic_fetch_add(p, v, __ATOMIC_RELAXED, __HIP_MEMORY_SCOPE_AGENT); }
__device__ __forceinline__ unsigned xb_xcc_id() { return (unsigned)__builtin_amdgcn_s_getreg((3 << 11) | 20) & 0xFu; }
#define XB_SPIN(cond, bar) do { unsigned _sp = 0; while (cond) { __builtin_amdgcn_s_sleep(1); \
    if ((++_sp & 255u) == 0u) { if (xb_ld(&(bar)[XB_TMO])) break; if (_sp > XB_SPIN_CAP) { atomicAdd(&(bar)[XB_TMO], 1u); break; } } } } while (0)

struct XcdBarrier {
    unsigned* bar; unsigned x;
    volatile LAS unsigned* st;
};

__device__ __forceinline__ XcdBarrier xcd_barrier_post(unsigned* bar, volatile LAS unsigned* st, const int tid) {
    XcdBarrier b; b.bar = bar; b.x = xb_xcc_id(); b.st = st;
    if (tid == 0) (void)xb_add(&bar[XB_XCNT(b.x)], 1u);
    return b;
}
__device__ __forceinline__ void xcd_barrier_complete(unsigned* bar, unsigned x, unsigned& nloc, unsigned& nx) {
    const unsigned G = gridDim.x * gridDim.y * gridDim.z;
    unsigned sum, cnt, mine, sp = 0u;
    for (;;) {
        sum = 0u; cnt = 0u; mine = 0u;
#pragma unroll
        for (unsigned j = 0; j < 16; ++j) { const unsigned c = xb_ld(&bar[XB_XCNT(j)]); sum += c; cnt += (c > 0u) ? 1u : 0u; mine = (j == x) ? c : mine; }
        if (sum == G) break;
        __builtin_amdgcn_s_sleep(1);
        if ((++sp & 255u) == 0u) { if (xb_ld(&bar[XB_TMO])) break; if (sp > XB_SPIN_CAP) { atomicAdd(&bar[XB_TMO], 1u); break; } }
    }
    nloc = mine > 0u ? mine : 1u; nx = cnt > 0u ? cnt : 1u;
}

__device__ __forceinline__ void xcd_barrier(const XcdBarrier& b, const int tid) {
    asm volatile("s_waitcnt vmcnt(0)" ::: "memory");
    __syncthreads();
    if (tid == 0) {
        unsigned* bar = b.bar;
        __builtin_amdgcn_s_waitcnt(0);
        unsigned nloc = b.st[0], nx = b.st[1];
        if (nloc == 0u) { xcd_barrier_complete(bar, b.x, nloc, nx); b.st[0] = nloc; b.st[1] = nx; }
        const unsigned old = xb_add(&bar[XB_XSUB(b.x)], 1u);
        const unsigned gen = old / nloc;
        if (old + 1u == (gen + 1u) * nloc) {
            __builtin_amdgcn_fence(__ATOMIC_RELEASE, "agent");
            asm volatile("s_waitcnt vmcnt(0)" ::: "memory");
            const unsigned og = xb_add(&bar[XB_TOP], 1u);
            const unsigned tg = og / nx;
            if (og + 1u == (tg + 1u) * nx) xb_add(&bar[XB_TOPGEN], 1u);
            else XB_SPIN(xb_ld(&bar[XB_TOPGEN]) == tg, bar);
            __builtin_amdgcn_fence(__ATOMIC_ACQUIRE, "agent");
            xb_add(&bar[XB_XGEN(b.x)], 1u);
            asm volatile("s_waitcnt vmcnt(0)" ::: "memory");
        } else {
            XB_SPIN(xb_ld(&bar[XB_XGEN(b.x)]) == gen, bar);
            __builtin_amdgcn_fence(__ATOMIC_ACQUIRE, "agent");
            asm volatile("s_waitcnt vmcnt(0)" ::: "memory");
        }
    }
    __syncthreads();
}
namespace att {
using bf16 = unsigned short;
constexpr int   D = 128, NW = 8, QBLK = 32, KVBLK = 64;
constexpr float SCALE = 0.088388347648318440f;
constexpr float THR = 8.f;
constexpr int SDEPTH = 1;
constexpr size_t SHM_V = KVBLK * D * 2, SHM_K = KVBLK * D * 2, SHM_ATTN = 2 * SHM_V + 2 * SHM_K + NW * 64 * 4;
using bf16x8 = __attribute__((ext_vector_type(8))) short;
using s16x4  = __attribute__((ext_vector_type(4))) short;
using f32x16 = __attribute__((ext_vector_type(16))) float;
using f32x8  = __attribute__((ext_vector_type(8))) float;
using u32x4  = __attribute__((ext_vector_type(4))) unsigned;
#define KSWZ(row, colB) ((row) * 256 + ((colB) ^ (((row) & 7) << 4)))
#define SBAR() __builtin_amdgcn_sched_barrier(0)
__device__ __forceinline__ int crow(int r, int hi) { return (r & 3) + 8 * (r >> 2) + 4 * hi; }
__device__ __forceinline__ unsigned cvtpk(float lo, float hi) {
  unsigned r; asm volatile("v_cvt_pk_bf16_f32 %0, %1, %2" : "=v"(r) : "v"(lo), "v"(hi)); return r;
}
template <typename TIn> struct Stage;
template <> struct Stage<bf16>  { using T = bf16x8;
  __device__ static __forceinline__ T ld8(const bf16* p) { return *reinterpret_cast<const bf16x8*>(p); }
  __device__ static __forceinline__ bf16x8 tobf(T x) { return x; } };
template <> struct Stage<float> { using T = f32x8;
  __device__ static __forceinline__ T ld8(const float* p) { return *reinterpret_cast<const f32x8*>(p); }
  __device__ static __forceinline__ bf16x8 tobf(T x) {
    u32x4 w = {cvtpk(x[0], x[1]), cvtpk(x[2], x[3]), cvtpk(x[4], x[5]), cvtpk(x[6], x[7])}; return *reinterpret_cast<bf16x8*>(&w); } };

__device__ __forceinline__ void partialSM(f32x16& p0, f32x16& p1, float& m_reg, float& mn, float& alpha) {
  constexpr float C = SCALE * 1.4426950408889634f;
  float pmax = p0[0]; for (int r = 1; r < 16; ++r) pmax = fmaxf(pmax, p0[r]); for (int r = 0; r < 16; ++r) pmax = fmaxf(pmax, p1[r]);
  { auto rr = __builtin_amdgcn_permlane32_swap(__float_as_uint(pmax), __float_as_uint(pmax), false, false);
    pmax = fmaxf(__uint_as_float(rr[0]), __uint_as_float(rr[1])); }
  if (__builtin_expect(__all(pmax - m_reg <= THR / SCALE), 1)) { mn = m_reg; alpha = 1.f; }
  else { mn = fmaxf(m_reg, pmax); alpha = __builtin_amdgcn_exp2f((m_reg - mn) * C); m_reg = mn; }
  float mnC = -mn * C;
  for (int r = 0; r < 16; ++r) p0[r] = fmaf(p0[r], C, mnC); for (int r = 0; r < 16; ++r) p1[r] = fmaf(p1[r], C, mnC);
  for (int r = 0; r < 16; ++r) p0[r] = __builtin_amdgcn_exp2f(p0[r]);
}
__device__ __forceinline__ void finishSM(f32x16& p0, f32x16& p1, float alpha, float& l_reg, bf16x8& pa0, bf16x8& pa1, bf16x8& pa2, bf16x8& pa3) {
  for (int r = 0; r < 16; ++r) p1[r] = __builtin_amdgcn_exp2f(p1[r]);
  float ps = 0; for (int r = 0; r < 16; ++r) ps += p0[r]; for (int r = 0; r < 16; ++r) ps += p1[r];
  { auto rr = __builtin_amdgcn_permlane32_swap(__float_as_uint(ps), __float_as_uint(ps), false, false);
    ps = __uint_as_float(rr[0]) + __uint_as_float(rr[1]); }
  l_reg = l_reg * alpha + ps;
#define PK4(P, BASE, OUT) do { unsigned a0 = cvtpk(P[BASE + 0], P[BASE + 1]), a1 = cvtpk(P[BASE + 2], P[BASE + 3]);   \
    unsigned b0 = cvtpk(P[BASE + 4], P[BASE + 5]), b1 = cvtpk(P[BASE + 6], P[BASE + 7]);                              \
    auto r0 = __builtin_amdgcn_permlane32_swap(a0, b0, false, false); auto r1 = __builtin_amdgcn_permlane32_swap(a1, b1, false, false); \
    u32x4 w = {r0[0], r1[0], r0[1], r1[1]}; OUT = *reinterpret_cast<bf16x8*>(&w); } while (0)
  PK4(p0, 0, pa0); PK4(p0, 8, pa1); PK4(p1, 0, pa2); PK4(p1, 8, pa3);
#undef PK4
}
__device__ __forceinline__ void qkt(f32x16& p0, f32x16& p1, const bf16* Ks, const bf16x8* qr, int r32, int hi) {
  p0 = f32x16{}; p1 = f32x16{};
  bf16x8 c0 = *reinterpret_cast<const bf16x8*>((const char*)Ks + KSWZ(r32, (hi * 8) * 2)), c1 = *reinterpret_cast<const bf16x8*>((const char*)Ks + KSWZ(32 + r32, (hi * 8) * 2));
#pragma unroll
  for (int d0 = 0; d0 < 8; ++d0) {
    bf16x8 n0 = c0, n1 = c1;
    if (d0 < 7) { const int cb = ((d0 + 1) * 16 + hi * 8) * 2;
      n0 = *reinterpret_cast<const bf16x8*>((const char*)Ks + KSWZ(r32, cb)); n1 = *reinterpret_cast<const bf16x8*>((const char*)Ks + KSWZ(32 + r32, cb)); }
    p0 = __builtin_amdgcn_mfma_f32_32x32x16_bf16(c0, qr[d0], p0, 0, 0, 0);
    p1 = __builtin_amdgcn_mfma_f32_32x32x16_bf16(c1, qr[d0], p1, 0, 0, 0);
    c0 = n0; c1 = n1; }
}
template <int OFF> __device__ __forceinline__ bf16x8 k_read(const int addr) {
  bf16x8 r; asm volatile("ds_read_b128 %0, %1 offset:%2" : "=&v"(r) : "v"(addr), "i"(OFF) : "memory"); return r;
}
template <int D0> __device__ __forceinline__ void qkt_step(f32x16& p0, f32x16& p1, const int (&a)[4], const bf16x8* qr, bf16x8 c0, bf16x8 c1) {
  bf16x8 n0 = c0, n1 = c1;
  if constexpr (D0 < 7) { n0 = k_read<((D0 + 1) >> 2) * 128>(a[(D0 + 1) & 3]); n1 = k_read<((D0 + 1) >> 2) * 128 + 8192>(a[(D0 + 1) & 3]); asm volatile("s_waitcnt lgkmcnt(2)" ::: "memory"); }
  else asm volatile("s_waitcnt lgkmcnt(0)" ::: "memory");
  SBAR();
  p0 = __builtin_amdgcn_mfma_f32_32x32x16_bf16(c0, qr[D0], p0, 0, 0, 0);
  p1 = __builtin_amdgcn_mfma_f32_32x32x16_bf16(c1, qr[D0], p1, 0, 0, 0);
  if constexpr (D0 < 7) qkt_step<D0 + 1>(p0, p1, a, qr, n0, n1);
}
__device__ __forceinline__ void qkt_pipe(f32x16& p0, f32x16& p1, const int ka, const bf16x8* qr, const int r32, const int hi) {
  p0 = f32x16{}; p1 = f32x16{};
  int a[4];
#pragma unroll
  for (int q = 0; q < 4; ++q) a[q] = ka + r32 * 256 + ((q * 32 + hi * 16) ^ ((r32 & 7) << 4));
  const bf16x8 c0 = k_read<0>(a[0]), c1 = k_read<8192>(a[0]);
  qkt_step<0>(p0, p1, a, qr, c0, c1);
}
__device__ __forceinline__ int v_st(int k, int c) { const int kk = (k & ~0xC) | ((k & 4) << 1) | ((k & 8) >> 1); return ((kk >> 3) * 4 + (c >> 5)) * 512 + ((kk & 7) * 32 + (c & 31)) * 2; }
__device__ __forceinline__ int v_rd_base(int lane) { return ((lane & 3) << 3) | (((lane >> 2) & 3) << 6) | (((lane >> 4) & 1) << 5) | (((lane >> 5) & 1) << 8); }
constexpr int v_rd_off(int d0, int ks, int half) { return d0 * 512 + ks * 4096 + half * 2048; }
template <int OFF> __device__ __forceinline__ s16x4 tr_read(int vb) {
  s16x4 r; asm volatile("ds_read_b64_tr_b16 %0, %1 offset:%2" : "=&v"(r) : "v"(vb), "i"(OFF) : "memory"); return r;
}
template <int D0> __device__ __forceinline__ void pv_one(f32x16& od, int vb, bf16x8 pa0, bf16x8 pa1, bf16x8 pa2, bf16x8 pa3) {
  const s16x4 l0 = tr_read<v_rd_off(D0, 0, 0)>(vb), h0 = tr_read<v_rd_off(D0, 0, 1)>(vb), l1 = tr_read<v_rd_off(D0, 1, 0)>(vb), h1 = tr_read<v_rd_off(D0, 1, 1)>(vb);
  const s16x4 l2 = tr_read<v_rd_off(D0, 2, 0)>(vb), h2 = tr_read<v_rd_off(D0, 2, 1)>(vb), l3 = tr_read<v_rd_off(D0, 3, 0)>(vb), h3 = tr_read<v_rd_off(D0, 3, 1)>(vb);
  asm volatile("s_waitcnt lgkmcnt(0)" ::: "memory"); SBAR();
#define PK(L, H) (bf16x8){L[0], L[1], L[2], L[3], H[0], H[1], H[2], H[3]}
  od = __builtin_amdgcn_mfma_f32_32x32x16_bf16(pa0, PK(l0, h0), od, 0, 0, 0);
  od = __builtin_amdgcn_mfma_f32_32x32x16_bf16(pa1, PK(l1, h1), od, 0, 0, 0);
  od = __builtin_amdgcn_mfma_f32_32x32x16_bf16(pa2, PK(l2, h2), od, 0, 0, 0);
  od = __builtin_amdgcn_mfma_f32_32x32x16_bf16(pa3, PK(l3, h3), od, 0, 0, 0);
#undef PK
}
__device__ __forceinline__ void pv_d0(f32x16* o, int vb, bf16x8 pa0, bf16x8 pa1, bf16x8 pa2, bf16x8 pa3) {
  pv_one<0>(o[0], vb, pa0, pa1, pa2, pa3); pv_one<1>(o[1], vb, pa0, pa1, pa2, pa3); pv_one<2>(o[2], vb, pa0, pa1, pa2, pa3); pv_one<3>(o[3], vb, pa0, pa1, pa2, pa3);
}

template <int B> __device__ __forceinline__ void pv_rd8(s16x4 (&f)[8], const int vb) {
  constexpr int D0 = B & 3, HB = (B >> 2) * 16384;
  f[0] = tr_read<HB + v_rd_off(D0, 0, 0)>(vb); f[1] = tr_read<HB + v_rd_off(D0, 0, 1)>(vb); f[2] = tr_read<HB + v_rd_off(D0, 1, 0)>(vb); f[3] = tr_read<HB + v_rd_off(D0, 1, 1)>(vb);
  f[4] = tr_read<HB + v_rd_off(D0, 2, 0)>(vb); f[5] = tr_read<HB + v_rd_off(D0, 2, 1)>(vb); f[6] = tr_read<HB + v_rd_off(D0, 3, 0)>(vb); f[7] = tr_read<HB + v_rd_off(D0, 3, 1)>(vb);
}
__device__ __forceinline__ void pv_mma4(f32x16& od, const s16x4 (&f)[8], bf16x8 pa0, bf16x8 pa1, bf16x8 pa2, bf16x8 pa3) {
#define PK(L, H) (bf16x8){L[0], L[1], L[2], L[3], H[0], H[1], H[2], H[3]}
  od = __builtin_amdgcn_mfma_f32_32x32x16_bf16(pa0, PK(f[0], f[1]), od, 0, 0, 0);
  od = __builtin_amdgcn_mfma_f32_32x32x16_bf16(pa1, PK(f[2], f[3]), od, 0, 0, 0);
  od = __builtin_amdgcn_mfma_f32_32x32x16_bf16(pa2, PK(f[4], f[5]), od, 0, 0, 0);
  od = __builtin_amdgcn_mfma_f32_32x32x16_bf16(pa3, PK(f[6], f[7]), od, 0, 0, 0);
#undef PK
}
template <int B, int NB> __device__ __forceinline__ void pv_pipe_step(f32x16* o, s16x4 (&cur)[8], s16x4 (&nxt)[8], const int vb, bf16x8 pa0, bf16x8 pa1, bf16x8 pa2, bf16x8 pa3) {
  if constexpr (B + 1 < NB) { pv_rd8<B + 1>(nxt, vb); asm volatile("s_waitcnt lgkmcnt(8)" ::: "memory"); }
  else asm volatile("s_waitcnt lgkmcnt(0)" ::: "memory");
  SBAR();
  pv_mma4(o[B], cur, pa0, pa1, pa2, pa3);
  if constexpr (B + 1 < NB) pv_pipe_step<B + 1, NB>(o, nxt, cur, vb, pa0, pa1, pa2, pa3);
}
template <int NB> __device__ __forceinline__ void pv_pipe(f32x16* o, const int vb, bf16x8 pa0, bf16x8 pa1, bf16x8 pa2, bf16x8 pa3) {
  s16x4 fa[8], fb[8];
  pv_rd8<0>(fa, vb);
  pv_pipe_step<0, NB>(o, fa, fb, vb, pa0, pa1, pa2, pa3);
}

template <typename TQ, int LDQ, int LDK, int LDO, typename TO>
__device__ __forceinline__ void attn_dense_body(const TQ* __restrict__ Qb, const bf16* __restrict__ Kh, const bf16* __restrict__ Vh,
                                                TO* __restrict__ Ob, int seq, char* lds, const int tid_in) {
  using St = Stage<bf16>; using SQ = Stage<TQ>;
  const int tid = tid_in, wid = tid >> 6, lane = tid & 63, r32 = lane & 31, hi = lane >> 5;
  bf16* V_lds = (bf16*)lds; bf16* K_lds = (bf16*)(lds + 2 * SHM_V);
  float* ws = (float*)(lds + 2 * SHM_V + 2 * SHM_K) + wid * 64; float* li_l = ws; float* al_l = ws + 32;
  float m_reg = -1e30f, l_reg = 0; f32x16 o[4] = {}; bf16x8 qr[8];
  const TQ* Qw = Qb + ((wid * QBLK + r32) * LDQ + hi * 8);
#pragma unroll
  for (int d0 = 0; d0 < 8; ++d0) qr[d0] = SQ::tobf(SQ::ld8(Qw + d0 * 16));
  const int sr = tid >> 4, sc = (tid & 15) * 8, vst0 = v_st(sr, sc), vst1 = v_st(32 + sr, sc);
  const int vb0 = (int)(uintptr_t)V_lds + v_rd_base(lane);
  struct { typename St::T vs0, vs1, ks0, ks1; } sr_[SDEPTH];
#define SLOAD(i, k0) do { sr_[i].vs0 = St::ld8(Vh + (((k0) + sr) * LDK + sc)); sr_[i].vs1 = St::ld8(Vh + (((k0) + 32 + sr) * LDK + sc)); \
    sr_[i].ks0 = St::ld8(Kh + (((k0) + sr) * LDK + sc)); sr_[i].ks1 = St::ld8(Kh + (((k0) + 32 + sr) * LDK + sc)); } while (0)
#define SWRITE(b, i) do { *(bf16x8*)((char*)V_lds + (b) * SHM_V + vst0) = St::tobf(sr_[i].vs0);          \
    *(bf16x8*)((char*)V_lds + (b) * SHM_V + vst1) = St::tobf(sr_[i].vs1); int kc = sc * 2;               \
    *(bf16x8*)((char*)K_lds + (b) * SHM_K + KSWZ(sr, kc)) = St::tobf(sr_[i].ks0);                       \
    *(bf16x8*)((char*)K_lds + (b) * SHM_K + KSWZ(32 + sr, kc)) = St::tobf(sr_[i].ks1); } while (0)
#define SWAIT() do { if constexpr (SDEPTH == 2) asm volatile("s_waitcnt vmcnt(4)" ::: "memory"); else asm volatile("s_waitcnt vmcnt(0)" ::: "memory"); } while (0)
#define RESC(a) do { if (__any((a) < 1.f)) { if (hi == 0) al_l[r32] = (a); asm volatile("s_waitcnt lgkmcnt(0)" ::: "memory"); \
    for (int d = 0; d < 4; ++d) for (int r = 0; r < 16; ++r) o[d][r] *= al_l[crow(r, hi)]; } } while (0)
  f32x16 pA0, pA1, pB0, pB1; float mnA, mnB, alA, alB; bf16x8 pa0, pa1, pa2, pa3; const int NT = seq / KVBLK;
  constexpr int SE = 0, SO = SDEPTH - 1;
  SLOAD(SE, 0); asm volatile("s_waitcnt vmcnt(0)" ::: "memory"); SWRITE(0, SE); __syncthreads();
  qkt(pA0, pA1, K_lds, qr, r32, hi); partialSM(pA0, pA1, m_reg, mnA, alA);
  SLOAD(SO, KVBLK); if constexpr (SDEPTH == 2) { if (2 < NT) SLOAD(SE, 2 * KVBLK); }
  SWAIT(); SWRITE(1, SO); __syncthreads();
  for (int j = 1; j + 1 < NT; j += 2) {
    SBAR(); qkt(pB0, pB1, (bf16*)((char*)K_lds + SHM_K), qr, r32, hi);
    finishSM(pA0, pA1, alA, l_reg, pa0, pa1, pa2, pa3); SBAR();
    SLOAD(SO, (j + SDEPTH) * KVBLK); SBAR();
    pv_d0(o, vb0, pa0, pa1, pa2, pa3); partialSM(pB0, pB1, m_reg, mnB, alB);
    __syncthreads(); SWAIT(); SWRITE(0, SE);
    RESC(alB); __syncthreads();
    SBAR(); qkt(pA0, pA1, K_lds, qr, r32, hi);
    finishSM(pB0, pB1, alB, l_reg, pa0, pa1, pa2, pa3); SBAR();
    if (SDEPTH == 1 || j + 3 < NT) SLOAD(SE, (j + 1 + SDEPTH) * KVBLK); SBAR();
    pv_d0(o, vb0 + (int)SHM_V, pa0, pa1, pa2, pa3); partialSM(pA0, pA1, m_reg, mnA, alA);
    __syncthreads(); SWAIT(); SWRITE(1, SO);
    RESC(alA); __syncthreads();
  }
  SBAR(); qkt(pB0, pB1, (bf16*)((char*)K_lds + SHM_K), qr, r32, hi);
  finishSM(pA0, pA1, alA, l_reg, pa0, pa1, pa2, pa3); SBAR();
  pv_d0(o, vb0, pa0, pa1, pa2, pa3); partialSM(pB0, pB1, m_reg, mnB, alB);
  __syncthreads(); RESC(alB);
  finishSM(pB0, pB1, alB, l_reg, pa0, pa1, pa2, pa3); SBAR();
  pv_d0(o, vb0 + (int)SHM_V, pa0, pa1, pa2, pa3);
  if (hi == 0) li_l[r32] = l_reg; asm volatile("s_waitcnt lgkmcnt(0)" ::: "memory");
  float rli[16];
#pragma unroll
  for (int r = 0; r < 16; ++r) rli[r] = __builtin_amdgcn_rcpf(li_l[crow(r, hi)]);
  TO* Ow = Ob + (wid * QBLK) * LDO;
#pragma unroll
  for (int r = 0; r < 16; ++r) { int orow = crow(r, hi);
    for (int d0 = 0; d0 < 4; ++d0) { const float val = o[d0][r] * rli[r];
      if constexpr (sizeof(TO) == 4) Ow[orow * LDO + d0 * 32 + r32] = val;
      else Ow[orow * LDO + d0 * 32 + r32] = (TO)(cvtpk(val, val) & 0xffffu); } }
#undef SLOAD
#undef SWRITE
#undef SWAIT
#undef RESC
}

template <int WIN>
__device__ __forceinline__ void attn_banded_body(const bf16* __restrict__ Qp, const bf16* __restrict__ Kp, const bf16* __restrict__ Vp, const long rs, const int Lseq, const int P0,
                                                 const float m_init, const float l_init, bf16* __restrict__ Ob, const long os, float* __restrict__ Lp, const long ls, char* lds, const int tid) {
  const int wid = __builtin_amdgcn_readfirstlane(tid >> 6), lane = tid & 63, r32 = lane & 31, hi = lane >> 5;
  constexpr int BT = 32768;
  float* wsf = (float*)(lds + 2 * BT) + wid * 64; float* li_l = wsf; float* al_l = wsf + 32;
  float m_reg = m_init, l_reg = l_init; f32x16 o[4] = {}; bf16x8 qr[8];
  const bf16* Qw = Qp + (long)(P0 + wid * QBLK + r32) * rs + hi * 8;
#pragma unroll
  for (int d0 = 0; d0 < 8; ++d0) qr[d0] = *reinterpret_cast<const bf16x8*>(Qw + d0 * 16);
  const int irs = (int)rs;
  int ksrc[2], vsrc[2];
#pragma unroll
  for (int i = 0; i < 2; ++i) { const int c = 2 * wid + i, row = 4 * c + (lane >> 4), colB = (16 * (lane & 15)) ^ ((row & 7) << 4); ksrc[i] = row * irs + (colB >> 1);
      const int sub = 2 * c + (lane >> 5), kk = ((sub >> 2) << 3) | ((lane & 31) >> 2), k = (kk & ~0xC) | ((kk & 4) << 1) | ((kk & 8) >> 1), col = (sub & 3) * 32 + 8 * (lane & 3); vsrc[i] = k * irs + col; }
  using LP = __attribute__((address_space(3))) unsigned*;
#define BB_DMA(buf, tb) do { const bf16* _kb = Kp + (long)(tb) * rs; const bf16* _vb = Vp + (long)(tb) * rs; char* _l = lds + (buf) * BT; \
    _Pragma("unroll") for (int _i = 0; _i < 2; ++_i) { __builtin_amdgcn_global_load_lds((const unsigned*)(_kb + ksrc[_i]), (LP)(_l + (2 * wid + _i) * 1024), 16, 0, 0); \
                                                       __builtin_amdgcn_global_load_lds((const unsigned*)(_vb + vsrc[_i]), (LP)(_l + 16384 + (2 * wid + _i) * 1024), 16, 0, 0); } } while (0)
  constexpr int NT = (256 + 2 * WIN) / 64, NTW = (2 * WIN + 32 + 63) / 64;
  const int klo = wid >> 1, qpos = P0 + wid * QBLK + r32;
  int kf = 0; while (P0 - WIN + 64 * kf < 0) ++kf;
  int kl = NT - 1; while (P0 - WIN + 64 * kl >= Lseq) --kl;
  BB_DMA(kf & 1, P0 - WIN + 64 * kf);
  for (int k = kf; k <= kl; ++k) {
    const int tb = P0 - WIN + 64 * k;
    asm volatile("s_waitcnt vmcnt(0)" ::: "memory");
    __builtin_amdgcn_s_barrier();
    asm volatile("" ::: "memory");
    if (k < kl) BB_DMA((k + 1) & 1, tb + 64);
    char* tbuf = lds + (k & 1) * BT;
    if (k >= klo && k < klo + NTW) {
      f32x16 p0, p1; float mn, al; bf16x8 pa0, pa1, pa2, pa3;
      qkt_pipe(p0, p1, (int)(uintptr_t)tbuf, qr, r32, hi);
      if (k == klo || k == klo + NTW - 1) {
#pragma unroll
        for (int r = 0; r < 16; ++r) { const int d = qpos - (tb + crow(r, hi));
          if (d > WIN || d < -WIN) p0[r] = -1e30f;
          if (d - 32 > WIN || d - 32 < -WIN) p1[r] = -1e30f; }
      }
      partialSM(p0, p1, m_reg, mn, al);
      if (__any(al < 1.f)) { if (hi == 0) al_l[r32] = al; asm volatile("s_waitcnt lgkmcnt(0)" ::: "memory");
#pragma unroll
        for (int d = 0; d < 4; ++d)
#pragma unroll
          for (int r = 0; r < 16; ++r) o[d][r] *= al_l[crow(r, hi)]; }
      finishSM(p0, p1, al, l_reg, pa0, pa1, pa2, pa3); SBAR();
      pv_pipe<4>(o, (int)(uintptr_t)(tbuf + 16384) + v_rd_base(lane), pa0, pa1, pa2, pa3);
    }
  }
#undef BB_DMA
  if (hi == 0) li_l[r32] = l_reg; asm volatile("s_waitcnt lgkmcnt(0)" ::: "memory");
  float rli[16];
#pragma unroll
  for (int r = 0; r < 16; ++r) rli[r] = __builtin_amdgcn_rcpf(li_l[crow(r, hi)]);
  bf16* Ow = Ob + (long)(P0 + wid * QBLK) * os;
#pragma unroll
  for (int r = 0; r < 16; ++r) { const int orow = crow(r, hi);
#pragma unroll
    for (int d0 = 0; d0 < 4; ++d0) { const float val = o[d0][r] * rli[r]; ((__attribute__((address_space(1))) bf16*)Ow)[(long)orow * os + d0 * 32 + r32] = (bf16)(cvtpk(val, val) & 0xffffu); } }
  if (Lp != nullptr && hi == 0) Lp[(long)(P0 + wid * QBLK + r32) * ls] = m_reg * SCALE + __logf(l_reg);
}

constexpr int WB_WS = 131072;
template <int LDQ, int LDK, int LDO, int NVH, typename TO, bool COMBINE = false, int LDC = 0, int TPB = 1>
__device__ __forceinline__ void attn_wide_body(const bf16* __restrict__ Qb, const bf16* __restrict__ Kh, const bf16* __restrict__ Vh, TO* __restrict__ Ob, const int seq, char* lds, const int tid,
                                               const float lam = 0.f, const float gsc = 0.f, const float* __restrict__ gain = nullptr, bf16* __restrict__ Cb = nullptr) {
  const int wid = __builtin_amdgcn_readfirstlane(tid >> 6), lane = tid & 63, r32 = lane & 31, hi = lane >> 5;
  float* wsf = (float*)(lds + WB_WS) + wid * 64; float* li_l = wsf; float* al_l = wsf + 32;
  float m_reg = -1e30f, l_reg = 0; f32x16 o[4 * NVH] = {}; bf16x8 qr[8];
  { const bf16* Qw = Qb + ((wid * QBLK + r32) * LDQ + hi * 8);
#pragma unroll
    for (int d0 = 0; d0 < 8; ++d0) qr[d0] = *reinterpret_cast<const bf16x8*>(Qw + d0 * 16); }
  constexpr int NVP = 2 * NVH;
  int ksrc[2], vsrc[NVP];
#pragma unroll
  for (int i = 0; i < 2; ++i) { const int c = 2 * wid + i, row = 4 * c + (lane >> 4), colB = (16 * (lane & 15)) ^ ((row & 7) << 4); ksrc[i] = row * LDK + (colB >> 1); }
#pragma unroll
  for (int i = 0; i < NVP; ++i) { const int pc = wid * NVP + i, hf = pc >> 4, c = pc & 15, sub = 2 * c + (lane >> 5), kk = ((sub >> 2) << 3) | ((lane & 31) >> 2);
      const int k = (kk & ~0xC) | ((kk & 4) << 1) | ((kk & 8) >> 1), col = (sub & 3) * 32 + 8 * (lane & 3); vsrc[i] = k * LDK + hf * 128 + col; }
  using LP = __attribute__((address_space(3))) unsigned*;
  constexpr int WB_ONE = 16384 * (1 + NVH), WB_SUP = TPB * WB_ONE;
  static_assert(2 * WB_SUP <= WB_WS, "ring");
#define WB_DMA(buf, key0) do { _Pragma("unroll") for (int _t = 0; _t < TPB; ++_t) { const bf16* _kb = Kh + ((key0) + _t * KVBLK) * LDK; const bf16* _vb = Vh + ((key0) + _t * KVBLK) * LDK; char* _l = lds + (buf) * WB_SUP + _t * WB_ONE; \
    _Pragma("unroll") for (int _i = 0; _i < 2; ++_i) __builtin_amdgcn_global_load_lds((const unsigned*)(_kb + ksrc[_i]), (LP)(_l + (2 * wid + _i) * 1024), 16, 0, 0); \
    _Pragma("unroll") for (int _i = 0; _i < NVP; ++_i) __builtin_amdgcn_global_load_lds((const unsigned*)(_vb + vsrc[_i]), (LP)(_l + 16384 + (wid * NVP + _i) * 1024), 16, 0, 0); } } while (0)
  const int NG = seq / (KVBLK * TPB);
  WB_DMA(0, 0);
  for (int j = 0; j < NG; ++j) {
    asm volatile("s_waitcnt vmcnt(0)" ::: "memory");
    __builtin_amdgcn_s_barrier();
    asm volatile("" ::: "memory");
    if (j + 1 < NG) WB_DMA((j + 1) & 1, (j + 1) * KVBLK * TPB);
#pragma unroll
    for (int tt = 0; tt < TPB; ++tt) {
    char* tb = lds + (j & 1) * WB_SUP + tt * WB_ONE;
    f32x16 p0, p1; float mn, al; bf16x8 pa0, pa1, pa2, pa3;
    qkt_pipe(p0, p1, (int)(uintptr_t)tb, qr, r32, hi);
    partialSM(p0, p1, m_reg, mn, al);
    if (__any(al < 1.f)) { if (hi == 0) al_l[r32] = al; asm volatile("s_waitcnt lgkmcnt(0)" ::: "memory");
#pragma unroll
      for (int d = 0; d < 4 * NVH; ++d)
#pragma unroll
        for (int r = 0; r < 16; ++r) o[d][r] *= al_l[crow(r, hi)]; }
    finishSM(p0, p1, al, l_reg, pa0, pa1, pa2, pa3); SBAR();
    const int vb0 = (int)(uintptr_t)(tb + 16384) + v_rd_base(lane);
    pv_pipe<4 * NVH>(o, vb0, pa0, pa1, pa2, pa3);
    }
  }
#undef WB_DMA
  int te = tid; asm volatile("" : "+v"(te));
  const int wid_e = __builtin_amdgcn_readfirstlane(te >> 6), r32_e = te & 31, hi_e = (te >> 5) & 1;
  float* li_e = (float*)(lds + WB_WS) + wid_e * 64;
  if (hi_e == 0) li_e[r32_e] = l_reg; asm volatile("s_waitcnt lgkmcnt(0)" ::: "memory");
  float rli[16];
#pragma unroll
  for (int r = 0; r < 16; ++r) rli[r] = __builtin_amdgcn_rcpf(li_e[crow(r, hi_e)]);
  TO* Ow = Ob + (wid_e * QBLK) * LDO;
  if constexpr (!COMBINE) {
#pragma unroll
    for (int r = 0; r < 16; ++r) { const int orow = crow(r, hi_e);
#pragma unroll
      for (int d0 = 0; d0 < 4 * NVH; ++d0) { const float val = o[d0][r] * rli[r];
        if constexpr (sizeof(TO) == 4) ((__attribute__((address_space(1))) TO*)Ow)[orow * LDO + d0 * 32 + r32_e] = val; else ((__attribute__((address_space(1))) TO*)Ow)[orow * LDO + d0 * 32 + r32_e] = (TO)(cvtpk(val, val) & 0xffffu); } }
  } else {
    static_assert(sizeof(TO) == 4 && NVH == 2, "combine: f32 first-map tile, 256-wide rows");
    float gn[8];
    { const float* g2 = gain; asm volatile("" : "+s"(g2));
#pragma unroll
      for (int d0 = 0; d0 < 8; ++d0) gn[d0] = g2[d0 * 32 + r32_e] * gsc; }
    bf16* Cw; { bf16* c2 = Cb; asm volatile("" : "+s"(c2)); Cw = c2 + (wid_e * QBLK) * LDC; }
    { TO* o2 = Ob; asm volatile("" : "+s"(o2)); Ow = o2 + (wid_e * QBLK) * LDO; }
#pragma unroll
    for (int r = 0; r < 16; ++r) { const int orow = crow(r, hi_e);
      float ss = 0.f;
#pragma unroll
      for (int d0 = 0; d0 < 8; ++d0) { const float o1 = __hip_atomic_load((const __attribute__((address_space(1))) float*)Ow + orow * LDO + d0 * 32 + r32_e, __ATOMIC_RELAXED, __HIP_MEMORY_SCOPE_AGENT);
        const float av = o1 - lam * (o[d0][r] * rli[r]); o[d0][r] = av; ss = fmaf(av, av, ss); }
#define WB_SWZ(v, m) __int_as_float(__builtin_amdgcn_ds_swizzle(__float_as_int(v), ((m) << 10) | 0x1F))
      ss += WB_SWZ(ss, 1); ss += WB_SWZ(ss, 2); ss += WB_SWZ(ss, 4); ss += WB_SWZ(ss, 8); ss += WB_SWZ(ss, 16);
#undef WB_SWZ
      const float sc = 1.0f / sqrtf(ss * (1.0f / 256.0f) + 1e-6f);
#pragma unroll
      for (int d0 = 0; d0 < 8; ++d0) { const float val = o[d0][r] * sc * gn[d0]; ((__attribute__((address_space(1))) bf16*)Cw)[orow * LDC + d0 * 32 + r32_e] = (bf16)(cvtpk(val, val) & 0xffffu); }
      asm volatile("" ::: "memory"); }
  }
}
}
typedef unsigned short bf16_t;
typedef unsigned u32x4v __attribute__((ext_vector_type(4)));
#define LDSA __attribute__((address_space(3)))
#define GLB __attribute__((address_space(1)))
constexpr size_t al256(size_t x) { return (x + 255) / 256 * 256; }
constexpr size_t WS_CTL  = 0;
constexpr size_t CTL_BYTES = 65536;
constexpr size_t WS_XB   = WS_CTL + CTL_BYTES;
constexpr size_t WS_WAB  = WS_XB + (size_t)SEQ * DM * 2;
constexpr size_t WS_WOAB = WS_WAB + (size_t)12288 * 4096 * 2;
constexpr size_t WS_WCD  = WS_WOAB + (size_t)4096 * 3072 * 2;
constexpr size_t WS_WOCD = WS_WCD + (size_t)9216 * 4096 * 2;
constexpr size_t WS_WQ   = WS_WOCD + (size_t)4096 * 4096 * 2;
constexpr size_t WS_UB   = WS_WQ + (size_t)2 * 2048 * 4096 * 2;
constexpr size_t WS_VB   = WS_UB + (size_t)2 * 16384 * 3072;
constexpr size_t WS_SU   = WS_VB + (size_t)2 * 16384 * 3072;
constexpr size_t WS_SV   = WS_SU + (size_t)2 * 16384 * 4;
constexpr size_t WS_H    = WS_SV + (size_t)2 * 16384 * 4;
constexpr size_t WS_Y    = WS_H;
constexpr size_t WS_PQ   = WS_H + (size_t)SEQ * 4096 * 4;
constexpr size_t WS_OC   = WS_H + (size_t)SEQ * 12288 * 4;
constexpr size_t WS_AB   = WS_OC + (size_t)2 * SEQ * 2048 * 4;
constexpr size_t WS_X1   = WS_AB + (size_t)SEQ * 4096 * 2;
constexpr size_t WS_X1B  = WS_X1 + (size_t)SEQ * 4096 * 4;
constexpr size_t WS_X2   = WS_X1B + (size_t)SEQ * 4096 * 2;
constexpr size_t WS_X2B  = WS_X2 + (size_t)SEQ * 4096 * 4;
constexpr size_t WS_EIDX = WS_X2B + (size_t)SEQ * 4096 * 2;
constexpr size_t WS_GATE = WS_EIDX + (size_t)SEQ * 128 * 4;
constexpr size_t WS_HB   = WS_GATE + (size_t)SEQ * 128 * 4;
constexpr size_t WS_KEYB = WS_HB + (size_t)SEQ * 12288 * 2;
constexpr size_t WS_CS0  = WS_KEYB + (size_t)2 * 8 * 2 * 128 * 128 * 2;
constexpr size_t WS_CSA  = WS_CS0 + (size_t)SEQ * 16 * 8;
constexpr size_t WS_END  = WS_CSA + (size_t)128 * 32 * 8;
static_assert(WS_END <= (size_t)2147483648ull, "workspace");

constexpr int LDS_BYTES = 155648;
constexpr int LDS_MISC = 139264;

struct MK { const float* in[21]; float* out; unsigned char* ws; int ph_lo, ph_hi; };

namespace pg8 {
struct EpiF32R {
    static constexpr bool PERM = false, AFTER_DRAIN = false;
    float* C; int ldc; const float* R; float ralpha;
    __device__ __forceinline__ void operator()(const f32x4 (&acc)[2][2][4][2], const Unit& u, int wr, int wc, int fr, int fq) const {
        const int row0 = u.pm * BM + wr * 64 + fr, col0 = u.pn * BM + wc * 32 + 4 * fq;
#pragma unroll
        for (int ai = 0; ai < 2; ++ai)
#pragma unroll
            for (int mp = 0; mp < 2; ++mp) {
                f32x4 r[2][2][2];
                if (R) {
#pragma unroll
                    for (int mm = 0; mm < 2; ++mm) { const size_t off = (size_t)(row0 + ai * HALF + (2 * mp + mm) * 16) * ldc + col0;
#pragma unroll
                        for (int bj = 0; bj < 2; ++bj)
#pragma unroll
                            for (int n = 0; n < 2; ++n) r[mm][bj][n] = *(const GLB f32x4*)(R + off + bj * HALF + n * 16); }
                }
#pragma unroll
                for (int mm = 0; mm < 2; ++mm) { const int m = 2 * mp + mm; const size_t off = (size_t)(row0 + ai * HALF + m * 16) * ldc + col0;
#pragma unroll
                    for (int bj = 0; bj < 2; ++bj)
#pragma unroll
                        for (int n = 0; n < 2; ++n) { f32x4 v = acc[ai][bj][m][n];
                            if (R) v += r[mm][bj][n] * ralpha;
                            *(GLB f32x4*)(C + off + bj * HALF + n * 16) = v; } }
                asm volatile("" ::: "memory");
            }
    }
};
struct EpiBf16R {
    static constexpr bool PERM = true, AFTER_DRAIN = false;
    bf16_t* O; int ldc; const bf16_t* R; float ralpha;
    __device__ __forceinline__ void operator()(const f32x4 (&acc)[2][2][4][2], const Unit& u, int wr, int wc, int fr, int fq) const {
        const int row0 = u.pm * BM + wr * 64 + fr, col0 = u.pn * BM + wc * 32 + 8 * fq;
#pragma unroll
        for (int ai = 0; ai < 2; ++ai) {
            u32x4 r[4][2];
#pragma unroll
            for (int m = 0; m < 4; ++m)
#pragma unroll
                for (int bj = 0; bj < 2; ++bj) r[m][bj] = *(const GLB u32x4*)(R + (size_t)(row0 + ai * HALF + m * 16) * ldc + col0 + bj * HALF);
#pragma unroll
            for (int m = 0; m < 4; ++m) { bf16_t* rowp = O + (size_t)(row0 + ai * HALF + m * 16) * ldc + col0;
#pragma unroll
                for (int bj = 0; bj < 2; ++bj) { const f32x4 v0 = acc[ai][bj][m][0], v1 = acc[ai][bj][m][1]; const u32x4 q = r[m][bj];
                    u32x4 w;
                    w.x = cvt_pk_bf16(v0[0] + ralpha * __uint_as_float(q.x << 16), v0[1] + ralpha * __uint_as_float(q.x & 0xffff0000u));
                    w.y = cvt_pk_bf16(v0[2] + ralpha * __uint_as_float(q.y << 16), v0[3] + ralpha * __uint_as_float(q.y & 0xffff0000u));
                    w.z = cvt_pk_bf16(v1[0] + ralpha * __uint_as_float(q.z << 16), v1[1] + ralpha * __uint_as_float(q.z & 0xffff0000u));
                    w.w = cvt_pk_bf16(v1[2] + ralpha * __uint_as_float(q.w << 16), v1[3] + ralpha * __uint_as_float(q.w & 0xffff0000u));
                    *(GLB u32x4*)(rowp + bj * HALF) = w; } }
            asm volatile("" ::: "memory");
        }
    }
};
struct EpiBf16P {
    static constexpr bool PERM = true, AFTER_DRAIN = false;
    bf16_t* O; int ldc;
    __device__ __forceinline__ void operator()(const f32x4 (&acc)[2][2][4][2], const Unit& u, int wr, int wc, int fr, int fq) const {
        const int row0 = u.pm * BM + wr * 64 + fr, col0 = u.pn * BM + wc * 32 + 8 * fq;
#pragma unroll
        for (int ai = 0; ai < 2; ++ai)
#pragma unroll
            for (int m = 0; m < 4; ++m) { bf16_t* rowp = O + (size_t)(row0 + ai * HALF + m * 16) * ldc + col0;
#pragma unroll
                for (int bj = 0; bj < 2; ++bj) { const f32x4 v0 = acc[ai][bj][m][0], v1 = acc[ai][bj][m][1];
                    u32x4 w; w.x = cvt_pk_bf16(v0[0], v0[1]); w.y = cvt_pk_bf16(v0[2], v0[3]); w.z = cvt_pk_bf16(v1[0], v1[1]); w.w = cvt_pk_bf16(v1[2], v1[3]);
                    *(GLB u32x4*)(rowp + bj * HALF) = w; } }
    }
};

template <int LAYER> struct EpiProj {
    static constexpr bool PERM = true, AFTER_DRAIN = false;
    bf16_t* O; int ldc; const float* cs0; const float* csa; const float* gq; const float* gk; PG8_LAS float* xch;
    __device__ __forceinline__ void operator()(const f32x4 (&acc)[2][2][4][2], const Unit& u, int wr, int wc, int fr, int fq) const {
        const int row0 = u.pm * BM + wr * 64 + fr, col0 = u.pn * BM + wc * 32 + 8 * fq;
        const int pn = u.pn;
        const bool prope = LAYER == 0 ? (pn < 10 || (pn >= 12 && pn < 36)) : (pn < 16);
        const bool dnorm = LAYER == 1 && pn >= 24 && pn < 34;
        float rs[2][4][2];
        float gn[8];
        if (dnorm) {
            const int lrow = fr;
#pragma unroll
            for (int ai = 0; ai < 2; ++ai)
#pragma unroll
                for (int m = 0; m < 4; ++m)
#pragma unroll
                    for (int bj = 0; bj < 2; ++bj) { const f32x4 a = acc[ai][bj][m][0], b = acc[ai][bj][m][1];
                        float q = (a[0] * a[0] + a[1] * a[1]) + (a[2] * a[2] + a[3] * a[3]) + (b[0] * b[0] + b[1] * b[1]) + (b[2] * b[2] + b[3] * b[3]);
                        q += __shfl_xor(q, 16); q += __shfl_xor(q, 32);
                        if (fq == 0) xch[((wr * 128 + (ai * 4 + m) * 16 + lrow) * 2 + bj) * 4 + wc] = q; }
            asm volatile("s_waitcnt lgkmcnt(0)" ::: "memory"); __builtin_amdgcn_s_barrier(); asm volatile("" ::: "memory");
#pragma unroll
            for (int ai = 0; ai < 2; ++ai)
#pragma unroll
                for (int m = 0; m < 4; ++m)
#pragma unroll
                    for (int bj = 0; bj < 2; ++bj) { const f32x4 p = *(const PG8_LAS f32x4*)(xch + ((wr * 128 + (ai * 4 + m) * 16 + lrow) * 2 + bj) * 4);
                        rs[ai][m][bj] = 1.0f / sqrtf(((p[0] + p[1]) + (p[2] + p[3])) * (1.0f / 128.0f) + 1e-6f); }
            const float* g = pn < 32 ? gq : gk;
#pragma unroll
            for (int e = 0; e < 8; ++e) { const int p = wc * 32 + 8 * fq + e; const int orig = (p & 64) + ((p & 63) >> 1) + 32 * (p & 1); gn[e] = g[orig]; }
        }
        const bool rot = dnorm || (prope && wc == 0);
#pragma unroll
        for (int ai = 0; ai < 2; ++ai) {
            f32x4 cs[4][2];
            if (rot) {
#pragma unroll
                for (int m = 0; m < 4; ++m) { const int row = row0 + ai * HALF + m * 16;
                    const float* cp = dnorm ? csa + ((size_t)(wc < 2 ? (row >> 6) : (row & 63)) * 32 + 16 * (wc & 1) + 4 * fq) * 2 : cs0 + ((size_t)row * 16 + 4 * fq) * 2;
                    cs[m][0] = *(const GLB f32x4*)cp; cs[m][1] = *(const GLB f32x4*)(cp + 4); }
            }
#pragma unroll
            for (int m = 0; m < 4; ++m) {
                const int row = row0 + ai * HALF + m * 16;
                bf16_t* rowp = O + (size_t)row * ldc + col0;
                f32x4 c0 = (f32x4){1.f, 0.f, 1.f, 0.f}, c1 = c0;
                if (rot) { c0 = cs[m][0]; c1 = cs[m][1]; }
#pragma unroll
                for (int bj = 0; bj < 2; ++bj) { f32x4 v0 = acc[ai][bj][m][0], v1 = acc[ai][bj][m][1];
                    if (dnorm) { const float r = rs[ai][m][bj];
                        v0[0] *= r * gn[0]; v0[1] *= r * gn[1]; v0[2] *= r * gn[2]; v0[3] *= r * gn[3]; v1[0] *= r * gn[4]; v1[1] *= r * gn[5]; v1[2] *= r * gn[6]; v1[3] *= r * gn[7]; }
                    if (rot) {
                        const float a0 = v0[0] * c0[0] - v0[1] * c0[1], b0 = v0[1] * c0[0] + v0[0] * c0[1];
                        const float a1 = v0[2] * c0[2] - v0[3] * c0[3], b1 = v0[3] * c0[2] + v0[2] * c0[3];
                        const float a2 = v1[0] * c1[0] - v1[1] * c1[1], b2 = v1[1] * c1[0] + v1[0] * c1[1];
                        const float a3 = v1[2] * c1[2] - v1[3] * c1[3], b3 = v1[3] * c1[2] + v1[2] * c1[3];
                        v0 = (f32x4){a0, b0, a1, b1}; v1 = (f32x4){a2, b2, a3, b3}; }
                    u32x4 w; w.x = cvt_pk_bf16(v0[0], v0[1]); w.y = cvt_pk_bf16(v0[2], v0[3]); w.z = cvt_pk_bf16(v1[0], v1[1]); w.w = cvt_pk_bf16(v1[2], v1[3]);
                    *(GLB u32x4*)(rowp + bj * HALF) = w; }
            }
            asm volatile("" ::: "memory");
        }
    }
};
}

__device__ __forceinline__ float bf_lo(unsigned w) { return __uint_as_float(w << 16); }
__device__ __forceinline__ float bf_hi(unsigned w) { return __uint_as_float(w & 0xffff0000u); }
__device__ __forceinline__ unsigned cvtpk_bf16(float lo, float hi) { unsigned r; asm volatile("v_cvt_pk_bf16_f32 %0, %1, %2" : "=v"(r) : "v"(lo), "v"(hi)); return r; }

__device__ __forceinline__ void cvt_rows_bf16(const float* __restrict__ src, bf16_t* __restrict__ dst, size_t n8, int bid, int nb, int tid, int nthr) {
    const size_t stride = (size_t)nb * nthr;
    for (size_t i = (size_t)bid * nthr + tid; i < n8; i += 4 * stride) {
        float4 a[4], b[4];
#pragma unroll
        for (int u = 0; u < 4; ++u) { const size_t j = i + u * stride; if (j < n8) { a[u] = *(const float4*)(src + j * 8); b[u] = *(const float4*)(src + j * 8 + 4); } }
#pragma unroll
        for (int u = 0; u < 4; ++u) { const size_t j = i + u * stride; if (j < n8) {
            u32x4v w; w.x = cvtpk_bf16(a[u].x, a[u].y); w.y = cvtpk_bf16(a[u].z, a[u].w); w.z = cvtpk_bf16(b[u].x, b[u].y); w.w = cvtpk_bf16(b[u].z, b[u].w);
            *(u32x4v*)(dst + j * 8) = w; } }
    }
}
template <class PM>
__device__ __forceinline__ void transpose_cvt(const float* __restrict__ W, bf16_t* __restrict__ Wt, int K, int N, LDSA float* tile0, int bid, int nb, PM pm, const int tid) {
    const int lane = tid & 63, wv = tid >> 6;
    LDSA float* tile = tile0 + wv * 4352;
    const int ntk = K / 64, ntn = N / 64;
    for (int t = bid * 8 + wv; t < ntk * ntn; t += nb * 8) {
        const int k0 = (t % ntk) * 64, n0 = (t / ntk) * 64;
        const int c = (lane & 15) * 4, r0 = lane >> 4;
        float4 v[16];
#pragma unroll
        for (int i = 0; i < 16; ++i) v[i] = *(const float4*)(W + (size_t)(k0 + r0 + 4 * i) * N + n0 + c);
#pragma unroll
        for (int i = 0; i < 16; ++i) { const int r = r0 + 4 * i; tile[r * 65 + c] = v[i].x; tile[r * 65 + c + 1] = v[i].y; tile[r * 65 + c + 2] = v[i].z; tile[r * 65 + c + 3] = v[i].w; }
        asm volatile("s_waitcnt lgkmcnt(0)" ::: "memory");
        const int mode = pm(n0);
#pragma unroll
        for (int h = 0; h < 8; ++h) {
            const int n = (lane >> 3) + 8 * h, kc = (lane & 7) * 8;
            int src = n;
            if (mode == 1) { if (n < 32) src = (n >> 1) + 16 * (n & 1); }
            else if (mode == 2) src = (n >> 1) + 32 * (n & 1);
            float f[8];
#pragma unroll
            for (int j = 0; j < 8; ++j) f[j] = tile[(kc + j) * 65 + src];
            u32x4v w; w.x = cvtpk_bf16(f[0], f[1]); w.y = cvtpk_bf16(f[2], f[3]); w.z = cvtpk_bf16(f[4], f[5]); w.w = cvtpk_bf16(f[6], f[7]);
            *(u32x4v*)(Wt + (size_t)(n0 + n) * K + k0 + kc) = w;
        }
        asm volatile("s_waitcnt lgkmcnt(0)" ::: "memory");
    }
}
struct PermNone { __device__ __forceinline__ int operator()(int) const { return 0; } };
struct PermAB { __device__ __forceinline__ int operator()(int n0) const { const bool rope = n0 < 2560 || (n0 >= 3072 && n0 < 9216); return (rope && (n0 & 127) == 0) ? 1 : 0; } };
struct PermCD { __device__ __forceinline__ int operator()(int n0) const { if (n0 < 4096) return (n0 & 127) == 0 ? 1 : 0; if (n0 >= 6144 && n0 < 8704) return 2; return 0; } };
__device__ __forceinline__ void rope_tables(float* __restrict__ cs0, float* __restrict__ csa, const int bid, const int G, const int tid) {
    for (int i = bid * 512 + tid; i < SEQ * 16; i += G * 512) { float s, c; sincos_rev((double)(i >> 4) * REV_P[i & 15], s, c); *(float2*)(cs0 + (size_t)i * 2) = make_float2(c, s); }
    for (int i = bid * 512 + tid; i < 128 * 32; i += G * 512) { float s, c; sincos_rev((double)(i >> 5) * REV_A[i & 31], s, c); *(float2*)(csa + (size_t)i * 2) = make_float2(c, s); }
}


typedef unsigned v6u_t __attribute__((ext_vector_type(6)));
typedef float f4v_t __attribute__((ext_vector_type(4)));
typedef unsigned v16u_t __attribute__((ext_vector_type(16)));
typedef float v16f_t __attribute__((ext_vector_type(16)));
typedef float v32f_t __attribute__((ext_vector_type(32)));
typedef __bf16 v32b_t __attribute__((ext_vector_type(32)));
constexpr int ROWB = 3072;
constexpr int XT_STRIDE = 68;
constexpr int XT_BYTES = 64 * XT_STRIDE * 4;
__device__ __forceinline__ void table_fp6(const float* __restrict__ src, unsigned char* __restrict__ dst, float* __restrict__ inv, const int rows, LDSA float* xt0, const int bid, const int G, const int tid) {
    const int lane = tid & 63, wv = tid >> 6;
    LDSA float* xt = xt0 + wv * (XT_BYTES / 4);
    for (int r = bid * 8 + wv; r < rows; r += G * 8) {
        float4 v[16]; float am = 0.f;
#pragma unroll
        for (int j = 0; j < 16; ++j) { v[j] = *(const float4*)(src + (size_t)r * DM + j * 256 + lane * 4); am = fmaxf(am, fmaxf(fmaxf(fabsf(v[j].x), fabsf(v[j].y)), fmaxf(fabsf(v[j].z), fabsf(v[j].w)))); }
        am = wave_max(am);
        const float sc = am > 0.f ? 7.0f / am : 1.0f;
#pragma unroll
        for (int j = 0; j < 16; ++j) *(LDSA f4v_t*)(xt + (4 * j + (lane >> 4)) * XT_STRIDE + 4 * (lane & 15)) = (f4v_t){v[j].x * sc, v[j].y * sc, v[j].z * sc, v[j].w * sc};
        asm volatile("s_waitcnt lgkmcnt(0)" ::: "memory");
        v16f_t f0, f1, f2, f3;
#pragma unroll
        for (int k = 0; k < 8; ++k) { const f4v_t a = *(const LDSA f4v_t*)(xt + lane * XT_STRIDE + 4 * k), c = *(const LDSA f4v_t*)(xt + lane * XT_STRIDE + 32 + 4 * k);
            f0[2 * k] = a[0]; f1[2 * k] = a[1]; f0[2 * k + 1] = a[2]; f1[2 * k + 1] = a[3];
            f2[2 * k] = c[0]; f3[2 * k] = c[1]; f2[2 * k + 1] = c[2]; f3[2 * k + 1] = c[3]; }
        asm volatile("s_waitcnt lgkmcnt(0)" ::: "memory");
        const v6u_t w0 = __builtin_amdgcn_cvt_scalef32_2xpk16_fp6_f32(f0, f1, 1.0f), w1 = __builtin_amdgcn_cvt_scalef32_2xpk16_fp6_f32(f2, f3, 1.0f);
        unsigned char* dp = dst + (size_t)r * ROWB + lane * 48;
        u32x4v s0, s1, s2; s0.x = w0[0]; s0.y = w0[1]; s0.z = w0[2]; s0.w = w0[3]; s1.x = w0[4]; s1.y = w0[5]; s1.z = w1[0]; s1.w = w1[1]; s2.x = w1[2]; s2.y = w1[3]; s2.z = w1[4]; s2.w = w1[5];
        *(u32x4v*)dp = s0; *(u32x4v*)(dp + 16) = s1; *(u32x4v*)(dp + 32) = s2;
        if (lane == 0) inv[r] = am > 0.f ? am * (1.0f / 7.0f) : 1.0f;
    }
}

typedef __bf16 bf2_t __attribute__((ext_vector_type(2)));
__device__ __forceinline__ float dot2_bf16(unsigned a, unsigned b, float c) { return __builtin_amdgcn_fdot2_f32_bf16(__builtin_bit_cast(bf2_t, a), __builtin_bit_cast(bf2_t, b), c, false); }
__device__ __forceinline__ float gelu_tanh_f(float x) {
    const float z = 0.7978845608028654f * (x + 0.044715f * x * x * x);
    const float e = __expf(2.0f * z);
    return 0.5f * x * (2.0f - 2.0f / (e + 1.0f));
}
__device__ __forceinline__ int pick_i(int a0, int a1, int k) { return k < 64 ? __builtin_amdgcn_readlane(a0, k) : __builtin_amdgcn_readlane(a1, k - 64); }
__device__ __forceinline__ float pick_f(float a0, float a1, int k) { return __int_as_float(pick_i(__float_as_int(a0), __float_as_int(a1), k)); }
__device__ __forceinline__ float dpp_shr(float v, const int ctrl_sel) {
    const int iv = __builtin_bit_cast(int, v); int r;
    switch (ctrl_sel) { case 1: r = __builtin_amdgcn_update_dpp(0, iv, 0x111, 0xf, 0xf, true); break; case 2: r = __builtin_amdgcn_update_dpp(0, iv, 0x112, 0xf, 0xf, true); break;
                        case 4: r = __builtin_amdgcn_update_dpp(0, iv, 0x114, 0xf, 0xf, true); break; default: r = __builtin_amdgcn_update_dpp(0, iv, 0x118, 0xf, 0xf, true); break; }
    return __builtin_bit_cast(float, r);
}
__device__ __forceinline__ float wave_sum_u(float v) {
    v += dpp_shr(v, 1); v += dpp_shr(v, 2); v += dpp_shr(v, 4); v += dpp_shr(v, 8);
    v += __builtin_bit_cast(float, __builtin_amdgcn_update_dpp(0, __builtin_bit_cast(int, v), 0x142, 0xa, 0xf, false));
    v += __builtin_bit_cast(float, __builtin_amdgcn_update_dpp(0, __builtin_bit_cast(int, v), 0x143, 0xc, 0xf, false));
    return __builtin_bit_cast(float, __builtin_amdgcn_readlane(__builtin_bit_cast(int, v), 63));
}
typedef const __attribute__((address_space(1))) u32x4v* gu32x4p;
#define PE_LOADROW(dst, base, e) do { const unsigned char* _p = (base) + (size_t)(e) * ROWB + lane * 48; dst[0] = *(gu32x4p)_p; dst[1] = *(gu32x4p)(_p + 16); dst[2] = *(gu32x4p)(_p + 32); } while (0)
__device__ __forceinline__ float pe_dot(const u32x4v (&r)[3], const u32x4v (&x)[8]) {
    float d0 = 0.f, d1 = 0.f, d2 = 0.f, d3 = 0.f;
    { const v6u_t g = {r[0].x, r[0].y, r[0].z, r[0].w, r[1].x, r[1].y};
      const v16u_t z = __builtin_bit_cast(v16u_t, __builtin_amdgcn_cvt_scalef32_pk32_bf16_fp6(g, 1.0f));
#pragma unroll
      for (int k = 0; k < 4; ++k) { const unsigned xa = x[k].x, xb = x[k].y, xc = x[k].z, xd = x[k].w; const unsigned za = z[4 * k], zb = z[4 * k + 1], zc = z[4 * k + 2], zd = z[4 * k + 3];
          d0 = dot2_bf16(za, xa, d0); d1 = dot2_bf16(zb, xb, d1); d2 = dot2_bf16(zc, xc, d2); d3 = dot2_bf16(zd, xd, d3); }
    }
    { const v6u_t g = {r[1].z, r[1].w, r[2].x, r[2].y, r[2].z, r[2].w};
      const v16u_t z = __builtin_bit_cast(v16u_t, __builtin_amdgcn_cvt_scalef32_pk32_bf16_fp6(g, 1.0f));
#pragma unroll
      for (int k = 0; k < 4; ++k) { const unsigned xa = x[4 + k].x, xb = x[4 + k].y, xc = x[4 + k].z, xd = x[4 + k].w; const unsigned za = z[4 * k], zb = z[4 * k + 1], zc = z[4 * k + 2], zd = z[4 * k + 3];
          d0 = dot2_bf16(za, xa, d0); d1 = dot2_bf16(zb, xb, d1); d2 = dot2_bf16(zc, xc, d2); d3 = dot2_bf16(zd, xd, d3); } }
    return wave_sum_u((d0 + d1) + (d2 + d3));
}
#define PE_PIN16(a, b) asm volatile("" : "+v"(a[b + 0]), "+v"(a[b + 1]), "+v"(a[b + 2]), "+v"(a[b + 3]), "+v"(a[b + 4]), "+v"(a[b + 5]), "+v"(a[b + 6]), "+v"(a[b + 7]), \
                                         "+v"(a[b + 8]), "+v"(a[b + 9]), "+v"(a[b + 10]), "+v"(a[b + 11]), "+v"(a[b + 12]), "+v"(a[b + 13]), "+v"(a[b + 14]), "+v"(a[b + 15]))
__device__ __forceinline__ void pe_axpy(float (&acc)[64], const u32x4v (&r)[3], const float w) {
    { const v6u_t g = {r[0].x, r[0].y, r[0].z, r[0].w, r[1].x, r[1].y};
      const v32f_t y = __builtin_amdgcn_cvt_scalef32_pk32_f32_fp6(g, 1.0f);
#pragma unroll
      for (int i = 0; i < 32; ++i) acc[i] = fmaf(w, y[i], acc[i]);
      PE_PIN16(acc, 0); PE_PIN16(acc, 16); }
    { const v6u_t g = {r[1].z, r[1].w, r[2].x, r[2].y, r[2].z, r[2].w};
      const v32f_t y = __builtin_amdgcn_cvt_scalef32_pk32_f32_fp6(g, 1.0f);
#pragma unroll
      for (int i = 0; i < 32; ++i) acc[32 + i] = fmaf(w, y[i], acc[32 + i]);
      PE_PIN16(acc, 32); PE_PIN16(acc, 48); }
}
__device__ __forceinline__ void wave_sort128(unsigned& a0, unsigned& a1, const int lane) {
#pragma unroll
    for (int k = 2; k <= 128; k <<= 1) {
#pragma unroll
        for (int j = k >> 1; j > 0; j >>= 1) {
            if (j == 64) { const unsigned lo = a0 < a1 ? a0 : a1, hi = a0 < a1 ? a1 : a0; a0 = lo; a1 = hi; }
            else {
                const unsigned o0 = (unsigned)__shfl_xor((int)a0, j), o1 = (unsigned)__shfl_xor((int)a1, j);
                const bool lowhalf = (lane & j) == 0;
                const bool up0 = k >= 128 ? true : ((lane & k) == 0);
                const bool up1 = k >= 128 ? true : (k == 64 ? false : ((lane & k) == 0));
                const bool min0 = lowhalf == up0, min1 = lowhalf == up1;
                const unsigned mn0 = a0 < o0 ? a0 : o0, mx0 = a0 < o0 ? o0 : a0, mn1 = a1 < o1 ? a1 : o1, mx1 = a1 < o1 ? o1 : a1;
                a0 = min0 ? mn0 : mx0; a1 = min1 ? mn1 : mx1;
            }
        }
    }
}
__device__ __forceinline__ void peer_expert_phase(const bf16_t* __restrict__ ypre, const float* __restrict__ stats, const float* __restrict__ gm, const float* __restrict__ bm, const bf16_t* __restrict__ x1b, int* __restrict__ eidx, float* __restrict__ gate,
                                                  const unsigned char* __restrict__ ub, const unsigned char* __restrict__ vb, const float* __restrict__ isu, const float* __restrict__ isv,
                                                  const float* __restrict__ lg, const float* __restrict__ lb, float* __restrict__ out, bf16_t* __restrict__ outb, LDSA float* xt0, const int bid, const int G, const int tid) {
    const int wv = __builtin_amdgcn_readfirstlane(tid >> 6);
    LDSA float* xt = xt0 + wv * (XT_BYTES / 4);
#define PE_POS(k) (rev ? 127 - (k) : (k))
#define PE_E(k) pick_i(e0, e1, PE_POS(k))
    int jt = 0;
    for (int t = bid * 8 + wv; t < SEQ; t += G * 8, ++jt) {
        int tl = tid; asm volatile("" : "+v"(tl));
        const int lane = tl & 63;
        const bool rev = (jt & 1) != 0;
        int e0, e1; float g0, g1;
        { const int r0 = eidx[(size_t)t * 128 + lane], r1 = eidx[(size_t)t * 128 + 64 + lane];
          const float h0 = gate[(size_t)t * 128 + lane], h1 = gate[(size_t)t * 128 + 64 + lane];
          unsigned a0 = ((unsigned)r0 << 7) | (unsigned)lane, a1 = ((unsigned)r1 << 7) | (unsigned)(64 + lane);
          wave_sort128(a0, a1, lane);
          e0 = (int)(a0 >> 7); e1 = (int)(a1 >> 7);
          const int k0 = (int)(a0 & 127u), k1 = (int)(a1 & 127u);
          const float p00 = __shfl(h0, k0 & 63), p01 = __shfl(h1, k0 & 63), p10 = __shfl(h0, k1 & 63), p11 = __shfl(h1, k1 & 63);
          g0 = k0 < 64 ? p00 : p01; g1 = k1 < 64 ? p10 : p11; }
        const float iu0 = isu[e0], iu1 = isu[e1], iv0 = isv[e0], iv1 = isv[e1];
        u32x4v xq[8];
#pragma unroll
        for (int k = 0; k < 8; ++k) xq[k] = *(const u32x4v*)(x1b + (size_t)t * DM + lane * 64 + k * 8);
        float w0 = 0.f, w1 = 0.f;
        u32x4v R0[3], R1[3], R2[3], R3[3], R4[3];
#define PE_USTEP(R, k) do { const int kk = PE_POS(k); const float d = pe_dot(R, xq) * pick_f(iu0, iu1, kk); const float w = pick_f(g0, g1, kk) * gelu_tanh_f(d) * pick_f(iv0, iv1, kk); \
            if (lane == (kk & 63)) { if (kk < 64) w0 = w; else w1 = w; } } while (0)
        PE_LOADROW(R0, ub, PE_E(0)); PE_LOADROW(R1, ub, PE_E(1)); PE_LOADROW(R2, ub, PE_E(2)); PE_LOADROW(R3, ub, PE_E(3));
        for (int k = 0; k < 125; k += 5) {
            if (k + 4 < 128) PE_LOADROW(R4, ub, PE_E(k + 4)); PE_USTEP(R0, k);
            if (k + 5 < 128) PE_LOADROW(R0, ub, PE_E(k + 5)); PE_USTEP(R1, k + 1);
            if (k + 6 < 128) PE_LOADROW(R1, ub, PE_E(k + 6)); PE_USTEP(R2, k + 2);
            if (k + 7 < 128) PE_LOADROW(R2, ub, PE_E(k + 7)); PE_USTEP(R3, k + 3);
            if (k + 8 < 128) PE_LOADROW(R3, ub, PE_E(k + 8)); PE_USTEP(R4, k + 4);
        }
        PE_USTEP(R0, 125); PE_USTEP(R1, 126); PE_USTEP(R2, 127);
#undef PE_USTEP
        eidx[(size_t)t * 128 + lane] = e0; eidx[(size_t)t * 128 + 64 + lane] = e1;
        gate[(size_t)t * 128 + lane] = w0; gate[(size_t)t * 128 + 64 + lane] = w1;
    }
    asm volatile("s_waitcnt vmcnt(0)" ::: "memory");
    for (int t = bid * 8 + wv; t < SEQ; t += G * 8, ++jt) {
        int tl = tid; asm volatile("" : "+v"(tl));
        const int lane = tl & 63;
        const bool rev = (jt & 1) != 0;
        const int e0 = __builtin_nontemporal_load(eidx + (size_t)t * 128 + lane), e1 = __builtin_nontemporal_load(eidx + (size_t)t * 128 + 64 + lane);
        const float w0 = __builtin_nontemporal_load(gate + (size_t)t * 128 + lane), w1 = __builtin_nontemporal_load(gate + (size_t)t * 128 + 64 + lane);
        u32x4v R0[3], R1[3], R2[3], R3[3], R4[3];
        float acc[64];
#pragma unroll
        for (int i = 0; i < 64; ++i) acc[i] = 0.f;
        PE_LOADROW(R0, vb, PE_E(0)); PE_LOADROW(R1, vb, PE_E(1)); PE_LOADROW(R2, vb, PE_E(2)); PE_LOADROW(R3, vb, PE_E(3));
        for (int k = 0; k < 125; k += 5) {
            if (k + 4 < 128) PE_LOADROW(R4, vb, PE_E(k + 4)); pe_axpy(acc, R0, pick_f(w0, w1, PE_POS(k)));
            if (k + 5 < 128) PE_LOADROW(R0, vb, PE_E(k + 5)); pe_axpy(acc, R1, pick_f(w0, w1, PE_POS(k + 1)));
            if (k + 6 < 128) PE_LOADROW(R1, vb, PE_E(k + 6)); pe_axpy(acc, R2, pick_f(w0, w1, PE_POS(k + 2)));
            if (k + 7 < 128) PE_LOADROW(R2, vb, PE_E(k + 7)); pe_axpy(acc, R3, pick_f(w0, w1, PE_POS(k + 3)));
            if (k + 8 < 128) PE_LOADROW(R3, vb, PE_E(k + 8)); pe_axpy(acc, R4, pick_f(w0, w1, PE_POS(k + 4)));
        }
        pe_axpy(acc, R0, pick_f(w0, w1, PE_POS(125))); pe_axpy(acc, R1, pick_f(w0, w1, PE_POS(126))); pe_axpy(acc, R2, pick_f(w0, w1, PE_POS(127)));
#pragma unroll
        for (int k = 0; k < 16; ++k) *(LDSA f4v_t*)(xt + lane * XT_STRIDE + 4 * k) = (f4v_t){acc[4 * k], acc[4 * k + 1], acc[4 * k + 2], acc[4 * k + 3]};
        asm volatile("s_waitcnt lgkmcnt(0)" ::: "memory");
        float4 y[16]; float s = 0.f;
#pragma unroll
        for (int j = 0; j < 16; ++j) { const f4v_t f = *(const LDSA f4v_t*)(xt + (4 * j + (lane >> 4)) * XT_STRIDE + 4 * (lane & 15));
            const uint2 xw = *(const uint2*)(x1b + (size_t)t * DM + j * 256 + lane * 4); const float4 xv = make_float4(bf_lo(xw.x), bf_hi(xw.x), bf_lo(xw.y), bf_hi(xw.y));
            y[j].x = fmaf(ALPHA, xv.x, f.x); y[j].y = fmaf(ALPHA, xv.y, f.y); y[j].z = fmaf(ALPHA, xv.z, f.z); y[j].w = fmaf(ALPHA, xv.w, f.w);
            s += (y[j].x + y[j].y) + (y[j].z + y[j].w);
            if ((j & 3) == 3) asm volatile("" ::: "memory"); }
        asm volatile("s_waitcnt lgkmcnt(0)" ::: "memory");
        const float mean = wave_sum_u(s) * (1.0f / DM);
        float qq = 0.f;
#pragma unroll
        for (int j = 0; j < 16; ++j) { const float a = y[j].x - mean, b = y[j].y - mean, c = y[j].z - mean, d = y[j].w - mean; qq += (a * a + b * b) + (c * c + d * d); }
        const float rstd = 1.0f / sqrtf(wave_sum_u(qq) * (1.0f / DM) + 1e-5f);
#pragma unroll
        for (int j = 0; j < 16; ++j) {
            const int c = j * 256 + lane * 4;
            const float4 ga = *(const float4*)(lg + c), ba = *(const float4*)(lb + c);
            float4 oa; oa.x = (y[j].x - mean) * rstd * ga.x + ba.x; oa.y = (y[j].y - mean) * rstd * ga.y + ba.y; oa.z = (y[j].z - mean) * rstd * ga.z + ba.z; oa.w = (y[j].w - mean) * rstd * ga.w + ba.w;
            if (out) *(float4*)(out + (size_t)t * DM + c) = oa;
            if (outb) { uint2 w; w.x = cvtpk_bf16(oa.x, oa.y); w.y = cvtpk_bf16(oa.z, oa.w); *(uint2*)(outb + (size_t)t * DM + c) = w; }
            if ((j & 3) == 3) asm volatile("" ::: "memory");
        }
    }
#undef PE_E
#undef PE_POS
}

__device__ __forceinline__ void attn1_phase(const bf16_t* __restrict__ hb, bf16_t* __restrict__ abb, float* __restrict__ oc, const float* __restrict__ lq1, const float* __restrict__ lk1, const float* __restrict__ lq2,
                                            const float* __restrict__ lk2, const float* __restrict__ subg, char* lds, const int bid, const int G, const int tid) {
    for (int u = bid; u < 512; u += G) {
        __syncthreads();
        const int kv = u >> 7, g = (u >> 5) & 3, qb = u & 31, hq = kv * 4 + g;
        att::attn_wide_body<9216, 9216, 4096, 1, att::bf16, false, 0, 2>(hb + (size_t)(qb * 256) * 9216 + 6144 + hq * 128, hb + 8192 + kv * 128, hb + 8704 + kv * 128,
                                                             abb + (size_t)(qb * 256) * 4096 + 2048 + hq * 128, SEQ, lds, tid);
    }
    int tid2 = tid; asm volatile("" : "+v"(tid2));
    const int lane_c = tid2 & 63;
    const float lam = __int_as_float(__builtin_amdgcn_readfirstlane(__float_as_int(__expf(wave_sum(lq1[lane_c] * lk1[lane_c] + lq1[lane_c + 64] * lk1[lane_c + 64])) - __expf(wave_sum(lq2[lane_c] * lk2[lane_c] + lq2[lane_c + 64] * lk2[lane_c + 64])) + LAMBDA_INIT)));
    for (int v = bid; v < 256; v += G) {
        __syncthreads();
        const int h = v >> 5, qb = v & 31;
        float* o1 = oc + (size_t)(qb * 256) * 2048 + h * 256;
        int tid4 = tid2; asm volatile("" : "+v"(tid4));
        att::attn_wide_body<9216, 9216, 2048, 2, float>(hb + (size_t)(qb * 256) * 9216 + h * 256, hb + 2048 + h * 256, hb + 4096 + h * 256, o1, SEQ, lds, tid4);
        __syncthreads();
        int tid3 = tid2; asm volatile("" : "+v"(tid3));
        att::attn_wide_body<9216, 9216, 2048, 2, float, true, 4096>(hb + (size_t)(qb * 256) * 9216 + h * 256 + 128, hb + 2048 + h * 256 + 128, hb + 4096 + h * 256, o1, SEQ, lds, tid3,
                                                                     lam, 1.0f - LAMBDA_INIT, subg, abb + (size_t)(qb * 256) * 4096 + h * 256);
    }
}


__device__ __forceinline__ void attn0_phase(const bf16_t* __restrict__ hb, const float* __restrict__ sink, bf16_t* __restrict__ abb, bf16_t* __restrict__ obg, float* __restrict__ lse, char* lds, const int bid, const int G, const int tid) {
    const long LD = 12288;
    for (int u = bid; u < 512; u += G) {
        __syncthreads();
        const int hq = u >> 5, qb = u & 31, kv = hq >> 2;
        att::attn_banded_body<128>(hb + hq * 128, hb + 2048 + kv * 128, hb + 2560 + kv * 128, LD, SEQ, qb * 256, sink[hq] * (1.0f / att::SCALE), 1.0f, abb + hq * 128, 3072, nullptr, 0, lds, tid);
    }
    int tid2 = tid; asm volatile("" : "+v"(tid2));
    for (int v = bid; v < 768; v += G) {
        __syncthreads();
        const int g = v >> 8, w = v & 255, h = w >> 5, rem = w & 31;
        const int dsh = 2 * g;
        const int nqb_sh = 5 - dsh;
        const int r = rem >> nqb_sh, qb = rem & ((1 << nqb_sh) - 1);
        const int head = 8 * g + h;
        const long rs = LD << dsh;
        att::attn_banded_body<64>(hb + (long)r * LD + 3072 + head * 128, hb + (long)r * LD + 6144 + head * 128, hb + (long)r * LD + 9216 + head * 128, rs, SEQ >> dsh, qb * 256, -1e30f, 0.f,
                                  obg + ((long)(g * 8 + h) * SEQ + r) * 128, (long)128 << dsh, lse + (long)(g * 8 + h) * SEQ + r, (long)1 << dsh, lds, tid2);
    }
}
__device__ __forceinline__ void merge0_phase(const bf16_t* __restrict__ obg, const float* __restrict__ lse, bf16_t* __restrict__ abb, const int bid, const int G, const int tid) {
    const int lane = tid & 63, wv = tid >> 6;
    for (int j = bid * 8 + wv; j < SEQ * 8; j += G * 8) {
        const int h = j >> 13, t = j & (SEQ - 1);
        const float l0 = lse[(size_t)(0 * 8 + h) * SEQ + t], l1 = lse[(size_t)(1 * 8 + h) * SEQ + t], l2 = lse[(size_t)(2 * 8 + h) * SEQ + t];
        const float mx = fmaxf(l0, fmaxf(l1, l2));
        const float e0 = __expf(l0 - mx), e1 = __expf(l1 - mx), e2 = __expf(l2 - mx), inv = 1.0f / (e0 + e1 + e2);
        const unsigned a0 = *(const unsigned*)(obg + ((size_t)(0 * 8 + h) * SEQ + t) * 128 + 2 * lane), a1 = *(const unsigned*)(obg + ((size_t)(1 * 8 + h) * SEQ + t) * 128 + 2 * lane), a2 = *(const unsigned*)(obg + ((size_t)(2 * 8 + h) * SEQ + t) * 128 + 2 * lane);
        const float x = (e0 * bf_lo(a0) + e1 * bf_lo(a1) + e2 * bf_lo(a2)) * inv, y = (e0 * bf_hi(a0) + e1 * bf_hi(a1) + e2 * bf_hi(a2)) * inv;
        *(unsigned*)(abb + (size_t)t * 3072 + 2048 + h * 128 + 2 * lane) = cvtpk_bf16(x, y);
    }
}

__device__ __forceinline__ void post_even_phase(const float* __restrict__ h, bf16_t* __restrict__ hb, const int bid, const int G, const int tid) {
    const int lane = tid & 63, wv = tid >> 6;
    for (int job = bid * 8 + wv; job < SEQ * 96; job += G * 8) {
        const int t = job / 96, blk = job - t * 96;
        const bool rope = (blk < 20) || (blk >= 24 && blk < 72);
        const float2 v = *(const float2*)(h + (size_t)t * 12288 + blk * 128 + 2 * lane);
        float o0 = v.x, o1 = v.y;
        const float p0 = __shfl_xor(v.x, 8), p1 = __shfl_xor(v.y, 8);
        if (rope && lane < 16) {
            const int i0 = (2 * lane) & 15;
            float s0, c0, s1, c1; sincos_rev((double)t * REV_P[i0], s0, c0); sincos_rev((double)t * REV_P[i0 + 1], s1, c1);
            if (lane < 8) { o0 = v.x * c0 - p0 * s0; o1 = v.y * c1 - p1 * s1; }
            else          { o0 = v.x * c0 + p0 * s0; o1 = v.y * c1 + p1 * s1; }
        }
        *(unsigned*)(hb + (size_t)t * 12288 + blk * 128 + 2 * lane) = cvtpk_bf16(o0, o1);
    }
}
__device__ __forceinline__ void post_odd_phase(const float* __restrict__ h, bf16_t* __restrict__ hb, const float* __restrict__ qg, const float* __restrict__ kg, const int bid, const int G, const int tid) {
    const int lane = tid & 63, wv = tid >> 6;
    for (int job = bid * 8 + wv; job < SEQ * 72; job += G * 8) {
        const int t = job / 72, blk = job - t * 72;
        const float2 v = *(const float2*)(h + (size_t)t * 9216 + blk * 128 + 2 * lane);
        float o0 = v.x, o1 = v.y;
        if (blk < 32) {
            const float p0 = __shfl_xor(v.x, 8), p1 = __shfl_xor(v.y, 8);
            if (lane < 16) {
                const int i0 = (2 * lane) & 15;
                float s0, c0, s1, c1; sincos_rev((double)t * REV_P[i0], s0, c0); sincos_rev((double)t * REV_P[i0 + 1], s1, c1);
                if (lane < 8) { o0 = v.x * c0 - p0 * s0; o1 = v.y * c1 - p1 * s1; }
                else          { o0 = v.x * c0 + p0 * s0; o1 = v.y * c1 + p1 * s1; }
            }
        } else if (blk >= 48 && blk < 68) {
            const float* g = blk < 64 ? qg : kg;
            const float ss = wave_sum(v.x * v.x + v.y * v.y) * (1.0f / 128.0f);
            const float rs = 1.0f / sqrtf(ss + 1e-6f);
            const float a0 = v.x * rs * g[2 * lane], a1 = v.y * rs * g[2 * lane + 1];
            const float p0 = __shfl_xor(a0, 16), p1 = __shfl_xor(a1, 16);
            const int i0 = (2 * lane) & 31;
            const double pos = (double)(lane < 32 ? (t >> 6) : (t & 63));
            float s0, c0, s1, c1; sincos_rev(pos * REV_A[i0], s0, c0); sincos_rev(pos * REV_A[i0 + 1], s1, c1);
            if ((lane & 16) == 0) { o0 = a0 * c0 - p0 * s0; o1 = a1 * c1 - p1 * s1; }
            else                  { o0 = a0 * c0 + p0 * s0; o1 = a1 * c1 + p1 * s1; }
        }
        *(unsigned*)(hb + (size_t)t * 9216 + blk * 128 + 2 * lane) = cvtpk_bf16(o0, o1);
    }
}

__device__ __forceinline__ void attn_seg_b(const float q0, const float q1, const bf16_t* __restrict__ Kb, const bf16_t* __restrict__ Vb, const int ld,
                                           const int t, const int step, int jlo, int jhi, float& m, float& l, float& o0, float& o1, const int lane) {
    { const int lo = -(t / step); if (jlo < lo) jlo = lo; const int hi = (SEQ - 1 - t) / step; if (jhi > hi) jhi = hi; }
    for (int j = jlo; j <= jhi; ++j) {
        const size_t tp = (size_t)(t + step * j);
        const unsigned kw = *(const unsigned*)(Kb + tp * ld + 2 * lane), vw = *(const unsigned*)(Vb + tp * ld + 2 * lane);
        const float s = wave_sum(q0 * bf_lo(kw) + q1 * bf_hi(kw)) * ATT_SCALE;
        const float mn = fmaxf(m, s);
        const float al = __expf(m - mn), p = __expf(s - mn);
        l = l * al + p;
        o0 = o0 * al + p * bf_lo(vw); o1 = o1 * al + p * bf_hi(vw);
        m = mn;
    }
}
__device__ __forceinline__ void attn_even_valu_phase(const bf16_t* __restrict__ hb, const float* __restrict__ sink, bf16_t* __restrict__ abb, const int bid, const int G, const int tid) {
    const int lane = tid & 63, wv = tid >> 6;
    const int LD = 12288;
    for (int job = bid * 8 + wv; job < SEQ * 24; job += G * 8) {
        const int hh = job / SEQ, t = job % SEQ;
        float o0 = 0.f, o1 = 0.f, m, l;
        if (hh < 16) {
            const int kv = hh >> 2;
            const unsigned qw = *(const unsigned*)(hb + (size_t)t * LD + hh * 128 + 2 * lane);
            m = sink[hh]; l = 1.f;
            attn_seg_b(bf_lo(qw), bf_hi(qw), hb + 2048 + kv * 128, hb + 2560 + kv * 128, LD, t, 1, -128, 128, m, l, o0, o1, lane);
        } else {
            const int hbh = hh - 16;
            m = -1e30f; l = 0.f;
#pragma unroll
            for (int g = 0; g < 3; ++g) {
                const int head = 8 * g + hbh; const int step = g == 0 ? 1 : (g == 1 ? 4 : 16);
                const unsigned qw = *(const unsigned*)(hb + (size_t)t * LD + 3072 + head * 128 + 2 * lane);
                attn_seg_b(bf_lo(qw), bf_hi(qw), hb + 6144 + head * 128, hb + 9216 + head * 128, LD, t, step, -64, 64, m, l, o0, o1, lane);
            }
        }
        const float il = 1.0f / l;
        *(unsigned*)(abb + (size_t)t * 3072 + hh * 128 + 2 * lane) = cvtpk_bf16(o0 * il, o1 * il);
    }
}

__device__ __forceinline__ void ln_phase(const bf16_t* __restrict__ y, const float* __restrict__ g, const float* __restrict__ b, float* __restrict__ stats, bf16_t* __restrict__ outb, const int bid, const int G, const int tid) {
    const int lane = tid & 63, wv = tid >> 6;
    for (int t = bid * 8 + wv; t < SEQ; t += G * 8) {
        float4 v[16]; float s = 0.f;
#pragma unroll
        for (int i = 0; i < 16; ++i) { const uint2 w = *(const uint2*)(y + (size_t)t * DM + i * 256 + lane * 4); v[i] = make_float4(bf_lo(w.x), bf_hi(w.x), bf_lo(w.y), bf_hi(w.y)); s += (v[i].x + v[i].y) + (v[i].z + v[i].w); }
        const float mean = wave_sum(s) * (1.0f / DM);
        float q = 0.f;
#pragma unroll
        for (int i = 0; i < 16; ++i) { const float a = v[i].x - mean, bb = v[i].y - mean, c = v[i].z - mean, d = v[i].w - mean; q += (a * a + bb * bb) + (c * c + d * d); }
        const float rstd = 1.0f / sqrtf(wave_sum(q) * (1.0f / DM) + 1e-5f);
#pragma unroll
        for (int i = 0; i < 16; ++i) {
            const float4 gg = *(const float4*)(g + i * 256 + lane * 4), bb = *(const float4*)(b + i * 256 + lane * 4);
            float4 o; o.x = (v[i].x - mean) * rstd * gg.x + bb.x; o.y = (v[i].y - mean) * rstd * gg.y + bb.y; o.z = (v[i].z - mean) * rstd * gg.z + bb.z; o.w = (v[i].w - mean) * rstd * gg.w + bb.w;
            uint2 w; w.x = cvtpk_bf16(o.x, o.y); w.y = cvtpk_bf16(o.z, o.w); *(uint2*)(outb + (size_t)t * DM + i * 256 + lane * 4) = w;
            if ((i & 3) == 3) asm volatile("" ::: "memory");
        }
    }
}

__device__ __forceinline__ void route_valu_phase(const float* __restrict__ q  , const float* __restrict__ keys  , int* __restrict__ eidx, float* __restrict__ gate, const int bid, const int G, const int tid) {
    const int lane = tid & 63, wv = tid >> 6;
    for (int job = bid * 8 + wv; job < SEQ * 8; job += G * 8) {
        const int hh = job & 7, t = job >> 3;
        float sv0 = 0.f, sv1 = 0.f; int si0 = 0, si1 = 0;
#pragma unroll
        for (int c = 0; c < 2; ++c) {
            const float* qq = q + (size_t)t * 2048 + hh * 256 + c * 128;
            const float* k0 = keys + ((size_t)(hh * 2 + c) * 128 + lane) * 128;
            const float* k1 = k0 + 64 * 128;
            float s0 = 0.f, s1 = 0.f;
            for (int d = 0; d < 128; d += 4) {
                const float4 qv = *(const float4*)(qq + d), a = *(const float4*)(k0 + d), b = *(const float4*)(k1 + d);
                s0 += qv.x * a.x + qv.y * a.y + qv.z * a.z + qv.w * a.w;
                s1 += qv.x * b.x + qv.y * b.y + qv.z * b.z + qv.w * b.w;
            }
            float myv = 0.f; int myi = 0;
            for (int k = 0; k < 16; ++k) {
                float bv; int bi;
                if (s1 > s0) { bv = s1; bi = lane + 64; } else { bv = s0; bi = lane; }
#pragma unroll
                for (int o = 32; o >= 1; o >>= 1) {
                    const float ov = __shfl_xor(bv, o); const int oi = __shfl_xor(bi, o);
                    if (ov > bv || (ov == bv && oi < bi)) { bv = ov; bi = oi; }
                }
                if (lane == k) { myv = bv; myi = bi; }
                if (bi == lane) s0 = -3.0e38f;
                if (bi == lane + 64) s1 = -3.0e38f;
            }
            if (c == 0) { sv0 = myv; si0 = myi; } else { sv1 = myv; si1 = myi; }
        }
        float cv0, cv1, cv2, cv3; int ci0, ci1, ci2, ci3;
        { const float a = __shfl(sv0, lane >> 2); const int ai = __shfl(si0, lane >> 2); const int jb = (lane & 3) * 4;
          cv0 = a + __shfl(sv1, jb + 0); ci0 = ai * 128 + __shfl(si1, jb + 0);
          cv1 = a + __shfl(sv1, jb + 1); ci1 = ai * 128 + __shfl(si1, jb + 1);
          cv2 = a + __shfl(sv1, jb + 2); ci2 = ai * 128 + __shfl(si1, jb + 2);
          cv3 = a + __shfl(sv1, jb + 3); ci3 = ai * 128 + __shfl(si1, jb + 3); }
        float tv = 0.f; int te = 0;
        for (int k = 0; k < 16; ++k) {
            float bv = cv0; int bp = lane * 4, be = ci0;
            if (cv1 > bv) { bv = cv1; bp = lane * 4 + 1; be = ci1; }
            if (cv2 > bv) { bv = cv2; bp = lane * 4 + 2; be = ci2; }
            if (cv3 > bv) { bv = cv3; bp = lane * 4 + 3; be = ci3; }
#pragma unroll
            for (int o = 32; o >= 1; o >>= 1) {
                const float ov = __shfl_xor(bv, o); const int op = __shfl_xor(bp, o); const int oe = __shfl_xor(be, o);
                if (ov > bv || (ov == bv && op < bp)) { bv = ov; bp = op; be = oe; }
            }
            if (lane == k) { tv = bv; te = be; }
            if (bp == lane * 4 + 0) cv0 = -3.0e38f;
            if (bp == lane * 4 + 1) cv1 = -3.0e38f;
            if (bp == lane * 4 + 2) cv2 = -3.0e38f;
            if (bp == lane * 4 + 3) cv3 = -3.0e38f;
        }
        const float v = lane < 16 ? tv : -3.0e38f;
        const float mx = wave_max(v);
        const float e = lane < 16 ? __expf(tv - mx) : 0.f;
        const float den = wave_sum(e);
        if (lane < 16) { eidx[(size_t)t * 128 + hh * 16 + lane] = te; gate[(size_t)t * 128 + hh * 16 + lane] = e / den; }
    }
}
namespace rt {
using att::f32x16; using att::bf16x8;
__device__ __forceinline__ float pair_max(float m) {
    auto rr = __builtin_amdgcn_permlane32_swap(__float_as_uint(m), __float_as_uint(m), false, false);
    return fmaxf(__uint_as_float(rr[0]), __uint_as_float(rr[1]));
}
__device__ __forceinline__ int pair_max_i(int m) {
    auto rr = __builtin_amdgcn_permlane32_swap((unsigned)m, (unsigned)m, false, false);
    const int a = (int)rr[0], b = (int)rr[1]; return a > b ? a : b;
}
__device__ __forceinline__ void top16_of_128(f32x16& p0, f32x16& p1, f32x16& p2, f32x16& p3, float (&t)[16]) {
#pragma unroll
    for (int k = 0; k < 16; ++k) {
        float m = p0[0];
#pragma unroll
        for (int r = 1; r < 16; ++r) m = fmaxf(m, p0[r]);
#pragma unroll
        for (int r = 0; r < 16; ++r) m = fmaxf(m, fmaxf(p1[r], fmaxf(p2[r], p3[r])));
        m = pair_max(m);
        t[k] = m;
#pragma unroll
        for (int r = 0; r < 16; ++r) { p0[r] = p0[r] == m ? -3.0e38f : p0[r]; p1[r] = p1[r] == m ? -3.0e38f : p1[r]; p2[r] = p2[r] == m ? -3.0e38f : p2[r]; p3[r] = p3[r] == m ? -3.0e38f : p3[r]; }
    }
}
__device__ __forceinline__ void tag_scores(f32x16& p, const int base, const int hi) {
#pragma unroll
    for (int r = 0; r < 16; ++r) p[r] = __uint_as_float((__float_as_uint(p[r]) & ~0x7Fu) | (unsigned)(base + att::crow(r, hi)));
}
}

__device__ __forceinline__ void route_mfma_phase(const bf16_t* __restrict__ pqb  , const bf16_t* __restrict__ keysb  , int* __restrict__ eidx, float* __restrict__ gate,
                                                 char* lds, const pg8::StaticOrder& S, const int tid) {
    using namespace rt;
    const int wid = __builtin_amdgcn_readfirstlane(tid >> 6), lane = tid & 63, r32 = lane & 31, hi = lane >> 5;
    att::bf16* K_lds = (att::bf16*)lds;
    pg8::Unit un;
    for (int ui = 0; S.next(ui, un); ++ui) {
        const int h = un.pn, tb = un.pm * 256;
        const int tok = tb + wid * 32 + r32;
        float t0[16], t1[16];
#pragma unroll
        for (int c = 0; c < 2; ++c) {
            __syncthreads();
            { const bf16_t* kp = keysb + (size_t)(h * 2 + c) * 128 * 128;
              const int row = tid >> 2;
#pragma unroll
              for (int i = 0; i < 4; ++i) { const int sc = ((tid & 3) * 4 + i) * 8;
                  const bf16x8 v = *reinterpret_cast<const bf16x8*>(kp + row * 128 + sc);
                  *(bf16x8*)((char*)K_lds + (row >> 6) * 16384 + KSWZ(row & 63, sc * 2)) = v; } }
            bf16x8 qr[8];
            { const bf16_t* qw = pqb + (size_t)tok * 2048 + h * 256 + c * 128 + hi * 8;
#pragma unroll
              for (int d0 = 0; d0 < 8; ++d0) qr[d0] = *reinterpret_cast<const bf16x8*>(qw + d0 * 16); }
            __syncthreads();
            f32x16 p0, p1, p2, p3;
            att::qkt_pipe(p0, p1, (int)(uintptr_t)K_lds, qr, r32, hi);
            att::qkt_pipe(p2, p3, (int)(uintptr_t)K_lds + 16384, qr, r32, hi);
            tag_scores(p0, 0, hi); tag_scores(p1, 32, hi); tag_scores(p2, 64, hi); tag_scores(p3, 96, hi);
            if (c == 0) top16_of_128(p0, p1, p2, p3, t0); else top16_of_128(p0, p1, p2, p3, t1);
        }
        float v0[16], v1[16]; int k0[16], k1[16];
#pragma unroll
        for (int i = 0; i < 16; ++i) { const unsigned a = __float_as_uint(t0[i]), b = __float_as_uint(t1[i]);
            v0[i] = __uint_as_float(a & ~0x7Fu); v1[i] = __uint_as_float(b & ~0x7Fu); k0[i] = (int)((a & 0x7Fu) << 7); k1[i] = (int)(b & 0x7Fu); }
        float cv[25]; int ce[25];
    { const float s = hi ? (v0[0] + v1[1]) : (v0[0] + v1[0]); cv[0] = __uint_as_float((__float_as_uint(s) & ~0xFFu) | (unsigned)(2 * 0 + hi)); ce[0] = hi ? (k0[0] | k1[1]) : (k0[0] | k1[0]); }
    { const float s = hi ? (v0[0] + v1[3]) : (v0[0] + v1[2]); cv[1] = __uint_as_float((__float_as_uint(s) & ~0xFFu) | (unsigned)(2 * 1 + hi)); ce[1] = hi ? (k0[0] | k1[3]) : (k0[0] | k1[2]); }
    { const float s = hi ? (v0[0] + v1[5]) : (v0[0] + v1[4]); cv[2] = __uint_as_float((__float_as_uint(s) & ~0xFFu) | (unsigned)(2 * 2 + hi)); ce[2] = hi ? (k0[0] | k1[5]) : (k0[0] | k1[4]); }
    { const float s = hi ? (v0[0] + v1[7]) : (v0[0] + v1[6]); cv[3] = __uint_as_float((__float_as_uint(s) & ~0xFFu) | (unsigned)(2 * 3 + hi)); ce[3] = hi ? (k0[0] | k1[7]) : (k0[0] | k1[6]); }
    { const float s = hi ? (v0[0] + v1[9]) : (v0[0] + v1[8]); cv[4] = __uint_as_float((__float_as_uint(s) & ~0xFFu) | (unsigned)(2 * 4 + hi)); ce[4] = hi ? (k0[0] | k1[9]) : (k0[0] | k1[8]); }
    { const float s = hi ? (v0[0] + v1[11]) : (v0[0] + v1[10]); cv[5] = __uint_as_float((__float_as_uint(s) & ~0xFFu) | (unsigned)(2 * 5 + hi)); ce[5] = hi ? (k0[0] | k1[11]) : (k0[0] | k1[10]); }
    { const float s = hi ? (v0[0] + v1[13]) : (v0[0] + v1[12]); cv[6] = __uint_as_float((__float_as_uint(s) & ~0xFFu) | (unsigned)(2 * 6 + hi)); ce[6] = hi ? (k0[0] | k1[13]) : (k0[0] | k1[12]); }
    { const float s = hi ? (v0[0] + v1[15]) : (v0[0] + v1[14]); cv[7] = __uint_as_float((__float_as_uint(s) & ~0xFFu) | (unsigned)(2 * 7 + hi)); ce[7] = hi ? (k0[0] | k1[15]) : (k0[0] | k1[14]); }
    { const float s = hi ? (v0[1] + v1[1]) : (v0[1] + v1[0]); cv[8] = __uint_as_float((__float_as_uint(s) & ~0xFFu) | (unsigned)(2 * 8 + hi)); ce[8] = hi ? (k0[1] | k1[1]) : (k0[1] | k1[0]); }
    { const float s = hi ? (v0[1] + v1[3]) : (v0[1] + v1[2]); cv[9] = __uint_as_float((__float_as_uint(s) & ~0xFFu) | (unsigned)(2 * 9 + hi)); ce[9] = hi ? (k0[1] | k1[3]) : (k0[1] | k1[2]); }
    { const float s = hi ? (v0[1] + v1[5]) : (v0[1] + v1[4]); cv[10] = __uint_as_float((__float_as_uint(s) & ~0xFFu) | (unsigned)(2 * 10 + hi)); ce[10] = hi ? (k0[1] | k1[5]) : (k0[1] | k1[4]); }
    { const float s = hi ? (v0[1] + v1[7]) : (v0[1] + v1[6]); cv[11] = __uint_as_float((__float_as_uint(s) & ~0xFFu) | (unsigned)(2 * 11 + hi)); ce[11] = hi ? (k0[1] | k1[7]) : (k0[1] | k1[6]); }
    { const float s = hi ? (v0[2] + v1[1]) : (v0[2] + v1[0]); cv[12] = __uint_as_float((__float_as_uint(s) & ~0xFFu) | (unsigned)(2 * 12 + hi)); ce[12] = hi ? (k0[2] | k1[1]) : (k0[2] | k1[0]); }
    { const float s = hi ? (v0[2] + v1[3]) : (v0[2] + v1[2]); cv[13] = __uint_as_float((__float_as_uint(s) & ~0xFFu) | (unsigned)(2 * 13 + hi)); ce[13] = hi ? (k0[2] | k1[3]) : (k0[2] | k1[2]); }
    { const float s = hi ? (v0[3] + v1[0]) : (v0[2] + v1[4]); cv[14] = __uint_as_float((__float_as_uint(s) & ~0xFFu) | (unsigned)(2 * 14 + hi)); ce[14] = hi ? (k0[3] | k1[0]) : (k0[2] | k1[4]); }
    { const float s = hi ? (v0[3] + v1[2]) : (v0[3] + v1[1]); cv[15] = __uint_as_float((__float_as_uint(s) & ~0xFFu) | (unsigned)(2 * 15 + hi)); ce[15] = hi ? (k0[3] | k1[2]) : (k0[3] | k1[1]); }
    { const float s = hi ? (v0[4] + v1[0]) : (v0[3] + v1[3]); cv[16] = __uint_as_float((__float_as_uint(s) & ~0xFFu) | (unsigned)(2 * 16 + hi)); ce[16] = hi ? (k0[4] | k1[0]) : (k0[3] | k1[3]); }
    { const float s = hi ? (v0[4] + v1[2]) : (v0[4] + v1[1]); cv[17] = __uint_as_float((__float_as_uint(s) & ~0xFFu) | (unsigned)(2 * 17 + hi)); ce[17] = hi ? (k0[4] | k1[2]) : (k0[4] | k1[1]); }
    { const float s = hi ? (v0[5] + v1[1]) : (v0[5] + v1[0]); cv[18] = __uint_as_float((__float_as_uint(s) & ~0xFFu) | (unsigned)(2 * 18 + hi)); ce[18] = hi ? (k0[5] | k1[1]) : (k0[5] | k1[0]); }
    { const float s = hi ? (v0[6] + v1[1]) : (v0[6] + v1[0]); cv[19] = __uint_as_float((__float_as_uint(s) & ~0xFFu) | (unsigned)(2 * 19 + hi)); ce[19] = hi ? (k0[6] | k1[1]) : (k0[6] | k1[0]); }
    { const float s = hi ? (v0[7] + v1[1]) : (v0[7] + v1[0]); cv[20] = __uint_as_float((__float_as_uint(s) & ~0xFFu) | (unsigned)(2 * 20 + hi)); ce[20] = hi ? (k0[7] | k1[1]) : (k0[7] | k1[0]); }
    { const float s = hi ? (v0[9] + v1[0]) : (v0[8] + v1[0]); cv[21] = __uint_as_float((__float_as_uint(s) & ~0xFFu) | (unsigned)(2 * 21 + hi)); ce[21] = hi ? (k0[9] | k1[0]) : (k0[8] | k1[0]); }
    { const float s = hi ? (v0[11] + v1[0]) : (v0[10] + v1[0]); cv[22] = __uint_as_float((__float_as_uint(s) & ~0xFFu) | (unsigned)(2 * 22 + hi)); ce[22] = hi ? (k0[11] | k1[0]) : (k0[10] | k1[0]); }
    { const float s = hi ? (v0[13] + v1[0]) : (v0[12] + v1[0]); cv[23] = __uint_as_float((__float_as_uint(s) & ~0xFFu) | (unsigned)(2 * 23 + hi)); ce[23] = hi ? (k0[13] | k1[0]) : (k0[12] | k1[0]); }
    { const float s = hi ? (v0[15] + v1[0]) : (v0[14] + v1[0]); cv[24] = __uint_as_float((__float_as_uint(s) & ~0xFFu) | (unsigned)(2 * 24 + hi)); ce[24] = hi ? (k0[15] | k1[0]) : (k0[14] | k1[0]); }
        float ts[16]; int te[16];
#pragma unroll
        for (int k = 0; k < 16; ++k) {
            float m = cv[0];
#pragma unroll
            for (int n = 1; n < 25; ++n) m = fmaxf(m, cv[n]);
            m = pair_max(m);
            int e = -1;
#pragma unroll
            for (int n = 0; n < 25; ++n) { const bool hit = cv[n] == m; e = hit ? ce[n] : e; cv[n] = hit ? -3.0e38f : cv[n]; }
            ts[k] = __uint_as_float(__float_as_uint(m) & ~0xFFu); te[k] = pair_max_i(e);
        }
        float den = 0.f; const float mx = ts[0];
#pragma unroll
        for (int k = 0; k < 16; ++k) { ts[k] = __expf(ts[k] - mx); den += ts[k]; }
        const float inv = 1.0f / den;
        if (hi == 0) { int4* op = (int4*)(eidx + (size_t)tok * 128 + h * 16);
            op[0] = make_int4(te[0], te[1], te[2], te[3]); op[1] = make_int4(te[4], te[5], te[6], te[7]); op[2] = make_int4(te[8], te[9], te[10], te[11]); op[3] = make_int4(te[12], te[13], te[14], te[15]); }
        else { float4* op = (float4*)(gate + (size_t)tok * 128 + h * 16);
            op[0] = make_float4(ts[0] * inv, ts[1] * inv, ts[2] * inv, ts[3] * inv); op[1] = make_float4(ts[4] * inv, ts[5] * inv, ts[6] * inv, ts[7] * inv);
            op[2] = make_float4(ts[8] * inv, ts[9] * inv, ts[10] * inv, ts[11] * inv); op[3] = make_float4(ts[12] * inv, ts[13] * inv, ts[14] * inv, ts[15] * inv); }
    }
}
#ifndef PH_MASK
#define PH_MASK 0xffffffffu
#endif
constexpr int N_PHASES = 20;
__global__ void __launch_bounds__(512, 2) mega(MK a) {
    extern __shared__ __attribute__((aligned(16))) unsigned char lds_raw[];
    LDSA unsigned char* lds = (LDSA unsigned char*)lds_raw;
    const int lo = a.ph_lo, hi = a.ph_hi;
    const int G = gridDim.x, bid = blockIdx.x;
    const int wid_s = __builtin_amdgcn_readfirstlane(threadIdx.x >> 6);
    unsigned char* ws = a.ws;
#define PH_TID() int tid; { int _z = 0; asm volatile("" : "+s"(_z)); tid = wid_s * 64 + (int)__builtin_amdgcn_mbcnt_hi(~0u, __builtin_amdgcn_mbcnt_lo(~0u, (unsigned)_z)); }
#define WSP(T, name, off) T* name; { unsigned char* _b = ws; asm volatile("" : "+s"(_b)); name = (T*)(_b + (off)); }
#define IN(k) ((((PH_MASK) >> (k)) & 1u) && lo <= (k) && (k) < hi)
#define SEAM(k) do { if ((k) + 1 < hi) { PH_TID() xcd_barrier(bar, tid); } } while (0)
    XcdBarrier bar;
    { PH_TID()
      volatile LAS unsigned* st = (volatile LAS unsigned*)(lds + LDS_MISC);
      if (tid == 0) { st[0] = 0u; st[1] = 0u; }
      __syncthreads();
      bar = xcd_barrier_post((unsigned*)(ws + WS_CTL), st, tid); }

    if (IN(0)) {
      {
        PH_TID()
        WSP(bf16_t, xb, WS_XB) WSP(bf16_t, wab, WS_WAB) WSP(bf16_t, woab, WS_WOAB) WSP(bf16_t, wcd, WS_WCD) WSP(bf16_t, wocd, WS_WOCD) WSP(bf16_t, wq, WS_WQ) WSP(unsigned char, ub, WS_UB) WSP(unsigned char, vb, WS_VB) WSP(float, isu, WS_SU) WSP(float, isv, WS_SV)
        cvt_rows_bf16(a.in[0], xb, (size_t)SEQ * DM / 8, bid, G, tid, 512);
        LDSA float* tile = (LDSA float*)lds;
        transpose_cvt(a.in[1], wab, 4096, 12288, tile, bid, G, PermAB(), tid);
        transpose_cvt(a.in[3], woab, 3072, 4096, tile, bid, G, PermNone(), tid);
        transpose_cvt(a.in[4], wcd, 4096, 9216, tile, bid, G, PermCD(), tid);
        transpose_cvt(a.in[12], wocd, 4096, 4096, tile, bid, G, PermNone(), tid);
        transpose_cvt(a.in[15], wq, 4096, 2048, tile, bid, G, PermNone(), tid);
        transpose_cvt(a.in[15] + (size_t)4096 * 2048, wq + (size_t)2048 * 4096, 4096, 2048, tile, bid, G, PermNone(), tid);
        table_fp6(a.in[17], ub, isu, 2 * 16384, (LDSA float*)lds, bid, G, tid);
        { const int nu1 = (SEQ / 256) * (9216 / 256); const bool slack = (nu1 % G) != 0 && (nu1 % G) <= G / 2;
          table_fp6(a.in[18], vb, isv, slack ? 16384 : 2 * 16384, (LDSA float*)lds, bid, G, tid); }
        { WSP(float, cs0, WS_CS0) WSP(float, csa, WS_CSA) rope_tables(cs0, csa, bid, G, tid); }
        { WSP(bf16_t, keyb, WS_KEYB) cvt_rows_bf16(a.in[16], keyb, (size_t)2 * 8 * 2 * 128 * 128 / 8, bid, G, tid, 512); }
      }
        SEAM(0);
    }
    { constexpr int layer = 0;
        const int pb = 1 + 10 * layer;
        if (IN(pb + 0)) {
            PH_TID() WSP(bf16_t, xb, WS_XB) WSP(bf16_t, x2b, WS_X2B) WSP(bf16_t, wab, WS_WAB) WSP(bf16_t, wcd, WS_WCD) WSP(bf16_t, hb, WS_HB) WSP(float, cs0, WS_CS0) WSP(float, csa, WS_CSA)
            if (layer == 0) {
                pg8::Gemm g{xb, wab, SEQ, 12288, 4096}; pg8::StaticOrder S; S.init(SEQ, 12288, G, bid);
                pg8::EpiProj<0> E{hb, 12288, cs0, csa, nullptr, nullptr, (LDSA float*)(lds + LDS_MISC + 64)};
                pg8::gemm_phase<pg8::EpiProj<0>, pg8::StaticOrder>(lds, g, S, E, nullptr, tid);
            } else {
                pg8::Gemm g{x2b, wcd, SEQ, 9216, 4096}; pg8::StaticOrder S; S.init(SEQ, 9216, G, bid);
                pg8::EpiProj<1> E{hb, 9216, cs0, csa, a.in[10], a.in[11], (LDSA float*)(lds + LDS_MISC + 64)};
                pg8::gemm_phase<pg8::EpiProj<1>, pg8::StaticOrder>(lds, g, S, E, nullptr, tid);
                { const int nu1 = (SEQ / 256) * (9216 / 256), busy = nu1 % G; const bool slack = busy != 0 && busy <= G / 2;
                  if (slack && bid >= busy) {
                      WSP(unsigned char, vb1, WS_VB) WSP(float, isv1, WS_SV)
                      int t5; { int _z = 0; asm volatile("" : "+s"(_z)); t5 = wid_s * 64 + (int)__builtin_amdgcn_mbcnt_hi(~0u, __builtin_amdgcn_mbcnt_lo(~0u, (unsigned)_z)); }
                      table_fp6(a.in[18] + (size_t)16384 * DM, vb1 + (size_t)16384 * ROWB, isv1 + 16384, 16384, (LDSA float*)lds, bid - busy, G - busy, t5); } }
            }
            SEAM(pb + 0);
        }
        if (IN(pb + 2)) {
            PH_TID() WSP(bf16_t, hb, WS_HB) WSP(bf16_t, abb, WS_AB) WSP(float, oc, WS_OC)
            if (layer == 0) attn0_phase(hb, a.in[2], abb, (bf16_t*)oc, (float*)((unsigned char*)oc + (size_t)3 * 8 * SEQ * 128 * 2), (char*)lds_raw, bid, G, tid);
            else attn1_phase(hb, abb, oc, a.in[5], a.in[6], a.in[7], a.in[8], a.in[9], (char*)lds_raw, bid, G, tid);
            SEAM(pb + 2);
        }
        if (layer == 0) {
            if (IN(pb + 3)) {
                PH_TID() WSP(bf16_t, abb, WS_AB) WSP(float, oc, WS_OC)
                merge0_phase((const bf16_t*)oc, (const float*)((unsigned char*)oc + (size_t)3 * 8 * SEQ * 128 * 2), abb, bid, G, tid);
                SEAM(pb + 3);
            }
        } else {
        }
        if (IN(pb + 4)) {
            const int K = layer == 0 ? 3072 : 4096;
            PH_TID() WSP(bf16_t, abb, WS_AB) WSP(bf16_t, woab, WS_WOAB) WSP(bf16_t, wocd, WS_WOCD) WSP(bf16_t, ybuf, WS_Y) WSP(bf16_t, xb, WS_XB) WSP(bf16_t, x2b, WS_X2B)
            pg8::Gemm g{abb, layer == 0 ? woab : wocd, SEQ, 4096, K}; pg8::StaticOrder S; S.init(SEQ, 4096, G, bid);
            pg8::EpiBf16R E{ybuf, 4096, layer == 0 ? xb : x2b, ALPHA};
            pg8::gemm_phase<pg8::EpiBf16R, pg8::StaticOrder>(lds, g, S, E, nullptr, tid);
            SEAM(pb + 4);
        }
        if (IN(pb + 5)) {
            PH_TID() WSP(bf16_t, ybuf, WS_Y) WSP(float, stats, WS_X1) WSP(bf16_t, x1b, WS_X1B)
            ln_phase(ybuf, a.in[13] + layer * DM, a.in[14] + layer * DM, stats, x1b, bid, G, tid);
            SEAM(pb + 5);
        }
        if (IN(pb + 6)) {
            PH_TID() WSP(bf16_t, x1b, WS_X1B) WSP(bf16_t, wq, WS_WQ) WSP(bf16_t, pqb, WS_PQ)
            pg8::Gemm g{x1b, wq + (size_t)layer * 2048 * 4096, SEQ, 2048, 4096}; pg8::StaticOrder S; S.init(SEQ, 2048, G, bid);
            pg8::EpiBf16P E{pqb, 2048};
            pg8::gemm_phase<pg8::EpiBf16P, pg8::StaticOrder>(lds, g, S, E, nullptr, tid);
            asm volatile("s_waitcnt vmcnt(0)" ::: "memory"); __syncthreads();
            { WSP(bf16_t, keyb, WS_KEYB) WSP(int, eidx, WS_EIDX) WSP(float, gate, WS_GATE)
              int t4 = tid; asm volatile("" : "+v"(t4));
              route_mfma_phase(pqb, keyb + (size_t)layer * 8 * 2 * 128 * 128, eidx, gate, (char*)lds_raw, S, t4); }
            SEAM(pb + 6);
        }
        if (IN(pb + 8)) {
            PH_TID() WSP(bf16_t, ybuf, WS_Y) WSP(float, stats, WS_X1) WSP(bf16_t, x1b, WS_X1B) WSP(int, eidx, WS_EIDX) WSP(float, gate, WS_GATE) WSP(unsigned char, ub, WS_UB) WSP(unsigned char, vb, WS_VB) WSP(float, isu, WS_SU) WSP(float, isv, WS_SV) WSP(float, x2, WS_X2) WSP(bf16_t, x2b, WS_X2B)
            peer_expert_phase(ybuf, stats, a.in[13] + layer * DM, a.in[14] + layer * DM, x1b, eidx, gate, ub + (size_t)layer * 16384 * ROWB, vb + (size_t)layer * 16384 * ROWB, isu + layer * 16384, isv + layer * 16384, a.in[19] + layer * DM, a.in[20] + layer * DM,
                              layer == 0 ? (float*)nullptr : a.out, layer == 0 ? x2b : (bf16_t*)nullptr, (LDSA float*)lds, bid, G, tid);
            SEAM(pb + 8);
        }
        }
    { constexpr int layer = 1;
        const int pb = 1 + 10 * layer;
        if (IN(pb + 0)) {
            PH_TID() WSP(bf16_t, xb, WS_XB) WSP(bf16_t, x2b, WS_X2B) WSP(bf16_t, wab, WS_WAB) WSP(bf16_t, wcd, WS_WCD) WSP(bf16_t, hb, WS_HB) WSP(float, cs0, WS_CS0) WSP(float, csa, WS_CSA)
            if (layer == 0) {
                pg8::Gemm g{xb, wab, SEQ, 12288, 4096}; pg8::StaticOrder S; S.init(SEQ, 12288, G, bid);
                pg8::EpiProj<0> E{hb, 12288, cs0, csa, nullptr, nullptr, (LDSA float*)(lds + LDS_MISC + 64)};
                pg8::gemm_phase<pg8::EpiProj<0>, pg8::StaticOrder>(lds, g, S, E, nullptr, tid);
            } else {
                pg8::Gemm g{x2b, wcd, SEQ, 9216, 4096}; pg8::StaticOrder S; S.init(SEQ, 9216, G, bid);
                pg8::EpiProj<1> E{hb, 9216, cs0, csa, a.in[10], a.in[11], (LDSA float*)(lds + LDS_MISC + 64)};
                pg8::gemm_phase<pg8::EpiProj<1>, pg8::StaticOrder>(lds, g, S, E, nullptr, tid);
                { const int nu1 = (SEQ / 256) * (9216 / 256), busy = nu1 % G; const bool slack = busy != 0 && busy <= G / 2;
                  if (slack && bid >= busy) {
                      WSP(unsigned char, vb1, WS_VB) WSP(float, isv1, WS_SV)
                      int t5; { int _z = 0; asm volatile("" : "+s"(_z)); t5 = wid_s * 64 + (int)__builtin_amdgcn_mbcnt_hi(~0u, __builtin_amdgcn_mbcnt_lo(~0u, (unsigned)_z)); }
                      table_fp6(a.in[18] + (size_t)16384 * DM, vb1 + (size_t)16384 * ROWB, isv1 + 16384, 16384, (LDSA float*)lds, bid - busy, G - busy, t5); } }
            }
            SEAM(pb + 0);
        }
        if (IN(pb + 2)) {
            PH_TID() WSP(bf16_t, hb, WS_HB) WSP(bf16_t, abb, WS_AB) WSP(float, oc, WS_OC)
            if (layer == 0) attn0_phase(hb, a.in[2], abb, (bf16_t*)oc, (float*)((unsigned char*)oc + (size_t)3 * 8 * SEQ * 128 * 2), (char*)lds_raw, bid, G, tid);
            else attn1_phase(hb, abb, oc, a.in[5], a.in[6], a.in[7], a.in[8], a.in[9], (char*)lds_raw, bid, G, tid);
            SEAM(pb + 2);
        }
        if (layer == 0) {
            if (IN(pb + 3)) {
                PH_TID() WSP(bf16_t, abb, WS_AB) WSP(float, oc, WS_OC)
                merge0_phase((const bf16_t*)oc, (const float*)((unsigned char*)oc + (size_t)3 * 8 * SEQ * 128 * 2), abb, bid, G, tid);
                SEAM(pb + 3);
            }
        } else {
        }
        if (IN(pb + 4)) {
            const int K = layer == 0 ? 3072 : 4096;
            PH_TID() WSP(bf16_t, abb, WS_AB) WSP(bf16_t, woab, WS_WOAB) WSP(bf16_t, wocd, WS_WOCD) WSP(bf16_t, ybuf, WS_Y) WSP(bf16_t, xb, WS_XB) WSP(bf16_t, x2b, WS_X2B)
            pg8::Gemm g{abb, layer == 0 ? woab : wocd, SEQ, 4096, K}; pg8::StaticOrder S; S.init(SEQ, 4096, G, bid);
            pg8::EpiBf16R E{ybuf, 4096, layer == 0 ? xb : x2b, ALPHA};
            pg8::gemm_phase<pg8::EpiBf16R, pg8::StaticOrder>(lds, g, S, E, nullptr, tid);
            SEAM(pb + 4);
        }
        if (IN(pb + 5)) {
            PH_TID() WSP(bf16_t, ybuf, WS_Y) WSP(float, stats, WS_X1) WSP(bf16_t, x1b, WS_X1B)
            ln_phase(ybuf, a.in[13] + layer * DM, a.in[14] + layer * DM, stats, x1b, bid, G, tid);
            SEAM(pb + 5);
        }
        if (IN(pb + 6)) {
            PH_TID() WSP(bf16_t, x1b, WS_X1B) WSP(bf16_t, wq, WS_WQ) WSP(bf16_t, pqb, WS_PQ)
            pg8::Gemm g{x1b, wq + (size_t)layer * 2048 * 4096, SEQ, 2048, 4096}; pg8::StaticOrder S; S.init(SEQ, 2048, G, bid);
            pg8::EpiBf16P E{pqb, 2048};
            pg8::gemm_phase<pg8::EpiBf16P, pg8::StaticOrder>(lds, g, S, E, nullptr, tid);
            asm volatile("s_waitcnt vmcnt(0)" ::: "memory"); __syncthreads();
            { WSP(bf16_t, keyb, WS_KEYB) WSP(int, eidx, WS_EIDX) WSP(float, gate, WS_GATE)
              int t4 = tid; asm volatile("" : "+v"(t4));
              route_mfma_phase(pqb, keyb + (size_t)layer * 8 * 2 * 128 * 128, eidx, gate, (char*)lds_raw, S, t4); }
            SEAM(pb + 6);
        }
        if (IN(pb + 8)) {
            PH_TID() WSP(bf16_t, ybuf, WS_Y) WSP(float, stats, WS_X1) WSP(bf16_t, x1b, WS_X1B) WSP(int, eidx, WS_EIDX) WSP(float, gate, WS_GATE) WSP(unsigned char, ub, WS_UB) WSP(unsigned char, vb, WS_VB) WSP(float, isu, WS_SU) WSP(float, isv, WS_SV) WSP(float, x2, WS_X2) WSP(bf16_t, x2b, WS_X2B)
            peer_expert_phase(ybuf, stats, a.in[13] + layer * DM, a.in[14] + layer * DM, x1b, eidx, gate, ub + (size_t)layer * 16384 * ROWB, vb + (size_t)layer * 16384 * ROWB, isu + layer * 16384, isv + layer * 16384, a.in[19] + layer * DM, a.in[20] + layer * DM,
                              layer == 0 ? (float*)nullptr : a.out, layer == 0 ? x2b : (bf16_t*)nullptr, (LDSA float*)lds, bid, G, tid);
            SEAM(pb + 8);
        }
        }

#undef IN
}
#ifndef ONE_LAUNCH
#define ONE_LAUNCH 1
#endif
extern "C" void kernel_launch(void* const* d_in, const int* in_sizes, int n_in, void* d_out, int out_size, void* d_ws, size_t ws_size, hipStream_t stream) {
    static int ready = 0;
    if (!ready) {
        if (ws_size < WS_END) { fprintf(stderr, "kernel_launch: workspace too small: %zu < %zu\n", ws_size, (size_t)WS_END); return; }
        if (hipFuncSetAttribute((const void*)mega, hipFuncAttributeMaxDynamicSharedMemorySize, LDS_BYTES) != hipSuccess) { fprintf(stderr, "kernel_launch: hipFuncSetAttribute failed\n"); return; }
        int per_cu = 0;
        if (hipOccupancyMaxActiveBlocksPerMultiprocessor(&per_cu, (const void*)mega, 512, LDS_BYTES) != hipSuccess || per_cu < 1) fprintf(stderr, "kernel_launch: note: occupancy query reports %d blocks per CU\n", per_cu);
        (void)hipGetLastError();
        ready = 1;
    }
    unsigned char* ws = (unsigned char*)d_ws;
    (void)hipMemsetAsync(ws + WS_CTL, 0, CTL_BYTES, stream);
    MK a{}; for (int i = 0; i < 21; ++i) a.in[i] = (const float*)d_in[i];
    a.out = (float*)d_out; a.ws = ws;
#if ONE_LAUNCH
    a.ph_lo = 0; a.ph_hi = N_PHASES;
    hipLaunchKernelGGL(mega, dim3(256), dim3(512), LDS_BYTES, stream, a);
#else
    for (int k = 0; k < N_PHASES; ++k) { if (k == 10 || k == 2 || k == 12 || k == 14 || k == 8 || k == 18) continue; a.ph_lo = k; a.ph_hi = k + 1; hipLaunchKernelGGL(mega, dim3(256), dim3(512), LDS_BYTES, stream, a); }
#endif
    const hipError_t le = hipPeekAtLastError();
    if (le != hipSuccess) fprintf(stderr, "kernel_launch: launch failed: %s\n", hipGetErrorName(le));
}
```
